# Optimizing an MI355X kernel written in HIP

```python
import math
import jax, jax.numpy as jnp
from jax import lax
import numpy as np

D_MODEL = 1024
BATCH = 4
SEQ = 8192
DEPTH = 1

HEAD_DIM = 64
SB_HEADS = 8
MB_HEADS = 8
SB_WIDTH = SB_HEADS * HEAD_DIM
MB_WIDTH = MB_HEADS * HEAD_DIM
SB_QBLOCK = 128
MB_BLOCK = 256
MB_TOPK = 3
MB_QCHUNK = 64
REL_BUCKETS = 32
REL_MAX_DIST = 128
IN_WIDTH = 3 * SB_WIDTH + 3 * MB_WIDTH + 2 * D_MODEL
N_EXPERTS = 64
N_GROUPS = 8
TOPK_GROUPS = 4
TOPK_EXPERTS = 8
EXPERT_FF = 256
SHARED_FF = 256
ROUTED_SCALE = 2.5
MOE_ROW_BLOCK = 256
N_MOD = 6
EPS = 1e-6
NEG = -1e30

kernel_name = "hybrid_stickbreak_moba_moe_adaln"


def rms_norm(x, g):
    x32 = x.astype(jnp.float32)
    y = x32 * lax.rsqrt(jnp.mean(x32 * x32, axis=-1, keepdims=True) + EPS)
    return (y * g.astype(jnp.float32)).astype(x.dtype)


def modulate(h, shift, scale):
    return h * (1.0 + scale[:, None, :]) + shift[:, None, :]


def split_heads(t, n_heads):
    b, s, _ = t.shape
    return t.reshape(b, s, n_heads, HEAD_DIM).transpose(0, 2, 1, 3)


def merge_heads(t):
    b, h, s, d = t.shape
    return t.transpose(0, 2, 1, 3).reshape(b, s, h * d)


def t5_bucket(dist):
    n = jnp.maximum(dist, 0)
    max_exact = REL_BUCKETS // 2
    nf = jnp.maximum(n, 1).astype(jnp.float32)
    large = max_exact + (jnp.log(nf / max_exact) / math.log(REL_MAX_DIST / max_exact)
                         * (REL_BUCKETS - max_exact)).astype(jnp.int32)
    large = jnp.minimum(large, REL_BUCKETS - 1)
    return jnp.where(n < max_exact, n, large)


def stick_breaking_attention(q, k, v):
    s_len = q.shape[2]
    scale = HEAD_DIM ** -0.5
    outs = []
    for i in range(s_len // SB_QBLOCK):
        q0 = i * SB_QBLOCK
        kend = q0 + SB_QBLOCK
        qb = q[:, :, q0:kend]
        kb = k[:, :, :kend]
        vb = v[:, :, :kend]
        z = jnp.einsum('bhqd,bhkd->bhqk', qb, kb).astype(jnp.float32) * scale
        qpos = q0 + jnp.arange(SB_QBLOCK)
        kpos = jnp.arange(kend)
        past = kpos[None, :] < qpos[:, None]
        log_beta = jax.nn.log_sigmoid(z)
        log_rest = jnp.where(past, jax.nn.log_sigmoid(-z), 0.0)
        log_skip = lax.cumsum(log_rest, axis=3, reverse=True) - log_rest
        a = jnp.where(past, jnp.exp(log_beta + log_skip), 0.0)
        outs.append(jnp.einsum('bhqk,bhkd->bhqd', a.astype(v.dtype), vb))
    return jnp.concatenate(outs, axis=2)


def moba_attention(q, k, v, rel_bias):
    b, h, s_len, dh = q.shape
    nb = -(-s_len // MB_BLOCK)
    sp = nb * MB_BLOCK
    pad = ((0, 0), (0, 0), (0, sp - s_len), (0, 0))
    kp = jnp.pad(k, pad)
    vp = jnp.pad(v, pad)
    kblk = kp.reshape(b, h, nb, MB_BLOCK, dh)
    vblk = vp.reshape(b, h, nb, MB_BLOCK, dh)
    kbar = jnp.mean(kblk.astype(jnp.float32), axis=3)
    topk = min(MB_TOPK, nb)
    scale = dh ** -0.5
    bi = jnp.arange(b)[:, None, None, None]
    hi = jnp.arange(h)[None, :, None, None]
    hi5 = hi[..., None]
    offs = jnp.arange(MB_BLOCK)

    def chunk(ci):
        q0 = ci * MB_QCHUNK
        qc = lax.dynamic_slice_in_dim(q, q0, MB_QCHUNK, axis=2)
        qpos = q0 + jnp.arange(MB_QCHUNK)
        blk = q0 // MB_BLOCK
        gate = jnp.einsum('bhqd,bhnd->bhqn', qc.astype(jnp.float32), kbar)
        gate = jnp.where(jnp.arange(nb) < blk, gate, NEG)
        _, sel = lax.top_k(gate, topk)
        valid = sel < blk
        ksel = kblk[bi, hi, sel]
        vsel = vblk[bi, hi, sel]
        kpos_sel = sel[..., None] * MB_BLOCK + offs
        bias_sel = rel_bias[hi5, t5_bucket(qpos[:, None, None] - kpos_sel)]
        s_sel = jnp.einsum('bhqd,bhqjnd->bhqjn', qc, ksel).astype(jnp.float32) * scale + bias_sel
        s_sel = jnp.where(valid[..., None], s_sel, NEG).reshape(b, h, MB_QCHUNK, topk * MB_BLOCK)
        k_own = lax.dynamic_slice_in_dim(kp, blk * MB_BLOCK, MB_BLOCK, axis=2)
        v_own = lax.dynamic_slice_in_dim(vp, blk * MB_BLOCK, MB_BLOCK, axis=2)
        dist = qpos[:, None] - (blk * MB_BLOCK + offs)[None, :]
        s_own = jnp.einsum('bhqd,bhnd->bhqn', qc, k_own).astype(jnp.float32) * scale
        s_own = jnp.where(dist >= 0, s_own + rel_bias[:, t5_bucket(dist)], NEG)
        p = jax.nn.softmax(jnp.concatenate([s_sel, s_own], axis=-1), axis=-1)
        p_sel = p[..., :topk * MB_BLOCK].reshape(b, h, MB_QCHUNK, topk, MB_BLOCK)
        p_own = p[..., topk * MB_BLOCK:]
        return (jnp.einsum('bhqjn,bhqjnd->bhqd', p_sel.astype(v.dtype), vsel)
                + jnp.einsum('bhqn,bhnd->bhqd', p_own.astype(v.dtype), v_own))

    outs = lax.map(chunk, jnp.arange(s_len // MB_QCHUNK))
    return outs.transpose(1, 2, 0, 3, 4).reshape(b, h, s_len, dh)


def swiglu(x, w_gate, w_up, w_down):
    return (jax.nn.silu(x @ w_gate) * (x @ w_up)) @ w_down


def moe_ffn(xt, w_router, router_bias, w_gate_e, w_up_e, w_down_e, w_gate_sh, w_up_sh, w_down_sh):
    t = xt.shape[0]
    scores = jax.nn.sigmoid((xt @ w_router).astype(jnp.float32))
    choice = scores + router_bias.astype(jnp.float32)
    grp = choice.reshape(t, N_GROUPS, N_EXPERTS // N_GROUPS)
    grp_score = jnp.sum(lax.top_k(grp, 2)[0], axis=-1)
    _, gidx = lax.top_k(grp_score, TOPK_GROUPS)
    gmask = jnp.any(gidx[..., None] == jnp.arange(N_GROUPS), axis=1)
    emask = jnp.repeat(gmask, N_EXPERTS // N_GROUPS, axis=1)
    _, eidx = lax.top_k(jnp.where(emask, choice, NEG), TOPK_EXPERTS)
    wts = jnp.take_along_axis(scores, eidx, axis=1)
    wts = wts / jnp.sum(wts, axis=-1, keepdims=True) * ROUTED_SCALE

    n_assign = t * TOPK_EXPERTS
    e_flat = eidx.reshape(n_assign)
    tok_flat = jnp.repeat(jnp.arange(t, dtype=jnp.int32), TOPK_EXPERTS)
    w_flat = wts.reshape(n_assign)
    order = jnp.argsort(e_flat)
    e_s = e_flat[order]
    counts = jnp.bincount(e_flat, length=N_EXPERTS)
    start = jnp.cumsum(counts) - counts
    pcounts = (counts + MOE_ROW_BLOCK - 1) // MOE_ROW_BLOCK * MOE_ROW_BLOCK
    pend = jnp.cumsum(pcounts)
    pstart = pend - pcounts
    dest = pstart[e_s] + (jnp.arange(n_assign) - start[e_s])
    n_blk = -(-n_assign // MOE_ROW_BLOCK) + N_EXPERTS
    n_rows = n_blk * MOE_ROW_BLOCK
    tok_buf = jnp.zeros((n_rows,), jnp.int32).at[dest].set(tok_flat[order])
    w_buf = jnp.zeros((n_rows,), jnp.float32).at[dest].set(w_flat[order])
    blk_expert = jnp.minimum(
        jnp.searchsorted(pend, jnp.arange(n_blk) * MOE_ROW_BLOCK, side='right'), N_EXPERTS - 1)

    def body(acc, bidx):
        rows = lax.dynamic_slice_in_dim(tok_buf, bidx * MOE_ROW_BLOCK, MOE_ROW_BLOCK)
        wr = lax.dynamic_slice_in_dim(w_buf, bidx * MOE_ROW_BLOCK, MOE_ROW_BLOCK)
        e = blk_expert[bidx]
        ye = swiglu(xt[rows], w_gate_e[e], w_up_e[e], w_down_e[e]) * wr[:, None]
        return acc.at[rows].add(ye.astype(acc.dtype)), None

    routed, _ = lax.scan(body, jnp.zeros_like(xt), jnp.arange(n_blk))
    return routed + swiglu(xt, w_gate_sh, w_up_sh, w_down_sh)


def setup_inputs(seed: int = 0) -> dict:
    key = jax.random.key(seed)
    ks = jax.random.split(key, 24)
    f32 = jnp.float32
    L, D, E = DEPTH, D_MODEL, N_EXPERTS

    def nrm(k, shape, s):
        return jax.random.normal(k, shape, f32) * s

    return {
        "x": nrm(ks[0], (BATCH, SEQ, D), 1.0),
        "c": nrm(ks[1], (BATCH, D), 1.0),
        "norm1_g": 1.0 + nrm(ks[2], (L, D), 0.05),
        "norm2_g": 1.0 + nrm(ks[3], (L, D), 0.05),
        "w_ada": nrm(ks[4], (L, D, N_MOD * D), 0.5 * D ** -0.5),
        "b_ada": nrm(ks[5], (L, N_MOD * D), 0.02),
        "w_in": nrm(ks[6], (L, D, IN_WIDTH), D ** -0.5),
        "w_branch_sb": nrm(ks[7], (L, SB_WIDTH, D), SB_WIDTH ** -0.5),
        "w_branch_mb": nrm(ks[8], (L, MB_WIDTH, D), MB_WIDTH ** -0.5),
        "w_out": nrm(ks[9], (L, D, D), D ** -0.5),
        "w_router": nrm(ks[10], (L, D, E), D ** -0.5),
        "router_bias": nrm(ks[11], (L, E), 0.01),
        "w_gate_e": nrm(ks[12], (L, E, D, EXPERT_FF), D ** -0.5),
        "w_up_e": nrm(ks[13], (L, E, D, EXPERT_FF), D ** -0.5),
        "w_down_e": nrm(ks[14], (L, E, EXPERT_FF, D), EXPERT_FF ** -0.5),
        "w_gate_sh": nrm(ks[15], (L, D, SHARED_FF), D ** -0.5),
        "w_up_sh": nrm(ks[16], (L, D, SHARED_FF), D ** -0.5),
        "w_down_sh": nrm(ks[17], (L, SHARED_FF, D), SHARED_FF ** -0.5),
        "rel_bias": nrm(ks[18], (MB_HEADS, REL_BUCKETS), 0.5),
        "final_g": 1.0 + nrm(ks[19], (D,), 0.05),
    }


def reference(x, c, norm1_g, norm2_g, w_ada, b_ada, w_in, w_branch_sb, w_branch_mb, w_out,
              w_router, router_bias, w_gate_e, w_up_e, w_down_e, w_gate_sh, w_up_sh, w_down_sh,
              rel_bias, final_g):
    b, s, d = x.shape
    cuts = [SB_WIDTH, 2 * SB_WIDTH, 3 * SB_WIDTH,
            3 * SB_WIDTH + MB_WIDTH, 3 * SB_WIDTH + 2 * MB_WIDTH, 3 * SB_WIDTH + 3 * MB_WIDTH,
            3 * SB_WIDTH + 3 * MB_WIDTH + D_MODEL]
    for l in range(DEPTH):
        mod = jax.nn.silu(c) @ w_ada[l] + b_ada[l]
        shift1, scale1, gate1, shift2, scale2, gate2 = jnp.split(mod, N_MOD, axis=-1)

        h = modulate(rms_norm(x, norm1_g[l]), shift1, scale1)
        proj = h @ w_in[l]
        q_sb, k_sb, v_sb, q_mb, k_mb, v_mb, g_sb, g_mb = jnp.split(proj, cuts, axis=-1)
        o_sb = stick_breaking_attention(split_heads(q_sb, SB_HEADS), split_heads(k_sb, SB_HEADS),
                                        split_heads(v_sb, SB_HEADS))
        o_mb = moba_attention(split_heads(q_mb, MB_HEADS), split_heads(k_mb, MB_HEADS),
                              split_heads(v_mb, MB_HEADS), rel_bias)
        merged = (jax.nn.sigmoid(g_sb) * (merge_heads(o_sb) @ w_branch_sb[l])
                  + jax.nn.sigmoid(g_mb) * (merge_heads(o_mb) @ w_branch_mb[l]))
        x = x + gate1[:, None, :] * (merged @ w_out[l])

        h2 = modulate(rms_norm(x, norm2_g[l]), shift2, scale2)
        y = moe_ffn(h2.reshape(b * s, d), w_router[l], router_bias[l], w_gate_e[l], w_up_e[l],
                    w_down_e[l], w_gate_sh[l], w_up_sh[l], w_down_sh[l]).reshape(b, s, d)
        x = x + gate2[:, None, :] * y
    return rms_norm(x, final_g)
```

```cpp
#include <hip/hip_runtime.h>
#include <cstdio>
#include <cstdint>

#define LAS __attribute__((address_space(3)))
#define GAS __attribute__((address_space(1)))
typedef unsigned short bf16_t;
typedef short bf16x8 __attribute__((ext_vector_type(8)));
typedef short s16x4 __attribute__((ext_vector_type(4)));
typedef float f32x4 __attribute__((ext_vector_type(4)));
typedef float f32x16 __attribute__((ext_vector_type(16)));
typedef float f32x2 __attribute__((ext_vector_type(2)));
typedef unsigned u32x4 __attribute__((ext_vector_type(4)));
typedef unsigned u32x2 __attribute__((ext_vector_type(2)));
typedef __bf16 bf16x2_t __attribute__((ext_vector_type(2)));

__device__ __forceinline__ unsigned cvtpk(float lo, float hi) { f32x2 v = {lo, hi}; bf16x2_t b = __builtin_convertvector(v, bf16x2_t); return __builtin_bit_cast(unsigned, b); }
__device__ __forceinline__ float bf2f(unsigned short u) { return __uint_as_float(((unsigned)u) << 16); }
__device__ __forceinline__ float bflo(unsigned u) { return __uint_as_float(u << 16); }
__device__ __forceinline__ float bfhi(unsigned u) { return __uint_as_float(u & 0xffff0000u); }

constexpr int NB = 4, SEQ = 8192, DM = 1024, MT = NB * SEQ;
constexpr int NHEAD = 8, HD = 64, QW = 1536;
constexpr int NE = 64, EFF = 256, NMOD = 6 * DM;
constexpr int RT = MT / 2;
constexpr float EPS = 1e-6f;
constexpr float LOG2E = 1.4426950408889634f;

constexpr size_t MiB = 1u << 20;
constexpr size_t WS_CTL = 0, CTL_BYTES = 1 * MiB;
constexpr size_t WS_SMALL = 1 * MiB;
constexpr size_t SM_MOD = 0, SM_GVEC = 98304, SM_CB = 114688, SM_KBAR = 131072, SM_WRT = 393216;
constexpr size_t WS_W2T = 2 * MiB;
constexpr size_t WS_W1T = 35 * MiB;
constexpr size_t WS_WINT = 100 * MiB;
constexpr size_t WS_WBRT = 110 * MiB;
constexpr size_t WS_WOUTT = 112 * MiB;
constexpr size_t WS_H = 114 * MiB;
constexpr size_t WS_OB = 114 * MiB;
constexpr size_t WS_QSB = 178 * MiB;
constexpr size_t WS_PO = 178 * MiB;
constexpr size_t WS_QMB = 274 * MiB;
constexpr size_t WS_MERGED = 274 * MiB;
constexpr size_t WS_G = 370 * MiB;
constexpr size_t WS_LMB = 498 * MiB;
constexpr size_t WS_PLSE = 506 * MiB;
constexpr size_t WS_H2 = 100 * MiB;
constexpr size_t WS_TOKL = 132 * MiB;
constexpr size_t WS_WL = 136 * MiB;
constexpr size_t WS_ACT = 140 * MiB;
constexpr size_t WS_SLOTS = 220 * MiB;
constexpr size_t WS_END = 509 * MiB;
constexpr int CW_MBCUR = 0;
constexpr int CW_MOECUR = 1024;
constexpr int CW_BAR = 4096;

constexpr int RING_BYTES = 131072;
constexpr int MISC_OFF = RING_BYTES;
constexpr int LDS_BYTES = 147456;

#define XB_TMO      128
#define XB_XCNT(j)  (256  + 64 * (j))
#define XB_XSUB(j)  (1280 + 64 * (j))
#define XB_XGEN(j)  (2304 + 64 * (j))
#define XB_TOP      3328
#define XB_TOPGEN   3392
#define XCD_BAR_WORDS 3456
#define XB_SPIN_CAP (1u << 18)
__device__ __forceinline__ unsigned xb_ld(unsigned* p)              { return __hip_atomic_load(p, __ATOMIC_RELAXED, __HIP_MEMORY_SCOPE_AGENT); }
__device__ __forceinline__ unsigned xb_add(unsigned* p, unsigned v) { return __hip_atomic_fetch_add(p, v, __ATOMIC_RELAXED, __HIP_MEMORY_SCOPE_AGENT); }
__device__ __forceinline__ unsigned xb_xcc_id() { return (unsigned)__builtin_amdgcn_s_getreg((3 << 11) | 20) & 0xFu; }
#define XB_SPIN(cond, bar) do { unsigned _sp = 0; while (cond) { __builtin_amdgcn_s_sleep(1); \
    if ((++_sp & 255u) == 0u) { if (xb_ld(&(bar)[XB_TMO])) break; if (_sp > XB_SPIN_CAP) { atomicAdd(&(bar)[XB_TMO], 1u); break; } } } } while (0)
struct XcdBarrier { unsigned* bar; unsigned x; volatile LAS unsigned* st; };
__device__ __forceinline__ XcdBarrier xcd_barrier_post(unsigned* bar, volatile LAS unsigned* st) {
    XcdBarrier b; b.bar = bar; b.x = xb_xcc_id(); b.st = st;
    if (threadIdx.x == 0) (void)xb_add(&bar[XB_XCNT(b.x)], 1u);
    return b;
}
__device__ __forceinline__ void xcd_barrier_complete(unsigned* bar, unsigned x, unsigned& nloc, unsigned& nx) {
    const unsigned G = gridDim.x * gridDim.y * gridDim.z;
    unsigned sum, cnt, mine, sp = 0u;
    for (;;) {
        sum = 0u; cnt = 0u; mine = 0u;
#pragma unroll
        for (unsigned j = 0; j < 16; ++j) { const unsigned c = xb_ld(&bar[XB_XCNT(j)]); sum += c; cnt += (c > 0u) ? 1u : 0u; mine = (j == x) ? c : mine; }
        if (sum == G) break;
        __builtin_amdgcn_s_sleep(1);
        if ((++sp & 255u) == 0u) { if (xb_ld(&bar[XB_TMO])) break; if (sp > XB_SPIN_CAP) { atomicAdd(&bar[XB_TMO], 1u); break; } }
    }
    nloc = mine > 0u ? mine : 1u; nx = cnt > 0u ? cnt : 1u;
}
__device__ __forceinline__ void xcd_barrier(const XcdBarrier& b) {
    asm volatile("s_waitcnt vmcnt(0)" ::: "memory");
    __syncthreads();
    if (threadIdx.x == 0) {
        unsigned* bar = b.bar;
        __builtin_amdgcn_s_waitcnt(0);
        unsigned nloc = b.st[0], nx = b.st[1];
        if (nloc == 0u) { xcd_barrier_complete(bar, b.x, nloc, nx); b.st[0] = nloc; b.st[1] = nx; }
        const unsigned old = xb_add(&bar[XB_XSUB(b.x)], 1u);
        const unsigned gen = old / nloc;
        if (old + 1u == (gen + 1u) * nloc) {
            __builtin_amdgcn_fence(__ATOMIC_RELEASE, "agent");
            asm volatile("s_waitcnt vmcnt(0)" ::: "memory");
            const unsigned og = xb_add(&bar[XB_TOP], 1u);
            const unsigned tg = og / nx;
            if (og + 1u == (tg + 1u) * nx) xb_add(&bar[XB_TOPGEN], 1u);
            else XB_SPIN(xb_ld(&bar[XB_TOPGEN]) == tg, bar);
            __builtin_amdgcn_fence(__ATOMIC_ACQUIRE, "agent");
            xb_add(&bar[XB_XGEN(b.x)], 1u);
            asm volatile("s_waitcnt vmcnt(0)" ::: "memory");
        } else {
            XB_SPIN(xb_ld(&bar[XB_XGEN(b.x)]) == gen, bar);
            __builtin_amdgcn_fence(__ATOMIC_ACQUIRE, "agent");
            asm volatile("s_waitcnt vmcnt(0)" ::: "memory");
        }
    }
    __syncthreads();
}

namespace gm {
constexpr int BM = 256, BK = 64, HALF = 128, HTB = HALF * BK * 2, STAGE_BYTES = 8 * HTB, NXCD = 8, WGM = 8;
__host__ __device__ __forceinline__ int lds_byte(int r, int c) { const int st = (r >> 4) * 2 + (c >> 5), rr = r & 15, cc = c & 31, ob = rr * 64 + cc * 2; return st * 1024 + (ob ^ (((ob >> 9) & 1) << 5)); }
__host__ __device__ __forceinline__ void stage_rc(int b, int& R, int& C) { const int st = b / 1024, sb = b % 1024, swz = sb ^ (((sb >> 9) & 1) << 5); R = (st >> 1) * 16 + swz / 64; C = (st & 1) * 32 + (swz % 64) / 2; }
__host__ __device__ __forceinline__ int perm32(int rho) { const int n = rho >> 4, i = rho & 15; return 8 * (i >> 2) + 4 * n + (i & 3); }

struct UnitD { const char* a; const char* b; unsigned va[2][2]; int e0, e1, e2, e3; };

__device__ __forceinline__ bool static_tile(int M, int N, int G, int c, int i, int& pm, int& pn) {
    const int nM = M / BM, nN = N / BM, nwg = nM * nN;
    const long L = (long)i * G + c; if (L >= nwg) return false;
    int wgid = (int)L; { const int q = nwg / NXCD, r = nwg % NXCD, xcd = wgid % NXCD, off = wgid / NXCD; wgid = (xcd < r ? xcd * (q + 1) : r * (q + 1) + (xcd - r) * q) + off; }
    const int nig = WGM * nN, gid = wgid / nig, fm = gid * WGM, gsz = (nM - fm) < WGM ? (nM - fm) : WGM;
    pm = fm + ((wgid % nig) % gsz); pn = (wgid % nig) / gsz; return true;
}

template <bool PERM, class Epi, class Sched>
__device__ __forceinline__ void gemm_phase(LAS unsigned char* lds, const int K, Sched& S, const Epi& E) {
    const int tid = threadIdx.x, wid = __builtin_amdgcn_readfirstlane(tid >> 6), lane = tid & 63, wr = wid >> 2, wc = wid & 3, fr = lane & 15, fq = lane >> 4;
    const int nt = K / BK;
    unsigned voffB[2];
#pragma unroll
    for (int i = 0; i < 2; ++i) { int R, C; stage_rc(tid * 16 + i * 8192, R, C); const int Rb = PERM ? ((R & ~31) + perm32(R & 31)) : R; voffB[i] = (unsigned)(Rb * K + C) * 2u; }
    const size_t kstep = (size_t)(BK * 2);
    const size_t hstep = (size_t)HALF * K * 2;
    const unsigned ldsw = (unsigned)wid * 1024u;
    const int aoff = lds_byte(wr * 64 + fr, fq * 8), boff = lds_byte(wc * 32 + fr, fq * 8);
#define GM_SA(b, h) (((b) * 2 + (h)) * HTB)
#define GM_SB(b, h) ((4 + (b) * 2 + (h)) * HTB)
#define GM_STAGE_A(bufoff, U, h, kb) do { _Pragma("unroll") for (int _i = 0; _i < 2; ++_i) \
        __builtin_amdgcn_global_load_lds((const unsigned*)((U).a + (kb) + (U).va[h][_i]), (LAS unsigned*)(lds + (bufoff) + ldsw + _i * 8192), 16, 0, 0); } while (0)
#define GM_STAGE_B(bufoff, U, h, kb) do { _Pragma("unroll") for (int _i = 0; _i < 2; ++_i) \
        __builtin_amdgcn_global_load_lds((const unsigned*)((U).b + (kb) + (size_t)(h) * hstep + voffB[_i]), (LAS unsigned*)(lds + (bufoff) + ldsw + _i * 8192), 16, 0, 0); } while (0)
#define GM_LDA(dst, b, h) do { _Pragma("unroll") for (int m = 0; m < 4; ++m) _Pragma("unroll") for (int k = 0; k < 2; ++k) dst[m][k] = *(const LAS bf16x8*)(lds + GM_SA(b, h) + aoff + m * 2048 + k * 1024); } while (0)
#define GM_LDB(dst, b, h) do { _Pragma("unroll") for (int n = 0; n < 2; ++n) _Pragma("unroll") for (int k = 0; k < 2; ++k) dst[n][k] = *(const LAS bf16x8*)(lds + GM_SB(b, h) + boff + n * 2048 + k * 1024); } while (0)
#define GM_MMA(ai, bj, At, Bt) do { __builtin_amdgcn_s_setprio(1); _Pragma("unroll") for (int m = 0; m < 4; ++m) _Pragma("unroll") for (int n = 0; n < 2; ++n) _Pragma("unroll") for (int k = 0; k < 2; ++k) \
        acc[ai][bj][m][n] = __builtin_amdgcn_mfma_f32_16x16x32_bf16(Bt[n][k], At[m][k], acc[ai][bj][m][n], 0, 0, 0); __builtin_amdgcn_s_setprio(0); } while (0)
#define GM_WAIT_V(n) asm volatile("s_waitcnt vmcnt(" #n ")" ::: "memory")
#define GM_WAIT_L(n) asm volatile("s_waitcnt lgkmcnt(" #n ")" ::: "memory")
#define GM_BAR __builtin_amdgcn_s_barrier()
#define GM_SCHED __builtin_amdgcn_sched_barrier(0)
    UnitD cur, nxt; int ui = 0;
    if (!S.next(0, cur)) return;
    f32x4 acc[2][2][4][2];
#pragma unroll
    for (int a = 0; a < 2; ++a)
#pragma unroll
        for (int b = 0; b < 2; ++b)
#pragma unroll
            for (int m = 0; m < 4; ++m)
#pragma unroll
                for (int n = 0; n < 2; ++n) acc[a][b][m][n] = (f32x4){0.f, 0.f, 0.f, 0.f};
    bf16x8 At[4][2], B0[2][2], B1[2][2];
    GM_STAGE_B(GM_SB(0, 0), cur, 0, 0); GM_STAGE_B(GM_SB(0, 1), cur, 1, 0); GM_STAGE_A(GM_SA(0, 0), cur, 0, 0); GM_STAGE_A(GM_SA(0, 1), cur, 1, 0);
    if (wr == 1) GM_BAR;
    GM_WAIT_V(2); GM_BAR;
    GM_STAGE_B(GM_SB(1, 0), cur, 0, kstep); GM_STAGE_A(GM_SA(1, 0), cur, 0, kstep); GM_STAGE_B(GM_SB(1, 1), cur, 1, kstep);
    GM_WAIT_V(6); GM_BAR;
    for (;;) {
        const bool has_next = S.next(ui + 1, nxt);
        if (!has_next) nxt = cur;
#pragma unroll 1
        for (int t = 0; t < nt; t += 2) {
            const bool last = (t == nt - 2);
            const size_t k1 = (size_t)(t + 1) * kstep;
            UnitD U2 = cur; size_t k2 = (size_t)(t + 2) * kstep;
            if (last) { U2 = nxt; k2 = 0; }
            const size_t k3 = k2 + kstep;
            GM_LDB(B0, 0, 0); GM_LDB(B1, 0, 1); GM_SCHED; GM_LDA(At, 0, 0); GM_STAGE_A(GM_SA(1, 1), cur, 1, k1);
            GM_WAIT_V(8); GM_WAIT_L(0); GM_BAR; GM_MMA(0, 0, At, B0); GM_MMA(0, 1, At, B1); GM_BAR; GM_SCHED;
            GM_LDA(At, 0, 1); GM_STAGE_B(GM_SB(0, 0), U2, 0, k2); GM_STAGE_B(GM_SB(0, 1), U2, 1, k2); GM_STAGE_A(GM_SA(0, 0), U2, 0, k2);
            GM_WAIT_V(8); GM_WAIT_L(0); GM_BAR; GM_MMA(1, 0, At, B0); GM_MMA(1, 1, At, B1); GM_BAR; GM_SCHED;
            GM_LDB(B0, 1, 0); GM_LDB(B1, 1, 1); GM_SCHED; GM_LDA(At, 1, 0); GM_STAGE_A(GM_SA(0, 1), U2, 1, k2);
            GM_WAIT_V(8); GM_WAIT_L(0); GM_BAR; GM_MMA(0, 0, At, B0); GM_MMA(0, 1, At, B1); GM_BAR; GM_SCHED;
            GM_LDA(At, 1, 1); GM_STAGE_B(GM_SB(1, 0), U2, 0, k3); GM_STAGE_B(GM_SB(1, 1), U2, 1, k3); GM_STAGE_A(GM_SA(1, 0), U2, 0, k3);
            GM_WAIT_V(8); GM_WAIT_L(0); GM_BAR; GM_MMA(1, 0, At, B0); GM_MMA(1, 1, At, B1); GM_BAR; GM_SCHED;
        }
        if (wr == 0) GM_BAR;
        E(acc, cur, wr, wc, fr, fq);
        if (!has_next) break;
#pragma unroll
        for (int a = 0; a < 2; ++a)
#pragma unroll
            for (int b = 0; b < 2; ++b)
#pragma unroll
                for (int m = 0; m < 4; ++m)
#pragma unroll
                    for (int n = 0; n < 2; ++n) acc[a][b][m][n] = (f32x4){0.f, 0.f, 0.f, 0.f};
        cur = nxt; ++ui;
        if (wr == 1) GM_BAR;
    }
    GM_WAIT_V(0);
    GM_BAR;
#undef GM_SA
#undef GM_SB
#undef GM_STAGE_A
#undef GM_STAGE_B
#undef GM_LDA
#undef GM_LDB
#undef GM_MMA
#undef GM_WAIT_V
#undef GM_WAIT_L
#undef GM_BAR
#undef GM_SCHED
}
__device__ __forceinline__ void stage_geom(int tid, int (&R)[2], int (&C)[2]) {
#pragma unroll
    for (int i = 0; i < 2; ++i) stage_rc(tid * 16 + i * 8192, R[i], C[i]);
}
}

struct Args { const float* in[20]; float* out; unsigned char* ws; int ph_lo, ph_hi; };
struct Ctx {
    LAS unsigned char* lds;
    unsigned char* ws;
    const float* const* in;
    float* out;
    int tid, lane, wave, G, bid;
};
#define LDS_WAIT() asm volatile("s_waitcnt lgkmcnt(0)" ::: "memory")
template <class P> __device__ __forceinline__ P launder_ptr(P p) {
    unsigned long long v = (unsigned long long)p; unsigned lo = (unsigned)v, hi = (unsigned)(v >> 32);
    asm volatile("" : "+v"(lo), "+v"(hi));
    lo = __builtin_amdgcn_readfirstlane(lo); hi = __builtin_amdgcn_readfirstlane(hi);
    return (P)(GAS unsigned char*)(((unsigned long long)hi << 32) | lo);
}
__device__ __forceinline__ void launder(Ctx& F) {
    int t = F.tid, g = F.G, bid = F.bid;
    asm volatile("" : "+v"(t), "+v"(g), "+v"(bid));
    F.tid = t; F.G = __builtin_amdgcn_readfirstlane(g); F.bid = __builtin_amdgcn_readfirstlane(bid); F.lane = t & 63; F.wave = __builtin_amdgcn_readfirstlane(t >> 6);
    F.ws = launder_ptr(F.ws); F.out = launder_ptr(F.out);
}
__device__ __forceinline__ float wave_sum(float v) {
#pragma unroll
    for (int o = 1; o < 64; o <<= 1) v += __shfl_xor(v, o);
    return v;
}
__device__ __forceinline__ int lds_add(LAS int* p, int v) { return __hip_atomic_fetch_add(p, v, __ATOMIC_RELAXED, __HIP_MEMORY_SCOPE_WORKGROUP); }
__device__ __forceinline__ float sigmoidf_(float x) { return 1.f / (1.f + __expf(-x)); }
__device__ __forceinline__ float siluf_(float x) { return x / (1.f + __expf(-x)); }

enum { I_X = 0, I_C, I_N1G, I_N2G, I_WADA, I_BADA, I_WIN, I_WBSB, I_WBMB, I_WOUT, I_WR, I_RB, I_WGE, I_WUE, I_WDE, I_WGS, I_WUS, I_WDS, I_RELB, I_FG };

__device__ __forceinline__ void transpose_item(const float* W, int ldn, int k0, int n0, bf16_t* WT, int Kdst, int drow0, LAS float* scr, int lane) {
#pragma unroll 8
    for (int i = 0; i < 32; ++i) { const int kk = 2 * i + (lane >> 5); scr[kk * 33 + (lane & 31)] = W[(size_t)(k0 + kk) * ldn + n0 + (lane & 31)]; }
    LDS_WAIT(); asm volatile("" ::: "memory");
    const int c = lane & 7;
#pragma unroll
    for (int j = 0; j < 4; ++j) { const int n = (lane >> 3) + 8 * j; const LAS float* s = scr + (8 * c) * 33 + n;
        u32x4 o; o.x = cvtpk(s[0 * 33], s[1 * 33]); o.y = cvtpk(s[2 * 33], s[3 * 33]); o.z = cvtpk(s[4 * 33], s[5 * 33]); o.w = cvtpk(s[6 * 33], s[7 * 33]);
        *(u32x4*)(WT + (size_t)(drow0 + n) * Kdst + k0 + 8 * c) = o; }
    LDS_WAIT(); asm volatile("" ::: "memory");
}
__device__ __forceinline__ void phase0(Ctx& F) {
    LAS float* silc = (LAS float*)(F.lds + MISC_OFF - 0);
    silc = (LAS float*)(F.lds + 0);
    for (int i = F.tid; i < 4 * DM; i += 512) silc[i] = siluf_(F.in[I_C][i]);
    __syncthreads();
    float* mod = (float*)(F.ws + WS_SMALL + SM_MOD);
    {
        const int gw = F.wave * F.G + F.bid;
        const int c = F.lane & 15, kp = F.lane >> 4;
        const float* wada = F.in[I_WADA];
        for (int item = gw; item < NMOD / 16; item += 8 * F.G) {
            const int col = item * 16 + c;
            float a0 = 0.f, a1 = 0.f, a2 = 0.f, a3 = 0.f;
#pragma unroll 8
            for (int k = kp; k < DM; k += 4) { const float w = wada[(size_t)k * NMOD + col]; a0 += silc[k] * w; a1 += silc[DM + k] * w; a2 += silc[2 * DM + k] * w; a3 += silc[3 * DM + k] * w; }
            a0 += __shfl_xor(a0, 16); a0 += __shfl_xor(a0, 32); a1 += __shfl_xor(a1, 16); a1 += __shfl_xor(a1, 32);
            a2 += __shfl_xor(a2, 16); a2 += __shfl_xor(a2, 32); a3 += __shfl_xor(a3, 16); a3 += __shfl_xor(a3, 32);
            if (kp == 0) { const float bb = F.in[I_BADA][col]; mod[col] = a0 + bb; mod[NMOD + col] = a1 + bb; mod[2 * NMOD + col] = a2 + bb; mod[3 * NMOD + col] = a3 + bb; }
        }
    }
    __syncthreads();
    {
        LAS float* scr = (LAS float*)(F.lds + F.wave * 16384);
        const int gw = F.bid * 8 + F.wave, NGW = F.G * 8;
        constexpr int I_IN = 16 * 160, I_BR = 8 * 32, I_OUT = 16 * 32, I_EXP = 384, NIT = I_IN + 2 * I_BR + I_OUT + 65 * I_EXP;
        for (int it = gw; it < NIT; it += NGW) {
            int r = it;
            if (r < I_IN) { const int kb = r / 160, nb = r % 160; transpose_item(F.in[I_WIN], 5120, kb * 64, nb * 32, (bf16_t*)(F.ws + WS_WINT), 1024, nb * 32, scr, F.lane); continue; } r -= I_IN;
            if (r < I_BR) { const int kb = r / 32, nb = r % 32; transpose_item(F.in[I_WBSB], 1024, kb * 64, nb * 32, (bf16_t*)(F.ws + WS_WBRT), 512, nb * 32, scr, F.lane); continue; } r -= I_BR;
            if (r < I_BR) { const int kb = r / 32, nb = r % 32; transpose_item(F.in[I_WBMB], 1024, kb * 64, nb * 32, (bf16_t*)(F.ws + WS_WBRT), 512, 1024 + nb * 32, scr, F.lane); continue; } r -= I_BR;
            if (r < I_OUT) { const int kb = r / 32, nb = r % 32; transpose_item(F.in[I_WOUT], 1024, kb * 64, nb * 32, (bf16_t*)(F.ws + WS_WOUTT), 1024, nb * 32, scr, F.lane); continue; } r -= I_OUT;
            const int e = r / I_EXP; r -= e * I_EXP;
            if (r < 128) {
                const float* src = e < NE ? F.in[I_WGE] + (size_t)e * DM * EFF : F.in[I_WGS];
                const int kb = r / 8, nb = r % 8, n0 = nb * 32;
                transpose_item(src, EFF, kb * 64, n0, (bf16_t*)(F.ws + WS_W1T) + (size_t)e * 512 * 1024, 1024, (n0 >> 7) * 256 + (n0 & 127), scr, F.lane);
            } else if (r < 256) {
                r -= 128;
                const float* src = e < NE ? F.in[I_WUE] + (size_t)e * DM * EFF : F.in[I_WUS];
                const int kb = r / 8, nb = r % 8, n0 = nb * 32;
                transpose_item(src, EFF, kb * 64, n0, (bf16_t*)(F.ws + WS_W1T) + (size_t)e * 512 * 1024, 1024, (n0 >> 7) * 256 + 128 + (n0 & 127), scr, F.lane);
            } else {
                r -= 256;
                const float* src = e < NE ? F.in[I_WDE] + (size_t)e * EFF * DM : F.in[I_WDS];
                const int kb = r / 32, nb = r % 32;
                transpose_item(src, DM, kb * 64, nb * 32, (bf16_t*)(F.ws + WS_W2T) + (size_t)e * 1024 * 256, 256, nb * 32, scr, F.lane);
            }
        }
    }
    {
        float* wrt = (float*)(F.ws + WS_SMALL + SM_WRT);
        const float* wr = F.in[I_WR];
        for (int i = F.bid * 512 + F.tid; i < NE * DM; i += F.G * 512) { const int e = i >> 10, k = i & 1023; wrt[i] = wr[k * NE + e]; }
    }
}

__device__ __forceinline__ void phase1(Ctx& F) {
    const float* mod = (const float*)(F.ws + WS_SMALL + SM_MOD);
    const float* x = F.in[I_X]; const float* g1 = F.in[I_N1G];
    bf16_t* H = (bf16_t*)(F.ws + WS_H);
    const int gw = F.bid * 8 + F.wave, NGW = F.G * 8;
    for (int m = gw; m < MT; m += NGW) {
        const int b = m / SEQ;
        const f32x4* xr = (const f32x4*)(x + (size_t)m * DM) + F.lane;
        f32x4 v[4]; float s = 0.f;
#pragma unroll
        for (int j = 0; j < 4; ++j) { v[j] = xr[64 * j]; s += (v[j].x * v[j].x + v[j].y * v[j].y) + (v[j].z * v[j].z + v[j].w * v[j].w); }
        const float rstd = rsqrtf(wave_sum(s) * (1.f / DM) + EPS);
        u32x2* o8 = (u32x2*)(H + (size_t)m * DM) + F.lane;
#pragma unroll
        for (int j = 0; j < 4; ++j) {
            const int col = 4 * F.lane + 256 * j;
            const f32x4 g = *(const f32x4*)(g1 + col), sh = *(const f32x4*)(mod + b * NMOD + col), sc = *(const f32x4*)(mod + b * NMOD + DM + col);
            const f32x4 h = (v[j] * rstd) * g * (sc + 1.0f) + sh;
            u32x2 w; w.x = cvtpk(h.x, h.y); w.y = cvtpk(h.z, h.w); o8[64 * j] = w;
        }
    }
    if (F.bid == 0) {
        float* gvec = (float*)(F.ws + WS_SMALL + SM_GVEC);
        for (int i = F.tid; i < 4 * DM; i += 512) { const int b = i >> 10, k = i & 1023; gvec[i] = F.in[I_N2G][k] * (1.f + mod[b * NMOD + 4 * DM + k]); }
    }
    if (F.bid == 1 && F.tid < 256) {
        float* cb = (float*)(F.ws + WS_SMALL + SM_CB);
        const int b = F.tid >> 6, e = F.tid & 63; const float* wr = F.in[I_WR]; float a = 0.f;
        for (int k = 0; k < DM; ++k) a += mod[b * NMOD + 3 * DM + k] * wr[k * NE + e];
        cb[F.tid] = a;
    }
}

struct ProjSched {
    const char* A; const char* Bt; int G, c; int R[2], C[2];
    __device__ __forceinline__ bool next(int i, gm::UnitD& u) {
        int pm, pn; if (!gm::static_tile(MT, 5120, G, c, i, pm, pn)) return false;
        u.a = A; u.b = Bt + (size_t)pn * 256 * 1024 * 2;
#pragma unroll
        for (int h = 0; h < 2; ++h)
#pragma unroll
            for (int j = 0; j < 2; ++j) u.va[h][j] = (unsigned)((pm * 256 + h * 128 + R[j]) * 1024 + C[j]) * 2u;
        u.e0 = pm; u.e1 = pn; u.e2 = 0; u.e3 = 0; return true;
    }
};
struct EpiProj {
    bf16_t* qsb; bf16_t* qmb; bf16_t* g;
    __device__ __forceinline__ void operator()(const f32x4 (&acc)[2][2][4][2], const gm::UnitD& u, int wr, int wc, int fr, int fq) const {
        const int pm = u.e0, pn = u.e1;
        bf16_t* base; int ldc, colt; float sc = 1.f;
        if (pn < 6) { base = qsb; ldc = QW; colt = pn * 256; if (pn < 2) sc = 0.125f; }
        else if (pn < 12) { base = qmb; ldc = QW; colt = (pn - 6) * 256; if (pn < 8) sc = 0.125f; }
        else { base = g; ldc = 2048; colt = (pn - 12) * 256; }
        const int row0 = pm * 256 + wr * 64 + fr, col0 = colt + wc * 32 + 8 * fq;
#pragma unroll
        for (int ai = 0; ai < 2; ++ai)
#pragma unroll
            for (int m = 0; m < 4; ++m) { bf16_t* rowp = base + (size_t)(row0 + ai * 128 + m * 16) * ldc + col0;
#pragma unroll
                for (int bj = 0; bj < 2; ++bj) { const f32x4 v0 = acc[ai][bj][m][0] * sc, v1 = acc[ai][bj][m][1] * sc;
                    u32x4 w; w.x = cvtpk(v0[0], v0[1]); w.y = cvtpk(v0[2], v0[3]); w.z = cvtpk(v1[0], v1[1]); w.w = cvtpk(v1[2], v1[3]);
                    *(u32x4*)(rowp + bj * 128) = w; } }
    }
};
__device__ __forceinline__ void phase2(Ctx& F) {
    ProjSched S; S.A = (const char*)(F.ws + WS_H); S.Bt = (const char*)(F.ws + WS_WINT); S.G = F.G; S.c = F.bid; gm::stage_geom(F.tid, S.R, S.C);
    EpiProj E{(bf16_t*)(F.ws + WS_QSB), (bf16_t*)(F.ws + WS_QMB), (bf16_t*)(F.ws + WS_G)};
    gm::gemm_phase<true>(F.lds, 1024, S, E);
}

__device__ __forceinline__ int crow(int r, int hi) { return (r & 3) + 8 * (r >> 2) + 4 * hi; }
typedef short v4i16_t __attribute__((ext_vector_type(4)));
__device__ __forceinline__ s16x4 vtr(const LAS unsigned char* p) { return __builtin_bit_cast(s16x4, __builtin_amdgcn_ds_read_tr16_b64_v4i16((LAS v4i16_t*)p)); }
__device__ __forceinline__ void pv64(f32x16 (&o)[2], const LAS unsigned char* vt, int lane, const u32x4 (&pw)[4]) {
    const int hi = lane >> 5;
    const LAS unsigned char* vb = vt + ((lane >> 4) & 1) * 32 + (lane & 3) * 8 + (4 * hi + ((lane & 15) >> 2)) * 64;
#pragma unroll
    for (int d0 = 0; d0 < 2; ++d0)
#pragma unroll
        for (int ks = 0; ks < 4; ++ks) {
            const s16x4 lo = vtr(vb + d0 * 4096 + ks * 1024), hh = vtr(vb + d0 * 4096 + ks * 1024 + 512);
            const bf16x8 bv = (bf16x8){lo[0], lo[1], lo[2], lo[3], hh[0], hh[1], hh[2], hh[3]};
            o[d0] = __builtin_amdgcn_mfma_f32_32x32x16_bf16(__builtin_bit_cast(bf16x8, pw[ks]), bv, o[d0], 0, 0, 0);
        }
}
__device__ __forceinline__ void store_o_tile(const f32x16 (&o)[2], LAS unsigned char* stgb, int lane, bf16_t* dst0, size_t row_pitch) {
    const int r32 = lane & 31, hi = lane >> 5;
    LAS bf16_t* stg = (LAS bf16_t*)stgb;
#pragma unroll
    for (int r = 0; r < 16; ++r) { const int orow = crow(r, hi);
#pragma unroll
        for (int d0 = 0; d0 < 2; ++d0) stg[orow * 64 + d0 * 32 + r32] = (bf16_t)(cvtpk(o[d0][r], 0.f) & 0xffffu); }
    LDS_WAIT();
#pragma unroll
    for (int i = 0; i < 4; ++i) { const int row = i * 8 + (lane >> 3), ch = lane & 7; const u32x4 v = *(const LAS u32x4*)(stg + row * 64 + ch * 8); *(u32x4*)(dst0 + (size_t)row * row_pitch + ch * 8) = v; }
    LDS_WAIT();
}

__device__ __forceinline__ void sb_unit(Ctx& F, int bh, int qt, LAS unsigned char* vl) {
    const int lane = F.lane, r32 = lane & 31, hi = lane >> 5;
    const int b = bh >> 3, h = bh & 7, q0 = qt * 32, qpos = q0 + r32;
    const bf16_t* base = (const bf16_t*)(F.ws + WS_QSB) + (size_t)b * SEQ * QW + h * 64;
    const bf16_t* Kb = base + 512; const bf16_t* Vb = base + 1024;
    bf16x8 qr[4];
#pragma unroll
    for (int d0 = 0; d0 < 4; ++d0) qr[d0] = *(const bf16x8*)(base + (size_t)qpos * QW + d0 * 16 + hi * 8);
    float R = 0.f; f32x16 o[2]; o[0] = f32x16{}; o[1] = f32x16{};
    for (int kt = q0 >> 6; kt >= 0; --kt) {
        if (__all(R > 105.f)) break;
        const int k0 = kt * 64;
        bf16x8 kf[8];
#pragma unroll
        for (int d0 = 0; d0 < 4; ++d0)
#pragma unroll
            for (int hf = 0; hf < 2; ++hf) kf[2 * d0 + hf] = *(const bf16x8*)(Kb + (size_t)(k0 + r32 + 32 * hf) * QW + d0 * 16 + hi * 8);
#pragma unroll
        for (int p = 0; p < 8; ++p) { const u32x4 v = *(const u32x4*)(Vb + (size_t)(k0 + 16 * (p & 3) + (lane >> 2)) * QW + (p >> 2) * 32 + (lane & 3) * 8); *(LAS u32x4*)(vl + p * 1024 + lane * 16) = v; }
        f32x16 z[2]; z[0] = f32x16{}; z[1] = f32x16{};
#pragma unroll
        for (int d0 = 0; d0 < 4; ++d0) { z[0] = __builtin_amdgcn_mfma_f32_32x32x16_bf16(kf[2 * d0], qr[d0], z[0], 0, 0, 0); z[1] = __builtin_amdgcn_mfma_f32_32x32x16_bf16(kf[2 * d0 + 1], qr[d0], z[1], 0, 0, 0); }
        f32x16 sp[2];
#pragma unroll
        for (int p = 0; p < 2; ++p)
#pragma unroll
            for (int r = 0; r < 16; ++r) { const float zz = z[p][r]; const float s = fmaxf(zz, 0.f) + __logf(1.f + __expf(-fabsf(zz))); const bool valid = (k0 + 32 * p + crow(r, hi)) < qpos; sp[p][r] = valid ? s : 0.f; }
        float Gs[8], PG[8], off[8];
#pragma unroll
        for (int idx = 0; idx < 8; ++idx) { const int p = idx >> 2, g4 = (idx & 3) * 4; Gs[idx] = (sp[p][g4] + sp[p][g4 + 1]) + (sp[p][g4 + 2] + sp[p][g4 + 3]); }
#pragma unroll
        for (int idx = 0; idx < 8; ++idx) PG[idx] = __shfl_xor(Gs[idx], 32);
        float run = R;
#pragma unroll
        for (int idx = 7; idx >= 0; --idx) { off[idx] = run + (hi ? 0.f : PG[idx]); run += (Gs[idx] + PG[idx]); }
        R = run;
        u32x4 pw[4];
#pragma unroll
        for (int idx = 0; idx < 8; ++idx) { const int p = idx >> 2, g4 = (idx & 3) * 4; float c = off[idx]; float a[4];
#pragma unroll
            for (int j = 3; j >= 0; --j) { c += sp[p][g4 + j]; const bool valid = (k0 + 32 * p + crow(g4 + j, hi)) < qpos; a[j] = valid ? __expf(z[p][g4 + j] - c) : 0.f; }
            pw[idx >> 1][(idx & 1) * 2] = cvtpk(a[0], a[1]); pw[idx >> 1][(idx & 1) * 2 + 1] = cvtpk(a[2], a[3]); }
        pv64(o, vl, lane, pw);
    }
    bf16_t* dst = (bf16_t*)(F.ws + WS_OB) + (size_t)(b * SEQ + q0) * 512 + h * 64;
    store_o_tile(o, vl, lane, dst, 512);
}
__device__ __forceinline__ void phase3(Ctx& F) {
    float* kbar = (float*)(F.ws + WS_SMALL + SM_KBAR);
    for (int u = F.bid; u < NB * 32; u += F.G) {
        const bf16_t* kp = (const bf16_t*)(F.ws + WS_QMB) + (size_t)(u * 256) * QW + 512 + F.tid;
        float s = 0.f;
#pragma unroll 8
        for (int r = 0; r < 256; ++r) s += bf2f(kp[(size_t)r * QW]);
        kbar[u * 512 + F.tid] = s * (1.f / 256.f);
    }
    LAS unsigned char* vl = F.lds + F.wave * 8192;
    const int gw = F.bid * 8 + F.wave, NGW = F.G * 8;
    for (int u = gw; u < 32 * 256; u += NGW) sb_unit(F, u >> 8, u & 255, vl);
}

constexpr int MO_LUT = 0, MO_PRE = 4224, MO_WSF = 8320, MO_ENT = 12416, MO_ST = 16368;
__device__ __forceinline__ int mb_list_off(int j) { return 256 * (31 * j - (j * (j - 1)) / 2); }
constexpr int MB_LIST_STRIDE = 126976;
__device__ __forceinline__ int t5_bucket_dev(int n) {
    if (n < 16) return n;
    int large = 16 + (int)(logf((float)n / 16.f) / 2.0794415416798357f * 16.f);
    return large < 31 ? large : 31;
}
__device__ __forceinline__ void build_lut(Ctx& F) {
    LAS float* lut = (LAS float*)(F.lds + MISC_OFF + MO_LUT);
    for (int i = F.tid; i < 8 * 132; i += 512) { const int h = i / 132, d = i % 132; lut[i] = F.in[I_RELB][h * 32 + t5_bucket_dev(d < 128 ? d : 128)] * LOG2E; }
}
__device__ __forceinline__ void phase4(Ctx& F) {
    LAS float* kb = (LAS float*)(F.lds);
    LAS int* lcnt = (LAS int*)(F.lds + MISC_OFF + MO_PRE); LAS int* lbase = lcnt + 32;
    const float* kbar = (const float*)(F.ws + WS_SMALL + SM_KBAR);
    unsigned* cur = (unsigned*)(F.ws + WS_CTL) + CW_MBCUR;
    unsigned short* lists = (unsigned short*)(F.ws + WS_LMB);
    for (int u = F.bid; u < 32 * 31; u += F.G) {
        const int bh = u / 31, i = 1 + (u % 31), b = bh >> 3, h = bh & 7;
        for (int idx = F.tid; idx < i * 64; idx += 512) kb[idx] = kbar[(b * 32 + (idx >> 6)) * 512 + h * 64 + (idx & 63)];
        if (F.tid < 32) lcnt[F.tid] = 0;
        __syncthreads();
        int j0 = -1, j1 = -1, j2 = -1, r0 = 0, r1 = 0, r2 = 0; const int nsel = i < 3 ? i : 3;
        const int qpos = i * 256 + F.tid;
        if (F.tid < 256) {
            float qv[64];
            const u32x4* qp = (const u32x4*)((const bf16_t*)(F.ws + WS_QMB) + (size_t)(b * SEQ + qpos) * QW + h * 64);
#pragma unroll
            for (int c = 0; c < 8; ++c) { const u32x4 w = qp[c];
                qv[8 * c] = bflo(w.x); qv[8 * c + 1] = bfhi(w.x); qv[8 * c + 2] = bflo(w.y); qv[8 * c + 3] = bfhi(w.y);
                qv[8 * c + 4] = bflo(w.z); qv[8 * c + 5] = bfhi(w.z); qv[8 * c + 6] = bflo(w.w); qv[8 * c + 7] = bfhi(w.w); }
            float v0 = -INFINITY, v1 = -INFINITY, v2 = -INFINITY;
            for (int j = 0; j < i; ++j) {
                const LAS f32x4* kr = (const LAS f32x4*)(kb + j * 64);
                float g = 0.f;
#pragma unroll
                for (int c = 0; c < 16; ++c) { const f32x4 kk = kr[c]; g += qv[4 * c] * kk.x + qv[4 * c + 1] * kk.y + qv[4 * c + 2] * kk.z + qv[4 * c + 3] * kk.w; }
                if (g > v0) { v2 = v1; j2 = j1; v1 = v0; j1 = j0; v0 = g; j0 = j; }
                else if (g > v1) { v2 = v1; j2 = j1; v1 = g; j1 = j; }
                else if (g > v2) { v2 = g; j2 = j; }
            }
            r0 = lds_add(&lcnt[j0], 1);
            if (nsel > 1) r1 = lds_add(&lcnt[j1], 1);
            if (nsel > 2) r2 = lds_add(&lcnt[j2], 1);
        }
        __syncthreads();
        if (F.tid < i) { const int n = lcnt[F.tid]; lbase[F.tid] = n > 0 ? (int)atomicAdd(&cur[bh * 32 + F.tid], (unsigned)n) : 0; }
        __syncthreads();
        if (F.tid < 256) {
            unsigned short* lb = lists + (size_t)bh * MB_LIST_STRIDE;
            lb[mb_list_off(j0) + lbase[j0] + r0] = (unsigned short)(qpos | (0 << 13));
            if (nsel > 1) lb[mb_list_off(j1) + lbase[j1] + r1] = (unsigned short)(qpos | (1 << 13));
            if (nsel > 2) lb[mb_list_off(j2) + lbase[j2] + r2] = (unsigned short)(qpos | (2 << 13));
        }
        __syncthreads();
    }
}
__device__ __forceinline__ void stage_kv_block(Ctx& F, const bf16_t* kg, const bf16_t* vg) {
#pragma unroll
    for (int i = 0; i < 4; ++i) { const int id = F.tid + 512 * i, row = id >> 3, ch = id & 7;
        const u32x4 kv = *(const u32x4*)(kg + (size_t)row * QW + ch * 8), vv = *(const u32x4*)(vg + (size_t)row * QW + ch * 8);
        *(LAS u32x4*)(F.lds + (row >> 6) * 8192 + ch * 1024 + (row & 63) * 16) = kv;
        *(LAS u32x4*)(F.lds + 32768 + (row >> 6) * 8192 + (ch >> 2) * 4096 + ((row >> 4) & 3) * 1024 + (row & 15) * 64 + (ch & 3) * 16) = vv; }
}
__device__ __forceinline__ void softmax_step(f32x16 (&t)[2], float& m, float& l, f32x16 (&o)[2], LAS float* wsf, const LAS unsigned char* vt, int lane) {
    const int r32 = lane & 31, hi = lane >> 5;
    float rm = -INFINITY;
#pragma unroll
    for (int p = 0; p < 2; ++p)
#pragma unroll
        for (int r = 0; r < 16; ++r) rm = fmaxf(rm, t[p][r]);
    rm = fmaxf(rm, __shfl_xor(rm, 32));
    const float mn = fmaxf(m, rm);
    const float f = __builtin_amdgcn_exp2f(m - mn);
    m = mn;
    float s = 0.f; u32x4 pw[4];
#pragma unroll
    for (int p = 0; p < 2; ++p)
#pragma unroll
        for (int r = 0; r < 16; ++r) { const float e = __builtin_amdgcn_exp2f(t[p][r] - mn); t[p][r] = e; s += e; }
    l = l * f + s;
#pragma unroll
    for (int idx = 0; idx < 8; ++idx) { const int p = idx >> 2, g4 = (idx & 3) * 4; pw[idx >> 1][(idx & 1) * 2] = cvtpk(t[p][g4], t[p][g4 + 1]); pw[idx >> 1][(idx & 1) * 2 + 1] = cvtpk(t[p][g4 + 2], t[p][g4 + 3]); }
    if (__any(f != 1.f)) {
        if (hi == 0) wsf[r32] = f;
        LDS_WAIT();
#pragma unroll
        for (int g = 0; g < 4; ++g) { const f32x4 fv = *(const LAS f32x4*)(wsf + 8 * g + 4 * hi);
#pragma unroll
            for (int j = 0; j < 4; ++j) { o[0][4 * g + j] *= fv[j]; o[1][4 * g + j] *= fv[j]; } }
        LDS_WAIT();
    }
    pv64(o, vt, lane, pw);
}
__device__ __forceinline__ void qkt64(f32x16 (&t)[2], const LAS unsigned char* kt, const bf16x8 (&qr)[4], int lane) {
    const int r32 = lane & 31, hi = lane >> 5;
    t[0] = f32x16{}; t[1] = f32x16{};
#pragma unroll
    for (int d0 = 0; d0 < 4; ++d0) {
        const bf16x8 k0 = *(const LAS bf16x8*)(kt + (2 * d0 + hi) * 1024 + r32 * 16), k1 = *(const LAS bf16x8*)(kt + (2 * d0 + hi) * 1024 + 512 + r32 * 16);
        t[0] = __builtin_amdgcn_mfma_f32_32x32x16_bf16(k0, qr[d0], t[0], 0, 0, 0); t[1] = __builtin_amdgcn_mfma_f32_32x32x16_bf16(k1, qr[d0], t[1], 0, 0, 0);
    }
}
__device__ __forceinline__ void phase5(Ctx& F) {
    LAS int* pre = (LAS int*)(F.lds + MISC_OFF + MO_PRE);
    LAS int* wtot = (LAS int*)(F.lds + MISC_OFF + MO_ENT);
    const unsigned* cur = (const unsigned*)(F.ws + WS_CTL) + CW_MBCUR;
    build_lut(F);
    int total;
    {
        const int p0 = 2 * F.tid, p1 = p0 + 1;
        const int c0 = p0 < 992 ? (int)((cur[(p0 / 31) * 32 + (p0 % 31)] + 255u) >> 8) : 0;
        const int c1 = p1 < 992 ? (int)((cur[(p1 / 31) * 32 + (p1 % 31)] + 255u) >> 8) : 0;
        const int s = c0 + c1; int v = s;
#pragma unroll
        for (int o = 1; o < 64; o <<= 1) { const int n = __shfl_up(v, o); if (F.lane >= o) v += n; }
        if (F.lane == 63) wtot[248 + F.wave] = v;
        __syncthreads();
        int woff = 0; total = 0;
#pragma unroll
        for (int w = 0; w < 8; ++w) { const int x = wtot[248 + w]; if (w < F.wave) woff += x; total += x; }
        const int excl = woff + v - s;
        pre[p0] = excl; pre[p1] = excl + c0;
        __syncthreads();
    }
    const unsigned short* lists = (const unsigned short*)(F.ws + WS_LMB);
    LAS float* wsf = (LAS float*)(F.lds + MISC_OFF + MO_WSF) + F.wave * 128;
    LAS int* ent = (LAS int*)(F.lds + MISC_OFF + MO_ENT) + F.wave * 32;
    const int lane = F.lane, r32 = lane & 31, hi = lane >> 5;
    for (int u = F.bid; u < total; u += F.G) {
        int lo = 0, hi_ = 992;
        while (hi_ - lo > 1) { const int mid = (lo + hi_) >> 1; if (pre[mid] <= u) lo = mid; else hi_ = mid; }
        const int p = lo, bh = p / 31, j = p % 31, c = u - pre[p], b = bh >> 3, h = bh & 7;
        const int n = (int)cur[bh * 32 + j];
        const bf16_t* base = (const bf16_t*)(F.ws + WS_QMB) + (size_t)b * SEQ * QW + h * 64;
        stage_kv_block(F, base + 512 + (size_t)(j * 256) * QW, base + 1024 + (size_t)(j * 256) * QW);
        __syncthreads();
        const int e0 = c * 256 + F.wave * 32;
        if (e0 < n) {
            const unsigned short* lb = lists + (size_t)bh * MB_LIST_STRIDE + mb_list_off(j);
            const int eidx = e0 + r32; const bool valid = eidx < n;
            const int entry = (int)lb[valid ? eidx : e0];
            const int qpos = entry & 8191, slot = entry >> 13;
            if (hi == 0) ent[r32] = valid ? entry : -1;
            bf16x8 qr[4];
#pragma unroll
            for (int d0 = 0; d0 < 4; ++d0) qr[d0] = *(const bf16x8*)(base + (size_t)qpos * QW + d0 * 16 + hi * 8);
            float m = -INFINITY, l = 0.f; f32x16 o[2]; o[0] = f32x16{}; o[1] = f32x16{};
            const LAS float* lut = (const LAS float*)(F.lds + MISC_OFF + MO_LUT) + h * 132;
            const float bfar = lut[128];
#pragma unroll 1
            for (int st = 0; st < 4; ++st) {
                f32x16 t[2]; qkt64(t, F.lds + st * 8192, qr, lane);
                const int kbase = j * 256 + st * 64;
                const bool far = __all(qpos - (kbase + 63) >= 128);
                if (far) {
#pragma unroll
                    for (int pp = 0; pp < 2; ++pp)
#pragma unroll
                        for (int r = 0; r < 16; ++r) t[pp][r] = t[pp][r] * LOG2E + bfar;
                } else {
#pragma unroll
                    for (int pp = 0; pp < 2; ++pp)
#pragma unroll
                        for (int r = 0; r < 16; ++r) { int d = qpos - (kbase + 32 * pp + crow(r, hi)); d = d < 128 ? d : 128; d = d > 0 ? d : 0; t[pp][r] = t[pp][r] * LOG2E + lut[d]; }
                }
                softmax_step(t, m, l, o, wsf, F.lds + 32768 + st * 8192, lane);
            }
            l += __shfl_xor(l, 32);
            const float rl = 1.f / l;
            if (hi == 0) { wsf[r32] = rl; if (valid) ((float*)(F.ws + WS_PLSE))[((size_t)bh * SEQ + qpos) * 3 + slot] = m + __log2f(l); }
            LDS_WAIT();
            bf16_t* po = (bf16_t*)(F.ws + WS_PO);
#pragma unroll
            for (int r = 0; r < 16; ++r) { const int q = crow(r, hi); const int en = ent[q]; const float sc = wsf[q];
                if (en >= 0) { bf16_t* dst = po + (((size_t)bh * SEQ + (en & 8191)) * 3 + (en >> 13)) * 64 + r32;
                    dst[0] = (bf16_t)(cvtpk(o[0][r] * sc, 0.f) & 0xffffu); dst[32] = (bf16_t)(cvtpk(o[1][r] * sc, 0.f) & 0xffffu); } }
            LDS_WAIT();
        }
        __syncthreads();
    }
}
__device__ __forceinline__ void phase6(Ctx& F) {
    build_lut(F);
    __syncthreads();
    LAS float* wsf = (LAS float*)(F.lds + MISC_OFF + MO_WSF) + F.wave * 128;
    const int lane = F.lane, r32 = lane & 31, hi = lane >> 5, w = F.wave;
    for (int u = F.bid; u < 32 * 32; u += F.G) {
        const int bh = u >> 5, i = 31 - (u & 31), b = bh >> 3, h = bh & 7;
        const bf16_t* base = (const bf16_t*)(F.ws + WS_QMB) + (size_t)b * SEQ * QW + h * 64;
        stage_kv_block(F, base + 512 + (size_t)(i * 256) * QW, base + 1024 + (size_t)(i * 256) * QW);
        __syncthreads();
        const int ql = w * 32 + r32, qpos = i * 256 + ql;
        bf16x8 qr[4];
#pragma unroll
        for (int d0 = 0; d0 < 4; ++d0) qr[d0] = *(const bf16x8*)(base + (size_t)qpos * QW + d0 * 16 + hi * 8);
        float m = -INFINITY, l = 0.f; f32x16 o[2]; o[0] = f32x16{}; o[1] = f32x16{};
        const LAS float* lut = (const LAS float*)(F.lds + MISC_OFF + MO_LUT) + h * 132;
        const int nst = (w >> 1) + 1;
#pragma unroll 1
        for (int st = 0; st < nst; ++st) {
            f32x16 t[2]; qkt64(t, F.lds + st * 8192, qr, lane);
#pragma unroll
            for (int pp = 0; pp < 2; ++pp)
#pragma unroll
                for (int r = 0; r < 16; ++r) { const int d = ql - (st * 64 + 32 * pp + crow(r, hi)); const int dc = d < 128 ? (d > 0 ? d : 0) : 128; const float v = t[pp][r] * LOG2E + lut[dc]; t[pp][r] = d >= 0 ? v : -INFINITY; }
            softmax_step(t, m, l, o, wsf, F.lds + 32768 + st * 8192, lane);
        }
        l += __shfl_xor(l, 32);
        const int nsel = i < 3 ? i : 3;
        const float* plse = (const float*)(F.ws + WS_PLSE) + ((size_t)bh * SEQ + qpos) * 3;
        float ls0 = -INFINITY, ls1 = -INFINITY, ls2 = -INFINITY;
        if (nsel > 0) ls0 = plse[0]; if (nsel > 1) ls1 = plse[1]; if (nsel > 2) ls2 = plse[2];
        const float M = fmaxf(fmaxf(m, ls0), fmaxf(ls1, ls2));
        const float eo = __builtin_amdgcn_exp2f(m - M), e0 = __builtin_amdgcn_exp2f(ls0 - M), e1 = __builtin_amdgcn_exp2f(ls1 - M), e2 = __builtin_amdgcn_exp2f(ls2 - M);
        const float rden = 1.f / (l * eo + e0 + e1 + e2);
        if (hi == 0) *(LAS f32x4*)(wsf + 4 * r32) = (f32x4){eo * rden, e0 * rden, e1 * rden, e2 * rden};
        LDS_WAIT();
        const bf16_t* po = (const bf16_t*)(F.ws + WS_PO) + ((size_t)bh * SEQ + i * 256 + w * 32) * 3 * 64 + r32;
#pragma unroll
        for (int r = 0; r < 16; ++r) { const int q = crow(r, hi); const f32x4 fc = *(const LAS f32x4*)(wsf + 4 * q);
            float a0 = o[0][r] * fc.x, a1 = o[1][r] * fc.x;
            if (nsel > 0) { a0 += fc.y * bf2f(po[(q * 3 + 0) * 64]); a1 += fc.y * bf2f(po[(q * 3 + 0) * 64 + 32]); }
            if (nsel > 1) { a0 += fc.z * bf2f(po[(q * 3 + 1) * 64]); a1 += fc.z * bf2f(po[(q * 3 + 1) * 64 + 32]); }
            if (nsel > 2) { a0 += fc.w * bf2f(po[(q * 3 + 2) * 64]); a1 += fc.w * bf2f(po[(q * 3 + 2) * 64 + 32]); }
            o[0][r] = a0; o[1][r] = a1; }
        LDS_WAIT();
        __syncthreads();
        bf16_t* dst = (bf16_t*)(F.ws + WS_OB) + (size_t)MT * 512 + (size_t)(b * SEQ + i * 256 + w * 32) * 512 + h * 64;
        store_o_tile(o, F.lds + w * 4096, lane, dst, 512);
        __syncthreads();
    }
}

struct BranchSched {
    const char* A; const char* Bt; int G, c; int R[2], C[2];
    __device__ __forceinline__ bool next(int i, gm::UnitD& u) {
        int pm, pn; if (!gm::static_tile(MT, 1024, G, c, i >> 1, pm, pn)) return false;
        const int br = i & 1;
        u.a = A + (size_t)br * MT * 512 * 2; u.b = Bt + (size_t)(br * 1024 + pn * 256) * 512 * 2;
#pragma unroll
        for (int h = 0; h < 2; ++h)
#pragma unroll
            for (int j = 0; j < 2; ++j) u.va[h][j] = (unsigned)((pm * 256 + h * 128 + R[j]) * 512 + C[j]) * 2u;
        u.e0 = pm; u.e1 = pn; u.e2 = br; u.e3 = 0; return true;
    }
};
struct EpiBranch {
    const bf16_t* g; bf16_t* merged;
    __device__ __forceinline__ void operator()(const f32x4 (&acc)[2][2][4][2], const gm::UnitD& u, int wr, int wc, int fr, int fq) const {
        const int pm = u.e0, pn = u.e1, br = u.e2;
        const int row0 = pm * 256 + wr * 64 + fr, col0 = pn * 256 + wc * 32 + 8 * fq;
#pragma unroll
        for (int ai = 0; ai < 2; ++ai)
#pragma unroll
            for (int m = 0; m < 4; ++m) { const size_t row = (size_t)(row0 + ai * 128 + m * 16);
#pragma unroll
                for (int bj = 0; bj < 2; ++bj) {
                    const u32x4 gv = *(const u32x4*)(g + row * 2048 + br * 1024 + col0 + bj * 128);
                    bf16_t* mp = merged + row * 1024 + col0 + bj * 128;
                    const f32x4 v0 = acc[ai][bj][m][0], v1 = acc[ai][bj][m][1];
                    float r[8];
                    r[0] = sigmoidf_(bflo(gv.x)) * v0[0]; r[1] = sigmoidf_(bfhi(gv.x)) * v0[1]; r[2] = sigmoidf_(bflo(gv.y)) * v0[2]; r[3] = sigmoidf_(bfhi(gv.y)) * v0[3];
                    r[4] = sigmoidf_(bflo(gv.z)) * v1[0]; r[5] = sigmoidf_(bfhi(gv.z)) * v1[1]; r[6] = sigmoidf_(bflo(gv.w)) * v1[2]; r[7] = sigmoidf_(bfhi(gv.w)) * v1[3];
                    if (br) { const u32x4 pv = *(const u32x4*)mp;
                        r[0] += bflo(pv.x); r[1] += bfhi(pv.x); r[2] += bflo(pv.y); r[3] += bfhi(pv.y); r[4] += bflo(pv.z); r[5] += bfhi(pv.z); r[6] += bflo(pv.w); r[7] += bfhi(pv.w); }
                    u32x4 w; w.x = cvtpk(r[0], r[1]); w.y = cvtpk(r[2], r[3]); w.z = cvtpk(r[4], r[5]); w.w = cvtpk(r[6], r[7]);
                    *(u32x4*)mp = w; } }
    }
};
__device__ __forceinline__ void phase7(Ctx& F) {
    BranchSched S; S.A = (const char*)(F.ws + WS_OB); S.Bt = (const char*)(F.ws + WS_WBRT); S.G = F.G; S.c = F.bid; gm::stage_geom(F.tid, S.R, S.C);
    EpiBranch E{(const bf16_t*)(F.ws + WS_G), (bf16_t*)(F.ws + WS_MERGED)};
    gm::gemm_phase<true>(F.lds, 512, S, E);
}
struct OutSched {
    const char* A; const char* Bt; int G, c; int R[2], C[2];
    __device__ __forceinline__ bool next(int i, gm::UnitD& u) {
        int pm, pn; if (!gm::static_tile(MT, 1024, G, c, i, pm, pn)) return false;
        u.a = A; u.b = Bt + (size_t)pn * 256 * 1024 * 2;
#pragma unroll
        for (int h = 0; h < 2; ++h)
#pragma unroll
            for (int j = 0; j < 2; ++j) u.va[h][j] = (unsigned)((pm * 256 + h * 128 + R[j]) * 1024 + C[j]) * 2u;
        u.e0 = pm; u.e1 = pn; u.e2 = 0; u.e3 = 0; return true;
    }
};
struct EpiOut {
    const float* x; const float* mod; float* out;
    __device__ __forceinline__ void operator()(const f32x4 (&acc)[2][2][4][2], const gm::UnitD& u, int wr, int wc, int fr, int fq) const {
        const int pm = u.e0, pn = u.e1, b = (pm * 256) / SEQ;
        const int row0 = pm * 256 + wr * 64 + fr, col0 = pn * 256 + wc * 32 + 4 * fq;
        f32x4 gt[2][2];
#pragma unroll
        for (int bj = 0; bj < 2; ++bj)
#pragma unroll
            for (int n = 0; n < 2; ++n) gt[bj][n] = *(const f32x4*)(mod + b * NMOD + 2 * DM + col0 + bj * 128 + n * 16);
#pragma unroll
        for (int ai = 0; ai < 2; ++ai)
#pragma unroll
            for (int m = 0; m < 4; ++m) { const size_t off = (size_t)(row0 + ai * 128 + m * 16) * DM + col0;
#pragma unroll
                for (int bj = 0; bj < 2; ++bj)
#pragma unroll
                    for (int n = 0; n < 2; ++n) { const f32x4 xv = *(const f32x4*)(x + off + bj * 128 + n * 16); *(f32x4*)(out + off + bj * 128 + n * 16) = xv + gt[bj][n] * acc[ai][bj][m][n]; } }
    }
};
__device__ __forceinline__ void phase8(Ctx& F) {
    OutSched S; S.A = (const char*)(F.ws + WS_MERGED); S.Bt = (const char*)(F.ws + WS_WOUTT); S.G = F.G; S.c = F.bid; gm::stage_geom(F.tid, S.R, S.C);
    EpiOut E{F.in[I_X], (const float*)(F.ws + WS_SMALL + SM_MOD), F.out};
    gm::gemm_phase<false>(F.lds, 1024, S, E);
}

constexpr int NR_LG = 0;
__device__ __forceinline__ void phase_n2r(Ctx& F, int rr) {
    const float* x1 = F.out; const float* gvec = (const float*)(F.ws + WS_SMALL + SM_GVEC); const float* cb = (const float*)(F.ws + WS_SMALL + SM_CB);
    const float* mod = (const float*)(F.ws + WS_SMALL + SM_MOD); const float* wrt = (const float*)(F.ws + WS_SMALL + SM_WRT); const float* rbias = F.in[I_RB];
    bf16_t* H2 = (bf16_t*)(F.ws + WS_H2); int* tokl = (int*)(F.ws + WS_TOKL); float* wl = (float*)(F.ws + WS_WL);
    unsigned* cur = (unsigned*)(F.ws + WS_CTL) + CW_MOECUR + rr * 64;
    LAS int* lcnt = (LAS int*)(F.lds + MISC_OFF + MO_PRE); LAS int* lbase = lcnt + 64;
    const int lane = F.lane, w = F.wave, i16 = lane & 15, kk = lane >> 4;
    LAS float* sc = (LAS float*)(F.lds + NR_LG) + w * (16 * 65); LAS float* ch = (LAS float*)(F.lds + NR_LG + 4 * 16 * 65 * 4) + w * (16 * 65);
    for (int u = F.bid; u < RT / 64; u += F.G) {
        if (F.tid < 64) lcnt[F.tid] = 0;
        __syncthreads();
        const int tok0 = rr * RT + u * 64 + w * 16, b = tok0 / SEQ;
        int se[8]; float sw[8]; int sr[8]; float rstd = 0.f;
        if (w < 4) {
            f32x4 acc[4]; acc[0] = acc[1] = acc[2] = acc[3] = (f32x4){0.f, 0.f, 0.f, 0.f};
            float ssq = 0.f;
            const float* xp = x1 + (size_t)(tok0 + i16) * DM + 4 * kk; const float* gp = gvec + b * DM + 4 * kk; const float* wp = wrt + (size_t)i16 * DM + 4 * kk;
#pragma unroll 2
            for (int s = 0; s < 64; ++s) {
                const f32x4 xv = *(const f32x4*)(xp + 16 * s), gv = *(const f32x4*)(gp + 16 * s);
                ssq += (xv.x * xv.x + xv.y * xv.y) + (xv.z * xv.z + xv.w * xv.w);
                const f32x4 a = xv * gv;
                f32x4 bw[4];
#pragma unroll
                for (int ct = 0; ct < 4; ++ct) bw[ct] = *(const f32x4*)(wp + (size_t)ct * 16 * DM + 16 * s);
#pragma unroll
                for (int n = 0; n < 4; ++n)
#pragma unroll
                    for (int ct = 0; ct < 4; ++ct) acc[ct] = __builtin_amdgcn_mfma_f32_16x16x4f32(a[n], bw[ct][n], acc[ct], 0, 0, 0);
            }
            ssq += __shfl_xor(ssq, 16); ssq += __shfl_xor(ssq, 32);
            rstd = rsqrtf(ssq * (1.f / DM) + EPS);
#pragma unroll
            for (int reg = 0; reg < 4; ++reg) { const float rs = __shfl(rstd, 4 * kk + reg);
#pragma unroll
                for (int ct = 0; ct < 4; ++ct) { const int e = 16 * ct + i16; const float lg = acc[ct][reg] * rs + cb[b * 64 + e]; const float s_ = sigmoidf_(lg);
                    sc[(4 * kk + reg) * 65 + e] = s_; ch[(4 * kk + reg) * 65 + e] = s_ + rbias[e]; } }
            LDS_WAIT();
            if (lane < 16) {
                const LAS float* cr = ch + lane * 65; const LAS float* sr_ = sc + lane * 65;
                float gs[8];
#pragma unroll
                for (int g = 0; g < 8; ++g) { float m1 = -INFINITY, m2 = -INFINITY;
#pragma unroll
                    for (int j = 0; j < 8; ++j) { const float v = cr[8 * g + j]; if (v > m1) { m2 = m1; m1 = v; } else if (v > m2) m2 = v; }
                    gs[g] = m1 + m2; }
                unsigned gmask = 0u;
#pragma unroll
                for (int g = 0; g < 8; ++g) { int rank = 0;
#pragma unroll
                    for (int g2 = 0; g2 < 8; ++g2) rank += (gs[g2] > gs[g] || (gs[g2] == gs[g] && g2 < g)) ? 1 : 0;
                    if (rank < 4) gmask |= 1u << g; }
                float wsum = 0.f;
                LAS float* crw = ch + lane * 65;
#pragma unroll
                for (int k = 0; k < 8; ++k) { float best = -INFINITY; int be = 0;
                    for (int e = 0; e < 64; ++e) { const float v = crw[e]; if (((gmask >> (e >> 3)) & 1u) && v > best) { best = v; be = e; } }
                    crw[be] = -INFINITY; se[k] = be; sw[k] = sr_[be]; wsum += sw[k]; }
                const float rn = 2.5f / wsum;
#pragma unroll
                for (int k = 0; k < 8; ++k) { sw[k] *= rn; sr[k] = lds_add(&lcnt[se[k]], 1); }
            }
        }
        __syncthreads();
        if (F.tid < 64) { const int n = lcnt[F.tid]; lbase[F.tid] = n > 0 ? (int)atomicAdd(&cur[F.tid], (unsigned)n) : 0; }
        __syncthreads();
        if (w < 4) {
            if (lane < 16) {
                const int tok = tok0 + lane;
#pragma unroll
                for (int k = 0; k < 8; ++k) { const int pos = lbase[se[k]] + sr[k]; tokl[se[k] * RT + pos] = tok * 8 + k; wl[se[k] * RT + pos] = sw[k]; }
            }
            const float* xp = x1 + (size_t)(tok0 + i16) * DM + 4 * kk; const float* gp = gvec + b * DM + 4 * kk; const float* shp = mod + b * NMOD + 3 * DM + 4 * kk;
            bf16_t* hp = H2 + (size_t)(tok0 - rr * RT + i16) * DM + 4 * kk;
#pragma unroll 4
            for (int s = 0; s < 64; ++s) { const f32x4 xv = *(const f32x4*)(xp + 16 * s), gv = *(const f32x4*)(gp + 16 * s), sh = *(const f32x4*)(shp + 16 * s);
                const f32x4 hv = (xv * rstd) * gv + sh; u32x2 o; o.x = cvtpk(hv.x, hv.y); o.y = cvtpk(hv.z, hv.w); *(u32x2*)(hp + 16 * s) = o; }
        }
        __syncthreads();
    }
}
constexpr int MO_TE = 4224;
struct MoeTabs { const LAS unsigned short* te; const LAS int* tb; const LAS int* cnt; int TR; };
__device__ __forceinline__ MoeTabs build_moe_tabs(Ctx& F, int rr) {
    LAS unsigned short* te = (LAS unsigned short*)(F.lds + MISC_OFF + MO_TE); LAS int* tb = (LAS int*)(F.lds + MISC_OFF + MO_TE + 1536); LAS int* cnt = tb + 72;
    const unsigned* cur = (const unsigned*)(F.ws + WS_CTL) + CW_MOECUR + rr * 64;
    __syncthreads();
    if (F.tid == 0) { int acc = 0; for (int e = 0; e < 64; ++e) { const int c = (int)cur[e]; cnt[e] = c; tb[e] = acc; acc += (c + 255) >> 8; } tb[64] = acc; tb[65] = acc + RT / 256; cnt[64] = RT; }
    __syncthreads();
    const int TR = tb[64];
    for (int e = F.tid >> 3; e < 65; e += 64) for (int t = tb[e] + (F.tid & 7); t < tb[e + 1]; t += 8) te[t] = (unsigned short)e;
    __syncthreads();
    MoeTabs T; T.te = te; T.tb = tb; T.cnt = cnt; T.TR = TR; return T;
}
struct Moe1Sched {
    const char* H2; const char* W1T; const int* tokl; MoeTabs T; int G, c, rr; int R[2], C[2];
    __device__ __forceinline__ bool next(int i, gm::UnitD& u) {
        const int uu = i * G + c; const int nt = T.TR + RT / 256;
        if (uu >= nt * 2) return false;
        const int tile = uu >> 1, pn = uu & 1, e = T.te[tile], rt = tile - T.tb[e], cnt = T.cnt[e];
        u.a = H2; u.b = W1T + (size_t)(e * 512 + pn * 256) * 1024 * 2;
#pragma unroll
        for (int h = 0; h < 2; ++h)
#pragma unroll
            for (int j = 0; j < 2; ++j) { const int idx = rt * 256 + h * 128 + R[j]; int trow;
                if (e < 64) { const int ent = tokl[e * RT + (idx < cnt ? idx : rt * 256)]; trow = (ent >> 3) - rr * RT; } else trow = idx;
                u.va[h][j] = (unsigned)(trow * 1024 + C[j]) * 2u; }
        u.e0 = tile; u.e1 = pn; u.e2 = e; u.e3 = rt; return true;
    }
};
struct EpiMoe1 {
    bf16_t* act;
    __device__ __forceinline__ void operator()(const f32x4 (&acc)[2][2][4][2], const gm::UnitD& u, int wr, int wc, int fr, int fq) const {
        const int row0 = u.e0 * 256 + wr * 64 + fr, col0 = u.e1 * 128 + wc * 32 + 8 * fq;
#pragma unroll
        for (int ai = 0; ai < 2; ++ai)
#pragma unroll
            for (int m = 0; m < 4; ++m) { const f32x4 g0 = acc[ai][0][m][0], g1 = acc[ai][0][m][1], u0 = acc[ai][1][m][0], u1 = acc[ai][1][m][1];
                u32x4 w; w.x = cvtpk(siluf_(g0[0]) * u0[0], siluf_(g0[1]) * u0[1]); w.y = cvtpk(siluf_(g0[2]) * u0[2], siluf_(g0[3]) * u0[3]);
                w.z = cvtpk(siluf_(g1[0]) * u1[0], siluf_(g1[1]) * u1[1]); w.w = cvtpk(siluf_(g1[2]) * u1[2], siluf_(g1[3]) * u1[3]);
                *(u32x4*)(act + (size_t)(row0 + ai * 128 + m * 16) * 256 + col0) = w; }
    }
};
__device__ __forceinline__ void phase_moe1(Ctx& F, int rr) {
    Moe1Sched S; S.T = build_moe_tabs(F, rr); S.H2 = (const char*)(F.ws + WS_H2); S.W1T = (const char*)(F.ws + WS_W1T); S.tokl = (const int*)(F.ws + WS_TOKL); S.G = F.G; S.c = F.bid; S.rr = rr; gm::stage_geom(F.tid, S.R, S.C);
    EpiMoe1 E{(bf16_t*)(F.ws + WS_ACT)};
    gm::gemm_phase<true>(F.lds, 1024, S, E);
}
struct Moe2Sched {
    const char* ACT; const char* W2T; MoeTabs T; int G, c; int R[2], C[2];
    __device__ __forceinline__ bool next(int i, gm::UnitD& u) {
        const int uu = i * G + c; const int nt = T.TR + RT / 256;
        if (uu >= nt * 4) return false;
        const int tile = uu >> 2, pn = uu & 3, e = T.te[tile], rt = tile - T.tb[e];
        u.a = ACT + (size_t)tile * 256 * 256 * 2; u.b = W2T + (size_t)(e * 1024 + pn * 256) * 256 * 2;
#pragma unroll
        for (int h = 0; h < 2; ++h)
#pragma unroll
            for (int j = 0; j < 2; ++j) u.va[h][j] = (unsigned)((h * 128 + R[j]) * 256 + C[j]) * 2u;
        u.e0 = pn; u.e1 = e; u.e2 = rt; u.e3 = T.cnt[e]; return true;
    }
};
struct EpiMoe2 {
    const int* tokl; const float* wl; bf16_t* slots; float* out; const float* mod; int rr;
    __device__ __forceinline__ void operator()(const f32x4 (&acc)[2][2][4][2], const gm::UnitD& u, int wr, int wc, int fr, int fq) const {
        const int pn = u.e0, e = u.e1, rt = u.e2, cnt = u.e3;
        const int col0 = pn * 256 + wc * 32 + 8 * fq;
#pragma unroll
        for (int ai = 0; ai < 2; ++ai)
#pragma unroll
            for (int m = 0; m < 4; ++m) { const int idx = rt * 256 + ai * 128 + wr * 64 + m * 16 + fr;
                if (e < 64) {
                    if (idx < cnt) { const int ent = tokl[e * RT + idx]; const float w = wl[e * RT + idx];
                        bf16_t* dst = slots + ((size_t)((ent >> 3) - rr * RT) * 8 + (ent & 7)) * 1024 + col0;
#pragma unroll
                        for (int bj = 0; bj < 2; ++bj) { const f32x4 v0 = acc[ai][bj][m][0] * w, v1 = acc[ai][bj][m][1] * w;
                            u32x4 o; o.x = cvtpk(v0[0], v0[1]); o.y = cvtpk(v0[2], v0[3]); o.z = cvtpk(v1[0], v1[1]); o.w = cvtpk(v1[2], v1[3]); *(u32x4*)(dst + bj * 128) = o; } }
                } else {
                    const int tok = rr * RT + idx, b = tok / SEQ; float* dst = out + (size_t)tok * DM + col0; const float* g2 = mod + b * NMOD + 5 * DM + col0;
#pragma unroll
                    for (int bj = 0; bj < 2; ++bj)
#pragma unroll
                        for (int n = 0; n < 2; ++n) { const f32x4 xv = *(const f32x4*)(dst + bj * 128 + 4 * n), gv = *(const f32x4*)(g2 + bj * 128 + 4 * n); *(f32x4*)(dst + bj * 128 + 4 * n) = xv + gv * acc[ai][bj][m][n]; }
                }
                asm volatile("" ::: "memory"); }
    }
};
__device__ __forceinline__ void phase_moe2(Ctx& F, int rr) {
    Moe2Sched S; S.T = build_moe_tabs(F, rr); S.ACT = (const char*)(F.ws + WS_ACT); S.W2T = (const char*)(F.ws + WS_W2T); S.G = F.G; S.c = F.bid; gm::stage_geom(F.tid, S.R, S.C);
    EpiMoe2 E{(const int*)(F.ws + WS_TOKL), (const float*)(F.ws + WS_WL), (bf16_t*)(F.ws + WS_SLOTS), F.out, (const float*)(F.ws + WS_SMALL + SM_MOD), rr};
    gm::gemm_phase<true>(F.lds, 256, S, E);
}
__device__ __forceinline__ void phase_final(Ctx& F, int rr) {
    const float* mod = (const float*)(F.ws + WS_SMALL + SM_MOD); const float* fg = F.in[I_FG];
    const bf16_t* slots = (const bf16_t*)(F.ws + WS_SLOTS);
    const int gw = F.bid * 8 + F.wave, NGW = F.G * 8;
    for (int t = gw; t < RT; t += NGW) {
        const int tok = rr * RT + t, b = tok / SEQ;
        f32x4* orow = (f32x4*)(F.out + (size_t)tok * DM) + F.lane;
        f32x4 v[4]; float s = 0.f;
#pragma unroll
        for (int j = 0; j < 4; ++j) {
            const int col = 4 * F.lane + 256 * j;
            f32x4 acc = (f32x4){0.f, 0.f, 0.f, 0.f};
#pragma unroll
            for (int k = 0; k < 8; ++k) { const u32x2 w = *(const u32x2*)(slots + ((size_t)t * 8 + k) * 1024 + col); acc += (f32x4){bflo(w.x), bfhi(w.x), bflo(w.y), bfhi(w.y)}; }
            const f32x4 g2 = *(const f32x4*)(mod + b * NMOD + 5 * DM + col);
            v[j] = orow[64 * j] + g2 * acc;
            s += (v[j].x * v[j].x + v[j].y * v[j].y) + (v[j].z * v[j].z + v[j].w * v[j].w);
        }
        const float rstd = rsqrtf(wave_sum(s) * (1.f / DM) + EPS);
#pragma unroll
        for (int j = 0; j < 4; ++j) { const f32x4 g = *(const f32x4*)(fg + 4 * F.lane + 256 * j); orow[64 * j] = (v[j] * rstd) * g; }
    }
}

constexpr int N_PHASES = 17;
__global__ void __launch_bounds__(512, 2) mega_fwd(Args args) {
    extern __shared__ __attribute__((aligned(16))) unsigned char lds_raw[];
    Ctx F; F.lds = (LAS unsigned char*)lds_raw; F.ws = args.ws; F.in = args.in; F.out = args.out;
    F.tid = threadIdx.x; F.lane = F.tid & 63; F.wave = __builtin_amdgcn_readfirstlane(F.tid >> 6); F.G = gridDim.x; F.bid = blockIdx.x;
    volatile LAS unsigned* st = (volatile LAS unsigned*)(F.lds + MISC_OFF + MO_ST);
    if (F.tid < 4) st[F.tid] = 0u;
    __syncthreads();
    XcdBarrier bar = xcd_barrier_post((unsigned*)(F.ws + WS_CTL) + CW_BAR, st);
    const int lo = args.ph_lo, hi = args.ph_hi;
#ifndef PH_MASK
#define PH_MASK 0x1ffff
#endif
#define IN(k) (((PH_MASK >> (k)) & 1) && lo <= (k) && (k) < hi && (launder(F), true))
#define INQ(k) (((PH_MASK >> (k)) & 1) && lo <= (k) && (k) < hi)
#define SEAM(k) do { if (INQ(k) && INQ((k) + 1)) xcd_barrier(bar); } while (0)
    if (IN(0)) phase0(F);
    SEAM(0);
    if (IN(1)) phase1(F);
    SEAM(1);
    if (IN(2)) phase2(F);
    SEAM(2);
    if (IN(3)) phase3(F);
    SEAM(3);
    if (IN(4)) phase4(F);
    SEAM(4);
    if (IN(5)) phase5(F);
    SEAM(5);
    if (IN(6)) phase6(F);
    SEAM(6);
    if (IN(7)) phase7(F);
    SEAM(7);
    if (IN(8)) phase8(F);
    SEAM(8);
#pragma unroll
    for (int rr = 0; rr < 2; ++rr) {
        const int p = 9 + 4 * rr;
        if (IN(p)) phase_n2r(F, rr);
        SEAM(p);
        if (IN(p + 1)) phase_moe1(F, rr);
        SEAM(p + 1);
        if (IN(p + 2)) phase_moe2(F, rr);
        SEAM(p + 2);
        if (IN(p + 3)) phase_final(F, rr);
        SEAM(p + 3);
    }
#undef IN
#undef SEAM
}

#ifndef MK_SPLIT
#define MK_SPLIT 0
#endif
extern "C" void kernel_launch(void* const* d_in, const int* in_sizes, int n_in, void* d_out, int out_size, void* d_ws, size_t ws_size, hipStream_t stream) {
    static int grid = 0;
    if (grid == 0) {
        if (n_in != 20 || in_sizes[0] != MT * DM || out_size != MT * DM || ws_size < WS_END) { fprintf(stderr, "kernel_launch: unexpected shapes (n_in %d, in0 %d, out %d, ws %zu)\n", n_in, n_in > 0 ? in_sizes[0] : -1, out_size, ws_size); grid = -1; return; }
        int dev = 0, cus = 0;
        if (hipGetDevice(&dev) != hipSuccess || hipDeviceGetAttribute(&cus, hipDeviceAttributeMultiprocessorCount, dev) != hipSuccess) { grid = -1; return; }
        if (hipFuncSetAttribute((const void*)mega_fwd, hipFuncAttributeMaxDynamicSharedMemorySize, LDS_BYTES) != hipSuccess) { fprintf(stderr, "kernel_launch: hipFuncSetAttribute failed\n"); grid = -1; return; }
        int per_cu = 0;
        if (hipOccupancyMaxActiveBlocksPerMultiprocessor(&per_cu, (const void*)mega_fwd, 512, LDS_BYTES) != hipSuccess || per_cu < 1) fprintf(stderr, "kernel_launch: occupancy query reports %d\n", per_cu);
        (void)hipGetLastError();
        grid = cus;
    }
    if (grid < 0) return;
    (void)hipMemsetAsync((char*)d_ws + WS_CTL, 0, CTL_BYTES, stream);
    Args a{};
    for (int i = 0; i < 20; ++i) a.in[i] = (const float*)d_in[i];
    a.out = (float*)d_out; a.ws = (unsigned char*)d_ws;
#if MK_SPLIT
    for (int p = 0; p < N_PHASES; ++p) { a.ph_lo = p; a.ph_hi = p + 1; hipLaunchKernelGGL(mega_fwd, dim3(grid), dim3(512), LDS_BYTES, stream, a); }
#else
    a.ph_lo = 0; a.ph_hi = N_PHASES;
    hipLaunchKernelGGL(mega_fwd, dim3(grid), dim3(512), LDS_BYTES, stream, a);
#endif
}
```

```cpp
#include <hip/hip_runtime.h>
#include <cstdio>
#include <cstdint>

#define LAS __attribute__((address_space(3)))
#define GAS __attribute__((address_space(1)))
typedef unsigned short bf16_t;
typedef short bf16x8 __attribute__((ext_vector_type(8)));
typedef short s16x4 __attribute__((ext_vector_type(4)));
typedef float f32x4 __attribute__((ext_vector_type(4)));
typedef float f32x16 __attribute__((ext_vector_type(16)));
typedef float f32x2 __attribute__((ext_vector_type(2)));
typedef unsigned u32x4 __attribute__((ext_vector_type(4)));
typedef unsigned u32x2 __attribute__((ext_vector_type(2)));
typedef __bf16 bf16x2_t __attribute__((ext_vector_type(2)));

__device__ __forceinline__ unsigned cvtpk(float lo, float hi) { f32x2 v = {lo, hi}; bf16x2_t b = __builtin_convertvector(v, bf16x2_t); return __builtin_bit_cast(unsigned, b); }
__device__ __forceinline__ float bf2f(unsigned short u) { return __uint_as_float(((unsigned)u) << 16); }
__device__ __forceinline__ float bflo(unsigned u) { return __uint_as_float(u << 16); }
__device__ __forceinline__ float bfhi(unsigned u) { return __uint_as_float(u & 0xffff0000u); }

constexpr int NB = 4, SEQ = 8192, DM = 1024, MT = NB * SEQ;
constexpr int NHEAD = 8, HD = 64, QW = 1536;
constexpr int NE = 64, EFF = 256, NMOD = 6 * DM;
constexpr int RT = MT / 2;
constexpr float EPS = 1e-6f;
constexpr float LOG2E = 1.4426950408889634f;

constexpr size_t MiB = 1u << 20;
constexpr size_t WS_CTL = 0, CTL_BYTES = 1 * MiB;
constexpr size_t WS_SMALL = 1 * MiB;
constexpr size_t SM_MOD = 0, SM_GVEC = 98304, SM_CB = 114688, SM_KBAR = 131072, SM_WRT = 393216;
constexpr size_t WS_W2T = 2 * MiB;
constexpr size_t WS_W1T = 35 * MiB;
constexpr size_t WS_WINT = 100 * MiB;
constexpr size_t WS_WBRT = 110 * MiB;
constexpr size_t WS_WOUTT = 112 * MiB;
constexpr size_t WS_H = 114 * MiB;
constexpr size_t WS_OB = 114 * MiB;
constexpr size_t WS_QSB = 178 * MiB;
constexpr size_t WS_PO = 178 * MiB;
constexpr size_t WS_QMB = 274 * MiB;
constexpr size_t WS_MERGED = 274 * MiB;
constexpr size_t WS_G = 370 * MiB;
constexpr size_t WS_LMB = 498 * MiB;
constexpr size_t WS_PLSE = 506 * MiB;
constexpr size_t WS_H2 = 100 * MiB;
constexpr size_t WS_TOKL = 132 * MiB;
constexpr size_t WS_WL = 136 * MiB;
constexpr size_t WS_ACT = 140 * MiB;
constexpr size_t WS_SLOTS = 220 * MiB;
constexpr size_t WS_END = 509 * MiB;
constexpr int CW_MBCUR = 0;
constexpr int CW_MOECUR = 1024;
constexpr int CW_BAR = 4096;

constexpr int RING_BYTES = 131072;
constexpr int MISC_OFF = RING_BYTES;
constexpr int LDS_BYTES = 147456;

#define XB_TMO      128
#define XB_XCNT(j)  (256  + 64 * (j))
#define XB_XSUB(j)  (1280 + 64 * (j))
#define XB_XGEN(j)  (2304 + 64 * (j))
#define XB_TOP      3328
#define XB_TOPGEN   3392
#define XCD_BAR_WORDS 3456
#define XB_SPIN_CAP (1u << 18)
__device__ __forceinline__ unsigned xb_ld(unsigned* p)              { return __hip_atomic_load(p, __ATOMIC_RELAXED, __HIP_MEMORY_SCOPE_AGENT); }
__device__ __forceinline__ unsigned xb_add(unsigned* p, unsigned v) { return __hip_atomic_fetch_add(p, v, __ATOMIC_RELAXED, __HIP_MEMORY_SCOPE_AGENT); }
__device__ __forceinline__ unsigned xb_xcc_id() { return (unsigned)__builtin_amdgcn_s_getreg((3 << 11) | 20) & 0xFu; }
#define XB_SPIN(cond, bar) do { unsigned _sp = 0; while (cond) { __builtin_amdgcn_s_sleep(1); \
    if ((++_sp & 255u) == 0u) { if (xb_ld(&(bar)[XB_TMO])) break; if (_sp > XB_SPIN_CAP) { atomicAdd(&(bar)[XB_TMO], 1u); break; } } } } while (0)
struct XcdBarrier { unsigned* bar; unsigned x; volatile LAS unsigned* st; };
__device__ __forceinline__ XcdBarrier xcd_barrier_post(unsigned* bar, volatile LAS unsigned* st) {
    XcdBarrier b; b.bar = bar; b.x = xb_xcc_id(); b.st = st;
    if (threadIdx.x == 0) (void)xb_add(&bar[XB_XCNT(b.x)], 1u);
    return b;
}
__device__ __forceinline__ void xcd_barrier_complete(unsigned* bar, unsigned x, unsigned& nloc, unsigned& nx) {
    const unsigned G = gridDim.x * gridDim.y * gridDim.z;
    unsigned sum, cnt, mine, sp = 0u;
    for (;;) {
        sum = 0u; cnt = 0u; mine = 0u;
#pragma unroll
        for (unsigned j = 0; j < 16; ++j) { const unsigned c = xb_ld(&bar[XB_XCNT(j)]); sum += c; cnt += (c > 0u) ? 1u : 0u; mine = (j == x) ? c : mine; }
        if (sum == G) break;
        __builtin_amdgcn_s_sleep(1);
        if ((++sp & 255u) == 0u) { if (xb_ld(&bar[XB_TMO])) break; if (sp > XB_SPIN_CAP) { atomicAdd(&bar[XB_TMO], 1u); break; } }
    }
    nloc = mine > 0u ? mine : 1u; nx = cnt > 0u ? cnt : 1u;
}
__device__ __forceinline__ void xcd_barrier(const XcdBarrier& b) {
    asm volatile("s_waitcnt vmcnt(0)" ::: "memory");
    __syncthreads();
    if (threadIdx.x == 0) {
        unsigned* bar = b.bar;
        __builtin_amdgcn_s_waitcnt(0);
        unsigned nloc = b.st[0], nx = b.st[1];
        const unsigned old = xb_add(&bar[XB_XSUB(b.x)], 1u);
        const unsigned gen = old / nloc;
        if (old + 1u == (gen + 1u) * nloc) {
            __builtin_amdgcn_fence(__ATOMIC_RELEASE, "agent");
            asm volatile("s_waitcnt vmcnt(0)" ::: "memory");
            const unsigned og = xb_add(&bar[XB_TOP], 1u);
            const unsigned tg = og / nx;
            if (og + 1u == (tg + 1u) * nx) xb_add(&bar[XB_TOPGEN], 1u);
            else XB_SPIN(xb_ld(&bar[XB_TOPGEN]) == tg, bar);
            __builtin_amdgcn_fence(__ATOMIC_ACQUIRE, "agent");
            xb_add(&bar[XB_XGEN(b.x)], 1u);
            asm volatile("s_waitcnt vmcnt(0)" ::: "memory");
        } else {
            XB_SPIN(xb_ld(&bar[XB_XGEN(b.x)]) == gen, bar);
            __builtin_amdgcn_fence(__ATOMIC_ACQUIRE, "agent");
            asm volatile("s_waitcnt vmcnt(0)" ::: "memory");
        }
    }
    __syncthreads();
}

namespace gm {
constexpr int BM = 256, BK = 64, HALF = 128, HTB = HALF * BK * 2, STAGE_BYTES = 8 * HTB, NXCD = 8, WGM = 8;
__host__ __device__ __forceinline__ int lds_byte(int r, int c) { const int st = (r >> 4) * 2 + (c >> 5), rr = r & 15, cc = c & 31, ob = rr * 64 + cc * 2; return st * 1024 + (ob ^ (((ob >> 9) & 1) << 5)); }
__host__ __device__ __forceinline__ void stage_rc(int b, int& R, int& C) { const int st = b / 1024, sb = b % 1024, swz = sb ^ (((sb >> 9) & 1) << 5); R = (st >> 1) * 16 + swz / 64; C = (st & 1) * 32 + (swz % 64) / 2; }
__host__ __device__ __forceinline__ int perm32(int rho) { const int n = rho >> 4, i = rho & 15; return 8 * (i >> 2) + 4 * n + (i & 3); }

struct UnitD { const char* a; const char* b; unsigned va[2][2]; int e0, e1, e2, e3; };

__device__ __forceinline__ bool static_tile(int M, int N, int G, int c, int i, int& pm, int& pn) {
    const int nM = M / BM, nN = N / BM, nwg = nM * nN;
    const long L = (long)i * G + c; if (L >= nwg) return false;
    int wgid = (int)L; { const int q = nwg / NXCD, r = nwg % NXCD, xcd = wgid % NXCD, off = wgid / NXCD; wgid = (xcd < r ? xcd * (q + 1) : r * (q + 1) + (xcd - r) * q) + off; }
    const int nig = WGM * nN, gid = wgid / nig, fm = gid * WGM, gsz = (nM - fm) < WGM ? (nM - fm) : WGM;
    pm = fm + ((wgid % nig) % gsz); pn = (wgid % nig) / gsz; return true;
}

template <bool PERM, class Epi, class Sched>
__device__ __forceinline__ void gemm_phase(LAS unsigned char* lds, const int K, Sched& S, const Epi& E) {
    const int tid = threadIdx.x, wid = __builtin_amdgcn_readfirstlane(tid >> 6), lane = tid & 63, wr = wid >> 2, wc = wid & 3, fr = lane & 15, fq = lane >> 4;
    const int nt = K / BK;
    unsigned voffB[2];
#pragma unroll
    for (int i = 0; i < 2; ++i) { int R, C; stage_rc(tid * 16 + i * 8192, R, C); const int Rb = PERM ? ((R & ~31) + perm32(R & 31)) : R; voffB[i] = (unsigned)(Rb * K + C) * 2u; }
    const size_t kstep = (size_t)(BK * 2);
    const size_t hstep = (size_t)HALF * K * 2;
    const unsigned ldsw = (unsigned)wid * 1024u;
    const int aoff = lds_byte(wr * 64 + fr, fq * 8), boff = lds_byte(wc * 32 + fr, fq * 8);
#define GM_SA(b, h) (((b) * 2 + (h)) * HTB)
#define GM_SB(b, h) ((4 + (b) * 2 + (h)) * HTB)
#define GM_STAGE_A(bufoff, U, h, kb) do { _Pragma("unroll") for (int _i = 0; _i < 2; ++_i) \
        __builtin_amdgcn_global_load_lds((const unsigned*)((U).a + (kb) + (U).va[h][_i]), (LAS unsigned*)(lds + (bufoff) + ldsw + _i * 8192), 16, 0, 0); } while (0)
#define GM_STAGE_B(bufoff, U, h, kb) do { _Pragma("unroll") for (int _i = 0; _i < 2; ++_i) \
        __builtin_amdgcn_global_load_lds((const unsigned*)((U).b + (kb) + (size_t)(h) * hstep + voffB[_i]), (LAS unsigned*)(lds + (bufoff) + ldsw + _i * 8192), 16, 0, 0); } while (0)
#define GM_LDA(dst, b, h) do { _Pragma("unroll") for (int m = 0; m < 4; ++m) _Pragma("unroll") for (int k = 0; k < 2; ++k) dst[m][k] = *(const LAS bf16x8*)(lds + GM_SA(b, h) + aoff + m * 2048 + k * 1024); } while (0)
#define GM_LDB(dst, b, h) do { _Pragma("unroll") for (int n = 0; n < 2; ++n) _Pragma("unroll") for (int k = 0; k < 2; ++k) dst[n][k] = *(const LAS bf16x8*)(lds + GM_SB(b, h) + boff + n * 2048 + k * 1024); } while (0)
#define GM_MMA(ai, bj, At, Bt) do { __builtin_amdgcn_s_setprio(1); _Pragma("unroll") for (int m = 0; m < 4; ++m) _Pragma("unroll") for (int n = 0; n < 2; ++n) _Pragma("unroll") for (int k = 0; k < 2; ++k) \
        acc[ai][bj][m][n] = __builtin_amdgcn_mfma_f32_16x16x32_bf16(Bt[n][k], At[m][k], acc[ai][bj][m][n], 0, 0, 0); __builtin_amdgcn_s_setprio(0); } while (0)
#define GM_WAIT_V(n) asm volatile("s_waitcnt vmcnt(" #n ")" ::: "memory")
#define GM_WAIT_L(n) asm volatile("s_waitcnt lgkmcnt(" #n ")" ::: "memory")
#define GM_BAR __builtin_amdgcn_s_barrier()
#define GM_SCHED __builtin_amdgcn_sched_barrier(0)
    UnitD cur, nxt; int ui = 0;
    if (!S.next(0, cur)) return;
    f32x4 acc[2][2][4][2];
#pragma unroll
    for (int a = 0; a < 2; ++a)
#pragma unroll
        for (int b = 0; b < 2; ++b)
#pragma unroll
            for (int m = 0; m < 4; ++m)
#pragma unroll
                for (int n = 0; n < 2; ++n) acc[a][b][m][n] = (f32x4){0.f, 0.f, 0.f, 0.f};
    bf16x8 At[4][2], B0[2][2], B1[2][2];
    GM_STAGE_B(GM_SB(0, 0), cur, 0, 0); GM_STAGE_B(GM_SB(0, 1), cur, 1, 0); GM_STAGE_A(GM_SA(0, 0), cur, 0, 0); GM_STAGE_A(GM_SA(0, 1), cur, 1, 0);
    if (wr == 1) GM_BAR;
    GM_WAIT_V(2); GM_BAR;
    GM_STAGE_B(GM_SB(1, 0), cur, 0, kstep); GM_STAGE_A(GM_SA(1, 0), cur, 0, kstep); GM_STAGE_B(GM_SB(1, 1), cur, 1, kstep);
    GM_WAIT_V(6); GM_BAR;
    for (;;) {
        const bool has_next = S.next(ui + 1, nxt);
        if (!has_next) nxt = cur;
#pragma unroll 1
        for (int t = 0; t < nt; t += 2) {
            const bool last = (t == nt - 2);
            const size_t k1 = (size_t)(t + 1) * kstep;
            UnitD U2 = cur; size_t k2 = (size_t)(t + 2) * kstep;
            if (last) { U2 = nxt; k2 = 0; }
            const size_t k3 = k2 + kstep;
            GM_LDB(B0, 0, 0); GM_LDB(B1, 0, 1); GM_SCHED; GM_LDA(At, 0, 0); GM_STAGE_A(GM_SA(1, 1), cur, 1, k1);
            GM_WAIT_V(8); GM_WAIT_L(0); GM_BAR; GM_MMA(0, 0, At, B0); GM_MMA(0, 1, At, B1); GM_BAR; GM_SCHED;
            GM_LDA(At, 0, 1); GM_STAGE_B(GM_SB(0, 0), U2, 0, k2); GM_STAGE_B(GM_SB(0, 1), U2, 1, k2); GM_STAGE_A(GM_SA(0, 0), U2, 0, k2);
            GM_WAIT_V(8); GM_WAIT_L(0); GM_BAR; GM_MMA(1, 0, At, B0); GM_MMA(1, 1, At, B1); GM_BAR; GM_SCHED;
            GM_LDB(B0, 1, 0); GM_LDB(B1, 1, 1); GM_SCHED; GM_LDA(At, 1, 0); GM_STAGE_A(GM_SA(0, 1), U2, 1, k2);
            GM_WAIT_V(8); GM_WAIT_L(0); GM_BAR; GM_MMA(0, 0, At, B0); GM_MMA(0, 1, At, B1); GM_BAR; GM_SCHED;
            GM_LDA(At, 1, 1); GM_STAGE_B(GM_SB(1, 0), U2, 0, k3); GM_STAGE_B(GM_SB(1, 1), U2, 1, k3); GM_STAGE_A(GM_SA(1, 0), U2, 0, k3);
            GM_WAIT_V(8); GM_WAIT_L(0); GM_BAR; GM_MMA(1, 0, At, B0); GM_MMA(1, 1, At, B1); GM_BAR; GM_SCHED;
        }
        if (wr == 0) GM_BAR;
        E(acc, cur, wr, wc, fr, fq);
        if (!has_next) break;
#pragma unroll
        for (int a = 0; a < 2; ++a)
#pragma unroll
            for (int b = 0; b < 2; ++b)
#pragma unroll
                for (int m = 0; m < 4; ++m)
#pragma unroll
                    for (int n = 0; n < 2; ++n) acc[a][b][m][n] = (f32x4){0.f, 0.f, 0.f, 0.f};
        cur = nxt; ++ui;
        if (wr == 1) GM_BAR;
    }
    GM_WAIT_V(0);
    GM_BAR;
#undef GM_SA
#undef GM_SB
#undef GM_STAGE_A
#undef GM_STAGE_B
#undef GM_LDA
#undef GM_LDB
#undef GM_MMA
#undef GM_WAIT_V
#undef GM_WAIT_L
#undef GM_BAR
#undef GM_SCHED
}
__device__ __forceinline__ void stage_geom(int tid, int (&R)[2], int (&C)[2]) {
#pragma unroll
    for (int i = 0; i < 2; ++i) stage_rc(tid * 16 + i * 8192, R[i], C[i]);
}
}

struct Args { const float* in[20]; float* out; unsigned char* ws; int ph_lo, ph_hi; };
struct Ctx {
    LAS unsigned char* lds;
    unsigned char* ws;
    const LAS unsigned long long* intab;
    float* out;
    int tid, lane, wave, G, bid;
};
#define LDS_WAIT() asm volatile("s_waitcnt lgkmcnt(0)" ::: "memory")
__device__ __forceinline__ const float* inp(const Ctx& F, int i) {
    const unsigned long long v = F.intab[i];
    const unsigned lo = __builtin_amdgcn_readfirstlane((unsigned)v), hi = __builtin_amdgcn_readfirstlane((unsigned)(v >> 32));
    return (const float*)(GAS const float*)(((unsigned long long)hi << 32) | lo);
}
template <class P> __device__ __forceinline__ P launder_ptr(P p) {
    unsigned long long v = (unsigned long long)p; unsigned lo = (unsigned)v, hi = (unsigned)(v >> 32);
    asm volatile("" : "+v"(lo), "+v"(hi));
    lo = __builtin_amdgcn_readfirstlane(lo); hi = __builtin_amdgcn_readfirstlane(hi);
    return (P)(GAS unsigned char*)(((unsigned long long)hi << 32) | lo);
}
__device__ __forceinline__ void launder(Ctx& F) {
    int t = F.tid, g = F.G, bid = F.bid;
    asm volatile("" : "+v"(t), "+v"(g), "+v"(bid));
    F.tid = t; F.G = __builtin_amdgcn_readfirstlane(g); F.bid = __builtin_amdgcn_readfirstlane(bid); F.lane = t & 63; F.wave = __builtin_amdgcn_readfirstlane(t >> 6);
    F.ws = launder_ptr(F.ws); F.out = launder_ptr(F.out);
}
__device__ __forceinline__ float wave_sum(float v) {
#pragma unroll
    for (int o = 1; o < 64; o <<= 1) v += __shfl_xor(v, o);
    return v;
}
__device__ __forceinline__ int lds_add(LAS int* p, int v) { return __hip_atomic_fetch_add(p, v, __ATOMIC_RELAXED, __HIP_MEMORY_SCOPE_WORKGROUP); }
__device__ __forceinline__ float sigmoidf_(float x) { return 1.f / (1.f + __expf(-x)); }
__device__ __forceinline__ float siluf_(float x) { return x / (1.f + __expf(-x)); }

enum { I_X = 0, I_C, I_N1G, I_N2G, I_WADA, I_BADA, I_WIN, I_WBSB, I_WBMB, I_WOUT, I_WR, I_RB, I_WGE, I_WUE, I_WDE, I_WGS, I_WUS, I_WDS, I_RELB, I_FG };

__device__ __forceinline__ void transpose_item(const float* W, int ldn, int k0, int n0, bf16_t* WT, int Kdst, int drow0, LAS float* scr, int lane) {
#pragma unroll 8
    for (int i = 0; i < 32; ++i) { const int kk = 2 * i + (lane >> 5); scr[kk * 33 + (lane & 31)] = W[(size_t)(k0 + kk) * ldn + n0 + (lane & 31)]; }
    LDS_WAIT(); asm volatile("" ::: "memory");
    const int c = lane & 7;
#pragma unroll
    for (int j = 0; j < 4; ++j) { const int n = (lane >> 3) + 8 * j; const LAS float* s = scr + (8 * c) * 33 + n;
        u32x4 o; o.x = cvtpk(s[0 * 33], s[1 * 33]); o.y = cvtpk(s[2 * 33], s[3 * 33]); o.z = cvtpk(s[4 * 33], s[5 * 33]); o.w = cvtpk(s[6 * 33], s[7 * 33]);
        *(u32x4*)(WT + (size_t)(drow0 + n) * Kdst + k0 + 8 * c) = o; }
    LDS_WAIT(); asm volatile("" ::: "memory");
}
__device__ __forceinline__ void phase0(Ctx& F) {
    LAS float* silc = (LAS float*)(F.lds + MISC_OFF - 0);
    silc = (LAS float*)(F.lds + 0);
    for (int i = F.tid; i < 4 * DM; i += 512) silc[i] = siluf_(inp(F, I_C)[i]);
    __syncthreads();
    float* mod = (float*)(F.ws + WS_SMALL + SM_MOD);
    {
        const int gw = F.wave * F.G + F.bid;
        const int c = F.lane & 15, kp = F.lane >> 4;
        const float* wada = inp(F, I_WADA);
        for (int item = gw; item < NMOD / 16; item += 8 * F.G) {
            const int col = item * 16 + c;
            float a0 = 0.f, a1 = 0.f, a2 = 0.f, a3 = 0.f;
#pragma unroll 8
            for (int k = kp; k < DM; k += 4) { const float w = wada[(size_t)k * NMOD + col]; a0 += silc[k] * w; a1 += silc[DM + k] * w; a2 += silc[2 * DM + k] * w; a3 += silc[3 * DM + k] * w; }
            a0 += __shfl_xor(a0, 16); a0 += __shfl_xor(a0, 32); a1 += __shfl_xor(a1, 16); a1 += __shfl_xor(a1, 32);
            a2 += __shfl_xor(a2, 16); a2 += __shfl_xor(a2, 32); a3 += __shfl_xor(a3, 16); a3 += __shfl_xor(a3, 32);
            if (kp == 0) { const float bb = inp(F, I_BADA)[col]; mod[col] = a0 + bb; mod[NMOD + col] = a1 + bb; mod[2 * NMOD + col] = a2 + bb; mod[3 * NMOD + col] = a3 + bb; }
        }
    }
    __syncthreads();
    {
        LAS float* scr = (LAS float*)(F.lds + F.wave * 16384);
        const int gw = F.bid * 8 + F.wave, NGW = F.G * 8;
        constexpr int I_IN = 16 * 160, I_BR = 8 * 32, I_OUT = 16 * 32, I_EXP = 384, NIT = I_IN + 2 * I_BR + I_OUT + 65 * I_EXP;
        for (int it = gw; it < NIT; it += NGW) {
            int r = it;
            if (r < I_IN) { const int kb = r / 160, nb = r % 160; transpose_item(inp(F, I_WIN), 5120, kb * 64, nb * 32, (bf16_t*)(F.ws + WS_WINT), 1024, nb * 32, scr, F.lane); continue; } r -= I_IN;
            if (r < I_BR) { const int kb = r / 32, nb = r % 32; transpose_item(inp(F, I_WBSB), 1024, kb * 64, nb * 32, (bf16_t*)(F.ws + WS_WBRT), 512, nb * 32, scr, F.lane); continue; } r -= I_BR;
            if (r < I_BR) { const int kb = r / 32, nb = r % 32; transpose_item(inp(F, I_WBMB), 1024, kb * 64, nb * 32, (bf16_t*)(F.ws + WS_WBRT), 512, 1024 + nb * 32, scr, F.lane); continue; } r -= I_BR;
            if (r < I_OUT) { const int kb = r / 32, nb = r % 32; transpose_item(inp(F, I_WOUT), 1024, kb * 64, nb * 32, (bf16_t*)(F.ws + WS_WOUTT), 1024, nb * 32, scr, F.lane); continue; } r -= I_OUT;
            const int e = r / I_EXP; r -= e * I_EXP;
            if (r < 128) {
                const float* src = e < NE ? inp(F, I_WGE) + (size_t)e * DM * EFF : inp(F, I_WGS);
                const int kb = r / 8, nb = r % 8, n0 = nb * 32;
                transpose_item(src, EFF, kb * 64, n0, (bf16_t*)(F.ws + WS_W1T) + (size_t)e * 512 * 1024, 1024, (n0 >> 7) * 256 + (n0 & 127), scr, F.lane);
            } else if (r < 256) {
                r -= 128;
                const float* src = e < NE ? inp(F, I_WUE) + (size_t)e * DM * EFF : inp(F, I_WUS);
                const int kb = r / 8, nb = r % 8, n0 = nb * 32;
                transpose_item(src, EFF, kb * 64, n0, (bf16_t*)(F.ws + WS_W1T) + (size_t)e * 512 * 1024, 1024, (n0 >> 7) * 256 + 128 + (n0 & 127), scr, F.lane);
            } else {
                r -= 256;
                const float* src = e < NE ? inp(F, I_WDE) + (size_t)e * EFF * DM : inp(F, I_WDS);
                const int kb = r / 32, nb = r % 32;
                transpose_item(src, DM, kb * 64, nb * 32, (bf16_t*)(F.ws + WS_W2T) + (size_t)e * 1024 * 256, 256, nb * 32, scr, F.lane);
            }
        }
    }
    {
        float* wrt = (float*)(F.ws + WS_SMALL + SM_WRT);
        const float* wr = inp(F, I_WR);
        for (int i = F.bid * 512 + F.tid; i < NE * DM; i += F.G * 512) { const int e = i >> 10, k = i & 1023; wrt[i] = wr[k * NE + e]; }
    }
}

__device__ __forceinline__ void phase1(Ctx& F) {
    const float* mod = (const float*)(F.ws + WS_SMALL + SM_MOD);
    const float* x = inp(F, I_X); const float* g1 = inp(F, I_N1G);
    bf16_t* H = (bf16_t*)(F.ws + WS_H);
    const int gw = F.bid * 8 + F.wave, NGW = F.G * 8;
    for (int m = gw; m < MT; m += NGW) {
        const int b = m / SEQ;
        const f32x4* xr = (const f32x4*)(x + (size_t)m * DM) + F.lane;
        f32x4 v[4]; float s = 0.f;
#pragma unroll
        for (int j = 0; j < 4; ++j) { v[j] = xr[64 * j]; s += (v[j].x * v[j].x + v[j].y * v[j].y) + (v[j].z * v[j].z + v[j].w * v[j].w); }
        const float rstd = rsqrtf(wave_sum(s) * (1.f / DM) + EPS);
        u32x2* o8 = (u32x2*)(H + (size_t)m * DM) + F.lane;
#pragma unroll
        for (int j = 0; j < 4; ++j) {
            const int col = 4 * F.lane + 256 * j;
            const f32x4 g = *(const f32x4*)(g1 + col), sh = *(const f32x4*)(mod + b * NMOD + col), sc = *(const f32x4*)(mod + b * NMOD + DM + col);
            const f32x4 h = (v[j] * rstd) * g * (sc + 1.0f) + sh;
            u32x2 w; w.x = cvtpk(h.x, h.y); w.y = cvtpk(h.z, h.w); o8[64 * j] = w;
        }
    }
    if (F.bid == 0) {
        float* gvec = (float*)(F.ws + WS_SMALL + SM_GVEC);
        for (int i = F.tid; i < 4 * DM; i += 512) { const int b = i >> 10, k = i & 1023; gvec[i] = inp(F, I_N2G)[k] * (1.f + mod[b * NMOD + 4 * DM + k]); }
    }
    if (F.bid == 1 && F.tid < 256) {
        float* cb = (float*)(F.ws + WS_SMALL + SM_CB);
        const int b = F.tid >> 6, e = F.tid & 63; const float* wr = inp(F, I_WR); float a = 0.f;
        for (int k = 0; k < DM; ++k) a += mod[b * NMOD + 3 * DM + k] * wr[k * NE + e];
        cb[F.tid] = a;
    }
}

struct ProjSched {
    const char* A; const char* Bt; int G, c; int R[2], C[2];
    __device__ __forceinline__ bool next(int i, gm::UnitD& u) {
        int pm, pn; if (!gm::static_tile(MT, 5120, G, c, i, pm, pn)) return false;
        u.a = A; u.b = Bt + (size_t)pn * 256 * 1024 * 2;
#pragma unroll
        for (int h = 0; h < 2; ++h)
#pragma unroll
            for (int j = 0; j < 2; ++j) u.va[h][j] = (unsigned)((pm * 256 + h * 128 + R[j]) * 1024 + C[j]) * 2u;
        u.e0 = pm; u.e1 = pn; u.e2 = 0; u.e3 = 0; return true;
    }
};
struct EpiProj {
    bf16_t* qsb; bf16_t* qmb; bf16_t* g;
    __device__ __forceinline__ void operator()(const f32x4 (&acc)[2][2][4][2], const gm::UnitD& u, int wr, int wc, int fr, int fq) const {
        const int pm = u.e0, pn = u.e1;
        bf16_t* base; int ldc, colt; float sc = 1.f;
        if (pn < 6) { base = qsb; ldc = QW; colt = pn * 256; if (pn < 2) sc = 0.125f; }
        else if (pn < 12) { base = qmb; ldc = QW; colt = (pn - 6) * 256; if (pn < 8) sc = 0.125f; }
        else { base = g; ldc = 2048; colt = (pn - 12) * 256; }
        const int row0 = pm * 256 + wr * 64 + fr, col0 = colt + wc * 32 + 8 * fq;
#pragma unroll
        for (int ai = 0; ai < 2; ++ai)
#pragma unroll
            for (int m = 0; m < 4; ++m) { bf16_t* rowp = base + (size_t)(row0 + ai * 128 + m * 16) * ldc + col0;
#pragma unroll
                for (int bj = 0; bj < 2; ++bj) { const f32x4 v0 = acc[ai][bj][m][0] * sc, v1 = acc[ai][bj][m][1] * sc;
                    u32x4 w; w.x = cvtpk(v0[0], v0[1]); w.y = cvtpk(v0[2], v0[3]); w.z = cvtpk(v1[0], v1[1]); w.w = cvtpk(v1[2], v1[3]);
                    *(u32x4*)(rowp + bj * 128) = w; } }
    }
};
__device__ __forceinline__ void phase2(Ctx& F) {
    ProjSched S; S.A = (const char*)(F.ws + WS_H); S.Bt = (const char*)(F.ws + WS_WINT); S.G = F.G; S.c = F.bid; gm::stage_geom(F.tid, S.R, S.C);
    EpiProj E{(bf16_t*)(F.ws + WS_QSB), (bf16_t*)(F.ws + WS_QMB), (bf16_t*)(F.ws + WS_G)};
    gm::gemm_phase<true>(F.lds, 1024, S, E);
}

__device__ __forceinline__ int crow(int r, int hi) { return (r & 3) + 8 * (r >> 2) + 4 * hi; }
typedef short v4i16_t __attribute__((ext_vector_type(4)));
__device__ __forceinline__ s16x4 vtr(const LAS unsigned char* p) { return __builtin_bit_cast(s16x4, __builtin_amdgcn_ds_read_tr16_b64_v4i16((LAS v4i16_t*)p)); }
__device__ __forceinline__ void pv64(f32x16 (&o)[2], const LAS unsigned char* vt, int lane, const u32x4 (&pw)[4]) {
    const int hi = lane >> 5;
    const LAS unsigned char* vb = vt + ((lane >> 4) & 1) * 32 + (lane & 3) * 8 + (4 * hi + ((lane & 15) >> 2)) * 64;
#pragma unroll
    for (int d0 = 0; d0 < 2; ++d0)
#pragma unroll
        for (int ks = 0; ks < 4; ++ks) {
            const s16x4 lo = vtr(vb + d0 * 4096 + ks * 1024), hh = vtr(vb + d0 * 4096 + ks * 1024 + 512);
            const bf16x8 bv = (bf16x8){lo[0], lo[1], lo[2], lo[3], hh[0], hh[1], hh[2], hh[3]};
            o[d0] = __builtin_amdgcn_mfma_f32_32x32x16_bf16(__builtin_bit_cast(bf16x8, pw[ks]), bv, o[d0], 0, 0, 0);
        }
}
__device__ __forceinline__ void store_o_tile(const f32x16 (&o)[2], LAS unsigned char* stgb, int lane, bf16_t* dst0, size_t row_pitch) {
    const int r32 = lane & 31, hi = lane >> 5;
    LAS bf16_t* stg = (LAS bf16_t*)stgb;
#pragma unroll
    for (int r = 0; r < 16; ++r) { const int orow = crow(r, hi);
#pragma unroll
        for (int d0 = 0; d0 < 2; ++d0) stg[orow * 64 + d0 * 32 + r32] = (bf16_t)(cvtpk(o[d0][r], 0.f) & 0xffffu); }
    LDS_WAIT();
#pragma unroll
    for (int i = 0; i < 4; ++i) { const int row = i * 8 + (lane >> 3), ch = lane & 7; const u32x4 v = *(const LAS u32x4*)(stg + row * 64 + ch * 8); *(u32x4*)(dst0 + (size_t)row * row_pitch + ch * 8) = v; }
    LDS_WAIT();
}

__device__ __forceinline__ void sb_unit(Ctx& F, int bh, int qt, LAS unsigned char* vl) {
    const int lane = F.lane, r32 = lane & 31, hi = lane >> 5;
    const int b = bh >> 3, h = bh & 7, q0 = qt * 32, qpos = q0 + r32;
    const bf16_t* base = (const bf16_t*)(F.ws + WS_QSB) + (size_t)b * SEQ * QW + h * 64;
    const bf16_t* Kb = base + 512; const bf16_t* Vb = base + 1024;
    bf16x8 qr[4];
#pragma unroll
    for (int d0 = 0; d0 < 4; ++d0) qr[d0] = *(const bf16x8*)(base + (size_t)qpos * QW + d0 * 16 + hi * 8);
    float R = 0.f; f32x16 o[2]; o[0] = f32x16{}; o[1] = f32x16{};
    for (int kt = q0 >> 6; kt >= 0; --kt) {
        if (__all(R > 105.f)) break;
        const int k0 = kt * 64;
        bf16x8 kf[8];
#pragma unroll
        for (int d0 = 0; d0 < 4; ++d0)
#pragma unroll
            for (int hf = 0; hf < 2; ++hf) kf[2 * d0 + hf] = *(const bf16x8*)(Kb + (size_t)(k0 + r32 + 32 * hf) * QW + d0 * 16 + hi * 8);
#pragma unroll
        for (int p = 0; p < 8; ++p) { const u32x4 v = *(const u32x4*)(Vb + (size_t)(k0 + 16 * (p & 3) + (lane >> 2)) * QW + (p >> 2) * 32 + (lane & 3) * 8); *(LAS u32x4*)(vl + p * 1024 + lane * 16) = v; }
        f32x16 z[2]; z[0] = f32x16{}; z[1] = f32x16{};
#pragma unroll
        for (int d0 = 0; d0 < 4; ++d0) { z[0] = __builtin_amdgcn_mfma_f32_32x32x16_bf16(kf[2 * d0], qr[d0], z[0], 0, 0, 0); z[1] = __builtin_amdgcn_mfma_f32_32x32x16_bf16(kf[2 * d0 + 1], qr[d0], z[1], 0, 0, 0); }
        f32x16 sp[2];
#pragma unroll
        for (int p = 0; p < 2; ++p)
#pragma unroll
            for (int r = 0; r < 16; ++r) { const float zz = z[p][r]; const float s = fmaxf(zz, 0.f) + __logf(1.f + __expf(-fabsf(zz))); const bool valid = (k0 + 32 * p + crow(r, hi)) < qpos; sp[p][r] = valid ? s : 0.f; }
        float Gs[8], PG[8], off[8];
#pragma unroll
        for (int idx = 0; idx < 8; ++idx) { const int p = idx >> 2, g4 = (idx & 3) * 4; Gs[idx] = (sp[p][g4] + sp[p][g4 + 1]) + (sp[p][g4 + 2] + sp[p][g4 + 3]); }
#pragma unroll
        for (int idx = 0; idx < 8; ++idx) PG[idx] = __shfl_xor(Gs[idx], 32);
        float run = R;
#pragma unroll
        for (int idx = 7; idx >= 0; --idx) { off[idx] = run + (hi ? 0.f : PG[idx]); run += (Gs[idx] + PG[idx]); }
        R = run;
        u32x4 pw[4];
#pragma unroll
        for (int idx = 0; idx < 8; ++idx) { const int p = idx >> 2, g4 = (idx & 3) * 4; float c = off[idx]; float a[4];
#pragma unroll
            for (int j = 3; j >= 0; --j) { c += sp[p][g4 + j]; const bool valid = (k0 + 32 * p + crow(g4 + j, hi)) < qpos; a[j] = valid ? __expf(z[p][g4 + j] - c) : 0.f; }
            pw[idx >> 1][(idx & 1) * 2] = cvtpk(a[0], a[1]); pw[idx >> 1][(idx & 1) * 2 + 1] = cvtpk(a[2], a[3]); }
        pv64(o, vl, lane, pw);
    }
    bf16_t* dst = (bf16_t*)(F.ws + WS_OB) + (size_t)(b * SEQ + q0) * 512 + h * 64;
    store_o_tile(o, vl, lane, dst, 512);
}
__device__ __forceinline__ void phase3(Ctx& F) {
    float* kbar = (float*)(F.ws + WS_SMALL + SM_KBAR);
    for (int u = F.bid; u < NB * 32; u += F.G) {
        const bf16_t* kp = (const bf16_t*)(F.ws + WS_QMB) + (size_t)(u * 256) * QW + 512 + F.tid;
        float s = 0.f;
#pragma unroll 8
        for (int r = 0; r < 256; ++r) s += bf2f(kp[(size_t)r * QW]);
        kbar[u * 512 + F.tid] = s * (1.f / 256.f);
    }
    LAS unsigned char* vl = F.lds + F.wave * 8192;
    const int gw = F.bid * 8 + F.wave, NGW = F.G * 8;
    for (int u = gw; u < 32 * 256; u += NGW) sb_unit(F, u >> 8, u & 255, vl);
}

constexpr int MO_LUT = 0, MO_PRE = 4224, MO_WSF = 8320, MO_ENT = 12416, MO_ST = 16368;
__device__ __forceinline__ int mb_list_off(int j) { return 256 * (31 * j - (j * (j - 1)) / 2); }
constexpr int MB_LIST_STRIDE = 126976;
__device__ __forceinline__ int t5_bucket_dev(int n) {
    if (n < 16) return n;
    int large = 16 + (int)(logf((float)n / 16.f) / 2.0794415416798357f * 16.f);
    return large < 31 ? large : 31;
}
__device__ __forceinline__ void build_lut(Ctx& F) {
    LAS float* lut = (LAS float*)(F.lds + MISC_OFF + MO_LUT);
    for (int i = F.tid; i < 8 * 132; i += 512) { const int h = i / 132, d = i % 132; lut[i] = inp(F, I_RELB)[h * 32 + t5_bucket_dev(d < 128 ? d : 128)] * LOG2E; }
}
__device__ __forceinline__ void phase4(Ctx& F) {
    LAS float* kb = (LAS float*)(F.lds);
    LAS int* lcnt = (LAS int*)(F.lds + MISC_OFF + MO_PRE); LAS int* lbase = lcnt + 32;
    const float* kbar = (const float*)(F.ws + WS_SMALL + SM_KBAR);
    unsigned* cur = (unsigned*)(F.ws + WS_CTL) + CW_MBCUR;
    unsigned short* lists = (unsigned short*)(F.ws + WS_LMB);
    for (int u = F.bid; u < 32 * 31; u += F.G) {
        const int bh = u / 31, i = 1 + (u % 31), b = bh >> 3, h = bh & 7;
        for (int idx = F.tid; idx < i * 64; idx += 512) kb[idx] = kbar[(b * 32 + (idx >> 6)) * 512 + h * 64 + (idx & 63)];
        if (F.tid < 32) lcnt[F.tid] = 0;
        __syncthreads();
        int j0 = -1, j1 = -1, j2 = -1, r0 = 0, r1 = 0, r2 = 0; const int nsel = i < 3 ? i : 3;
        const int qpos = i * 256 + F.tid;
        if (F.tid < 256) {
            float qv[64];
            const u32x4* qp = (const u32x4*)((const bf16_t*)(F.ws + WS_QMB) + (size_t)(b * SEQ + qpos) * QW + h * 64);
#pragma unroll
            for (int c = 0; c < 8; ++c) { const u32x4 w = qp[c];
                qv[8 * c] = bflo(w.x); qv[8 * c + 1] = bfhi(w.x); qv[8 * c + 2] = bflo(w.y); qv[8 * c + 3] = bfhi(w.y);
                qv[8 * c + 4] = bflo(w.z); qv[8 * c + 5] = bfhi(w.z); qv[8 * c + 6] = bflo(w.w); qv[8 * c + 7] = bfhi(w.w); }
            float v0 = -INFINITY, v1 = -INFINITY, v2 = -INFINITY;
            for (int j = 0; j < i; ++j) {
                const LAS f32x4* kr = (const LAS f32x4*)(kb + j * 64);
                float g = 0.f;
#pragma unroll
                for (int c = 0; c < 16; ++c) { const f32x4 kk = kr[c]; g += qv[4 * c] * kk.x + qv[4 * c + 1] * kk.y + qv[4 * c + 2] * kk.z + qv[4 * c + 3] * kk.w; }
                if (g > v0) { v2 = v1; j2 = j1; v1 = v0; j1 = j0; v0 = g; j0 = j; }
                else if (g > v1) { v2 = v1; j2 = j1; v1 = g; j1 = j; }
                else if (g > v2) { v2 = g; j2 = j; }
            }
            r0 = lds_add(&lcnt[j0], 1);
            if (nsel > 1) r1 = lds_add(&lcnt[j1], 1);
            if (nsel > 2) r2 = lds_add(&lcnt[j2], 1);
        }
        __syncthreads();
        if (F.tid < i) { const int n = lcnt[F.tid]; lbase[F.tid] = n > 0 ? (int)atomicAdd(&cur[bh * 32 + F.tid], (unsigned)n) : 0; }
        __syncthreads();
        if (F.tid < 256) {
            unsigned short* lb = lists + (size_t)bh * MB_LIST_STRIDE;
            lb[mb_list_off(j0) + lbase[j0] + r0] = (unsigned short)(qpos | (0 << 13));
            if (nsel > 1) lb[mb_list_off(j1) + lbase[j1] + r1] = (unsigned short)(qpos | (1 << 13));
            if (nsel > 2) lb[mb_list_off(j2) + lbase[j2] + r2] = (unsigned short)(qpos | (2 << 13));
        }
        __syncthreads();
    }
}
__device__ __forceinline__ void stage_kv_block(Ctx& F, const bf16_t* kg, const bf16_t* vg) {
#pragma unroll
    for (int i = 0; i < 4; ++i) { const int id = F.tid + 512 * i, row = id >> 3, ch = id & 7;
        const u32x4 kv = *(const u32x4*)(kg + (size_t)row * QW + ch * 8), vv = *(const u32x4*)(vg + (size_t)row * QW + ch * 8);
        *(LAS u32x4*)(F.lds + (row >> 6) * 8192 + ch * 1024 + (row & 63) * 16) = kv;
        *(LAS u32x4*)(F.lds + 32768 + (row >> 6) * 8192 + (ch >> 2) * 4096 + ((row >> 4) & 3) * 1024 + (row & 15) * 64 + (ch & 3) * 16) = vv; }
}
__device__ __forceinline__ void softmax_step(f32x16 (&t)[2], float& m, float& l, f32x16 (&o)[2], LAS float* wsf, const LAS unsigned char* vt, int lane) {
    const int r32 = lane & 31, hi = lane >> 5;
    float rm = -INFINITY;
#pragma unroll
    for (int p = 0; p < 2; ++p)
#pragma unroll
        for (int r = 0; r < 16; ++r) rm = fmaxf(rm, t[p][r]);
    rm = fmaxf(rm, __shfl_xor(rm, 32));
    const float mn = fmaxf(m, rm);
    const float f = __builtin_amdgcn_exp2f(m - mn);
    m = mn;
    float s = 0.f; u32x4 pw[4];
#pragma unroll
    for (int p = 0; p < 2; ++p)
#pragma unroll
        for (int r = 0; r < 16; ++r) { const float e = __builtin_amdgcn_exp2f(t[p][r] - mn); t[p][r] = e; s += e; }
    l = l * f + s;
#pragma unroll
    for (int idx = 0; idx < 8; ++idx) { const int p = idx >> 2, g4 = (idx & 3) * 4; pw[idx >> 1][(idx & 1) * 2] = cvtpk(t[p][g4], t[p][g4 + 1]); pw[idx >> 1][(idx & 1) * 2 + 1] = cvtpk(t[p][g4 + 2], t[p][g4 + 3]); }
    if (__any(f != 1.f)) {
        if (hi == 0) wsf[r32] = f;
        LDS_WAIT();
#pragma unroll
        for (int g = 0; g < 4; ++g) { const f32x4 fv = *(const LAS f32x4*)(wsf + 8 * g + 4 * hi);
#pragma unroll
            for (int j = 0; j < 4; ++j) { o[0][4 * g + j] *= fv[j]; o[1][4 * g + j] *= fv[j]; } }
        LDS_WAIT();
    }
    pv64(o, vt, lane, pw);
}
__device__ __forceinline__ void qkt64(f32x16 (&t)[2], const LAS unsigned char* kt, const bf16x8 (&qr)[4], int lane) {
    const int r32 = lane & 31, hi = lane >> 5;
    t[0] = f32x16{}; t[1] = f32x16{};
#pragma unroll
    for (int d0 = 0; d0 < 4; ++d0) {
        const bf16x8 k0 = *(const LAS bf16x8*)(kt + (2 * d0 + hi) * 1024 + r32 * 16), k1 = *(const LAS bf16x8*)(kt + (2 * d0 + hi) * 1024 + 512 + r32 * 16);
        t[0] = __builtin_amdgcn_mfma_f32_32x32x16_bf16(k0, qr[d0], t[0], 0, 0, 0); t[1] = __builtin_amdgcn_mfma_f32_32x32x16_bf16(k1, qr[d0], t[1], 0, 0, 0);
    }
}
__device__ __forceinline__ void phase5(Ctx& F) {
    LAS int* pre = (LAS int*)(F.lds + MISC_OFF + MO_PRE);
    LAS int* wtot = (LAS int*)(F.lds + MISC_OFF + MO_ENT);
    const unsigned* cur = (const unsigned*)(F.ws + WS_CTL) + CW_MBCUR;
    build_lut(F);
    int total;
    {
        const int p0 = 2 * F.tid, p1 = p0 + 1;
        const int c0 = p0 < 992 ? (int)((cur[(p0 / 31) * 32 + (p0 % 31)] + 255u) >> 8) : 0;
        const int c1 = p1 < 992 ? (int)((cur[(p1 / 31) * 32 + (p1 % 31)] + 255u) >> 8) : 0;
        const int s = c0 + c1; int v = s;
#pragma unroll
        for (int o = 1; o < 64; o <<= 1) { const int n = __shfl_up(v, o); if (F.lane >= o) v += n; }
        if (F.lane == 63) wtot[248 + F.wave] = v;
        __syncthreads();
        int woff = 0; total = 0;
#pragma unroll
        for (int w = 0; w < 8; ++w) { const int x = wtot[248 + w]; if (w < F.wave) woff += x; total += x; }
        const int excl = woff + v - s;
        pre[p0] = excl; pre[p1] = excl + c0;
        __syncthreads();
    }
    const unsigned short* lists = (const unsigned short*)(F.ws + WS_LMB);
    LAS float* wsf = (LAS float*)(F.lds + MISC_OFF + MO_WSF) + F.wave * 128;
    LAS int* ent = (LAS int*)(F.lds + MISC_OFF + MO_ENT) + F.wave * 32;
    const int lane = F.lane, r32 = lane & 31, hi = lane >> 5;
    for (int u = F.bid; u < total; u += F.G) {
        int lo = 0, hi_ = 992;
        while (hi_ - lo > 1) { const int mid = (lo + hi_) >> 1; if (pre[mid] <= u) lo = mid; else hi_ = mid; }
        const int p = lo, bh = p / 31, j = p % 31, c = u - pre[p], b = bh >> 3, h = bh & 7;
        const int n = (int)cur[bh * 32 + j];
        const bf16_t* base = (const bf16_t*)(F.ws + WS_QMB) + (size_t)b * SEQ * QW + h * 64;
        stage_kv_block(F, base + 512 + (size_t)(j * 256) * QW, base + 1024 + (size_t)(j * 256) * QW);
        __syncthreads();
        const int e0 = c * 256 + F.wave * 32;
        if (e0 < n) {
            const unsigned short* lb = lists + (size_t)bh * MB_LIST_STRIDE + mb_list_off(j);
            const int eidx = e0 + r32; const bool valid = eidx < n;
            const int entry = (int)lb[valid ? eidx : e0];
            const int qpos = entry & 8191, slot = entry >> 13;
            if (hi == 0) ent[r32] = valid ? entry : -1;
            bf16x8 qr[4];
#pragma unroll
            for (int d0 = 0; d0 < 4; ++d0) qr[d0] = *(const bf16x8*)(base + (size_t)qpos * QW + d0 * 16 + hi * 8);
            float m = -INFINITY, l = 0.f; f32x16 o[2]; o[0] = f32x16{}; o[1] = f32x16{};
            const LAS float* lut = (const LAS float*)(F.lds + MISC_OFF + MO_LUT) + h * 132;
            const float bfar = lut[128];
#pragma unroll 1
            for (int st = 0; st < 4; ++st) {
                f32x16 t[2]; qkt64(t, F.lds + st * 8192, qr, lane);
                const int kbase = j * 256 + st * 64;
                const bool far = __all(qpos - (kbase + 63) >= 128);
                if (far) {
#pragma unroll
                    for (int pp = 0; pp < 2; ++pp)
#pragma unroll
                        for (int r = 0; r < 16; ++r) t[pp][r] = t[pp][r] * LOG2E + bfar;
                } else {
#pragma unroll
                    for (int pp = 0; pp < 2; ++pp)
#pragma unroll
                        for (int r = 0; r < 16; ++r) { int d = qpos - (kbase + 32 * pp + crow(r, hi)); d = d < 128 ? d : 128; d = d > 0 ? d : 0; t[pp][r] = t[pp][r] * LOG2E + lut[d]; }
                }
                softmax_step(t, m, l, o, wsf, F.lds + 32768 + st * 8192, lane);
            }
            l += __shfl_xor(l, 32);
            const float rl = 1.f / l;
            if (hi == 0) { wsf[r32] = rl; if (valid) ((float*)(F.ws + WS_PLSE))[((size_t)bh * SEQ + qpos) * 3 + slot] = m + __log2f(l); }
            LDS_WAIT();
            bf16_t* po = (bf16_t*)(F.ws + WS_PO);
#pragma unroll
            for (int r = 0; r < 16; ++r) { const int q = crow(r, hi); const int en = ent[q]; const float sc = wsf[q];
                if (en >= 0) { bf16_t* dst = po + (((size_t)bh * SEQ + (en & 8191)) * 3 + (en >> 13)) * 64 + r32;
                    dst[0] = (bf16_t)(cvtpk(o[0][r] * sc, 0.f) & 0xffffu); dst[32] = (bf16_t)(cvtpk(o[1][r] * sc, 0.f) & 0xffffu); } }
            LDS_WAIT();
        }
        __syncthreads();
    }
}
__device__ __forceinline__ void phase6(Ctx& F) {
    build_lut(F);
    __syncthreads();
    LAS float* wsf = (LAS float*)(F.lds + MISC_OFF + MO_WSF) + F.wave * 128;
    const int lane = F.lane, r32 = lane & 31, hi = lane >> 5, w = F.wave;
    for (int u = F.bid; u < 32 * 32; u += F.G) {
        const int bh = u >> 5, i = 31 - (u & 31), b = bh >> 3, h = bh & 7;
        const bf16_t* base = (const bf16_t*)(F.ws + WS_QMB) + (size_t)b * SEQ * QW + h * 64;
        stage_kv_block(F, base + 512 + (size_t)(i * 256) * QW, base + 1024 + (size_t)(i * 256) * QW);
        __syncthreads();
        const int ql = w * 32 + r32, qpos = i * 256 + ql;
        bf16x8 qr[4];
#pragma unroll
        for (int d0 = 0; d0 < 4; ++d0) qr[d0] = *(const bf16x8*)(base + (size_t)qpos * QW + d0 * 16 + hi * 8);
        float m = -INFINITY, l = 0.f; f32x16 o[2]; o[0] = f32x16{}; o[1] = f32x16{};
        const LAS float* lut = (const LAS float*)(F.lds + MISC_OFF + MO_LUT) + h * 132;
        const int nst = (w >> 1) + 1;
#pragma unroll 1
        for (int st = 0; st < nst; ++st) {
            f32x16 t[2]; qkt64(t, F.lds + st * 8192, qr, lane);
#pragma unroll
            for (int pp = 0; pp < 2; ++pp)
#pragma unroll
                for (int r = 0; r < 16; ++r) { const int d = ql - (st * 64 + 32 * pp + crow(r, hi)); const int dc = d < 128 ? (d > 0 ? d : 0) : 128; const float v = t[pp][r] * LOG2E + lut[dc]; t[pp][r] = d >= 0 ? v : -INFINITY; }
            softmax_step(t, m, l, o, wsf, F.lds + 32768 + st * 8192, lane);
        }
        l += __shfl_xor(l, 32);
        const int nsel = i < 3 ? i : 3;
        const float* plse = (const float*)(F.ws + WS_PLSE) + ((size_t)bh * SEQ + qpos) * 3;
        float ls0 = -INFINITY, ls1 = -INFINITY, ls2 = -INFINITY;
        if (nsel > 0) ls0 = plse[0]; if (nsel > 1) ls1 = plse[1]; if (nsel > 2) ls2 = plse[2];
        const float M = fmaxf(fmaxf(m, ls0), fmaxf(ls1, ls2));
        const float eo = __builtin_amdgcn_exp2f(m - M), e0 = __builtin_amdgcn_exp2f(ls0 - M), e1 = __builtin_amdgcn_exp2f(ls1 - M), e2 = __builtin_amdgcn_exp2f(ls2 - M);
        const float rden = 1.f / (l * eo + e0 + e1 + e2);
        if (hi == 0) *(LAS f32x4*)(wsf + 4 * r32) = (f32x4){eo * rden, e0 * rden, e1 * rden, e2 * rden};
        LDS_WAIT();
        const bf16_t* po = (const bf16_t*)(F.ws + WS_PO) + ((size_t)bh * SEQ + i * 256 + w * 32) * 3 * 64 + r32;
#pragma unroll
        for (int r = 0; r < 16; ++r) { const int q = crow(r, hi); const f32x4 fc = *(const LAS f32x4*)(wsf + 4 * q);
            float a0 = o[0][r] * fc.x, a1 = o[1][r] * fc.x;
            if (nsel > 0) { a0 += fc.y * bf2f(po[(q * 3 + 0) * 64]); a1 += fc.y * bf2f(po[(q * 3 + 0) * 64 + 32]); }
            if (nsel > 1) { a0 += fc.z * bf2f(po[(q * 3 + 1) * 64]); a1 += fc.z * bf2f(po[(q * 3 + 1) * 64 + 32]); }
            if (nsel > 2) { a0 += fc.w * bf2f(po[(q * 3 + 2) * 64]); a1 += fc.w * bf2f(po[(q * 3 + 2) * 64 + 32]); }
            o[0][r] = a0; o[1][r] = a1; }
        LDS_WAIT();
        __syncthreads();
        bf16_t* dst = (bf16_t*)(F.ws + WS_OB) + (size_t)MT * 512 + (size_t)(b * SEQ + i * 256 + w * 32) * 512 + h * 64;
        store_o_tile(o, F.lds + w * 4096, lane, dst, 512);
        __syncthreads();
    }
}

struct BranchSched {
    const char* A; const char* Bt; int G, c; int R[2], C[2];
    __device__ __forceinline__ bool next(int i, gm::UnitD& u) {
        int pm, pn; if (!gm::static_tile(MT, 1024, G, c, i >> 1, pm, pn)) return false;
        const int br = i & 1;
        u.a = A + (size_t)br * MT * 512 * 2; u.b = Bt + (size_t)(br * 1024 + pn * 256) * 512 * 2;
#pragma unroll
        for (int h = 0; h < 2; ++h)
#pragma unroll
            for (int j = 0; j < 2; ++j) u.va[h][j] = (unsigned)((pm * 256 + h * 128 + R[j]) * 512 + C[j]) * 2u;
        u.e0 = pm; u.e1 = pn; u.e2 = br; u.e3 = 0; return true;
    }
};
struct EpiBranch {
    const bf16_t* g; bf16_t* merged;
    __device__ __forceinline__ void operator()(const f32x4 (&acc)[2][2][4][2], const gm::UnitD& u, int wr, int wc, int fr, int fq) const {
        const int pm = u.e0, pn = u.e1, br = u.e2;
        const int row0 = pm * 256 + wr * 64 + fr, col0 = pn * 256 + wc * 32 + 8 * fq;
#pragma unroll
        for (int ai = 0; ai < 2; ++ai)
#pragma unroll
            for (int m = 0; m < 4; ++m) { const size_t row = (size_t)(row0 + ai * 128 + m * 16);
#pragma unroll
                for (int bj = 0; bj < 2; ++bj) {
                    const u32x4 gv = *(const u32x4*)(g + row * 2048 + br * 1024 + col0 + bj * 128);
                    bf16_t* mp = merged + row * 1024 + col0 + bj * 128;
                    const f32x4 v0 = acc[ai][bj][m][0], v1 = acc[ai][bj][m][1];
                    float r[8];
                    r[0] = sigmoidf_(bflo(gv.x)) * v0[0]; r[1] = sigmoidf_(bfhi(gv.x)) * v0[1]; r[2] = sigmoidf_(bflo(gv.y)) * v0[2]; r[3] = sigmoidf_(bfhi(gv.y)) * v0[3];
                    r[4] = sigmoidf_(bflo(gv.z)) * v1[0]; r[5] = sigmoidf_(bfhi(gv.z)) * v1[1]; r[6] = sigmoidf_(bflo(gv.w)) * v1[2]; r[7] = sigmoidf_(bfhi(gv.w)) * v1[3];
                    if (br) { const u32x4 pv = *(const u32x4*)mp;
                        r[0] += bflo(pv.x); r[1] += bfhi(pv.x); r[2] += bflo(pv.y); r[3] += bfhi(pv.y); r[4] += bflo(pv.z); r[5] += bfhi(pv.z); r[6] += bflo(pv.w); r[7] += bfhi(pv.w); }
                    u32x4 w; w.x = cvtpk(r[0], r[1]); w.y = cvtpk(r[2], r[3]); w.z = cvtpk(r[4], r[5]); w.w = cvtpk(r[6], r[7]);
                    *(u32x4*)mp = w; } }
    }
};
__device__ __forceinline__ void phase7(Ctx& F) {
    BranchSched S; S.A = (const char*)(F.ws + WS_OB); S.Bt = (const char*)(F.ws + WS_WBRT); S.G = F.G; S.c = F.bid; gm::stage_geom(F.tid, S.R, S.C);
    EpiBranch E{(const bf16_t*)(F.ws + WS_G), (bf16_t*)(F.ws + WS_MERGED)};
    gm::gemm_phase<true>(F.lds, 512, S, E);
}
struct OutSched {
    const char* A; const char* Bt; int G, c; int R[2], C[2];
    __device__ __forceinline__ bool next(int i, gm::UnitD& u) {
        int pm, pn; if (!gm::static_tile(MT, 1024, G, c, i, pm, pn)) return false;
        u.a = A; u.b = Bt + (size_t)pn * 256 * 1024 * 2;
#pragma unroll
        for (int h = 0; h < 2; ++h)
#pragma unroll
            for (int j = 0; j < 2; ++j) u.va[h][j] = (unsigned)((pm * 256 + h * 128 + R[j]) * 1024 + C[j]) * 2u;
        u.e0 = pm; u.e1 = pn; u.e2 = 0; u.e3 = 0; return true;
    }
};
struct EpiOut {
    const float* x; const float* mod; float* out;
    __device__ __forceinline__ void operator()(const f32x4 (&acc)[2][2][4][2], const gm::UnitD& u, int wr, int wc, int fr, int fq) const {
        const int pm = u.e0, pn = u.e1, b = (pm * 256) / SEQ;
        const int row0 = pm * 256 + wr * 64 + fr, col0 = pn * 256 + wc * 32 + 4 * fq;
        f32x4 gt[2][2];
#pragma unroll
        for (int bj = 0; bj < 2; ++bj)
#pragma unroll
            for (int n = 0; n < 2; ++n) gt[bj][n] = *(const f32x4*)(mod + b * NMOD + 2 * DM + col0 + bj * 128 + n * 16);
#pragma unroll
        for (int ai = 0; ai < 2; ++ai)
#pragma unroll
            for (int m = 0; m < 4; ++m) { const size_t off = (size_t)(row0 + ai * 128 + m * 16) * DM + col0;
#pragma unroll
                for (int bj = 0; bj < 2; ++bj)
#pragma unroll
                    for (int n = 0; n < 2; ++n) { const f32x4 xv = *(const f32x4*)(x + off + bj * 128 + n * 16); *(f32x4*)(out + off + bj * 128 + n * 16) = xv + gt[bj][n] * acc[ai][bj][m][n]; } }
    }
};
__device__ __forceinline__ void phase8(Ctx& F) {
    OutSched S; S.A = (const char*)(F.ws + WS_MERGED); S.Bt = (const char*)(F.ws + WS_WOUTT); S.G = F.G; S.c = F.bid; gm::stage_geom(F.tid, S.R, S.C);
    EpiOut E{inp(F, I_X), (const float*)(F.ws + WS_SMALL + SM_MOD), F.out};
    gm::gemm_phase<false>(F.lds, 1024, S, E);
}

constexpr int NR_LG = 0;
__device__ __forceinline__ void phase_n2r(Ctx& F, int rr) {
    const float* x1 = F.out; const float* gvec = (const float*)(F.ws + WS_SMALL + SM_GVEC); const float* cb = (const float*)(F.ws + WS_SMALL + SM_CB);
    const float* mod = (const float*)(F.ws + WS_SMALL + SM_MOD); const float* wrt = (const float*)(F.ws + WS_SMALL + SM_WRT); const float* rbias = inp(F, I_RB);
    bf16_t* H2 = (bf16_t*)(F.ws + WS_H2); int* tokl = (int*)(F.ws + WS_TOKL); float* wl = (float*)(F.ws + WS_WL);
    unsigned* cur = (unsigned*)(F.ws + WS_CTL) + CW_MOECUR + rr * 64;
    LAS int* lcnt = (LAS int*)(F.lds + MISC_OFF + MO_PRE); LAS int* lbase = lcnt + 64;
    const int lane = F.lane, w = F.wave, i16 = lane & 15, kk = lane >> 4;
    LAS float* sc = (LAS float*)(F.lds + NR_LG) + w * (16 * 65); LAS float* ch = (LAS float*)(F.lds + NR_LG + 4 * 16 * 65 * 4) + w * (16 * 65);
    for (int u = F.bid; u < RT / 64; u += F.G) {
        if (F.tid < 64) lcnt[F.tid] = 0;
        __syncthreads();
        const int tok0 = rr * RT + u * 64 + w * 16, b = tok0 / SEQ;
        int se[8]; float sw[8]; int sr[8]; float rstd = 0.f;
        if (w < 4) {
            f32x4 acc[4]; acc[0] = acc[1] = acc[2] = acc[3] = (f32x4){0.f, 0.f, 0.f, 0.f};
            float ssq = 0.f;
            const float* xp = x1 + (size_t)(tok0 + i16) * DM + 4 * kk; const float* gp = gvec + b * DM + 4 * kk; const float* wp = wrt + (size_t)i16 * DM + 4 * kk;
#pragma unroll 2
            for (int s = 0; s < 64; ++s) {
                const f32x4 xv = *(const f32x4*)(xp + 16 * s), gv = *(const f32x4*)(gp + 16 * s);
                ssq += (xv.x * xv.x + xv.y * xv.y) + (xv.z * xv.z + xv.w * xv.w);
                const f32x4 a = xv * gv;
                f32x4 bw[4];
#pragma unroll
                for (int ct = 0; ct < 4; ++ct) bw[ct] = *(const f32x4*)(wp + (size_t)ct * 16 * DM + 16 * s);
#pragma unroll
                for (int n = 0; n < 4; ++n)
#pragma unroll
                    for (int ct = 0; ct < 4; ++ct) acc[ct] = __builtin_amdgcn_mfma_f32_16x16x4f32(a[n], bw[ct][n], acc[ct], 0, 0, 0);
            }
            ssq += __shfl_xor(ssq, 16); ssq += __shfl_xor(ssq, 32);
            rstd = rsqrtf(ssq * (1.f / DM) + EPS);
#pragma unroll
            for (int reg = 0; reg < 4; ++reg) { const float rs = __shfl(rstd, 4 * kk + reg);
#pragma unroll
                for (int ct = 0; ct < 4; ++ct) { const int e = 16 * ct + i16; const float lg = acc[ct][reg] * rs + cb[b * 64 + e]; const float s_ = sigmoidf_(lg);
                    sc[(4 * kk + reg) * 65 + e] = s_; ch[(4 * kk + reg) * 65 + e] = s_ + rbias[e]; } }
            LDS_WAIT();
            if (lane < 16) {
                const LAS float* cr = ch + lane * 65; const LAS float* sr_ = sc + lane * 65;
                float gs[8];
#pragma unroll
                for (int g = 0; g < 8; ++g) { float m1 = -INFINITY, m2 = -INFINITY;
#pragma unroll
                    for (int j = 0; j < 8; ++j) { const float v = cr[8 * g + j]; if (v > m1) { m2 = m1; m1 = v; } else if (v > m2) m2 = v; }
                    gs[g] = m1 + m2; }
                unsigned gmask = 0u;
#pragma unroll
                for (int g = 0; g < 8; ++g) { int rank = 0;
#pragma unroll
                    for (int g2 = 0; g2 < 8; ++g2) rank += (gs[g2] > gs[g] || (gs[g2] == gs[g] && g2 < g)) ? 1 : 0;
                    if (rank < 4) gmask |= 1u << g; }
                float wsum = 0.f;
                LAS float* crw = ch + lane * 65;
#pragma unroll
                for (int k = 0; k < 8; ++k) { float best = -INFINITY; int be = 0;
                    for (int e = 0; e < 64; ++e) { const float v = crw[e]; if (((gmask >> (e >> 3)) & 1u) && v > best) { best = v; be = e; } }
                    crw[be] = -INFINITY; se[k] = be; sw[k] = sr_[be]; wsum += sw[k]; }
                const float rn = 2.5f / wsum;
#pragma unroll
                for (int k = 0; k < 8; ++k) { sw[k] *= rn; sr[k] = lds_add(&lcnt[se[k]], 1); }
            }
        }
        __syncthreads();
        if (F.tid < 64) { const int n = lcnt[F.tid]; lbase[F.tid] = n > 0 ? (int)atomicAdd(&cur[F.tid], (unsigned)n) : 0; }
        __syncthreads();
        if (w < 4) {
            if (lane < 16) {
                const int tok = tok0 + lane;
#pragma unroll
                for (int k = 0; k < 8; ++k) { const int pos = lbase[se[k]] + sr[k]; tokl[se[k] * RT + pos] = tok * 8 + k; wl[se[k] * RT + pos] = sw[k]; }
            }
            const float* xp = x1 + (size_t)(tok0 + i16) * DM + 4 * kk; const float* gp = gvec + b * DM + 4 * kk; const float* shp = mod + b * NMOD + 3 * DM + 4 * kk;
            bf16_t* hp = H2 + (size_t)(tok0 - rr * RT + i16) * DM + 4 * kk;
#pragma unroll 4
            for (int s = 0; s < 64; ++s) { const f32x4 xv = *(const f32x4*)(xp + 16 * s), gv = *(const f32x4*)(gp + 16 * s), sh = *(const f32x4*)(shp + 16 * s);
                const f32x4 hv = (xv * rstd) * gv + sh; u32x2 o; o.x = cvtpk(hv.x, hv.y); o.y = cvtpk(hv.z, hv.w); *(u32x2*)(hp + 16 * s) = o; }
        }
        __syncthreads();
    }
}
constexpr int MO_TE = 4224;
struct MoeTabs { const LAS unsigned short* te; const LAS int* tb; const LAS int* cnt; int TR; };
__device__ __forceinline__ MoeTabs build_moe_tabs(Ctx& F, int rr) {
    LAS unsigned short* te = (LAS unsigned short*)(F.lds + MISC_OFF + MO_TE); LAS int* tb = (LAS int*)(F.lds + MISC_OFF + MO_TE + 1536); LAS int* cnt = tb + 72;
    const unsigned* cur = (const unsigned*)(F.ws + WS_CTL) + CW_MOECUR + rr * 64;
    __syncthreads();
    if (F.tid == 0) { int acc = 0; for (int e = 0; e < 64; ++e) { const int c = (int)cur[e]; cnt[e] = c; tb[e] = acc; acc += (c + 255) >> 8; } tb[64] = acc; tb[65] = acc + RT / 256; cnt[64] = RT; }
    __syncthreads();
    const int TR = tb[64];
    for (int e = F.tid >> 3; e < 65; e += 64) for (int t = tb[e] + (F.tid & 7); t < tb[e + 1]; t += 8) te[t] = (unsigned short)e;
    __syncthreads();
    MoeTabs T; T.te = te; T.tb = tb; T.cnt = cnt; T.TR = TR; return T;
}
struct Moe1Sched {
    const char* H2; const char* W1T; const int* tokl; MoeTabs T; int G, c, rr; int R[2], C[2];
    __device__ __forceinline__ bool next(int i, gm::UnitD& u) {
        const int uu = i * G + c; const int nt = T.TR + RT / 256;
        if (uu >= nt * 2) return false;
        const int tile = uu >> 1, pn = uu & 1, e = T.te[tile], rt = tile - T.tb[e], cnt = T.cnt[e];
        u.a = H2; u.b = W1T + (size_t)(e * 512 + pn * 256) * 1024 * 2;
#pragma unroll
        for (int h = 0; h < 2; ++h)
#pragma unroll
            for (int j = 0; j < 2; ++j) { const int idx = rt * 256 + h * 128 + R[j]; int trow;
                if (e < 64) { const int ent = tokl[e * RT + (idx < cnt ? idx : rt * 256)]; trow = (ent >> 3) - rr * RT; } else trow = idx;
                u.va[h][j] = (unsigned)(trow * 1024 + C[j]) * 2u; }
        u.e0 = tile; u.e1 = pn; u.e2 = e; u.e3 = rt; return true;
    }
};
struct EpiMoe1 {
    bf16_t* act;
    __device__ __forceinline__ void operator()(const f32x4 (&acc)[2][2][4][2], const gm::UnitD& u, int wr, int wc, int fr, int fq) const {
        const int row0 = u.e0 * 256 + wr * 64 + fr, col0 = u.e1 * 128 + wc * 32 + 8 * fq;
#pragma unroll
        for (int ai = 0; ai < 2; ++ai)
#pragma unroll
            for (int m = 0; m < 4; ++m) { const f32x4 g0 = acc[ai][0][m][0], g1 = acc[ai][0][m][1], u0 = acc[ai][1][m][0], u1 = acc[ai][1][m][1];
                u32x4 w; w.x = cvtpk(siluf_(g0[0]) * u0[0], siluf_(g0[1]) * u0[1]); w.y = cvtpk(siluf_(g0[2]) * u0[2], siluf_(g0[3]) * u0[3]);
                w.z = cvtpk(siluf_(g1[0]) * u1[0], siluf_(g1[1]) * u1[1]); w.w = cvtpk(siluf_(g1[2]) * u1[2], siluf_(g1[3]) * u1[3]);
                *(u32x4*)(act + (size_t)(row0 + ai * 128 + m * 16) * 256 + col0) = w; }
    }
};
__device__ __forceinline__ void phase_moe1(Ctx& F, int rr) {
    Moe1Sched S; S.T = build_moe_tabs(F, rr); S.H2 = (const char*)(F.ws + WS_H2); S.W1T = (const char*)(F.ws + WS_W1T); S.tokl = (const int*)(F.ws + WS_TOKL); S.G = F.G; S.c = F.bid; S.rr = rr; gm::stage_geom(F.tid, S.R, S.C);
    EpiMoe1 E{(bf16_t*)(F.ws + WS_ACT)};
    gm::gemm_phase<true>(F.lds, 1024, S, E);
}
struct Moe2Sched {
    const char* ACT; const char* W2T; MoeTabs T; int G, c; int R[2], C[2];
    __device__ __forceinline__ bool next(int i, gm::UnitD& u) {
        const int uu = i * G + c; const int nt = T.TR + RT / 256;
        if (uu >= nt * 4) return false;
        const int tile = uu >> 2, pn = uu & 3, e = T.te[tile], rt = tile - T.tb[e];
        u.a = ACT + (size_t)tile * 256 * 256 * 2; u.b = W2T + (size_t)(e * 1024 + pn * 256) * 256 * 2;
#pragma unroll
        for (int h = 0; h < 2; ++h)
#pragma unroll
            for (int j = 0; j < 2; ++j) u.va[h][j] = (unsigned)((h * 128 + R[j]) * 256 + C[j]) * 2u;
        u.e0 = pn; u.e1 = e; u.e2 = rt; u.e3 = T.cnt[e]; return true;
    }
};
struct EpiMoe2 {
    const int* tokl; const float* wl; bf16_t* slots; float* out; const float* mod; int rr;
    __device__ __forceinline__ void operator()(const f32x4 (&acc)[2][2][4][2], const gm::UnitD& u, int wr, int wc, int fr, int fq) const {
        const int pn = u.e0, e = u.e1, rt = u.e2, cnt = u.e3;
        const int col0 = pn * 256 + wc * 32 + 8 * fq;
#pragma unroll
        for (int ai = 0; ai < 2; ++ai)
#pragma unroll
            for (int m = 0; m < 4; ++m) { const int idx = rt * 256 + ai * 128 + wr * 64 + m * 16 + fr;
                if (e < 64) {
                    if (idx < cnt) { const int ent = tokl[e * RT + idx]; const float w = wl[e * RT + idx];
                        bf16_t* dst = slots + ((size_t)((ent >> 3) - rr * RT) * 8 + (ent & 7)) * 1024 + col0;
#pragma unroll
                        for (int bj = 0; bj < 2; ++bj) { const f32x4 v0 = acc[ai][bj][m][0] * w, v1 = acc[ai][bj][m][1] * w;
                            u32x4 o; o.x = cvtpk(v0[0], v0[1]); o.y = cvtpk(v0[2], v0[3]); o.z = cvtpk(v1[0], v1[1]); o.w = cvtpk(v1[2], v1[3]); *(u32x4*)(dst + bj * 128) = o; } }
                } else {
                    const int tok = rr * RT + idx, b = tok / SEQ; float* dst = out + (size_t)tok * DM + col0; const float* g2 = mod + b * NMOD + 5 * DM + col0;
#pragma unroll
                    for (int bj = 0; bj < 2; ++bj)
#pragma unroll
                        for (int n = 0; n < 2; ++n) { const f32x4 xv = *(const f32x4*)(dst + bj * 128 + 4 * n), gv = *(const f32x4*)(g2 + bj * 128 + 4 * n); *(f32x4*)(dst + bj * 128 + 4 * n) = xv + gv * acc[ai][bj][m][n]; }
                }
                asm volatile("" ::: "memory"); }
    }
};
__device__ __forceinline__ void phase_moe2(Ctx& F, int rr) {
    Moe2Sched S; S.T = build_moe_tabs(F, rr); S.ACT = (const char*)(F.ws + WS_ACT); S.W2T = (const char*)(F.ws + WS_W2T); S.G = F.G; S.c = F.bid; gm::stage_geom(F.tid, S.R, S.C);
    EpiMoe2 E{(const int*)(F.ws + WS_TOKL), (const float*)(F.ws + WS_WL), (bf16_t*)(F.ws + WS_SLOTS), F.out, (const float*)(F.ws + WS_SMALL + SM_MOD), rr};
    gm::gemm_phase<true>(F.lds, 256, S, E);
}
__device__ __forceinline__ void phase_final(Ctx& F, int rr) {
    const float* mod = (const float*)(F.ws + WS_SMALL + SM_MOD); const float* fg = inp(F, I_FG);
    const bf16_t* slots = (const bf16_t*)(F.ws + WS_SLOTS);
    const int gw = F.bid * 8 + F.wave, NGW = F.G * 8;
    for (int t = gw; t < RT; t += NGW) {
        const int tok = rr * RT + t, b = tok / SEQ;
        f32x4* orow = (f32x4*)(F.out + (size_t)tok * DM) + F.lane;
        f32x4 v[4]; float s = 0.f;
#pragma unroll
        for (int j = 0; j < 4; ++j) {
            const int col = 4 * F.lane + 256 * j;
            f32x4 acc = (f32x4){0.f, 0.f, 0.f, 0.f};
#pragma unroll
            for (int k = 0; k < 8; ++k) { const u32x2 w = *(const u32x2*)(slots + ((size_t)t * 8 + k) * 1024 + col); acc += (f32x4){bflo(w.x), bfhi(w.x), bflo(w.y), bfhi(w.y)}; }
            const f32x4 g2 = *(const f32x4*)(mod + b * NMOD + 5 * DM + col);
            v[j] = orow[64 * j] + g2 * acc;
            s += (v[j].x * v[j].x + v[j].y * v[j].y) + (v[j].z * v[j].z + v[j].w * v[j].w);
        }
        const float rstd = rsqrtf(wave_sum(s) * (1.f / DM) + EPS);
#pragma unroll
        for (int j = 0; j < 4; ++j) { const f32x4 g = *(const f32x4*)(fg + 4 * F.lane + 256 * j); orow[64 * j] = (v[j] * rstd) * g; }
    }
}

constexpr int N_PHASES = 17;
__global__ void __launch_bounds__(512, 2) mega_fwd(Args args) {
    extern __shared__ __attribute__((aligned(16))) unsigned char lds_raw[];
    Ctx F; F.lds = (LAS unsigned char*)lds_raw; F.ws = args.ws; F.out = args.out;
    {
        typedef __attribute__((address_space(4))) const unsigned long long* karg_t;
        const karg_t ka = (karg_t)__builtin_amdgcn_kernarg_segment_ptr();
        LAS unsigned long long* tab = (LAS unsigned long long*)(lds_raw + MISC_OFF + 14336);
        if (threadIdx.x < 20) tab[threadIdx.x] = ka[threadIdx.x];
        F.intab = tab;
    }
    F.tid = threadIdx.x; F.lane = F.tid & 63; F.wave = __builtin_amdgcn_readfirstlane(F.tid >> 6); F.G = gridDim.x; F.bid = blockIdx.x;
    volatile LAS unsigned* st = (volatile LAS unsigned*)(F.lds + MISC_OFF + MO_ST);
    if (F.tid < 4) st[F.tid] = 0u;
    __syncthreads();
    XcdBarrier bar = xcd_barrier_post((unsigned*)(F.ws + WS_CTL) + CW_BAR, st);
    if (threadIdx.x == 0) { unsigned nloc, nx; xcd_barrier_complete(bar.bar, bar.x, nloc, nx); st[0] = nloc; st[1] = nx; }
    int lo = args.ph_lo, hi = args.ph_hi;
    { int a = lo, b = hi; asm volatile("" : "+v"(a), "+v"(b)); lo = __builtin_amdgcn_readfirstlane(a); hi = __builtin_amdgcn_readfirstlane(b); }
    launder(F);
#ifndef PH_MASK
#define PH_MASK 0x1ffff
#endif
#define PH_ON(k) ((PH_MASK >> (k)) & 1)
#define IN(k) (lo <= (k) && (k) < hi)
#define SEAM(k) do { if (IN(k) && IN((k) + 1)) { bar.bar = launder_ptr(bar.bar); xcd_barrier(bar); } } while (0)
#define RUN(k, call) do { if (PH_ON(k) && IN(k)) { launder(F); call; } } while (0)
    RUN(0, phase0(F)); SEAM(0);
    RUN(1, phase1(F)); SEAM(1);
    RUN(2, phase2(F)); SEAM(2);
    RUN(3, phase3(F)); SEAM(3);
    RUN(4, phase4(F)); SEAM(4);
    RUN(5, phase5(F)); SEAM(5);
    RUN(6, phase6(F)); SEAM(6);
    RUN(7, phase7(F)); SEAM(7);
    RUN(8, phase8(F)); SEAM(8);
#pragma unroll 1
    for (int ph = (lo > 9 ? lo : 9); ph < hi; ++ph) {
        launder(F);
        const int rr = ph >= 13 ? 1 : 0, pq = ph >= 13 ? ph - 4 : ph;
        switch (pq) {
            case 9: if (PH_ON(9)) phase_n2r(F, rr); break;
            case 10: if (PH_ON(10)) phase_moe1(F, rr); break;
            case 11: if (PH_ON(11)) phase_moe2(F, rr); break;
            default: if (PH_ON(12)) phase_final(F, rr); break;
        }
        if (ph + 1 < hi) { bar.bar = launder_ptr(bar.bar); xcd_barrier(bar); }
    }
#undef IN
#undef SEAM
#undef RUN
}

#ifndef MK_SPLIT
#define MK_SPLIT 0
#endif
extern "C" void kernel_launch(void* const* d_in, const int* in_sizes, int n_in, void* d_out, int out_size, void* d_ws, size_t ws_size, hipStream_t stream) {
    static int grid = 0;
    if (grid == 0) {
        if (n_in != 20 || in_sizes[0] != MT * DM || out_size != MT * DM || ws_size < WS_END) { fprintf(stderr, "kernel_launch: unexpected shapes (n_in %d, in0 %d, out %d, ws %zu)\n", n_in, n_in > 0 ? in_sizes[0] : -1, out_size, ws_size); grid = -1; return; }
        int dev = 0, cus = 0;
        if (hipGetDevice(&dev) != hipSuccess || hipDeviceGetAttribute(&cus, hipDeviceAttributeMultiprocessorCount, dev) != hipSuccess) { grid = -1; return; }
        if (hipFuncSetAttribute((const void*)mega_fwd, hipFuncAttributeMaxDynamicSharedMemorySize, LDS_BYTES) != hipSuccess) { fprintf(stderr, "kernel_launch: hipFuncSetAttribute failed\n"); grid = -1; return; }
        int per_cu = 0;
        if (hipOccupancyMaxActiveBlocksPerMultiprocessor(&per_cu, (const void*)mega_fwd, 512, LDS_BYTES) != hipSuccess || per_cu < 1) fprintf(stderr, "kernel_launch: occupancy query reports %d\n", per_cu);
        (void)hipGetLastError();
        grid = cus;
    }
    if (grid < 0) return;
    (void)hipMemsetAsync((char*)d_ws + WS_CTL, 0, CTL_BYTES, stream);
    Args a{};
    for (int i = 0; i < 20; ++i) a.in[i] = (const float*)d_in[i];
    a.out = (float*)d_out; a.ws = (unsigned char*)d_ws;
#if MK_SPLIT
    for (int p = 0; p < N_PHASES; ++p) { a.ph_lo = p; a.ph_hi = p + 1; hipLaunchKernelGGL(mega_fwd, dim3(grid), dim3(512), LDS_BYTES, stream, a); }
#else
    a.ph_lo = 0; a.ph_hi = N_PHASES;
    hipLaunchKernelGGL(mega_fwd, dim3(grid), dim3(512), LDS_BYTES, stream, a);
#endif
}
```

```cpp
#include <hip/hip_runtime.h>
#include <cstdio>
#include <cstdint>

#define LAS __attribute__((address_space(3)))
#define GAS __attribute__((address_space(1)))
typedef unsigned short bf16_t;
typedef short bf16x8 __attribute__((ext_vector_type(8)));
typedef short s16x4 __attribute__((ext_vector_type(4)));
typedef float f32x4 __attribute__((ext_vector_type(4)));
typedef float f32x16 __attribute__((ext_vector_type(16)));
typedef float f32x2 __attribute__((ext_vector_type(2)));
typedef unsigned u32x4 __attribute__((ext_vector_type(4)));
typedef unsigned u32x2 __attribute__((ext_vector_type(2)));
typedef __bf16 bf16x2_t __attribute__((ext_vector_type(2)));

__device__ __forceinline__ unsigned cvtpk(float lo, float hi) { f32x2 v = {lo, hi}; bf16x2_t b = __builtin_convertvector(v, bf16x2_t); return __builtin_bit_cast(unsigned, b); }
__device__ __forceinline__ float bf2f(unsigned short u) { return __uint_as_float(((unsigned)u) << 16); }
__device__ __forceinline__ float bflo(unsigned u) { return __uint_as_float(u << 16); }
__device__ __forceinline__ float bfhi(unsigned u) { return __uint_as_float(u & 0xffff0000u); }

constexpr int NB = 4, SEQ = 8192, DM = 1024, MT = NB * SEQ;
constexpr int NHEAD = 8, HD = 64, QW = 1536;
constexpr int NE = 64, EFF = 256, NMOD = 6 * DM;
constexpr int RT = MT / 2;
constexpr float EPS = 1e-6f;
constexpr float LOG2E = 1.4426950408889634f;

constexpr size_t MiB = 1u << 20;
constexpr size_t WS_CTL = 0, CTL_BYTES = 1 * MiB;
constexpr size_t WS_SMALL = 1 * MiB;
constexpr size_t SM_MOD = 0, SM_GVEC = 98304, SM_CB = 114688, SM_KBAR = 131072, SM_WRT = 393216;
constexpr size_t WS_W2T = 2 * MiB;
constexpr size_t WS_W1T = 35 * MiB;
constexpr size_t WS_WINT = 100 * MiB;
constexpr size_t WS_WBRT = 110 * MiB;
constexpr size_t WS_WOUTT = 112 * MiB;
constexpr size_t WS_H = 114 * MiB;
constexpr size_t WS_OB = 114 * MiB;
constexpr size_t WS_QSB = 178 * MiB;
constexpr size_t WS_PO = 178 * MiB;
constexpr size_t WS_QMB = 274 * MiB;
constexpr size_t WS_MERGED = 274 * MiB;
constexpr size_t WS_G = 370 * MiB;
constexpr size_t WS_LMB = 498 * MiB;
constexpr size_t WS_PLSE = 506 * MiB;
constexpr size_t WS_H2 = 100 * MiB;
constexpr size_t WS_TOKL = 132 * MiB;
constexpr size_t WS_WL = 136 * MiB;
constexpr size_t WS_ACT = 140 * MiB;
constexpr size_t WS_SLOTS = 220 * MiB;
constexpr size_t WS_TPOS = 508 * MiB;
constexpr size_t WS_END = 509 * MiB;
constexpr int CW_MBCUR = 0;
constexpr int CW_MOECUR = 1024;
constexpr int CW_BAR = 4096;

constexpr int RING_BYTES = 131072;
constexpr int MISC_OFF = RING_BYTES;
constexpr int LDS_BYTES = 147456;

#define XB_TMO      128
#define XB_XCNT(j)  (256  + 64 * (j))
#define XB_XSUB(j)  (1280 + 64 * (j))
#define XB_XGEN(j)  (2304 + 64 * (j))
#define XB_TOP      3328
#define XB_TOPGEN   3392
#define XCD_BAR_WORDS 3456
#define XB_SPIN_CAP (1u << 18)
__device__ __forceinline__ unsigned xb_ld(unsigned* p)              { return __hip_atomic_load(p, __ATOMIC_RELAXED, __HIP_MEMORY_SCOPE_AGENT); }
__device__ __forceinline__ unsigned xb_add(unsigned* p, unsigned v) { return __hip_atomic_fetch_add(p, v, __ATOMIC_RELAXED, __HIP_MEMORY_SCOPE_AGENT); }
__device__ __forceinline__ unsigned xb_xcc_id() { return (unsigned)__builtin_amdgcn_s_getreg((3 << 11) | 20) & 0xFu; }
#define XB_SPIN(cond, bar) do { unsigned _sp = 0; while (cond) { __builtin_amdgcn_s_sleep(1); \
    if ((++_sp & 255u) == 0u) { if (xb_ld(&(bar)[XB_TMO])) break; if (_sp > XB_SPIN_CAP) { atomicAdd(&(bar)[XB_TMO], 1u); break; } } } } while (0)
struct XcdBarrier { unsigned* bar; unsigned x; volatile LAS unsigned* st; };
__device__ __forceinline__ XcdBarrier xcd_barrier_post(unsigned* bar, volatile LAS unsigned* st) {
    XcdBarrier b; b.bar = bar; b.x = xb_xcc_id(); b.st = st;
    if (threadIdx.x == 0) (void)xb_add(&bar[XB_XCNT(b.x)], 1u);
    return b;
}
__device__ __forceinline__ void xcd_barrier_complete(unsigned* bar, unsigned x, unsigned& nloc, unsigned& nx) {
    const unsigned G = gridDim.x * gridDim.y * gridDim.z;
    unsigned sum, cnt, mine, sp = 0u;
    for (;;) {
        sum = 0u; cnt = 0u; mine = 0u;
#pragma unroll
        for (unsigned j = 0; j < 16; ++j) { const unsigned c = xb_ld(&bar[XB_XCNT(j)]); sum += c; cnt += (c > 0u) ? 1u : 0u; mine = (j == x) ? c : mine; }
        if (sum == G) break;
        __builtin_amdgcn_s_sleep(1);
        if ((++sp & 255u) == 0u) { if (xb_ld(&bar[XB_TMO])) break; if (sp > XB_SPIN_CAP) { atomicAdd(&bar[XB_TMO], 1u); break; } }
    }
    nloc = mine > 0u ? mine : 1u; nx = cnt > 0u ? cnt : 1u;
}
__device__ __forceinline__ void xcd_barrier(const XcdBarrier& b) {
    asm volatile("s_waitcnt vmcnt(0)" ::: "memory");
    __syncthreads();
    if (threadIdx.x == 0) {
        unsigned* bar = b.bar;
        __builtin_amdgcn_s_waitcnt(0);
        unsigned nloc = b.st[0], nx = b.st[1];
        const unsigned old = xb_add(&bar[XB_XSUB(b.x)], 1u);
        const unsigned gen = old / nloc;
        if (old + 1u == (gen + 1u) * nloc) {
            __builtin_amdgcn_fence(__ATOMIC_RELEASE, "agent");
            asm volatile("s_waitcnt vmcnt(0)" ::: "memory");
            const unsigned og = xb_add(&bar[XB_TOP], 1u);
            const unsigned tg = og / nx;
            if (og + 1u == (tg + 1u) * nx) xb_add(&bar[XB_TOPGEN], 1u);
            else XB_SPIN(xb_ld(&bar[XB_TOPGEN]) == tg, bar);
            __builtin_amdgcn_fence(__ATOMIC_ACQUIRE, "agent");
            xb_add(&bar[XB_XGEN(b.x)], 1u);
            asm volatile("s_waitcnt vmcnt(0)" ::: "memory");
        } else {
            XB_SPIN(xb_ld(&bar[XB_XGEN(b.x)]) == gen, bar);
            __builtin_amdgcn_fence(__ATOMIC_ACQUIRE, "agent");
            asm volatile("s_waitcnt vmcnt(0)" ::: "memory");
        }
    }
    __syncthreads();
}

namespace gm {
constexpr int BM = 256, BK = 64, HALF = 128, HTB = HALF * BK * 2, STAGE_BYTES = 8 * HTB, NXCD = 8, WGM = 8;
__host__ __device__ __forceinline__ int lds_byte(int r, int c) { const int st = (r >> 4) * 2 + (c >> 5), rr = r & 15, cc = c & 31, ob = rr * 64 + cc * 2; return st * 1024 + (ob ^ (((ob >> 9) & 1) << 5)); }
__host__ __device__ __forceinline__ void stage_rc(int b, int& R, int& C) { const int st = b / 1024, sb = b % 1024, swz = sb ^ (((sb >> 9) & 1) << 5); R = (st >> 1) * 16 + swz / 64; C = (st & 1) * 32 + (swz % 64) / 2; }
__host__ __device__ __forceinline__ int perm32(int rho) { const int n = rho >> 4, i = rho & 15; return 8 * (i >> 2) + 4 * n + (i & 3); }

struct UnitD { const char* a; const char* b; unsigned va[2][2]; int e0, e1, e2, e3; };

__device__ __forceinline__ bool static_tile(int M, int N, int G, int c, int i, int& pm, int& pn) {
    const int nM = M / BM, nN = N / BM, nwg = nM * nN;
    const long L = (long)i * G + c; if (L >= nwg) return false;
    int wgid = (int)L; { const int q = nwg / NXCD, r = nwg % NXCD, xcd = wgid % NXCD, off = wgid / NXCD; wgid = (xcd < r ? xcd * (q + 1) : r * (q + 1) + (xcd - r) * q) + off; }
    const int nig = WGM * nN, gid = wgid / nig, fm = gid * WGM, gsz = (nM - fm) < WGM ? (nM - fm) : WGM;
    pm = fm + ((wgid % nig) % gsz); pn = (wgid % nig) / gsz; return true;
}

template <bool PERM, class Epi, class Sched>
__device__ __forceinline__ void gemm_phase(LAS unsigned char* lds, const int K, Sched& S, const Epi& E) {
    const int tid = threadIdx.x, wid = __builtin_amdgcn_readfirstlane(tid >> 6), lane = tid & 63, wr = wid >> 2, wc = wid & 3, fr = lane & 15, fq = lane >> 4;
    const int nt = K / BK;
    unsigned voffB[2];
#pragma unroll
    for (int i = 0; i < 2; ++i) { int R, C; stage_rc(tid * 16 + i * 8192, R, C); const int Rb = PERM ? ((R & ~31) + perm32(R & 31)) : R; voffB[i] = (unsigned)(Rb * K + C) * 2u; }
    const size_t kstep = (size_t)(BK * 2);
    const size_t hstep = (size_t)HALF * K * 2;
    const unsigned ldsw = (unsigned)wid * 1024u;
    const int aoff = lds_byte(wr * 64 + fr, fq * 8), boff = lds_byte(wc * 32 + fr, fq * 8);
#define GM_SA(b, h) (((b) * 2 + (h)) * HTB)
#define GM_SB(b, h) ((4 + (b) * 2 + (h)) * HTB)
#define GM_STAGE_A(bufoff, U, h, kb) do { _Pragma("unroll") for (int _i = 0; _i < 2; ++_i) \
        __builtin_amdgcn_global_load_lds((const unsigned*)((U).a + (kb) + (U).va[h][_i]), (LAS unsigned*)(lds + (bufoff) + ldsw + _i * 8192), 16, 0, 0); } while (0)
#define GM_STAGE_B(bufoff, U, h, kb) do { _Pragma("unroll") for (int _i = 0; _i < 2; ++_i) \
        __builtin_amdgcn_global_load_lds((const unsigned*)((U).b + (kb) + (size_t)(h) * hstep + voffB[_i]), (LAS unsigned*)(lds + (bufoff) + ldsw + _i * 8192), 16, 0, 0); } while (0)
#define GM_LDA(dst, b, h) do { _Pragma("unroll") for (int m = 0; m < 4; ++m) _Pragma("unroll") for (int k = 0; k < 2; ++k) dst[m][k] = *(const LAS bf16x8*)(lds + GM_SA(b, h) + aoff + m * 2048 + k * 1024); } while (0)
#define GM_LDB(dst, b, h) do { _Pragma("unroll") for (int n = 0; n < 2; ++n) _Pragma("unroll") for (int k = 0; k < 2; ++k) dst[n][k] = *(const LAS bf16x8*)(lds + GM_SB(b, h) + boff + n * 2048 + k * 1024); } while (0)
#define GM_MMA(ai, bj, At, Bt) do { __builtin_amdgcn_s_setprio(1); _Pragma("unroll") for (int m = 0; m < 4; ++m) _Pragma("unroll") for (int n = 0; n < 2; ++n) _Pragma("unroll") for (int k = 0; k < 2; ++k) \
        acc[ai][bj][m][n] = __builtin_amdgcn_mfma_f32_16x16x32_bf16(Bt[n][k], At[m][k], acc[ai][bj][m][n], 0, 0, 0); __builtin_amdgcn_s_setprio(0); } while (0)
#define GM_WAIT_V(n) asm volatile("s_waitcnt vmcnt(" #n ")" ::: "memory")
#define GM_WAIT_L(n) asm volatile("s_waitcnt lgkmcnt(" #n ")" ::: "memory")
#define GM_BAR __builtin_amdgcn_s_barrier()
#define GM_SCHED __builtin_amdgcn_sched_barrier(0)
    UnitD cur, nxt; int ui = 0;
    if (!S.next(0, cur)) return;
    f32x4 acc[2][2][4][2];
#pragma unroll
    for (int a = 0; a < 2; ++a)
#pragma unroll
        for (int b = 0; b < 2; ++b)
#pragma unroll
            for (int m = 0; m < 4; ++m)
#pragma unroll
                for (int n = 0; n < 2; ++n) acc[a][b][m][n] = (f32x4){0.f, 0.f, 0.f, 0.f};
    bf16x8 At[4][2], B0[2][2], B1[2][2];
    GM_STAGE_B(GM_SB(0, 0), cur, 0, 0); GM_STAGE_B(GM_SB(0, 1), cur, 1, 0); GM_STAGE_A(GM_SA(0, 0), cur, 0, 0); GM_STAGE_A(GM_SA(0, 1), cur, 1, 0);
    if (wr == 1) GM_BAR;
    GM_WAIT_V(2); GM_BAR;
    GM_STAGE_B(GM_SB(1, 0), cur, 0, kstep); GM_STAGE_A(GM_SA(1, 0), cur, 0, kstep); GM_STAGE_B(GM_SB(1, 1), cur, 1, kstep);
    GM_WAIT_V(6); GM_BAR;
    for (;;) {
        const bool has_next = S.next(ui + 1, nxt);
        if (!has_next) nxt = cur;
#pragma unroll 1
        for (int t = 0; t < nt; t += 2) {
            const bool last = (t == nt - 2);
            const size_t k1 = (size_t)(t + 1) * kstep;
            UnitD U2 = cur; size_t k2 = (size_t)(t + 2) * kstep;
            if (last) { U2 = nxt; k2 = 0; }
            const size_t k3 = k2 + kstep;
            GM_LDB(B0, 0, 0); GM_LDB(B1, 0, 1); GM_SCHED; GM_LDA(At, 0, 0); GM_STAGE_A(GM_SA(1, 1), cur, 1, k1);
            GM_WAIT_V(8); GM_WAIT_L(0); GM_BAR; GM_MMA(0, 0, At, B0); GM_MMA(0, 1, At, B1); GM_BAR; GM_SCHED;
            GM_LDA(At, 0, 1); GM_STAGE_B(GM_SB(0, 0), U2, 0, k2); GM_STAGE_B(GM_SB(0, 1), U2, 1, k2); GM_STAGE_A(GM_SA(0, 0), U2, 0, k2);
            GM_WAIT_V(8); GM_WAIT_L(0); GM_BAR; GM_MMA(1, 0, At, B0); GM_MMA(1, 1, At, B1); GM_BAR; GM_SCHED;
            GM_LDB(B0, 1, 0); GM_LDB(B1, 1, 1); GM_SCHED; GM_LDA(At, 1, 0); GM_STAGE_A(GM_SA(0, 1), U2, 1, k2);
            GM_WAIT_V(8); GM_WAIT_L(0); GM_BAR; GM_MMA(0, 0, At, B0); GM_MMA(0, 1, At, B1); GM_BAR; GM_SCHED;
            GM_LDA(At, 1, 1); GM_STAGE_B(GM_SB(1, 0), U2, 0, k3); GM_STAGE_B(GM_SB(1, 1), U2, 1, k3); GM_STAGE_A(GM_SA(1, 0), U2, 0, k3);
            GM_WAIT_V(8); GM_WAIT_L(0); GM_BAR; GM_MMA(1, 0, At, B0); GM_MMA(1, 1, At, B1); GM_BAR; GM_SCHED;
        }
        if (wr == 0) GM_BAR;
        E(acc, cur, wr, wc, fr, fq);
        if (!has_next) break;
#pragma unroll
        for (int a = 0; a < 2; ++a)
#pragma unroll
            for (int b = 0; b < 2; ++b)
#pragma unroll
                for (int m = 0; m < 4; ++m)
#pragma unroll
                    for (int n = 0; n < 2; ++n) acc[a][b][m][n] = (f32x4){0.f, 0.f, 0.f, 0.f};
        cur = nxt; ++ui;
        if (wr == 1) GM_BAR;
    }
    GM_WAIT_V(0);
    GM_BAR;
#undef GM_SA
#undef GM_SB
#undef GM_STAGE_A
#undef GM_STAGE_B
#undef GM_LDA
#undef GM_LDB
#undef GM_MMA
#undef GM_WAIT_V
#undef GM_WAIT_L
#undef GM_BAR
#undef GM_SCHED
}
__device__ __forceinline__ void stage_geom(int tid, int (&R)[2], int (&C)[2]) {
#pragma unroll
    for (int i = 0; i < 2; ++i) stage_rc(tid * 16 + i * 8192, R[i], C[i]);
}
}

struct Args { const float* in[20]; float* out; unsigned char* ws; int ph_lo, ph_hi; };
struct Ctx {
    LAS unsigned char* lds;
    unsigned char* ws;
    const LAS unsigned long long* intab;
    float* out;
    int tid, lane, wave, G, bid;
};
#define LDS_WAIT() asm volatile("s_waitcnt lgkmcnt(0)" ::: "memory")
__device__ __forceinline__ const float* inp(const Ctx& F, int i) {
    const unsigned long long v = F.intab[i];
    const unsigned lo = __builtin_amdgcn_readfirstlane((unsigned)v), hi = __builtin_amdgcn_readfirstlane((unsigned)(v >> 32));
    return (const float*)(GAS const float*)(((unsigned long long)hi << 32) | lo);
}
template <class P> __device__ __forceinline__ P launder_ptr(P p) {
    unsigned long long v = (unsigned long long)p; unsigned lo = (unsigned)v, hi = (unsigned)(v >> 32);
    asm volatile("" : "+v"(lo), "+v"(hi));
    lo = __builtin_amdgcn_readfirstlane(lo); hi = __builtin_amdgcn_readfirstlane(hi);
    return (P)(GAS unsigned char*)(((unsigned long long)hi << 32) | lo);
}
__device__ __forceinline__ void launder(Ctx& F) {
    int t = F.tid, g = F.G, bid = F.bid;
    asm volatile("" : "+v"(t), "+v"(g), "+v"(bid));
    F.tid = t; F.G = __builtin_amdgcn_readfirstlane(g); F.bid = __builtin_amdgcn_readfirstlane(bid); F.lane = t & 63; F.wave = __builtin_amdgcn_readfirstlane(t >> 6);
    F.ws = launder_ptr(F.ws); F.out = launder_ptr(F.out);
}
__device__ __forceinline__ float wave_sum(float v) {
#pragma unroll
    for (int o = 1; o < 64; o <<= 1) v += __shfl_xor(v, o);
    return v;
}
__device__ __forceinline__ int lds_add(LAS int* p, int v) { return __hip_atomic_fetch_add(p, v, __ATOMIC_RELAXED, __HIP_MEMORY_SCOPE_WORKGROUP); }
__device__ __forceinline__ float sigmoidf_(float x) { return 1.f / (1.f + __expf(-x)); }
__device__ __forceinline__ float siluf_(float x) { return x / (1.f + __expf(-x)); }

enum { I_X = 0, I_C, I_N1G, I_N2G, I_WADA, I_BADA, I_WIN, I_WBSB, I_WBMB, I_WOUT, I_WR, I_RB, I_WGE, I_WUE, I_WDE, I_WGS, I_WUS, I_WDS, I_RELB, I_FG };

__device__ __forceinline__ void transpose_item(const float* W, int ldn, int k0, int n0, bf16_t* WT, int Kdst, int drow0, LAS float* scr, int lane) {
#pragma unroll 8
    for (int i = 0; i < 32; ++i) { const int kk = 2 * i + (lane >> 5); scr[kk * 33 + (lane & 31)] = W[(size_t)(k0 + kk) * ldn + n0 + (lane & 31)]; }
    LDS_WAIT(); asm volatile("" ::: "memory");
    const int c = lane & 7;
#pragma unroll
    for (int j = 0; j < 4; ++j) { const int n = (lane >> 3) + 8 * j; const LAS float* s = scr + (8 * c) * 33 + n;
        u32x4 o; o.x = cvtpk(s[0 * 33], s[1 * 33]); o.y = cvtpk(s[2 * 33], s[3 * 33]); o.z = cvtpk(s[4 * 33], s[5 * 33]); o.w = cvtpk(s[6 * 33], s[7 * 33]);
        *(u32x4*)(WT + (size_t)(drow0 + n) * Kdst + k0 + 8 * c) = o; }
    LDS_WAIT(); asm volatile("" ::: "memory");
}
__device__ __forceinline__ void phase0(Ctx& F) {
    LAS float* silc = (LAS float*)(F.lds + MISC_OFF - 0);
    silc = (LAS float*)(F.lds + 0);
    for (int i = F.tid; i < 4 * DM; i += 512) silc[i] = siluf_(inp(F, I_C)[i]);
    __syncthreads();
    float* mod = (float*)(F.ws + WS_SMALL + SM_MOD);
    {
        const int gw = F.wave * F.G + F.bid;
        const int c = F.lane & 15, kp = F.lane >> 4;
        const float* wada = inp(F, I_WADA);
        for (int item = gw; item < NMOD / 16; item += 8 * F.G) {
            const int col = item * 16 + c;
            float a0 = 0.f, a1 = 0.f, a2 = 0.f, a3 = 0.f;
#pragma unroll 8
            for (int k = kp; k < DM; k += 4) { const float w = wada[(size_t)k * NMOD + col]; a0 += silc[k] * w; a1 += silc[DM + k] * w; a2 += silc[2 * DM + k] * w; a3 += silc[3 * DM + k] * w; }
            a0 += __shfl_xor(a0, 16); a0 += __shfl_xor(a0, 32); a1 += __shfl_xor(a1, 16); a1 += __shfl_xor(a1, 32);
            a2 += __shfl_xor(a2, 16); a2 += __shfl_xor(a2, 32); a3 += __shfl_xor(a3, 16); a3 += __shfl_xor(a3, 32);
            if (kp == 0) { const float bb = inp(F, I_BADA)[col]; mod[col] = a0 + bb; mod[NMOD + col] = a1 + bb; mod[2 * NMOD + col] = a2 + bb; mod[3 * NMOD + col] = a3 + bb; }
        }
    }
    __syncthreads();
    {
        LAS float* scr = (LAS float*)(F.lds + F.wave * 16384);
        const int gw = F.bid * 8 + F.wave, NGW = F.G * 8;
        constexpr int I_IN = 16 * 160, I_BR = 8 * 32, I_OUT = 16 * 32, I_EXP = 384, NIT = I_IN + 2 * I_BR + I_OUT + 65 * I_EXP;
        for (int it = gw; it < NIT; it += NGW) {
            int r = it;
            if (r < I_IN) { const int kb = r / 160, nb = r % 160; transpose_item(inp(F, I_WIN), 5120, kb * 64, nb * 32, (bf16_t*)(F.ws + WS_WINT), 1024, nb * 32, scr, F.lane); continue; } r -= I_IN;
            if (r < I_BR) { const int kb = r / 32, nb = r % 32; transpose_item(inp(F, I_WBSB), 1024, kb * 64, nb * 32, (bf16_t*)(F.ws + WS_WBRT), 512, nb * 32, scr, F.lane); continue; } r -= I_BR;
            if (r < I_BR) { const int kb = r / 32, nb = r % 32; transpose_item(inp(F, I_WBMB), 1024, kb * 64, nb * 32, (bf16_t*)(F.ws + WS_WBRT), 512, 1024 + nb * 32, scr, F.lane); continue; } r -= I_BR;
            if (r < I_OUT) { const int kb = r / 32, nb = r % 32; transpose_item(inp(F, I_WOUT), 1024, kb * 64, nb * 32, (bf16_t*)(F.ws + WS_WOUTT), 1024, nb * 32, scr, F.lane); continue; } r -= I_OUT;
            const int e = r / I_EXP; r -= e * I_EXP;
            if (r < 128) {
                const float* src = e < NE ? inp(F, I_WGE) + (size_t)e * DM * EFF : inp(F, I_WGS);
                const int kb = r / 8, nb = r % 8, n0 = nb * 32;
                transpose_item(src, EFF, kb * 64, n0, (bf16_t*)(F.ws + WS_W1T) + (size_t)e * 512 * 1024, 1024, (n0 >> 7) * 256 + (n0 & 127), scr, F.lane);
            } else if (r < 256) {
                r -= 128;
                const float* src = e < NE ? inp(F, I_WUE) + (size_t)e * DM * EFF : inp(F, I_WUS);
                const int kb = r / 8, nb = r % 8, n0 = nb * 32;
                transpose_item(src, EFF, kb * 64, n0, (bf16_t*)(F.ws + WS_W1T) + (size_t)e * 512 * 1024, 1024, (n0 >> 7) * 256 + 128 + (n0 & 127), scr, F.lane);
            } else {
                r -= 256;
                const float* src = e < NE ? inp(F, I_WDE) + (size_t)e * EFF * DM : inp(F, I_WDS);
                const int kb = r / 32, nb = r % 32;
                transpose_item(src, DM, kb * 64, nb * 32, (bf16_t*)(F.ws + WS_W2T) + (size_t)e * 1024 * 256, 256, nb * 32, scr, F.lane);
            }
        }
    }
    {
        float* wrt = (float*)(F.ws + WS_SMALL + SM_WRT);
        const float* wr = inp(F, I_WR);
        for (int i = F.bid * 512 + F.tid; i < NE * DM; i += F.G * 512) { const int e = i >> 10, k = i & 1023; wrt[i] = wr[k * NE + e]; }
    }
}

__device__ __forceinline__ void phase1(Ctx& F) {
    const float* mod = (const float*)(F.ws + WS_SMALL + SM_MOD);
    const float* x = inp(F, I_X); const float* g1 = inp(F, I_N1G);
    bf16_t* H = (bf16_t*)(F.ws + WS_H);
    const int gw = F.bid * 8 + F.wave, NGW = F.G * 8;
    if (gw < 256) {
        const int b = gw >> 6, e = gw & 63; const float* wr = inp(F, I_WR); float a = 0.f;
#pragma unroll 4
        for (int k = F.lane; k < DM; k += 64) a += mod[b * NMOD + 3 * DM + k] * wr[k * NE + e];
        a = wave_sum(a);
        if (F.lane == 0) ((float*)(F.ws + WS_SMALL + SM_CB))[gw] = a;
    }
    if (F.bid == 32) {
        float* gvec = (float*)(F.ws + WS_SMALL + SM_GVEC); const float* g2 = inp(F, I_N2G);
        for (int i = F.tid; i < 4 * DM; i += 512) { const int b = i >> 10, k = i & 1023; gvec[i] = g2[k] * (1.f + mod[b * NMOD + 4 * DM + k]); }
    }
    for (int m0 = gw; m0 < MT; m0 += 2 * NGW) {
        const int m1 = m0 + NGW;
        const bool two = m1 < MT;
        const f32x4* xr0 = (const f32x4*)(x + (size_t)m0 * DM) + F.lane; const f32x4* xr1 = (const f32x4*)(x + (size_t)(two ? m1 : m0) * DM) + F.lane;
        f32x4 v0[4], v1[4]; float s0 = 0.f, s1 = 0.f;
#pragma unroll
        for (int j = 0; j < 4; ++j) { v0[j] = xr0[64 * j]; v1[j] = xr1[64 * j]; }
#pragma unroll
        for (int j = 0; j < 4; ++j) { s0 += (v0[j].x * v0[j].x + v0[j].y * v0[j].y) + (v0[j].z * v0[j].z + v0[j].w * v0[j].w); s1 += (v1[j].x * v1[j].x + v1[j].y * v1[j].y) + (v1[j].z * v1[j].z + v1[j].w * v1[j].w); }
        const float r0 = rsqrtf(wave_sum(s0) * (1.f / DM) + EPS), r1 = rsqrtf(wave_sum(s1) * (1.f / DM) + EPS);
        const int b0 = m0 / SEQ, b1 = (two ? m1 : m0) / SEQ;
        u32x2* o0 = (u32x2*)(H + (size_t)m0 * DM) + F.lane; u32x2* o1 = (u32x2*)(H + (size_t)(two ? m1 : m0) * DM) + F.lane;
#pragma unroll
        for (int j = 0; j < 4; ++j) {
            const int col = 4 * F.lane + 256 * j;
            const f32x4 g = *(const f32x4*)(g1 + col);
            const f32x4 h0 = (v0[j] * r0) * g * (*(const f32x4*)(mod + b0 * NMOD + DM + col) + 1.0f) + *(const f32x4*)(mod + b0 * NMOD + col);
            const f32x4 h1 = (v1[j] * r1) * g * (*(const f32x4*)(mod + b1 * NMOD + DM + col) + 1.0f) + *(const f32x4*)(mod + b1 * NMOD + col);
            u32x2 w; w.x = cvtpk(h0.x, h0.y); w.y = cvtpk(h0.z, h0.w); o0[64 * j] = w;
            if (two) { w.x = cvtpk(h1.x, h1.y); w.y = cvtpk(h1.z, h1.w); o1[64 * j] = w; }
        }
    }
}

struct ProjSched {
    const char* A; const char* Bt; int G, c; int R[2], C[2];
    __device__ __forceinline__ bool next(int i, gm::UnitD& u) {
        int pm, pn; if (!gm::static_tile(MT, 5120, G, c, i, pm, pn)) return false;
        u.a = A; u.b = Bt + (size_t)pn * 256 * 1024 * 2;
#pragma unroll
        for (int h = 0; h < 2; ++h)
#pragma unroll
            for (int j = 0; j < 2; ++j) u.va[h][j] = (unsigned)((pm * 256 + h * 128 + R[j]) * 1024 + C[j]) * 2u;
        u.e0 = pm; u.e1 = pn; u.e2 = 0; u.e3 = 0; return true;
    }
};
struct EpiProj {
    bf16_t* qsb; bf16_t* qmb; bf16_t* g;
    __device__ __forceinline__ void operator()(const f32x4 (&acc)[2][2][4][2], const gm::UnitD& u, int wr, int wc, int fr, int fq) const {
        const int pm = u.e0, pn = u.e1;
        bf16_t* base; int ldc, colt; float sc = 1.f;
        if (pn < 6) { base = qsb; ldc = QW; colt = pn * 256; if (pn < 2) sc = 0.125f; }
        else if (pn < 12) { base = qmb; ldc = QW; colt = (pn - 6) * 256; if (pn < 8) sc = 0.125f; }
        else { base = g; ldc = 2048; colt = (pn - 12) * 256; }
        const int row0 = pm * 256 + wr * 64 + fr, col0 = colt + wc * 32 + 8 * fq;
#pragma unroll
        for (int ai = 0; ai < 2; ++ai)
#pragma unroll
            for (int m = 0; m < 4; ++m) { bf16_t* rowp = base + (size_t)(row0 + ai * 128 + m * 16) * ldc + col0;
#pragma unroll
                for (int bj = 0; bj < 2; ++bj) { const f32x4 v0 = acc[ai][bj][m][0] * sc, v1 = acc[ai][bj][m][1] * sc;
                    u32x4 w; w.x = cvtpk(v0[0], v0[1]); w.y = cvtpk(v0[2], v0[3]); w.z = cvtpk(v1[0], v1[1]); w.w = cvtpk(v1[2], v1[3]);
                    *(u32x4*)(rowp + bj * 128) = w; } }
    }
};
__device__ __forceinline__ void phase2(Ctx& F) {
    ProjSched S; S.A = (const char*)(F.ws + WS_H); S.Bt = (const char*)(F.ws + WS_WINT); S.G = F.G; S.c = F.bid; gm::stage_geom(F.tid, S.R, S.C);
    EpiProj E{(bf16_t*)(F.ws + WS_QSB), (bf16_t*)(F.ws + WS_QMB), (bf16_t*)(F.ws + WS_G)};
    gm::gemm_phase<true>(F.lds, 1024, S, E);
}

__device__ __forceinline__ int crow(int r, int hi) { return (r & 3) + 8 * (r >> 2) + 4 * hi; }
typedef short v4i16_t __attribute__((ext_vector_type(4)));
__device__ __forceinline__ s16x4 vtr(const LAS unsigned char* p) { return __builtin_bit_cast(s16x4, __builtin_amdgcn_ds_read_tr16_b64_v4i16((LAS v4i16_t*)p)); }
__device__ __forceinline__ void pv64(f32x16 (&o)[2], const LAS unsigned char* vt, int lane, const u32x4 (&pw)[4]) {
    const int hi = lane >> 5;
    const LAS unsigned char* vb = vt + ((lane >> 4) & 1) * 32 + (lane & 3) * 8 + (4 * hi + ((lane & 15) >> 2)) * 64;
#pragma unroll
    for (int d0 = 0; d0 < 2; ++d0)
#pragma unroll
        for (int ks = 0; ks < 4; ++ks) {
            const s16x4 lo = vtr(vb + d0 * 4096 + ks * 1024), hh = vtr(vb + d0 * 4096 + ks * 1024 + 512);
            const bf16x8 bv = (bf16x8){lo[0], lo[1], lo[2], lo[3], hh[0], hh[1], hh[2], hh[3]};
            o[d0] = __builtin_amdgcn_mfma_f32_32x32x16_bf16(__builtin_bit_cast(bf16x8, pw[ks]), bv, o[d0], 0, 0, 0);
        }
}
__device__ __forceinline__ void store_o_tile(const f32x16 (&o)[2], LAS unsigned char* stgb, int lane, bf16_t* dst0, size_t row_pitch) {
    const int r32 = lane & 31, hi = lane >> 5;
    LAS bf16_t* stg = (LAS bf16_t*)stgb;
#pragma unroll
    for (int r = 0; r < 16; ++r) { const int orow = crow(r, hi);
#pragma unroll
        for (int d0 = 0; d0 < 2; ++d0) stg[orow * 64 + d0 * 32 + r32] = (bf16_t)(cvtpk(o[d0][r], 0.f) & 0xffffu); }
    LDS_WAIT();
#pragma unroll
    for (int i = 0; i < 4; ++i) { const int row = i * 8 + (lane >> 3), ch = lane & 7; const u32x4 v = *(const LAS u32x4*)(stg + row * 64 + ch * 8); *(u32x4*)(dst0 + (size_t)row * row_pitch + ch * 8) = v; }
    LDS_WAIT();
}

template <bool MASKED>
__device__ __forceinline__ void sb_tile(const f32x16 (&z)[2], float& P, u32x4 (&pw)[4], int k0, int qpos, int hi) {
    f32x16 be[2], nb[2];
#pragma unroll
    for (int p = 0; p < 2; ++p)
#pragma unroll
        for (int r = 0; r < 16; ++r) {
            const float zz = __builtin_amdgcn_fmed3f(z[p][r] * LOG2E, -126.f, 126.f);
            const float t = __builtin_amdgcn_exp2f(-zz), b_ = __builtin_amdgcn_rcpf(1.f + t);
            float n_ = t * b_, bb = b_;
            if (MASKED) { const bool valid = (k0 + 32 * p + crow(r, hi)) < qpos; n_ = valid ? n_ : 1.f; bb = valid ? bb : 0.f; }
            be[p][r] = bb; nb[p][r] = n_;
        }
    float Gp[8], PG[8], off[8];
#pragma unroll
    for (int idx = 0; idx < 8; ++idx) { const int p = idx >> 2, g4 = (idx & 3) * 4; Gp[idx] = (nb[p][g4] * nb[p][g4 + 1]) * (nb[p][g4 + 2] * nb[p][g4 + 3]); }
#pragma unroll
    for (int idx = 0; idx < 8; ++idx) PG[idx] = __shfl_xor(Gp[idx], 32);
    float run = P;
#pragma unroll
    for (int idx = 7; idx >= 0; --idx) { off[idx] = hi ? run : run * PG[idx]; run *= (Gp[idx] * PG[idx]); }
    P = run;
#pragma unroll
    for (int idx = 0; idx < 8; ++idx) { const int p = idx >> 2, g4 = (idx & 3) * 4; float c = off[idx]; float a[4];
#pragma unroll
        for (int j = 3; j >= 0; --j) { a[j] = be[p][g4 + j] * c; c *= nb[p][g4 + j]; }
        pw[idx >> 1][(idx & 1) * 2] = cvtpk(a[0], a[1]); pw[idx >> 1][(idx & 1) * 2 + 1] = cvtpk(a[2], a[3]); }
}
__device__ __forceinline__ void sb_unit(Ctx& F, int bh, int qt, LAS unsigned char* vl) {
    const int lane = F.lane, r32 = lane & 31, hi = lane >> 5;
    const int b = bh >> 3, h = bh & 7, q0 = qt * 32, qpos = q0 + r32;
    const bf16_t* base = (const bf16_t*)(F.ws + WS_QSB) + (size_t)b * SEQ * QW + h * 64;
    const bf16_t* Kb = base + 512 + (size_t)r32 * QW + hi * 8; const bf16_t* Vb = base + 1024 + (size_t)(lane >> 2) * QW + (lane & 3) * 8;
    bf16x8 qr[4];
#pragma unroll
    for (int d0 = 0; d0 < 4; ++d0) qr[d0] = *(const bf16x8*)(base + (size_t)qpos * QW + d0 * 16 + hi * 8);
    float P = 1.f; f32x16 o[2]; o[0] = f32x16{}; o[1] = f32x16{};
    bf16x8 kfn[8];
    const int kt0 = q0 >> 6; int kt = kt0, cur = 0;
#define SB_PREFETCH(KT, BUF) do { const size_t ko_ = (size_t)(KT) * 64 * QW; \
        _Pragma("unroll") for (int d0 = 0; d0 < 4; ++d0) _Pragma("unroll") for (int hf = 0; hf < 2; ++hf) kfn[2 * d0 + hf] = *(const bf16x8*)(Kb + ko_ + (size_t)(32 * hf) * QW + d0 * 16); \
        _Pragma("unroll") for (int p = 0; p < 8; ++p) __builtin_amdgcn_global_load_lds((const unsigned*)(Vb + ko_ + (size_t)(16 * (p & 3)) * QW + (p >> 2) * 32), (LAS unsigned*)(vl + (BUF) * 8192 + p * 1024), 16, 0, 0); } while (0)
    SB_PREFETCH(kt, 0);
#pragma unroll 1
    for (; kt >= 0; --kt) {
        if (__all(P == 0.f)) break;
        f32x16 z[2]; z[0] = f32x16{}; z[1] = f32x16{};
#pragma unroll
        for (int d0 = 0; d0 < 4; ++d0) { z[0] = __builtin_amdgcn_mfma_f32_32x32x16_bf16(kfn[2 * d0], qr[d0], z[0], 0, 0, 0); z[1] = __builtin_amdgcn_mfma_f32_32x32x16_bf16(kfn[2 * d0 + 1], qr[d0], z[1], 0, 0, 0); }
        asm volatile("" : "+v"(z[0]), "+v"(z[1]));
        { const int ktn = kt > 0 ? kt - 1 : 0; SB_PREFETCH(ktn, cur ^ 1); }
        u32x4 pw[4];
        if (kt == kt0) sb_tile<true>(z, P, pw, kt * 64, qpos, hi); else sb_tile<false>(z, P, pw, kt * 64, qpos, hi);
        asm volatile("s_waitcnt vmcnt(16)" ::: "memory");
        pv64(o, vl + cur * 8192, lane, pw);
        cur ^= 1;
    }
#undef SB_PREFETCH
    asm volatile("s_waitcnt vmcnt(0)" ::: "memory");
    bf16_t* dst = (bf16_t*)(F.ws + WS_OB) + (size_t)(b * SEQ + q0) * 512 + h * 64;
    store_o_tile(o, vl, lane, dst, 512);
}
__device__ __forceinline__ void phase3(Ctx& F) {
    {
        float* kbar = (float*)(F.ws + WS_SMALL + SM_KBAR);
        const int gwk = F.wave * F.G + F.bid;
        for (int it = gwk; it < NB * 32 * 8; it += 8 * F.G) {
            const int u = it >> 3, hh = it & 7, rs = F.lane >> 3, ch = F.lane & 7;
            const bf16_t* kp = (const bf16_t*)(F.ws + WS_QMB) + (size_t)(u * 256 + rs) * QW + 512 + hh * 64 + ch * 8;
            float a[8];
#pragma unroll
            for (int j = 0; j < 8; ++j) a[j] = 0.f;
#pragma unroll 4
            for (int g = 0; g < 4; ++g) {
                u32x4 w[8];
#pragma unroll
                for (int i = 0; i < 8; ++i) w[i] = *(const u32x4*)(kp + (size_t)(g * 64 + i * 8) * QW);
#pragma unroll
                for (int i = 0; i < 8; ++i) { a[0] += bflo(w[i].x); a[1] += bfhi(w[i].x); a[2] += bflo(w[i].y); a[3] += bfhi(w[i].y); a[4] += bflo(w[i].z); a[5] += bfhi(w[i].z); a[6] += bflo(w[i].w); a[7] += bfhi(w[i].w); }
            }
#pragma unroll
            for (int j = 0; j < 8; ++j) { a[j] += __shfl_xor(a[j], 8); a[j] += __shfl_xor(a[j], 16); a[j] += __shfl_xor(a[j], 32); }
            if (rs == 0) { float* dst = kbar + u * 512 + hh * 64 + ch * 8;
                *(f32x4*)dst = (f32x4){a[0], a[1], a[2], a[3]} * (1.f / 256.f); *(f32x4*)(dst + 4) = (f32x4){a[4], a[5], a[6], a[7]} * (1.f / 256.f); }
        }
    }
    LAS unsigned char* vl = F.lds + F.wave * 16384;
    const int gw = F.bid * 8 + F.wave, NGW = F.G * 8;
    for (int u = gw; u < 32 * 256; u += NGW) sb_unit(F, u >> 8, u & 255, vl);
}

constexpr int MO_LUT = 0, MO_PRE = 4224, MO_WSF = 8320, MO_ENT = 12416, MO_ST = 16368;
__device__ __forceinline__ int mb_list_off(int j) { return 256 * (31 * j - (j * (j - 1)) / 2); }
constexpr int MB_LIST_STRIDE = 126976;
__device__ __forceinline__ int t5_bucket_dev(int n) {
    if (n < 16) return n;
    int large = 16 + (int)(logf((float)n / 16.f) / 2.0794415416798357f * 16.f);
    return large < 31 ? large : 31;
}
__device__ __forceinline__ void build_lut(Ctx& F) {
    LAS float* lut = (LAS float*)(F.lds + MISC_OFF + MO_LUT);
    for (int i = F.tid; i < 8 * 132; i += 512) { const int h = i / 132, d = i % 132; lut[i] = inp(F, I_RELB)[h * 32 + t5_bucket_dev(d < 128 ? d : 128)] * LOG2E; }
}
__device__ __forceinline__ void phase4(Ctx& F) {
    LAS float* kb = (LAS float*)(F.lds);
    LAS int* lcnt = (LAS int*)(F.lds + MISC_OFF + MO_PRE); LAS int* lbase = lcnt + 32;
    const float* kbar = (const float*)(F.ws + WS_SMALL + SM_KBAR);
    unsigned* cur = (unsigned*)(F.ws + WS_CTL) + CW_MBCUR;
    unsigned short* lists = (unsigned short*)(F.ws + WS_LMB);
    for (int u = F.bid; u < 32 * 31; u += F.G) {
        const int bh = u / 31, i = 1 + (u % 31), b = bh >> 3, h = bh & 7;
        for (int idx = F.tid; idx < i * 64; idx += 512) kb[idx] = kbar[(b * 32 + (idx >> 6)) * 512 + h * 64 + (idx & 63)];
        if (F.tid < 32) lcnt[F.tid] = 0;
        __syncthreads();
        int j0 = -1, j1 = -1, j2 = -1, r0 = 0, r1 = 0, r2 = 0; const int nsel = i < 3 ? i : 3;
        const int qpos = i * 256 + F.tid;
        if (F.tid < 256) {
            float qv[64];
            const u32x4* qp = (const u32x4*)((const bf16_t*)(F.ws + WS_QMB) + (size_t)(b * SEQ + qpos) * QW + h * 64);
#pragma unroll
            for (int c = 0; c < 8; ++c) { const u32x4 w = qp[c];
                qv[8 * c] = bflo(w.x); qv[8 * c + 1] = bfhi(w.x); qv[8 * c + 2] = bflo(w.y); qv[8 * c + 3] = bfhi(w.y);
                qv[8 * c + 4] = bflo(w.z); qv[8 * c + 5] = bfhi(w.z); qv[8 * c + 6] = bflo(w.w); qv[8 * c + 7] = bfhi(w.w); }
            float v0 = -INFINITY, v1 = -INFINITY, v2 = -INFINITY;
            for (int j = 0; j < i; ++j) {
                const LAS f32x4* kr = (const LAS f32x4*)(kb + j * 64);
                float g = 0.f;
#pragma unroll
                for (int c = 0; c < 16; ++c) { const f32x4 kk = kr[c]; g += qv[4 * c] * kk.x + qv[4 * c + 1] * kk.y + qv[4 * c + 2] * kk.z + qv[4 * c + 3] * kk.w; }
                if (g > v0) { v2 = v1; j2 = j1; v1 = v0; j1 = j0; v0 = g; j0 = j; }
                else if (g > v1) { v2 = v1; j2 = j1; v1 = g; j1 = j; }
                else if (g > v2) { v2 = g; j2 = j; }
            }
            r0 = lds_add(&lcnt[j0], 1);
            if (nsel > 1) r1 = lds_add(&lcnt[j1], 1);
            if (nsel > 2) r2 = lds_add(&lcnt[j2], 1);
        }
        __syncthreads();
        if (F.tid < i) { const int n = lcnt[F.tid]; lbase[F.tid] = n > 0 ? (int)atomicAdd(&cur[bh * 32 + F.tid], (unsigned)n) : 0; }
        __syncthreads();
        if (F.tid < 256) {
            unsigned short* lb = lists + (size_t)bh * MB_LIST_STRIDE;
            lb[mb_list_off(j0) + lbase[j0] + r0] = (unsigned short)(qpos | (0 << 13));
            if (nsel > 1) lb[mb_list_off(j1) + lbase[j1] + r1] = (unsigned short)(qpos | (1 << 13));
            if (nsel > 2) lb[mb_list_off(j2) + lbase[j2] + r2] = (unsigned short)(qpos | (2 << 13));
        }
        __syncthreads();
    }
}
__device__ __forceinline__ void stage_kv_block(Ctx& F, const bf16_t* kg, const bf16_t* vg) {
#pragma unroll
    for (int i = 0; i < 4; ++i) { const int id = F.tid + 512 * i, row = id >> 3, ch = id & 7;
        const u32x4 kv = *(const u32x4*)(kg + (size_t)row * QW + ch * 8), vv = *(const u32x4*)(vg + (size_t)row * QW + ch * 8);
        *(LAS u32x4*)(F.lds + (row >> 6) * 8192 + ch * 1024 + (row & 63) * 16) = kv;
        *(LAS u32x4*)(F.lds + 32768 + (row >> 6) * 8192 + (ch >> 2) * 4096 + ((row >> 4) & 3) * 1024 + (row & 15) * 64 + (ch & 3) * 16) = vv; }
}
__device__ __forceinline__ void softmax_step(f32x16 (&t)[2], float& m, float& l, f32x16 (&o)[2], LAS float* wsf, const LAS unsigned char* vt, int lane) {
    const int r32 = lane & 31, hi = lane >> 5;
    float rm = -INFINITY;
#pragma unroll
    for (int p = 0; p < 2; ++p)
#pragma unroll
        for (int r = 0; r < 16; ++r) rm = fmaxf(rm, t[p][r]);
    rm = fmaxf(rm, __shfl_xor(rm, 32));
    const float mn = fmaxf(m, rm);
    const float f = __builtin_amdgcn_exp2f(m - mn);
    m = mn;
    float s = 0.f; u32x4 pw[4];
#pragma unroll
    for (int p = 0; p < 2; ++p)
#pragma unroll
        for (int r = 0; r < 16; ++r) { const float e = __builtin_amdgcn_exp2f(t[p][r] - mn); t[p][r] = e; s += e; }
    l = l * f + s;
#pragma unroll
    for (int idx = 0; idx < 8; ++idx) { const int p = idx >> 2, g4 = (idx & 3) * 4; pw[idx >> 1][(idx & 1) * 2] = cvtpk(t[p][g4], t[p][g4 + 1]); pw[idx >> 1][(idx & 1) * 2 + 1] = cvtpk(t[p][g4 + 2], t[p][g4 + 3]); }
    if (__any(f != 1.f)) {
        if (hi == 0) wsf[r32] = f;
        LDS_WAIT();
#pragma unroll
        for (int g = 0; g < 4; ++g) { const f32x4 fv = *(const LAS f32x4*)(wsf + 8 * g + 4 * hi);
#pragma unroll
            for (int j = 0; j < 4; ++j) { o[0][4 * g + j] *= fv[j]; o[1][4 * g + j] *= fv[j]; } }
        LDS_WAIT();
    }
    pv64(o, vt, lane, pw);
}
__device__ __forceinline__ void qkt64(f32x16 (&t)[2], const LAS unsigned char* kt, const bf16x8 (&qr)[4], int lane) {
    const int r32 = lane & 31, hi = lane >> 5;
    t[0] = f32x16{}; t[1] = f32x16{};
#pragma unroll
    for (int d0 = 0; d0 < 4; ++d0) {
        const bf16x8 k0 = *(const LAS bf16x8*)(kt + (2 * d0 + hi) * 1024 + r32 * 16), k1 = *(const LAS bf16x8*)(kt + (2 * d0 + hi) * 1024 + 512 + r32 * 16);
        t[0] = __builtin_amdgcn_mfma_f32_32x32x16_bf16(k0, qr[d0], t[0], 0, 0, 0); t[1] = __builtin_amdgcn_mfma_f32_32x32x16_bf16(k1, qr[d0], t[1], 0, 0, 0);
    }
}
__device__ __forceinline__ void phase5(Ctx& F) {
    LAS int* pre = (LAS int*)(F.lds + MISC_OFF + MO_PRE);
    LAS int* wtot = (LAS int*)(F.lds + MISC_OFF + MO_ENT);
    const unsigned* cur = (const unsigned*)(F.ws + WS_CTL) + CW_MBCUR;
    build_lut(F);
    int total;
    {
        const int p0 = 2 * F.tid, p1 = p0 + 1;
        const int c0 = p0 < 992 ? (int)((cur[(p0 / 31) * 32 + (p0 % 31)] + 255u) >> 8) : 0;
        const int c1 = p1 < 992 ? (int)((cur[(p1 / 31) * 32 + (p1 % 31)] + 255u) >> 8) : 0;
        const int s = c0 + c1; int v = s;
#pragma unroll
        for (int o = 1; o < 64; o <<= 1) { const int n = __shfl_up(v, o); if (F.lane >= o) v += n; }
        if (F.lane == 63) wtot[248 + F.wave] = v;
        __syncthreads();
        int woff = 0; total = 0;
#pragma unroll
        for (int w = 0; w < 8; ++w) { const int x = wtot[248 + w]; if (w < F.wave) woff += x; total += x; }
        const int excl = woff + v - s;
        pre[p0] = excl; pre[p1] = excl + c0;
        __syncthreads();
    }
    const unsigned short* lists = (const unsigned short*)(F.ws + WS_LMB);
    LAS float* wsf = (LAS float*)(F.lds + MISC_OFF + MO_WSF) + F.wave * 128;
    LAS int* ent = (LAS int*)(F.lds + MISC_OFF + MO_ENT) + F.wave * 32;
    const int lane = F.lane, r32 = lane & 31, hi = lane >> 5;
    for (int u = F.bid; u < total; u += F.G) {
        int lo = 0, hi_ = 992;
        while (hi_ - lo > 1) { const int mid = (lo + hi_) >> 1; if (pre[mid] <= u) lo = mid; else hi_ = mid; }
        const int p = lo, bh = p / 31, j = p % 31, c = u - pre[p], b = bh >> 3, h = bh & 7;
        const int n = (int)cur[bh * 32 + j];
        const bf16_t* base = (const bf16_t*)(F.ws + WS_QMB) + (size_t)b * SEQ * QW + h * 64;
        stage_kv_block(F, base + 512 + (size_t)(j * 256) * QW, base + 1024 + (size_t)(j * 256) * QW);
        __syncthreads();
        const int e0 = c * 256 + F.wave * 32;
        if (e0 < n) {
            const unsigned short* lb = lists + (size_t)bh * MB_LIST_STRIDE + mb_list_off(j);
            const int eidx = e0 + r32; const bool valid = eidx < n;
            const int entry = (int)lb[valid ? eidx : e0];
            const int qpos = entry & 8191, slot = entry >> 13;
            if (hi == 0) ent[r32] = valid ? entry : -1;
            bf16x8 qr[4];
#pragma unroll
            for (int d0 = 0; d0 < 4; ++d0) qr[d0] = *(const bf16x8*)(base + (size_t)qpos * QW + d0 * 16 + hi * 8);
            float m = -INFINITY, l = 0.f; f32x16 o[2]; o[0] = f32x16{}; o[1] = f32x16{};
            const LAS float* lut = (const LAS float*)(F.lds + MISC_OFF + MO_LUT) + h * 132;
            const float bfar = lut[128];
#pragma unroll 1
            for (int st = 0; st < 4; ++st) {
                f32x16 t[2]; qkt64(t, F.lds + st * 8192, qr, lane);
                const int kbase = j * 256 + st * 64;
                const bool far = __all(qpos - (kbase + 63) >= 128);
                if (far) {
#pragma unroll
                    for (int pp = 0; pp < 2; ++pp)
#pragma unroll
                        for (int r = 0; r < 16; ++r) t[pp][r] = t[pp][r] * LOG2E + bfar;
                } else {
#pragma unroll
                    for (int pp = 0; pp < 2; ++pp)
#pragma unroll
                        for (int r = 0; r < 16; ++r) { int d = qpos - (kbase + 32 * pp + crow(r, hi)); d = d < 128 ? d : 128; d = d > 0 ? d : 0; t[pp][r] = t[pp][r] * LOG2E + lut[d]; }
                }
                softmax_step(t, m, l, o, wsf, F.lds + 32768 + st * 8192, lane);
            }
            l += __shfl_xor(l, 32);
            const float rl = 1.f / l;
            if (hi == 0) { wsf[r32] = rl; if (valid) ((float*)(F.ws + WS_PLSE))[((size_t)bh * SEQ + qpos) * 3 + slot] = m + __log2f(l); }
            LDS_WAIT();
            bf16_t* po = (bf16_t*)(F.ws + WS_PO);
#pragma unroll
            for (int r = 0; r < 16; ++r) { const int q = crow(r, hi); const int en = ent[q]; const float sc = wsf[q];
                if (en >= 0) { bf16_t* dst = po + (((size_t)bh * SEQ + (en & 8191)) * 3 + (en >> 13)) * 64 + r32;
                    dst[0] = (bf16_t)(cvtpk(o[0][r] * sc, 0.f) & 0xffffu); dst[32] = (bf16_t)(cvtpk(o[1][r] * sc, 0.f) & 0xffffu); } }
            LDS_WAIT();
        }
        __syncthreads();
    }
}
__device__ __forceinline__ void phase6(Ctx& F) {
    build_lut(F);
    __syncthreads();
    LAS float* wsf = (LAS float*)(F.lds + MISC_OFF + MO_WSF) + F.wave * 128;
    const int lane = F.lane, r32 = lane & 31, hi = lane >> 5, w = F.wave;
    for (int u = F.bid; u < 32 * 32; u += F.G) {
        const int bh = u >> 5, i = 31 - (u & 31), b = bh >> 3, h = bh & 7;
        const bf16_t* base = (const bf16_t*)(F.ws + WS_QMB) + (size_t)b * SEQ * QW + h * 64;
        stage_kv_block(F, base + 512 + (size_t)(i * 256) * QW, base + 1024 + (size_t)(i * 256) * QW);
        __syncthreads();
        const int ql = w * 32 + r32, qpos = i * 256 + ql;
        bf16x8 qr[4];
#pragma unroll
        for (int d0 = 0; d0 < 4; ++d0) qr[d0] = *(const bf16x8*)(base + (size_t)qpos * QW + d0 * 16 + hi * 8);
        float m = -INFINITY, l = 0.f; f32x16 o[2]; o[0] = f32x16{}; o[1] = f32x16{};
        const LAS float* lut = (const LAS float*)(F.lds + MISC_OFF + MO_LUT) + h * 132;
        const int nst = (w >> 1) + 1;
#pragma unroll 1
        for (int st = 0; st < nst; ++st) {
            f32x16 t[2]; qkt64(t, F.lds + st * 8192, qr, lane);
#pragma unroll
            for (int pp = 0; pp < 2; ++pp)
#pragma unroll
                for (int r = 0; r < 16; ++r) { const int d = ql - (st * 64 + 32 * pp + crow(r, hi)); const int dc = d < 128 ? (d > 0 ? d : 0) : 128; const float v = t[pp][r] * LOG2E + lut[dc]; t[pp][r] = d >= 0 ? v : -INFINITY; }
            softmax_step(t, m, l, o, wsf, F.lds + 32768 + st * 8192, lane);
        }
        l += __shfl_xor(l, 32);
        const int nsel = i < 3 ? i : 3;
        const float* plse = (const float*)(F.ws + WS_PLSE) + ((size_t)bh * SEQ + qpos) * 3;
        float ls0 = -INFINITY, ls1 = -INFINITY, ls2 = -INFINITY;
        if (nsel > 0) ls0 = plse[0]; if (nsel > 1) ls1 = plse[1]; if (nsel > 2) ls2 = plse[2];
        const float M = fmaxf(fmaxf(m, ls0), fmaxf(ls1, ls2));
        const float eo = __builtin_amdgcn_exp2f(m - M), e0 = __builtin_amdgcn_exp2f(ls0 - M), e1 = __builtin_amdgcn_exp2f(ls1 - M), e2 = __builtin_amdgcn_exp2f(ls2 - M);
        const float rden = 1.f / (l * eo + e0 + e1 + e2);
        if (hi == 0) *(LAS f32x4*)(wsf + 4 * r32) = (f32x4){eo * rden, e0 * rden, e1 * rden, e2 * rden};
        LDS_WAIT();
        const bf16_t* po = (const bf16_t*)(F.ws + WS_PO) + ((size_t)bh * SEQ + i * 256 + w * 32) * 3 * 64 + r32;
#pragma unroll
        for (int r = 0; r < 16; ++r) { const int q = crow(r, hi); const f32x4 fc = *(const LAS f32x4*)(wsf + 4 * q);
            float a0 = o[0][r] * fc.x, a1 = o[1][r] * fc.x;
            if (nsel > 0) { a0 += fc.y * bf2f(po[(q * 3 + 0) * 64]); a1 += fc.y * bf2f(po[(q * 3 + 0) * 64 + 32]); }
            if (nsel > 1) { a0 += fc.z * bf2f(po[(q * 3 + 1) * 64]); a1 += fc.z * bf2f(po[(q * 3 + 1) * 64 + 32]); }
            if (nsel > 2) { a0 += fc.w * bf2f(po[(q * 3 + 2) * 64]); a1 += fc.w * bf2f(po[(q * 3 + 2) * 64 + 32]); }
            o[0][r] = a0; o[1][r] = a1; }
        LDS_WAIT();
        __syncthreads();
        bf16_t* dst = (bf16_t*)(F.ws + WS_OB) + (size_t)MT * 512 + (size_t)(b * SEQ + i * 256 + w * 32) * 512 + h * 64;
        store_o_tile(o, F.lds + w * 4096, lane, dst, 512);
        __syncthreads();
    }
}

struct BranchSched {
    const char* A; const char* Bt; int G, c; int R[2], C[2];
    __device__ __forceinline__ bool next(int i, gm::UnitD& u) {
        int pm, pn; if (!gm::static_tile(MT, 1024, G, c, i >> 1, pm, pn)) return false;
        const int br = i & 1;
        u.a = A + (size_t)br * MT * 512 * 2; u.b = Bt + (size_t)(br * 1024 + pn * 256) * 512 * 2;
#pragma unroll
        for (int h = 0; h < 2; ++h)
#pragma unroll
            for (int j = 0; j < 2; ++j) u.va[h][j] = (unsigned)((pm * 256 + h * 128 + R[j]) * 512 + C[j]) * 2u;
        u.e0 = pm; u.e1 = pn; u.e2 = br; u.e3 = 0; return true;
    }
};
struct EpiBranch {
    const bf16_t* g; bf16_t* merged;
    __device__ __forceinline__ void operator()(const f32x4 (&acc)[2][2][4][2], const gm::UnitD& u, int wr, int wc, int fr, int fq) const {
        const int pm = u.e0, pn = u.e1, br = u.e2;
        const int row0 = pm * 256 + wr * 64 + fr, col0 = pn * 256 + wc * 32 + 8 * fq;
#pragma unroll
        for (int ai = 0; ai < 2; ++ai)
#pragma unroll
            for (int m = 0; m < 4; ++m) { const size_t row = (size_t)(row0 + ai * 128 + m * 16);
#pragma unroll
                for (int bj = 0; bj < 2; ++bj) {
                    const u32x4 gv = *(const u32x4*)(g + row * 2048 + br * 1024 + col0 + bj * 128);
                    bf16_t* mp = merged + row * 1024 + col0 + bj * 128;
                    const f32x4 v0 = acc[ai][bj][m][0], v1 = acc[ai][bj][m][1];
                    float r[8];
                    r[0] = sigmoidf_(bflo(gv.x)) * v0[0]; r[1] = sigmoidf_(bfhi(gv.x)) * v0[1]; r[2] = sigmoidf_(bflo(gv.y)) * v0[2]; r[3] = sigmoidf_(bfhi(gv.y)) * v0[3];
                    r[4] = sigmoidf_(bflo(gv.z)) * v1[0]; r[5] = sigmoidf_(bfhi(gv.z)) * v1[1]; r[6] = sigmoidf_(bflo(gv.w)) * v1[2]; r[7] = sigmoidf_(bfhi(gv.w)) * v1[3];
                    if (br) { const u32x4 pv = *(const u32x4*)mp;
                        r[0] += bflo(pv.x); r[1] += bfhi(pv.x); r[2] += bflo(pv.y); r[3] += bfhi(pv.y); r[4] += bflo(pv.z); r[5] += bfhi(pv.z); r[6] += bflo(pv.w); r[7] += bfhi(pv.w); }
                    u32x4 w; w.x = cvtpk(r[0], r[1]); w.y = cvtpk(r[2], r[3]); w.z = cvtpk(r[4], r[5]); w.w = cvtpk(r[6], r[7]);
                    *(u32x4*)mp = w; } }
    }
};
__device__ __forceinline__ void phase7(Ctx& F) {
    BranchSched S; S.A = (const char*)(F.ws + WS_OB); S.Bt = (const char*)(F.ws + WS_WBRT); S.G = F.G; S.c = F.bid; gm::stage_geom(F.tid, S.R, S.C);
    EpiBranch E{(const bf16_t*)(F.ws + WS_G), (bf16_t*)(F.ws + WS_MERGED)};
    gm::gemm_phase<true>(F.lds, 512, S, E);
}
struct OutSched {
    const char* A; const char* Bt; int G, c; int R[2], C[2];
    __device__ __forceinline__ bool next(int i, gm::UnitD& u) {
        int pm, pn; if (!gm::static_tile(MT, 1024, G, c, i, pm, pn)) return false;
        u.a = A; u.b = Bt + (size_t)pn * 256 * 1024 * 2;
#pragma unroll
        for (int h = 0; h < 2; ++h)
#pragma unroll
            for (int j = 0; j < 2; ++j) u.va[h][j] = (unsigned)((pm * 256 + h * 128 + R[j]) * 1024 + C[j]) * 2u;
        u.e0 = pm; u.e1 = pn; u.e2 = 0; u.e3 = 0; return true;
    }
};
struct EpiOut {
    const float* x; const float* mod; float* out;
    __device__ __forceinline__ void operator()(const f32x4 (&acc)[2][2][4][2], const gm::UnitD& u, int wr, int wc, int fr, int fq) const {
        const int pm = u.e0, pn = u.e1, b = (pm * 256) / SEQ;
        const int row0 = pm * 256 + wr * 64 + fr, col0 = pn * 256 + wc * 32 + 4 * fq;
        f32x4 gt[2][2];
#pragma unroll
        for (int bj = 0; bj < 2; ++bj)
#pragma unroll
            for (int n = 0; n < 2; ++n) gt[bj][n] = *(const f32x4*)(mod + b * NMOD + 2 * DM + col0 + bj * 128 + n * 16);
#pragma unroll
        for (int ai = 0; ai < 2; ++ai)
#pragma unroll
            for (int m = 0; m < 4; ++m) { const size_t off = (size_t)(row0 + ai * 128 + m * 16) * DM + col0;
#pragma unroll
                for (int bj = 0; bj < 2; ++bj)
#pragma unroll
                    for (int n = 0; n < 2; ++n) { const f32x4 xv = *(const f32x4*)(x + off + bj * 128 + n * 16); *(f32x4*)(out + off + bj * 128 + n * 16) = xv + gt[bj][n] * acc[ai][bj][m][n]; } }
    }
};
__device__ __forceinline__ void phase8(Ctx& F) {
    OutSched S; S.A = (const char*)(F.ws + WS_MERGED); S.Bt = (const char*)(F.ws + WS_WOUTT); S.G = F.G; S.c = F.bid; gm::stage_geom(F.tid, S.R, S.C);
    EpiOut E{inp(F, I_X), (const float*)(F.ws + WS_SMALL + SM_MOD), F.out};
    gm::gemm_phase<false>(F.lds, 1024, S, E);
}

constexpr int NR_SC = 0, NR_CH = 64 * 65 * 4, NR_RS = 2 * 64 * 65 * 4;
__device__ __forceinline__ void phase_n2r(Ctx& F, int rr) {
    const float* x1 = F.out; const float* gvec = (const float*)(F.ws + WS_SMALL + SM_GVEC); const float* cb = (const float*)(F.ws + WS_SMALL + SM_CB);
    const float* mod = (const float*)(F.ws + WS_SMALL + SM_MOD); const float* wrt = (const float*)(F.ws + WS_SMALL + SM_WRT); const float* rbias = inp(F, I_RB);
    bf16_t* H2 = (bf16_t*)(F.ws + WS_H2); int* tokl = (int*)(F.ws + WS_TOKL); float* wl = (float*)(F.ws + WS_WL); int* tpos = (int*)(F.ws + WS_TPOS);
    unsigned* cur = (unsigned*)(F.ws + WS_CTL) + CW_MOECUR + rr * 64;
    LAS int* lcnt = (LAS int*)(F.lds + MISC_OFF + MO_PRE); LAS int* lbase = lcnt + 64;
    LAS float* sc = (LAS float*)(F.lds + NR_SC); LAS float* ch = (LAS float*)(F.lds + NR_CH); LAS float* rsl = (LAS float*)(F.lds + NR_RS);
    const int lane = F.lane, w = F.wave, i16 = lane & 15, kk = lane >> 4, tg = w & 3, eh = w >> 2;
    for (int u = F.bid; u < RT / 64; u += F.G) {
        if (F.tid < 64) lcnt[F.tid] = 0;
        const int tokb = rr * RT + u * 64, b = tokb / SEQ;
        {
            f32x4 acc[2]; acc[0] = acc[1] = (f32x4){0.f, 0.f, 0.f, 0.f};
            float ssq = 0.f;
            const float* xp = x1 + (size_t)(tokb + tg * 16 + i16) * DM + 4 * kk; const float* gp = gvec + b * DM + 4 * kk; const float* wp = wrt + (size_t)(eh * 32 + i16) * DM + 4 * kk;
            f32x4 xa[4], ga[4], wa[4][2], xb[4], gb[4], wb[4][2];
#define NR_LOAD(X, G_, W_, C) do { _Pragma("unroll") for (int q = 0; q < 4; ++q) { const int ko = (C) * 64 + q * 16; X[q] = *(const f32x4*)(xp + ko); G_[q] = *(const f32x4*)(gp + ko); \
                W_[q][0] = *(const f32x4*)(wp + ko); W_[q][1] = *(const f32x4*)(wp + (size_t)16 * DM + ko); } } while (0)
#define NR_MMA(X, G_, W_) do { _Pragma("unroll") for (int q = 0; q < 4; ++q) { const f32x4 xv = X[q]; ssq += (xv.x * xv.x + xv.y * xv.y) + (xv.z * xv.z + xv.w * xv.w); const f32x4 a = xv * G_[q]; \
                _Pragma("unroll") for (int n = 0; n < 4; ++n) { acc[0] = __builtin_amdgcn_mfma_f32_16x16x4f32(a[n], W_[q][0][n], acc[0], 0, 0, 0); acc[1] = __builtin_amdgcn_mfma_f32_16x16x4f32(a[n], W_[q][1][n], acc[1], 0, 0, 0); } } } while (0)
            NR_LOAD(xa, ga, wa, 0);
#pragma unroll 1
            for (int c = 0; c < 16; c += 2) {
                NR_LOAD(xb, gb, wb, c + 1);
                NR_MMA(xa, ga, wa);
                if (c + 2 < 16) NR_LOAD(xa, ga, wa, c + 2);
                NR_MMA(xb, gb, wb);
            }
#undef NR_LOAD
#undef NR_MMA
            ssq += __shfl_xor(ssq, 16); ssq += __shfl_xor(ssq, 32);
            const float rstd = rsqrtf(ssq * (1.f / DM) + EPS);
            if (eh == 0 && kk == 0) rsl[tg * 16 + i16] = rstd;
#pragma unroll
            for (int reg = 0; reg < 4; ++reg) { const float rs = __shfl(rstd, 4 * kk + reg); const int tl = tg * 16 + 4 * kk + reg;
#pragma unroll
                for (int c = 0; c < 2; ++c) { const int e = eh * 32 + 16 * c + i16; const float lg = acc[c][reg] * rs + cb[b * 64 + e]; const float s_ = sigmoidf_(lg);
                    sc[tl * 65 + e] = s_; ch[tl * 65 + e] = s_ + rbias[e]; } }
        }
        __syncthreads();
        const int tl = F.tid >> 3, g = F.tid & 7;
        int my_e; float my_w; int my_rank;
        {
            float c8[8];
#pragma unroll
            for (int j = 0; j < 8; ++j) c8[j] = ch[tl * 65 + 8 * g + j];
            float m1 = -INFINITY, m2 = -INFINITY;
#pragma unroll
            for (int j = 0; j < 8; ++j) { const float v = c8[j]; if (v > m1) { m2 = m1; m1 = v; } else if (v > m2) m2 = v; }
            const float gs = m1 + m2;
            int rank = 0;
#pragma unroll
            for (int g2 = 0; g2 < 8; ++g2) { const float o = __shfl(gs, g2, 8); rank += (o > gs || (o == gs && g2 < g)) ? 1 : 0; }
            if (rank >= 4) {
#pragma unroll
                for (int j = 0; j < 8; ++j) c8[j] = -INFINITY;
            }
            int sel_e[8];
#pragma unroll
            for (int k = 0; k < 8; ++k) {
                float bv = -INFINITY; int be = 8 * g;
#pragma unroll
                for (int j = 0; j < 8; ++j) if (c8[j] > bv) { bv = c8[j]; be = 8 * g + j; }
#pragma unroll
                for (int o = 1; o < 8; o <<= 1) { const float ov = __shfl_xor(bv, o, 8); const int oe = __shfl_xor(be, o, 8); if (ov > bv || (ov == bv && oe < be)) { bv = ov; be = oe; } }
                sel_e[k] = be;
#pragma unroll
                for (int j = 0; j < 8; ++j) if (be == 8 * g + j) c8[j] = -INFINITY;
            }
            float wsum = 0.f, sk[8];
#pragma unroll
            for (int k = 0; k < 8; ++k) { sk[k] = sc[tl * 65 + sel_e[k]]; wsum += sk[k]; }
            my_e = sel_e[0]; my_w = sk[0];
#pragma unroll
            for (int k = 1; k < 8; ++k) if (g == k) { my_e = sel_e[k]; my_w = sk[k]; }
            my_w *= 2.5f / wsum;
            my_rank = lds_add(&lcnt[my_e], 1);
        }
        __syncthreads();
        if (F.tid < 64) { const int n = lcnt[F.tid]; lbase[F.tid] = n > 0 ? (int)atomicAdd(&cur[F.tid], (unsigned)n) : 0; }
        __syncthreads();
        { const int tok = tokb + tl, pos = lbase[my_e] + my_rank; tokl[my_e * RT + pos] = tok * 8 + g; wl[my_e * RT + pos] = my_w; tpos[(tok - rr * RT) * 8 + g] = (my_e << 16) | pos; }
#pragma unroll 2
        for (int r = 0; r < 8; ++r) {
            const int tl2 = w * 8 + r; const float rstd = rsl[tl2];
            const f32x4* xr = (const f32x4*)(x1 + (size_t)(tokb + tl2) * DM) + lane;
            u32x2* o8 = (u32x2*)(H2 + (size_t)(tokb - rr * RT + tl2) * DM) + lane;
#pragma unroll
            for (int j = 0; j < 4; ++j) { const int col = 4 * lane + 256 * j; const f32x4 hv = (xr[64 * j] * rstd) * *(const f32x4*)(gvec + b * DM + col) + *(const f32x4*)(mod + b * NMOD + 3 * DM + col);
                u32x2 o; o.x = cvtpk(hv.x, hv.y); o.y = cvtpk(hv.z, hv.w); o8[64 * j] = o; }
        }
        __syncthreads();
    }
}
constexpr int MO_TE = 4224;
struct MoeTabs { const LAS unsigned short* te; const LAS int* tb; const LAS int* cnt; int TR; };
__device__ __forceinline__ MoeTabs build_moe_tabs(Ctx& F, int rr) {
    LAS unsigned short* te = (LAS unsigned short*)(F.lds + MISC_OFF + MO_TE); LAS int* tb = (LAS int*)(F.lds + MISC_OFF + MO_TE + 1536); LAS int* cnt = tb + 72;
    const unsigned* cur = (const unsigned*)(F.ws + WS_CTL) + CW_MOECUR + rr * 64;
    __syncthreads();
    if (F.tid == 0) { int acc = 0; for (int e = 0; e < 64; ++e) { const int c = (int)cur[e]; cnt[e] = c; tb[e] = acc; acc += (c + 255) >> 8; } tb[64] = acc; tb[65] = acc + RT / 256; cnt[64] = RT; }
    __syncthreads();
    const int TR = tb[64];
    for (int e = F.tid >> 3; e < 65; e += 64) for (int t = tb[e] + (F.tid & 7); t < tb[e + 1]; t += 8) te[t] = (unsigned short)e;
    __syncthreads();
    MoeTabs T; T.te = te; T.tb = tb; T.cnt = cnt; T.TR = TR; return T;
}
struct Moe1Sched {
    const char* H2; const char* W1T; const int* tokl; MoeTabs T; int G, c, rr; int R[2], C[2];
    __device__ __forceinline__ bool next(int i, gm::UnitD& u) {
        const int uu = i * G + c; const int nt = T.TR + RT / 256;
        if (uu >= nt * 2) return false;
        const int tile = uu >> 1, pn = uu & 1, e = T.te[tile], rt = tile - T.tb[e], cnt = T.cnt[e];
        u.a = H2; u.b = W1T + (size_t)(e * 512 + pn * 256) * 1024 * 2;
#pragma unroll
        for (int h = 0; h < 2; ++h)
#pragma unroll
            for (int j = 0; j < 2; ++j) { const int idx = rt * 256 + h * 128 + R[j]; int trow;
                if (e < 64) { const int ent = tokl[e * RT + (idx < cnt ? idx : rt * 256)]; trow = (ent >> 3) - rr * RT; } else trow = idx;
                u.va[h][j] = (unsigned)(trow * 1024 + C[j]) * 2u; }
        u.e0 = tile; u.e1 = pn; u.e2 = e; u.e3 = rt; return true;
    }
};
struct EpiMoe1 {
    bf16_t* act; const float* wl; const LAS int* cnt;
    __device__ __forceinline__ void operator()(const f32x4 (&acc)[2][2][4][2], const gm::UnitD& u, int wr, int wc, int fr, int fq) const {
        const int row0 = u.e0 * 256 + wr * 64 + fr, col0 = u.e1 * 128 + wc * 32 + 8 * fq, e = u.e2, n = cnt[e];
        float rw[2][4];
#pragma unroll
        for (int ai = 0; ai < 2; ++ai)
#pragma unroll
            for (int m = 0; m < 4; ++m) { const int idx = u.e3 * 256 + ai * 128 + wr * 64 + m * 16 + fr; rw[ai][m] = e < 64 ? (idx < n ? wl[e * RT + idx] : 0.f) : 1.f; }
#pragma unroll
        for (int ai = 0; ai < 2; ++ai)
#pragma unroll
            for (int m = 0; m < 4; ++m) { const float ww = rw[ai][m]; const f32x4 g0 = acc[ai][0][m][0], g1 = acc[ai][0][m][1], u0 = acc[ai][1][m][0] * ww, u1 = acc[ai][1][m][1] * ww;
                u32x4 w; w.x = cvtpk(siluf_(g0[0]) * u0[0], siluf_(g0[1]) * u0[1]); w.y = cvtpk(siluf_(g0[2]) * u0[2], siluf_(g0[3]) * u0[3]);
                w.z = cvtpk(siluf_(g1[0]) * u1[0], siluf_(g1[1]) * u1[1]); w.w = cvtpk(siluf_(g1[2]) * u1[2], siluf_(g1[3]) * u1[3]);
                *(u32x4*)(act + (size_t)(row0 + ai * 128 + m * 16) * 256 + col0) = w; }
    }
};
__device__ __forceinline__ void phase_moe1(Ctx& F, int rr) {
    Moe1Sched S; S.T = build_moe_tabs(F, rr); S.H2 = (const char*)(F.ws + WS_H2); S.W1T = (const char*)(F.ws + WS_W1T); S.tokl = (const int*)(F.ws + WS_TOKL); S.G = F.G; S.c = F.bid; S.rr = rr; gm::stage_geom(F.tid, S.R, S.C);
    EpiMoe1 E{(bf16_t*)(F.ws + WS_ACT), (const float*)(F.ws + WS_WL), S.T.cnt};
    gm::gemm_phase<true>(F.lds, 1024, S, E);
}
struct Moe2Sched {
    const char* ACT; const char* W2T; MoeTabs T; int G, c; int R[2], C[2];
    __device__ __forceinline__ bool next(int i, gm::UnitD& u) {
        const int uu = i * G + c; const int nt = T.TR + RT / 256;
        if (uu >= nt * 4) return false;
        const int tile = uu >> 2, pn = uu & 3, e = T.te[tile], rt = tile - T.tb[e];
        u.a = ACT + (size_t)tile * 256 * 256 * 2; u.b = W2T + (size_t)(e * 1024 + pn * 256) * 256 * 2;
#pragma unroll
        for (int h = 0; h < 2; ++h)
#pragma unroll
            for (int j = 0; j < 2; ++j) u.va[h][j] = (unsigned)((h * 128 + R[j]) * 256 + C[j]) * 2u;
        u.e0 = pn; u.e1 = e; u.e2 = rt; u.e3 = tile; return true;
    }
};
struct EpiMoe2 {
    bf16_t* slots; float* out; const float* mod; int rr;
    __device__ __forceinline__ void operator()(const f32x4 (&acc)[2][2][4][2], const gm::UnitD& u, int wr, int wc, int fr, int fq) const {
        const int pn = u.e0, e = u.e1, rt = u.e2, tile = u.e3;
        const int col0 = pn * 256 + wc * 32 + 8 * fq;
        if (e < 64) {
            bf16_t* base = slots + (size_t)(tile * 256 + wr * 64 + fr) * 1024 + col0;
#pragma unroll
            for (int ai = 0; ai < 2; ++ai)
#pragma unroll
                for (int m = 0; m < 4; ++m)
#pragma unroll
                    for (int bj = 0; bj < 2; ++bj) { const f32x4 v0 = acc[ai][bj][m][0], v1 = acc[ai][bj][m][1];
                        u32x4 o; o.x = cvtpk(v0[0], v0[1]); o.y = cvtpk(v0[2], v0[3]); o.z = cvtpk(v1[0], v1[1]); o.w = cvtpk(v1[2], v1[3]); *(u32x4*)(base + (size_t)(ai * 128 + m * 16) * 1024 + bj * 128) = o; }
        } else {
#pragma unroll
            for (int ai = 0; ai < 2; ++ai)
#pragma unroll
                for (int m = 0; m < 4; ++m) { const int tok = rr * RT + rt * 256 + ai * 128 + wr * 64 + m * 16 + fr, b = tok / SEQ; float* dst = out + (size_t)tok * DM + col0; const float* g2 = mod + b * NMOD + 5 * DM + col0;
#pragma unroll
                    for (int bj = 0; bj < 2; ++bj)
#pragma unroll
                        for (int n = 0; n < 2; ++n) { const f32x4 xv = *(const f32x4*)(dst + bj * 128 + 4 * n), gv = *(const f32x4*)(g2 + bj * 128 + 4 * n); *(f32x4*)(dst + bj * 128 + 4 * n) = xv + gv * acc[ai][bj][m][n]; }
                    asm volatile("" ::: "memory"); }
        }
    }
};
__device__ __forceinline__ void phase_moe2(Ctx& F, int rr) {
    Moe2Sched S; S.T = build_moe_tabs(F, rr); S.ACT = (const char*)(F.ws + WS_ACT); S.W2T = (const char*)(F.ws + WS_W2T); S.G = F.G; S.c = F.bid; gm::stage_geom(F.tid, S.R, S.C);
    EpiMoe2 E{(bf16_t*)(F.ws + WS_SLOTS), F.out, (const float*)(F.ws + WS_SMALL + SM_MOD), rr};
    gm::gemm_phase<true>(F.lds, 256, S, E);
}
__device__ __forceinline__ void phase_final(Ctx& F, int rr) {
    const MoeTabs T = build_moe_tabs(F, rr);
    const float* mod = (const float*)(F.ws + WS_SMALL + SM_MOD); const float* fg = inp(F, I_FG);
    const bf16_t* slots = (const bf16_t*)(F.ws + WS_SLOTS); const int* tpos = (const int*)(F.ws + WS_TPOS);
    const int gw = F.bid * 8 + F.wave, NGW = F.G * 8, c0 = F.lane * 8;
    for (int t = gw; t < RT; t += NGW) {
        const int tok = rr * RT + t, b = tok / SEQ;
        const bf16_t* rp[8];
#pragma unroll
        for (int k = 0; k < 8; ++k) { const int v = tpos[t * 8 + k]; rp[k] = slots + (size_t)(T.tb[v >> 16] * 256 + (v & 0xffff)) * 1024 + c0; }
        float* orow = F.out + (size_t)tok * DM + c0;
        u32x4 sv[8][2]; f32x4 xv[2][2];
#pragma unroll
        for (int k = 0; k < 8; ++k) { sv[k][0] = *(const u32x4*)(rp[k]); sv[k][1] = *(const u32x4*)(rp[k] + 512); }
#pragma unroll
        for (int h = 0; h < 2; ++h) { xv[h][0] = *(const f32x4*)(orow + h * 512); xv[h][1] = *(const f32x4*)(orow + h * 512 + 4); }
        float s = 0.f; f32x4 v[2][2];
#pragma unroll
        for (int h = 0; h < 2; ++h) {
            f32x4 a0 = (f32x4){0.f, 0.f, 0.f, 0.f}, a1 = a0;
#pragma unroll
            for (int k = 0; k < 8; ++k) { const u32x4 w = sv[k][h]; a0 += (f32x4){bflo(w.x), bfhi(w.x), bflo(w.y), bfhi(w.y)}; a1 += (f32x4){bflo(w.z), bfhi(w.z), bflo(w.w), bfhi(w.w)}; }
            const float* g2 = mod + b * NMOD + 5 * DM + c0 + h * 512;
            v[h][0] = xv[h][0] + *(const f32x4*)g2 * a0; v[h][1] = xv[h][1] + *(const f32x4*)(g2 + 4) * a1;
#pragma unroll
            for (int q = 0; q < 2; ++q) s += (v[h][q].x * v[h][q].x + v[h][q].y * v[h][q].y) + (v[h][q].z * v[h][q].z + v[h][q].w * v[h][q].w);
        }
        const float rstd = rsqrtf(wave_sum(s) * (1.f / DM) + EPS);
#pragma unroll
        for (int h = 0; h < 2; ++h)
#pragma unroll
            for (int q = 0; q < 2; ++q) { const f32x4 g = *(const f32x4*)(fg + c0 + h * 512 + 4 * q); *(f32x4*)(orow + h * 512 + 4 * q) = (v[h][q] * rstd) * g; }
    }
}

constexpr int N_PHASES = 17;
__global__ void __launch_bounds__(512, 2) mega_fwd(Args args) {
    extern __shared__ __attribute__((aligned(16))) unsigned char lds_raw[];
    Ctx F; F.lds = (LAS unsigned char*)lds_raw; F.ws = args.ws; F.out = args.out;
    {
        typedef __attribute__((address_space(4))) const unsigned long long* karg_t;
        const karg_t ka = (karg_t)__builtin_amdgcn_kernarg_segment_ptr();
        LAS unsigned long long* tab = (LAS unsigned long long*)(lds_raw + MISC_OFF + 14336);
        if (threadIdx.x < 20) tab[threadIdx.x] = ka[threadIdx.x];
        F.intab = tab;
    }
    F.tid = threadIdx.x; F.lane = F.tid & 63; F.wave = __builtin_amdgcn_readfirstlane(F.tid >> 6); F.G = gridDim.x; F.bid = blockIdx.x;
    volatile LAS unsigned* st = (volatile LAS unsigned*)(F.lds + MISC_OFF + MO_ST);
    if (F.tid < 4) st[F.tid] = 0u;
    __syncthreads();
    XcdBarrier bar = xcd_barrier_post((unsigned*)(F.ws + WS_CTL) + CW_BAR, st);
    if (threadIdx.x == 0) { unsigned nloc, nx; xcd_barrier_complete(bar.bar, bar.x, nloc, nx); st[0] = nloc; st[1] = nx; }
    int lo = args.ph_lo, hi = args.ph_hi;
    { int a = lo, b = hi; asm volatile("" : "+v"(a), "+v"(b)); lo = __builtin_amdgcn_readfirstlane(a); hi = __builtin_amdgcn_readfirstlane(b); }
    launder(F);
#ifndef PH_MASK
#define PH_MASK 0x1ffff
#endif
#define PH_ON(k) ((PH_MASK >> (k)) & 1)
#define IN(k) (lo <= (k) && (k) < hi)
#define SEAM(k) do { if (IN(k) && IN((k) + 1)) { bar.bar = launder_ptr(bar.bar); xcd_barrier(bar); } } while (0)
#define RUN(k, call) do { if (PH_ON(k) && IN(k)) { launder(F); call; } } while (0)
    RUN(0, phase0(F)); SEAM(0);
    RUN(1, phase1(F)); SEAM(1);
    RUN(2, phase2(F)); SEAM(2);
    RUN(3, phase3(F)); SEAM(3);
    RUN(4, phase4(F)); SEAM(4);
    RUN(5, phase5(F)); SEAM(5);
    RUN(6, phase6(F)); SEAM(6);
    RUN(7, phase7(F)); SEAM(7);
    RUN(8, phase8(F)); SEAM(8);
#pragma unroll 1
    for (int ph = (lo > 9 ? lo : 9); ph < hi; ++ph) {
        launder(F);
        const int rr = ph >= 13 ? 1 : 0, pq = ph >= 13 ? ph - 4 : ph;
        switch (pq) {
            case 9: if (PH_ON(9)) phase_n2r(F, rr); break;
            case 10: if (PH_ON(10)) phase_moe1(F, rr); break;
            case 11: if (PH_ON(11)) phase_moe2(F, rr); break;
            default: if (PH_ON(12)) phase_final(F, rr); break;
        }
        if (ph + 1 < hi) { bar.bar = launder_ptr(bar.bar); xcd_barrier(bar); }
    }
#undef IN
#undef SEAM
#undef RUN
}

#ifndef MK_SPLIT
#define MK_SPLIT 0
#endif
extern "C" void kernel_launch(void* const* d_in, const int* in_sizes, int n_in, void* d_out, int out_size, void* d_ws, size_t ws_size, hipStream_t stream) {
    static int grid = 0;
    if (grid == 0) {
        if (n_in != 20 || in_sizes[0] != MT * DM || out_size != MT * DM || ws_size < WS_END) { fprintf(stderr, "kernel_launch: unexpected shapes (n_in %d, in0 %d, out %d, ws %zu)\n", n_in, n_in > 0 ? in_sizes[0] : -1, out_size, ws_size); grid = -1; return; }
        int dev = 0, cus = 0;
        if (hipGetDevice(&dev) != hipSuccess || hipDeviceGetAttribute(&cus, hipDeviceAttributeMultiprocessorCount, dev) != hipSuccess) { grid = -1; return; }
        if (hipFuncSetAttribute((const void*)mega_fwd, hipFuncAttributeMaxDynamicSharedMemorySize, LDS_BYTES) != hipSuccess) { fprintf(stderr, "kernel_launch: hipFuncSetAttribute failed\n"); grid = -1; return; }
        int per_cu = 0;
        if (hipOccupancyMaxActiveBlocksPerMultiprocessor(&per_cu, (const void*)mega_fwd, 512, LDS_BYTES) != hipSuccess || per_cu < 1) fprintf(stderr, "kernel_launch: occupancy query reports %d\n", per_cu);
        (void)hipGetLastError();
        grid = cus;
    }
    if (grid < 0) return;
    (void)hipMemsetAsync((char*)d_ws + WS_CTL, 0, CTL_BYTES, stream);
    Args a{};
    for (int i = 0; i < 20; ++i) a.in[i] = (const float*)d_in[i];
    a.out = (float*)d_out; a.ws = (unsigned char*)d_ws;
#if MK_SPLIT
    for (int p = 0; p < N_PHASES; ++p) { a.ph_lo = p; a.ph_hi = p + 1; hipLaunchKernelGGL(mega_fwd, dim3(grid), dim3(512), LDS_BYTES, stream, a); }
#else
    a.ph_lo = 0; a.ph_hi = N_PHASES;
    hipLaunchKernelGGL(mega_fwd, dim3(grid), dim3(512), LDS_BYTES, stream, a);
#endif
}
```

```cpp
#include <hip/hip_runtime.h>
#include <cstdio>
#include <cstdint>

#define LAS __attribute__((address_space(3)))
#define GAS __attribute__((address_space(1)))
typedef unsigned short bf16_t;
typedef short bf16x8 __attribute__((ext_vector_type(8)));
typedef short s16x4 __attribute__((ext_vector_type(4)));
typedef float f32x4 __attribute__((ext_vector_type(4)));
typedef float f32x16 __attribute__((ext_vector_type(16)));
typedef float f32x2 __attribute__((ext_vector_type(2)));
typedef unsigned u32x4 __attribute__((ext_vector_type(4)));
typedef unsigned u32x2 __attribute__((ext_vector_type(2)));
typedef __bf16 bf16x2_t __attribute__((ext_vector_type(2)));

__device__ __forceinline__ unsigned cvtpk(float lo, float hi) { f32x2 v = {lo, hi}; bf16x2_t b = __builtin_convertvector(v, bf16x2_t); return __builtin_bit_cast(unsigned, b); }
__device__ __forceinline__ float bf2f(unsigned short u) { return __uint_as_float(((unsigned)u) << 16); }
__device__ __forceinline__ float bflo(unsigned u) { return __uint_as_float(u << 16); }
__device__ __forceinline__ float bfhi(unsigned u) { return __uint_as_float(u & 0xffff0000u); }

constexpr int NB = 4, SEQ = 8192, DM = 1024, MT = NB * SEQ;
constexpr int NHEAD = 8, HD = 64, QW = 1536;
constexpr int NE = 64, EFF = 256, NMOD = 6 * DM;
constexpr int RT = MT / 2;
constexpr float EPS = 1e-6f;
constexpr float LOG2E = 1.4426950408889634f;

constexpr size_t MiB = 1u << 20;
constexpr size_t WS_CTL = 0, CTL_BYTES = 1 * MiB;
constexpr size_t WS_SMALL = 1 * MiB;
constexpr size_t SM_MOD = 0, SM_GVEC = 98304, SM_CB = 114688, SM_KBAR = 131072, SM_WRH = 393216, SM_WRL = 524288;
constexpr size_t WS_W2T = 2 * MiB;
constexpr size_t WS_W1T = 35 * MiB;
constexpr size_t WS_WINT = 100 * MiB;
constexpr size_t WS_WBRT = 110 * MiB;
constexpr size_t WS_WOUTT = 112 * MiB;
constexpr size_t WS_H = 114 * MiB;
constexpr size_t WS_OB = 114 * MiB;
constexpr size_t WS_QSB = 178 * MiB;
constexpr size_t WS_PO = 178 * MiB;
constexpr size_t WS_QMB = 274 * MiB;
constexpr size_t WS_MERGED = 274 * MiB;
constexpr size_t WS_G = 370 * MiB;
constexpr size_t WS_LMB = 498 * MiB;
constexpr size_t WS_PLSE = 506 * MiB;
constexpr size_t WS_H2 = 100 * MiB;
constexpr size_t WS_TOKL = 132 * MiB;
constexpr size_t WS_WL = 136 * MiB;
constexpr size_t WS_ACT = 140 * MiB;
constexpr size_t WS_SLOTS = 220 * MiB;
constexpr size_t WS_TPOS = 508 * MiB;
constexpr size_t WS_END = 509 * MiB;
constexpr int CW_MBCUR = 0;
constexpr int CW_MOECUR = 1024;
constexpr int CW_BAR = 4096;

constexpr int RING_BYTES = 131072;
constexpr int MISC_OFF = RING_BYTES;
constexpr int LDS_BYTES = 163840;
constexpr int MO_STG = 16384;

#define XB_TMO      128
#define XB_XCNT(j)  (256  + 64 * (j))
#define XB_XSUB(j)  (1280 + 64 * (j))
#define XB_XGEN(j)  (2304 + 64 * (j))
#define XB_TOP      3328
#define XB_TOPGEN   3392
#define XCD_BAR_WORDS 3456
#define XB_SPIN_CAP (1u << 18)
__device__ __forceinline__ unsigned xb_ld(unsigned* p)              { return __hip_atomic_load(p, __ATOMIC_RELAXED, __HIP_MEMORY_SCOPE_AGENT); }
__device__ __forceinline__ unsigned xb_add(unsigned* p, unsigned v) { return __hip_atomic_fetch_add(p, v, __ATOMIC_RELAXED, __HIP_MEMORY_SCOPE_AGENT); }
__device__ __forceinline__ unsigned xb_xcc_id() { return (unsigned)__builtin_amdgcn_s_getreg((3 << 11) | 20) & 0xFu; }
#define XB_SPIN(cond, bar) do { unsigned _sp = 0; while (cond) { __builtin_amdgcn_s_sleep(1); \
    if ((++_sp & 255u) == 0u) { if (xb_ld(&(bar)[XB_TMO])) break; if (_sp > XB_SPIN_CAP) { atomicAdd(&(bar)[XB_TMO], 1u); break; } } } } while (0)
struct XcdBarrier { unsigned* bar; unsigned x; volatile LAS unsigned* st; };
__device__ __forceinline__ XcdBarrier xcd_barrier_post(unsigned* bar, volatile LAS unsigned* st) {
    XcdBarrier b; b.bar = bar; b.x = xb_xcc_id(); b.st = st;
    if (threadIdx.x == 0) (void)xb_add(&bar[XB_XCNT(b.x)], 1u);
    return b;
}
__device__ __forceinline__ void xcd_barrier_complete(unsigned* bar, unsigned x, unsigned& nloc, unsigned& nx) {
    const unsigned G = gridDim.x * gridDim.y * gridDim.z;
    unsigned sum, cnt, mine, sp = 0u;
    for (;;) {
        sum = 0u; cnt = 0u; mine = 0u;
#pragma unroll
        for (unsigned j = 0; j < 16; ++j) { const unsigned c = xb_ld(&bar[XB_XCNT(j)]); sum += c; cnt += (c > 0u) ? 1u : 0u; mine = (j == x) ? c : mine; }
        if (sum == G) break;
        __builtin_amdgcn_s_sleep(1);
        if ((++sp & 255u) == 0u) { if (xb_ld(&bar[XB_TMO])) break; if (sp > XB_SPIN_CAP) { atomicAdd(&bar[XB_TMO], 1u); break; } }
    }
    nloc = mine > 0u ? mine : 1u; nx = cnt > 0u ? cnt : 1u;
}
__device__ __forceinline__ void xcd_barrier(const XcdBarrier& b) {
    asm volatile("s_waitcnt vmcnt(0)" ::: "memory");
    __syncthreads();
    if (threadIdx.x == 0) {
        unsigned* bar = b.bar;
        __builtin_amdgcn_s_waitcnt(0);
        unsigned nloc = b.st[0], nx = b.st[1];
        const unsigned old = xb_add(&bar[XB_XSUB(b.x)], 1u);
        const unsigned gen = old / nloc;
        if (old + 1u == (gen + 1u) * nloc) {
            __builtin_amdgcn_fence(__ATOMIC_RELEASE, "agent");
            asm volatile("s_waitcnt vmcnt(0)" ::: "memory");
            const unsigned og = xb_add(&bar[XB_TOP], 1u);
            const unsigned tg = og / nx;
            if (og + 1u == (tg + 1u) * nx) xb_add(&bar[XB_TOPGEN], 1u);
            else XB_SPIN(xb_ld(&bar[XB_TOPGEN]) == tg, bar);
            __builtin_amdgcn_fence(__ATOMIC_ACQUIRE, "agent");
            xb_add(&bar[XB_XGEN(b.x)], 1u);
            asm volatile("s_waitcnt vmcnt(0)" ::: "memory");
        } else {
            XB_SPIN(xb_ld(&bar[XB_XGEN(b.x)]) == gen, bar);
            __builtin_amdgcn_fence(__ATOMIC_ACQUIRE, "agent");
            asm volatile("s_waitcnt vmcnt(0)" ::: "memory");
        }
    }
    __syncthreads();
}

namespace gm {
constexpr int BM = 256, BK = 64, HALF = 128, HTB = HALF * BK * 2, STAGE_BYTES = 8 * HTB, NXCD = 8, WGM = 8;
__host__ __device__ __forceinline__ int lds_byte(int r, int c) { const int st = (r >> 4) * 2 + (c >> 5), rr = r & 15, cc = c & 31, ob = rr * 64 + cc * 2; return st * 1024 + (ob ^ (((ob >> 9) & 1) << 5)); }
__host__ __device__ __forceinline__ void stage_rc(int b, int& R, int& C) { const int st = b / 1024, sb = b % 1024, swz = sb ^ (((sb >> 9) & 1) << 5); R = (st >> 1) * 16 + swz / 64; C = (st & 1) * 32 + (swz % 64) / 2; }
__host__ __device__ __forceinline__ int perm32(int rho) { const int n = rho >> 4, i = rho & 15; return 8 * (i >> 2) + 4 * n + (i & 3); }

struct UnitD { const char* a; const char* b; unsigned va[2][2]; int e0, e1, e2, e3; };

__device__ __forceinline__ bool static_tile(int M, int N, int G, int c, int i, int& pm, int& pn) {
    const int nM = M / BM, nN = N / BM, nwg = nM * nN;
    const long L = (long)i * G + c; if (L >= nwg) return false;
    int wgid = (int)L; { const int q = nwg / NXCD, r = nwg % NXCD, xcd = wgid % NXCD, off = wgid / NXCD; wgid = (xcd < r ? xcd * (q + 1) : r * (q + 1) + (xcd - r) * q) + off; }
    const int nig = WGM * nN, gid = wgid / nig, fm = gid * WGM, gsz = (nM - fm) < WGM ? (nM - fm) : WGM;
    pm = fm + ((wgid % nig) % gsz); pn = (wgid % nig) / gsz; return true;
}

template <bool PERM, class Epi, class Sched>
__device__ __forceinline__ void gemm_phase(LAS unsigned char* lds, const int K, Sched& S, const Epi& E) {
    const int tid = threadIdx.x, wid = __builtin_amdgcn_readfirstlane(tid >> 6), lane = tid & 63, wr = wid >> 2, wc = wid & 3, fr = lane & 15, fq = lane >> 4;
    const int nt = K / BK;
    unsigned voffB[2];
#pragma unroll
    for (int i = 0; i < 2; ++i) { int R, C; stage_rc(tid * 16 + i * 8192, R, C); const int Rb = PERM ? ((R & ~31) + perm32(R & 31)) : R; voffB[i] = (unsigned)(Rb * K + C) * 2u; }
    const size_t kstep = (size_t)(BK * 2);
    const size_t hstep = (size_t)HALF * K * 2;
    const unsigned ldsw = (unsigned)wid * 1024u;
    const int aoff = lds_byte(wr * 64 + fr, fq * 8), boff = lds_byte(wc * 32 + fr, fq * 8);
#define GM_SA(b, h) (((b) * 2 + (h)) * HTB)
#define GM_SB(b, h) ((4 + (b) * 2 + (h)) * HTB)
#define GM_STAGE_A(bufoff, U, h, kb) do { _Pragma("unroll") for (int _i = 0; _i < 2; ++_i) \
        __builtin_amdgcn_global_load_lds((const unsigned*)((U).a + (kb) + (U).va[h][_i]), (LAS unsigned*)(lds + (bufoff) + ldsw + _i * 8192), 16, 0, 0); } while (0)
#define GM_STAGE_B(bufoff, U, h, kb) do { _Pragma("unroll") for (int _i = 0; _i < 2; ++_i) \
        __builtin_amdgcn_global_load_lds((const unsigned*)((U).b + (kb) + (size_t)(h) * hstep + voffB[_i]), (LAS unsigned*)(lds + (bufoff) + ldsw + _i * 8192), 16, 0, 0); } while (0)
#define GM_LDA(dst, b, h) do { _Pragma("unroll") for (int m = 0; m < 4; ++m) _Pragma("unroll") for (int k = 0; k < 2; ++k) dst[m][k] = *(const LAS bf16x8*)(lds + GM_SA(b, h) + aoff + m * 2048 + k * 1024); } while (0)
#define GM_LDB(dst, b, h) do { _Pragma("unroll") for (int n = 0; n < 2; ++n) _Pragma("unroll") for (int k = 0; k < 2; ++k) dst[n][k] = *(const LAS bf16x8*)(lds + GM_SB(b, h) + boff + n * 2048 + k * 1024); } while (0)
#define GM_MMA(ai, bj, At, Bt) do { __builtin_amdgcn_s_setprio(1); _Pragma("unroll") for (int m = 0; m < 4; ++m) _Pragma("unroll") for (int n = 0; n < 2; ++n) _Pragma("unroll") for (int k = 0; k < 2; ++k) \
        acc[ai][bj][m][n] = __builtin_amdgcn_mfma_f32_16x16x32_bf16(Bt[n][k], At[m][k], acc[ai][bj][m][n], 0, 0, 0); __builtin_amdgcn_s_setprio(0); } while (0)
#define GM_WAIT_V(n) asm volatile("s_waitcnt vmcnt(" #n ")" ::: "memory")
#define GM_WAIT_L(n) asm volatile("s_waitcnt lgkmcnt(" #n ")" ::: "memory")
#define GM_BAR __builtin_amdgcn_s_barrier()
#define GM_SCHED __builtin_amdgcn_sched_barrier(0)
    UnitD cur, nxt; int ui = 0;
    if (!S.next(0, cur)) return;
    f32x4 acc[2][2][4][2];
#pragma unroll
    for (int a = 0; a < 2; ++a)
#pragma unroll
        for (int b = 0; b < 2; ++b)
#pragma unroll
            for (int m = 0; m < 4; ++m)
#pragma unroll
                for (int n = 0; n < 2; ++n) acc[a][b][m][n] = (f32x4){0.f, 0.f, 0.f, 0.f};
    bf16x8 At[4][2], B0[2][2], B1[2][2];
    GM_STAGE_B(GM_SB(0, 0), cur, 0, 0); GM_STAGE_B(GM_SB(0, 1), cur, 1, 0); GM_STAGE_A(GM_SA(0, 0), cur, 0, 0); GM_STAGE_A(GM_SA(0, 1), cur, 1, 0);
    if (wr == 1) GM_BAR;
    GM_WAIT_V(2); GM_BAR;
    GM_STAGE_B(GM_SB(1, 0), cur, 0, kstep); GM_STAGE_A(GM_SA(1, 0), cur, 0, kstep); GM_STAGE_B(GM_SB(1, 1), cur, 1, kstep);
    GM_WAIT_V(6); GM_BAR;
    for (;;) {
        const bool has_next = S.next(ui + 1, nxt);
        if (!has_next) nxt = cur;
#pragma unroll 1
        for (int t = 0; t < nt; t += 2) {
            const bool last = (t == nt - 2);
            const size_t k1 = (size_t)(t + 1) * kstep;
            UnitD U2 = cur; size_t k2 = (size_t)(t + 2) * kstep;
            if (last) { U2 = nxt; k2 = 0; }
            const size_t k3 = k2 + kstep;
            GM_LDB(B0, 0, 0); GM_LDB(B1, 0, 1); GM_SCHED; GM_LDA(At, 0, 0); GM_STAGE_A(GM_SA(1, 1), cur, 1, k1);
            GM_WAIT_V(8); GM_WAIT_L(0); GM_BAR; GM_MMA(0, 0, At, B0); GM_MMA(0, 1, At, B1); GM_BAR; GM_SCHED;
            GM_LDA(At, 0, 1); GM_STAGE_B(GM_SB(0, 0), U2, 0, k2); GM_STAGE_B(GM_SB(0, 1), U2, 1, k2); GM_STAGE_A(GM_SA(0, 0), U2, 0, k2);
            GM_WAIT_V(8); GM_WAIT_L(0); GM_BAR; GM_MMA(1, 0, At, B0); GM_MMA(1, 1, At, B1); GM_BAR; GM_SCHED;
            GM_LDB(B0, 1, 0); GM_LDB(B1, 1, 1); GM_SCHED; GM_LDA(At, 1, 0); GM_STAGE_A(GM_SA(0, 1), U2, 1, k2);
            GM_WAIT_V(8); GM_WAIT_L(0); GM_BAR; GM_MMA(0, 0, At, B0); GM_MMA(0, 1, At, B1); GM_BAR; GM_SCHED;
            GM_LDA(At, 1, 1); GM_STAGE_B(GM_SB(1, 0), U2, 0, k3); GM_STAGE_B(GM_SB(1, 1), U2, 1, k3); GM_STAGE_A(GM_SA(1, 0), U2, 0, k3);
            GM_WAIT_V(8); GM_WAIT_L(0); GM_BAR; GM_MMA(1, 0, At, B0); GM_MMA(1, 1, At, B1); GM_BAR; GM_SCHED;
        }
        if (wr == 0) GM_BAR;
        E(acc, cur, wr, wc, fr, fq);
        if (!has_next) break;
#pragma unroll
        for (int a = 0; a < 2; ++a)
#pragma unroll
            for (int b = 0; b < 2; ++b)
#pragma unroll
                for (int m = 0; m < 4; ++m)
#pragma unroll
                    for (int n = 0; n < 2; ++n) acc[a][b][m][n] = (f32x4){0.f, 0.f, 0.f, 0.f};
        cur = nxt; ++ui;
        if (wr == 1) GM_BAR;
    }
    GM_WAIT_V(0);
    GM_BAR;
#undef GM_SA
#undef GM_SB
#undef GM_STAGE_A
#undef GM_STAGE_B
#undef GM_LDA
#undef GM_LDB
#undef GM_MMA
#undef GM_WAIT_V
#undef GM_WAIT_L
#undef GM_BAR
#undef GM_SCHED
}
__device__ __forceinline__ void stage_geom(int tid, int (&R)[2], int (&C)[2]) {
#pragma unroll
    for (int i = 0; i < 2; ++i) stage_rc(tid * 16 + i * 8192, R[i], C[i]);
}
}

struct Args { const float* in[20]; float* out; unsigned char* ws; int ph_lo, ph_hi; };
struct Ctx {
    LAS unsigned char* lds;
    unsigned char* ws;
    const LAS unsigned long long* intab;
    float* out;
    int tid, lane, wave, G, bid;
};
#define LDS_WAIT() asm volatile("s_waitcnt lgkmcnt(0)" ::: "memory")
__device__ __forceinline__ const float* inp(const Ctx& F, int i) {
    const unsigned long long v = F.intab[i];
    const unsigned lo = __builtin_amdgcn_readfirstlane((unsigned)v), hi = __builtin_amdgcn_readfirstlane((unsigned)(v >> 32));
    return (const float*)(GAS const float*)(((unsigned long long)hi << 32) | lo);
}
template <class P> __device__ __forceinline__ P launder_ptr(P p) {
    unsigned long long v = (unsigned long long)p; unsigned lo = (unsigned)v, hi = (unsigned)(v >> 32);
    asm volatile("" : "+v"(lo), "+v"(hi));
    lo = __builtin_amdgcn_readfirstlane(lo); hi = __builtin_amdgcn_readfirstlane(hi);
    return (P)(GAS unsigned char*)(((unsigned long long)hi << 32) | lo);
}
__device__ __forceinline__ void launder(Ctx& F) {
    int t = F.tid, g = F.G, bid = F.bid;
    asm volatile("" : "+v"(t), "+v"(g), "+v"(bid));
    F.tid = t; F.G = __builtin_amdgcn_readfirstlane(g); F.bid = __builtin_amdgcn_readfirstlane(bid); F.lane = t & 63; F.wave = __builtin_amdgcn_readfirstlane(t >> 6);
    F.ws = launder_ptr(F.ws); F.out = launder_ptr(F.out);
}
__device__ __forceinline__ float wave_sum(float v) {
#pragma unroll
    for (int o = 1; o < 64; o <<= 1) v += __shfl_xor(v, o);
    return v;
}
__device__ __forceinline__ int lds_add(LAS int* p, int v) { return __hip_atomic_fetch_add(p, v, __ATOMIC_RELAXED, __HIP_MEMORY_SCOPE_WORKGROUP); }
__device__ __forceinline__ float sigmoidf_(float x) { return 1.f / (1.f + __expf(-x)); }
__device__ __forceinline__ float siluf_(float x) { return x / (1.f + __expf(-x)); }

enum { I_X = 0, I_C, I_N1G, I_N2G, I_WADA, I_BADA, I_WIN, I_WBSB, I_WBMB, I_WOUT, I_WR, I_RB, I_WGE, I_WUE, I_WDE, I_WGS, I_WUS, I_WDS, I_RELB, I_FG };

__device__ __forceinline__ void transpose_item(const float* W, int ldn, int k0, int n0, bf16_t* WT, int Kdst, int drow0, LAS float* scr, int lane) {
    const float* wp = W + (size_t)(k0 + (lane >> 3)) * ldn + n0 + 4 * (lane & 7);
    f32x4 v[8];
#pragma unroll
    for (int i = 0; i < 8; ++i) v[i] = *(const f32x4*)(wp + (size_t)(8 * i) * ldn);
#pragma unroll
    for (int i = 0; i < 8; ++i) { LAS float* d = scr + (8 * i + (lane >> 3)) * 33 + 4 * (lane & 7); d[0] = v[i].x; d[1] = v[i].y; d[2] = v[i].z; d[3] = v[i].w; }
    LDS_WAIT(); asm volatile("" ::: "memory");
    const int c = lane & 7;
#pragma unroll
    for (int j = 0; j < 4; ++j) { const int n = (lane >> 3) + 8 * j; const LAS float* s = scr + (8 * c) * 33 + n;
        u32x4 o; o.x = cvtpk(s[0 * 33], s[1 * 33]); o.y = cvtpk(s[2 * 33], s[3 * 33]); o.z = cvtpk(s[4 * 33], s[5 * 33]); o.w = cvtpk(s[6 * 33], s[7 * 33]);
        *(u32x4*)(WT + (size_t)(drow0 + n) * Kdst + k0 + 8 * c) = o; }
    LDS_WAIT(); asm volatile("" ::: "memory");
}
__device__ __forceinline__ void phase0(Ctx& F) {
    LAS float* silc = (LAS float*)(F.lds + MISC_OFF - 0);
    silc = (LAS float*)(F.lds + 0);
    for (int i = F.tid; i < 4 * DM; i += 512) silc[i] = siluf_(inp(F, I_C)[i]);
    __syncthreads();
    float* mod = (float*)(F.ws + WS_SMALL + SM_MOD);
    {
        const int gw = F.wave * F.G + F.bid;
        const int c = F.lane & 15, kp = F.lane >> 4;
        const float* wada = inp(F, I_WADA);
        for (int item = gw; item < NMOD / 16; item += 8 * F.G) {
            const int col = item * 16 + c;
            float a0 = 0.f, a1 = 0.f, a2 = 0.f, a3 = 0.f;
#pragma unroll 32
            for (int k = kp; k < DM; k += 4) { const float w = wada[(size_t)k * NMOD + col]; a0 += silc[k] * w; a1 += silc[DM + k] * w; a2 += silc[2 * DM + k] * w; a3 += silc[3 * DM + k] * w; }
            a0 += __shfl_xor(a0, 16); a0 += __shfl_xor(a0, 32); a1 += __shfl_xor(a1, 16); a1 += __shfl_xor(a1, 32);
            a2 += __shfl_xor(a2, 16); a2 += __shfl_xor(a2, 32); a3 += __shfl_xor(a3, 16); a3 += __shfl_xor(a3, 32);
            if (kp == 0) { const float bb = inp(F, I_BADA)[col]; mod[col] = a0 + bb; mod[NMOD + col] = a1 + bb; mod[2 * NMOD + col] = a2 + bb; mod[3 * NMOD + col] = a3 + bb; }
        }
    }
    __syncthreads();
    {
        LAS float* scr = (LAS float*)(F.lds + F.wave * 16384);
        const int gw = F.bid * 8 + F.wave, NGW = F.G * 8, lane = F.lane;
        constexpr int I_IN = 16 * 160, I_BR = 8 * 32, I_OUT = 16 * 32, I_EXP = 384, NIT = I_IN + 2 * I_BR + I_OUT + 65 * I_EXP;
        const float* p_win = inp(F, I_WIN); const float* p_bsb = inp(F, I_WBSB); const float* p_bmb = inp(F, I_WBMB); const float* p_out = inp(F, I_WOUT);
        const float* p_ge = inp(F, I_WGE); const float* p_ue = inp(F, I_WUE); const float* p_de = inp(F, I_WDE); const float* p_gs = inp(F, I_WGS); const float* p_us = inp(F, I_WUS); const float* p_ds = inp(F, I_WDS);
#define TD_GET(IT, SRC, LDN, DST, KD) do { int r = (IT); \
            if (r < I_IN) { const int kb = r / 160, nb = r % 160; SRC = p_win + (size_t)(kb * 64) * 5120 + nb * 32; LDN = 5120; DST = (bf16_t*)(F.ws + WS_WINT) + (size_t)(nb * 32) * 1024 + kb * 64; KD = 1024; } \
            else if ((r -= I_IN) < I_BR) { const int kb = r / 32, nb = r % 32; SRC = p_bsb + (size_t)(kb * 64) * 1024 + nb * 32; LDN = 1024; DST = (bf16_t*)(F.ws + WS_WBRT) + (size_t)(nb * 32) * 512 + kb * 64; KD = 512; } \
            else if ((r -= I_BR) < I_BR) { const int kb = r / 32, nb = r % 32; SRC = p_bmb + (size_t)(kb * 64) * 1024 + nb * 32; LDN = 1024; DST = (bf16_t*)(F.ws + WS_WBRT) + (size_t)(1024 + nb * 32) * 512 + kb * 64; KD = 512; } \
            else if ((r -= I_BR) < I_OUT) { const int kb = r / 32, nb = r % 32; SRC = p_out + (size_t)(kb * 64) * 1024 + nb * 32; LDN = 1024; DST = (bf16_t*)(F.ws + WS_WOUTT) + (size_t)(nb * 32) * 1024 + kb * 64; KD = 1024; } \
            else { r -= I_OUT; const int e = r / I_EXP; r -= e * I_EXP; \
                if (r < 128) { const int kb = r / 8, n0 = (r % 8) * 32; SRC = (e < NE ? p_ge + (size_t)e * DM * EFF : p_gs) + (size_t)(kb * 64) * EFF + n0; LDN = EFF; \
                    DST = (bf16_t*)(F.ws + WS_W1T) + ((size_t)e * 512 + (n0 >> 7) * 256 + (n0 & 127)) * 1024 + kb * 64; KD = 1024; } \
                else if (r < 256) { r -= 128; const int kb = r / 8, n0 = (r % 8) * 32; SRC = (e < NE ? p_ue + (size_t)e * DM * EFF : p_us) + (size_t)(kb * 64) * EFF + n0; LDN = EFF; \
                    DST = (bf16_t*)(F.ws + WS_W1T) + ((size_t)e * 512 + (n0 >> 7) * 256 + 128 + (n0 & 127)) * 1024 + kb * 64; KD = 1024; } \
                else { r -= 256; const int kb = r / 32, nb = r % 32; SRC = (e < NE ? p_de + (size_t)e * EFF * DM : p_ds) + (size_t)(kb * 64) * DM + nb * 32; LDN = DM; \
                    DST = (bf16_t*)(F.ws + WS_W2T) + ((size_t)e * 1024 + nb * 32) * 256 + kb * 64; KD = 256; } } } while (0)
#define TD_LOAD(V, SRC, LDN) do { const float* wp_ = (SRC) + (size_t)(lane >> 3) * (LDN) + 4 * (lane & 7); _Pragma("unroll") for (int i = 0; i < 8; ++i) V[i] = *(const f32x4*)(wp_ + (size_t)(8 * i) * (LDN)); } while (0)
        const float* src = nullptr; bf16_t* dst = nullptr; int ldn = 0, kd = 0;
        f32x4 v[8];
        int it = gw;
        if (it < NIT) { TD_GET(it, src, ldn, dst, kd); TD_LOAD(v, src, ldn); }
        for (; it < NIT; it += NGW) {
            const float* srcn = src; bf16_t* dstn = dst; int ldnn = ldn, kdn = kd;
            f32x4 vn[8];
            const bool has_next = it + NGW < NIT;
            if (has_next) { TD_GET(it + NGW, srcn, ldnn, dstn, kdn); TD_LOAD(vn, srcn, ldnn); }
#pragma unroll
            for (int i = 0; i < 8; ++i) { LAS float* d = scr + (8 * i + (lane >> 3)) * 33 + 4 * (lane & 7); d[0] = v[i].x; d[1] = v[i].y; d[2] = v[i].z; d[3] = v[i].w; }
            LDS_WAIT(); asm volatile("" ::: "memory");
            const int c = lane & 7;
#pragma unroll
            for (int j = 0; j < 4; ++j) { const int n = (lane >> 3) + 8 * j; const LAS float* sp = scr + (8 * c) * 33 + n;
                u32x4 o; o.x = cvtpk(sp[0 * 33], sp[1 * 33]); o.y = cvtpk(sp[2 * 33], sp[3 * 33]); o.z = cvtpk(sp[4 * 33], sp[5 * 33]); o.w = cvtpk(sp[6 * 33], sp[7 * 33]);
                *(u32x4*)(dst + (size_t)n * kd + 8 * c) = o; }
            LDS_WAIT(); asm volatile("" ::: "memory");
            if (has_next) {
#pragma unroll
                for (int i = 0; i < 8; ++i) v[i] = vn[i];
                src = srcn; dst = dstn; ldn = ldnn; kd = kdn; }
        }
#undef TD_GET
#undef TD_LOAD
    }
    {
        bf16_t* wrh = (bf16_t*)(F.ws + WS_SMALL + SM_WRH); bf16_t* wrl = (bf16_t*)(F.ws + WS_SMALL + SM_WRL);
        const float* wr = inp(F, I_WR);
        for (int i = F.bid * 512 + F.tid; i < NE * DM; i += F.G * 512) { const int e = i >> 10, k = i & 1023; const float v = wr[k * NE + e];
            const unsigned h = cvtpk(v, 0.f) & 0xffffu; wrh[i] = (bf16_t)h; wrl[i] = (bf16_t)(cvtpk(v - bflo(h), 0.f) & 0xffffu); }
    }
}

__device__ __forceinline__ void phase1(Ctx& F) {
    const float* mod = (const float*)(F.ws + WS_SMALL + SM_MOD);
    const float* x = inp(F, I_X); const float* g1 = inp(F, I_N1G);
    bf16_t* H = (bf16_t*)(F.ws + WS_H);
    const int gw = F.bid * 8 + F.wave, NGW = F.G * 8;
    if (gw < 256) {
        const int b = gw >> 6, e = gw & 63; const float* wr = inp(F, I_WR); float a = 0.f;
#pragma unroll 4
        for (int k = F.lane; k < DM; k += 64) a += mod[b * NMOD + 3 * DM + k] * wr[k * NE + e];
        a = wave_sum(a);
        if (F.lane == 0) ((float*)(F.ws + WS_SMALL + SM_CB))[gw] = a;
    }
    if (F.bid == 32) {
        float* gvec = (float*)(F.ws + WS_SMALL + SM_GVEC); const float* g2 = inp(F, I_N2G);
        for (int i = F.tid; i < 4 * DM; i += 512) { const int b = i >> 10, k = i & 1023; gvec[i] = g2[k] * (1.f + mod[b * NMOD + 4 * DM + k]); }
    }
    for (int m0 = gw; m0 < MT; m0 += 2 * NGW) {
        const int m1 = m0 + NGW;
        const bool two = m1 < MT;
        const f32x4* xr0 = (const f32x4*)(x + (size_t)m0 * DM) + F.lane; const f32x4* xr1 = (const f32x4*)(x + (size_t)(two ? m1 : m0) * DM) + F.lane;
        f32x4 v0[4], v1[4]; float s0 = 0.f, s1 = 0.f;
#pragma unroll
        for (int j = 0; j < 4; ++j) { v0[j] = xr0[64 * j]; v1[j] = xr1[64 * j]; }
#pragma unroll
        for (int j = 0; j < 4; ++j) { s0 += (v0[j].x * v0[j].x + v0[j].y * v0[j].y) + (v0[j].z * v0[j].z + v0[j].w * v0[j].w); s1 += (v1[j].x * v1[j].x + v1[j].y * v1[j].y) + (v1[j].z * v1[j].z + v1[j].w * v1[j].w); }
        const float r0 = rsqrtf(wave_sum(s0) * (1.f / DM) + EPS), r1 = rsqrtf(wave_sum(s1) * (1.f / DM) + EPS);
        const int b0 = m0 / SEQ, b1 = (two ? m1 : m0) / SEQ;
        u32x2* o0 = (u32x2*)(H + (size_t)m0 * DM) + F.lane; u32x2* o1 = (u32x2*)(H + (size_t)(two ? m1 : m0) * DM) + F.lane;
#pragma unroll
        for (int j = 0; j < 4; ++j) {
            const int col = 4 * F.lane + 256 * j;
            const f32x4 g = *(const f32x4*)(g1 + col);
            const f32x4 h0 = (v0[j] * r0) * g * (*(const f32x4*)(mod + b0 * NMOD + DM + col) + 1.0f) + *(const f32x4*)(mod + b0 * NMOD + col);
            const f32x4 h1 = (v1[j] * r1) * g * (*(const f32x4*)(mod + b1 * NMOD + DM + col) + 1.0f) + *(const f32x4*)(mod + b1 * NMOD + col);
            u32x2 w; w.x = cvtpk(h0.x, h0.y); w.y = cvtpk(h0.z, h0.w); o0[64 * j] = w;
            if (two) { w.x = cvtpk(h1.x, h1.y); w.y = cvtpk(h1.z, h1.w); o1[64 * j] = w; }
        }
    }
}

struct ProjSched {
    const char* A; const char* Bt; int G, c; int R[2], C[2];
    __device__ __forceinline__ bool next(int i, gm::UnitD& u) {
        int pm, pn; if (!gm::static_tile(MT, 5120, G, c, i, pm, pn)) return false;
        u.a = A; u.b = Bt + (size_t)pn * 256 * 1024 * 2;
#pragma unroll
        for (int h = 0; h < 2; ++h)
#pragma unroll
            for (int j = 0; j < 2; ++j) u.va[h][j] = (unsigned)((pm * 256 + h * 128 + R[j]) * 1024 + C[j]) * 2u;
        u.e0 = pm; u.e1 = pn; u.e2 = 0; u.e3 = 0; return true;
    }
};
struct EpiProj {
    bf16_t* qsb; bf16_t* qmb; bf16_t* g;
    __device__ __forceinline__ void operator()(const f32x4 (&acc)[2][2][4][2], const gm::UnitD& u, int wr, int wc, int fr, int fq) const {
        const int pm = u.e0, pn = u.e1;
        bf16_t* base; int ldc, colt; float sc = 1.f;
        if (pn < 6) { base = qsb; ldc = QW; colt = pn * 256; if (pn < 2) sc = 0.125f; }
        else if (pn < 12) { base = qmb; ldc = QW; colt = (pn - 6) * 256; if (pn < 8) sc = 0.125f; }
        else { base = g; ldc = 2048; colt = (pn - 12) * 256; }
        const int row0 = pm * 256 + wr * 64 + fr, col0 = colt + wc * 32 + 8 * fq;
#pragma unroll
        for (int ai = 0; ai < 2; ++ai)
#pragma unroll
            for (int m = 0; m < 4; ++m) { bf16_t* rowp = base + (size_t)(row0 + ai * 128 + m * 16) * ldc + col0;
#pragma unroll
                for (int bj = 0; bj < 2; ++bj) { const f32x4 v0 = acc[ai][bj][m][0] * sc, v1 = acc[ai][bj][m][1] * sc;
                    u32x4 w; w.x = cvtpk(v0[0], v0[1]); w.y = cvtpk(v0[2], v0[3]); w.z = cvtpk(v1[0], v1[1]); w.w = cvtpk(v1[2], v1[3]);
                    *(u32x4*)(rowp + bj * 128) = w; } }
    }
};
__device__ __forceinline__ void phase2(Ctx& F) {
    ProjSched S; S.A = (const char*)(F.ws + WS_H); S.Bt = (const char*)(F.ws + WS_WINT); S.G = F.G; S.c = F.bid; gm::stage_geom(F.tid, S.R, S.C);
    EpiProj E{(bf16_t*)(F.ws + WS_QSB), (bf16_t*)(F.ws + WS_QMB), (bf16_t*)(F.ws + WS_G)};
    gm::gemm_phase<true>(F.lds, 1024, S, E);
}

__device__ __forceinline__ int crow(int r, int hi) { return (r & 3) + 8 * (r >> 2) + 4 * hi; }
typedef short v4i16_t __attribute__((ext_vector_type(4)));
__device__ __forceinline__ s16x4 vtr(const LAS unsigned char* p) { return __builtin_bit_cast(s16x4, __builtin_amdgcn_ds_read_tr16_b64_v4i16((LAS v4i16_t*)p)); }
__device__ __forceinline__ void pv64(f32x16 (&o)[2], const LAS unsigned char* vt, int lane, const u32x4 (&pw)[4]) {
    const int hi = lane >> 5;
    const LAS unsigned char* vb = vt + ((lane >> 4) & 1) * 32 + (lane & 3) * 8 + (4 * hi + ((lane & 15) >> 2)) * 64;
#pragma unroll
    for (int d0 = 0; d0 < 2; ++d0)
#pragma unroll
        for (int ks = 0; ks < 4; ++ks) {
            const s16x4 lo = vtr(vb + d0 * 4096 + ks * 1024), hh = vtr(vb + d0 * 4096 + ks * 1024 + 512);
            const bf16x8 bv = (bf16x8){lo[0], lo[1], lo[2], lo[3], hh[0], hh[1], hh[2], hh[3]};
            o[d0] = __builtin_amdgcn_mfma_f32_32x32x16_bf16(__builtin_bit_cast(bf16x8, pw[ks]), bv, o[d0], 0, 0, 0);
        }
}
__device__ __forceinline__ void store_o_tile(const f32x16 (&o)[2], LAS unsigned char* stgb, int lane, bf16_t* dst0, size_t row_pitch) {
    const int r32 = lane & 31, hi = lane >> 5;
    LAS bf16_t* stg = (LAS bf16_t*)stgb;
#pragma unroll
    for (int r = 0; r < 16; ++r) { const int orow = crow(r, hi);
#pragma unroll
        for (int d0 = 0; d0 < 2; ++d0) stg[orow * 64 + d0 * 32 + r32] = (bf16_t)(cvtpk(o[d0][r], 0.f) & 0xffffu); }
    LDS_WAIT();
#pragma unroll
    for (int i = 0; i < 4; ++i) { const int row = i * 8 + (lane >> 3), ch = lane & 7; const u32x4 v = *(const LAS u32x4*)(stg + row * 64 + ch * 8); *(u32x4*)(dst0 + (size_t)row * row_pitch + ch * 8) = v; }
    LDS_WAIT();
}

template <bool MASKED>
__device__ __forceinline__ void sb_tile(const f32x16 (&z)[2], float& P, u32x4 (&pw)[4], int k0, int qpos, int hi) {
    f32x16 be[2], nb[2];
#pragma unroll
    for (int p = 0; p < 2; ++p)
#pragma unroll
        for (int r = 0; r < 16; ++r) {
            const float zz = __builtin_amdgcn_fmed3f(z[p][r] * LOG2E, -126.f, 126.f);
            const float t = __builtin_amdgcn_exp2f(-zz), b_ = __builtin_amdgcn_rcpf(1.f + t);
            float n_ = t * b_, bb = b_;
            if (MASKED) { const bool valid = (k0 + 32 * p + crow(r, hi)) < qpos; n_ = valid ? n_ : 1.f; bb = valid ? bb : 0.f; }
            be[p][r] = bb; nb[p][r] = n_;
        }
    float Gp[8], PG[8], off[8];
#pragma unroll
    for (int idx = 0; idx < 8; ++idx) { const int p = idx >> 2, g4 = (idx & 3) * 4; Gp[idx] = (nb[p][g4] * nb[p][g4 + 1]) * (nb[p][g4 + 2] * nb[p][g4 + 3]); }
#pragma unroll
    for (int idx = 0; idx < 8; ++idx) PG[idx] = __shfl_xor(Gp[idx], 32);
    float run = P;
#pragma unroll
    for (int idx = 7; idx >= 0; --idx) { off[idx] = hi ? run : run * PG[idx]; run *= (Gp[idx] * PG[idx]); }
    P = run;
#pragma unroll
    for (int idx = 0; idx < 8; ++idx) { const int p = idx >> 2, g4 = (idx & 3) * 4; float c = off[idx]; float a[4];
#pragma unroll
        for (int j = 3; j >= 0; --j) { a[j] = be[p][g4 + j] * c; c *= nb[p][g4 + j]; }
        pw[idx >> 1][(idx & 1) * 2] = cvtpk(a[0], a[1]); pw[idx >> 1][(idx & 1) * 2 + 1] = cvtpk(a[2], a[3]); }
}
__device__ __forceinline__ void sb_unit(Ctx& F, int bh, int qt, LAS unsigned char* vl) {
    const int lane = F.lane, r32 = lane & 31, hi = lane >> 5;
    const int b = bh >> 3, h = bh & 7, q0 = qt * 32, qpos = q0 + r32;
    const bf16_t* base = (const bf16_t*)(F.ws + WS_QSB) + (size_t)b * SEQ * QW + h * 64;
    const bf16_t* Kb = base + 512 + (size_t)r32 * QW + hi * 8; const bf16_t* Vb = base + 1024 + (size_t)(lane >> 2) * QW + (lane & 3) * 8;
    bf16x8 qr[4];
#pragma unroll
    for (int d0 = 0; d0 < 4; ++d0) qr[d0] = *(const bf16x8*)(base + (size_t)qpos * QW + d0 * 16 + hi * 8);
    float P = 1.f; f32x16 o[2]; o[0] = f32x16{}; o[1] = f32x16{};
    bf16x8 kfn[8];
    const int kt0 = q0 >> 6; int kt = kt0, cur = 0;
#define SB_PREFETCH(KT, BUF) do { const size_t ko_ = (size_t)(KT) * 64 * QW; \
        _Pragma("unroll") for (int d0 = 0; d0 < 4; ++d0) _Pragma("unroll") for (int hf = 0; hf < 2; ++hf) kfn[2 * d0 + hf] = *(const bf16x8*)(Kb + ko_ + (size_t)(32 * hf) * QW + d0 * 16); \
        _Pragma("unroll") for (int p = 0; p < 8; ++p) __builtin_amdgcn_global_load_lds((const unsigned*)(Vb + ko_ + (size_t)(16 * (p & 3)) * QW + (p >> 2) * 32), (LAS unsigned*)(vl + (BUF) * 8192 + p * 1024), 16, 0, 0); } while (0)
    SB_PREFETCH(kt, 0);
#pragma unroll 1
    for (; kt >= 0; --kt) {
        if (__all(P == 0.f)) break;
        f32x16 z[2]; z[0] = f32x16{}; z[1] = f32x16{};
#pragma unroll
        for (int d0 = 0; d0 < 4; ++d0) { z[0] = __builtin_amdgcn_mfma_f32_32x32x16_bf16(kfn[2 * d0], qr[d0], z[0], 0, 0, 0); z[1] = __builtin_amdgcn_mfma_f32_32x32x16_bf16(kfn[2 * d0 + 1], qr[d0], z[1], 0, 0, 0); }
        asm volatile("" : "+v"(z[0]), "+v"(z[1]));
        { const int ktn = kt > 0 ? kt - 1 : 0; SB_PREFETCH(ktn, cur ^ 1); }
        u32x4 pw[4];
        if (kt == kt0) sb_tile<true>(z, P, pw, kt * 64, qpos, hi); else sb_tile<false>(z, P, pw, kt * 64, qpos, hi);
        asm volatile("s_waitcnt vmcnt(16)" ::: "memory");
        pv64(o, vl + cur * 8192, lane, pw);
        cur ^= 1;
    }
#undef SB_PREFETCH
    asm volatile("s_waitcnt vmcnt(0)" ::: "memory");
    bf16_t* dst = (bf16_t*)(F.ws + WS_OB) + (size_t)(b * SEQ + q0) * 512 + h * 64;
    store_o_tile(o, vl, lane, dst, 512);
}
__device__ __forceinline__ void phase3(Ctx& F) {
    {
        float* kbar = (float*)(F.ws + WS_SMALL + SM_KBAR);
        const int gwk = F.wave * F.G + F.bid;
        for (int it = gwk; it < NB * 32 * 8; it += 8 * F.G) {
            const int u = it >> 3, hh = it & 7, rs = F.lane >> 3, ch = F.lane & 7;
            const bf16_t* kp = (const bf16_t*)(F.ws + WS_QMB) + (size_t)(u * 256 + rs) * QW + 512 + hh * 64 + ch * 8;
            float a[8];
#pragma unroll
            for (int j = 0; j < 8; ++j) a[j] = 0.f;
#pragma unroll 4
            for (int g = 0; g < 4; ++g) {
                u32x4 w[8];
#pragma unroll
                for (int i = 0; i < 8; ++i) w[i] = *(const u32x4*)(kp + (size_t)(g * 64 + i * 8) * QW);
#pragma unroll
                for (int i = 0; i < 8; ++i) { a[0] += bflo(w[i].x); a[1] += bfhi(w[i].x); a[2] += bflo(w[i].y); a[3] += bfhi(w[i].y); a[4] += bflo(w[i].z); a[5] += bfhi(w[i].z); a[6] += bflo(w[i].w); a[7] += bfhi(w[i].w); }
            }
#pragma unroll
            for (int j = 0; j < 8; ++j) { a[j] += __shfl_xor(a[j], 8); a[j] += __shfl_xor(a[j], 16); a[j] += __shfl_xor(a[j], 32); }
            if (rs == 0) { float* dst = kbar + u * 512 + hh * 64 + ch * 8;
                *(f32x4*)dst = (f32x4){a[0], a[1], a[2], a[3]} * (1.f / 256.f); *(f32x4*)(dst + 4) = (f32x4){a[4], a[5], a[6], a[7]} * (1.f / 256.f); }
        }
    }
    LAS unsigned char* vl = F.lds + F.wave * 16384;
    const int gw = F.bid * 8 + F.wave, NGW = F.G * 8;
    for (int u = gw; u < 32 * 256; u += NGW) sb_unit(F, u >> 8, u & 255, vl);
}

constexpr int MO_LUT = 0, MO_PRE = 4224, MO_WSF = 8320, MO_ENT = 12416, MO_ST = 16368;
__device__ __forceinline__ int mb_list_off(int j) { return 256 * (31 * j - (j * (j - 1)) / 2); }
constexpr int MB_LIST_STRIDE = 126976;
__device__ __forceinline__ int t5_bucket_dev(int n) {
    if (n < 16) return n;
    int large = 16 + (int)(logf((float)n / 16.f) / 2.0794415416798357f * 16.f);
    return large < 31 ? large : 31;
}
__device__ __forceinline__ void build_lut(Ctx& F) {
    LAS float* lut = (LAS float*)(F.lds + MISC_OFF + MO_LUT);
    for (int i = F.tid; i < 8 * 132; i += 512) { const int h = i / 132, d = i % 132; lut[i] = inp(F, I_RELB)[h * 32 + t5_bucket_dev(d < 128 ? d : 128)] * LOG2E; }
}
__device__ __forceinline__ void phase4(Ctx& F) {
    LAS float* kb = (LAS float*)(F.lds);
    LAS int* lcnt = (LAS int*)(F.lds + MISC_OFF + MO_PRE); LAS int* lbase = lcnt + 32;
    const float* kbar = (const float*)(F.ws + WS_SMALL + SM_KBAR);
    unsigned* cur = (unsigned*)(F.ws + WS_CTL) + CW_MBCUR;
    unsigned short* lists = (unsigned short*)(F.ws + WS_LMB);
    for (int u = F.bid; u < 32 * 31; u += F.G) {
        const int bh = u / 31, i = 1 + (u % 31), b = bh >> 3, h = bh & 7;
        for (int idx = F.tid; idx < i * 64; idx += 512) kb[idx] = kbar[(b * 32 + (idx >> 6)) * 512 + h * 64 + (idx & 63)];
        if (F.tid < 32) lcnt[F.tid] = 0;
        __syncthreads();
        int j0 = -1, j1 = -1, j2 = -1, r0 = 0, r1 = 0, r2 = 0; const int nsel = i < 3 ? i : 3;
        const int qpos = i * 256 + F.tid;
        if (F.tid < 256) {
            float qv[64];
            const u32x4* qp = (const u32x4*)((const bf16_t*)(F.ws + WS_QMB) + (size_t)(b * SEQ + qpos) * QW + h * 64);
#pragma unroll
            for (int c = 0; c < 8; ++c) { const u32x4 w = qp[c];
                qv[8 * c] = bflo(w.x); qv[8 * c + 1] = bfhi(w.x); qv[8 * c + 2] = bflo(w.y); qv[8 * c + 3] = bfhi(w.y);
                qv[8 * c + 4] = bflo(w.z); qv[8 * c + 5] = bfhi(w.z); qv[8 * c + 6] = bflo(w.w); qv[8 * c + 7] = bfhi(w.w); }
            float v0 = -INFINITY, v1 = -INFINITY, v2 = -INFINITY;
            for (int j = 0; j < i; ++j) {
                const LAS f32x4* kr = (const LAS f32x4*)(kb + j * 64);
                float g = 0.f;
#pragma unroll
                for (int c = 0; c < 16; ++c) { const f32x4 kk = kr[c]; g += qv[4 * c] * kk.x + qv[4 * c + 1] * kk.y + qv[4 * c + 2] * kk.z + qv[4 * c + 3] * kk.w; }
                if (g > v0) { v2 = v1; j2 = j1; v1 = v0; j1 = j0; v0 = g; j0 = j; }
                else if (g > v1) { v2 = v1; j2 = j1; v1 = g; j1 = j; }
                else if (g > v2) { v2 = g; j2 = j; }
            }
            r0 = lds_add(&lcnt[j0], 1);
            if (nsel > 1) r1 = lds_add(&lcnt[j1], 1);
            if (nsel > 2) r2 = lds_add(&lcnt[j2], 1);
        }
        __syncthreads();
        if (F.tid < i) { const int n = lcnt[F.tid]; lbase[F.tid] = n > 0 ? (int)atomicAdd(&cur[bh * 32 + F.tid], (unsigned)n) : 0; }
        __syncthreads();
        if (F.tid < 256) {
            unsigned short* lb = lists + (size_t)bh * MB_LIST_STRIDE;
            lb[mb_list_off(j0) + lbase[j0] + r0] = (unsigned short)(qpos | (0 << 13));
            if (nsel > 1) lb[mb_list_off(j1) + lbase[j1] + r1] = (unsigned short)(qpos | (1 << 13));
            if (nsel > 2) lb[mb_list_off(j2) + lbase[j2] + r2] = (unsigned short)(qpos | (2 << 13));
        }
        __syncthreads();
    }
}
__device__ __forceinline__ void kv_dma(Ctx& F, const bf16_t* kg, const bf16_t* vg, int bufoff) {
    const int l = F.lane;
#pragma unroll
    for (int i = 0; i < 4; ++i) { const int p = 4 * F.wave + i;
        __builtin_amdgcn_global_load_lds((const unsigned*)(kg + (size_t)(8 * p + (l >> 3)) * QW + ((l & 7) ^ ((l >> 3) & 7)) * 8), (LAS unsigned*)(F.lds + bufoff + p * 1024), 16, 0, 0);
        __builtin_amdgcn_global_load_lds((const unsigned*)(vg + (size_t)((p >> 3) * 64 + (p & 3) * 16 + (l >> 2)) * QW + ((p >> 2) & 1) * 32 + (l & 3) * 8), (LAS unsigned*)(F.lds + bufoff + 32768 + p * 1024), 16, 0, 0); }
}
__device__ __forceinline__ void softmax_step(f32x16 (&t)[2], float& m, float& l, f32x16 (&o)[2], LAS float* wsf, const LAS unsigned char* vt, int lane) {
    const int r32 = lane & 31, hi = lane >> 5;
    float rm = -INFINITY;
#pragma unroll
    for (int p = 0; p < 2; ++p)
#pragma unroll
        for (int r = 0; r < 16; ++r) rm = fmaxf(rm, t[p][r]);
    rm = fmaxf(rm, __shfl_xor(rm, 32));
    const float mn = fmaxf(m, rm);
    const float f = __builtin_amdgcn_exp2f(m - mn);
    m = mn;
    float s = 0.f; u32x4 pw[4];
#pragma unroll
    for (int p = 0; p < 2; ++p)
#pragma unroll
        for (int r = 0; r < 16; ++r) { const float e = __builtin_amdgcn_exp2f(t[p][r] - mn); t[p][r] = e; s += e; }
    l = l * f + s;
#pragma unroll
    for (int idx = 0; idx < 8; ++idx) { const int p = idx >> 2, g4 = (idx & 3) * 4; pw[idx >> 1][(idx & 1) * 2] = cvtpk(t[p][g4], t[p][g4 + 1]); pw[idx >> 1][(idx & 1) * 2 + 1] = cvtpk(t[p][g4 + 2], t[p][g4 + 3]); }
    if (__any(f != 1.f)) {
        if (hi == 0) wsf[r32] = f;
        LDS_WAIT();
#pragma unroll
        for (int g = 0; g < 4; ++g) { const f32x4 fv = *(const LAS f32x4*)(wsf + 8 * g + 4 * hi);
#pragma unroll
            for (int j = 0; j < 4; ++j) { o[0][4 * g + j] *= fv[j]; o[1][4 * g + j] *= fv[j]; } }
        LDS_WAIT();
    }
    pv64(o, vt, lane, pw);
}
__device__ __forceinline__ void qkt64(f32x16 (&t)[2], const LAS unsigned char* kt, const bf16x8 (&qr)[4], int lane) {
    const int r32 = lane & 31, hi = lane >> 5;
    t[0] = f32x16{}; t[1] = f32x16{};
    const LAS unsigned char* rp = kt + r32 * 128;
#pragma unroll
    for (int d0 = 0; d0 < 4; ++d0) {
        const int pos = ((2 * d0 + hi) ^ (r32 & 7)) * 16;
        const bf16x8 k0 = *(const LAS bf16x8*)(rp + pos), k1 = *(const LAS bf16x8*)(rp + 4096 + pos);
        t[0] = __builtin_amdgcn_mfma_f32_32x32x16_bf16(k0, qr[d0], t[0], 0, 0, 0); t[1] = __builtin_amdgcn_mfma_f32_32x32x16_bf16(k1, qr[d0], t[1], 0, 0, 0);
    }
}
__device__ __forceinline__ void phase5(Ctx& F) {
    LAS int* pre = (LAS int*)(F.lds + MISC_OFF + MO_PRE);
    LAS int* wtot = (LAS int*)(F.lds + MISC_OFF + MO_ENT);
    const unsigned* cur = (const unsigned*)(F.ws + WS_CTL) + CW_MBCUR;
    build_lut(F);
    int total;
    {
        const int p0 = 2 * F.tid, p1 = p0 + 1;
        const int c0 = p0 < 992 ? (int)((cur[(p0 / 31) * 32 + (p0 % 31)] + 255u) >> 8) : 0;
        const int c1 = p1 < 992 ? (int)((cur[(p1 / 31) * 32 + (p1 % 31)] + 255u) >> 8) : 0;
        const int s = c0 + c1; int v = s;
#pragma unroll
        for (int o = 1; o < 64; o <<= 1) { const int n = __shfl_up(v, o); if (F.lane >= o) v += n; }
        if (F.lane == 63) wtot[248 + F.wave] = v;
        __syncthreads();
        int woff = 0; total = 0;
#pragma unroll
        for (int w = 0; w < 8; ++w) { const int x = wtot[248 + w]; if (w < F.wave) woff += x; total += x; }
        const int excl = woff + v - s;
        pre[p0] = excl; pre[p1] = excl + c0;
        __syncthreads();
    }
    const unsigned short* lists = (const unsigned short*)(F.ws + WS_LMB);
    LAS float* wsf = (LAS float*)(F.lds + MISC_OFF + MO_WSF) + F.wave * 128;
    LAS int* ent = (LAS int*)(F.lds + MISC_OFF + MO_ENT) + F.wave * 32;
    const int lane = F.lane, r32 = lane & 31, hi = lane >> 5;
#define P5_UNIT(U, BH, J, C) do { int lo_ = 0, hi_ = 992; while (hi_ - lo_ > 1) { const int mid = (lo_ + hi_) >> 1; if (pre[mid] <= (U)) lo_ = mid; else hi_ = mid; } BH = lo_ / 31; J = lo_ % 31; C = (U) - pre[lo_]; } while (0)
#define P5_DMA(BH, J, BUF) do { const bf16_t* b_ = (const bf16_t*)(F.ws + WS_QMB) + (size_t)((BH) >> 3) * SEQ * QW + ((BH) & 7) * 64; kv_dma(F, b_ + 512 + (size_t)((J) * 256) * QW, b_ + 1024 + (size_t)((J) * 256) * QW, (BUF) * 65536); } while (0)
    int u = F.bid, bh = 0, j = 0, c = 0, buf = 0;
    if (u < total) { P5_UNIT(u, bh, j, c); P5_DMA(bh, j, 0); }
    for (; u < total; u += F.G) {
        const int un = u + F.G; int bhn = 0, jn = 0, cn = 0;
        if (un < total) P5_UNIT(un, bhn, jn, cn);
        const int b = bh >> 3, h = bh & 7;
        const int n = (int)cur[bh * 32 + j];
        const bf16_t* base = (const bf16_t*)(F.ws + WS_QMB) + (size_t)b * SEQ * QW + h * 64;
        const int e0 = c * 256 + F.wave * 32;
        const bool act = e0 < n;
        const unsigned short* lb = lists + (size_t)bh * MB_LIST_STRIDE + mb_list_off(j);
        const int eidx = e0 + r32; const bool valid = act && eidx < n;
        const int entry = act ? (int)lb[valid ? eidx : e0] : 0;
        const int qpos = entry & 8191, slot = entry >> 13;
        bf16x8 qr[4];
#pragma unroll
        for (int d0 = 0; d0 < 4; ++d0) qr[d0] = *(const bf16x8*)(base + (size_t)qpos * QW + d0 * 16 + hi * 8);
        asm volatile("s_waitcnt vmcnt(0)" ::: "memory");
        __syncthreads();
        if (un < total) P5_DMA(bhn, jn, buf ^ 1);
        const LAS unsigned char* kimg = F.lds + buf * 65536; const LAS unsigned char* vimg = kimg + 32768;
        if (act) {
            if (hi == 0) ent[r32] = valid ? entry : -1;
            float m = -INFINITY, l = 0.f; f32x16 o[2]; o[0] = f32x16{}; o[1] = f32x16{};
            const LAS float* lut = (const LAS float*)(F.lds + MISC_OFF + MO_LUT) + h * 132;
            const float bfar = lut[128];
#pragma unroll 1
            for (int st = 0; st < 4; ++st) {
                f32x16 t[2]; qkt64(t, kimg + st * 8192, qr, lane);
                const int kbase = j * 256 + st * 64;
                const bool far = __all(qpos - (kbase + 63) >= 128);
                if (far) {
#pragma unroll
                    for (int pp = 0; pp < 2; ++pp)
#pragma unroll
                        for (int r = 0; r < 16; ++r) t[pp][r] = t[pp][r] * LOG2E + bfar;
                } else {
#pragma unroll
                    for (int pp = 0; pp < 2; ++pp)
#pragma unroll
                        for (int r = 0; r < 16; ++r) { int d = qpos - (kbase + 32 * pp + crow(r, hi)); d = d < 128 ? d : 128; d = d > 0 ? d : 0; t[pp][r] = t[pp][r] * LOG2E + lut[d]; }
                }
                softmax_step(t, m, l, o, wsf, vimg + st * 8192, lane);
            }
            l += __shfl_xor(l, 32);
            const float rl = 1.f / l;
            if (hi == 0) { wsf[r32] = rl; if (valid) ((float*)(F.ws + WS_PLSE))[((size_t)bh * SEQ + qpos) * 3 + slot] = m + __log2f(l); }
            LDS_WAIT();
            {
                LAS bf16_t* stg = (LAS bf16_t*)(F.lds + MISC_OFF + MO_STG + F.wave * 2048);
                bf16_t* po = (bf16_t*)(F.ws + WS_PO);
#pragma unroll
                for (int d0 = 0; d0 < 2; ++d0) {
#pragma unroll
                    for (int r = 0; r < 16; ++r) { const int q = crow(r, hi); stg[q * 32 + r32] = (bf16_t)(cvtpk(o[d0][r] * wsf[q], 0.f) & 0xffffu); }
                    LDS_WAIT();
#pragma unroll
                    for (int it2 = 0; it2 < 2; ++it2) { const int row = it2 * 16 + (lane >> 2), ch = lane & 3; const int en = ent[row];
                        const u32x4 v = *(const LAS u32x4*)(stg + row * 32 + ch * 8);
                        if (en >= 0) *(u32x4*)(po + (((size_t)bh * SEQ + (en & 8191)) * 3 + (en >> 13)) * 64 + d0 * 32 + ch * 8) = v; }
                    LDS_WAIT();
                }
            }
        }
        bh = bhn; j = jn; c = cn; buf ^= 1;
    }
#undef P5_UNIT
#undef P5_DMA
    asm volatile("s_waitcnt vmcnt(0)" ::: "memory");
    __syncthreads();
}
__device__ __forceinline__ void phase6(Ctx& F) {
    build_lut(F);
    LAS float* wsf = (LAS float*)(F.lds + MISC_OFF + MO_WSF) + F.wave * 128;
    const int lane = F.lane, r32 = lane & 31, hi = lane >> 5, w = F.wave;
#define P6_DMA(U, BUF) do { const int bh_ = (U) >> 5, i_ = 31 - ((U) & 31); const bf16_t* b_ = (const bf16_t*)(F.ws + WS_QMB) + (size_t)(bh_ >> 3) * SEQ * QW + (bh_ & 7) * 64; \
        kv_dma(F, b_ + 512 + (size_t)(i_ * 256) * QW, b_ + 1024 + (size_t)(i_ * 256) * QW, (BUF) * 65536); } while (0)
    int buf = 0;
    if (F.bid < 32 * 32) P6_DMA(F.bid, 0);
    for (int u = F.bid; u < 32 * 32; u += F.G) {
        const int bh = u >> 5, i = 31 - (u & 31), b = bh >> 3, h = bh & 7;
        const bf16_t* base = (const bf16_t*)(F.ws + WS_QMB) + (size_t)b * SEQ * QW + h * 64;
        const int ql = w * 32 + r32, qpos = i * 256 + ql;
        bf16x8 qr[4];
#pragma unroll
        for (int d0 = 0; d0 < 4; ++d0) qr[d0] = *(const bf16x8*)(base + (size_t)qpos * QW + d0 * 16 + hi * 8);
        const int nsel = i < 3 ? i : 3;
        const float* plse = (const float*)(F.ws + WS_PLSE) + ((size_t)bh * SEQ + qpos) * 3;
        float ls0 = -INFINITY, ls1 = -INFINITY, ls2 = -INFINITY;
        if (nsel > 0) ls0 = plse[0]; if (nsel > 1) ls1 = plse[1]; if (nsel > 2) ls2 = plse[2];
        asm volatile("s_waitcnt vmcnt(0)" ::: "memory");
        __syncthreads();
        if (u + F.G < 32 * 32) P6_DMA(u + F.G, buf ^ 1);
        const LAS unsigned char* kimg = F.lds + buf * 65536; const LAS unsigned char* vimg = kimg + 32768;
        float m = -INFINITY, l = 0.f; f32x16 o[2]; o[0] = f32x16{}; o[1] = f32x16{};
        const LAS float* lut = (const LAS float*)(F.lds + MISC_OFF + MO_LUT) + h * 132;
        const int nst = (w >> 1) + 1;
#pragma unroll 1
        for (int st = 0; st < nst; ++st) {
            f32x16 t[2]; qkt64(t, kimg + st * 8192, qr, lane);
#pragma unroll
            for (int pp = 0; pp < 2; ++pp)
#pragma unroll
                for (int r = 0; r < 16; ++r) { const int d = ql - (st * 64 + 32 * pp + crow(r, hi)); const int dc = d < 128 ? (d > 0 ? d : 0) : 128; const float v = t[pp][r] * LOG2E + lut[dc]; t[pp][r] = d >= 0 ? v : -INFINITY; }
            softmax_step(t, m, l, o, wsf, vimg + st * 8192, lane);
        }
        l += __shfl_xor(l, 32);
        const float M = fmaxf(fmaxf(m, ls0), fmaxf(ls1, ls2));
        const float eo = __builtin_amdgcn_exp2f(m - M), e0 = __builtin_amdgcn_exp2f(ls0 - M), e1 = __builtin_amdgcn_exp2f(ls1 - M), e2 = __builtin_amdgcn_exp2f(ls2 - M);
        const float rden = 1.f / (l * eo + e0 + e1 + e2);
        if (hi == 0) *(LAS f32x4*)(wsf + 4 * r32) = (f32x4){eo * rden, e0 * rden, e1 * rden, e2 * rden};
        LDS_WAIT();
#pragma unroll
        for (int r = 0; r < 16; ++r) { const float fo = wsf[4 * crow(r, hi)]; o[0][r] *= fo; o[1][r] *= fo; }
        __syncthreads();
        {
            LAS bf16_t* stg = (LAS bf16_t*)(F.lds + buf * 65536 + w * 4096);
#pragma unroll
            for (int r = 0; r < 16; ++r) { const int orow = crow(r, hi);
#pragma unroll
                for (int d0 = 0; d0 < 2; ++d0) stg[orow * 64 + d0 * 32 + r32] = (bf16_t)(cvtpk(o[d0][r], 0.f) & 0xffffu); }
            LDS_WAIT();
            const bf16_t* po = (const bf16_t*)(F.ws + WS_PO) + ((size_t)bh * SEQ + i * 256 + w * 32) * 3 * 64;
            bf16_t* dst = (bf16_t*)(F.ws + WS_OB) + (size_t)MT * 512 + (size_t)(b * SEQ + i * 256 + w * 32) * 512 + h * 64;
#pragma unroll
            for (int it4 = 0; it4 < 4; ++it4) { const int row = it4 * 8 + (lane >> 3), ch = lane & 7;
                const u32x4 ov = *(const LAS u32x4*)(stg + row * 64 + ch * 8);
                float a[8] = {bflo(ov.x), bfhi(ov.x), bflo(ov.y), bfhi(ov.y), bflo(ov.z), bfhi(ov.z), bflo(ov.w), bfhi(ov.w)};
                const f32x4 fc = *(const LAS f32x4*)(wsf + 4 * row);
#pragma unroll
                for (int sl = 0; sl < 3; ++sl) if (sl < nsel) { const u32x4 pv = *(const u32x4*)(po + (size_t)(row * 3 + sl) * 64 + ch * 8); const float f = fc[1 + sl];
                    a[0] += f * bflo(pv.x); a[1] += f * bfhi(pv.x); a[2] += f * bflo(pv.y); a[3] += f * bfhi(pv.y); a[4] += f * bflo(pv.z); a[5] += f * bfhi(pv.z); a[6] += f * bflo(pv.w); a[7] += f * bfhi(pv.w); }
                u32x4 w4; w4.x = cvtpk(a[0], a[1]); w4.y = cvtpk(a[2], a[3]); w4.z = cvtpk(a[4], a[5]); w4.w = cvtpk(a[6], a[7]);
                *(u32x4*)(dst + (size_t)row * 512 + ch * 8) = w4; }
            LDS_WAIT();
        }
        buf ^= 1;
    }
#undef P6_DMA
    asm volatile("s_waitcnt vmcnt(0)" ::: "memory");
    __syncthreads();
}

struct BranchSched {
    const char* A; const char* Bt; int G, c; int R[2], C[2];
    __device__ __forceinline__ bool next(int i, gm::UnitD& u) {
        int pm, pn; if (!gm::static_tile(MT, 1024, G, c, i >> 1, pm, pn)) return false;
        const int br = i & 1;
        u.a = A + (size_t)br * MT * 512 * 2; u.b = Bt + (size_t)(br * 1024 + pn * 256) * 512 * 2;
#pragma unroll
        for (int h = 0; h < 2; ++h)
#pragma unroll
            for (int j = 0; j < 2; ++j) u.va[h][j] = (unsigned)((pm * 256 + h * 128 + R[j]) * 512 + C[j]) * 2u;
        u.e0 = pm; u.e1 = pn; u.e2 = br; u.e3 = 0; return true;
    }
};
struct EpiBranch {
    const bf16_t* g; bf16_t* merged;
    __device__ __forceinline__ void operator()(const f32x4 (&acc)[2][2][4][2], const gm::UnitD& u, int wr, int wc, int fr, int fq) const {
        const int pm = u.e0, pn = u.e1, br = u.e2;
        const int row0 = pm * 256 + wr * 64 + fr, col0 = pn * 256 + wc * 32 + 8 * fq;
#pragma unroll
        for (int ai = 0; ai < 2; ++ai)
#pragma unroll
            for (int m = 0; m < 4; ++m) { const size_t row = (size_t)(row0 + ai * 128 + m * 16);
#pragma unroll
                for (int bj = 0; bj < 2; ++bj) {
                    const u32x4 gv = *(const u32x4*)(g + row * 2048 + br * 1024 + col0 + bj * 128);
                    bf16_t* mp = merged + row * 1024 + col0 + bj * 128;
                    const f32x4 v0 = acc[ai][bj][m][0], v1 = acc[ai][bj][m][1];
                    float r[8];
                    r[0] = sigmoidf_(bflo(gv.x)) * v0[0]; r[1] = sigmoidf_(bfhi(gv.x)) * v0[1]; r[2] = sigmoidf_(bflo(gv.y)) * v0[2]; r[3] = sigmoidf_(bfhi(gv.y)) * v0[3];
                    r[4] = sigmoidf_(bflo(gv.z)) * v1[0]; r[5] = sigmoidf_(bfhi(gv.z)) * v1[1]; r[6] = sigmoidf_(bflo(gv.w)) * v1[2]; r[7] = sigmoidf_(bfhi(gv.w)) * v1[3];
                    if (br) { const u32x4 pv = *(const u32x4*)mp;
                        r[0] += bflo(pv.x); r[1] += bfhi(pv.x); r[2] += bflo(pv.y); r[3] += bfhi(pv.y); r[4] += bflo(pv.z); r[5] += bfhi(pv.z); r[6] += bflo(pv.w); r[7] += bfhi(pv.w); }
                    u32x4 w; w.x = cvtpk(r[0], r[1]); w.y = cvtpk(r[2], r[3]); w.z = cvtpk(r[4], r[5]); w.w = cvtpk(r[6], r[7]);
                    *(u32x4*)mp = w; } }
    }
};
__device__ __forceinline__ void phase7(Ctx& F) {
    BranchSched S; S.A = (const char*)(F.ws + WS_OB); S.Bt = (const char*)(F.ws + WS_WBRT); S.G = F.G; S.c = F.bid; gm::stage_geom(F.tid, S.R, S.C);
    EpiBranch E{(const bf16_t*)(F.ws + WS_G), (bf16_t*)(F.ws + WS_MERGED)};
    gm::gemm_phase<true>(F.lds, 512, S, E);
}
struct OutSched {
    const char* A; const char* Bt; int G, c; int R[2], C[2];
    __device__ __forceinline__ bool next(int i, gm::UnitD& u) {
        int pm, pn; if (!gm::static_tile(MT, 1024, G, c, i, pm, pn)) return false;
        u.a = A; u.b = Bt + (size_t)pn * 256 * 1024 * 2;
#pragma unroll
        for (int h = 0; h < 2; ++h)
#pragma unroll
            for (int j = 0; j < 2; ++j) u.va[h][j] = (unsigned)((pm * 256 + h * 128 + R[j]) * 1024 + C[j]) * 2u;
        u.e0 = pm; u.e1 = pn; u.e2 = 0; u.e3 = 0; return true;
    }
};
struct EpiOut {
    const float* x; const float* mod; float* out;
    __device__ __forceinline__ void operator()(const f32x4 (&acc)[2][2][4][2], const gm::UnitD& u, int wr, int wc, int fr, int fq) const {
        const int pm = u.e0, pn = u.e1, b = (pm * 256) / SEQ;
        const int row0 = pm * 256 + wr * 64 + fr, col0 = pn * 256 + wc * 32 + 4 * fq;
        f32x4 gt[2][2];
#pragma unroll
        for (int bj = 0; bj < 2; ++bj)
#pragma unroll
            for (int n = 0; n < 2; ++n) gt[bj][n] = *(const f32x4*)(mod + b * NMOD + 2 * DM + col0 + bj * 128 + n * 16);
#pragma unroll
        for (int ai = 0; ai < 2; ++ai)
#pragma unroll
            for (int m = 0; m < 4; ++m) { const size_t off = (size_t)(row0 + ai * 128 + m * 16) * DM + col0;
#pragma unroll
                for (int bj = 0; bj < 2; ++bj)
#pragma unroll
                    for (int n = 0; n < 2; ++n) { const f32x4 xv = *(const f32x4*)(x + off + bj * 128 + n * 16); *(f32x4*)(out + off + bj * 128 + n * 16) = xv + gt[bj][n] * acc[ai][bj][m][n]; } }
    }
};
__device__ __forceinline__ void phase8(Ctx& F) {
    OutSched S; S.A = (const char*)(F.ws + WS_MERGED); S.Bt = (const char*)(F.ws + WS_WOUTT); S.G = F.G; S.c = F.bid; gm::stage_geom(F.tid, S.R, S.C);
    EpiOut E{inp(F, I_X), (const float*)(F.ws + WS_SMALL + SM_MOD), F.out};
    gm::gemm_phase<false>(F.lds, 1024, S, E);
}

constexpr int NR_SSQ = MO_PRE + 1024;
constexpr int NR_RS = MO_PRE + 3072;
__device__ __forceinline__ void phase_n2r(Ctx& F, int rr) {
    const float* x1 = F.out; const float* gvec = (const float*)(F.ws + WS_SMALL + SM_GVEC); const float* cb = (const float*)(F.ws + WS_SMALL + SM_CB);
    const float* mod = (const float*)(F.ws + WS_SMALL + SM_MOD); const float* rbias = inp(F, I_RB);
    bf16_t* H2 = (bf16_t*)(F.ws + WS_H2); int* tokl = (int*)(F.ws + WS_TOKL); float* wl = (float*)(F.ws + WS_WL); int* tpos = (int*)(F.ws + WS_TPOS);
    unsigned* cur = (unsigned*)(F.ws + WS_CTL) + CW_MOECUR + rr * 64;
    LAS int* lcnt = (LAS int*)(F.lds + MISC_OFF + MO_PRE); LAS int* lbase = lcnt + 64;
    LAS float* part = (LAS float*)(F.lds);
    LAS float* ssqp = (LAS float*)(F.lds + MISC_OFF + NR_SSQ); LAS float* rsl = (LAS float*)(F.lds + MISC_OFF + NR_RS);
    const int lane = F.lane, w = F.wave, i16 = lane & 15, kk = lane >> 4;
    for (int u = F.bid; u < RT / 64; u += F.G) {
        if (F.tid < 64) lcnt[F.tid] = 0;
        const int tokb = rr * RT + u * 64, b = tokb / SEQ;
        {
            bf16x8 fah[4][4], fal[4][4];
            {
                const float* gp = gvec + b * DM + 128 * w + 8 * kk;
                f32x4 gv[4][2];
#pragma unroll
                for (int s4 = 0; s4 < 4; ++s4) { gv[s4][0] = *(const f32x4*)(gp + 32 * s4); gv[s4][1] = *(const f32x4*)(gp + 32 * s4 + 4); }
#pragma unroll
                for (int tt = 0; tt < 4; ++tt) {
                    const float* xp = x1 + (size_t)(tokb + tt * 16 + i16) * DM + 128 * w + 8 * kk;
                    f32x4 xa[4][2];
#pragma unroll
                    for (int s4 = 0; s4 < 4; ++s4) { xa[s4][0] = *(const f32x4*)(xp + 32 * s4); xa[s4][1] = *(const f32x4*)(xp + 32 * s4 + 4); }
                    float ssq = 0.f;
#pragma unroll
                    for (int s4 = 0; s4 < 4; ++s4) {
                        u32x4 ah, al;
#pragma unroll
                        for (int q = 0; q < 2; ++q) { const f32x4 xv = xa[s4][q]; ssq += (xv.x * xv.x + xv.y * xv.y) + (xv.z * xv.z + xv.w * xv.w);
                            const f32x4 a = xv * gv[s4][q];
                            const unsigned h0 = cvtpk(a.x, a.y), h1 = cvtpk(a.z, a.w);
                            ah[2 * q] = h0; ah[2 * q + 1] = h1; al[2 * q] = cvtpk(a.x - bflo(h0), a.y - bfhi(h0)); al[2 * q + 1] = cvtpk(a.z - bflo(h1), a.w - bfhi(h1)); }
                        fah[tt][s4] = __builtin_bit_cast(bf16x8, ah); fal[tt][s4] = __builtin_bit_cast(bf16x8, al);
                    }
                    ssq += __shfl_xor(ssq, 16); ssq += __shfl_xor(ssq, 32); if (kk == 0) ssqp[w * 64 + tt * 16 + i16] = ssq;
                }
            }
#pragma unroll 1
            for (int eh = 0; eh < 2; ++eh) {
                bf16x8 wh[2][4], wl_[2][4];
                {
                    const bf16_t* ph = (const bf16_t*)(F.ws + WS_SMALL + SM_WRH) + (size_t)(eh * 32 + i16) * DM + 128 * w + 8 * kk;
                    const bf16_t* pl = (const bf16_t*)(F.ws + WS_SMALL + SM_WRL) + (size_t)(eh * 32 + i16) * DM + 128 * w + 8 * kk;
#pragma unroll
                    for (int c = 0; c < 2; ++c)
#pragma unroll
                        for (int s4 = 0; s4 < 4; ++s4) { wh[c][s4] = *(const bf16x8*)(ph + (size_t)c * 16 * DM + 32 * s4); wl_[c][s4] = *(const bf16x8*)(pl + (size_t)c * 16 * DM + 32 * s4); }
                }
#pragma unroll
                for (int tt = 0; tt < 4; ++tt) {
                    f32x4 acc[2]; acc[0] = acc[1] = (f32x4){0.f, 0.f, 0.f, 0.f};
#pragma unroll
                    for (int s4 = 0; s4 < 4; ++s4)
#pragma unroll
                        for (int c = 0; c < 2; ++c) {
                            acc[c] = __builtin_amdgcn_mfma_f32_16x16x32_bf16(fal[tt][s4], wh[c][s4], acc[c], 0, 0, 0);
                            acc[c] = __builtin_amdgcn_mfma_f32_16x16x32_bf16(fah[tt][s4], wl_[c][s4], acc[c], 0, 0, 0);
                            acc[c] = __builtin_amdgcn_mfma_f32_16x16x32_bf16(fah[tt][s4], wh[c][s4], acc[c], 0, 0, 0); }
#pragma unroll
                    for (int c = 0; c < 2; ++c)
#pragma unroll
                        for (int reg = 0; reg < 4; ++reg) part[(w * 64 + tt * 16 + 4 * kk + reg) * 64 + eh * 32 + 16 * c + i16] = acc[c][reg];
                }
            }
        }
        __syncthreads();
        const int tl = F.tid >> 3, g = F.tid & 7;
        int my_e; float my_w; int my_rank;
        {
            float ssq = 0.f;
#pragma unroll
            for (int q = 0; q < 8; ++q) ssq += ssqp[q * 64 + tl];
            const float rstd = rsqrtf(ssq * (1.f / DM) + EPS);
            if (g == 0) rsl[tl] = rstd;
            float s8[8], c8[8];
            {
                f32x4 lo4 = (f32x4){0.f, 0.f, 0.f, 0.f}, hi4 = lo4;
#pragma unroll
                for (int q = 0; q < 8; ++q) { const LAS f32x4* pp = (const LAS f32x4*)(part + (q * 64 + tl) * 64 + 8 * g); lo4 += pp[0]; hi4 += pp[1]; }
                const f32x4 cb0 = *(const f32x4*)(cb + b * 64 + 8 * g), cb1 = *(const f32x4*)(cb + b * 64 + 8 * g + 4), rb0 = *(const f32x4*)(rbias + 8 * g), rb1 = *(const f32x4*)(rbias + 8 * g + 4);
#pragma unroll
                for (int j = 0; j < 4; ++j) { s8[j] = sigmoidf_(lo4[j] * rstd + cb0[j]); s8[4 + j] = sigmoidf_(hi4[j] * rstd + cb1[j]); c8[j] = s8[j] + rb0[j]; c8[4 + j] = s8[4 + j] + rb1[j]; }
            }
            float m1 = -INFINITY, m2 = -INFINITY;
#pragma unroll
            for (int j = 0; j < 8; ++j) { const float v = c8[j]; if (v > m1) { m2 = m1; m1 = v; } else if (v > m2) m2 = v; }
            const float gs = m1 + m2;
            int rank = 0;
#pragma unroll
            for (int g2 = 0; g2 < 8; ++g2) { const float o = __shfl(gs, g2, 8); rank += (o > gs || (o == gs && g2 < g)) ? 1 : 0; }
            if (rank >= 4) {
#pragma unroll
                for (int j = 0; j < 8; ++j) c8[j] = -INFINITY;
            }
            int sel_e[8]; float sk[8]; float wsum = 0.f;
#pragma unroll
            for (int k = 0; k < 8; ++k) {
                float bv = -INFINITY, bs = 0.f; int be = 8 * g;
#pragma unroll
                for (int j = 0; j < 8; ++j) if (c8[j] > bv) { bv = c8[j]; be = 8 * g + j; bs = s8[j]; }
#pragma unroll
                for (int o = 1; o < 8; o <<= 1) { const float ov = __shfl_xor(bv, o, 8), os = __shfl_xor(bs, o, 8); const int oe = __shfl_xor(be, o, 8); if (ov > bv || (ov == bv && oe < be)) { bv = ov; be = oe; bs = os; } }
                sel_e[k] = be; sk[k] = bs; wsum += bs;
#pragma unroll
                for (int j = 0; j < 8; ++j) if (be == 8 * g + j) c8[j] = -INFINITY;
            }
            my_e = sel_e[0]; my_w = sk[0];
#pragma unroll
            for (int k = 1; k < 8; ++k) if (g == k) { my_e = sel_e[k]; my_w = sk[k]; }
            my_w *= 2.5f / wsum;
            my_rank = lds_add(&lcnt[my_e], 1);
        }
        __syncthreads();
        if (F.tid < 64) { const int n = lcnt[F.tid]; lbase[F.tid] = n > 0 ? (int)atomicAdd(&cur[F.tid], (unsigned)n) : 0; }
        __syncthreads();
        { const int tok = tokb + tl, pos = lbase[my_e] + my_rank; tokl[my_e * RT + pos] = tok * 8 + g; wl[my_e * RT + pos] = my_w; tpos[(tok - rr * RT) * 8 + g] = (my_e << 16) | pos; }
#pragma unroll 1
        for (int r0 = 0; r0 < 8; r0 += 4) {
            f32x4 xv[4][4];
#pragma unroll
            for (int r = 0; r < 4; ++r) { const f32x4* xr = (const f32x4*)(x1 + (size_t)(tokb + w * 8 + r0 + r) * DM) + lane;
#pragma unroll
                for (int j = 0; j < 4; ++j) xv[r][j] = xr[64 * j]; }
#pragma unroll
            for (int j = 0; j < 4; ++j) { const int col = 4 * lane + 256 * j; const f32x4 gq = *(const f32x4*)(gvec + b * DM + col), sh = *(const f32x4*)(mod + b * NMOD + 3 * DM + col);
#pragma unroll
                for (int r = 0; r < 4; ++r) { const int tl2 = w * 8 + r0 + r; const f32x4 hv = (xv[r][j] * rsl[tl2]) * gq + sh;
                    u32x2 o; o.x = cvtpk(hv.x, hv.y); o.y = cvtpk(hv.z, hv.w); ((u32x2*)(H2 + (size_t)(tokb - rr * RT + tl2) * DM) + lane)[64 * j] = o; } }
        }
        __syncthreads();
    }
}
constexpr int MO_TE = 4224;
struct MoeTabs { const LAS unsigned short* te; const LAS int* tb; const LAS int* cnt; int TR; };
__device__ __forceinline__ MoeTabs build_moe_tabs(Ctx& F, int rr) {
    LAS unsigned short* te = (LAS unsigned short*)(F.lds + MISC_OFF + MO_TE); LAS int* tb = (LAS int*)(F.lds + MISC_OFF + MO_TE + 1536); LAS int* cnt = tb + 72;
    const unsigned* cur = (const unsigned*)(F.ws + WS_CTL) + CW_MOECUR + rr * 64;
    __syncthreads();
    if (F.tid == 0) { int acc = 0; for (int e = 0; e < 64; ++e) { const int c = (int)cur[e]; cnt[e] = c; tb[e] = acc; acc += (c + 255) >> 8; } tb[64] = acc; tb[65] = acc + RT / 256; cnt[64] = RT; }
    __syncthreads();
    const int TR = tb[64];
    for (int e = F.tid >> 3; e < 65; e += 64) for (int t = tb[e] + (F.tid & 7); t < tb[e + 1]; t += 8) te[t] = (unsigned short)e;
    __syncthreads();
    MoeTabs T; T.te = te; T.tb = tb; T.cnt = cnt; T.TR = TR; return T;
}
struct Moe1Sched {
    const char* H2; const char* W1T; const int* tokl; MoeTabs T; int G, c, rr; int R[2], C[2];
    __device__ __forceinline__ bool next(int i, gm::UnitD& u) {
        const int uu = i * G + c; const int nt = T.TR + RT / 256;
        if (uu >= nt * 2) return false;
        const int tile = uu >> 1, pn = uu & 1, e = T.te[tile], rt = tile - T.tb[e], cnt = T.cnt[e];
        u.a = H2; u.b = W1T + (size_t)(e * 512 + pn * 256) * 1024 * 2;
#pragma unroll
        for (int h = 0; h < 2; ++h)
#pragma unroll
            for (int j = 0; j < 2; ++j) { const int idx = rt * 256 + h * 128 + R[j]; int trow;
                if (e < 64) { const int ent = tokl[e * RT + (idx < cnt ? idx : rt * 256)]; trow = (ent >> 3) - rr * RT; } else trow = idx;
                u.va[h][j] = (unsigned)(trow * 1024 + C[j]) * 2u; }
        u.e0 = tile; u.e1 = pn; u.e2 = e; u.e3 = rt; return true;
    }
};
struct EpiMoe1 {
    bf16_t* act; const float* wl; const LAS int* cnt;
    __device__ __forceinline__ void operator()(const f32x4 (&acc)[2][2][4][2], const gm::UnitD& u, int wr, int wc, int fr, int fq) const {
        const int row0 = u.e0 * 256 + wr * 64 + fr, col0 = u.e1 * 128 + wc * 32 + 8 * fq, e = u.e2, n = cnt[e];
        float rw[2][4];
#pragma unroll
        for (int ai = 0; ai < 2; ++ai)
#pragma unroll
            for (int m = 0; m < 4; ++m) { const int idx = u.e3 * 256 + ai * 128 + wr * 64 + m * 16 + fr; rw[ai][m] = e < 64 ? (idx < n ? wl[e * RT + idx] : 0.f) : 1.f; }
#pragma unroll
        for (int ai = 0; ai < 2; ++ai)
#pragma unroll
            for (int m = 0; m < 4; ++m) { const float ww = rw[ai][m]; const f32x4 g0 = acc[ai][0][m][0], g1 = acc[ai][0][m][1], u0 = acc[ai][1][m][0] * ww, u1 = acc[ai][1][m][1] * ww;
                u32x4 w; w.x = cvtpk(siluf_(g0[0]) * u0[0], siluf_(g0[1]) * u0[1]); w.y = cvtpk(siluf_(g0[2]) * u0[2], siluf_(g0[3]) * u0[3]);
                w.z = cvtpk(siluf_(g1[0]) * u1[0], siluf_(g1[1]) * u1[1]); w.w = cvtpk(siluf_(g1[2]) * u1[2], siluf_(g1[3]) * u1[3]);
                *(u32x4*)(act + (size_t)(row0 + ai * 128 + m * 16) * 256 + col0) = w; }
    }
};
__device__ __forceinline__ void phase_moe1(Ctx& F, int rr) {
    Moe1Sched S; S.T = build_moe_tabs(F, rr); S.H2 = (const char*)(F.ws + WS_H2); S.W1T = (const char*)(F.ws + WS_W1T); S.tokl = (const int*)(F.ws + WS_TOKL); S.G = F.G; S.c = F.bid; S.rr = rr; gm::stage_geom(F.tid, S.R, S.C);
    EpiMoe1 E{(bf16_t*)(F.ws + WS_ACT), (const float*)(F.ws + WS_WL), S.T.cnt};
    gm::gemm_phase<true>(F.lds, 1024, S, E);
}
struct Moe2Sched {
    const char* ACT; const char* W2T; MoeTabs T; int G, c; int R[2], C[2];
    __device__ __forceinline__ bool next(int i, gm::UnitD& u) {
        const int uu = i * G + c; const int nt = T.TR + RT / 256;
        if (uu >= nt * 4) return false;
        const int tile = uu >> 2, pn = uu & 3, e = T.te[tile], rt = tile - T.tb[e];
        u.a = ACT + (size_t)tile * 256 * 256 * 2; u.b = W2T + (size_t)(e * 1024 + pn * 256) * 256 * 2;
#pragma unroll
        for (int h = 0; h < 2; ++h)
#pragma unroll
            for (int j = 0; j < 2; ++j) u.va[h][j] = (unsigned)((h * 128 + R[j]) * 256 + C[j]) * 2u;
        u.e0 = pn; u.e1 = e; u.e2 = rt; u.e3 = tile; return true;
    }
};
struct EpiMoe2 {
    bf16_t* slots; bf16_t* shout; const LAS int* cnt;
    __device__ __forceinline__ void operator()(const f32x4 (&acc)[2][2][4][2], const gm::UnitD& u, int wr, int wc, int fr, int fq) const {
        const int pn = u.e0, e = u.e1, rt = u.e2, tile = u.e3;
        const int col0 = pn * 256 + wc * 32 + 8 * fq, n = cnt[e];
        bf16_t* base = (e < 64 ? slots + (size_t)(tile * 256) * 1024 : shout + (size_t)(rt * 256) * 1024) + (size_t)(wr * 64 + fr) * 1024 + col0;
#pragma unroll
        for (int ai = 0; ai < 2; ++ai)
#pragma unroll
            for (int m = 0; m < 4; ++m) {
                if (rt * 256 + ai * 128 + wr * 64 + m * 16 + fr < n) {
#pragma unroll
                    for (int bj = 0; bj < 2; ++bj) { const f32x4 v0 = acc[ai][bj][m][0], v1 = acc[ai][bj][m][1];
                        u32x4 o; o.x = cvtpk(v0[0], v0[1]); o.y = cvtpk(v0[2], v0[3]); o.z = cvtpk(v1[0], v1[1]); o.w = cvtpk(v1[2], v1[3]); *(u32x4*)(base + (size_t)(ai * 128 + m * 16) * 1024 + bj * 128) = o; } } }
    }
};
__device__ __forceinline__ void phase_moe2(Ctx& F, int rr) {
    Moe2Sched S; S.T = build_moe_tabs(F, rr); S.ACT = (const char*)(F.ws + WS_ACT); S.W2T = (const char*)(F.ws + WS_W2T); S.G = F.G; S.c = F.bid; gm::stage_geom(F.tid, S.R, S.C);
    EpiMoe2 E{(bf16_t*)(F.ws + WS_SLOTS), (bf16_t*)(F.ws + WS_H2), S.T.cnt};
    gm::gemm_phase<true>(F.lds, 256, S, E);
}
__device__ __forceinline__ void phase_final(Ctx& F, int rr) {
    const MoeTabs T = build_moe_tabs(F, rr);
    const float* mod = (const float*)(F.ws + WS_SMALL + SM_MOD); const float* fg = inp(F, I_FG);
    const bf16_t* slots = (const bf16_t*)(F.ws + WS_SLOTS); const int* tpos = (const int*)(F.ws + WS_TPOS);
    const int gw = F.bid * 8 + F.wave, NGW = F.G * 8, c0 = F.lane * 8;
    for (int t = gw; t < RT; t += NGW) {
        const int tok = rr * RT + t, b = tok / SEQ;
        const bf16_t* rp[8];
#pragma unroll
        for (int k = 0; k < 8; ++k) { const int v = tpos[t * 8 + k]; rp[k] = slots + (size_t)(T.tb[v >> 16] * 256 + (v & 0xffff)) * 1024 + c0; }
        float* orow = F.out + (size_t)tok * DM + c0;
        u32x4 sv[9][2]; f32x4 xv[2][2];
#pragma unroll
        for (int k = 0; k < 8; ++k) { sv[k][0] = *(const u32x4*)(rp[k]); sv[k][1] = *(const u32x4*)(rp[k] + 512); }
        { const bf16_t* sp = (const bf16_t*)(F.ws + WS_H2) + (size_t)t * 1024 + c0; sv[8][0] = *(const u32x4*)sp; sv[8][1] = *(const u32x4*)(sp + 512); }
#pragma unroll
        for (int h = 0; h < 2; ++h) { xv[h][0] = *(const f32x4*)(orow + h * 512); xv[h][1] = *(const f32x4*)(orow + h * 512 + 4); }
        float s = 0.f; f32x4 v[2][2];
#pragma unroll
        for (int h = 0; h < 2; ++h) {
            f32x4 a0 = (f32x4){0.f, 0.f, 0.f, 0.f}, a1 = a0;
#pragma unroll
            for (int k = 0; k < 9; ++k) { const u32x4 w = sv[k][h]; a0 += (f32x4){bflo(w.x), bfhi(w.x), bflo(w.y), bfhi(w.y)}; a1 += (f32x4){bflo(w.z), bfhi(w.z), bflo(w.w), bfhi(w.w)}; }
            const float* g2 = mod + b * NMOD + 5 * DM + c0 + h * 512;
            v[h][0] = xv[h][0] + *(const f32x4*)g2 * a0; v[h][1] = xv[h][1] + *(const f32x4*)(g2 + 4) * a1;
#pragma unroll
            for (int q = 0; q < 2; ++q) s += (v[h][q].x * v[h][q].x + v[h][q].y * v[h][q].y) + (v[h][q].z * v[h][q].z + v[h][q].w * v[h][q].w);
        }
        const float rstd = rsqrtf(wave_sum(s) * (1.f / DM) + EPS);
#pragma unroll
        for (int h = 0; h < 2; ++h)
#pragma unroll
            for (int q = 0; q < 2; ++q) { const f32x4 g = *(const f32x4*)(fg + c0 + h * 512 + 4 * q); *(f32x4*)(orow + h * 512 + 4 * q) = (v[h][q] * rstd) * g; }
    }
}

constexpr int N_PHASES = 17;
__global__ void __launch_bounds__(512, 2) mega_fwd(Args args) {
    extern __shared__ __attribute__((aligned(16))) unsigned char lds_raw[];
    Ctx F; F.lds = (LAS unsigned char*)lds_raw; F.ws = args.ws; F.out = args.out;
    {
        typedef __attribute__((address_space(4))) const unsigned long long* karg_t;
        const karg_t ka = (karg_t)__builtin_amdgcn_kernarg_segment_ptr();
        LAS unsigned long long* tab = (LAS unsigned long long*)(lds_raw + MISC_OFF + 14336);
        if (threadIdx.x < 20) tab[threadIdx.x] = ka[threadIdx.x];
        F.intab = tab;
    }
    F.tid = threadIdx.x; F.lane = F.tid & 63; F.wave = __builtin_amdgcn_readfirstlane(F.tid >> 6); F.G = gridDim.x; F.bid = blockIdx.x;
    volatile LAS unsigned* st = (volatile LAS unsigned*)(F.lds + MISC_OFF + MO_ST);
    if (F.tid < 4) st[F.tid] = 0u;
    __syncthreads();
    XcdBarrier bar = xcd_barrier_post((unsigned*)(F.ws + WS_CTL) + CW_BAR, st);
    if (threadIdx.x == 0) { unsigned nloc, nx; xcd_barrier_complete(bar.bar, bar.x, nloc, nx); st[0] = nloc; st[1] = nx; }
    int lo = args.ph_lo, hi = args.ph_hi;
    { int a = lo, b = hi; asm volatile("" : "+v"(a), "+v"(b)); lo = __builtin_amdgcn_readfirstlane(a); hi = __builtin_amdgcn_readfirstlane(b); }
    launder(F);
#ifndef PH_MASK
#define PH_MASK 0x1ffff
#endif
#define PH_ON(k) ((PH_MASK >> (k)) & 1)
#define IN(k) (lo <= (k) && (k) < hi)
#define SEAM(k) do { if (IN(k) && IN((k) + 1)) { bar.bar = launder_ptr(bar.bar); xcd_barrier(bar); } } while (0)
#define RUN(k, call) do { if (PH_ON(k) && IN(k)) { launder(F); call; } } while (0)
    RUN(0, phase0(F)); SEAM(0);
    RUN(1, phase1(F)); SEAM(1);
    RUN(2, phase2(F)); SEAM(2);
    RUN(3, phase3(F)); SEAM(3);
    RUN(4, phase4(F)); SEAM(4);
    RUN(5, phase5(F)); SEAM(5);
    RUN(6, phase6(F)); SEAM(6);
    RUN(7, phase7(F)); SEAM(7);
    RUN(8, phase8(F)); SEAM(8);
#pragma unroll 1
    for (int ph = (lo > 9 ? lo : 9); ph < hi; ++ph) {
        launder(F);
        const int rr = ph >= 13 ? 1 : 0, pq = ph >= 13 ? ph - 4 : ph;
        switch (pq) {
            case 9: if (PH_ON(9)) phase_n2r(F, rr); break;
            case 10: if (PH_ON(10)) phase_moe1(F, rr); break;
            case 11: if (PH_ON(11)) phase_moe2(F, rr); break;
            default: if (PH_ON(12)) phase_final(F, rr); break;
        }
        if (ph + 1 < hi) { bar.bar = launder_ptr(bar.bar); xcd_barrier(bar); }
    }
#undef IN
#undef SEAM
#undef RUN
}

#ifndef MK_SPLIT
#define MK_SPLIT 0
#endif
extern "C" void kernel_launch(void* const* d_in, const int* in_sizes, int n_in, void* d_out, int out_size, void* d_ws, size_t ws_size, hipStream_t stream) {
    static int grid = 0;
    if (grid == 0) {
        if (n_in != 20 || in_sizes[0] != MT * DM || out_size != MT * DM || ws_size < WS_END) { fprintf(stderr, "kernel_launch: unexpected shapes (n_in %d, in0 %d, out %d, ws %zu)\n", n_in, n_in > 0 ? in_sizes[0] : -1, out_size, ws_size); grid = -1; return; }
        int dev = 0, cus = 0;
        if (hipGetDevice(&dev) != hipSuccess || hipDeviceGetAttribute(&cus, hipDeviceAttributeMultiprocessorCount, dev) != hipSuccess) { grid = -1; return; }
        if (hipFuncSetAttribute((const void*)mega_fwd, hipFuncAttributeMaxDynamicSharedMemorySize, LDS_BYTES) != hipSuccess) { fprintf(stderr, "kernel_launch: hipFuncSetAttribute failed\n"); grid = -1; return; }
        int per_cu = 0;
        if (hipOccupancyMaxActiveBlocksPerMultiprocessor(&per_cu, (const void*)mega_fwd, 512, LDS_BYTES) != hipSuccess || per_cu < 1) fprintf(stderr, "kernel_launch: occupancy query reports %d\n", per_cu);
        (void)hipGetLastError();
        grid = cus;
    }
    if (grid < 0) return;
    (void)hipMemsetAsync((char*)d_ws + WS_CTL, 0, CTL_BYTES, stream);
    Args a{};
    for (int i = 0; i < 20; ++i) a.in[i] = (const float*)d_in[i];
    a.out = (float*)d_out; a.ws = (unsigned char*)d_ws;
#if MK_SPLIT
    for (int p = 0; p < N_PHASES; ++p) { a.ph_lo = p; a.ph_hi = p + 1; hipLaunchKernelGGL(mega_fwd, dim3(grid), dim3(512), LDS_BYTES, stream, a); }
#else
    a.ph_lo = 0; a.ph_hi = N_PHASES;
    hipLaunchKernelGGL(mega_fwd, dim3(grid), dim3(512), LDS_BYTES, stream, a);
#endif
}
```

```cpp
#include <hip/hip_runtime.h>
#include <cstdio>
#include <cstdint>

#define LAS __attribute__((address_space(3)))
#define GAS __attribute__((address_space(1)))
typedef unsigned short bf16_t;
typedef short bf16x8 __attribute__((ext_vector_type(8)));
typedef short s16x4 __attribute__((ext_vector_type(4)));
typedef float f32x4 __attribute__((ext_vector_type(4)));
typedef float f32x16 __attribute__((ext_vector_type(16)));
typedef float f32x2 __attribute__((ext_vector_type(2)));
typedef unsigned u32x4 __attribute__((ext_vector_type(4)));
typedef unsigned u32x2 __attribute__((ext_vector_type(2)));
typedef __bf16 bf16x2_t __attribute__((ext_vector_type(2)));

__device__ __forceinline__ unsigned cvtpk(float lo, float hi) { f32x2 v = {lo, hi}; bf16x2_t b = __builtin_convertvector(v, bf16x2_t); return __builtin_bit_cast(unsigned, b); }
__device__ __forceinline__ float bf2f(unsigned short u) { return __uint_as_float(((unsigned)u) << 16); }
__device__ __forceinline__ float bflo(unsigned u) { return __uint_as_float(u << 16); }
__device__ __forceinline__ float bfhi(unsigned u) { return __uint_as_float(u & 0xffff0000u); }

constexpr int NB = 4, SEQ = 8192, DM = 1024, MT = NB * SEQ;
constexpr int NHEAD = 8, HD = 64, QW = 1536;
constexpr int NE = 64, EFF = 256, NMOD = 6 * DM;
constexpr int RT = MT / 2;
constexpr float EPS = 1e-6f;
constexpr float LOG2E = 1.4426950408889634f;

constexpr size_t MiB = 1u << 20;
constexpr size_t WS_CTL = 0, CTL_BYTES = 1 * MiB;
constexpr size_t WS_SMALL = 1 * MiB;
constexpr size_t SM_MOD = 0, SM_GVEC = 98304, SM_CB = 114688, SM_KBAR = 131072, SM_WRH = 393216, SM_WRL = 524288;
constexpr size_t WS_W2T = 2 * MiB;
constexpr size_t WS_W1T = 35 * MiB;
constexpr size_t WS_WINT = 100 * MiB;
constexpr size_t WS_WBRT = 110 * MiB;
constexpr size_t WS_WOUTT = 112 * MiB;
constexpr size_t WS_H = 114 * MiB;
constexpr size_t WS_OB = 114 * MiB;
constexpr size_t WS_QSB = 178 * MiB;
constexpr size_t WS_PO = 178 * MiB;
constexpr size_t WS_QMB = 274 * MiB;
constexpr size_t WS_MERGED = 274 * MiB;
constexpr size_t WS_G = 370 * MiB;
constexpr size_t WS_LMB = 498 * MiB;
constexpr size_t WS_PLSE = 506 * MiB;
constexpr size_t WS_H2 = 100 * MiB;
constexpr size_t WS_TOKL = 132 * MiB;
constexpr size_t WS_WL = 136 * MiB;
constexpr size_t WS_ACT = 140 * MiB;
constexpr size_t WS_SLOTS = 220 * MiB;
constexpr size_t WS_TPOS = 508 * MiB;
constexpr size_t WS_END = 509 * MiB;
constexpr int CW_MBCUR = 0;
constexpr int CW_MOECUR = 1024;
constexpr int CW_BAR = 4096;

constexpr int RING_BYTES = 131072;
constexpr int MISC_OFF = RING_BYTES;
constexpr int LDS_BYTES = 163840;
constexpr int MO_STG = 16384;

#define XB_TMO      128
#define XB_XCNT(j)  (256  + 64 * (j))
#define XB_XSUB(j)  (1280 + 64 * (j))
#define XB_XGEN(j)  (2304 + 64 * (j))
#define XB_TOP      3328
#define XB_TOPGEN   3392
#define XCD_BAR_WORDS 3456
#define XB_SPIN_CAP (1u << 18)
__device__ __forceinline__ unsigned xb_ld(unsigned* p)              { return __hip_atomic_load(p, __ATOMIC_RELAXED, __HIP_MEMORY_SCOPE_AGENT); }
__device__ __forceinline__ unsigned xb_add(unsigned* p, unsigned v) { return __hip_atomic_fetch_add(p, v, __ATOMIC_RELAXED, __HIP_MEMORY_SCOPE_AGENT); }
__device__ __forceinline__ unsigned xb_xcc_id() { return (unsigned)__builtin_amdgcn_s_getreg((3 << 11) | 20) & 0xFu; }
#define XB_SPIN(cond, bar) do { unsigned _sp = 0; while (cond) { __builtin_amdgcn_s_sleep(1); \
    if ((++_sp & 255u) == 0u) { if (xb_ld(&(bar)[XB_TMO])) break; if (_sp > XB_SPIN_CAP) { atomicAdd(&(bar)[XB_TMO], 1u); break; } } } } while (0)
struct XcdBarrier { unsigned* bar; unsigned x; volatile LAS unsigned* st; };
__device__ __forceinline__ XcdBarrier xcd_barrier_post(unsigned* bar, volatile LAS unsigned* st) {
    XcdBarrier b; b.bar = bar; b.x = xb_xcc_id(); b.st = st;
    if (threadIdx.x == 0) (void)xb_add(&bar[XB_XCNT(b.x)], 1u);
    return b;
}
__device__ __forceinline__ void xcd_barrier_complete(unsigned* bar, unsigned x, unsigned& nloc, unsigned& nx) {
    const unsigned G = gridDim.x * gridDim.y * gridDim.z;
    unsigned sum, cnt, mine, sp = 0u;
    for (;;) {
        sum = 0u; cnt = 0u; mine = 0u;
#pragma unroll
        for (unsigned j = 0; j < 16; ++j) { const unsigned c = xb_ld(&bar[XB_XCNT(j)]); sum += c; cnt += (c > 0u) ? 1u : 0u; mine = (j == x) ? c : mine; }
        if (sum == G) break;
        __builtin_amdgcn_s_sleep(1);
        if ((++sp & 255u) == 0u) { if (xb_ld(&bar[XB_TMO])) break; if (sp > XB_SPIN_CAP) { atomicAdd(&bar[XB_TMO], 1u); break; } }
    }
    nloc = mine > 0u ? mine : 1u; nx = cnt > 0u ? cnt : 1u;
}
__device__ __forceinline__ void xcd_barrier(const XcdBarrier& b) {
    asm volatile("s_waitcnt vmcnt(0)" ::: "memory");
    __syncthreads();
    if (threadIdx.x == 0) {
        unsigned* bar = b.bar;
        __builtin_amdgcn_s_waitcnt(0);
        unsigned nloc = b.st[0], nx = b.st[1];
        const unsigned old = xb_add(&bar[XB_XSUB(b.x)], 1u);
        const unsigned gen = old / nloc;
        if (old + 1u == (gen + 1u) * nloc) {
            __builtin_amdgcn_fence(__ATOMIC_RELEASE, "agent");
            asm volatile("s_waitcnt vmcnt(0)" ::: "memory");
            const unsigned og = xb_add(&bar[XB_TOP], 1u);
            const unsigned tg = og / nx;
            if (og + 1u == (tg + 1u) * nx) xb_add(&bar[XB_TOPGEN], 1u);
            else XB_SPIN(xb_ld(&bar[XB_TOPGEN]) == tg, bar);
            __builtin_amdgcn_fence(__ATOMIC_ACQUIRE, "agent");
            xb_add(&bar[XB_XGEN(b.x)], 1u);
            asm volatile("s_waitcnt vmcnt(0)" ::: "memory");
        } else {
            XB_SPIN(xb_ld(&bar[XB_XGEN(b.x)]) == gen, bar);
            __builtin_amdgcn_fence(__ATOMIC_ACQUIRE, "agent");
            asm volatile("s_waitcnt vmcnt(0)" ::: "memory");
        }
    }
    __syncthreads();
}

namespace gm {
constexpr int BM = 256, BK = 64, HALF = 128, HTB = HALF * BK * 2, STAGE_BYTES = 8 * HTB, NXCD = 8, WGM = 8;
__host__ __device__ __forceinline__ int lds_byte(int r, int c) { const int st = (r >> 4) * 2 + (c >> 5), rr = r & 15, cc = c & 31, ob = rr * 64 + cc * 2; return st * 1024 + (ob ^ (((ob >> 9) & 1) << 5)); }
__host__ __device__ __forceinline__ void stage_rc(int b, int& R, int& C) { const int st = b / 1024, sb = b % 1024, swz = sb ^ (((sb >> 9) & 1) << 5); R = (st >> 1) * 16 + swz / 64; C = (st & 1) * 32 + (swz % 64) / 2; }
__host__ __device__ __forceinline__ int perm32(int rho) { const int n = rho >> 4, i = rho & 15; return 8 * (i >> 2) + 4 * n + (i & 3); }

struct UnitD { const char* a; const char* b; unsigned va[2][2]; int e0, e1, e2, e3; };

__device__ __forceinline__ bool static_tile(int M, int N, int G, int c, int i, int& pm, int& pn) {
    const int nM = M / BM, nN = N / BM, nwg = nM * nN;
    const long L = (long)i * G + c; if (L >= nwg) return false;
    int wgid = (int)L; { const int q = nwg / NXCD, r = nwg % NXCD, xcd = wgid % NXCD, off = wgid / NXCD; wgid = (xcd < r ? xcd * (q + 1) : r * (q + 1) + (xcd - r) * q) + off; }
    const int nig = WGM * nN, gid = wgid / nig, fm = gid * WGM, gsz = (nM - fm) < WGM ? (nM - fm) : WGM;
    pm = fm + ((wgid % nig) % gsz); pn = (wgid % nig) / gsz; return true;
}

template <bool PERM, bool HOOK = false, class Epi, class Sched>
__device__ __forceinline__ void gemm_phase(LAS unsigned char* lds, const int K, Sched& S, const Epi& E) {
    const int tid = threadIdx.x, wid = __builtin_amdgcn_readfirstlane(tid >> 6), lane = tid & 63, wr = wid >> 2, wc = wid & 3, fr = lane & 15, fq = lane >> 4;
    const int nt = K / BK;
    unsigned voffB[2];
#pragma unroll
    for (int i = 0; i < 2; ++i) { int R, C; stage_rc(tid * 16 + i * 8192, R, C); const int Rb = PERM ? ((R & ~31) + perm32(R & 31)) : R; voffB[i] = (unsigned)(Rb * K + C) * 2u; }
    const size_t kstep = (size_t)(BK * 2);
    const size_t hstep = (size_t)HALF * K * 2;
    const unsigned ldsw = (unsigned)wid * 1024u;
    const int aoff = lds_byte(wr * 64 + fr, fq * 8), boff = lds_byte(wc * 32 + fr, fq * 8);
#define GM_SA(b, h) (((b) * 2 + (h)) * HTB)
#define GM_SB(b, h) ((4 + (b) * 2 + (h)) * HTB)
#define GM_STAGE_A(bufoff, U, h, kb) do { _Pragma("unroll") for (int _i = 0; _i < 2; ++_i) \
        __builtin_amdgcn_global_load_lds((const unsigned*)((U).a + (kb) + (U).va[h][_i]), (LAS unsigned*)(lds + (bufoff) + ldsw + _i * 8192), 16, 0, 0); } while (0)
#define GM_STAGE_B(bufoff, U, h, kb) do { _Pragma("unroll") for (int _i = 0; _i < 2; ++_i) \
        __builtin_amdgcn_global_load_lds((const unsigned*)((U).b + (kb) + (size_t)(h) * hstep + voffB[_i]), (LAS unsigned*)(lds + (bufoff) + ldsw + _i * 8192), 16, 0, 0); } while (0)
#define GM_LDA(dst, b, h) do { _Pragma("unroll") for (int m = 0; m < 4; ++m) _Pragma("unroll") for (int k = 0; k < 2; ++k) dst[m][k] = *(const LAS bf16x8*)(lds + GM_SA(b, h) + aoff + m * 2048 + k * 1024); } while (0)
#define GM_LDB(dst, b, h) do { _Pragma("unroll") for (int n = 0; n < 2; ++n) _Pragma("unroll") for (int k = 0; k < 2; ++k) dst[n][k] = *(const LAS bf16x8*)(lds + GM_SB(b, h) + boff + n * 2048 + k * 1024); } while (0)
#define GM_MMA(ai, bj, At, Bt) do { __builtin_amdgcn_s_setprio(1); _Pragma("unroll") for (int m = 0; m < 4; ++m) _Pragma("unroll") for (int n = 0; n < 2; ++n) _Pragma("unroll") for (int k = 0; k < 2; ++k) \
        acc[ai][bj][m][n] = __builtin_amdgcn_mfma_f32_16x16x32_bf16(Bt[n][k], At[m][k], acc[ai][bj][m][n], 0, 0, 0); __builtin_amdgcn_s_setprio(0); } while (0)
#define GM_WAIT_V(n) asm volatile("s_waitcnt vmcnt(" #n ")" ::: "memory")
#define GM_WAIT_L(n) asm volatile("s_waitcnt lgkmcnt(" #n ")" ::: "memory")
#define GM_BAR __builtin_amdgcn_s_barrier()
#define GM_SCHED __builtin_amdgcn_sched_barrier(0)
    UnitD cur, nxt; int ui = 0;
    if (!S.next(0, cur)) return;
    f32x4 acc[2][2][4][2];
#pragma unroll
    for (int a = 0; a < 2; ++a)
#pragma unroll
        for (int b = 0; b < 2; ++b)
#pragma unroll
            for (int m = 0; m < 4; ++m)
#pragma unroll
                for (int n = 0; n < 2; ++n) acc[a][b][m][n] = (f32x4){0.f, 0.f, 0.f, 0.f};
    bf16x8 At[4][2], B0[2][2], B1[2][2];
    GM_STAGE_B(GM_SB(0, 0), cur, 0, 0); GM_STAGE_B(GM_SB(0, 1), cur, 1, 0); GM_STAGE_A(GM_SA(0, 0), cur, 0, 0); GM_STAGE_A(GM_SA(0, 1), cur, 1, 0);
    if (wr == 1) GM_BAR;
    GM_WAIT_V(2); GM_BAR;
    GM_STAGE_B(GM_SB(1, 0), cur, 0, kstep); GM_STAGE_A(GM_SA(1, 0), cur, 0, kstep); GM_STAGE_B(GM_SB(1, 1), cur, 1, kstep);
    GM_WAIT_V(6); GM_BAR;
    for (;;) {
        const bool has_next = S.next(ui + 1, nxt);
        if (!has_next) nxt = cur;
#pragma unroll 1
        for (int t = 0; t < nt; t += 2) {
            const bool last = (t == nt - 2);
            if constexpr (HOOK) { if (t == nt / 2) E.mid(acc, cur, wr, wc, fr, fq); }
            const size_t k1 = (size_t)(t + 1) * kstep;
            UnitD U2 = cur; size_t k2 = (size_t)(t + 2) * kstep;
            if (last) { U2 = nxt; k2 = 0; }
            const size_t k3 = k2 + kstep;
            GM_LDB(B0, 0, 0); GM_LDB(B1, 0, 1); GM_SCHED; GM_LDA(At, 0, 0); GM_STAGE_A(GM_SA(1, 1), cur, 1, k1);
            GM_WAIT_V(8); GM_WAIT_L(0); GM_BAR; GM_MMA(0, 0, At, B0); GM_MMA(0, 1, At, B1); GM_BAR; GM_SCHED;
            GM_LDA(At, 0, 1); GM_STAGE_B(GM_SB(0, 0), U2, 0, k2); GM_STAGE_B(GM_SB(0, 1), U2, 1, k2); GM_STAGE_A(GM_SA(0, 0), U2, 0, k2);
            GM_WAIT_V(8); GM_WAIT_L(0); GM_BAR; GM_MMA(1, 0, At, B0); GM_MMA(1, 1, At, B1); GM_BAR; GM_SCHED;
            GM_LDB(B0, 1, 0); GM_LDB(B1, 1, 1); GM_SCHED; GM_LDA(At, 1, 0); GM_STAGE_A(GM_SA(0, 1), U2, 1, k2);
            GM_WAIT_V(8); GM_WAIT_L(0); GM_BAR; GM_MMA(0, 0, At, B0); GM_MMA(0, 1, At, B1); GM_BAR; GM_SCHED;
            GM_LDA(At, 1, 1); GM_STAGE_B(GM_SB(1, 0), U2, 0, k3); GM_STAGE_B(GM_SB(1, 1), U2, 1, k3); GM_STAGE_A(GM_SA(1, 0), U2, 0, k3);
            GM_WAIT_V(8); GM_WAIT_L(0); GM_BAR; GM_MMA(1, 0, At, B0); GM_MMA(1, 1, At, B1); GM_BAR; GM_SCHED;
        }
        if (wr == 0) GM_BAR;
        E(acc, cur, wr, wc, fr, fq);
        if (!has_next) break;
#pragma unroll
        for (int a = 0; a < 2; ++a)
#pragma unroll
            for (int b = 0; b < 2; ++b)
#pragma unroll
                for (int m = 0; m < 4; ++m)
#pragma unroll
                    for (int n = 0; n < 2; ++n) acc[a][b][m][n] = (f32x4){0.f, 0.f, 0.f, 0.f};
        cur = nxt; ++ui;
        if (wr == 1) GM_BAR;
    }
    GM_WAIT_V(0);
    GM_BAR;
#undef GM_SA
#undef GM_SB
#undef GM_STAGE_A
#undef GM_STAGE_B
#undef GM_LDA
#undef GM_LDB
#undef GM_MMA
#undef GM_WAIT_V
#undef GM_WAIT_L
#undef GM_BAR
#undef GM_SCHED
}
__device__ __forceinline__ void stage_geom(int tid, int (&R)[2], int (&C)[2]) {
#pragma unroll
    for (int i = 0; i < 2; ++i) stage_rc(tid * 16 + i * 8192, R[i], C[i]);
}
}

struct Args { const float* in[20]; float* out; unsigned char* ws; int ph_lo, ph_hi; };
struct Ctx {
    LAS unsigned char* lds;
    unsigned char* ws;
    const LAS unsigned long long* intab;
    float* out;
    int tid, lane, wave, G, bid;
};
#define LDS_WAIT() asm volatile("s_waitcnt lgkmcnt(0)" ::: "memory")
__device__ __forceinline__ const float* inp(const Ctx& F, int i) {
    const unsigned long long v = F.intab[i];
    const unsigned lo = __builtin_amdgcn_readfirstlane((unsigned)v), hi = __builtin_amdgcn_readfirstlane((unsigned)(v >> 32));
    return (const float*)(GAS const float*)(((unsigned long long)hi << 32) | lo);
}
template <class P> __device__ __forceinline__ P launder_ptr(P p) {
    unsigned long long v = (unsigned long long)p; unsigned lo = (unsigned)v, hi = (unsigned)(v >> 32);
    asm volatile("" : "+v"(lo), "+v"(hi));
    lo = __builtin_amdgcn_readfirstlane(lo); hi = __builtin_amdgcn_readfirstlane(hi);
    return (P)(GAS unsigned char*)(((unsigned long long)hi << 32) | lo);
}
__device__ __forceinline__ void launder(Ctx& F) {
    int t = F.tid, g = F.G, bid = F.bid;
    asm volatile("" : "+v"(t), "+v"(g), "+v"(bid));
    F.tid = t; F.G = __builtin_amdgcn_readfirstlane(g); F.bid = __builtin_amdgcn_readfirstlane(bid); F.lane = t & 63; F.wave = __builtin_amdgcn_readfirstlane(t >> 6);
    F.ws = launder_ptr(F.ws); F.out = launder_ptr(F.out);
}
__device__ __forceinline__ float wave_sum(float v) {
#pragma unroll
    for (int o = 1; o < 64; o <<= 1) v += __shfl_xor(v, o);
    return v;
}
__device__ __forceinline__ int lds_add(LAS int* p, int v) { return __hip_atomic_fetch_add(p, v, __ATOMIC_RELAXED, __HIP_MEMORY_SCOPE_WORKGROUP); }
__device__ __forceinline__ float sigmoidf_(float x) { return 1.f / (1.f + __expf(-x)); }
__device__ __forceinline__ float siluf_(float x) { return x / (1.f + __expf(-x)); }

enum { I_X = 0, I_C, I_N1G, I_N2G, I_WADA, I_BADA, I_WIN, I_WBSB, I_WBMB, I_WOUT, I_WR, I_RB, I_WGE, I_WUE, I_WDE, I_WGS, I_WUS, I_WDS, I_RELB, I_FG };

__device__ __forceinline__ void transpose_item(const float* W, int ldn, int k0, int n0, bf16_t* WT, int Kdst, int drow0, LAS float* scr, int lane) {
    const float* wp = W + (size_t)(k0 + (lane >> 3)) * ldn + n0 + 4 * (lane & 7);
    f32x4 v[8];
#pragma unroll
    for (int i = 0; i < 8; ++i) v[i] = *(const f32x4*)(wp + (size_t)(8 * i) * ldn);
#pragma unroll
    for (int i = 0; i < 8; ++i) { LAS float* d = scr + (8 * i + (lane >> 3)) * 33 + 4 * (lane & 7); d[0] = v[i].x; d[1] = v[i].y; d[2] = v[i].z; d[3] = v[i].w; }
    LDS_WAIT(); asm volatile("" ::: "memory");
    const int c = lane & 7;
#pragma unroll
    for (int j = 0; j < 4; ++j) { const int n = (lane >> 3) + 8 * j; const LAS float* s = scr + (8 * c) * 33 + n;
        u32x4 o; o.x = cvtpk(s[0 * 33], s[1 * 33]); o.y = cvtpk(s[2 * 33], s[3 * 33]); o.z = cvtpk(s[4 * 33], s[5 * 33]); o.w = cvtpk(s[6 * 33], s[7 * 33]);
        *(u32x4*)(WT + (size_t)(drow0 + n) * Kdst + k0 + 8 * c) = o; }
    LDS_WAIT(); asm volatile("" ::: "memory");
}
__device__ __forceinline__ void phase0(Ctx& F) {
    LAS float* silc = (LAS float*)(F.lds + MISC_OFF - 0);
    silc = (LAS float*)(F.lds + 0);
    for (int i = F.tid; i < 4 * DM; i += 512) silc[i] = siluf_(inp(F, I_C)[i]);
    __syncthreads();
    float* mod = (float*)(F.ws + WS_SMALL + SM_MOD);
    {
        const int gw = F.wave * F.G + F.bid;
        const int c = F.lane & 15, kp = F.lane >> 4;
        const float* wada = inp(F, I_WADA);
        for (int item = gw; item < NMOD / 16; item += 8 * F.G) {
            const int col = item * 16 + c;
            float a0 = 0.f, a1 = 0.f, a2 = 0.f, a3 = 0.f;
#pragma unroll 32
            for (int k = kp; k < DM; k += 4) { const float w = wada[(size_t)k * NMOD + col]; a0 += silc[k] * w; a1 += silc[DM + k] * w; a2 += silc[2 * DM + k] * w; a3 += silc[3 * DM + k] * w; }
            a0 += __shfl_xor(a0, 16); a0 += __shfl_xor(a0, 32); a1 += __shfl_xor(a1, 16); a1 += __shfl_xor(a1, 32);
            a2 += __shfl_xor(a2, 16); a2 += __shfl_xor(a2, 32); a3 += __shfl_xor(a3, 16); a3 += __shfl_xor(a3, 32);
            if (kp == 0) { const float bb = inp(F, I_BADA)[col]; mod[col] = a0 + bb; mod[NMOD + col] = a1 + bb; mod[2 * NMOD + col] = a2 + bb; mod[3 * NMOD + col] = a3 + bb; }
        }
    }
    __syncthreads();
    {
        LAS float* scr = (LAS float*)(F.lds + F.wave * 16384);
        const int gw = F.bid * 8 + F.wave, NGW = F.G * 8, lane = F.lane;
        constexpr int I_IN = 16 * 160, I_BR = 8 * 32, I_OUT = 16 * 32, I_EXP = 384, NIT = I_IN + 2 * I_BR + I_OUT + 65 * I_EXP;
        const float* p_win = inp(F, I_WIN); const float* p_bsb = inp(F, I_WBSB); const float* p_bmb = inp(F, I_WBMB); const float* p_out = inp(F, I_WOUT);
        const float* p_ge = inp(F, I_WGE); const float* p_ue = inp(F, I_WUE); const float* p_de = inp(F, I_WDE); const float* p_gs = inp(F, I_WGS); const float* p_us = inp(F, I_WUS); const float* p_ds = inp(F, I_WDS);
#define TD_GET(IT, SRC, LDN, DST, KD) do { int r = (IT); \
            if (r < I_IN) { const int kb = r / 160, nb = r % 160; SRC = p_win + (size_t)(kb * 64) * 5120 + nb * 32; LDN = 5120; DST = (bf16_t*)(F.ws + WS_WINT) + (size_t)(nb * 32) * 1024 + kb * 64; KD = 1024; } \
            else if ((r -= I_IN) < I_BR) { const int kb = r / 32, nb = r % 32; SRC = p_bsb + (size_t)(kb * 64) * 1024 + nb * 32; LDN = 1024; DST = (bf16_t*)(F.ws + WS_WBRT) + (size_t)(nb * 32) * 1024 + kb * 64; KD = 1024; } \
            else if ((r -= I_BR) < I_BR) { const int kb = r / 32, nb = r % 32; SRC = p_bmb + (size_t)(kb * 64) * 1024 + nb * 32; LDN = 1024; DST = (bf16_t*)(F.ws + WS_WBRT) + (size_t)(nb * 32) * 1024 + 512 + kb * 64; KD = 1024; } \
            else if ((r -= I_BR) < I_OUT) { const int kb = r / 32, nb = r % 32; SRC = p_out + (size_t)(kb * 64) * 1024 + nb * 32; LDN = 1024; DST = (bf16_t*)(F.ws + WS_WOUTT) + (size_t)(nb * 32) * 1024 + kb * 64; KD = 1024; } \
            else { r -= I_OUT; const int e = r / I_EXP; r -= e * I_EXP; \
                if (r < 128) { const int kb = r / 8, n0 = (r % 8) * 32; SRC = (e < NE ? p_ge + (size_t)e * DM * EFF : p_gs) + (size_t)(kb * 64) * EFF + n0; LDN = EFF; \
                    DST = (bf16_t*)(F.ws + WS_W1T) + ((size_t)e * 512 + (n0 >> 7) * 256 + (n0 & 127)) * 1024 + kb * 64; KD = 1024; } \
                else if (r < 256) { r -= 128; const int kb = r / 8, n0 = (r % 8) * 32; SRC = (e < NE ? p_ue + (size_t)e * DM * EFF : p_us) + (size_t)(kb * 64) * EFF + n0; LDN = EFF; \
                    DST = (bf16_t*)(F.ws + WS_W1T) + ((size_t)e * 512 + (n0 >> 7) * 256 + 128 + (n0 & 127)) * 1024 + kb * 64; KD = 1024; } \
                else { r -= 256; const int kb = r / 32, nb = r % 32; SRC = (e < NE ? p_de + (size_t)e * EFF * DM : p_ds) + (size_t)(kb * 64) * DM + nb * 32; LDN = DM; \
                    DST = (bf16_t*)(F.ws + WS_W2T) + ((size_t)e * 1024 + nb * 32) * 256 + kb * 64; KD = 256; } } } while (0)
#define TD_LOAD(V, SRC, LDN) do { const float* wp_ = (SRC) + (size_t)(lane >> 3) * (LDN) + 4 * (lane & 7); _Pragma("unroll") for (int i = 0; i < 8; ++i) V[i] = *(const f32x4*)(wp_ + (size_t)(8 * i) * (LDN)); } while (0)
        const float* src = nullptr; bf16_t* dst = nullptr; int ldn = 0, kd = 0;
        f32x4 v[8];
        int it = gw;
        if (it < NIT) { TD_GET(it, src, ldn, dst, kd); TD_LOAD(v, src, ldn); }
        for (; it < NIT; it += NGW) {
            const float* srcn = src; bf16_t* dstn = dst; int ldnn = ldn, kdn = kd;
            f32x4 vn[8];
            const bool has_next = it + NGW < NIT;
            if (has_next) { TD_GET(it + NGW, srcn, ldnn, dstn, kdn); TD_LOAD(vn, srcn, ldnn); }
#pragma unroll
            for (int i = 0; i < 8; ++i) { LAS float* d = scr + (8 * i + (lane >> 3)) * 33 + 4 * (lane & 7); d[0] = v[i].x; d[1] = v[i].y; d[2] = v[i].z; d[3] = v[i].w; }
            LDS_WAIT(); asm volatile("" ::: "memory");
            const int c = lane & 7;
#pragma unroll
            for (int j = 0; j < 4; ++j) { const int n = (lane >> 3) + 8 * j; const LAS float* sp = scr + (8 * c) * 33 + n;
                u32x4 o; o.x = cvtpk(sp[0 * 33], sp[1 * 33]); o.y = cvtpk(sp[2 * 33], sp[3 * 33]); o.z = cvtpk(sp[4 * 33], sp[5 * 33]); o.w = cvtpk(sp[6 * 33], sp[7 * 33]);
                *(u32x4*)(dst + (size_t)n * kd + 8 * c) = o; }
            LDS_WAIT(); asm volatile("" ::: "memory");
            if (has_next) {
#pragma unroll
                for (int i = 0; i < 8; ++i) v[i] = vn[i];
                src = srcn; dst = dstn; ldn = ldnn; kd = kdn; }
        }
#undef TD_GET
#undef TD_LOAD
    }
    {
        bf16_t* wrh = (bf16_t*)(F.ws + WS_SMALL + SM_WRH); bf16_t* wrl = (bf16_t*)(F.ws + WS_SMALL + SM_WRL);
        const float* wr = inp(F, I_WR);
        for (int i = F.bid * 512 + F.tid; i < NE * DM; i += F.G * 512) { const int e = i >> 10, k = i & 1023; const float v = wr[k * NE + e];
            const unsigned h = cvtpk(v, 0.f) & 0xffffu; wrh[i] = (bf16_t)h; wrl[i] = (bf16_t)(cvtpk(v - bflo(h), 0.f) & 0xffffu); }
    }
}

__device__ __forceinline__ void phase1(Ctx& F) {
    const float* mod = (const float*)(F.ws + WS_SMALL + SM_MOD);
    const float* x = inp(F, I_X); const float* g1 = inp(F, I_N1G);
    bf16_t* H = (bf16_t*)(F.ws + WS_H);
    const int gw = F.bid * 8 + F.wave, NGW = F.G * 8;
    if (gw < 256) {
        const int b = gw >> 6, e = gw & 63; const float* wr = inp(F, I_WR); float a = 0.f;
#pragma unroll 4
        for (int k = F.lane; k < DM; k += 64) a += mod[b * NMOD + 3 * DM + k] * wr[k * NE + e];
        a = wave_sum(a);
        if (F.lane == 0) ((float*)(F.ws + WS_SMALL + SM_CB))[gw] = a;
    }
    if (F.bid == 32) {
        float* gvec = (float*)(F.ws + WS_SMALL + SM_GVEC); const float* g2 = inp(F, I_N2G);
        for (int i = F.tid; i < 4 * DM; i += 512) { const int b = i >> 10, k = i & 1023; gvec[i] = g2[k] * (1.f + mod[b * NMOD + 4 * DM + k]); }
    }
    for (int m0 = gw; m0 < MT; m0 += 2 * NGW) {
        const int m1 = m0 + NGW;
        const bool two = m1 < MT;
        const f32x4* xr0 = (const f32x4*)(x + (size_t)m0 * DM) + F.lane; const f32x4* xr1 = (const f32x4*)(x + (size_t)(two ? m1 : m0) * DM) + F.lane;
        f32x4 v0[4], v1[4]; float s0 = 0.f, s1 = 0.f;
#pragma unroll
        for (int j = 0; j < 4; ++j) { v0[j] = xr0[64 * j]; v1[j] = xr1[64 * j]; }
#pragma unroll
        for (int j = 0; j < 4; ++j) { s0 += (v0[j].x * v0[j].x + v0[j].y * v0[j].y) + (v0[j].z * v0[j].z + v0[j].w * v0[j].w); s1 += (v1[j].x * v1[j].x + v1[j].y * v1[j].y) + (v1[j].z * v1[j].z + v1[j].w * v1[j].w); }
        const float r0 = rsqrtf(wave_sum(s0) * (1.f / DM) + EPS), r1 = rsqrtf(wave_sum(s1) * (1.f / DM) + EPS);
        const int b0 = m0 / SEQ, b1 = (two ? m1 : m0) / SEQ;
        u32x2* o0 = (u32x2*)(H + (size_t)m0 * DM) + F.lane; u32x2* o1 = (u32x2*)(H + (size_t)(two ? m1 : m0) * DM) + F.lane;
#pragma unroll
        for (int j = 0; j < 4; ++j) {
            const int col = 4 * F.lane + 256 * j;
            const f32x4 g = *(const f32x4*)(g1 + col);
            const f32x4 h0 = (v0[j] * r0) * g * (*(const f32x4*)(mod + b0 * NMOD + DM + col) + 1.0f) + *(const f32x4*)(mod + b0 * NMOD + col);
            const f32x4 h1 = (v1[j] * r1) * g * (*(const f32x4*)(mod + b1 * NMOD + DM + col) + 1.0f) + *(const f32x4*)(mod + b1 * NMOD + col);
            u32x2 w; w.x = cvtpk(h0.x, h0.y); w.y = cvtpk(h0.z, h0.w); o0[64 * j] = w;
            if (two) { w.x = cvtpk(h1.x, h1.y); w.y = cvtpk(h1.z, h1.w); o1[64 * j] = w; }
        }
    }
}

struct ProjSched {
    const char* A; const char* Bt; int G, c; int R[2], C[2];
    __device__ __forceinline__ bool next(int i, gm::UnitD& u) {
        int pm, pn; if (!gm::static_tile(MT, 5120, G, c, i, pm, pn)) return false;
        u.a = A; u.b = Bt + (size_t)pn * 256 * 1024 * 2;
#pragma unroll
        for (int h = 0; h < 2; ++h)
#pragma unroll
            for (int j = 0; j < 2; ++j) u.va[h][j] = (unsigned)((pm * 256 + h * 128 + R[j]) * 1024 + C[j]) * 2u;
        u.e0 = pm; u.e1 = pn; u.e2 = 0; u.e3 = 0; return true;
    }
};
struct EpiProj {
    bf16_t* qsb; bf16_t* qmb; bf16_t* g;
    __device__ __forceinline__ void operator()(const f32x4 (&acc)[2][2][4][2], const gm::UnitD& u, int wr, int wc, int fr, int fq) const {
        const int pm = u.e0, pn = u.e1;
        bf16_t* base; int ldc, colt; float sc = 1.f;
        if (pn < 6) { base = qsb; ldc = QW; colt = pn * 256; if (pn < 2) sc = 0.125f; }
        else if (pn < 12) { base = qmb; ldc = QW; colt = (pn - 6) * 256; if (pn < 8) sc = 0.125f; }
        else { base = g; ldc = 2048; colt = (pn - 12) * 256; }
        const int row0 = pm * 256 + wr * 64 + fr, col0 = colt + wc * 32 + 8 * fq;
#pragma unroll
        for (int ai = 0; ai < 2; ++ai)
#pragma unroll
            for (int m = 0; m < 4; ++m) { bf16_t* rowp = base + (size_t)(row0 + ai * 128 + m * 16) * ldc + col0;
#pragma unroll
                for (int bj = 0; bj < 2; ++bj) { const f32x4 v0 = acc[ai][bj][m][0] * sc, v1 = acc[ai][bj][m][1] * sc;
                    u32x4 w; w.x = cvtpk(v0[0], v0[1]); w.y = cvtpk(v0[2], v0[3]); w.z = cvtpk(v1[0], v1[1]); w.w = cvtpk(v1[2], v1[3]);
                    *(u32x4*)(rowp + bj * 128) = w; } }
    }
};
__device__ __forceinline__ void phase2(Ctx& F) {
    ProjSched S; S.A = (const char*)(F.ws + WS_H); S.Bt = (const char*)(F.ws + WS_WINT); S.G = F.G; S.c = F.bid; gm::stage_geom(F.tid, S.R, S.C);
    EpiProj E{(bf16_t*)(F.ws + WS_QSB), (bf16_t*)(F.ws + WS_QMB), (bf16_t*)(F.ws + WS_G)};
    gm::gemm_phase<true>(F.lds, 1024, S, E);
}

__device__ __forceinline__ int crow(int r, int hi) { return (r & 3) + 8 * (r >> 2) + 4 * hi; }
typedef short v4i16_t __attribute__((ext_vector_type(4)));
__device__ __forceinline__ s16x4 vtr(const LAS unsigned char* p) { return __builtin_bit_cast(s16x4, __builtin_amdgcn_ds_read_tr16_b64_v4i16((LAS v4i16_t*)p)); }
__device__ __forceinline__ void pv64(f32x16 (&o)[2], const LAS unsigned char* vt, int lane, const u32x4 (&pw)[4]) {
    const int hi = lane >> 5;
    const LAS unsigned char* vb = vt + ((lane >> 4) & 1) * 32 + (lane & 3) * 8 + (4 * hi + ((lane & 15) >> 2)) * 64;
#pragma unroll
    for (int d0 = 0; d0 < 2; ++d0)
#pragma unroll
        for (int ks = 0; ks < 4; ++ks) {
            const s16x4 lo = vtr(vb + d0 * 4096 + ks * 1024), hh = vtr(vb + d0 * 4096 + ks * 1024 + 512);
            const bf16x8 bv = (bf16x8){lo[0], lo[1], lo[2], lo[3], hh[0], hh[1], hh[2], hh[3]};
            o[d0] = __builtin_amdgcn_mfma_f32_32x32x16_bf16(__builtin_bit_cast(bf16x8, pw[ks]), bv, o[d0], 0, 0, 0);
        }
}
__device__ __forceinline__ void store_o_tile(const f32x16 (&o)[2], LAS unsigned char* stgb, int lane, bf16_t* dst0, size_t row_pitch) {
    const int r32 = lane & 31, hi = lane >> 5;
    LAS bf16_t* stg = (LAS bf16_t*)stgb;
#pragma unroll
    for (int r = 0; r < 16; ++r) { const int orow = crow(r, hi);
#pragma unroll
        for (int d0 = 0; d0 < 2; ++d0) stg[orow * 64 + d0 * 32 + r32] = (bf16_t)(cvtpk(o[d0][r], 0.f) & 0xffffu); }
    LDS_WAIT();
#pragma unroll
    for (int i = 0; i < 4; ++i) { const int row = i * 8 + (lane >> 3), ch = lane & 7; const u32x4 v = *(const LAS u32x4*)(stg + row * 64 + ch * 8); *(u32x4*)(dst0 + (size_t)row * row_pitch + ch * 8) = v; }
    LDS_WAIT();
}

template <bool MASKED>
__device__ __forceinline__ void sb_tile(const f32x16 (&z)[2], float& P, u32x4 (&pw)[4], int k0, int qpos, int hi) {
    f32x16 be[2], nb[2];
#pragma unroll
    for (int p = 0; p < 2; ++p)
#pragma unroll
        for (int r = 0; r < 16; ++r) {
            const float zz = __builtin_amdgcn_fmed3f(z[p][r] * LOG2E, -126.f, 126.f);
            const float t = __builtin_amdgcn_exp2f(-zz), b_ = __builtin_amdgcn_rcpf(1.f + t);
            float n_ = t * b_, bb = b_;
            if (MASKED) { const bool valid = (k0 + 32 * p + crow(r, hi)) < qpos; n_ = valid ? n_ : 1.f; bb = valid ? bb : 0.f; }
            be[p][r] = bb; nb[p][r] = n_;
        }
    float Gp[8], PG[8], off[8];
#pragma unroll
    for (int idx = 0; idx < 8; ++idx) { const int p = idx >> 2, g4 = (idx & 3) * 4; Gp[idx] = (nb[p][g4] * nb[p][g4 + 1]) * (nb[p][g4 + 2] * nb[p][g4 + 3]); }
#pragma unroll
    for (int idx = 0; idx < 8; ++idx) PG[idx] = __shfl_xor(Gp[idx], 32);
    float run = P;
#pragma unroll
    for (int idx = 7; idx >= 0; --idx) { off[idx] = hi ? run : run * PG[idx]; run *= (Gp[idx] * PG[idx]); }
    P = run;
#pragma unroll
    for (int idx = 0; idx < 8; ++idx) { const int p = idx >> 2, g4 = (idx & 3) * 4; float c = off[idx]; float a[4];
#pragma unroll
        for (int j = 3; j >= 0; --j) { a[j] = be[p][g4 + j] * c; c *= nb[p][g4 + j]; }
        pw[idx >> 1][(idx & 1) * 2] = cvtpk(a[0], a[1]); pw[idx >> 1][(idx & 1) * 2 + 1] = cvtpk(a[2], a[3]); }
}
__device__ __forceinline__ void sb_unit(Ctx& F, int bh, int qt, LAS unsigned char* vl) {
    const int lane = F.lane, r32 = lane & 31, hi = lane >> 5;
    const int b = bh >> 3, h = bh & 7, q0 = qt * 32, qpos = q0 + r32;
    const bf16_t* base = (const bf16_t*)(F.ws + WS_QSB) + (size_t)b * SEQ * QW + h * 64;
    const bf16_t* Kb = base + 512 + (size_t)r32 * QW + hi * 8; const bf16_t* Vb = base + 1024 + (size_t)(lane >> 2) * QW + (lane & 3) * 8;
    bf16x8 qr[4];
#pragma unroll
    for (int d0 = 0; d0 < 4; ++d0) qr[d0] = *(const bf16x8*)(base + (size_t)qpos * QW + d0 * 16 + hi * 8);
    float P = 1.f; f32x16 o[2]; o[0] = f32x16{}; o[1] = f32x16{};
    bf16x8 kfn[8];
    const int kt0 = q0 >> 6; int kt = kt0, cur = 0;
#define SB_PREFETCH(KT, BUF) do { const size_t ko_ = (size_t)(KT) * 64 * QW; \
        _Pragma("unroll") for (int d0 = 0; d0 < 4; ++d0) _Pragma("unroll") for (int hf = 0; hf < 2; ++hf) kfn[2 * d0 + hf] = *(const bf16x8*)(Kb + ko_ + (size_t)(32 * hf) * QW + d0 * 16); \
        _Pragma("unroll") for (int p = 0; p < 8; ++p) __builtin_amdgcn_global_load_lds((const unsigned*)(Vb + ko_ + (size_t)(16 * (p & 3)) * QW + (p >> 2) * 32), (LAS unsigned*)(vl + (BUF) * 8192 + p * 1024), 16, 0, 0); } while (0)
    SB_PREFETCH(kt, 0);
#pragma unroll 1
    for (; kt >= 0; --kt) {
        if (__all(P == 0.f)) break;
        f32x16 z[2]; z[0] = f32x16{}; z[1] = f32x16{};
#pragma unroll
        for (int d0 = 0; d0 < 4; ++d0) { z[0] = __builtin_amdgcn_mfma_f32_32x32x16_bf16(kfn[2 * d0], qr[d0], z[0], 0, 0, 0); z[1] = __builtin_amdgcn_mfma_f32_32x32x16_bf16(kfn[2 * d0 + 1], qr[d0], z[1], 0, 0, 0); }
        asm volatile("" : "+v"(z[0]), "+v"(z[1]));
        { const int ktn = kt > 0 ? kt - 1 : 0; SB_PREFETCH(ktn, cur ^ 1); }
        u32x4 pw[4];
        if (kt == kt0) sb_tile<true>(z, P, pw, kt * 64, qpos, hi); else sb_tile<false>(z, P, pw, kt * 64, qpos, hi);
        asm volatile("s_waitcnt vmcnt(16)" ::: "memory");
        pv64(o, vl + cur * 8192, lane, pw);
        cur ^= 1;
    }
#undef SB_PREFETCH
    asm volatile("s_waitcnt vmcnt(0)" ::: "memory");
    bf16_t* dst = (bf16_t*)(F.ws + WS_OB) + (size_t)(b * SEQ + q0) * 1024 + h * 64;
    store_o_tile(o, vl, lane, dst, 1024);
}
__device__ __forceinline__ void phase3(Ctx& F) {
    {
        float* kbar = (float*)(F.ws + WS_SMALL + SM_KBAR);
        const int gwk = F.wave * F.G + F.bid;
        for (int it = gwk; it < NB * 32 * 8; it += 8 * F.G) {
            const int u = it >> 3, hh = it & 7, rs = F.lane >> 3, ch = F.lane & 7;
            const bf16_t* kp = (const bf16_t*)(F.ws + WS_QMB) + (size_t)(u * 256 + rs) * QW + 512 + hh * 64 + ch * 8;
            float a[8];
#pragma unroll
            for (int j = 0; j < 8; ++j) a[j] = 0.f;
#pragma unroll 4
            for (int g = 0; g < 4; ++g) {
                u32x4 w[8];
#pragma unroll
                for (int i = 0; i < 8; ++i) w[i] = *(const u32x4*)(kp + (size_t)(g * 64 + i * 8) * QW);
#pragma unroll
                for (int i = 0; i < 8; ++i) { a[0] += bflo(w[i].x); a[1] += bfhi(w[i].x); a[2] += bflo(w[i].y); a[3] += bfhi(w[i].y); a[4] += bflo(w[i].z); a[5] += bfhi(w[i].z); a[6] += bflo(w[i].w); a[7] += bfhi(w[i].w); }
            }
#pragma unroll
            for (int j = 0; j < 8; ++j) { a[j] += __shfl_xor(a[j], 8); a[j] += __shfl_xor(a[j], 16); a[j] += __shfl_xor(a[j], 32); }
            if (rs == 0) { float* dst = kbar + u * 512 + hh * 64 + ch * 8;
                *(f32x4*)dst = (f32x4){a[0], a[1], a[2], a[3]} * (1.f / 256.f); *(f32x4*)(dst + 4) = (f32x4){a[4], a[5], a[6], a[7]} * (1.f / 256.f); }
        }
    }
    LAS unsigned char* vl = F.lds + F.wave * 16384;
    const int gw = F.bid * 8 + F.wave, NGW = F.G * 8;
    for (int u = gw; u < 32 * 256; u += NGW) sb_unit(F, u >> 8, u & 255, vl);
}

constexpr int MO_LUT = 0, MO_PRE = 4224, MO_WSF = 8320, MO_ENT = 12416, MO_ST = 16368;
__device__ __forceinline__ int mb_list_off(int j) { return 256 * (31 * j - (j * (j - 1)) / 2); }
constexpr int MB_LIST_STRIDE = 126976;
__device__ __forceinline__ int t5_bucket_dev(int n) {
    if (n < 16) return n;
    int large = 16 + (int)(logf((float)n / 16.f) / 2.0794415416798357f * 16.f);
    return large < 31 ? large : 31;
}
__device__ __forceinline__ void build_lut(Ctx& F) {
    LAS float* lut = (LAS float*)(F.lds + MISC_OFF + MO_LUT);
    for (int i = F.tid; i < 8 * 132; i += 512) { const int h = i / 132, d = i % 132; lut[i] = inp(F, I_RELB)[h * 32 + t5_bucket_dev(d < 128 ? d : 128)] * LOG2E; }
}
__device__ __forceinline__ void phase4(Ctx& F) {
    LAS float* kb = (LAS float*)(F.lds);
    LAS int* lcnt = (LAS int*)(F.lds + MISC_OFF + MO_PRE); LAS int* lbase = lcnt + 32;
    const float* kbar = (const float*)(F.ws + WS_SMALL + SM_KBAR);
    unsigned* cur = (unsigned*)(F.ws + WS_CTL) + CW_MBCUR;
    unsigned short* lists = (unsigned short*)(F.ws + WS_LMB);
    for (int u = F.bid; u < 32 * 31; u += F.G) {
        const int bh = u / 31, i = 1 + (u % 31), b = bh >> 3, h = bh & 7;
        for (int idx = F.tid; idx < i * 64; idx += 512) kb[idx] = kbar[(b * 32 + (idx >> 6)) * 512 + h * 64 + (idx & 63)];
        if (F.tid < 32) lcnt[F.tid] = 0;
        __syncthreads();
        int j0 = -1, j1 = -1, j2 = -1, r0 = 0, r1 = 0, r2 = 0; const int nsel = i < 3 ? i : 3;
        const int qpos = i * 256 + F.tid;
        if (F.tid < 256) {
            float qv[64];
            const u32x4* qp = (const u32x4*)((const bf16_t*)(F.ws + WS_QMB) + (size_t)(b * SEQ + qpos) * QW + h * 64);
#pragma unroll
            for (int c = 0; c < 8; ++c) { const u32x4 w = qp[c];
                qv[8 * c] = bflo(w.x); qv[8 * c + 1] = bfhi(w.x); qv[8 * c + 2] = bflo(w.y); qv[8 * c + 3] = bfhi(w.y);
                qv[8 * c + 4] = bflo(w.z); qv[8 * c + 5] = bfhi(w.z); qv[8 * c + 6] = bflo(w.w); qv[8 * c + 7] = bfhi(w.w); }
            float v0 = -INFINITY, v1 = -INFINITY, v2 = -INFINITY;
            for (int j = 0; j < i; ++j) {
                const LAS f32x4* kr = (const LAS f32x4*)(kb + j * 64);
                float g = 0.f;
#pragma unroll
                for (int c = 0; c < 16; ++c) { const f32x4 kk = kr[c]; g += qv[4 * c] * kk.x + qv[4 * c + 1] * kk.y + qv[4 * c + 2] * kk.z + qv[4 * c + 3] * kk.w; }
                if (g > v0) { v2 = v1; j2 = j1; v1 = v0; j1 = j0; v0 = g; j0 = j; }
                else if (g > v1) { v2 = v1; j2 = j1; v1 = g; j1 = j; }
                else if (g > v2) { v2 = g; j2 = j; }
            }
            r0 = lds_add(&lcnt[j0], 1);
            if (nsel > 1) r1 = lds_add(&lcnt[j1], 1);
            if (nsel > 2) r2 = lds_add(&lcnt[j2], 1);
        }
        __syncthreads();
        if (F.tid < i) { const int n = lcnt[F.tid]; lbase[F.tid] = n > 0 ? (int)atomicAdd(&cur[bh * 32 + F.tid], (unsigned)n) : 0; }
        __syncthreads();
        if (F.tid < 256) {
            unsigned short* lb = lists + (size_t)bh * MB_LIST_STRIDE;
            lb[mb_list_off(j0) + lbase[j0] + r0] = (unsigned short)(qpos | (0 << 13));
            if (nsel > 1) lb[mb_list_off(j1) + lbase[j1] + r1] = (unsigned short)(qpos | (1 << 13));
            if (nsel > 2) lb[mb_list_off(j2) + lbase[j2] + r2] = (unsigned short)(qpos | (2 << 13));
        }
        __syncthreads();
    }
}
__device__ __forceinline__ void kv_dma(Ctx& F, const bf16_t* kg, const bf16_t* vg, int bufoff) {
    const int l = F.lane;
#pragma unroll
    for (int i = 0; i < 4; ++i) { const int p = 4 * F.wave + i;
        __builtin_amdgcn_global_load_lds((const unsigned*)(kg + (size_t)(8 * p + (l >> 3)) * QW + ((l & 7) ^ ((l >> 3) & 7)) * 8), (LAS unsigned*)(F.lds + bufoff + p * 1024), 16, 0, 0);
        __builtin_amdgcn_global_load_lds((const unsigned*)(vg + (size_t)((p >> 3) * 64 + (p & 3) * 16 + (l >> 2)) * QW + ((p >> 2) & 1) * 32 + (l & 3) * 8), (LAS unsigned*)(F.lds + bufoff + 32768 + p * 1024), 16, 0, 0); }
}
__device__ __forceinline__ void softmax_step(f32x16 (&t)[2], float& m, float& l, f32x16 (&o)[2], LAS float* wsf, const LAS unsigned char* vt, int lane) {
    const int r32 = lane & 31, hi = lane >> 5;
    float rm = -INFINITY;
#pragma unroll
    for (int p = 0; p < 2; ++p)
#pragma unroll
        for (int r = 0; r < 16; ++r) rm = fmaxf(rm, t[p][r]);
    rm = fmaxf(rm, __shfl_xor(rm, 32));
    const float mn = fmaxf(m, rm);
    const float f = __builtin_amdgcn_exp2f(m - mn);
    m = mn;
    float s = 0.f; u32x4 pw[4];
#pragma unroll
    for (int p = 0; p < 2; ++p)
#pragma unroll
        for (int r = 0; r < 16; ++r) { const float e = __builtin_amdgcn_exp2f(t[p][r] - mn); t[p][r] = e; s += e; }
    l = l * f + s;
#pragma unroll
    for (int idx = 0; idx < 8; ++idx) { const int p = idx >> 2, g4 = (idx & 3) * 4; pw[idx >> 1][(idx & 1) * 2] = cvtpk(t[p][g4], t[p][g4 + 1]); pw[idx >> 1][(idx & 1) * 2 + 1] = cvtpk(t[p][g4 + 2], t[p][g4 + 3]); }
    if (__any(f != 1.f)) {
        if (hi == 0) wsf[r32] = f;
        LDS_WAIT();
#pragma unroll
        for (int g = 0; g < 4; ++g) { const f32x4 fv = *(const LAS f32x4*)(wsf + 8 * g + 4 * hi);
#pragma unroll
            for (int j = 0; j < 4; ++j) { o[0][4 * g + j] *= fv[j]; o[1][4 * g + j] *= fv[j]; } }
        LDS_WAIT();
    }
    pv64(o, vt, lane, pw);
}
__device__ __forceinline__ void qkt64(f32x16 (&t)[2], const LAS unsigned char* kt, const bf16x8 (&qr)[4], int lane) {
    const int r32 = lane & 31, hi = lane >> 5;
    t[0] = f32x16{}; t[1] = f32x16{};
    const LAS unsigned char* rp = kt + r32 * 128;
#pragma unroll
    for (int d0 = 0; d0 < 4; ++d0) {
        const int pos = ((2 * d0 + hi) ^ (r32 & 7)) * 16;
        const bf16x8 k0 = *(const LAS bf16x8*)(rp + pos), k1 = *(const LAS bf16x8*)(rp + 4096 + pos);
        t[0] = __builtin_amdgcn_mfma_f32_32x32x16_bf16(k0, qr[d0], t[0], 0, 0, 0); t[1] = __builtin_amdgcn_mfma_f32_32x32x16_bf16(k1, qr[d0], t[1], 0, 0, 0);
    }
}
__device__ __forceinline__ void phase5(Ctx& F) {
    LAS int* pre = (LAS int*)(F.lds + MISC_OFF + MO_PRE);
    LAS int* wtot = (LAS int*)(F.lds + MISC_OFF + MO_ENT);
    const unsigned* cur = (const unsigned*)(F.ws + WS_CTL) + CW_MBCUR;
    build_lut(F);
    int total;
    {
        const int p0 = 2 * F.tid, p1 = p0 + 1;
        const int c0 = p0 < 992 ? (int)((cur[(p0 / 31) * 32 + (p0 % 31)] + 255u) >> 8) : 0;
        const int c1 = p1 < 992 ? (int)((cur[(p1 / 31) * 32 + (p1 % 31)] + 255u) >> 8) : 0;
        const int s = c0 + c1; int v = s;
#pragma unroll
        for (int o = 1; o < 64; o <<= 1) { const int n = __shfl_up(v, o); if (F.lane >= o) v += n; }
        if (F.lane == 63) wtot[248 + F.wave] = v;
        __syncthreads();
        int woff = 0; total = 0;
#pragma unroll
        for (int w = 0; w < 8; ++w) { const int x = wtot[248 + w]; if (w < F.wave) woff += x; total += x; }
        const int excl = woff + v - s;
        pre[p0] = excl; pre[p1] = excl + c0;
        __syncthreads();
    }
    const unsigned short* lists = (const unsigned short*)(F.ws + WS_LMB);
    LAS float* wsf = (LAS float*)(F.lds + MISC_OFF + MO_WSF) + F.wave * 128;
    LAS int* ent = (LAS int*)(F.lds + MISC_OFF + MO_ENT) + F.wave * 32;
    const int lane = F.lane, r32 = lane & 31, hi = lane >> 5;
#define P5_UNIT(U, BH, J, C) do { int lo_ = 0, hi_ = 992; while (hi_ - lo_ > 1) { const int mid = (lo_ + hi_) >> 1; if (pre[mid] <= (U)) lo_ = mid; else hi_ = mid; } BH = lo_ / 31; J = lo_ % 31; C = (U) - pre[lo_]; } while (0)
#define P5_DMA(BH, J, BUF) do { const bf16_t* b_ = (const bf16_t*)(F.ws + WS_QMB) + (size_t)((BH) >> 3) * SEQ * QW + ((BH) & 7) * 64; kv_dma(F, b_ + 512 + (size_t)((J) * 256) * QW, b_ + 1024 + (size_t)((J) * 256) * QW, (BUF) * 65536); } while (0)
#define P5_ENTRY(BH, J, C, ACT, VALID, ENTRY) do { const int n_ = (int)cur[(BH) * 32 + (J)]; const int e0_ = (C) * 256 + F.wave * 32; ACT = e0_ < n_; VALID = ACT && (e0_ + r32) < n_; \
        const unsigned short* lb_ = lists + (size_t)(BH) * MB_LIST_STRIDE + mb_list_off(J); ENTRY = ACT ? (int)lb_[VALID ? e0_ + r32 : e0_] : 0; } while (0)
#define P5_QLOAD(BH, ENTRY, Q) do { const bf16_t* b_ = (const bf16_t*)(F.ws + WS_QMB) + (size_t)((BH) >> 3) * SEQ * QW + ((BH) & 7) * 64 + (size_t)((ENTRY) & 8191) * QW + hi * 8; \
        _Pragma("unroll") for (int d0 = 0; d0 < 4; ++d0) Q[d0] = *(const bf16x8*)(b_ + d0 * 16); } while (0)
    int u = F.bid, bh = 0, j = 0, c = 0, buf = 0;
    bool act = false, valid = false; int entry = 0; bf16x8 qr[4];
    if (u < total) { P5_UNIT(u, bh, j, c); P5_DMA(bh, j, 0); P5_ENTRY(bh, j, c, act, valid, entry); P5_QLOAD(bh, entry, qr); }
    for (; u < total; u += F.G) {
        const int un = u + F.G; int bhn = 0, jn = 0, cn = 0;
        const bool has_next = un < total;
        if (has_next) P5_UNIT(un, bhn, jn, cn);
        const int h = bh & 7;
        const int qpos = entry & 8191, slot = entry >> 13;
        asm volatile("s_waitcnt vmcnt(0)" ::: "memory");
        __syncthreads();
        bool actn = false, validn = false; int entryn = 0; bf16x8 qn[4];
        if (has_next) { P5_DMA(bhn, jn, buf ^ 1); P5_ENTRY(bhn, jn, cn, actn, validn, entryn); }
        const LAS unsigned char* kimg = F.lds + buf * 65536; const LAS unsigned char* vimg = kimg + 32768;
        if (act) {
            if (hi == 0) ent[r32] = valid ? entry : -1;
            float m = -INFINITY, l = 0.f; f32x16 o[2]; o[0] = f32x16{}; o[1] = f32x16{};
            const LAS float* lut = (const LAS float*)(F.lds + MISC_OFF + MO_LUT) + h * 132;
            const float bfar = lut[128];
#pragma unroll 1
            for (int st = 0; st < 4; ++st) {
                if (st == 2 && has_next) P5_QLOAD(bhn, entryn, qn);
                f32x16 t[2]; qkt64(t, kimg + st * 8192, qr, lane);
                const int kbase = j * 256 + st * 64;
                const bool far = __all(qpos - (kbase + 63) >= 128);
                if (far) {
#pragma unroll
                    for (int pp = 0; pp < 2; ++pp)
#pragma unroll
                        for (int r = 0; r < 16; ++r) t[pp][r] = t[pp][r] * LOG2E + bfar;
                } else {
#pragma unroll
                    for (int pp = 0; pp < 2; ++pp)
#pragma unroll
                        for (int r = 0; r < 16; ++r) { int d = qpos - (kbase + 32 * pp + crow(r, hi)); d = d < 128 ? d : 128; d = d > 0 ? d : 0; t[pp][r] = t[pp][r] * LOG2E + lut[d]; }
                }
                softmax_step(t, m, l, o, wsf, vimg + st * 8192, lane);
            }
            l += __shfl_xor(l, 32);
            const float rl = 1.f / l;
            if (hi == 0) { wsf[r32] = rl; if (valid) ((float*)(F.ws + WS_PLSE))[((size_t)bh * SEQ + qpos) * 3 + slot] = m + __log2f(l); }
            LDS_WAIT();
            {
                LAS bf16_t* stg = (LAS bf16_t*)(F.lds + MISC_OFF + MO_STG + F.wave * 2048);
                bf16_t* po = (bf16_t*)(F.ws + WS_PO);
#pragma unroll
                for (int d0 = 0; d0 < 2; ++d0) {
#pragma unroll
                    for (int r = 0; r < 16; ++r) { const int q = crow(r, hi); stg[q * 32 + r32] = (bf16_t)(cvtpk(o[d0][r] * wsf[q], 0.f) & 0xffffu); }
                    LDS_WAIT();
#pragma unroll
                    for (int it2 = 0; it2 < 2; ++it2) { const int row = it2 * 16 + (lane >> 2), ch = lane & 3; const int en = ent[row];
                        const u32x4 v = *(const LAS u32x4*)(stg + row * 32 + ch * 8);
                        if (en >= 0) *(u32x4*)(po + (((size_t)bh * SEQ + (en & 8191)) * 3 + (en >> 13)) * 64 + d0 * 32 + ch * 8) = v; }
                    LDS_WAIT();
                }
            }
        } else if (has_next) { P5_QLOAD(bhn, entryn, qn); }
        bh = bhn; j = jn; c = cn; buf ^= 1; act = actn; valid = validn; entry = entryn;
#pragma unroll
        for (int d0 = 0; d0 < 4; ++d0) qr[d0] = qn[d0];
    }
#undef P5_ENTRY
#undef P5_QLOAD
#undef P5_UNIT
#undef P5_DMA
    asm volatile("s_waitcnt vmcnt(0)" ::: "memory");
    __syncthreads();
}
__device__ __forceinline__ void phase6(Ctx& F) {
    build_lut(F);
    LAS float* wsf = (LAS float*)(F.lds + MISC_OFF + MO_WSF) + F.wave * 128;
    const int lane = F.lane, r32 = lane & 31, hi = lane >> 5, w = F.wave;
#define P6_DMA(U, BUF) do { const int bh_ = (U) >> 5, i_ = 31 - ((U) & 31); const bf16_t* b_ = (const bf16_t*)(F.ws + WS_QMB) + (size_t)(bh_ >> 3) * SEQ * QW + (bh_ & 7) * 64; \
        kv_dma(F, b_ + 512 + (size_t)(i_ * 256) * QW, b_ + 1024 + (size_t)(i_ * 256) * QW, (BUF) * 65536); } while (0)
    int buf = 0;
    if (F.bid < 32 * 32) P6_DMA(F.bid, 0);
    for (int u = F.bid; u < 32 * 32; u += F.G) {
        const int bh = u >> 5, i = 31 - (u & 31), b = bh >> 3, h = bh & 7;
        const bf16_t* base = (const bf16_t*)(F.ws + WS_QMB) + (size_t)b * SEQ * QW + h * 64;
        const int ql = w * 32 + r32, qpos = i * 256 + ql;
        bf16x8 qr[4];
#pragma unroll
        for (int d0 = 0; d0 < 4; ++d0) qr[d0] = *(const bf16x8*)(base + (size_t)qpos * QW + d0 * 16 + hi * 8);
        const int nsel = i < 3 ? i : 3;
        const float* plse = (const float*)(F.ws + WS_PLSE) + ((size_t)bh * SEQ + qpos) * 3;
        float ls0 = -INFINITY, ls1 = -INFINITY, ls2 = -INFINITY;
        if (nsel > 0) ls0 = plse[0]; if (nsel > 1) ls1 = plse[1]; if (nsel > 2) ls2 = plse[2];
        asm volatile("s_waitcnt vmcnt(0)" ::: "memory");
        __syncthreads();
        if (u + F.G < 32 * 32) P6_DMA(u + F.G, buf ^ 1);
        const LAS unsigned char* kimg = F.lds + buf * 65536; const LAS unsigned char* vimg = kimg + 32768;
        float m = -INFINITY, l = 0.f; f32x16 o[2]; o[0] = f32x16{}; o[1] = f32x16{};
        const LAS float* lut = (const LAS float*)(F.lds + MISC_OFF + MO_LUT) + h * 132;
        const int nst = (w >> 1) + 1;
#pragma unroll 1
        for (int st = 0; st < nst; ++st) {
            f32x16 t[2]; qkt64(t, kimg + st * 8192, qr, lane);
#pragma unroll
            for (int pp = 0; pp < 2; ++pp)
#pragma unroll
                for (int r = 0; r < 16; ++r) { const int d = ql - (st * 64 + 32 * pp + crow(r, hi)); const int dc = d < 128 ? (d > 0 ? d : 0) : 128; const float v = t[pp][r] * LOG2E + lut[dc]; t[pp][r] = d >= 0 ? v : -INFINITY; }
            softmax_step(t, m, l, o, wsf, vimg + st * 8192, lane);
        }
        l += __shfl_xor(l, 32);
        const float M = fmaxf(fmaxf(m, ls0), fmaxf(ls1, ls2));
        const float eo = __builtin_amdgcn_exp2f(m - M), e0 = __builtin_amdgcn_exp2f(ls0 - M), e1 = __builtin_amdgcn_exp2f(ls1 - M), e2 = __builtin_amdgcn_exp2f(ls2 - M);
        const float rden = 1.f / (l * eo + e0 + e1 + e2);
        if (hi == 0) *(LAS f32x4*)(wsf + 4 * r32) = (f32x4){eo * rden, e0 * rden, e1 * rden, e2 * rden};
        LDS_WAIT();
#pragma unroll
        for (int r = 0; r < 16; ++r) { const float fo = wsf[4 * crow(r, hi)]; o[0][r] *= fo; o[1][r] *= fo; }
        __syncthreads();
        {
            LAS bf16_t* stg = (LAS bf16_t*)(F.lds + buf * 65536 + w * 4096);
#pragma unroll
            for (int r = 0; r < 16; ++r) { const int orow = crow(r, hi);
#pragma unroll
                for (int d0 = 0; d0 < 2; ++d0) stg[orow * 64 + d0 * 32 + r32] = (bf16_t)(cvtpk(o[d0][r], 0.f) & 0xffffu); }
            LDS_WAIT();
            const bf16_t* po = (const bf16_t*)(F.ws + WS_PO) + ((size_t)bh * SEQ + i * 256 + w * 32) * 3 * 64;
            bf16_t* dst = (bf16_t*)(F.ws + WS_OB) + (size_t)(b * SEQ + i * 256 + w * 32) * 1024 + 512 + h * 64;
#pragma unroll
            for (int it4 = 0; it4 < 4; ++it4) { const int row = it4 * 8 + (lane >> 3), ch = lane & 7;
                const u32x4 ov = *(const LAS u32x4*)(stg + row * 64 + ch * 8);
                float a[8] = {bflo(ov.x), bfhi(ov.x), bflo(ov.y), bfhi(ov.y), bflo(ov.z), bfhi(ov.z), bflo(ov.w), bfhi(ov.w)};
                const f32x4 fc = *(const LAS f32x4*)(wsf + 4 * row);
#pragma unroll
                for (int sl = 0; sl < 3; ++sl) if (sl < nsel) { const u32x4 pv = *(const u32x4*)(po + (size_t)(row * 3 + sl) * 64 + ch * 8); const float f = fc[1 + sl];
                    a[0] += f * bflo(pv.x); a[1] += f * bfhi(pv.x); a[2] += f * bflo(pv.y); a[3] += f * bfhi(pv.y); a[4] += f * bflo(pv.z); a[5] += f * bfhi(pv.z); a[6] += f * bflo(pv.w); a[7] += f * bfhi(pv.w); }
                u32x4 w4; w4.x = cvtpk(a[0], a[1]); w4.y = cvtpk(a[2], a[3]); w4.z = cvtpk(a[4], a[5]); w4.w = cvtpk(a[6], a[7]);
                *(u32x4*)(dst + (size_t)row * 1024 + ch * 8) = w4; }
            LDS_WAIT();
        }
        buf ^= 1;
    }
#undef P6_DMA
    asm volatile("s_waitcnt vmcnt(0)" ::: "memory");
    __syncthreads();
}

struct BranchSched {
    const char* A; const char* Bt; int G, c; int R[2], C[2];
    __device__ __forceinline__ bool next(int i, gm::UnitD& u) {
        int pm, pn; if (!gm::static_tile(MT, 1024, G, c, i, pm, pn)) return false;
        u.a = A; u.b = Bt + (size_t)(pn * 256) * 1024 * 2;
#pragma unroll
        for (int h = 0; h < 2; ++h)
#pragma unroll
            for (int j = 0; j < 2; ++j) u.va[h][j] = (unsigned)((pm * 256 + h * 128 + R[j]) * 1024 + C[j]) * 2u;
        u.e0 = pm; u.e1 = pn; u.e2 = 0; u.e3 = 0; return true;
    }
};
struct EpiBranch {
    const bf16_t* g; bf16_t* merged;
    static __device__ __forceinline__ float ratio(float gs, float gm_) { return (1.f + fminf(__expf(-gm_), 1e30f)) * __builtin_amdgcn_rcpf(1.f + __expf(-gs)); }
    __device__ __forceinline__ void mid(f32x4 (&acc)[2][2][4][2], const gm::UnitD& u, int wr, int wc, int fr, int fq) const {
        const bf16_t* gp = g + (size_t)(u.e0 * 256 + wr * 64 + fr) * 2048 + u.e1 * 256 + wc * 32 + 8 * fq;
#pragma unroll
        for (int ai = 0; ai < 2; ++ai)
#pragma unroll
            for (int m = 0; m < 4; m += 2) {
                asm volatile("" : "+v"(gp) :: "memory");
                u32x4 gs[2][2], gq[2][2];
#pragma unroll
                for (int mm = 0; mm < 2; ++mm)
#pragma unroll
                    for (int bj = 0; bj < 2; ++bj) { gs[mm][bj] = *(const u32x4*)(gp + (size_t)mm * 16 * 2048 + bj * 128); gq[mm][bj] = *(const u32x4*)(gp + (size_t)mm * 16 * 2048 + 1024 + bj * 128); }
#pragma unroll
                for (int mm = 0; mm < 2; ++mm)
#pragma unroll
                    for (int bj = 0; bj < 2; ++bj) { const u32x4 a = gs[mm][bj], b = gq[mm][bj];
                        f32x4& c0 = acc[ai][bj][m + mm][0]; f32x4& c1 = acc[ai][bj][m + mm][1];
                        c0[0] *= ratio(bflo(a.x), bflo(b.x)); c0[1] *= ratio(bfhi(a.x), bfhi(b.x)); c0[2] *= ratio(bflo(a.y), bflo(b.y)); c0[3] *= ratio(bfhi(a.y), bfhi(b.y));
                        c1[0] *= ratio(bflo(a.z), bflo(b.z)); c1[1] *= ratio(bfhi(a.z), bfhi(b.z)); c1[2] *= ratio(bflo(a.w), bflo(b.w)); c1[3] *= ratio(bfhi(a.w), bfhi(b.w));
                        asm volatile("" : "+v"(c0), "+v"(c1) :: "memory"); }
                gp += (m == 2 ? 96 : 32) * 2048; }
    }
    __device__ __forceinline__ void operator()(const f32x4 (&acc)[2][2][4][2], const gm::UnitD& u, int wr, int wc, int fr, int fq) const {
        const int row0 = u.e0 * 256 + wr * 64 + fr, col0 = u.e1 * 256 + wc * 32 + 8 * fq;
#pragma unroll
        for (int ai = 0; ai < 2; ++ai)
#pragma unroll
            for (int m = 0; m < 4; ++m) { const size_t row = (size_t)(row0 + ai * 128 + m * 16);
#pragma unroll
                for (int bj = 0; bj < 2; ++bj) { const u32x4 gm_ = *(const u32x4*)(g + row * 2048 + 1024 + col0 + bj * 128);
                    const float b[8] = {bflo(gm_.x), bfhi(gm_.x), bflo(gm_.y), bfhi(gm_.y), bflo(gm_.z), bfhi(gm_.z), bflo(gm_.w), bfhi(gm_.w)};
                    float r[8];
#pragma unroll
                    for (int j = 0; j < 8; ++j) r[j] = acc[ai][bj][m][j >> 2][j & 3] * __builtin_amdgcn_rcpf(1.f + fminf(__expf(-b[j]), 1e30f));
                    u32x4 w; w.x = cvtpk(r[0], r[1]); w.y = cvtpk(r[2], r[3]); w.z = cvtpk(r[4], r[5]); w.w = cvtpk(r[6], r[7]);
                    *(u32x4*)(merged + row * 1024 + col0 + bj * 128) = w; } }
    }
};
__device__ __forceinline__ void phase7(Ctx& F) {
    BranchSched S; S.A = (const char*)(F.ws + WS_OB); S.Bt = (const char*)(F.ws + WS_WBRT); S.G = F.G; S.c = F.bid; gm::stage_geom(F.tid, S.R, S.C);
    EpiBranch E{(const bf16_t*)(F.ws + WS_G), (bf16_t*)(F.ws + WS_MERGED)};
    gm::gemm_phase<true, true>(F.lds, 1024, S, E);
}
struct OutSched {
    const char* A; const char* Bt; int G, c; int R[2], C[2];
    __device__ __forceinline__ bool next(int i, gm::UnitD& u) {
        int pm, pn; if (!gm::static_tile(MT, 1024, G, c, i, pm, pn)) return false;
        u.a = A; u.b = Bt + (size_t)pn * 256 * 1024 * 2;
#pragma unroll
        for (int h = 0; h < 2; ++h)
#pragma unroll
            for (int j = 0; j < 2; ++j) u.va[h][j] = (unsigned)((pm * 256 + h * 128 + R[j]) * 1024 + C[j]) * 2u;
        u.e0 = pm; u.e1 = pn; u.e2 = 0; u.e3 = 0; return true;
    }
};
struct EpiOut {
    const float* x; const float* mod; float* out;
    __device__ __forceinline__ void operator()(const f32x4 (&acc)[2][2][4][2], const gm::UnitD& u, int wr, int wc, int fr, int fq) const {
        const int pm = u.e0, pn = u.e1, b = (pm * 256) / SEQ;
        const int row0 = pm * 256 + wr * 64 + fr, col0 = pn * 256 + wc * 32 + 4 * fq;
        f32x4 gt[2][2];
#pragma unroll
        for (int bj = 0; bj < 2; ++bj)
#pragma unroll
            for (int n = 0; n < 2; ++n) gt[bj][n] = *(const f32x4*)(mod + b * NMOD + 2 * DM + col0 + bj * 128 + n * 16);
#pragma unroll
        for (int ai = 0; ai < 2; ++ai)
#pragma unroll
            for (int m = 0; m < 4; ++m) { const size_t off = (size_t)(row0 + ai * 128 + m * 16) * DM + col0;
#pragma unroll
                for (int bj = 0; bj < 2; ++bj)
#pragma unroll
                    for (int n = 0; n < 2; ++n) { const f32x4 xv = *(const f32x4*)(x + off + bj * 128 + n * 16); *(f32x4*)(out + off + bj * 128 + n * 16) = xv + gt[bj][n] * acc[ai][bj][m][n]; } }
    }
};
__device__ __forceinline__ void phase8(Ctx& F) {
    OutSched S; S.A = (const char*)(F.ws + WS_MERGED); S.Bt = (const char*)(F.ws + WS_WOUTT); S.G = F.G; S.c = F.bid; gm::stage_geom(F.tid, S.R, S.C);
    EpiOut E{inp(F, I_X), (const float*)(F.ws + WS_SMALL + SM_MOD), F.out};
    gm::gemm_phase<false>(F.lds, 1024, S, E);
}

constexpr int NR_SSQ = MO_PRE + 1024;
constexpr int NR_RS = MO_PRE + 3072;
__device__ __forceinline__ void phase_n2r(Ctx& F, int rr) {
    const float* x1 = F.out; const float* gvec = (const float*)(F.ws + WS_SMALL + SM_GVEC); const float* cb = (const float*)(F.ws + WS_SMALL + SM_CB);
    const float* mod = (const float*)(F.ws + WS_SMALL + SM_MOD); const float* rbias = inp(F, I_RB);
    bf16_t* H2 = (bf16_t*)(F.ws + WS_H2); int* tokl = (int*)(F.ws + WS_TOKL); float* wl = (float*)(F.ws + WS_WL); int* tpos = (int*)(F.ws + WS_TPOS);
    unsigned* cur = (unsigned*)(F.ws + WS_CTL) + CW_MOECUR + rr * 64;
    LAS int* lcnt = (LAS int*)(F.lds + MISC_OFF + MO_PRE); LAS int* lbase = lcnt + 64;
    LAS float* part = (LAS float*)(F.lds);
    LAS float* ssqp = (LAS float*)(F.lds + MISC_OFF + NR_SSQ); LAS float* rsl = (LAS float*)(F.lds + MISC_OFF + NR_RS);
    const int lane = F.lane, w = F.wave, i16 = lane & 15, kk = lane >> 4;
    for (int u = F.bid; u < RT / 64; u += F.G) {
        if (F.tid < 64) lcnt[F.tid] = 0;
        const int tokb = rr * RT + u * 64, b = tokb / SEQ;
        {
            bf16x8 fah[4][4], fal[4][4];
            {
                const float* gp = gvec + b * DM + 128 * w + 8 * kk;
                f32x4 gv[4][2];
#pragma unroll
                for (int s4 = 0; s4 < 4; ++s4) { gv[s4][0] = *(const f32x4*)(gp + 32 * s4); gv[s4][1] = *(const f32x4*)(gp + 32 * s4 + 4); }
#pragma unroll
                for (int tt = 0; tt < 4; ++tt) {
                    const float* xp = x1 + (size_t)(tokb + tt * 16 + i16) * DM + 128 * w + 8 * kk;
                    f32x4 xa[4][2];
#pragma unroll
                    for (int s4 = 0; s4 < 4; ++s4) { xa[s4][0] = *(const f32x4*)(xp + 32 * s4); xa[s4][1] = *(const f32x4*)(xp + 32 * s4 + 4); }
                    float ssq = 0.f;
#pragma unroll
                    for (int s4 = 0; s4 < 4; ++s4) {
                        u32x4 ah, al;
#pragma unroll
                        for (int q = 0; q < 2; ++q) { const f32x4 xv = xa[s4][q]; ssq += (xv.x * xv.x + xv.y * xv.y) + (xv.z * xv.z + xv.w * xv.w);
                            const f32x4 a = xv * gv[s4][q];
                            const unsigned h0 = cvtpk(a.x, a.y), h1 = cvtpk(a.z, a.w);
                            ah[2 * q] = h0; ah[2 * q + 1] = h1; al[2 * q] = cvtpk(a.x - bflo(h0), a.y - bfhi(h0)); al[2 * q + 1] = cvtpk(a.z - bflo(h1), a.w - bfhi(h1)); }
                        fah[tt][s4] = __builtin_bit_cast(bf16x8, ah); fal[tt][s4] = __builtin_bit_cast(bf16x8, al);
                    }
                    ssq += __shfl_xor(ssq, 16); ssq += __shfl_xor(ssq, 32); if (kk == 0) ssqp[w * 64 + tt * 16 + i16] = ssq;
                }
            }
#pragma unroll 1
            for (int eh = 0; eh < 2; ++eh) {
                bf16x8 wh[2][4], wl_[2][4];
                {
                    const bf16_t* ph = (const bf16_t*)(F.ws + WS_SMALL + SM_WRH) + (size_t)(eh * 32 + i16) * DM + 128 * w + 8 * kk;
                    const bf16_t* pl = (const bf16_t*)(F.ws + WS_SMALL + SM_WRL) + (size_t)(eh * 32 + i16) * DM + 128 * w + 8 * kk;
#pragma unroll
                    for (int c = 0; c < 2; ++c)
#pragma unroll
                        for (int s4 = 0; s4 < 4; ++s4) { wh[c][s4] = *(const bf16x8*)(ph + (size_t)c * 16 * DM + 32 * s4); wl_[c][s4] = *(const bf16x8*)(pl + (size_t)c * 16 * DM + 32 * s4); }
                }
#pragma unroll
                for (int tt = 0; tt < 4; ++tt) {
                    f32x4 acc[2]; acc[0] = acc[1] = (f32x4){0.f, 0.f, 0.f, 0.f};
#pragma unroll
                    for (int s4 = 0; s4 < 4; ++s4)
#pragma unroll
                        for (int c = 0; c < 2; ++c) {
                            acc[c] = __builtin_amdgcn_mfma_f32_16x16x32_bf16(fal[tt][s4], wh[c][s4], acc[c], 0, 0, 0);
                            acc[c] = __builtin_amdgcn_mfma_f32_16x16x32_bf16(fah[tt][s4], wl_[c][s4], acc[c], 0, 0, 0);
                            acc[c] = __builtin_amdgcn_mfma_f32_16x16x32_bf16(fah[tt][s4], wh[c][s4], acc[c], 0, 0, 0); }
#pragma unroll
                    for (int c = 0; c < 2; ++c)
#pragma unroll
                        for (int reg = 0; reg < 4; ++reg) part[(w * 64 + tt * 16 + 4 * kk + reg) * 64 + eh * 32 + 16 * c + i16] = acc[c][reg];
                }
            }
        }
        __syncthreads();
        const int tl = F.tid >> 3, g = F.tid & 7;
        int my_e; float my_w; int my_rank;
        {
            float ssq = 0.f;
#pragma unroll
            for (int q = 0; q < 8; ++q) ssq += ssqp[q * 64 + tl];
            const float rstd = rsqrtf(ssq * (1.f / DM) + EPS);
            if (g == 0) rsl[tl] = rstd;
            float s8[8], c8[8];
            {
                f32x4 lo4 = (f32x4){0.f, 0.f, 0.f, 0.f}, hi4 = lo4;
#pragma unroll
                for (int q = 0; q < 8; ++q) { const LAS f32x4* pp = (const LAS f32x4*)(part + (q * 64 + tl) * 64 + 8 * g); lo4 += pp[0]; hi4 += pp[1]; }
                const f32x4 cb0 = *(const f32x4*)(cb + b * 64 + 8 * g), cb1 = *(const f32x4*)(cb + b * 64 + 8 * g + 4), rb0 = *(const f32x4*)(rbias + 8 * g), rb1 = *(const f32x4*)(rbias + 8 * g + 4);
#pragma unroll
                for (int j = 0; j < 4; ++j) { s8[j] = sigmoidf_(lo4[j] * rstd + cb0[j]); s8[4 + j] = sigmoidf_(hi4[j] * rstd + cb1[j]); c8[j] = s8[j] + rb0[j]; c8[4 + j] = s8[4 + j] + rb1[j]; }
            }
            float m1 = -INFINITY, m2 = -INFINITY;
#pragma unroll
            for (int j = 0; j < 8; ++j) { const float v = c8[j]; if (v > m1) { m2 = m1; m1 = v; } else if (v > m2) m2 = v; }
            const float gs = m1 + m2;
            int rank = 0;
#pragma unroll
            for (int g2 = 0; g2 < 8; ++g2) { const float o = __shfl(gs, g2, 8); rank += (o > gs || (o == gs && g2 < g)) ? 1 : 0; }
            if (rank >= 4) {
#pragma unroll
                for (int j = 0; j < 8; ++j) c8[j] = -INFINITY;
            }
            int sel_e[8]; float sk[8]; float wsum = 0.f;
#pragma unroll
            for (int k = 0; k < 8; ++k) {
                float bv = -INFINITY, bs = 0.f; int be = 8 * g;
#pragma unroll
                for (int j = 0; j < 8; ++j) if (c8[j] > bv) { bv = c8[j]; be = 8 * g + j; bs = s8[j]; }
#pragma unroll
                for (int o = 1; o < 8; o <<= 1) { const float ov = __shfl_xor(bv, o, 8), os = __shfl_xor(bs, o, 8); const int oe = __shfl_xor(be, o, 8); if (ov > bv || (ov == bv && oe < be)) { bv = ov; be = oe; bs = os; } }
                sel_e[k] = be; sk[k] = bs; wsum += bs;
#pragma unroll
                for (int j = 0; j < 8; ++j) if (be == 8 * g + j) c8[j] = -INFINITY;
            }
            my_e = sel_e[0]; my_w = sk[0];
#pragma unroll
            for (int k = 1; k < 8; ++k) if (g == k) { my_e = sel_e[k]; my_w = sk[k]; }
            my_w *= 2.5f / wsum;
            my_rank = lds_add(&lcnt[my_e], 1);
        }
        __syncthreads();
        if (F.tid < 64) { const int n = lcnt[F.tid]; lbase[F.tid] = n > 0 ? (int)atomicAdd(&cur[F.tid], (unsigned)n) : 0; }
        __syncthreads();
        { const int tok = tokb + tl, pos = lbase[my_e] + my_rank; tokl[my_e * RT + pos] = tok * 8 + g; wl[my_e * RT + pos] = my_w; tpos[(tok - rr * RT) * 8 + g] = (my_e << 16) | pos; }
#pragma unroll 1
        for (int r0 = 0; r0 < 8; r0 += 4) {
            f32x4 xv[4][4];
#pragma unroll
            for (int r = 0; r < 4; ++r) { const f32x4* xr = (const f32x4*)(x1 + (size_t)(tokb + w * 8 + r0 + r) * DM) + lane;
#pragma unroll
                for (int j = 0; j < 4; ++j) xv[r][j] = xr[64 * j]; }
#pragma unroll
            for (int j = 0; j < 4; ++j) { const int col = 4 * lane + 256 * j; const f32x4 gq = *(const f32x4*)(gvec + b * DM + col), sh = *(const f32x4*)(mod + b * NMOD + 3 * DM + col);
#pragma unroll
                for (int r = 0; r < 4; ++r) { const int tl2 = w * 8 + r0 + r; const f32x4 hv = (xv[r][j] * rsl[tl2]) * gq + sh;
                    u32x2 o; o.x = cvtpk(hv.x, hv.y); o.y = cvtpk(hv.z, hv.w); ((u32x2*)(H2 + (size_t)(tokb - rr * RT + tl2) * DM) + lane)[64 * j] = o; } }
        }
        __syncthreads();
    }
}
constexpr int MO_TE = 4224;
struct MoeTabs { const LAS unsigned short* te; const LAS int* tb; const LAS int* cnt; int TR; };
__device__ __forceinline__ MoeTabs build_moe_tabs(Ctx& F, int rr) {
    LAS unsigned short* te = (LAS unsigned short*)(F.lds + MISC_OFF + MO_TE); LAS int* tb = (LAS int*)(F.lds + MISC_OFF + MO_TE + 1536); LAS int* cnt = tb + 72;
    const unsigned* cur = (const unsigned*)(F.ws + WS_CTL) + CW_MOECUR + rr * 64;
    __syncthreads();
    if (F.tid == 0) { int acc = 0; for (int e = 0; e < 64; ++e) { const int c = (int)cur[e]; cnt[e] = c; tb[e] = acc; acc += (c + 255) >> 8; } tb[64] = acc; tb[65] = acc + RT / 256; cnt[64] = RT; }
    __syncthreads();
    const int TR = tb[64];
    for (int e = F.tid >> 3; e < 65; e += 64) for (int t = tb[e] + (F.tid & 7); t < tb[e + 1]; t += 8) te[t] = (unsigned short)e;
    __syncthreads();
    MoeTabs T; T.te = te; T.tb = tb; T.cnt = cnt; T.TR = TR; return T;
}
struct Moe1Sched {
    const char* H2; const char* W1T; const int* tokl; MoeTabs T; int G, c, rr; int R[2], C[2];
    __device__ __forceinline__ bool next(int i, gm::UnitD& u) {
        const int uu = i * G + c; const int nt = T.TR + RT / 256;
        if (uu >= nt * 2) return false;
        const int tile = uu >> 1, pn = uu & 1, e = T.te[tile], rt = tile - T.tb[e], cnt = T.cnt[e];
        u.a = H2; u.b = W1T + (size_t)(e * 512 + pn * 256) * 1024 * 2;
#pragma unroll
        for (int h = 0; h < 2; ++h)
#pragma unroll
            for (int j = 0; j < 2; ++j) { const int idx = rt * 256 + h * 128 + R[j]; int trow;
                if (e < 64) { const int ent = tokl[e * RT + (idx < cnt ? idx : rt * 256)]; trow = (ent >> 3) - rr * RT; } else trow = idx;
                u.va[h][j] = (unsigned)(trow * 1024 + C[j]) * 2u; }
        u.e0 = tile; u.e1 = pn; u.e2 = e; u.e3 = rt; return true;
    }
};
struct EpiMoe1 {
    bf16_t* act; const float* wl; const LAS int* cnt;
    __device__ __forceinline__ void operator()(const f32x4 (&acc)[2][2][4][2], const gm::UnitD& u, int wr, int wc, int fr, int fq) const {
        const int row0 = u.e0 * 256 + wr * 64 + fr, col0 = u.e1 * 128 + wc * 32 + 8 * fq, e = u.e2, n = cnt[e];
        float rw[2][4];
#pragma unroll
        for (int ai = 0; ai < 2; ++ai)
#pragma unroll
            for (int m = 0; m < 4; ++m) { const int idx = u.e3 * 256 + ai * 128 + wr * 64 + m * 16 + fr; rw[ai][m] = e < 64 ? (idx < n ? wl[e * RT + idx] : 0.f) : 1.f; }
#pragma unroll
        for (int ai = 0; ai < 2; ++ai)
#pragma unroll
            for (int m = 0; m < 4; ++m) { const float ww = rw[ai][m]; const f32x4 g0 = acc[ai][0][m][0], g1 = acc[ai][0][m][1], u0 = acc[ai][1][m][0] * ww, u1 = acc[ai][1][m][1] * ww;
                u32x4 w; w.x = cvtpk(siluf_(g0[0]) * u0[0], siluf_(g0[1]) * u0[1]); w.y = cvtpk(siluf_(g0[2]) * u0[2], siluf_(g0[3]) * u0[3]);
                w.z = cvtpk(siluf_(g1[0]) * u1[0], siluf_(g1[1]) * u1[1]); w.w = cvtpk(siluf_(g1[2]) * u1[2], siluf_(g1[3]) * u1[3]);
                *(u32x4*)(act + (size_t)(row0 + ai * 128 + m * 16) * 256 + col0) = w; }
    }
};
__device__ __forceinline__ void phase_moe1(Ctx& F, int rr) {
    Moe1Sched S; S.T = build_moe_tabs(F, rr); S.H2 = (const char*)(F.ws + WS_H2); S.W1T = (const char*)(F.ws + WS_W1T); S.tokl = (const int*)(F.ws + WS_TOKL); S.G = F.G; S.c = (F.G % 8 == 0) ? (F.bid % 8) * (F.G / 8) + F.bid / 8 : F.bid; S.rr = rr; gm::stage_geom(F.tid, S.R, S.C);
    EpiMoe1 E{(bf16_t*)(F.ws + WS_ACT), (const float*)(F.ws + WS_WL), S.T.cnt};
    gm::gemm_phase<true>(F.lds, 1024, S, E);
}
struct Moe2Sched {
    const char* ACT; const char* W2T; MoeTabs T; int G, c; int R[2], C[2];
    __device__ __forceinline__ bool next(int i, gm::UnitD& u) {
        const int uu = i * G + c; const int nt = T.TR + RT / 256;
        if (uu >= nt * 4) return false;
        const int tile = uu >> 2, pn = uu & 3, e = T.te[tile], rt = tile - T.tb[e];
        u.a = ACT + (size_t)tile * 256 * 256 * 2; u.b = W2T + (size_t)(e * 1024 + pn * 256) * 256 * 2;
#pragma unroll
        for (int h = 0; h < 2; ++h)
#pragma unroll
            for (int j = 0; j < 2; ++j) u.va[h][j] = (unsigned)((h * 128 + R[j]) * 256 + C[j]) * 2u;
        u.e0 = pn; u.e1 = e; u.e2 = rt; u.e3 = tile; return true;
    }
};
struct EpiMoe2 {
    bf16_t* slots; bf16_t* shout; const LAS int* cnt;
    __device__ __forceinline__ void operator()(const f32x4 (&acc)[2][2][4][2], const gm::UnitD& u, int wr, int wc, int fr, int fq) const {
        const int pn = u.e0, e = u.e1, rt = u.e2, tile = u.e3;
        const int col0 = pn * 256 + wc * 32 + 8 * fq, n = cnt[e];
        if (e < 64) {
            unsigned char* base = (unsigned char*)slots + (size_t)(tile * 256 + wr * 64 + fr) * 1024 + col0;
#pragma unroll
            for (int ai = 0; ai < 2; ++ai)
#pragma unroll
                for (int m = 0; m < 4; ++m) {
                    if (rt * 256 + ai * 128 + wr * 64 + m * 16 + fr < n) {
#pragma unroll
                        for (int bj = 0; bj < 2; ++bj) { const f32x4 v0 = acc[ai][bj][m][0] * 16.f, v1 = acc[ai][bj][m][1] * 16.f;
                            int w0 = 0, w1 = 0;
                            w0 = __builtin_amdgcn_cvt_pk_fp8_f32(v0[0], v0[1], w0, false); w0 = __builtin_amdgcn_cvt_pk_fp8_f32(v0[2], v0[3], w0, true);
                            w1 = __builtin_amdgcn_cvt_pk_fp8_f32(v1[0], v1[1], w1, false); w1 = __builtin_amdgcn_cvt_pk_fp8_f32(v1[2], v1[3], w1, true);
                            *(u32x2*)(base + (size_t)(ai * 128 + m * 16) * 1024 + bj * 128) = (u32x2){(unsigned)w0, (unsigned)w1}; } } }
        } else {
            bf16_t* base = shout + (size_t)(rt * 256 + wr * 64 + fr) * 1024 + col0;
#pragma unroll
            for (int ai = 0; ai < 2; ++ai)
#pragma unroll
                for (int m = 0; m < 4; ++m)
#pragma unroll
                    for (int bj = 0; bj < 2; ++bj) { const f32x4 v0 = acc[ai][bj][m][0], v1 = acc[ai][bj][m][1];
                        u32x4 o; o.x = cvtpk(v0[0], v0[1]); o.y = cvtpk(v0[2], v0[3]); o.z = cvtpk(v1[0], v1[1]); o.w = cvtpk(v1[2], v1[3]); *(u32x4*)(base + (size_t)(ai * 128 + m * 16) * 1024 + bj * 128) = o; }
        }
    }
};
__device__ __forceinline__ void phase_moe2(Ctx& F, int rr) {
    Moe2Sched S; S.T = build_moe_tabs(F, rr); S.ACT = (const char*)(F.ws + WS_ACT); S.W2T = (const char*)(F.ws + WS_W2T); S.G = F.G; S.c = (F.G % 8 == 0) ? (F.bid % 8) * (F.G / 8) + F.bid / 8 : F.bid; gm::stage_geom(F.tid, S.R, S.C);
    EpiMoe2 E{(bf16_t*)(F.ws + WS_SLOTS), (bf16_t*)(F.ws + WS_H2), S.T.cnt};
    gm::gemm_phase<true>(F.lds, 256, S, E);
}
__device__ __forceinline__ void phase_final(Ctx& F, int rr) {
    const MoeTabs T = build_moe_tabs(F, rr);
    const float* mod = (const float*)(F.ws + WS_SMALL + SM_MOD); const float* fg = inp(F, I_FG);
    const unsigned char* slots = (const unsigned char*)(F.ws + WS_SLOTS); const int* tpos = (const int*)(F.ws + WS_TPOS);
    const int gw = F.bid * 8 + F.wave, NGW = F.G * 8, c0 = F.lane * 8;
    for (int t = gw; t < RT; t += NGW) {
        const int tok = rr * RT + t, b = tok / SEQ;
        const unsigned char* rp[8];
#pragma unroll
        for (int k = 0; k < 8; ++k) { const int v = tpos[t * 8 + k]; rp[k] = slots + (size_t)(T.tb[v >> 16] * 256 + (v & 0xffff)) * 1024 + c0; }
        float* orow = F.out + (size_t)tok * DM + c0;
        u32x2 sv[8][2]; u32x4 sh[2]; f32x4 xv[2][2];
#pragma unroll
        for (int k = 0; k < 8; ++k) { sv[k][0] = *(const u32x2*)(rp[k]); sv[k][1] = *(const u32x2*)(rp[k] + 512); }
        { const bf16_t* sp = (const bf16_t*)(F.ws + WS_H2) + (size_t)t * 1024 + c0; sh[0] = *(const u32x4*)sp; sh[1] = *(const u32x4*)(sp + 512); }
#pragma unroll
        for (int h = 0; h < 2; ++h) { xv[h][0] = *(const f32x4*)(orow + h * 512); xv[h][1] = *(const f32x4*)(orow + h * 512 + 4); }
        float s = 0.f; f32x4 v[2][2];
#pragma unroll
        for (int h = 0; h < 2; ++h) {
            f32x4 a0 = (f32x4){0.f, 0.f, 0.f, 0.f}, a1 = a0;
#pragma unroll
            for (int k = 0; k < 8; ++k) { const u32x2 w = sv[k][h];
                const f32x2 p0 = __builtin_amdgcn_cvt_pk_f32_fp8((int)w.x, false), p1 = __builtin_amdgcn_cvt_pk_f32_fp8((int)w.x, true), p2 = __builtin_amdgcn_cvt_pk_f32_fp8((int)w.y, false), p3 = __builtin_amdgcn_cvt_pk_f32_fp8((int)w.y, true);
                a0 += (f32x4){p0.x, p0.y, p1.x, p1.y}; a1 += (f32x4){p2.x, p2.y, p3.x, p3.y}; }
            { const u32x4 w = sh[h]; a0 = a0 * 0.0625f + (f32x4){bflo(w.x), bfhi(w.x), bflo(w.y), bfhi(w.y)}; a1 = a1 * 0.0625f + (f32x4){bflo(w.z), bfhi(w.z), bflo(w.w), bfhi(w.w)}; }
            const float* g2 = mod + b * NMOD + 5 * DM + c0 + h * 512;
            v[h][0] = xv[h][0] + *(const f32x4*)g2 * a0; v[h][1] = xv[h][1] + *(const f32x4*)(g2 + 4) * a1;
#pragma unroll
            for (int q = 0; q < 2; ++q) s += (v[h][q].x * v[h][q].x + v[h][q].y * v[h][q].y) + (v[h][q].z * v[h][q].z + v[h][q].w * v[h][q].w);
        }
        const float rstd = rsqrtf(wave_sum(s) * (1.f / DM) + EPS);
#pragma unroll
        for (int h = 0; h < 2; ++h)
#pragma unroll
            for (int q = 0; q < 2; ++q) { const f32x4 g = *(const f32x4*)(fg + c0 + h * 512 + 4 * q); *(f32x4*)(orow + h * 512 + 4 * q) = (v[h][q] * rstd) * g; }
    }
}

constexpr int N_PHASES = 17;
__global__ void __launch_bounds__(512, 2) mega_fwd(Args args) {
    extern __shared__ __attribute__((aligned(16))) unsigned char lds_raw[];
    Ctx F; F.lds = (LAS unsigned char*)lds_raw; F.ws = args.ws; F.out = args.out;
    {
        typedef __attribute__((address_space(4))) const unsigned long long* karg_t;
        const karg_t ka = (karg_t)__builtin_amdgcn_kernarg_segment_ptr();
        LAS unsigned long long* tab = (LAS unsigned long long*)(lds_raw + MISC_OFF + 14336);
        if (threadIdx.x < 20) tab[threadIdx.x] = ka[threadIdx.x];
        F.intab = tab;
    }
    F.tid = threadIdx.x; F.lane = F.tid & 63; F.wave = __builtin_amdgcn_readfirstlane(F.tid >> 6); F.G = gridDim.x; F.bid = blockIdx.x;
    volatile LAS unsigned* st = (volatile LAS unsigned*)(F.lds + MISC_OFF + MO_ST);
    if (F.tid < 4) st[F.tid] = 0u;
    __syncthreads();
    XcdBarrier bar = xcd_barrier_post((unsigned*)(F.ws + WS_CTL) + CW_BAR, st);
    if (threadIdx.x == 0) { unsigned nloc, nx; xcd_barrier_complete(bar.bar, bar.x, nloc, nx); st[0] = nloc; st[1] = nx; }
    int lo = args.ph_lo, hi = args.ph_hi;
    { int a = lo, b = hi; asm volatile("" : "+v"(a), "+v"(b)); lo = __builtin_amdgcn_readfirstlane(a); hi = __builtin_amdgcn_readfirstlane(b); }
    launder(F);
#ifndef PH_MASK
#define PH_MASK 0x1ffff
#endif
#define PH_ON(k) ((PH_MASK >> (k)) & 1)
#define IN(k) (lo <= (k) && (k) < hi)
#define SEAM(k) do { if (IN(k) && IN((k) + 1)) { bar.bar = launder_ptr(bar.bar); xcd_barrier(bar); } } while (0)
#define RUN(k, call) do { if (PH_ON(k) && IN(k)) { launder(F); call; } } while (0)
    RUN(0, phase0(F)); SEAM(0);
    RUN(1, phase1(F)); SEAM(1);
    RUN(2, phase2(F)); SEAM(2);
    RUN(3, phase3(F)); SEAM(3);
    RUN(4, phase4(F)); SEAM(4);
    RUN(5, phase5(F)); SEAM(5);
    RUN(6, phase6(F)); SEAM(6);
    RUN(7, phase7(F)); SEAM(7);
    RUN(8, phase8(F)); SEAM(8);
#pragma unroll 1
    for (int ph = (lo > 9 ? lo : 9); ph < hi; ++ph) {
        launder(F);
        const int rr = ph >= 13 ? 1 : 0, pq = ph >= 13 ? ph - 4 : ph;
        switch (pq) {
            case 9: if (PH_ON(9)) phase_n2r(F, rr); break;
            case 10: if (PH_ON(10)) phase_moe1(F, rr); break;
            case 11: if (PH_ON(11)) phase_moe2(F, rr); break;
            default: if (PH_ON(12)) phase_final(F, rr); break;
        }
        if (ph + 1 < hi) { bar.bar = launder_ptr(bar.bar); xcd_barrier(bar); }
    }
#undef IN
#undef SEAM
#undef RUN
}

#ifndef MK_SPLIT
#define MK_SPLIT 0
#endif
extern "C" void kernel_launch(void* const* d_in, const int* in_sizes, int n_in, void* d_out, int out_size, void* d_ws, size_t ws_size, hipStream_t stream) {
    static int grid = 0;
    if (grid == 0) {
        if (n_in != 20 || in_sizes[0] != MT * DM || out_size != MT * DM || ws_size < WS_END) { fprintf(stderr, "kernel_launch: unexpected shapes (n_in %d, in0 %d, out %d, ws %zu)\n", n_in, n_in > 0 ? in_sizes[0] : -1, out_size, ws_size); grid = -1; return; }
        int dev = 0, cus = 0;
        if (hipGetDevice(&dev) != hipSuccess || hipDeviceGetAttribute(&cus, hipDeviceAttributeMultiprocessorCount, dev) != hipSuccess) { grid = -1; return; }
        if (hipFuncSetAttribute((const void*)mega_fwd, hipFuncAttributeMaxDynamicSharedMemorySize, LDS_BYTES) != hipSuccess) { fprintf(stderr, "kernel_launch: hipFuncSetAttribute failed\n"); grid = -1; return; }
        int per_cu = 0;
        if (hipOccupancyMaxActiveBlocksPerMultiprocessor(&per_cu, (const void*)mega_fwd, 512, LDS_BYTES) != hipSuccess || per_cu < 1) fprintf(stderr, "kernel_launch: occupancy query reports %d\n", per_cu);
        (void)hipGetLastError();
        grid = cus;
    }
    if (grid < 0) return;
    (void)hipMemsetAsync((char*)d_ws + WS_CTL, 0, CTL_BYTES, stream);
    Args a{};
    for (int i = 0; i < 20; ++i) a.in[i] = (const float*)d_in[i];
    a.out = (float*)d_out; a.ws = (unsigned char*)d_ws;
#if MK_SPLIT
    for (int p = 0; p < N_PHASES; ++p) { a.ph_lo = p; a.ph_hi = p + 1; hipLaunchKernelGGL(mega_fwd, dim3(grid), dim3(512), LDS_BYTES, stream, a); }
#else
    a.ph_lo = 0; a.ph_hi = N_PHASES;
    hipLaunchKernelGGL(mega_fwd, dim3(grid), dim3(512), LDS_BYTES, stream, a);
#endif
}
```

```cpp
#include <hip/hip_runtime.h>
#include <cstdio>
#include <cstdint>

#define LAS __attribute__((address_space(3)))
#define GAS __attribute__((address_space(1)))
typedef unsigned short bf16_t;
typedef short bf16x8 __attribute__((ext_vector_type(8)));
typedef short s16x4 __attribute__((ext_vector_type(4)));
typedef float f32x4 __attribute__((ext_vector_type(4)));
typedef float f32x16 __attribute__((ext_vector_type(16)));
typedef float f32x2 __attribute__((ext_vector_type(2)));
typedef unsigned u32x4 __attribute__((ext_vector_type(4)));
typedef unsigned u32x2 __attribute__((ext_vector_type(2)));
typedef __bf16 bf16x2_t __attribute__((ext_vector_type(2)));

__device__ __forceinline__ unsigned cvtpk(float lo, float hi) { f32x2 v = {lo, hi}; bf16x2_t b = __builtin_convertvector(v, bf16x2_t); return __builtin_bit_cast(unsigned, b); }
__device__ __forceinline__ float bf2f(unsigned short u) { return __uint_as_float(((unsigned)u) << 16); }
__device__ __forceinline__ float bflo(unsigned u) { return __uint_as_float(u << 16); }
__device__ __forceinline__ float bfhi(unsigned u) { return __uint_as_float(u & 0xffff0000u); }

constexpr int NB = 4, SEQ = 8192, DM = 1024, MT = NB * SEQ;
constexpr int NHEAD = 8, HD = 64, QW = 1536;
constexpr int NE = 64, EFF = 256, NMOD = 6 * DM;
constexpr int RT = MT / 2;
constexpr float EPS = 1e-6f;
constexpr float LOG2E = 1.4426950408889634f;

constexpr size_t MiB = 1u << 20;
constexpr size_t WS_CTL = 0, CTL_BYTES = 1 * MiB;
constexpr size_t WS_SMALL = 1 * MiB;
constexpr size_t SM_MOD = 0, SM_GVEC = 98304, SM_CB = 114688, SM_KBAR = 131072, SM_WRH = 393216, SM_WRL = 524288;
constexpr size_t WS_W2T = 2 * MiB;
constexpr size_t WS_W1T = 35 * MiB;
constexpr size_t WS_WINT = 100 * MiB;
constexpr size_t WS_WBRT = 110 * MiB;
constexpr size_t WS_WOUTT = 112 * MiB;
constexpr size_t WS_H = 114 * MiB;
constexpr size_t WS_OB = 114 * MiB;
constexpr size_t WS_QSB = 178 * MiB;
constexpr size_t WS_PO = 178 * MiB;
constexpr size_t WS_QMB = 274 * MiB;
constexpr size_t WS_MERGED = 274 * MiB;
constexpr size_t WS_G = 370 * MiB;
constexpr size_t WS_LMB = 498 * MiB;
constexpr size_t WS_PLSE = 506 * MiB;
constexpr size_t WS_H2 = 100 * MiB;
constexpr size_t WS_TOKL = 132 * MiB;
constexpr size_t WS_WL = 136 * MiB;
constexpr size_t WS_ACT = 140 * MiB;
constexpr size_t WS_SLOTS = 220 * MiB;
constexpr size_t WS_TPOS = 508 * MiB;
constexpr size_t WS_END = 509 * MiB;
constexpr int CW_MBCUR = 0;
constexpr int CW_MOECUR = 1024;
constexpr int CW_BAR = 4096;

constexpr int RING_BYTES = 131072;
constexpr int MISC_OFF = RING_BYTES;
constexpr int LDS_BYTES = 163840;
constexpr int MO_STG = 16384;

#define XB_TMO      128
#define XB_XCNT(j)  (256  + 64 * (j))
#define XB_XSUB(j)  (1280 + 64 * (j))
#define XB_XGEN(j)  (2304 + 64 * (j))
#define XB_TOP      3328
#define XB_TOPGEN   3392
#define XCD_BAR_WORDS 3456
#define XB_SPIN_CAP (1u << 18)
__device__ __forceinline__ unsigned xb_ld(unsigned* p)              { return __hip_atomic_load(p, __ATOMIC_RELAXED, __HIP_MEMORY_SCOPE_AGENT); }
__device__ __forceinline__ unsigned xb_add(unsigned* p, unsigned v) { return __hip_atomic_fetch_add(p, v, __ATOMIC_RELAXED, __HIP_MEMORY_SCOPE_AGENT); }
__device__ __forceinline__ unsigned xb_xcc_id() { return (unsigned)__builtin_amdgcn_s_getreg((3 << 11) | 20) & 0xFu; }
#define XB_SPIN(cond, bar) do { unsigned _sp = 0; while (cond) { __builtin_amdgcn_s_sleep(1); \
    if ((++_sp & 255u) == 0u) { if (xb_ld(&(bar)[XB_TMO])) break; if (_sp > XB_SPIN_CAP) { atomicAdd(&(bar)[XB_TMO], 1u); break; } } } } while (0)
struct XcdBarrier { unsigned* bar; unsigned x; volatile LAS unsigned* st; };
__device__ __forceinline__ XcdBarrier xcd_barrier_post(unsigned* bar, volatile LAS unsigned* st) {
    XcdBarrier b; b.bar = bar; b.x = xb_xcc_id(); b.st = st;
    if (threadIdx.x == 0) (void)xb_add(&bar[XB_XCNT(b.x)], 1u);
    return b;
}
__device__ __forceinline__ void xcd_barrier_complete(unsigned* bar, unsigned x, unsigned& nloc, unsigned& nx) {
    const unsigned G = gridDim.x * gridDim.y * gridDim.z;
    unsigned sum, cnt, mine, sp = 0u;
    for (;;) {
        sum = 0u; cnt = 0u; mine = 0u;
#pragma unroll
        for (unsigned j = 0; j < 16; ++j) { const unsigned c = xb_ld(&bar[XB_XCNT(j)]); sum += c; cnt += (c > 0u) ? 1u : 0u; mine = (j == x) ? c : mine; }
        if (sum == G) break;
        __builtin_amdgcn_s_sleep(1);
        if ((++sp & 255u) == 0u) { if (xb_ld(&bar[XB_TMO])) break; if (sp > XB_SPIN_CAP) { atomicAdd(&bar[XB_TMO], 1u); break; } }
    }
    nloc = mine > 0u ? mine : 1u; nx = cnt > 0u ? cnt : 1u;
}
__device__ __forceinline__ void xcd_barrier(const XcdBarrier& b) {
    asm volatile("s_waitcnt vmcnt(0)" ::: "memory");
    __syncthreads();
    if (threadIdx.x == 0) {
        unsigned* bar = b.bar;
        __builtin_amdgcn_s_waitcnt(0);
        unsigned nloc = b.st[0], nx = b.st[1];
        const unsigned old = xb_add(&bar[XB_XSUB(b.x)], 1u);
        const unsigned gen = old / nloc;
        if (old + 1u == (gen + 1u) * nloc) {
            __builtin_amdgcn_fence(__ATOMIC_RELEASE, "agent");
            asm volatile("s_waitcnt vmcnt(0)" ::: "memory");
            const unsigned og = xb_add(&bar[XB_TOP], 1u);
            const unsigned tg = og / nx;
            if (og + 1u == (tg + 1u) * nx) xb_add(&bar[XB_TOPGEN], 1u);
            else XB_SPIN(xb_ld(&bar[XB_TOPGEN]) == tg, bar);
            __builtin_amdgcn_fence(__ATOMIC_ACQUIRE, "agent");
            xb_add(&bar[XB_XGEN(b.x)], 1u);
            asm volatile("s_waitcnt vmcnt(0)" ::: "memory");
        } else {
            XB_SPIN(xb_ld(&bar[XB_XGEN(b.x)]) == gen, bar);
            __builtin_amdgcn_fence(__ATOMIC_ACQUIRE, "agent");
            asm volatile("s_waitcnt vmcnt(0)" ::: "memory");
        }
    }
    __syncthreads();
}

namespace gm {
constexpr int BM = 256, BK = 64, HALF = 128, HTB = HALF * BK * 2, STAGE_BYTES = 8 * HTB, NXCD = 8, WGM = 8;
__host__ __device__ __forceinline__ int lds_byte(int r, int c) { const int st = (r >> 4) * 2 + (c >> 5), rr = r & 15, cc = c & 31, ob = rr * 64 + cc * 2; return st * 1024 + (ob ^ (((ob >> 9) & 1) << 5)); }
__host__ __device__ __forceinline__ void stage_rc(int b, int& R, int& C) { const int st = b / 1024, sb = b % 1024, swz = sb ^ (((sb >> 9) & 1) << 5); R = (st >> 1) * 16 + swz / 64; C = (st & 1) * 32 + (swz % 64) / 2; }
__host__ __device__ __forceinline__ int perm32(int rho) { const int n = rho >> 4, i = rho & 15; return 8 * (i >> 2) + 4 * n + (i & 3); }

struct UnitD { const char* a; const char* b; unsigned va[2][2]; int e0, e1, e2, e3; };

__device__ __forceinline__ bool static_tile(int M, int N, int G, int c, int i, int& pm, int& pn) {
    const int nM = M / BM, nN = N / BM, nwg = nM * nN;
    const long L = (long)i * G + c; if (L >= nwg) return false;
    int wgid = (int)L; { const int q = nwg / NXCD, r = nwg % NXCD, xcd = wgid % NXCD, off = wgid / NXCD; wgid = (xcd < r ? xcd * (q + 1) : r * (q + 1) + (xcd - r) * q) + off; }
    const int nig = WGM * nN, gid = wgid / nig, fm = gid * WGM, gsz = (nM - fm) < WGM ? (nM - fm) : WGM;
    pm = fm + ((wgid % nig) % gsz); pn = (wgid % nig) / gsz; return true;
}

template <bool PERM, bool HOOK = false, class Epi, class Sched>
__device__ __forceinline__ void gemm_phase(LAS unsigned char* lds, const int K, Sched& S, const Epi& E) {
    const int tid = threadIdx.x, wid = __builtin_amdgcn_readfirstlane(tid >> 6), lane = tid & 63, wr = wid >> 2, wc = wid & 3, fr = lane & 15, fq = lane >> 4;
    const int nt = K / BK;
    unsigned voffB[2];
#pragma unroll
    for (int i = 0; i < 2; ++i) { int R, C; stage_rc(tid * 16 + i * 8192, R, C); const int Rb = PERM ? ((R & ~31) + perm32(R & 31)) : R; voffB[i] = (unsigned)(Rb * K + C) * 2u; }
    const size_t kstep = (size_t)(BK * 2);
    const size_t hstep = (size_t)HALF * K * 2;
    const unsigned ldsw = (unsigned)wid * 1024u;
    const int aoff = lds_byte(wr * 64 + fr, fq * 8), boff = lds_byte(wc * 32 + fr, fq * 8);
#define GM_SA(b, h) (((b) * 2 + (h)) * HTB)
#define GM_SB(b, h) ((4 + (b) * 2 + (h)) * HTB)
#define GM_STAGE_A(bufoff, U, h, kb) do { _Pragma("unroll") for (int _i = 0; _i < 2; ++_i) \
        __builtin_amdgcn_global_load_lds((const unsigned*)((U).a + (kb) + (U).va[h][_i]), (LAS unsigned*)(lds + (bufoff) + ldsw + _i * 8192), 16, 0, 0); } while (0)
#define GM_STAGE_B(bufoff, U, h, kb) do { _Pragma("unroll") for (int _i = 0; _i < 2; ++_i) \
        __builtin_amdgcn_global_load_lds((const unsigned*)((U).b + (kb) + (size_t)(h) * hstep + voffB[_i]), (LAS unsigned*)(lds + (bufoff) + ldsw + _i * 8192), 16, 0, 0); } while (0)
#define GM_LDA(dst, b, h) do { _Pragma("unroll") for (int m = 0; m < 4; ++m) _Pragma("unroll") for (int k = 0; k < 2; ++k) dst[m][k] = *(const LAS bf16x8*)(lds + GM_SA(b, h) + aoff + m * 2048 + k * 1024); } while (0)
#define GM_LDB(dst, b, h) do { _Pragma("unroll") for (int n = 0; n < 2; ++n) _Pragma("unroll") for (int k = 0; k < 2; ++k) dst[n][k] = *(const LAS bf16x8*)(lds + GM_SB(b, h) + boff + n * 2048 + k * 1024); } while (0)
#define GM_MMA(ai, bj, At, Bt) do { __builtin_amdgcn_s_setprio(1); _Pragma("unroll") for (int m = 0; m < 4; ++m) _Pragma("unroll") for (int n = 0; n < 2; ++n) _Pragma("unroll") for (int k = 0; k < 2; ++k) \
        acc[ai][bj][m][n] = __builtin_amdgcn_mfma_f32_16x16x32_bf16(Bt[n][k], At[m][k], acc[ai][bj][m][n], 0, 0, 0); __builtin_amdgcn_s_setprio(0); } while (0)
#define GM_WAIT_V(n) asm volatile("s_waitcnt vmcnt(" #n ")" ::: "memory")
#define GM_WAIT_L(n) asm volatile("s_waitcnt lgkmcnt(" #n ")" ::: "memory")
#define GM_BAR __builtin_amdgcn_s_barrier()
#define GM_SCHED __builtin_amdgcn_sched_barrier(0)
    UnitD cur, nxt; int ui = 0;
    if (!S.next(0, cur)) return;
    f32x4 acc[2][2][4][2];
#pragma unroll
    for (int a = 0; a < 2; ++a)
#pragma unroll
        for (int b = 0; b < 2; ++b)
#pragma unroll
            for (int m = 0; m < 4; ++m)
#pragma unroll
                for (int n = 0; n < 2; ++n) acc[a][b][m][n] = (f32x4){0.f, 0.f, 0.f, 0.f};
    bf16x8 At[4][2], B0[2][2], B1[2][2];
    GM_STAGE_B(GM_SB(0, 0), cur, 0, 0); GM_STAGE_B(GM_SB(0, 1), cur, 1, 0); GM_STAGE_A(GM_SA(0, 0), cur, 0, 0); GM_STAGE_A(GM_SA(0, 1), cur, 1, 0);
    if (wr == 1) GM_BAR;
    GM_WAIT_V(2); GM_BAR;
    GM_STAGE_B(GM_SB(1, 0), cur, 0, kstep); GM_STAGE_A(GM_SA(1, 0), cur, 0, kstep); GM_STAGE_B(GM_SB(1, 1), cur, 1, kstep);
    GM_WAIT_V(6); GM_BAR;
    for (;;) {
        const bool has_next = S.next(ui + 1, nxt);
        if (!has_next) nxt = cur;
#pragma unroll 1
        for (int t = 0; t < nt; t += 2) {
            const bool last = (t == nt - 2);
            if constexpr (HOOK) { if (t == nt / 2) E.mid(acc, cur, wr, wc, fr, fq); }
            const size_t k1 = (size_t)(t + 1) * kstep;
            UnitD U2 = cur; size_t k2 = (size_t)(t + 2) * kstep;
            if (last) { U2 = nxt; k2 = 0; }
            const size_t k3 = k2 + kstep;
            GM_LDB(B0, 0, 0); GM_LDB(B1, 0, 1); GM_SCHED; GM_LDA(At, 0, 0); GM_STAGE_A(GM_SA(1, 1), cur, 1, k1);
            GM_WAIT_V(8); GM_WAIT_L(0); GM_BAR; GM_MMA(0, 0, At, B0); GM_MMA(0, 1, At, B1); GM_BAR; GM_SCHED;
            GM_LDA(At, 0, 1); GM_STAGE_B(GM_SB(0, 0), U2, 0, k2); GM_STAGE_B(GM_SB(0, 1), U2, 1, k2); GM_STAGE_A(GM_SA(0, 0), U2, 0, k2);
            GM_WAIT_V(8); GM_WAIT_L(0); GM_BAR; GM_MMA(1, 0, At, B0); GM_MMA(1, 1, At, B1); GM_BAR; GM_SCHED;
            GM_LDB(B0, 1, 0); GM_LDB(B1, 1, 1); GM_SCHED; GM_LDA(At, 1, 0); GM_STAGE_A(GM_SA(0, 1), U2, 1, k2);
            GM_WAIT_V(8); GM_WAIT_L(0); GM_BAR; GM_MMA(0, 0, At, B0); GM_MMA(0, 1, At, B1); GM_BAR; GM_SCHED;
            GM_LDA(At, 1, 1); GM_STAGE_B(GM_SB(1, 0), U2, 0, k3); GM_STAGE_B(GM_SB(1, 1), U2, 1, k3); GM_STAGE_A(GM_SA(1, 0), U2, 0, k3);
            GM_WAIT_V(8); GM_WAIT_L(0); GM_BAR; GM_MMA(1, 0, At, B0); GM_MMA(1, 1, At, B1); GM_BAR; GM_SCHED;
        }
        if (wr == 0) GM_BAR;
        E(acc, cur, wr, wc, fr, fq);
        if (!has_next) break;
#pragma unroll
        for (int a = 0; a < 2; ++a)
#pragma unroll
            for (int b = 0; b < 2; ++b)
#pragma unroll
                for (int m = 0; m < 4; ++m)
#pragma unroll
                    for (int n = 0; n < 2; ++n) acc[a][b][m][n] = (f32x4){0.f, 0.f, 0.f, 0.f};
        cur = nxt; ++ui;
        if (wr == 1) GM_BAR;
    }
    GM_WAIT_V(0);
    GM_BAR;
#undef GM_SA
#undef GM_SB
#undef GM_STAGE_A
#undef GM_STAGE_B
#undef GM_LDA
#undef GM_LDB
#undef GM_MMA
#undef GM_WAIT_V
#undef GM_WAIT_L
#undef GM_BAR
#undef GM_SCHED
}
__device__ __forceinline__ void stage_geom(int tid, int (&R)[2], int (&C)[2]) {
#pragma unroll
    for (int i = 0; i < 2; ++i) stage_rc(tid * 16 + i * 8192, R[i], C[i]);
}
}

struct Args { const float* in[20]; float* out; unsigned char* ws; int ph_lo, ph_hi; };
struct Ctx {
    LAS unsigned char* lds;
    unsigned char* ws;
    const LAS unsigned long long* intab;
    float* out;
    int tid, lane, wave, G, bid;
};
#define LDS_WAIT() asm volatile("s_waitcnt lgkmcnt(0)" ::: "memory")
__device__ __forceinline__ const float* inp(const Ctx& F, int i) {
    const unsigned long long v = F.intab[i];
    const unsigned lo = __builtin_amdgcn_readfirstlane((unsigned)v), hi = __builtin_amdgcn_readfirstlane((unsigned)(v >> 32));
    return (const float*)(GAS const float*)(((unsigned long long)hi << 32) | lo);
}
template <class P> __device__ __forceinline__ P launder_ptr(P p) {
    unsigned long long v = (unsigned long long)p; unsigned lo = (unsigned)v, hi = (unsigned)(v >> 32);
    asm volatile("" : "+v"(lo), "+v"(hi));
    lo = __builtin_amdgcn_readfirstlane(lo); hi = __builtin_amdgcn_readfirstlane(hi);
    return (P)(GAS unsigned char*)(((unsigned long long)hi << 32) | lo);
}
__device__ __forceinline__ void launder(Ctx& F) {
    int t = F.tid, g = F.G, bid = F.bid;
    asm volatile("" : "+v"(t), "+v"(g), "+v"(bid));
    F.tid = t; F.G = __builtin_amdgcn_readfirstlane(g); F.bid = __builtin_amdgcn_readfirstlane(bid); F.lane = t & 63; F.wave = __builtin_amdgcn_readfirstlane(t >> 6);
    F.ws = launder_ptr(F.ws); F.out = launder_ptr(F.out);
}
__device__ __forceinline__ float wave_sum(float v) {
#pragma unroll
    for (int o = 1; o < 64; o <<= 1) v += __shfl_xor(v, o);
    return v;
}
__device__ __forceinline__ int lds_add(LAS int* p, int v) { return __hip_atomic_fetch_add(p, v, __ATOMIC_RELAXED, __HIP_MEMORY_SCOPE_WORKGROUP); }
__device__ __forceinline__ float sigmoidf_(float x) { return 1.f / (1.f + __expf(-x)); }
__device__ __forceinline__ float siluf_(float x) { return x / (1.f + __expf(-x)); }

enum { I_X = 0, I_C, I_N1G, I_N2G, I_WADA, I_BADA, I_WIN, I_WBSB, I_WBMB, I_WOUT, I_WR, I_RB, I_WGE, I_WUE, I_WDE, I_WGS, I_WUS, I_WDS, I_RELB, I_FG };

__device__ __forceinline__ void transpose_item(const float* W, int ldn, int k0, int n0, bf16_t* WT, int Kdst, int drow0, LAS float* scr, int lane) {
    const float* wp = W + (size_t)(k0 + (lane >> 3)) * ldn + n0 + 4 * (lane & 7);
    f32x4 v[8];
#pragma unroll
    for (int i = 0; i < 8; ++i) v[i] = *(const f32x4*)(wp + (size_t)(8 * i) * ldn);
#pragma unroll
    for (int i = 0; i < 8; ++i) { LAS float* d = scr + (8 * i + (lane >> 3)) * 33 + 4 * (lane & 7); d[0] = v[i].x; d[1] = v[i].y; d[2] = v[i].z; d[3] = v[i].w; }
    LDS_WAIT(); asm volatile("" ::: "memory");
    const int c = lane & 7;
#pragma unroll
    for (int j = 0; j < 4; ++j) { const int n = (lane >> 3) + 8 * j; const LAS float* s = scr + (8 * c) * 33 + n;
        u32x4 o; o.x = cvtpk(s[0 * 33], s[1 * 33]); o.y = cvtpk(s[2 * 33], s[3 * 33]); o.z = cvtpk(s[4 * 33], s[5 * 33]); o.w = cvtpk(s[6 * 33], s[7 * 33]);
        *(u32x4*)(WT + (size_t)(drow0 + n) * Kdst + k0 + 8 * c) = o; }
    LDS_WAIT(); asm volatile("" ::: "memory");
}
__device__ __forceinline__ void phase0(Ctx& F) {
    LAS float* silc = (LAS float*)(F.lds + MISC_OFF - 0);
    silc = (LAS float*)(F.lds + 0);
    for (int i = F.tid; i < 4 * DM; i += 512) silc[i] = siluf_(inp(F, I_C)[i]);
    __syncthreads();
    float* mod = (float*)(F.ws + WS_SMALL + SM_MOD);
    {
        const int gw = F.wave * F.G + F.bid;
        const int c = F.lane & 15, kp = F.lane >> 4;
        const float* wada = inp(F, I_WADA);
        for (int item = gw; item < NMOD / 16; item += 8 * F.G) {
            const int col = item * 16 + c;
            float a0 = 0.f, a1 = 0.f, a2 = 0.f, a3 = 0.f;
#pragma unroll 32
            for (int k = kp; k < DM; k += 4) { const float w = wada[(size_t)k * NMOD + col]; a0 += silc[k] * w; a1 += silc[DM + k] * w; a2 += silc[2 * DM + k] * w; a3 += silc[3 * DM + k] * w; }
            a0 += __shfl_xor(a0, 16); a0 += __shfl_xor(a0, 32); a1 += __shfl_xor(a1, 16); a1 += __shfl_xor(a1, 32);
            a2 += __shfl_xor(a2, 16); a2 += __shfl_xor(a2, 32); a3 += __shfl_xor(a3, 16); a3 += __shfl_xor(a3, 32);
            if (kp == 0) { const float bb = inp(F, I_BADA)[col]; mod[col] = a0 + bb; mod[NMOD + col] = a1 + bb; mod[2 * NMOD + col] = a2 + bb; mod[3 * NMOD + col] = a3 + bb; }
        }
    }
    __syncthreads();
    {
        LAS float* scr = (LAS float*)(F.lds + F.wave * 16384);
        const int gw = F.bid * 8 + F.wave, NGW = F.G * 8, lane = F.lane;
        constexpr int I_IN = 16 * 160, I_BR = 8 * 32, I_OUT = 16 * 32, I_EXP = 384, NIT = I_IN + 2 * I_BR + I_OUT + 65 * I_EXP;
        const float* p_win = inp(F, I_WIN); const float* p_bsb = inp(F, I_WBSB); const float* p_bmb = inp(F, I_WBMB); const float* p_out = inp(F, I_WOUT);
        const float* p_ge = inp(F, I_WGE); const float* p_ue = inp(F, I_WUE); const float* p_de = inp(F, I_WDE); const float* p_gs = inp(F, I_WGS); const float* p_us = inp(F, I_WUS); const float* p_ds = inp(F, I_WDS);
#define TD_GET(IT, SRC, LDN, DST, KD) do { int r = (IT); \
            if (r < I_IN) { const int kb = r / 160, nb = r % 160; SRC = p_win + (size_t)(kb * 64) * 5120 + nb * 32; LDN = 5120; DST = (bf16_t*)(F.ws + WS_WINT) + (size_t)(nb * 32) * 1024 + kb * 64; KD = 1024; } \
            else if ((r -= I_IN) < I_BR) { const int kb = r / 32, nb = r % 32; SRC = p_bsb + (size_t)(kb * 64) * 1024 + nb * 32; LDN = 1024; DST = (bf16_t*)(F.ws + WS_WBRT) + (size_t)(nb * 32) * 1024 + kb * 64; KD = 1024; } \
            else if ((r -= I_BR) < I_BR) { const int kb = r / 32, nb = r % 32; SRC = p_bmb + (size_t)(kb * 64) * 1024 + nb * 32; LDN = 1024; DST = (bf16_t*)(F.ws + WS_WBRT) + (size_t)(nb * 32) * 1024 + 512 + kb * 64; KD = 1024; } \
            else if ((r -= I_BR) < I_OUT) { const int kb = r / 32, nb = r % 32; SRC = p_out + (size_t)(kb * 64) * 1024 + nb * 32; LDN = 1024; DST = (bf16_t*)(F.ws + WS_WOUTT) + (size_t)(nb * 32) * 1024 + kb * 64; KD = 1024; } \
            else { r -= I_OUT; const int e = r / I_EXP; r -= e * I_EXP; \
                if (r < 128) { const int kb = r / 8, n0 = (r % 8) * 32; SRC = (e < NE ? p_ge + (size_t)e * DM * EFF : p_gs) + (size_t)(kb * 64) * EFF + n0; LDN = EFF; \
                    DST = (bf16_t*)(F.ws + WS_W1T) + ((size_t)e * 512 + (n0 >> 7) * 256 + (n0 & 127)) * 1024 + kb * 64; KD = 1024; } \
                else if (r < 256) { r -= 128; const int kb = r / 8, n0 = (r % 8) * 32; SRC = (e < NE ? p_ue + (size_t)e * DM * EFF : p_us) + (size_t)(kb * 64) * EFF + n0; LDN = EFF; \
                    DST = (bf16_t*)(F.ws + WS_W1T) + ((size_t)e * 512 + (n0 >> 7) * 256 + 128 + (n0 & 127)) * 1024 + kb * 64; KD = 1024; } \
                else { r -= 256; const int kb = r / 32, nb = r % 32; SRC = (e < NE ? p_de + (size_t)e * EFF * DM : p_ds) + (size_t)(kb * 64) * DM + nb * 32; LDN = DM; \
                    DST = (bf16_t*)(F.ws + WS_W2T) + ((size_t)e * 1024 + nb * 32) * 256 + kb * 64; KD = 256; } } } while (0)
#define TD_LOAD(V, SRC, LDN) do { const float* wp_ = (SRC) + (size_t)(lane >> 3) * (LDN) + 4 * (lane & 7); _Pragma("unroll") for (int i = 0; i < 8; ++i) V[i] = *(const f32x4*)(wp_ + (size_t)(8 * i) * (LDN)); } while (0)
#define TD_PROC(V, DST, KD) do { \
            _Pragma("unroll") for (int i = 0; i < 8; ++i) { LAS float* d = scr + (8 * i + (lane >> 3)) * 33 + 4 * (lane & 7); d[0] = V[i].x; d[1] = V[i].y; d[2] = V[i].z; d[3] = V[i].w; } \
            LDS_WAIT(); asm volatile("" ::: "memory"); \
            _Pragma("unroll") for (int j = 0; j < 4; ++j) { const int n = (lane >> 3) + 8 * j; const LAS float* sp = scr + (8 * (lane & 7)) * 33 + n; \
                u32x4 o; o.x = cvtpk(sp[0 * 33], sp[1 * 33]); o.y = cvtpk(sp[2 * 33], sp[3 * 33]); o.z = cvtpk(sp[4 * 33], sp[5 * 33]); o.w = cvtpk(sp[6 * 33], sp[7 * 33]); \
                *(u32x4*)((DST) + (size_t)n * (KD) + 8 * (lane & 7)) = o; } \
            LDS_WAIT(); asm volatile("" ::: "memory"); } while (0)
        const float* srcA = nullptr; const float* srcB = nullptr; bf16_t* dstA = nullptr; bf16_t* dstB = nullptr; int ldA = 0, ldB = 0, kdA = 0, kdB = 0;
        f32x4 vA[8], vB[8];
        int it = 2 * gw;
        if (it < NIT) { TD_GET(it, srcA, ldA, dstA, kdA); TD_GET(it + 1, srcB, ldB, dstB, kdB); TD_LOAD(vA, srcA, ldA); TD_LOAD(vB, srcB, ldB); }
        for (; it < NIT; it += 2 * NGW) {
            const float* srcAn = srcA; const float* srcBn = srcB; bf16_t* dstAn = dstA; bf16_t* dstBn = dstB; int ldAn = ldA, ldBn = ldB, kdAn = kdA, kdBn = kdB;
            f32x4 vAn[8], vBn[8];
            const bool has_next = it + 2 * NGW < NIT;
            if (has_next) { TD_GET(it + 2 * NGW, srcAn, ldAn, dstAn, kdAn); TD_GET(it + 2 * NGW + 1, srcBn, ldBn, dstBn, kdBn); TD_LOAD(vAn, srcAn, ldAn); TD_LOAD(vBn, srcBn, ldBn); }
            TD_PROC(vA, dstA, kdA);
            TD_PROC(vB, dstB, kdB);
            if (has_next) {
#pragma unroll
                for (int i = 0; i < 8; ++i) { vA[i] = vAn[i]; vB[i] = vBn[i]; }
                srcA = srcAn; srcB = srcBn; dstA = dstAn; dstB = dstBn; ldA = ldAn; ldB = ldBn; kdA = kdAn; kdB = kdBn; }
        }
#undef TD_PROC
#undef TD_GET
#undef TD_LOAD
    }
    {
        bf16_t* wrh = (bf16_t*)(F.ws + WS_SMALL + SM_WRH); bf16_t* wrl = (bf16_t*)(F.ws + WS_SMALL + SM_WRL);
        const float* wr = inp(F, I_WR);
        for (int i = F.bid * 512 + F.tid; i < NE * DM; i += F.G * 512) { const int e = i >> 10, k = i & 1023; const float v = wr[k * NE + e];
            const unsigned h = cvtpk(v, 0.f) & 0xffffu; wrh[i] = (bf16_t)h; wrl[i] = (bf16_t)(cvtpk(v - bflo(h), 0.f) & 0xffffu); }
    }
}

__device__ __forceinline__ void phase1(Ctx& F) {
    const float* mod = (const float*)(F.ws + WS_SMALL + SM_MOD);
    const float* x = inp(F, I_X); const float* g1 = inp(F, I_N1G);
    bf16_t* H = (bf16_t*)(F.ws + WS_H);
    const int gw = F.bid * 8 + F.wave, NGW = F.G * 8;
    if (gw < 256) {
        const int b = gw >> 6, e = gw & 63; const float* wr = inp(F, I_WR); float a = 0.f;
#pragma unroll 4
        for (int k = F.lane; k < DM; k += 64) a += mod[b * NMOD + 3 * DM + k] * wr[k * NE + e];
        a = wave_sum(a);
        if (F.lane == 0) ((float*)(F.ws + WS_SMALL + SM_CB))[gw] = a;
    }
    if (F.bid == 32) {
        float* gvec = (float*)(F.ws + WS_SMALL + SM_GVEC); const float* g2 = inp(F, I_N2G);
        for (int i = F.tid; i < 4 * DM; i += 512) { const int b = i >> 10, k = i & 1023; gvec[i] = g2[k] * (1.f + mod[b * NMOD + 4 * DM + k]); }
    }
    for (int m0 = gw; m0 < MT; m0 += 2 * NGW) {
        const int m1 = m0 + NGW;
        const bool two = m1 < MT;
        const f32x4* xr0 = (const f32x4*)(x + (size_t)m0 * DM) + F.lane; const f32x4* xr1 = (const f32x4*)(x + (size_t)(two ? m1 : m0) * DM) + F.lane;
        f32x4 v0[4], v1[4]; float s0 = 0.f, s1 = 0.f;
#pragma unroll
        for (int j = 0; j < 4; ++j) { v0[j] = xr0[64 * j]; v1[j] = xr1[64 * j]; }
#pragma unroll
        for (int j = 0; j < 4; ++j) { s0 += (v0[j].x * v0[j].x + v0[j].y * v0[j].y) + (v0[j].z * v0[j].z + v0[j].w * v0[j].w); s1 += (v1[j].x * v1[j].x + v1[j].y * v1[j].y) + (v1[j].z * v1[j].z + v1[j].w * v1[j].w); }
        const float r0 = rsqrtf(wave_sum(s0) * (1.f / DM) + EPS), r1 = rsqrtf(wave_sum(s1) * (1.f / DM) + EPS);
        const int b0 = m0 / SEQ, b1 = (two ? m1 : m0) / SEQ;
        u32x2* o0 = (u32x2*)(H + (size_t)m0 * DM) + F.lane; u32x2* o1 = (u32x2*)(H + (size_t)(two ? m1 : m0) * DM) + F.lane;
#pragma unroll
        for (int j = 0; j < 4; ++j) {
            const int col = 4 * F.lane + 256 * j;
            const f32x4 g = *(const f32x4*)(g1 + col);
            const f32x4 h0 = (v0[j] * r0) * g * (*(const f32x4*)(mod + b0 * NMOD + DM + col) + 1.0f) + *(const f32x4*)(mod + b0 * NMOD + col);
            const f32x4 h1 = (v1[j] * r1) * g * (*(const f32x4*)(mod + b1 * NMOD + DM + col) + 1.0f) + *(const f32x4*)(mod + b1 * NMOD + col);
            u32x2 w; w.x = cvtpk(h0.x, h0.y); w.y = cvtpk(h0.z, h0.w); o0[64 * j] = w;
            if (two) { w.x = cvtpk(h1.x, h1.y); w.y = cvtpk(h1.z, h1.w); o1[64 * j] = w; }
        }
    }
}

struct ProjSched {
    const char* A; const char* Bt; int G, c; int R[2], C[2];
    __device__ __forceinline__ bool next(int i, gm::UnitD& u) {
        int pm, pn; if (!gm::static_tile(MT, 5120, G, c, i, pm, pn)) return false;
        u.a = A; u.b = Bt + (size_t)pn * 256 * 1024 * 2;
#pragma unroll
        for (int h = 0; h < 2; ++h)
#pragma unroll
            for (int j = 0; j < 2; ++j) u.va[h][j] = (unsigned)((pm * 256 + h * 128 + R[j]) * 1024 + C[j]) * 2u;
        u.e0 = pm; u.e1 = pn; u.e2 = 0; u.e3 = 0; return true;
    }
};
struct EpiProj {
    bf16_t* qsb; bf16_t* qmb; bf16_t* g;
    __device__ __forceinline__ void operator()(const f32x4 (&acc)[2][2][4][2], const gm::UnitD& u, int wr, int wc, int fr, int fq) const {
        const int pm = u.e0, pn = u.e1;
        bf16_t* base; int ldc, colt; float sc = 1.f;
        if (pn < 6) { base = qsb; ldc = QW; colt = pn * 256; if (pn < 2) sc = 0.125f; }
        else if (pn < 12) { base = qmb; ldc = QW; colt = (pn - 6) * 256; if (pn < 8) sc = 0.125f; }
        else { base = g; ldc = 2048; colt = (pn - 12) * 256; }
        const int row0 = pm * 256 + wr * 64 + fr, col0 = colt + wc * 32 + 8 * fq;
#pragma unroll
        for (int ai = 0; ai < 2; ++ai)
#pragma unroll
            for (int m = 0; m < 4; ++m) { bf16_t* rowp = base + (size_t)(row0 + ai * 128 + m * 16) * ldc + col0;
#pragma unroll
                for (int bj = 0; bj < 2; ++bj) { const f32x4 v0 = acc[ai][bj][m][0] * sc, v1 = acc[ai][bj][m][1] * sc;
                    u32x4 w; w.x = cvtpk(v0[0], v0[1]); w.y = cvtpk(v0[2], v0[3]); w.z = cvtpk(v1[0], v1[1]); w.w = cvtpk(v1[2], v1[3]);
                    *(u32x4*)(rowp + bj * 128) = w; } }
    }
};
__device__ __forceinline__ void phase2(Ctx& F) {
    ProjSched S; S.A = (const char*)(F.ws + WS_H); S.Bt = (const char*)(F.ws + WS_WINT); S.G = F.G; S.c = F.bid; gm::stage_geom(F.tid, S.R, S.C);
    EpiProj E{(bf16_t*)(F.ws + WS_QSB), (bf16_t*)(F.ws + WS_QMB), (bf16_t*)(F.ws + WS_G)};
    gm::gemm_phase<true>(F.lds, 1024, S, E);
}

__device__ __forceinline__ int crow(int r, int hi) { return (r & 3) + 8 * (r >> 2) + 4 * hi; }
typedef short v4i16_t __attribute__((ext_vector_type(4)));
__device__ __forceinline__ s16x4 vtr(const LAS unsigned char* p) { return __builtin_bit_cast(s16x4, __builtin_amdgcn_ds_read_tr16_b64_v4i16((LAS v4i16_t*)p)); }
__device__ __forceinline__ void pv64(f32x16 (&o)[2], const LAS unsigned char* vt, int lane, const u32x4 (&pw)[4]) {
    const int hi = lane >> 5;
    const LAS unsigned char* vb = vt + ((lane >> 4) & 1) * 32 + (lane & 3) * 8 + (4 * hi + ((lane & 15) >> 2)) * 64;
#pragma unroll
    for (int d0 = 0; d0 < 2; ++d0)
#pragma unroll
        for (int ks = 0; ks < 4; ++ks) {
            const s16x4 lo = vtr(vb + d0 * 4096 + ks * 1024), hh = vtr(vb + d0 * 4096 + ks * 1024 + 512);
            const bf16x8 bv = (bf16x8){lo[0], lo[1], lo[2], lo[3], hh[0], hh[1], hh[2], hh[3]};
            o[d0] = __builtin_amdgcn_mfma_f32_32x32x16_bf16(__builtin_bit_cast(bf16x8, pw[ks]), bv, o[d0], 0, 0, 0);
        }
}
__device__ __forceinline__ void store_o_tile(const f32x16 (&o)[2], LAS unsigned char* stgb, int lane, bf16_t* dst0, size_t row_pitch) {
    const int r32 = lane & 31, hi = lane >> 5;
    LAS bf16_t* stg = (LAS bf16_t*)stgb;
#pragma unroll
    for (int r = 0; r < 16; ++r) { const int orow = crow(r, hi);
#pragma unroll
        for (int d0 = 0; d0 < 2; ++d0) stg[orow * 64 + d0 * 32 + r32] = (bf16_t)(cvtpk(o[d0][r], 0.f) & 0xffffu); }
    LDS_WAIT();
#pragma unroll
    for (int i = 0; i < 4; ++i) { const int row = i * 8 + (lane >> 3), ch = lane & 7; const u32x4 v = *(const LAS u32x4*)(stg + row * 64 + ch * 8); *(u32x4*)(dst0 + (size_t)row * row_pitch + ch * 8) = v; }
    LDS_WAIT();
}

template <bool MASKED>
__device__ __forceinline__ void sb_tile(const f32x16 (&z)[2], float& P, u32x4 (&pw)[4], int k0, int qpos, int hi) {
    f32x16 be[2], nb[2];
#pragma unroll
    for (int p = 0; p < 2; ++p)
#pragma unroll
        for (int r = 0; r < 16; ++r) {
            const float zz = __builtin_amdgcn_fmed3f(z[p][r] * LOG2E, -126.f, 126.f);
            const float t = __builtin_amdgcn_exp2f(-zz), b_ = __builtin_amdgcn_rcpf(1.f + t);
            float n_ = t * b_, bb = b_;
            if (MASKED) { const bool valid = (k0 + 32 * p + crow(r, hi)) < qpos; n_ = valid ? n_ : 1.f; bb = valid ? bb : 0.f; }
            be[p][r] = bb; nb[p][r] = n_;
        }
    float Gp[8], PG[8], off[8];
#pragma unroll
    for (int idx = 0; idx < 8; ++idx) { const int p = idx >> 2, g4 = (idx & 3) * 4; Gp[idx] = (nb[p][g4] * nb[p][g4 + 1]) * (nb[p][g4 + 2] * nb[p][g4 + 3]); }
#pragma unroll
    for (int idx = 0; idx < 8; ++idx) PG[idx] = __shfl_xor(Gp[idx], 32);
    float run = P;
#pragma unroll
    for (int idx = 7; idx >= 0; --idx) { off[idx] = hi ? run : run * PG[idx]; run *= (Gp[idx] * PG[idx]); }
    P = run;
#pragma unroll
    for (int idx = 0; idx < 8; ++idx) { const int p = idx >> 2, g4 = (idx & 3) * 4; float c = off[idx]; float a[4];
#pragma unroll
        for (int j = 3; j >= 0; --j) { a[j] = be[p][g4 + j] * c; c *= nb[p][g4 + j]; }
        pw[idx >> 1][(idx & 1) * 2] = cvtpk(a[0], a[1]); pw[idx >> 1][(idx & 1) * 2 + 1] = cvtpk(a[2], a[3]); }
}
__device__ __forceinline__ void sb_unit(Ctx& F, int bh, int qt, LAS unsigned char* vl) {
    const int lane = F.lane, r32 = lane & 31, hi = lane >> 5;
    const int b = bh >> 3, h = bh & 7, q0 = qt * 32, qpos = q0 + r32;
    const bf16_t* base = (const bf16_t*)(F.ws + WS_QSB) + (size_t)b * SEQ * QW + h * 64;
    const bf16_t* Kb = base + 512 + (size_t)r32 * QW + hi * 8; const bf16_t* Vb = base + 1024 + (size_t)(lane >> 2) * QW + (lane & 3) * 8;
    bf16x8 qr[4];
#pragma unroll
    for (int d0 = 0; d0 < 4; ++d0) qr[d0] = *(const bf16x8*)(base + (size_t)qpos * QW + d0 * 16 + hi * 8);
    float P = 1.f; f32x16 o[2]; o[0] = f32x16{}; o[1] = f32x16{};
    bf16x8 kfn[8];
    const int kt0 = q0 >> 6; int kt = kt0, cur = 0;
#define SB_PREFETCH(KT, BUF) do { const size_t ko_ = (size_t)(KT) * 64 * QW; \
        _Pragma("unroll") for (int d0 = 0; d0 < 4; ++d0) _Pragma("unroll") for (int hf = 0; hf < 2; ++hf) kfn[2 * d0 + hf] = *(const bf16x8*)(Kb + ko_ + (size_t)(32 * hf) * QW + d0 * 16); \
        _Pragma("unroll") for (int p = 0; p < 8; ++p) __builtin_amdgcn_global_load_lds((const unsigned*)(Vb + ko_ + (size_t)(16 * (p & 3)) * QW + (p >> 2) * 32), (LAS unsigned*)(vl + (BUF) * 8192 + p * 1024), 16, 0, 0); } while (0)
    SB_PREFETCH(kt, 0);
#pragma unroll 1
    for (; kt >= 0; --kt) {
        if (__all(P == 0.f)) break;
        f32x16 z[2]; z[0] = f32x16{}; z[1] = f32x16{};
#pragma unroll
        for (int d0 = 0; d0 < 4; ++d0) { z[0] = __builtin_amdgcn_mfma_f32_32x32x16_bf16(kfn[2 * d0], qr[d0], z[0], 0, 0, 0); z[1] = __builtin_amdgcn_mfma_f32_32x32x16_bf16(kfn[2 * d0 + 1], qr[d0], z[1], 0, 0, 0); }
        asm volatile("" : "+v"(z[0]), "+v"(z[1]));
        { const int ktn = kt > 0 ? kt - 1 : 0; SB_PREFETCH(ktn, cur ^ 1); }
        u32x4 pw[4];
        if (kt == kt0) sb_tile<true>(z, P, pw, kt * 64, qpos, hi); else sb_tile<false>(z, P, pw, kt * 64, qpos, hi);
        asm volatile("s_waitcnt vmcnt(16)" ::: "memory");
        pv64(o, vl + cur * 8192, lane, pw);
        cur ^= 1;
    }
#undef SB_PREFETCH
    asm volatile("s_waitcnt vmcnt(0)" ::: "memory");
    bf16_t* dst = (bf16_t*)(F.ws + WS_OB) + (size_t)(b * SEQ + q0) * 1024 + h * 64;
    store_o_tile(o, vl, lane, dst, 1024);
}
__device__ __forceinline__ void phase3(Ctx& F) {
    {
        float* kbar = (float*)(F.ws + WS_SMALL + SM_KBAR);
        const int gwk = F.wave * F.G + F.bid;
        for (int it = gwk; it < NB * 32 * 8; it += 8 * F.G) {
            const int u = it >> 3, hh = it & 7, rs = F.lane >> 3, ch = F.lane & 7;
            const bf16_t* kp = (const bf16_t*)(F.ws + WS_QMB) + (size_t)(u * 256 + rs) * QW + 512 + hh * 64 + ch * 8;
            float a[8];
#pragma unroll
            for (int j = 0; j < 8; ++j) a[j] = 0.f;
#pragma unroll 4
            for (int g = 0; g < 4; ++g) {
                u32x4 w[8];
#pragma unroll
                for (int i = 0; i < 8; ++i) w[i] = *(const u32x4*)(kp + (size_t)(g * 64 + i * 8) * QW);
#pragma unroll
                for (int i = 0; i < 8; ++i) { a[0] += bflo(w[i].x); a[1] += bfhi(w[i].x); a[2] += bflo(w[i].y); a[3] += bfhi(w[i].y); a[4] += bflo(w[i].z); a[5] += bfhi(w[i].z); a[6] += bflo(w[i].w); a[7] += bfhi(w[i].w); }
            }
#pragma unroll
            for (int j = 0; j < 8; ++j) { a[j] += __shfl_xor(a[j], 8); a[j] += __shfl_xor(a[j], 16); a[j] += __shfl_xor(a[j], 32); }
            if (rs == 0) { float* dst = kbar + u * 512 + hh * 64 + ch * 8;
                *(f32x4*)dst = (f32x4){a[0], a[1], a[2], a[3]} * (1.f / 256.f); *(f32x4*)(dst + 4) = (f32x4){a[4], a[5], a[6], a[7]} * (1.f / 256.f); }
        }
    }
    LAS unsigned char* vl = F.lds + F.wave * 16384;
    const int gw = F.bid * 8 + F.wave, NGW = F.G * 8;
    for (int u = gw; u < 32 * 256; u += NGW) sb_unit(F, u >> 8, u & 255, vl);
}

constexpr int MO_LUT = 0, MO_PRE = 4224, MO_WSF = 8320, MO_ENT = 12416, MO_ST = 16368;
__device__ __forceinline__ int mb_list_off(int j) { return 256 * (31 * j - (j * (j - 1)) / 2); }
constexpr int MB_LIST_STRIDE = 126976;
__device__ __forceinline__ int t5_bucket_dev(int n) {
    if (n < 16) return n;
    int large = 16 + (int)(logf((float)n / 16.f) / 2.0794415416798357f * 16.f);
    return large < 31 ? large : 31;
}
__device__ __forceinline__ void build_lut(Ctx& F) {
    LAS float* lut = (LAS float*)(F.lds + MISC_OFF + MO_LUT);
    for (int i = F.tid; i < 8 * 132; i += 512) { const int h = i / 132, d = i % 132; lut[i] = inp(F, I_RELB)[h * 32 + t5_bucket_dev(d < 128 ? d : 128)] * LOG2E; }
}
__device__ __forceinline__ void phase4(Ctx& F) {
    LAS int* lcnt = (LAS int*)(F.lds + MISC_OFF + MO_PRE); LAS int* lbase = lcnt + 32;
    const float* kbar = (const float*)(F.ws + WS_SMALL + SM_KBAR);
    unsigned* cur = (unsigned*)(F.ws + WS_CTL) + CW_MBCUR;
    unsigned short* lists = (unsigned short*)(F.ws + WS_LMB);
    const int lane = F.lane, r32 = lane & 31, hi = lane >> 5;
    for (int u = F.bid; u < 32 * 31; u += F.G) {
        const int bh = u / 31, i = 1 + (u % 31), b = bh >> 3, h = bh & 7;
        if (F.tid < 32) lcnt[F.tid] = 0;
        __syncthreads();
        const int qpos = i * 256 + F.wave * 32 + r32;
        const float* kp = kbar + (size_t)(b * 32 + r32) * 512 + h * 64 + hi * 8;
        const bf16_t* qp = (const bf16_t*)(F.ws + WS_QMB) + (size_t)(b * SEQ + qpos) * QW + h * 64 + hi * 8;
        f32x16 gt = f32x16{};
#pragma unroll
        for (int s4 = 0; s4 < 4; ++s4) {
            const f32x4 k0 = *(const f32x4*)(kp + 16 * s4), k1 = *(const f32x4*)(kp + 16 * s4 + 4);
            const bf16x8 qf = *(const bf16x8*)(qp + 16 * s4);
            const unsigned a0 = cvtpk(k0.x, k0.y), a1 = cvtpk(k0.z, k0.w), a2 = cvtpk(k1.x, k1.y), a3 = cvtpk(k1.z, k1.w);
            const u32x4 kh = (u32x4){a0, a1, a2, a3};
            const u32x4 kl = (u32x4){cvtpk(k0.x - bflo(a0), k0.y - bfhi(a0)), cvtpk(k0.z - bflo(a1), k0.w - bfhi(a1)), cvtpk(k1.x - bflo(a2), k1.y - bfhi(a2)), cvtpk(k1.z - bflo(a3), k1.w - bfhi(a3))};
            gt = __builtin_amdgcn_mfma_f32_32x32x16_bf16(__builtin_bit_cast(bf16x8, kl), qf, gt, 0, 0, 0);
            gt = __builtin_amdgcn_mfma_f32_32x32x16_bf16(__builtin_bit_cast(bf16x8, kh), qf, gt, 0, 0, 0);
        }
        float v0 = -INFINITY, v1 = -INFINITY, v2 = -INFINITY; int j0 = 64, j1 = 64, j2 = 64;
#pragma unroll
        for (int r = 0; r < 16; ++r) { const int j = crow(r, hi); const float g = j < i ? gt[r] : -INFINITY;
            if (g > v0) { v2 = v1; j2 = j1; v1 = v0; j1 = j0; v0 = g; j0 = j; }
            else if (g > v1) { v2 = v1; j2 = j1; v1 = g; j1 = j; }
            else if (g > v2) { v2 = g; j2 = j; } }
        {
            const float pv[3] = {__shfl_xor(v0, 32), __shfl_xor(v1, 32), __shfl_xor(v2, 32)}; const int pj[3] = {__shfl_xor(j0, 32), __shfl_xor(j1, 32), __shfl_xor(j2, 32)};
#pragma unroll
            for (int t = 0; t < 3; ++t) { const float g = pv[t]; const int j = pj[t];
                if (g > v0 || (g == v0 && j < j0)) { v2 = v1; j2 = j1; v1 = v0; j1 = j0; v0 = g; j0 = j; }
                else if (g > v1 || (g == v1 && j < j1)) { v2 = v1; j2 = j1; v1 = g; j1 = j; }
                else if (g > v2 || (g == v2 && j < j2)) { v2 = g; j2 = j; } }
        }
        const int nsel = i < 3 ? i : 3;
        int r0 = 0, r1 = 0, r2 = 0;
        if (hi == 0) { r0 = lds_add(&lcnt[j0], 1); if (nsel > 1) r1 = lds_add(&lcnt[j1], 1); if (nsel > 2) r2 = lds_add(&lcnt[j2], 1); }
        __syncthreads();
        if (F.tid < i) { const int n = lcnt[F.tid]; lbase[F.tid] = n > 0 ? (int)atomicAdd(&cur[bh * 32 + F.tid], (unsigned)n) : 0; }
        __syncthreads();
        if (hi == 0) {
            unsigned short* lb = lists + (size_t)bh * MB_LIST_STRIDE;
            lb[mb_list_off(j0) + lbase[j0] + r0] = (unsigned short)(qpos | (0 << 13));
            if (nsel > 1) lb[mb_list_off(j1) + lbase[j1] + r1] = (unsigned short)(qpos | (1 << 13));
            if (nsel > 2) lb[mb_list_off(j2) + lbase[j2] + r2] = (unsigned short)(qpos | (2 << 13));
        }
    }
}
__device__ __forceinline__ void kv_dma(Ctx& F, const bf16_t* kg, const bf16_t* vg, int bufoff) {
    const int l = F.lane;
#pragma unroll
    for (int i = 0; i < 4; ++i) { const int p = 4 * F.wave + i;
        __builtin_amdgcn_global_load_lds((const unsigned*)(kg + (size_t)(8 * p + (l >> 3)) * QW + ((l & 7) ^ ((l >> 3) & 7)) * 8), (LAS unsigned*)(F.lds + bufoff + p * 1024), 16, 0, 0);
        __builtin_amdgcn_global_load_lds((const unsigned*)(vg + (size_t)((p >> 3) * 64 + (p & 3) * 16 + (l >> 2)) * QW + ((p >> 2) & 1) * 32 + (l & 3) * 8), (LAS unsigned*)(F.lds + bufoff + 32768 + p * 1024), 16, 0, 0); }
}
__device__ __forceinline__ void softmax_step(f32x16 (&t)[2], float& m, float& l, f32x16 (&o)[2], LAS float* wsf, const LAS unsigned char* vt, int lane) {
    const int r32 = lane & 31, hi = lane >> 5;
    float rm = -INFINITY;
#pragma unroll
    for (int p = 0; p < 2; ++p)
#pragma unroll
        for (int r = 0; r < 16; ++r) rm = fmaxf(rm, t[p][r]);
    rm = fmaxf(rm, __shfl_xor(rm, 32));
    const float mn = fmaxf(m, rm);
    const float f = __builtin_amdgcn_exp2f(m - mn);
    m = mn;
    float s = 0.f; u32x4 pw[4];
#pragma unroll
    for (int p = 0; p < 2; ++p)
#pragma unroll
        for (int r = 0; r < 16; ++r) { const float e = __builtin_amdgcn_exp2f(t[p][r] - mn); t[p][r] = e; s += e; }
    l = l * f + s;
#pragma unroll
    for (int idx = 0; idx < 8; ++idx) { const int p = idx >> 2, g4 = (idx & 3) * 4; pw[idx >> 1][(idx & 1) * 2] = cvtpk(t[p][g4], t[p][g4 + 1]); pw[idx >> 1][(idx & 1) * 2 + 1] = cvtpk(t[p][g4 + 2], t[p][g4 + 3]); }
    if (__any(f != 1.f)) {
        if (hi == 0) wsf[r32] = f;
        LDS_WAIT();
#pragma unroll
        for (int g = 0; g < 4; ++g) { const f32x4 fv = *(const LAS f32x4*)(wsf + 8 * g + 4 * hi);
#pragma unroll
            for (int j = 0; j < 4; ++j) { o[0][4 * g + j] *= fv[j]; o[1][4 * g + j] *= fv[j]; } }
        LDS_WAIT();
    }
    pv64(o, vt, lane, pw);
}
__device__ __forceinline__ void qkt64(f32x16 (&t)[2], const LAS unsigned char* kt, const bf16x8 (&qr)[4], int lane) {
    const int r32 = lane & 31, hi = lane >> 5;
    t[0] = f32x16{}; t[1] = f32x16{};
    const LAS unsigned char* rp = kt + r32 * 128;
#pragma unroll
    for (int d0 = 0; d0 < 4; ++d0) {
        const int pos = ((2 * d0 + hi) ^ (r32 & 7)) * 16;
        const bf16x8 k0 = *(const LAS bf16x8*)(rp + pos), k1 = *(const LAS bf16x8*)(rp + 4096 + pos);
        t[0] = __builtin_amdgcn_mfma_f32_32x32x16_bf16(k0, qr[d0], t[0], 0, 0, 0); t[1] = __builtin_amdgcn_mfma_f32_32x32x16_bf16(k1, qr[d0], t[1], 0, 0, 0);
    }
}
__device__ __forceinline__ void phase5(Ctx& F) {
    LAS int* pre = (LAS int*)(F.lds + MISC_OFF + MO_PRE);
    LAS int* wtot = (LAS int*)(F.lds + MISC_OFF + MO_ENT);
    const unsigned* cur = (const unsigned*)(F.ws + WS_CTL) + CW_MBCUR;
    build_lut(F);
    int total;
    {
        const int p0 = 2 * F.tid, p1 = p0 + 1;
        const int c0 = p0 < 992 ? (int)((cur[(p0 / 31) * 32 + (p0 % 31)] + 255u) >> 8) : 0;
        const int c1 = p1 < 992 ? (int)((cur[(p1 / 31) * 32 + (p1 % 31)] + 255u) >> 8) : 0;
        const int s = c0 + c1; int v = s;
#pragma unroll
        for (int o = 1; o < 64; o <<= 1) { const int n = __shfl_up(v, o); if (F.lane >= o) v += n; }
        if (F.lane == 63) wtot[248 + F.wave] = v;
        __syncthreads();
        int woff = 0; total = 0;
#pragma unroll
        for (int w = 0; w < 8; ++w) { const int x = wtot[248 + w]; if (w < F.wave) woff += x; total += x; }
        const int excl = woff + v - s;
        pre[p0] = excl; pre[p1] = excl + c0;
        __syncthreads();
    }
    const unsigned short* lists = (const unsigned short*)(F.ws + WS_LMB);
    LAS float* wsf = (LAS float*)(F.lds + MISC_OFF + MO_WSF) + F.wave * 128;
    LAS int* ent = (LAS int*)(F.lds + MISC_OFF + MO_ENT) + F.wave * 32;
    const int lane = F.lane, r32 = lane & 31, hi = lane >> 5;
#define P5_UNIT(U, BH, J, C) do { int lo_ = 0, hi_ = 992; while (hi_ - lo_ > 1) { const int mid = (lo_ + hi_) >> 1; if (pre[mid] <= (U)) lo_ = mid; else hi_ = mid; } BH = lo_ / 31; J = lo_ % 31; C = (U) - pre[lo_]; } while (0)
#define P5_DMA(BH, J, BUF) do { const bf16_t* b_ = (const bf16_t*)(F.ws + WS_QMB) + (size_t)((BH) >> 3) * SEQ * QW + ((BH) & 7) * 64; kv_dma(F, b_ + 512 + (size_t)((J) * 256) * QW, b_ + 1024 + (size_t)((J) * 256) * QW, (BUF) * 65536); } while (0)
#define P5_ENTRY(BH, J, C, ACT, VALID, ENTRY) do { const int n_ = (int)cur[(BH) * 32 + (J)]; const int e0_ = (C) * 256 + F.wave * 32; ACT = e0_ < n_; VALID = ACT && (e0_ + r32) < n_; \
        const unsigned short* lb_ = lists + (size_t)(BH) * MB_LIST_STRIDE + mb_list_off(J); ENTRY = ACT ? (int)lb_[VALID ? e0_ + r32 : e0_] : 0; } while (0)
#define P5_QLOAD(BH, ENTRY, Q) do { const bf16_t* b_ = (const bf16_t*)(F.ws + WS_QMB) + (size_t)((BH) >> 3) * SEQ * QW + ((BH) & 7) * 64 + (size_t)((ENTRY) & 8191) * QW + hi * 8; \
        _Pragma("unroll") for (int d0 = 0; d0 < 4; ++d0) Q[d0] = *(const bf16x8*)(b_ + d0 * 16); } while (0)
    int u = F.bid, bh = 0, j = 0, c = 0, buf = 0;
    bool act = false, valid = false; int entry = 0; bf16x8 qr[4];
    if (u < total) { P5_UNIT(u, bh, j, c); P5_DMA(bh, j, 0); P5_ENTRY(bh, j, c, act, valid, entry); P5_QLOAD(bh, entry, qr); }
    for (; u < total; u += F.G) {
        const int un = u + F.G; int bhn = 0, jn = 0, cn = 0;
        const bool has_next = un < total;
        if (has_next) P5_UNIT(un, bhn, jn, cn);
        const int h = bh & 7;
        const int qpos = entry & 8191, slot = entry >> 13;
        asm volatile("s_waitcnt vmcnt(0)" ::: "memory");
        __syncthreads();
        bool actn = false, validn = false; int entryn = 0; bf16x8 qn[4];
        if (has_next) { P5_DMA(bhn, jn, buf ^ 1); P5_ENTRY(bhn, jn, cn, actn, validn, entryn); }
        const LAS unsigned char* kimg = F.lds + buf * 65536; const LAS unsigned char* vimg = kimg + 32768;
        if (act) {
            if (hi == 0) ent[r32] = valid ? entry : -1;
            float m = -INFINITY, l = 0.f; f32x16 o[2]; o[0] = f32x16{}; o[1] = f32x16{};
            const LAS float* lut = (const LAS float*)(F.lds + MISC_OFF + MO_LUT) + h * 132;
            const float bfar = lut[128];
#pragma unroll 1
            for (int st = 0; st < 4; ++st) {
                if (st == 2 && has_next) P5_QLOAD(bhn, entryn, qn);
                f32x16 t[2]; qkt64(t, kimg + st * 8192, qr, lane);
                const int kbase = j * 256 + st * 64;
                const bool far = __all(qpos - (kbase + 63) >= 128);
                if (far) {
#pragma unroll
                    for (int pp = 0; pp < 2; ++pp)
#pragma unroll
                        for (int r = 0; r < 16; ++r) t[pp][r] = t[pp][r] * LOG2E + bfar;
                } else {
#pragma unroll
                    for (int pp = 0; pp < 2; ++pp)
#pragma unroll
                        for (int r = 0; r < 16; ++r) { int d = qpos - (kbase + 32 * pp + crow(r, hi)); d = d < 128 ? d : 128; d = d > 0 ? d : 0; t[pp][r] = t[pp][r] * LOG2E + lut[d]; }
                }
                softmax_step(t, m, l, o, wsf, vimg + st * 8192, lane);
            }
            l += __shfl_xor(l, 32);
            const float rl = 1.f / l;
            if (hi == 0) { wsf[r32] = rl; if (valid) ((float*)(F.ws + WS_PLSE))[((size_t)bh * SEQ + qpos) * 3 + slot] = m + __log2f(l); }
            LDS_WAIT();
            {
                LAS bf16_t* stg = (LAS bf16_t*)(F.lds + MISC_OFF + MO_STG + F.wave * 2048);
                bf16_t* po = (bf16_t*)(F.ws + WS_PO);
#pragma unroll
                for (int d0 = 0; d0 < 2; ++d0) {
#pragma unroll
                    for (int r = 0; r < 16; ++r) { const int q = crow(r, hi); stg[q * 32 + r32] = (bf16_t)(cvtpk(o[d0][r] * wsf[q], 0.f) & 0xffffu); }
                    LDS_WAIT();
#pragma unroll
                    for (int it2 = 0; it2 < 2; ++it2) { const int row = it2 * 16 + (lane >> 2), ch = lane & 3; const int en = ent[row];
                        const u32x4 v = *(const LAS u32x4*)(stg + row * 32 + ch * 8);
                        if (en >= 0) *(u32x4*)(po + (((size_t)bh * SEQ + (en & 8191)) * 3 + (en >> 13)) * 64 + d0 * 32 + ch * 8) = v; }
                    LDS_WAIT();
                }
            }
        } else if (has_next) { P5_QLOAD(bhn, entryn, qn); }
        bh = bhn; j = jn; c = cn; buf ^= 1; act = actn; valid = validn; entry = entryn;
#pragma unroll
        for (int d0 = 0; d0 < 4; ++d0) qr[d0] = qn[d0];
    }
#undef P5_ENTRY
#undef P5_QLOAD
#undef P5_UNIT
#undef P5_DMA
    asm volatile("s_waitcnt vmcnt(0)" ::: "memory");
    __syncthreads();
}
__device__ __forceinline__ void phase6(Ctx& F) {
    build_lut(F);
    LAS float* wsf = (LAS float*)(F.lds + MISC_OFF + MO_WSF) + F.wave * 128;
    const int lane = F.lane, r32 = lane & 31, hi = lane >> 5, w = F.wave;
#define P6_DMA(U, BUF) do { const int bh_ = (U) >> 5, i_ = 31 - ((U) & 31); const bf16_t* b_ = (const bf16_t*)(F.ws + WS_QMB) + (size_t)(bh_ >> 3) * SEQ * QW + (bh_ & 7) * 64; \
        kv_dma(F, b_ + 512 + (size_t)(i_ * 256) * QW, b_ + 1024 + (size_t)(i_ * 256) * QW, (BUF) * 65536); } while (0)
    int buf = 0;
    if (F.bid < 32 * 32) P6_DMA(F.bid, 0);
    for (int u = F.bid; u < 32 * 32; u += F.G) {
        const int bh = u >> 5, i = 31 - (u & 31), b = bh >> 3, h = bh & 7;
        const bf16_t* base = (const bf16_t*)(F.ws + WS_QMB) + (size_t)b * SEQ * QW + h * 64;
        const int ql = w * 32 + r32, qpos = i * 256 + ql;
        bf16x8 qr[4];
#pragma unroll
        for (int d0 = 0; d0 < 4; ++d0) qr[d0] = *(const bf16x8*)(base + (size_t)qpos * QW + d0 * 16 + hi * 8);
        const int nsel = i < 3 ? i : 3;
        const float* plse = (const float*)(F.ws + WS_PLSE) + ((size_t)bh * SEQ + qpos) * 3;
        float ls0 = -INFINITY, ls1 = -INFINITY, ls2 = -INFINITY;
        if (nsel > 0) ls0 = plse[0]; if (nsel > 1) ls1 = plse[1]; if (nsel > 2) ls2 = plse[2];
        asm volatile("s_waitcnt vmcnt(0)" ::: "memory");
        __syncthreads();
        if (u + F.G < 32 * 32) P6_DMA(u + F.G, buf ^ 1);
        const LAS unsigned char* kimg = F.lds + buf * 65536; const LAS unsigned char* vimg = kimg + 32768;
        float m = -INFINITY, l = 0.f; f32x16 o[2]; o[0] = f32x16{}; o[1] = f32x16{};
        const LAS float* lut = (const LAS float*)(F.lds + MISC_OFF + MO_LUT) + h * 132;
        const int nst = (w >> 1) + 1;
#pragma unroll 1
        for (int st = 0; st < nst; ++st) {
            f32x16 t[2]; qkt64(t, kimg + st * 8192, qr, lane);
#pragma unroll
            for (int pp = 0; pp < 2; ++pp)
#pragma unroll
                for (int r = 0; r < 16; ++r) { const int d = ql - (st * 64 + 32 * pp + crow(r, hi)); const int dc = d < 128 ? (d > 0 ? d : 0) : 128; const float v = t[pp][r] * LOG2E + lut[dc]; t[pp][r] = d >= 0 ? v : -INFINITY; }
            softmax_step(t, m, l, o, wsf, vimg + st * 8192, lane);
        }
        l += __shfl_xor(l, 32);
        const float M = fmaxf(fmaxf(m, ls0), fmaxf(ls1, ls2));
        const float eo = __builtin_amdgcn_exp2f(m - M), e0 = __builtin_amdgcn_exp2f(ls0 - M), e1 = __builtin_amdgcn_exp2f(ls1 - M), e2 = __builtin_amdgcn_exp2f(ls2 - M);
        const float rden = 1.f / (l * eo + e0 + e1 + e2);
        if (hi == 0) *(LAS f32x4*)(wsf + 4 * r32) = (f32x4){eo * rden, e0 * rden, e1 * rden, e2 * rden};
        LDS_WAIT();
#pragma unroll
        for (int r = 0; r < 16; ++r) { const float fo = wsf[4 * crow(r, hi)]; o[0][r] *= fo; o[1][r] *= fo; }
        __syncthreads();
        {
            LAS bf16_t* stg = (LAS bf16_t*)(F.lds + buf * 65536 + w * 4096);
#pragma unroll
            for (int r = 0; r < 16; ++r) { const int orow = crow(r, hi);
#pragma unroll
                for (int d0 = 0; d0 < 2; ++d0) stg[orow * 64 + d0 * 32 + r32] = (bf16_t)(cvtpk(o[d0][r], 0.f) & 0xffffu); }
            LDS_WAIT();
            const bf16_t* po = (const bf16_t*)(F.ws + WS_PO) + ((size_t)bh * SEQ + i * 256 + w * 32) * 3 * 64;
            bf16_t* dst = (bf16_t*)(F.ws + WS_OB) + (size_t)(b * SEQ + i * 256 + w * 32) * 1024 + 512 + h * 64;
#pragma unroll
            for (int it4 = 0; it4 < 4; ++it4) { const int row = it4 * 8 + (lane >> 3), ch = lane & 7;
                const u32x4 ov = *(const LAS u32x4*)(stg + row * 64 + ch * 8);
                float a[8] = {bflo(ov.x), bfhi(ov.x), bflo(ov.y), bfhi(ov.y), bflo(ov.z), bfhi(ov.z), bflo(ov.w), bfhi(ov.w)};
                const f32x4 fc = *(const LAS f32x4*)(wsf + 4 * row);
#pragma unroll
                for (int sl = 0; sl < 3; ++sl) if (sl < nsel) { const u32x4 pv = *(const u32x4*)(po + (size_t)(row * 3 + sl) * 64 + ch * 8); const float f = fc[1 + sl];
                    a[0] += f * bflo(pv.x); a[1] += f * bfhi(pv.x); a[2] += f * bflo(pv.y); a[3] += f * bfhi(pv.y); a[4] += f * bflo(pv.z); a[5] += f * bfhi(pv.z); a[6] += f * bflo(pv.w); a[7] += f * bfhi(pv.w); }
                u32x4 w4; w4.x = cvtpk(a[0], a[1]); w4.y = cvtpk(a[2], a[3]); w4.z = cvtpk(a[4], a[5]); w4.w = cvtpk(a[6], a[7]);
                *(u32x4*)(dst + (size_t)row * 1024 + ch * 8) = w4; }
            LDS_WAIT();
        }
        buf ^= 1;
    }
#undef P6_DMA
    asm volatile("s_waitcnt vmcnt(0)" ::: "memory");
    __syncthreads();
}

struct BranchSched {
    const char* A; const char* Bt; int G, c; int R[2], C[2];
    __device__ __forceinline__ bool next(int i, gm::UnitD& u) {
        int pm, pn; if (!gm::static_tile(MT, 1024, G, c, i, pm, pn)) return false;
        u.a = A; u.b = Bt + (size_t)(pn * 256) * 1024 * 2;
#pragma unroll
        for (int h = 0; h < 2; ++h)
#pragma unroll
            for (int j = 0; j < 2; ++j) u.va[h][j] = (unsigned)((pm * 256 + h * 128 + R[j]) * 1024 + C[j]) * 2u;
        u.e0 = pm; u.e1 = pn; u.e2 = 0; u.e3 = 0; return true;
    }
};
struct EpiBranch {
    const bf16_t* g; bf16_t* merged;
    static __device__ __forceinline__ float ratio(float gs, float gm_) { return (1.f + fminf(__expf(-gm_), 1e30f)) * __builtin_amdgcn_rcpf(1.f + __expf(-gs)); }
    __device__ __forceinline__ void mid(f32x4 (&acc)[2][2][4][2], const gm::UnitD& u, int wr, int wc, int fr, int fq) const {
        const bf16_t* gp = g + (size_t)(u.e0 * 256 + wr * 64 + fr) * 2048 + u.e1 * 256 + wc * 32 + 8 * fq;
#pragma unroll
        for (int ai = 0; ai < 2; ++ai)
#pragma unroll
            for (int m = 0; m < 4; m += 2) {
                asm volatile("" : "+v"(gp) :: "memory");
                u32x4 gs[2][2], gq[2][2];
#pragma unroll
                for (int mm = 0; mm < 2; ++mm)
#pragma unroll
                    for (int bj = 0; bj < 2; ++bj) { gs[mm][bj] = *(const u32x4*)(gp + (size_t)mm * 16 * 2048 + bj * 128); gq[mm][bj] = *(const u32x4*)(gp + (size_t)mm * 16 * 2048 + 1024 + bj * 128); }
#pragma unroll
                for (int mm = 0; mm < 2; ++mm)
#pragma unroll
                    for (int bj = 0; bj < 2; ++bj) { const u32x4 a = gs[mm][bj], b = gq[mm][bj];
                        f32x4& c0 = acc[ai][bj][m + mm][0]; f32x4& c1 = acc[ai][bj][m + mm][1];
                        c0[0] *= ratio(bflo(a.x), bflo(b.x)); c0[1] *= ratio(bfhi(a.x), bfhi(b.x)); c0[2] *= ratio(bflo(a.y), bflo(b.y)); c0[3] *= ratio(bfhi(a.y), bfhi(b.y));
                        c1[0] *= ratio(bflo(a.z), bflo(b.z)); c1[1] *= ratio(bfhi(a.z), bfhi(b.z)); c1[2] *= ratio(bflo(a.w), bflo(b.w)); c1[3] *= ratio(bfhi(a.w), bfhi(b.w));
                        asm volatile("" : "+v"(c0), "+v"(c1) :: "memory"); }
                gp += (m == 2 ? 96 : 32) * 2048; }
    }
    __device__ __forceinline__ void operator()(const f32x4 (&acc)[2][2][4][2], const gm::UnitD& u, int wr, int wc, int fr, int fq) const {
        const int row0 = u.e0 * 256 + wr * 64 + fr, col0 = u.e1 * 256 + wc * 32 + 8 * fq;
#pragma unroll
        for (int ai = 0; ai < 2; ++ai)
#pragma unroll
            for (int m = 0; m < 4; ++m) { const size_t row = (size_t)(row0 + ai * 128 + m * 16);
#pragma unroll
                for (int bj = 0; bj < 2; ++bj) { const u32x4 gm_ = *(const u32x4*)(g + row * 2048 + 1024 + col0 + bj * 128);
                    const float b[8] = {bflo(gm_.x), bfhi(gm_.x), bflo(gm_.y), bfhi(gm_.y), bflo(gm_.z), bfhi(gm_.z), bflo(gm_.w), bfhi(gm_.w)};
                    float r[8];
#pragma unroll
                    for (int j = 0; j < 8; ++j) r[j] = acc[ai][bj][m][j >> 2][j & 3] * __builtin_amdgcn_rcpf(1.f + fminf(__expf(-b[j]), 1e30f));
                    u32x4 w; w.x = cvtpk(r[0], r[1]); w.y = cvtpk(r[2], r[3]); w.z = cvtpk(r[4], r[5]); w.w = cvtpk(r[6], r[7]);
                    *(u32x4*)(merged + row * 1024 + col0 + bj * 128) = w; } }
    }
};
__device__ __forceinline__ void phase7(Ctx& F) {
    BranchSched S; S.A = (const char*)(F.ws + WS_OB); S.Bt = (const char*)(F.ws + WS_WBRT); S.G = F.G; S.c = F.bid; gm::stage_geom(F.tid, S.R, S.C);
    EpiBranch E{(const bf16_t*)(F.ws + WS_G), (bf16_t*)(F.ws + WS_MERGED)};
    gm::gemm_phase<true, true>(F.lds, 1024, S, E);
}
struct OutSched {
    const char* A; const char* Bt; int G, c; int R[2], C[2];
    __device__ __forceinline__ bool next(int i, gm::UnitD& u) {
        int pm, pn; if (!gm::static_tile(MT, 1024, G, c, i, pm, pn)) return false;
        u.a = A; u.b = Bt + (size_t)pn * 256 * 1024 * 2;
#pragma unroll
        for (int h = 0; h < 2; ++h)
#pragma unroll
            for (int j = 0; j < 2; ++j) u.va[h][j] = (unsigned)((pm * 256 + h * 128 + R[j]) * 1024 + C[j]) * 2u;
        u.e0 = pm; u.e1 = pn; u.e2 = 0; u.e3 = 0; return true;
    }
};
struct EpiOut {
    const float* x; const float* mod; float* out;
    __device__ __forceinline__ void operator()(const f32x4 (&acc)[2][2][4][2], const gm::UnitD& u, int wr, int wc, int fr, int fq) const {
        const int pm = u.e0, pn = u.e1, b = (pm * 256) / SEQ;
        const int row0 = pm * 256 + wr * 64 + fr, col0 = pn * 256 + wc * 32 + 4 * fq;
        f32x4 gt[2][2];
#pragma unroll
        for (int bj = 0; bj < 2; ++bj)
#pragma unroll
            for (int n = 0; n < 2; ++n) gt[bj][n] = *(const f32x4*)(mod + b * NMOD + 2 * DM + col0 + bj * 128 + n * 16);
#pragma unroll
        for (int ai = 0; ai < 2; ++ai)
#pragma unroll
            for (int m = 0; m < 4; ++m) { const size_t off = (size_t)(row0 + ai * 128 + m * 16) * DM + col0;
#pragma unroll
                for (int bj = 0; bj < 2; ++bj)
#pragma unroll
                    for (int n = 0; n < 2; ++n) { const f32x4 xv = *(const f32x4*)(x + off + bj * 128 + n * 16); *(f32x4*)(out + off + bj * 128 + n * 16) = xv + gt[bj][n] * acc[ai][bj][m][n]; } }
    }
};
__device__ __forceinline__ void phase8(Ctx& F) {
    OutSched S; S.A = (const char*)(F.ws + WS_MERGED); S.Bt = (const char*)(F.ws + WS_WOUTT); S.G = F.G; S.c = F.bid; gm::stage_geom(F.tid, S.R, S.C);
    EpiOut E{inp(F, I_X), (const float*)(F.ws + WS_SMALL + SM_MOD), F.out};
    gm::gemm_phase<false>(F.lds, 1024, S, E);
}

constexpr int NR_SSQ = MO_PRE + 1024;
constexpr int NR_RS = MO_PRE + 3072;
__device__ __forceinline__ void phase_n2r(Ctx& F, int rr) {
    const float* x1 = F.out; const float* gvec = (const float*)(F.ws + WS_SMALL + SM_GVEC); const float* cb = (const float*)(F.ws + WS_SMALL + SM_CB);
    const float* mod = (const float*)(F.ws + WS_SMALL + SM_MOD); const float* rbias = inp(F, I_RB);
    bf16_t* H2 = (bf16_t*)(F.ws + WS_H2); int* tokl = (int*)(F.ws + WS_TOKL); float* wl = (float*)(F.ws + WS_WL); int* tpos = (int*)(F.ws + WS_TPOS);
    unsigned* cur = (unsigned*)(F.ws + WS_CTL) + CW_MOECUR + rr * 64;
    LAS int* lcnt = (LAS int*)(F.lds + MISC_OFF + MO_PRE); LAS int* lbase = lcnt + 64;
    LAS float* part = (LAS float*)(F.lds);
    LAS float* ssqp = (LAS float*)(F.lds + MISC_OFF + NR_SSQ); LAS float* rsl = (LAS float*)(F.lds + MISC_OFF + NR_RS);
    const int lane = F.lane, w = F.wave, i16 = lane & 15, kk = lane >> 4;
    for (int u = F.bid; u < RT / 64; u += F.G) {
        if (F.tid < 64) lcnt[F.tid] = 0;
        const int tokb = rr * RT + u * 64, b = tokb / SEQ;
        {
            bf16x8 fah[4][4], fal[4][4];
            {
                const float* gp = gvec + b * DM + 128 * w + 8 * kk;
                f32x4 gv[4][2];
#pragma unroll
                for (int s4 = 0; s4 < 4; ++s4) { gv[s4][0] = *(const f32x4*)(gp + 32 * s4); gv[s4][1] = *(const f32x4*)(gp + 32 * s4 + 4); }
#pragma unroll
                for (int tt = 0; tt < 4; ++tt) {
                    const float* xp = x1 + (size_t)(tokb + tt * 16 + i16) * DM + 128 * w + 8 * kk;
                    f32x4 xa[4][2];
#pragma unroll
                    for (int s4 = 0; s4 < 4; ++s4) { xa[s4][0] = *(const f32x4*)(xp + 32 * s4); xa[s4][1] = *(const f32x4*)(xp + 32 * s4 + 4); }
                    float ssq = 0.f;
#pragma unroll
                    for (int s4 = 0; s4 < 4; ++s4) {
                        u32x4 ah, al;
#pragma unroll
                        for (int q = 0; q < 2; ++q) { const f32x4 xv = xa[s4][q]; ssq += (xv.x * xv.x + xv.y * xv.y) + (xv.z * xv.z + xv.w * xv.w);
                            const f32x4 a = xv * gv[s4][q];
                            const unsigned h0 = cvtpk(a.x, a.y), h1 = cvtpk(a.z, a.w);
                            ah[2 * q] = h0; ah[2 * q + 1] = h1; al[2 * q] = cvtpk(a.x - bflo(h0), a.y - bfhi(h0)); al[2 * q + 1] = cvtpk(a.z - bflo(h1), a.w - bfhi(h1)); }
                        fah[tt][s4] = __builtin_bit_cast(bf16x8, ah); fal[tt][s4] = __builtin_bit_cast(bf16x8, al);
                    }
                    ssq += __shfl_xor(ssq, 16); ssq += __shfl_xor(ssq, 32); if (kk == 0) ssqp[w * 64 + tt * 16 + i16] = ssq;
                }
            }
#pragma unroll 1
            for (int eh = 0; eh < 2; ++eh) {
                bf16x8 wh[2][4], wl_[2][4];
                {
                    const bf16_t* ph = (const bf16_t*)(F.ws + WS_SMALL + SM_WRH) + (size_t)(eh * 32 + i16) * DM + 128 * w + 8 * kk;
                    const bf16_t* pl = (const bf16_t*)(F.ws + WS_SMALL + SM_WRL) + (size_t)(eh * 32 + i16) * DM + 128 * w + 8 * kk;
#pragma unroll
                    for (int c = 0; c < 2; ++c)
#pragma unroll
                        for (int s4 = 0; s4 < 4; ++s4) { wh[c][s4] = *(const bf16x8*)(ph + (size_t)c * 16 * DM + 32 * s4); wl_[c][s4] = *(const bf16x8*)(pl + (size_t)c * 16 * DM + 32 * s4); }
                }
#pragma unroll
                for (int tt = 0; tt < 4; ++tt) {
                    f32x4 acc[2]; acc[0] = acc[1] = (f32x4){0.f, 0.f, 0.f, 0.f};
#pragma unroll
                    for (int s4 = 0; s4 < 4; ++s4)
#pragma unroll
                        for (int c = 0; c < 2; ++c) {
                            acc[c] = __builtin_amdgcn_mfma_f32_16x16x32_bf16(fal[tt][s4], wh[c][s4], acc[c], 0, 0, 0);
                            acc[c] = __builtin_amdgcn_mfma_f32_16x16x32_bf16(fah[tt][s4], wl_[c][s4], acc[c], 0, 0, 0);
                            acc[c] = __builtin_amdgcn_mfma_f32_16x16x32_bf16(fah[tt][s4], wh[c][s4], acc[c], 0, 0, 0); }
#pragma unroll
                    for (int c = 0; c < 2; ++c)
#pragma unroll
                        for (int reg = 0; reg < 4; ++reg) part[(w * 64 + tt * 16 + 4 * kk + reg) * 64 + eh * 32 + 16 * c + i16] = acc[c][reg];
                }
            }
        }
        __syncthreads();
        const int tl = F.tid >> 3, g = F.tid & 7;
        int my_e; float my_w; int my_rank;
        {
            float ssq = 0.f;
#pragma unroll
            for (int q = 0; q < 8; ++q) ssq += ssqp[q * 64 + tl];
            const float rstd = rsqrtf(ssq * (1.f / DM) + EPS);
            if (g == 0) rsl[tl] = rstd;
            float s8[8], c8[8];
            {
                f32x4 lo4 = (f32x4){0.f, 0.f, 0.f, 0.f}, hi4 = lo4;
#pragma unroll
                for (int q = 0; q < 8; ++q) { const LAS f32x4* pp = (const LAS f32x4*)(part + (q * 64 + tl) * 64 + 8 * g); lo4 += pp[0]; hi4 += pp[1]; }
                const f32x4 cb0 = *(const f32x4*)(cb + b * 64 + 8 * g), cb1 = *(const f32x4*)(cb + b * 64 + 8 * g + 4), rb0 = *(const f32x4*)(rbias + 8 * g), rb1 = *(const f32x4*)(rbias + 8 * g + 4);
#pragma unroll
                for (int j = 0; j < 4; ++j) { s8[j] = sigmoidf_(lo4[j] * rstd + cb0[j]); s8[4 + j] = sigmoidf_(hi4[j] * rstd + cb1[j]); c8[j] = s8[j] + rb0[j]; c8[4 + j] = s8[4 + j] + rb1[j]; }
            }
            float m1 = -INFINITY, m2 = -INFINITY;
#pragma unroll
            for (int j = 0; j < 8; ++j) { const float v = c8[j]; if (v > m1) { m2 = m1; m1 = v; } else if (v > m2) m2 = v; }
            const float gs = m1 + m2;
            int rank = 0;
#pragma unroll
            for (int g2 = 0; g2 < 8; ++g2) { const float o = __shfl(gs, g2, 8); rank += (o > gs || (o == gs && g2 < g)) ? 1 : 0; }
            if (rank >= 4) {
#pragma unroll
                for (int j = 0; j < 8; ++j) c8[j] = -INFINITY;
            }
            int sel_e[8]; float sk[8]; float wsum = 0.f;
#pragma unroll
            for (int k = 0; k < 8; ++k) {
                float bv = -INFINITY, bs = 0.f; int be = 8 * g;
#pragma unroll
                for (int j = 0; j < 8; ++j) if (c8[j] > bv) { bv = c8[j]; be = 8 * g + j; bs = s8[j]; }
#pragma unroll
                for (int o = 1; o < 8; o <<= 1) { const float ov = __shfl_xor(bv, o, 8), os = __shfl_xor(bs, o, 8); const int oe = __shfl_xor(be, o, 8); if (ov > bv || (ov == bv && oe < be)) { bv = ov; be = oe; bs = os; } }
                sel_e[k] = be; sk[k] = bs; wsum += bs;
#pragma unroll
                for (int j = 0; j < 8; ++j) if (be == 8 * g + j) c8[j] = -INFINITY;
            }
            my_e = sel_e[0]; my_w = sk[0];
#pragma unroll
            for (int k = 1; k < 8; ++k) if (g == k) { my_e = sel_e[k]; my_w = sk[k]; }
            my_w *= 2.5f / wsum;
            my_rank = lds_add(&lcnt[my_e], 1);
        }
        __syncthreads();
        if (F.tid < 64) { const int n = lcnt[F.tid]; lbase[F.tid] = n > 0 ? (int)atomicAdd(&cur[F.tid], (unsigned)n) : 0; }
        __syncthreads();
        { const int tok = tokb + tl, pos = lbase[my_e] + my_rank; tokl[my_e * RT + pos] = tok * 8 + g; wl[my_e * RT + pos] = my_w; tpos[(tok - rr * RT) * 8 + g] = (my_e << 16) | pos; }
#pragma unroll 1
        for (int r0 = 0; r0 < 8; r0 += 4) {
            f32x4 xv[4][4];
#pragma unroll
            for (int r = 0; r < 4; ++r) { const f32x4* xr = (const f32x4*)(x1 + (size_t)(tokb + w * 8 + r0 + r) * DM) + lane;
#pragma unroll
                for (int j = 0; j < 4; ++j) xv[r][j] = xr[64 * j]; }
#pragma unroll
            for (int j = 0; j < 4; ++j) { const int col = 4 * lane + 256 * j; const f32x4 gq = *(const f32x4*)(gvec + b * DM + col), sh = *(const f32x4*)(mod + b * NMOD + 3 * DM + col);
#pragma unroll
                for (int r = 0; r < 4; ++r) { const int tl2 = w * 8 + r0 + r; const f32x4 hv = (xv[r][j] * rsl[tl2]) * gq + sh;
                    u32x2 o; o.x = cvtpk(hv.x, hv.y); o.y = cvtpk(hv.z, hv.w); ((u32x2*)(H2 + (size_t)(tokb - rr * RT + tl2) * DM) + lane)[64 * j] = o; } }
        }
        __syncthreads();
    }
}
constexpr int MO_TE = 4224;
struct MoeTabs { const LAS unsigned short* te; const LAS int* tb; const LAS int* cnt; int TR; };
__device__ __forceinline__ MoeTabs build_moe_tabs(Ctx& F, int rr) {
    LAS unsigned short* te = (LAS unsigned short*)(F.lds + MISC_OFF + MO_TE); LAS int* tb = (LAS int*)(F.lds + MISC_OFF + MO_TE + 1536); LAS int* cnt = tb + 72;
    const unsigned* cur = (const unsigned*)(F.ws + WS_CTL) + CW_MOECUR + rr * 64;
    __syncthreads();
    if (F.tid == 0) { int acc = 0; for (int e = 0; e < 64; ++e) { const int c = (int)cur[e]; cnt[e] = c; tb[e] = acc; acc += (c + 255) >> 8; } tb[64] = acc; tb[65] = acc + RT / 256; cnt[64] = RT; }
    __syncthreads();
    const int TR = tb[64];
    for (int e = F.tid >> 3; e < 65; e += 64) for (int t = tb[e] + (F.tid & 7); t < tb[e + 1]; t += 8) te[t] = (unsigned short)e;
    __syncthreads();
    MoeTabs T; T.te = te; T.tb = tb; T.cnt = cnt; T.TR = TR; return T;
}
struct Moe1Sched {
    const char* H2; const char* W1T; const int* tokl; MoeTabs T; int G, c, rr; int R[2], C[2];
    __device__ __forceinline__ bool next(int i, gm::UnitD& u) {
        const int uu = i * G + c; const int nt = T.TR + RT / 256;
        if (uu >= nt * 2) return false;
        const int tile = uu >> 1, pn = uu & 1, e = T.te[tile], rt = tile - T.tb[e], cnt = T.cnt[e];
        u.a = H2; u.b = W1T + (size_t)(e * 512 + pn * 256) * 1024 * 2;
#pragma unroll
        for (int h = 0; h < 2; ++h)
#pragma unroll
            for (int j = 0; j < 2; ++j) { const int idx = rt * 256 + h * 128 + R[j]; int trow;
                if (e < 64) { const int ent = tokl[e * RT + (idx < cnt ? idx : rt * 256)]; trow = (ent >> 3) - rr * RT; } else trow = idx;
                u.va[h][j] = (unsigned)(trow * 1024 + C[j]) * 2u; }
        u.e0 = tile; u.e1 = pn; u.e2 = e; u.e3 = rt; return true;
    }
};
struct EpiMoe1 {
    bf16_t* act; const float* wl; const LAS int* cnt;
    __device__ __forceinline__ void operator()(const f32x4 (&acc)[2][2][4][2], const gm::UnitD& u, int wr, int wc, int fr, int fq) const {
        const int row0 = u.e0 * 256 + wr * 64 + fr, col0 = u.e1 * 128 + wc * 32 + 8 * fq, e = u.e2, n = cnt[e];
        float rw[2][4];
#pragma unroll
        for (int ai = 0; ai < 2; ++ai)
#pragma unroll
            for (int m = 0; m < 4; ++m) { const int idx = u.e3 * 256 + ai * 128 + wr * 64 + m * 16 + fr; rw[ai][m] = e < 64 ? (idx < n ? wl[e * RT + idx] : 0.f) : 1.f; }
#pragma unroll
        for (int ai = 0; ai < 2; ++ai)
#pragma unroll
            for (int m = 0; m < 4; ++m) { const float ww = rw[ai][m]; const f32x4 g0 = acc[ai][0][m][0], g1 = acc[ai][0][m][1], u0 = acc[ai][1][m][0] * ww, u1 = acc[ai][1][m][1] * ww;
                u32x4 w; w.x = cvtpk(siluf_(g0[0]) * u0[0], siluf_(g0[1]) * u0[1]); w.y = cvtpk(siluf_(g0[2]) * u0[2], siluf_(g0[3]) * u0[3]);
                w.z = cvtpk(siluf_(g1[0]) * u1[0], siluf_(g1[1]) * u1[1]); w.w = cvtpk(siluf_(g1[2]) * u1[2], siluf_(g1[3]) * u1[3]);
                *(u32x4*)(act + (size_t)(row0 + ai * 128 + m * 16) * 256 + col0) = w; }
    }
};
__device__ __forceinline__ void phase_moe1(Ctx& F, int rr) {
    Moe1Sched S; S.T = build_moe_tabs(F, rr); S.H2 = (const char*)(F.ws + WS_H2); S.W1T = (const char*)(F.ws + WS_W1T); S.tokl = (const int*)(F.ws + WS_TOKL); S.G = F.G; S.c = (F.G % 8 == 0) ? (F.bid % 8) * (F.G / 8) + F.bid / 8 : F.bid; S.rr = rr; gm::stage_geom(F.tid, S.R, S.C);
    EpiMoe1 E{(bf16_t*)(F.ws + WS_ACT), (const float*)(F.ws + WS_WL), S.T.cnt};
    gm::gemm_phase<true>(F.lds, 1024, S, E);
}
struct Moe2Sched {
    const char* ACT; const char* W2T; MoeTabs T; int G, c; int R[2], C[2];
    __device__ __forceinline__ bool next(int i, gm::UnitD& u) {
        const int uu = i * G + c; const int nt = T.TR + RT / 256;
        if (uu >= nt * 4) return false;
        const int tile = uu >> 2, pn = uu & 3, e = T.te[tile], rt = tile - T.tb[e];
        u.a = ACT + (size_t)tile * 256 * 256 * 2; u.b = W2T + (size_t)(e * 1024 + pn * 256) * 256 * 2;
#pragma unroll
        for (int h = 0; h < 2; ++h)
#pragma unroll
            for (int j = 0; j < 2; ++j) u.va[h][j] = (unsigned)((h * 128 + R[j]) * 256 + C[j]) * 2u;
        u.e0 = pn; u.e1 = e; u.e2 = rt; u.e3 = tile; return true;
    }
};
struct EpiMoe2 {
    bf16_t* slots; bf16_t* shout; const LAS int* cnt;
    __device__ __forceinline__ void operator()(const f32x4 (&acc)[2][2][4][2], const gm::UnitD& u, int wr, int wc, int fr, int fq) const {
        const int pn = u.e0, e = u.e1, rt = u.e2, tile = u.e3;
        const int col0 = pn * 256 + wc * 32 + 8 * fq, n = cnt[e];
        if (e < 64) {
            unsigned char* base = (unsigned char*)slots + (size_t)(tile * 256 + wr * 64 + fr) * 1024 + col0;
#pragma unroll
            for (int ai = 0; ai < 2; ++ai)
#pragma unroll
                for (int m = 0; m < 4; ++m) {
                    if (rt * 256 + ai * 128 + wr * 64 + m * 16 + fr < n) {
#pragma unroll
                        for (int bj = 0; bj < 2; ++bj) { f32x4 v0 = acc[ai][bj][m][0] * 16.f, v1 = acc[ai][bj][m][1] * 16.f;
#pragma unroll
                            for (int j = 0; j < 4; ++j) { v0[j] = __builtin_amdgcn_fmed3f(v0[j], -440.f, 440.f); v1[j] = __builtin_amdgcn_fmed3f(v1[j], -440.f, 440.f); }
                            int w0 = 0, w1 = 0;
                            w0 = __builtin_amdgcn_cvt_pk_fp8_f32(v0[0], v0[1], w0, false); w0 = __builtin_amdgcn_cvt_pk_fp8_f32(v0[2], v0[3], w0, true);
                            w1 = __builtin_amdgcn_cvt_pk_fp8_f32(v1[0], v1[1], w1, false); w1 = __builtin_amdgcn_cvt_pk_fp8_f32(v1[2], v1[3], w1, true);
                            *(u32x2*)(base + (size_t)(ai * 128 + m * 16) * 1024 + bj * 128) = (u32x2){(unsigned)w0, (unsigned)w1}; } } }
        } else {
            bf16_t* base = shout + (size_t)(rt * 256 + wr * 64 + fr) * 1024 + col0;
#pragma unroll
            for (int ai = 0; ai < 2; ++ai)
#pragma unroll
                for (int m = 0; m < 4; ++m)
#pragma unroll
                    for (int bj = 0; bj < 2; ++bj) { const f32x4 v0 = acc[ai][bj][m][0], v1 = acc[ai][bj][m][1];
                        u32x4 o; o.x = cvtpk(v0[0], v0[1]); o.y = cvtpk(v0[2], v0[3]); o.z = cvtpk(v1[0], v1[1]); o.w = cvtpk(v1[2], v1[3]); *(u32x4*)(base + (size_t)(ai * 128 + m * 16) * 1024 + bj * 128) = o; }
        }
    }
};
__device__ __forceinline__ void phase_moe2(Ctx& F, int rr) {
    Moe2Sched S; S.T = build_moe_tabs(F, rr); S.ACT = (const char*)(F.ws + WS_ACT); S.W2T = (const char*)(F.ws + WS_W2T); S.G = F.G; S.c = (F.G % 8 == 0) ? (F.bid % 8) * (F.G / 8) + F.bid / 8 : F.bid; gm::stage_geom(F.tid, S.R, S.C);
    EpiMoe2 E{(bf16_t*)(F.ws + WS_SLOTS), (bf16_t*)(F.ws + WS_H2), S.T.cnt};
    gm::gemm_phase<true>(F.lds, 256, S, E);
}
__device__ __forceinline__ void phase_final(Ctx& F, int rr) {
    const MoeTabs T = build_moe_tabs(F, rr);
    const float* mod = (const float*)(F.ws + WS_SMALL + SM_MOD); const float* fg = inp(F, I_FG);
    const unsigned char* slots = (const unsigned char*)(F.ws + WS_SLOTS); const int* tpos = (const int*)(F.ws + WS_TPOS);
    const int gw = F.bid * 8 + F.wave, NGW = F.G * 8, c0 = F.lane * 8;
    for (int t = gw; t < RT; t += NGW) {
        const int tok = rr * RT + t, b = tok / SEQ;
        const unsigned char* rp[8];
#pragma unroll
        for (int k = 0; k < 8; ++k) { const int v = tpos[t * 8 + k]; rp[k] = slots + (size_t)(T.tb[v >> 16] * 256 + (v & 0xffff)) * 1024 + c0; }
        float* orow = F.out + (size_t)tok * DM + c0;
        u32x2 sv[8][2]; u32x4 sh[2]; f32x4 xv[2][2];
#pragma unroll
        for (int k = 0; k < 8; ++k) { sv[k][0] = *(const u32x2*)(rp[k]); sv[k][1] = *(const u32x2*)(rp[k] + 512); }
        { const bf16_t* sp = (const bf16_t*)(F.ws + WS_H2) + (size_t)t * 1024 + c0; sh[0] = *(const u32x4*)sp; sh[1] = *(const u32x4*)(sp + 512); }
#pragma unroll
        for (int h = 0; h < 2; ++h) { xv[h][0] = *(const f32x4*)(orow + h * 512); xv[h][1] = *(const f32x4*)(orow + h * 512 + 4); }
        float s = 0.f; f32x4 v[2][2];
#pragma unroll
        for (int h = 0; h < 2; ++h) {
            f32x4 a0 = (f32x4){0.f, 0.f, 0.f, 0.f}, a1 = a0;
#pragma unroll
            for (int k = 0; k < 8; ++k) { const u32x2 w = sv[k][h];
                const f32x2 p0 = __builtin_amdgcn_cvt_pk_f32_fp8((int)w.x, false), p1 = __builtin_amdgcn_cvt_pk_f32_fp8((int)w.x, true), p2 = __builtin_amdgcn_cvt_pk_f32_fp8((int)w.y, false), p3 = __builtin_amdgcn_cvt_pk_f32_fp8((int)w.y, true);
                a0 += (f32x4){p0.x, p0.y, p1.x, p1.y}; a1 += (f32x4){p2.x, p2.y, p3.x, p3.y}; }
            { const u32x4 w = sh[h]; a0 = a0 * 0.0625f + (f32x4){bflo(w.x), bfhi(w.x), bflo(w.y), bfhi(w.y)}; a1 = a1 * 0.0625f + (f32x4){bflo(w.z), bfhi(w.z), bflo(w.w), bfhi(w.w)}; }
            const float* g2 = mod + b * NMOD + 5 * DM + c0 + h * 512;
            v[h][0] = xv[h][0] + *(const f32x4*)g2 * a0; v[h][1] = xv[h][1] + *(const f32x4*)(g2 + 4) * a1;
#pragma unroll
            for (int q = 0; q < 2; ++q) s += (v[h][q].x * v[h][q].x + v[h][q].y * v[h][q].y) + (v[h][q].z * v[h][q].z + v[h][q].w * v[h][q].w);
        }
        const float rstd = rsqrtf(wave_sum(s) * (1.f / DM) + EPS);
#pragma unroll
        for (int h = 0; h < 2; ++h)
#pragma unroll
            for (int q = 0; q < 2; ++q) { const f32x4 g = *(const f32x4*)(fg + c0 + h * 512 + 4 * q); *(f32x4*)(orow + h * 512 + 4 * q) = (v[h][q] * rstd) * g; }
    }
}

constexpr int N_PHASES = 17;
__global__ void __launch_bounds__(512, 2) mega_fwd(Args args) {
    extern __shared__ __attribute__((aligned(16))) unsigned char lds_raw[];
    Ctx F; F.lds = (LAS unsigned char*)lds_raw; F.ws = args.ws; F.out = args.out;
    {
        typedef __attribute__((address_space(4))) const unsigned long long* karg_t;
        const karg_t ka = (karg_t)__builtin_amdgcn_kernarg_segment_ptr();
        LAS unsigned long long* tab = (LAS unsigned long long*)(lds_raw + MISC_OFF + 14336);
        if (threadIdx.x < 20) tab[threadIdx.x] = ka[threadIdx.x];
        F.intab = tab;
    }
    F.tid = threadIdx.x; F.lane = F.tid & 63; F.wave = __builtin_amdgcn_readfirstlane(F.tid >> 6); F.G = gridDim.x; F.bid = blockIdx.x;
    volatile LAS unsigned* st = (volatile LAS unsigned*)(F.lds + MISC_OFF + MO_ST);
    if (F.tid < 4) st[F.tid] = 0u;
    __syncthreads();
    XcdBarrier bar = xcd_barrier_post((unsigned*)(F.ws + WS_CTL) + CW_BAR, st);
    if (threadIdx.x == 0) { unsigned nloc, nx; xcd_barrier_complete(bar.bar, bar.x, nloc, nx); st[0] = nloc; st[1] = nx; }
    int lo = args.ph_lo, hi = args.ph_hi;
    { int a = lo, b = hi; asm volatile("" : "+v"(a), "+v"(b)); lo = __builtin_amdgcn_readfirstlane(a); hi = __builtin_amdgcn_readfirstlane(b); }
    launder(F);
#ifndef PH_MASK
#define PH_MASK 0x1ffff
#endif
#define PH_ON(k) ((PH_MASK >> (k)) & 1)
#define IN(k) (lo <= (k) && (k) < hi)
#define SEAM(k) do { if (IN(k) && IN((k) + 1)) { bar.bar = launder_ptr(bar.bar); xcd_barrier(bar); } } while (0)
#define RUN(k, call) do { if (PH_ON(k) && IN(k)) { launder(F); call; } } while (0)
    RUN(0, phase0(F)); SEAM(0);
    RUN(1, phase1(F)); SEAM(1);
    RUN(2, phase2(F)); SEAM(2);
    RUN(3, phase3(F)); SEAM(3);
    RUN(4, phase4(F)); SEAM(4);
    RUN(5, phase5(F)); SEAM(5);
    RUN(6, phase6(F)); SEAM(6);
    RUN(7, phase7(F)); SEAM(7);
    RUN(8, phase8(F)); SEAM(8);
#pragma unroll 1
    for (int ph = (lo > 9 ? lo : 9); ph < hi; ++ph) {
        launder(F);
        const int rr = ph >= 13 ? 1 : 0, pq = ph >= 13 ? ph - 4 : ph;
        switch (pq) {
            case 9: if (PH_ON(9)) phase_n2r(F, rr); break;
            case 10: if (PH_ON(10)) phase_moe1(F, rr); break;
            case 11: if (PH_ON(11)) phase_moe2(F, rr); break;
            default: if (PH_ON(12)) phase_final(F, rr); break;
        }
        if (ph + 1 < hi) { bar.bar = launder_ptr(bar.bar); xcd_barrier(bar); }
    }
#undef IN
#undef SEAM
#undef RUN
}

#ifndef MK_SPLIT
#define MK_SPLIT 0
#endif
extern "C" void kernel_launch(void* const* d_in, const int* in_sizes, int n_in, void* d_out, int out_size, void* d_ws, size_t ws_size, hipStream_t stream) {
    static int grid = 0;
    if (grid == 0) {
        if (n_in != 20 || in_sizes[0] != MT * DM || out_size != MT * DM || ws_size < WS_END) { fprintf(stderr, "kernel_launch: unexpected shapes (n_in %d, in0 %d, out %d, ws %zu)\n", n_in, n_in > 0 ? in_sizes[0] : -1, out_size, ws_size); grid = -1; return; }
        int dev = 0, cus = 0;
        if (hipGetDevice(&dev) != hipSuccess || hipDeviceGetAttribute(&cus, hipDeviceAttributeMultiprocessorCount, dev) != hipSuccess) { grid = -1; return; }
        if (hipFuncSetAttribute((const void*)mega_fwd, hipFuncAttributeMaxDynamicSharedMemorySize, LDS_BYTES) != hipSuccess) { fprintf(stderr, "kernel_launch: hipFuncSetAttribute failed\n"); grid = -1; return; }
        int per_cu = 0;
        if (hipOccupancyMaxActiveBlocksPerMultiprocessor(&per_cu, (const void*)mega_fwd, 512, LDS_BYTES) != hipSuccess || per_cu < 1) fprintf(stderr, "kernel_launch: occupancy query reports %d\n", per_cu);
        (void)hipGetLastError();
        grid = cus;
    }
    if (grid < 0) return;
    (void)hipMemsetAsync((char*)d_ws + WS_CTL, 0, CTL_BYTES, stream);
    Args a{};
    for (int i = 0; i < 20; ++i) a.in[i] = (const float*)d_in[i];
    a.out = (float*)d_out; a.ws = (unsigned char*)d_ws;
#if MK_SPLIT
    for (int p = 0; p < N_PHASES; ++p) { a.ph_lo = p; a.ph_hi = p + 1; hipLaunchKernelGGL(mega_fwd, dim3(grid), dim3(512), LDS_BYTES, stream, a); }
#else
    a.ph_lo = 0; a.ph_hi = N_PHASES;
    hipLaunchKernelGGL(mega_fwd, dim3(grid), dim3(512), LDS_BYTES, stream, a);
#endif
}
```

```cpp
#include <hip/hip_runtime.h>
#include <cstdio>
#include <cstdint>

#define LAS __attribute__((address_space(3)))
#define GAS __attribute__((address_space(1)))
typedef unsigned short bf16_t;
typedef short bf16x8 __attribute__((ext_vector_type(8)));
typedef short s16x4 __attribute__((ext_vector_type(4)));
typedef float f32x4 __attribute__((ext_vector_type(4)));
typedef float f32x16 __attribute__((ext_vector_type(16)));
typedef float f32x2 __attribute__((ext_vector_type(2)));
typedef unsigned u32x4 __attribute__((ext_vector_type(4)));
typedef unsigned u32x2 __attribute__((ext_vector_type(2)));
typedef __bf16 bf16x2_t __attribute__((ext_vector_type(2)));

__device__ __forceinline__ unsigned cvtpk(float lo, float hi) { f32x2 v = {lo, hi}; bf16x2_t b = __builtin_convertvector(v, bf16x2_t); return __builtin_bit_cast(unsigned, b); }
__device__ __forceinline__ float bf2f(unsigned short u) { return __uint_as_float(((unsigned)u) << 16); }
__device__ __forceinline__ float bflo(unsigned u) { return __uint_as_float(u << 16); }
__device__ __forceinline__ float bfhi(unsigned u) { return __uint_as_float(u & 0xffff0000u); }

constexpr int NB = 4, SEQ = 8192, DM = 1024, MT = NB * SEQ;
constexpr int NHEAD = 8, HD = 64, QW = 1536;
constexpr int NE = 64, EFF = 256, NMOD = 6 * DM;
constexpr int RT = MT / 2;
constexpr float EPS = 1e-6f;
constexpr float LOG2E = 1.4426950408889634f;

constexpr size_t MiB = 1u << 20;
constexpr size_t WS_CTL = 0, CTL_BYTES = 1 * MiB;
constexpr size_t WS_SMALL = 1 * MiB;
constexpr size_t SM_MOD = 0, SM_GVEC = 98304, SM_CB = 114688, SM_KBAR = 131072, SM_WRH = 393216, SM_WRL = 524288;
constexpr size_t WS_W2T = 2 * MiB;
constexpr size_t WS_W1T = 35 * MiB;
constexpr size_t WS_WINT = 100 * MiB;
constexpr size_t WS_WBRT = 110 * MiB;
constexpr size_t WS_WOUTT = 112 * MiB;
constexpr size_t WS_H = 114 * MiB;
constexpr size_t WS_OB = 114 * MiB;
constexpr size_t WS_QSB = 178 * MiB;
constexpr size_t WS_PO = 178 * MiB;
constexpr size_t WS_QMB = 274 * MiB;
constexpr size_t WS_MERGED = 274 * MiB;
constexpr size_t WS_G = 370 * MiB;
constexpr size_t WS_LMB = 498 * MiB;
constexpr size_t WS_PLSE = 506 * MiB;
constexpr size_t WS_H2 = 100 * MiB;
constexpr size_t WS_TOKL = 164 * MiB;
constexpr size_t WS_WL = 172 * MiB;
constexpr size_t WS_TPOS = 180 * MiB;
constexpr size_t WS_ACT = 184 * MiB;
constexpr size_t WS_SLOTS = 264 * MiB;
constexpr size_t WS_SHOUT = 408 * MiB;
constexpr size_t WS_END = 509 * MiB;
constexpr int CW_MBCUR = 0;
constexpr int CW_MOECUR = 1024;
constexpr int CW_BAR = 4096;
constexpr size_t CTL_KBS = 512 * 1024;

constexpr int RING_BYTES = 131072;
constexpr int MISC_OFF = RING_BYTES;
constexpr int LDS_BYTES = 163840;
constexpr int MO_STG = 16384;

#define XB_TMO      128
#define XB_XCNT(j)  (256  + 64 * (j))
#define XB_XSUB(j)  (1280 + 64 * (j))
#define XB_XGEN(j)  (2304 + 64 * (j))
#define XB_TOP      3328
#define XB_TOPGEN   3392
#define XCD_BAR_WORDS 3456
#define XB_SPIN_CAP (1u << 18)
__device__ __forceinline__ unsigned xb_ld(unsigned* p)              { return __hip_atomic_load(p, __ATOMIC_RELAXED, __HIP_MEMORY_SCOPE_AGENT); }
__device__ __forceinline__ unsigned xb_add(unsigned* p, unsigned v) { return __hip_atomic_fetch_add(p, v, __ATOMIC_RELAXED, __HIP_MEMORY_SCOPE_AGENT); }
__device__ __forceinline__ unsigned xb_xcc_id() { return (unsigned)__builtin_amdgcn_s_getreg((3 << 11) | 20) & 0xFu; }
#define XB_SPIN(cond, bar) do { unsigned _sp = 0; while (cond) { __builtin_amdgcn_s_sleep(1); \
    if ((++_sp & 255u) == 0u) { if (xb_ld(&(bar)[XB_TMO])) break; if (_sp > XB_SPIN_CAP) { atomicAdd(&(bar)[XB_TMO], 1u); break; } } } } while (0)
struct XcdBarrier { unsigned* bar; unsigned x; volatile LAS unsigned* st; };
__device__ __forceinline__ XcdBarrier xcd_barrier_post(unsigned* bar, volatile LAS unsigned* st) {
    XcdBarrier b; b.bar = bar; b.x = xb_xcc_id(); b.st = st;
    if (threadIdx.x == 0) (void)xb_add(&bar[XB_XCNT(b.x)], 1u);
    return b;
}
__device__ __forceinline__ void xcd_barrier_complete(unsigned* bar, unsigned x, unsigned& nloc, unsigned& nx) {
    const unsigned G = gridDim.x * gridDim.y * gridDim.z;
    unsigned sum, cnt, mine, sp = 0u;
    for (;;) {
        sum = 0u; cnt = 0u; mine = 0u;
#pragma unroll
        for (unsigned j = 0; j < 16; ++j) { const unsigned c = xb_ld(&bar[XB_XCNT(j)]); sum += c; cnt += (c > 0u) ? 1u : 0u; mine = (j == x) ? c : mine; }
        if (sum == G) break;
        __builtin_amdgcn_s_sleep(1);
        if ((++sp & 255u) == 0u) { if (xb_ld(&bar[XB_TMO])) break; if (sp > XB_SPIN_CAP) { atomicAdd(&bar[XB_TMO], 1u); break; } }
    }
    nloc = mine > 0u ? mine : 1u; nx = cnt > 0u ? cnt : 1u;
}
__device__ __forceinline__ void xcd_barrier(const XcdBarrier& b) {
    asm volatile("s_waitcnt vmcnt(0)" ::: "memory");
    __syncthreads();
    if (threadIdx.x == 0) {
        unsigned* bar = b.bar;
        __builtin_amdgcn_s_waitcnt(0);
        unsigned nloc = b.st[0], nx = b.st[1];
        const unsigned old = xb_add(&bar[XB_XSUB(b.x)], 1u);
        const unsigned gen = old / nloc;
        if (old + 1u == (gen + 1u) * nloc) {
            __builtin_amdgcn_fence(__ATOMIC_RELEASE, "agent");
            asm volatile("s_waitcnt vmcnt(0)" ::: "memory");
            const unsigned og = xb_add(&bar[XB_TOP], 1u);
            const unsigned tg = og / nx;
            if (og + 1u == (tg + 1u) * nx) xb_add(&bar[XB_TOPGEN], 1u);
            else XB_SPIN(xb_ld(&bar[XB_TOPGEN]) == tg, bar);
            __builtin_amdgcn_fence(__ATOMIC_ACQUIRE, "agent");
            xb_add(&bar[XB_XGEN(b.x)], 1u);
            asm volatile("s_waitcnt vmcnt(0)" ::: "memory");
        } else {
            XB_SPIN(xb_ld(&bar[XB_XGEN(b.x)]) == gen, bar);
            __builtin_amdgcn_fence(__ATOMIC_ACQUIRE, "agent");
            asm volatile("s_waitcnt vmcnt(0)" ::: "memory");
        }
    }
    __syncthreads();
}

namespace gm {
constexpr int BM = 256, BK = 64, HALF = 128, HTB = HALF * BK * 2, STAGE_BYTES = 8 * HTB, NXCD = 8, WGM = 8;
__host__ __device__ __forceinline__ int lds_byte(int r, int c) { const int st = (r >> 4) * 2 + (c >> 5), rr = r & 15, cc = c & 31, ob = rr * 64 + cc * 2; return st * 1024 + (ob ^ (((ob >> 9) & 1) << 5)); }
__host__ __device__ __forceinline__ void stage_rc(int b, int& R, int& C) { const int st = b / 1024, sb = b % 1024, swz = sb ^ (((sb >> 9) & 1) << 5); R = (st >> 1) * 16 + swz / 64; C = (st & 1) * 32 + (swz % 64) / 2; }
__host__ __device__ __forceinline__ int perm32(int rho) { const int n = rho >> 4, i = rho & 15; return 8 * (i >> 2) + 4 * n + (i & 3); }

struct UnitD { const char* a; const char* b; unsigned va[2][2]; int e0, e1, e2, e3; };

__device__ __forceinline__ bool static_tile(int M, int N, int G, int c, int i, int& pm, int& pn) {
    const int nM = M / BM, nN = N / BM, nwg = nM * nN;
    const long L = (long)i * G + c; if (L >= nwg) return false;
    int wgid = (int)L; { const int q = nwg / NXCD, r = nwg % NXCD, xcd = wgid % NXCD, off = wgid / NXCD; wgid = (xcd < r ? xcd * (q + 1) : r * (q + 1) + (xcd - r) * q) + off; }
    const int nig = WGM * nN, gid = wgid / nig, fm = gid * WGM, gsz = (nM - fm) < WGM ? (nM - fm) : WGM;
    pm = fm + ((wgid % nig) % gsz); pn = (wgid % nig) / gsz; return true;
}

template <bool PERM, bool HOOK = false, class Epi, class Sched>
__device__ __forceinline__ void gemm_phase(LAS unsigned char* lds, const int K, Sched& S, const Epi& E) {
    const int tid = threadIdx.x, wid = __builtin_amdgcn_readfirstlane(tid >> 6), lane = tid & 63, wr = wid >> 2, wc = wid & 3, fr = lane & 15, fq = lane >> 4;
    const int nt = K / BK;
    unsigned voffB[2];
#pragma unroll
    for (int i = 0; i < 2; ++i) { int R, C; stage_rc(tid * 16 + i * 8192, R, C); const int Rb = PERM ? ((R & ~31) + perm32(R & 31)) : R; voffB[i] = (unsigned)(Rb * K + C) * 2u; }
    const size_t kstep = (size_t)(BK * 2);
    const size_t hstep = (size_t)HALF * K * 2;
    const unsigned ldsw = (unsigned)wid * 1024u;
    const int aoff = lds_byte(wr * 64 + fr, fq * 8), boff = lds_byte(wc * 32 + fr, fq * 8);
#define GM_SA(b, h) (((b) * 2 + (h)) * HTB)
#define GM_SB(b, h) ((4 + (b) * 2 + (h)) * HTB)
#define GM_STAGE_A(bufoff, U, h, kb) do { _Pragma("unroll") for (int _i = 0; _i < 2; ++_i) \
        __builtin_amdgcn_global_load_lds((const unsigned*)((U).a + (kb) + (U).va[h][_i]), (LAS unsigned*)(lds + (bufoff) + ldsw + _i * 8192), 16, 0, 0); } while (0)
#define GM_STAGE_B(bufoff, U, h, kb) do { _Pragma("unroll") for (int _i = 0; _i < 2; ++_i) \
        __builtin_amdgcn_global_load_lds((const unsigned*)((U).b + (kb) + (size_t)(h) * hstep + voffB[_i]), (LAS unsigned*)(lds + (bufoff) + ldsw + _i * 8192), 16, 0, 0); } while (0)
#define GM_LDA(dst, b, h) do { _Pragma("unroll") for (int m = 0; m < 4; ++m) _Pragma("unroll") for (int k = 0; k < 2; ++k) dst[m][k] = *(const LAS bf16x8*)(lds + GM_SA(b, h) + aoff + m * 2048 + k * 1024); } while (0)
#define GM_LDB(dst, b, h) do { _Pragma("unroll") for (int n = 0; n < 2; ++n) _Pragma("unroll") for (int k = 0; k < 2; ++k) dst[n][k] = *(const LAS bf16x8*)(lds + GM_SB(b, h) + boff + n * 2048 + k * 1024); } while (0)
#define GM_MMA(ai, bj, At, Bt) do { __builtin_amdgcn_s_setprio(1); _Pragma("unroll") for (int m = 0; m < 4; ++m) _Pragma("unroll") for (int n = 0; n < 2; ++n) _Pragma("unroll") for (int k = 0; k < 2; ++k) \
        acc[ai][bj][m][n] = __builtin_amdgcn_mfma_f32_16x16x32_bf16(Bt[n][k], At[m][k], acc[ai][bj][m][n], 0, 0, 0); __builtin_amdgcn_s_setprio(0); } while (0)
#define GM_WAIT_V(n) asm volatile("s_waitcnt vmcnt(" #n ")" ::: "memory")
#define GM_WAIT_L(n) asm volatile("s_waitcnt lgkmcnt(" #n ")" ::: "memory")
#define GM_BAR __builtin_amdgcn_s_barrier()
#define GM_SCHED __builtin_amdgcn_sched_barrier(0)
    UnitD cur, nxt; int ui = 0;
    if (!S.next(0, cur)) return;
    f32x4 acc[2][2][4][2];
#pragma unroll
    for (int a = 0; a < 2; ++a)
#pragma unroll
        for (int b = 0; b < 2; ++b)
#pragma unroll
            for (int m = 0; m < 4; ++m)
#pragma unroll
                for (int n = 0; n < 2; ++n) acc[a][b][m][n] = (f32x4){0.f, 0.f, 0.f, 0.f};
    bf16x8 At[4][2], B0[2][2], B1[2][2];
    GM_STAGE_B(GM_SB(0, 0), cur, 0, 0); GM_STAGE_B(GM_SB(0, 1), cur, 1, 0); GM_STAGE_A(GM_SA(0, 0), cur, 0, 0); GM_STAGE_A(GM_SA(0, 1), cur, 1, 0);
    if (wr == 1) GM_BAR;
    GM_WAIT_V(2); GM_BAR;
    GM_STAGE_B(GM_SB(1, 0), cur, 0, kstep); GM_STAGE_A(GM_SA(1, 0), cur, 0, kstep); GM_STAGE_B(GM_SB(1, 1), cur, 1, kstep);
    GM_WAIT_V(6); GM_BAR;
    for (;;) {
        const bool has_next = S.next(ui + 1, nxt);
        if (!has_next) nxt = cur;
#pragma unroll 1
        for (int t = 0; t < nt; t += 2) {
            const bool last = (t == nt - 2);
            if constexpr (HOOK) { if (t == nt / 2) E.mid(acc, cur, wr, wc, fr, fq); }
            const size_t k1 = (size_t)(t + 1) * kstep;
            UnitD U2 = cur; size_t k2 = (size_t)(t + 2) * kstep;
            if (last) { U2 = nxt; k2 = 0; }
            const size_t k3 = k2 + kstep;
            GM_LDB(B0, 0, 0); GM_LDB(B1, 0, 1); GM_SCHED; GM_LDA(At, 0, 0); GM_STAGE_A(GM_SA(1, 1), cur, 1, k1);
            GM_WAIT_V(8); GM_WAIT_L(0); GM_BAR; GM_MMA(0, 0, At, B0); GM_MMA(0, 1, At, B1); GM_BAR; GM_SCHED;
            GM_LDA(At, 0, 1); GM_STAGE_B(GM_SB(0, 0), U2, 0, k2); GM_STAGE_B(GM_SB(0, 1), U2, 1, k2); GM_STAGE_A(GM_SA(0, 0), U2, 0, k2);
            GM_WAIT_V(8); GM_WAIT_L(0); GM_BAR; GM_MMA(1, 0, At, B0); GM_MMA(1, 1, At, B1); GM_BAR; GM_SCHED;
            GM_LDB(B0, 1, 0); GM_LDB(B1, 1, 1); GM_SCHED; GM_LDA(At, 1, 0); GM_STAGE_A(GM_SA(0, 1), U2, 1, k2);
            GM_WAIT_V(8); GM_WAIT_L(0); GM_BAR; GM_MMA(0, 0, At, B0); GM_MMA(0, 1, At, B1); GM_BAR; GM_SCHED;
            GM_LDA(At, 1, 1); GM_STAGE_B(GM_SB(1, 0), U2, 0, k3); GM_STAGE_B(GM_SB(1, 1), U2, 1, k3); GM_STAGE_A(GM_SA(1, 0), U2, 0, k3);
            GM_WAIT_V(8); GM_WAIT_L(0); GM_BAR; GM_MMA(1, 0, At, B0); GM_MMA(1, 1, At, B1); GM_BAR; GM_SCHED;
        }
        if (wr == 0) GM_BAR;
        E(acc, cur, wr, wc, fr, fq);
        if (!has_next) break;
#pragma unroll
        for (int a = 0; a < 2; ++a)
#pragma unroll
            for (int b = 0; b < 2; ++b)
#pragma unroll
                for (int m = 0; m < 4; ++m)
#pragma unroll
                    for (int n = 0; n < 2; ++n) acc[a][b][m][n] = (f32x4){0.f, 0.f, 0.f, 0.f};
        cur = nxt; ++ui;
        if (wr == 1) GM_BAR;
    }
    GM_WAIT_V(0);
    GM_BAR;
#undef GM_SA
#undef GM_SB
#undef GM_STAGE_A
#undef GM_STAGE_B
#undef GM_LDA
#undef GM_LDB
#undef GM_MMA
#undef GM_WAIT_V
#undef GM_WAIT_L
#undef GM_BAR
#undef GM_SCHED
}
__device__ __forceinline__ void stage_geom(int tid, int (&R)[2], int (&C)[2]) {
#pragma unroll
    for (int i = 0; i < 2; ++i) stage_rc(tid * 16 + i * 8192, R[i], C[i]);
}
}

struct Args { const float* in[20]; float* out; unsigned char* ws; int ph_lo, ph_hi; };
struct Ctx {
    LAS unsigned char* lds;
    unsigned char* ws;
    const LAS unsigned long long* intab;
    float* out;
    int tid, lane, wave, G, bid;
};
#define LDS_WAIT() asm volatile("s_waitcnt lgkmcnt(0)" ::: "memory")
__device__ __forceinline__ const float* inp(const Ctx& F, int i) {
    const unsigned long long v = F.intab[i];
    const unsigned lo = __builtin_amdgcn_readfirstlane((unsigned)v), hi = __builtin_amdgcn_readfirstlane((unsigned)(v >> 32));
    return (const float*)(GAS const float*)(((unsigned long long)hi << 32) | lo);
}
template <class P> __device__ __forceinline__ P launder_ptr(P p) {
    unsigned long long v = (unsigned long long)p; unsigned lo = (unsigned)v, hi = (unsigned)(v >> 32);
    asm volatile("" : "+v"(lo), "+v"(hi));
    lo = __builtin_amdgcn_readfirstlane(lo); hi = __builtin_amdgcn_readfirstlane(hi);
    return (P)(GAS unsigned char*)(((unsigned long long)hi << 32) | lo);
}
__device__ __forceinline__ void launder(Ctx& F) {
    int t = F.tid, g = F.G, bid = F.bid;
    asm volatile("" : "+v"(t), "+v"(g), "+v"(bid));
    F.tid = t; F.G = __builtin_amdgcn_readfirstlane(g); F.bid = __builtin_amdgcn_readfirstlane(bid); F.lane = t & 63; F.wave = __builtin_amdgcn_readfirstlane(t >> 6);
    F.ws = launder_ptr(F.ws); F.out = launder_ptr(F.out);
}
__device__ __forceinline__ float wave_sum(float v) {
#pragma unroll
    for (int o = 1; o < 64; o <<= 1) v += __shfl_xor(v, o);
    return v;
}
__device__ __forceinline__ int lds_add(LAS int* p, int v) { return __hip_atomic_fetch_add(p, v, __ATOMIC_RELAXED, __HIP_MEMORY_SCOPE_WORKGROUP); }
__device__ __forceinline__ float sigmoidf_(float x) { return 1.f / (1.f + __expf(-x)); }
__device__ __forceinline__ float siluf_(float x) { return x / (1.f + __expf(-x)); }

enum { I_X = 0, I_C, I_N1G, I_N2G, I_WADA, I_BADA, I_WIN, I_WBSB, I_WBMB, I_WOUT, I_WR, I_RB, I_WGE, I_WUE, I_WDE, I_WGS, I_WUS, I_WDS, I_RELB, I_FG };

__device__ __forceinline__ void transpose_item(const float* W, int ldn, int k0, int n0, bf16_t* WT, int Kdst, int drow0, LAS float* scr, int lane) {
    const float* wp = W + (size_t)(k0 + (lane >> 3)) * ldn + n0 + 4 * (lane & 7);
    f32x4 v[8];
#pragma unroll
    for (int i = 0; i < 8; ++i) v[i] = *(const f32x4*)(wp + (size_t)(8 * i) * ldn);
#pragma unroll
    for (int i = 0; i < 8; ++i) { LAS float* d = scr + (8 * i + (lane >> 3)) * 33 + 4 * (lane & 7); d[0] = v[i].x; d[1] = v[i].y; d[2] = v[i].z; d[3] = v[i].w; }
    LDS_WAIT(); asm volatile("" ::: "memory");
    const int c = lane & 7;
#pragma unroll
    for (int j = 0; j < 4; ++j) { const int n = (lane >> 3) + 8 * j; const LAS float* s = scr + (8 * c) * 33 + n;
        u32x4 o; o.x = cvtpk(s[0 * 33], s[1 * 33]); o.y = cvtpk(s[2 * 33], s[3 * 33]); o.z = cvtpk(s[4 * 33], s[5 * 33]); o.w = cvtpk(s[6 * 33], s[7 * 33]);
        *(u32x4*)(WT + (size_t)(drow0 + n) * Kdst + k0 + 8 * c) = o; }
    LDS_WAIT(); asm volatile("" ::: "memory");
}
__device__ __forceinline__ void phase0(Ctx& F) {
    LAS float* silc = (LAS float*)(F.lds + MISC_OFF - 0);
    silc = (LAS float*)(F.lds + 0);
    for (int i = F.tid; i < 4 * DM; i += 512) silc[i] = siluf_(inp(F, I_C)[i]);
    __syncthreads();
    float* mod = (float*)(F.ws + WS_SMALL + SM_MOD);
    {
        const int gw = F.wave * F.G + F.bid;
        const int c = F.lane & 15, kp = F.lane >> 4;
        const float* wada = inp(F, I_WADA);
        for (int item = gw; item < NMOD / 16; item += 8 * F.G) {
            const int col = item * 16 + c;
            float a0 = 0.f, a1 = 0.f, a2 = 0.f, a3 = 0.f;
#pragma unroll 32
            for (int k = kp; k < DM; k += 4) { const float w = wada[(size_t)k * NMOD + col]; a0 += silc[k] * w; a1 += silc[DM + k] * w; a2 += silc[2 * DM + k] * w; a3 += silc[3 * DM + k] * w; }
            a0 += __shfl_xor(a0, 16); a0 += __shfl_xor(a0, 32); a1 += __shfl_xor(a1, 16); a1 += __shfl_xor(a1, 32);
            a2 += __shfl_xor(a2, 16); a2 += __shfl_xor(a2, 32); a3 += __shfl_xor(a3, 16); a3 += __shfl_xor(a3, 32);
            if (kp == 0) { const float bb = inp(F, I_BADA)[col]; mod[col] = a0 + bb; mod[NMOD + col] = a1 + bb; mod[2 * NMOD + col] = a2 + bb; mod[3 * NMOD + col] = a3 + bb; }
        }
    }
    __syncthreads();
    {
        LAS float* scr = (LAS float*)(F.lds + F.wave * 16384);
        const int gw = F.bid * 8 + F.wave, NGW = F.G * 8, lane = F.lane;
        constexpr int I_IN = 16 * 160, I_BR = 8 * 32, I_OUT = 16 * 32, I_EXP = 384, NIT = I_IN + 2 * I_BR + I_OUT + 65 * I_EXP;
        const float* p_win = inp(F, I_WIN); const float* p_bsb = inp(F, I_WBSB); const float* p_bmb = inp(F, I_WBMB); const float* p_out = inp(F, I_WOUT);
        const float* p_ge = inp(F, I_WGE); const float* p_ue = inp(F, I_WUE); const float* p_de = inp(F, I_WDE); const float* p_gs = inp(F, I_WGS); const float* p_us = inp(F, I_WUS); const float* p_ds = inp(F, I_WDS);
#define TD_GET(IT, SRC, LDN, DST, KD) do { int r = (IT); \
            if (r < I_IN) { const int kb = r / 160, nb = r % 160; SRC = p_win + (size_t)(kb * 64) * 5120 + nb * 32; LDN = 5120; DST = (bf16_t*)(F.ws + WS_WINT) + (size_t)(nb * 32) * 1024 + kb * 64; KD = 1024; } \
            else if ((r -= I_IN) < I_BR) { const int kb = r / 32, nb = r % 32; SRC = p_bsb + (size_t)(kb * 64) * 1024 + nb * 32; LDN = 1024; DST = (bf16_t*)(F.ws + WS_WBRT) + (size_t)(nb * 32) * 1024 + kb * 64; KD = 1024; } \
            else if ((r -= I_BR) < I_BR) { const int kb = r / 32, nb = r % 32; SRC = p_bmb + (size_t)(kb * 64) * 1024 + nb * 32; LDN = 1024; DST = (bf16_t*)(F.ws + WS_WBRT) + (size_t)(nb * 32) * 1024 + 512 + kb * 64; KD = 1024; } \
            else if ((r -= I_BR) < I_OUT) { const int kb = r / 32, nb = r % 32; SRC = p_out + (size_t)(kb * 64) * 1024 + nb * 32; LDN = 1024; DST = (bf16_t*)(F.ws + WS_WOUTT) + (size_t)(nb * 32) * 1024 + kb * 64; KD = 1024; } \
            else { r -= I_OUT; const int e = r / I_EXP; r -= e * I_EXP; \
                if (r < 128) { const int kb = r / 8, n0 = (r % 8) * 32; SRC = (e < NE ? p_ge + (size_t)e * DM * EFF : p_gs) + (size_t)(kb * 64) * EFF + n0; LDN = EFF; \
                    DST = (bf16_t*)(F.ws + WS_W1T) + ((size_t)e * 512 + (n0 >> 7) * 256 + (n0 & 127)) * 1024 + kb * 64; KD = 1024; } \
                else if (r < 256) { r -= 128; const int kb = r / 8, n0 = (r % 8) * 32; SRC = (e < NE ? p_ue + (size_t)e * DM * EFF : p_us) + (size_t)(kb * 64) * EFF + n0; LDN = EFF; \
                    DST = (bf16_t*)(F.ws + WS_W1T) + ((size_t)e * 512 + (n0 >> 7) * 256 + 128 + (n0 & 127)) * 1024 + kb * 64; KD = 1024; } \
                else { r -= 256; const int kb = r / 32, nb = r % 32; SRC = (e < NE ? p_de + (size_t)e * EFF * DM : p_ds) + (size_t)(kb * 64) * DM + nb * 32; LDN = DM; \
                    DST = (bf16_t*)(F.ws + WS_W2T) + ((size_t)e * 1024 + nb * 32) * 256 + kb * 64; KD = 256; } } } while (0)
#define TD_LOAD(V, SRC, LDN) do { const float* wp_ = (SRC) + (size_t)(lane >> 3) * (LDN) + 4 * (lane & 7); _Pragma("unroll") for (int i = 0; i < 8; ++i) V[i] = *(const f32x4*)(wp_ + (size_t)(8 * i) * (LDN)); } while (0)
#define TD_PROC(V, DST, KD) do { \
            _Pragma("unroll") for (int i = 0; i < 8; ++i) { LAS float* d = scr + (8 * i + (lane >> 3)) * 33 + 4 * (lane & 7); d[0] = V[i].x; d[1] = V[i].y; d[2] = V[i].z; d[3] = V[i].w; } \
            LDS_WAIT(); asm volatile("" ::: "memory"); \
            _Pragma("unroll") for (int j = 0; j < 4; ++j) { const int n = (lane >> 3) + 8 * j; const LAS float* sp = scr + (8 * (lane & 7)) * 33 + n; \
                u32x4 o; o.x = cvtpk(sp[0 * 33], sp[1 * 33]); o.y = cvtpk(sp[2 * 33], sp[3 * 33]); o.z = cvtpk(sp[4 * 33], sp[5 * 33]); o.w = cvtpk(sp[6 * 33], sp[7 * 33]); \
                *(u32x4*)((DST) + (size_t)n * (KD) + 8 * (lane & 7)) = o; } \
            LDS_WAIT(); asm volatile("" ::: "memory"); } while (0)
        const float* srcA = nullptr; const float* srcB = nullptr; bf16_t* dstA = nullptr; bf16_t* dstB = nullptr; int ldA = 0, ldB = 0, kdA = 0, kdB = 0;
        f32x4 vA[8], vB[8];
        int it = 2 * gw;
        if (it < NIT) { TD_GET(it, srcA, ldA, dstA, kdA); TD_GET(it + 1, srcB, ldB, dstB, kdB); TD_LOAD(vA, srcA, ldA); TD_LOAD(vB, srcB, ldB); }
        for (; it < NIT; it += 2 * NGW) {
            const float* srcAn = srcA; const float* srcBn = srcB; bf16_t* dstAn = dstA; bf16_t* dstBn = dstB; int ldAn = ldA, ldBn = ldB, kdAn = kdA, kdBn = kdB;
            f32x4 vAn[8], vBn[8];
            const bool has_next = it + 2 * NGW < NIT;
            if (has_next) { TD_GET(it + 2 * NGW, srcAn, ldAn, dstAn, kdAn); TD_GET(it + 2 * NGW + 1, srcBn, ldBn, dstBn, kdBn); TD_LOAD(vAn, srcAn, ldAn); TD_LOAD(vBn, srcBn, ldBn); }
            TD_PROC(vA, dstA, kdA);
            TD_PROC(vB, dstB, kdB);
            if (has_next) {
#pragma unroll
                for (int i = 0; i < 8; ++i) { vA[i] = vAn[i]; vB[i] = vBn[i]; }
                srcA = srcAn; srcB = srcBn; dstA = dstAn; dstB = dstBn; ldA = ldAn; ldB = ldBn; kdA = kdAn; kdB = kdBn; }
        }
#undef TD_PROC
#undef TD_GET
#undef TD_LOAD
    }
    {
        bf16_t* wrh = (bf16_t*)(F.ws + WS_SMALL + SM_WRH); bf16_t* wrl = (bf16_t*)(F.ws + WS_SMALL + SM_WRL);
        const float* wr = inp(F, I_WR);
        for (int i = F.bid * 512 + F.tid; i < NE * DM; i += F.G * 512) { const int e = i >> 10, k = i & 1023; const float v = wr[k * NE + e];
            const unsigned h = cvtpk(v, 0.f) & 0xffffu; wrh[i] = (bf16_t)h; wrl[i] = (bf16_t)(cvtpk(v - bflo(h), 0.f) & 0xffffu); }
    }
}

__device__ __forceinline__ void phase1(Ctx& F) {
    const float* mod = (const float*)(F.ws + WS_SMALL + SM_MOD);
    const float* x = inp(F, I_X); const float* g1 = inp(F, I_N1G);
    bf16_t* H = (bf16_t*)(F.ws + WS_H);
    const int gw = F.bid * 8 + F.wave, NGW = F.G * 8;
    if (gw < 256) {
        const int b = gw >> 6, e = gw & 63; const float* wr = inp(F, I_WR); float a = 0.f;
#pragma unroll 4
        for (int k = F.lane; k < DM; k += 64) a += mod[b * NMOD + 3 * DM + k] * wr[k * NE + e];
        a = wave_sum(a);
        if (F.lane == 0) ((float*)(F.ws + WS_SMALL + SM_CB))[gw] = a;
    }
    if (F.bid == 32) {
        float* gvec = (float*)(F.ws + WS_SMALL + SM_GVEC); const float* g2 = inp(F, I_N2G);
        for (int i = F.tid; i < 4 * DM; i += 512) { const int b = i >> 10, k = i & 1023; gvec[i] = g2[k] * (1.f + mod[b * NMOD + 4 * DM + k]); }
    }
    for (int m0 = gw; m0 < MT; m0 += 2 * NGW) {
        const int m1 = m0 + NGW;
        const bool two = m1 < MT;
        const f32x4* xr0 = (const f32x4*)(x + (size_t)m0 * DM) + F.lane; const f32x4* xr1 = (const f32x4*)(x + (size_t)(two ? m1 : m0) * DM) + F.lane;
        f32x4 v0[4], v1[4]; float s0 = 0.f, s1 = 0.f;
#pragma unroll
        for (int j = 0; j < 4; ++j) { v0[j] = xr0[64 * j]; v1[j] = xr1[64 * j]; }
#pragma unroll
        for (int j = 0; j < 4; ++j) { s0 += (v0[j].x * v0[j].x + v0[j].y * v0[j].y) + (v0[j].z * v0[j].z + v0[j].w * v0[j].w); s1 += (v1[j].x * v1[j].x + v1[j].y * v1[j].y) + (v1[j].z * v1[j].z + v1[j].w * v1[j].w); }
        const float r0 = rsqrtf(wave_sum(s0) * (1.f / DM) + EPS), r1 = rsqrtf(wave_sum(s1) * (1.f / DM) + EPS);
        const int b0 = m0 / SEQ, b1 = (two ? m1 : m0) / SEQ;
        u32x2* o0 = (u32x2*)(H + (size_t)m0 * DM) + F.lane; u32x2* o1 = (u32x2*)(H + (size_t)(two ? m1 : m0) * DM) + F.lane;
#pragma unroll
        for (int j = 0; j < 4; ++j) {
            const int col = 4 * F.lane + 256 * j;
            const f32x4 g = *(const f32x4*)(g1 + col);
            const f32x4 h0 = (v0[j] * r0) * g * (*(const f32x4*)(mod + b0 * NMOD + DM + col) + 1.0f) + *(const f32x4*)(mod + b0 * NMOD + col);
            const f32x4 h1 = (v1[j] * r1) * g * (*(const f32x4*)(mod + b1 * NMOD + DM + col) + 1.0f) + *(const f32x4*)(mod + b1 * NMOD + col);
            u32x2 w; w.x = cvtpk(h0.x, h0.y); w.y = cvtpk(h0.z, h0.w); o0[64 * j] = w;
            if (two) { w.x = cvtpk(h1.x, h1.y); w.y = cvtpk(h1.z, h1.w); o1[64 * j] = w; }
        }
    }
}

struct ProjSched {
    const char* A; const char* Bt; int G, c; int R[2], C[2];
    __device__ __forceinline__ bool next(int i, gm::UnitD& u) {
        int pm, pn; if (!gm::static_tile(MT, 5120, G, c, i, pm, pn)) return false;
        u.a = A; u.b = Bt + (size_t)pn * 256 * 1024 * 2;
#pragma unroll
        for (int h = 0; h < 2; ++h)
#pragma unroll
            for (int j = 0; j < 2; ++j) u.va[h][j] = (unsigned)((pm * 256 + h * 128 + R[j]) * 1024 + C[j]) * 2u;
        u.e0 = pm; u.e1 = pn; u.e2 = 0; u.e3 = 0; return true;
    }
};
struct EpiProj {
    bf16_t* qsb; bf16_t* qmb; bf16_t* g; float* kbs;
    __device__ __forceinline__ void operator()(const f32x4 (&acc)[2][2][4][2], const gm::UnitD& u, int wr, int wc, int fr, int fq) const {
        const int pm = u.e0, pn = u.e1;
        bf16_t* base; int ldc, colt; float sc = 1.f;
        if (pn < 6) { base = qsb; ldc = QW; colt = pn * 256; if (pn < 2) sc = 0.125f * LOG2E; }
        else if (pn < 12) { base = qmb; ldc = QW; colt = (pn - 6) * 256; if (pn < 8) sc = 0.125f; }
        else { base = g; ldc = 2048; colt = (pn - 12) * 256; }
        const int row0 = pm * 256 + wr * 64 + fr, col0 = colt + wc * 32 + 8 * fq;
        if (pn == 8 || pn == 9) {
#pragma unroll
            for (int bj = 0; bj < 2; ++bj)
#pragma unroll
                for (int n = 0; n < 2; ++n) { f32x4 cs = (f32x4){0.f, 0.f, 0.f, 0.f};
#pragma unroll
                    for (int ai = 0; ai < 2; ++ai)
#pragma unroll
                        for (int m = 0; m < 4; ++m) cs += acc[ai][bj][m][n];
#pragma unroll
                    for (int o = 1; o < 16; o <<= 1) { cs[0] += __shfl_xor(cs[0], o); cs[1] += __shfl_xor(cs[1], o); cs[2] += __shfl_xor(cs[2], o); cs[3] += __shfl_xor(cs[3], o); }
                    if (fr == 0) { float* kd = kbs + (size_t)pm * 512 + (pn - 8) * 256 + bj * 128 + wc * 32 + 8 * fq + 4 * n;
#pragma unroll
                        for (int j = 0; j < 4; ++j) atomicAdd(kd + j, cs[j]); } }
        }
#pragma unroll
        for (int ai = 0; ai < 2; ++ai)
#pragma unroll
            for (int m = 0; m < 4; ++m) { bf16_t* rowp = base + (size_t)(row0 + ai * 128 + m * 16) * ldc + col0;
#pragma unroll
                for (int bj = 0; bj < 2; ++bj) { const f32x4 v0 = acc[ai][bj][m][0] * sc, v1 = acc[ai][bj][m][1] * sc;
                    u32x4 w; w.x = cvtpk(v0[0], v0[1]); w.y = cvtpk(v0[2], v0[3]); w.z = cvtpk(v1[0], v1[1]); w.w = cvtpk(v1[2], v1[3]);
                    *(u32x4*)(rowp + bj * 128) = w; } }
    }
};
__device__ __forceinline__ void phase2(Ctx& F) {
    ProjSched S; S.A = (const char*)(F.ws + WS_H); S.Bt = (const char*)(F.ws + WS_WINT); S.G = F.G; S.c = F.bid; gm::stage_geom(F.tid, S.R, S.C);
    EpiProj E{(bf16_t*)(F.ws + WS_QSB), (bf16_t*)(F.ws + WS_QMB), (bf16_t*)(F.ws + WS_G), (float*)(F.ws + WS_CTL + CTL_KBS)};
    gm::gemm_phase<true>(F.lds, 1024, S, E);
}

__device__ __forceinline__ int crow(int r, int hi) { return (r & 3) + 8 * (r >> 2) + 4 * hi; }
typedef short v4i16_t __attribute__((ext_vector_type(4)));
__device__ __forceinline__ s16x4 vtr(const LAS unsigned char* p) { return __builtin_bit_cast(s16x4, __builtin_amdgcn_ds_read_tr16_b64_v4i16((LAS v4i16_t*)p)); }
__device__ __forceinline__ void pv64(f32x16 (&o)[2], const LAS unsigned char* vt, int lane, const u32x4 (&pw)[4]) {
    const int hi = lane >> 5;
    const LAS unsigned char* vb = vt + ((lane >> 4) & 1) * 32 + (lane & 3) * 8 + (4 * hi + ((lane & 15) >> 2)) * 64;
#pragma unroll
    for (int d0 = 0; d0 < 2; ++d0)
#pragma unroll
        for (int ks = 0; ks < 4; ++ks) {
            const s16x4 lo = vtr(vb + d0 * 4096 + ks * 1024), hh = vtr(vb + d0 * 4096 + ks * 1024 + 512);
            const bf16x8 bv = (bf16x8){lo[0], lo[1], lo[2], lo[3], hh[0], hh[1], hh[2], hh[3]};
            o[d0] = __builtin_amdgcn_mfma_f32_32x32x16_bf16(__builtin_bit_cast(bf16x8, pw[ks]), bv, o[d0], 0, 0, 0);
        }
}
__device__ __forceinline__ void store_o_tile(const f32x16 (&o)[2], LAS unsigned char* stgb, int lane, bf16_t* dst0, size_t row_pitch) {
    const int r32 = lane & 31, hi = lane >> 5;
    LAS bf16_t* stg = (LAS bf16_t*)stgb;
#pragma unroll
    for (int r = 0; r < 16; ++r) { const int orow = crow(r, hi);
#pragma unroll
        for (int d0 = 0; d0 < 2; ++d0) stg[orow * 64 + d0 * 32 + r32] = (bf16_t)(cvtpk(o[d0][r], 0.f) & 0xffffu); }
    LDS_WAIT();
#pragma unroll
    for (int i = 0; i < 4; ++i) { const int row = i * 8 + (lane >> 3), ch = lane & 7; const u32x4 v = *(const LAS u32x4*)(stg + row * 64 + ch * 8); *(u32x4*)(dst0 + (size_t)row * row_pitch + ch * 8) = v; }
    LDS_WAIT();
}

template <bool MASKED>
__device__ __forceinline__ void sb_tile(const f32x16 (&z)[2], float& P, u32x4 (&pw)[4], int k0, int qpos, int hi) {
    f32x16 be[2], nb[2];
#pragma unroll
    for (int p = 0; p < 2; ++p)
#pragma unroll
        for (int r = 0; r < 16; ++r) {
            const float zz = __builtin_amdgcn_fmed3f(z[p][r], -126.f, 126.f);
            const float t = __builtin_amdgcn_exp2f(-zz), b_ = __builtin_amdgcn_rcpf(1.f + t);
            float n_ = t * b_, bb = b_;
            if (MASKED) { const bool valid = (k0 + 32 * p + crow(r, hi)) < qpos; n_ = valid ? n_ : 1.f; bb = valid ? bb : 0.f; }
            be[p][r] = bb; nb[p][r] = n_;
        }
    float Gp[8], PG[8], off[8];
#pragma unroll
    for (int idx = 0; idx < 8; ++idx) { const int p = idx >> 2, g4 = (idx & 3) * 4; Gp[idx] = (nb[p][g4] * nb[p][g4 + 1]) * (nb[p][g4 + 2] * nb[p][g4 + 3]); }
#pragma unroll
    for (int idx = 0; idx < 8; ++idx) PG[idx] = __shfl_xor(Gp[idx], 32);
    float run = P;
#pragma unroll
    for (int idx = 7; idx >= 0; --idx) { off[idx] = hi ? run : run * PG[idx]; run *= (Gp[idx] * PG[idx]); }
    P = run;
#pragma unroll
    for (int idx = 0; idx < 8; ++idx) { const int p = idx >> 2, g4 = (idx & 3) * 4; float c = off[idx]; float a[4];
#pragma unroll
        for (int j = 3; j >= 0; --j) { a[j] = be[p][g4 + j] * c; c *= nb[p][g4 + j]; }
        pw[idx >> 1][(idx & 1) * 2] = cvtpk(a[0], a[1]); pw[idx >> 1][(idx & 1) * 2 + 1] = cvtpk(a[2], a[3]); }
}
__device__ __forceinline__ void sb_unit(Ctx& F, int bh, int qt, LAS unsigned char* vl) {
    const int lane = F.lane, r32 = lane & 31, hi = lane >> 5;
    const int b = bh >> 3, h = bh & 7, q0 = qt * 32, qpos = q0 + r32;
    const bf16_t* base = (const bf16_t*)(F.ws + WS_QSB) + (size_t)b * SEQ * QW + h * 64;
    const bf16_t* Kb = base + 512 + (size_t)r32 * QW + hi * 8; const bf16_t* Vb = base + 1024 + (size_t)(lane >> 2) * QW + (lane & 3) * 8;
    bf16x8 qr[4];
#pragma unroll
    for (int d0 = 0; d0 < 4; ++d0) qr[d0] = *(const bf16x8*)(base + (size_t)qpos * QW + d0 * 16 + hi * 8);
    float P = 1.f; f32x16 o[2]; o[0] = f32x16{}; o[1] = f32x16{};
    bf16x8 kfn[8];
    const int kt0 = q0 >> 6; int kt = kt0, cur = 0;
#define SB_PREFETCH(KT, BUF) do { const size_t ko_ = (size_t)(KT) * 64 * QW; \
        _Pragma("unroll") for (int d0 = 0; d0 < 4; ++d0) _Pragma("unroll") for (int hf = 0; hf < 2; ++hf) kfn[2 * d0 + hf] = *(const bf16x8*)(Kb + ko_ + (size_t)(32 * hf) * QW + d0 * 16); \
        _Pragma("unroll") for (int p = 0; p < 8; ++p) __builtin_amdgcn_global_load_lds((const unsigned*)(Vb + ko_ + (size_t)(16 * (p & 3)) * QW + (p >> 2) * 32), (LAS unsigned*)(vl + (BUF) * 8192 + p * 1024), 16, 0, 0); } while (0)
    SB_PREFETCH(kt, 0);
#pragma unroll 1
    for (; kt >= 0; --kt) {
        if (__all(P == 0.f)) break;
        f32x16 z[2]; z[0] = f32x16{}; z[1] = f32x16{};
#pragma unroll
        for (int d0 = 0; d0 < 4; ++d0) { z[0] = __builtin_amdgcn_mfma_f32_32x32x16_bf16(kfn[2 * d0], qr[d0], z[0], 0, 0, 0); z[1] = __builtin_amdgcn_mfma_f32_32x32x16_bf16(kfn[2 * d0 + 1], qr[d0], z[1], 0, 0, 0); }
        asm volatile("" : "+v"(z[0]), "+v"(z[1]));
        { const int ktn = kt > 0 ? kt - 1 : 0; SB_PREFETCH(ktn, cur ^ 1); }
        u32x4 pw[4];
        if (kt == kt0) sb_tile<true>(z, P, pw, kt * 64, qpos, hi); else sb_tile<false>(z, P, pw, kt * 64, qpos, hi);
        asm volatile("s_waitcnt vmcnt(16)" ::: "memory");
        pv64(o, vl + cur * 8192, lane, pw);
        cur ^= 1;
    }
#undef SB_PREFETCH
    asm volatile("s_waitcnt vmcnt(0)" ::: "memory");
    bf16_t* dst = (bf16_t*)(F.ws + WS_OB) + (size_t)(b * SEQ + q0) * 1024 + h * 64;
    store_o_tile(o, vl, lane, dst, 1024);
}
__device__ __forceinline__ void sb_units(Ctx& F) {
    const int gw = F.bid * 8 + F.wave, NGW = F.G * 8;
    LAS unsigned char* vl = F.lds + F.wave * 16384;
    for (int u = gw; u < 32 * 256; u += NGW) sb_unit(F, u >> 8, u & 255, vl);
}

constexpr int MO_LUT = 0, MO_PRE = 4224, MO_WSF = 8320, MO_ENT = 12416, MO_ST = 16368;
__device__ __forceinline__ int mb_list_off(int j) { return 256 * (31 * j - (j * (j - 1)) / 2); }
constexpr int MB_LIST_STRIDE = 126976;
__device__ __forceinline__ int t5_bucket_dev(int n) {
    if (n < 16) return n;
    int large = 16 + (int)(logf((float)n / 16.f) / 2.0794415416798357f * 16.f);
    return large < 31 ? large : 31;
}
__device__ __forceinline__ void build_lut(Ctx& F) {
    LAS float* lut = (LAS float*)(F.lds + MISC_OFF + MO_LUT);
    for (int i = F.tid; i < 8 * 132; i += 512) { const int h = i / 132, d = i % 132; lut[i] = inp(F, I_RELB)[h * 32 + t5_bucket_dev(d < 128 ? d : 128)] * LOG2E; }
}
__device__ __forceinline__ void phase4(Ctx& F) {
    LAS int* lcnt = (LAS int*)(F.lds + MISC_OFF + MO_PRE); LAS int* lbase = lcnt + 32;
    const float* kbar = (const float*)(F.ws + WS_CTL + CTL_KBS);
    unsigned* cur = (unsigned*)(F.ws + WS_CTL) + CW_MBCUR;
    unsigned short* lists = (unsigned short*)(F.ws + WS_LMB);
    const int lane = F.lane, r32 = lane & 31, hi = lane >> 5;
    for (int u = F.bid; u < 32 * 31; u += F.G) {
        const int bh = u / 31, i = 1 + (u % 31), b = bh >> 3, h = bh & 7;
        if (F.tid < 32) lcnt[F.tid] = 0;
        __syncthreads();
        const int qpos = i * 256 + F.wave * 32 + r32;
        const float* kp = kbar + (size_t)(b * 32 + r32) * 512 + h * 64 + hi * 8;
        const bf16_t* qp = (const bf16_t*)(F.ws + WS_QMB) + (size_t)(b * SEQ + qpos) * QW + h * 64 + hi * 8;
        f32x16 gt = f32x16{};
#pragma unroll
        for (int s4 = 0; s4 < 4; ++s4) {
            const f32x4 k0 = *(const f32x4*)(kp + 16 * s4), k1 = *(const f32x4*)(kp + 16 * s4 + 4);
            const bf16x8 qf = *(const bf16x8*)(qp + 16 * s4);
            const unsigned a0 = cvtpk(k0.x, k0.y), a1 = cvtpk(k0.z, k0.w), a2 = cvtpk(k1.x, k1.y), a3 = cvtpk(k1.z, k1.w);
            const u32x4 kh = (u32x4){a0, a1, a2, a3};
            const u32x4 kl = (u32x4){cvtpk(k0.x - bflo(a0), k0.y - bfhi(a0)), cvtpk(k0.z - bflo(a1), k0.w - bfhi(a1)), cvtpk(k1.x - bflo(a2), k1.y - bfhi(a2)), cvtpk(k1.z - bflo(a3), k1.w - bfhi(a3))};
            gt = __builtin_amdgcn_mfma_f32_32x32x16_bf16(__builtin_bit_cast(bf16x8, kl), qf, gt, 0, 0, 0);
            gt = __builtin_amdgcn_mfma_f32_32x32x16_bf16(__builtin_bit_cast(bf16x8, kh), qf, gt, 0, 0, 0);
        }
        float v0 = -INFINITY, v1 = -INFINITY, v2 = -INFINITY; int j0 = 64, j1 = 64, j2 = 64;
#pragma unroll
        for (int r = 0; r < 16; ++r) { const int j = crow(r, hi); const float g = j < i ? gt[r] : -INFINITY;
            if (g > v0) { v2 = v1; j2 = j1; v1 = v0; j1 = j0; v0 = g; j0 = j; }
            else if (g > v1) { v2 = v1; j2 = j1; v1 = g; j1 = j; }
            else if (g > v2) { v2 = g; j2 = j; } }
        {
            const float pv[3] = {__shfl_xor(v0, 32), __shfl_xor(v1, 32), __shfl_xor(v2, 32)}; const int pj[3] = {__shfl_xor(j0, 32), __shfl_xor(j1, 32), __shfl_xor(j2, 32)};
#pragma unroll
            for (int t = 0; t < 3; ++t) { const float g = pv[t]; const int j = pj[t];
                if (g > v0 || (g == v0 && j < j0)) { v2 = v1; j2 = j1; v1 = v0; j1 = j0; v0 = g; j0 = j; }
                else if (g > v1 || (g == v1 && j < j1)) { v2 = v1; j2 = j1; v1 = g; j1 = j; }
                else if (g > v2 || (g == v2 && j < j2)) { v2 = g; j2 = j; } }
        }
        const int nsel = i < 3 ? i : 3;
        int r0 = 0, r1 = 0, r2 = 0;
        if (hi == 0) { r0 = lds_add(&lcnt[j0], 1); if (nsel > 1) r1 = lds_add(&lcnt[j1], 1); if (nsel > 2) r2 = lds_add(&lcnt[j2], 1); }
        __syncthreads();
        if (F.tid < i) { const int n = lcnt[F.tid]; lbase[F.tid] = n > 0 ? (int)atomicAdd(&cur[bh * 32 + F.tid], (unsigned)n) : 0; }
        __syncthreads();
        if (hi == 0) {
            unsigned short* lb = lists + (size_t)bh * MB_LIST_STRIDE;
            lb[mb_list_off(j0) + lbase[j0] + r0] = (unsigned short)(qpos | (0 << 13));
            if (nsel > 1) lb[mb_list_off(j1) + lbase[j1] + r1] = (unsigned short)(qpos | (1 << 13));
            if (nsel > 2) lb[mb_list_off(j2) + lbase[j2] + r2] = (unsigned short)(qpos | (2 << 13));
        }
    }
}
__device__ __forceinline__ void kv_dma(Ctx& F, const bf16_t* kg, const bf16_t* vg, int bufoff) {
    const int l = F.lane;
#pragma unroll
    for (int i = 0; i < 4; ++i) { const int p = 4 * F.wave + i;
        __builtin_amdgcn_global_load_lds((const unsigned*)(kg + (size_t)(8 * p + (l >> 3)) * QW + ((l & 7) ^ ((l >> 3) & 7)) * 8), (LAS unsigned*)(F.lds + bufoff + p * 1024), 16, 0, 0);
        __builtin_amdgcn_global_load_lds((const unsigned*)(vg + (size_t)((p >> 3) * 64 + (p & 3) * 16 + (l >> 2)) * QW + ((p >> 2) & 1) * 32 + (l & 3) * 8), (LAS unsigned*)(F.lds + bufoff + 32768 + p * 1024), 16, 0, 0); }
}
__device__ __forceinline__ void softmax_step(f32x16 (&t)[2], float& m, float& l, f32x16 (&o)[2], LAS float* wsf, const LAS unsigned char* vt, int lane) {
    const int r32 = lane & 31, hi = lane >> 5;
    float rm = -INFINITY;
#pragma unroll
    for (int p = 0; p < 2; ++p)
#pragma unroll
        for (int r = 0; r < 16; ++r) rm = fmaxf(rm, t[p][r]);
    rm = fmaxf(rm, __shfl_xor(rm, 32));
    const float mn = fmaxf(m, rm);
    const float f = __builtin_amdgcn_exp2f(m - mn);
    m = mn;
    float s = 0.f; u32x4 pw[4];
#pragma unroll
    for (int p = 0; p < 2; ++p)
#pragma unroll
        for (int r = 0; r < 16; ++r) { const float e = __builtin_amdgcn_exp2f(t[p][r] - mn); t[p][r] = e; s += e; }
    l = l * f + s;
#pragma unroll
    for (int idx = 0; idx < 8; ++idx) { const int p = idx >> 2, g4 = (idx & 3) * 4; pw[idx >> 1][(idx & 1) * 2] = cvtpk(t[p][g4], t[p][g4 + 1]); pw[idx >> 1][(idx & 1) * 2 + 1] = cvtpk(t[p][g4 + 2], t[p][g4 + 3]); }
    if (__any(f != 1.f)) {
        if (hi == 0) wsf[r32] = f;
        LDS_WAIT();
#pragma unroll
        for (int g = 0; g < 4; ++g) { const f32x4 fv = *(const LAS f32x4*)(wsf + 8 * g + 4 * hi);
#pragma unroll
            for (int j = 0; j < 4; ++j) { o[0][4 * g + j] *= fv[j]; o[1][4 * g + j] *= fv[j]; } }
        LDS_WAIT();
    }
    pv64(o, vt, lane, pw);
}
__device__ __forceinline__ void qkt64(f32x16 (&t)[2], const LAS unsigned char* kt, const bf16x8 (&qr)[4], int lane) {
    const int r32 = lane & 31, hi = lane >> 5;
    t[0] = f32x16{}; t[1] = f32x16{};
    const LAS unsigned char* rp = kt + r32 * 128;
#pragma unroll
    for (int d0 = 0; d0 < 4; ++d0) {
        const int pos = ((2 * d0 + hi) ^ (r32 & 7)) * 16;
        const bf16x8 k0 = *(const LAS bf16x8*)(rp + pos), k1 = *(const LAS bf16x8*)(rp + 4096 + pos);
        t[0] = __builtin_amdgcn_mfma_f32_32x32x16_bf16(k0, qr[d0], t[0], 0, 0, 0); t[1] = __builtin_amdgcn_mfma_f32_32x32x16_bf16(k1, qr[d0], t[1], 0, 0, 0);
    }
}
__device__ __forceinline__ void phase5(Ctx& F) {
    LAS int* pre = (LAS int*)(F.lds + MISC_OFF + MO_PRE);
    LAS int* wtot = (LAS int*)(F.lds + MISC_OFF + MO_ENT);
    const unsigned* cur = (const unsigned*)(F.ws + WS_CTL) + CW_MBCUR;
    build_lut(F);
    int total;
    {
        const int p0 = 2 * F.tid, p1 = p0 + 1;
        const int c0 = p0 < 992 ? (int)((cur[(p0 / 31) * 32 + (p0 % 31)] + 255u) >> 8) : 0;
        const int c1 = p1 < 992 ? (int)((cur[(p1 / 31) * 32 + (p1 % 31)] + 255u) >> 8) : 0;
        const int s = c0 + c1; int v = s;
#pragma unroll
        for (int o = 1; o < 64; o <<= 1) { const int n = __shfl_up(v, o); if (F.lane >= o) v += n; }
        if (F.lane == 63) wtot[248 + F.wave] = v;
        __syncthreads();
        int woff = 0; total = 0;
#pragma unroll
        for (int w = 0; w < 8; ++w) { const int x = wtot[248 + w]; if (w < F.wave) woff += x; total += x; }
        const int excl = woff + v - s;
        pre[p0] = excl; pre[p1] = excl + c0;
        __syncthreads();
    }
    const unsigned short* lists = (const unsigned short*)(F.ws + WS_LMB);
    LAS float* wsf = (LAS float*)(F.lds + MISC_OFF + MO_WSF) + F.wave * 128;
    LAS int* ent = (LAS int*)(F.lds + MISC_OFF + MO_ENT) + F.wave * 32;
    const int lane = F.lane, r32 = lane & 31, hi = lane >> 5;
#define P5_UNIT(U, BH, J, C) do { int lo_ = 0, hi_ = 992; while (hi_ - lo_ > 1) { const int mid = (lo_ + hi_) >> 1; if (pre[mid] <= (U)) lo_ = mid; else hi_ = mid; } BH = lo_ / 31; J = lo_ % 31; C = (U) - pre[lo_]; } while (0)
#define P5_DMA(BH, J, BUF) do { const bf16_t* b_ = (const bf16_t*)(F.ws + WS_QMB) + (size_t)((BH) >> 3) * SEQ * QW + ((BH) & 7) * 64; kv_dma(F, b_ + 512 + (size_t)((J) * 256) * QW, b_ + 1024 + (size_t)((J) * 256) * QW, (BUF) * 65536); } while (0)
#define P5_ENTRY(BH, J, C, ACT, VALID, ENTRY) do { const int n_ = (int)cur[(BH) * 32 + (J)]; const int e0_ = (C) * 256 + F.wave * 32; ACT = e0_ < n_; VALID = ACT && (e0_ + r32) < n_; \
        const unsigned short* lb_ = lists + (size_t)(BH) * MB_LIST_STRIDE + mb_list_off(J); ENTRY = ACT ? (int)lb_[VALID ? e0_ + r32 : e0_] : 0; } while (0)
#define P5_QLOAD(BH, ENTRY, Q) do { const bf16_t* b_ = (const bf16_t*)(F.ws + WS_QMB) + (size_t)((BH) >> 3) * SEQ * QW + ((BH) & 7) * 64 + (size_t)((ENTRY) & 8191) * QW + hi * 8; \
        _Pragma("unroll") for (int d0 = 0; d0 < 4; ++d0) Q[d0] = *(const bf16x8*)(b_ + d0 * 16); } while (0)
    int u = F.bid, bh = 0, j = 0, c = 0, buf = 0;
    bool act = false, valid = false; int entry = 0; bf16x8 qr[4];
    if (u < total) { P5_UNIT(u, bh, j, c); P5_DMA(bh, j, 0); P5_ENTRY(bh, j, c, act, valid, entry); P5_QLOAD(bh, entry, qr); }
    for (; u < total; u += F.G) {
        const int un = u + F.G; int bhn = 0, jn = 0, cn = 0;
        const bool has_next = un < total;
        if (has_next) P5_UNIT(un, bhn, jn, cn);
        const int h = bh & 7;
        const int qpos = entry & 8191, slot = entry >> 13;
        asm volatile("s_waitcnt vmcnt(0)" ::: "memory");
        __syncthreads();
        bool actn = false, validn = false; int entryn = 0; bf16x8 qn[4];
        if (has_next) { P5_DMA(bhn, jn, buf ^ 1); P5_ENTRY(bhn, jn, cn, actn, validn, entryn); }
        const LAS unsigned char* kimg = F.lds + buf * 65536; const LAS unsigned char* vimg = kimg + 32768;
        if (act) {
            if (hi == 0) ent[r32] = valid ? entry : -1;
            float m = -INFINITY, l = 0.f; f32x16 o[2]; o[0] = f32x16{}; o[1] = f32x16{};
            const LAS float* lut = (const LAS float*)(F.lds + MISC_OFF + MO_LUT) + h * 132;
            const float bfar = lut[128];
#pragma unroll 1
            for (int st = 0; st < 4; ++st) {
                if (st == 2 && has_next) P5_QLOAD(bhn, entryn, qn);
                f32x16 t[2]; qkt64(t, kimg + st * 8192, qr, lane);
                const int kbase = j * 256 + st * 64;
                const bool far = __all(qpos - (kbase + 63) >= 128);
                if (far) {
#pragma unroll
                    for (int pp = 0; pp < 2; ++pp)
#pragma unroll
                        for (int r = 0; r < 16; ++r) t[pp][r] = t[pp][r] * LOG2E + bfar;
                } else {
#pragma unroll
                    for (int pp = 0; pp < 2; ++pp)
#pragma unroll
                        for (int r = 0; r < 16; ++r) { int d = qpos - (kbase + 32 * pp + crow(r, hi)); d = d < 128 ? d : 128; d = d > 0 ? d : 0; t[pp][r] = t[pp][r] * LOG2E + lut[d]; }
                }
                softmax_step(t, m, l, o, wsf, vimg + st * 8192, lane);
            }
            l += __shfl_xor(l, 32);
            const float rl = 1.f / l;
            if (hi == 0) { wsf[r32] = rl; if (valid) ((float*)(F.ws + WS_PLSE))[((size_t)bh * SEQ + qpos) * 3 + slot] = m + __log2f(l); }
            LDS_WAIT();
            {
                LAS bf16_t* stg = (LAS bf16_t*)(F.lds + MISC_OFF + MO_STG + F.wave * 2048);
                bf16_t* po = (bf16_t*)(F.ws + WS_PO);
#pragma unroll
                for (int d0 = 0; d0 < 2; ++d0) {
#pragma unroll
                    for (int r = 0; r < 16; ++r) { const int q = crow(r, hi); stg[q * 32 + r32] = (bf16_t)(cvtpk(o[d0][r] * wsf[q], 0.f) & 0xffffu); }
                    LDS_WAIT();
#pragma unroll
                    for (int it2 = 0; it2 < 2; ++it2) { const int row = it2 * 16 + (lane >> 2), ch = lane & 3; const int en = ent[row];
                        const u32x4 v = *(const LAS u32x4*)(stg + row * 32 + ch * 8);
                        if (en >= 0) *(u32x4*)(po + (((size_t)bh * SEQ + (en & 8191)) * 3 + (en >> 13)) * 64 + d0 * 32 + ch * 8) = v; }
                    LDS_WAIT();
                }
            }
        } else if (has_next) { P5_QLOAD(bhn, entryn, qn); }
        bh = bhn; j = jn; c = cn; buf ^= 1; act = actn; valid = validn; entry = entryn;
#pragma unroll
        for (int d0 = 0; d0 < 4; ++d0) qr[d0] = qn[d0];
    }
#undef P5_ENTRY
#undef P5_QLOAD
#undef P5_UNIT
#undef P5_DMA
    asm volatile("s_waitcnt vmcnt(0)" ::: "memory");
    __syncthreads();
}
__device__ __forceinline__ void phase6(Ctx& F) {
    build_lut(F);
    LAS float* wsf = (LAS float*)(F.lds + MISC_OFF + MO_WSF) + F.wave * 128;
    const int lane = F.lane, r32 = lane & 31, hi = lane >> 5, w = F.wave;
#define P6_DMA(U, BUF) do { const int bh_ = (U) >> 5, i_ = 31 - ((U) & 31); const bf16_t* b_ = (const bf16_t*)(F.ws + WS_QMB) + (size_t)(bh_ >> 3) * SEQ * QW + (bh_ & 7) * 64; \
        kv_dma(F, b_ + 512 + (size_t)(i_ * 256) * QW, b_ + 1024 + (size_t)(i_ * 256) * QW, (BUF) * 65536); } while (0)
    int buf = 0;
    if (F.bid < 32 * 32) P6_DMA(F.bid, 0);
    for (int u = F.bid; u < 32 * 32; u += F.G) {
        const int bh = u >> 5, i = 31 - (u & 31), b = bh >> 3, h = bh & 7;
        const bf16_t* base = (const bf16_t*)(F.ws + WS_QMB) + (size_t)b * SEQ * QW + h * 64;
        const int ql = w * 32 + r32, qpos = i * 256 + ql;
        bf16x8 qr[4];
#pragma unroll
        for (int d0 = 0; d0 < 4; ++d0) qr[d0] = *(const bf16x8*)(base + (size_t)qpos * QW + d0 * 16 + hi * 8);
        const int nsel = i < 3 ? i : 3;
        const float* plse = (const float*)(F.ws + WS_PLSE) + ((size_t)bh * SEQ + qpos) * 3;
        float ls0 = -INFINITY, ls1 = -INFINITY, ls2 = -INFINITY;
        if (nsel > 0) ls0 = plse[0]; if (nsel > 1) ls1 = plse[1]; if (nsel > 2) ls2 = plse[2];
        asm volatile("s_waitcnt vmcnt(0)" ::: "memory");
        __syncthreads();
        if (u + F.G < 32 * 32) P6_DMA(u + F.G, buf ^ 1);
        const LAS unsigned char* kimg = F.lds + buf * 65536; const LAS unsigned char* vimg = kimg + 32768;
        float m = -INFINITY, l = 0.f; f32x16 o[2]; o[0] = f32x16{}; o[1] = f32x16{};
        const LAS float* lut = (const LAS float*)(F.lds + MISC_OFF + MO_LUT) + h * 132;
        const int nst = (w >> 1) + 1;
#pragma unroll 1
        for (int st = 0; st < nst; ++st) {
            f32x16 t[2]; qkt64(t, kimg + st * 8192, qr, lane);
#pragma unroll
            for (int pp = 0; pp < 2; ++pp)
#pragma unroll
                for (int r = 0; r < 16; ++r) { const int d = ql - (st * 64 + 32 * pp + crow(r, hi)); const int dc = d < 128 ? (d > 0 ? d : 0) : 128; const float v = t[pp][r] * LOG2E + lut[dc]; t[pp][r] = d >= 0 ? v : -INFINITY; }
            softmax_step(t, m, l, o, wsf, vimg + st * 8192, lane);
        }
        l += __shfl_xor(l, 32);
        const float M = fmaxf(fmaxf(m, ls0), fmaxf(ls1, ls2));
        const float eo = __builtin_amdgcn_exp2f(m - M), e0 = __builtin_amdgcn_exp2f(ls0 - M), e1 = __builtin_amdgcn_exp2f(ls1 - M), e2 = __builtin_amdgcn_exp2f(ls2 - M);
        const float rden = 1.f / (l * eo + e0 + e1 + e2);
        if (hi == 0) *(LAS f32x4*)(wsf + 4 * r32) = (f32x4){eo * rden, e0 * rden, e1 * rden, e2 * rden};
        LDS_WAIT();
#pragma unroll
        for (int r = 0; r < 16; ++r) { const float fo = wsf[4 * crow(r, hi)]; o[0][r] *= fo; o[1][r] *= fo; }
        __syncthreads();
        {
            LAS bf16_t* stg = (LAS bf16_t*)(F.lds + buf * 65536 + w * 4096);
#pragma unroll
            for (int r = 0; r < 16; ++r) { const int orow = crow(r, hi);
#pragma unroll
                for (int d0 = 0; d0 < 2; ++d0) stg[orow * 64 + d0 * 32 + r32] = (bf16_t)(cvtpk(o[d0][r], 0.f) & 0xffffu); }
            LDS_WAIT();
            const bf16_t* po = (const bf16_t*)(F.ws + WS_PO) + ((size_t)bh * SEQ + i * 256 + w * 32) * 3 * 64;
            bf16_t* dst = (bf16_t*)(F.ws + WS_OB) + (size_t)(b * SEQ + i * 256 + w * 32) * 1024 + 512 + h * 64;
#pragma unroll
            for (int it4 = 0; it4 < 4; ++it4) { const int row = it4 * 8 + (lane >> 3), ch = lane & 7;
                const u32x4 ov = *(const LAS u32x4*)(stg + row * 64 + ch * 8);
                float a[8] = {bflo(ov.x), bfhi(ov.x), bflo(ov.y), bfhi(ov.y), bflo(ov.z), bfhi(ov.z), bflo(ov.w), bfhi(ov.w)};
                const f32x4 fc = *(const LAS f32x4*)(wsf + 4 * row);
#pragma unroll
                for (int sl = 0; sl < 3; ++sl) if (sl < nsel) { const u32x4 pv = *(const u32x4*)(po + (size_t)(row * 3 + sl) * 64 + ch * 8); const float f = fc[1 + sl];
                    a[0] += f * bflo(pv.x); a[1] += f * bfhi(pv.x); a[2] += f * bflo(pv.y); a[3] += f * bfhi(pv.y); a[4] += f * bflo(pv.z); a[5] += f * bfhi(pv.z); a[6] += f * bflo(pv.w); a[7] += f * bfhi(pv.w); }
                u32x4 w4; w4.x = cvtpk(a[0], a[1]); w4.y = cvtpk(a[2], a[3]); w4.z = cvtpk(a[4], a[5]); w4.w = cvtpk(a[6], a[7]);
                *(u32x4*)(dst + (size_t)row * 1024 + ch * 8) = w4; }
            LDS_WAIT();
        }
        buf ^= 1;
    }
#undef P6_DMA
    asm volatile("s_waitcnt vmcnt(0)" ::: "memory");
    __syncthreads();
}

struct BranchSched {
    const char* A; const char* Bt; int G, c; int R[2], C[2];
    __device__ __forceinline__ bool next(int i, gm::UnitD& u) {
        int pm, pn; if (!gm::static_tile(MT, 1024, G, c, i, pm, pn)) return false;
        u.a = A; u.b = Bt + (size_t)(pn * 256) * 1024 * 2;
#pragma unroll
        for (int h = 0; h < 2; ++h)
#pragma unroll
            for (int j = 0; j < 2; ++j) u.va[h][j] = (unsigned)((pm * 256 + h * 128 + R[j]) * 1024 + C[j]) * 2u;
        u.e0 = pm; u.e1 = pn; u.e2 = 0; u.e3 = 0; return true;
    }
};
struct EpiBranch {
    const bf16_t* g; bf16_t* merged;
    static __device__ __forceinline__ float ratio(float gs, float gm_) { return (1.f + fminf(__expf(-gm_), 1e30f)) * __builtin_amdgcn_rcpf(1.f + __expf(-gs)); }
    __device__ __forceinline__ void mid(f32x4 (&acc)[2][2][4][2], const gm::UnitD& u, int wr, int wc, int fr, int fq) const {
        const bf16_t* gp = g + (size_t)(u.e0 * 256 + wr * 64 + fr) * 2048 + u.e1 * 256 + wc * 32 + 8 * fq;
#pragma unroll
        for (int ai = 0; ai < 2; ++ai)
#pragma unroll
            for (int m = 0; m < 4; m += 2) {
                asm volatile("" : "+v"(gp) :: "memory");
                u32x4 gs[2][2], gq[2][2];
#pragma unroll
                for (int mm = 0; mm < 2; ++mm)
#pragma unroll
                    for (int bj = 0; bj < 2; ++bj) { gs[mm][bj] = *(const u32x4*)(gp + (size_t)mm * 16 * 2048 + bj * 128); gq[mm][bj] = *(const u32x4*)(gp + (size_t)mm * 16 * 2048 + 1024 + bj * 128); }
#pragma unroll
                for (int mm = 0; mm < 2; ++mm)
#pragma unroll
                    for (int bj = 0; bj < 2; ++bj) { const u32x4 a = gs[mm][bj], b = gq[mm][bj];
                        f32x4& c0 = acc[ai][bj][m + mm][0]; f32x4& c1 = acc[ai][bj][m + mm][1];
                        c0[0] *= ratio(bflo(a.x), bflo(b.x)); c0[1] *= ratio(bfhi(a.x), bfhi(b.x)); c0[2] *= ratio(bflo(a.y), bflo(b.y)); c0[3] *= ratio(bfhi(a.y), bfhi(b.y));
                        c1[0] *= ratio(bflo(a.z), bflo(b.z)); c1[1] *= ratio(bfhi(a.z), bfhi(b.z)); c1[2] *= ratio(bflo(a.w), bflo(b.w)); c1[3] *= ratio(bfhi(a.w), bfhi(b.w));
                        asm volatile("" : "+v"(c0), "+v"(c1) :: "memory"); }
                gp += (m == 2 ? 96 : 32) * 2048; }
    }
    __device__ __forceinline__ void operator()(const f32x4 (&acc)[2][2][4][2], const gm::UnitD& u, int wr, int wc, int fr, int fq) const {
        const int row0 = u.e0 * 256 + wr * 64 + fr, col0 = u.e1 * 256 + wc * 32 + 8 * fq;
#pragma unroll
        for (int ai = 0; ai < 2; ++ai)
#pragma unroll
            for (int m = 0; m < 4; ++m) { const size_t row = (size_t)(row0 + ai * 128 + m * 16);
#pragma unroll
                for (int bj = 0; bj < 2; ++bj) { const u32x4 gm_ = *(const u32x4*)(g + row * 2048 + 1024 + col0 + bj * 128);
                    const float b[8] = {bflo(gm_.x), bfhi(gm_.x), bflo(gm_.y), bfhi(gm_.y), bflo(gm_.z), bfhi(gm_.z), bflo(gm_.w), bfhi(gm_.w)};
                    float r[8];
#pragma unroll
                    for (int j = 0; j < 8; ++j) r[j] = acc[ai][bj][m][j >> 2][j & 3] * __builtin_amdgcn_rcpf(1.f + fminf(__expf(-b[j]), 1e30f));
                    u32x4 w; w.x = cvtpk(r[0], r[1]); w.y = cvtpk(r[2], r[3]); w.z = cvtpk(r[4], r[5]); w.w = cvtpk(r[6], r[7]);
                    *(u32x4*)(merged + row * 1024 + col0 + bj * 128) = w; } }
    }
};
__device__ __forceinline__ void phase7(Ctx& F) {
    BranchSched S; S.A = (const char*)(F.ws + WS_OB); S.Bt = (const char*)(F.ws + WS_WBRT); S.G = F.G; S.c = F.bid; gm::stage_geom(F.tid, S.R, S.C);
    EpiBranch E{(const bf16_t*)(F.ws + WS_G), (bf16_t*)(F.ws + WS_MERGED)};
    gm::gemm_phase<true, true>(F.lds, 1024, S, E);
}
struct OutSched {
    const char* A; const char* Bt; int G, c; int R[2], C[2];
    __device__ __forceinline__ bool next(int i, gm::UnitD& u) {
        int pm, pn; if (!gm::static_tile(MT, 1024, G, c, i, pm, pn)) return false;
        u.a = A; u.b = Bt + (size_t)pn * 256 * 1024 * 2;
#pragma unroll
        for (int h = 0; h < 2; ++h)
#pragma unroll
            for (int j = 0; j < 2; ++j) u.va[h][j] = (unsigned)((pm * 256 + h * 128 + R[j]) * 1024 + C[j]) * 2u;
        u.e0 = pm; u.e1 = pn; u.e2 = 0; u.e3 = 0; return true;
    }
};
struct EpiOut {
    const float* x; const float* mod; float* out;
    __device__ __forceinline__ void operator()(const f32x4 (&acc)[2][2][4][2], const gm::UnitD& u, int wr, int wc, int fr, int fq) const {
        const int pm = u.e0, pn = u.e1, b = (pm * 256) / SEQ;
        const int row0 = pm * 256 + wr * 64 + fr, col0 = pn * 256 + wc * 32 + 4 * fq;
        f32x4 gt[2][2];
#pragma unroll
        for (int bj = 0; bj < 2; ++bj)
#pragma unroll
            for (int n = 0; n < 2; ++n) gt[bj][n] = *(const f32x4*)(mod + b * NMOD + 2 * DM + col0 + bj * 128 + n * 16);
#pragma unroll
        for (int ai = 0; ai < 2; ++ai)
#pragma unroll
            for (int m = 0; m < 4; ++m) { const size_t off = (size_t)(row0 + ai * 128 + m * 16) * DM + col0;
#pragma unroll
                for (int bj = 0; bj < 2; ++bj)
#pragma unroll
                    for (int n = 0; n < 2; ++n) { const f32x4 xv = *(const f32x4*)(x + off + bj * 128 + n * 16); *(f32x4*)(out + off + bj * 128 + n * 16) = xv + gt[bj][n] * acc[ai][bj][m][n]; } }
    }
};
__device__ __forceinline__ void phase8(Ctx& F) {
    OutSched S; S.A = (const char*)(F.ws + WS_MERGED); S.Bt = (const char*)(F.ws + WS_WOUTT); S.G = F.G; S.c = F.bid; gm::stage_geom(F.tid, S.R, S.C);
    EpiOut E{inp(F, I_X), (const float*)(F.ws + WS_SMALL + SM_MOD), F.out};
    gm::gemm_phase<false>(F.lds, 1024, S, E);
}

constexpr int NR_SSQ = MO_PRE + 1024;
constexpr int NR_RS = MO_PRE + 3072;
__device__ __forceinline__ void phase_n2r(Ctx& F, int rr) {
    const float* x1 = F.out; const float* gvec = (const float*)(F.ws + WS_SMALL + SM_GVEC); const float* cb = (const float*)(F.ws + WS_SMALL + SM_CB);
    const float* mod = (const float*)(F.ws + WS_SMALL + SM_MOD); const float* rbias = inp(F, I_RB);
    bf16_t* H2 = (bf16_t*)(F.ws + WS_H2) + (size_t)rr * RT * DM; int* tokl = (int*)(F.ws + WS_TOKL) + (size_t)rr * 64 * RT; float* wl = (float*)(F.ws + WS_WL) + (size_t)rr * 64 * RT; int* tpos = (int*)(F.ws + WS_TPOS) + (size_t)rr * RT * 8;
    unsigned* cur = (unsigned*)(F.ws + WS_CTL) + CW_MOECUR + rr * 64;
    LAS int* lcnt = (LAS int*)(F.lds + MISC_OFF + MO_PRE); LAS int* lbase = lcnt + 64;
    LAS float* part = (LAS float*)(F.lds);
    LAS float* ssqp = (LAS float*)(F.lds + MISC_OFF + NR_SSQ); LAS float* rsl = (LAS float*)(F.lds + MISC_OFF + NR_RS);
    const int lane = F.lane, w = F.wave, i16 = lane & 15, kk = lane >> 4;
    for (int u = F.bid; u < RT / 64; u += F.G) {
        if (F.tid < 64) lcnt[F.tid] = 0;
        const int tokb = rr * RT + u * 64, b = tokb / SEQ;
        {
            bf16x8 fah[4][4], fal[4][4];
            {
                const float* gp = gvec + b * DM + 128 * w + 8 * kk;
                f32x4 gv[4][2];
#pragma unroll
                for (int s4 = 0; s4 < 4; ++s4) { gv[s4][0] = *(const f32x4*)(gp + 32 * s4); gv[s4][1] = *(const f32x4*)(gp + 32 * s4 + 4); }
#pragma unroll
                for (int tt = 0; tt < 4; ++tt) {
                    const float* xp = x1 + (size_t)(tokb + tt * 16 + i16) * DM + 128 * w + 8 * kk;
                    f32x4 xa[4][2];
#pragma unroll
                    for (int s4 = 0; s4 < 4; ++s4) { xa[s4][0] = *(const f32x4*)(xp + 32 * s4); xa[s4][1] = *(const f32x4*)(xp + 32 * s4 + 4); }
                    float ssq = 0.f;
#pragma unroll
                    for (int s4 = 0; s4 < 4; ++s4) {
                        u32x4 ah, al;
#pragma unroll
                        for (int q = 0; q < 2; ++q) { const f32x4 xv = xa[s4][q]; ssq += (xv.x * xv.x + xv.y * xv.y) + (xv.z * xv.z + xv.w * xv.w);
                            const f32x4 a = xv * gv[s4][q];
                            const unsigned h0 = cvtpk(a.x, a.y), h1 = cvtpk(a.z, a.w);
                            ah[2 * q] = h0; ah[2 * q + 1] = h1; al[2 * q] = cvtpk(a.x - bflo(h0), a.y - bfhi(h0)); al[2 * q + 1] = cvtpk(a.z - bflo(h1), a.w - bfhi(h1)); }
                        fah[tt][s4] = __builtin_bit_cast(bf16x8, ah); fal[tt][s4] = __builtin_bit_cast(bf16x8, al);
                    }
                    ssq += __shfl_xor(ssq, 16); ssq += __shfl_xor(ssq, 32); if (kk == 0) ssqp[w * 64 + tt * 16 + i16] = ssq;
                }
            }
#pragma unroll 1
            for (int eh = 0; eh < 2; ++eh) {
                bf16x8 wh[2][4], wl_[2][4];
                {
                    const bf16_t* ph = (const bf16_t*)(F.ws + WS_SMALL + SM_WRH) + (size_t)(eh * 32 + i16) * DM + 128 * w + 8 * kk;
                    const bf16_t* pl = (const bf16_t*)(F.ws + WS_SMALL + SM_WRL) + (size_t)(eh * 32 + i16) * DM + 128 * w + 8 * kk;
#pragma unroll
                    for (int c = 0; c < 2; ++c)
#pragma unroll
                        for (int s4 = 0; s4 < 4; ++s4) { wh[c][s4] = *(const bf16x8*)(ph + (size_t)c * 16 * DM + 32 * s4); wl_[c][s4] = *(const bf16x8*)(pl + (size_t)c * 16 * DM + 32 * s4); }
                }
#pragma unroll
                for (int tt = 0; tt < 4; ++tt) {
                    f32x4 acc[2]; acc[0] = acc[1] = (f32x4){0.f, 0.f, 0.f, 0.f};
#pragma unroll
                    for (int s4 = 0; s4 < 4; ++s4)
#pragma unroll
                        for (int c = 0; c < 2; ++c) {
                            acc[c] = __builtin_amdgcn_mfma_f32_16x16x32_bf16(fal[tt][s4], wh[c][s4], acc[c], 0, 0, 0);
                            acc[c] = __builtin_amdgcn_mfma_f32_16x16x32_bf16(fah[tt][s4], wl_[c][s4], acc[c], 0, 0, 0);
                            acc[c] = __builtin_amdgcn_mfma_f32_16x16x32_bf16(fah[tt][s4], wh[c][s4], acc[c], 0, 0, 0); }
#pragma unroll
                    for (int c = 0; c < 2; ++c)
#pragma unroll
                        for (int reg = 0; reg < 4; ++reg) part[(w * 64 + tt * 16 + 4 * kk + reg) * 64 + eh * 32 + 16 * c + i16] = acc[c][reg];
                }
            }
        }
        __syncthreads();
        const int tl = F.tid >> 3, g = F.tid & 7;
        int my_e; float my_w; int my_rank;
        {
            float ssq = 0.f;
#pragma unroll
            for (int q = 0; q < 8; ++q) ssq += ssqp[q * 64 + tl];
            const float rstd = rsqrtf(ssq * (1.f / DM) + EPS);
            if (g == 0) rsl[tl] = rstd;
            float s8[8], c8[8];
            {
                f32x4 lo4 = (f32x4){0.f, 0.f, 0.f, 0.f}, hi4 = lo4;
#pragma unroll
                for (int q = 0; q < 8; ++q) { const LAS f32x4* pp = (const LAS f32x4*)(part + (q * 64 + tl) * 64 + 8 * g); lo4 += pp[0]; hi4 += pp[1]; }
                const f32x4 cb0 = *(const f32x4*)(cb + b * 64 + 8 * g), cb1 = *(const f32x4*)(cb + b * 64 + 8 * g + 4), rb0 = *(const f32x4*)(rbias + 8 * g), rb1 = *(const f32x4*)(rbias + 8 * g + 4);
#pragma unroll
                for (int j = 0; j < 4; ++j) { s8[j] = sigmoidf_(lo4[j] * rstd + cb0[j]); s8[4 + j] = sigmoidf_(hi4[j] * rstd + cb1[j]); c8[j] = s8[j] + rb0[j]; c8[4 + j] = s8[4 + j] + rb1[j]; }
            }
            float m1 = -INFINITY, m2 = -INFINITY;
#pragma unroll
            for (int j = 0; j < 8; ++j) { const float v = c8[j]; if (v > m1) { m2 = m1; m1 = v; } else if (v > m2) m2 = v; }
            const float gs = m1 + m2;
            int rank = 0;
#pragma unroll
            for (int g2 = 0; g2 < 8; ++g2) { const float o = __shfl(gs, g2, 8); rank += (o > gs || (o == gs && g2 < g)) ? 1 : 0; }
            if (rank >= 4) {
#pragma unroll
                for (int j = 0; j < 8; ++j) c8[j] = -INFINITY;
            }
            int sel_e[8]; float sk[8]; float wsum = 0.f;
#pragma unroll
            for (int k = 0; k < 8; ++k) {
                float bv = -INFINITY, bs = 0.f; int be = 8 * g;
#pragma unroll
                for (int j = 0; j < 8; ++j) if (c8[j] > bv) { bv = c8[j]; be = 8 * g + j; bs = s8[j]; }
#pragma unroll
                for (int o = 1; o < 8; o <<= 1) { const float ov = __shfl_xor(bv, o, 8), os = __shfl_xor(bs, o, 8); const int oe = __shfl_xor(be, o, 8); if (ov > bv || (ov == bv && oe < be)) { bv = ov; be = oe; bs = os; } }
                sel_e[k] = be; sk[k] = bs; wsum += bs;
#pragma unroll
                for (int j = 0; j < 8; ++j) if (be == 8 * g + j) c8[j] = -INFINITY;
            }
            my_e = sel_e[0]; my_w = sk[0];
#pragma unroll
            for (int k = 1; k < 8; ++k) if (g == k) { my_e = sel_e[k]; my_w = sk[k]; }
            my_w *= 2.5f / wsum;
            my_rank = lds_add(&lcnt[my_e], 1);
        }
        __syncthreads();
        if (F.tid < 64) { const int n = lcnt[F.tid]; lbase[F.tid] = n > 0 ? (int)atomicAdd(&cur[F.tid], (unsigned)n) : 0; }
        __syncthreads();
        { const int tok = tokb + tl, pos = lbase[my_e] + my_rank; tokl[my_e * RT + pos] = tok * 8 + g; wl[my_e * RT + pos] = my_w; tpos[(tok - rr * RT) * 8 + g] = (my_e << 16) | pos; }
#pragma unroll 1
        for (int r0 = 0; r0 < 8; r0 += 4) {
            f32x4 xv[4][4];
#pragma unroll
            for (int r = 0; r < 4; ++r) { const f32x4* xr = (const f32x4*)(x1 + (size_t)(tokb + w * 8 + r0 + r) * DM) + lane;
#pragma unroll
                for (int j = 0; j < 4; ++j) xv[r][j] = xr[64 * j]; }
#pragma unroll
            for (int j = 0; j < 4; ++j) { const int col = 4 * lane + 256 * j; const f32x4 gq = *(const f32x4*)(gvec + b * DM + col), sh = *(const f32x4*)(mod + b * NMOD + 3 * DM + col);
#pragma unroll
                for (int r = 0; r < 4; ++r) { const int tl2 = w * 8 + r0 + r; const f32x4 hv = (xv[r][j] * rsl[tl2]) * gq + sh;
                    u32x2 o; o.x = cvtpk(hv.x, hv.y); o.y = cvtpk(hv.z, hv.w); ((u32x2*)(H2 + (size_t)(tokb - rr * RT + tl2) * DM) + lane)[64 * j] = o; } }
        }
        __syncthreads();
    }
}
constexpr int MO_TE = 4224;
struct MoeTabs { const LAS unsigned short* te; const LAS int* tb; const LAS int* cnt; int TR; };
__device__ __forceinline__ MoeTabs build_moe_tabs(Ctx& F, int rr) {
    LAS unsigned short* te = (LAS unsigned short*)(F.lds + MISC_OFF + MO_TE); LAS int* tb = (LAS int*)(F.lds + MISC_OFF + MO_TE + 1536); LAS int* cnt = tb + 72;
    const unsigned* cur = (const unsigned*)(F.ws + WS_CTL) + CW_MOECUR + rr * 64;
    __syncthreads();
    if (F.tid == 0) { int acc = 0; for (int e = 0; e < 64; ++e) { const int c = (int)cur[e]; cnt[e] = c; tb[e] = acc; acc += (c + 255) >> 8; } tb[64] = acc; tb[65] = acc + RT / 256; cnt[64] = RT; }
    __syncthreads();
    const int TR = tb[64];
    for (int e = F.tid >> 3; e < 65; e += 64) for (int t = tb[e] + (F.tid & 7); t < tb[e + 1]; t += 8) te[t] = (unsigned short)e;
    __syncthreads();
    MoeTabs T; T.te = te; T.tb = tb; T.cnt = cnt; T.TR = TR; return T;
}
struct Moe1Sched {
    const char* H2; const char* W1T; const int* tokl; MoeTabs T; int G, c, rr; int R[2], C[2];
    __device__ __forceinline__ bool next(int i, gm::UnitD& u) {
        const int uu = i * G + c; const int nt = T.TR + RT / 256;
        if (uu >= nt * 2) return false;
        const int tile = uu >> 1, pn = uu & 1, e = T.te[tile], rt = tile - T.tb[e], cnt = T.cnt[e];
        u.a = H2; u.b = W1T + (size_t)(e * 512 + pn * 256) * 1024 * 2;
#pragma unroll
        for (int h = 0; h < 2; ++h)
#pragma unroll
            for (int j = 0; j < 2; ++j) { const int idx = rt * 256 + h * 128 + R[j]; int trow;
                if (e < 64) { const int ent = tokl[e * RT + (idx < cnt ? idx : rt * 256)]; trow = (ent >> 3) - rr * RT; } else trow = idx;
                u.va[h][j] = (unsigned)(trow * 1024 + C[j]) * 2u; }
        u.e0 = tile; u.e1 = pn; u.e2 = e; u.e3 = rt; return true;
    }
};
struct EpiMoe1 {
    bf16_t* act; const float* wl; const LAS int* cnt;
    __device__ __forceinline__ void operator()(const f32x4 (&acc)[2][2][4][2], const gm::UnitD& u, int wr, int wc, int fr, int fq) const {
        const int row0 = u.e0 * 256 + wr * 64 + fr, col0 = u.e1 * 128 + wc * 32 + 8 * fq, e = u.e2, n = cnt[e];
        float rw[2][4];
#pragma unroll
        for (int ai = 0; ai < 2; ++ai)
#pragma unroll
            for (int m = 0; m < 4; ++m) { const int idx = u.e3 * 256 + ai * 128 + wr * 64 + m * 16 + fr; rw[ai][m] = e < 64 ? (idx < n ? wl[e * RT + idx] : 0.f) : 1.f; }
#pragma unroll
        for (int ai = 0; ai < 2; ++ai)
#pragma unroll
            for (int m = 0; m < 4; ++m) { const float ww = rw[ai][m]; const f32x4 g0 = acc[ai][0][m][0], g1 = acc[ai][0][m][1], u0 = acc[ai][1][m][0] * ww, u1 = acc[ai][1][m][1] * ww;
                u32x4 w; w.x = cvtpk(siluf_(g0[0]) * u0[0], siluf_(g0[1]) * u0[1]); w.y = cvtpk(siluf_(g0[2]) * u0[2], siluf_(g0[3]) * u0[3]);
                w.z = cvtpk(siluf_(g1[0]) * u1[0], siluf_(g1[1]) * u1[1]); w.w = cvtpk(siluf_(g1[2]) * u1[2], siluf_(g1[3]) * u1[3]);
                *(u32x4*)(act + (size_t)(row0 + ai * 128 + m * 16) * 256 + col0) = w; }
    }
};
__device__ __forceinline__ void phase_moe1(Ctx& F, int rr) {
    Moe1Sched S; S.T = build_moe_tabs(F, rr); S.H2 = (const char*)(F.ws + WS_H2) + (size_t)rr * RT * DM * 2; S.W1T = (const char*)(F.ws + WS_W1T); S.tokl = (const int*)(F.ws + WS_TOKL) + (size_t)rr * 64 * RT; S.G = F.G; S.c = (F.G % 8 == 0) ? (F.bid % 8) * (F.G / 8) + F.bid / 8 : F.bid; S.rr = rr; gm::stage_geom(F.tid, S.R, S.C);
    EpiMoe1 E{(bf16_t*)(F.ws + WS_ACT), (const float*)(F.ws + WS_WL) + (size_t)rr * 64 * RT, S.T.cnt};
    gm::gemm_phase<true>(F.lds, 1024, S, E);
}
struct Moe2Sched {
    const char* ACT; const char* W2T; MoeTabs T; int G, c; int R[2], C[2];
    __device__ __forceinline__ bool next(int i, gm::UnitD& u) {
        const int uu = i * G + c; const int nt = T.TR + RT / 256;
        if (uu >= nt * 4) return false;
        const int tile = uu >> 2, pn = uu & 3, e = T.te[tile], rt = tile - T.tb[e];
        u.a = ACT + (size_t)tile * 256 * 256 * 2; u.b = W2T + (size_t)(e * 1024 + pn * 256) * 256 * 2;
#pragma unroll
        for (int h = 0; h < 2; ++h)
#pragma unroll
            for (int j = 0; j < 2; ++j) u.va[h][j] = (unsigned)((h * 128 + R[j]) * 256 + C[j]) * 2u;
        u.e0 = pn; u.e1 = e; u.e2 = rt; u.e3 = tile; return true;
    }
};
struct EpiMoe2 {
    bf16_t* slots; bf16_t* shout; const LAS int* cnt;
    __device__ __forceinline__ void operator()(const f32x4 (&acc)[2][2][4][2], const gm::UnitD& u, int wr, int wc, int fr, int fq) const {
        const int pn = u.e0, e = u.e1, rt = u.e2, tile = u.e3;
        const int col0 = pn * 256 + wc * 32 + 8 * fq, n = cnt[e];
        if (e < 64) {
            unsigned char* base = (unsigned char*)slots + (size_t)(tile * 256 + wr * 64 + fr) * 1024 + col0;
#pragma unroll
            for (int ai = 0; ai < 2; ++ai)
#pragma unroll
                for (int m = 0; m < 4; ++m) {
                    if (rt * 256 + ai * 128 + wr * 64 + m * 16 + fr < n) {
#pragma unroll
                        for (int bj = 0; bj < 2; ++bj) { f32x4 v0 = acc[ai][bj][m][0] * 16.f, v1 = acc[ai][bj][m][1] * 16.f;
#pragma unroll
                            for (int j = 0; j < 4; ++j) { v0[j] = __builtin_amdgcn_fmed3f(v0[j], -440.f, 440.f); v1[j] = __builtin_amdgcn_fmed3f(v1[j], -440.f, 440.f); }
                            int w0 = 0, w1 = 0;
                            w0 = __builtin_amdgcn_cvt_pk_fp8_f32(v0[0], v0[1], w0, false); w0 = __builtin_amdgcn_cvt_pk_fp8_f32(v0[2], v0[3], w0, true);
                            w1 = __builtin_amdgcn_cvt_pk_fp8_f32(v1[0], v1[1], w1, false); w1 = __builtin_amdgcn_cvt_pk_fp8_f32(v1[2], v1[3], w1, true);
                            *(u32x2*)(base + (size_t)(ai * 128 + m * 16) * 1024 + bj * 128) = (u32x2){(unsigned)w0, (unsigned)w1}; } } }
        } else {
            bf16_t* base = shout + (size_t)(rt * 256 + wr * 64 + fr) * 1024 + col0;
#pragma unroll
            for (int ai = 0; ai < 2; ++ai)
#pragma unroll
                for (int m = 0; m < 4; ++m)
#pragma unroll
                    for (int bj = 0; bj < 2; ++bj) { const f32x4 v0 = acc[ai][bj][m][0], v1 = acc[ai][bj][m][1];
                        u32x4 o; o.x = cvtpk(v0[0], v0[1]); o.y = cvtpk(v0[2], v0[3]); o.z = cvtpk(v1[0], v1[1]); o.w = cvtpk(v1[2], v1[3]); *(u32x4*)(base + (size_t)(ai * 128 + m * 16) * 1024 + bj * 128) = o; }
        }
    }
};
__device__ __forceinline__ void phase_moe2(Ctx& F, int rr) {
    Moe2Sched S; S.T = build_moe_tabs(F, rr); S.ACT = (const char*)(F.ws + WS_ACT); S.W2T = (const char*)(F.ws + WS_W2T); S.G = F.G; S.c = (F.G % 8 == 0) ? (F.bid % 8) * (F.G / 8) + F.bid / 8 : F.bid; gm::stage_geom(F.tid, S.R, S.C);
    EpiMoe2 E{(bf16_t*)(F.ws + WS_SLOTS), (bf16_t*)(F.ws + WS_SHOUT), S.T.cnt};
    gm::gemm_phase<true>(F.lds, 256, S, E);
}
__device__ __forceinline__ void phase_final(Ctx& F, int rr) {
    const MoeTabs T = build_moe_tabs(F, rr);
    const float* mod = (const float*)(F.ws + WS_SMALL + SM_MOD); const float* fg = inp(F, I_FG);
    const unsigned char* slots = (const unsigned char*)(F.ws + WS_SLOTS); const int* tpos = (const int*)(F.ws + WS_TPOS) + (size_t)rr * RT * 8;
    const int gw = F.bid * 8 + F.wave, NGW = F.G * 8, c0 = F.lane * 8;
    for (int t = gw; t < RT; t += NGW) {
        const int tok = rr * RT + t, b = tok / SEQ;
        const unsigned char* rp[8];
#pragma unroll
        for (int k = 0; k < 8; ++k) { const int v = tpos[t * 8 + k]; rp[k] = slots + (size_t)(T.tb[v >> 16] * 256 + (v & 0xffff)) * 1024 + c0; }
        float* orow = F.out + (size_t)tok * DM + c0;
        u32x2 sv[8][2]; u32x4 sh[2]; f32x4 xv[2][2];
#pragma unroll
        for (int k = 0; k < 8; ++k) { sv[k][0] = *(const u32x2*)(rp[k]); sv[k][1] = *(const u32x2*)(rp[k] + 512); }
        { const bf16_t* sp = (const bf16_t*)(F.ws + WS_SHOUT) + (size_t)t * 1024 + c0; sh[0] = *(const u32x4*)sp; sh[1] = *(const u32x4*)(sp + 512); }
#pragma unroll
        for (int h = 0; h < 2; ++h) { xv[h][0] = *(const f32x4*)(orow + h * 512); xv[h][1] = *(const f32x4*)(orow + h * 512 + 4); }
        float s = 0.f; f32x4 v[2][2];
#pragma unroll
        for (int h = 0; h < 2; ++h) {
            f32x4 a0 = (f32x4){0.f, 0.f, 0.f, 0.f}, a1 = a0;
#pragma unroll
            for (int k = 0; k < 8; ++k) { const u32x2 w = sv[k][h];
                const f32x2 p0 = __builtin_amdgcn_cvt_pk_f32_fp8((int)w.x, false), p1 = __builtin_amdgcn_cvt_pk_f32_fp8((int)w.x, true), p2 = __builtin_amdgcn_cvt_pk_f32_fp8((int)w.y, false), p3 = __builtin_amdgcn_cvt_pk_f32_fp8((int)w.y, true);
                a0 += (f32x4){p0.x, p0.y, p1.x, p1.y}; a1 += (f32x4){p2.x, p2.y, p3.x, p3.y}; }
            { const u32x4 w = sh[h]; a0 = a0 * 0.0625f + (f32x4){bflo(w.x), bfhi(w.x), bflo(w.y), bfhi(w.y)}; a1 = a1 * 0.0625f + (f32x4){bflo(w.z), bfhi(w.z), bflo(w.w), bfhi(w.w)}; }
            const float* g2 = mod + b * NMOD + 5 * DM + c0 + h * 512;
            v[h][0] = xv[h][0] + *(const f32x4*)g2 * a0; v[h][1] = xv[h][1] + *(const f32x4*)(g2 + 4) * a1;
#pragma unroll
            for (int q = 0; q < 2; ++q) s += (v[h][q].x * v[h][q].x + v[h][q].y * v[h][q].y) + (v[h][q].z * v[h][q].z + v[h][q].w * v[h][q].w);
        }
        const float rstd = rsqrtf(wave_sum(s) * (1.f / DM) + EPS);
#pragma unroll
        for (int h = 0; h < 2; ++h)
#pragma unroll
            for (int q = 0; q < 2; ++q) { const f32x4 g = *(const f32x4*)(fg + c0 + h * 512 + 4 * q); *(f32x4*)(orow + h * 512 + 4 * q) = (v[h][q] * rstd) * g; }
    }
}

constexpr int N_PHASES = 10;
__global__ void __launch_bounds__(512, 2) mega_fwd(Args args) {
    extern __shared__ __attribute__((aligned(16))) unsigned char lds_raw[];
    Ctx F; F.lds = (LAS unsigned char*)lds_raw; F.ws = args.ws; F.out = args.out;
    {
        typedef __attribute__((address_space(4))) const unsigned long long* karg_t;
        const karg_t ka = (karg_t)__builtin_amdgcn_kernarg_segment_ptr();
        LAS unsigned long long* tab = (LAS unsigned long long*)(lds_raw + MISC_OFF + 14336);
        if (threadIdx.x < 20) tab[threadIdx.x] = ka[threadIdx.x];
        F.intab = tab;
    }
    F.tid = threadIdx.x; F.lane = F.tid & 63; F.wave = __builtin_amdgcn_readfirstlane(F.tid >> 6); F.G = gridDim.x; F.bid = blockIdx.x;
    volatile LAS unsigned* st = (volatile LAS unsigned*)(F.lds + MISC_OFF + MO_ST);
    if (F.tid < 4) st[F.tid] = 0u;
    __syncthreads();
    XcdBarrier bar = xcd_barrier_post((unsigned*)(F.ws + WS_CTL) + CW_BAR, st);
    if (threadIdx.x == 0) { unsigned nloc, nx; xcd_barrier_complete(bar.bar, bar.x, nloc, nx); st[0] = nloc; st[1] = nx; }
    int lo = args.ph_lo, hi = args.ph_hi;
    { int a = lo, b = hi; asm volatile("" : "+v"(a), "+v"(b)); lo = __builtin_amdgcn_readfirstlane(a); hi = __builtin_amdgcn_readfirstlane(b); }
    launder(F);
#ifndef PH_MASK
#define PH_MASK 0x1ffff
#endif
#define PH_ON(k) ((PH_MASK >> (k)) & 1)
#define IN(k) (lo <= (k) && (k) < hi)
#define SEAM(k) do { if (IN(k) && IN((k) + 1)) { bar.bar = launder_ptr(bar.bar); xcd_barrier(bar); } } while (0)
#define RUN(k, call) do { if (PH_ON(k) && IN(k)) { launder(F); call; } } while (0)
    RUN(0, phase0(F)); SEAM(0);
    RUN(1, phase1(F)); SEAM(1);
    RUN(2, phase2(F)); SEAM(2);
    RUN(4, (phase4(F), sb_units(F))); SEAM(4);
    RUN(5, phase5(F)); SEAM(5);
    RUN(6, phase6(F)); SEAM(6);
    RUN(7, phase7(F)); SEAM(7);
    RUN(8, phase8(F)); SEAM(8);
    if (PH_ON(9) && IN(9)) {
        const int par = (F.bid >> 3) & 1;
#pragma unroll 1
        for (int i = 0; i < 8; ++i) {
            launder(F);
            int op, rr; bool bar_after = true;
            switch (i) {
                case 0: op = 0; rr = 0; break;
                case 1: op = 1; rr = 0; break;
                case 2: op = par ? 0 : 2; rr = par ? 1 : 0; bar_after = false; break;
                case 3: op = par ? 2 : 0; rr = par ? 0 : 1; break;
                case 4: op = par ? 1 : 3; rr = par ? 1 : 0; bar_after = false; break;
                case 5: op = par ? 3 : 1; rr = par ? 0 : 1; break;
                case 6: op = 2; rr = 1; break;
                default: op = 3; rr = 1; bar_after = false; break;
            }
            switch (op) {
                case 0: phase_n2r(F, rr); break;
                case 1: phase_moe1(F, rr); break;
                case 2: phase_moe2(F, rr); break;
                default: phase_final(F, rr); break;
            }
            if (bar_after) { bar.bar = launder_ptr(bar.bar); xcd_barrier(bar); } else __syncthreads();
        }
    }
#undef IN
#undef SEAM
#undef RUN
}

#ifndef MK_SPLIT
#define MK_SPLIT 0
#endif
extern "C" void kernel_launch(void* const* d_in, const int* in_sizes, int n_in, void* d_out, int out_size, void* d_ws, size_t ws_size, hipStream_t stream) {
    static int grid = 0;
    if (grid == 0) {
        if (n_in != 20 || in_sizes[0] != MT * DM || out_size != MT * DM || ws_size < WS_END) { fprintf(stderr, "kernel_launch: unexpected shapes (n_in %d, in0 %d, out %d, ws %zu)\n", n_in, n_in > 0 ? in_sizes[0] : -1, out_size, ws_size); grid = -1; return; }
        int dev = 0, cus = 0;
        if (hipGetDevice(&dev) != hipSuccess || hipDeviceGetAttribute(&cus, hipDeviceAttributeMultiprocessorCount, dev) != hipSuccess) { grid = -1; return; }
        if (hipFuncSetAttribute((const void*)mega_fwd, hipFuncAttributeMaxDynamicSharedMemorySize, LDS_BYTES) != hipSuccess) { fprintf(stderr, "kernel_launch: hipFuncSetAttribute failed\n"); grid = -1; return; }
        int per_cu = 0;
        if (hipOccupancyMaxActiveBlocksPerMultiprocessor(&per_cu, (const void*)mega_fwd, 512, LDS_BYTES) != hipSuccess || per_cu < 1) fprintf(stderr, "kernel_launch: occupancy query reports %d\n", per_cu);
        (void)hipGetLastError();
        grid = cus;
    }
    if (grid < 0) return;
    (void)hipMemsetAsync((char*)d_ws + WS_CTL, 0, CTL_BYTES, stream);
    Args a{};
    for (int i = 0; i < 20; ++i) a.in[i] = (const float*)d_in[i];
    a.out = (float*)d_out; a.ws = (unsigned char*)d_ws;
#if MK_SPLIT
    for (int p = 0; p < N_PHASES; ++p) { a.ph_lo = p; a.ph_hi = p + 1; hipLaunchKernelGGL(mega_fwd, dim3(grid), dim3(512), LDS_BYTES, stream, a); }
#else
    a.ph_lo = 0; a.ph_hi = N_PHASES;
    hipLaunchKernelGGL(mega_fwd, dim3(grid), dim3(512), LDS_BYTES, stream, a);
#endif
}
```

```cpp
#include <hip/hip_runtime.h>
#include <cstdio>
#include <cstdint>

#define LAS __attribute__((address_space(3)))
#define GAS __attribute__((address_space(1)))
typedef unsigned short bf16_t;
typedef short bf16x8 __attribute__((ext_vector_type(8)));
typedef short s16x4 __attribute__((ext_vector_type(4)));
typedef float f32x4 __attribute__((ext_vector_type(4)));
typedef float f32x16 __attribute__((ext_vector_type(16)));
typedef float f32x2 __attribute__((ext_vector_type(2)));
typedef unsigned u32x4 __attribute__((ext_vector_type(4)));
typedef unsigned u32x2 __attribute__((ext_vector_type(2)));
typedef __bf16 bf16x2_t __attribute__((ext_vector_type(2)));

__device__ __forceinline__ unsigned cvtpk(float lo, float hi) { f32x2 v = {lo, hi}; bf16x2_t b = __builtin_convertvector(v, bf16x2_t); return __builtin_bit_cast(unsigned, b); }
__device__ __forceinline__ float bf2f(unsigned short u) { return __uint_as_float(((unsigned)u) << 16); }
__device__ __forceinline__ float bflo(unsigned u) { return __uint_as_float(u << 16); }
__device__ __forceinline__ float bfhi(unsigned u) { return __uint_as_float(u & 0xffff0000u); }

constexpr int NB = 4, SEQ = 8192, DM = 1024, MT = NB * SEQ;
constexpr int NHEAD = 8, HD = 64, QW = 1536;
constexpr int NE = 64, EFF = 256, NMOD = 6 * DM;
constexpr int RT = MT / 2;
constexpr float EPS = 1e-6f;
constexpr float LOG2E = 1.4426950408889634f;

constexpr size_t MiB = 1u << 20;
constexpr size_t WS_CTL = 0, CTL_BYTES = 1 * MiB;
constexpr size_t WS_SMALL = 1 * MiB;
constexpr size_t SM_MOD = 0, SM_GVEC = 98304, SM_CB = 114688, SM_KBAR = 131072, SM_WRH = 393216, SM_WRL = 524288;
constexpr size_t WS_W2T = 2 * MiB;
constexpr size_t WS_W1T = 35 * MiB;
constexpr size_t WS_WINT = 100 * MiB;
constexpr size_t WS_WBRT = 110 * MiB;
constexpr size_t WS_WOUTT = 112 * MiB;
constexpr size_t WS_H = 114 * MiB;
constexpr size_t WS_OB = 114 * MiB;
constexpr size_t WS_QSB = 178 * MiB;
constexpr size_t WS_PO = 178 * MiB;
constexpr size_t WS_QMB = 274 * MiB;
constexpr size_t WS_MERGED = 274 * MiB;
constexpr size_t WS_G = 370 * MiB;
constexpr size_t WS_LMB = 498 * MiB;
constexpr size_t WS_PLSE = 506 * MiB;
constexpr size_t WS_H2 = 100 * MiB;
constexpr size_t WS_TOKL = 164 * MiB;
constexpr size_t WS_WL = 172 * MiB;
constexpr size_t WS_TPOS = 180 * MiB;
constexpr size_t WS_ACT = 184 * MiB;
constexpr size_t WS_SLOTS = 264 * MiB;
constexpr size_t WS_SHOUT = 408 * MiB;
constexpr size_t WS_END = 509 * MiB;
constexpr int CW_MBCUR = 0;
constexpr int CW_MOECUR = 1024;
constexpr int CW_BAR = 4096;
constexpr size_t CTL_KBS = 512 * 1024;

constexpr int RING_BYTES = 131072;
constexpr int MISC_OFF = RING_BYTES;
constexpr int LDS_BYTES = 163840;
constexpr int MO_STG = 16384;

#define XB_TMO      128
#define XB_XCNT(j)  (256  + 64 * (j))
#define XB_XSUB(j)  (1280 + 64 * (j))
#define XB_XGEN(j)  (2304 + 64 * (j))
#define XB_TOP      3328
#define XB_TOPGEN   3392
#define XCD_BAR_WORDS 3456
#define XB_SPIN_CAP (1u << 18)
__device__ __forceinline__ unsigned xb_ld(unsigned* p)              { return __hip_atomic_load(p, __ATOMIC_RELAXED, __HIP_MEMORY_SCOPE_AGENT); }
__device__ __forceinline__ unsigned xb_add(unsigned* p, unsigned v) { return __hip_atomic_fetch_add(p, v, __ATOMIC_RELAXED, __HIP_MEMORY_SCOPE_AGENT); }
__device__ __forceinline__ unsigned xb_xcc_id() { return (unsigned)__builtin_amdgcn_s_getreg((3 << 11) | 20) & 0xFu; }
#define XB_SPIN(cond, bar) do { unsigned _sp = 0; while (cond) { __builtin_amdgcn_s_sleep(1); \
    if ((++_sp & 255u) == 0u) { if (xb_ld(&(bar)[XB_TMO])) break; if (_sp > XB_SPIN_CAP) { atomicAdd(&(bar)[XB_TMO], 1u); break; } } } } while (0)
struct XcdBarrier { unsigned* bar; unsigned x; volatile LAS unsigned* st; };
__device__ __forceinline__ XcdBarrier xcd_barrier_post(unsigned* bar, volatile LAS unsigned* st) {
    XcdBarrier b; b.bar = bar; b.x = xb_xcc_id(); b.st = st;
    if (threadIdx.x == 0) (void)xb_add(&bar[XB_XCNT(b.x)], 1u);
    return b;
}
__device__ __forceinline__ void xcd_barrier_complete(unsigned* bar, unsigned x, unsigned& nloc, unsigned& nx) {
    const unsigned G = gridDim.x * gridDim.y * gridDim.z;
    unsigned sum, cnt, mine, sp = 0u;
    for (;;) {
        sum = 0u; cnt = 0u; mine = 0u;
#pragma unroll
        for (unsigned j = 0; j < 16; ++j) { const unsigned c = xb_ld(&bar[XB_XCNT(j)]); sum += c; cnt += (c > 0u) ? 1u : 0u; mine = (j == x) ? c : mine; }
        if (sum == G) break;
        __builtin_amdgcn_s_sleep(1);
        if ((++sp & 255u) == 0u) { if (xb_ld(&bar[XB_TMO])) break; if (sp > XB_SPIN_CAP) { atomicAdd(&bar[XB_TMO], 1u); break; } }
    }
    nloc = mine > 0u ? mine : 1u; nx = cnt > 0u ? cnt : 1u;
}
__device__ __forceinline__ void xcd_barrier(const XcdBarrier& b) {
    asm volatile("s_waitcnt vmcnt(0)" ::: "memory");
    __syncthreads();
    if (threadIdx.x == 0) {
        unsigned* bar = b.bar;
        __builtin_amdgcn_s_waitcnt(0);
        unsigned nloc = b.st[0], nx = b.st[1];
        const unsigned old = xb_add(&bar[XB_XSUB(b.x)], 1u);
        const unsigned gen = old / nloc;
        if (old + 1u == (gen + 1u) * nloc) {
            __builtin_amdgcn_fence(__ATOMIC_RELEASE, "agent");
            asm volatile("s_waitcnt vmcnt(0)" ::: "memory");
            const unsigned og = xb_add(&bar[XB_TOP], 1u);
            const unsigned tg = og / nx;
            if (og + 1u == (tg + 1u) * nx) xb_add(&bar[XB_TOPGEN], 1u);
            else XB_SPIN(xb_ld(&bar[XB_TOPGEN]) == tg, bar);
            __builtin_amdgcn_fence(__ATOMIC_ACQUIRE, "agent");
            xb_add(&bar[XB_XGEN(b.x)], 1u);
            asm volatile("s_waitcnt vmcnt(0)" ::: "memory");
        } else {
            XB_SPIN(xb_ld(&bar[XB_XGEN(b.x)]) == gen, bar);
            __builtin_amdgcn_fence(__ATOMIC_ACQUIRE, "agent");
            asm volatile("s_waitcnt vmcnt(0)" ::: "memory");
        }
    }
    __syncthreads();
}

namespace gm {
constexpr int BM = 256, BK = 64, HALF = 128, HTB = HALF * BK * 2, STAGE_BYTES = 8 * HTB, NXCD = 8, WGM = 8;
__host__ __device__ __forceinline__ int lds_byte(int r, int c) { const int st = (r >> 4) * 2 + (c >> 5), rr = r & 15, cc = c & 31, ob = rr * 64 + cc * 2; return st * 1024 + (ob ^ (((ob >> 9) & 1) << 5)); }
__host__ __device__ __forceinline__ void stage_rc(int b, int& R, int& C) { const int st = b / 1024, sb = b % 1024, swz = sb ^ (((sb >> 9) & 1) << 5); R = (st >> 1) * 16 + swz / 64; C = (st & 1) * 32 + (swz % 64) / 2; }
__host__ __device__ __forceinline__ int perm32(int rho) { const int n = rho >> 4, i = rho & 15; return 8 * (i >> 2) + 4 * n + (i & 3); }

struct UnitD { const char* a; const char* b; unsigned va[2][2]; int e0, e1, e2, e3; };

__device__ __forceinline__ bool static_tile(int M, int N, int G, int c, int i, int& pm, int& pn) {
    const int nM = M / BM, nN = N / BM, nwg = nM * nN;
    const long L = (long)i * G + c; if (L >= nwg) return false;
    int wgid = (int)L; { const int q = nwg / NXCD, r = nwg % NXCD, xcd = wgid % NXCD, off = wgid / NXCD; wgid = (xcd < r ? xcd * (q + 1) : r * (q + 1) + (xcd - r) * q) + off; }
    const int nig = WGM * nN, gid = wgid / nig, fm = gid * WGM, gsz = (nM - fm) < WGM ? (nM - fm) : WGM;
    pm = fm + ((wgid % nig) % gsz); pn = (wgid % nig) / gsz; return true;
}

template <bool PERM, bool HOOK = false, bool FP8 = false, class Epi, class Sched>
__device__ __forceinline__ void gemm_phase(LAS unsigned char* lds, const int K, Sched& S, const Epi& E) {
    const int tid = threadIdx.x, wid = __builtin_amdgcn_readfirstlane(tid >> 6), lane = tid & 63, wr = wid >> 2, wc = wid & 3, fr = lane & 15, fq = lane >> 4;
    const int nt = K / BK;
    unsigned voffB[2];
#pragma unroll
    for (int i = 0; i < 2; ++i) { int R, C; stage_rc(tid * 16 + i * 8192, R, C); const int Rb = PERM ? ((R & ~31) + perm32(R & 31)) : R; voffB[i] = (unsigned)(Rb * K + C) * 2u; }
    const size_t kstep = (size_t)(BK * 2);
    const size_t hstep = (size_t)HALF * K * 2;
    const unsigned ldsw = (unsigned)wid * 1024u;
    const int aoff = lds_byte(wr * 64 + fr, fq * 8), boff = lds_byte(wc * 32 + fr, fq * 8);
#define GM_SA(b, h) (((b) * 2 + (h)) * HTB)
#define GM_SB(b, h) ((4 + (b) * 2 + (h)) * HTB)
#define GM_STAGE_A(bufoff, U, h, kb) do { _Pragma("unroll") for (int _i = 0; _i < 2; ++_i) \
        __builtin_amdgcn_global_load_lds((const unsigned*)((U).a + (kb) + (U).va[h][_i]), (LAS unsigned*)(lds + (bufoff) + ldsw + _i * 8192), 16, 0, 0); } while (0)
#define GM_STAGE_B(bufoff, U, h, kb) do { _Pragma("unroll") for (int _i = 0; _i < 2; ++_i) \
        __builtin_amdgcn_global_load_lds((const unsigned*)((U).b + (kb) + (size_t)(h) * hstep + voffB[_i]), (LAS unsigned*)(lds + (bufoff) + ldsw + _i * 8192), 16, 0, 0); } while (0)
#define GM_LDA(dst, b, h) do { _Pragma("unroll") for (int m = 0; m < 4; ++m) _Pragma("unroll") for (int k = 0; k < 2; ++k) { \
        if constexpr (FP8) { const i32x4_ t_ = *(const LAS i32x4_*)(lds + GM_SA(b, h) + aoff + m * 2048 + k * 1024); dst##8[m][4 * k] = t_[0]; dst##8[m][4 * k + 1] = t_[1]; dst##8[m][4 * k + 2] = t_[2]; dst##8[m][4 * k + 3] = t_[3]; } \
        else dst[m][k] = *(const LAS bf16x8*)(lds + GM_SA(b, h) + aoff + m * 2048 + k * 1024); } } while (0)
#define GM_LDB(dst, b, h) do { _Pragma("unroll") for (int n = 0; n < 2; ++n) _Pragma("unroll") for (int k = 0; k < 2; ++k) { \
        if constexpr (FP8) { const i32x4_ t_ = *(const LAS i32x4_*)(lds + GM_SB(b, h) + boff + n * 2048 + k * 1024); dst##8[n][4 * k] = t_[0]; dst##8[n][4 * k + 1] = t_[1]; dst##8[n][4 * k + 2] = t_[2]; dst##8[n][4 * k + 3] = t_[3]; } \
        else dst[n][k] = *(const LAS bf16x8*)(lds + GM_SB(b, h) + boff + n * 2048 + k * 1024); } } while (0)
#define GM_MMA(ai, bj, At, Bt) do { __builtin_amdgcn_s_setprio(1); \
        if constexpr (FP8) { _Pragma("unroll") for (int m = 0; m < 4; ++m) _Pragma("unroll") for (int n = 0; n < 2; ++n) \
            asm volatile("v_mfma_scale_f32_16x16x128_f8f6f4 %0, %1, %2, %0, %3, %3 op_sel_hi:[0,0,0]" : "+v"(acc[ai][bj][m][n]) : "v"(Bt##8[n]), "v"(At##8[m]), "v"(scl1)); } \
        else { _Pragma("unroll") for (int m = 0; m < 4; ++m) _Pragma("unroll") for (int n = 0; n < 2; ++n) _Pragma("unroll") for (int k = 0; k < 2; ++k) \
            acc[ai][bj][m][n] = __builtin_amdgcn_mfma_f32_16x16x32_bf16(Bt[n][k], At[m][k], acc[ai][bj][m][n], 0, 0, 0); } \
        __builtin_amdgcn_s_setprio(0); } while (0)
#define GM_WAIT_V(n) asm volatile("s_waitcnt vmcnt(" #n ")" ::: "memory")
#define GM_WAIT_L(n) asm volatile("s_waitcnt lgkmcnt(" #n ")" ::: "memory")
#define GM_BAR __builtin_amdgcn_s_barrier()
#define GM_SCHED __builtin_amdgcn_sched_barrier(0)
    UnitD cur, nxt; int ui = 0;
    if (!S.next(0, cur)) return;
    f32x4 acc[2][2][4][2];
#pragma unroll
    for (int a = 0; a < 2; ++a)
#pragma unroll
        for (int b = 0; b < 2; ++b)
#pragma unroll
            for (int m = 0; m < 4; ++m)
#pragma unroll
                for (int n = 0; n < 2; ++n) acc[a][b][m][n] = (f32x4){0.f, 0.f, 0.f, 0.f};
    typedef int i32x8_ __attribute__((ext_vector_type(8))); typedef int i32x4_ __attribute__((ext_vector_type(4)));
    bf16x8 At[4][2], B0[2][2], B1[2][2]; i32x8_ At8[4], B08[2], B18[2];
    int scl1 = 0x7f7f7f7f; asm volatile("" : "+v"(scl1));
    GM_STAGE_B(GM_SB(0, 0), cur, 0, 0); GM_STAGE_B(GM_SB(0, 1), cur, 1, 0); GM_STAGE_A(GM_SA(0, 0), cur, 0, 0); GM_STAGE_A(GM_SA(0, 1), cur, 1, 0);
    if (wr == 1) GM_BAR;
    GM_WAIT_V(2); GM_BAR;
    GM_STAGE_B(GM_SB(1, 0), cur, 0, kstep); GM_STAGE_A(GM_SA(1, 0), cur, 0, kstep); GM_STAGE_B(GM_SB(1, 1), cur, 1, kstep);
    GM_WAIT_V(6); GM_BAR;
    for (;;) {
        const bool has_next = S.next(ui + 1, nxt);
        if (!has_next) nxt = cur;
#pragma unroll 1
        for (int t = 0; t < nt; t += 2) {
            const bool last = (t == nt - 2);
            if constexpr (HOOK) { if (t == nt / 2) E.mid(acc, cur, wr, wc, fr, fq); }
            const size_t k1 = (size_t)(t + 1) * kstep;
            UnitD U2 = cur; size_t k2 = (size_t)(t + 2) * kstep;
            if (last) { U2 = nxt; k2 = 0; }
            const size_t k3 = k2 + kstep;
            GM_LDB(B0, 0, 0); GM_LDB(B1, 0, 1); GM_SCHED; GM_LDA(At, 0, 0); GM_STAGE_A(GM_SA(1, 1), cur, 1, k1);
            GM_WAIT_V(8); GM_WAIT_L(0); GM_BAR; GM_MMA(0, 0, At, B0); GM_MMA(0, 1, At, B1); GM_BAR; GM_SCHED;
            GM_LDA(At, 0, 1); GM_STAGE_B(GM_SB(0, 0), U2, 0, k2); GM_STAGE_B(GM_SB(0, 1), U2, 1, k2); GM_STAGE_A(GM_SA(0, 0), U2, 0, k2);
            GM_WAIT_V(8); GM_WAIT_L(0); GM_BAR; GM_MMA(1, 0, At, B0); GM_MMA(1, 1, At, B1); GM_BAR; GM_SCHED;
            GM_LDB(B0, 1, 0); GM_LDB(B1, 1, 1); GM_SCHED; GM_LDA(At, 1, 0); GM_STAGE_A(GM_SA(0, 1), U2, 1, k2);
            GM_WAIT_V(8); GM_WAIT_L(0); GM_BAR; GM_MMA(0, 0, At, B0); GM_MMA(0, 1, At, B1); GM_BAR; GM_SCHED;
            GM_LDA(At, 1, 1); GM_STAGE_B(GM_SB(1, 0), U2, 0, k3); GM_STAGE_B(GM_SB(1, 1), U2, 1, k3); GM_STAGE_A(GM_SA(1, 0), U2, 0, k3);
            GM_WAIT_V(8); GM_WAIT_L(0); GM_BAR; GM_MMA(1, 0, At, B0); GM_MMA(1, 1, At, B1); GM_BAR; GM_SCHED;
        }
        if constexpr (FP8) asm volatile("s_nop 15\n\ts_nop 15" ::: "memory");
        if (wr == 0) GM_BAR;
        E(acc, cur, wr, wc, fr, fq);
        if (!has_next) break;
#pragma unroll
        for (int a = 0; a < 2; ++a)
#pragma unroll
            for (int b = 0; b < 2; ++b)
#pragma unroll
                for (int m = 0; m < 4; ++m)
#pragma unroll
                    for (int n = 0; n < 2; ++n) acc[a][b][m][n] = (f32x4){0.f, 0.f, 0.f, 0.f};
        cur = nxt; ++ui;
        if (wr == 1) GM_BAR;
    }
    GM_WAIT_V(0);
    GM_BAR;
#undef GM_SA
#undef GM_SB
#undef GM_STAGE_A
#undef GM_STAGE_B
#undef GM_LDA
#undef GM_LDB
#undef GM_MMA
#undef GM_WAIT_V
#undef GM_WAIT_L
#undef GM_BAR
#undef GM_SCHED
}
__device__ __forceinline__ void stage_geom(int tid, int (&R)[2], int (&C)[2]) {
#pragma unroll
    for (int i = 0; i < 2; ++i) stage_rc(tid * 16 + i * 8192, R[i], C[i]);
}
}

struct Args { const float* in[20]; float* out; unsigned char* ws; int ph_lo, ph_hi; };
struct Ctx {
    LAS unsigned char* lds;
    unsigned char* ws;
    const LAS unsigned long long* intab;
    float* out;
    int tid, lane, wave, G, bid;
};
#define LDS_WAIT() asm volatile("s_waitcnt lgkmcnt(0)" ::: "memory")
__device__ __forceinline__ const float* inp(const Ctx& F, int i) {
    const unsigned long long v = F.intab[i];
    const unsigned lo = __builtin_amdgcn_readfirstlane((unsigned)v), hi = __builtin_amdgcn_readfirstlane((unsigned)(v >> 32));
    return (const float*)(GAS const float*)(((unsigned long long)hi << 32) | lo);
}
template <class P> __device__ __forceinline__ P launder_ptr(P p) {
    unsigned long long v = (unsigned long long)p; unsigned lo = (unsigned)v, hi = (unsigned)(v >> 32);
    asm volatile("" : "+v"(lo), "+v"(hi));
    lo = __builtin_amdgcn_readfirstlane(lo); hi = __builtin_amdgcn_readfirstlane(hi);
    return (P)(GAS unsigned char*)(((unsigned long long)hi << 32) | lo);
}
__device__ __forceinline__ void launder(Ctx& F) {
    int t = F.tid, g = F.G, bid = F.bid;
    asm volatile("" : "+v"(t), "+v"(g), "+v"(bid));
    F.tid = t; F.G = __builtin_amdgcn_readfirstlane(g); F.bid = __builtin_amdgcn_readfirstlane(bid); F.lane = t & 63; F.wave = __builtin_amdgcn_readfirstlane(t >> 6);
    F.ws = launder_ptr(F.ws); F.out = launder_ptr(F.out);
}
__device__ __forceinline__ float wave_sum(float v) {
#pragma unroll
    for (int o = 1; o < 64; o <<= 1) v += __shfl_xor(v, o);
    return v;
}
__device__ __forceinline__ int lds_add(LAS int* p, int v) { return __hip_atomic_fetch_add(p, v, __ATOMIC_RELAXED, __HIP_MEMORY_SCOPE_WORKGROUP); }
__device__ __forceinline__ float f8c(float x) { return __builtin_amdgcn_fmed3f(x, -440.f, 440.f); }
__device__ __forceinline__ float sigmoidf_(float x) { return 1.f / (1.f + __expf(-x)); }
__device__ __forceinline__ float siluf_(float x) { return x / (1.f + __expf(-x)); }

enum { I_X = 0, I_C, I_N1G, I_N2G, I_WADA, I_BADA, I_WIN, I_WBSB, I_WBMB, I_WOUT, I_WR, I_RB, I_WGE, I_WUE, I_WDE, I_WGS, I_WUS, I_WDS, I_RELB, I_FG };

__device__ __forceinline__ void transpose_item(const float* W, int ldn, int k0, int n0, bf16_t* WT, int Kdst, int drow0, LAS float* scr, int lane) {
    const float* wp = W + (size_t)(k0 + (lane >> 3)) * ldn + n0 + 4 * (lane & 7);
    f32x4 v[8];
#pragma unroll
    for (int i = 0; i < 8; ++i) v[i] = *(const f32x4*)(wp + (size_t)(8 * i) * ldn);
#pragma unroll
    for (int i = 0; i < 8; ++i) { LAS float* d = scr + (8 * i + (lane >> 3)) * 33 + 4 * (lane & 7); d[0] = v[i].x; d[1] = v[i].y; d[2] = v[i].z; d[3] = v[i].w; }
    LDS_WAIT(); asm volatile("" ::: "memory");
    const int c = lane & 7;
#pragma unroll
    for (int j = 0; j < 4; ++j) { const int n = (lane >> 3) + 8 * j; const LAS float* s = scr + (8 * c) * 33 + n;
        u32x4 o; o.x = cvtpk(s[0 * 33], s[1 * 33]); o.y = cvtpk(s[2 * 33], s[3 * 33]); o.z = cvtpk(s[4 * 33], s[5 * 33]); o.w = cvtpk(s[6 * 33], s[7 * 33]);
        *(u32x4*)(WT + (size_t)(drow0 + n) * Kdst + k0 + 8 * c) = o; }
    LDS_WAIT(); asm volatile("" ::: "memory");
}
__device__ __forceinline__ void phase0(Ctx& F) {
    LAS float* silc = (LAS float*)(F.lds + MISC_OFF - 0);
    silc = (LAS float*)(F.lds + 0);
    for (int i = F.tid; i < 4 * DM; i += 512) silc[i] = siluf_(inp(F, I_C)[i]);
    __syncthreads();
    float* mod = (float*)(F.ws + WS_SMALL + SM_MOD);
    {
        const int gw = F.wave * F.G + F.bid;
        const int c = F.lane & 15, kp = F.lane >> 4;
        const float* wada = inp(F, I_WADA);
        for (int item = gw; item < NMOD / 16; item += 8 * F.G) {
            const int col = item * 16 + c;
            float a0 = 0.f, a1 = 0.f, a2 = 0.f, a3 = 0.f;
#pragma unroll 32
            for (int k = kp; k < DM; k += 4) { const float w = wada[(size_t)k * NMOD + col]; a0 += silc[k] * w; a1 += silc[DM + k] * w; a2 += silc[2 * DM + k] * w; a3 += silc[3 * DM + k] * w; }
            a0 += __shfl_xor(a0, 16); a0 += __shfl_xor(a0, 32); a1 += __shfl_xor(a1, 16); a1 += __shfl_xor(a1, 32);
            a2 += __shfl_xor(a2, 16); a2 += __shfl_xor(a2, 32); a3 += __shfl_xor(a3, 16); a3 += __shfl_xor(a3, 32);
            if (kp == 0) { const float bb = inp(F, I_BADA)[col]; mod[col] = a0 + bb; mod[NMOD + col] = a1 + bb; mod[2 * NMOD + col] = a2 + bb; mod[3 * NMOD + col] = a3 + bb; }
        }
    }
    __syncthreads();
    {
        LAS float* scr = (LAS float*)(F.lds + F.wave * 16384);
        const int gw = F.bid * 8 + F.wave, NGW = F.G * 8, lane = F.lane;
        constexpr int I_IN = 16 * 160, I_BR = 8 * 32, I_OUT = 16 * 32, I_EXP = 384, NIT = I_IN + 2 * I_BR + I_OUT + 65 * I_EXP;
        const float* p_win = inp(F, I_WIN); const float* p_bsb = inp(F, I_WBSB); const float* p_bmb = inp(F, I_WBMB); const float* p_out = inp(F, I_WOUT);
        const float* p_ge = inp(F, I_WGE); const float* p_ue = inp(F, I_WUE); const float* p_de = inp(F, I_WDE); const float* p_gs = inp(F, I_WGS); const float* p_us = inp(F, I_WUS); const float* p_ds = inp(F, I_WDS);
#define TD_GET(IT, SRC, LDN, DST, KD, F8) do { int r = (IT); F8 = 0; \
            if (r < I_IN) { const int kb = r / 160, nb = r % 160; SRC = p_win + (size_t)(kb * 64) * 5120 + nb * 32; LDN = 5120; DST = (bf16_t*)(F.ws + WS_WINT) + (size_t)(nb * 32) * 1024 + kb * 64; KD = 1024; } \
            else if ((r -= I_IN) < I_BR) { const int kb = r / 32, nb = r % 32; SRC = p_bsb + (size_t)(kb * 64) * 1024 + nb * 32; LDN = 1024; DST = (bf16_t*)(F.ws + WS_WBRT) + (size_t)(nb * 32) * 1024 + kb * 64; KD = 1024; } \
            else if ((r -= I_BR) < I_BR) { const int kb = r / 32, nb = r % 32; SRC = p_bmb + (size_t)(kb * 64) * 1024 + nb * 32; LDN = 1024; DST = (bf16_t*)(F.ws + WS_WBRT) + (size_t)(nb * 32) * 1024 + 512 + kb * 64; KD = 1024; } \
            else if ((r -= I_BR) < I_OUT) { const int kb = r / 32, nb = r % 32; SRC = p_out + (size_t)(kb * 64) * 1024 + nb * 32; LDN = 1024; DST = (bf16_t*)(F.ws + WS_WOUTT) + (size_t)(nb * 32) * 1024 + kb * 64; KD = 1024; } \
            else { r -= I_OUT; const int e = r / I_EXP; r -= e * I_EXP; \
                if (r < 128) { const int kb = r / 8, n0 = (r % 8) * 32; SRC = (e < NE ? p_ge + (size_t)e * DM * EFF : p_gs) + (size_t)(kb * 64) * EFF + n0; LDN = EFF; \
                    DST = (bf16_t*)((unsigned char*)(F.ws + WS_W1T) + ((size_t)e * 512 + (n0 >> 7) * 256 + (n0 & 127)) * 1024 + kb * 64); KD = 1024; F8 = 1; } \
                else if (r < 256) { r -= 128; const int kb = r / 8, n0 = (r % 8) * 32; SRC = (e < NE ? p_ue + (size_t)e * DM * EFF : p_us) + (size_t)(kb * 64) * EFF + n0; LDN = EFF; \
                    DST = (bf16_t*)((unsigned char*)(F.ws + WS_W1T) + ((size_t)e * 512 + (n0 >> 7) * 256 + 128 + (n0 & 127)) * 1024 + kb * 64); KD = 1024; F8 = 1; } \
                else { r -= 256; const int kb = r / 32, nb = r % 32; SRC = (e < NE ? p_de + (size_t)e * EFF * DM : p_ds) + (size_t)(kb * 64) * DM + nb * 32; LDN = DM; \
                    DST = (bf16_t*)(F.ws + WS_W2T) + ((size_t)e * 1024 + nb * 32) * 256 + kb * 64; KD = 256; } } } while (0)
#define TD_LOAD(V, SRC, LDN) do { const float* wp_ = (SRC) + (size_t)(lane >> 3) * (LDN) + 4 * (lane & 7); _Pragma("unroll") for (int i = 0; i < 8; ++i) V[i] = *(const f32x4*)(wp_ + (size_t)(8 * i) * (LDN)); } while (0)
#define TD_PROC(V, DST, KD, F8) do { \
            _Pragma("unroll") for (int i = 0; i < 8; ++i) { LAS float* d = scr + (8 * i + (lane >> 3)) * 33 + 4 * (lane & 7); d[0] = V[i].x; d[1] = V[i].y; d[2] = V[i].z; d[3] = V[i].w; } \
            LDS_WAIT(); asm volatile("" ::: "memory"); \
            if (F8) { _Pragma("unroll") for (int j = 0; j < 4; ++j) { const int n = (lane >> 3) + 8 * j; const LAS float* sp = scr + (8 * (lane & 7)) * 33 + n; \
                int w0 = 0, w1 = 0; \
                w0 = __builtin_amdgcn_cvt_pk_fp8_f32(f8c(sp[0 * 33] * 256.f), f8c(sp[1 * 33] * 256.f), w0, false); w0 = __builtin_amdgcn_cvt_pk_fp8_f32(f8c(sp[2 * 33] * 256.f), f8c(sp[3 * 33] * 256.f), w0, true); \
                w1 = __builtin_amdgcn_cvt_pk_fp8_f32(f8c(sp[4 * 33] * 256.f), f8c(sp[5 * 33] * 256.f), w1, false); w1 = __builtin_amdgcn_cvt_pk_fp8_f32(f8c(sp[6 * 33] * 256.f), f8c(sp[7 * 33] * 256.f), w1, true); \
                *(u32x2*)((unsigned char*)(DST) + (size_t)n * (KD) + 8 * (lane & 7)) = (u32x2){(unsigned)w0, (unsigned)w1}; } } \
            else { _Pragma("unroll") for (int j = 0; j < 4; ++j) { const int n = (lane >> 3) + 8 * j; const LAS float* sp = scr + (8 * (lane & 7)) * 33 + n; \
                u32x4 o; o.x = cvtpk(sp[0 * 33], sp[1 * 33]); o.y = cvtpk(sp[2 * 33], sp[3 * 33]); o.z = cvtpk(sp[4 * 33], sp[5 * 33]); o.w = cvtpk(sp[6 * 33], sp[7 * 33]); \
                *(u32x4*)((DST) + (size_t)n * (KD) + 8 * (lane & 7)) = o; } } \
            LDS_WAIT(); asm volatile("" ::: "memory"); } while (0)
        const float* srcA = nullptr; const float* srcB = nullptr; bf16_t* dstA = nullptr; bf16_t* dstB = nullptr; int ldA = 0, ldB = 0, kdA = 0, kdB = 0, f8A = 0, f8B = 0;
        f32x4 vA[8], vB[8];
        int it = 2 * gw;
        if (it < NIT) { TD_GET(it, srcA, ldA, dstA, kdA, f8A); TD_GET(it + 1, srcB, ldB, dstB, kdB, f8B); TD_LOAD(vA, srcA, ldA); TD_LOAD(vB, srcB, ldB); }
        for (; it < NIT; it += 2 * NGW) {
            const float* srcAn = srcA; const float* srcBn = srcB; bf16_t* dstAn = dstA; bf16_t* dstBn = dstB; int ldAn = ldA, ldBn = ldB, kdAn = kdA, kdBn = kdB, f8An = f8A, f8Bn = f8B;
            f32x4 vAn[8], vBn[8];
            const bool has_next = it + 2 * NGW < NIT;
            if (has_next) { TD_GET(it + 2 * NGW, srcAn, ldAn, dstAn, kdAn, f8An); TD_GET(it + 2 * NGW + 1, srcBn, ldBn, dstBn, kdBn, f8Bn); TD_LOAD(vAn, srcAn, ldAn); TD_LOAD(vBn, srcBn, ldBn); }
            TD_PROC(vA, dstA, kdA, f8A);
            TD_PROC(vB, dstB, kdB, f8B);
            if (has_next) {
#pragma unroll
                for (int i = 0; i < 8; ++i) { vA[i] = vAn[i]; vB[i] = vBn[i]; }
                srcA = srcAn; srcB = srcBn; dstA = dstAn; dstB = dstBn; ldA = ldAn; ldB = ldBn; kdA = kdAn; kdB = kdBn; f8A = f8An; f8B = f8Bn; }
        }
#undef TD_PROC
#undef TD_GET
#undef TD_LOAD
    }
    {
        bf16_t* wrh = (bf16_t*)(F.ws + WS_SMALL + SM_WRH); bf16_t* wrl = (bf16_t*)(F.ws + WS_SMALL + SM_WRL);
        const float* wr = inp(F, I_WR);
        for (int i = F.bid * 512 + F.tid; i < NE * DM; i += F.G * 512) { const int e = i >> 10, k = i & 1023; const float v = wr[k * NE + e];
            const unsigned h = cvtpk(v, 0.f) & 0xffffu; wrh[i] = (bf16_t)h; wrl[i] = (bf16_t)(cvtpk(v - bflo(h), 0.f) & 0xffffu); }
    }
}

__device__ __forceinline__ void phase1(Ctx& F) {
    const float* mod = (const float*)(F.ws + WS_SMALL + SM_MOD);
    const float* x = inp(F, I_X); const float* g1 = inp(F, I_N1G);
    bf16_t* H = (bf16_t*)(F.ws + WS_H);
    const int gw = F.bid * 8 + F.wave, NGW = F.G * 8;
    if (gw < 256) {
        const int b = gw >> 6, e = gw & 63; const float* wr = inp(F, I_WR); float a = 0.f;
#pragma unroll 4
        for (int k = F.lane; k < DM; k += 64) a += mod[b * NMOD + 3 * DM + k] * wr[k * NE + e];
        a = wave_sum(a);
        if (F.lane == 0) ((float*)(F.ws + WS_SMALL + SM_CB))[gw] = a;
    }
    if (F.bid == 32) {
        float* gvec = (float*)(F.ws + WS_SMALL + SM_GVEC); const float* g2 = inp(F, I_N2G);
        for (int i = F.tid; i < 4 * DM; i += 512) { const int b = i >> 10, k = i & 1023; gvec[i] = g2[k] * (1.f + mod[b * NMOD + 4 * DM + k]); }
    }
    for (int m0 = gw; m0 < MT; m0 += 2 * NGW) {
        const int m1 = m0 + NGW;
        const bool two = m1 < MT;
        const f32x4* xr0 = (const f32x4*)(x + (size_t)m0 * DM) + F.lane; const f32x4* xr1 = (const f32x4*)(x + (size_t)(two ? m1 : m0) * DM) + F.lane;
        f32x4 v0[4], v1[4]; float s0 = 0.f, s1 = 0.f;
#pragma unroll
        for (int j = 0; j < 4; ++j) { v0[j] = xr0[64 * j]; v1[j] = xr1[64 * j]; }
#pragma unroll
        for (int j = 0; j < 4; ++j) { s0 += (v0[j].x * v0[j].x + v0[j].y * v0[j].y) + (v0[j].z * v0[j].z + v0[j].w * v0[j].w); s1 += (v1[j].x * v1[j].x + v1[j].y * v1[j].y) + (v1[j].z * v1[j].z + v1[j].w * v1[j].w); }
        const float r0 = rsqrtf(wave_sum(s0) * (1.f / DM) + EPS), r1 = rsqrtf(wave_sum(s1) * (1.f / DM) + EPS);
        const int b0 = m0 / SEQ, b1 = (two ? m1 : m0) / SEQ;
        u32x2* o0 = (u32x2*)(H + (size_t)m0 * DM) + F.lane; u32x2* o1 = (u32x2*)(H + (size_t)(two ? m1 : m0) * DM) + F.lane;
#pragma unroll
        for (int j = 0; j < 4; ++j) {
            const int col = 4 * F.lane + 256 * j;
            const f32x4 g = *(const f32x4*)(g1 + col);
            const f32x4 h0 = (v0[j] * r0) * g * (*(const f32x4*)(mod + b0 * NMOD + DM + col) + 1.0f) + *(const f32x4*)(mod + b0 * NMOD + col);
            const f32x4 h1 = (v1[j] * r1) * g * (*(const f32x4*)(mod + b1 * NMOD + DM + col) + 1.0f) + *(const f32x4*)(mod + b1 * NMOD + col);
            u32x2 w; w.x = cvtpk(h0.x, h0.y); w.y = cvtpk(h0.z, h0.w); o0[64 * j] = w;
            if (two) { w.x = cvtpk(h1.x, h1.y); w.y = cvtpk(h1.z, h1.w); o1[64 * j] = w; }
        }
    }
}

struct ProjSched {
    const char* A; const char* Bt; int G, c; int R[2], C[2];
    __device__ __forceinline__ bool next(int i, gm::UnitD& u) {
        int pm, pn; if (!gm::static_tile(MT, 5120, G, c, i, pm, pn)) return false;
        u.a = A; u.b = Bt + (size_t)pn * 256 * 1024 * 2;
#pragma unroll
        for (int h = 0; h < 2; ++h)
#pragma unroll
            for (int j = 0; j < 2; ++j) u.va[h][j] = (unsigned)((pm * 256 + h * 128 + R[j]) * 1024 + C[j]) * 2u;
        u.e0 = pm; u.e1 = pn; u.e2 = 0; u.e3 = 0; return true;
    }
};
struct EpiProj {
    bf16_t* qsb; bf16_t* qmb; bf16_t* g; float* kbs;
    __device__ __forceinline__ void operator()(const f32x4 (&acc)[2][2][4][2], const gm::UnitD& u, int wr, int wc, int fr, int fq) const {
        const int pm = u.e0, pn = u.e1;
        bf16_t* base; int ldc, colt; float sc = 1.f;
        if (pn < 6) { base = qsb; ldc = QW; colt = pn * 256; if (pn < 2) sc = 0.125f * LOG2E; }
        else if (pn < 12) { base = qmb; ldc = QW; colt = (pn - 6) * 256; if (pn < 8) sc = 0.125f; }
        else { base = g; ldc = 2048; colt = (pn - 12) * 256; }
        const int row0 = pm * 256 + wr * 64 + fr, col0 = colt + wc * 32 + 8 * fq;
        if (pn == 8 || pn == 9) {
#pragma unroll
            for (int bj = 0; bj < 2; ++bj)
#pragma unroll
                for (int n = 0; n < 2; ++n) { f32x4 cs = (f32x4){0.f, 0.f, 0.f, 0.f};
#pragma unroll
                    for (int ai = 0; ai < 2; ++ai)
#pragma unroll
                        for (int m = 0; m < 4; ++m) cs += acc[ai][bj][m][n];
#pragma unroll
                    for (int o = 1; o < 16; o <<= 1) { cs[0] += __shfl_xor(cs[0], o); cs[1] += __shfl_xor(cs[1], o); cs[2] += __shfl_xor(cs[2], o); cs[3] += __shfl_xor(cs[3], o); }
                    if (fr == 0) { float* kd = kbs + (size_t)pm * 512 + (pn - 8) * 256 + bj * 128 + wc * 32 + 8 * fq + 4 * n;
#pragma unroll
                        for (int j = 0; j < 4; ++j) atomicAdd(kd + j, cs[j]); } }
        }
#pragma unroll
        for (int ai = 0; ai < 2; ++ai)
#pragma unroll
            for (int m = 0; m < 4; ++m) { bf16_t* rowp = base + (size_t)(row0 + ai * 128 + m * 16) * ldc + col0;
#pragma unroll
                for (int bj = 0; bj < 2; ++bj) { const f32x4 v0 = acc[ai][bj][m][0] * sc, v1 = acc[ai][bj][m][1] * sc;
                    u32x4 w; w.x = cvtpk(v0[0], v0[1]); w.y = cvtpk(v0[2], v0[3]); w.z = cvtpk(v1[0], v1[1]); w.w = cvtpk(v1[2], v1[3]);
                    *(u32x4*)(rowp + bj * 128) = w; } }
    }
};
__device__ __forceinline__ void phase2(Ctx& F) {
    ProjSched S; S.A = (const char*)(F.ws + WS_H); S.Bt = (const char*)(F.ws + WS_WINT); S.G = F.G; S.c = F.bid; gm::stage_geom(F.tid, S.R, S.C);
    EpiProj E{(bf16_t*)(F.ws + WS_QSB), (bf16_t*)(F.ws + WS_QMB), (bf16_t*)(F.ws + WS_G), (float*)(F.ws + WS_CTL + CTL_KBS)};
    gm::gemm_phase<true>(F.lds, 1024, S, E);
}

__device__ __forceinline__ int crow(int r, int hi) { return (r & 3) + 8 * (r >> 2) + 4 * hi; }
typedef short v4i16_t __attribute__((ext_vector_type(4)));
__device__ __forceinline__ s16x4 vtr(const LAS unsigned char* p) { return __builtin_bit_cast(s16x4, __builtin_amdgcn_ds_read_tr16_b64_v4i16((LAS v4i16_t*)p)); }
__device__ __forceinline__ void pv64(f32x16 (&o)[2], const LAS unsigned char* vt, int lane, const u32x4 (&pw)[4]) {
    const int hi = lane >> 5;
    const LAS unsigned char* vb = vt + ((lane >> 4) & 1) * 32 + (lane & 3) * 8 + (4 * hi + ((lane & 15) >> 2)) * 64;
#pragma unroll
    for (int d0 = 0; d0 < 2; ++d0)
#pragma unroll
        for (int ks = 0; ks < 4; ++ks) {
            const s16x4 lo = vtr(vb + d0 * 4096 + ks * 1024), hh = vtr(vb + d0 * 4096 + ks * 1024 + 512);
            const bf16x8 bv = (bf16x8){lo[0], lo[1], lo[2], lo[3], hh[0], hh[1], hh[2], hh[3]};
            o[d0] = __builtin_amdgcn_mfma_f32_32x32x16_bf16(__builtin_bit_cast(bf16x8, pw[ks]), bv, o[d0], 0, 0, 0);
        }
}
__device__ __forceinline__ void store_o_tile(const f32x16 (&o)[2], LAS unsigned char* stgb, int lane, bf16_t* dst0, size_t row_pitch) {
    const int r32 = lane & 31, hi = lane >> 5;
    LAS bf16_t* stg = (LAS bf16_t*)stgb;
#pragma unroll
    for (int r = 0; r < 16; ++r) { const int orow = crow(r, hi);
#pragma unroll
        for (int d0 = 0; d0 < 2; ++d0) stg[orow * 64 + d0 * 32 + r32] = (bf16_t)(cvtpk(o[d0][r], 0.f) & 0xffffu); }
    LDS_WAIT();
#pragma unroll
    for (int i = 0; i < 4; ++i) { const int row = i * 8 + (lane >> 3), ch = lane & 7; const u32x4 v = *(const LAS u32x4*)(stg + row * 64 + ch * 8); *(u32x4*)(dst0 + (size_t)row * row_pitch + ch * 8) = v; }
    LDS_WAIT();
}

template <bool MASKED>
__device__ __forceinline__ void sb_tile(const f32x16 (&z)[2], float& P, u32x4 (&pw)[4], int k0, int qpos, int hi) {
    f32x16 be[2], nb[2];
#pragma unroll
    for (int p = 0; p < 2; ++p)
#pragma unroll
        for (int r = 0; r < 16; ++r) {
            const float zz = __builtin_amdgcn_fmed3f(z[p][r], -126.f, 126.f);
            const float t = __builtin_amdgcn_exp2f(-zz), b_ = __builtin_amdgcn_rcpf(1.f + t);
            float n_ = t * b_, bb = b_;
            if (MASKED) { const bool valid = (k0 + 32 * p + crow(r, hi)) < qpos; n_ = valid ? n_ : 1.f; bb = valid ? bb : 0.f; }
            be[p][r] = bb; nb[p][r] = n_;
        }
    float Gp[8], PG[8], off[8];
#pragma unroll
    for (int idx = 0; idx < 8; ++idx) { const int p = idx >> 2, g4 = (idx & 3) * 4; Gp[idx] = (nb[p][g4] * nb[p][g4 + 1]) * (nb[p][g4 + 2] * nb[p][g4 + 3]); }
#pragma unroll
    for (int idx = 0; idx < 8; ++idx) PG[idx] = __shfl_xor(Gp[idx], 32);
    float run = P;
#pragma unroll
    for (int idx = 7; idx >= 0; --idx) { off[idx] = hi ? run : run * PG[idx]; run *= (Gp[idx] * PG[idx]); }
    P = run;
#pragma unroll
    for (int idx = 0; idx < 8; ++idx) { const int p = idx >> 2, g4 = (idx & 3) * 4; float c = off[idx]; float a[4];
#pragma unroll
        for (int j = 3; j >= 0; --j) { a[j] = be[p][g4 + j] * c; c *= nb[p][g4 + j]; }
        pw[idx >> 1][(idx & 1) * 2] = cvtpk(a[0], a[1]); pw[idx >> 1][(idx & 1) * 2 + 1] = cvtpk(a[2], a[3]); }
}
__device__ __forceinline__ void sb_unit(Ctx& F, int bh, int qt, LAS unsigned char* vl) {
    const int lane = F.lane, r32 = lane & 31, hi = lane >> 5;
    const int b = bh >> 3, h = bh & 7, q0 = qt * 32, qpos = q0 + r32;
    const bf16_t* base = (const bf16_t*)(F.ws + WS_QSB) + (size_t)b * SEQ * QW + h * 64;
    const bf16_t* Kb = base + 512 + (size_t)r32 * QW + hi * 8; const bf16_t* Vb = base + 1024 + (size_t)(lane >> 2) * QW + (lane & 3) * 8;
    bf16x8 qr[4];
#pragma unroll
    for (int d0 = 0; d0 < 4; ++d0) qr[d0] = *(const bf16x8*)(base + (size_t)qpos * QW + d0 * 16 + hi * 8);
    float P = 1.f; f32x16 o[2]; o[0] = f32x16{}; o[1] = f32x16{};
    bf16x8 kfn[8];
    const int kt0 = q0 >> 6; int kt = kt0, cur = 0;
#define SB_PREFETCH(KT, BUF) do { const size_t ko_ = (size_t)(KT) * 64 * QW; \
        _Pragma("unroll") for (int d0 = 0; d0 < 4; ++d0) _Pragma("unroll") for (int hf = 0; hf < 2; ++hf) kfn[2 * d0 + hf] = *(const bf16x8*)(Kb + ko_ + (size_t)(32 * hf) * QW + d0 * 16); \
        _Pragma("unroll") for (int p = 0; p < 8; ++p) __builtin_amdgcn_global_load_lds((const unsigned*)(Vb + ko_ + (size_t)(16 * (p & 3)) * QW + (p >> 2) * 32), (LAS unsigned*)(vl + (BUF) * 8192 + p * 1024), 16, 0, 0); } while (0)
    SB_PREFETCH(kt, 0);
#pragma unroll 1
    for (; kt >= 0; --kt) {
        if (__all(P == 0.f)) break;
        f32x16 z[2]; z[0] = f32x16{}; z[1] = f32x16{};
#pragma unroll
        for (int d0 = 0; d0 < 4; ++d0) { z[0] = __builtin_amdgcn_mfma_f32_32x32x16_bf16(kfn[2 * d0], qr[d0], z[0], 0, 0, 0); z[1] = __builtin_amdgcn_mfma_f32_32x32x16_bf16(kfn[2 * d0 + 1], qr[d0], z[1], 0, 0, 0); }
        asm volatile("" : "+v"(z[0]), "+v"(z[1]));
        { const int ktn = kt > 0 ? kt - 1 : 0; SB_PREFETCH(ktn, cur ^ 1); }
        u32x4 pw[4];
        if (kt == kt0) sb_tile<true>(z, P, pw, kt * 64, qpos, hi); else sb_tile<false>(z, P, pw, kt * 64, qpos, hi);
        asm volatile("s_waitcnt vmcnt(16)" ::: "memory");
        pv64(o, vl + cur * 8192, lane, pw);
        cur ^= 1;
    }
#undef SB_PREFETCH
    asm volatile("s_waitcnt vmcnt(0)" ::: "memory");
    bf16_t* dst = (bf16_t*)(F.ws + WS_OB) + (size_t)(b * SEQ + q0) * 1024 + h * 64;
    store_o_tile(o, vl, lane, dst, 1024);
}
__device__ __forceinline__ void sb_units(Ctx& F) {
    const int gw = F.bid * 8 + F.wave, NGW = F.G * 8;
    LAS unsigned char* vl = F.lds + F.wave * 16384;
    for (int u = gw; u < 32 * 256; u += NGW) sb_unit(F, u >> 8, u & 255, vl);
}

constexpr int MO_LUT = 0, MO_PRE = 4224, MO_WSF = 8320, MO_ENT = 12416, MO_ST = 16368;
__device__ __forceinline__ int mb_list_off(int j) { return 256 * (31 * j - (j * (j - 1)) / 2); }
constexpr int MB_LIST_STRIDE = 126976;
__device__ __forceinline__ int t5_bucket_dev(int n) {
    if (n < 16) return n;
    int large = 16 + (int)(logf((float)n / 16.f) / 2.0794415416798357f * 16.f);
    return large < 31 ? large : 31;
}
__device__ __forceinline__ void build_lut(Ctx& F) {
    LAS float* lut = (LAS float*)(F.lds + MISC_OFF + MO_LUT);
    for (int i = F.tid; i < 8 * 132; i += 512) { const int h = i / 132, d = i % 132; lut[i] = inp(F, I_RELB)[h * 32 + t5_bucket_dev(d < 128 ? d : 128)] * LOG2E; }
}
__device__ __forceinline__ void phase4(Ctx& F) {
    LAS int* lcnt = (LAS int*)(F.lds + MISC_OFF + MO_PRE); LAS int* lbase = lcnt + 32;
    const float* kbar = (const float*)(F.ws + WS_CTL + CTL_KBS);
    unsigned* cur = (unsigned*)(F.ws + WS_CTL) + CW_MBCUR;
    unsigned short* lists = (unsigned short*)(F.ws + WS_LMB);
    const int lane = F.lane, r32 = lane & 31, hi = lane >> 5;
    for (int u = F.bid; u < 32 * 31; u += F.G) {
        const int bh = u / 31, i = 1 + (u % 31), b = bh >> 3, h = bh & 7;
        if (F.tid < 32) lcnt[F.tid] = 0;
        __syncthreads();
        const int qpos = i * 256 + F.wave * 32 + r32;
        const float* kp = kbar + (size_t)(b * 32 + r32) * 512 + h * 64 + hi * 8;
        const bf16_t* qp = (const bf16_t*)(F.ws + WS_QMB) + (size_t)(b * SEQ + qpos) * QW + h * 64 + hi * 8;
        f32x16 gt = f32x16{};
#pragma unroll
        for (int s4 = 0; s4 < 4; ++s4) {
            const f32x4 k0 = *(const f32x4*)(kp + 16 * s4), k1 = *(const f32x4*)(kp + 16 * s4 + 4);
            const bf16x8 qf = *(const bf16x8*)(qp + 16 * s4);
            const unsigned a0 = cvtpk(k0.x, k0.y), a1 = cvtpk(k0.z, k0.w), a2 = cvtpk(k1.x, k1.y), a3 = cvtpk(k1.z, k1.w);
            const u32x4 kh = (u32x4){a0, a1, a2, a3};
            const u32x4 kl = (u32x4){cvtpk(k0.x - bflo(a0), k0.y - bfhi(a0)), cvtpk(k0.z - bflo(a1), k0.w - bfhi(a1)), cvtpk(k1.x - bflo(a2), k1.y - bfhi(a2)), cvtpk(k1.z - bflo(a3), k1.w - bfhi(a3))};
            gt = __builtin_amdgcn_mfma_f32_32x32x16_bf16(__builtin_bit_cast(bf16x8, kl), qf, gt, 0, 0, 0);
            gt = __builtin_amdgcn_mfma_f32_32x32x16_bf16(__builtin_bit_cast(bf16x8, kh), qf, gt, 0, 0, 0);
        }
        float v0 = -INFINITY, v1 = -INFINITY, v2 = -INFINITY; int j0 = 64, j1 = 64, j2 = 64;
#pragma unroll
        for (int r = 0; r < 16; ++r) { const int j = crow(r, hi); const float g = j < i ? gt[r] : -INFINITY;
            if (g > v0) { v2 = v1; j2 = j1; v1 = v0; j1 = j0; v0 = g; j0 = j; }
            else if (g > v1) { v2 = v1; j2 = j1; v1 = g; j1 = j; }
            else if (g > v2) { v2 = g; j2 = j; } }
        {
            const float pv[3] = {__shfl_xor(v0, 32), __shfl_xor(v1, 32), __shfl_xor(v2, 32)}; const int pj[3] = {__shfl_xor(j0, 32), __shfl_xor(j1, 32), __shfl_xor(j2, 32)};
#pragma unroll
            for (int t = 0; t < 3; ++t) { const float g = pv[t]; const int j = pj[t];
                if (g > v0 || (g == v0 && j < j0)) { v2 = v1; j2 = j1; v1 = v0; j1 = j0; v0 = g; j0 = j; }
                else if (g > v1 || (g == v1 && j < j1)) { v2 = v1; j2 = j1; v1 = g; j1 = j; }
                else if (g > v2 || (g == v2 && j < j2)) { v2 = g; j2 = j; } }
        }
        const int nsel = i < 3 ? i : 3;
        int r0 = 0, r1 = 0, r2 = 0;
        if (hi == 0) { r0 = lds_add(&lcnt[j0], 1); if (nsel > 1) r1 = lds_add(&lcnt[j1], 1); if (nsel > 2) r2 = lds_add(&lcnt[j2], 1); }
        __syncthreads();
        if (F.tid < i) { const int n = lcnt[F.tid]; lbase[F.tid] = n > 0 ? (int)atomicAdd(&cur[bh * 32 + F.tid], (unsigned)n) : 0; }
        __syncthreads();
        if (hi == 0) {
            unsigned short* lb = lists + (size_t)bh * MB_LIST_STRIDE;
            lb[mb_list_off(j0) + lbase[j0] + r0] = (unsigned short)(qpos | (0 << 13));
            if (nsel > 1) lb[mb_list_off(j1) + lbase[j1] + r1] = (unsigned short)(qpos | (1 << 13));
            if (nsel > 2) lb[mb_list_off(j2) + lbase[j2] + r2] = (unsigned short)(qpos | (2 << 13));
        }
    }
}
__device__ __forceinline__ void kv_dma(Ctx& F, const bf16_t* kg, const bf16_t* vg, int bufoff) {
    const int l = F.lane;
#pragma unroll
    for (int i = 0; i < 4; ++i) { const int p = 4 * F.wave + i;
        __builtin_amdgcn_global_load_lds((const unsigned*)(kg + (size_t)(8 * p + (l >> 3)) * QW + ((l & 7) ^ ((l >> 3) & 7)) * 8), (LAS unsigned*)(F.lds + bufoff + p * 1024), 16, 0, 0);
        __builtin_amdgcn_global_load_lds((const unsigned*)(vg + (size_t)((p >> 3) * 64 + (p & 3) * 16 + (l >> 2)) * QW + ((p >> 2) & 1) * 32 + (l & 3) * 8), (LAS unsigned*)(F.lds + bufoff + 32768 + p * 1024), 16, 0, 0); }
}
__device__ __forceinline__ void softmax_step(f32x16 (&t)[2], float& m, float& l, f32x16 (&o)[2], LAS float* wsf, const LAS unsigned char* vt, int lane) {
    const int r32 = lane & 31, hi = lane >> 5;
    float rm = -INFINITY;
#pragma unroll
    for (int p = 0; p < 2; ++p)
#pragma unroll
        for (int r = 0; r < 16; ++r) rm = fmaxf(rm, t[p][r]);
    rm = fmaxf(rm, __shfl_xor(rm, 32));
    const float mn = fmaxf(m, rm);
    const float f = __builtin_amdgcn_exp2f(m - mn);
    m = mn;
    float s = 0.f; u32x4 pw[4];
#pragma unroll
    for (int p = 0; p < 2; ++p)
#pragma unroll
        for (int r = 0; r < 16; ++r) { const float e = __builtin_amdgcn_exp2f(t[p][r] - mn); t[p][r] = e; s += e; }
    l = l * f + s;
#pragma unroll
    for (int idx = 0; idx < 8; ++idx) { const int p = idx >> 2, g4 = (idx & 3) * 4; pw[idx >> 1][(idx & 1) * 2] = cvtpk(t[p][g4], t[p][g4 + 1]); pw[idx >> 1][(idx & 1) * 2 + 1] = cvtpk(t[p][g4 + 2], t[p][g4 + 3]); }
    if (__any(f != 1.f)) {
        if (hi == 0) wsf[r32] = f;
        LDS_WAIT();
#pragma unroll
        for (int g = 0; g < 4; ++g) { const f32x4 fv = *(const LAS f32x4*)(wsf + 8 * g + 4 * hi);
#pragma unroll
            for (int j = 0; j < 4; ++j) { o[0][4 * g + j] *= fv[j]; o[1][4 * g + j] *= fv[j]; } }
        LDS_WAIT();
    }
    pv64(o, vt, lane, pw);
}
__device__ __forceinline__ void qkt64(f32x16 (&t)[2], const LAS unsigned char* kt, const bf16x8 (&qr)[4], int lane) {
    const int r32 = lane & 31, hi = lane >> 5;
    t[0] = f32x16{}; t[1] = f32x16{};
    const LAS unsigned char* rp = kt + r32 * 128;
#pragma unroll
    for (int d0 = 0; d0 < 4; ++d0) {
        const int pos = ((2 * d0 + hi) ^ (r32 & 7)) * 16;
        const bf16x8 k0 = *(const LAS bf16x8*)(rp + pos), k1 = *(const LAS bf16x8*)(rp + 4096 + pos);
        t[0] = __builtin_amdgcn_mfma_f32_32x32x16_bf16(k0, qr[d0], t[0], 0, 0, 0); t[1] = __builtin_amdgcn_mfma_f32_32x32x16_bf16(k1, qr[d0], t[1], 0, 0, 0);
    }
}
__device__ __forceinline__ void phase5(Ctx& F) {
    LAS int* pre = (LAS int*)(F.lds + MISC_OFF + MO_PRE);
    LAS int* wtot = (LAS int*)(F.lds + MISC_OFF + MO_ENT);
    const unsigned* cur = (const unsigned*)(F.ws + WS_CTL) + CW_MBCUR;
    build_lut(F);
    int total;
    {
        const int p0 = 2 * F.tid, p1 = p0 + 1;
        const int c0 = p0 < 992 ? (int)((cur[(p0 / 31) * 32 + (p0 % 31)] + 255u) >> 8) : 0;
        const int c1 = p1 < 992 ? (int)((cur[(p1 / 31) * 32 + (p1 % 31)] + 255u) >> 8) : 0;
        const int s = c0 + c1; int v = s;
#pragma unroll
        for (int o = 1; o < 64; o <<= 1) { const int n = __shfl_up(v, o); if (F.lane >= o) v += n; }
        if (F.lane == 63) wtot[248 + F.wave] = v;
        __syncthreads();
        int woff = 0; total = 0;
#pragma unroll
        for (int w = 0; w < 8; ++w) { const int x = wtot[248 + w]; if (w < F.wave) woff += x; total += x; }
        const int excl = woff + v - s;
        pre[p0] = excl; pre[p1] = excl + c0;
        __syncthreads();
    }
    const unsigned short* lists = (const unsigned short*)(F.ws + WS_LMB);
    LAS float* wsf = (LAS float*)(F.lds + MISC_OFF + MO_WSF) + F.wave * 128;
    LAS int* ent = (LAS int*)(F.lds + MISC_OFF + MO_ENT) + F.wave * 32;
    const int lane = F.lane, r32 = lane & 31, hi = lane >> 5;
#define P5_UNIT(U, BH, J, C) do { int lo_ = 0, hi_ = 992; while (hi_ - lo_ > 1) { const int mid = (lo_ + hi_) >> 1; if (pre[mid] <= (U)) lo_ = mid; else hi_ = mid; } BH = lo_ / 31; J = lo_ % 31; C = (U) - pre[lo_]; } while (0)
#define P5_DMA(BH, J, BUF) do { const bf16_t* b_ = (const bf16_t*)(F.ws + WS_QMB) + (size_t)((BH) >> 3) * SEQ * QW + ((BH) & 7) * 64; kv_dma(F, b_ + 512 + (size_t)((J) * 256) * QW, b_ + 1024 + (size_t)((J) * 256) * QW, (BUF) * 65536); } while (0)
#define P5_ENTRY(BH, J, C, ACT, VALID, ENTRY) do { const int n_ = (int)cur[(BH) * 32 + (J)]; const int e0_ = (C) * 256 + F.wave * 32; ACT = e0_ < n_; VALID = ACT && (e0_ + r32) < n_; \
        const unsigned short* lb_ = lists + (size_t)(BH) * MB_LIST_STRIDE + mb_list_off(J); ENTRY = ACT ? (int)lb_[VALID ? e0_ + r32 : e0_] : 0; } while (0)
#define P5_QLOAD(BH, ENTRY, Q) do { const bf16_t* b_ = (const bf16_t*)(F.ws + WS_QMB) + (size_t)((BH) >> 3) * SEQ * QW + ((BH) & 7) * 64 + (size_t)((ENTRY) & 8191) * QW + hi * 8; \
        _Pragma("unroll") for (int d0 = 0; d0 < 4; ++d0) Q[d0] = *(const bf16x8*)(b_ + d0 * 16); } while (0)
    int u = F.bid, bh = 0, j = 0, c = 0, buf = 0;
    bool act = false, valid = false; int entry = 0; bf16x8 qr[4];
    if (u < total) { P5_UNIT(u, bh, j, c); P5_DMA(bh, j, 0); P5_ENTRY(bh, j, c, act, valid, entry); P5_QLOAD(bh, entry, qr); }
    for (; u < total; u += F.G) {
        const int un = u + F.G; int bhn = 0, jn = 0, cn = 0;
        const bool has_next = un < total;
        if (has_next) P5_UNIT(un, bhn, jn, cn);
        const int h = bh & 7;
        const int qpos = entry & 8191, slot = entry >> 13;
        asm volatile("s_waitcnt vmcnt(0)" ::: "memory");
        __syncthreads();
        bool actn = false, validn = false; int entryn = 0; bf16x8 qn[4];
        if (has_next) { P5_DMA(bhn, jn, buf ^ 1); P5_ENTRY(bhn, jn, cn, actn, validn, entryn); }
        const LAS unsigned char* kimg = F.lds + buf * 65536; const LAS unsigned char* vimg = kimg + 32768;
        if (act) {
            if (hi == 0) ent[r32] = valid ? entry : -1;
            float m = -INFINITY, l = 0.f; f32x16 o[2]; o[0] = f32x16{}; o[1] = f32x16{};
            const LAS float* lut = (const LAS float*)(F.lds + MISC_OFF + MO_LUT) + h * 132;
            const float bfar = lut[128];
#pragma unroll 1
            for (int st = 0; st < 4; ++st) {
                if (st == 2 && has_next) P5_QLOAD(bhn, entryn, qn);
                f32x16 t[2]; qkt64(t, kimg + st * 8192, qr, lane);
                const int kbase = j * 256 + st * 64;
                const bool far = __all(qpos - (kbase + 63) >= 128);
                if (far) {
#pragma unroll
                    for (int pp = 0; pp < 2; ++pp)
#pragma unroll
                        for (int r = 0; r < 16; ++r) t[pp][r] = t[pp][r] * LOG2E + bfar;
                } else {
#pragma unroll
                    for (int pp = 0; pp < 2; ++pp)
#pragma unroll
                        for (int r = 0; r < 16; ++r) { int d = qpos - (kbase + 32 * pp + crow(r, hi)); d = d < 128 ? d : 128; d = d > 0 ? d : 0; t[pp][r] = t[pp][r] * LOG2E + lut[d]; }
                }
                softmax_step(t, m, l, o, wsf, vimg + st * 8192, lane);
            }
            l += __shfl_xor(l, 32);
            const float rl = 1.f / l;
            if (hi == 0) { wsf[r32] = rl; if (valid) ((float*)(F.ws + WS_PLSE))[((size_t)bh * SEQ + qpos) * 3 + slot] = m + __log2f(l); }
            LDS_WAIT();
            {
                LAS bf16_t* stg = (LAS bf16_t*)(F.lds + MISC_OFF + MO_STG + F.wave * 2048);
                bf16_t* po = (bf16_t*)(F.ws + WS_PO);
#pragma unroll
                for (int d0 = 0; d0 < 2; ++d0) {
#pragma unroll
                    for (int r = 0; r < 16; ++r) { const int q = crow(r, hi); stg[q * 32 + r32] = (bf16_t)(cvtpk(o[d0][r] * wsf[q], 0.f) & 0xffffu); }
                    LDS_WAIT();
#pragma unroll
                    for (int it2 = 0; it2 < 2; ++it2) { const int row = it2 * 16 + (lane >> 2), ch = lane & 3; const int en = ent[row];
                        const u32x4 v = *(const LAS u32x4*)(stg + row * 32 + ch * 8);
                        if (en >= 0) *(u32x4*)(po + (((size_t)bh * SEQ + (en & 8191)) * 3 + (en >> 13)) * 64 + d0 * 32 + ch * 8) = v; }
                    LDS_WAIT();
                }
            }
        } else if (has_next) { P5_QLOAD(bhn, entryn, qn); }
        bh = bhn; j = jn; c = cn; buf ^= 1; act = actn; valid = validn; entry = entryn;
#pragma unroll
        for (int d0 = 0; d0 < 4; ++d0) qr[d0] = qn[d0];
    }
#undef P5_ENTRY
#undef P5_QLOAD
#undef P5_UNIT
#undef P5_DMA
    asm volatile("s_waitcnt vmcnt(0)" ::: "memory");
    __syncthreads();
}
__device__ __forceinline__ void phase6(Ctx& F) {
    build_lut(F);
    LAS float* wsf = (LAS float*)(F.lds + MISC_OFF + MO_WSF) + F.wave * 128;
    const int lane = F.lane, r32 = lane & 31, hi = lane >> 5, w = F.wave;
#define P6_DMA(U, BUF) do { const int bh_ = (U) >> 5, i_ = 31 - ((U) & 31); const bf16_t* b_ = (const bf16_t*)(F.ws + WS_QMB) + (size_t)(bh_ >> 3) * SEQ * QW + (bh_ & 7) * 64; \
        kv_dma(F, b_ + 512 + (size_t)(i_ * 256) * QW, b_ + 1024 + (size_t)(i_ * 256) * QW, (BUF) * 65536); } while (0)
    int buf = 0;
    if (F.bid < 32 * 32) P6_DMA(F.bid, 0);
    for (int u = F.bid; u < 32 * 32; u += F.G) {
        const int bh = u >> 5, i = 31 - (u & 31), b = bh >> 3, h = bh & 7;
        const bf16_t* base = (const bf16_t*)(F.ws + WS_QMB) + (size_t)b * SEQ * QW + h * 64;
        const int ql = w * 32 + r32, qpos = i * 256 + ql;
        bf16x8 qr[4];
#pragma unroll
        for (int d0 = 0; d0 < 4; ++d0) qr[d0] = *(const bf16x8*)(base + (size_t)qpos * QW + d0 * 16 + hi * 8);
        const int nsel = i < 3 ? i : 3;
        const float* plse = (const float*)(F.ws + WS_PLSE) + ((size_t)bh * SEQ + qpos) * 3;
        float ls0 = -INFINITY, ls1 = -INFINITY, ls2 = -INFINITY;
        if (nsel > 0) ls0 = plse[0]; if (nsel > 1) ls1 = plse[1]; if (nsel > 2) ls2 = plse[2];
        asm volatile("s_waitcnt vmcnt(0)" ::: "memory");
        __syncthreads();
        if (u + F.G < 32 * 32) P6_DMA(u + F.G, buf ^ 1);
        const LAS unsigned char* kimg = F.lds + buf * 65536; const LAS unsigned char* vimg = kimg + 32768;
        float m = -INFINITY, l = 0.f; f32x16 o[2]; o[0] = f32x16{}; o[1] = f32x16{};
        const LAS float* lut = (const LAS float*)(F.lds + MISC_OFF + MO_LUT) + h * 132;
        const int nst = (w >> 1) + 1;
#pragma unroll 1
        for (int st = 0; st < nst; ++st) {
            f32x16 t[2]; qkt64(t, kimg + st * 8192, qr, lane);
#pragma unroll
            for (int pp = 0; pp < 2; ++pp)
#pragma unroll
                for (int r = 0; r < 16; ++r) { const int d = ql - (st * 64 + 32 * pp + crow(r, hi)); const int dc = d < 128 ? (d > 0 ? d : 0) : 128; const float v = t[pp][r] * LOG2E + lut[dc]; t[pp][r] = d >= 0 ? v : -INFINITY; }
            softmax_step(t, m, l, o, wsf, vimg + st * 8192, lane);
        }
        l += __shfl_xor(l, 32);
        const float M = fmaxf(fmaxf(m, ls0), fmaxf(ls1, ls2));
        const float eo = __builtin_amdgcn_exp2f(m - M), e0 = __builtin_amdgcn_exp2f(ls0 - M), e1 = __builtin_amdgcn_exp2f(ls1 - M), e2 = __builtin_amdgcn_exp2f(ls2 - M);
        const float rden = 1.f / (l * eo + e0 + e1 + e2);
        if (hi == 0) *(LAS f32x4*)(wsf + 4 * r32) = (f32x4){eo * rden, e0 * rden, e1 * rden, e2 * rden};
        LDS_WAIT();
#pragma unroll
        for (int r = 0; r < 16; ++r) { const float fo = wsf[4 * crow(r, hi)]; o[0][r] *= fo; o[1][r] *= fo; }
        __syncthreads();
        {
            LAS bf16_t* stg = (LAS bf16_t*)(F.lds + buf * 65536 + w * 4096);
#pragma unroll
            for (int r = 0; r < 16; ++r) { const int orow = crow(r, hi);
#pragma unroll
                for (int d0 = 0; d0 < 2; ++d0) stg[orow * 64 + d0 * 32 + r32] = (bf16_t)(cvtpk(o[d0][r], 0.f) & 0xffffu); }
            LDS_WAIT();
            const bf16_t* po = (const bf16_t*)(F.ws + WS_PO) + ((size_t)bh * SEQ + i * 256 + w * 32) * 3 * 64;
            bf16_t* dst = (bf16_t*)(F.ws + WS_OB) + (size_t)(b * SEQ + i * 256 + w * 32) * 1024 + 512 + h * 64;
#pragma unroll
            for (int it4 = 0; it4 < 4; ++it4) { const int row = it4 * 8 + (lane >> 3), ch = lane & 7;
                const u32x4 ov = *(const LAS u32x4*)(stg + row * 64 + ch * 8);
                float a[8] = {bflo(ov.x), bfhi(ov.x), bflo(ov.y), bfhi(ov.y), bflo(ov.z), bfhi(ov.z), bflo(ov.w), bfhi(ov.w)};
                const f32x4 fc = *(const LAS f32x4*)(wsf + 4 * row);
#pragma unroll
                for (int sl = 0; sl < 3; ++sl) if (sl < nsel) { const u32x4 pv = *(const u32x4*)(po + (size_t)(row * 3 + sl) * 64 + ch * 8); const float f = fc[1 + sl];
                    a[0] += f * bflo(pv.x); a[1] += f * bfhi(pv.x); a[2] += f * bflo(pv.y); a[3] += f * bfhi(pv.y); a[4] += f * bflo(pv.z); a[5] += f * bfhi(pv.z); a[6] += f * bflo(pv.w); a[7] += f * bfhi(pv.w); }
                u32x4 w4; w4.x = cvtpk(a[0], a[1]); w4.y = cvtpk(a[2], a[3]); w4.z = cvtpk(a[4], a[5]); w4.w = cvtpk(a[6], a[7]);
                *(u32x4*)(dst + (size_t)row * 1024 + ch * 8) = w4; }
            LDS_WAIT();
        }
        buf ^= 1;
    }
#undef P6_DMA
    asm volatile("s_waitcnt vmcnt(0)" ::: "memory");
    __syncthreads();
}

struct BranchSched {
    const char* A; const char* Bt; int G, c; int R[2], C[2];
    __device__ __forceinline__ bool next(int i, gm::UnitD& u) {
        int pm, pn; if (!gm::static_tile(MT, 1024, G, c, i, pm, pn)) return false;
        u.a = A; u.b = Bt + (size_t)(pn * 256) * 1024 * 2;
#pragma unroll
        for (int h = 0; h < 2; ++h)
#pragma unroll
            for (int j = 0; j < 2; ++j) u.va[h][j] = (unsigned)((pm * 256 + h * 128 + R[j]) * 1024 + C[j]) * 2u;
        u.e0 = pm; u.e1 = pn; u.e2 = 0; u.e3 = 0; return true;
    }
};
struct EpiBranch {
    const bf16_t* g; bf16_t* merged;
    static __device__ __forceinline__ float ratio(float gs, float gm_) { return (1.f + fminf(__expf(-gm_), 1e30f)) * __builtin_amdgcn_rcpf(1.f + __expf(-gs)); }
    __device__ __forceinline__ void mid(f32x4 (&acc)[2][2][4][2], const gm::UnitD& u, int wr, int wc, int fr, int fq) const {
        const bf16_t* gp = g + (size_t)(u.e0 * 256 + wr * 64 + fr) * 2048 + u.e1 * 256 + wc * 32 + 8 * fq;
#pragma unroll
        for (int ai = 0; ai < 2; ++ai)
#pragma unroll
            for (int m = 0; m < 4; m += 2) {
                asm volatile("" : "+v"(gp) :: "memory");
                u32x4 gs[2][2], gq[2][2];
#pragma unroll
                for (int mm = 0; mm < 2; ++mm)
#pragma unroll
                    for (int bj = 0; bj < 2; ++bj) { gs[mm][bj] = *(const u32x4*)(gp + (size_t)mm * 16 * 2048 + bj * 128); gq[mm][bj] = *(const u32x4*)(gp + (size_t)mm * 16 * 2048 + 1024 + bj * 128); }
#pragma unroll
                for (int mm = 0; mm < 2; ++mm)
#pragma unroll
                    for (int bj = 0; bj < 2; ++bj) { const u32x4 a = gs[mm][bj], b = gq[mm][bj];
                        f32x4& c0 = acc[ai][bj][m + mm][0]; f32x4& c1 = acc[ai][bj][m + mm][1];
                        c0[0] *= ratio(bflo(a.x), bflo(b.x)); c0[1] *= ratio(bfhi(a.x), bfhi(b.x)); c0[2] *= ratio(bflo(a.y), bflo(b.y)); c0[3] *= ratio(bfhi(a.y), bfhi(b.y));
                        c1[0] *= ratio(bflo(a.z), bflo(b.z)); c1[1] *= ratio(bfhi(a.z), bfhi(b.z)); c1[2] *= ratio(bflo(a.w), bflo(b.w)); c1[3] *= ratio(bfhi(a.w), bfhi(b.w));
                        asm volatile("" : "+v"(c0), "+v"(c1) :: "memory"); }
                gp += (m == 2 ? 96 : 32) * 2048; }
    }
    __device__ __forceinline__ void operator()(const f32x4 (&acc)[2][2][4][2], const gm::UnitD& u, int wr, int wc, int fr, int fq) const {
        const int row0 = u.e0 * 256 + wr * 64 + fr, col0 = u.e1 * 256 + wc * 32 + 8 * fq;
#pragma unroll
        for (int ai = 0; ai < 2; ++ai)
#pragma unroll
            for (int m = 0; m < 4; ++m) { const size_t row = (size_t)(row0 + ai * 128 + m * 16);
#pragma unroll
                for (int bj = 0; bj < 2; ++bj) { const u32x4 gm_ = *(const u32x4*)(g + row * 2048 + 1024 + col0 + bj * 128);
                    const float b[8] = {bflo(gm_.x), bfhi(gm_.x), bflo(gm_.y), bfhi(gm_.y), bflo(gm_.z), bfhi(gm_.z), bflo(gm_.w), bfhi(gm_.w)};
                    float r[8];
#pragma unroll
                    for (int j = 0; j < 8; ++j) r[j] = acc[ai][bj][m][j >> 2][j & 3] * __builtin_amdgcn_rcpf(1.f + fminf(__expf(-b[j]), 1e30f));
                    u32x4 w; w.x = cvtpk(r[0], r[1]); w.y = cvtpk(r[2], r[3]); w.z = cvtpk(r[4], r[5]); w.w = cvtpk(r[6], r[7]);
                    *(u32x4*)(merged + row * 1024 + col0 + bj * 128) = w; } }
    }
};
__device__ __forceinline__ void phase7(Ctx& F) {
    BranchSched S; S.A = (const char*)(F.ws + WS_OB); S.Bt = (const char*)(F.ws + WS_WBRT); S.G = F.G; S.c = F.bid; gm::stage_geom(F.tid, S.R, S.C);
    EpiBranch E{(const bf16_t*)(F.ws + WS_G), (bf16_t*)(F.ws + WS_MERGED)};
    gm::gemm_phase<true, true>(F.lds, 1024, S, E);
}
struct OutSched {
    const char* A; const char* Bt; int G, c; int R[2], C[2];
    __device__ __forceinline__ bool next(int i, gm::UnitD& u) {
        int pm, pn; if (!gm::static_tile(MT, 1024, G, c, i, pm, pn)) return false;
        u.a = A; u.b = Bt + (size_t)pn * 256 * 1024 * 2;
#pragma unroll
        for (int h = 0; h < 2; ++h)
#pragma unroll
            for (int j = 0; j < 2; ++j) u.va[h][j] = (unsigned)((pm * 256 + h * 128 + R[j]) * 1024 + C[j]) * 2u;
        u.e0 = pm; u.e1 = pn; u.e2 = 0; u.e3 = 0; return true;
    }
};
struct EpiOut {
    const float* x; const float* mod; float* out;
    __device__ __forceinline__ void operator()(const f32x4 (&acc)[2][2][4][2], const gm::UnitD& u, int wr, int wc, int fr, int fq) const {
        const int pm = u.e0, pn = u.e1, b = (pm * 256) / SEQ;
        const int row0 = pm * 256 + wr * 64 + fr, col0 = pn * 256 + wc * 32 + 4 * fq;
        f32x4 gt[2][2];
#pragma unroll
        for (int bj = 0; bj < 2; ++bj)
#pragma unroll
            for (int n = 0; n < 2; ++n) gt[bj][n] = *(const f32x4*)(mod + b * NMOD + 2 * DM + col0 + bj * 128 + n * 16);
#pragma unroll
        for (int ai = 0; ai < 2; ++ai)
#pragma unroll
            for (int m = 0; m < 4; ++m) { const size_t off = (size_t)(row0 + ai * 128 + m * 16) * DM + col0;
#pragma unroll
                for (int bj = 0; bj < 2; ++bj)
#pragma unroll
                    for (int n = 0; n < 2; ++n) { const f32x4 xv = *(const f32x4*)(x + off + bj * 128 + n * 16); *(f32x4*)(out + off + bj * 128 + n * 16) = xv + gt[bj][n] * acc[ai][bj][m][n]; } }
    }
};
__device__ __forceinline__ void phase8(Ctx& F) {
    OutSched S; S.A = (const char*)(F.ws + WS_MERGED); S.Bt = (const char*)(F.ws + WS_WOUTT); S.G = F.G; S.c = F.bid; gm::stage_geom(F.tid, S.R, S.C);
    EpiOut E{inp(F, I_X), (const float*)(F.ws + WS_SMALL + SM_MOD), F.out};
    gm::gemm_phase<false>(F.lds, 1024, S, E);
}

constexpr int NR_SSQ = MO_PRE + 1024;
constexpr int NR_RS = MO_PRE + 3072;
__device__ __forceinline__ void phase_n2r(Ctx& F, int rr) {
    const float* x1 = F.out; const float* gvec = (const float*)(F.ws + WS_SMALL + SM_GVEC); const float* cb = (const float*)(F.ws + WS_SMALL + SM_CB);
    const float* mod = (const float*)(F.ws + WS_SMALL + SM_MOD); const float* rbias = inp(F, I_RB);
    unsigned char* H2 = (unsigned char*)(F.ws + WS_H2) + (size_t)rr * RT * DM; int* tokl = (int*)(F.ws + WS_TOKL) + (size_t)rr * 64 * RT; float* wl = (float*)(F.ws + WS_WL) + (size_t)rr * 64 * RT; int* tpos = (int*)(F.ws + WS_TPOS) + (size_t)rr * RT * 8;
    unsigned* cur = (unsigned*)(F.ws + WS_CTL) + CW_MOECUR + rr * 64;
    LAS int* lcnt = (LAS int*)(F.lds + MISC_OFF + MO_PRE); LAS int* lbase = lcnt + 64;
    LAS float* part = (LAS float*)(F.lds);
    LAS float* ssqp = (LAS float*)(F.lds + MISC_OFF + NR_SSQ); LAS float* rsl = (LAS float*)(F.lds + MISC_OFF + NR_RS);
    const int lane = F.lane, w = F.wave, i16 = lane & 15, kk = lane >> 4;
    for (int u = F.bid; u < RT / 64; u += F.G) {
        if (F.tid < 64) lcnt[F.tid] = 0;
        const int tokb = rr * RT + u * 64, b = tokb / SEQ;
        {
            bf16x8 fah[4][4], fal[4][4];
            {
                const float* gp = gvec + b * DM + 128 * w + 8 * kk;
                f32x4 gv[4][2];
#pragma unroll
                for (int s4 = 0; s4 < 4; ++s4) { gv[s4][0] = *(const f32x4*)(gp + 32 * s4); gv[s4][1] = *(const f32x4*)(gp + 32 * s4 + 4); }
#pragma unroll
                for (int tt = 0; tt < 4; ++tt) {
                    const float* xp = x1 + (size_t)(tokb + tt * 16 + i16) * DM + 128 * w + 8 * kk;
                    f32x4 xa[4][2];
#pragma unroll
                    for (int s4 = 0; s4 < 4; ++s4) { xa[s4][0] = *(const f32x4*)(xp + 32 * s4); xa[s4][1] = *(const f32x4*)(xp + 32 * s4 + 4); }
                    float ssq = 0.f;
#pragma unroll
                    for (int s4 = 0; s4 < 4; ++s4) {
                        u32x4 ah, al;
#pragma unroll
                        for (int q = 0; q < 2; ++q) { const f32x4 xv = xa[s4][q]; ssq += (xv.x * xv.x + xv.y * xv.y) + (xv.z * xv.z + xv.w * xv.w);
                            const f32x4 a = xv * gv[s4][q];
                            const unsigned h0 = cvtpk(a.x, a.y), h1 = cvtpk(a.z, a.w);
                            ah[2 * q] = h0; ah[2 * q + 1] = h1; al[2 * q] = cvtpk(a.x - bflo(h0), a.y - bfhi(h0)); al[2 * q + 1] = cvtpk(a.z - bflo(h1), a.w - bfhi(h1)); }
                        fah[tt][s4] = __builtin_bit_cast(bf16x8, ah); fal[tt][s4] = __builtin_bit_cast(bf16x8, al);
                    }
                    ssq += __shfl_xor(ssq, 16); ssq += __shfl_xor(ssq, 32); if (kk == 0) ssqp[w * 64 + tt * 16 + i16] = ssq;
                }
            }
#pragma unroll 1
            for (int eh = 0; eh < 2; ++eh) {
                bf16x8 wh[2][4], wl_[2][4];
                {
                    const bf16_t* ph = (const bf16_t*)(F.ws + WS_SMALL + SM_WRH) + (size_t)(eh * 32 + i16) * DM + 128 * w + 8 * kk;
                    const bf16_t* pl = (const bf16_t*)(F.ws + WS_SMALL + SM_WRL) + (size_t)(eh * 32 + i16) * DM + 128 * w + 8 * kk;
#pragma unroll
                    for (int c = 0; c < 2; ++c)
#pragma unroll
                        for (int s4 = 0; s4 < 4; ++s4) { wh[c][s4] = *(const bf16x8*)(ph + (size_t)c * 16 * DM + 32 * s4); wl_[c][s4] = *(const bf16x8*)(pl + (size_t)c * 16 * DM + 32 * s4); }
                }
#pragma unroll
                for (int tt = 0; tt < 4; ++tt) {
                    f32x4 acc[2]; acc[0] = acc[1] = (f32x4){0.f, 0.f, 0.f, 0.f};
#pragma unroll
                    for (int s4 = 0; s4 < 4; ++s4)
#pragma unroll
                        for (int c = 0; c < 2; ++c) {
                            acc[c] = __builtin_amdgcn_mfma_f32_16x16x32_bf16(fal[tt][s4], wh[c][s4], acc[c], 0, 0, 0);
                            acc[c] = __builtin_amdgcn_mfma_f32_16x16x32_bf16(fah[tt][s4], wl_[c][s4], acc[c], 0, 0, 0);
                            acc[c] = __builtin_amdgcn_mfma_f32_16x16x32_bf16(fah[tt][s4], wh[c][s4], acc[c], 0, 0, 0); }
#pragma unroll
                    for (int c = 0; c < 2; ++c)
#pragma unroll
                        for (int reg = 0; reg < 4; ++reg) part[(w * 64 + tt * 16 + 4 * kk + reg) * 64 + eh * 32 + 16 * c + i16] = acc[c][reg];
                }
            }
        }
        __syncthreads();
        const int tl = F.tid >> 3, g = F.tid & 7;
        int my_e; float my_w; int my_rank;
        {
            float ssq = 0.f;
#pragma unroll
            for (int q = 0; q < 8; ++q) ssq += ssqp[q * 64 + tl];
            const float rstd = rsqrtf(ssq * (1.f / DM) + EPS);
            if (g == 0) rsl[tl] = rstd;
            float s8[8], c8[8];
            {
                f32x4 lo4 = (f32x4){0.f, 0.f, 0.f, 0.f}, hi4 = lo4;
#pragma unroll
                for (int q = 0; q < 8; ++q) { const LAS f32x4* pp = (const LAS f32x4*)(part + (q * 64 + tl) * 64 + 8 * g); lo4 += pp[0]; hi4 += pp[1]; }
                const f32x4 cb0 = *(const f32x4*)(cb + b * 64 + 8 * g), cb1 = *(const f32x4*)(cb + b * 64 + 8 * g + 4), rb0 = *(const f32x4*)(rbias + 8 * g), rb1 = *(const f32x4*)(rbias + 8 * g + 4);
#pragma unroll
                for (int j = 0; j < 4; ++j) { s8[j] = sigmoidf_(lo4[j] * rstd + cb0[j]); s8[4 + j] = sigmoidf_(hi4[j] * rstd + cb1[j]); c8[j] = s8[j] + rb0[j]; c8[4 + j] = s8[4 + j] + rb1[j]; }
            }
            float m1 = -INFINITY, m2 = -INFINITY;
#pragma unroll
            for (int j = 0; j < 8; ++j) { const float v = c8[j]; if (v > m1) { m2 = m1; m1 = v; } else if (v > m2) m2 = v; }
            const float gs = m1 + m2;
            int rank = 0;
#pragma unroll
            for (int g2 = 0; g2 < 8; ++g2) { const float o = __shfl(gs, g2, 8); rank += (o > gs || (o == gs && g2 < g)) ? 1 : 0; }
            if (rank >= 4) {
#pragma unroll
                for (int j = 0; j < 8; ++j) c8[j] = -INFINITY;
            }
            int sel_e[8]; float sk[8]; float wsum = 0.f;
#pragma unroll
            for (int k = 0; k < 8; ++k) {
                float bv = -INFINITY, bs = 0.f; int be = 8 * g;
#pragma unroll
                for (int j = 0; j < 8; ++j) if (c8[j] > bv) { bv = c8[j]; be = 8 * g + j; bs = s8[j]; }
#pragma unroll
                for (int o = 1; o < 8; o <<= 1) { const float ov = __shfl_xor(bv, o, 8), os = __shfl_xor(bs, o, 8); const int oe = __shfl_xor(be, o, 8); if (ov > bv || (ov == bv && oe < be)) { bv = ov; be = oe; bs = os; } }
                sel_e[k] = be; sk[k] = bs; wsum += bs;
#pragma unroll
                for (int j = 0; j < 8; ++j) if (be == 8 * g + j) c8[j] = -INFINITY;
            }
            my_e = sel_e[0]; my_w = sk[0];
#pragma unroll
            for (int k = 1; k < 8; ++k) if (g == k) { my_e = sel_e[k]; my_w = sk[k]; }
            my_w *= 2.5f / wsum;
            my_rank = lds_add(&lcnt[my_e], 1);
        }
        __syncthreads();
        if (F.tid < 64) { const int n = lcnt[F.tid]; lbase[F.tid] = n > 0 ? (int)atomicAdd(&cur[F.tid], (unsigned)n) : 0; }
        __syncthreads();
        { const int tok = tokb + tl, pos = lbase[my_e] + my_rank; tokl[my_e * RT + pos] = tok * 8 + g; wl[my_e * RT + pos] = my_w; tpos[(tok - rr * RT) * 8 + g] = (my_e << 16) | pos; }
#pragma unroll 1
        for (int r0 = 0; r0 < 8; r0 += 4) {
            f32x4 xv[4][4];
#pragma unroll
            for (int r = 0; r < 4; ++r) { const f32x4* xr = (const f32x4*)(x1 + (size_t)(tokb + w * 8 + r0 + r) * DM) + lane;
#pragma unroll
                for (int j = 0; j < 4; ++j) xv[r][j] = xr[64 * j]; }
#pragma unroll
            for (int j = 0; j < 4; ++j) { const int col = 4 * lane + 256 * j; const f32x4 gq = *(const f32x4*)(gvec + b * DM + col), sh = *(const f32x4*)(mod + b * NMOD + 3 * DM + col);
#pragma unroll
                for (int r = 0; r < 4; ++r) { const int tl2 = w * 8 + r0 + r; const f32x4 hv = (xv[r][j] * rsl[tl2]) * gq + sh;
                    int o = 0; o = __builtin_amdgcn_cvt_pk_fp8_f32(f8c(hv.x * 16.f), f8c(hv.y * 16.f), o, false); o = __builtin_amdgcn_cvt_pk_fp8_f32(f8c(hv.z * 16.f), f8c(hv.w * 16.f), o, true);
                    ((unsigned*)(H2 + (size_t)(tokb - rr * RT + tl2) * DM) + lane)[64 * j] = (unsigned)o; } }
        }
        __syncthreads();
    }
}
constexpr int MO_TE = 4224;
struct MoeTabs { const LAS unsigned short* te; const LAS int* tb; const LAS int* cnt; int TR; };
__device__ __forceinline__ MoeTabs build_moe_tabs(Ctx& F, int rr) {
    LAS unsigned short* te = (LAS unsigned short*)(F.lds + MISC_OFF + MO_TE); LAS int* tb = (LAS int*)(F.lds + MISC_OFF + MO_TE + 1536); LAS int* cnt = tb + 72;
    const unsigned* cur = (const unsigned*)(F.ws + WS_CTL) + CW_MOECUR + rr * 64;
    __syncthreads();
    if (F.tid == 0) { int acc = 0; for (int e = 0; e < 64; ++e) { const int c = (int)cur[e]; cnt[e] = c; tb[e] = acc; acc += (c + 255) >> 8; } tb[64] = acc; tb[65] = acc + RT / 256; cnt[64] = RT; }
    __syncthreads();
    const int TR = tb[64];
    for (int e = F.tid >> 3; e < 65; e += 64) for (int t = tb[e] + (F.tid & 7); t < tb[e + 1]; t += 8) te[t] = (unsigned short)e;
    __syncthreads();
    MoeTabs T; T.te = te; T.tb = tb; T.cnt = cnt; T.TR = TR; return T;
}
struct Moe1Sched {
    const char* H2; const char* W1T; const int* tokl; MoeTabs T; int G, c, rr; int R[2], C[2];
    __device__ __forceinline__ bool next(int i, gm::UnitD& u) {
        const int uu = i * G + c; const int nt = T.TR + RT / 256;
        if (uu >= nt * 2) return false;
        const int tile = uu >> 1, pn = uu & 1, e = T.te[tile], rt = tile - T.tb[e], cnt = T.cnt[e];
        u.a = H2; u.b = W1T + (size_t)(e * 512 + pn * 256) * 1024;
#pragma unroll
        for (int h = 0; h < 2; ++h)
#pragma unroll
            for (int j = 0; j < 2; ++j) { const int idx = rt * 256 + h * 128 + R[j]; int trow;
                if (e < 64) { const int ent = tokl[e * RT + (idx < cnt ? idx : rt * 256)]; trow = (ent >> 3) - rr * RT; } else trow = idx;
                u.va[h][j] = (unsigned)(trow * 512 + C[j]) * 2u; }
        u.e0 = tile; u.e1 = pn; u.e2 = e; u.e3 = rt; return true;
    }
};
struct EpiMoe1 {
    bf16_t* act; const float* wl; const LAS int* cnt;
    __device__ __forceinline__ void operator()(const f32x4 (&acc)[2][2][4][2], const gm::UnitD& u, int wr, int wc, int fr, int fq) const {
        const int row0 = u.e0 * 256 + wr * 64 + fr, col0 = u.e1 * 128 + wc * 32 + 8 * fq, e = u.e2, n = cnt[e];
        float rw[2][4];
#pragma unroll
        for (int ai = 0; ai < 2; ++ai)
#pragma unroll
            for (int m = 0; m < 4; ++m) { const int idx = u.e3 * 256 + ai * 128 + wr * 64 + m * 16 + fr; rw[ai][m] = e < 64 ? (idx < n ? wl[e * RT + idx] : 0.f) : 1.f; }
#pragma unroll
        for (int ai = 0; ai < 2; ++ai)
#pragma unroll
            for (int m = 0; m < 4; ++m) { const float ww = rw[ai][m] * (1.f / 4096.f); const f32x4 g0 = acc[ai][0][m][0] * (1.f / 4096.f), g1 = acc[ai][0][m][1] * (1.f / 4096.f), u0 = acc[ai][1][m][0] * ww, u1 = acc[ai][1][m][1] * ww;
                u32x4 w; w.x = cvtpk(siluf_(g0[0]) * u0[0], siluf_(g0[1]) * u0[1]); w.y = cvtpk(siluf_(g0[2]) * u0[2], siluf_(g0[3]) * u0[3]);
                w.z = cvtpk(siluf_(g1[0]) * u1[0], siluf_(g1[1]) * u1[1]); w.w = cvtpk(siluf_(g1[2]) * u1[2], siluf_(g1[3]) * u1[3]);
                *(u32x4*)(act + (size_t)(row0 + ai * 128 + m * 16) * 256 + col0) = w; }
    }
};
__device__ __forceinline__ void phase_moe1(Ctx& F, int rr) {
    Moe1Sched S; S.T = build_moe_tabs(F, rr); S.H2 = (const char*)(F.ws + WS_H2) + (size_t)rr * RT * DM; S.W1T = (const char*)(F.ws + WS_W1T); S.tokl = (const int*)(F.ws + WS_TOKL) + (size_t)rr * 64 * RT; S.G = F.G; S.c = (F.G % 8 == 0) ? (F.bid % 8) * (F.G / 8) + F.bid / 8 : F.bid; S.rr = rr; gm::stage_geom(F.tid, S.R, S.C);
    EpiMoe1 E{(bf16_t*)(F.ws + WS_ACT), (const float*)(F.ws + WS_WL) + (size_t)rr * 64 * RT, S.T.cnt};
    gm::gemm_phase<true, false, true>(F.lds, 512, S, E);
}
struct Moe2Sched {
    const char* ACT; const char* W2T; MoeTabs T; int G, c; int R[2], C[2];
    __device__ __forceinline__ bool next(int i, gm::UnitD& u) {
        const int uu = i * G + c; const int nt = T.TR + RT / 256;
        if (uu >= nt * 4) return false;
        const int tile = uu >> 2, pn = uu & 3, e = T.te[tile], rt = tile - T.tb[e];
        u.a = ACT + (size_t)tile * 256 * 256 * 2; u.b = W2T + (size_t)(e * 1024 + pn * 256) * 256 * 2;
#pragma unroll
        for (int h = 0; h < 2; ++h)
#pragma unroll
            for (int j = 0; j < 2; ++j) u.va[h][j] = (unsigned)((h * 128 + R[j]) * 256 + C[j]) * 2u;
        u.e0 = pn; u.e1 = e; u.e2 = rt; u.e3 = tile; return true;
    }
};
struct EpiMoe2 {
    bf16_t* slots; bf16_t* shout; const LAS int* cnt;
    __device__ __forceinline__ void operator()(const f32x4 (&acc)[2][2][4][2], const gm::UnitD& u, int wr, int wc, int fr, int fq) const {
        const int pn = u.e0, e = u.e1, rt = u.e2, tile = u.e3;
        const int col0 = pn * 256 + wc * 32 + 8 * fq, n = cnt[e];
        if (e < 64) {
            unsigned char* base = (unsigned char*)slots + (size_t)(tile * 256 + wr * 64 + fr) * 1024 + col0;
#pragma unroll
            for (int ai = 0; ai < 2; ++ai)
#pragma unroll
                for (int m = 0; m < 4; ++m) {
                    if (rt * 256 + ai * 128 + wr * 64 + m * 16 + fr < n) {
#pragma unroll
                        for (int bj = 0; bj < 2; ++bj) { f32x4 v0 = acc[ai][bj][m][0] * 16.f, v1 = acc[ai][bj][m][1] * 16.f;
#pragma unroll
                            for (int j = 0; j < 4; ++j) { v0[j] = __builtin_amdgcn_fmed3f(v0[j], -440.f, 440.f); v1[j] = __builtin_amdgcn_fmed3f(v1[j], -440.f, 440.f); }
                            int w0 = 0, w1 = 0;
                            w0 = __builtin_amdgcn_cvt_pk_fp8_f32(v0[0], v0[1], w0, false); w0 = __builtin_amdgcn_cvt_pk_fp8_f32(v0[2], v0[3], w0, true);
                            w1 = __builtin_amdgcn_cvt_pk_fp8_f32(v1[0], v1[1], w1, false); w1 = __builtin_amdgcn_cvt_pk_fp8_f32(v1[2], v1[3], w1, true);
                            *(u32x2*)(base + (size_t)(ai * 128 + m * 16) * 1024 + bj * 128) = (u32x2){(unsigned)w0, (unsigned)w1}; } } }
        } else {
            bf16_t* base = shout + (size_t)(rt * 256 + wr * 64 + fr) * 1024 + col0;
#pragma unroll
            for (int ai = 0; ai < 2; ++ai)
#pragma unroll
                for (int m = 0; m < 4; ++m)
#pragma unroll
                    for (int bj = 0; bj < 2; ++bj) { const f32x4 v0 = acc[ai][bj][m][0], v1 = acc[ai][bj][m][1];
                        u32x4 o; o.x = cvtpk(v0[0], v0[1]); o.y = cvtpk(v0[2], v0[3]); o.z = cvtpk(v1[0], v1[1]); o.w = cvtpk(v1[2], v1[3]); *(u32x4*)(base + (size_t)(ai * 128 + m * 16) * 1024 + bj * 128) = o; }
        }
    }
};
__device__ __forceinline__ void phase_moe2(Ctx& F, int rr) {
    Moe2Sched S; S.T = build_moe_tabs(F, rr); S.ACT = (const char*)(F.ws + WS_ACT); S.W2T = (const char*)(F.ws + WS_W2T); S.G = F.G; S.c = (F.G % 8 == 0) ? (F.bid % 8) * (F.G / 8) + F.bid / 8 : F.bid; gm::stage_geom(F.tid, S.R, S.C);
    EpiMoe2 E{(bf16_t*)(F.ws + WS_SLOTS), (bf16_t*)(F.ws + WS_SHOUT), S.T.cnt};
    gm::gemm_phase<true>(F.lds, 256, S, E);
}
__device__ __forceinline__ void phase_final(Ctx& F, int rr) {
    const MoeTabs T = build_moe_tabs(F, rr);
    const float* mod = (const float*)(F.ws + WS_SMALL + SM_MOD); const float* fg = inp(F, I_FG);
    const unsigned char* slots = (const unsigned char*)(F.ws + WS_SLOTS); const int* tpos = (const int*)(F.ws + WS_TPOS) + (size_t)rr * RT * 8;
    const int gw = F.bid * 8 + F.wave, NGW = F.G * 8, c0 = F.lane * 8;
    for (int t = gw; t < RT; t += NGW) {
        const int tok = rr * RT + t, b = tok / SEQ;
        const unsigned char* rp[8];
#pragma unroll
        for (int k = 0; k < 8; ++k) { const int v = tpos[t * 8 + k]; rp[k] = slots + (size_t)(T.tb[v >> 16] * 256 + (v & 0xffff)) * 1024 + c0; }
        float* orow = F.out + (size_t)tok * DM + c0;
        u32x2 sv[8][2]; u32x4 sh[2]; f32x4 xv[2][2];
#pragma unroll
        for (int k = 0; k < 8; ++k) { sv[k][0] = *(const u32x2*)(rp[k]); sv[k][1] = *(const u32x2*)(rp[k] + 512); }
        { const bf16_t* sp = (const bf16_t*)(F.ws + WS_SHOUT) + (size_t)t * 1024 + c0; sh[0] = *(const u32x4*)sp; sh[1] = *(const u32x4*)(sp + 512); }
#pragma unroll
        for (int h = 0; h < 2; ++h) { xv[h][0] = *(const f32x4*)(orow + h * 512); xv[h][1] = *(const f32x4*)(orow + h * 512 + 4); }
        float s = 0.f; f32x4 v[2][2];
#pragma unroll
        for (int h = 0; h < 2; ++h) {
            f32x4 a0 = (f32x4){0.f, 0.f, 0.f, 0.f}, a1 = a0;
#pragma unroll
            for (int k = 0; k < 8; ++k) { const u32x2 w = sv[k][h];
                const f32x2 p0 = __builtin_amdgcn_cvt_pk_f32_fp8((int)w.x, false), p1 = __builtin_amdgcn_cvt_pk_f32_fp8((int)w.x, true), p2 = __builtin_amdgcn_cvt_pk_f32_fp8((int)w.y, false), p3 = __builtin_amdgcn_cvt_pk_f32_fp8((int)w.y, true);
                a0 += (f32x4){p0.x, p0.y, p1.x, p1.y}; a1 += (f32x4){p2.x, p2.y, p3.x, p3.y}; }
            { const u32x4 w = sh[h]; a0 = a0 * 0.0625f + (f32x4){bflo(w.x), bfhi(w.x), bflo(w.y), bfhi(w.y)}; a1 = a1 * 0.0625f + (f32x4){bflo(w.z), bfhi(w.z), bflo(w.w), bfhi(w.w)}; }
            const float* g2 = mod + b * NMOD + 5 * DM + c0 + h * 512;
            v[h][0] = xv[h][0] + *(const f32x4*)g2 * a0; v[h][1] = xv[h][1] + *(const f32x4*)(g2 + 4) * a1;
#pragma unroll
            for (int q = 0; q < 2; ++q) s += (v[h][q].x * v[h][q].x + v[h][q].y * v[h][q].y) + (v[h][q].z * v[h][q].z + v[h][q].w * v[h][q].w);
        }
        const float rstd = rsqrtf(wave_sum(s) * (1.f / DM) + EPS);
#pragma unroll
        for (int h = 0; h < 2; ++h)
#pragma unroll
            for (int q = 0; q < 2; ++q) { const f32x4 g = *(const f32x4*)(fg + c0 + h * 512 + 4 * q); *(f32x4*)(orow + h * 512 + 4 * q) = (v[h][q] * rstd) * g; }
    }
}

constexpr int N_PHASES = 10;
__global__ void __launch_bounds__(512, 2) mega_fwd(Args args) {
    extern __shared__ __attribute__((aligned(16))) unsigned char lds_raw[];
    Ctx F; F.lds = (LAS unsigned char*)lds_raw; F.ws = args.ws; F.out = args.out;
    {
        typedef __attribute__((address_space(4))) const unsigned long long* karg_t;
        const karg_t ka = (karg_t)__builtin_amdgcn_kernarg_segment_ptr();
        LAS unsigned long long* tab = (LAS unsigned long long*)(lds_raw + MISC_OFF + 14336);
        if (threadIdx.x < 20) tab[threadIdx.x] = ka[threadIdx.x];
        F.intab = tab;
    }
    F.tid = threadIdx.x; F.lane = F.tid & 63; F.wave = __builtin_amdgcn_readfirstlane(F.tid >> 6); F.G = gridDim.x; F.bid = blockIdx.x;
    volatile LAS unsigned* st = (volatile LAS unsigned*)(F.lds + MISC_OFF + MO_ST);
    if (F.tid < 4) st[F.tid] = 0u;
    __syncthreads();
    XcdBarrier bar = xcd_barrier_post((unsigned*)(F.ws + WS_CTL) + CW_BAR, st);
    if (threadIdx.x == 0) { unsigned nloc, nx; xcd_barrier_complete(bar.bar, bar.x, nloc, nx); st[0] = nloc; st[1] = nx; }
    int lo = args.ph_lo, hi = args.ph_hi;
    { int a = lo, b = hi; asm volatile("" : "+v"(a), "+v"(b)); lo = __builtin_amdgcn_readfirstlane(a); hi = __builtin_amdgcn_readfirstlane(b); }
    launder(F);
#ifndef PH_MASK
#define PH_MASK 0x1ffff
#endif
#define PH_ON(k) ((PH_MASK >> (k)) & 1)
#define IN(k) (lo <= (k) && (k) < hi)
#define SEAM(k) do { if (IN(k) && IN((k) + 1)) { bar.bar = launder_ptr(bar.bar); xcd_barrier(bar); } } while (0)
#define RUN(k, call) do { if (PH_ON(k) && IN(k)) { launder(F); call; } } while (0)
    RUN(0, phase0(F)); SEAM(0);
    RUN(1, phase1(F)); SEAM(1);
    RUN(2, phase2(F)); SEAM(2);
    RUN(4, (phase4(F), sb_units(F))); SEAM(4);
    RUN(5, phase5(F)); SEAM(5);
    RUN(6, phase6(F)); SEAM(6);
    RUN(7, phase7(F)); SEAM(7);
    RUN(8, phase8(F)); SEAM(8);
    if (PH_ON(9) && IN(9)) {
        const int par = (F.bid >> 3) & 1;
#pragma unroll 1
        for (int i = 0; i < 8; ++i) {
            launder(F);
            int op, rr; bool bar_after = true;
            switch (i) {
                case 0: op = 0; rr = 0; break;
                case 1: op = 1; rr = 0; break;
                case 2: op = par ? 0 : 2; rr = par ? 1 : 0; bar_after = false; break;
                case 3: op = par ? 2 : 0; rr = par ? 0 : 1; break;
                case 4: op = par ? 1 : 3; rr = par ? 1 : 0; bar_after = false; break;
                case 5: op = par ? 3 : 1; rr = par ? 0 : 1; break;
                case 6: op = 2; rr = 1; break;
                default: op = 3; rr = 1; bar_after = false; break;
            }
            switch (op) {
                case 0: phase_n2r(F, rr); break;
                case 1: phase_moe1(F, rr); break;
                case 2: phase_moe2(F, rr); break;
                default: phase_final(F, rr); break;
            }
            if (bar_after) { bar.bar = launder_ptr(bar.bar); xcd_barrier(bar); } else __syncthreads();
        }
    }
#undef IN
#undef SEAM
#undef RUN
}

#ifndef MK_SPLIT
#define MK_SPLIT 0
#endif
extern "C" void kernel_launch(void* const* d_in, const int* in_sizes, int n_in, void* d_out, int out_size, void* d_ws, size_t ws_size, hipStream_t stream) {
    static int grid = 0;
    if (grid == 0) {
        if (n_in != 20 || in_sizes[0] != MT * DM || out_size != MT * DM || ws_size < WS_END) { fprintf(stderr, "kernel_launch: unexpected shapes (n_in %d, in0 %d, out %d, ws %zu)\n", n_in, n_in > 0 ? in_sizes[0] : -1, out_size, ws_size); grid = -1; return; }
        int dev = 0, cus = 0;
        if (hipGetDevice(&dev) != hipSuccess || hipDeviceGetAttribute(&cus, hipDeviceAttributeMultiprocessorCount, dev) != hipSuccess) { grid = -1; return; }
        if (hipFuncSetAttribute((const void*)mega_fwd, hipFuncAttributeMaxDynamicSharedMemorySize, LDS_BYTES) != hipSuccess) { fprintf(stderr, "kernel_launch: hipFuncSetAttribute failed\n"); grid = -1; return; }
        int per_cu = 0;
        if (hipOccupancyMaxActiveBlocksPerMultiprocessor(&per_cu, (const void*)mega_fwd, 512, LDS_BYTES) != hipSuccess || per_cu < 1) fprintf(stderr, "kernel_launch: occupancy query reports %d\n", per_cu);
        (void)hipGetLastError();
        grid = cus;
    }
    if (grid < 0) return;
    (void)hipMemsetAsync((char*)d_ws + WS_CTL, 0, CTL_BYTES, stream);
    Args a{};
    for (int i = 0; i < 20; ++i) a.in[i] = (const float*)d_in[i];
    a.out = (float*)d_out; a.ws = (unsigned char*)d_ws;
#if MK_SPLIT
    for (int p = 0; p < N_PHASES; ++p) { a.ph_lo = p; a.ph_hi = p + 1; hipLaunchKernelGGL(mega_fwd, dim3(grid), dim3(512), LDS_BYTES, stream, a); }
#else
    a.ph_lo = 0; a.ph_hi = N_PHASES;
    hipLaunchKernelGGL(mega_fwd, dim3(grid), dim3(512), LDS_BYTES, stream, a);
#endif
}
```

```cpp
#include <hip/hip_runtime.h>
#include <cstdio>
#include <cstdint>

#define LAS __attribute__((address_space(3)))
#define GAS __attribute__((address_space(1)))
typedef unsigned short bf16_t;
typedef short bf16x8 __attribute__((ext_vector_type(8)));
typedef short s16x4 __attribute__((ext_vector_type(4)));
typedef float f32x4 __attribute__((ext_vector_type(4)));
typedef float f32x16 __attribute__((ext_vector_type(16)));
typedef float f32x2 __attribute__((ext_vector_type(2)));
typedef unsigned u32x4 __attribute__((ext_vector_type(4)));
typedef unsigned u32x2 __attribute__((ext_vector_type(2)));
typedef __bf16 bf16x2_t __attribute__((ext_vector_type(2)));

__device__ __forceinline__ unsigned cvtpk(float lo, float hi) { f32x2 v = {lo, hi}; bf16x2_t b = __builtin_convertvector(v, bf16x2_t); return __builtin_bit_cast(unsigned, b); }
__device__ __forceinline__ float bf2f(unsigned short u) { return __uint_as_float(((unsigned)u) << 16); }
__device__ __forceinline__ float bflo(unsigned u) { return __uint_as_float(u << 16); }
__device__ __forceinline__ float bfhi(unsigned u) { return __uint_as_float(u & 0xffff0000u); }

constexpr int NB = 4, SEQ = 8192, DM = 1024, MT = NB * SEQ;
constexpr int NHEAD = 8, HD = 64, QW = 1536;
constexpr int NE = 64, EFF = 256, NMOD = 6 * DM;
constexpr int RT = MT / 2;
constexpr float EPS = 1e-6f;
constexpr float LOG2E = 1.4426950408889634f;

constexpr size_t MiB = 1u << 20;
constexpr size_t WS_CTL = 0, CTL_BYTES = 1 * MiB;
constexpr size_t WS_SMALL = 1 * MiB;
constexpr size_t SM_MOD = 0, SM_GVEC = 98304, SM_CB = 114688, SM_KBAR = 131072, SM_WRH = 393216, SM_WRL = 524288;
constexpr size_t WS_W2T = 2 * MiB;
constexpr size_t WS_W1T = 35 * MiB;
constexpr size_t WS_WINT = 100 * MiB;
constexpr size_t WS_WBRT = 110 * MiB;
constexpr size_t WS_WOUTT = 112 * MiB;
constexpr size_t WS_H = 114 * MiB;
constexpr size_t WS_OB = 114 * MiB;
constexpr size_t WS_QSB = 178 * MiB;
constexpr size_t WS_PO = 178 * MiB;
constexpr size_t WS_QMB = 274 * MiB;
constexpr size_t WS_MERGED = 274 * MiB;
constexpr size_t WS_G = 370 * MiB;
constexpr size_t WS_LMB = 498 * MiB;
constexpr size_t WS_PLSE = 506 * MiB;
constexpr size_t WS_H2 = 100 * MiB;
constexpr size_t WS_TOKL = 164 * MiB;
constexpr size_t WS_WL = 172 * MiB;
constexpr size_t WS_TPOS = 180 * MiB;
constexpr size_t WS_ACT = 184 * MiB;
constexpr size_t WS_SLOTS = 264 * MiB;
constexpr size_t WS_SHOUT = 408 * MiB;
constexpr size_t WS_END = 509 * MiB;
constexpr int CW_MBCUR = 0;
constexpr int CW_MOECUR = 1024;
constexpr int CW_BAR = 4096;
constexpr size_t CTL_KBS = 512 * 1024;

constexpr int RING_BYTES = 131072;
constexpr int MISC_OFF = RING_BYTES;
constexpr int LDS_BYTES = 163840;
constexpr int MO_STG = 16384;

#define XB_TMO      128
#define XB_XCNT(j)  (256  + 64 * (j))
#define XB_XSUB(j)  (1280 + 64 * (j))
#define XB_XGEN(j)  (2304 + 64 * (j))
#define XB_TOP      3328
#define XB_TOPGEN   3392
#define XCD_BAR_WORDS 3456
#define XB_SPIN_CAP (1u << 18)
__device__ __forceinline__ unsigned xb_ld(unsigned* p)              { return __hip_atomic_load(p, __ATOMIC_RELAXED, __HIP_MEMORY_SCOPE_AGENT); }
__device__ __forceinline__ unsigned xb_add(unsigned* p, unsigned v) { return __hip_atomic_fetch_add(p, v, __ATOMIC_RELAXED, __HIP_MEMORY_SCOPE_AGENT); }
__device__ __forceinline__ unsigned xb_xcc_id() { return (unsigned)__builtin_amdgcn_s_getreg((3 << 11) | 20) & 0xFu; }
#define XB_SPIN(cond, bar) do { unsigned _sp = 0; while (cond) { __builtin_amdgcn_s_sleep(1); \
    if ((++_sp & 255u) == 0u) { if (xb_ld(&(bar)[XB_TMO])) break; if (_sp > XB_SPIN_CAP) { atomicAdd(&(bar)[XB_TMO], 1u); break; } } } } while (0)
struct XcdBarrier { unsigned* bar; unsigned x; volatile LAS unsigned* st; };
__device__ __forceinline__ XcdBarrier xcd_barrier_post(unsigned* bar, volatile LAS unsigned* st) {
    XcdBarrier b; b.bar = bar; b.x = xb_xcc_id(); b.st = st;
    if (threadIdx.x == 0) (void)xb_add(&bar[XB_XCNT(b.x)], 1u);
    return b;
}
__device__ __forceinline__ void xcd_barrier_complete(unsigned* bar, unsigned x, unsigned& nloc, unsigned& nx) {
    const unsigned G = gridDim.x * gridDim.y * gridDim.z;
    unsigned sum, cnt, mine, sp = 0u;
    for (;;) {
        sum = 0u; cnt = 0u; mine = 0u;
#pragma unroll
        for (unsigned j = 0; j < 16; ++j) { const unsigned c = xb_ld(&bar[XB_XCNT(j)]); sum += c; cnt += (c > 0u) ? 1u : 0u; mine = (j == x) ? c : mine; }
        if (sum == G) break;
        __builtin_amdgcn_s_sleep(1);
        if ((++sp & 255u) == 0u) { if (xb_ld(&bar[XB_TMO])) break; if (sp > XB_SPIN_CAP) { atomicAdd(&bar[XB_TMO], 1u); break; } }
    }
    nloc = mine > 0u ? mine : 1u; nx = cnt > 0u ? cnt : 1u;
}
__device__ __forceinline__ void xcd_barrier(const XcdBarrier& b) {
    asm volatile("s_waitcnt vmcnt(0)" ::: "memory");
    __syncthreads();
    if (threadIdx.x == 0) {
        unsigned* bar = b.bar;
        __builtin_amdgcn_s_waitcnt(0);
        unsigned nloc = b.st[0], nx = b.st[1];
        const unsigned old = xb_add(&bar[XB_XSUB(b.x)], 1u);
        const unsigned gen = old / nloc;
        if (old + 1u == (gen + 1u) * nloc) {
            __builtin_amdgcn_fence(__ATOMIC_RELEASE, "agent");
            asm volatile("s_waitcnt vmcnt(0)" ::: "memory");
            const unsigned og = xb_add(&bar[XB_TOP], 1u);
            const unsigned tg = og / nx;
            if (og + 1u == (tg + 1u) * nx) xb_add(&bar[XB_TOPGEN], 1u);
            else XB_SPIN(xb_ld(&bar[XB_TOPGEN]) == tg, bar);
            __builtin_amdgcn_fence(__ATOMIC_ACQUIRE, "agent");
            xb_add(&bar[XB_XGEN(b.x)], 1u);
            asm volatile("s_waitcnt vmcnt(0)" ::: "memory");
        } else {
            XB_SPIN(xb_ld(&bar[XB_XGEN(b.x)]) == gen, bar);
            __builtin_amdgcn_fence(__ATOMIC_ACQUIRE, "agent");
            asm volatile("s_waitcnt vmcnt(0)" ::: "memory");
        }
    }
    __syncthreads();
}

namespace gm {
constexpr int BM = 256, BK = 64, HALF = 128, HTB = HALF * BK * 2, STAGE_BYTES = 8 * HTB, NXCD = 8, WGM = 8;
__host__ __device__ __forceinline__ int lds_byte(int r, int c) { const int st = (r >> 4) * 2 + (c >> 5), rr = r & 15, cc = c & 31, ob = rr * 64 + cc * 2; return st * 1024 + (ob ^ (((ob >> 9) & 1) << 5)); }
__host__ __device__ __forceinline__ void stage_rc(int b, int& R, int& C) { const int st = b / 1024, sb = b % 1024, swz = sb ^ (((sb >> 9) & 1) << 5); R = (st >> 1) * 16 + swz / 64; C = (st & 1) * 32 + (swz % 64) / 2; }
__host__ __device__ __forceinline__ int perm32(int rho) { const int n = rho >> 4, i = rho & 15; return 8 * (i >> 2) + 4 * n + (i & 3); }

struct UnitD { const char* a; const char* b; unsigned va[2][2]; int e0, e1, e2, e3; };

__device__ __forceinline__ bool static_tile(int M, int N, int G, int c, int i, int& pm, int& pn) {
    const int nM = M / BM, nN = N / BM, nwg = nM * nN;
    const long L = (long)i * G + c; if (L >= nwg) return false;
    int wgid = (int)L; { const int q = nwg / NXCD, r = nwg % NXCD, xcd = wgid % NXCD, off = wgid / NXCD; wgid = (xcd < r ? xcd * (q + 1) : r * (q + 1) + (xcd - r) * q) + off; }
    const int nig = WGM * nN, gid = wgid / nig, fm = gid * WGM, gsz = (nM - fm) < WGM ? (nM - fm) : WGM;
    pm = fm + ((wgid % nig) % gsz); pn = (wgid % nig) / gsz; return true;
}

template <bool PERM, bool HOOK = false, bool FP8 = false, class Epi, class Sched>
__device__ __forceinline__ void gemm_phase(LAS unsigned char* lds, const int K, Sched& S, const Epi& E) {
    const int tid = threadIdx.x, wid = __builtin_amdgcn_readfirstlane(tid >> 6), lane = tid & 63, wr = wid >> 2, wc = wid & 3, fr = lane & 15, fq = lane >> 4;
    const int nt = K / BK;
    unsigned voffB[2];
#pragma unroll
    for (int i = 0; i < 2; ++i) { int R, C; stage_rc(tid * 16 + i * 8192, R, C); const int Rb = PERM ? ((R & ~31) + perm32(R & 31)) : R; voffB[i] = (unsigned)(Rb * K + C) * 2u; }
    const size_t kstep = (size_t)(BK * 2);
    const size_t hstep = (size_t)HALF * K * 2;
    const unsigned ldsw = (unsigned)wid * 1024u;
    const int aoff = lds_byte(wr * 64 + fr, fq * 8), boff = lds_byte(wc * 32 + fr, fq * 8);
#define GM_SA(b, h) (((b) * 2 + (h)) * HTB)
#define GM_SB(b, h) ((4 + (b) * 2 + (h)) * HTB)
#define GM_STAGE_A(bufoff, U, h, kb) do { _Pragma("unroll") for (int _i = 0; _i < 2; ++_i) \
        __builtin_amdgcn_global_load_lds((const unsigned*)((U).a + (kb) + (U).va[h][_i]), (LAS unsigned*)(lds + (bufoff) + ldsw + _i * 8192), 16, 0, 0); } while (0)
#define GM_STAGE_B(bufoff, U, h, kb) do { _Pragma("unroll") for (int _i = 0; _i < 2; ++_i) \
        __builtin_amdgcn_global_load_lds((const unsigned*)((U).b + (kb) + (size_t)(h) * hstep + voffB[_i]), (LAS unsigned*)(lds + (bufoff) + ldsw + _i * 8192), 16, 0, 0); } while (0)
#define GM_LDA(dst, b, h) do { _Pragma("unroll") for (int m = 0; m < 4; ++m) _Pragma("unroll") for (int k = 0; k < 2; ++k) { \
        if constexpr (FP8) { const i32x4_ t_ = *(const LAS i32x4_*)(lds + GM_SA(b, h) + aoff + m * 2048 + k * 1024); dst##8[m][4 * k] = t_[0]; dst##8[m][4 * k + 1] = t_[1]; dst##8[m][4 * k + 2] = t_[2]; dst##8[m][4 * k + 3] = t_[3]; } \
        else dst[m][k] = *(const LAS bf16x8*)(lds + GM_SA(b, h) + aoff + m * 2048 + k * 1024); } } while (0)
#define GM_LDB(dst, b, h) do { _Pragma("unroll") for (int n = 0; n < 2; ++n) _Pragma("unroll") for (int k = 0; k < 2; ++k) { \
        if constexpr (FP8) { const i32x4_ t_ = *(const LAS i32x4_*)(lds + GM_SB(b, h) + boff + n * 2048 + k * 1024); dst##8[n][4 * k] = t_[0]; dst##8[n][4 * k + 1] = t_[1]; dst##8[n][4 * k + 2] = t_[2]; dst##8[n][4 * k + 3] = t_[3]; } \
        else dst[n][k] = *(const LAS bf16x8*)(lds + GM_SB(b, h) + boff + n * 2048 + k * 1024); } } while (0)
#define GM_MMA(ai, bj, At, Bt) do { __builtin_amdgcn_s_setprio(1); \
        if constexpr (FP8) { _Pragma("unroll") for (int m = 0; m < 4; ++m) _Pragma("unroll") for (int n = 0; n < 2; ++n) \
            asm volatile("v_mfma_scale_f32_16x16x128_f8f6f4 %0, %1, %2, %0, %3, %3 op_sel_hi:[0,0,0]" : "+v"(acc[ai][bj][m][n]) : "v"(Bt##8[n]), "v"(At##8[m]), "v"(scl1)); } \
        else { _Pragma("unroll") for (int m = 0; m < 4; ++m) _Pragma("unroll") for (int n = 0; n < 2; ++n) _Pragma("unroll") for (int k = 0; k < 2; ++k) \
            acc[ai][bj][m][n] = __builtin_amdgcn_mfma_f32_16x16x32_bf16(Bt[n][k], At[m][k], acc[ai][bj][m][n], 0, 0, 0); } \
        __builtin_amdgcn_s_setprio(0); } while (0)
#define GM_WAIT_V(n) asm volatile("s_waitcnt vmcnt(" #n ")" ::: "memory")
#define GM_WAIT_L(n) asm volatile("s_waitcnt lgkmcnt(" #n ")" ::: "memory")
#define GM_BAR __builtin_amdgcn_s_barrier()
#define GM_SCHED __builtin_amdgcn_sched_barrier(0)
    UnitD cur, nxt; int ui = 0;
    if (!S.next(0, cur)) return;
    f32x4 acc[2][2][4][2];
#pragma unroll
    for (int a = 0; a < 2; ++a)
#pragma unroll
        for (int b = 0; b < 2; ++b)
#pragma unroll
            for (int m = 0; m < 4; ++m)
#pragma unroll
                for (int n = 0; n < 2; ++n) acc[a][b][m][n] = (f32x4){0.f, 0.f, 0.f, 0.f};
    typedef int i32x8_ __attribute__((ext_vector_type(8))); typedef int i32x4_ __attribute__((ext_vector_type(4)));
    bf16x8 At[4][2], B0[2][2], B1[2][2]; i32x8_ At8[4], B08[2], B18[2];
    int scl1 = 0x7f7f7f7f; asm volatile("" : "+v"(scl1));
    GM_STAGE_B(GM_SB(0, 0), cur, 0, 0); GM_STAGE_B(GM_SB(0, 1), cur, 1, 0); GM_STAGE_A(GM_SA(0, 0), cur, 0, 0); GM_STAGE_A(GM_SA(0, 1), cur, 1, 0);
    if (wr == 1) GM_BAR;
    GM_WAIT_V(2); GM_BAR;
    GM_STAGE_B(GM_SB(1, 0), cur, 0, kstep); GM_STAGE_A(GM_SA(1, 0), cur, 0, kstep); GM_STAGE_B(GM_SB(1, 1), cur, 1, kstep);
    GM_WAIT_V(6); GM_BAR;
    for (;;) {
        const bool has_next = S.next(ui + 1, nxt);
        if (!has_next) nxt = cur;
#pragma unroll 1
        for (int t = 0; t < nt; t += 2) {
            const bool last = (t == nt - 2);
            if constexpr (HOOK) { if (t == nt / 2) E.mid(acc, cur, wr, wc, fr, fq); }
            const size_t k1 = (size_t)(t + 1) * kstep;
            UnitD U2 = cur; size_t k2 = (size_t)(t + 2) * kstep;
            if (last) { U2 = nxt; k2 = 0; }
            const size_t k3 = k2 + kstep;
            GM_LDB(B0, 0, 0); GM_LDB(B1, 0, 1); GM_SCHED; GM_LDA(At, 0, 0); GM_STAGE_A(GM_SA(1, 1), cur, 1, k1);
            GM_WAIT_V(8); GM_WAIT_L(0); GM_BAR; GM_MMA(0, 0, At, B0); GM_MMA(0, 1, At, B1); GM_BAR; GM_SCHED;
            GM_LDA(At, 0, 1); GM_STAGE_B(GM_SB(0, 0), U2, 0, k2); GM_STAGE_B(GM_SB(0, 1), U2, 1, k2); GM_STAGE_A(GM_SA(0, 0), U2, 0, k2);
            GM_WAIT_V(8); GM_WAIT_L(0); GM_BAR; GM_MMA(1, 0, At, B0); GM_MMA(1, 1, At, B1); GM_BAR; GM_SCHED;
            GM_LDB(B0, 1, 0); GM_LDB(B1, 1, 1); GM_SCHED; GM_LDA(At, 1, 0); GM_STAGE_A(GM_SA(0, 1), U2, 1, k2);
            GM_WAIT_V(8); GM_WAIT_L(0); GM_BAR; GM_MMA(0, 0, At, B0); GM_MMA(0, 1, At, B1); GM_BAR; GM_SCHED;
            GM_LDA(At, 1, 1); GM_STAGE_B(GM_SB(1, 0), U2, 0, k3); GM_STAGE_B(GM_SB(1, 1), U2, 1, k3); GM_STAGE_A(GM_SA(1, 0), U2, 0, k3);
            GM_WAIT_V(8); GM_WAIT_L(0); GM_BAR; GM_MMA(1, 0, At, B0); GM_MMA(1, 1, At, B1); GM_BAR; GM_SCHED;
        }
        if constexpr (FP8) asm volatile("s_nop 15\n\ts_nop 15" ::: "memory");
        if (wr == 0) GM_BAR;
        E(acc, cur, wr, wc, fr, fq);
        if (!has_next) break;
#pragma unroll
        for (int a = 0; a < 2; ++a)
#pragma unroll
            for (int b = 0; b < 2; ++b)
#pragma unroll
                for (int m = 0; m < 4; ++m)
#pragma unroll
                    for (int n = 0; n < 2; ++n) acc[a][b][m][n] = (f32x4){0.f, 0.f, 0.f, 0.f};
        cur = nxt; ++ui;
        if (wr == 1) GM_BAR;
    }
    GM_WAIT_V(0);
    GM_BAR;
#undef GM_SA
#undef GM_SB
#undef GM_STAGE_A
#undef GM_STAGE_B
#undef GM_LDA
#undef GM_LDB
#undef GM_MMA
#undef GM_WAIT_V
#undef GM_WAIT_L
#undef GM_BAR
#undef GM_SCHED
}
__device__ __forceinline__ void stage_geom(int tid, int (&R)[2], int (&C)[2]) {
#pragma unroll
    for (int i = 0; i < 2; ++i) stage_rc(tid * 16 + i * 8192, R[i], C[i]);
}
}

struct Args { const float* in[20]; float* out; unsigned char* ws; int ph_lo, ph_hi; };
struct Ctx {
    LAS unsigned char* lds;
    unsigned char* ws;
    const LAS unsigned long long* intab;
    float* out;
    int tid, lane, wave, G, bid;
};
#define LDS_WAIT() asm volatile("s_waitcnt lgkmcnt(0)" ::: "memory")
__device__ __forceinline__ const float* inp(const Ctx& F, int i) {
    const unsigned long long v = F.intab[i];
    const unsigned lo = __builtin_amdgcn_readfirstlane((unsigned)v), hi = __builtin_amdgcn_readfirstlane((unsigned)(v >> 32));
    return (const float*)(GAS const float*)(((unsigned long long)hi << 32) | lo);
}
template <class P> __device__ __forceinline__ P launder_ptr(P p) {
    unsigned long long v = (unsigned long long)p; unsigned lo = (unsigned)v, hi = (unsigned)(v >> 32);
    asm volatile("" : "+v"(lo), "+v"(hi));
    lo = __builtin_amdgcn_readfirstlane(lo); hi = __builtin_amdgcn_readfirstlane(hi);
    return (P)(GAS unsigned char*)(((unsigned long long)hi << 32) | lo);
}
__device__ __forceinline__ void launder(Ctx& F) {
    int t = F.tid, g = F.G, bid = F.bid;
    asm volatile("" : "+v"(t), "+v"(g), "+v"(bid));
    F.tid = t; F.G = __builtin_amdgcn_readfirstlane(g); F.bid = __builtin_amdgcn_readfirstlane(bid); F.lane = t & 63; F.wave = __builtin_amdgcn_readfirstlane(t >> 6);
    F.ws = launder_ptr(F.ws); F.out = launder_ptr(F.out);
}
__device__ __forceinline__ float wave_sum(float v) {
#pragma unroll
    for (int o = 1; o < 64; o <<= 1) v += __shfl_xor(v, o);
    return v;
}
__device__ __forceinline__ int lds_add(LAS int* p, int v) { return __hip_atomic_fetch_add(p, v, __ATOMIC_RELAXED, __HIP_MEMORY_SCOPE_WORKGROUP); }
__device__ __forceinline__ float f8c(float x) { return __builtin_amdgcn_fmed3f(x, -440.f, 440.f); }
__device__ __forceinline__ float sigmoidf_(float x) { return 1.f / (1.f + __expf(-x)); }
__device__ __forceinline__ float siluf_(float x) { return x / (1.f + __expf(-x)); }

enum { I_X = 0, I_C, I_N1G, I_N2G, I_WADA, I_BADA, I_WIN, I_WBSB, I_WBMB, I_WOUT, I_WR, I_RB, I_WGE, I_WUE, I_WDE, I_WGS, I_WUS, I_WDS, I_RELB, I_FG };

__device__ __forceinline__ void transpose_item(const float* W, int ldn, int k0, int n0, bf16_t* WT, int Kdst, int drow0, LAS float* scr, int lane) {
    const float* wp = W + (size_t)(k0 + (lane >> 3)) * ldn + n0 + 4 * (lane & 7);
    f32x4 v[8];
#pragma unroll
    for (int i = 0; i < 8; ++i) v[i] = *(const f32x4*)(wp + (size_t)(8 * i) * ldn);
#pragma unroll
    for (int i = 0; i < 8; ++i) { LAS float* d = scr + (8 * i + (lane >> 3)) * 33 + 4 * (lane & 7); d[0] = v[i].x; d[1] = v[i].y; d[2] = v[i].z; d[3] = v[i].w; }
    LDS_WAIT(); asm volatile("" ::: "memory");
    const int c = lane & 7;
#pragma unroll
    for (int j = 0; j < 4; ++j) { const int n = (lane >> 3) + 8 * j; const LAS float* s = scr + (8 * c) * 33 + n;
        u32x4 o; o.x = cvtpk(s[0 * 33], s[1 * 33]); o.y = cvtpk(s[2 * 33], s[3 * 33]); o.z = cvtpk(s[4 * 33], s[5 * 33]); o.w = cvtpk(s[6 * 33], s[7 * 33]);
        *(u32x4*)(WT + (size_t)(drow0 + n) * Kdst + k0 + 8 * c) = o; }
    LDS_WAIT(); asm volatile("" ::: "memory");
}
__device__ __forceinline__ void phase0(Ctx& F) {
    LAS float* silc = (LAS float*)(F.lds + MISC_OFF - 0);
    silc = (LAS float*)(F.lds + 0);
    for (int i = F.tid; i < 4 * DM; i += 512) silc[i] = siluf_(inp(F, I_C)[i]);
    __syncthreads();
    float* mod = (float*)(F.ws + WS_SMALL + SM_MOD);
    {
        const int gw = F.wave * F.G + F.bid;
        const int c = F.lane & 15, kp = F.lane >> 4;
        const float* wada = inp(F, I_WADA);
        for (int item = gw; item < NMOD / 16; item += 8 * F.G) {
            const int col = item * 16 + c;
            float a0 = 0.f, a1 = 0.f, a2 = 0.f, a3 = 0.f;
#pragma unroll 32
            for (int k = kp; k < DM; k += 4) { const float w = wada[(size_t)k * NMOD + col]; a0 += silc[k] * w; a1 += silc[DM + k] * w; a2 += silc[2 * DM + k] * w; a3 += silc[3 * DM + k] * w; }
            a0 += __shfl_xor(a0, 16); a0 += __shfl_xor(a0, 32); a1 += __shfl_xor(a1, 16); a1 += __shfl_xor(a1, 32);
            a2 += __shfl_xor(a2, 16); a2 += __shfl_xor(a2, 32); a3 += __shfl_xor(a3, 16); a3 += __shfl_xor(a3, 32);
            if (kp == 0) { const float bb = inp(F, I_BADA)[col]; mod[col] = a0 + bb; mod[NMOD + col] = a1 + bb; mod[2 * NMOD + col] = a2 + bb; mod[3 * NMOD + col] = a3 + bb; }
        }
    }
    __syncthreads();
    {
        LAS float* scr = (LAS float*)(F.lds + F.wave * 16384);
        const int gw = F.bid * 8 + F.wave, NGW = F.G * 8, lane = F.lane;
        constexpr int I_IN = 16 * 160, I_BR = 8 * 32, I_OUT = 16 * 32, I_EXP = 384, NIT = I_IN + 2 * I_BR + I_OUT + 65 * I_EXP;
        const float* p_win = inp(F, I_WIN); const float* p_bsb = inp(F, I_WBSB); const float* p_bmb = inp(F, I_WBMB); const float* p_out = inp(F, I_WOUT);
        const float* p_ge = inp(F, I_WGE); const float* p_ue = inp(F, I_WUE); const float* p_de = inp(F, I_WDE); const float* p_gs = inp(F, I_WGS); const float* p_us = inp(F, I_WUS); const float* p_ds = inp(F, I_WDS);
#define TD_GET(IT, SRC, LDN, DST, KD, F8) do { int r = (IT); F8 = 0; \
            if (r < I_IN) { const int kb = r / 160, nb = r % 160; SRC = p_win + (size_t)(kb * 64) * 5120 + nb * 32; LDN = 5120; DST = (bf16_t*)(F.ws + WS_WINT) + (size_t)(nb * 32) * 1024 + kb * 64; KD = 1024; } \
            else if ((r -= I_IN) < I_BR) { const int kb = r / 32, nb = r % 32; SRC = p_bsb + (size_t)(kb * 64) * 1024 + nb * 32; LDN = 1024; DST = (bf16_t*)(F.ws + WS_WBRT) + (size_t)(nb * 32) * 1024 + kb * 64; KD = 1024; } \
            else if ((r -= I_BR) < I_BR) { const int kb = r / 32, nb = r % 32; SRC = p_bmb + (size_t)(kb * 64) * 1024 + nb * 32; LDN = 1024; DST = (bf16_t*)(F.ws + WS_WBRT) + (size_t)(nb * 32) * 1024 + 512 + kb * 64; KD = 1024; } \
            else if ((r -= I_BR) < I_OUT) { const int kb = r / 32, nb = r % 32; SRC = p_out + (size_t)(kb * 64) * 1024 + nb * 32; LDN = 1024; DST = (bf16_t*)(F.ws + WS_WOUTT) + (size_t)(nb * 32) * 1024 + kb * 64; KD = 1024; } \
            else { r -= I_OUT; const int e = r / I_EXP; r -= e * I_EXP; \
                if (r < 128) { const int kb = r / 8, n0 = (r % 8) * 32; SRC = (e < NE ? p_ge + (size_t)e * DM * EFF : p_gs) + (size_t)(kb * 64) * EFF + n0; LDN = EFF; \
                    DST = (bf16_t*)((unsigned char*)(F.ws + WS_W1T) + ((size_t)e * 512 + (n0 >> 7) * 256 + (n0 & 127)) * 1024 + kb * 64); KD = 1024; F8 = 256; } \
                else if (r < 256) { r -= 128; const int kb = r / 8, n0 = (r % 8) * 32; SRC = (e < NE ? p_ue + (size_t)e * DM * EFF : p_us) + (size_t)(kb * 64) * EFF + n0; LDN = EFF; \
                    DST = (bf16_t*)((unsigned char*)(F.ws + WS_W1T) + ((size_t)e * 512 + (n0 >> 7) * 256 + 128 + (n0 & 127)) * 1024 + kb * 64); KD = 1024; F8 = 256; } \
                else { r -= 256; const int kb = r / 32, nb = r % 32; SRC = (e < NE ? p_de + (size_t)e * EFF * DM : p_ds) + (size_t)(kb * 64) * DM + nb * 32; LDN = DM; \
                    DST = (bf16_t*)((unsigned char*)(F.ws + WS_W2T) + ((size_t)e * 1024 + nb * 32) * 256 + kb * 64); KD = 256; F8 = 128; } } } while (0)
#define TD_LOAD(V, SRC, LDN) do { const float* wp_ = (SRC) + (size_t)(lane >> 3) * (LDN) + 4 * (lane & 7); _Pragma("unroll") for (int i = 0; i < 8; ++i) V[i] = *(const f32x4*)(wp_ + (size_t)(8 * i) * (LDN)); } while (0)
#define TD_PROC(V, DST, KD, F8) do { \
            _Pragma("unroll") for (int i = 0; i < 8; ++i) { LAS float* d = scr + (8 * i + (lane >> 3)) * 33 + 4 * (lane & 7); d[0] = V[i].x; d[1] = V[i].y; d[2] = V[i].z; d[3] = V[i].w; } \
            LDS_WAIT(); asm volatile("" ::: "memory"); \
            if (F8) { _Pragma("unroll") for (int j = 0; j < 4; ++j) { const int n = (lane >> 3) + 8 * j; const LAS float* sp = scr + (8 * (lane & 7)) * 33 + n; \
                int w0 = 0, w1 = 0; \
                const float fs_ = (float)(F8); w0 = __builtin_amdgcn_cvt_pk_fp8_f32(f8c(sp[0 * 33] * fs_), f8c(sp[1 * 33] * fs_), w0, false); w0 = __builtin_amdgcn_cvt_pk_fp8_f32(f8c(sp[2 * 33] * fs_), f8c(sp[3 * 33] * fs_), w0, true); \
                w1 = __builtin_amdgcn_cvt_pk_fp8_f32(f8c(sp[4 * 33] * fs_), f8c(sp[5 * 33] * fs_), w1, false); w1 = __builtin_amdgcn_cvt_pk_fp8_f32(f8c(sp[6 * 33] * fs_), f8c(sp[7 * 33] * fs_), w1, true); \
                *(u32x2*)((unsigned char*)(DST) + (size_t)n * (KD) + 8 * (lane & 7)) = (u32x2){(unsigned)w0, (unsigned)w1}; } } \
            else { _Pragma("unroll") for (int j = 0; j < 4; ++j) { const int n = (lane >> 3) + 8 * j; const LAS float* sp = scr + (8 * (lane & 7)) * 33 + n; \
                u32x4 o; o.x = cvtpk(sp[0 * 33], sp[1 * 33]); o.y = cvtpk(sp[2 * 33], sp[3 * 33]); o.z = cvtpk(sp[4 * 33], sp[5 * 33]); o.w = cvtpk(sp[6 * 33], sp[7 * 33]); \
                *(u32x4*)((DST) + (size_t)n * (KD) + 8 * (lane & 7)) = o; } } \
            LDS_WAIT(); asm volatile("" ::: "memory"); } while (0)
        const float* srcA = nullptr; const float* srcB = nullptr; bf16_t* dstA = nullptr; bf16_t* dstB = nullptr; int ldA = 0, ldB = 0, kdA = 0, kdB = 0, f8A = 0, f8B = 0;
        f32x4 vA[8], vB[8];
        int it = 2 * gw;
        if (it < NIT) { TD_GET(it, srcA, ldA, dstA, kdA, f8A); TD_GET(it + 1, srcB, ldB, dstB, kdB, f8B); TD_LOAD(vA, srcA, ldA); TD_LOAD(vB, srcB, ldB); }
        for (; it < NIT; it += 2 * NGW) {
            const float* srcAn = srcA; const float* srcBn = srcB; bf16_t* dstAn = dstA; bf16_t* dstBn = dstB; int ldAn = ldA, ldBn = ldB, kdAn = kdA, kdBn = kdB, f8An = f8A, f8Bn = f8B;
            f32x4 vAn[8], vBn[8];
            const bool has_next = it + 2 * NGW < NIT;
            if (has_next) { TD_GET(it + 2 * NGW, srcAn, ldAn, dstAn, kdAn, f8An); TD_GET(it + 2 * NGW + 1, srcBn, ldBn, dstBn, kdBn, f8Bn); TD_LOAD(vAn, srcAn, ldAn); TD_LOAD(vBn, srcBn, ldBn); }
            TD_PROC(vA, dstA, kdA, f8A);
            TD_PROC(vB, dstB, kdB, f8B);
            if (has_next) {
#pragma unroll
                for (int i = 0; i < 8; ++i) { vA[i] = vAn[i]; vB[i] = vBn[i]; }
                srcA = srcAn; srcB = srcBn; dstA = dstAn; dstB = dstBn; ldA = ldAn; ldB = ldBn; kdA = kdAn; kdB = kdBn; f8A = f8An; f8B = f8Bn; }
        }
#undef TD_PROC
#undef TD_GET
#undef TD_LOAD
    }
    {
        bf16_t* wrh = (bf16_t*)(F.ws + WS_SMALL + SM_WRH); bf16_t* wrl = (bf16_t*)(F.ws + WS_SMALL + SM_WRL);
        const float* wr = inp(F, I_WR);
        for (int i = F.bid * 512 + F.tid; i < NE * DM; i += F.G * 512) { const int e = i >> 10, k = i & 1023; const float v = wr[k * NE + e];
            const unsigned h = cvtpk(v, 0.f) & 0xffffu; wrh[i] = (bf16_t)h; wrl[i] = (bf16_t)(cvtpk(v - bflo(h), 0.f) & 0xffffu); }
    }
}

__device__ __forceinline__ void phase1(Ctx& F) {
    const float* mod = (const float*)(F.ws + WS_SMALL + SM_MOD);
    const float* x = inp(F, I_X); const float* g1 = inp(F, I_N1G);
    bf16_t* H = (bf16_t*)(F.ws + WS_H);
    const int gw = F.bid * 8 + F.wave, NGW = F.G * 8;
    if (gw < 256) {
        const int b = gw >> 6, e = gw & 63; const float* wr = inp(F, I_WR); float a = 0.f;
#pragma unroll 4
        for (int k = F.lane; k < DM; k += 64) a += mod[b * NMOD + 3 * DM + k] * wr[k * NE + e];
        a = wave_sum(a);
        if (F.lane == 0) ((float*)(F.ws + WS_SMALL + SM_CB))[gw] = a;
    }
    if (F.bid == 32) {
        float* gvec = (float*)(F.ws + WS_SMALL + SM_GVEC); const float* g2 = inp(F, I_N2G);
        for (int i = F.tid; i < 4 * DM; i += 512) { const int b = i >> 10, k = i & 1023; gvec[i] = g2[k] * (1.f + mod[b * NMOD + 4 * DM + k]); }
    }
    for (int m0 = gw; m0 < MT; m0 += 2 * NGW) {
        const int m1 = m0 + NGW;
        const bool two = m1 < MT;
        const f32x4* xr0 = (const f32x4*)(x + (size_t)m0 * DM) + F.lane; const f32x4* xr1 = (const f32x4*)(x + (size_t)(two ? m1 : m0) * DM) + F.lane;
        f32x4 v0[4], v1[4]; float s0 = 0.f, s1 = 0.f;
#pragma unroll
        for (int j = 0; j < 4; ++j) { v0[j] = xr0[64 * j]; v1[j] = xr1[64 * j]; }
#pragma unroll
        for (int j = 0; j < 4; ++j) { s0 += (v0[j].x * v0[j].x + v0[j].y * v0[j].y) + (v0[j].z * v0[j].z + v0[j].w * v0[j].w); s1 += (v1[j].x * v1[j].x + v1[j].y * v1[j].y) + (v1[j].z * v1[j].z + v1[j].w * v1[j].w); }
        const float r0 = rsqrtf(wave_sum(s0) * (1.f / DM) + EPS), r1 = rsqrtf(wave_sum(s1) * (1.f / DM) + EPS);
        const int b0 = m0 / SEQ, b1 = (two ? m1 : m0) / SEQ;
        u32x2* o0 = (u32x2*)(H + (size_t)m0 * DM) + F.lane; u32x2* o1 = (u32x2*)(H + (size_t)(two ? m1 : m0) * DM) + F.lane;
#pragma unroll
        for (int j = 0; j < 4; ++j) {
            const int col = 4 * F.lane + 256 * j;
            const f32x4 g = *(const f32x4*)(g1 + col);
            const f32x4 h0 = (v0[j] * r0) * g * (*(const f32x4*)(mod + b0 * NMOD + DM + col) + 1.0f) + *(const f32x4*)(mod + b0 * NMOD + col);
            const f32x4 h1 = (v1[j] * r1) * g * (*(const f32x4*)(mod + b1 * NMOD + DM + col) + 1.0f) + *(const f32x4*)(mod + b1 * NMOD + col);
            u32x2 w; w.x = cvtpk(h0.x, h0.y); w.y = cvtpk(h0.z, h0.w); o0[64 * j] = w;
            if (two) { w.x = cvtpk(h1.x, h1.y); w.y = cvtpk(h1.z, h1.w); o1[64 * j] = w; }
        }
    }
}

struct ProjSched {
    const char* A; const char* Bt; int G, c; int R[2], C[2];
    __device__ __forceinline__ bool next(int i, gm::UnitD& u) {
        int pm, pn; if (!gm::static_tile(MT, 5120, G, c, i, pm, pn)) return false;
        u.a = A; u.b = Bt + (size_t)pn * 256 * 1024 * 2;
#pragma unroll
        for (int h = 0; h < 2; ++h)
#pragma unroll
            for (int j = 0; j < 2; ++j) u.va[h][j] = (unsigned)((pm * 256 + h * 128 + R[j]) * 1024 + C[j]) * 2u;
        u.e0 = pm; u.e1 = pn; u.e2 = 0; u.e3 = 0; return true;
    }
};
struct EpiProj {
    bf16_t* qsb; bf16_t* qmb; bf16_t* g; float* kbs;
    __device__ __forceinline__ void operator()(const f32x4 (&acc)[2][2][4][2], const gm::UnitD& u, int wr, int wc, int fr, int fq) const {
        const int pm = u.e0, pn = u.e1;
        bf16_t* base; int ldc, colt; float sc = 1.f;
        if (pn < 6) { base = qsb; ldc = QW; colt = pn * 256; if (pn < 2) sc = 0.125f * LOG2E; }
        else if (pn < 12) { base = qmb; ldc = QW; colt = (pn - 6) * 256; if (pn < 8) sc = 0.125f; }
        else { base = g; ldc = 2048; colt = (pn - 12) * 256; }
        const int row0 = pm * 256 + wr * 64 + fr, col0 = colt + wc * 32 + 8 * fq;
        if (pn == 8 || pn == 9) {
#pragma unroll
            for (int bj = 0; bj < 2; ++bj)
#pragma unroll
                for (int n = 0; n < 2; ++n) { f32x4 cs = (f32x4){0.f, 0.f, 0.f, 0.f};
#pragma unroll
                    for (int ai = 0; ai < 2; ++ai)
#pragma unroll
                        for (int m = 0; m < 4; ++m) cs += acc[ai][bj][m][n];
#pragma unroll
                    for (int o = 1; o < 16; o <<= 1) { cs[0] += __shfl_xor(cs[0], o); cs[1] += __shfl_xor(cs[1], o); cs[2] += __shfl_xor(cs[2], o); cs[3] += __shfl_xor(cs[3], o); }
                    if (fr == 0) { float* kd = kbs + (size_t)pm * 512 + (pn - 8) * 256 + bj * 128 + wc * 32 + 8 * fq + 4 * n;
#pragma unroll
                        for (int j = 0; j < 4; ++j) atomicAdd(kd + j, cs[j]); } }
        }
#pragma unroll
        for (int ai = 0; ai < 2; ++ai)
#pragma unroll
            for (int m = 0; m < 4; ++m) { bf16_t* rowp = base + (size_t)(row0 + ai * 128 + m * 16) * ldc + col0;
#pragma unroll
                for (int bj = 0; bj < 2; ++bj) { const f32x4 v0 = acc[ai][bj][m][0] * sc, v1 = acc[ai][bj][m][1] * sc;
                    u32x4 w; w.x = cvtpk(v0[0], v0[1]); w.y = cvtpk(v0[2], v0[3]); w.z = cvtpk(v1[0], v1[1]); w.w = cvtpk(v1[2], v1[3]);
                    *(u32x4*)(rowp + bj * 128) = w; } }
    }
};
__device__ __forceinline__ void phase2(Ctx& F) {
    ProjSched S; S.A = (const char*)(F.ws + WS_H); S.Bt = (const char*)(F.ws + WS_WINT); S.G = F.G; S.c = F.bid; gm::stage_geom(F.tid, S.R, S.C);
    EpiProj E{(bf16_t*)(F.ws + WS_QSB), (bf16_t*)(F.ws + WS_QMB), (bf16_t*)(F.ws + WS_G), (float*)(F.ws + WS_CTL + CTL_KBS)};
    gm::gemm_phase<true>(F.lds, 1024, S, E);
}

__device__ __forceinline__ int crow(int r, int hi) { return (r & 3) + 8 * (r >> 2) + 4 * hi; }
typedef short v4i16_t __attribute__((ext_vector_type(4)));
__device__ __forceinline__ s16x4 vtr(const LAS unsigned char* p) { return __builtin_bit_cast(s16x4, __builtin_amdgcn_ds_read_tr16_b64_v4i16((LAS v4i16_t*)p)); }
__device__ __forceinline__ void pv64(f32x16 (&o)[2], const LAS unsigned char* vt, int lane, const u32x4 (&pw)[4]) {
    const int hi = lane >> 5;
    const LAS unsigned char* vb = vt + ((lane >> 4) & 1) * 32 + (lane & 3) * 8 + (4 * hi + ((lane & 15) >> 2)) * 64;
#pragma unroll
    for (int d0 = 0; d0 < 2; ++d0)
#pragma unroll
        for (int ks = 0; ks < 4; ++ks) {
            const s16x4 lo = vtr(vb + d0 * 4096 + ks * 1024), hh = vtr(vb + d0 * 4096 + ks * 1024 + 512);
            const bf16x8 bv = (bf16x8){lo[0], lo[1], lo[2], lo[3], hh[0], hh[1], hh[2], hh[3]};
            o[d0] = __builtin_amdgcn_mfma_f32_32x32x16_bf16(__builtin_bit_cast(bf16x8, pw[ks]), bv, o[d0], 0, 0, 0);
        }
}
__device__ __forceinline__ void store_o_tile(const f32x16 (&o)[2], LAS unsigned char* stgb, int lane, bf16_t* dst0, size_t row_pitch) {
    const int r32 = lane & 31, hi = lane >> 5;
    LAS bf16_t* stg = (LAS bf16_t*)stgb;
#pragma unroll
    for (int r = 0; r < 16; ++r) { const int orow = crow(r, hi);
#pragma unroll
        for (int d0 = 0; d0 < 2; ++d0) stg[orow * 64 + d0 * 32 + r32] = (bf16_t)(cvtpk(o[d0][r], 0.f) & 0xffffu); }
    LDS_WAIT();
#pragma unroll
    for (int i = 0; i < 4; ++i) { const int row = i * 8 + (lane >> 3), ch = lane & 7; const u32x4 v = *(const LAS u32x4*)(stg + row * 64 + ch * 8); *(u32x4*)(dst0 + (size_t)row * row_pitch + ch * 8) = v; }
    LDS_WAIT();
}

template <bool MASKED>
__device__ __forceinline__ void sb_tile(const f32x16 (&z)[2], float& P, u32x4 (&pw)[4], int k0, int qpos, int hi) {
    f32x16 be[2], nb[2];
#pragma unroll
    for (int p = 0; p < 2; ++p)
#pragma unroll
        for (int r = 0; r < 16; ++r) {
            const float zz = __builtin_amdgcn_fmed3f(z[p][r], -126.f, 126.f);
            const float t = __builtin_amdgcn_exp2f(-zz), b_ = __builtin_amdgcn_rcpf(1.f + t);
            float n_ = t * b_, bb = b_;
            if (MASKED) { const bool valid = (k0 + 32 * p + crow(r, hi)) < qpos; n_ = valid ? n_ : 1.f; bb = valid ? bb : 0.f; }
            be[p][r] = bb; nb[p][r] = n_;
        }
    float Gp[8], PG[8], off[8];
#pragma unroll
    for (int idx = 0; idx < 8; ++idx) { const int p = idx >> 2, g4 = (idx & 3) * 4; Gp[idx] = (nb[p][g4] * nb[p][g4 + 1]) * (nb[p][g4 + 2] * nb[p][g4 + 3]); }
#pragma unroll
    for (int idx = 0; idx < 8; ++idx) PG[idx] = __shfl_xor(Gp[idx], 32);
    float run = P;
#pragma unroll
    for (int idx = 7; idx >= 0; --idx) { off[idx] = hi ? run : run * PG[idx]; run *= (Gp[idx] * PG[idx]); }
    P = run;
#pragma unroll
    for (int idx = 0; idx < 8; ++idx) { const int p = idx >> 2, g4 = (idx & 3) * 4; float c = off[idx]; float a[4];
#pragma unroll
        for (int j = 3; j >= 0; --j) { a[j] = be[p][g4 + j] * c; c *= nb[p][g4 + j]; }
        pw[idx >> 1][(idx & 1) * 2] = cvtpk(a[0], a[1]); pw[idx >> 1][(idx & 1) * 2 + 1] = cvtpk(a[2], a[3]); }
}
__device__ __forceinline__ void sb_unit(Ctx& F, int bh, int qt, LAS unsigned char* vl) {
    const int lane = F.lane, r32 = lane & 31, hi = lane >> 5;
    const int b = bh >> 3, h = bh & 7, q0 = qt * 32, qpos = q0 + r32;
    const bf16_t* base = (const bf16_t*)(F.ws + WS_QSB) + (size_t)b * SEQ * QW + h * 64;
    const bf16_t* Kb = base + 512 + (size_t)r32 * QW + hi * 8; const bf16_t* Vb = base + 1024 + (size_t)(lane >> 2) * QW + (lane & 3) * 8;
    bf16x8 qr[4];
#pragma unroll
    for (int d0 = 0; d0 < 4; ++d0) qr[d0] = *(const bf16x8*)(base + (size_t)qpos * QW + d0 * 16 + hi * 8);
    float P = 1.f; f32x16 o[2]; o[0] = f32x16{}; o[1] = f32x16{};
    bf16x8 kfn[8];
    const int kt0 = q0 >> 6; int kt = kt0, cur = 0;
#define SB_PREFETCH(KT, BUF) do { const size_t ko_ = (size_t)(KT) * 64 * QW; \
        _Pragma("unroll") for (int d0 = 0; d0 < 4; ++d0) _Pragma("unroll") for (int hf = 0; hf < 2; ++hf) kfn[2 * d0 + hf] = *(const bf16x8*)(Kb + ko_ + (size_t)(32 * hf) * QW + d0 * 16); \
        _Pragma("unroll") for (int p = 0; p < 8; ++p) __builtin_amdgcn_global_load_lds((const unsigned*)(Vb + ko_ + (size_t)(16 * (p & 3)) * QW + (p >> 2) * 32), (LAS unsigned*)(vl + (BUF) * 8192 + p * 1024), 16, 0, 0); } while (0)
    SB_PREFETCH(kt, 0);
#pragma unroll 1
    for (; kt >= 0; --kt) {
        if (__all(P == 0.f)) break;
        f32x16 z[2]; z[0] = f32x16{}; z[1] = f32x16{};
#pragma unroll
        for (int d0 = 0; d0 < 4; ++d0) { z[0] = __builtin_amdgcn_mfma_f32_32x32x16_bf16(kfn[2 * d0], qr[d0], z[0], 0, 0, 0); z[1] = __builtin_amdgcn_mfma_f32_32x32x16_bf16(kfn[2 * d0 + 1], qr[d0], z[1], 0, 0, 0); }
        asm volatile("" : "+v"(z[0]), "+v"(z[1]));
        { const int ktn = kt > 0 ? kt - 1 : 0; SB_PREFETCH(ktn, cur ^ 1); }
        u32x4 pw[4];
        if (kt == kt0) sb_tile<true>(z, P, pw, kt * 64, qpos, hi); else sb_tile<false>(z, P, pw, kt * 64, qpos, hi);
        asm volatile("s_waitcnt vmcnt(16)" ::: "memory");
        pv64(o, vl + cur * 8192, lane, pw);
        cur ^= 1;
    }
#undef SB_PREFETCH
    asm volatile("s_waitcnt vmcnt(0)" ::: "memory");
    bf16_t* dst = (bf16_t*)(F.ws + WS_OB) + (size_t)(b * SEQ + q0) * 1024 + h * 64;
    store_o_tile(o, vl, lane, dst, 1024);
}
__device__ __forceinline__ void sb_units(Ctx& F) {
    const int gw = F.bid * 8 + F.wave, NGW = F.G * 8;
    LAS unsigned char* vl = F.lds + F.wave * 16384;
    for (int u = gw; u < 32 * 256; u += NGW) sb_unit(F, u >> 8, u & 255, vl);
}

constexpr int MO_LUT = 0, MO_PRE = 4224, MO_WSF = 8320, MO_ENT = 12416, MO_ST = 16368;
__device__ __forceinline__ int mb_list_off(int j) { return 256 * (31 * j - (j * (j - 1)) / 2); }
constexpr int MB_LIST_STRIDE = 126976;
__device__ __forceinline__ int t5_bucket_dev(int n) {
    if (n < 16) return n;
    int large = 16 + (int)(logf((float)n / 16.f) / 2.0794415416798357f * 16.f);
    return large < 31 ? large : 31;
}
__device__ __forceinline__ void build_lut(Ctx& F) {
    LAS float* lut = (LAS float*)(F.lds + MISC_OFF + MO_LUT);
    for (int i = F.tid; i < 8 * 132; i += 512) { const int h = i / 132, d = i % 132; lut[i] = inp(F, I_RELB)[h * 32 + t5_bucket_dev(d < 128 ? d : 128)] * LOG2E; }
}
__device__ __forceinline__ void phase4(Ctx& F) {
    LAS int* lcnt = (LAS int*)(F.lds + MISC_OFF + MO_PRE); LAS int* lbase = lcnt + 32;
    const float* kbar = (const float*)(F.ws + WS_CTL + CTL_KBS);
    unsigned* cur = (unsigned*)(F.ws + WS_CTL) + CW_MBCUR;
    unsigned short* lists = (unsigned short*)(F.ws + WS_LMB);
    const int lane = F.lane, r32 = lane & 31, hi = lane >> 5;
    for (int u = F.bid; u < 32 * 31; u += F.G) {
        const int bh = u / 31, i = 1 + (u % 31), b = bh >> 3, h = bh & 7;
        if (F.tid < 32) lcnt[F.tid] = 0;
        __syncthreads();
        const int qpos = i * 256 + F.wave * 32 + r32;
        const float* kp = kbar + (size_t)(b * 32 + r32) * 512 + h * 64 + hi * 8;
        const bf16_t* qp = (const bf16_t*)(F.ws + WS_QMB) + (size_t)(b * SEQ + qpos) * QW + h * 64 + hi * 8;
        f32x16 gt = f32x16{};
#pragma unroll
        for (int s4 = 0; s4 < 4; ++s4) {
            const f32x4 k0 = *(const f32x4*)(kp + 16 * s4), k1 = *(const f32x4*)(kp + 16 * s4 + 4);
            const bf16x8 qf = *(const bf16x8*)(qp + 16 * s4);
            const unsigned a0 = cvtpk(k0.x, k0.y), a1 = cvtpk(k0.z, k0.w), a2 = cvtpk(k1.x, k1.y), a3 = cvtpk(k1.z, k1.w);
            const u32x4 kh = (u32x4){a0, a1, a2, a3};
            const u32x4 kl = (u32x4){cvtpk(k0.x - bflo(a0), k0.y - bfhi(a0)), cvtpk(k0.z - bflo(a1), k0.w - bfhi(a1)), cvtpk(k1.x - bflo(a2), k1.y - bfhi(a2)), cvtpk(k1.z - bflo(a3), k1.w - bfhi(a3))};
            gt = __builtin_amdgcn_mfma_f32_32x32x16_bf16(__builtin_bit_cast(bf16x8, kl), qf, gt, 0, 0, 0);
            gt = __builtin_amdgcn_mfma_f32_32x32x16_bf16(__builtin_bit_cast(bf16x8, kh), qf, gt, 0, 0, 0);
        }
        float v0 = -INFINITY, v1 = -INFINITY, v2 = -INFINITY; int j0 = 64, j1 = 64, j2 = 64;
#pragma unroll
        for (int r = 0; r < 16; ++r) { const int j = crow(r, hi); const float g = j < i ? gt[r] : -INFINITY;
            if (g > v0) { v2 = v1; j2 = j1; v1 = v0; j1 = j0; v0 = g; j0 = j; }
            else if (g > v1) { v2 = v1; j2 = j1; v1 = g; j1 = j; }
            else if (g > v2) { v2 = g; j2 = j; } }
        {
            const float pv[3] = {__shfl_xor(v0, 32), __shfl_xor(v1, 32), __shfl_xor(v2, 32)}; const int pj[3] = {__shfl_xor(j0, 32), __shfl_xor(j1, 32), __shfl_xor(j2, 32)};
#pragma unroll
            for (int t = 0; t < 3; ++t) { const float g = pv[t]; const int j = pj[t];
                if (g > v0 || (g == v0 && j < j0)) { v2 = v1; j2 = j1; v1 = v0; j1 = j0; v0 = g; j0 = j; }
                else if (g > v1 || (g == v1 && j < j1)) { v2 = v1; j2 = j1; v1 = g; j1 = j; }
                else if (g > v2 || (g == v2 && j < j2)) { v2 = g; j2 = j; } }
        }
        const int nsel = i < 3 ? i : 3;
        int r0 = 0, r1 = 0, r2 = 0;
        if (hi == 0) { r0 = lds_add(&lcnt[j0], 1); if (nsel > 1) r1 = lds_add(&lcnt[j1], 1); if (nsel > 2) r2 = lds_add(&lcnt[j2], 1); }
        __syncthreads();
        if (F.tid < i) { const int n = lcnt[F.tid]; lbase[F.tid] = n > 0 ? (int)atomicAdd(&cur[bh * 32 + F.tid], (unsigned)n) : 0; }
        __syncthreads();
        if (hi == 0) {
            unsigned short* lb = lists + (size_t)bh * MB_LIST_STRIDE;
            lb[mb_list_off(j0) + lbase[j0] + r0] = (unsigned short)(qpos | (0 << 13));
            if (nsel > 1) lb[mb_list_off(j1) + lbase[j1] + r1] = (unsigned short)(qpos | (1 << 13));
            if (nsel > 2) lb[mb_list_off(j2) + lbase[j2] + r2] = (unsigned short)(qpos | (2 << 13));
        }
    }
}
__device__ __forceinline__ void kv_dma(Ctx& F, const bf16_t* kg, const bf16_t* vg, int bufoff) {
    const int l = F.lane;
#pragma unroll
    for (int i = 0; i < 4; ++i) { const int p = 4 * F.wave + i;
        __builtin_amdgcn_global_load_lds((const unsigned*)(kg + (size_t)(8 * p + (l >> 3)) * QW + ((l & 7) ^ ((l >> 3) & 7)) * 8), (LAS unsigned*)(F.lds + bufoff + p * 1024), 16, 0, 0);
        __builtin_amdgcn_global_load_lds((const unsigned*)(vg + (size_t)((p >> 3) * 64 + (p & 3) * 16 + (l >> 2)) * QW + ((p >> 2) & 1) * 32 + (l & 3) * 8), (LAS unsigned*)(F.lds + bufoff + 32768 + p * 1024), 16, 0, 0); }
}
__device__ __forceinline__ void softmax_step(f32x16 (&t)[2], float& m, float& l, f32x16 (&o)[2], LAS float* wsf, const LAS unsigned char* vt, int lane) {
    const int r32 = lane & 31, hi = lane >> 5;
    float rm = -INFINITY;
#pragma unroll
    for (int p = 0; p < 2; ++p)
#pragma unroll
        for (int r = 0; r < 16; ++r) rm = fmaxf(rm, t[p][r]);
    rm = fmaxf(rm, __shfl_xor(rm, 32));
    const float mn = fmaxf(m, rm);
    const float f = __builtin_amdgcn_exp2f(m - mn);
    m = mn;
    float s = 0.f; u32x4 pw[4];
#pragma unroll
    for (int p = 0; p < 2; ++p)
#pragma unroll
        for (int r = 0; r < 16; ++r) { const float e = __builtin_amdgcn_exp2f(t[p][r] - mn); t[p][r] = e; s += e; }
    l = l * f + s;
#pragma unroll
    for (int idx = 0; idx < 8; ++idx) { const int p = idx >> 2, g4 = (idx & 3) * 4; pw[idx >> 1][(idx & 1) * 2] = cvtpk(t[p][g4], t[p][g4 + 1]); pw[idx >> 1][(idx & 1) * 2 + 1] = cvtpk(t[p][g4 + 2], t[p][g4 + 3]); }
    if (__any(f != 1.f)) {
        if (hi == 0) wsf[r32] = f;
        LDS_WAIT();
#pragma unroll
        for (int g = 0; g < 4; ++g) { const f32x4 fv = *(const LAS f32x4*)(wsf + 8 * g + 4 * hi);
#pragma unroll
            for (int j = 0; j < 4; ++j) { o[0][4 * g + j] *= fv[j]; o[1][4 * g + j] *= fv[j]; } }
        LDS_WAIT();
    }
    pv64(o, vt, lane, pw);
}
__device__ __forceinline__ void qkt64(f32x16 (&t)[2], const LAS unsigned char* kt, const bf16x8 (&qr)[4], int lane) {
    const int r32 = lane & 31, hi = lane >> 5;
    t[0] = f32x16{}; t[1] = f32x16{};
    const LAS unsigned char* rp = kt + r32 * 128;
#pragma unroll
    for (int d0 = 0; d0 < 4; ++d0) {
        const int pos = ((2 * d0 + hi) ^ (r32 & 7)) * 16;
        const bf16x8 k0 = *(const LAS bf16x8*)(rp + pos), k1 = *(const LAS bf16x8*)(rp + 4096 + pos);
        t[0] = __builtin_amdgcn_mfma_f32_32x32x16_bf16(k0, qr[d0], t[0], 0, 0, 0); t[1] = __builtin_amdgcn_mfma_f32_32x32x16_bf16(k1, qr[d0], t[1], 0, 0, 0);
    }
}
__device__ __forceinline__ void phase5(Ctx& F) {
    LAS int* pre = (LAS int*)(F.lds + MISC_OFF + MO_PRE);
    LAS int* wtot = (LAS int*)(F.lds + MISC_OFF + MO_ENT);
    const unsigned* cur = (const unsigned*)(F.ws + WS_CTL) + CW_MBCUR;
    build_lut(F);
    int total;
    {
        const int p0 = 2 * F.tid, p1 = p0 + 1;
        const int c0 = p0 < 992 ? (int)((cur[(p0 / 31) * 32 + (p0 % 31)] + 255u) >> 8) : 0;
        const int c1 = p1 < 992 ? (int)((cur[(p1 / 31) * 32 + (p1 % 31)] + 255u) >> 8) : 0;
        const int s = c0 + c1; int v = s;
#pragma unroll
        for (int o = 1; o < 64; o <<= 1) { const int n = __shfl_up(v, o); if (F.lane >= o) v += n; }
        if (F.lane == 63) wtot[248 + F.wave] = v;
        __syncthreads();
        int woff = 0; total = 0;
#pragma unroll
        for (int w = 0; w < 8; ++w) { const int x = wtot[248 + w]; if (w < F.wave) woff += x; total += x; }
        const int excl = woff + v - s;
        pre[p0] = excl; pre[p1] = excl + c0;
        __syncthreads();
    }
    const unsigned short* lists = (const unsigned short*)(F.ws + WS_LMB);
    LAS float* wsf = (LAS float*)(F.lds + MISC_OFF + MO_WSF) + F.wave * 128;
    LAS int* ent = (LAS int*)(F.lds + MISC_OFF + MO_ENT) + F.wave * 32;
    const int lane = F.lane, r32 = lane & 31, hi = lane >> 5;
#define P5_UNIT(U, BH, J, C) do { int lo_ = 0, hi_ = 992; while (hi_ - lo_ > 1) { const int mid = (lo_ + hi_) >> 1; if (pre[mid] <= (U)) lo_ = mid; else hi_ = mid; } BH = lo_ / 31; J = lo_ % 31; C = (U) - pre[lo_]; } while (0)
#define P5_DMA(BH, J, BUF) do { const bf16_t* b_ = (const bf16_t*)(F.ws + WS_QMB) + (size_t)((BH) >> 3) * SEQ * QW + ((BH) & 7) * 64; kv_dma(F, b_ + 512 + (size_t)((J) * 256) * QW, b_ + 1024 + (size_t)((J) * 256) * QW, (BUF) * 65536); } while (0)
#define P5_ENTRY(BH, J, C, ACT, VALID, ENTRY) do { const int n_ = (int)cur[(BH) * 32 + (J)]; const int e0_ = (C) * 256 + F.wave * 32; ACT = e0_ < n_; VALID = ACT && (e0_ + r32) < n_; \
        const unsigned short* lb_ = lists + (size_t)(BH) * MB_LIST_STRIDE + mb_list_off(J); ENTRY = ACT ? (int)lb_[VALID ? e0_ + r32 : e0_] : 0; } while (0)
#define P5_QLOAD(BH, ENTRY, Q) do { const bf16_t* b_ = (const bf16_t*)(F.ws + WS_QMB) + (size_t)((BH) >> 3) * SEQ * QW + ((BH) & 7) * 64 + (size_t)((ENTRY) & 8191) * QW + hi * 8; \
        _Pragma("unroll") for (int d0 = 0; d0 < 4; ++d0) Q[d0] = *(const bf16x8*)(b_ + d0 * 16); } while (0)
    int u = F.bid, bh = 0, j = 0, c = 0, buf = 0;
    bool act = false, valid = false; int entry = 0; bf16x8 qr[4];
    if (u < total) { P5_UNIT(u, bh, j, c); P5_DMA(bh, j, 0); P5_ENTRY(bh, j, c, act, valid, entry); P5_QLOAD(bh, entry, qr); }
    for (; u < total; u += F.G) {
        const int un = u + F.G; int bhn = 0, jn = 0, cn = 0;
        const bool has_next = un < total;
        if (has_next) P5_UNIT(un, bhn, jn, cn);
        const int h = bh & 7;
        const int qpos = entry & 8191, slot = entry >> 13;
        asm volatile("s_waitcnt vmcnt(0)" ::: "memory");
        __syncthreads();
        bool actn = false, validn = false; int entryn = 0; bf16x8 qn[4];
        if (has_next) { P5_DMA(bhn, jn, buf ^ 1); P5_ENTRY(bhn, jn, cn, actn, validn, entryn); }
        const LAS unsigned char* kimg = F.lds + buf * 65536; const LAS unsigned char* vimg = kimg + 32768;
        if (act) {
            if (hi == 0) ent[r32] = valid ? entry : -1;
            float m = -INFINITY, l = 0.f; f32x16 o[2]; o[0] = f32x16{}; o[1] = f32x16{};
            const LAS float* lut = (const LAS float*)(F.lds + MISC_OFF + MO_LUT) + h * 132;
            const float bfar = lut[128];
#pragma unroll 1
            for (int st = 0; st < 4; ++st) {
                if (st == 2 && has_next) P5_QLOAD(bhn, entryn, qn);
                f32x16 t[2]; qkt64(t, kimg + st * 8192, qr, lane);
                const int kbase = j * 256 + st * 64;
                const bool far = __all(qpos - (kbase + 63) >= 128);
                if (far) {
#pragma unroll
                    for (int pp = 0; pp < 2; ++pp)
#pragma unroll
                        for (int r = 0; r < 16; ++r) t[pp][r] = t[pp][r] * LOG2E + bfar;
                } else {
#pragma unroll
                    for (int pp = 0; pp < 2; ++pp)
#pragma unroll
                        for (int r = 0; r < 16; ++r) { int d = qpos - (kbase + 32 * pp + crow(r, hi)); d = d < 128 ? d : 128; d = d > 0 ? d : 0; t[pp][r] = t[pp][r] * LOG2E + lut[d]; }
                }
                softmax_step(t, m, l, o, wsf, vimg + st * 8192, lane);
            }
            l += __shfl_xor(l, 32);
            const float rl = 1.f / l;
            if (hi == 0) { wsf[r32] = rl; if (valid) ((float*)(F.ws + WS_PLSE))[((size_t)bh * SEQ + qpos) * 3 + slot] = m + __log2f(l); }
            LDS_WAIT();
            {
                LAS bf16_t* stg = (LAS bf16_t*)(F.lds + MISC_OFF + MO_STG + F.wave * 2048);
                bf16_t* po = (bf16_t*)(F.ws + WS_PO);
#pragma unroll
                for (int d0 = 0; d0 < 2; ++d0) {
#pragma unroll
                    for (int r = 0; r < 16; ++r) { const int q = crow(r, hi); stg[q * 32 + r32] = (bf16_t)(cvtpk(o[d0][r] * wsf[q], 0.f) & 0xffffu); }
                    LDS_WAIT();
#pragma unroll
                    for (int it2 = 0; it2 < 2; ++it2) { const int row = it2 * 16 + (lane >> 2), ch = lane & 3; const int en = ent[row];
                        const u32x4 v = *(const LAS u32x4*)(stg + row * 32 + ch * 8);
                        if (en >= 0) *(u32x4*)(po + (((size_t)bh * SEQ + (en & 8191)) * 3 + (en >> 13)) * 64 + d0 * 32 + ch * 8) = v; }
                    LDS_WAIT();
                }
            }
        } else if (has_next) { P5_QLOAD(bhn, entryn, qn); }
        bh = bhn; j = jn; c = cn; buf ^= 1; act = actn; valid = validn; entry = entryn;
#pragma unroll
        for (int d0 = 0; d0 < 4; ++d0) qr[d0] = qn[d0];
    }
#undef P5_ENTRY
#undef P5_QLOAD
#undef P5_UNIT
#undef P5_DMA
    asm volatile("s_waitcnt vmcnt(0)" ::: "memory");
    __syncthreads();
}
__device__ __forceinline__ void phase6(Ctx& F) {
    build_lut(F);
    LAS float* wsf = (LAS float*)(F.lds + MISC_OFF + MO_WSF) + F.wave * 128;
    const int lane = F.lane, r32 = lane & 31, hi = lane >> 5, w = F.wave;
#define P6_DMA(U, BUF) do { const int bh_ = (U) >> 5, i_ = 31 - ((U) & 31); const bf16_t* b_ = (const bf16_t*)(F.ws + WS_QMB) + (size_t)(bh_ >> 3) * SEQ * QW + (bh_ & 7) * 64; \
        kv_dma(F, b_ + 512 + (size_t)(i_ * 256) * QW, b_ + 1024 + (size_t)(i_ * 256) * QW, (BUF) * 65536); } while (0)
    int buf = 0;
    if (F.bid < 32 * 32) P6_DMA(F.bid, 0);
    for (int u = F.bid; u < 32 * 32; u += F.G) {
        const int bh = u >> 5, i = 31 - (u & 31), b = bh >> 3, h = bh & 7;
        const bf16_t* base = (const bf16_t*)(F.ws + WS_QMB) + (size_t)b * SEQ * QW + h * 64;
        const int ql = w * 32 + r32, qpos = i * 256 + ql;
        bf16x8 qr[4];
#pragma unroll
        for (int d0 = 0; d0 < 4; ++d0) qr[d0] = *(const bf16x8*)(base + (size_t)qpos * QW + d0 * 16 + hi * 8);
        const int nsel = i < 3 ? i : 3;
        const float* plse = (const float*)(F.ws + WS_PLSE) + ((size_t)bh * SEQ + qpos) * 3;
        float ls0 = -INFINITY, ls1 = -INFINITY, ls2 = -INFINITY;
        if (nsel > 0) ls0 = plse[0]; if (nsel > 1) ls1 = plse[1]; if (nsel > 2) ls2 = plse[2];
        asm volatile("s_waitcnt vmcnt(0)" ::: "memory");
        __syncthreads();
        if (u + F.G < 32 * 32) P6_DMA(u + F.G, buf ^ 1);
        const LAS unsigned char* kimg = F.lds + buf * 65536; const LAS unsigned char* vimg = kimg + 32768;
        float m = -INFINITY, l = 0.f; f32x16 o[2]; o[0] = f32x16{}; o[1] = f32x16{};
        const LAS float* lut = (const LAS float*)(F.lds + MISC_OFF + MO_LUT) + h * 132;
        const int nst = (w >> 1) + 1;
#pragma unroll 1
        for (int st = 0; st < nst; ++st) {
            f32x16 t[2]; qkt64(t, kimg + st * 8192, qr, lane);
#pragma unroll
            for (int pp = 0; pp < 2; ++pp)
#pragma unroll
                for (int r = 0; r < 16; ++r) { const int d = ql - (st * 64 + 32 * pp + crow(r, hi)); const int dc = d < 128 ? (d > 0 ? d : 0) : 128; const float v = t[pp][r] * LOG2E + lut[dc]; t[pp][r] = d >= 0 ? v : -INFINITY; }
            softmax_step(t, m, l, o, wsf, vimg + st * 8192, lane);
        }
        l += __shfl_xor(l, 32);
        const float M = fmaxf(fmaxf(m, ls0), fmaxf(ls1, ls2));
        const float eo = __builtin_amdgcn_exp2f(m - M), e0 = __builtin_amdgcn_exp2f(ls0 - M), e1 = __builtin_amdgcn_exp2f(ls1 - M), e2 = __builtin_amdgcn_exp2f(ls2 - M);
        const float rden = 1.f / (l * eo + e0 + e1 + e2);
        if (hi == 0) *(LAS f32x4*)(wsf + 4 * r32) = (f32x4){eo * rden, e0 * rden, e1 * rden, e2 * rden};
        LDS_WAIT();
#pragma unroll
        for (int r = 0; r < 16; ++r) { const float fo = wsf[4 * crow(r, hi)]; o[0][r] *= fo; o[1][r] *= fo; }
        __syncthreads();
        {
            LAS bf16_t* stg = (LAS bf16_t*)(F.lds + buf * 65536 + w * 4096);
#pragma unroll
            for (int r = 0; r < 16; ++r) { const int orow = crow(r, hi);
#pragma unroll
                for (int d0 = 0; d0 < 2; ++d0) stg[orow * 64 + d0 * 32 + r32] = (bf16_t)(cvtpk(o[d0][r], 0.f) & 0xffffu); }
            LDS_WAIT();
            const bf16_t* po = (const bf16_t*)(F.ws + WS_PO) + ((size_t)bh * SEQ + i * 256 + w * 32) * 3 * 64;
            bf16_t* dst = (bf16_t*)(F.ws + WS_OB) + (size_t)(b * SEQ + i * 256 + w * 32) * 1024 + 512 + h * 64;
#pragma unroll
            for (int it4 = 0; it4 < 4; ++it4) { const int row = it4 * 8 + (lane >> 3), ch = lane & 7;
                const u32x4 ov = *(const LAS u32x4*)(stg + row * 64 + ch * 8);
                float a[8] = {bflo(ov.x), bfhi(ov.x), bflo(ov.y), bfhi(ov.y), bflo(ov.z), bfhi(ov.z), bflo(ov.w), bfhi(ov.w)};
                const f32x4 fc = *(const LAS f32x4*)(wsf + 4 * row);
#pragma unroll
                for (int sl = 0; sl < 3; ++sl) if (sl < nsel) { const u32x4 pv = *(const u32x4*)(po + (size_t)(row * 3 + sl) * 64 + ch * 8); const float f = fc[1 + sl];
                    a[0] += f * bflo(pv.x); a[1] += f * bfhi(pv.x); a[2] += f * bflo(pv.y); a[3] += f * bfhi(pv.y); a[4] += f * bflo(pv.z); a[5] += f * bfhi(pv.z); a[6] += f * bflo(pv.w); a[7] += f * bfhi(pv.w); }
                u32x4 w4; w4.x = cvtpk(a[0], a[1]); w4.y = cvtpk(a[2], a[3]); w4.z = cvtpk(a[4], a[5]); w4.w = cvtpk(a[6], a[7]);
                *(u32x4*)(dst + (size_t)row * 1024 + ch * 8) = w4; }
            LDS_WAIT();
        }
        buf ^= 1;
    }
#undef P6_DMA
    asm volatile("s_waitcnt vmcnt(0)" ::: "memory");
    __syncthreads();
}

struct BranchSched {
    const char* A; const char* Bt; int G, c; int R[2], C[2];
    __device__ __forceinline__ bool next(int i, gm::UnitD& u) {
        int pm, pn; if (!gm::static_tile(MT, 1024, G, c, i, pm, pn)) return false;
        u.a = A; u.b = Bt + (size_t)(pn * 256) * 1024 * 2;
#pragma unroll
        for (int h = 0; h < 2; ++h)
#pragma unroll
            for (int j = 0; j < 2; ++j) u.va[h][j] = (unsigned)((pm * 256 + h * 128 + R[j]) * 1024 + C[j]) * 2u;
        u.e0 = pm; u.e1 = pn; u.e2 = 0; u.e3 = 0; return true;
    }
};
struct EpiBranch {
    const bf16_t* g; bf16_t* merged;
    static __device__ __forceinline__ float ratio(float gs, float gm_) { return (1.f + fminf(__expf(-gm_), 1e30f)) * __builtin_amdgcn_rcpf(1.f + __expf(-gs)); }
    __device__ __forceinline__ void mid(f32x4 (&acc)[2][2][4][2], const gm::UnitD& u, int wr, int wc, int fr, int fq) const {
        const bf16_t* gp = g + (size_t)(u.e0 * 256 + wr * 64 + fr) * 2048 + u.e1 * 256 + wc * 32 + 8 * fq;
#pragma unroll
        for (int ai = 0; ai < 2; ++ai)
#pragma unroll
            for (int m = 0; m < 4; m += 2) {
                asm volatile("" : "+v"(gp) :: "memory");
                u32x4 gs[2][2], gq[2][2];
#pragma unroll
                for (int mm = 0; mm < 2; ++mm)
#pragma unroll
                    for (int bj = 0; bj < 2; ++bj) { gs[mm][bj] = *(const u32x4*)(gp + (size_t)mm * 16 * 2048 + bj * 128); gq[mm][bj] = *(const u32x4*)(gp + (size_t)mm * 16 * 2048 + 1024 + bj * 128); }
#pragma unroll
                for (int mm = 0; mm < 2; ++mm)
#pragma unroll
                    for (int bj = 0; bj < 2; ++bj) { const u32x4 a = gs[mm][bj], b = gq[mm][bj];
                        f32x4& c0 = acc[ai][bj][m + mm][0]; f32x4& c1 = acc[ai][bj][m + mm][1];
                        c0[0] *= ratio(bflo(a.x), bflo(b.x)); c0[1] *= ratio(bfhi(a.x), bfhi(b.x)); c0[2] *= ratio(bflo(a.y), bflo(b.y)); c0[3] *= ratio(bfhi(a.y), bfhi(b.y));
                        c1[0] *= ratio(bflo(a.z), bflo(b.z)); c1[1] *= ratio(bfhi(a.z), bfhi(b.z)); c1[2] *= ratio(bflo(a.w), bflo(b.w)); c1[3] *= ratio(bfhi(a.w), bfhi(b.w));
                        asm volatile("" : "+v"(c0), "+v"(c1) :: "memory"); }
                gp += (m == 2 ? 96 : 32) * 2048; }
    }
    __device__ __forceinline__ void operator()(const f32x4 (&acc)[2][2][4][2], const gm::UnitD& u, int wr, int wc, int fr, int fq) const {
        const int row0 = u.e0 * 256 + wr * 64 + fr, col0 = u.e1 * 256 + wc * 32 + 8 * fq;
#pragma unroll
        for (int ai = 0; ai < 2; ++ai)
#pragma unroll
            for (int m = 0; m < 4; ++m) { const size_t row = (size_t)(row0 + ai * 128 + m * 16);
#pragma unroll
                for (int bj = 0; bj < 2; ++bj) { const u32x4 gm_ = *(const u32x4*)(g + row * 2048 + 1024 + col0 + bj * 128);
                    const float b[8] = {bflo(gm_.x), bfhi(gm_.x), bflo(gm_.y), bfhi(gm_.y), bflo(gm_.z), bfhi(gm_.z), bflo(gm_.w), bfhi(gm_.w)};
                    float r[8];
#pragma unroll
                    for (int j = 0; j < 8; ++j) r[j] = acc[ai][bj][m][j >> 2][j & 3] * __builtin_amdgcn_rcpf(1.f + fminf(__expf(-b[j]), 1e30f));
                    u32x4 w; w.x = cvtpk(r[0], r[1]); w.y = cvtpk(r[2], r[3]); w.z = cvtpk(r[4], r[5]); w.w = cvtpk(r[6], r[7]);
                    *(u32x4*)(merged + row * 1024 + col0 + bj * 128) = w; } }
    }
};
__device__ __forceinline__ void phase7(Ctx& F) {
    BranchSched S; S.A = (const char*)(F.ws + WS_OB); S.Bt = (const char*)(F.ws + WS_WBRT); S.G = F.G; S.c = F.bid; gm::stage_geom(F.tid, S.R, S.C);
    EpiBranch E{(const bf16_t*)(F.ws + WS_G), (bf16_t*)(F.ws + WS_MERGED)};
    gm::gemm_phase<true, true>(F.lds, 1024, S, E);
}
struct OutSched {
    const char* A; const char* Bt; int G, c; int R[2], C[2];
    __device__ __forceinline__ bool next(int i, gm::UnitD& u) {
        int pm, pn; if (!gm::static_tile(MT, 1024, G, c, i, pm, pn)) return false;
        u.a = A; u.b = Bt + (size_t)pn * 256 * 1024 * 2;
#pragma unroll
        for (int h = 0; h < 2; ++h)
#pragma unroll
            for (int j = 0; j < 2; ++j) u.va[h][j] = (unsigned)((pm * 256 + h * 128 + R[j]) * 1024 + C[j]) * 2u;
        u.e0 = pm; u.e1 = pn; u.e2 = 0; u.e3 = 0; return true;
    }
};
struct EpiOut {
    const float* x; const float* mod; float* out;
    __device__ __forceinline__ void operator()(const f32x4 (&acc)[2][2][4][2], const gm::UnitD& u, int wr, int wc, int fr, int fq) const {
        const int pm = u.e0, pn = u.e1, b = (pm * 256) / SEQ;
        const int row0 = pm * 256 + wr * 64 + fr, col0 = pn * 256 + wc * 32 + 4 * fq;
        f32x4 gt[2][2];
#pragma unroll
        for (int bj = 0; bj < 2; ++bj)
#pragma unroll
            for (int n = 0; n < 2; ++n) gt[bj][n] = *(const f32x4*)(mod + b * NMOD + 2 * DM + col0 + bj * 128 + n * 16);
#pragma unroll
        for (int ai = 0; ai < 2; ++ai)
#pragma unroll
            for (int m = 0; m < 4; ++m) { const size_t off = (size_t)(row0 + ai * 128 + m * 16) * DM + col0;
#pragma unroll
                for (int bj = 0; bj < 2; ++bj)
#pragma unroll
                    for (int n = 0; n < 2; ++n) { const f32x4 xv = *(const f32x4*)(x + off + bj * 128 + n * 16); *(f32x4*)(out + off + bj * 128 + n * 16) = xv + gt[bj][n] * acc[ai][bj][m][n]; } }
    }
};
__device__ __forceinline__ void phase8(Ctx& F) {
    OutSched S; S.A = (const char*)(F.ws + WS_MERGED); S.Bt = (const char*)(F.ws + WS_WOUTT); S.G = F.G; S.c = F.bid; gm::stage_geom(F.tid, S.R, S.C);
    EpiOut E{inp(F, I_X), (const float*)(F.ws + WS_SMALL + SM_MOD), F.out};
    gm::gemm_phase<false>(F.lds, 1024, S, E);
}

constexpr int NR_SSQ = MO_PRE + 1024;
constexpr int NR_RS = MO_PRE + 3072;
__device__ __forceinline__ void phase_n2r(Ctx& F, int rr) {
    const float* x1 = F.out; const float* gvec = (const float*)(F.ws + WS_SMALL + SM_GVEC); const float* cb = (const float*)(F.ws + WS_SMALL + SM_CB);
    const float* mod = (const float*)(F.ws + WS_SMALL + SM_MOD); const float* rbias = inp(F, I_RB);
    unsigned char* H2 = (unsigned char*)(F.ws + WS_H2) + (size_t)rr * RT * DM; int* tokl = (int*)(F.ws + WS_TOKL) + (size_t)rr * 64 * RT; float* wl = (float*)(F.ws + WS_WL) + (size_t)rr * 64 * RT; int* tpos = (int*)(F.ws + WS_TPOS) + (size_t)rr * RT * 8;
    unsigned* cur = (unsigned*)(F.ws + WS_CTL) + CW_MOECUR + rr * 64;
    LAS int* lcnt = (LAS int*)(F.lds + MISC_OFF + MO_PRE); LAS int* lbase = lcnt + 64;
    LAS float* part = (LAS float*)(F.lds);
    LAS float* ssqp = (LAS float*)(F.lds + MISC_OFF + NR_SSQ); LAS float* rsl = (LAS float*)(F.lds + MISC_OFF + NR_RS);
    const int lane = F.lane, w = F.wave, i16 = lane & 15, kk = lane >> 4;
    for (int u = F.bid; u < RT / 64; u += F.G) {
        if (F.tid < 64) lcnt[F.tid] = 0;
        const int tokb = rr * RT + u * 64, b = tokb / SEQ;
        {
            bf16x8 fah[4][4], fal[4][4];
            {
                const float* gp = gvec + b * DM + 128 * w + 8 * kk;
                f32x4 gv[4][2];
#pragma unroll
                for (int s4 = 0; s4 < 4; ++s4) { gv[s4][0] = *(const f32x4*)(gp + 32 * s4); gv[s4][1] = *(const f32x4*)(gp + 32 * s4 + 4); }
#pragma unroll
                for (int tt = 0; tt < 4; ++tt) {
                    const float* xp = x1 + (size_t)(tokb + tt * 16 + i16) * DM + 128 * w + 8 * kk;
                    f32x4 xa[4][2];
#pragma unroll
                    for (int s4 = 0; s4 < 4; ++s4) { xa[s4][0] = *(const f32x4*)(xp + 32 * s4); xa[s4][1] = *(const f32x4*)(xp + 32 * s4 + 4); }
                    float ssq = 0.f;
#pragma unroll
                    for (int s4 = 0; s4 < 4; ++s4) {
                        u32x4 ah, al;
#pragma unroll
                        for (int q = 0; q < 2; ++q) { const f32x4 xv = xa[s4][q]; ssq += (xv.x * xv.x + xv.y * xv.y) + (xv.z * xv.z + xv.w * xv.w);
                            const f32x4 a = xv * gv[s4][q];
                            const unsigned h0 = cvtpk(a.x, a.y), h1 = cvtpk(a.z, a.w);
                            ah[2 * q] = h0; ah[2 * q + 1] = h1; al[2 * q] = cvtpk(a.x - bflo(h0), a.y - bfhi(h0)); al[2 * q + 1] = cvtpk(a.z - bflo(h1), a.w - bfhi(h1)); }
                        fah[tt][s4] = __builtin_bit_cast(bf16x8, ah); fal[tt][s4] = __builtin_bit_cast(bf16x8, al);
                    }
                    ssq += __shfl_xor(ssq, 16); ssq += __shfl_xor(ssq, 32); if (kk == 0) ssqp[w * 64 + tt * 16 + i16] = ssq;
                }
            }
#pragma unroll 1
            for (int eh = 0; eh < 2; ++eh) {
                bf16x8 wh[2][4], wl_[2][4];
                {
                    const bf16_t* ph = (const bf16_t*)(F.ws + WS_SMALL + SM_WRH) + (size_t)(eh * 32 + i16) * DM + 128 * w + 8 * kk;
                    const bf16_t* pl = (const bf16_t*)(F.ws + WS_SMALL + SM_WRL) + (size_t)(eh * 32 + i16) * DM + 128 * w + 8 * kk;
#pragma unroll
                    for (int c = 0; c < 2; ++c)
#pragma unroll
                        for (int s4 = 0; s4 < 4; ++s4) { wh[c][s4] = *(const bf16x8*)(ph + (size_t)c * 16 * DM + 32 * s4); wl_[c][s4] = *(const bf16x8*)(pl + (size_t)c * 16 * DM + 32 * s4); }
                }
#pragma unroll
                for (int tt = 0; tt < 4; ++tt) {
                    f32x4 acc[2]; acc[0] = acc[1] = (f32x4){0.f, 0.f, 0.f, 0.f};
#pragma unroll
                    for (int s4 = 0; s4 < 4; ++s4)
#pragma unroll
                        for (int c = 0; c < 2; ++c) {
                            acc[c] = __builtin_amdgcn_mfma_f32_16x16x32_bf16(fal[tt][s4], wh[c][s4], acc[c], 0, 0, 0);
                            acc[c] = __builtin_amdgcn_mfma_f32_16x16x32_bf16(fah[tt][s4], wl_[c][s4], acc[c], 0, 0, 0);
                            acc[c] = __builtin_amdgcn_mfma_f32_16x16x32_bf16(fah[tt][s4], wh[c][s4], acc[c], 0, 0, 0); }
#pragma unroll
                    for (int c = 0; c < 2; ++c)
#pragma unroll
                        for (int reg = 0; reg < 4; ++reg) part[(w * 64 + tt * 16 + 4 * kk + reg) * 64 + eh * 32 + 16 * c + i16] = acc[c][reg];
                }
            }
        }
        __syncthreads();
        const int tl = F.tid >> 3, g = F.tid & 7;
        int my_e; float my_w; int my_rank;
        {
            float ssq = 0.f;
#pragma unroll
            for (int q = 0; q < 8; ++q) ssq += ssqp[q * 64 + tl];
            const float rstd = rsqrtf(ssq * (1.f / DM) + EPS);
            if (g == 0) rsl[tl] = rstd;
            float s8[8], c8[8];
            {
                f32x4 lo4 = (f32x4){0.f, 0.f, 0.f, 0.f}, hi4 = lo4;
#pragma unroll
                for (int q = 0; q < 8; ++q) { const LAS f32x4* pp = (const LAS f32x4*)(part + (q * 64 + tl) * 64 + 8 * g); lo4 += pp[0]; hi4 += pp[1]; }
                const f32x4 cb0 = *(const f32x4*)(cb + b * 64 + 8 * g), cb1 = *(const f32x4*)(cb + b * 64 + 8 * g + 4), rb0 = *(const f32x4*)(rbias + 8 * g), rb1 = *(const f32x4*)(rbias + 8 * g + 4);
#pragma unroll
                for (int j = 0; j < 4; ++j) { s8[j] = sigmoidf_(lo4[j] * rstd + cb0[j]); s8[4 + j] = sigmoidf_(hi4[j] * rstd + cb1[j]); c8[j] = s8[j] + rb0[j]; c8[4 + j] = s8[4 + j] + rb1[j]; }
            }
            float m1 = -INFINITY, m2 = -INFINITY;
#pragma unroll
            for (int j = 0; j < 8; ++j) { const float v = c8[j]; if (v > m1) { m2 = m1; m1 = v; } else if (v > m2) m2 = v; }
            const float gs = m1 + m2;
            int rank = 0;
#pragma unroll
            for (int g2 = 0; g2 < 8; ++g2) { const float o = __shfl(gs, g2, 8); rank += (o > gs || (o == gs && g2 < g)) ? 1 : 0; }
            if (rank >= 4) {
#pragma unroll
                for (int j = 0; j < 8; ++j) c8[j] = -INFINITY;
            }
            int sel_e[8]; float sk[8]; float wsum = 0.f;
#pragma unroll
            for (int k = 0; k < 8; ++k) {
                float bv = -INFINITY, bs = 0.f; int be = 8 * g;
#pragma unroll
                for (int j = 0; j < 8; ++j) if (c8[j] > bv) { bv = c8[j]; be = 8 * g + j; bs = s8[j]; }
#pragma unroll
                for (int o = 1; o < 8; o <<= 1) { const float ov = __shfl_xor(bv, o, 8), os = __shfl_xor(bs, o, 8); const int oe = __shfl_xor(be, o, 8); if (ov > bv || (ov == bv && oe < be)) { bv = ov; be = oe; bs = os; } }
                sel_e[k] = be; sk[k] = bs; wsum += bs;
#pragma unroll
                for (int j = 0; j < 8; ++j) if (be == 8 * g + j) c8[j] = -INFINITY;
            }
            my_e = sel_e[0]; my_w = sk[0];
#pragma unroll
            for (int k = 1; k < 8; ++k) if (g == k) { my_e = sel_e[k]; my_w = sk[k]; }
            my_w *= 2.5f / wsum;
            my_rank = lds_add(&lcnt[my_e], 1);
        }
        __syncthreads();
        if (F.tid < 64) { const int n = lcnt[F.tid]; lbase[F.tid] = n > 0 ? (int)atomicAdd(&cur[F.tid], (unsigned)n) : 0; }
        __syncthreads();
        { const int tok = tokb + tl, pos = lbase[my_e] + my_rank; tokl[my_e * RT + pos] = tok * 8 + g; wl[my_e * RT + pos] = my_w; tpos[(tok - rr * RT) * 8 + g] = (my_e << 16) | pos; }
#pragma unroll 1
        for (int r0 = 0; r0 < 8; r0 += 4) {
            f32x4 xv[4][4];
#pragma unroll
            for (int r = 0; r < 4; ++r) { const f32x4* xr = (const f32x4*)(x1 + (size_t)(tokb + w * 8 + r0 + r) * DM) + lane;
#pragma unroll
                for (int j = 0; j < 4; ++j) xv[r][j] = xr[64 * j]; }
#pragma unroll
            for (int j = 0; j < 4; ++j) { const int col = 4 * lane + 256 * j; const f32x4 gq = *(const f32x4*)(gvec + b * DM + col), sh = *(const f32x4*)(mod + b * NMOD + 3 * DM + col);
#pragma unroll
                for (int r = 0; r < 4; ++r) { const int tl2 = w * 8 + r0 + r; const f32x4 hv = (xv[r][j] * rsl[tl2]) * gq + sh;
                    int o = 0; o = __builtin_amdgcn_cvt_pk_fp8_f32(f8c(hv.x * 16.f), f8c(hv.y * 16.f), o, false); o = __builtin_amdgcn_cvt_pk_fp8_f32(f8c(hv.z * 16.f), f8c(hv.w * 16.f), o, true);
                    ((unsigned*)(H2 + (size_t)(tokb - rr * RT + tl2) * DM) + lane)[64 * j] = (unsigned)o; } }
        }
        __syncthreads();
    }
}
constexpr int MO_TE = 4224;
struct MoeTabs { const LAS unsigned short* te; const LAS int* tb; const LAS int* cnt; int TR; };
__device__ __forceinline__ MoeTabs build_moe_tabs(Ctx& F, int rr) {
    LAS unsigned short* te = (LAS unsigned short*)(F.lds + MISC_OFF + MO_TE); LAS int* tb = (LAS int*)(F.lds + MISC_OFF + MO_TE + 1536); LAS int* cnt = tb + 72;
    const unsigned* cur = (const unsigned*)(F.ws + WS_CTL) + CW_MOECUR + rr * 64;
    __syncthreads();
    if (F.tid == 0) { int acc = 0; for (int e = 0; e < 64; ++e) { const int c = (int)cur[e]; cnt[e] = c; tb[e] = acc; acc += (c + 255) >> 8; } tb[64] = acc; tb[65] = acc + RT / 256; cnt[64] = RT; }
    __syncthreads();
    const int TR = tb[64];
    for (int e = F.tid >> 3; e < 65; e += 64) for (int t = tb[e] + (F.tid & 7); t < tb[e + 1]; t += 8) te[t] = (unsigned short)e;
    __syncthreads();
    MoeTabs T; T.te = te; T.tb = tb; T.cnt = cnt; T.TR = TR; return T;
}
struct Moe1Sched {
    const char* H2; const char* W1T; const int* tokl; MoeTabs T; int G, c, rr; int R[2], C[2];
    __device__ __forceinline__ bool next(int i, gm::UnitD& u) {
        const int uu = i * G + c; const int nt = T.TR + RT / 256;
        if (uu >= nt * 2) return false;
        const int tile = uu >> 1, pn = uu & 1, e = T.te[tile], rt = tile - T.tb[e], cnt = T.cnt[e];
        u.a = H2; u.b = W1T + (size_t)(e * 512 + pn * 256) * 1024;
#pragma unroll
        for (int h = 0; h < 2; ++h)
#pragma unroll
            for (int j = 0; j < 2; ++j) { const int idx = rt * 256 + h * 128 + R[j]; int trow;
                if (e < 64) { const int ent = tokl[e * RT + (idx < cnt ? idx : rt * 256)]; trow = (ent >> 3) - rr * RT; } else trow = idx;
                u.va[h][j] = (unsigned)(trow * 512 + C[j]) * 2u; }
        u.e0 = tile; u.e1 = pn; u.e2 = e; u.e3 = rt; return true;
    }
};
struct EpiMoe1 {
    bf16_t* act; const float* wl; const LAS int* cnt;
    __device__ __forceinline__ void operator()(const f32x4 (&acc)[2][2][4][2], const gm::UnitD& u, int wr, int wc, int fr, int fq) const {
        const int row0 = u.e0 * 256 + wr * 64 + fr, col0 = u.e1 * 128 + wc * 32 + 8 * fq, e = u.e2, n = cnt[e];
        float rw[2][4];
#pragma unroll
        for (int ai = 0; ai < 2; ++ai)
#pragma unroll
            for (int m = 0; m < 4; ++m) { const int idx = u.e3 * 256 + ai * 128 + wr * 64 + m * 16 + fr; rw[ai][m] = e < 64 ? (idx < n ? wl[e * RT + idx] : 0.f) : 1.f; }
#pragma unroll
        for (int ai = 0; ai < 2; ++ai)
#pragma unroll
            for (int m = 0; m < 4; ++m) { const float ww = rw[ai][m] * (32.f / 4096.f); const f32x4 g0 = acc[ai][0][m][0] * (1.f / 4096.f), g1 = acc[ai][0][m][1] * (1.f / 4096.f), u0 = acc[ai][1][m][0] * ww, u1 = acc[ai][1][m][1] * ww;
                int w0 = 0, w1 = 0;
                w0 = __builtin_amdgcn_cvt_pk_fp8_f32(f8c(siluf_(g0[0]) * u0[0]), f8c(siluf_(g0[1]) * u0[1]), w0, false); w0 = __builtin_amdgcn_cvt_pk_fp8_f32(f8c(siluf_(g0[2]) * u0[2]), f8c(siluf_(g0[3]) * u0[3]), w0, true);
                w1 = __builtin_amdgcn_cvt_pk_fp8_f32(f8c(siluf_(g1[0]) * u1[0]), f8c(siluf_(g1[1]) * u1[1]), w1, false); w1 = __builtin_amdgcn_cvt_pk_fp8_f32(f8c(siluf_(g1[2]) * u1[2]), f8c(siluf_(g1[3]) * u1[3]), w1, true);
                *(u32x2*)((unsigned char*)act + (size_t)(row0 + ai * 128 + m * 16) * 256 + col0) = (u32x2){(unsigned)w0, (unsigned)w1}; }
    }
};
__device__ __forceinline__ void phase_moe1(Ctx& F, int rr) {
    Moe1Sched S; S.T = build_moe_tabs(F, rr); S.H2 = (const char*)(F.ws + WS_H2) + (size_t)rr * RT * DM; S.W1T = (const char*)(F.ws + WS_W1T); S.tokl = (const int*)(F.ws + WS_TOKL) + (size_t)rr * 64 * RT; S.G = F.G; S.c = (F.G % 8 == 0) ? (F.bid % 8) * (F.G / 8) + F.bid / 8 : F.bid; S.rr = rr; gm::stage_geom(F.tid, S.R, S.C);
    EpiMoe1 E{(bf16_t*)(F.ws + WS_ACT), (const float*)(F.ws + WS_WL) + (size_t)rr * 64 * RT, S.T.cnt};
    gm::gemm_phase<true, false, true>(F.lds, 512, S, E);
}
struct Moe2Sched {
    const char* ACT; const char* W2T; MoeTabs T; int G, c; int R[2], C[2];
    __device__ __forceinline__ bool next(int i, gm::UnitD& u) {
        const int uu = i * G + c; const int nt = T.TR + RT / 256;
        if (uu >= nt * 4) return false;
        const int tile = uu >> 2, pn = uu & 3, e = T.te[tile], rt = tile - T.tb[e];
        u.a = ACT + (size_t)tile * 256 * 256; u.b = W2T + (size_t)(e * 1024 + pn * 256) * 256;
#pragma unroll
        for (int h = 0; h < 2; ++h)
#pragma unroll
            for (int j = 0; j < 2; ++j) u.va[h][j] = (unsigned)((h * 128 + R[j]) * 128 + C[j]) * 2u;
        u.e0 = pn; u.e1 = e; u.e2 = rt; u.e3 = tile; return true;
    }
};
struct EpiMoe2 {
    bf16_t* slots; bf16_t* shout; const LAS int* cnt;
    __device__ __forceinline__ void operator()(const f32x4 (&acc)[2][2][4][2], const gm::UnitD& u, int wr, int wc, int fr, int fq) const {
        const int pn = u.e0, e = u.e1, rt = u.e2, tile = u.e3;
        const int col0 = pn * 256 + wc * 32 + 8 * fq, n = cnt[e];
        if (e < 64) {
            unsigned char* base = (unsigned char*)slots + (size_t)(tile * 256 + wr * 64 + fr) * 1024 + col0;
#pragma unroll
            for (int ai = 0; ai < 2; ++ai)
#pragma unroll
                for (int m = 0; m < 4; ++m) {
                    if (rt * 256 + ai * 128 + wr * 64 + m * 16 + fr < n) {
#pragma unroll
                        for (int bj = 0; bj < 2; ++bj) { f32x4 v0 = acc[ai][bj][m][0] * (16.f / 4096.f), v1 = acc[ai][bj][m][1] * (16.f / 4096.f);
#pragma unroll
                            for (int j = 0; j < 4; ++j) { v0[j] = __builtin_amdgcn_fmed3f(v0[j], -440.f, 440.f); v1[j] = __builtin_amdgcn_fmed3f(v1[j], -440.f, 440.f); }
                            int w0 = 0, w1 = 0;
                            w0 = __builtin_amdgcn_cvt_pk_fp8_f32(v0[0], v0[1], w0, false); w0 = __builtin_amdgcn_cvt_pk_fp8_f32(v0[2], v0[3], w0, true);
                            w1 = __builtin_amdgcn_cvt_pk_fp8_f32(v1[0], v1[1], w1, false); w1 = __builtin_amdgcn_cvt_pk_fp8_f32(v1[2], v1[3], w1, true);
                            *(u32x2*)(base + (size_t)(ai * 128 + m * 16) * 1024 + bj * 128) = (u32x2){(unsigned)w0, (unsigned)w1}; } } }
        } else {
            bf16_t* base = shout + (size_t)(rt * 256 + wr * 64 + fr) * 1024 + col0;
#pragma unroll
            for (int ai = 0; ai < 2; ++ai)
#pragma unroll
                for (int m = 0; m < 4; ++m)
#pragma unroll
                    for (int bj = 0; bj < 2; ++bj) { const f32x4 v0 = acc[ai][bj][m][0] * (1.f / 4096.f), v1 = acc[ai][bj][m][1] * (1.f / 4096.f);
                        u32x4 o; o.x = cvtpk(v0[0], v0[1]); o.y = cvtpk(v0[2], v0[3]); o.z = cvtpk(v1[0], v1[1]); o.w = cvtpk(v1[2], v1[3]); *(u32x4*)(base + (size_t)(ai * 128 + m * 16) * 1024 + bj * 128) = o; }
        }
    }
};
__device__ __forceinline__ void phase_moe2(Ctx& F, int rr) {
    Moe2Sched S; S.T = build_moe_tabs(F, rr); S.ACT = (const char*)(F.ws + WS_ACT); S.W2T = (const char*)(F.ws + WS_W2T); S.G = F.G; S.c = (F.G % 8 == 0) ? (F.bid % 8) * (F.G / 8) + F.bid / 8 : F.bid; gm::stage_geom(F.tid, S.R, S.C);
    EpiMoe2 E{(bf16_t*)(F.ws + WS_SLOTS), (bf16_t*)(F.ws + WS_SHOUT), S.T.cnt};
    gm::gemm_phase<true, false, true>(F.lds, 128, S, E);
}
__device__ __forceinline__ void phase_final(Ctx& F, int rr) {
    const MoeTabs T = build_moe_tabs(F, rr);
    const float* mod = (const float*)(F.ws + WS_SMALL + SM_MOD); const float* fg = inp(F, I_FG);
    const unsigned char* slots = (const unsigned char*)(F.ws + WS_SLOTS); const int* tpos = (const int*)(F.ws + WS_TPOS) + (size_t)rr * RT * 8;
    const int gw = F.bid * 8 + F.wave, NGW = F.G * 8, c0 = F.lane * 8;
    for (int t = gw; t < RT; t += NGW) {
        const int tok = rr * RT + t, b = tok / SEQ;
        const unsigned char* rp[8];
#pragma unroll
        for (int k = 0; k < 8; ++k) { const int v = tpos[t * 8 + k]; rp[k] = slots + (size_t)(T.tb[v >> 16] * 256 + (v & 0xffff)) * 1024 + c0; }
        float* orow = F.out + (size_t)tok * DM + c0;
        u32x2 sv[8][2]; u32x4 sh[2]; f32x4 xv[2][2];
#pragma unroll
        for (int k = 0; k < 8; ++k) { sv[k][0] = *(const u32x2*)(rp[k]); sv[k][1] = *(const u32x2*)(rp[k] + 512); }
        { const bf16_t* sp = (const bf16_t*)(F.ws + WS_SHOUT) + (size_t)t * 1024 + c0; sh[0] = *(const u32x4*)sp; sh[1] = *(const u32x4*)(sp + 512); }
#pragma unroll
        for (int h = 0; h < 2; ++h) { xv[h][0] = *(const f32x4*)(orow + h * 512); xv[h][1] = *(const f32x4*)(orow + h * 512 + 4); }
        float s = 0.f; f32x4 v[2][2];
#pragma unroll
        for (int h = 0; h < 2; ++h) {
            f32x4 a0 = (f32x4){0.f, 0.f, 0.f, 0.f}, a1 = a0;
#pragma unroll
            for (int k = 0; k < 8; ++k) { const u32x2 w = sv[k][h];
                const f32x2 p0 = __builtin_amdgcn_cvt_pk_f32_fp8((int)w.x, false), p1 = __builtin_amdgcn_cvt_pk_f32_fp8((int)w.x, true), p2 = __builtin_amdgcn_cvt_pk_f32_fp8((int)w.y, false), p3 = __builtin_amdgcn_cvt_pk_f32_fp8((int)w.y, true);
                a0 += (f32x4){p0.x, p0.y, p1.x, p1.y}; a1 += (f32x4){p2.x, p2.y, p3.x, p3.y}; }
            { const u32x4 w = sh[h]; a0 = a0 * 0.0625f + (f32x4){bflo(w.x), bfhi(w.x), bflo(w.y), bfhi(w.y)}; a1 = a1 * 0.0625f + (f32x4){bflo(w.z), bfhi(w.z), bflo(w.w), bfhi(w.w)}; }
            const float* g2 = mod + b * NMOD + 5 * DM + c0 + h * 512;
            v[h][0] = xv[h][0] + *(const f32x4*)g2 * a0; v[h][1] = xv[h][1] + *(const f32x4*)(g2 + 4) * a1;
#pragma unroll
            for (int q = 0; q < 2; ++q) s += (v[h][q].x * v[h][q].x + v[h][q].y * v[h][q].y) + (v[h][q].z * v[h][q].z + v[h][q].w * v[h][q].w);
        }
        const float rstd = rsqrtf(wave_sum(s) * (1.f / DM) + EPS);
#pragma unroll
        for (int h = 0; h < 2; ++h)
#pragma unroll
            for (int q = 0; q < 2; ++q) { const f32x4 g = *(const f32x4*)(fg + c0 + h * 512 + 4 * q); *(f32x4*)(orow + h * 512 + 4 * q) = (v[h][q] * rstd) * g; }
    }
}

constexpr int N_PHASES = 10;
__global__ void __launch_bounds__(512, 2) mega_fwd(Args args) {
    extern __shared__ __attribute__((aligned(16))) unsigned char lds_raw[];
    Ctx F; F.lds = (LAS unsigned char*)lds_raw; F.ws = args.ws; F.out = args.out;
    {
        typedef __attribute__((address_space(4))) const unsigned long long* karg_t;
        const karg_t ka = (karg_t)__builtin_amdgcn_kernarg_segment_ptr();
        LAS unsigned long long* tab = (LAS unsigned long long*)(lds_raw + MISC_OFF + 14336);
        if (threadIdx.x < 20) tab[threadIdx.x] = ka[threadIdx.x];
        F.intab = tab;
    }
    F.tid = threadIdx.x; F.lane = F.tid & 63; F.wave = __builtin_amdgcn_readfirstlane(F.tid >> 6); F.G = gridDim.x; F.bid = blockIdx.x;
    volatile LAS unsigned* st = (volatile LAS unsigned*)(F.lds + MISC_OFF + MO_ST);
    if (F.tid < 4) st[F.tid] = 0u;
    __syncthreads();
    XcdBarrier bar = xcd_barrier_post((unsigned*)(F.ws + WS_CTL) + CW_BAR, st);
    if (threadIdx.x == 0) { unsigned nloc, nx; xcd_barrier_complete(bar.bar, bar.x, nloc, nx); st[0] = nloc; st[1] = nx; }
    int lo = args.ph_lo, hi = args.ph_hi;
    { int a = lo, b = hi; asm volatile("" : "+v"(a), "+v"(b)); lo = __builtin_amdgcn_readfirstlane(a); hi = __builtin_amdgcn_readfirstlane(b); }
    launder(F);
#ifndef PH_MASK
#define PH_MASK 0x1ffff
#endif
#define PH_ON(k) ((PH_MASK >> (k)) & 1)
#define IN(k) (lo <= (k) && (k) < hi)
#define SEAM(k) do { if (IN(k) && IN((k) + 1)) { bar.bar = launder_ptr(bar.bar); xcd_barrier(bar); } } while (0)
#define RUN(k, call) do { if (PH_ON(k) && IN(k)) { launder(F); call; } } while (0)
    RUN(0, phase0(F)); SEAM(0);
    RUN(1, phase1(F)); SEAM(1);
    RUN(2, phase2(F)); SEAM(2);
    RUN(4, (phase4(F), sb_units(F))); SEAM(4);
    RUN(5, phase5(F)); SEAM(5);
    RUN(6, phase6(F)); SEAM(6);
    RUN(7, phase7(F)); SEAM(7);
    RUN(8, phase8(F)); SEAM(8);
    if (PH_ON(9) && IN(9)) {
        const int par = (F.bid >> 3) & 1;
#pragma unroll 1
        for (int i = 0; i < 8; ++i) {
            launder(F);
            int op, rr; bool bar_after = true;
            switch (i) {
                case 0: op = 0; rr = 0; break;
                case 1: op = 1; rr = 0; break;
                case 2: op = par ? 0 : 2; rr = par ? 1 : 0; bar_after = false; break;
                case 3: op = par ? 2 : 0; rr = par ? 0 : 1; break;
                case 4: op = par ? 1 : 3; rr = par ? 1 : 0; bar_after = false; break;
                case 5: op = par ? 3 : 1; rr = par ? 0 : 1; break;
                case 6: op = 2; rr = 1; break;
                default: op = 3; rr = 1; bar_after = false; break;
            }
            switch (op) {
                case 0: phase_n2r(F, rr); break;
                case 1: phase_moe1(F, rr); break;
                case 2: phase_moe2(F, rr); break;
                default: phase_final(F, rr); break;
            }
            if (bar_after) { bar.bar = launder_ptr(bar.bar); xcd_barrier(bar); } else __syncthreads();
        }
    }
#undef IN
#undef SEAM
#undef RUN
}

#ifndef MK_SPLIT
#define MK_SPLIT 0
#endif
extern "C" void kernel_launch(void* const* d_in, const int* in_sizes, int n_in, void* d_out, int out_size, void* d_ws, size_t ws_size, hipStream_t stream) {
    static int grid = 0;
    if (grid == 0) {
        if (n_in != 20 || in_sizes[0] != MT * DM || out_size != MT * DM || ws_size < WS_END) { fprintf(stderr, "kernel_launch: unexpected shapes (n_in %d, in0 %d, out %d, ws %zu)\n", n_in, n_in > 0 ? in_sizes[0] : -1, out_size, ws_size); grid = -1; return; }
        int dev = 0, cus = 0;
        if (hipGetDevice(&dev) != hipSuccess || hipDeviceGetAttribute(&cus, hipDeviceAttributeMultiprocessorCount, dev) != hipSuccess) { grid = -1; return; }
        if (hipFuncSetAttribute((const void*)mega_fwd, hipFuncAttributeMaxDynamicSharedMemorySize, LDS_BYTES) != hipSuccess) { fprintf(stderr, "kernel_launch: hipFuncSetAttribute failed\n"); grid = -1; return; }
        int per_cu = 0;
        if (hipOccupancyMaxActiveBlocksPerMultiprocessor(&per_cu, (const void*)mega_fwd, 512, LDS_BYTES) != hipSuccess || per_cu < 1) fprintf(stderr, "kernel_launch: occupancy query reports %d\n", per_cu);
        (void)hipGetLastError();
        grid = cus;
    }
    if (grid < 0) return;
    (void)hipMemsetAsync((char*)d_ws + WS_CTL, 0, CTL_BYTES, stream);
    Args a{};
    for (int i = 0; i < 20; ++i) a.in[i] = (const float*)d_in[i];
    a.out = (float*)d_out; a.ws = (unsigned char*)d_ws;
#if MK_SPLIT
    for (int p = 0; p < N_PHASES; ++p) { a.ph_lo = p; a.ph_hi = p + 1; hipLaunchKernelGGL(mega_fwd, dim3(grid), dim3(512), LDS_BYTES, stream, a); }
#else
    a.ph_lo = 0; a.ph_hi = N_PHASES;
    hipLaunchKernelGGL(mega_fwd, dim3(grid), dim3(512), LDS_BYTES, stream, a);
#endif
}
```

```cpp
#include <hip/hip_runtime.h>
#include <cstdio>
#include <cstdint>

#define LAS __attribute__((address_space(3)))
#define GAS __attribute__((address_space(1)))
typedef unsigned short bf16_t;
typedef short bf16x8 __attribute__((ext_vector_type(8)));
typedef short s16x4 __attribute__((ext_vector_type(4)));
typedef float f32x4 __attribute__((ext_vector_type(4)));
typedef float f32x16 __attribute__((ext_vector_type(16)));
typedef float f32x2 __attribute__((ext_vector_type(2)));
typedef unsigned u32x4 __attribute__((ext_vector_type(4)));
typedef unsigned u32x2 __attribute__((ext_vector_type(2)));
typedef __bf16 bf16x2_t __attribute__((ext_vector_type(2)));

__device__ __forceinline__ unsigned cvtpk(float lo, float hi) { f32x2 v = {lo, hi}; bf16x2_t b = __builtin_convertvector(v, bf16x2_t); return __builtin_bit_cast(unsigned, b); }
__device__ __forceinline__ float bf2f(unsigned short u) { return __uint_as_float(((unsigned)u) << 16); }
__device__ __forceinline__ float bflo(unsigned u) { return __uint_as_float(u << 16); }
__device__ __forceinline__ float bfhi(unsigned u) { return __uint_as_float(u & 0xffff0000u); }

constexpr int NB = 4, SEQ = 8192, DM = 1024, MT = NB * SEQ;
constexpr int NHEAD = 8, HD = 64, QW = 1536;
constexpr int NE = 64, EFF = 256, NMOD = 6 * DM;
constexpr int RT = MT / 2;
constexpr float EPS = 1e-6f;
constexpr float LOG2E = 1.4426950408889634f;

constexpr size_t MiB = 1u << 20;
constexpr size_t WS_CTL = 0, CTL_BYTES = 1 * MiB;
constexpr size_t WS_SMALL = 1 * MiB;
constexpr size_t SM_MOD = 0, SM_GVEC = 98304, SM_CB = 114688, SM_KBAR = 131072, SM_WRH = 393216, SM_WRL = 524288;
constexpr size_t WS_W2T = 2 * MiB;
constexpr size_t WS_W1T = 35 * MiB;
constexpr size_t WS_WIN8 = 19 * MiB;
constexpr size_t WS_H8 = 68 * MiB;
constexpr size_t WS_WINT = 100 * MiB;
constexpr size_t WS_WBRT = 110 * MiB;
constexpr size_t WS_WOUTT = 112 * MiB;
constexpr size_t WS_H = 114 * MiB;
constexpr size_t WS_OB = 114 * MiB;
constexpr size_t WS_QSB = 178 * MiB;
constexpr size_t WS_PO = 178 * MiB;
constexpr size_t WS_QMB = 274 * MiB;
constexpr size_t WS_MERGED = 274 * MiB;
constexpr size_t WS_G = 370 * MiB;
constexpr size_t WS_LMB = 498 * MiB;
constexpr size_t WS_PLSE = 506 * MiB;
constexpr size_t WS_H2 = 100 * MiB;
constexpr size_t WS_TOKL = 164 * MiB;
constexpr size_t WS_WL = 172 * MiB;
constexpr size_t WS_TPOS = 180 * MiB;
constexpr size_t WS_ACT = 184 * MiB;
constexpr size_t WS_SLOTS = 264 * MiB;
constexpr size_t WS_SHOUT = 408 * MiB;
constexpr size_t WS_END = 509 * MiB;
constexpr int CW_MBCUR = 0;
constexpr int CW_MOECUR = 1024;
constexpr int CW_BAR = 4096;
constexpr size_t CTL_KBS = 512 * 1024;

constexpr int RING_BYTES = 131072;
constexpr int MISC_OFF = RING_BYTES;
constexpr int LDS_BYTES = 163840;
constexpr int MO_STG = 16384;

#define XB_TMO      128
#define XB_XCNT(j)  (256  + 64 * (j))
#define XB_XSUB(j)  (1280 + 64 * (j))
#define XB_XGEN(j)  (2304 + 64 * (j))
#define XB_TOP      3328
#define XB_TOPGEN   3392
#define XCD_BAR_WORDS 3456
#define XB_SPIN_CAP (1u << 18)
__device__ __forceinline__ unsigned xb_ld(unsigned* p)              { return __hip_atomic_load(p, __ATOMIC_RELAXED, __HIP_MEMORY_SCOPE_AGENT); }
__device__ __forceinline__ unsigned xb_add(unsigned* p, unsigned v) { return __hip_atomic_fetch_add(p, v, __ATOMIC_RELAXED, __HIP_MEMORY_SCOPE_AGENT); }
__device__ __forceinline__ unsigned xb_xcc_id() { return (unsigned)__builtin_amdgcn_s_getreg((3 << 11) | 20) & 0xFu; }
#define XB_SPIN(cond, bar) do { unsigned _sp = 0; while (cond) { __builtin_amdgcn_s_sleep(1); \
    if ((++_sp & 255u) == 0u) { if (xb_ld(&(bar)[XB_TMO])) break; if (_sp > XB_SPIN_CAP) { atomicAdd(&(bar)[XB_TMO], 1u); break; } } } } while (0)
struct XcdBarrier { unsigned* bar; unsigned x; volatile LAS unsigned* st; };
__device__ __forceinline__ XcdBarrier xcd_barrier_post(unsigned* bar, volatile LAS unsigned* st) {
    XcdBarrier b; b.bar = bar; b.x = xb_xcc_id(); b.st = st;
    if (threadIdx.x == 0) (void)xb_add(&bar[XB_XCNT(b.x)], 1u);
    return b;
}
__device__ __forceinline__ void xcd_barrier_complete(unsigned* bar, unsigned x, unsigned& nloc, unsigned& nx) {
    const unsigned G = gridDim.x * gridDim.y * gridDim.z;
    unsigned sum, cnt, mine, sp = 0u;
    for (;;) {
        sum = 0u; cnt = 0u; mine = 0u;
#pragma unroll
        for (unsigned j = 0; j < 16; ++j) { const unsigned c = xb_ld(&bar[XB_XCNT(j)]); sum += c; cnt += (c > 0u) ? 1u : 0u; mine = (j == x) ? c : mine; }
        if (sum == G) break;
        __builtin_amdgcn_s_sleep(1);
        if ((++sp & 255u) == 0u) { if (xb_ld(&bar[XB_TMO])) break; if (sp > XB_SPIN_CAP) { atomicAdd(&bar[XB_TMO], 1u); break; } }
    }
    nloc = mine > 0u ? mine : 1u; nx = cnt > 0u ? cnt : 1u;
}
__device__ __forceinline__ void xcd_barrier(const XcdBarrier& b) {
    asm volatile("s_waitcnt vmcnt(0)" ::: "memory");
    __syncthreads();
    if (threadIdx.x == 0) {
        unsigned* bar = b.bar;
        __builtin_amdgcn_s_waitcnt(0);
        unsigned nloc = b.st[0], nx = b.st[1];
        const unsigned old = xb_add(&bar[XB_XSUB(b.x)], 1u);
        const unsigned gen = old / nloc;
        if (old + 1u == (gen + 1u) * nloc) {
            __builtin_amdgcn_fence(__ATOMIC_RELEASE, "agent");
            asm volatile("s_waitcnt vmcnt(0)" ::: "memory");
            const unsigned og = xb_add(&bar[XB_TOP], 1u);
            const unsigned tg = og / nx;
            if (og + 1u == (tg + 1u) * nx) xb_add(&bar[XB_TOPGEN], 1u);
            else XB_SPIN(xb_ld(&bar[XB_TOPGEN]) == tg, bar);
            __builtin_amdgcn_fence(__ATOMIC_ACQUIRE, "agent");
            xb_add(&bar[XB_XGEN(b.x)], 1u);
            asm volatile("s_waitcnt vmcnt(0)" ::: "memory");
        } else {
            XB_SPIN(xb_ld(&bar[XB_XGEN(b.x)]) == gen, bar);
            __builtin_amdgcn_fence(__ATOMIC_ACQUIRE, "agent");
            asm volatile("s_waitcnt vmcnt(0)" ::: "memory");
        }
    }
    __syncthreads();
}

namespace gm {
constexpr int BM = 256, BK = 64, HALF = 128, HTB = HALF * BK * 2, STAGE_BYTES = 8 * HTB, NXCD = 8, WGM = 8;
__host__ __device__ __forceinline__ int lds_byte(int r, int c) { const int st = (r >> 4) * 2 + (c >> 5), rr = r & 15, cc = c & 31, ob = rr * 64 + cc * 2; return st * 1024 + (ob ^ (((ob >> 9) & 1) << 5)); }
__host__ __device__ __forceinline__ void stage_rc(int b, int& R, int& C) { const int st = b / 1024, sb = b % 1024, swz = sb ^ (((sb >> 9) & 1) << 5); R = (st >> 1) * 16 + swz / 64; C = (st & 1) * 32 + (swz % 64) / 2; }
__host__ __device__ __forceinline__ int perm32(int rho) { const int n = rho >> 4, i = rho & 15; return 8 * (i >> 2) + 4 * n + (i & 3); }

struct UnitD { const char* a; const char* b; unsigned va[2][2]; int e0, e1, e2, e3; };

__device__ __forceinline__ bool static_tile(int M, int N, int G, int c, int i, int& pm, int& pn) {
    const int nM = M / BM, nN = N / BM, nwg = nM * nN;
    const long L = (long)i * G + c; if (L >= nwg) return false;
    int wgid = (int)L; { const int q = nwg / NXCD, r = nwg % NXCD, xcd = wgid % NXCD, off = wgid / NXCD; wgid = (xcd < r ? xcd * (q + 1) : r * (q + 1) + (xcd - r) * q) + off; }
    const int nig = WGM * nN, gid = wgid / nig, fm = gid * WGM, gsz = (nM - fm) < WGM ? (nM - fm) : WGM;
    pm = fm + ((wgid % nig) % gsz); pn = (wgid % nig) / gsz; return true;
}

template <bool PERM, bool HOOK = false, bool FP8 = false, class Epi, class Sched>
__device__ __forceinline__ void gemm_phase(LAS unsigned char* lds, const int K, Sched& S, const Epi& E) {
    const int tid = threadIdx.x, wid = __builtin_amdgcn_readfirstlane(tid >> 6), lane = tid & 63, wr = wid >> 2, wc = wid & 3, fr = lane & 15, fq = lane >> 4;
    const int nt = K / BK;
    unsigned voffB[2];
#pragma unroll
    for (int i = 0; i < 2; ++i) { int R, C; stage_rc(tid * 16 + i * 8192, R, C); const int Rb = PERM ? ((R & ~31) + perm32(R & 31)) : R; voffB[i] = (unsigned)(Rb * K + C) * 2u; }
    const size_t kstep = (size_t)(BK * 2);
    const size_t hstep = (size_t)HALF * K * 2;
    const unsigned ldsw = (unsigned)wid * 1024u;
    const int aoff = lds_byte(wr * 64 + fr, fq * 8), boff = lds_byte(wc * 32 + fr, fq * 8);
#define GM_SA(b, h) (((b) * 2 + (h)) * HTB)
#define GM_SB(b, h) ((4 + (b) * 2 + (h)) * HTB)
#define GM_STAGE_A(bufoff, U, h, kb) do { _Pragma("unroll") for (int _i = 0; _i < 2; ++_i) \
        __builtin_amdgcn_global_load_lds((const unsigned*)((U).a + (kb) + (U).va[h][_i]), (LAS unsigned*)(lds + (bufoff) + ldsw + _i * 8192), 16, 0, 0); } while (0)
#define GM_STAGE_B(bufoff, U, h, kb) do { _Pragma("unroll") for (int _i = 0; _i < 2; ++_i) \
        __builtin_amdgcn_global_load_lds((const unsigned*)((U).b + (kb) + (size_t)(h) * hstep + voffB[_i]), (LAS unsigned*)(lds + (bufoff) + ldsw + _i * 8192), 16, 0, 0); } while (0)
#define GM_LDA(dst, b, h) do { _Pragma("unroll") for (int m = 0; m < 4; ++m) _Pragma("unroll") for (int k = 0; k < 2; ++k) { \
        if constexpr (FP8) { const i32x4_ t_ = *(const LAS i32x4_*)(lds + GM_SA(b, h) + aoff + m * 2048 + k * 1024); dst##8[m][4 * k] = t_[0]; dst##8[m][4 * k + 1] = t_[1]; dst##8[m][4 * k + 2] = t_[2]; dst##8[m][4 * k + 3] = t_[3]; } \
        else dst[m][k] = *(const LAS bf16x8*)(lds + GM_SA(b, h) + aoff + m * 2048 + k * 1024); } } while (0)
#define GM_LDB(dst, b, h) do { _Pragma("unroll") for (int n = 0; n < 2; ++n) _Pragma("unroll") for (int k = 0; k < 2; ++k) { \
        if constexpr (FP8) { const i32x4_ t_ = *(const LAS i32x4_*)(lds + GM_SB(b, h) + boff + n * 2048 + k * 1024); dst##8[n][4 * k] = t_[0]; dst##8[n][4 * k + 1] = t_[1]; dst##8[n][4 * k + 2] = t_[2]; dst##8[n][4 * k + 3] = t_[3]; } \
        else dst[n][k] = *(const LAS bf16x8*)(lds + GM_SB(b, h) + boff + n * 2048 + k * 1024); } } while (0)
#define GM_MMA(ai, bj, At, Bt) do { __builtin_amdgcn_s_setprio(1); \
        if constexpr (FP8) { _Pragma("unroll") for (int m = 0; m < 4; ++m) _Pragma("unroll") for (int n = 0; n < 2; ++n) \
            asm volatile("v_mfma_scale_f32_16x16x128_f8f6f4 %0, %1, %2, %0, %3, %3 op_sel_hi:[0,0,0]" : "+v"(acc[ai][bj][m][n]) : "v"(Bt##8[n]), "v"(At##8[m]), "v"(scl1)); } \
        else { _Pragma("unroll") for (int m = 0; m < 4; ++m) _Pragma("unroll") for (int n = 0; n < 2; ++n) _Pragma("unroll") for (int k = 0; k < 2; ++k) \
            acc[ai][bj][m][n] = __builtin_amdgcn_mfma_f32_16x16x32_bf16(Bt[n][k], At[m][k], acc[ai][bj][m][n], 0, 0, 0); } \
        __builtin_amdgcn_s_setprio(0); } while (0)
#define GM_WAIT_V(n) asm volatile("s_waitcnt vmcnt(" #n ")" ::: "memory")
#define GM_WAIT_L(n) asm volatile("s_waitcnt lgkmcnt(" #n ")" ::: "memory")
#define GM_BAR __builtin_amdgcn_s_barrier()
#define GM_SCHED __builtin_amdgcn_sched_barrier(0)
    UnitD cur, nxt; int ui = 0;
    if (!S.next(0, cur)) return;
    f32x4 acc[2][2][4][2];
#pragma unroll
    for (int a = 0; a < 2; ++a)
#pragma unroll
        for (int b = 0; b < 2; ++b)
#pragma unroll
            for (int m = 0; m < 4; ++m)
#pragma unroll
                for (int n = 0; n < 2; ++n) acc[a][b][m][n] = (f32x4){0.f, 0.f, 0.f, 0.f};
    typedef int i32x8_ __attribute__((ext_vector_type(8))); typedef int i32x4_ __attribute__((ext_vector_type(4)));
    bf16x8 At[4][2], B0[2][2], B1[2][2]; i32x8_ At8[4], B08[2], B18[2];
    int scl1 = 0x7f7f7f7f; asm volatile("" : "+v"(scl1));
    GM_STAGE_B(GM_SB(0, 0), cur, 0, 0); GM_STAGE_B(GM_SB(0, 1), cur, 1, 0); GM_STAGE_A(GM_SA(0, 0), cur, 0, 0); GM_STAGE_A(GM_SA(0, 1), cur, 1, 0);
    if (wr == 1) GM_BAR;
    GM_WAIT_V(2); GM_BAR;
    GM_STAGE_B(GM_SB(1, 0), cur, 0, kstep); GM_STAGE_A(GM_SA(1, 0), cur, 0, kstep); GM_STAGE_B(GM_SB(1, 1), cur, 1, kstep);
    GM_WAIT_V(6); GM_BAR;
    for (;;) {
        const bool has_next = S.next(ui + 1, nxt);
        if (!has_next) nxt = cur;
#pragma unroll 1
        for (int t = 0; t < nt; t += 2) {
            const bool last = (t == nt - 2);
            if constexpr (HOOK) { if (t == nt / 2) E.mid(acc, cur, wr, wc, fr, fq); }
            const size_t k1 = (size_t)(t + 1) * kstep;
            UnitD U2 = cur; size_t k2 = (size_t)(t + 2) * kstep;
            if (last) { U2 = nxt; k2 = 0; }
            const size_t k3 = k2 + kstep;
            GM_LDB(B0, 0, 0); GM_LDB(B1, 0, 1); GM_SCHED; GM_LDA(At, 0, 0); GM_STAGE_A(GM_SA(1, 1), cur, 1, k1);
            GM_WAIT_V(8); GM_WAIT_L(0); GM_BAR; GM_MMA(0, 0, At, B0); GM_MMA(0, 1, At, B1); GM_BAR; GM_SCHED;
            GM_LDA(At, 0, 1); GM_STAGE_B(GM_SB(0, 0), U2, 0, k2); GM_STAGE_B(GM_SB(0, 1), U2, 1, k2); GM_STAGE_A(GM_SA(0, 0), U2, 0, k2);
            GM_WAIT_V(8); GM_WAIT_L(0); GM_BAR; GM_MMA(1, 0, At, B0); GM_MMA(1, 1, At, B1); GM_BAR; GM_SCHED;
            GM_LDB(B0, 1, 0); GM_LDB(B1, 1, 1); GM_SCHED; GM_LDA(At, 1, 0); GM_STAGE_A(GM_SA(0, 1), U2, 1, k2);
            GM_WAIT_V(8); GM_WAIT_L(0); GM_BAR; GM_MMA(0, 0, At, B0); GM_MMA(0, 1, At, B1); GM_BAR; GM_SCHED;
            GM_LDA(At, 1, 1); GM_STAGE_B(GM_SB(1, 0), U2, 0, k3); GM_STAGE_B(GM_SB(1, 1), U2, 1, k3); GM_STAGE_A(GM_SA(1, 0), U2, 0, k3);
            GM_WAIT_V(8); GM_WAIT_L(0); GM_BAR; GM_MMA(1, 0, At, B0); GM_MMA(1, 1, At, B1); GM_BAR; GM_SCHED;
        }
        if constexpr (FP8) asm volatile("s_nop 15\n\ts_nop 15" ::: "memory");
        if (wr == 0) GM_BAR;
        E(acc, cur, wr, wc, fr, fq);
        if (!has_next) break;
#pragma unroll
        for (int a = 0; a < 2; ++a)
#pragma unroll
            for (int b = 0; b < 2; ++b)
#pragma unroll
                for (int m = 0; m < 4; ++m)
#pragma unroll
                    for (int n = 0; n < 2; ++n) acc[a][b][m][n] = (f32x4){0.f, 0.f, 0.f, 0.f};
        cur = nxt; ++ui;
        if (wr == 1) GM_BAR;
    }
    GM_WAIT_V(0);
    GM_BAR;
#undef GM_SA
#undef GM_SB
#undef GM_STAGE_A
#undef GM_STAGE_B
#undef GM_LDA
#undef GM_LDB
#undef GM_MMA
#undef GM_WAIT_V
#undef GM_WAIT_L
#undef GM_BAR
#undef GM_SCHED
}
__device__ __forceinline__ void stage_geom(int tid, int (&R)[2], int (&C)[2]) {
#pragma unroll
    for (int i = 0; i < 2; ++i) stage_rc(tid * 16 + i * 8192, R[i], C[i]);
}
}

struct Args { const float* in[20]; float* out; unsigned char* ws; int ph_lo, ph_hi; };
struct Ctx {
    LAS unsigned char* lds;
    unsigned char* ws;
    const LAS unsigned long long* intab;
    float* out;
    int tid, lane, wave, G, bid;
};
#define LDS_WAIT() asm volatile("s_waitcnt lgkmcnt(0)" ::: "memory")
__device__ __forceinline__ const float* inp(const Ctx& F, int i) {
    const unsigned long long v = F.intab[i];
    const unsigned lo = __builtin_amdgcn_readfirstlane((unsigned)v), hi = __builtin_amdgcn_readfirstlane((unsigned)(v >> 32));
    return (const float*)(GAS const float*)(((unsigned long long)hi << 32) | lo);
}
template <class P> __device__ __forceinline__ P launder_ptr(P p) {
    unsigned long long v = (unsigned long long)p; unsigned lo = (unsigned)v, hi = (unsigned)(v >> 32);
    asm volatile("" : "+v"(lo), "+v"(hi));
    lo = __builtin_amdgcn_readfirstlane(lo); hi = __builtin_amdgcn_readfirstlane(hi);
    return (P)(GAS unsigned char*)(((unsigned long long)hi << 32) | lo);
}
__device__ __forceinline__ void launder(Ctx& F) {
    int t = F.tid, g = F.G, bid = F.bid;
    asm volatile("" : "+v"(t), "+v"(g), "+v"(bid));
    F.tid = t; F.G = __builtin_amdgcn_readfirstlane(g); F.bid = __builtin_amdgcn_readfirstlane(bid); F.lane = t & 63; F.wave = __builtin_amdgcn_readfirstlane(t >> 6);
    F.ws = launder_ptr(F.ws); F.out = launder_ptr(F.out);
}
__device__ __forceinline__ float wave_sum(float v) {
#pragma unroll
    for (int o = 1; o < 64; o <<= 1) v += __shfl_xor(v, o);
    return v;
}
__device__ __forceinline__ int lds_add(LAS int* p, int v) { return __hip_atomic_fetch_add(p, v, __ATOMIC_RELAXED, __HIP_MEMORY_SCOPE_WORKGROUP); }
__device__ __forceinline__ float f8c(float x) { return __builtin_amdgcn_fmed3f(x, -440.f, 440.f); }
__device__ __forceinline__ float sigmoidf_(float x) { return 1.f / (1.f + __expf(-x)); }
__device__ __forceinline__ float siluf_(float x) { return x / (1.f + __expf(-x)); }

enum { I_X = 0, I_C, I_N1G, I_N2G, I_WADA, I_BADA, I_WIN, I_WBSB, I_WBMB, I_WOUT, I_WR, I_RB, I_WGE, I_WUE, I_WDE, I_WGS, I_WUS, I_WDS, I_RELB, I_FG };

__device__ __forceinline__ void transpose_item(const float* W, int ldn, int k0, int n0, bf16_t* WT, int Kdst, int drow0, LAS float* scr, int lane) {
    const float* wp = W + (size_t)(k0 + (lane >> 3)) * ldn + n0 + 4 * (lane & 7);
    f32x4 v[8];
#pragma unroll
    for (int i = 0; i < 8; ++i) v[i] = *(const f32x4*)(wp + (size_t)(8 * i) * ldn);
#pragma unroll
    for (int i = 0; i < 8; ++i) { LAS float* d = scr + (8 * i + (lane >> 3)) * 33 + 4 * (lane & 7); d[0] = v[i].x; d[1] = v[i].y; d[2] = v[i].z; d[3] = v[i].w; }
    LDS_WAIT(); asm volatile("" ::: "memory");
    const int c = lane & 7;
#pragma unroll
    for (int j = 0; j < 4; ++j) { const int n = (lane >> 3) + 8 * j; const LAS float* s = scr + (8 * c) * 33 + n;
        u32x4 o; o.x = cvtpk(s[0 * 33], s[1 * 33]); o.y = cvtpk(s[2 * 33], s[3 * 33]); o.z = cvtpk(s[4 * 33], s[5 * 33]); o.w = cvtpk(s[6 * 33], s[7 * 33]);
        *(u32x4*)(WT + (size_t)(drow0 + n) * Kdst + k0 + 8 * c) = o; }
    LDS_WAIT(); asm volatile("" ::: "memory");
}
__device__ __forceinline__ void phase0(Ctx& F) {
    LAS float* silc = (LAS float*)(F.lds + MISC_OFF - 0);
    silc = (LAS float*)(F.lds + 0);
    for (int i = F.tid; i < 4 * DM; i += 512) silc[i] = siluf_(inp(F, I_C)[i]);
    __syncthreads();
    float* mod = (float*)(F.ws + WS_SMALL + SM_MOD);
    {
        const int gw = F.wave * F.G + F.bid;
        const int c = F.lane & 15, kp = F.lane >> 4;
        const float* wada = inp(F, I_WADA);
        for (int item = gw; item < NMOD / 16; item += 8 * F.G) {
            const int col = item * 16 + c;
            float a0 = 0.f, a1 = 0.f, a2 = 0.f, a3 = 0.f;
#pragma unroll 32
            for (int k = kp; k < DM; k += 4) { const float w = wada[(size_t)k * NMOD + col]; a0 += silc[k] * w; a1 += silc[DM + k] * w; a2 += silc[2 * DM + k] * w; a3 += silc[3 * DM + k] * w; }
            a0 += __shfl_xor(a0, 16); a0 += __shfl_xor(a0, 32); a1 += __shfl_xor(a1, 16); a1 += __shfl_xor(a1, 32);
            a2 += __shfl_xor(a2, 16); a2 += __shfl_xor(a2, 32); a3 += __shfl_xor(a3, 16); a3 += __shfl_xor(a3, 32);
            if (kp == 0) { const float bb = inp(F, I_BADA)[col]; mod[col] = a0 + bb; mod[NMOD + col] = a1 + bb; mod[2 * NMOD + col] = a2 + bb; mod[3 * NMOD + col] = a3 + bb; }
        }
    }
    __syncthreads();
    {
        LAS float* scr = (LAS float*)(F.lds + F.wave * 16384);
        const int gw = F.bid * 8 + F.wave, NGW = F.G * 8, lane = F.lane;
        constexpr int I_IN = 16 * 160, I_BR = 8 * 32, I_OUT = 16 * 32, I_EXP = 384, NIT = I_IN + 2 * I_BR + I_OUT + 65 * I_EXP;
        const float* p_win = inp(F, I_WIN); const float* p_bsb = inp(F, I_WBSB); const float* p_bmb = inp(F, I_WBMB); const float* p_out = inp(F, I_WOUT);
        const float* p_ge = inp(F, I_WGE); const float* p_ue = inp(F, I_WUE); const float* p_de = inp(F, I_WDE); const float* p_gs = inp(F, I_WGS); const float* p_us = inp(F, I_WUS); const float* p_ds = inp(F, I_WDS);
#define TD_GET(IT, SRC, LDN, DST, KD, F8) do { int r = (IT); F8 = 0; \
            if (r < I_IN) { const int kb = r / 160, nb = r % 160; SRC = p_win + (size_t)(kb * 64) * 5120 + nb * 32; LDN = 5120; \
                if (nb < 48) { DST = (bf16_t*)(F.ws + WS_WINT) + (size_t)(nb * 32) * 1024 + kb * 64; KD = 1024; } \
                else { DST = (bf16_t*)((unsigned char*)(F.ws + WS_WIN8) + (size_t)(nb * 32 - 1536) * 1024 + kb * 64); KD = 1024; F8 = 256; } } \
            else if ((r -= I_IN) < I_BR) { const int kb = r / 32, nb = r % 32; SRC = p_bsb + (size_t)(kb * 64) * 1024 + nb * 32; LDN = 1024; DST = (bf16_t*)(F.ws + WS_WBRT) + (size_t)(nb * 32) * 1024 + kb * 64; KD = 1024; } \
            else if ((r -= I_BR) < I_BR) { const int kb = r / 32, nb = r % 32; SRC = p_bmb + (size_t)(kb * 64) * 1024 + nb * 32; LDN = 1024; DST = (bf16_t*)(F.ws + WS_WBRT) + (size_t)(nb * 32) * 1024 + 512 + kb * 64; KD = 1024; } \
            else if ((r -= I_BR) < I_OUT) { const int kb = r / 32, nb = r % 32; SRC = p_out + (size_t)(kb * 64) * 1024 + nb * 32; LDN = 1024; DST = (bf16_t*)(F.ws + WS_WOUTT) + (size_t)(nb * 32) * 1024 + kb * 64; KD = 1024; } \
            else { r -= I_OUT; const int e = r / I_EXP; r -= e * I_EXP; \
                if (r < 128) { const int kb = r / 8, n0 = (r % 8) * 32; SRC = (e < NE ? p_ge + (size_t)e * DM * EFF : p_gs) + (size_t)(kb * 64) * EFF + n0; LDN = EFF; \
                    DST = (bf16_t*)((unsigned char*)(F.ws + WS_W1T) + ((size_t)e * 512 + (n0 >> 7) * 256 + (n0 & 127)) * 1024 + kb * 64); KD = 1024; F8 = 256; } \
                else if (r < 256) { r -= 128; const int kb = r / 8, n0 = (r % 8) * 32; SRC = (e < NE ? p_ue + (size_t)e * DM * EFF : p_us) + (size_t)(kb * 64) * EFF + n0; LDN = EFF; \
                    DST = (bf16_t*)((unsigned char*)(F.ws + WS_W1T) + ((size_t)e * 512 + (n0 >> 7) * 256 + 128 + (n0 & 127)) * 1024 + kb * 64); KD = 1024; F8 = 256; } \
                else { r -= 256; const int kb = r / 32, nb = r % 32; SRC = (e < NE ? p_de + (size_t)e * EFF * DM : p_ds) + (size_t)(kb * 64) * DM + nb * 32; LDN = DM; \
                    DST = (bf16_t*)((unsigned char*)(F.ws + WS_W2T) + ((size_t)e * 1024 + nb * 32) * 256 + kb * 64); KD = 256; F8 = 128; } } } while (0)
#define TD_LOAD(V, SRC, LDN) do { const float* wp_ = (SRC) + (size_t)(lane >> 3) * (LDN) + 4 * (lane & 7); _Pragma("unroll") for (int i = 0; i < 8; ++i) V[i] = *(const f32x4*)(wp_ + (size_t)(8 * i) * (LDN)); } while (0)
#define TD_PROC(V, DST, KD, F8) do { \
            _Pragma("unroll") for (int i = 0; i < 8; ++i) { LAS float* d = scr + (8 * i + (lane >> 3)) * 33 + 4 * (lane & 7); d[0] = V[i].x; d[1] = V[i].y; d[2] = V[i].z; d[3] = V[i].w; } \
            LDS_WAIT(); asm volatile("" ::: "memory"); \
            if (F8) { _Pragma("unroll") for (int j = 0; j < 4; ++j) { const int n = (lane >> 3) + 8 * j; const LAS float* sp = scr + (8 * (lane & 7)) * 33 + n; \
                int w0 = 0, w1 = 0; \
                const float fs_ = (float)(F8); w0 = __builtin_amdgcn_cvt_pk_fp8_f32(f8c(sp[0 * 33] * fs_), f8c(sp[1 * 33] * fs_), w0, false); w0 = __builtin_amdgcn_cvt_pk_fp8_f32(f8c(sp[2 * 33] * fs_), f8c(sp[3 * 33] * fs_), w0, true); \
                w1 = __builtin_amdgcn_cvt_pk_fp8_f32(f8c(sp[4 * 33] * fs_), f8c(sp[5 * 33] * fs_), w1, false); w1 = __builtin_amdgcn_cvt_pk_fp8_f32(f8c(sp[6 * 33] * fs_), f8c(sp[7 * 33] * fs_), w1, true); \
                *(u32x2*)((unsigned char*)(DST) + (size_t)n * (KD) + 8 * (lane & 7)) = (u32x2){(unsigned)w0, (unsigned)w1}; } } \
            else { _Pragma("unroll") for (int j = 0; j < 4; ++j) { const int n = (lane >> 3) + 8 * j; const LAS float* sp = scr + (8 * (lane & 7)) * 33 + n; \
                u32x4 o; o.x = cvtpk(sp[0 * 33], sp[1 * 33]); o.y = cvtpk(sp[2 * 33], sp[3 * 33]); o.z = cvtpk(sp[4 * 33], sp[5 * 33]); o.w = cvtpk(sp[6 * 33], sp[7 * 33]); \
                *(u32x4*)((DST) + (size_t)n * (KD) + 8 * (lane & 7)) = o; } } \
            LDS_WAIT(); asm volatile("" ::: "memory"); } while (0)
        for (int it = 4 * gw; it < NIT; it += 4 * NGW) {
            const float* src[4]; bf16_t* dst[4]; int ld[4], kd[4], f8[4];
            f32x4 v0[8], v1[8], v2[8], v3[8];
            TD_GET(it, src[0], ld[0], dst[0], kd[0], f8[0]); TD_GET(it + 1, src[1], ld[1], dst[1], kd[1], f8[1]); TD_GET(it + 2, src[2], ld[2], dst[2], kd[2], f8[2]); TD_GET(it + 3, src[3], ld[3], dst[3], kd[3], f8[3]);
            TD_LOAD(v0, src[0], ld[0]); TD_LOAD(v1, src[1], ld[1]); TD_LOAD(v2, src[2], ld[2]); TD_LOAD(v3, src[3], ld[3]);
            TD_PROC(v0, dst[0], kd[0], f8[0]); TD_PROC(v1, dst[1], kd[1], f8[1]); TD_PROC(v2, dst[2], kd[2], f8[2]); TD_PROC(v3, dst[3], kd[3], f8[3]);
        }
#undef TD_PROC
#undef TD_GET
#undef TD_LOAD
    }
    {
        bf16_t* wrh = (bf16_t*)(F.ws + WS_SMALL + SM_WRH); bf16_t* wrl = (bf16_t*)(F.ws + WS_SMALL + SM_WRL);
        const float* wr = inp(F, I_WR);
        for (int i = F.bid * 512 + F.tid; i < NE * DM; i += F.G * 512) { const int e = i >> 10, k = i & 1023; const float v = wr[k * NE + e];
            const unsigned h = cvtpk(v, 0.f) & 0xffffu; wrh[i] = (bf16_t)h; wrl[i] = (bf16_t)(cvtpk(v - bflo(h), 0.f) & 0xffffu); }
    }
}

__device__ __forceinline__ void phase1(Ctx& F) {
    const float* mod = (const float*)(F.ws + WS_SMALL + SM_MOD);
    const float* x = inp(F, I_X); const float* g1 = inp(F, I_N1G);
    bf16_t* H = (bf16_t*)(F.ws + WS_H); unsigned char* H8 = (unsigned char*)(F.ws + WS_H8);
    const int gw = F.bid * 8 + F.wave, NGW = F.G * 8;
    if (gw < 256) {
        const int b = gw >> 6, e = gw & 63; const float* wr = inp(F, I_WR); float a = 0.f;
#pragma unroll 4
        for (int k = F.lane; k < DM; k += 64) a += mod[b * NMOD + 3 * DM + k] * wr[k * NE + e];
        a = wave_sum(a);
        if (F.lane == 0) ((float*)(F.ws + WS_SMALL + SM_CB))[gw] = a;
    }
    if (F.bid == 32) {
        float* gvec = (float*)(F.ws + WS_SMALL + SM_GVEC); const float* g2 = inp(F, I_N2G);
        for (int i = F.tid; i < 4 * DM; i += 512) { const int b = i >> 10, k = i & 1023; gvec[i] = g2[k] * (1.f + mod[b * NMOD + 4 * DM + k]); }
    }
    for (int m0 = gw; m0 < MT; m0 += 2 * NGW) {
        const int m1 = m0 + NGW;
        const bool two = m1 < MT;
        const f32x4* xr0 = (const f32x4*)(x + (size_t)m0 * DM) + F.lane; const f32x4* xr1 = (const f32x4*)(x + (size_t)(two ? m1 : m0) * DM) + F.lane;
        f32x4 v0[4], v1[4]; float s0 = 0.f, s1 = 0.f;
#pragma unroll
        for (int j = 0; j < 4; ++j) { v0[j] = xr0[64 * j]; v1[j] = xr1[64 * j]; }
#pragma unroll
        for (int j = 0; j < 4; ++j) { s0 += (v0[j].x * v0[j].x + v0[j].y * v0[j].y) + (v0[j].z * v0[j].z + v0[j].w * v0[j].w); s1 += (v1[j].x * v1[j].x + v1[j].y * v1[j].y) + (v1[j].z * v1[j].z + v1[j].w * v1[j].w); }
        const float r0 = rsqrtf(wave_sum(s0) * (1.f / DM) + EPS), r1 = rsqrtf(wave_sum(s1) * (1.f / DM) + EPS);
        const int b0 = m0 / SEQ, b1 = (two ? m1 : m0) / SEQ;
        u32x2* o0 = (u32x2*)(H + (size_t)m0 * DM) + F.lane; u32x2* o1 = (u32x2*)(H + (size_t)(two ? m1 : m0) * DM) + F.lane;
#pragma unroll
        for (int j = 0; j < 4; ++j) {
            const int col = 4 * F.lane + 256 * j;
            const f32x4 g = *(const f32x4*)(g1 + col);
            const f32x4 h0 = (v0[j] * r0) * g * (*(const f32x4*)(mod + b0 * NMOD + DM + col) + 1.0f) + *(const f32x4*)(mod + b0 * NMOD + col);
            const f32x4 h1 = (v1[j] * r1) * g * (*(const f32x4*)(mod + b1 * NMOD + DM + col) + 1.0f) + *(const f32x4*)(mod + b1 * NMOD + col);
            u32x2 w; w.x = cvtpk(h0.x, h0.y); w.y = cvtpk(h0.z, h0.w); o0[64 * j] = w;
            { int q8 = 0; q8 = __builtin_amdgcn_cvt_pk_fp8_f32(f8c(h0.x * 16.f), f8c(h0.y * 16.f), q8, false); q8 = __builtin_amdgcn_cvt_pk_fp8_f32(f8c(h0.z * 16.f), f8c(h0.w * 16.f), q8, true);
              ((unsigned*)(H8 + (size_t)m0 * DM) + F.lane)[64 * j] = (unsigned)q8; }
            if (two) { w.x = cvtpk(h1.x, h1.y); w.y = cvtpk(h1.z, h1.w); o1[64 * j] = w;
                int q8 = 0; q8 = __builtin_amdgcn_cvt_pk_fp8_f32(f8c(h1.x * 16.f), f8c(h1.y * 16.f), q8, false); q8 = __builtin_amdgcn_cvt_pk_fp8_f32(f8c(h1.z * 16.f), f8c(h1.w * 16.f), q8, true);
                ((unsigned*)(H8 + (size_t)m1 * DM) + F.lane)[64 * j] = (unsigned)q8; }
        }
    }
}

struct ProjSched {
    const char* A; const char* Bt; int G, c, pn0, npn, f8; int R[2], C[2];
    __device__ __forceinline__ bool next(int i, gm::UnitD& u) {
        int pm, pn; if (!gm::static_tile(MT, npn * 256, G, c, i, pm, pn)) return false;
        const int kp = f8 ? 512 : 1024;
        u.a = A; u.b = Bt + (size_t)pn * 256 * kp * 2;
#pragma unroll
        for (int h = 0; h < 2; ++h)
#pragma unroll
            for (int j = 0; j < 2; ++j) u.va[h][j] = (unsigned)((pm * 256 + h * 128 + R[j]) * kp + C[j]) * 2u;
        u.e0 = pm; u.e1 = pn0 + pn; u.e2 = f8; u.e3 = 0; return true;
    }
};
struct EpiProj {
    bf16_t* qsb; bf16_t* qmb; bf16_t* g; float* kbs;
    __device__ __forceinline__ void operator()(const f32x4 (&acc)[2][2][4][2], const gm::UnitD& u, int wr, int wc, int fr, int fq) const {
        const int pm = u.e0, pn = u.e1;
        bf16_t* base; int ldc, colt; float sc = 1.f;
        if (pn < 6) { base = qsb; ldc = QW; colt = pn * 256; if (pn < 2) sc = 0.125f * LOG2E; }
        else if (pn < 12) { base = qmb; ldc = QW; colt = (pn - 6) * 256; if (pn < 8) sc = 0.125f; }
        else { base = g; ldc = 2048; colt = (pn - 12) * 256; }
        if (u.e2) sc *= (1.f / 4096.f);
        const int row0 = pm * 256 + wr * 64 + fr, col0 = colt + wc * 32 + 8 * fq;
        if (pn == 8 || pn == 9) {
#pragma unroll
            for (int bj = 0; bj < 2; ++bj)
#pragma unroll
                for (int n = 0; n < 2; ++n) { f32x4 cs = (f32x4){0.f, 0.f, 0.f, 0.f};
#pragma unroll
                    for (int ai = 0; ai < 2; ++ai)
#pragma unroll
                        for (int m = 0; m < 4; ++m) cs += acc[ai][bj][m][n];
#pragma unroll
                    for (int o = 1; o < 16; o <<= 1) { cs[0] += __shfl_xor(cs[0], o); cs[1] += __shfl_xor(cs[1], o); cs[2] += __shfl_xor(cs[2], o); cs[3] += __shfl_xor(cs[3], o); }
                    if (fr == 0) { float* kd = kbs + (size_t)pm * 512 + (pn - 8) * 256 + bj * 128 + wc * 32 + 8 * fq + 4 * n;
#pragma unroll
                        for (int j = 0; j < 4; ++j) atomicAdd(kd + j, cs[j]); } }
        }
#pragma unroll
        for (int ai = 0; ai < 2; ++ai)
#pragma unroll
            for (int m = 0; m < 4; ++m) { bf16_t* rowp = base + (size_t)(row0 + ai * 128 + m * 16) * ldc + col0;
#pragma unroll
                for (int bj = 0; bj < 2; ++bj) { const f32x4 v0 = acc[ai][bj][m][0] * sc, v1 = acc[ai][bj][m][1] * sc;
                    u32x4 w; w.x = cvtpk(v0[0], v0[1]); w.y = cvtpk(v0[2], v0[3]); w.z = cvtpk(v1[0], v1[1]); w.w = cvtpk(v1[2], v1[3]);
                    *(u32x4*)(rowp + bj * 128) = w; } }
    }
};
__device__ __forceinline__ void phase2(Ctx& F) {
    EpiProj E{(bf16_t*)(F.ws + WS_QSB), (bf16_t*)(F.ws + WS_QMB), (bf16_t*)(F.ws + WS_G), (float*)(F.ws + WS_CTL + CTL_KBS)};
    {
        ProjSched S; S.A = (const char*)(F.ws + WS_H); S.Bt = (const char*)(F.ws + WS_WINT); S.G = F.G; S.c = F.bid; S.pn0 = 0; S.npn = 6; S.f8 = 0; gm::stage_geom(F.tid, S.R, S.C);
        gm::gemm_phase<true>(F.lds, 1024, S, E);
    }
    {
        ProjSched S; S.A = (const char*)(F.ws + WS_H8); S.Bt = (const char*)(F.ws + WS_WIN8); S.G = F.G; S.c = F.bid; S.pn0 = 6; S.npn = 14; S.f8 = 1; gm::stage_geom(F.tid, S.R, S.C);
        gm::gemm_phase<true, false, true>(F.lds, 512, S, E);
    }
}

__device__ __forceinline__ int crow(int r, int hi) { return (r & 3) + 8 * (r >> 2) + 4 * hi; }
typedef short v4i16_t __attribute__((ext_vector_type(4)));
__device__ __forceinline__ s16x4 vtr(const LAS unsigned char* p) { return __builtin_bit_cast(s16x4, __builtin_amdgcn_ds_read_tr16_b64_v4i16((LAS v4i16_t*)p)); }
__device__ __forceinline__ void pv64(f32x16 (&o)[2], const LAS unsigned char* vt, int lane, const u32x4 (&pw)[4]) {
    const int hi = lane >> 5;
    const LAS unsigned char* vb = vt + ((lane >> 4) & 1) * 32 + (lane & 3) * 8 + (4 * hi + ((lane & 15) >> 2)) * 64;
#pragma unroll
    for (int d0 = 0; d0 < 2; ++d0)
#pragma unroll
        for (int ks = 0; ks < 4; ++ks) {
            const s16x4 lo = vtr(vb + d0 * 4096 + ks * 1024), hh = vtr(vb + d0 * 4096 + ks * 1024 + 512);
            const bf16x8 bv = (bf16x8){lo[0], lo[1], lo[2], lo[3], hh[0], hh[1], hh[2], hh[3]};
            o[d0] = __builtin_amdgcn_mfma_f32_32x32x16_bf16(__builtin_bit_cast(bf16x8, pw[ks]), bv, o[d0], 0, 0, 0);
        }
}
__device__ __forceinline__ void store_o_tile(const f32x16 (&o)[2], LAS unsigned char* stgb, int lane, bf16_t* dst0, size_t row_pitch) {
    const int r32 = lane & 31, hi = lane >> 5;
    LAS bf16_t* stg = (LAS bf16_t*)stgb;
#pragma unroll
    for (int r = 0; r < 16; ++r) { const int orow = crow(r, hi);
#pragma unroll
        for (int d0 = 0; d0 < 2; ++d0) stg[orow * 64 + d0 * 32 + r32] = (bf16_t)(cvtpk(o[d0][r], 0.f) & 0xffffu); }
    LDS_WAIT();
#pragma unroll
    for (int i = 0; i < 4; ++i) { const int row = i * 8 + (lane >> 3), ch = lane & 7; const u32x4 v = *(const LAS u32x4*)(stg + row * 64 + ch * 8); *(u32x4*)(dst0 + (size_t)row * row_pitch + ch * 8) = v; }
    LDS_WAIT();
}

template <bool MASKED>
__device__ __forceinline__ void sb_tile(const f32x16 (&z)[2], float& P, u32x4 (&pw)[4], int k0, int qpos, int hi) {
    f32x16 be[2], nb[2];
#pragma unroll
    for (int p = 0; p < 2; ++p)
#pragma unroll
        for (int r = 0; r < 16; ++r) {
            const float zz = __builtin_amdgcn_fmed3f(z[p][r], -126.f, 126.f);
            const float t = __builtin_amdgcn_exp2f(-zz), b_ = __builtin_amdgcn_rcpf(1.f + t);
            float n_ = t * b_, bb = b_;
            if (MASKED) { const bool valid = (k0 + 32 * p + crow(r, hi)) < qpos; n_ = valid ? n_ : 1.f; bb = valid ? bb : 0.f; }
            be[p][r] = bb; nb[p][r] = n_;
        }
    float Gp[8], PG[8], off[8];
#pragma unroll
    for (int idx = 0; idx < 8; ++idx) { const int p = idx >> 2, g4 = (idx & 3) * 4; Gp[idx] = (nb[p][g4] * nb[p][g4 + 1]) * (nb[p][g4 + 2] * nb[p][g4 + 3]); }
#pragma unroll
    for (int idx = 0; idx < 8; ++idx) PG[idx] = __shfl_xor(Gp[idx], 32);
    float run = P;
#pragma unroll
    for (int idx = 7; idx >= 0; --idx) { off[idx] = hi ? run : run * PG[idx]; run *= (Gp[idx] * PG[idx]); }
    P = run;
#pragma unroll
    for (int idx = 0; idx < 8; ++idx) { const int p = idx >> 2, g4 = (idx & 3) * 4; float c = off[idx]; float a[4];
#pragma unroll
        for (int j = 3; j >= 0; --j) { a[j] = be[p][g4 + j] * c; c *= nb[p][g4 + j]; }
        pw[idx >> 1][(idx & 1) * 2] = cvtpk(a[0], a[1]); pw[idx >> 1][(idx & 1) * 2 + 1] = cvtpk(a[2], a[3]); }
}
__device__ __forceinline__ void sb_unit(Ctx& F, int bh, int qt, LAS unsigned char* vl) {
    const int lane = F.lane, r32 = lane & 31, hi = lane >> 5;
    const int b = bh >> 3, h = bh & 7, q0 = qt * 32, qpos = q0 + r32;
    const bf16_t* base = (const bf16_t*)(F.ws + WS_QSB) + (size_t)b * SEQ * QW + h * 64;
    const bf16_t* Kb = base + 512 + (size_t)r32 * QW + hi * 8; const bf16_t* Vb = base + 1024 + (size_t)(lane >> 2) * QW + (lane & 3) * 8;
    bf16x8 qr[4];
#pragma unroll
    for (int d0 = 0; d0 < 4; ++d0) qr[d0] = *(const bf16x8*)(base + (size_t)qpos * QW + d0 * 16 + hi * 8);
    float P = 1.f; f32x16 o[2]; o[0] = f32x16{}; o[1] = f32x16{};
    bf16x8 kfn[8];
    const int kt0 = q0 >> 6; int kt = kt0, cur = 0;
#define SB_PREFETCH(KT, BUF) do { const size_t ko_ = (size_t)(KT) * 64 * QW; \
        _Pragma("unroll") for (int d0 = 0; d0 < 4; ++d0) _Pragma("unroll") for (int hf = 0; hf < 2; ++hf) kfn[2 * d0 + hf] = *(const bf16x8*)(Kb + ko_ + (size_t)(32 * hf) * QW + d0 * 16); \
        _Pragma("unroll") for (int p = 0; p < 8; ++p) __builtin_amdgcn_global_load_lds((const unsigned*)(Vb + ko_ + (size_t)(16 * (p & 3)) * QW + (p >> 2) * 32), (LAS unsigned*)(vl + (BUF) * 8192 + p * 1024), 16, 0, 0); } while (0)
    SB_PREFETCH(kt, 0);
#pragma unroll 1
    for (; kt >= 0; --kt) {
        if (__all(P == 0.f)) break;
        f32x16 z[2]; z[0] = f32x16{}; z[1] = f32x16{};
#pragma unroll
        for (int d0 = 0; d0 < 4; ++d0) { z[0] = __builtin_amdgcn_mfma_f32_32x32x16_bf16(kfn[2 * d0], qr[d0], z[0], 0, 0, 0); z[1] = __builtin_amdgcn_mfma_f32_32x32x16_bf16(kfn[2 * d0 + 1], qr[d0], z[1], 0, 0, 0); }
        asm volatile("" : "+v"(z[0]), "+v"(z[1]));
        { const int ktn = kt > 0 ? kt - 1 : 0; SB_PREFETCH(ktn, cur ^ 1); }
        u32x4 pw[4];
        if (kt == kt0) sb_tile<true>(z, P, pw, kt * 64, qpos, hi); else sb_tile<false>(z, P, pw, kt * 64, qpos, hi);
        asm volatile("s_waitcnt vmcnt(16)" ::: "memory");
        pv64(o, vl + cur * 8192, lane, pw);
        cur ^= 1;
    }
#undef SB_PREFETCH
    asm volatile("s_waitcnt vmcnt(0)" ::: "memory");
    bf16_t* dst = (bf16_t*)(F.ws + WS_OB) + (size_t)(b * SEQ + q0) * 1024 + h * 64;
    store_o_tile(o, vl, lane, dst, 1024);
}
__device__ __forceinline__ void sb_units(Ctx& F) {
    const int gw = F.bid * 8 + F.wave, NGW = F.G * 8;
    LAS unsigned char* vl = F.lds + F.wave * 16384;
    for (int u = gw; u < 32 * 256; u += NGW) sb_unit(F, u >> 8, u & 255, vl);
}

constexpr int MO_LUT = 0, MO_PRE = 4224, MO_WSF = 8320, MO_ENT = 12416, MO_ST = 16368;
__device__ __forceinline__ int mb_list_off(int j) { return 256 * (31 * j - (j * (j - 1)) / 2); }
constexpr int MB_LIST_STRIDE = 126976;
__device__ __forceinline__ int t5_bucket_dev(int n) {
    if (n < 16) return n;
    int large = 16 + (int)(logf((float)n / 16.f) / 2.0794415416798357f * 16.f);
    return large < 31 ? large : 31;
}
__device__ __forceinline__ void build_lut(Ctx& F) {
    LAS float* lut = (LAS float*)(F.lds + MISC_OFF + MO_LUT);
    for (int i = F.tid; i < 8 * 132; i += 512) { const int h = i / 132, d = i % 132; lut[i] = inp(F, I_RELB)[h * 32 + t5_bucket_dev(d < 128 ? d : 128)] * LOG2E; }
}
__device__ __forceinline__ void phase4(Ctx& F) {
    LAS int* lcnt = (LAS int*)(F.lds + MISC_OFF + MO_PRE); LAS int* lbase = lcnt + 32;
    const float* kbar = (const float*)(F.ws + WS_CTL + CTL_KBS);
    unsigned* cur = (unsigned*)(F.ws + WS_CTL) + CW_MBCUR;
    unsigned short* lists = (unsigned short*)(F.ws + WS_LMB);
    const int lane = F.lane, r32 = lane & 31, hi = lane >> 5;
    for (int u = F.bid; u < 32 * 31; u += F.G) {
        const int bh = u / 31, i = 1 + (u % 31), b = bh >> 3, h = bh & 7;
        if (F.tid < 32) lcnt[F.tid] = 0;
        __syncthreads();
        const int qpos = i * 256 + F.wave * 32 + r32;
        const float* kp = kbar + (size_t)(b * 32 + r32) * 512 + h * 64 + hi * 8;
        const bf16_t* qp = (const bf16_t*)(F.ws + WS_QMB) + (size_t)(b * SEQ + qpos) * QW + h * 64 + hi * 8;
        f32x16 gt = f32x16{};
#pragma unroll
        for (int s4 = 0; s4 < 4; ++s4) {
            const f32x4 k0 = *(const f32x4*)(kp + 16 * s4), k1 = *(const f32x4*)(kp + 16 * s4 + 4);
            const bf16x8 qf = *(const bf16x8*)(qp + 16 * s4);
            const unsigned a0 = cvtpk(k0.x, k0.y), a1 = cvtpk(k0.z, k0.w), a2 = cvtpk(k1.x, k1.y), a3 = cvtpk(k1.z, k1.w);
            const u32x4 kh = (u32x4){a0, a1, a2, a3};
            const u32x4 kl = (u32x4){cvtpk(k0.x - bflo(a0), k0.y - bfhi(a0)), cvtpk(k0.z - bflo(a1), k0.w - bfhi(a1)), cvtpk(k1.x - bflo(a2), k1.y - bfhi(a2)), cvtpk(k1.z - bflo(a3), k1.w - bfhi(a3))};
            gt = __builtin_amdgcn_mfma_f32_32x32x16_bf16(__builtin_bit_cast(bf16x8, kl), qf, gt, 0, 0, 0);
            gt = __builtin_amdgcn_mfma_f32_32x32x16_bf16(__builtin_bit_cast(bf16x8, kh), qf, gt, 0, 0, 0);
        }
        float v0 = -INFINITY, v1 = -INFINITY, v2 = -INFINITY; int j0 = 64, j1 = 64, j2 = 64;
#pragma unroll
        for (int r = 0; r < 16; ++r) { const int j = crow(r, hi); const float g = j < i ? gt[r] : -INFINITY;
            if (g > v0) { v2 = v1; j2 = j1; v1 = v0; j1 = j0; v0 = g; j0 = j; }
            else if (g > v1) { v2 = v1; j2 = j1; v1 = g; j1 = j; }
            else if (g > v2) { v2 = g; j2 = j; } }
        {
            const float pv[3] = {__shfl_xor(v0, 32), __shfl_xor(v1, 32), __shfl_xor(v2, 32)}; const int pj[3] = {__shfl_xor(j0, 32), __shfl_xor(j1, 32), __shfl_xor(j2, 32)};
#pragma unroll
            for (int t = 0; t < 3; ++t) { const float g = pv[t]; const int j = pj[t];
                if (g > v0 || (g == v0 && j < j0)) { v2 = v1; j2 = j1; v1 = v0; j1 = j0; v0 = g; j0 = j; }
                else if (g > v1 || (g == v1 && j < j1)) { v2 = v1; j2 = j1; v1 = g; j1 = j; }
                else if (g > v2 || (g == v2 && j < j2)) { v2 = g; j2 = j; } }
        }
        const int nsel = i < 3 ? i : 3;
        int r0 = 0, r1 = 0, r2 = 0;
        if (hi == 0) { r0 = lds_add(&lcnt[j0], 1); if (nsel > 1) r1 = lds_add(&lcnt[j1], 1); if (nsel > 2) r2 = lds_add(&lcnt[j2], 1); }
        __syncthreads();
        if (F.tid < i) { const int n = lcnt[F.tid]; lbase[F.tid] = n > 0 ? (int)atomicAdd(&cur[bh * 32 + F.tid], (unsigned)n) : 0; }
        __syncthreads();
        if (hi == 0) {
            unsigned short* lb = lists + (size_t)bh * MB_LIST_STRIDE;
            lb[mb_list_off(j0) + lbase[j0] + r0] = (unsigned short)(qpos | (0 << 13));
            if (nsel > 1) lb[mb_list_off(j1) + lbase[j1] + r1] = (unsigned short)(qpos | (1 << 13));
            if (nsel > 2) lb[mb_list_off(j2) + lbase[j2] + r2] = (unsigned short)(qpos | (2 << 13));
        }
    }
}
__device__ __forceinline__ void kv_dma(Ctx& F, const bf16_t* kg, const bf16_t* vg, int bufoff) {
    const int l = F.lane;
#pragma unroll
    for (int i = 0; i < 4; ++i) { const int p = 4 * F.wave + i;
        __builtin_amdgcn_global_load_lds((const unsigned*)(kg + (size_t)(8 * p + (l >> 3)) * QW + ((l & 7) ^ ((l >> 3) & 7)) * 8), (LAS unsigned*)(F.lds + bufoff + p * 1024), 16, 0, 0);
        __builtin_amdgcn_global_load_lds((const unsigned*)(vg + (size_t)((p >> 3) * 64 + (p & 3) * 16 + (l >> 2)) * QW + ((p >> 2) & 1) * 32 + (l & 3) * 8), (LAS unsigned*)(F.lds + bufoff + 32768 + p * 1024), 16, 0, 0); }
}
__device__ __forceinline__ void softmax_step(f32x16 (&t)[2], float& m, float& l, f32x16 (&o)[2], LAS float* wsf, const LAS unsigned char* vt, int lane) {
    const int r32 = lane & 31, hi = lane >> 5;
    float rm = -INFINITY;
#pragma unroll
    for (int p = 0; p < 2; ++p)
#pragma unroll
        for (int r = 0; r < 16; ++r) rm = fmaxf(rm, t[p][r]);
    rm = fmaxf(rm, __shfl_xor(rm, 32));
    const float mn = fmaxf(m, rm);
    const float f = __builtin_amdgcn_exp2f(m - mn);
    m = mn;
    float s = 0.f; u32x4 pw[4];
#pragma unroll
    for (int p = 0; p < 2; ++p)
#pragma unroll
        for (int r = 0; r < 16; ++r) { const float e = __builtin_amdgcn_exp2f(t[p][r] - mn); t[p][r] = e; s += e; }
    l = l * f + s;
#pragma unroll
    for (int idx = 0; idx < 8; ++idx) { const int p = idx >> 2, g4 = (idx & 3) * 4; pw[idx >> 1][(idx & 1) * 2] = cvtpk(t[p][g4], t[p][g4 + 1]); pw[idx >> 1][(idx & 1) * 2 + 1] = cvtpk(t[p][g4 + 2], t[p][g4 + 3]); }
    if (__any(f != 1.f)) {
        if (hi == 0) wsf[r32] = f;
        LDS_WAIT();
#pragma unroll
        for (int g = 0; g < 4; ++g) { const f32x4 fv = *(const LAS f32x4*)(wsf + 8 * g + 4 * hi);
#pragma unroll
            for (int j = 0; j < 4; ++j) { o[0][4 * g + j] *= fv[j]; o[1][4 * g + j] *= fv[j]; } }
        LDS_WAIT();
    }
    pv64(o, vt, lane, pw);
}
__device__ __forceinline__ void qkt64(f32x16 (&t)[2], const LAS unsigned char* kt, const bf16x8 (&qr)[4], int lane) {
    const int r32 = lane & 31, hi = lane >> 5;
    t[0] = f32x16{}; t[1] = f32x16{};
    const LAS unsigned char* rp = kt + r32 * 128;
#pragma unroll
    for (int d0 = 0; d0 < 4; ++d0) {
        const int pos = ((2 * d0 + hi) ^ (r32 & 7)) * 16;
        const bf16x8 k0 = *(const LAS bf16x8*)(rp + pos), k1 = *(const LAS bf16x8*)(rp + 4096 + pos);
        t[0] = __builtin_amdgcn_mfma_f32_32x32x16_bf16(k0, qr[d0], t[0], 0, 0, 0); t[1] = __builtin_amdgcn_mfma_f32_32x32x16_bf16(k1, qr[d0], t[1], 0, 0, 0);
    }
}
__device__ __forceinline__ void phase5(Ctx& F) {
    LAS int* pre = (LAS int*)(F.lds + MISC_OFF + MO_PRE);
    LAS int* wtot = (LAS int*)(F.lds + MISC_OFF + MO_ENT);
    const unsigned* cur = (const unsigned*)(F.ws + WS_CTL) + CW_MBCUR;
    build_lut(F);
    int total;
    {
        const int p0 = 2 * F.tid, p1 = p0 + 1;
        const int c0 = p0 < 992 ? (int)((cur[(p0 / 31) * 32 + (p0 % 31)] + 255u) >> 8) : 0;
        const int c1 = p1 < 992 ? (int)((cur[(p1 / 31) * 32 + (p1 % 31)] + 255u) >> 8) : 0;
        const int s = c0 + c1; int v = s;
#pragma unroll
        for (int o = 1; o < 64; o <<= 1) { const int n = __shfl_up(v, o); if (F.lane >= o) v += n; }
        if (F.lane == 63) wtot[248 + F.wave] = v;
        __syncthreads();
        int woff = 0; total = 0;
#pragma unroll
        for (int w = 0; w < 8; ++w) { const int x = wtot[248 + w]; if (w < F.wave) woff += x; total += x; }
        const int excl = woff + v - s;
        pre[p0] = excl; pre[p1] = excl + c0;
        __syncthreads();
    }
    const unsigned short* lists = (const unsigned short*)(F.ws + WS_LMB);
    LAS float* wsf = (LAS float*)(F.lds + MISC_OFF + MO_WSF) + F.wave * 128;
    LAS int* ent = (LAS int*)(F.lds + MISC_OFF + MO_ENT) + F.wave * 32;
    const int lane = F.lane, r32 = lane & 31, hi = lane >> 5;
#define P5_UNIT(U, BH, J, C) do { int lo_ = 0, hi_ = 992; while (hi_ - lo_ > 1) { const int mid = (lo_ + hi_) >> 1; if (pre[mid] <= (U)) lo_ = mid; else hi_ = mid; } BH = lo_ / 31; J = lo_ % 31; C = (U) - pre[lo_]; } while (0)
#define P5_DMA(BH, J, BUF) do { const bf16_t* b_ = (const bf16_t*)(F.ws + WS_QMB) + (size_t)((BH) >> 3) * SEQ * QW + ((BH) & 7) * 64; kv_dma(F, b_ + 512 + (size_t)((J) * 256) * QW, b_ + 1024 + (size_t)((J) * 256) * QW, (BUF) * 65536); } while (0)
#define P5_ENTRY(BH, J, C, ACT, VALID, ENTRY) do { const int n_ = (int)cur[(BH) * 32 + (J)]; const int e0_ = (C) * 256 + F.wave * 32; ACT = e0_ < n_; VALID = ACT && (e0_ + r32) < n_; \
        const unsigned short* lb_ = lists + (size_t)(BH) * MB_LIST_STRIDE + mb_list_off(J); ENTRY = ACT ? (int)lb_[VALID ? e0_ + r32 : e0_] : 0; } while (0)
#define P5_QLOAD(BH, ENTRY, Q) do { const bf16_t* b_ = (const bf16_t*)(F.ws + WS_QMB) + (size_t)((BH) >> 3) * SEQ * QW + ((BH) & 7) * 64 + (size_t)((ENTRY) & 8191) * QW + hi * 8; \
        _Pragma("unroll") for (int d0 = 0; d0 < 4; ++d0) Q[d0] = *(const bf16x8*)(b_ + d0 * 16); } while (0)
    int u = F.bid, bh = 0, j = 0, c = 0, buf = 0;
    bool act = false, valid = false; int entry = 0; bf16x8 qr[4];
    if (u < total) { P5_UNIT(u, bh, j, c); P5_DMA(bh, j, 0); P5_ENTRY(bh, j, c, act, valid, entry); P5_QLOAD(bh, entry, qr); }
    for (; u < total; u += F.G) {
        const int un = u + F.G; int bhn = 0, jn = 0, cn = 0;
        const bool has_next = un < total;
        if (has_next) P5_UNIT(un, bhn, jn, cn);
        const int h = bh & 7;
        const int qpos = entry & 8191, slot = entry >> 13;
        asm volatile("s_waitcnt vmcnt(0)" ::: "memory");
        __syncthreads();
        bool actn = false, validn = false; int entryn = 0; bf16x8 qn[4];
        if (has_next) { P5_DMA(bhn, jn, buf ^ 1); P5_ENTRY(bhn, jn, cn, actn, validn, entryn); }
        const LAS unsigned char* kimg = F.lds + buf * 65536; const LAS unsigned char* vimg = kimg + 32768;
        if (act) {
            if (hi == 0) ent[r32] = valid ? entry : -1;
            float m = -INFINITY, l = 0.f; f32x16 o[2]; o[0] = f32x16{}; o[1] = f32x16{};
            const LAS float* lut = (const LAS float*)(F.lds + MISC_OFF + MO_LUT) + h * 132;
            const float bfar = lut[128];
#pragma unroll 1
            for (int st = 0; st < 4; ++st) {
                if (st == 2 && has_next) P5_QLOAD(bhn, entryn, qn);
                f32x16 t[2]; qkt64(t, kimg + st * 8192, qr, lane);
                const int kbase = j * 256 + st * 64;
                const bool far = __all(qpos - (kbase + 63) >= 128);
                if (far) {
#pragma unroll
                    for (int pp = 0; pp < 2; ++pp)
#pragma unroll
                        for (int r = 0; r < 16; ++r) t[pp][r] = t[pp][r] * LOG2E + bfar;
                } else {
#pragma unroll
                    for (int pp = 0; pp < 2; ++pp)
#pragma unroll
                        for (int r = 0; r < 16; ++r) { int d = qpos - (kbase + 32 * pp + crow(r, hi)); d = d < 128 ? d : 128; d = d > 0 ? d : 0; t[pp][r] = t[pp][r] * LOG2E + lut[d]; }
                }
                softmax_step(t, m, l, o, wsf, vimg + st * 8192, lane);
            }
            l += __shfl_xor(l, 32);
            const float rl = 1.f / l;
            if (hi == 0) { wsf[r32] = rl; if (valid) ((float*)(F.ws + WS_PLSE))[((size_t)bh * SEQ + qpos) * 3 + slot] = m + __log2f(l); }
            LDS_WAIT();
            {
                LAS bf16_t* stg = (LAS bf16_t*)(F.lds + MISC_OFF + MO_STG + F.wave * 2048);
                bf16_t* po = (bf16_t*)(F.ws + WS_PO);
#pragma unroll
                for (int d0 = 0; d0 < 2; ++d0) {
#pragma unroll
                    for (int r = 0; r < 16; ++r) { const int q = crow(r, hi); stg[q * 32 + r32] = (bf16_t)(cvtpk(o[d0][r] * wsf[q], 0.f) & 0xffffu); }
                    LDS_WAIT();
#pragma unroll
                    for (int it2 = 0; it2 < 2; ++it2) { const int row = it2 * 16 + (lane >> 2), ch = lane & 3; const int en = ent[row];
                        const u32x4 v = *(const LAS u32x4*)(stg + row * 32 + ch * 8);
                        if (en >= 0) *(u32x4*)(po + (((size_t)bh * SEQ + (en & 8191)) * 3 + (en >> 13)) * 64 + d0 * 32 + ch * 8) = v; }
                    LDS_WAIT();
                }
            }
        } else if (has_next) { P5_QLOAD(bhn, entryn, qn); }
        bh = bhn; j = jn; c = cn; buf ^= 1; act = actn; valid = validn; entry = entryn;
#pragma unroll
        for (int d0 = 0; d0 < 4; ++d0) qr[d0] = qn[d0];
    }
#undef P5_ENTRY
#undef P5_QLOAD
#undef P5_UNIT
#undef P5_DMA
    asm volatile("s_waitcnt vmcnt(0)" ::: "memory");
    __syncthreads();
}
__device__ __forceinline__ void phase6(Ctx& F) {
    build_lut(F);
    LAS float* wsf = (LAS float*)(F.lds + MISC_OFF + MO_WSF) + F.wave * 128;
    const int lane = F.lane, r32 = lane & 31, hi = lane >> 5, w = F.wave;
#define P6_DMA(U, BUF) do { const int bh_ = (U) >> 5, i_ = 31 - ((U) & 31); const bf16_t* b_ = (const bf16_t*)(F.ws + WS_QMB) + (size_t)(bh_ >> 3) * SEQ * QW + (bh_ & 7) * 64; \
        kv_dma(F, b_ + 512 + (size_t)(i_ * 256) * QW, b_ + 1024 + (size_t)(i_ * 256) * QW, (BUF) * 65536); } while (0)
    int buf = 0;
    if (F.bid < 32 * 32) P6_DMA(F.bid, 0);
    for (int u = F.bid; u < 32 * 32; u += F.G) {
        const int bh = u >> 5, i = 31 - (u & 31), b = bh >> 3, h = bh & 7;
        const bf16_t* base = (const bf16_t*)(F.ws + WS_QMB) + (size_t)b * SEQ * QW + h * 64;
        const int ql = w * 32 + r32, qpos = i * 256 + ql;
        bf16x8 qr[4];
#pragma unroll
        for (int d0 = 0; d0 < 4; ++d0) qr[d0] = *(const bf16x8*)(base + (size_t)qpos * QW + d0 * 16 + hi * 8);
        const int nsel = i < 3 ? i : 3;
        const float* plse = (const float*)(F.ws + WS_PLSE) + ((size_t)bh * SEQ + qpos) * 3;
        float ls0 = -INFINITY, ls1 = -INFINITY, ls2 = -INFINITY;
        if (nsel > 0) ls0 = plse[0]; if (nsel > 1) ls1 = plse[1]; if (nsel > 2) ls2 = plse[2];
        asm volatile("s_waitcnt vmcnt(0)" ::: "memory");
        __syncthreads();
        if (u + F.G < 32 * 32) P6_DMA(u + F.G, buf ^ 1);
        const LAS unsigned char* kimg = F.lds + buf * 65536; const LAS unsigned char* vimg = kimg + 32768;
        float m = -INFINITY, l = 0.f; f32x16 o[2]; o[0] = f32x16{}; o[1] = f32x16{};
        const LAS float* lut = (const LAS float*)(F.lds + MISC_OFF + MO_LUT) + h * 132;
        const int nst = (w >> 1) + 1;
#pragma unroll 1
        for (int st = 0; st < nst; ++st) {
            f32x16 t[2]; qkt64(t, kimg + st * 8192, qr, lane);
#pragma unroll
            for (int pp = 0; pp < 2; ++pp)
#pragma unroll
                for (int r = 0; r < 16; ++r) { const int d = ql - (st * 64 + 32 * pp + crow(r, hi)); const int dc = d < 128 ? (d > 0 ? d : 0) : 128; const float v = t[pp][r] * LOG2E + lut[dc]; t[pp][r] = d >= 0 ? v : -INFINITY; }
            softmax_step(t, m, l, o, wsf, vimg + st * 8192, lane);
        }
        l += __shfl_xor(l, 32);
        const float M = fmaxf(fmaxf(m, ls0), fmaxf(ls1, ls2));
        const float eo = __builtin_amdgcn_exp2f(m - M), e0 = __builtin_amdgcn_exp2f(ls0 - M), e1 = __builtin_amdgcn_exp2f(ls1 - M), e2 = __builtin_amdgcn_exp2f(ls2 - M);
        const float rden = 1.f / (l * eo + e0 + e1 + e2);
        if (hi == 0) *(LAS f32x4*)(wsf + 4 * r32) = (f32x4){eo * rden, e0 * rden, e1 * rden, e2 * rden};
        LDS_WAIT();
#pragma unroll
        for (int r = 0; r < 16; ++r) { const float fo = wsf[4 * crow(r, hi)]; o[0][r] *= fo; o[1][r] *= fo; }
        __syncthreads();
        {
            LAS bf16_t* stg = (LAS bf16_t*)(F.lds + buf * 65536 + w * 4096);
#pragma unroll
            for (int r = 0; r < 16; ++r) { const int orow = crow(r, hi);
#pragma unroll
                for (int d0 = 0; d0 < 2; ++d0) stg[orow * 64 + d0 * 32 + r32] = (bf16_t)(cvtpk(o[d0][r], 0.f) & 0xffffu); }
            LDS_WAIT();
            const bf16_t* po = (const bf16_t*)(F.ws + WS_PO) + ((size_t)bh * SEQ + i * 256 + w * 32) * 3 * 64;
            bf16_t* dst = (bf16_t*)(F.ws + WS_OB) + (size_t)(b * SEQ + i * 256 + w * 32) * 1024 + 512 + h * 64;
#pragma unroll
            for (int it4 = 0; it4 < 4; ++it4) { const int row = it4 * 8 + (lane >> 3), ch = lane & 7;
                const u32x4 ov = *(const LAS u32x4*)(stg + row * 64 + ch * 8);
                float a[8] = {bflo(ov.x), bfhi(ov.x), bflo(ov.y), bfhi(ov.y), bflo(ov.z), bfhi(ov.z), bflo(ov.w), bfhi(ov.w)};
                const f32x4 fc = *(const LAS f32x4*)(wsf + 4 * row);
#pragma unroll
                for (int sl = 0; sl < 3; ++sl) if (sl < nsel) { const u32x4 pv = *(const u32x4*)(po + (size_t)(row * 3 + sl) * 64 + ch * 8); const float f = fc[1 + sl];
                    a[0] += f * bflo(pv.x); a[1] += f * bfhi(pv.x); a[2] += f * bflo(pv.y); a[3] += f * bfhi(pv.y); a[4] += f * bflo(pv.z); a[5] += f * bfhi(pv.z); a[6] += f * bflo(pv.w); a[7] += f * bfhi(pv.w); }
                u32x4 w4; w4.x = cvtpk(a[0], a[1]); w4.y = cvtpk(a[2], a[3]); w4.z = cvtpk(a[4], a[5]); w4.w = cvtpk(a[6], a[7]);
                *(u32x4*)(dst + (size_t)row * 1024 + ch * 8) = w4; }
            LDS_WAIT();
        }
        buf ^= 1;
    }
#undef P6_DMA
    asm volatile("s_waitcnt vmcnt(0)" ::: "memory");
    __syncthreads();
}

struct BranchSched {
    const char* A; const char* Bt; int G, c; int R[2], C[2];
    __device__ __forceinline__ bool next(int i, gm::UnitD& u) {
        int pm, pn; if (!gm::static_tile(MT, 1024, G, c, i, pm, pn)) return false;
        u.a = A; u.b = Bt + (size_t)(pn * 256) * 1024 * 2;
#pragma unroll
        for (int h = 0; h < 2; ++h)
#pragma unroll
            for (int j = 0; j < 2; ++j) u.va[h][j] = (unsigned)((pm * 256 + h * 128 + R[j]) * 1024 + C[j]) * 2u;
        u.e0 = pm; u.e1 = pn; u.e2 = 0; u.e3 = 0; return true;
    }
};
struct EpiBranch {
    const bf16_t* g; bf16_t* merged;
    static __device__ __forceinline__ float ratio(float gs, float gm_) { return (1.f + fminf(__expf(-gm_), 1e30f)) * __builtin_amdgcn_rcpf(1.f + __expf(-gs)); }
    __device__ __forceinline__ void mid(f32x4 (&acc)[2][2][4][2], const gm::UnitD& u, int wr, int wc, int fr, int fq) const {
        const bf16_t* gp = g + (size_t)(u.e0 * 256 + wr * 64 + fr) * 2048 + u.e1 * 256 + wc * 32 + 8 * fq;
#pragma unroll
        for (int ai = 0; ai < 2; ++ai)
#pragma unroll
            for (int m = 0; m < 4; m += 2) {
                asm volatile("" : "+v"(gp) :: "memory");
                u32x4 gs[2][2], gq[2][2];
#pragma unroll
                for (int mm = 0; mm < 2; ++mm)
#pragma unroll
                    for (int bj = 0; bj < 2; ++bj) { gs[mm][bj] = *(const u32x4*)(gp + (size_t)mm * 16 * 2048 + bj * 128); gq[mm][bj] = *(const u32x4*)(gp + (size_t)mm * 16 * 2048 + 1024 + bj * 128); }
#pragma unroll
                for (int mm = 0; mm < 2; ++mm)
#pragma unroll
                    for (int bj = 0; bj < 2; ++bj) { const u32x4 a = gs[mm][bj], b = gq[mm][bj];
                        f32x4& c0 = acc[ai][bj][m + mm][0]; f32x4& c1 = acc[ai][bj][m + mm][1];
                        c0[0] *= ratio(bflo(a.x), bflo(b.x)); c0[1] *= ratio(bfhi(a.x), bfhi(b.x)); c0[2] *= ratio(bflo(a.y), bflo(b.y)); c0[3] *= ratio(bfhi(a.y), bfhi(b.y));
                        c1[0] *= ratio(bflo(a.z), bflo(b.z)); c1[1] *= ratio(bfhi(a.z), bfhi(b.z)); c1[2] *= ratio(bflo(a.w), bflo(b.w)); c1[3] *= ratio(bfhi(a.w), bfhi(b.w));
                        asm volatile("" : "+v"(c0), "+v"(c1) :: "memory"); }
                gp += (m == 2 ? 96 : 32) * 2048; }
    }
    __device__ __forceinline__ void operator()(const f32x4 (&acc)[2][2][4][2], const gm::UnitD& u, int wr, int wc, int fr, int fq) const {
        const int row0 = u.e0 * 256 + wr * 64 + fr, col0 = u.e1 * 256 + wc * 32 + 8 * fq;
#pragma unroll
        for (int ai = 0; ai < 2; ++ai)
#pragma unroll
            for (int m = 0; m < 4; ++m) { const size_t row = (size_t)(row0 + ai * 128 + m * 16);
#pragma unroll
                for (int bj = 0; bj < 2; ++bj) { const u32x4 gm_ = *(const u32x4*)(g + row * 2048 + 1024 + col0 + bj * 128);
                    const float b[8] = {bflo(gm_.x), bfhi(gm_.x), bflo(gm_.y), bfhi(gm_.y), bflo(gm_.z), bfhi(gm_.z), bflo(gm_.w), bfhi(gm_.w)};
                    float r[8];
#pragma unroll
                    for (int j = 0; j < 8; ++j) r[j] = acc[ai][bj][m][j >> 2][j & 3] * __builtin_amdgcn_rcpf(1.f + fminf(__expf(-b[j]), 1e30f));
                    u32x4 w; w.x = cvtpk(r[0], r[1]); w.y = cvtpk(r[2], r[3]); w.z = cvtpk(r[4], r[5]); w.w = cvtpk(r[6], r[7]);
                    *(u32x4*)(merged + row * 1024 + col0 + bj * 128) = w; } }
    }
};
__device__ __forceinline__ void phase7(Ctx& F) {
    BranchSched S; S.A = (const char*)(F.ws + WS_OB); S.Bt = (const char*)(F.ws + WS_WBRT); S.G = F.G; S.c = F.bid; gm::stage_geom(F.tid, S.R, S.C);
    EpiBranch E{(const bf16_t*)(F.ws + WS_G), (bf16_t*)(F.ws + WS_MERGED)};
    gm::gemm_phase<true, true>(F.lds, 1024, S, E);
}
struct OutSched {
    const char* A; const char* Bt; int G, c; int R[2], C[2];
    __device__ __forceinline__ bool next(int i, gm::UnitD& u) {
        int pm, pn; if (!gm::static_tile(MT, 1024, G, c, i, pm, pn)) return false;
        u.a = A; u.b = Bt + (size_t)pn * 256 * 1024 * 2;
#pragma unroll
        for (int h = 0; h < 2; ++h)
#pragma unroll
            for (int j = 0; j < 2; ++j) u.va[h][j] = (unsigned)((pm * 256 + h * 128 + R[j]) * 1024 + C[j]) * 2u;
        u.e0 = pm; u.e1 = pn; u.e2 = 0; u.e3 = 0; return true;
    }
};
struct EpiOut {
    const float* x; const float* mod; float* out;
    __device__ __forceinline__ void operator()(const f32x4 (&acc)[2][2][4][2], const gm::UnitD& u, int wr, int wc, int fr, int fq) const {
        const int pm = u.e0, pn = u.e1, b = (pm * 256) / SEQ;
        const int row0 = pm * 256 + wr * 64 + fr, col0 = pn * 256 + wc * 32 + 4 * fq;
        f32x4 gt[2][2];
#pragma unroll
        for (int bj = 0; bj < 2; ++bj)
#pragma unroll
            for (int n = 0; n < 2; ++n) gt[bj][n] = *(const f32x4*)(mod + b * NMOD + 2 * DM + col0 + bj * 128 + n * 16);
#pragma unroll
        for (int ai = 0; ai < 2; ++ai)
#pragma unroll
            for (int m = 0; m < 4; ++m) { const size_t off = (size_t)(row0 + ai * 128 + m * 16) * DM + col0;
#pragma unroll
                for (int bj = 0; bj < 2; ++bj)
#pragma unroll
                    for (int n = 0; n < 2; ++n) { const f32x4 xv = *(const f32x4*)(x + off + bj * 128 + n * 16); *(f32x4*)(out + off + bj * 128 + n * 16) = xv + gt[bj][n] * acc[ai][bj][m][n]; } }
    }
};
__device__ __forceinline__ void phase8(Ctx& F) {
    OutSched S; S.A = (const char*)(F.ws + WS_MERGED); S.Bt = (const char*)(F.ws + WS_WOUTT); S.G = F.G; S.c = F.bid; gm::stage_geom(F.tid, S.R, S.C);
    EpiOut E{inp(F, I_X), (const float*)(F.ws + WS_SMALL + SM_MOD), F.out};
    gm::gemm_phase<false>(F.lds, 1024, S, E);
}

constexpr int NR_SSQ = MO_PRE + 1024;
constexpr int NR_RS = MO_PRE + 3072;
__device__ __forceinline__ void phase_n2r(Ctx& F, int rr) {
    const float* x1 = F.out; const float* gvec = (const float*)(F.ws + WS_SMALL + SM_GVEC); const float* cb = (const float*)(F.ws + WS_SMALL + SM_CB);
    const float* mod = (const float*)(F.ws + WS_SMALL + SM_MOD); const float* rbias = inp(F, I_RB);
    unsigned char* H2 = (unsigned char*)(F.ws + WS_H2) + (size_t)rr * RT * DM; int* tokl = (int*)(F.ws + WS_TOKL) + (size_t)rr * 64 * RT; float* wl = (float*)(F.ws + WS_WL) + (size_t)rr * 64 * RT; int* tpos = (int*)(F.ws + WS_TPOS) + (size_t)rr * RT * 8;
    unsigned* cur = (unsigned*)(F.ws + WS_CTL) + CW_MOECUR + rr * 64;
    LAS int* lcnt = (LAS int*)(F.lds + MISC_OFF + MO_PRE); LAS int* lbase = lcnt + 64;
    LAS float* part = (LAS float*)(F.lds);
    LAS float* ssqp = (LAS float*)(F.lds + MISC_OFF + NR_SSQ); LAS float* rsl = (LAS float*)(F.lds + MISC_OFF + NR_RS);
    const int lane = F.lane, w = F.wave, i16 = lane & 15, kk = lane >> 4;
    for (int u = F.bid; u < RT / 64; u += F.G) {
        if (F.tid < 64) lcnt[F.tid] = 0;
        const int tokb = rr * RT + u * 64, b = tokb / SEQ;
        {
            bf16x8 fah[4][4], fal[4][4];
            {
                const float* gp = gvec + b * DM + 128 * w + 8 * kk;
                f32x4 gv[4][2];
#pragma unroll
                for (int s4 = 0; s4 < 4; ++s4) { gv[s4][0] = *(const f32x4*)(gp + 32 * s4); gv[s4][1] = *(const f32x4*)(gp + 32 * s4 + 4); }
#pragma unroll
                for (int tt = 0; tt < 4; ++tt) {
                    const float* xp = x1 + (size_t)(tokb + tt * 16 + i16) * DM + 128 * w + 8 * kk;
                    f32x4 xa[4][2];
#pragma unroll
                    for (int s4 = 0; s4 < 4; ++s4) { xa[s4][0] = *(const f32x4*)(xp + 32 * s4); xa[s4][1] = *(const f32x4*)(xp + 32 * s4 + 4); }
                    float ssq = 0.f;
#pragma unroll
                    for (int s4 = 0; s4 < 4; ++s4) {
                        u32x4 ah, al;
#pragma unroll
                        for (int q = 0; q < 2; ++q) { const f32x4 xv = xa[s4][q]; ssq += (xv.x * xv.x + xv.y * xv.y) + (xv.z * xv.z + xv.w * xv.w);
                            const f32x4 a = xv * gv[s4][q];
                            const unsigned h0 = cvtpk(a.x, a.y), h1 = cvtpk(a.z, a.w);
                            ah[2 * q] = h0; ah[2 * q + 1] = h1; al[2 * q] = cvtpk(a.x - bflo(h0), a.y - bfhi(h0)); al[2 * q + 1] = cvtpk(a.z - bflo(h1), a.w - bfhi(h1)); }
                        fah[tt][s4] = __builtin_bit_cast(bf16x8, ah); fal[tt][s4] = __builtin_bit_cast(bf16x8, al);
                    }
                    ssq += __shfl_xor(ssq, 16); ssq += __shfl_xor(ssq, 32); if (kk == 0) ssqp[w * 64 + tt * 16 + i16] = ssq;
                }
            }
#pragma unroll 1
            for (int eh = 0; eh < 2; ++eh) {
                bf16x8 wh[2][4], wl_[2][4];
                {
                    const bf16_t* ph = (const bf16_t*)(F.ws + WS_SMALL + SM_WRH) + (size_t)(eh * 32 + i16) * DM + 128 * w + 8 * kk;
                    const bf16_t* pl = (const bf16_t*)(F.ws + WS_SMALL + SM_WRL) + (size_t)(eh * 32 + i16) * DM + 128 * w + 8 * kk;
#pragma unroll
                    for (int c = 0; c < 2; ++c)
#pragma unroll
                        for (int s4 = 0; s4 < 4; ++s4) { wh[c][s4] = *(const bf16x8*)(ph + (size_t)c * 16 * DM + 32 * s4); wl_[c][s4] = *(const bf16x8*)(pl + (size_t)c * 16 * DM + 32 * s4); }
                }
#pragma unroll
                for (int tt = 0; tt < 4; ++tt) {
                    f32x4 acc[2]; acc[0] = acc[1] = (f32x4){0.f, 0.f, 0.f, 0.f};
#pragma unroll
                    for (int s4 = 0; s4 < 4; ++s4)
#pragma unroll
                        for (int c = 0; c < 2; ++c) {
                            acc[c] = __builtin_amdgcn_mfma_f32_16x16x32_bf16(fal[tt][s4], wh[c][s4], acc[c], 0, 0, 0);
                            acc[c] = __builtin_amdgcn_mfma_f32_16x16x32_bf16(fah[tt][s4], wl_[c][s4], acc[c], 0, 0, 0);
                            acc[c] = __builtin_amdgcn_mfma_f32_16x16x32_bf16(fah[tt][s4], wh[c][s4], acc[c], 0, 0, 0); }
#pragma unroll
                    for (int c = 0; c < 2; ++c)
#pragma unroll
                        for (int reg = 0; reg < 4; ++reg) part[(w * 64 + tt * 16 + 4 * kk + reg) * 64 + eh * 32 + 16 * c + i16] = acc[c][reg];
                }
            }
        }
        __syncthreads();
        const int tl = F.tid >> 3, g = F.tid & 7;
        int my_e; float my_w; int my_rank;
        {
            float ssq = 0.f;
#pragma unroll
            for (int q = 0; q < 8; ++q) ssq += ssqp[q * 64 + tl];
            const float rstd = rsqrtf(ssq * (1.f / DM) + EPS);
            if (g == 0) rsl[tl] = rstd;
            float s8[8], c8[8];
            {
                f32x4 lo4 = (f32x4){0.f, 0.f, 0.f, 0.f}, hi4 = lo4;
#pragma unroll
                for (int q = 0; q < 8; ++q) { const LAS f32x4* pp = (const LAS f32x4*)(part + (q * 64 + tl) * 64 + 8 * g); lo4 += pp[0]; hi4 += pp[1]; }
                const f32x4 cb0 = *(const f32x4*)(cb + b * 64 + 8 * g), cb1 = *(const f32x4*)(cb + b * 64 + 8 * g + 4), rb0 = *(const f32x4*)(rbias + 8 * g), rb1 = *(const f32x4*)(rbias + 8 * g + 4);
#pragma unroll
                for (int j = 0; j < 4; ++j) { s8[j] = sigmoidf_(lo4[j] * rstd + cb0[j]); s8[4 + j] = sigmoidf_(hi4[j] * rstd + cb1[j]); c8[j] = s8[j] + rb0[j]; c8[4 + j] = s8[4 + j] + rb1[j]; }
            }
            float m1 = -INFINITY, m2 = -INFINITY;
#pragma unroll
            for (int j = 0; j < 8; ++j) { const float v = c8[j]; if (v > m1) { m2 = m1; m1 = v; } else if (v > m2) m2 = v; }
            const float gs = m1 + m2;
            int rank = 0;
#pragma unroll
            for (int g2 = 0; g2 < 8; ++g2) { const float o = __shfl(gs, g2, 8); rank += (o > gs || (o == gs && g2 < g)) ? 1 : 0; }
            if (rank >= 4) {
#pragma unroll
                for (int j = 0; j < 8; ++j) c8[j] = -INFINITY;
            }
            int sel_e[8]; float sk[8]; float wsum = 0.f;
#pragma unroll
            for (int k = 0; k < 8; ++k) {
                float bv = -INFINITY, bs = 0.f; int be = 8 * g;
#pragma unroll
                for (int j = 0; j < 8; ++j) if (c8[j] > bv) { bv = c8[j]; be = 8 * g + j; bs = s8[j]; }
#pragma unroll
                for (int o = 1; o < 8; o <<= 1) { const float ov = __shfl_xor(bv, o, 8), os = __shfl_xor(bs, o, 8); const int oe = __shfl_xor(be, o, 8); if (ov > bv || (ov == bv && oe < be)) { bv = ov; be = oe; bs = os; } }
                sel_e[k] = be; sk[k] = bs; wsum += bs;
#pragma unroll
                for (int j = 0; j < 8; ++j) if (be == 8 * g + j) c8[j] = -INFINITY;
            }
            my_e = sel_e[0]; my_w = sk[0];
#pragma unroll
            for (int k = 1; k < 8; ++k) if (g == k) { my_e = sel_e[k]; my_w = sk[k]; }
            my_w *= 2.5f / wsum;
            my_rank = lds_add(&lcnt[my_e], 1);
        }
        __syncthreads();
        if (F.tid < 64) { const int n = lcnt[F.tid]; lbase[F.tid] = n > 0 ? (int)atomicAdd(&cur[F.tid], (unsigned)n) : 0; }
        __syncthreads();
        { const int tok = tokb + tl, pos = lbase[my_e] + my_rank; tokl[my_e * RT + pos] = tok * 8 + g; wl[my_e * RT + pos] = my_w; tpos[(tok - rr * RT) * 8 + g] = (my_e << 16) | pos; }
#pragma unroll 1
        for (int r0 = 0; r0 < 8; r0 += 4) {
            f32x4 xv[4][4];
#pragma unroll
            for (int r = 0; r < 4; ++r) { const f32x4* xr = (const f32x4*)(x1 + (size_t)(tokb + w * 8 + r0 + r) * DM) + lane;
#pragma unroll
                for (int j = 0; j < 4; ++j) xv[r][j] = xr[64 * j]; }
#pragma unroll
            for (int j = 0; j < 4; ++j) { const int col = 4 * lane + 256 * j; const f32x4 gq = *(const f32x4*)(gvec + b * DM + col), sh = *(const f32x4*)(mod + b * NMOD + 3 * DM + col);
#pragma unroll
                for (int r = 0; r < 4; ++r) { const int tl2 = w * 8 + r0 + r; const f32x4 hv = (xv[r][j] * rsl[tl2]) * gq + sh;
                    int o = 0; o = __builtin_amdgcn_cvt_pk_fp8_f32(f8c(hv.x * 16.f), f8c(hv.y * 16.f), o, false); o = __builtin_amdgcn_cvt_pk_fp8_f32(f8c(hv.z * 16.f), f8c(hv.w * 16.f), o, true);
                    ((unsigned*)(H2 + (size_t)(tokb - rr * RT + tl2) * DM) + lane)[64 * j] = (unsigned)o; } }
        }
        __syncthreads();
    }
}
constexpr int MO_TE = 4224;
struct MoeTabs { const LAS unsigned short* te; const LAS int* tb; const LAS int* cnt; int TR; };
__device__ __forceinline__ MoeTabs build_moe_tabs(Ctx& F, int rr) {
    LAS unsigned short* te = (LAS unsigned short*)(F.lds + MISC_OFF + MO_TE); LAS int* tb = (LAS int*)(F.lds + MISC_OFF + MO_TE + 1536); LAS int* cnt = tb + 72;
    const unsigned* cur = (const unsigned*)(F.ws + WS_CTL) + CW_MOECUR + rr * 64;
    __syncthreads();
    if (F.tid == 0) { int acc = 0; for (int e = 0; e < 64; ++e) { const int c = (int)cur[e]; cnt[e] = c; tb[e] = acc; acc += (c + 255) >> 8; } tb[64] = acc; tb[65] = acc + RT / 256; cnt[64] = RT; }
    __syncthreads();
    const int TR = tb[64];
    for (int e = F.tid >> 3; e < 65; e += 64) for (int t = tb[e] + (F.tid & 7); t < tb[e + 1]; t += 8) te[t] = (unsigned short)e;
    __syncthreads();
    MoeTabs T; T.te = te; T.tb = tb; T.cnt = cnt; T.TR = TR; return T;
}
struct Moe1Sched {
    const char* H2; const char* W1T; const int* tokl; MoeTabs T; int G, c, rr; int R[2], C[2];
    __device__ __forceinline__ bool next(int i, gm::UnitD& u) {
        const int uu = i * G + c; const int nt = T.TR + RT / 256;
        if (uu >= nt * 2) return false;
        const int tile = uu >> 1, pn = uu & 1, e = T.te[tile], rt = tile - T.tb[e], cnt = T.cnt[e];
        u.a = H2; u.b = W1T + (size_t)(e * 512 + pn * 256) * 1024;
#pragma unroll
        for (int h = 0; h < 2; ++h)
#pragma unroll
            for (int j = 0; j < 2; ++j) { const int idx = rt * 256 + h * 128 + R[j]; int trow;
                if (e < 64) { const int ent = tokl[e * RT + (idx < cnt ? idx : rt * 256)]; trow = (ent >> 3) - rr * RT; } else trow = idx;
                u.va[h][j] = (unsigned)(trow * 512 + C[j]) * 2u; }
        u.e0 = tile; u.e1 = pn; u.e2 = e; u.e3 = rt; return true;
    }
};
struct EpiMoe1 {
    bf16_t* act; const float* wl; const LAS int* cnt;
    __device__ __forceinline__ void operator()(const f32x4 (&acc)[2][2][4][2], const gm::UnitD& u, int wr, int wc, int fr, int fq) const {
        const int row0 = u.e0 * 256 + wr * 64 + fr, col0 = u.e1 * 128 + wc * 32 + 8 * fq, e = u.e2, n = cnt[e];
        float rw[2][4];
#pragma unroll
        for (int ai = 0; ai < 2; ++ai)
#pragma unroll
            for (int m = 0; m < 4; ++m) { const int idx = u.e3 * 256 + ai * 128 + wr * 64 + m * 16 + fr; rw[ai][m] = e < 64 ? (idx < n ? wl[e * RT + idx] : 0.f) : 1.f; }
#pragma unroll
        for (int ai = 0; ai < 2; ++ai)
#pragma unroll
            for (int m = 0; m < 4; ++m) { const float ww = rw[ai][m] * (32.f / 4096.f); const f32x4 g0 = acc[ai][0][m][0] * (1.f / 4096.f), g1 = acc[ai][0][m][1] * (1.f / 4096.f), u0 = acc[ai][1][m][0] * ww, u1 = acc[ai][1][m][1] * ww;
                int w0 = 0, w1 = 0;
                w0 = __builtin_amdgcn_cvt_pk_fp8_f32(f8c(siluf_(g0[0]) * u0[0]), f8c(siluf_(g0[1]) * u0[1]), w0, false); w0 = __builtin_amdgcn_cvt_pk_fp8_f32(f8c(siluf_(g0[2]) * u0[2]), f8c(siluf_(g0[3]) * u0[3]), w0, true);
                w1 = __builtin_amdgcn_cvt_pk_fp8_f32(f8c(siluf_(g1[0]) * u1[0]), f8c(siluf_(g1[1]) * u1[1]), w1, false); w1 = __builtin_amdgcn_cvt_pk_fp8_f32(f8c(siluf_(g1[2]) * u1[2]), f8c(siluf_(g1[3]) * u1[3]), w1, true);
                *(u32x2*)((unsigned char*)act + (size_t)(row0 + ai * 128 + m * 16) * 256 + col0) = (u32x2){(unsigned)w0, (unsigned)w1}; }
    }
};
__device__ __forceinline__ void phase_moe1(Ctx& F, int rr) {
    Moe1Sched S; S.T = build_moe_tabs(F, rr); S.H2 = (const char*)(F.ws + WS_H2) + (size_t)rr * RT * DM; S.W1T = (const char*)(F.ws + WS_W1T); S.tokl = (const int*)(F.ws + WS_TOKL) + (size_t)rr * 64 * RT; S.G = F.G; S.c = (F.G % 8 == 0) ? (F.bid % 8) * (F.G / 8) + F.bid / 8 : F.bid; S.rr = rr; gm::stage_geom(F.tid, S.R, S.C);
    EpiMoe1 E{(bf16_t*)(F.ws + WS_ACT), (const float*)(F.ws + WS_WL) + (size_t)rr * 64 * RT, S.T.cnt};
    gm::gemm_phase<true, false, true>(F.lds, 512, S, E);
}
struct Moe2Sched {
    const char* ACT; const char* W2T; MoeTabs T; int G, c; int R[2], C[2];
    __device__ __forceinline__ bool next(int i, gm::UnitD& u) {
        const int uu = i * G + c; const int nt = T.TR + RT / 256;
        if (uu >= nt * 4) return false;
        const int tile = uu >> 2, pn = uu & 3, e = T.te[tile], rt = tile - T.tb[e];
        u.a = ACT + (size_t)tile * 256 * 256; u.b = W2T + (size_t)(e * 1024 + pn * 256) * 256;
#pragma unroll
        for (int h = 0; h < 2; ++h)
#pragma unroll
            for (int j = 0; j < 2; ++j) u.va[h][j] = (unsigned)((h * 128 + R[j]) * 128 + C[j]) * 2u;
        u.e0 = pn; u.e1 = e; u.e2 = rt; u.e3 = tile; return true;
    }
};
struct EpiMoe2 {
    bf16_t* slots; bf16_t* shout; const LAS int* cnt;
    __device__ __forceinline__ void operator()(const f32x4 (&acc)[2][2][4][2], const gm::UnitD& u, int wr, int wc, int fr, int fq) const {
        const int pn = u.e0, e = u.e1, rt = u.e2, tile = u.e3;
        const int col0 = pn * 256 + wc * 32 + 8 * fq, n = cnt[e];
        if (e < 64) {
            unsigned char* base = (unsigned char*)slots + (size_t)(tile * 256 + wr * 64 + fr) * 1024 + col0;
#pragma unroll
            for (int ai = 0; ai < 2; ++ai)
#pragma unroll
                for (int m = 0; m < 4; ++m) {
                    if (rt * 256 + ai * 128 + wr * 64 + m * 16 + fr < n) {
#pragma unroll
                        for (int bj = 0; bj < 2; ++bj) { f32x4 v0 = acc[ai][bj][m][0] * (16.f / 4096.f), v1 = acc[ai][bj][m][1] * (16.f / 4096.f);
#pragma unroll
                            for (int j = 0; j < 4; ++j) { v0[j] = __builtin_amdgcn_fmed3f(v0[j], -440.f, 440.f); v1[j] = __builtin_amdgcn_fmed3f(v1[j], -440.f, 440.f); }
                            int w0 = 0, w1 = 0;
                            w0 = __builtin_amdgcn_cvt_pk_fp8_f32(v0[0], v0[1], w0, false); w0 = __builtin_amdgcn_cvt_pk_fp8_f32(v0[2], v0[3], w0, true);
                            w1 = __builtin_amdgcn_cvt_pk_fp8_f32(v1[0], v1[1], w1, false); w1 = __builtin_amdgcn_cvt_pk_fp8_f32(v1[2], v1[3], w1, true);
                            *(u32x2*)(base + (size_t)(ai * 128 + m * 16) * 1024 + bj * 128) = (u32x2){(unsigned)w0, (unsigned)w1}; } } }
        } else {
            bf16_t* base = shout + (size_t)(rt * 256 + wr * 64 + fr) * 1024 + col0;
#pragma unroll
            for (int ai = 0; ai < 2; ++ai)
#pragma unroll
                for (int m = 0; m < 4; ++m)
#pragma unroll
                    for (int bj = 0; bj < 2; ++bj) { const f32x4 v0 = acc[ai][bj][m][0] * (1.f / 4096.f), v1 = acc[ai][bj][m][1] * (1.f / 4096.f);
                        u32x4 o; o.x = cvtpk(v0[0], v0[1]); o.y = cvtpk(v0[2], v0[3]); o.z = cvtpk(v1[0], v1[1]); o.w = cvtpk(v1[2], v1[3]); *(u32x4*)(base + (size_t)(ai * 128 + m * 16) * 1024 + bj * 128) = o; }
        }
    }
};
__device__ __forceinline__ void phase_moe2(Ctx& F, int rr) {
    Moe2Sched S; S.T = build_moe_tabs(F, rr); S.ACT = (const char*)(F.ws + WS_ACT); S.W2T = (const char*)(F.ws + WS_W2T); S.G = F.G; S.c = (F.G % 8 == 0) ? (F.bid % 8) * (F.G / 8) + F.bid / 8 : F.bid; gm::stage_geom(F.tid, S.R, S.C);
    EpiMoe2 E{(bf16_t*)(F.ws + WS_SLOTS), (bf16_t*)(F.ws + WS_SHOUT), S.T.cnt};
    gm::gemm_phase<true, false, true>(F.lds, 128, S, E);
}
__device__ __forceinline__ void phase_final(Ctx& F, int rr) {
    const MoeTabs T = build_moe_tabs(F, rr);
    const float* mod = (const float*)(F.ws + WS_SMALL + SM_MOD); const float* fg = inp(F, I_FG);
    const unsigned char* slots = (const unsigned char*)(F.ws + WS_SLOTS); const int* tpos = (const int*)(F.ws + WS_TPOS) + (size_t)rr * RT * 8;
    const int gw = F.bid * 8 + F.wave, NGW = F.G * 8, c0 = F.lane * 8;
    for (int t = gw; t < RT; t += NGW) {
        const int tok = rr * RT + t, b = tok / SEQ;
        const unsigned char* rp[8];
#pragma unroll
        for (int k = 0; k < 8; ++k) { const int v = tpos[t * 8 + k]; rp[k] = slots + (size_t)(T.tb[v >> 16] * 256 + (v & 0xffff)) * 1024 + c0; }
        float* orow = F.out + (size_t)tok * DM + c0;
        u32x2 sv[8][2]; u32x4 sh[2]; f32x4 xv[2][2];
#pragma unroll
        for (int k = 0; k < 8; ++k) { sv[k][0] = *(const u32x2*)(rp[k]); sv[k][1] = *(const u32x2*)(rp[k] + 512); }
        { const bf16_t* sp = (const bf16_t*)(F.ws + WS_SHOUT) + (size_t)t * 1024 + c0; sh[0] = *(const u32x4*)sp; sh[1] = *(const u32x4*)(sp + 512); }
#pragma unroll
        for (int h = 0; h < 2; ++h) { xv[h][0] = *(const f32x4*)(orow + h * 512); xv[h][1] = *(const f32x4*)(orow + h * 512 + 4); }
        float s = 0.f; f32x4 v[2][2];
#pragma unroll
        for (int h = 0; h < 2; ++h) {
            f32x4 a0 = (f32x4){0.f, 0.f, 0.f, 0.f}, a1 = a0;
#pragma unroll
            for (int k = 0; k < 8; ++k) { const u32x2 w = sv[k][h];
                const f32x2 p0 = __builtin_amdgcn_cvt_pk_f32_fp8((int)w.x, false), p1 = __builtin_amdgcn_cvt_pk_f32_fp8((int)w.x, true), p2 = __builtin_amdgcn_cvt_pk_f32_fp8((int)w.y, false), p3 = __builtin_amdgcn_cvt_pk_f32_fp8((int)w.y, true);
                a0 += (f32x4){p0.x, p0.y, p1.x, p1.y}; a1 += (f32x4){p2.x, p2.y, p3.x, p3.y}; }
            { const u32x4 w = sh[h]; a0 = a0 * 0.0625f + (f32x4){bflo(w.x), bfhi(w.x), bflo(w.y), bfhi(w.y)}; a1 = a1 * 0.0625f + (f32x4){bflo(w.z), bfhi(w.z), bflo(w.w), bfhi(w.w)}; }
            const float* g2 = mod + b * NMOD + 5 * DM + c0 + h * 512;
            v[h][0] = xv[h][0] + *(const f32x4*)g2 * a0; v[h][1] = xv[h][1] + *(const f32x4*)(g2 + 4) * a1;
#pragma unroll
            for (int q = 0; q < 2; ++q) s += (v[h][q].x * v[h][q].x + v[h][q].y * v[h][q].y) + (v[h][q].z * v[h][q].z + v[h][q].w * v[h][q].w);
        }
        const float rstd = rsqrtf(wave_sum(s) * (1.f / DM) + EPS);
#pragma unroll
        for (int h = 0; h < 2; ++h)
#pragma unroll
            for (int q = 0; q < 2; ++q) { const f32x4 g = *(const f32x4*)(fg + c0 + h * 512 + 4 * q); *(f32x4*)(orow + h * 512 + 4 * q) = (v[h][q] * rstd) * g; }
    }
}

constexpr int N_PHASES = 10;
__global__ void __launch_bounds__(512, 2) mega_fwd(Args args) {
    extern __shared__ __attribute__((aligned(16))) unsigned char lds_raw[];
    Ctx F; F.lds = (LAS unsigned char*)lds_raw; F.ws = args.ws; F.out = args.out;
    {
        typedef __attribute__((address_space(4))) const unsigned long long* karg_t;
        const karg_t ka = (karg_t)__builtin_amdgcn_kernarg_segment_ptr();
        LAS unsigned long long* tab = (LAS unsigned long long*)(lds_raw + MISC_OFF + 14336);
        if (threadIdx.x < 20) tab[threadIdx.x] = ka[threadIdx.x];
        F.intab = tab;
    }
    F.tid = threadIdx.x; F.lane = F.tid & 63; F.wave = __builtin_amdgcn_readfirstlane(F.tid >> 6); F.G = gridDim.x; F.bid = blockIdx.x;
    volatile LAS unsigned* st = (volatile LAS unsigned*)(F.lds + MISC_OFF + MO_ST);
    if (F.tid < 4) st[F.tid] = 0u;
    __syncthreads();
    XcdBarrier bar = xcd_barrier_post((unsigned*)(F.ws + WS_CTL) + CW_BAR, st);
    if (threadIdx.x == 0) { unsigned nloc, nx; xcd_barrier_complete(bar.bar, bar.x, nloc, nx); st[0] = nloc; st[1] = nx; }
    int lo = args.ph_lo, hi = args.ph_hi;
    { int a = lo, b = hi; asm volatile("" : "+v"(a), "+v"(b)); lo = __builtin_amdgcn_readfirstlane(a); hi = __builtin_amdgcn_readfirstlane(b); }
    launder(F);
#ifndef PH_MASK
#define PH_MASK 0x1ffff
#endif
#define PH_ON(k) ((PH_MASK >> (k)) & 1)
#define IN(k) (lo <= (k) && (k) < hi)
#define SEAM(k) do { if (IN(k) && IN((k) + 1)) { bar.bar = launder_ptr(bar.bar); xcd_barrier(bar); } } while (0)
#define RUN(k, call) do { if (PH_ON(k) && IN(k)) { launder(F); call; } } while (0)
    RUN(0, phase0(F)); SEAM(0);
    RUN(1, phase1(F)); SEAM(1);
    RUN(2, phase2(F)); SEAM(2);
    RUN(4, (phase4(F), sb_units(F))); SEAM(4);
    RUN(5, phase5(F)); SEAM(5);
    RUN(6, phase6(F)); SEAM(6);
    RUN(7, phase7(F)); SEAM(7);
    RUN(8, phase8(F)); SEAM(8);
    if (PH_ON(9) && IN(9)) {
        const int par = (F.bid >> 3) & 1;
#pragma unroll 1
        for (int i = 0; i < 8; ++i) {
            launder(F);
            int op, rr; bool bar_after = true;
            switch (i) {
                case 0: op = 0; rr = 0; break;
                case 1: op = 1; rr = 0; break;
                case 2: op = par ? 0 : 2; rr = par ? 1 : 0; bar_after = false; break;
                case 3: op = par ? 2 : 0; rr = par ? 0 : 1; break;
                case 4: op = par ? 1 : 3; rr = par ? 1 : 0; bar_after = false; break;
                case 5: op = par ? 3 : 1; rr = par ? 0 : 1; break;
                case 6: op = 2; rr = 1; break;
                default: op = 3; rr = 1; bar_after = false; break;
            }
            switch (op) {
                case 0: phase_n2r(F, rr); break;
                case 1: phase_moe1(F, rr); break;
                case 2: phase_moe2(F, rr); break;
                default: phase_final(F, rr); break;
            }
            if (bar_after) { bar.bar = launder_ptr(bar.bar); xcd_barrier(bar); } else __syncthreads();
        }
    }
#undef IN
#undef SEAM
#undef RUN
}

#ifndef MK_SPLIT
#define MK_SPLIT 0
#endif
extern "C" void kernel_launch(void* const* d_in, const int* in_sizes, int n_in, void* d_out, int out_size, void* d_ws, size_t ws_size, hipStream_t stream) {
    static int grid = 0;
    if (grid == 0) {
        if (n_in != 20 || in_sizes[0] != MT * DM || out_size != MT * DM || ws_size < WS_END) { fprintf(stderr, "kernel_launch: unexpected shapes (n_in %d, in0 %d, out %d, ws %zu)\n", n_in, n_in > 0 ? in_sizes[0] : -1, out_size, ws_size); grid = -1; return; }
        int dev = 0, cus = 0;
        if (hipGetDevice(&dev) != hipSuccess || hipDeviceGetAttribute(&cus, hipDeviceAttributeMultiprocessorCount, dev) != hipSuccess) { grid = -1; return; }
        if (hipFuncSetAttribute((const void*)mega_fwd, hipFuncAttributeMaxDynamicSharedMemorySize, LDS_BYTES) != hipSuccess) { fprintf(stderr, "kernel_launch: hipFuncSetAttribute failed\n"); grid = -1; return; }
        int per_cu = 0;
        if (hipOccupancyMaxActiveBlocksPerMultiprocessor(&per_cu, (const void*)mega_fwd, 512, LDS_BYTES) != hipSuccess || per_cu < 1) fprintf(stderr, "kernel_launch: occupancy query reports %d\n", per_cu);
        (void)hipGetLastError();
        grid = cus;
    }
    if (grid < 0) return;
    (void)hipMemsetAsync((char*)d_ws + WS_CTL, 0, CTL_BYTES, stream);
    Args a{};
    for (int i = 0; i < 20; ++i) a.in[i] = (const float*)d_in[i];
    a.out = (float*)d_out; a.ws = (unsigned char*)d_ws;
#if MK_SPLIT
    for (int p = 0; p < N_PHASES; ++p) { a.ph_lo = p; a.ph_hi = p + 1; hipLaunchKernelGGL(mega_fwd, dim3(grid), dim3(512), LDS_BYTES, stream, a); }
#else
    a.ph_lo = 0; a.ph_hi = N_PHASES;
    hipLaunchKernelGGL(mega_fwd, dim3(grid), dim3(512), LDS_BYTES, stream, a);
#endif
}
```

```cpp
#include <hip/hip_runtime.h>
#include <cstdio>
#include <cstdint>

#define LAS __attribute__((address_space(3)))
#define GAS __attribute__((address_space(1)))
typedef unsigned short bf16_t;
typedef short bf16x8 __attribute__((ext_vector_type(8)));
typedef short s16x4 __attribute__((ext_vector_type(4)));
typedef float f32x4 __attribute__((ext_vector_type(4)));
typedef float f32x16 __attribute__((ext_vector_type(16)));
typedef float f32x2 __attribute__((ext_vector_type(2)));
typedef unsigned u32x4 __attribute__((ext_vector_type(4)));
typedef unsigned u32x2 __attribute__((ext_vector_type(2)));
typedef __bf16 bf16x2_t __attribute__((ext_vector_type(2)));

__device__ __forceinline__ unsigned cvtpk(float lo, float hi) { f32x2 v = {lo, hi}; bf16x2_t b = __builtin_convertvector(v, bf16x2_t); return __builtin_bit_cast(unsigned, b); }
__device__ __forceinline__ float bf2f(unsigned short u) { return __uint_as_float(((unsigned)u) << 16); }
__device__ __forceinline__ float bflo(unsigned u) { return __uint_as_float(u << 16); }
__device__ __forceinline__ float bfhi(unsigned u) { return __uint_as_float(u & 0xffff0000u); }

constexpr int NB = 4, SEQ = 8192, DM = 1024, MT = NB * SEQ;
constexpr int NHEAD = 8, HD = 64, QW = 1536;
constexpr int NE = 64, EFF = 256, NMOD = 6 * DM;
constexpr int RT = MT / 2;
constexpr float EPS = 1e-6f;
constexpr float LOG2E = 1.4426950408889634f;

constexpr size_t MiB = 1u << 20;
constexpr size_t WS_CTL = 0, CTL_BYTES = 1 * MiB;
constexpr size_t WS_SMALL = 1 * MiB;
constexpr size_t SM_MOD = 0, SM_GVEC = 98304, SM_CB = 114688, SM_KBAR = 131072, SM_WRH = 393216, SM_WRL = 524288;
constexpr size_t WS_W2T = 2 * MiB;
constexpr size_t WS_W1T = 35 * MiB;
constexpr size_t WS_WIN8 = 19 * MiB;
constexpr size_t WS_H8 = 68 * MiB;
constexpr size_t WS_WINT = 100 * MiB;
constexpr size_t WS_WBRT = 110 * MiB;
constexpr size_t WS_WOUTT = 112 * MiB;
constexpr size_t WS_H = 114 * MiB;
constexpr size_t WS_OB = 114 * MiB;
constexpr size_t WS_QSB = 178 * MiB;
constexpr size_t WS_PO = 178 * MiB;
constexpr size_t WS_QMB = 274 * MiB;
constexpr size_t WS_MERGED = 274 * MiB;
constexpr size_t WS_G = 370 * MiB;
constexpr size_t WS_LMB = 498 * MiB;
constexpr size_t WS_PLSE = 506 * MiB;
constexpr size_t WS_H2 = 100 * MiB;
constexpr size_t WS_TOKL = 164 * MiB;
constexpr size_t WS_WL = 172 * MiB;
constexpr size_t WS_TPOS = 180 * MiB;
constexpr size_t WS_ACT = 184 * MiB;
constexpr size_t WS_SLOTS = 264 * MiB;
constexpr size_t WS_SHOUT = 408 * MiB;
constexpr size_t WS_END = 509 * MiB;
constexpr int CW_MBCUR = 0;
constexpr int CW_MOECUR = 1024;
constexpr int CW_BAR = 4096;
constexpr size_t CTL_KBS = 512 * 1024;

constexpr int RING_BYTES = 131072;
constexpr int MISC_OFF = RING_BYTES;
constexpr int LDS_BYTES = 163840;
constexpr int MO_STG = 16384;

#define XB_TMO      128
#define XB_XCNT(j)  (256  + 64 * (j))
#define XB_XSUB(j)  (1280 + 64 * (j))
#define XB_XGEN(j)  (2304 + 64 * (j))
#define XB_TOP      3328
#define XB_TOPGEN   3392
#define XCD_BAR_WORDS 3456
#define XB_SPIN_CAP (1u << 18)
__device__ __forceinline__ unsigned xb_ld(unsigned* p)              { return __hip_atomic_load(p, __ATOMIC_RELAXED, __HIP_MEMORY_SCOPE_AGENT); }
__device__ __forceinline__ unsigned xb_add(unsigned* p, unsigned v) { return __hip_atomic_fetch_add(p, v, __ATOMIC_RELAXED, __HIP_MEMORY_SCOPE_AGENT); }
__device__ __forceinline__ unsigned xb_xcc_id() { return (unsigned)__builtin_amdgcn_s_getreg((3 << 11) | 20) & 0xFu; }
#define XB_SPIN(cond, bar) do { unsigned _sp = 0; while (cond) { __builtin_amdgcn_s_sleep(1); \
    if ((++_sp & 255u) == 0u) { if (xb_ld(&(bar)[XB_TMO])) break; if (_sp > XB_SPIN_CAP) { atomicAdd(&(bar)[XB_TMO], 1u); break; } } } } while (0)
struct XcdBarrier { unsigned* bar; unsigned x; volatile LAS unsigned* st; };
__device__ __forceinline__ XcdBarrier xcd_barrier_post(unsigned* bar, volatile LAS unsigned* st) {
    XcdBarrier b; b.bar = bar; b.x = xb_xcc_id(); b.st = st;
    if (threadIdx.x == 0) (void)xb_add(&bar[XB_XCNT(b.x)], 1u);
    return b;
}
__device__ __forceinline__ void xcd_barrier_complete(unsigned* bar, unsigned x, unsigned& nloc, unsigned& nx) {
    const unsigned G = gridDim.x * gridDim.y * gridDim.z;
    unsigned sum, cnt, mine, sp = 0u;
    for (;;) {
        sum = 0u; cnt = 0u; mine = 0u;
#pragma unroll
        for (unsigned j = 0; j < 16; ++j) { const unsigned c = xb_ld(&bar[XB_XCNT(j)]); sum += c; cnt += (c > 0u) ? 1u : 0u; mine = (j == x) ? c : mine; }
        if (sum == G) break;
        __builtin_amdgcn_s_sleep(1);
        if ((++sp & 255u) == 0u) { if (xb_ld(&bar[XB_TMO])) break; if (sp > XB_SPIN_CAP) { atomicAdd(&bar[XB_TMO], 1u); break; } }
    }
    nloc = mine > 0u ? mine : 1u; nx = cnt > 0u ? cnt : 1u;
}
__device__ __forceinline__ void xcd_barrier(const XcdBarrier& b) {
    asm volatile("s_waitcnt vmcnt(0)" ::: "memory");
    __syncthreads();
    if (threadIdx.x == 0) {
        unsigned* bar = b.bar;
        __builtin_amdgcn_s_waitcnt(0);
        unsigned nloc = b.st[0], nx = b.st[1];
        const unsigned old = xb_add(&bar[XB_XSUB(b.x)], 1u);
        const unsigned gen = old / nloc;
        if (old + 1u == (gen + 1u) * nloc) {
            __builtin_amdgcn_fence(__ATOMIC_RELEASE, "agent");
            asm volatile("s_waitcnt vmcnt(0)" ::: "memory");
            const unsigned og = xb_add(&bar[XB_TOP], 1u);
            const unsigned tg = og / nx;
            if (og + 1u == (tg + 1u) * nx) xb_add(&bar[XB_TOPGEN], 1u);
            else XB_SPIN(xb_ld(&bar[XB_TOPGEN]) == tg, bar);
            __builtin_amdgcn_fence(__ATOMIC_ACQUIRE, "agent");
            xb_add(&bar[XB_XGEN(b.x)], 1u);
            asm volatile("s_waitcnt vmcnt(0)" ::: "memory");
        } else {
            XB_SPIN(xb_ld(&bar[XB_XGEN(b.x)]) == gen, bar);
            __builtin_amdgcn_fence(__ATOMIC_ACQUIRE, "agent");
            asm volatile("s_waitcnt vmcnt(0)" ::: "memory");
        }
    }
    __syncthreads();
}

namespace gm {
constexpr int BM = 256, BK = 64, HALF = 128, HTB = HALF * BK * 2, STAGE_BYTES = 8 * HTB, NXCD = 8, WGM = 8;
__host__ __device__ __forceinline__ int lds_byte(int r, int c) { const int st = (r >> 4) * 2 + (c >> 5), rr = r & 15, cc = c & 31, ob = rr * 64 + cc * 2; return st * 1024 + (ob ^ (((ob >> 9) & 1) << 5)); }
__host__ __device__ __forceinline__ void stage_rc(int b, int& R, int& C) { const int st = b / 1024, sb = b % 1024, swz = sb ^ (((sb >> 9) & 1) << 5); R = (st >> 1) * 16 + swz / 64; C = (st & 1) * 32 + (swz % 64) / 2; }
__host__ __device__ __forceinline__ int perm32(int rho) { const int n = rho >> 4, i = rho & 15; return 8 * (i >> 2) + 4 * n + (i & 3); }

struct UnitD { const char* a; const char* b; unsigned va[2][2]; int e0, e1, e2, e3; };

__device__ __forceinline__ bool static_tile(int M, int N, int G, int c, int i, int& pm, int& pn) {
    const int nM = M / BM, nN = N / BM, nwg = nM * nN;
    const long L = (long)i * G + c; if (L >= nwg) return false;
    int wgid = (int)L; { const int q = nwg / NXCD, r = nwg % NXCD, xcd = wgid % NXCD, off = wgid / NXCD; wgid = (xcd < r ? xcd * (q + 1) : r * (q + 1) + (xcd - r) * q) + off; }
    const int nig = WGM * nN, gid = wgid / nig, fm = gid * WGM, gsz = (nM - fm) < WGM ? (nM - fm) : WGM;
    pm = fm + ((wgid % nig) % gsz); pn = (wgid % nig) / gsz; return true;
}

template <bool PERM, bool HOOK = false, bool FP8 = false, class Epi, class Sched>
__device__ __forceinline__ void gemm_phase(LAS unsigned char* lds, const int K, Sched& S, const Epi& E) {
    const int tid = threadIdx.x, wid = __builtin_amdgcn_readfirstlane(tid >> 6), lane = tid & 63, wr = wid >> 2, wc = wid & 3, fr = lane & 15, fq = lane >> 4;
    const int nt = K / BK;
    unsigned voffB[2];
#pragma unroll
    for (int i = 0; i < 2; ++i) { int R, C; stage_rc(tid * 16 + i * 8192, R, C); const int Rb = PERM ? ((R & ~31) + perm32(R & 31)) : R; voffB[i] = (unsigned)(Rb * K + C) * 2u; }
    const size_t kstep = (size_t)(BK * 2);
    const size_t hstep = (size_t)HALF * K * 2;
    const unsigned ldsw = (unsigned)wid * 1024u;
    const int aoff = lds_byte(wr * 64 + fr, fq * 8), boff = lds_byte(wc * 32 + fr, fq * 8);
#define GM_SA(b, h) (((b) * 2 + (h)) * HTB)
#define GM_SB(b, h) ((4 + (b) * 2 + (h)) * HTB)
#define GM_STAGE_A(bufoff, U, h, kb) do { _Pragma("unroll") for (int _i = 0; _i < 2; ++_i) \
        __builtin_amdgcn_global_load_lds((const unsigned*)((U).a + (kb) + (U).va[h][_i]), (LAS unsigned*)(lds + (bufoff) + ldsw + _i * 8192), 16, 0, 0); } while (0)
#define GM_STAGE_B(bufoff, U, h, kb) do { _Pragma("unroll") for (int _i = 0; _i < 2; ++_i) \
        __builtin_amdgcn_global_load_lds((const unsigned*)((U).b + (kb) + (size_t)(h) * hstep + voffB[_i]), (LAS unsigned*)(lds + (bufoff) + ldsw + _i * 8192), 16, 0, 0); } while (0)
#define GM_LDA(dst, b, h) do { _Pragma("unroll") for (int m = 0; m < 4; ++m) _Pragma("unroll") for (int k = 0; k < 2; ++k) { \
        if constexpr (FP8) { const i32x4_ t_ = *(const LAS i32x4_*)(lds + GM_SA(b, h) + aoff + m * 2048 + k * 1024); dst##8[m][4 * k] = t_[0]; dst##8[m][4 * k + 1] = t_[1]; dst##8[m][4 * k + 2] = t_[2]; dst##8[m][4 * k + 3] = t_[3]; } \
        else dst[m][k] = *(const LAS bf16x8*)(lds + GM_SA(b, h) + aoff + m * 2048 + k * 1024); } } while (0)
#define GM_LDB(dst, b, h) do { _Pragma("unroll") for (int n = 0; n < 2; ++n) _Pragma("unroll") for (int k = 0; k < 2; ++k) { \
        if constexpr (FP8) { const i32x4_ t_ = *(const LAS i32x4_*)(lds + GM_SB(b, h) + boff + n * 2048 + k * 1024); dst##8[n][4 * k] = t_[0]; dst##8[n][4 * k + 1] = t_[1]; dst##8[n][4 * k + 2] = t_[2]; dst##8[n][4 * k + 3] = t_[3]; } \
        else dst[n][k] = *(const LAS bf16x8*)(lds + GM_SB(b, h) + boff + n * 2048 + k * 1024); } } while (0)
#define GM_MMA(ai, bj, At, Bt) do { __builtin_amdgcn_s_setprio(1); \
        if constexpr (FP8) { _Pragma("unroll") for (int m = 0; m < 4; ++m) _Pragma("unroll") for (int n = 0; n < 2; ++n) \
            asm volatile("v_mfma_scale_f32_16x16x128_f8f6f4 %0, %1, %2, %0, %3, %3 op_sel_hi:[0,0,0]" : "+v"(acc[ai][bj][m][n]) : "v"(Bt##8[n]), "v"(At##8[m]), "v"(scl1)); } \
        else { _Pragma("unroll") for (int m = 0; m < 4; ++m) _Pragma("unroll") for (int n = 0; n < 2; ++n) _Pragma("unroll") for (int k = 0; k < 2; ++k) \
            acc[ai][bj][m][n] = __builtin_amdgcn_mfma_f32_16x16x32_bf16(Bt[n][k], At[m][k], acc[ai][bj][m][n], 0, 0, 0); } \
        __builtin_amdgcn_s_setprio(0); } while (0)
#define GM_WAIT_V(n) asm volatile("s_waitcnt vmcnt(" #n ")" ::: "memory")
#define GM_WAIT_L(n) asm volatile("s_waitcnt lgkmcnt(" #n ")" ::: "memory")
#define GM_BAR __builtin_amdgcn_s_barrier()
#define GM_SCHED __builtin_amdgcn_sched_barrier(0)
    UnitD cur, nxt; int ui = 0;
    if (!S.next(0, cur)) return;
    f32x4 acc[2][2][4][2];
#pragma unroll
    for (int a = 0; a < 2; ++a)
#pragma unroll
        for (int b = 0; b < 2; ++b)
#pragma unroll
            for (int m = 0; m < 4; ++m)
#pragma unroll
                for (int n = 0; n < 2; ++n) acc[a][b][m][n] = (f32x4){0.f, 0.f, 0.f, 0.f};
    typedef int i32x8_ __attribute__((ext_vector_type(8))); typedef int i32x4_ __attribute__((ext_vector_type(4)));
    bf16x8 At[4][2], B0[2][2], B1[2][2]; i32x8_ At8[4], B08[2], B18[2];
    int scl1 = 0x7f7f7f7f; asm volatile("" : "+v"(scl1));
    GM_STAGE_B(GM_SB(0, 0), cur, 0, 0); GM_STAGE_B(GM_SB(0, 1), cur, 1, 0); GM_STAGE_A(GM_SA(0, 0), cur, 0, 0); GM_STAGE_A(GM_SA(0, 1), cur, 1, 0);
    if (wr == 1) GM_BAR;
    GM_WAIT_V(2); GM_BAR;
    GM_STAGE_B(GM_SB(1, 0), cur, 0, kstep); GM_STAGE_A(GM_SA(1, 0), cur, 0, kstep); GM_STAGE_B(GM_SB(1, 1), cur, 1, kstep);
    GM_WAIT_V(6); GM_BAR;
    for (;;) {
        const bool has_next = S.next(ui + 1, nxt);
        if (!has_next) nxt = cur;
#pragma unroll 1
        for (int t = 0; t < nt; t += 2) {
            const bool last = (t == nt - 2);
            if constexpr (HOOK) { if (t == nt / 2) E.mid(acc, cur, wr, wc, fr, fq); }
            const size_t k1 = (size_t)(t + 1) * kstep;
            UnitD U2 = cur; size_t k2 = (size_t)(t + 2) * kstep;
            if (last) { U2 = nxt; k2 = 0; }
            const size_t k3 = k2 + kstep;
            GM_LDB(B0, 0, 0); GM_LDB(B1, 0, 1); GM_SCHED; GM_LDA(At, 0, 0); GM_STAGE_A(GM_SA(1, 1), cur, 1, k1);
            GM_WAIT_V(8); GM_WAIT_L(0); GM_BAR; GM_MMA(0, 0, At, B0); GM_MMA(0, 1, At, B1); GM_BAR; GM_SCHED;
            GM_LDA(At, 0, 1); GM_STAGE_B(GM_SB(0, 0), U2, 0, k2); GM_STAGE_B(GM_SB(0, 1), U2, 1, k2); GM_STAGE_A(GM_SA(0, 0), U2, 0, k2);
            GM_WAIT_V(8); GM_WAIT_L(0); GM_BAR; GM_MMA(1, 0, At, B0); GM_MMA(1, 1, At, B1); GM_BAR; GM_SCHED;
            GM_LDB(B0, 1, 0); GM_LDB(B1, 1, 1); GM_SCHED; GM_LDA(At, 1, 0); GM_STAGE_A(GM_SA(0, 1), U2, 1, k2);
            GM_WAIT_V(8); GM_WAIT_L(0); GM_BAR; GM_MMA(0, 0, At, B0); GM_MMA(0, 1, At, B1); GM_BAR; GM_SCHED;
            GM_LDA(At, 1, 1); GM_STAGE_B(GM_SB(1, 0), U2, 0, k3); GM_STAGE_B(GM_SB(1, 1), U2, 1, k3); GM_STAGE_A(GM_SA(1, 0), U2, 0, k3);
            GM_WAIT_V(8); GM_WAIT_L(0); GM_BAR; GM_MMA(1, 0, At, B0); GM_MMA(1, 1, At, B1); GM_BAR; GM_SCHED;
        }
        if constexpr (FP8) asm volatile("s_nop 15\n\ts_nop 15" ::: "memory");
        if (wr == 0) GM_BAR;
        E(acc, cur, wr, wc, fr, fq);
        if (!has_next) break;
#pragma unroll
        for (int a = 0; a < 2; ++a)
#pragma unroll
            for (int b = 0; b < 2; ++b)
#pragma unroll
                for (int m = 0; m < 4; ++m)
#pragma unroll
                    for (int n = 0; n < 2; ++n) acc[a][b][m][n] = (f32x4){0.f, 0.f, 0.f, 0.f};
        cur = nxt; ++ui;
        if (wr == 1) GM_BAR;
    }
    GM_WAIT_V(0);
    GM_BAR;
#undef GM_SA
#undef GM_SB
#undef GM_STAGE_A
#undef GM_STAGE_B
#undef GM_LDA
#undef GM_LDB
#undef GM_MMA
#undef GM_WAIT_V
#undef GM_WAIT_L
#undef GM_BAR
#undef GM_SCHED
}
__device__ __forceinline__ void stage_geom(int tid, int (&R)[2], int (&C)[2]) {
#pragma unroll
    for (int i = 0; i < 2; ++i) stage_rc(tid * 16 + i * 8192, R[i], C[i]);
}
}

struct Args { const float* in[20]; float* out; unsigned char* ws; int ph_lo, ph_hi; };
struct Ctx {
    LAS unsigned char* lds;
    unsigned char* ws;
    const LAS unsigned long long* intab;
    float* out;
    int tid, lane, wave, G, bid;
};
#define LDS_WAIT() asm volatile("s_waitcnt lgkmcnt(0)" ::: "memory")
__device__ __forceinline__ const float* inp(const Ctx& F, int i) {
    const unsigned long long v = F.intab[i];
    const unsigned lo = __builtin_amdgcn_readfirstlane((unsigned)v), hi = __builtin_amdgcn_readfirstlane((unsigned)(v >> 32));
    return (const float*)(GAS const float*)(((unsigned long long)hi << 32) | lo);
}
template <class P> __device__ __forceinline__ P launder_ptr(P p) {
    unsigned long long v = (unsigned long long)p; unsigned lo = (unsigned)v, hi = (unsigned)(v >> 32);
    asm volatile("" : "+v"(lo), "+v"(hi));
    lo = __builtin_amdgcn_readfirstlane(lo); hi = __builtin_amdgcn_readfirstlane(hi);
    return (P)(GAS unsigned char*)(((unsigned long long)hi << 32) | lo);
}
__device__ __forceinline__ void launder(Ctx& F) {
    int t = F.tid, g = F.G, bid = F.bid;
    asm volatile("" : "+v"(t), "+v"(g), "+v"(bid));
    F.tid = t; F.G = __builtin_amdgcn_readfirstlane(g); F.bid = __builtin_amdgcn_readfirstlane(bid); F.lane = t & 63; F.wave = __builtin_amdgcn_readfirstlane(t >> 6);
    F.ws = launder_ptr(F.ws); F.out = launder_ptr(F.out);
}
__device__ __forceinline__ float wave_sum(float v) {
#pragma unroll
    for (int o = 1; o < 64; o <<= 1) v += __shfl_xor(v, o);
    return v;
}
__device__ __forceinline__ int lds_add(LAS int* p, int v) { return __hip_atomic_fetch_add(p, v, __ATOMIC_RELAXED, __HIP_MEMORY_SCOPE_WORKGROUP); }
__device__ __forceinline__ float f8c(float x) { return __builtin_amdgcn_fmed3f(x, -440.f, 440.f); }
__device__ __forceinline__ float sigmoidf_(float x) { return 1.f / (1.f + __expf(-x)); }
__device__ __forceinline__ float siluf_(float x) { return x / (1.f + __expf(-x)); }

enum { I_X = 0, I_C, I_N1G, I_N2G, I_WADA, I_BADA, I_WIN, I_WBSB, I_WBMB, I_WOUT, I_WR, I_RB, I_WGE, I_WUE, I_WDE, I_WGS, I_WUS, I_WDS, I_RELB, I_FG };

__device__ __forceinline__ void transpose_item(const float* W, int ldn, int k0, int n0, bf16_t* WT, int Kdst, int drow0, LAS float* scr, int lane) {
    const float* wp = W + (size_t)(k0 + (lane >> 3)) * ldn + n0 + 4 * (lane & 7);
    f32x4 v[8];
#pragma unroll
    for (int i = 0; i < 8; ++i) v[i] = *(const f32x4*)(wp + (size_t)(8 * i) * ldn);
#pragma unroll
    for (int i = 0; i < 8; ++i) { LAS float* d = scr + (8 * i + (lane >> 3)) * 33 + 4 * (lane & 7); d[0] = v[i].x; d[1] = v[i].y; d[2] = v[i].z; d[3] = v[i].w; }
    LDS_WAIT(); asm volatile("" ::: "memory");
    const int c = lane & 7;
#pragma unroll
    for (int j = 0; j < 4; ++j) { const int n = (lane >> 3) + 8 * j; const LAS float* s = scr + (8 * c) * 33 + n;
        u32x4 o; o.x = cvtpk(s[0 * 33], s[1 * 33]); o.y = cvtpk(s[2 * 33], s[3 * 33]); o.z = cvtpk(s[4 * 33], s[5 * 33]); o.w = cvtpk(s[6 * 33], s[7 * 33]);
        *(u32x4*)(WT + (size_t)(drow0 + n) * Kdst + k0 + 8 * c) = o; }
    LDS_WAIT(); asm volatile("" ::: "memory");
}
__device__ __forceinline__ void phase0(Ctx& F) {
    LAS float* silc = (LAS float*)(F.lds + MISC_OFF - 0);
    silc = (LAS float*)(F.lds + 0);
    for (int i = F.tid; i < 4 * DM; i += 512) silc[i] = siluf_(inp(F, I_C)[i]);
    __syncthreads();
    float* mod = (float*)(F.ws + WS_SMALL + SM_MOD);
    {
        const int gw = F.wave * F.G + F.bid;
        const int c = F.lane & 15, kp = F.lane >> 4;
        const float* wada = inp(F, I_WADA);
        for (int item = gw; item < NMOD / 16; item += 8 * F.G) {
            const int col = item * 16 + c;
            float a0 = 0.f, a1 = 0.f, a2 = 0.f, a3 = 0.f;
#pragma unroll 32
            for (int k = kp; k < DM; k += 4) { const float w = wada[(size_t)k * NMOD + col]; a0 += silc[k] * w; a1 += silc[DM + k] * w; a2 += silc[2 * DM + k] * w; a3 += silc[3 * DM + k] * w; }
            a0 += __shfl_xor(a0, 16); a0 += __shfl_xor(a0, 32); a1 += __shfl_xor(a1, 16); a1 += __shfl_xor(a1, 32);
            a2 += __shfl_xor(a2, 16); a2 += __shfl_xor(a2, 32); a3 += __shfl_xor(a3, 16); a3 += __shfl_xor(a3, 32);
            if (kp == 0) { const float bb = inp(F, I_BADA)[col]; mod[col] = a0 + bb; mod[NMOD + col] = a1 + bb; mod[2 * NMOD + col] = a2 + bb; mod[3 * NMOD + col] = a3 + bb; }
        }
    }
    __syncthreads();
    {
        LAS float* scr = (LAS float*)(F.lds + F.wave * 16384);
        const int gw = F.bid * 8 + F.wave, NGW = F.G * 8, lane = F.lane;
        constexpr int I_IN = 16 * 160, I_BR = 8 * 32, I_OUT = 16 * 32, I_EXP = 384, NIT = I_IN + 2 * I_BR + I_OUT + 65 * I_EXP;
        const float* p_win = inp(F, I_WIN); const float* p_bsb = inp(F, I_WBSB); const float* p_bmb = inp(F, I_WBMB); const float* p_out = inp(F, I_WOUT);
        const float* p_ge = inp(F, I_WGE); const float* p_ue = inp(F, I_WUE); const float* p_de = inp(F, I_WDE); const float* p_gs = inp(F, I_WGS); const float* p_us = inp(F, I_WUS); const float* p_ds = inp(F, I_WDS);
#define TD_GET(IT, SRC, LDN, DST, KD, F8) do { int r = (IT); F8 = 0; \
            if (r < I_IN) { const int kb = r / 160, nb = r % 160; SRC = p_win + (size_t)(kb * 64) * 5120 + nb * 32; LDN = 5120; \
                if (nb < 48) { DST = (bf16_t*)(F.ws + WS_WINT) + (size_t)(nb * 32) * 1024 + kb * 64; KD = 1024; } \
                else { DST = (bf16_t*)((unsigned char*)(F.ws + WS_WIN8) + (size_t)(nb * 32 - 1536) * 1024 + kb * 64); KD = 1024; F8 = 256; } } \
            else if ((r -= I_IN) < I_BR) { const int kb = r / 32, nb = r % 32; SRC = p_bsb + (size_t)(kb * 64) * 1024 + nb * 32; LDN = 1024; DST = (bf16_t*)(F.ws + WS_WBRT) + (size_t)(nb * 32) * 1024 + kb * 64; KD = 1024; } \
            else if ((r -= I_BR) < I_BR) { const int kb = r / 32, nb = r % 32; SRC = p_bmb + (size_t)(kb * 64) * 1024 + nb * 32; LDN = 1024; DST = (bf16_t*)(F.ws + WS_WBRT) + (size_t)(nb * 32) * 1024 + 512 + kb * 64; KD = 1024; } \
            else if ((r -= I_BR) < I_OUT) { const int kb = r / 32, nb = r % 32; SRC = p_out + (size_t)(kb * 64) * 1024 + nb * 32; LDN = 1024; DST = (bf16_t*)(F.ws + WS_WOUTT) + (size_t)(nb * 32) * 1024 + kb * 64; KD = 1024; } \
            else { r -= I_OUT; const int e = r / I_EXP; r -= e * I_EXP; \
                if (r < 128) { const int kb = r / 8, n0 = (r % 8) * 32; SRC = (e < NE ? p_ge + (size_t)e * DM * EFF : p_gs) + (size_t)(kb * 64) * EFF + n0; LDN = EFF; \
                    DST = (bf16_t*)((unsigned char*)(F.ws + WS_W1T) + ((size_t)e * 512 + (n0 >> 7) * 256 + (n0 & 127)) * 1024 + kb * 64); KD = 1024; F8 = 256; } \
                else if (r < 256) { r -= 128; const int kb = r / 8, n0 = (r % 8) * 32; SRC = (e < NE ? p_ue + (size_t)e * DM * EFF : p_us) + (size_t)(kb * 64) * EFF + n0; LDN = EFF; \
                    DST = (bf16_t*)((unsigned char*)(F.ws + WS_W1T) + ((size_t)e * 512 + (n0 >> 7) * 256 + 128 + (n0 & 127)) * 1024 + kb * 64); KD = 1024; F8 = 256; } \
                else { r -= 256; const int kb = r / 32, nb = r % 32; SRC = (e < NE ? p_de + (size_t)e * EFF * DM : p_ds) + (size_t)(kb * 64) * DM + nb * 32; LDN = DM; \
                    DST = (bf16_t*)((unsigned char*)(F.ws + WS_W2T) + ((size_t)e * 1024 + nb * 32) * 256 + kb * 64); KD = 256; F8 = 128; } } } while (0)
#define TD_LOAD(V, SRC, LDN) do { const float* wp_ = (SRC) + (size_t)(lane >> 3) * (LDN) + 4 * (lane & 7); _Pragma("unroll") for (int i = 0; i < 8; ++i) V[i] = *(const f32x4*)(wp_ + (size_t)(8 * i) * (LDN)); } while (0)
#define TD_PROC(V, DST, KD, F8) do { \
            _Pragma("unroll") for (int i = 0; i < 8; ++i) { LAS float* d = scr + (8 * i + (lane >> 3)) * 33 + 4 * (lane & 7); d[0] = V[i].x; d[1] = V[i].y; d[2] = V[i].z; d[3] = V[i].w; } \
            LDS_WAIT(); asm volatile("" ::: "memory"); \
            if (F8) { _Pragma("unroll") for (int j = 0; j < 4; ++j) { const int n = (lane >> 3) + 8 * j; const LAS float* sp = scr + (8 * (lane & 7)) * 33 + n; \
                int w0 = 0, w1 = 0; \
                const float fs_ = (float)(F8); w0 = __builtin_amdgcn_cvt_pk_fp8_f32(f8c(sp[0 * 33] * fs_), f8c(sp[1 * 33] * fs_), w0, false); w0 = __builtin_amdgcn_cvt_pk_fp8_f32(f8c(sp[2 * 33] * fs_), f8c(sp[3 * 33] * fs_), w0, true); \
                w1 = __builtin_amdgcn_cvt_pk_fp8_f32(f8c(sp[4 * 33] * fs_), f8c(sp[5 * 33] * fs_), w1, false); w1 = __builtin_amdgcn_cvt_pk_fp8_f32(f8c(sp[6 * 33] * fs_), f8c(sp[7 * 33] * fs_), w1, true); \
                *(u32x2*)((unsigned char*)(DST) + (size_t)n * (KD) + 8 * (lane & 7)) = (u32x2){(unsigned)w0, (unsigned)w1}; } } \
            else { _Pragma("unroll") for (int j = 0; j < 4; ++j) { const int n = (lane >> 3) + 8 * j; const LAS float* sp = scr + (8 * (lane & 7)) * 33 + n; \
                u32x4 o; o.x = cvtpk(sp[0 * 33], sp[1 * 33]); o.y = cvtpk(sp[2 * 33], sp[3 * 33]); o.z = cvtpk(sp[4 * 33], sp[5 * 33]); o.w = cvtpk(sp[6 * 33], sp[7 * 33]); \
                *(u32x4*)((DST) + (size_t)n * (KD) + 8 * (lane & 7)) = o; } } \
            LDS_WAIT(); asm volatile("" ::: "memory"); } while (0)
        for (int it = 4 * gw; it < NIT; it += 4 * NGW) {
            const float* src[4]; bf16_t* dst[4]; int ld[4], kd[4], f8[4];
            f32x4 v0[8], v1[8], v2[8], v3[8];
            TD_GET(it, src[0], ld[0], dst[0], kd[0], f8[0]); TD_GET(it + 1, src[1], ld[1], dst[1], kd[1], f8[1]); TD_GET(it + 2, src[2], ld[2], dst[2], kd[2], f8[2]); TD_GET(it + 3, src[3], ld[3], dst[3], kd[3], f8[3]);
            TD_LOAD(v0, src[0], ld[0]); TD_LOAD(v1, src[1], ld[1]); TD_LOAD(v2, src[2], ld[2]); TD_LOAD(v3, src[3], ld[3]);
            TD_PROC(v0, dst[0], kd[0], f8[0]); TD_PROC(v1, dst[1], kd[1], f8[1]); TD_PROC(v2, dst[2], kd[2], f8[2]); TD_PROC(v3, dst[3], kd[3], f8[3]);
        }
#undef TD_PROC
#undef TD_GET
#undef TD_LOAD
    }
    {
        bf16_t* wrh = (bf16_t*)(F.ws + WS_SMALL + SM_WRH); bf16_t* wrl = (bf16_t*)(F.ws + WS_SMALL + SM_WRL);
        const float* wr = inp(F, I_WR);
        for (int i = F.bid * 512 + F.tid; i < NE * DM; i += F.G * 512) { const int e = i >> 10, k = i & 1023; const float v = wr[k * NE + e];
            const unsigned h = cvtpk(v, 0.f) & 0xffffu; wrh[i] = (bf16_t)h; wrl[i] = (bf16_t)(cvtpk(v - bflo(h), 0.f) & 0xffffu); }
    }
}

__device__ __forceinline__ void phase1(Ctx& F) {
    const float* mod = (const float*)(F.ws + WS_SMALL + SM_MOD);
    const float* x = inp(F, I_X); const float* g1 = inp(F, I_N1G);
    bf16_t* H = (bf16_t*)(F.ws + WS_H); unsigned char* H8 = (unsigned char*)(F.ws + WS_H8);
    const int gw = F.bid * 8 + F.wave, NGW = F.G * 8;
    if (gw < 256) {
        const int b = gw >> 6, e = gw & 63; const float* wr = inp(F, I_WR); float a = 0.f;
#pragma unroll 4
        for (int k = F.lane; k < DM; k += 64) a += mod[b * NMOD + 3 * DM + k] * wr[k * NE + e];
        a = wave_sum(a);
        if (F.lane == 0) ((float*)(F.ws + WS_SMALL + SM_CB))[gw] = a;
    }
    if (F.bid == 32) {
        float* gvec = (float*)(F.ws + WS_SMALL + SM_GVEC); const float* g2 = inp(F, I_N2G);
        for (int i = F.tid; i < 4 * DM; i += 512) { const int b = i >> 10, k = i & 1023; gvec[i] = g2[k] * (1.f + mod[b * NMOD + 4 * DM + k]); }
    }
    for (int m0 = gw; m0 < MT; m0 += 2 * NGW) {
        const int m1 = m0 + NGW;
        const bool two = m1 < MT;
        const f32x4* xr0 = (const f32x4*)(x + (size_t)m0 * DM) + F.lane; const f32x4* xr1 = (const f32x4*)(x + (size_t)(two ? m1 : m0) * DM) + F.lane;
        f32x4 v0[4], v1[4]; float s0 = 0.f, s1 = 0.f;
#pragma unroll
        for (int j = 0; j < 4; ++j) { v0[j] = xr0[64 * j]; v1[j] = xr1[64 * j]; }
#pragma unroll
        for (int j = 0; j < 4; ++j) { s0 += (v0[j].x * v0[j].x + v0[j].y * v0[j].y) + (v0[j].z * v0[j].z + v0[j].w * v0[j].w); s1 += (v1[j].x * v1[j].x + v1[j].y * v1[j].y) + (v1[j].z * v1[j].z + v1[j].w * v1[j].w); }
        const float r0 = rsqrtf(wave_sum(s0) * (1.f / DM) + EPS), r1 = rsqrtf(wave_sum(s1) * (1.f / DM) + EPS);
        const int b0 = m0 / SEQ, b1 = (two ? m1 : m0) / SEQ;
        u32x2* o0 = (u32x2*)(H + (size_t)m0 * DM) + F.lane; u32x2* o1 = (u32x2*)(H + (size_t)(two ? m1 : m0) * DM) + F.lane;
#pragma unroll
        for (int j = 0; j < 4; ++j) {
            const int col = 4 * F.lane + 256 * j;
            const f32x4 g = *(const f32x4*)(g1 + col);
            const f32x4 h0 = (v0[j] * r0) * g * (*(const f32x4*)(mod + b0 * NMOD + DM + col) + 1.0f) + *(const f32x4*)(mod + b0 * NMOD + col);
            const f32x4 h1 = (v1[j] * r1) * g * (*(const f32x4*)(mod + b1 * NMOD + DM + col) + 1.0f) + *(const f32x4*)(mod + b1 * NMOD + col);
            u32x2 w; w.x = cvtpk(h0.x, h0.y); w.y = cvtpk(h0.z, h0.w); o0[64 * j] = w;
            { int q8 = 0; q8 = __builtin_amdgcn_cvt_pk_fp8_f32(f8c(h0.x * 16.f), f8c(h0.y * 16.f), q8, false); q8 = __builtin_amdgcn_cvt_pk_fp8_f32(f8c(h0.z * 16.f), f8c(h0.w * 16.f), q8, true);
              ((unsigned*)(H8 + (size_t)m0 * DM) + F.lane)[64 * j] = (unsigned)q8; }
            if (two) { w.x = cvtpk(h1.x, h1.y); w.y = cvtpk(h1.z, h1.w); o1[64 * j] = w;
                int q8 = 0; q8 = __builtin_amdgcn_cvt_pk_fp8_f32(f8c(h1.x * 16.f), f8c(h1.y * 16.f), q8, false); q8 = __builtin_amdgcn_cvt_pk_fp8_f32(f8c(h1.z * 16.f), f8c(h1.w * 16.f), q8, true);
                ((unsigned*)(H8 + (size_t)m1 * DM) + F.lane)[64 * j] = (unsigned)q8; }
        }
    }
}

struct ProjSched {
    const char* A; const char* Bt; int G, c, pn0, npn, f8; int R[2], C[2];
    __device__ __forceinline__ bool next(int i, gm::UnitD& u) {
        int pm, pn; if (!gm::static_tile(MT, npn * 256, G, c, i, pm, pn)) return false;
        const int kp = f8 ? 512 : 1024;
        u.a = A; u.b = Bt + (size_t)pn * 256 * kp * 2;
#pragma unroll
        for (int h = 0; h < 2; ++h)
#pragma unroll
            for (int j = 0; j < 2; ++j) u.va[h][j] = (unsigned)((pm * 256 + h * 128 + R[j]) * kp + C[j]) * 2u;
        u.e0 = pm; u.e1 = pn0 + pn; u.e2 = f8; u.e3 = 0; return true;
    }
};
struct EpiProj {
    bf16_t* qsb; bf16_t* qmb; bf16_t* g; float* kbs;
    __device__ __forceinline__ void operator()(const f32x4 (&acc)[2][2][4][2], const gm::UnitD& u, int wr, int wc, int fr, int fq) const {
        const int pm = u.e0, pn = u.e1;
        bf16_t* base; int ldc, colt; float sc = 1.f;
        if (pn < 6) { base = qsb; ldc = QW; colt = pn * 256; if (pn < 2) sc = 0.125f * LOG2E; }
        else if (pn < 12) { base = qmb; ldc = QW; colt = (pn - 6) * 256; if (pn < 8) sc = 0.125f; }
        else { base = g; ldc = 2048; colt = (pn - 12) * 256; }
        if (u.e2) sc *= (1.f / 4096.f);
        const int row0 = pm * 256 + wr * 64 + fr, col0 = colt + wc * 32 + 8 * fq;
        if (pn == 8 || pn == 9) {
#pragma unroll
            for (int bj = 0; bj < 2; ++bj)
#pragma unroll
                for (int n = 0; n < 2; ++n) { f32x4 cs = (f32x4){0.f, 0.f, 0.f, 0.f};
#pragma unroll
                    for (int ai = 0; ai < 2; ++ai)
#pragma unroll
                        for (int m = 0; m < 4; ++m) cs += acc[ai][bj][m][n];
#pragma unroll
                    for (int o = 1; o < 16; o <<= 1) { cs[0] += __shfl_xor(cs[0], o); cs[1] += __shfl_xor(cs[1], o); cs[2] += __shfl_xor(cs[2], o); cs[3] += __shfl_xor(cs[3], o); }
                    if (fr == 0) { float* kd = kbs + (size_t)pm * 512 + (pn - 8) * 256 + bj * 128 + wc * 32 + 8 * fq + 4 * n;
#pragma unroll
                        for (int j = 0; j < 4; ++j) atomicAdd(kd + j, cs[j]); } }
        }
#pragma unroll
        for (int ai = 0; ai < 2; ++ai)
#pragma unroll
            for (int m = 0; m < 4; ++m) { bf16_t* rowp = base + (size_t)(row0 + ai * 128 + m * 16) * ldc + col0;
#pragma unroll
                for (int bj = 0; bj < 2; ++bj) { const f32x4 v0 = acc[ai][bj][m][0] * sc, v1 = acc[ai][bj][m][1] * sc;
                    u32x4 w; w.x = cvtpk(v0[0], v0[1]); w.y = cvtpk(v0[2], v0[3]); w.z = cvtpk(v1[0], v1[1]); w.w = cvtpk(v1[2], v1[3]);
                    *(u32x4*)(rowp + bj * 128) = w; } }
    }
};
__device__ __forceinline__ void phase2(Ctx& F) {
    EpiProj E{(bf16_t*)(F.ws + WS_QSB), (bf16_t*)(F.ws + WS_QMB), (bf16_t*)(F.ws + WS_G), (float*)(F.ws + WS_CTL + CTL_KBS)};
    {
        ProjSched S; S.A = (const char*)(F.ws + WS_H); S.Bt = (const char*)(F.ws + WS_WINT); S.G = F.G; S.c = F.bid; S.pn0 = 0; S.npn = 6; S.f8 = 0; gm::stage_geom(F.tid, S.R, S.C);
        gm::gemm_phase<true>(F.lds, 1024, S, E);
    }
    {
        ProjSched S; S.A = (const char*)(F.ws + WS_H8); S.Bt = (const char*)(F.ws + WS_WIN8); S.G = F.G; S.c = F.bid; S.pn0 = 6; S.npn = 14; S.f8 = 1; gm::stage_geom(F.tid, S.R, S.C);
        gm::gemm_phase<true, false, true>(F.lds, 512, S, E);
    }
}

__device__ __forceinline__ int crow(int r, int hi) { return (r & 3) + 8 * (r >> 2) + 4 * hi; }
typedef short v4i16_t __attribute__((ext_vector_type(4)));
__device__ __forceinline__ s16x4 vtr(const LAS unsigned char* p) { return __builtin_bit_cast(s16x4, __builtin_amdgcn_ds_read_tr16_b64_v4i16((LAS v4i16_t*)p)); }
#define PV_TR(dst, off) asm volatile("ds_read_b64_tr_b16 %0, %1 offset:%2" : "=v"(dst) : "v"(vb), "n"(off) : "memory")
__device__ __forceinline__ void pv64(f32x16 (&o)[2], const LAS unsigned char* vt, int lane, const u32x4 (&pw)[4]) {
    const int hi = lane >> 5;
    const LAS unsigned char* vb = vt + ((lane >> 4) & 1) * 32 + (lane & 3) * 8 + (4 * hi + ((lane & 15) >> 2)) * 64;
    s16x4 lo[2][4], hh[2][4];
#pragma unroll
    for (int ks = 0; ks < 4; ++ks) { PV_TR(lo[0][ks], ks * 1024); PV_TR(hh[0][ks], ks * 1024 + 512); }
#pragma unroll
    for (int ks = 0; ks < 4; ++ks) { PV_TR(lo[1][ks], 4096 + ks * 1024); PV_TR(hh[1][ks], 4096 + ks * 1024 + 512); }
    asm volatile("s_waitcnt lgkmcnt(8)" : "+v"(lo[0][0]), "+v"(lo[0][1]), "+v"(lo[0][2]), "+v"(lo[0][3]), "+v"(hh[0][0]), "+v"(hh[0][1]), "+v"(hh[0][2]), "+v"(hh[0][3]) :: "memory");
#pragma unroll
    for (int ks = 0; ks < 4; ++ks) {
        const bf16x8 bv = (bf16x8){lo[0][ks][0], lo[0][ks][1], lo[0][ks][2], lo[0][ks][3], hh[0][ks][0], hh[0][ks][1], hh[0][ks][2], hh[0][ks][3]};
        o[0] = __builtin_amdgcn_mfma_f32_32x32x16_bf16(__builtin_bit_cast(bf16x8, pw[ks]), bv, o[0], 0, 0, 0);
    }
    asm volatile("s_waitcnt lgkmcnt(0)" : "+v"(lo[1][0]), "+v"(lo[1][1]), "+v"(lo[1][2]), "+v"(lo[1][3]), "+v"(hh[1][0]), "+v"(hh[1][1]), "+v"(hh[1][2]), "+v"(hh[1][3]) :: "memory");
#pragma unroll
    for (int ks = 0; ks < 4; ++ks) {
        const bf16x8 bv = (bf16x8){lo[1][ks][0], lo[1][ks][1], lo[1][ks][2], lo[1][ks][3], hh[1][ks][0], hh[1][ks][1], hh[1][ks][2], hh[1][ks][3]};
        o[1] = __builtin_amdgcn_mfma_f32_32x32x16_bf16(__builtin_bit_cast(bf16x8, pw[ks]), bv, o[1], 0, 0, 0);
    }
}
__device__ __forceinline__ void store_o_tile(const f32x16 (&o)[2], LAS unsigned char* stgb, int lane, bf16_t* dst0, size_t row_pitch) {
    const int r32 = lane & 31, hi = lane >> 5;
    LAS bf16_t* stg = (LAS bf16_t*)stgb;
#pragma unroll
    for (int r = 0; r < 16; ++r) { const int orow = crow(r, hi);
#pragma unroll
        for (int d0 = 0; d0 < 2; ++d0) stg[orow * 64 + d0 * 32 + r32] = (bf16_t)(cvtpk(o[d0][r], 0.f) & 0xffffu); }
    LDS_WAIT();
#pragma unroll
    for (int i = 0; i < 4; ++i) { const int row = i * 8 + (lane >> 3), ch = lane & 7; const u32x4 v = *(const LAS u32x4*)(stg + row * 64 + ch * 8); *(u32x4*)(dst0 + (size_t)row * row_pitch + ch * 8) = v; }
    LDS_WAIT();
}

template <bool MASKED>
__device__ __forceinline__ void sb_tile(const f32x16 (&z)[2], float& P, u32x4 (&pw)[4], int k0, int qpos, int hi) {
    f32x16 be[2], nb[2];
#pragma unroll
    for (int p = 0; p < 2; ++p)
#pragma unroll
        for (int r = 0; r < 16; ++r) {
            const float zz = __builtin_amdgcn_fmed3f(z[p][r], -126.f, 126.f);
            const float t = __builtin_amdgcn_exp2f(-zz), b_ = __builtin_amdgcn_rcpf(1.f + t);
            float n_ = t * b_, bb = b_;
            if (MASKED) { const bool valid = (k0 + 32 * p + crow(r, hi)) < qpos; n_ = valid ? n_ : 1.f; bb = valid ? bb : 0.f; }
            be[p][r] = bb; nb[p][r] = n_;
        }
    float Gp[8], PG[8], off[8];
#pragma unroll
    for (int idx = 0; idx < 8; ++idx) { const int p = idx >> 2, g4 = (idx & 3) * 4; Gp[idx] = (nb[p][g4] * nb[p][g4 + 1]) * (nb[p][g4 + 2] * nb[p][g4 + 3]); }
#pragma unroll
    for (int idx = 0; idx < 8; ++idx) PG[idx] = __shfl_xor(Gp[idx], 32);
    float run = P;
#pragma unroll
    for (int idx = 7; idx >= 0; --idx) { off[idx] = hi ? run : run * PG[idx]; run *= (Gp[idx] * PG[idx]); }
    P = run;
#pragma unroll
    for (int idx = 0; idx < 8; ++idx) { const int p = idx >> 2, g4 = (idx & 3) * 4; float c = off[idx]; float a[4];
#pragma unroll
        for (int j = 3; j >= 0; --j) { a[j] = be[p][g4 + j] * c; c *= nb[p][g4 + j]; }
        pw[idx >> 1][(idx & 1) * 2] = cvtpk(a[0], a[1]); pw[idx >> 1][(idx & 1) * 2 + 1] = cvtpk(a[2], a[3]); }
}
__device__ __forceinline__ void sb_unit(Ctx& F, int bh, int qt, LAS unsigned char* vl) {
    const int lane = F.lane, r32 = lane & 31, hi = lane >> 5;
    const int b = bh >> 3, h = bh & 7, q0 = qt * 32, qpos = q0 + r32;
    const bf16_t* base = (const bf16_t*)(F.ws + WS_QSB) + (size_t)b * SEQ * QW + h * 64;
    const bf16_t* Kb = base + 512 + (size_t)r32 * QW + hi * 8; const bf16_t* Vb = base + 1024 + (size_t)(lane >> 2) * QW + (lane & 3) * 8;
    bf16x8 qr[4];
#pragma unroll
    for (int d0 = 0; d0 < 4; ++d0) qr[d0] = *(const bf16x8*)(base + (size_t)qpos * QW + d0 * 16 + hi * 8);
    float P = 1.f; f32x16 o[2]; o[0] = f32x16{}; o[1] = f32x16{};
    bf16x8 kfn[8];
    const int kt0 = q0 >> 6; int kt = kt0, cur = 0;
#define SB_PREFETCH(KT, BUF) do { const size_t ko_ = (size_t)(KT) * 64 * QW; \
        _Pragma("unroll") for (int d0 = 0; d0 < 4; ++d0) _Pragma("unroll") for (int hf = 0; hf < 2; ++hf) kfn[2 * d0 + hf] = *(const bf16x8*)(Kb + ko_ + (size_t)(32 * hf) * QW + d0 * 16); \
        _Pragma("unroll") for (int p = 0; p < 8; ++p) __builtin_amdgcn_global_load_lds((const unsigned*)(Vb + ko_ + (size_t)(16 * (p & 3)) * QW + (p >> 2) * 32), (LAS unsigned*)(vl + (BUF) * 8192 + p * 1024), 16, 0, 0); } while (0)
    SB_PREFETCH(kt, 0);
#pragma unroll 1
    for (; kt >= 0; --kt) {
        if (__all(P == 0.f)) break;
        f32x16 z[2]; z[0] = f32x16{}; z[1] = f32x16{};
#pragma unroll
        for (int d0 = 0; d0 < 4; ++d0) { z[0] = __builtin_amdgcn_mfma_f32_32x32x16_bf16(kfn[2 * d0], qr[d0], z[0], 0, 0, 0); z[1] = __builtin_amdgcn_mfma_f32_32x32x16_bf16(kfn[2 * d0 + 1], qr[d0], z[1], 0, 0, 0); }
        asm volatile("" : "+v"(z[0]), "+v"(z[1]));
        { const int ktn = kt > 0 ? kt - 1 : 0; SB_PREFETCH(ktn, cur ^ 1); }
        u32x4 pw[4];
        if (kt == kt0) sb_tile<true>(z, P, pw, kt * 64, qpos, hi); else sb_tile<false>(z, P, pw, kt * 64, qpos, hi);
        asm volatile("s_waitcnt vmcnt(16)" ::: "memory");
        pv64(o, vl + cur * 8192, lane, pw);
        cur ^= 1;
    }
#undef SB_PREFETCH
    asm volatile("s_waitcnt vmcnt(0)" ::: "memory");
    bf16_t* dst = (bf16_t*)(F.ws + WS_OB) + (size_t)(b * SEQ + q0) * 1024 + h * 64;
    store_o_tile(o, vl, lane, dst, 1024);
}
__device__ __forceinline__ void sb_units(Ctx& F) {
    const int gw = F.bid * 8 + F.wave, NGW = F.G * 8;
    LAS unsigned char* vl = F.lds + F.wave * 16384;
    for (int u = gw; u < 32 * 256; u += NGW) sb_unit(F, u >> 8, u & 255, vl);
}

constexpr int MO_LUT = 0, MO_PRE = 4224, MO_WSF = 8320, MO_ENT = 12416, MO_ST = 16368;
__device__ __forceinline__ int mb_list_off(int j) { return 256 * (31 * j - (j * (j - 1)) / 2); }
constexpr int MB_LIST_STRIDE = 126976;
__device__ __forceinline__ int t5_bucket_dev(int n) {
    if (n < 16) return n;
    int large = 16 + (int)(logf((float)n / 16.f) / 2.0794415416798357f * 16.f);
    return large < 31 ? large : 31;
}
__device__ __forceinline__ void build_lut(Ctx& F) {
    LAS float* lut = (LAS float*)(F.lds + MISC_OFF + MO_LUT);
    for (int i = F.tid; i < 8 * 132; i += 512) { const int h = i / 132, d = i % 132; lut[i] = inp(F, I_RELB)[h * 32 + t5_bucket_dev(d < 128 ? d : 128)] * LOG2E; }
}
__device__ __forceinline__ void phase4(Ctx& F) {
    LAS int* lcnt = (LAS int*)(F.lds + MISC_OFF + MO_PRE); LAS int* lbase = lcnt + 32;
    const float* kbar = (const float*)(F.ws + WS_CTL + CTL_KBS);
    unsigned* cur = (unsigned*)(F.ws + WS_CTL) + CW_MBCUR;
    unsigned short* lists = (unsigned short*)(F.ws + WS_LMB);
    const int lane = F.lane, r32 = lane & 31, hi = lane >> 5;
    for (int u = F.bid; u < 32 * 31; u += F.G) {
        const int bh = u / 31, i = 1 + (u % 31), b = bh >> 3, h = bh & 7;
        if (F.tid < 32) lcnt[F.tid] = 0;
        __syncthreads();
        const int qpos = i * 256 + F.wave * 32 + r32;
        const float* kp = kbar + (size_t)(b * 32 + r32) * 512 + h * 64 + hi * 8;
        const bf16_t* qp = (const bf16_t*)(F.ws + WS_QMB) + (size_t)(b * SEQ + qpos) * QW + h * 64 + hi * 8;
        f32x16 gt = f32x16{};
#pragma unroll
        for (int s4 = 0; s4 < 4; ++s4) {
            const f32x4 k0 = *(const f32x4*)(kp + 16 * s4), k1 = *(const f32x4*)(kp + 16 * s4 + 4);
            const bf16x8 qf = *(const bf16x8*)(qp + 16 * s4);
            const unsigned a0 = cvtpk(k0.x, k0.y), a1 = cvtpk(k0.z, k0.w), a2 = cvtpk(k1.x, k1.y), a3 = cvtpk(k1.z, k1.w);
            const u32x4 kh = (u32x4){a0, a1, a2, a3};
            const u32x4 kl = (u32x4){cvtpk(k0.x - bflo(a0), k0.y - bfhi(a0)), cvtpk(k0.z - bflo(a1), k0.w - bfhi(a1)), cvtpk(k1.x - bflo(a2), k1.y - bfhi(a2)), cvtpk(k1.z - bflo(a3), k1.w - bfhi(a3))};
            gt = __builtin_amdgcn_mfma_f32_32x32x16_bf16(__builtin_bit_cast(bf16x8, kl), qf, gt, 0, 0, 0);
            gt = __builtin_amdgcn_mfma_f32_32x32x16_bf16(__builtin_bit_cast(bf16x8, kh), qf, gt, 0, 0, 0);
        }
        float v0 = -INFINITY, v1 = -INFINITY, v2 = -INFINITY; int j0 = 64, j1 = 64, j2 = 64;
#pragma unroll
        for (int r = 0; r < 16; ++r) { const int j = crow(r, hi); const float g = j < i ? gt[r] : -INFINITY;
            if (g > v0) { v2 = v1; j2 = j1; v1 = v0; j1 = j0; v0 = g; j0 = j; }
            else if (g > v1) { v2 = v1; j2 = j1; v1 = g; j1 = j; }
            else if (g > v2) { v2 = g; j2 = j; } }
        {
            const float pv[3] = {__shfl_xor(v0, 32), __shfl_xor(v1, 32), __shfl_xor(v2, 32)}; const int pj[3] = {__shfl_xor(j0, 32), __shfl_xor(j1, 32), __shfl_xor(j2, 32)};
#pragma unroll
            for (int t = 0; t < 3; ++t) { const float g = pv[t]; const int j = pj[t];
                if (g > v0 || (g == v0 && j < j0)) { v2 = v1; j2 = j1; v1 = v0; j1 = j0; v0 = g; j0 = j; }
                else if (g > v1 || (g == v1 && j < j1)) { v2 = v1; j2 = j1; v1 = g; j1 = j; }
                else if (g > v2 || (g == v2 && j < j2)) { v2 = g; j2 = j; } }
        }
        const int nsel = i < 3 ? i : 3;
        int r0 = 0, r1 = 0, r2 = 0;
        if (hi == 0) { r0 = lds_add(&lcnt[j0], 1); if (nsel > 1) r1 = lds_add(&lcnt[j1], 1); if (nsel > 2) r2 = lds_add(&lcnt[j2], 1); }
        __syncthreads();
        if (F.tid < i) { const int n = lcnt[F.tid]; lbase[F.tid] = n > 0 ? (int)atomicAdd(&cur[bh * 32 + F.tid], (unsigned)n) : 0; }
        __syncthreads();
        if (hi == 0) {
            unsigned short* lb = lists + (size_t)bh * MB_LIST_STRIDE;
            lb[mb_list_off(j0) + lbase[j0] + r0] = (unsigned short)(qpos | (0 << 13));
            if (nsel > 1) lb[mb_list_off(j1) + lbase[j1] + r1] = (unsigned short)(qpos | (1 << 13));
            if (nsel > 2) lb[mb_list_off(j2) + lbase[j2] + r2] = (unsigned short)(qpos | (2 << 13));
        }
    }
}
__device__ __forceinline__ void kv_dma(Ctx& F, const bf16_t* kg, const bf16_t* vg, int bufoff) {
    const int l = F.lane;
#pragma unroll
    for (int i = 0; i < 4; ++i) { const int p = 4 * F.wave + i;
        __builtin_amdgcn_global_load_lds((const unsigned*)(kg + (size_t)(8 * p + (l >> 3)) * QW + ((l & 7) ^ ((l >> 3) & 7)) * 8), (LAS unsigned*)(F.lds + bufoff + p * 1024), 16, 0, 0);
        __builtin_amdgcn_global_load_lds((const unsigned*)(vg + (size_t)((p >> 3) * 64 + (p & 3) * 16 + (l >> 2)) * QW + ((p >> 2) & 1) * 32 + (l & 3) * 8), (LAS unsigned*)(F.lds + bufoff + 32768 + p * 1024), 16, 0, 0); }
}
__device__ __forceinline__ void softmax_step(f32x16 (&t)[2], float& m, float& l, f32x16 (&o)[2], LAS float* wsf, const LAS unsigned char* vt, int lane) {
    const int r32 = lane & 31, hi = lane >> 5;
    float rm = -INFINITY;
#pragma unroll
    for (int p = 0; p < 2; ++p)
#pragma unroll
        for (int r = 0; r < 16; ++r) rm = fmaxf(rm, t[p][r]);
    rm = fmaxf(rm, __shfl_xor(rm, 32));
    const float mn = fmaxf(m, rm);
    const float f = __builtin_amdgcn_exp2f(m - mn);
    m = mn;
    float s = 0.f; u32x4 pw[4];
#pragma unroll
    for (int p = 0; p < 2; ++p)
#pragma unroll
        for (int r = 0; r < 16; ++r) { const float e = __builtin_amdgcn_exp2f(t[p][r] - mn); t[p][r] = e; s += e; }
    l = l * f + s;
#pragma unroll
    for (int idx = 0; idx < 8; ++idx) { const int p = idx >> 2, g4 = (idx & 3) * 4; pw[idx >> 1][(idx & 1) * 2] = cvtpk(t[p][g4], t[p][g4 + 1]); pw[idx >> 1][(idx & 1) * 2 + 1] = cvtpk(t[p][g4 + 2], t[p][g4 + 3]); }
    if (__any(f != 1.f)) {
        if (hi == 0) wsf[r32] = f;
        LDS_WAIT();
#pragma unroll
        for (int g = 0; g < 4; ++g) { const f32x4 fv = *(const LAS f32x4*)(wsf + 8 * g + 4 * hi);
#pragma unroll
            for (int j = 0; j < 4; ++j) { o[0][4 * g + j] *= fv[j]; o[1][4 * g + j] *= fv[j]; } }
        LDS_WAIT();
    }
    pv64(o, vt, lane, pw);
}
__device__ __forceinline__ void qkt64(f32x16 (&t)[2], const LAS unsigned char* kt, const bf16x8 (&qr)[4], int lane) {
    const int r32 = lane & 31, hi = lane >> 5;
    t[0] = f32x16{}; t[1] = f32x16{};
    const LAS unsigned char* rp = kt + r32 * 128;
#pragma unroll
    for (int d0 = 0; d0 < 4; ++d0) {
        const int pos = ((2 * d0 + hi) ^ (r32 & 7)) * 16;
        const bf16x8 k0 = *(const LAS bf16x8*)(rp + pos), k1 = *(const LAS bf16x8*)(rp + 4096 + pos);
        t[0] = __builtin_amdgcn_mfma_f32_32x32x16_bf16(k0, qr[d0], t[0], 0, 0, 0); t[1] = __builtin_amdgcn_mfma_f32_32x32x16_bf16(k1, qr[d0], t[1], 0, 0, 0);
    }
}
__device__ __forceinline__ void phase5(Ctx& F) {
    LAS int* pre = (LAS int*)(F.lds + MISC_OFF + MO_PRE);
    LAS int* wtot = (LAS int*)(F.lds + MISC_OFF + MO_ENT);
    const unsigned* cur = (const unsigned*)(F.ws + WS_CTL) + CW_MBCUR;
    build_lut(F);
    int total;
    {
        const int p0 = 2 * F.tid, p1 = p0 + 1;
        const int n0 = p0 < 992 ? (int)cur[(p0 / 31) * 32 + (p0 % 31)] : 0, n1 = p1 < 992 ? (int)cur[(p1 / 31) * 32 + (p1 % 31)] : 0;
        const int c0 = (n0 + 255) >> 8, c1 = (n1 + 255) >> 8;
        const int s = c0 + c1; int v = s;
#pragma unroll
        for (int o = 1; o < 64; o <<= 1) { const int n = __shfl_up(v, o); if (F.lane >= o) v += n; }
        if (F.lane == 63) wtot[248 + F.wave] = v;
        __syncthreads();
        int woff = 0; total = 0;
#pragma unroll
        for (int w = 0; w < 8; ++w) { const int x = wtot[248 + w]; if (w < F.wave) woff += x; total += x; }
        const int excl = woff + v - s;
        pre[p0] = excl | (n0 << 16); pre[p1] = (excl + c0) | (n1 << 16);
        __syncthreads();
    }
    const unsigned short* lists = (const unsigned short*)(F.ws + WS_LMB);
    LAS float* wsf = (LAS float*)(F.lds + MISC_OFF + MO_WSF) + F.wave * 128;
    LAS int* ent = (LAS int*)(F.lds + MISC_OFF + MO_ENT) + F.wave * 32;
    const int lane = F.lane, r32 = lane & 31, hi = lane >> 5;
#define P5_UNIT(U, BH, J, C, N) do { int lo_ = 0, hi_ = 992; while (hi_ - lo_ > 1) { const int mid = (lo_ + hi_) >> 1; if ((pre[mid] & 0xffff) <= (U)) lo_ = mid; else hi_ = mid; } \
        const int w_ = pre[lo_]; BH = lo_ / 31; J = lo_ % 31; C = (U) - (w_ & 0xffff); N = w_ >> 16; } while (0)
#define P5_DMA(BH, J, BUF) do { const bf16_t* b_ = (const bf16_t*)(F.ws + WS_QMB) + (size_t)((BH) >> 3) * SEQ * QW + ((BH) & 7) * 64; kv_dma(F, b_ + 512 + (size_t)((J) * 256) * QW, b_ + 1024 + (size_t)((J) * 256) * QW, (BUF) * 65536); } while (0)
#define P5_ENTRY(BH, J, C, N, ACT, VALID, ENTRY) do { const int e0_ = (C) * 256 + F.wave * 32; ACT = e0_ < (N); VALID = ACT && (e0_ + r32) < (N); \
        const unsigned short* lb_ = lists + (size_t)(BH) * MB_LIST_STRIDE + mb_list_off(J); ENTRY = ACT ? (int)lb_[VALID ? e0_ + r32 : e0_] : 0; } while (0)
#define P5_QLOAD(BH, ENTRY, Q) do { const bf16_t* b_ = (const bf16_t*)(F.ws + WS_QMB) + (size_t)((BH) >> 3) * SEQ * QW + ((BH) & 7) * 64 + (size_t)((ENTRY) & 8191) * QW + hi * 8; \
        _Pragma("unroll") for (int d0 = 0; d0 < 4; ++d0) Q[d0] = *(const bf16x8*)(b_ + d0 * 16); } while (0)
    int u = F.bid, bh = 0, j = 0, c = 0, n = 0, buf = 0, bhn = 0, jn = 0, cn = 0, nn = 0;
    bool act = false, valid = false, actn = false, validn = false; int entry = 0, entryn = 0; bf16x8 qr[4] = {};
    if (u < total) {
        P5_UNIT(u, bh, j, c, n); P5_ENTRY(bh, j, c, n, act, valid, entry);
        if (u + F.G < total) { P5_UNIT(u + F.G, bhn, jn, cn, nn); P5_ENTRY(bhn, jn, cn, nn, actn, validn, entryn); }
        P5_QLOAD(bh, entry, qr); P5_DMA(bh, j, 0);
    }
    asm volatile("s_waitcnt vmcnt(0)" : "+v"(qr[0]), "+v"(qr[1]), "+v"(qr[2]), "+v"(qr[3]), "+v"(entry), "+v"(entryn) :: "memory");
    for (; u < total; u += F.G) {
        const bool has_next = u + F.G < total, has_n2 = u + 2 * F.G < total;
        int bh2 = 0, j2 = 0, c2 = 0, n2 = 0;
        if (has_n2) P5_UNIT(u + 2 * F.G, bh2, j2, c2, n2);
        const int h = bh & 7;
        const int qpos = entry & 8191, slot = entry >> 13;
        LDS_WAIT();
        __builtin_amdgcn_s_barrier();
        bool act2 = false, valid2 = false; int entry2 = 0; bf16x8 qn[4] = {};
        if (has_next) { P5_QLOAD(bhn, entryn, qn); P5_DMA(bhn, jn, buf ^ 1); }
        if (has_n2) P5_ENTRY(bh2, j2, c2, n2, act2, valid2, entry2);
        const LAS unsigned char* kimg = F.lds + buf * 65536; const LAS unsigned char* vimg = kimg + 32768;
        float m = -INFINITY, l = 0.f; f32x16 o[2];
        if (act) {
            if (hi == 0) ent[r32] = valid ? entry : -1;
            o[0] = f32x16{}; o[1] = f32x16{};
            const LAS float* lut = (const LAS float*)(F.lds + MISC_OFF + MO_LUT) + h * 132;
            const float bfar = lut[128];
#pragma unroll 1
            for (int st = 0; st < 4; ++st) {
                f32x16 t[2]; qkt64(t, kimg + st * 8192, qr, lane);
                const int kbase = j * 256 + st * 64;
                const bool far = __all(qpos - (kbase + 63) >= 128);
                if (far) {
#pragma unroll
                    for (int pp = 0; pp < 2; ++pp)
#pragma unroll
                        for (int r = 0; r < 16; ++r) t[pp][r] = t[pp][r] * LOG2E + bfar;
                } else {
#pragma unroll
                    for (int pp = 0; pp < 2; ++pp)
#pragma unroll
                        for (int r = 0; r < 16; ++r) { int d = qpos - (kbase + 32 * pp + crow(r, hi)); d = d < 128 ? d : 128; d = d > 0 ? d : 0; t[pp][r] = t[pp][r] * LOG2E + lut[d]; }
                }
                softmax_step(t, m, l, o, wsf, vimg + st * 8192, lane);
            }
        }
        asm volatile("s_waitcnt vmcnt(0)" : "+v"(qn[0]), "+v"(qn[1]), "+v"(qn[2]), "+v"(qn[3]), "+v"(entry2) :: "memory");
#pragma unroll
        for (int d0 = 0; d0 < 4; ++d0) qr[d0] = qn[d0];
        if (act) {
            l += __shfl_xor(l, 32);
            const float rl = 1.f / l;
            if (hi == 0) { wsf[r32] = rl; if (valid) ((float*)(F.ws + WS_PLSE))[((size_t)bh * SEQ + qpos) * 3 + slot] = m + __log2f(l); }
            LDS_WAIT();
            {
                LAS bf16_t* stg = (LAS bf16_t*)(F.lds + MISC_OFF + MO_STG + F.wave * 2048);
                bf16_t* po = (bf16_t*)(F.ws + WS_PO);
#pragma unroll
                for (int d0 = 0; d0 < 2; ++d0) {
#pragma unroll
                    for (int r = 0; r < 16; ++r) { const int q = crow(r, hi); stg[q * 32 + r32] = (bf16_t)(cvtpk(o[d0][r] * wsf[q], 0.f) & 0xffffu); }
                    LDS_WAIT();
#pragma unroll
                    for (int it2 = 0; it2 < 2; ++it2) { const int row = it2 * 16 + (lane >> 2), ch = lane & 3; const int en = ent[row];
                        const u32x4 v = *(const LAS u32x4*)(stg + row * 32 + ch * 8);
                        if (en >= 0) *(u32x4*)(po + (((size_t)bh * SEQ + (en & 8191)) * 3 + (en >> 13)) * 64 + d0 * 32 + ch * 8) = v; }
                    LDS_WAIT();
                }
            }
        }
        bh = bhn; j = jn; c = cn; n = nn; act = actn; valid = validn; entry = entryn;
        bhn = bh2; jn = j2; cn = c2; nn = n2; actn = act2; validn = valid2; entryn = entry2;
        buf ^= 1;
    }
#undef P5_ENTRY
#undef P5_QLOAD
#undef P5_UNIT
#undef P5_DMA
    asm volatile("s_waitcnt vmcnt(0)" ::: "memory");
    __syncthreads();
}
__device__ __forceinline__ void phase6(Ctx& F) {
    build_lut(F);
    LAS float* wsf = (LAS float*)(F.lds + MISC_OFF + MO_WSF) + F.wave * 128;
    const int lane = F.lane, r32 = lane & 31, hi = lane >> 5, w = F.wave;
#define P6_DMA(U, BUF) do { const int bh_ = (U) >> 5, i_ = 31 - ((U) & 31); const bf16_t* b_ = (const bf16_t*)(F.ws + WS_QMB) + (size_t)(bh_ >> 3) * SEQ * QW + (bh_ & 7) * 64; \
        kv_dma(F, b_ + 512 + (size_t)(i_ * 256) * QW, b_ + 1024 + (size_t)(i_ * 256) * QW, (BUF) * 65536); } while (0)
#define P6_QLOAD(U, Q, L0, L1, L2) do { const int bh_ = (U) >> 5, i_ = 31 - ((U) & 31), qp_ = i_ * 256 + w * 32 + r32, ns_ = i_ < 3 ? i_ : 3; \
        const bf16_t* b_ = (const bf16_t*)(F.ws + WS_QMB) + (size_t)(bh_ >> 3) * SEQ * QW + (bh_ & 7) * 64 + (size_t)qp_ * QW + hi * 8; \
        _Pragma("unroll") for (int d0 = 0; d0 < 4; ++d0) Q[d0] = *(const bf16x8*)(b_ + d0 * 16); \
        const float* pl_ = (const float*)(F.ws + WS_PLSE) + ((size_t)bh_ * SEQ + qp_) * 3; \
        L0 = -INFINITY; L1 = -INFINITY; L2 = -INFINITY; if (ns_ > 0) L0 = pl_[0]; if (ns_ > 1) L1 = pl_[1]; if (ns_ > 2) L2 = pl_[2]; } while (0)
    int buf = 0;
    bf16x8 qr[4] = {}; float ls0 = -INFINITY, ls1 = -INFINITY, ls2 = -INFINITY;
    if (F.bid < 32 * 32) { P6_QLOAD(F.bid, qr, ls0, ls1, ls2); P6_DMA(F.bid, 0); }
    asm volatile("s_waitcnt vmcnt(0)" : "+v"(qr[0]), "+v"(qr[1]), "+v"(qr[2]), "+v"(qr[3]), "+v"(ls0), "+v"(ls1), "+v"(ls2) :: "memory");
    for (int u = F.bid; u < 32 * 32; u += F.G) {
        const int bh = u >> 5, i = 31 - (u & 31), b = bh >> 3, h = bh & 7;
        const int ql = w * 32 + r32;
        const int nsel = i < 3 ? i : 3;
        const bool has_next = u + F.G < 32 * 32;
        LDS_WAIT();
        __builtin_amdgcn_s_barrier();
        if (has_next) P6_DMA(u + F.G, buf ^ 1);
        const LAS unsigned char* kimg = F.lds + buf * 65536; const LAS unsigned char* vimg = kimg + 32768;
        float m = -INFINITY, l = 0.f; f32x16 o[2]; o[0] = f32x16{}; o[1] = f32x16{};
        const LAS float* lut = (const LAS float*)(F.lds + MISC_OFF + MO_LUT) + h * 132;
        const int nst = (w >> 1) + 1;
#pragma unroll 1
        for (int st = 0; st < nst; ++st) {
            f32x16 t[2]; qkt64(t, kimg + st * 8192, qr, lane);
#pragma unroll
            for (int pp = 0; pp < 2; ++pp)
#pragma unroll
                for (int r = 0; r < 16; ++r) { const int d = ql - (st * 64 + 32 * pp + crow(r, hi)); const int dc = d < 128 ? (d > 0 ? d : 0) : 128; const float v = t[pp][r] * LOG2E + lut[dc]; t[pp][r] = d >= 0 ? v : -INFINITY; }
            softmax_step(t, m, l, o, wsf, vimg + st * 8192, lane);
        }
        l += __shfl_xor(l, 32);
        const float M = fmaxf(fmaxf(m, ls0), fmaxf(ls1, ls2));
        const float eo = __builtin_amdgcn_exp2f(m - M), e0 = __builtin_amdgcn_exp2f(ls0 - M), e1 = __builtin_amdgcn_exp2f(ls1 - M), e2 = __builtin_amdgcn_exp2f(ls2 - M);
        const float rden = 1.f / (l * eo + e0 + e1 + e2);
        if (hi == 0) *(LAS f32x4*)(wsf + 4 * r32) = (f32x4){eo * rden, e0 * rden, e1 * rden, e2 * rden};
        LDS_WAIT();
#pragma unroll
        for (int r = 0; r < 16; ++r) { const float fo = wsf[4 * crow(r, hi)]; o[0][r] *= fo; o[1][r] *= fo; }
        LDS_WAIT();
        __builtin_amdgcn_s_barrier();
        {
            const bf16_t* po = (const bf16_t*)(F.ws + WS_PO) + ((size_t)bh * SEQ + i * 256 + w * 32) * 3 * 64;
            u32x4 pv[4][3];
#pragma unroll
            for (int it4 = 0; it4 < 4; ++it4) { const int row = it4 * 8 + (lane >> 3), ch = lane & 7;
#pragma unroll
                for (int sl = 0; sl < 3; ++sl) { pv[it4][sl] = (u32x4){0u, 0u, 0u, 0u}; if (sl < nsel) pv[it4][sl] = *(const u32x4*)(po + (size_t)(row * 3 + sl) * 64 + ch * 8); } }
            bf16x8 qn[4] = {}; float ln0 = -INFINITY, ln1 = -INFINITY, ln2 = -INFINITY;
            if (has_next) P6_QLOAD(u + F.G, qn, ln0, ln1, ln2);
            LAS bf16_t* stg = (LAS bf16_t*)(F.lds + buf * 65536 + w * 4096);
#pragma unroll
            for (int r = 0; r < 16; ++r) { const int orow = crow(r, hi);
#pragma unroll
                for (int d0 = 0; d0 < 2; ++d0) stg[orow * 64 + d0 * 32 + r32] = (bf16_t)(cvtpk(o[d0][r], 0.f) & 0xffffu); }
            LDS_WAIT();
            asm volatile("s_waitcnt vmcnt(0)" : "+v"(qn[0]), "+v"(qn[1]), "+v"(qn[2]), "+v"(qn[3]), "+v"(ln0), "+v"(ln1), "+v"(ln2) :: "memory");
#pragma unroll
            for (int it4 = 0; it4 < 4; ++it4)
#pragma unroll
                for (int sl = 0; sl < 3; ++sl) asm volatile("" : "+v"(pv[it4][sl]));
            bf16_t* dst = (bf16_t*)(F.ws + WS_OB) + (size_t)(b * SEQ + i * 256 + w * 32) * 1024 + 512 + h * 64;
#pragma unroll
            for (int it4 = 0; it4 < 4; ++it4) { const int row = it4 * 8 + (lane >> 3), ch = lane & 7;
                const u32x4 ov = *(const LAS u32x4*)(stg + row * 64 + ch * 8);
                float a[8] = {bflo(ov.x), bfhi(ov.x), bflo(ov.y), bfhi(ov.y), bflo(ov.z), bfhi(ov.z), bflo(ov.w), bfhi(ov.w)};
                const f32x4 fc = *(const LAS f32x4*)(wsf + 4 * row);
#pragma unroll
                for (int sl = 0; sl < 3; ++sl) if (sl < nsel) { const u32x4 pvv = pv[it4][sl]; const float f = fc[1 + sl];
                    a[0] += f * bflo(pvv.x); a[1] += f * bfhi(pvv.x); a[2] += f * bflo(pvv.y); a[3] += f * bfhi(pvv.y); a[4] += f * bflo(pvv.z); a[5] += f * bfhi(pvv.z); a[6] += f * bflo(pvv.w); a[7] += f * bfhi(pvv.w); }
                u32x4 w4; w4.x = cvtpk(a[0], a[1]); w4.y = cvtpk(a[2], a[3]); w4.z = cvtpk(a[4], a[5]); w4.w = cvtpk(a[6], a[7]);
                *(u32x4*)(dst + (size_t)row * 1024 + ch * 8) = w4; }
            LDS_WAIT();
#pragma unroll
            for (int d0 = 0; d0 < 4; ++d0) qr[d0] = qn[d0];
            ls0 = ln0; ls1 = ln1; ls2 = ln2;
        }
        buf ^= 1;
    }
#undef P6_DMA
#undef P6_QLOAD
    asm volatile("s_waitcnt vmcnt(0)" ::: "memory");
    __syncthreads();
}

struct BranchSched {
    const char* A; const char* Bt; int G, c; int R[2], C[2];
    __device__ __forceinline__ bool next(int i, gm::UnitD& u) {
        int pm, pn; if (!gm::static_tile(MT, 1024, G, c, i, pm, pn)) return false;
        u.a = A; u.b = Bt + (size_t)(pn * 256) * 1024 * 2;
#pragma unroll
        for (int h = 0; h < 2; ++h)
#pragma unroll
            for (int j = 0; j < 2; ++j) u.va[h][j] = (unsigned)((pm * 256 + h * 128 + R[j]) * 1024 + C[j]) * 2u;
        u.e0 = pm; u.e1 = pn; u.e2 = 0; u.e3 = 0; return true;
    }
};
struct EpiBranch {
    const bf16_t* g; bf16_t* merged;
    static __device__ __forceinline__ float ratio(float gs, float gm_) { return (1.f + fminf(__expf(-gm_), 1e30f)) * __builtin_amdgcn_rcpf(1.f + __expf(-gs)); }
    __device__ __forceinline__ void mid(f32x4 (&acc)[2][2][4][2], const gm::UnitD& u, int wr, int wc, int fr, int fq) const {
        const bf16_t* gp = g + (size_t)(u.e0 * 256 + wr * 64 + fr) * 2048 + u.e1 * 256 + wc * 32 + 8 * fq;
#pragma unroll
        for (int ai = 0; ai < 2; ++ai)
#pragma unroll
            for (int m = 0; m < 4; m += 2) {
                asm volatile("" : "+v"(gp) :: "memory");
                u32x4 gs[2][2], gq[2][2];
#pragma unroll
                for (int mm = 0; mm < 2; ++mm)
#pragma unroll
                    for (int bj = 0; bj < 2; ++bj) { gs[mm][bj] = *(const u32x4*)(gp + (size_t)mm * 16 * 2048 + bj * 128); gq[mm][bj] = *(const u32x4*)(gp + (size_t)mm * 16 * 2048 + 1024 + bj * 128); }
#pragma unroll
                for (int mm = 0; mm < 2; ++mm)
#pragma unroll
                    for (int bj = 0; bj < 2; ++bj) { const u32x4 a = gs[mm][bj], b = gq[mm][bj];
                        f32x4& c0 = acc[ai][bj][m + mm][0]; f32x4& c1 = acc[ai][bj][m + mm][1];
                        c0[0] *= ratio(bflo(a.x), bflo(b.x)); c0[1] *= ratio(bfhi(a.x), bfhi(b.x)); c0[2] *= ratio(bflo(a.y), bflo(b.y)); c0[3] *= ratio(bfhi(a.y), bfhi(b.y));
                        c1[0] *= ratio(bflo(a.z), bflo(b.z)); c1[1] *= ratio(bfhi(a.z), bfhi(b.z)); c1[2] *= ratio(bflo(a.w), bflo(b.w)); c1[3] *= ratio(bfhi(a.w), bfhi(b.w));
                        asm volatile("" : "+v"(c0), "+v"(c1) :: "memory"); }
                gp += (m == 2 ? 96 : 32) * 2048; }
    }
    __device__ __forceinline__ void operator()(const f32x4 (&acc)[2][2][4][2], const gm::UnitD& u, int wr, int wc, int fr, int fq) const {
        const int row0 = u.e0 * 256 + wr * 64 + fr, col0 = u.e1 * 256 + wc * 32 + 8 * fq;
#pragma unroll
        for (int ai = 0; ai < 2; ++ai)
#pragma unroll
            for (int m = 0; m < 4; ++m) { const size_t row = (size_t)(row0 + ai * 128 + m * 16);
#pragma unroll
                for (int bj = 0; bj < 2; ++bj) { const u32x4 gm_ = *(const u32x4*)(g + row * 2048 + 1024 + col0 + bj * 128);
                    const float b[8] = {bflo(gm_.x), bfhi(gm_.x), bflo(gm_.y), bfhi(gm_.y), bflo(gm_.z), bfhi(gm_.z), bflo(gm_.w), bfhi(gm_.w)};
                    float r[8];
#pragma unroll
                    for (int j = 0; j < 8; ++j) r[j] = acc[ai][bj][m][j >> 2][j & 3] * __builtin_amdgcn_rcpf(1.f + fminf(__expf(-b[j]), 1e30f));
                    u32x4 w; w.x = cvtpk(r[0], r[1]); w.y = cvtpk(r[2], r[3]); w.z = cvtpk(r[4], r[5]); w.w = cvtpk(r[6], r[7]);
                    *(u32x4*)(merged + row * 1024 + col0 + bj * 128) = w; } }
    }
};
__device__ __forceinline__ void phase7(Ctx& F) {
    BranchSched S; S.A = (const char*)(F.ws + WS_OB); S.Bt = (const char*)(F.ws + WS_WBRT); S.G = F.G; S.c = F.bid; gm::stage_geom(F.tid, S.R, S.C);
    EpiBranch E{(const bf16_t*)(F.ws + WS_G), (bf16_t*)(F.ws + WS_MERGED)};
    gm::gemm_phase<true, true>(F.lds, 1024, S, E);
}
struct OutSched {
    const char* A; const char* Bt; int G, c; int R[2], C[2];
    __device__ __forceinline__ bool next(int i, gm::UnitD& u) {
        int pm, pn; if (!gm::static_tile(MT, 1024, G, c, i, pm, pn)) return false;
        u.a = A; u.b = Bt + (size_t)pn * 256 * 1024 * 2;
#pragma unroll
        for (int h = 0; h < 2; ++h)
#pragma unroll
            for (int j = 0; j < 2; ++j) u.va[h][j] = (unsigned)((pm * 256 + h * 128 + R[j]) * 1024 + C[j]) * 2u;
        u.e0 = pm; u.e1 = pn; u.e2 = 0; u.e3 = 0; return true;
    }
};
struct EpiOut {
    const float* x; const float* mod; float* out;
    __device__ __forceinline__ void operator()(const f32x4 (&acc)[2][2][4][2], const gm::UnitD& u, int wr, int wc, int fr, int fq) const {
        const int pm = u.e0, pn = u.e1, b = (pm * 256) / SEQ;
        const int row0 = pm * 256 + wr * 64 + fr, col0 = pn * 256 + wc * 32 + 4 * fq;
        f32x4 gt[2][2];
#pragma unroll
        for (int bj = 0; bj < 2; ++bj)
#pragma unroll
            for (int n = 0; n < 2; ++n) gt[bj][n] = *(const f32x4*)(mod + b * NMOD + 2 * DM + col0 + bj * 128 + n * 16);
#pragma unroll
        for (int ai = 0; ai < 2; ++ai)
#pragma unroll
            for (int m = 0; m < 4; ++m) { const size_t off = (size_t)(row0 + ai * 128 + m * 16) * DM + col0;
#pragma unroll
                for (int bj = 0; bj < 2; ++bj)
#pragma unroll
                    for (int n = 0; n < 2; ++n) { const f32x4 xv = *(const f32x4*)(x + off + bj * 128 + n * 16); *(f32x4*)(out + off + bj * 128 + n * 16) = xv + gt[bj][n] * acc[ai][bj][m][n]; } }
    }
};
__device__ __forceinline__ void phase8(Ctx& F) {
    OutSched S; S.A = (const char*)(F.ws + WS_MERGED); S.Bt = (const char*)(F.ws + WS_WOUTT); S.G = F.G; S.c = F.bid; gm::stage_geom(F.tid, S.R, S.C);
    EpiOut E{inp(F, I_X), (const float*)(F.ws + WS_SMALL + SM_MOD), F.out};
    gm::gemm_phase<false>(F.lds, 1024, S, E);
}

constexpr int NR_SSQ = MO_PRE + 1024;
constexpr int NR_RS = MO_PRE + 3072;
__device__ __forceinline__ void phase_n2r(Ctx& F, int rr) {
    const float* x1 = F.out; const float* gvec = (const float*)(F.ws + WS_SMALL + SM_GVEC); const float* cb = (const float*)(F.ws + WS_SMALL + SM_CB);
    const float* mod = (const float*)(F.ws + WS_SMALL + SM_MOD); const float* rbias = inp(F, I_RB);
    unsigned char* H2 = (unsigned char*)(F.ws + WS_H2) + (size_t)rr * RT * DM; int* tokl = (int*)(F.ws + WS_TOKL) + (size_t)rr * 64 * RT; float* wl = (float*)(F.ws + WS_WL) + (size_t)rr * 64 * RT; int* tpos = (int*)(F.ws + WS_TPOS) + (size_t)rr * RT * 8;
    unsigned* cur = (unsigned*)(F.ws + WS_CTL) + CW_MOECUR + rr * 64;
    LAS int* lcnt = (LAS int*)(F.lds + MISC_OFF + MO_PRE); LAS int* lbase = lcnt + 64;
    LAS float* part = (LAS float*)(F.lds);
    LAS float* ssqp = (LAS float*)(F.lds + MISC_OFF + NR_SSQ); LAS float* rsl = (LAS float*)(F.lds + MISC_OFF + NR_RS);
    const int lane = F.lane, w = F.wave, i16 = lane & 15, kk = lane >> 4;
    for (int u = F.bid; u < RT / 64; u += F.G) {
        if (F.tid < 64) lcnt[F.tid] = 0;
        const int tokb = rr * RT + u * 64, b = tokb / SEQ;
        {
            bf16x8 fah[4][4], fal[4][4];
            {
                const float* gp = gvec + b * DM + 128 * w + 8 * kk;
                f32x4 gv[4][2];
#pragma unroll
                for (int s4 = 0; s4 < 4; ++s4) { gv[s4][0] = *(const f32x4*)(gp + 32 * s4); gv[s4][1] = *(const f32x4*)(gp + 32 * s4 + 4); }
#pragma unroll
                for (int tt = 0; tt < 4; ++tt) {
                    const float* xp = x1 + (size_t)(tokb + tt * 16 + i16) * DM + 128 * w + 8 * kk;
                    f32x4 xa[4][2];
#pragma unroll
                    for (int s4 = 0; s4 < 4; ++s4) { xa[s4][0] = *(const f32x4*)(xp + 32 * s4); xa[s4][1] = *(const f32x4*)(xp + 32 * s4 + 4); }
                    float ssq = 0.f;
#pragma unroll
                    for (int s4 = 0; s4 < 4; ++s4) {
                        u32x4 ah, al;
#pragma unroll
                        for (int q = 0; q < 2; ++q) { const f32x4 xv = xa[s4][q]; ssq += (xv.x * xv.x + xv.y * xv.y) + (xv.z * xv.z + xv.w * xv.w);
                            const f32x4 a = xv * gv[s4][q];
                            const unsigned h0 = cvtpk(a.x, a.y), h1 = cvtpk(a.z, a.w);
                            ah[2 * q] = h0; ah[2 * q + 1] = h1; al[2 * q] = cvtpk(a.x - bflo(h0), a.y - bfhi(h0)); al[2 * q + 1] = cvtpk(a.z - bflo(h1), a.w - bfhi(h1)); }
                        fah[tt][s4] = __builtin_bit_cast(bf16x8, ah); fal[tt][s4] = __builtin_bit_cast(bf16x8, al);
                    }
                    ssq += __shfl_xor(ssq, 16); ssq += __shfl_xor(ssq, 32); if (kk == 0) ssqp[w * 64 + tt * 16 + i16] = ssq;
                }
            }
#pragma unroll 1
            for (int eh = 0; eh < 2; ++eh) {
                bf16x8 wh[2][4], wl_[2][4];
                {
                    const bf16_t* ph = (const bf16_t*)(F.ws + WS_SMALL + SM_WRH) + (size_t)(eh * 32 + i16) * DM + 128 * w + 8 * kk;
                    const bf16_t* pl = (const bf16_t*)(F.ws + WS_SMALL + SM_WRL) + (size_t)(eh * 32 + i16) * DM + 128 * w + 8 * kk;
#pragma unroll
                    for (int c = 0; c < 2; ++c)
#pragma unroll
                        for (int s4 = 0; s4 < 4; ++s4) { wh[c][s4] = *(const bf16x8*)(ph + (size_t)c * 16 * DM + 32 * s4); wl_[c][s4] = *(const bf16x8*)(pl + (size_t)c * 16 * DM + 32 * s4); }
                }
#pragma unroll
                for (int tt = 0; tt < 4; ++tt) {
                    f32x4 acc[2]; acc[0] = acc[1] = (f32x4){0.f, 0.f, 0.f, 0.f};
#pragma unroll
                    for (int s4 = 0; s4 < 4; ++s4)
#pragma unroll
                        for (int c = 0; c < 2; ++c) {
                            acc[c] = __builtin_amdgcn_mfma_f32_16x16x32_bf16(fal[tt][s4], wh[c][s4], acc[c], 0, 0, 0);
                            acc[c] = __builtin_amdgcn_mfma_f32_16x16x32_bf16(fah[tt][s4], wl_[c][s4], acc[c], 0, 0, 0);
                            acc[c] = __builtin_amdgcn_mfma_f32_16x16x32_bf16(fah[tt][s4], wh[c][s4], acc[c], 0, 0, 0); }
#pragma unroll
                    for (int c = 0; c < 2; ++c)
#pragma unroll
                        for (int reg = 0; reg < 4; ++reg) part[(w * 64 + tt * 16 + 4 * kk + reg) * 64 + eh * 32 + 16 * c + i16] = acc[c][reg];
                }
            }
        }
        __syncthreads();
        const int tl = F.tid >> 3, g = F.tid & 7;
        int my_e; float my_w; int my_rank;
        {
            float ssq = 0.f;
#pragma unroll
            for (int q = 0; q < 8; ++q) ssq += ssqp[q * 64 + tl];
            const float rstd = rsqrtf(ssq * (1.f / DM) + EPS);
            if (g == 0) rsl[tl] = rstd;
            float s8[8], c8[8];
            {
                f32x4 lo4 = (f32x4){0.f, 0.f, 0.f, 0.f}, hi4 = lo4;
#pragma unroll
                for (int q = 0; q < 8; ++q) { const LAS f32x4* pp = (const LAS f32x4*)(part + (q * 64 + tl) * 64 + 8 * g); lo4 += pp[0]; hi4 += pp[1]; }
                const f32x4 cb0 = *(const f32x4*)(cb + b * 64 + 8 * g), cb1 = *(const f32x4*)(cb + b * 64 + 8 * g + 4), rb0 = *(const f32x4*)(rbias + 8 * g), rb1 = *(const f32x4*)(rbias + 8 * g + 4);
#pragma unroll
                for (int j = 0; j < 4; ++j) { s8[j] = sigmoidf_(lo4[j] * rstd + cb0[j]); s8[4 + j] = sigmoidf_(hi4[j] * rstd + cb1[j]); c8[j] = s8[j] + rb0[j]; c8[4 + j] = s8[4 + j] + rb1[j]; }
            }
            float m1 = -INFINITY, m2 = -INFINITY;
#pragma unroll
            for (int j = 0; j < 8; ++j) { const float v = c8[j]; if (v > m1) { m2 = m1; m1 = v; } else if (v > m2) m2 = v; }
            const float gs = m1 + m2;
            int rank = 0;
#pragma unroll
            for (int g2 = 0; g2 < 8; ++g2) { const float o = __shfl(gs, g2, 8); rank += (o > gs || (o == gs && g2 < g)) ? 1 : 0; }
            if (rank >= 4) {
#pragma unroll
                for (int j = 0; j < 8; ++j) c8[j] = -INFINITY;
            }
            int sel_e[8]; float sk[8]; float wsum = 0.f;
#pragma unroll
            for (int k = 0; k < 8; ++k) {
                float bv = -INFINITY, bs = 0.f; int be = 8 * g;
#pragma unroll
                for (int j = 0; j < 8; ++j) if (c8[j] > bv) { bv = c8[j]; be = 8 * g + j; bs = s8[j]; }
#pragma unroll
                for (int o = 1; o < 8; o <<= 1) { const float ov = __shfl_xor(bv, o, 8), os = __shfl_xor(bs, o, 8); const int oe = __shfl_xor(be, o, 8); if (ov > bv || (ov == bv && oe < be)) { bv = ov; be = oe; bs = os; } }
                sel_e[k] = be; sk[k] = bs; wsum += bs;
#pragma unroll
                for (int j = 0; j < 8; ++j) if (be == 8 * g + j) c8[j] = -INFINITY;
            }
            my_e = sel_e[0]; my_w = sk[0];
#pragma unroll
            for (int k = 1; k < 8; ++k) if (g == k) { my_e = sel_e[k]; my_w = sk[k]; }
            my_w *= 2.5f / wsum;
            my_rank = lds_add(&lcnt[my_e], 1);
        }
        __syncthreads();
        if (F.tid < 64) { const int n = lcnt[F.tid]; lbase[F.tid] = n > 0 ? (int)atomicAdd(&cur[F.tid], (unsigned)n) : 0; }
        __syncthreads();
        { const int tok = tokb + tl, pos = lbase[my_e] + my_rank; tokl[my_e * RT + pos] = tok * 8 + g; wl[my_e * RT + pos] = my_w; tpos[(tok - rr * RT) * 8 + g] = (my_e << 16) | pos; }
#pragma unroll 1
        for (int r0 = 0; r0 < 8; r0 += 4) {
            f32x4 xv[4][4];
#pragma unroll
            for (int r = 0; r < 4; ++r) { const f32x4* xr = (const f32x4*)(x1 + (size_t)(tokb + w * 8 + r0 + r) * DM) + lane;
#pragma unroll
                for (int j = 0; j < 4; ++j) xv[r][j] = xr[64 * j]; }
#pragma unroll
            for (int j = 0; j < 4; ++j) { const int col = 4 * lane + 256 * j; const f32x4 gq = *(const f32x4*)(gvec + b * DM + col), sh = *(const f32x4*)(mod + b * NMOD + 3 * DM + col);
#pragma unroll
                for (int r = 0; r < 4; ++r) { const int tl2 = w * 8 + r0 + r; const f32x4 hv = (xv[r][j] * rsl[tl2]) * gq + sh;
                    int o = 0; o = __builtin_amdgcn_cvt_pk_fp8_f32(f8c(hv.x * 16.f), f8c(hv.y * 16.f), o, false); o = __builtin_amdgcn_cvt_pk_fp8_f32(f8c(hv.z * 16.f), f8c(hv.w * 16.f), o, true);
                    ((unsigned*)(H2 + (size_t)(tokb - rr * RT + tl2) * DM) + lane)[64 * j] = (unsigned)o; } }
        }
        __syncthreads();
    }
}
constexpr int MO_TE = 4224;
struct MoeTabs { const LAS unsigned short* te; const LAS int* tb; const LAS int* cnt; int TR; };
__device__ __forceinline__ MoeTabs build_moe_tabs(Ctx& F, int rr) {
    LAS unsigned short* te = (LAS unsigned short*)(F.lds + MISC_OFF + MO_TE); LAS int* tb = (LAS int*)(F.lds + MISC_OFF + MO_TE + 1536); LAS int* cnt = tb + 72;
    const unsigned* cur = (const unsigned*)(F.ws + WS_CTL) + CW_MOECUR + rr * 64;
    __syncthreads();
    if (F.tid == 0) { int acc = 0; for (int e = 0; e < 64; ++e) { const int c = (int)cur[e]; cnt[e] = c; tb[e] = acc; acc += (c + 255) >> 8; } tb[64] = acc; tb[65] = acc + RT / 256; cnt[64] = RT; }
    __syncthreads();
    const int TR = tb[64];
    for (int e = F.tid >> 3; e < 65; e += 64) for (int t = tb[e] + (F.tid & 7); t < tb[e + 1]; t += 8) te[t] = (unsigned short)e;
    __syncthreads();
    MoeTabs T; T.te = te; T.tb = tb; T.cnt = cnt; T.TR = TR; return T;
}
struct Moe1Sched {
    const char* H2; const char* W1T; const int* tokl; MoeTabs T; int G, c, rr; int R[2], C[2];
    __device__ __forceinline__ bool next(int i, gm::UnitD& u) {
        const int uu = i * G + c; const int nt = T.TR + RT / 256;
        if (uu >= nt * 2) return false;
        const int tile = uu >> 1, pn = uu & 1, e = T.te[tile], rt = tile - T.tb[e], cnt = T.cnt[e];
        u.a = H2; u.b = W1T + (size_t)(e * 512 + pn * 256) * 1024;
#pragma unroll
        for (int h = 0; h < 2; ++h)
#pragma unroll
            for (int j = 0; j < 2; ++j) { const int idx = rt * 256 + h * 128 + R[j]; int trow;
                if (e < 64) { const int ent = tokl[e * RT + (idx < cnt ? idx : rt * 256)]; trow = (ent >> 3) - rr * RT; } else trow = idx;
                u.va[h][j] = (unsigned)(trow * 512 + C[j]) * 2u; }
        u.e0 = tile; u.e1 = pn; u.e2 = e; u.e3 = rt; return true;
    }
};
struct EpiMoe1 {
    bf16_t* act; const float* wl; const LAS int* cnt;
    __device__ __forceinline__ void operator()(const f32x4 (&acc)[2][2][4][2], const gm::UnitD& u, int wr, int wc, int fr, int fq) const {
        const int row0 = u.e0 * 256 + wr * 64 + fr, col0 = u.e1 * 128 + wc * 32 + 8 * fq, e = u.e2, n = cnt[e];
        float rw[2][4];
#pragma unroll
        for (int ai = 0; ai < 2; ++ai)
#pragma unroll
            for (int m = 0; m < 4; ++m) { const int idx = u.e3 * 256 + ai * 128 + wr * 64 + m * 16 + fr; rw[ai][m] = e < 64 ? (idx < n ? wl[e * RT + idx] : 0.f) : 1.f; }
#pragma unroll
        for (int ai = 0; ai < 2; ++ai)
#pragma unroll
            for (int m = 0; m < 4; ++m) { const float ww = rw[ai][m] * (32.f / 4096.f); const f32x4 g0 = acc[ai][0][m][0] * (1.f / 4096.f), g1 = acc[ai][0][m][1] * (1.f / 4096.f), u0 = acc[ai][1][m][0] * ww, u1 = acc[ai][1][m][1] * ww;
                int w0 = 0, w1 = 0;
                w0 = __builtin_amdgcn_cvt_pk_fp8_f32(f8c(siluf_(g0[0]) * u0[0]), f8c(siluf_(g0[1]) * u0[1]), w0, false); w0 = __builtin_amdgcn_cvt_pk_fp8_f32(f8c(siluf_(g0[2]) * u0[2]), f8c(siluf_(g0[3]) * u0[3]), w0, true);
                w1 = __builtin_amdgcn_cvt_pk_fp8_f32(f8c(siluf_(g1[0]) * u1[0]), f8c(siluf_(g1[1]) * u1[1]), w1, false); w1 = __builtin_amdgcn_cvt_pk_fp8_f32(f8c(siluf_(g1[2]) * u1[2]), f8c(siluf_(g1[3]) * u1[3]), w1, true);
                *(u32x2*)((unsigned char*)act + (size_t)(row0 + ai * 128 + m * 16) * 256 + col0) = (u32x2){(unsigned)w0, (unsigned)w1}; }
    }
};
__device__ __forceinline__ void phase_moe1(Ctx& F, int rr) {
    Moe1Sched S; S.T = build_moe_tabs(F, rr); S.H2 = (const char*)(F.ws + WS_H2) + (size_t)rr * RT * DM; S.W1T = (const char*)(F.ws + WS_W1T); S.tokl = (const int*)(F.ws + WS_TOKL) + (size_t)rr * 64 * RT; S.G = F.G; S.c = (F.G % 8 == 0) ? (F.bid % 8) * (F.G / 8) + F.bid / 8 : F.bid; S.rr = rr; gm::stage_geom(F.tid, S.R, S.C);
    EpiMoe1 E{(bf16_t*)(F.ws + WS_ACT), (const float*)(F.ws + WS_WL) + (size_t)rr * 64 * RT, S.T.cnt};
    gm::gemm_phase<true, false, true>(F.lds, 512, S, E);
}
struct Moe2Sched {
    const char* ACT; const char* W2T; MoeTabs T; int G, c; int R[2], C[2];
    __device__ __forceinline__ bool next(int i, gm::UnitD& u) {
        const int uu = i * G + c; const int nt = T.TR + RT / 256;
        if (uu >= nt * 4) return false;
        const int tile = uu >> 2, pn = uu & 3, e = T.te[tile], rt = tile - T.tb[e];
        u.a = ACT + (size_t)tile * 256 * 256; u.b = W2T + (size_t)(e * 1024 + pn * 256) * 256;
#pragma unroll
        for (int h = 0; h < 2; ++h)
#pragma unroll
            for (int j = 0; j < 2; ++j) u.va[h][j] = (unsigned)((h * 128 + R[j]) * 128 + C[j]) * 2u;
        u.e0 = pn; u.e1 = e; u.e2 = rt; u.e3 = tile; return true;
    }
};
struct EpiMoe2 {
    bf16_t* slots; bf16_t* shout; const LAS int* cnt;
    __device__ __forceinline__ void operator()(const f32x4 (&acc)[2][2][4][2], const gm::UnitD& u, int wr, int wc, int fr, int fq) const {
        const int pn = u.e0, e = u.e1, rt = u.e2, tile = u.e3;
        const int col0 = pn * 256 + wc * 32 + 8 * fq, n = cnt[e];
        if (e < 64) {
            unsigned char* base = (unsigned char*)slots + (size_t)(tile * 256 + wr * 64 + fr) * 1024 + col0;
#pragma unroll
            for (int ai = 0; ai < 2; ++ai)
#pragma unroll
                for (int m = 0; m < 4; ++m) {
                    if (rt * 256 + ai * 128 + wr * 64 + m * 16 + fr < n) {
#pragma unroll
                        for (int bj = 0; bj < 2; ++bj) { f32x4 v0 = acc[ai][bj][m][0] * (16.f / 4096.f), v1 = acc[ai][bj][m][1] * (16.f / 4096.f);
#pragma unroll
                            for (int j = 0; j < 4; ++j) { v0[j] = __builtin_amdgcn_fmed3f(v0[j], -440.f, 440.f); v1[j] = __builtin_amdgcn_fmed3f(v1[j], -440.f, 440.f); }
                            int w0 = 0, w1 = 0;
                            w0 = __builtin_amdgcn_cvt_pk_fp8_f32(v0[0], v0[1], w0, false); w0 = __builtin_amdgcn_cvt_pk_fp8_f32(v0[2], v0[3], w0, true);
                            w1 = __builtin_amdgcn_cvt_pk_fp8_f32(v1[0], v1[1], w1, false); w1 = __builtin_amdgcn_cvt_pk_fp8_f32(v1[2], v1[3], w1, true);
                            *(u32x2*)(base + (size_t)(ai * 128 + m * 16) * 1024 + bj * 128) = (u32x2){(unsigned)w0, (unsigned)w1}; } } }
        } else {
            bf16_t* base = shout + (size_t)(rt * 256 + wr * 64 + fr) * 1024 + col0;
#pragma unroll
            for (int ai = 0; ai < 2; ++ai)
#pragma unroll
                for (int m = 0; m < 4; ++m)
#pragma unroll
                    for (int bj = 0; bj < 2; ++bj) { const f32x4 v0 = acc[ai][bj][m][0] * (1.f / 4096.f), v1 = acc[ai][bj][m][1] * (1.f / 4096.f);
                        u32x4 o; o.x = cvtpk(v0[0], v0[1]); o.y = cvtpk(v0[2], v0[3]); o.z = cvtpk(v1[0], v1[1]); o.w = cvtpk(v1[2], v1[3]); *(u32x4*)(base + (size_t)(ai * 128 + m * 16) * 1024 + bj * 128) = o; }
        }
    }
};
__device__ __forceinline__ void phase_moe2(Ctx& F, int rr) {
    Moe2Sched S; S.T = build_moe_tabs(F, rr); S.ACT = (const char*)(F.ws + WS_ACT); S.W2T = (const char*)(F.ws + WS_W2T); S.G = F.G; S.c = (F.G % 8 == 0) ? (F.bid % 8) * (F.G / 8) + F.bid / 8 : F.bid; gm::stage_geom(F.tid, S.R, S.C);
    EpiMoe2 E{(bf16_t*)(F.ws + WS_SLOTS), (bf16_t*)(F.ws + WS_SHOUT), S.T.cnt};
    gm::gemm_phase<true, false, true>(F.lds, 128, S, E);
}
__device__ __forceinline__ void phase_final(Ctx& F, int rr) {
    const MoeTabs T = build_moe_tabs(F, rr);
    const float* mod = (const float*)(F.ws + WS_SMALL + SM_MOD); const float* fg = inp(F, I_FG);
    const unsigned char* slots = (const unsigned char*)(F.ws + WS_SLOTS); const int* tpos = (const int*)(F.ws + WS_TPOS) + (size_t)rr * RT * 8;
    const int gw = F.bid * 8 + F.wave, NGW = F.G * 8, c0 = F.lane * 8;
    for (int t = gw; t < RT; t += NGW) {
        const int tok = rr * RT + t, b = tok / SEQ;
        const unsigned char* rp[8];
#pragma unroll
        for (int k = 0; k < 8; ++k) { const int v = tpos[t * 8 + k]; rp[k] = slots + (size_t)(T.tb[v >> 16] * 256 + (v & 0xffff)) * 1024 + c0; }
        float* orow = F.out + (size_t)tok * DM + c0;
        u32x2 sv[8][2]; u32x4 sh[2]; f32x4 xv[2][2];
#pragma unroll
        for (int k = 0; k < 8; ++k) { sv[k][0] = *(const u32x2*)(rp[k]); sv[k][1] = *(const u32x2*)(rp[k] + 512); }
        { const bf16_t* sp = (const bf16_t*)(F.ws + WS_SHOUT) + (size_t)t * 1024 + c0; sh[0] = *(const u32x4*)sp; sh[1] = *(const u32x4*)(sp + 512); }
#pragma unroll
        for (int h = 0; h < 2; ++h) { xv[h][0] = *(const f32x4*)(orow + h * 512); xv[h][1] = *(const f32x4*)(orow + h * 512 + 4); }
        float s = 0.f; f32x4 v[2][2];
#pragma unroll
        for (int h = 0; h < 2; ++h) {
            f32x4 a0 = (f32x4){0.f, 0.f, 0.f, 0.f}, a1 = a0;
#pragma unroll
            for (int k = 0; k < 8; ++k) { const u32x2 w = sv[k][h];
                const f32x2 p0 = __builtin_amdgcn_cvt_pk_f32_fp8((int)w.x, false), p1 = __builtin_amdgcn_cvt_pk_f32_fp8((int)w.x, true), p2 = __builtin_amdgcn_cvt_pk_f32_fp8((int)w.y, false), p3 = __builtin_amdgcn_cvt_pk_f32_fp8((int)w.y, true);
                a0 += (f32x4){p0.x, p0.y, p1.x, p1.y}; a1 += (f32x4){p2.x, p2.y, p3.x, p3.y}; }
            { const u32x4 w = sh[h]; a0 = a0 * 0.0625f + (f32x4){bflo(w.x), bfhi(w.x), bflo(w.y), bfhi(w.y)}; a1 = a1 * 0.0625f + (f32x4){bflo(w.z), bfhi(w.z), bflo(w.w), bfhi(w.w)}; }
            const float* g2 = mod + b * NMOD + 5 * DM + c0 + h * 512;
            v[h][0] = xv[h][0] + *(const f32x4*)g2 * a0; v[h][1] = xv[h][1] + *(const f32x4*)(g2 + 4) * a1;
#pragma unroll
            for (int q = 0; q < 2; ++q) s += (v[h][q].x * v[h][q].x + v[h][q].y * v[h][q].y) + (v[h][q].z * v[h][q].z + v[h][q].w * v[h][q].w);
        }
        const float rstd = rsqrtf(wave_sum(s) * (1.f / DM) + EPS);
#pragma unroll
        for (int h = 0; h < 2; ++h)
#pragma unroll
            for (int q = 0; q < 2; ++q) { const f32x4 g = *(const f32x4*)(fg + c0 + h * 512 + 4 * q); *(f32x4*)(orow + h * 512 + 4 * q) = (v[h][q] * rstd) * g; }
    }
}

constexpr int N_PHASES = 10;
__global__ void __launch_bounds__(512, 2) mega_fwd(Args args) {
    extern __shared__ __attribute__((aligned(16))) unsigned char lds_raw[];
    Ctx F; F.lds = (LAS unsigned char*)lds_raw; F.ws = args.ws; F.out = args.out;
    {
        typedef __attribute__((address_space(4))) const unsigned long long* karg_t;
        const karg_t ka = (karg_t)__builtin_amdgcn_kernarg_segment_ptr();
        LAS unsigned long long* tab = (LAS unsigned long long*)(lds_raw + MISC_OFF + 14336);
        if (threadIdx.x < 20) tab[threadIdx.x] = ka[threadIdx.x];
        F.intab = tab;
    }
    F.tid = threadIdx.x; F.lane = F.tid & 63; F.wave = __builtin_amdgcn_readfirstlane(F.tid >> 6); F.G = gridDim.x; F.bid = blockIdx.x;
    volatile LAS unsigned* st = (volatile LAS unsigned*)(F.lds + MISC_OFF + MO_ST);
    if (F.tid < 4) st[F.tid] = 0u;
    __syncthreads();
    XcdBarrier bar = xcd_barrier_post((unsigned*)(F.ws + WS_CTL) + CW_BAR, st);
    if (threadIdx.x == 0) { unsigned nloc, nx; xcd_barrier_complete(bar.bar, bar.x, nloc, nx); st[0] = nloc; st[1] = nx; }
    int lo = args.ph_lo, hi = args.ph_hi;
    { int a = lo, b = hi; asm volatile("" : "+v"(a), "+v"(b)); lo = __builtin_amdgcn_readfirstlane(a); hi = __builtin_amdgcn_readfirstlane(b); }
    launder(F);
#ifndef PH_MASK
#define PH_MASK 0x1ffff
#endif
#define PH_ON(k) ((PH_MASK >> (k)) & 1)
#define IN(k) (lo <= (k) && (k) < hi)
#define SEAM(k) do { if (IN(k) && IN((k) + 1)) { bar.bar = launder_ptr(bar.bar); xcd_barrier(bar); } } while (0)
#define RUN(k, call) do { if (PH_ON(k) && IN(k)) { launder(F); call; } } while (0)
    RUN(0, phase0(F)); SEAM(0);
    RUN(1, phase1(F)); SEAM(1);
    RUN(2, phase2(F)); SEAM(2);
    RUN(4, (phase4(F), sb_units(F))); SEAM(4);
    RUN(5, phase5(F)); SEAM(5);
    RUN(6, phase6(F)); SEAM(6);
    RUN(7, phase7(F)); SEAM(7);
    RUN(8, phase8(F)); SEAM(8);
    if (PH_ON(9) && IN(9)) {
        const int par = (F.bid >> 3) & 1;
#pragma unroll 1
        for (int i = 0; i < 8; ++i) {
            launder(F);
            int op, rr; bool bar_after = true;
            switch (i) {
                case 0: op = 0; rr = 0; break;
                case 1: op = 1; rr = 0; break;
                case 2: op = par ? 0 : 2; rr = par ? 1 : 0; bar_after = false; break;
                case 3: op = par ? 2 : 0; rr = par ? 0 : 1; break;
                case 4: op = par ? 1 : 3; rr = par ? 1 : 0; bar_after = false; break;
                case 5: op = par ? 3 : 1; rr = par ? 0 : 1; break;
                case 6: op = 2; rr = 1; break;
                default: op = 3; rr = 1; bar_after = false; break;
            }
            switch (op) {
                case 0: phase_n2r(F, rr); break;
                case 1: phase_moe1(F, rr); break;
                case 2: phase_moe2(F, rr); break;
                default: phase_final(F, rr); break;
            }
            if (bar_after) { bar.bar = launder_ptr(bar.bar); xcd_barrier(bar); } else __syncthreads();
        }
    }
#undef IN
#undef SEAM
#undef RUN
}

#ifndef MK_SPLIT
#define MK_SPLIT 0
#endif
extern "C" void kernel_launch(void* const* d_in, const int* in_sizes, int n_in, void* d_out, int out_size, void* d_ws, size_t ws_size, hipStream_t stream) {
    static int grid = 0;
    if (grid == 0) {
        if (n_in != 20 || in_sizes[0] != MT * DM || out_size != MT * DM || ws_size < WS_END) { fprintf(stderr, "kernel_launch: unexpected shapes (n_in %d, in0 %d, out %d, ws %zu)\n", n_in, n_in > 0 ? in_sizes[0] : -1, out_size, ws_size); grid = -1; return; }
        int dev = 0, cus = 0;
        if (hipGetDevice(&dev) != hipSuccess || hipDeviceGetAttribute(&cus, hipDeviceAttributeMultiprocessorCount, dev) != hipSuccess) { grid = -1; return; }
        if (hipFuncSetAttribute((const void*)mega_fwd, hipFuncAttributeMaxDynamicSharedMemorySize, LDS_BYTES) != hipSuccess) { fprintf(stderr, "kernel_launch: hipFuncSetAttribute failed\n"); grid = -1; return; }
        int per_cu = 0;
        if (hipOccupancyMaxActiveBlocksPerMultiprocessor(&per_cu, (const void*)mega_fwd, 512, LDS_BYTES) != hipSuccess || per_cu < 1) fprintf(stderr, "kernel_launch: occupancy query reports %d\n", per_cu);
        (void)hipGetLastError();
        grid = cus;
    }
    if (grid < 0) return;
    (void)hipMemsetAsync((char*)d_ws + WS_CTL, 0, CTL_BYTES, stream);
    Args a{};
    for (int i = 0; i < 20; ++i) a.in[i] = (const float*)d_in[i];
    a.out = (float*)d_out; a.ws = (unsigned char*)d_ws;
#if MK_SPLIT
    for (int p = 0; p < N_PHASES; ++p) { a.ph_lo = p; a.ph_hi = p + 1; hipLaunchKernelGGL(mega_fwd, dim3(grid), dim3(512), LDS_BYTES, stream, a); }
#else
    a.ph_lo = 0; a.ph_hi = N_PHASES;
    hipLaunchKernelGGL(mega_fwd, dim3(grid), dim3(512), LDS_BYTES, stream, a);
#endif
}
```

```cpp
#include <hip/hip_runtime.h>
#include <cstdio>
#include <cstdint>

#define LAS __attribute__((address_space(3)))
#define GAS __attribute__((address_space(1)))
typedef unsigned short bf16_t;
typedef short bf16x8 __attribute__((ext_vector_type(8)));
typedef short s16x4 __attribute__((ext_vector_type(4)));
typedef float f32x4 __attribute__((ext_vector_type(4)));
typedef float f32x16 __attribute__((ext_vector_type(16)));
typedef float f32x2 __attribute__((ext_vector_type(2)));
typedef unsigned u32x4 __attribute__((ext_vector_type(4)));
typedef unsigned u32x2 __attribute__((ext_vector_type(2)));
typedef __bf16 bf16x2_t __attribute__((ext_vector_type(2)));

__device__ __forceinline__ unsigned cvtpk(float lo, float hi) { f32x2 v = {lo, hi}; bf16x2_t b = __builtin_convertvector(v, bf16x2_t); return __builtin_bit_cast(unsigned, b); }
__device__ __forceinline__ float bf2f(unsigned short u) { return __uint_as_float(((unsigned)u) << 16); }
__device__ __forceinline__ float bflo(unsigned u) { return __uint_as_float(u << 16); }
__device__ __forceinline__ float bfhi(unsigned u) { return __uint_as_float(u & 0xffff0000u); }

constexpr int NB = 4, SEQ = 8192, DM = 1024, MT = NB * SEQ;
constexpr int NHEAD = 8, HD = 64, QW = 1536;
constexpr int NE = 64, EFF = 256, NMOD = 6 * DM;
constexpr int RT = MT / 2;
constexpr float EPS = 1e-6f;
constexpr float LOG2E = 1.4426950408889634f;

constexpr size_t MiB = 1u << 20;
constexpr size_t WS_CTL = 0, CTL_BYTES = 1 * MiB;
constexpr size_t WS_SMALL = 1 * MiB;
constexpr size_t SM_MOD = 0, SM_GVEC = 98304, SM_CB = 114688, SM_KBAR = 131072, SM_WRH = 393216, SM_WRL = 524288;
constexpr size_t WS_W2T = 2 * MiB;
constexpr size_t WS_W1T = 35 * MiB;
constexpr size_t WS_WIN8 = 19 * MiB;
constexpr size_t WS_H8 = 68 * MiB;
constexpr size_t WS_WINT = 100 * MiB;
constexpr size_t WS_WBRT = 110 * MiB;
constexpr size_t WS_WOUTT = 112 * MiB;
constexpr size_t WS_H = 114 * MiB;
constexpr size_t WS_OB = 114 * MiB;
constexpr size_t WS_QSB = 178 * MiB;
constexpr size_t WS_PO = 178 * MiB;
constexpr size_t WS_QMB = 274 * MiB;
constexpr size_t WS_MERGED = 274 * MiB;
constexpr size_t WS_G = 370 * MiB;
constexpr size_t WS_LMB = 498 * MiB;
constexpr size_t WS_PLSE = 506 * MiB;
constexpr size_t WS_H2 = 100 * MiB;
constexpr size_t WS_TOKL = 164 * MiB;
constexpr size_t WS_WL = 172 * MiB;
constexpr size_t WS_TPOS = 180 * MiB;
constexpr size_t WS_ACT = 184 * MiB;
constexpr size_t WS_SLOTS = 264 * MiB;
constexpr size_t WS_SHOUT = 408 * MiB;
constexpr size_t WS_X1B = 440 * MiB;
constexpr size_t WS_END = 509 * MiB;
constexpr int CW_MBCUR = 0;
constexpr int CW_MOECUR = 1024;
constexpr int CW_BAR = 4096;
constexpr size_t CTL_KBS = 512 * 1024;

constexpr int RING_BYTES = 131072;
constexpr int MISC_OFF = RING_BYTES;
constexpr int LDS_BYTES = 163840;
constexpr int MO_STG = 16384;

#define XB_TMO      128
#define XB_XCNT(j)  (256  + 64 * (j))
#define XB_XSUB(j)  (1280 + 64 * (j))
#define XB_XGEN(j)  (2304 + 64 * (j))
#define XB_TOP      3328
#define XB_TOPGEN   3392
#define XCD_BAR_WORDS 3456
#define XB_SPIN_CAP (1u << 18)
__device__ __forceinline__ unsigned xb_ld(unsigned* p)              { return __hip_atomic_load(p, __ATOMIC_RELAXED, __HIP_MEMORY_SCOPE_AGENT); }
__device__ __forceinline__ unsigned xb_add(unsigned* p, unsigned v) { return __hip_atomic_fetch_add(p, v, __ATOMIC_RELAXED, __HIP_MEMORY_SCOPE_AGENT); }
__device__ __forceinline__ unsigned xb_xcc_id() { return (unsigned)__builtin_amdgcn_s_getreg((3 << 11) | 20) & 0xFu; }
#define XB_SPIN(cond, bar) do { unsigned _sp = 0; while (cond) { __builtin_amdgcn_s_sleep(1); \
    if ((++_sp & 255u) == 0u) { if (xb_ld(&(bar)[XB_TMO])) break; if (_sp > XB_SPIN_CAP) { atomicAdd(&(bar)[XB_TMO], 1u); break; } } } } while (0)
struct XcdBarrier { unsigned* bar; unsigned x; volatile LAS unsigned* st; };
__device__ __forceinline__ XcdBarrier xcd_barrier_post(unsigned* bar, volatile LAS unsigned* st) {
    XcdBarrier b; b.bar = bar; b.x = xb_xcc_id(); b.st = st;
    if (threadIdx.x == 0) (void)xb_add(&bar[XB_XCNT(b.x)], 1u);
    return b;
}
__device__ __forceinline__ void xcd_barrier_complete(unsigned* bar, unsigned x, unsigned& nloc, unsigned& nx) {
    const unsigned G = gridDim.x * gridDim.y * gridDim.z;
    unsigned sum, cnt, mine, sp = 0u;
    for (;;) {
        sum = 0u; cnt = 0u; mine = 0u;
#pragma unroll
        for (unsigned j = 0; j < 16; ++j) { const unsigned c = xb_ld(&bar[XB_XCNT(j)]); sum += c; cnt += (c > 0u) ? 1u : 0u; mine = (j == x) ? c : mine; }
        if (sum == G) break;
        __builtin_amdgcn_s_sleep(1);
        if ((++sp & 255u) == 0u) { if (xb_ld(&bar[XB_TMO])) break; if (sp > XB_SPIN_CAP) { atomicAdd(&bar[XB_TMO], 1u); break; } }
    }
    nloc = mine > 0u ? mine : 1u; nx = cnt > 0u ? cnt : 1u;
}
__device__ __forceinline__ void xcd_barrier(const XcdBarrier& b) {
    asm volatile("s_waitcnt vmcnt(0)" ::: "memory");
    __syncthreads();
    if (threadIdx.x == 0) {
        unsigned* bar = b.bar;
        __builtin_amdgcn_s_waitcnt(0);
        unsigned nloc = b.st[0], nx = b.st[1];
        const unsigned old = xb_add(&bar[XB_XSUB(b.x)], 1u);
        const unsigned gen = old / nloc;
        if (old + 1u == (gen + 1u) * nloc) {
            __builtin_amdgcn_fence(__ATOMIC_RELEASE, "agent");
            asm volatile("s_waitcnt vmcnt(0)" ::: "memory");
            const unsigned og = xb_add(&bar[XB_TOP], 1u);
            const unsigned tg = og / nx;
            if (og + 1u == (tg + 1u) * nx) xb_add(&bar[XB_TOPGEN], 1u);
            else XB_SPIN(xb_ld(&bar[XB_TOPGEN]) == tg, bar);
            __builtin_amdgcn_fence(__ATOMIC_ACQUIRE, "agent");
            xb_add(&bar[XB_XGEN(b.x)], 1u);
            asm volatile("s_waitcnt vmcnt(0)" ::: "memory");
        } else {
            XB_SPIN(xb_ld(&bar[XB_XGEN(b.x)]) == gen, bar);
            __builtin_amdgcn_fence(__ATOMIC_ACQUIRE, "agent");
            asm volatile("s_waitcnt vmcnt(0)" ::: "memory");
        }
    }
    __syncthreads();
}

namespace gm {
constexpr int BM = 256, BK = 64, HALF = 128, HTB = HALF * BK * 2, STAGE_BYTES = 8 * HTB, NXCD = 8, WGM = 8;
__host__ __device__ __forceinline__ int lds_byte(int r, int c) { const int st = (r >> 4) * 2 + (c >> 5), rr = r & 15, cc = c & 31, ob = rr * 64 + cc * 2; return st * 1024 + (ob ^ (((ob >> 9) & 1) << 5)); }
__host__ __device__ __forceinline__ void stage_rc(int b, int& R, int& C) { const int st = b / 1024, sb = b % 1024, swz = sb ^ (((sb >> 9) & 1) << 5); R = (st >> 1) * 16 + swz / 64; C = (st & 1) * 32 + (swz % 64) / 2; }
__host__ __device__ __forceinline__ int perm32(int rho) { const int n = rho >> 4, i = rho & 15; return 8 * (i >> 2) + 4 * n + (i & 3); }

struct UnitD { const char* a; const char* b; unsigned va[2][2]; int e0, e1, e2, e3; };

__device__ __forceinline__ bool static_tile(int M, int N, int G, int c, int i, int& pm, int& pn) {
    const int nM = M / BM, nN = N / BM, nwg = nM * nN;
    const long L = (long)i * G + c; if (L >= nwg) return false;
    int wgid = (int)L; { const int q = nwg / NXCD, r = nwg % NXCD, xcd = wgid % NXCD, off = wgid / NXCD; wgid = (xcd < r ? xcd * (q + 1) : r * (q + 1) + (xcd - r) * q) + off; }
    const int nig = WGM * nN, gid = wgid / nig, fm = gid * WGM, gsz = (nM - fm) < WGM ? (nM - fm) : WGM;
    pm = fm + ((wgid % nig) % gsz); pn = (wgid % nig) / gsz; return true;
}

template <bool PERM, bool HOOK = false, bool FP8 = false, class Epi, class Sched>
__device__ __forceinline__ void gemm_phase(LAS unsigned char* lds, const int K, Sched& S, const Epi& E) {
    int tid_ = threadIdx.x; asm volatile("" : "+v"(tid_));
    const int tid = tid_, wid = __builtin_amdgcn_readfirstlane(tid >> 6), lane = tid & 63, wr = wid >> 2, wc = wid & 3, fr = lane & 15, fq = lane >> 4;
    const int nt = K / BK;
    unsigned voffB[2];
#pragma unroll
    for (int i = 0; i < 2; ++i) { int R, C; stage_rc(tid * 16 + i * 8192, R, C); const int Rb = PERM ? ((R & ~31) + perm32(R & 31)) : R; voffB[i] = (unsigned)(Rb * K + C) * 2u; }
    const size_t kstep = (size_t)(BK * 2);
    const size_t hstep = (size_t)HALF * K * 2;
    const unsigned ldsw = (unsigned)wid * 1024u;
    const int aoff = lds_byte(wr * 64 + fr, fq * 8), boff = lds_byte(wc * 32 + fr, fq * 8);
#define GM_SA(b, h) (((b) * 2 + (h)) * HTB)
#define GM_SB(b, h) ((4 + (b) * 2 + (h)) * HTB)
#define GM_STAGE_A(bufoff, U, h, kb) do { _Pragma("unroll") for (int _i = 0; _i < 2; ++_i) \
        __builtin_amdgcn_global_load_lds((const unsigned*)((U).a + (kb) + (U).va[h][_i]), (LAS unsigned*)(lds + (bufoff) + ldsw + _i * 8192), 16, 0, 0); } while (0)
#define GM_STAGE_B(bufoff, U, h, kb) do { _Pragma("unroll") for (int _i = 0; _i < 2; ++_i) \
        __builtin_amdgcn_global_load_lds((const unsigned*)((U).b + (kb) + (size_t)(h) * hstep + voffB[_i]), (LAS unsigned*)(lds + (bufoff) + ldsw + _i * 8192), 16, 0, 0); } while (0)
#define GM_LDA(dst, b, h) do { _Pragma("unroll") for (int m = 0; m < 4; ++m) _Pragma("unroll") for (int k = 0; k < 2; ++k) { \
        if constexpr (FP8) { const i32x4_ t_ = *(const LAS i32x4_*)(lds + GM_SA(b, h) + aoff + m * 2048 + k * 1024); dst##8[m][4 * k] = t_[0]; dst##8[m][4 * k + 1] = t_[1]; dst##8[m][4 * k + 2] = t_[2]; dst##8[m][4 * k + 3] = t_[3]; } \
        else dst[m][k] = *(const LAS bf16x8*)(lds + GM_SA(b, h) + aoff + m * 2048 + k * 1024); } } while (0)
#define GM_LDB(dst, b, h) do { _Pragma("unroll") for (int n = 0; n < 2; ++n) _Pragma("unroll") for (int k = 0; k < 2; ++k) { \
        if constexpr (FP8) { const i32x4_ t_ = *(const LAS i32x4_*)(lds + GM_SB(b, h) + boff + n * 2048 + k * 1024); dst##8[n][4 * k] = t_[0]; dst##8[n][4 * k + 1] = t_[1]; dst##8[n][4 * k + 2] = t_[2]; dst##8[n][4 * k + 3] = t_[3]; } \
        else dst[n][k] = *(const LAS bf16x8*)(lds + GM_SB(b, h) + boff + n * 2048 + k * 1024); } } while (0)
#define GM_MMA(ai, bj, At, Bt) do { __builtin_amdgcn_s_setprio(1); \
        if constexpr (FP8) { _Pragma("unroll") for (int m = 0; m < 4; ++m) _Pragma("unroll") for (int n = 0; n < 2; ++n) \
            asm volatile("v_mfma_scale_f32_16x16x128_f8f6f4 %0, %1, %2, %0, %3, %3 op_sel_hi:[0,0,0]" : "+v"(acc[ai][bj][m][n]) : "v"(Bt##8[n]), "v"(At##8[m]), "v"(scl1)); } \
        else { _Pragma("unroll") for (int m = 0; m < 4; ++m) _Pragma("unroll") for (int n = 0; n < 2; ++n) _Pragma("unroll") for (int k = 0; k < 2; ++k) \
            acc[ai][bj][m][n] = __builtin_amdgcn_mfma_f32_16x16x32_bf16(Bt[n][k], At[m][k], acc[ai][bj][m][n], 0, 0, 0); } \
        __builtin_amdgcn_s_setprio(0); } while (0)
#define GM_WAIT_V(n) asm volatile("s_waitcnt vmcnt(" #n ")" ::: "memory")
#define GM_WAIT_L(n) asm volatile("s_waitcnt lgkmcnt(" #n ")" ::: "memory")
#define GM_BAR __builtin_amdgcn_s_barrier()
#define GM_SCHED __builtin_amdgcn_sched_barrier(0)
    UnitD cur, nxt; int ui = 0;
    if (!S.next(0, cur)) return;
    f32x4 acc[2][2][4][2];
#pragma unroll
    for (int a = 0; a < 2; ++a)
#pragma unroll
        for (int b = 0; b < 2; ++b)
#pragma unroll
            for (int m = 0; m < 4; ++m)
#pragma unroll
                for (int n = 0; n < 2; ++n) acc[a][b][m][n] = (f32x4){0.f, 0.f, 0.f, 0.f};
    typedef int i32x8_ __attribute__((ext_vector_type(8))); typedef int i32x4_ __attribute__((ext_vector_type(4)));
    bf16x8 At[4][2], B0[2][2], B1[2][2]; i32x8_ At8[4], B08[2], B18[2];
    int scl1 = 0x7f7f7f7f; asm volatile("" : "+v"(scl1));
    GM_STAGE_B(GM_SB(0, 0), cur, 0, 0); GM_STAGE_B(GM_SB(0, 1), cur, 1, 0); GM_STAGE_A(GM_SA(0, 0), cur, 0, 0); GM_STAGE_A(GM_SA(0, 1), cur, 1, 0);
    if (wr == 1) GM_BAR;
    GM_WAIT_V(2); GM_BAR;
    GM_STAGE_B(GM_SB(1, 0), cur, 0, kstep); GM_STAGE_A(GM_SA(1, 0), cur, 0, kstep); GM_STAGE_B(GM_SB(1, 1), cur, 1, kstep);
    GM_WAIT_V(6); GM_BAR;
    for (;;) {
        const bool has_next = S.next(ui + 1, nxt);
        if (!has_next) nxt = cur;
#pragma unroll 1
        for (int t = 0; t < nt; t += 2) {
            const bool last = (t == nt - 2);
            if constexpr (HOOK) { if (t == nt / 2) E.mid(acc, cur, wr, wc, fr, fq); }
            const size_t k1 = (size_t)(t + 1) * kstep;
            UnitD U2 = cur; size_t k2 = (size_t)(t + 2) * kstep;
            if (last) { U2 = nxt; k2 = 0; }
            const size_t k3 = k2 + kstep;
            GM_LDB(B0, 0, 0); GM_LDB(B1, 0, 1); GM_SCHED; GM_LDA(At, 0, 0); GM_STAGE_A(GM_SA(1, 1), cur, 1, k1);
            GM_WAIT_V(8); GM_WAIT_L(0); GM_BAR; GM_MMA(0, 0, At, B0); GM_MMA(0, 1, At, B1); GM_BAR; GM_SCHED;
            GM_LDA(At, 0, 1); GM_STAGE_B(GM_SB(0, 0), U2, 0, k2); GM_STAGE_B(GM_SB(0, 1), U2, 1, k2); GM_STAGE_A(GM_SA(0, 0), U2, 0, k2);
            GM_WAIT_V(8); GM_WAIT_L(0); GM_BAR; GM_MMA(1, 0, At, B0); GM_MMA(1, 1, At, B1); GM_BAR; GM_SCHED;
            GM_LDB(B0, 1, 0); GM_LDB(B1, 1, 1); GM_SCHED; GM_LDA(At, 1, 0); GM_STAGE_A(GM_SA(0, 1), U2, 1, k2);
            GM_WAIT_V(8); GM_WAIT_L(0); GM_BAR; GM_MMA(0, 0, At, B0); GM_MMA(0, 1, At, B1); GM_BAR; GM_SCHED;
            GM_LDA(At, 1, 1); GM_STAGE_B(GM_SB(1, 0), U2, 0, k3); GM_STAGE_B(GM_SB(1, 1), U2, 1, k3); GM_STAGE_A(GM_SA(1, 0), U2, 0, k3);
            GM_WAIT_V(8); GM_WAIT_L(0); GM_BAR; GM_MMA(1, 0, At, B0); GM_MMA(1, 1, At, B1); GM_BAR; GM_SCHED;
        }
        if constexpr (FP8) asm volatile("s_nop 15\n\ts_nop 15" ::: "memory");
        if (wr == 0) GM_BAR;
        E(acc, cur, wr, wc, fr, fq);
        if (!has_next) break;
#pragma unroll
        for (int a = 0; a < 2; ++a)
#pragma unroll
            for (int b = 0; b < 2; ++b)
#pragma unroll
                for (int m = 0; m < 4; ++m)
#pragma unroll
                    for (int n = 0; n < 2; ++n) acc[a][b][m][n] = (f32x4){0.f, 0.f, 0.f, 0.f};
        cur = nxt; ++ui;
        if (wr == 1) GM_BAR;
    }
    GM_WAIT_V(0);
    GM_BAR;
#undef GM_SA
#undef GM_SB
#undef GM_STAGE_A
#undef GM_STAGE_B
#undef GM_LDA
#undef GM_LDB
#undef GM_MMA
#undef GM_WAIT_V
#undef GM_WAIT_L
#undef GM_BAR
#undef GM_SCHED
}
__device__ __forceinline__ void stage_geom(int tid, int (&R)[2], int (&C)[2]) {
#pragma unroll
    for (int i = 0; i < 2; ++i) stage_rc(tid * 16 + i * 8192, R[i], C[i]);
}
}

struct Args { const float* in[20]; float* out; unsigned char* ws; int ph_lo, ph_hi; };
struct Ctx {
    LAS unsigned char* lds;
    unsigned char* ws;
    const LAS unsigned long long* intab;
    float* out;
    int tid, lane, wave, G, bid;
};
#define LDS_WAIT() asm volatile("s_waitcnt lgkmcnt(0)" ::: "memory")
__device__ __forceinline__ const float* inp(const Ctx& F, int i) {
    const unsigned long long v = F.intab[i];
    const unsigned lo = __builtin_amdgcn_readfirstlane((unsigned)v), hi = __builtin_amdgcn_readfirstlane((unsigned)(v >> 32));
    return (const float*)(GAS const float*)(((unsigned long long)hi << 32) | lo);
}
template <class P> __device__ __forceinline__ P launder_ptr(P p) {
    unsigned long long v = (unsigned long long)p; unsigned lo = (unsigned)v, hi = (unsigned)(v >> 32);
    asm volatile("" : "+v"(lo), "+v"(hi));
    lo = __builtin_amdgcn_readfirstlane(lo); hi = __builtin_amdgcn_readfirstlane(hi);
    return (P)(GAS unsigned char*)(((unsigned long long)hi << 32) | lo);
}
__device__ __forceinline__ void launder(Ctx& F) {
    int t = F.tid, g = F.G, bid = F.bid;
    asm volatile("" : "+v"(t), "+v"(g), "+v"(bid));
    F.tid = t; F.G = __builtin_amdgcn_readfirstlane(g); F.bid = __builtin_amdgcn_readfirstlane(bid); F.lane = t & 63; F.wave = __builtin_amdgcn_readfirstlane(t >> 6);
    F.ws = launder_ptr(F.ws); F.out = launder_ptr(F.out);
}
__device__ __forceinline__ float wave_sum(float v) {
#pragma unroll
    for (int o = 1; o < 64; o <<= 1) v += __shfl_xor(v, o);
    return v;
}
__device__ __forceinline__ int lds_add(LAS int* p, int v) { return __hip_atomic_fetch_add(p, v, __ATOMIC_RELAXED, __HIP_MEMORY_SCOPE_WORKGROUP); }
__device__ __forceinline__ float f8c(float x) { return __builtin_amdgcn_fmed3f(x, -440.f, 440.f); }
__device__ __forceinline__ float sigmoidf_(float x) { return 1.f / (1.f + __expf(-x)); }
__device__ __forceinline__ float siluf_(float x) { return x / (1.f + __expf(-x)); }

enum { I_X = 0, I_C, I_N1G, I_N2G, I_WADA, I_BADA, I_WIN, I_WBSB, I_WBMB, I_WOUT, I_WR, I_RB, I_WGE, I_WUE, I_WDE, I_WGS, I_WUS, I_WDS, I_RELB, I_FG };

__device__ __forceinline__ void transpose_item(const float* W, int ldn, int k0, int n0, bf16_t* WT, int Kdst, int drow0, LAS float* scr, int lane) {
    const float* wp = W + (size_t)(k0 + (lane >> 3)) * ldn + n0 + 4 * (lane & 7);
    f32x4 v[8];
#pragma unroll
    for (int i = 0; i < 8; ++i) v[i] = *(const f32x4*)(wp + (size_t)(8 * i) * ldn);
#pragma unroll
    for (int i = 0; i < 8; ++i) { LAS float* d = scr + (8 * i + (lane >> 3)) * 33 + 4 * (lane & 7); d[0] = v[i].x; d[1] = v[i].y; d[2] = v[i].z; d[3] = v[i].w; }
    LDS_WAIT(); asm volatile("" ::: "memory");
    const int c = lane & 7;
#pragma unroll
    for (int j = 0; j < 4; ++j) { const int n = (lane >> 3) + 8 * j; const LAS float* s = scr + (8 * c) * 33 + n;
        u32x4 o; o.x = cvtpk(s[0 * 33], s[1 * 33]); o.y = cvtpk(s[2 * 33], s[3 * 33]); o.z = cvtpk(s[4 * 33], s[5 * 33]); o.w = cvtpk(s[6 * 33], s[7 * 33]);
        *(u32x4*)(WT + (size_t)(drow0 + n) * Kdst + k0 + 8 * c) = o; }
    LDS_WAIT(); asm volatile("" ::: "memory");
}
__device__ __forceinline__ void phase0(Ctx& F) {
    LAS float* silc = (LAS float*)(F.lds + MISC_OFF - 0);
    silc = (LAS float*)(F.lds + 0);
    for (int i = F.tid; i < 4 * DM; i += 512) silc[i] = siluf_(inp(F, I_C)[i]);
    __syncthreads();
    float* mod = (float*)(F.ws + WS_SMALL + SM_MOD);
    {
        const int gw = F.wave * F.G + F.bid;
        const int c = F.lane & 15, kp = F.lane >> 4;
        const float* wada = inp(F, I_WADA);
        for (int item = gw; item < NMOD / 16; item += 8 * F.G) {
            const int col = item * 16 + c;
            float a0 = 0.f, a1 = 0.f, a2 = 0.f, a3 = 0.f;
#pragma unroll 32
            for (int k = kp; k < DM; k += 4) { const float w = wada[(size_t)k * NMOD + col]; a0 += silc[k] * w; a1 += silc[DM + k] * w; a2 += silc[2 * DM + k] * w; a3 += silc[3 * DM + k] * w; }
            a0 += __shfl_xor(a0, 16); a0 += __shfl_xor(a0, 32); a1 += __shfl_xor(a1, 16); a1 += __shfl_xor(a1, 32);
            a2 += __shfl_xor(a2, 16); a2 += __shfl_xor(a2, 32); a3 += __shfl_xor(a3, 16); a3 += __shfl_xor(a3, 32);
            if (kp == 0) { const float bb = inp(F, I_BADA)[col]; mod[col] = a0 + bb; mod[NMOD + col] = a1 + bb; mod[2 * NMOD + col] = a2 + bb; mod[3 * NMOD + col] = a3 + bb; }
        }
    }
    __syncthreads();
    {
        LAS float* scr = (LAS float*)(F.lds + F.wave * 16384);
        const int gw = F.bid * 8 + F.wave, NGW = F.G * 8, lane = F.lane;
        constexpr int I_IN = 16 * 160, I_BR = 8 * 32, I_OUT = 16 * 32, I_EXP = 384, NIT = I_IN + 2 * I_BR + I_OUT + 65 * I_EXP;
        const float* p_win = inp(F, I_WIN); const float* p_bsb = inp(F, I_WBSB); const float* p_bmb = inp(F, I_WBMB); const float* p_out = inp(F, I_WOUT);
        const float* p_ge = inp(F, I_WGE); const float* p_ue = inp(F, I_WUE); const float* p_de = inp(F, I_WDE); const float* p_gs = inp(F, I_WGS); const float* p_us = inp(F, I_WUS); const float* p_ds = inp(F, I_WDS);
#define TD_GET(IT, SRC, LDN, DST, KD, F8) do { int r = (IT); F8 = 0; \
            if (r < I_IN) { const int kb = r / 160, nb = r % 160; SRC = p_win + (size_t)(kb * 64) * 5120 + nb * 32; LDN = 5120; \
                if (nb < 48) { DST = (bf16_t*)(F.ws + WS_WINT) + (size_t)(nb * 32) * 1024 + kb * 64; KD = 1024; } \
                else { DST = (bf16_t*)((unsigned char*)(F.ws + WS_WIN8) + (size_t)(nb * 32 - 1536) * 1024 + kb * 64); KD = 1024; F8 = 256; } } \
            else if ((r -= I_IN) < I_BR) { const int kb = r / 32, nb = r % 32; SRC = p_bsb + (size_t)(kb * 64) * 1024 + nb * 32; LDN = 1024; DST = (bf16_t*)(F.ws + WS_WBRT) + (size_t)(nb * 32) * 1024 + kb * 64; KD = 1024; } \
            else if ((r -= I_BR) < I_BR) { const int kb = r / 32, nb = r % 32; SRC = p_bmb + (size_t)(kb * 64) * 1024 + nb * 32; LDN = 1024; DST = (bf16_t*)(F.ws + WS_WBRT) + (size_t)(nb * 32) * 1024 + 512 + kb * 64; KD = 1024; } \
            else if ((r -= I_BR) < I_OUT) { const int kb = r / 32, nb = r % 32; SRC = p_out + (size_t)(kb * 64) * 1024 + nb * 32; LDN = 1024; DST = (bf16_t*)(F.ws + WS_WOUTT) + (size_t)(nb * 32) * 1024 + kb * 64; KD = 1024; } \
            else { r -= I_OUT; const int e = r / I_EXP; r -= e * I_EXP; \
                if (r < 128) { const int kb = r / 8, n0 = (r % 8) * 32; SRC = (e < NE ? p_ge + (size_t)e * DM * EFF : p_gs) + (size_t)(kb * 64) * EFF + n0; LDN = EFF; \
                    DST = (bf16_t*)((unsigned char*)(F.ws + WS_W1T) + ((size_t)e * 512 + (n0 >> 7) * 256 + (n0 & 127)) * 1024 + kb * 64); KD = 1024; F8 = 256; } \
                else if (r < 256) { r -= 128; const int kb = r / 8, n0 = (r % 8) * 32; SRC = (e < NE ? p_ue + (size_t)e * DM * EFF : p_us) + (size_t)(kb * 64) * EFF + n0; LDN = EFF; \
                    DST = (bf16_t*)((unsigned char*)(F.ws + WS_W1T) + ((size_t)e * 512 + (n0 >> 7) * 256 + 128 + (n0 & 127)) * 1024 + kb * 64); KD = 1024; F8 = 256; } \
                else { r -= 256; const int kb = r / 32, nb = r % 32; SRC = (e < NE ? p_de + (size_t)e * EFF * DM : p_ds) + (size_t)(kb * 64) * DM + nb * 32; LDN = DM; \
                    DST = (bf16_t*)((unsigned char*)(F.ws + WS_W2T) + ((size_t)e * 1024 + nb * 32) * 256 + kb * 64); KD = 256; F8 = 128; } } } while (0)
#define TD_LOAD(V, SRC, LDN) do { const float* wp_ = (SRC) + (size_t)(lane >> 3) * (LDN) + 4 * (lane & 7); _Pragma("unroll") for (int i = 0; i < 8; ++i) V[i] = *(const f32x4*)(wp_ + (size_t)(8 * i) * (LDN)); } while (0)
#define TD_PROC(V, DST, KD, F8) do { \
            _Pragma("unroll") for (int i = 0; i < 8; ++i) { LAS float* d = scr + (8 * i + (lane >> 3)) * 33 + 4 * (lane & 7); d[0] = V[i].x; d[1] = V[i].y; d[2] = V[i].z; d[3] = V[i].w; } \
            LDS_WAIT(); asm volatile("" ::: "memory"); \
            if (F8) { _Pragma("unroll") for (int j = 0; j < 4; ++j) { const int n = (lane >> 3) + 8 * j; const LAS float* sp = scr + (8 * (lane & 7)) * 33 + n; \
                int w0 = 0, w1 = 0; \
                const float fs_ = (float)(F8); w0 = __builtin_amdgcn_cvt_pk_fp8_f32(f8c(sp[0 * 33] * fs_), f8c(sp[1 * 33] * fs_), w0, false); w0 = __builtin_amdgcn_cvt_pk_fp8_f32(f8c(sp[2 * 33] * fs_), f8c(sp[3 * 33] * fs_), w0, true); \
                w1 = __builtin_amdgcn_cvt_pk_fp8_f32(f8c(sp[4 * 33] * fs_), f8c(sp[5 * 33] * fs_), w1, false); w1 = __builtin_amdgcn_cvt_pk_fp8_f32(f8c(sp[6 * 33] * fs_), f8c(sp[7 * 33] * fs_), w1, true); \
                *(u32x2*)((unsigned char*)(DST) + (size_t)n * (KD) + 8 * (lane & 7)) = (u32x2){(unsigned)w0, (unsigned)w1}; } } \
            else { _Pragma("unroll") for (int j = 0; j < 4; ++j) { const int n = (lane >> 3) + 8 * j; const LAS float* sp = scr + (8 * (lane & 7)) * 33 + n; \
                u32x4 o; o.x = cvtpk(sp[0 * 33], sp[1 * 33]); o.y = cvtpk(sp[2 * 33], sp[3 * 33]); o.z = cvtpk(sp[4 * 33], sp[5 * 33]); o.w = cvtpk(sp[6 * 33], sp[7 * 33]); \
                *(u32x4*)((DST) + (size_t)n * (KD) + 8 * (lane & 7)) = o; } } \
            LDS_WAIT(); asm volatile("" ::: "memory"); } while (0)
        for (int it = 4 * gw; it < NIT; it += 4 * NGW) {
            const float* src[4]; bf16_t* dst[4]; int ld[4], kd[4], f8[4];
            f32x4 v0[8], v1[8], v2[8], v3[8];
            TD_GET(it, src[0], ld[0], dst[0], kd[0], f8[0]); TD_GET(it + 1, src[1], ld[1], dst[1], kd[1], f8[1]); TD_GET(it + 2, src[2], ld[2], dst[2], kd[2], f8[2]); TD_GET(it + 3, src[3], ld[3], dst[3], kd[3], f8[3]);
            TD_LOAD(v0, src[0], ld[0]); TD_LOAD(v1, src[1], ld[1]); TD_LOAD(v2, src[2], ld[2]); TD_LOAD(v3, src[3], ld[3]);
            TD_PROC(v0, dst[0], kd[0], f8[0]); TD_PROC(v1, dst[1], kd[1], f8[1]); TD_PROC(v2, dst[2], kd[2], f8[2]); TD_PROC(v3, dst[3], kd[3], f8[3]);
        }
#undef TD_PROC
#undef TD_GET
#undef TD_LOAD
    }
    {
        bf16_t* wrh = (bf16_t*)(F.ws + WS_SMALL + SM_WRH); bf16_t* wrl = (bf16_t*)(F.ws + WS_SMALL + SM_WRL);
        const float* wr = inp(F, I_WR);
        for (int i = F.bid * 512 + F.tid; i < NE * DM; i += F.G * 512) { const int e = i >> 10, k = i & 1023; const float v = wr[k * NE + e];
            const unsigned h = cvtpk(v, 0.f) & 0xffffu; wrh[i] = (bf16_t)h; wrl[i] = (bf16_t)(cvtpk(v - bflo(h), 0.f) & 0xffffu); }
    }
}

__device__ __forceinline__ void phase1(Ctx& F) {
    const float* mod = (const float*)(F.ws + WS_SMALL + SM_MOD);
    const float* x = inp(F, I_X); const float* g1 = inp(F, I_N1G);
    bf16_t* H = (bf16_t*)(F.ws + WS_H); unsigned char* H8 = (unsigned char*)(F.ws + WS_H8);
    const int gw = F.bid * 8 + F.wave, NGW = F.G * 8;
    if (gw < 256) {
        const int b = gw >> 6, e = gw & 63; const float* wr = inp(F, I_WR); float a = 0.f;
#pragma unroll 4
        for (int k = F.lane; k < DM; k += 64) a += mod[b * NMOD + 3 * DM + k] * wr[k * NE + e];
        a = wave_sum(a);
        if (F.lane == 0) ((float*)(F.ws + WS_SMALL + SM_CB))[gw] = a;
    }
    if (F.bid == 32) {
        float* gvec = (float*)(F.ws + WS_SMALL + SM_GVEC); const float* g2 = inp(F, I_N2G);
        for (int i = F.tid; i < 4 * DM; i += 512) { const int b = i >> 10, k = i & 1023; gvec[i] = g2[k] * (1.f + mod[b * NMOD + 4 * DM + k]); }
    }
    for (int m0 = gw; m0 < MT; m0 += 2 * NGW) {
        const int m1 = m0 + NGW;
        const bool two = m1 < MT;
        const f32x4* xr0 = (const f32x4*)(x + (size_t)m0 * DM) + F.lane; const f32x4* xr1 = (const f32x4*)(x + (size_t)(two ? m1 : m0) * DM) + F.lane;
        f32x4 v0[4], v1[4]; float s0 = 0.f, s1 = 0.f;
#pragma unroll
        for (int j = 0; j < 4; ++j) { v0[j] = xr0[64 * j]; v1[j] = xr1[64 * j]; }
#pragma unroll
        for (int j = 0; j < 4; ++j) { s0 += (v0[j].x * v0[j].x + v0[j].y * v0[j].y) + (v0[j].z * v0[j].z + v0[j].w * v0[j].w); s1 += (v1[j].x * v1[j].x + v1[j].y * v1[j].y) + (v1[j].z * v1[j].z + v1[j].w * v1[j].w); }
        const float r0 = rsqrtf(wave_sum(s0) * (1.f / DM) + EPS), r1 = rsqrtf(wave_sum(s1) * (1.f / DM) + EPS);
        const int b0 = m0 / SEQ, b1 = (two ? m1 : m0) / SEQ;
        u32x2* o0 = (u32x2*)(H + (size_t)m0 * DM) + F.lane; u32x2* o1 = (u32x2*)(H + (size_t)(two ? m1 : m0) * DM) + F.lane;
#pragma unroll
        for (int j = 0; j < 4; ++j) {
            const int col = 4 * F.lane + 256 * j;
            const f32x4 g = *(const f32x4*)(g1 + col);
            const f32x4 h0 = (v0[j] * r0) * g * (*(const f32x4*)(mod + b0 * NMOD + DM + col) + 1.0f) + *(const f32x4*)(mod + b0 * NMOD + col);
            const f32x4 h1 = (v1[j] * r1) * g * (*(const f32x4*)(mod + b1 * NMOD + DM + col) + 1.0f) + *(const f32x4*)(mod + b1 * NMOD + col);
            u32x2 w; w.x = cvtpk(h0.x, h0.y); w.y = cvtpk(h0.z, h0.w); o0[64 * j] = w;
            { int q8 = 0; q8 = __builtin_amdgcn_cvt_pk_fp8_f32(f8c(h0.x * 16.f), f8c(h0.y * 16.f), q8, false); q8 = __builtin_amdgcn_cvt_pk_fp8_f32(f8c(h0.z * 16.f), f8c(h0.w * 16.f), q8, true);
              ((unsigned*)(H8 + (size_t)m0 * DM) + F.lane)[64 * j] = (unsigned)q8; }
            if (two) { w.x = cvtpk(h1.x, h1.y); w.y = cvtpk(h1.z, h1.w); o1[64 * j] = w;
                int q8 = 0; q8 = __builtin_amdgcn_cvt_pk_fp8_f32(f8c(h1.x * 16.f), f8c(h1.y * 16.f), q8, false); q8 = __builtin_amdgcn_cvt_pk_fp8_f32(f8c(h1.z * 16.f), f8c(h1.w * 16.f), q8, true);
                ((unsigned*)(H8 + (size_t)m1 * DM) + F.lane)[64 * j] = (unsigned)q8; }
        }
    }
}

struct ProjSched {
    const char* A; const char* Bt; int G, c, pn0, npn, f8; int R[2], C[2];
    __device__ __forceinline__ bool next(int i, gm::UnitD& u) {
        int pm, pn; if (!gm::static_tile(MT, npn * 256, G, c, i, pm, pn)) return false;
        const int kp = f8 ? 512 : 1024;
        u.a = A; u.b = Bt + (size_t)pn * 256 * kp * 2;
#pragma unroll
        for (int h = 0; h < 2; ++h)
#pragma unroll
            for (int j = 0; j < 2; ++j) u.va[h][j] = (unsigned)((pm * 256 + h * 128 + R[j]) * kp + C[j]) * 2u;
        u.e0 = pm; u.e1 = pn0 + pn; u.e2 = f8; u.e3 = 0; return true;
    }
};
struct EpiProj {
    bf16_t* qsb; bf16_t* qmb; bf16_t* g; float* kbs;
    __device__ __forceinline__ void operator()(const f32x4 (&acc)[2][2][4][2], const gm::UnitD& u, int wr, int wc, int fr, int fq) const {
        const int pm = u.e0, pn = u.e1;
        bf16_t* base; int ldc, colt; float sc = 1.f;
        if (pn < 6) { base = qsb; ldc = QW; colt = pn * 256; if (pn < 2) sc = 0.125f * LOG2E; }
        else if (pn < 12) { base = qmb; ldc = QW; colt = (pn - 6) * 256; if (pn < 8) sc = 0.125f; }
        else { base = g; ldc = 2048; colt = (pn - 12) * 256; }
        if (u.e2) sc *= (1.f / 4096.f);
        const int row0 = pm * 256 + wr * 64 + fr, col0 = colt + wc * 32 + 8 * fq;
        if (pn == 8 || pn == 9) {
#pragma unroll
            for (int bj = 0; bj < 2; ++bj)
#pragma unroll
                for (int n = 0; n < 2; ++n) { f32x4 cs = (f32x4){0.f, 0.f, 0.f, 0.f};
#pragma unroll
                    for (int ai = 0; ai < 2; ++ai)
#pragma unroll
                        for (int m = 0; m < 4; ++m) cs += acc[ai][bj][m][n];
#pragma unroll
                    for (int o = 1; o < 16; o <<= 1) { cs[0] += __shfl_xor(cs[0], o); cs[1] += __shfl_xor(cs[1], o); cs[2] += __shfl_xor(cs[2], o); cs[3] += __shfl_xor(cs[3], o); }
                    if (fr == 0) { float* kd = kbs + (size_t)pm * 512 + (pn - 8) * 256 + bj * 128 + wc * 32 + 8 * fq + 4 * n;
#pragma unroll
                        for (int j = 0; j < 4; ++j) atomicAdd(kd + j, cs[j]); } }
        }
#pragma unroll
        for (int ai = 0; ai < 2; ++ai)
#pragma unroll
            for (int m = 0; m < 4; ++m) { bf16_t* rowp = base + (size_t)(row0 + ai * 128 + m * 16) * ldc + col0;
#pragma unroll
                for (int bj = 0; bj < 2; ++bj) { const f32x4 v0 = acc[ai][bj][m][0] * sc, v1 = acc[ai][bj][m][1] * sc;
                    u32x4 w; w.x = cvtpk(v0[0], v0[1]); w.y = cvtpk(v0[2], v0[3]); w.z = cvtpk(v1[0], v1[1]); w.w = cvtpk(v1[2], v1[3]);
                    *(u32x4*)(rowp + bj * 128) = w; } }
    }
};
__device__ __forceinline__ void phase2(Ctx& F) {
    EpiProj E{(bf16_t*)(F.ws + WS_QSB), (bf16_t*)(F.ws + WS_QMB), (bf16_t*)(F.ws + WS_G), (float*)(F.ws + WS_CTL + CTL_KBS)};
    {
        ProjSched S; S.A = (const char*)(F.ws + WS_H); S.Bt = (const char*)(F.ws + WS_WINT); S.G = F.G; S.c = F.bid; S.pn0 = 0; S.npn = 6; S.f8 = 0; gm::stage_geom(F.tid, S.R, S.C);
        gm::gemm_phase<true>(F.lds, 1024, S, E);
    }
    {
        ProjSched S; S.A = (const char*)(F.ws + WS_H8); S.Bt = (const char*)(F.ws + WS_WIN8); S.G = F.G; S.c = F.bid; S.pn0 = 6; S.npn = 14; S.f8 = 1; gm::stage_geom(F.tid, S.R, S.C);
        gm::gemm_phase<true, false, true>(F.lds, 512, S, E);
    }
}

__device__ __forceinline__ int crow(int r, int hi) { return (r & 3) + 8 * (r >> 2) + 4 * hi; }
typedef short v4i16_t __attribute__((ext_vector_type(4)));
__device__ __forceinline__ s16x4 vtr(const LAS unsigned char* p) { return __builtin_bit_cast(s16x4, __builtin_amdgcn_ds_read_tr16_b64_v4i16((LAS v4i16_t*)p)); }
#define PV_TR(dst, off) asm volatile("ds_read_b64_tr_b16 %0, %1 offset:%2" : "=v"(dst) : "v"(vb), "n"(off) : "memory")
__device__ __forceinline__ void pv64(f32x16 (&o)[2], const LAS unsigned char* vt, int lane, const u32x4 (&pw)[4]) {
    const int hi = lane >> 5;
    const LAS unsigned char* vb = vt + ((lane >> 4) & 1) * 32 + (lane & 3) * 8 + (4 * hi + ((lane & 15) >> 2)) * 64;
    s16x4 lo[2][4], hh[2][4];
#pragma unroll
    for (int ks = 0; ks < 4; ++ks) { PV_TR(lo[0][ks], ks * 1024); PV_TR(hh[0][ks], ks * 1024 + 512); }
#pragma unroll
    for (int ks = 0; ks < 4; ++ks) { PV_TR(lo[1][ks], 4096 + ks * 1024); PV_TR(hh[1][ks], 4096 + ks * 1024 + 512); }
    asm volatile("s_waitcnt lgkmcnt(8)" : "+v"(lo[0][0]), "+v"(lo[0][1]), "+v"(lo[0][2]), "+v"(lo[0][3]), "+v"(hh[0][0]), "+v"(hh[0][1]), "+v"(hh[0][2]), "+v"(hh[0][3]) :: "memory");
#pragma unroll
    for (int ks = 0; ks < 4; ++ks) {
        const bf16x8 bv = (bf16x8){lo[0][ks][0], lo[0][ks][1], lo[0][ks][2], lo[0][ks][3], hh[0][ks][0], hh[0][ks][1], hh[0][ks][2], hh[0][ks][3]};
        o[0] = __builtin_amdgcn_mfma_f32_32x32x16_bf16(__builtin_bit_cast(bf16x8, pw[ks]), bv, o[0], 0, 0, 0);
    }
    asm volatile("s_waitcnt lgkmcnt(0)" : "+v"(lo[1][0]), "+v"(lo[1][1]), "+v"(lo[1][2]), "+v"(lo[1][3]), "+v"(hh[1][0]), "+v"(hh[1][1]), "+v"(hh[1][2]), "+v"(hh[1][3]) :: "memory");
#pragma unroll
    for (int ks = 0; ks < 4; ++ks) {
        const bf16x8 bv = (bf16x8){lo[1][ks][0], lo[1][ks][1], lo[1][ks][2], lo[1][ks][3], hh[1][ks][0], hh[1][ks][1], hh[1][ks][2], hh[1][ks][3]};
        o[1] = __builtin_amdgcn_mfma_f32_32x32x16_bf16(__builtin_bit_cast(bf16x8, pw[ks]), bv, o[1], 0, 0, 0);
    }
}
__device__ __forceinline__ void store_o_tile(const f32x16 (&o)[2], LAS unsigned char* stgb, int lane, bf16_t* dst0, size_t row_pitch) {
    const int r32 = lane & 31, hi = lane >> 5;
    LAS bf16_t* stg = (LAS bf16_t*)stgb;
#pragma unroll
    for (int r = 0; r < 16; ++r) { const int orow = crow(r, hi);
#pragma unroll
        for (int d0 = 0; d0 < 2; ++d0) stg[orow * 64 + d0 * 32 + r32] = (bf16_t)(cvtpk(o[d0][r], 0.f) & 0xffffu); }
    LDS_WAIT();
#pragma unroll
    for (int i = 0; i < 4; ++i) { const int row = i * 8 + (lane >> 3), ch = lane & 7; const u32x4 v = *(const LAS u32x4*)(stg + row * 64 + ch * 8); *(u32x4*)(dst0 + (size_t)row * row_pitch + ch * 8) = v; }
    LDS_WAIT();
}

template <bool MASKED>
__device__ __forceinline__ void sb_tile(const f32x16 (&z)[2], float& P, u32x4 (&pw)[4], int k0, int qpos, int hi) {
    f32x16 be[2], nb[2];
#pragma unroll
    for (int p = 0; p < 2; ++p)
#pragma unroll
        for (int r = 0; r < 16; ++r) {
            const float zz = __builtin_amdgcn_fmed3f(z[p][r], -126.f, 126.f);
            const float t = __builtin_amdgcn_exp2f(-zz), b_ = __builtin_amdgcn_rcpf(1.f + t);
            float n_ = t * b_, bb = b_;
            if (MASKED) { const bool valid = (k0 + 32 * p + crow(r, hi)) < qpos; n_ = valid ? n_ : 1.f; bb = valid ? bb : 0.f; }
            be[p][r] = bb; nb[p][r] = n_;
        }
    float Gp[8], PG[8], off[8];
#pragma unroll
    for (int idx = 0; idx < 8; ++idx) { const int p = idx >> 2, g4 = (idx & 3) * 4; Gp[idx] = (nb[p][g4] * nb[p][g4 + 1]) * (nb[p][g4 + 2] * nb[p][g4 + 3]); }
#pragma unroll
    for (int idx = 0; idx < 8; ++idx) PG[idx] = __shfl_xor(Gp[idx], 32);
    float run = P;
#pragma unroll
    for (int idx = 7; idx >= 0; --idx) { off[idx] = hi ? run : run * PG[idx]; run *= (Gp[idx] * PG[idx]); }
    P = run;
#pragma unroll
    for (int idx = 0; idx < 8; ++idx) { const int p = idx >> 2, g4 = (idx & 3) * 4; float c = off[idx]; float a[4];
#pragma unroll
        for (int j = 3; j >= 0; --j) { a[j] = be[p][g4 + j] * c; c *= nb[p][g4 + j]; }
        pw[idx >> 1][(idx & 1) * 2] = cvtpk(a[0], a[1]); pw[idx >> 1][(idx & 1) * 2 + 1] = cvtpk(a[2], a[3]); }
}
__device__ __forceinline__ void sb_unit(Ctx& F, int bh, int qt, LAS unsigned char* vl) {
    const int lane = F.lane, r32 = lane & 31, hi = lane >> 5;
    const int b = bh >> 3, h = bh & 7, q0 = qt * 32, qpos = q0 + r32;
    const bf16_t* base = (const bf16_t*)(F.ws + WS_QSB) + (size_t)b * SEQ * QW + h * 64;
    const bf16_t* Kb = base + 512 + (size_t)r32 * QW + hi * 8; const bf16_t* Vb = base + 1024 + (size_t)(lane >> 2) * QW + (lane & 3) * 8;
    bf16x8 qr[4];
#pragma unroll
    for (int d0 = 0; d0 < 4; ++d0) qr[d0] = *(const bf16x8*)(base + (size_t)qpos * QW + d0 * 16 + hi * 8);
    float P = 1.f; f32x16 o[2]; o[0] = f32x16{}; o[1] = f32x16{};
    bf16x8 kfn[8];
    const int kt0 = q0 >> 6; int kt = kt0, cur = 0;
#define SB_PREFETCH(KT, BUF) do { const size_t ko_ = (size_t)(KT) * 64 * QW; \
        _Pragma("unroll") for (int d0 = 0; d0 < 4; ++d0) _Pragma("unroll") for (int hf = 0; hf < 2; ++hf) kfn[2 * d0 + hf] = *(const bf16x8*)(Kb + ko_ + (size_t)(32 * hf) * QW + d0 * 16); \
        _Pragma("unroll") for (int p = 0; p < 8; ++p) __builtin_amdgcn_global_load_lds((const unsigned*)(Vb + ko_ + (size_t)(16 * (p & 3)) * QW + (p >> 2) * 32), (LAS unsigned*)(vl + (BUF) * 8192 + p * 1024), 16, 0, 0); } while (0)
    SB_PREFETCH(kt, 0);
#pragma unroll 1
    for (; kt >= 0; --kt) {
        if (__all(P == 0.f)) break;
        f32x16 z[2]; z[0] = f32x16{}; z[1] = f32x16{};
#pragma unroll
        for (int d0 = 0; d0 < 4; ++d0) { z[0] = __builtin_amdgcn_mfma_f32_32x32x16_bf16(kfn[2 * d0], qr[d0], z[0], 0, 0, 0); z[1] = __builtin_amdgcn_mfma_f32_32x32x16_bf16(kfn[2 * d0 + 1], qr[d0], z[1], 0, 0, 0); }
        asm volatile("" : "+v"(z[0]), "+v"(z[1]));
        { const int ktn = kt > 0 ? kt - 1 : 0; SB_PREFETCH(ktn, cur ^ 1); }
        u32x4 pw[4];
        if (kt == kt0) sb_tile<true>(z, P, pw, kt * 64, qpos, hi); else sb_tile<false>(z, P, pw, kt * 64, qpos, hi);
        asm volatile("s_waitcnt vmcnt(16)" ::: "memory");
        pv64(o, vl + cur * 8192, lane, pw);
        cur ^= 1;
    }
#undef SB_PREFETCH
    asm volatile("s_waitcnt vmcnt(0)" ::: "memory");
    bf16_t* dst = (bf16_t*)(F.ws + WS_OB) + (size_t)(b * SEQ + q0) * 1024 + h * 64;
    store_o_tile(o, vl, lane, dst, 1024);
}
__device__ __forceinline__ void sb_units(Ctx& F) {
    const int gw = F.bid * 8 + F.wave, NGW = F.G * 8;
    LAS unsigned char* vl = F.lds + F.wave * 16384;
    for (int u = gw; u < 32 * 256; u += NGW) sb_unit(F, u >> 8, u & 255, vl);
}

constexpr int MO_LUT = 0, MO_PRE = 4224, MO_WSF = 8320, MO_ENT = 12416, MO_ST = 16368;
__device__ __forceinline__ int mb_list_off(int j) { return 256 * (31 * j - (j * (j - 1)) / 2); }
constexpr int MB_LIST_STRIDE = 126976;
__device__ __forceinline__ int t5_bucket_dev(int n) {
    if (n < 16) return n;
    int large = 16 + (int)(logf((float)n / 16.f) / 2.0794415416798357f * 16.f);
    return large < 31 ? large : 31;
}
__device__ __forceinline__ void build_lut(Ctx& F) {
    LAS float* lut = (LAS float*)(F.lds + MISC_OFF + MO_LUT);
    for (int i = F.tid; i < 8 * 132; i += 512) { const int h = i / 132, d = i % 132; lut[i] = inp(F, I_RELB)[h * 32 + t5_bucket_dev(d < 128 ? d : 128)] * LOG2E; }
}
__device__ __forceinline__ void phase4(Ctx& F) {
    LAS int* lcnt = (LAS int*)(F.lds + MISC_OFF + MO_PRE); LAS int* lbase = lcnt + 32;
    const float* kbar = (const float*)(F.ws + WS_CTL + CTL_KBS);
    unsigned* cur = (unsigned*)(F.ws + WS_CTL) + CW_MBCUR;
    unsigned short* lists = (unsigned short*)(F.ws + WS_LMB);
    const int lane = F.lane, r32 = lane & 31, hi = lane >> 5;
    for (int u = F.bid; u < 32 * 31; u += F.G) {
        const int bh = u / 31, i = 1 + (u % 31), b = bh >> 3, h = bh & 7;
        if (F.tid < 32) lcnt[F.tid] = 0;
        __syncthreads();
        const int qpos = i * 256 + F.wave * 32 + r32;
        const float* kp = kbar + (size_t)(b * 32 + r32) * 512 + h * 64 + hi * 8;
        const bf16_t* qp = (const bf16_t*)(F.ws + WS_QMB) + (size_t)(b * SEQ + qpos) * QW + h * 64 + hi * 8;
        f32x16 gt = f32x16{};
#pragma unroll
        for (int s4 = 0; s4 < 4; ++s4) {
            const f32x4 k0 = *(const f32x4*)(kp + 16 * s4), k1 = *(const f32x4*)(kp + 16 * s4 + 4);
            const bf16x8 qf = *(const bf16x8*)(qp + 16 * s4);
            const unsigned a0 = cvtpk(k0.x, k0.y), a1 = cvtpk(k0.z, k0.w), a2 = cvtpk(k1.x, k1.y), a3 = cvtpk(k1.z, k1.w);
            const u32x4 kh = (u32x4){a0, a1, a2, a3};
            const u32x4 kl = (u32x4){cvtpk(k0.x - bflo(a0), k0.y - bfhi(a0)), cvtpk(k0.z - bflo(a1), k0.w - bfhi(a1)), cvtpk(k1.x - bflo(a2), k1.y - bfhi(a2)), cvtpk(k1.z - bflo(a3), k1.w - bfhi(a3))};
            gt = __builtin_amdgcn_mfma_f32_32x32x16_bf16(__builtin_bit_cast(bf16x8, kl), qf, gt, 0, 0, 0);
            gt = __builtin_amdgcn_mfma_f32_32x32x16_bf16(__builtin_bit_cast(bf16x8, kh), qf, gt, 0, 0, 0);
        }
        float v0 = -INFINITY, v1 = -INFINITY, v2 = -INFINITY; int j0 = 64, j1 = 64, j2 = 64;
#pragma unroll
        for (int r = 0; r < 16; ++r) { const int j = crow(r, hi); const float g = j < i ? gt[r] : -INFINITY;
            if (g > v0) { v2 = v1; j2 = j1; v1 = v0; j1 = j0; v0 = g; j0 = j; }
            else if (g > v1) { v2 = v1; j2 = j1; v1 = g; j1 = j; }
            else if (g > v2) { v2 = g; j2 = j; } }
        {
            const float pv[3] = {__shfl_xor(v0, 32), __shfl_xor(v1, 32), __shfl_xor(v2, 32)}; const int pj[3] = {__shfl_xor(j0, 32), __shfl_xor(j1, 32), __shfl_xor(j2, 32)};
#pragma unroll
            for (int t = 0; t < 3; ++t) { const float g = pv[t]; const int j = pj[t];
                if (g > v0 || (g == v0 && j < j0)) { v2 = v1; j2 = j1; v1 = v0; j1 = j0; v0 = g; j0 = j; }
                else if (g > v1 || (g == v1 && j < j1)) { v2 = v1; j2 = j1; v1 = g; j1 = j; }
                else if (g > v2 || (g == v2 && j < j2)) { v2 = g; j2 = j; } }
        }
        const int nsel = i < 3 ? i : 3;
        int r0 = 0, r1 = 0, r2 = 0;
        if (hi == 0) { r0 = lds_add(&lcnt[j0], 1); if (nsel > 1) r1 = lds_add(&lcnt[j1], 1); if (nsel > 2) r2 = lds_add(&lcnt[j2], 1); }
        __syncthreads();
        if (F.tid < i) { const int n = lcnt[F.tid]; lbase[F.tid] = n > 0 ? (int)atomicAdd(&cur[bh * 32 + F.tid], (unsigned)n) : 0; }
        __syncthreads();
        if (hi == 0) {
            unsigned short* lb = lists + (size_t)bh * MB_LIST_STRIDE;
            lb[mb_list_off(j0) + lbase[j0] + r0] = (unsigned short)(qpos | (0 << 13));
            if (nsel > 1) lb[mb_list_off(j1) + lbase[j1] + r1] = (unsigned short)(qpos | (1 << 13));
            if (nsel > 2) lb[mb_list_off(j2) + lbase[j2] + r2] = (unsigned short)(qpos | (2 << 13));
        }
    }
}
__device__ __forceinline__ void kv_dma(Ctx& F, const bf16_t* kg, const bf16_t* vg, int bufoff) {
    const int l = F.lane;
#pragma unroll
    for (int i = 0; i < 4; ++i) { const int p = 4 * F.wave + i;
        __builtin_amdgcn_global_load_lds((const unsigned*)(kg + (size_t)(8 * p + (l >> 3)) * QW + ((l & 7) ^ ((l >> 3) & 7)) * 8), (LAS unsigned*)(F.lds + bufoff + p * 1024), 16, 0, 0);
        __builtin_amdgcn_global_load_lds((const unsigned*)(vg + (size_t)((p >> 3) * 64 + (p & 3) * 16 + (l >> 2)) * QW + ((p >> 2) & 1) * 32 + (l & 3) * 8), (LAS unsigned*)(F.lds + bufoff + 32768 + p * 1024), 16, 0, 0); }
}
__device__ __forceinline__ void softmax_step(f32x16 (&t)[2], float& m, float& l, f32x16 (&o)[2], LAS float* wsf, const LAS unsigned char* vt, int lane) {
    const int r32 = lane & 31, hi = lane >> 5;
    float rm = -INFINITY;
#pragma unroll
    for (int p = 0; p < 2; ++p)
#pragma unroll
        for (int r = 0; r < 16; ++r) rm = fmaxf(rm, t[p][r]);
    rm = fmaxf(rm, __shfl_xor(rm, 32));
    const float mn = fmaxf(m, rm);
    const float f = __builtin_amdgcn_exp2f(m - mn);
    m = mn;
    float s = 0.f; u32x4 pw[4];
#pragma unroll
    for (int p = 0; p < 2; ++p)
#pragma unroll
        for (int r = 0; r < 16; ++r) { const float e = __builtin_amdgcn_exp2f(t[p][r] - mn); t[p][r] = e; s += e; }
    l = l * f + s;
#pragma unroll
    for (int idx = 0; idx < 8; ++idx) { const int p = idx >> 2, g4 = (idx & 3) * 4; pw[idx >> 1][(idx & 1) * 2] = cvtpk(t[p][g4], t[p][g4 + 1]); pw[idx >> 1][(idx & 1) * 2 + 1] = cvtpk(t[p][g4 + 2], t[p][g4 + 3]); }
    if (__any(f != 1.f)) {
        if (hi == 0) wsf[r32] = f;
        LDS_WAIT();
#pragma unroll
        for (int g = 0; g < 4; ++g) { const f32x4 fv = *(const LAS f32x4*)(wsf + 8 * g + 4 * hi);
#pragma unroll
            for (int j = 0; j < 4; ++j) { o[0][4 * g + j] *= fv[j]; o[1][4 * g + j] *= fv[j]; } }
        LDS_WAIT();
    }
    pv64(o, vt, lane, pw);
}
__device__ __forceinline__ void qkt64(f32x16 (&t)[2], const LAS unsigned char* kt, const bf16x8 (&qr)[4], int lane) {
    const int r32 = lane & 31, hi = lane >> 5;
    t[0] = f32x16{}; t[1] = f32x16{};
    const LAS unsigned char* rp = kt + r32 * 128;
#pragma unroll
    for (int d0 = 0; d0 < 4; ++d0) {
        const int pos = ((2 * d0 + hi) ^ (r32 & 7)) * 16;
        const bf16x8 k0 = *(const LAS bf16x8*)(rp + pos), k1 = *(const LAS bf16x8*)(rp + 4096 + pos);
        t[0] = __builtin_amdgcn_mfma_f32_32x32x16_bf16(k0, qr[d0], t[0], 0, 0, 0); t[1] = __builtin_amdgcn_mfma_f32_32x32x16_bf16(k1, qr[d0], t[1], 0, 0, 0);
    }
}
__device__ __forceinline__ void phase5(Ctx& F) {
    LAS int* pre = (LAS int*)(F.lds + MISC_OFF + MO_PRE);
    LAS int* wtot = (LAS int*)(F.lds + MISC_OFF + MO_ENT);
    const unsigned* cur = (const unsigned*)(F.ws + WS_CTL) + CW_MBCUR;
    build_lut(F);
    int total;
    {
        const int p0 = 2 * F.tid, p1 = p0 + 1;
        const int n0 = p0 < 992 ? (int)cur[(p0 / 31) * 32 + (p0 % 31)] : 0, n1 = p1 < 992 ? (int)cur[(p1 / 31) * 32 + (p1 % 31)] : 0;
        const int c0 = (n0 + 255) >> 8, c1 = (n1 + 255) >> 8;
        const int s = c0 + c1; int v = s;
#pragma unroll
        for (int o = 1; o < 64; o <<= 1) { const int n = __shfl_up(v, o); if (F.lane >= o) v += n; }
        if (F.lane == 63) wtot[248 + F.wave] = v;
        __syncthreads();
        int woff = 0; total = 0;
#pragma unroll
        for (int w = 0; w < 8; ++w) { const int x = wtot[248 + w]; if (w < F.wave) woff += x; total += x; }
        const int excl = woff + v - s;
        pre[p0] = excl | (n0 << 16); pre[p1] = (excl + c0) | (n1 << 16);
        __syncthreads();
    }
    const unsigned short* lists = (const unsigned short*)(F.ws + WS_LMB);
    LAS float* wsf = (LAS float*)(F.lds + MISC_OFF + MO_WSF) + F.wave * 128;
    LAS int* ent = (LAS int*)(F.lds + MISC_OFF + MO_ENT) + F.wave * 32;
    const int lane = F.lane, r32 = lane & 31, hi = lane >> 5;
#define P5_UNIT(U, BH, J, C, N) do { int lo_ = 0, hi_ = 992; while (hi_ - lo_ > 1) { const int mid = (lo_ + hi_) >> 1; if ((pre[mid] & 0xffff) <= (U)) lo_ = mid; else hi_ = mid; } \
        const int w_ = pre[lo_]; BH = lo_ / 31; J = lo_ % 31; C = (U) - (w_ & 0xffff); N = w_ >> 16; } while (0)
#define P5_DMA(BH, J, BUF) do { const bf16_t* b_ = (const bf16_t*)(F.ws + WS_QMB) + (size_t)((BH) >> 3) * SEQ * QW + ((BH) & 7) * 64; kv_dma(F, b_ + 512 + (size_t)((J) * 256) * QW, b_ + 1024 + (size_t)((J) * 256) * QW, (BUF) * 65536); } while (0)
#define P5_ENTRY(BH, J, C, N, ACT, VALID, ENTRY) do { const int e0_ = (C) * 256 + F.wave * 32; ACT = e0_ < (N); VALID = ACT && (e0_ + r32) < (N); \
        const unsigned short* lb_ = lists + (size_t)(BH) * MB_LIST_STRIDE + mb_list_off(J); ENTRY = ACT ? (int)lb_[VALID ? e0_ + r32 : e0_] : 0; } while (0)
#define P5_QLOAD(BH, ENTRY, Q) do { const bf16_t* b_ = (const bf16_t*)(F.ws + WS_QMB) + (size_t)((BH) >> 3) * SEQ * QW + ((BH) & 7) * 64 + (size_t)((ENTRY) & 8191) * QW + hi * 8; \
        _Pragma("unroll") for (int d0 = 0; d0 < 4; ++d0) Q[d0] = *(const bf16x8*)(b_ + d0 * 16); } while (0)
    int u = F.bid, bh = 0, j = 0, c = 0, n = 0, buf = 0, bhn = 0, jn = 0, cn = 0, nn = 0;
    bool act = false, valid = false, actn = false, validn = false; int entry = 0, entryn = 0; bf16x8 qr[4] = {};
    if (u < total) {
        P5_UNIT(u, bh, j, c, n); P5_ENTRY(bh, j, c, n, act, valid, entry);
        if (u + F.G < total) { P5_UNIT(u + F.G, bhn, jn, cn, nn); P5_ENTRY(bhn, jn, cn, nn, actn, validn, entryn); }
        P5_QLOAD(bh, entry, qr); P5_DMA(bh, j, 0);
    }
    asm volatile("s_waitcnt vmcnt(0)" : "+v"(qr[0]), "+v"(qr[1]), "+v"(qr[2]), "+v"(qr[3]), "+v"(entry), "+v"(entryn) :: "memory");
    for (; u < total; u += F.G) {
        const bool has_next = u + F.G < total, has_n2 = u + 2 * F.G < total;
        int bh2 = 0, j2 = 0, c2 = 0, n2 = 0;
        if (has_n2) P5_UNIT(u + 2 * F.G, bh2, j2, c2, n2);
        const int h = bh & 7;
        const int qpos = entry & 8191, slot = entry >> 13;
        LDS_WAIT();
        __builtin_amdgcn_s_barrier();
        bool act2 = false, valid2 = false; int entry2 = 0; bf16x8 qn[4] = {};
        if (has_next) { P5_QLOAD(bhn, entryn, qn); P5_DMA(bhn, jn, buf ^ 1); }
        if (has_n2) P5_ENTRY(bh2, j2, c2, n2, act2, valid2, entry2);
        const LAS unsigned char* kimg = F.lds + buf * 65536; const LAS unsigned char* vimg = kimg + 32768;
        float m = -INFINITY, l = 0.f; f32x16 o[2];
        if (act) {
            if (hi == 0) ent[r32] = valid ? entry : -1;
            o[0] = f32x16{}; o[1] = f32x16{};
            const LAS float* lut = (const LAS float*)(F.lds + MISC_OFF + MO_LUT) + h * 132;
            const float bfar = lut[128];
#pragma unroll 1
            for (int st = 0; st < 4; ++st) {
                f32x16 t[2]; qkt64(t, kimg + st * 8192, qr, lane);
                const int kbase = j * 256 + st * 64;
                const bool far = __all(qpos - (kbase + 63) >= 128);
                if (far) {
#pragma unroll
                    for (int pp = 0; pp < 2; ++pp)
#pragma unroll
                        for (int r = 0; r < 16; ++r) t[pp][r] = t[pp][r] * LOG2E + bfar;
                } else {
#pragma unroll
                    for (int pp = 0; pp < 2; ++pp)
#pragma unroll
                        for (int r = 0; r < 16; ++r) { int d = qpos - (kbase + 32 * pp + crow(r, hi)); d = d < 128 ? d : 128; d = d > 0 ? d : 0; t[pp][r] = t[pp][r] * LOG2E + lut[d]; }
                }
                softmax_step(t, m, l, o, wsf, vimg + st * 8192, lane);
            }
        }
        asm volatile("s_waitcnt vmcnt(0)" : "+v"(qn[0]), "+v"(qn[1]), "+v"(qn[2]), "+v"(qn[3]), "+v"(entry2) :: "memory");
#pragma unroll
        for (int d0 = 0; d0 < 4; ++d0) qr[d0] = qn[d0];
        if (act) {
            l += __shfl_xor(l, 32);
            const float rl = 1.f / l;
            if (hi == 0) { wsf[r32] = rl; if (valid) ((float*)(F.ws + WS_PLSE))[((size_t)bh * SEQ + qpos) * 3 + slot] = m + __log2f(l); }
            LDS_WAIT();
            {
                LAS bf16_t* stg = (LAS bf16_t*)(F.lds + MISC_OFF + MO_STG + F.wave * 2048);
                bf16_t* po = (bf16_t*)(F.ws + WS_PO);
#pragma unroll
                for (int d0 = 0; d0 < 2; ++d0) {
#pragma unroll
                    for (int r = 0; r < 16; ++r) { const int q = crow(r, hi); stg[q * 32 + r32] = (bf16_t)(cvtpk(o[d0][r] * wsf[q], 0.f) & 0xffffu); }
                    LDS_WAIT();
#pragma unroll
                    for (int it2 = 0; it2 < 2; ++it2) { const int row = it2 * 16 + (lane >> 2), ch = lane & 3; const int en = ent[row];
                        const u32x4 v = *(const LAS u32x4*)(stg + row * 32 + ch * 8);
                        if (en >= 0) *(u32x4*)(po + (((size_t)bh * SEQ + (en & 8191)) * 3 + (en >> 13)) * 64 + d0 * 32 + ch * 8) = v; }
                    LDS_WAIT();
                }
            }
        }
        bh = bhn; j = jn; c = cn; n = nn; act = actn; valid = validn; entry = entryn;
        bhn = bh2; jn = j2; cn = c2; nn = n2; actn = act2; validn = valid2; entryn = entry2;
        buf ^= 1;
    }
#undef P5_ENTRY
#undef P5_QLOAD
#undef P5_UNIT
#undef P5_DMA
    asm volatile("s_waitcnt vmcnt(0)" ::: "memory");
    __syncthreads();
}
__device__ __forceinline__ void phase6(Ctx& F) {
    build_lut(F);
    LAS float* wsf = (LAS float*)(F.lds + MISC_OFF + MO_WSF) + F.wave * 128;
    const int lane = F.lane, r32 = lane & 31, hi = lane >> 5, w = F.wave;
#define P6_DMA(U, BUF) do { const int bh_ = (U) >> 5, i_ = 31 - ((U) & 31); const bf16_t* b_ = (const bf16_t*)(F.ws + WS_QMB) + (size_t)(bh_ >> 3) * SEQ * QW + (bh_ & 7) * 64; \
        kv_dma(F, b_ + 512 + (size_t)(i_ * 256) * QW, b_ + 1024 + (size_t)(i_ * 256) * QW, (BUF) * 65536); } while (0)
#define P6_QLOAD(U, Q, L0, L1, L2) do { const int bh_ = (U) >> 5, i_ = 31 - ((U) & 31), qp_ = i_ * 256 + w * 32 + r32, ns_ = i_ < 3 ? i_ : 3; \
        const bf16_t* b_ = (const bf16_t*)(F.ws + WS_QMB) + (size_t)(bh_ >> 3) * SEQ * QW + (bh_ & 7) * 64 + (size_t)qp_ * QW + hi * 8; \
        _Pragma("unroll") for (int d0 = 0; d0 < 4; ++d0) Q[d0] = *(const bf16x8*)(b_ + d0 * 16); \
        const float* pl_ = (const float*)(F.ws + WS_PLSE) + ((size_t)bh_ * SEQ + qp_) * 3; \
        L0 = -INFINITY; L1 = -INFINITY; L2 = -INFINITY; if (ns_ > 0) L0 = pl_[0]; if (ns_ > 1) L1 = pl_[1]; if (ns_ > 2) L2 = pl_[2]; } while (0)
    int buf = 0;
    bf16x8 qr[4] = {}; float ls0 = -INFINITY, ls1 = -INFINITY, ls2 = -INFINITY;
    if (F.bid < 32 * 32) { P6_QLOAD(F.bid, qr, ls0, ls1, ls2); P6_DMA(F.bid, 0); }
    asm volatile("s_waitcnt vmcnt(0)" : "+v"(qr[0]), "+v"(qr[1]), "+v"(qr[2]), "+v"(qr[3]), "+v"(ls0), "+v"(ls1), "+v"(ls2) :: "memory");
    for (int u = F.bid; u < 32 * 32; u += F.G) {
        const int bh = u >> 5, i = 31 - (u & 31), b = bh >> 3, h = bh & 7;
        const int ql = w * 32 + r32;
        const int nsel = i < 3 ? i : 3;
        const bool has_next = u + F.G < 32 * 32;
        LDS_WAIT();
        __builtin_amdgcn_s_barrier();
        if (has_next) P6_DMA(u + F.G, buf ^ 1);
        const LAS unsigned char* kimg = F.lds + buf * 65536; const LAS unsigned char* vimg = kimg + 32768;
        float m = -INFINITY, l = 0.f; f32x16 o[2]; o[0] = f32x16{}; o[1] = f32x16{};
        const LAS float* lut = (const LAS float*)(F.lds + MISC_OFF + MO_LUT) + h * 132;
        const int nst = (w >> 1) + 1;
#pragma unroll 1
        for (int st = 0; st < nst; ++st) {
            f32x16 t[2]; qkt64(t, kimg + st * 8192, qr, lane);
#pragma unroll
            for (int pp = 0; pp < 2; ++pp)
#pragma unroll
                for (int r = 0; r < 16; ++r) { const int d = ql - (st * 64 + 32 * pp + crow(r, hi)); const int dc = d < 128 ? (d > 0 ? d : 0) : 128; const float v = t[pp][r] * LOG2E + lut[dc]; t[pp][r] = d >= 0 ? v : -INFINITY; }
            softmax_step(t, m, l, o, wsf, vimg + st * 8192, lane);
        }
        l += __shfl_xor(l, 32);
        const float M = fmaxf(fmaxf(m, ls0), fmaxf(ls1, ls2));
        const float eo = __builtin_amdgcn_exp2f(m - M), e0 = __builtin_amdgcn_exp2f(ls0 - M), e1 = __builtin_amdgcn_exp2f(ls1 - M), e2 = __builtin_amdgcn_exp2f(ls2 - M);
        const float rden = 1.f / (l * eo + e0 + e1 + e2);
        if (hi == 0) *(LAS f32x4*)(wsf + 4 * r32) = (f32x4){eo * rden, e0 * rden, e1 * rden, e2 * rden};
        LDS_WAIT();
#pragma unroll
        for (int r = 0; r < 16; ++r) { const float fo = wsf[4 * crow(r, hi)]; o[0][r] *= fo; o[1][r] *= fo; }
        LDS_WAIT();
        __builtin_amdgcn_s_barrier();
        {
            const bf16_t* po = (const bf16_t*)(F.ws + WS_PO) + ((size_t)bh * SEQ + i * 256 + w * 32) * 3 * 64;
            u32x4 pv[4][3];
#pragma unroll
            for (int it4 = 0; it4 < 4; ++it4) { const int row = it4 * 8 + (lane >> 3), ch = lane & 7;
#pragma unroll
                for (int sl = 0; sl < 3; ++sl) { pv[it4][sl] = (u32x4){0u, 0u, 0u, 0u}; if (sl < nsel) pv[it4][sl] = *(const u32x4*)(po + (size_t)(row * 3 + sl) * 64 + ch * 8); } }
            bf16x8 qn[4] = {}; float ln0 = -INFINITY, ln1 = -INFINITY, ln2 = -INFINITY;
            if (has_next) P6_QLOAD(u + F.G, qn, ln0, ln1, ln2);
            LAS bf16_t* stg = (LAS bf16_t*)(F.lds + buf * 65536 + w * 4096);
#pragma unroll
            for (int r = 0; r < 16; ++r) { const int orow = crow(r, hi);
#pragma unroll
                for (int d0 = 0; d0 < 2; ++d0) stg[orow * 64 + d0 * 32 + r32] = (bf16_t)(cvtpk(o[d0][r], 0.f) & 0xffffu); }
            LDS_WAIT();
            asm volatile("s_waitcnt vmcnt(0)" : "+v"(qn[0]), "+v"(qn[1]), "+v"(qn[2]), "+v"(qn[3]), "+v"(ln0), "+v"(ln1), "+v"(ln2) :: "memory");
#pragma unroll
            for (int it4 = 0; it4 < 4; ++it4)
#pragma unroll
                for (int sl = 0; sl < 3; ++sl) asm volatile("" : "+v"(pv[it4][sl]));
            bf16_t* dst = (bf16_t*)(F.ws + WS_OB) + (size_t)(b * SEQ + i * 256 + w * 32) * 1024 + 512 + h * 64;
#pragma unroll
            for (int it4 = 0; it4 < 4; ++it4) { const int row = it4 * 8 + (lane >> 3), ch = lane & 7;
                const u32x4 ov = *(const LAS u32x4*)(stg + row * 64 + ch * 8);
                float a[8] = {bflo(ov.x), bfhi(ov.x), bflo(ov.y), bfhi(ov.y), bflo(ov.z), bfhi(ov.z), bflo(ov.w), bfhi(ov.w)};
                const f32x4 fc = *(const LAS f32x4*)(wsf + 4 * row);
#pragma unroll
                for (int sl = 0; sl < 3; ++sl) if (sl < nsel) { const u32x4 pvv = pv[it4][sl]; const float f = fc[1 + sl];
                    a[0] += f * bflo(pvv.x); a[1] += f * bfhi(pvv.x); a[2] += f * bflo(pvv.y); a[3] += f * bfhi(pvv.y); a[4] += f * bflo(pvv.z); a[5] += f * bfhi(pvv.z); a[6] += f * bflo(pvv.w); a[7] += f * bfhi(pvv.w); }
                u32x4 w4; w4.x = cvtpk(a[0], a[1]); w4.y = cvtpk(a[2], a[3]); w4.z = cvtpk(a[4], a[5]); w4.w = cvtpk(a[6], a[7]);
                *(u32x4*)(dst + (size_t)row * 1024 + ch * 8) = w4; }
            LDS_WAIT();
#pragma unroll
            for (int d0 = 0; d0 < 4; ++d0) qr[d0] = qn[d0];
            ls0 = ln0; ls1 = ln1; ls2 = ln2;
        }
        buf ^= 1;
    }
#undef P6_DMA
#undef P6_QLOAD
    asm volatile("s_waitcnt vmcnt(0)" ::: "memory");
    __syncthreads();
}

struct BranchSched {
    const char* A; const char* Bt; int G, c; int R[2], C[2];
    __device__ __forceinline__ bool next(int i, gm::UnitD& u) {
        int pm, pn; if (!gm::static_tile(MT, 1024, G, c, i, pm, pn)) return false;
        u.a = A; u.b = Bt + (size_t)(pn * 256) * 1024 * 2;
#pragma unroll
        for (int h = 0; h < 2; ++h)
#pragma unroll
            for (int j = 0; j < 2; ++j) u.va[h][j] = (unsigned)((pm * 256 + h * 128 + R[j]) * 1024 + C[j]) * 2u;
        u.e0 = pm; u.e1 = pn; u.e2 = 0; u.e3 = 0; return true;
    }
};
struct EpiBranch {
    const bf16_t* g; bf16_t* merged;
    static __device__ __forceinline__ float ratio(float gs, float gm_) { return (1.f + fminf(__expf(-gm_), 1e30f)) * __builtin_amdgcn_rcpf(1.f + __expf(-gs)); }
    __device__ __forceinline__ void mid(f32x4 (&acc)[2][2][4][2], const gm::UnitD& u, int wr, int wc, int fr, int fq) const {
        const bf16_t* gp = g + (size_t)(u.e0 * 256 + wr * 64 + fr) * 2048 + u.e1 * 256 + wc * 32 + 8 * fq;
#pragma unroll
        for (int ai = 0; ai < 2; ++ai)
#pragma unroll
            for (int m = 0; m < 4; m += 2) {
                asm volatile("" : "+v"(gp) :: "memory");
                u32x4 gs[2][2], gq[2][2];
#pragma unroll
                for (int mm = 0; mm < 2; ++mm)
#pragma unroll
                    for (int bj = 0; bj < 2; ++bj) { gs[mm][bj] = *(const u32x4*)(gp + (size_t)mm * 16 * 2048 + bj * 128); gq[mm][bj] = *(const u32x4*)(gp + (size_t)mm * 16 * 2048 + 1024 + bj * 128); }
#pragma unroll
                for (int mm = 0; mm < 2; ++mm)
#pragma unroll
                    for (int bj = 0; bj < 2; ++bj) { const u32x4 a = gs[mm][bj], b = gq[mm][bj];
                        f32x4& c0 = acc[ai][bj][m + mm][0]; f32x4& c1 = acc[ai][bj][m + mm][1];
                        c0[0] *= ratio(bflo(a.x), bflo(b.x)); c0[1] *= ratio(bfhi(a.x), bfhi(b.x)); c0[2] *= ratio(bflo(a.y), bflo(b.y)); c0[3] *= ratio(bfhi(a.y), bfhi(b.y));
                        c1[0] *= ratio(bflo(a.z), bflo(b.z)); c1[1] *= ratio(bfhi(a.z), bfhi(b.z)); c1[2] *= ratio(bflo(a.w), bflo(b.w)); c1[3] *= ratio(bfhi(a.w), bfhi(b.w));
                        asm volatile("" : "+v"(c0), "+v"(c1) :: "memory"); }
                gp += (m == 2 ? 96 : 32) * 2048; }
    }
    __device__ __forceinline__ void operator()(const f32x4 (&acc)[2][2][4][2], const gm::UnitD& u, int wr, int wc, int fr, int fq) const {
        const int row0 = u.e0 * 256 + wr * 64 + fr, col0 = u.e1 * 256 + wc * 32 + 8 * fq;
#pragma unroll
        for (int ai = 0; ai < 2; ++ai)
#pragma unroll
            for (int m = 0; m < 4; ++m) { const size_t row = (size_t)(row0 + ai * 128 + m * 16);
#pragma unroll
                for (int bj = 0; bj < 2; ++bj) { const u32x4 gm_ = *(const u32x4*)(g + row * 2048 + 1024 + col0 + bj * 128);
                    const float b[8] = {bflo(gm_.x), bfhi(gm_.x), bflo(gm_.y), bfhi(gm_.y), bflo(gm_.z), bfhi(gm_.z), bflo(gm_.w), bfhi(gm_.w)};
                    float r[8];
#pragma unroll
                    for (int j = 0; j < 8; ++j) r[j] = acc[ai][bj][m][j >> 2][j & 3] * __builtin_amdgcn_rcpf(1.f + fminf(__expf(-b[j]), 1e30f));
                    u32x4 w; w.x = cvtpk(r[0], r[1]); w.y = cvtpk(r[2], r[3]); w.z = cvtpk(r[4], r[5]); w.w = cvtpk(r[6], r[7]);
                    *(u32x4*)(merged + row * 1024 + col0 + bj * 128) = w; } }
    }
};
__device__ __forceinline__ void phase7(Ctx& F) {
    BranchSched S; S.A = (const char*)(F.ws + WS_OB); S.Bt = (const char*)(F.ws + WS_WBRT); S.G = F.G; S.c = F.bid; gm::stage_geom(F.tid, S.R, S.C);
    EpiBranch E{(const bf16_t*)(F.ws + WS_G), (bf16_t*)(F.ws + WS_MERGED)};
    gm::gemm_phase<true, true>(F.lds, 1024, S, E);
}
struct OutSched {
    const char* A; const char* Bt; int G, c; int R[2], C[2];
    __device__ __forceinline__ bool next(int i, gm::UnitD& u) {
        int pm, pn; if (!gm::static_tile(MT, 1024, G, c, i, pm, pn)) return false;
        u.a = A; u.b = Bt + (size_t)pn * 256 * 1024 * 2;
#pragma unroll
        for (int h = 0; h < 2; ++h)
#pragma unroll
            for (int j = 0; j < 2; ++j) u.va[h][j] = (unsigned)((pm * 256 + h * 128 + R[j]) * 1024 + C[j]) * 2u;
        u.e0 = pm; u.e1 = pn; u.e2 = 0; u.e3 = 0; return true;
    }
};
struct EpiOut {
    const float* x; const float* mod; bf16_t* out;
    __device__ __forceinline__ void operator()(const f32x4 (&acc)[2][2][4][2], const gm::UnitD& u, int wr, int wc, int fr, int fq) const {
        const int pm = u.e0, pn = u.e1, b = (pm * 256) / SEQ;
        const int row0 = pm * 256 + wr * 64 + fr, col0 = pn * 256 + wc * 32 + 4 * fq;
        f32x4 gt[2][2];
#pragma unroll
        for (int bj = 0; bj < 2; ++bj)
#pragma unroll
            for (int n = 0; n < 2; ++n) gt[bj][n] = *(const f32x4*)(mod + b * NMOD + 2 * DM + col0 + bj * 128 + n * 16);
#pragma unroll
        for (int ai = 0; ai < 2; ++ai)
#pragma unroll
            for (int m = 0; m < 4; ++m) { const size_t off = (size_t)(row0 + ai * 128 + m * 16) * DM + col0;
#pragma unroll
                for (int bj = 0; bj < 2; ++bj)
#pragma unroll
                    for (int n = 0; n < 2; ++n) { const f32x4 xv = *(const f32x4*)(x + off + bj * 128 + n * 16); const f32x4 r = xv + gt[bj][n] * acc[ai][bj][m][n];
                        u32x2 pk; pk.x = cvtpk(r.x, r.y); pk.y = cvtpk(r.z, r.w); *(u32x2*)(out + off + bj * 128 + n * 16) = pk; } }
    }
};
__device__ __forceinline__ void phase8(Ctx& F) {
    OutSched S; S.A = (const char*)(F.ws + WS_MERGED); S.Bt = (const char*)(F.ws + WS_WOUTT); S.G = F.G; S.c = F.bid; gm::stage_geom(F.tid, S.R, S.C);
    EpiOut E{inp(F, I_X), (const float*)(F.ws + WS_SMALL + SM_MOD), (bf16_t*)(F.ws + WS_X1B)};
    gm::gemm_phase<false>(F.lds, 1024, S, E);
}

constexpr int NR_SSQ = MO_PRE + 1024;
constexpr int NR_RS = MO_PRE + 3072;
__device__ __forceinline__ void phase_n2r(Ctx& F, int rr) {
    const bf16_t* x1 = (const bf16_t*)(F.ws + WS_X1B); const float* gvec = (const float*)(F.ws + WS_SMALL + SM_GVEC); const float* cb = (const float*)(F.ws + WS_SMALL + SM_CB);
    const float* mod = (const float*)(F.ws + WS_SMALL + SM_MOD); const float* rbias = inp(F, I_RB);
    unsigned char* H2 = (unsigned char*)(F.ws + WS_H2) + (size_t)rr * RT * DM; int* tokl = (int*)(F.ws + WS_TOKL) + (size_t)rr * 64 * RT; float* wl = (float*)(F.ws + WS_WL) + (size_t)rr * 64 * RT; int* tpos = (int*)(F.ws + WS_TPOS) + (size_t)rr * RT * 8;
    unsigned* cur = (unsigned*)(F.ws + WS_CTL) + CW_MOECUR + rr * 64;
    LAS int* lcnt = (LAS int*)(F.lds + MISC_OFF + MO_PRE); LAS int* lbase = lcnt + 64;
    LAS float* part = (LAS float*)(F.lds);
    LAS float* ssqp = (LAS float*)(F.lds + MISC_OFF + NR_SSQ); LAS float* rsl = (LAS float*)(F.lds + MISC_OFF + NR_RS);
    const int lane = F.lane, w = F.wave, i16 = lane & 15, kk = lane >> 4;
    for (int u = F.bid; u < RT / 64; u += F.G) {
        if (F.tid < 64) lcnt[F.tid] = 0;
        const int tokb = rr * RT + u * 64, b = tokb / SEQ;
        {
            bf16x8 fah[4][4], fal[4][4];
            {
                const float* gp = gvec + b * DM + 128 * w + 8 * kk;
                f32x4 gv[4][2];
#pragma unroll
                for (int s4 = 0; s4 < 4; ++s4) { gv[s4][0] = *(const f32x4*)(gp + 32 * s4); gv[s4][1] = *(const f32x4*)(gp + 32 * s4 + 4); }
#pragma unroll
                for (int tt = 0; tt < 4; ++tt) {
                    const bf16_t* xp = x1 + (size_t)(tokb + tt * 16 + i16) * DM + 128 * w + 8 * kk;
                    u32x4 xb[4];
#pragma unroll
                    for (int s4 = 0; s4 < 4; ++s4) xb[s4] = *(const u32x4*)(xp + 32 * s4);
                    float ssq = 0.f;
#pragma unroll
                    for (int s4 = 0; s4 < 4; ++s4) {
                        u32x4 ah, al;
#pragma unroll
                        for (int q = 0; q < 2; ++q) { const unsigned b0 = q ? xb[s4].z : xb[s4].x, b1 = q ? xb[s4].w : xb[s4].y; const f32x4 xv = (f32x4){bflo(b0), bfhi(b0), bflo(b1), bfhi(b1)}; ssq += (xv.x * xv.x + xv.y * xv.y) + (xv.z * xv.z + xv.w * xv.w);
                            const f32x4 a = xv * gv[s4][q];
                            const unsigned h0 = cvtpk(a.x, a.y), h1 = cvtpk(a.z, a.w);
                            ah[2 * q] = h0; ah[2 * q + 1] = h1; al[2 * q] = cvtpk(a.x - bflo(h0), a.y - bfhi(h0)); al[2 * q + 1] = cvtpk(a.z - bflo(h1), a.w - bfhi(h1)); }
                        fah[tt][s4] = __builtin_bit_cast(bf16x8, ah); fal[tt][s4] = __builtin_bit_cast(bf16x8, al);
                    }
                    ssq += __shfl_xor(ssq, 16); ssq += __shfl_xor(ssq, 32); if (kk == 0) ssqp[w * 64 + tt * 16 + i16] = ssq;
                }
            }
#pragma unroll 1
            for (int eh = 0; eh < 2; ++eh) {
                bf16x8 wh[2][4], wl_[2][4];
                {
                    const bf16_t* ph = (const bf16_t*)(F.ws + WS_SMALL + SM_WRH) + (size_t)(eh * 32 + i16) * DM + 128 * w + 8 * kk;
                    const bf16_t* pl = (const bf16_t*)(F.ws + WS_SMALL + SM_WRL) + (size_t)(eh * 32 + i16) * DM + 128 * w + 8 * kk;
#pragma unroll
                    for (int c = 0; c < 2; ++c)
#pragma unroll
                        for (int s4 = 0; s4 < 4; ++s4) { wh[c][s4] = *(const bf16x8*)(ph + (size_t)c * 16 * DM + 32 * s4); wl_[c][s4] = *(const bf16x8*)(pl + (size_t)c * 16 * DM + 32 * s4); }
                }
#pragma unroll
                for (int tt = 0; tt < 4; ++tt) {
                    f32x4 acc[2]; acc[0] = acc[1] = (f32x4){0.f, 0.f, 0.f, 0.f};
#pragma unroll
                    for (int s4 = 0; s4 < 4; ++s4)
#pragma unroll
                        for (int c = 0; c < 2; ++c) {
                            acc[c] = __builtin_amdgcn_mfma_f32_16x16x32_bf16(fal[tt][s4], wh[c][s4], acc[c], 0, 0, 0);
                            acc[c] = __builtin_amdgcn_mfma_f32_16x16x32_bf16(fah[tt][s4], wl_[c][s4], acc[c], 0, 0, 0);
                            acc[c] = __builtin_amdgcn_mfma_f32_16x16x32_bf16(fah[tt][s4], wh[c][s4], acc[c], 0, 0, 0); }
#pragma unroll
                    for (int c = 0; c < 2; ++c)
#pragma unroll
                        for (int reg = 0; reg < 4; ++reg) part[(w * 64 + tt * 16 + 4 * kk + reg) * 64 + eh * 32 + 16 * c + i16] = acc[c][reg];
                }
            }
        }
        __syncthreads();
        const int tl = F.tid >> 3, g = F.tid & 7;
        int my_e; float my_w; int my_rank;
        {
            float ssq = 0.f;
#pragma unroll
            for (int q = 0; q < 8; ++q) ssq += ssqp[q * 64 + tl];
            const float rstd = rsqrtf(ssq * (1.f / DM) + EPS);
            if (g == 0) rsl[tl] = rstd;
            float s8[8], c8[8];
            {
                f32x4 lo4 = (f32x4){0.f, 0.f, 0.f, 0.f}, hi4 = lo4;
#pragma unroll
                for (int q = 0; q < 8; ++q) { const LAS f32x4* pp = (const LAS f32x4*)(part + (q * 64 + tl) * 64 + 8 * g); lo4 += pp[0]; hi4 += pp[1]; }
                const f32x4 cb0 = *(const f32x4*)(cb + b * 64 + 8 * g), cb1 = *(const f32x4*)(cb + b * 64 + 8 * g + 4), rb0 = *(const f32x4*)(rbias + 8 * g), rb1 = *(const f32x4*)(rbias + 8 * g + 4);
#pragma unroll
                for (int j = 0; j < 4; ++j) { s8[j] = sigmoidf_(lo4[j] * rstd + cb0[j]); s8[4 + j] = sigmoidf_(hi4[j] * rstd + cb1[j]); c8[j] = s8[j] + rb0[j]; c8[4 + j] = s8[4 + j] + rb1[j]; }
            }
            float m1 = -INFINITY, m2 = -INFINITY;
#pragma unroll
            for (int j = 0; j < 8; ++j) { const float v = c8[j]; if (v > m1) { m2 = m1; m1 = v; } else if (v > m2) m2 = v; }
            const float gs = m1 + m2;
            int rank = 0;
#pragma unroll
            for (int g2 = 0; g2 < 8; ++g2) { const float o = __shfl(gs, g2, 8); rank += (o > gs || (o == gs && g2 < g)) ? 1 : 0; }
            if (rank >= 4) {
#pragma unroll
                for (int j = 0; j < 8; ++j) c8[j] = -INFINITY;
            }
            int sel_e[8]; float sk[8]; float wsum = 0.f;
#pragma unroll
            for (int k = 0; k < 8; ++k) {
                float bv = -INFINITY, bs = 0.f; int be = 8 * g;
#pragma unroll
                for (int j = 0; j < 8; ++j) if (c8[j] > bv) { bv = c8[j]; be = 8 * g + j; bs = s8[j]; }
#pragma unroll
                for (int o = 1; o < 8; o <<= 1) { const float ov = __shfl_xor(bv, o, 8), os = __shfl_xor(bs, o, 8); const int oe = __shfl_xor(be, o, 8); if (ov > bv || (ov == bv && oe < be)) { bv = ov; be = oe; bs = os; } }
                sel_e[k] = be; sk[k] = bs; wsum += bs;
#pragma unroll
                for (int j = 0; j < 8; ++j) if (be == 8 * g + j) c8[j] = -INFINITY;
            }
            my_e = sel_e[0]; my_w = sk[0];
#pragma unroll
            for (int k = 1; k < 8; ++k) if (g == k) { my_e = sel_e[k]; my_w = sk[k]; }
            my_w *= 2.5f / wsum;
            my_rank = lds_add(&lcnt[my_e], 1);
        }
        __syncthreads();
        if (F.tid < 64) { const int n = lcnt[F.tid]; lbase[F.tid] = n > 0 ? (int)atomicAdd(&cur[F.tid], (unsigned)n) : 0; }
        __syncthreads();
        { const int tok = tokb + tl, pos = lbase[my_e] + my_rank; tokl[my_e * RT + pos] = tok * 8 + g; wl[my_e * RT + pos] = my_w; tpos[(tok - rr * RT) * 8 + g] = (my_e << 16) | pos; }
#pragma unroll 1
        for (int r0 = 0; r0 < 8; r0 += 4) {
            f32x4 xv[4][4];
#pragma unroll
            for (int r = 0; r < 4; ++r) { const u32x2* xr = (const u32x2*)(x1 + (size_t)(tokb + w * 8 + r0 + r) * DM) + lane;
#pragma unroll
                for (int j = 0; j < 4; ++j) { const u32x2 q = xr[64 * j]; xv[r][j] = (f32x4){bflo(q.x), bfhi(q.x), bflo(q.y), bfhi(q.y)}; } }
#pragma unroll
            for (int j = 0; j < 4; ++j) { const int col = 4 * lane + 256 * j; const f32x4 gq = *(const f32x4*)(gvec + b * DM + col), sh = *(const f32x4*)(mod + b * NMOD + 3 * DM + col);
#pragma unroll
                for (int r = 0; r < 4; ++r) { const int tl2 = w * 8 + r0 + r; const f32x4 hv = (xv[r][j] * rsl[tl2]) * gq + sh;
                    int o = 0; o = __builtin_amdgcn_cvt_pk_fp8_f32(f8c(hv.x * 16.f), f8c(hv.y * 16.f), o, false); o = __builtin_amdgcn_cvt_pk_fp8_f32(f8c(hv.z * 16.f), f8c(hv.w * 16.f), o, true);
                    ((unsigned*)(H2 + (size_t)(tokb - rr * RT + tl2) * DM) + lane)[64 * j] = (unsigned)o; } }
        }
        __syncthreads();
    }
}
constexpr int MO_TE = 4224;
struct MoeTabs { const LAS unsigned short* te; const LAS int* tb; const LAS int* cnt; int TR; };
__device__ __forceinline__ MoeTabs build_moe_tabs(Ctx& F, int rr) {
    LAS unsigned short* te = (LAS unsigned short*)(F.lds + MISC_OFF + MO_TE); LAS int* tb = (LAS int*)(F.lds + MISC_OFF + MO_TE + 1536); LAS int* cnt = tb + 72;
    const unsigned* cur = (const unsigned*)(F.ws + WS_CTL) + CW_MOECUR + rr * 64;
    __syncthreads();
    if (F.tid == 0) { int acc = 0; for (int e = 0; e < 64; ++e) { const int c = (int)cur[e]; cnt[e] = c; tb[e] = acc; acc += (c + 255) >> 8; } tb[64] = acc; tb[65] = acc + RT / 256; cnt[64] = RT; }
    __syncthreads();
    const int TR = tb[64];
    for (int e = F.tid >> 3; e < 65; e += 64) for (int t = tb[e] + (F.tid & 7); t < tb[e + 1]; t += 8) te[t] = (unsigned short)e;
    __syncthreads();
    MoeTabs T; T.te = te; T.tb = tb; T.cnt = cnt; T.TR = TR; return T;
}
struct Moe1Sched {
    const char* H2; const char* W1T; const int* tokl; MoeTabs T; int G, c, rr; int R[2], C[2];
    __device__ __forceinline__ bool next(int i, gm::UnitD& u) {
        const int uu = i * G + c; const int nt = T.TR + RT / 256;
        if (uu >= nt * 2) return false;
        const int tile = uu >> 1, pn = uu & 1, e = T.te[tile], rt = tile - T.tb[e], cnt = T.cnt[e];
        u.a = H2; u.b = W1T + (size_t)(e * 512 + pn * 256) * 1024;
#pragma unroll
        for (int h = 0; h < 2; ++h)
#pragma unroll
            for (int j = 0; j < 2; ++j) { const int idx = rt * 256 + h * 128 + R[j]; int trow;
                if (e < 64) { const int ent = tokl[e * RT + (idx < cnt ? idx : rt * 256)]; trow = (ent >> 3) - rr * RT; } else trow = idx;
                u.va[h][j] = (unsigned)(trow * 512 + C[j]) * 2u; }
        u.e0 = tile; u.e1 = pn; u.e2 = e; u.e3 = rt; return true;
    }
};
struct EpiMoe1 {
    bf16_t* act; const float* wl; const LAS int* cnt;
    __device__ __forceinline__ void operator()(const f32x4 (&acc)[2][2][4][2], const gm::UnitD& u, int wr, int wc, int fr, int fq) const {
        const int row0 = u.e0 * 256 + wr * 64 + fr, col0 = u.e1 * 128 + wc * 32 + 8 * fq, e = u.e2, n = cnt[e];
        float rw[2][4];
#pragma unroll
        for (int ai = 0; ai < 2; ++ai)
#pragma unroll
            for (int m = 0; m < 4; ++m) { const int idx = u.e3 * 256 + ai * 128 + wr * 64 + m * 16 + fr; rw[ai][m] = e < 64 ? (idx < n ? wl[e * RT + idx] : 0.f) : 1.f; }
#pragma unroll
        for (int ai = 0; ai < 2; ++ai)
#pragma unroll
            for (int m = 0; m < 4; ++m) { const float ww = rw[ai][m] * (32.f / 4096.f); const f32x4 g0 = acc[ai][0][m][0] * (1.f / 4096.f), g1 = acc[ai][0][m][1] * (1.f / 4096.f), u0 = acc[ai][1][m][0] * ww, u1 = acc[ai][1][m][1] * ww;
                int w0 = 0, w1 = 0;
                w0 = __builtin_amdgcn_cvt_pk_fp8_f32(f8c(siluf_(g0[0]) * u0[0]), f8c(siluf_(g0[1]) * u0[1]), w0, false); w0 = __builtin_amdgcn_cvt_pk_fp8_f32(f8c(siluf_(g0[2]) * u0[2]), f8c(siluf_(g0[3]) * u0[3]), w0, true);
                w1 = __builtin_amdgcn_cvt_pk_fp8_f32(f8c(siluf_(g1[0]) * u1[0]), f8c(siluf_(g1[1]) * u1[1]), w1, false); w1 = __builtin_amdgcn_cvt_pk_fp8_f32(f8c(siluf_(g1[2]) * u1[2]), f8c(siluf_(g1[3]) * u1[3]), w1, true);
                *(u32x2*)((unsigned char*)act + (size_t)(row0 + ai * 128 + m * 16) * 256 + col0) = (u32x2){(unsigned)w0, (unsigned)w1}; }
    }
};
__device__ __forceinline__ void phase_moe1(Ctx& F, int rr) {
    Moe1Sched S; S.T = build_moe_tabs(F, rr); S.H2 = (const char*)(F.ws + WS_H2) + (size_t)rr * RT * DM; S.W1T = (const char*)(F.ws + WS_W1T); S.tokl = (const int*)(F.ws + WS_TOKL) + (size_t)rr * 64 * RT; S.G = F.G; S.c = (F.G % 8 == 0) ? (F.bid % 8) * (F.G / 8) + F.bid / 8 : F.bid; S.rr = rr; gm::stage_geom(F.tid, S.R, S.C);
    EpiMoe1 E{(bf16_t*)(F.ws + WS_ACT), (const float*)(F.ws + WS_WL) + (size_t)rr * 64 * RT, S.T.cnt};
    gm::gemm_phase<true, false, true>(F.lds, 512, S, E);
}
struct Moe2Sched {
    const char* ACT; const char* W2T; MoeTabs T; int G, c; int R[2], C[2];
    __device__ __forceinline__ bool next(int i, gm::UnitD& u) {
        const int uu = i * G + c; const int nt = T.TR + RT / 256;
        if (uu >= nt * 4) return false;
        const int tile = uu >> 2, pn = uu & 3, e = T.te[tile], rt = tile - T.tb[e];
        u.a = ACT + (size_t)tile * 256 * 256; u.b = W2T + (size_t)(e * 1024 + pn * 256) * 256;
#pragma unroll
        for (int h = 0; h < 2; ++h)
#pragma unroll
            for (int j = 0; j < 2; ++j) u.va[h][j] = (unsigned)((h * 128 + R[j]) * 128 + C[j]) * 2u;
        u.e0 = pn; u.e1 = e; u.e2 = rt; u.e3 = tile; return true;
    }
};
struct EpiMoe2 {
    bf16_t* slots; bf16_t* shout; const LAS int* cnt;
    __device__ __forceinline__ void operator()(const f32x4 (&acc)[2][2][4][2], const gm::UnitD& u, int wr, int wc, int fr, int fq) const {
        const int pn = u.e0, e = u.e1, rt = u.e2, tile = u.e3;
        const int col0 = pn * 256 + wc * 32 + 8 * fq, n = cnt[e];
        if (e < 64) {
            unsigned char* base = (unsigned char*)slots + (size_t)(tile * 256 + wr * 64 + fr) * 1024 + col0;
#pragma unroll
            for (int ai = 0; ai < 2; ++ai)
#pragma unroll
                for (int m = 0; m < 4; ++m) {
                    if (rt * 256 + ai * 128 + wr * 64 + m * 16 + fr < n) {
#pragma unroll
                        for (int bj = 0; bj < 2; ++bj) { f32x4 v0 = acc[ai][bj][m][0] * (16.f / 4096.f), v1 = acc[ai][bj][m][1] * (16.f / 4096.f);
#pragma unroll
                            for (int j = 0; j < 4; ++j) { v0[j] = __builtin_amdgcn_fmed3f(v0[j], -440.f, 440.f); v1[j] = __builtin_amdgcn_fmed3f(v1[j], -440.f, 440.f); }
                            int w0 = 0, w1 = 0;
                            w0 = __builtin_amdgcn_cvt_pk_fp8_f32(v0[0], v0[1], w0, false); w0 = __builtin_amdgcn_cvt_pk_fp8_f32(v0[2], v0[3], w0, true);
                            w1 = __builtin_amdgcn_cvt_pk_fp8_f32(v1[0], v1[1], w1, false); w1 = __builtin_amdgcn_cvt_pk_fp8_f32(v1[2], v1[3], w1, true);
                            *(u32x2*)(base + (size_t)(ai * 128 + m * 16) * 1024 + bj * 128) = (u32x2){(unsigned)w0, (unsigned)w1}; } } }
        } else {
            bf16_t* base = shout + (size_t)(rt * 256 + wr * 64 + fr) * 1024 + col0;
#pragma unroll
            for (int ai = 0; ai < 2; ++ai)
#pragma unroll
                for (int m = 0; m < 4; ++m)
#pragma unroll
                    for (int bj = 0; bj < 2; ++bj) { const f32x4 v0 = acc[ai][bj][m][0] * (1.f / 4096.f), v1 = acc[ai][bj][m][1] * (1.f / 4096.f);
                        u32x4 o; o.x = cvtpk(v0[0], v0[1]); o.y = cvtpk(v0[2], v0[3]); o.z = cvtpk(v1[0], v1[1]); o.w = cvtpk(v1[2], v1[3]); *(u32x4*)(base + (size_t)(ai * 128 + m * 16) * 1024 + bj * 128) = o; }
        }
    }
};
__device__ __forceinline__ void phase_moe2(Ctx& F, int rr) {
    Moe2Sched S; S.T = build_moe_tabs(F, rr); S.ACT = (const char*)(F.ws + WS_ACT); S.W2T = (const char*)(F.ws + WS_W2T); S.G = F.G; S.c = (F.G % 8 == 0) ? (F.bid % 8) * (F.G / 8) + F.bid / 8 : F.bid; gm::stage_geom(F.tid, S.R, S.C);
    EpiMoe2 E{(bf16_t*)(F.ws + WS_SLOTS), (bf16_t*)(F.ws + WS_SHOUT), S.T.cnt};
    gm::gemm_phase<true, false, true>(F.lds, 128, S, E);
}
__device__ __forceinline__ void phase_final(Ctx& F, int rr) {
    const MoeTabs T = build_moe_tabs(F, rr);
    const float* mod = (const float*)(F.ws + WS_SMALL + SM_MOD); const float* fg = inp(F, I_FG);
    const unsigned char* slots = (const unsigned char*)(F.ws + WS_SLOTS); const int* tpos = (const int*)(F.ws + WS_TPOS) + (size_t)rr * RT * 8;
    const int gw = F.bid * 8 + F.wave, NGW = F.G * 8, c0 = F.lane * 8;
    for (int t = gw; t < RT; t += NGW) {
        const int tok = rr * RT + t, b = tok / SEQ;
        const unsigned char* rp[8];
#pragma unroll
        for (int k = 0; k < 8; ++k) { const int v = tpos[t * 8 + k]; rp[k] = slots + (size_t)(T.tb[v >> 16] * 256 + (v & 0xffff)) * 1024 + c0; }
        float* orow = F.out + (size_t)tok * DM + c0;
        u32x2 sv[8][2]; u32x4 sh[2]; f32x4 xv[2][2];
#pragma unroll
        for (int k = 0; k < 8; ++k) { sv[k][0] = *(const u32x2*)(rp[k]); sv[k][1] = *(const u32x2*)(rp[k] + 512); }
        { const bf16_t* sp = (const bf16_t*)(F.ws + WS_SHOUT) + (size_t)t * 1024 + c0; sh[0] = *(const u32x4*)sp; sh[1] = *(const u32x4*)(sp + 512); }
#pragma unroll
        for (int h = 0; h < 2; ++h) { const u32x4 q = *(const u32x4*)((const bf16_t*)(F.ws + WS_X1B) + (size_t)tok * DM + c0 + h * 512);
            xv[h][0] = (f32x4){bflo(q.x), bfhi(q.x), bflo(q.y), bfhi(q.y)}; xv[h][1] = (f32x4){bflo(q.z), bfhi(q.z), bflo(q.w), bfhi(q.w)}; }
        float s = 0.f; f32x4 v[2][2];
#pragma unroll
        for (int h = 0; h < 2; ++h) {
            f32x4 a0 = (f32x4){0.f, 0.f, 0.f, 0.f}, a1 = a0;
#pragma unroll
            for (int k = 0; k < 8; ++k) { const u32x2 w = sv[k][h];
                const f32x2 p0 = __builtin_amdgcn_cvt_pk_f32_fp8((int)w.x, false), p1 = __builtin_amdgcn_cvt_pk_f32_fp8((int)w.x, true), p2 = __builtin_amdgcn_cvt_pk_f32_fp8((int)w.y, false), p3 = __builtin_amdgcn_cvt_pk_f32_fp8((int)w.y, true);
                a0 += (f32x4){p0.x, p0.y, p1.x, p1.y}; a1 += (f32x4){p2.x, p2.y, p3.x, p3.y}; }
            { const u32x4 w = sh[h]; a0 = a0 * 0.0625f + (f32x4){bflo(w.x), bfhi(w.x), bflo(w.y), bfhi(w.y)}; a1 = a1 * 0.0625f + (f32x4){bflo(w.z), bfhi(w.z), bflo(w.w), bfhi(w.w)}; }
            const float* g2 = mod + b * NMOD + 5 * DM + c0 + h * 512;
            v[h][0] = xv[h][0] + *(const f32x4*)g2 * a0; v[h][1] = xv[h][1] + *(const f32x4*)(g2 + 4) * a1;
#pragma unroll
            for (int q = 0; q < 2; ++q) s += (v[h][q].x * v[h][q].x + v[h][q].y * v[h][q].y) + (v[h][q].z * v[h][q].z + v[h][q].w * v[h][q].w);
        }
        const float rstd = rsqrtf(wave_sum(s) * (1.f / DM) + EPS);
#pragma unroll
        for (int h = 0; h < 2; ++h)
#pragma unroll
            for (int q = 0; q < 2; ++q) { const f32x4 g = *(const f32x4*)(fg + c0 + h * 512 + 4 * q); *(f32x4*)(orow + h * 512 + 4 * q) = (v[h][q] * rstd) * g; }
    }
}

constexpr int N_PHASES = 10;
__global__ void __launch_bounds__(512, 2) mega_fwd(Args args) {
    extern __shared__ __attribute__((aligned(16))) unsigned char lds_raw[];
    Ctx F; F.lds = (LAS unsigned char*)lds_raw; F.ws = args.ws; F.out = args.out;
    {
        typedef __attribute__((address_space(4))) const unsigned long long* karg_t;
        const karg_t ka = (karg_t)__builtin_amdgcn_kernarg_segment_ptr();
        LAS unsigned long long* tab = (LAS unsigned long long*)(lds_raw + MISC_OFF + 14336);
        if (threadIdx.x < 20) tab[threadIdx.x] = ka[threadIdx.x];
        F.intab = tab;
    }
    F.tid = threadIdx.x; F.lane = F.tid & 63; F.wave = __builtin_amdgcn_readfirstlane(F.tid >> 6); F.G = gridDim.x; F.bid = blockIdx.x;
    volatile LAS unsigned* st = (volatile LAS unsigned*)(F.lds + MISC_OFF + MO_ST);
    if (F.tid < 4) st[F.tid] = 0u;
    __syncthreads();
    XcdBarrier bar = xcd_barrier_post((unsigned*)(F.ws + WS_CTL) + CW_BAR, st);
    if (threadIdx.x == 0) { unsigned nloc, nx; xcd_barrier_complete(bar.bar, bar.x, nloc, nx); st[0] = nloc; st[1] = nx; }
    int lo = args.ph_lo, hi = args.ph_hi;
    { int a = lo, b = hi; asm volatile("" : "+v"(a), "+v"(b)); lo = __builtin_amdgcn_readfirstlane(a); hi = __builtin_amdgcn_readfirstlane(b); }
    launder(F);
#ifndef PH_MASK
#define PH_MASK 0x1ffff
#endif
#define PH_ON(k) ((PH_MASK >> (k)) & 1)
#define IN(k) (lo <= (k) && (k) < hi)
#define SEAM(k) do { if (IN(k) && IN((k) + 1)) { bar.bar = launder_ptr(bar.bar); xcd_barrier(bar); } } while (0)
#define RUN(k, call) do { if (PH_ON(k) && IN(k)) { launder(F); call; } } while (0)
    RUN(0, phase0(F)); SEAM(0);
    RUN(1, phase1(F)); SEAM(1);
    RUN(2, phase2(F)); SEAM(2);
    RUN(4, (phase4(F), sb_units(F))); SEAM(4);
    RUN(5, phase5(F)); SEAM(5);
    RUN(6, phase6(F)); SEAM(6);
    RUN(7, phase7(F)); SEAM(7);
    RUN(8, phase8(F)); SEAM(8);
    if (PH_ON(9) && IN(9)) {
        const int par = (F.bid >> 3) & 1;
#pragma unroll 1
        for (int i = 0; i < 8; ++i) {
            launder(F);
            int op, rr; bool bar_after = true;
            switch (i) {
                case 0: op = 0; rr = 0; break;
                case 1: op = 1; rr = 0; break;
                case 2: op = par ? 0 : 2; rr = par ? 1 : 0; bar_after = false; break;
                case 3: op = par ? 2 : 0; rr = par ? 0 : 1; break;
                case 4: op = par ? 1 : 3; rr = par ? 1 : 0; bar_after = false; break;
                case 5: op = par ? 3 : 1; rr = par ? 0 : 1; break;
                case 6: op = 2; rr = 1; break;
                default: op = 3; rr = 1; bar_after = false; break;
            }
            switch (op) {
                case 0: launder(F); phase_n2r(F, rr); break;
                case 1: launder(F); phase_moe1(F, rr); break;
                case 2: launder(F); phase_moe2(F, rr); break;
                default: launder(F); phase_final(F, rr); break;
            }
            if (bar_after) { bar.bar = launder_ptr(bar.bar); xcd_barrier(bar); } else __syncthreads();
        }
    }
#undef IN
#undef SEAM
#undef RUN
}

#ifndef MK_SPLIT
#define MK_SPLIT 0
#endif
extern "C" void kernel_launch(void* const* d_in, const int* in_sizes, int n_in, void* d_out, int out_size, void* d_ws, size_t ws_size, hipStream_t stream) {
    static int grid = 0;
    if (grid == 0) {
        if (n_in != 20 || in_sizes[0] != MT * DM || out_size != MT * DM || ws_size < WS_END) { fprintf(stderr, "kernel_launch: unexpected shapes (n_in %d, in0 %d, out %d, ws %zu)\n", n_in, n_in > 0 ? in_sizes[0] : -1, out_size, ws_size); grid = -1; return; }
        int dev = 0, cus = 0;
        if (hipGetDevice(&dev) != hipSuccess || hipDeviceGetAttribute(&cus, hipDeviceAttributeMultiprocessorCount, dev) != hipSuccess) { grid = -1; return; }
        if (hipFuncSetAttribute((const void*)mega_fwd, hipFuncAttributeMaxDynamicSharedMemorySize, LDS_BYTES) != hipSuccess) { fprintf(stderr, "kernel_launch: hipFuncSetAttribute failed\n"); grid = -1; return; }
        int per_cu = 0;
        if (hipOccupancyMaxActiveBlocksPerMultiprocessor(&per_cu, (const void*)mega_fwd, 512, LDS_BYTES) != hipSuccess || per_cu < 1) fprintf(stderr, "kernel_launch: occupancy query reports %d\n", per_cu);
        (void)hipGetLastError();
        grid = cus;
    }
    if (grid < 0) return;
    (void)hipMemsetAsync((char*)d_ws + WS_CTL, 0, CTL_BYTES, stream);
    Args a{};
    for (int i = 0; i < 20; ++i) a.in[i] = (const float*)d_in[i];
    a.out = (float*)d_out; a.ws = (unsigned char*)d_ws;
#if MK_SPLIT
    for (int p = 0; p < N_PHASES; ++p) { a.ph_lo = p; a.ph_hi = p + 1; hipLaunchKernelGGL(mega_fwd, dim3(grid), dim3(512), LDS_BYTES, stream, a); }
#else
    a.ph_lo = 0; a.ph_hi = N_PHASES;
    hipLaunchKernelGGL(mega_fwd, dim3(grid), dim3(512), LDS_BYTES, stream, a);
#endif
}
```

```cpp
#include <hip/hip_runtime.h>
#include <cstdio>
#include <cstdint>

#define LAS __attribute__((address_space(3)))
#define GAS __attribute__((address_space(1)))
typedef unsigned short bf16_t;
typedef short bf16x8 __attribute__((ext_vector_type(8)));
typedef short s16x4 __attribute__((ext_vector_type(4)));
typedef float f32x4 __attribute__((ext_vector_type(4)));
typedef float f32x16 __attribute__((ext_vector_type(16)));
typedef float f32x2 __attribute__((ext_vector_type(2)));
typedef unsigned u32x4 __attribute__((ext_vector_type(4)));
typedef unsigned u32x2 __attribute__((ext_vector_type(2)));
typedef __bf16 bf16x2_t __attribute__((ext_vector_type(2)));

__device__ __forceinline__ unsigned cvtpk(float lo, float hi) { f32x2 v = {lo, hi}; bf16x2_t b = __builtin_convertvector(v, bf16x2_t); return __builtin_bit_cast(unsigned, b); }
__device__ __forceinline__ float bf2f(unsigned short u) { return __uint_as_float(((unsigned)u) << 16); }
__device__ __forceinline__ float bflo(unsigned u) { return __uint_as_float(u << 16); }
__device__ __forceinline__ float bfhi(unsigned u) { return __uint_as_float(u & 0xffff0000u); }

constexpr int NB = 4, SEQ = 8192, DM = 1024, MT = NB * SEQ;
constexpr int NHEAD = 8, HD = 64, QW = 1536;
constexpr int NE = 64, EFF = 256, NMOD = 6 * DM;
constexpr int RT = MT / 2;
constexpr float EPS = 1e-6f;
constexpr float LOG2E = 1.4426950408889634f;

constexpr size_t MiB = 1u << 20;
constexpr size_t WS_CTL = 0, CTL_BYTES = 1 * MiB;
constexpr size_t WS_SMALL = 1 * MiB;
constexpr size_t SM_MOD = 0, SM_GVEC = 98304, SM_CB = 114688, SM_KBAR = 131072, SM_WRH = 393216, SM_WRL = 524288;
constexpr size_t WS_W2T = 2 * MiB;
constexpr size_t WS_W1T = 35 * MiB;
constexpr size_t WS_WIN8 = 19 * MiB;
constexpr size_t WS_H8 = 68 * MiB;
constexpr size_t WS_WINT = 100 * MiB;
constexpr size_t WS_WBRT = 110 * MiB;
constexpr size_t WS_WOUTT = 112 * MiB;
constexpr size_t WS_H = 114 * MiB;
constexpr size_t WS_OB = 114 * MiB;
constexpr size_t WS_QSB = 178 * MiB;
constexpr size_t WS_PO = 178 * MiB;
constexpr size_t WS_QMB = 274 * MiB;
constexpr size_t WS_MERGED = 274 * MiB;
constexpr size_t WS_G = 370 * MiB;
constexpr size_t WS_LMB = 498 * MiB;
constexpr size_t WS_PLSE = 506 * MiB;
constexpr size_t WS_H2 = 100 * MiB;
constexpr size_t WS_TOKL = 164 * MiB;
constexpr size_t WS_WL = 172 * MiB;
constexpr size_t WS_TPOS = 180 * MiB;
constexpr size_t WS_ACT = 184 * MiB;
constexpr size_t WS_SLOTS = 264 * MiB;
constexpr size_t WS_SHOUT = 408 * MiB;
constexpr size_t WS_X1B = 440 * MiB;
constexpr size_t WS_END = 509 * MiB;
constexpr int CW_MBCUR = 0;
constexpr int CW_MOECUR = 1024;
constexpr int CW_BAR = 4096;
constexpr size_t CTL_KBS = 512 * 1024;

constexpr int RING_BYTES = 131072;
constexpr int MISC_OFF = RING_BYTES;
constexpr int LDS_BYTES = 163840;
constexpr int MO_STG = 16384;

#define XB_TMO      128
#define XB_XCNT(j)  (256  + 64 * (j))
#define XB_XSUB(j)  (1280 + 64 * (j))
#define XB_XGEN(j)  (2304 + 64 * (j))
#define XB_TOP      3328
#define XB_TOPGEN   3392
#define XCD_BAR_WORDS 3456
#define XB_SPIN_CAP (1u << 18)
__device__ __forceinline__ unsigned xb_ld(unsigned* p)              { return __hip_atomic_load(p, __ATOMIC_RELAXED, __HIP_MEMORY_SCOPE_AGENT); }
__device__ __forceinline__ unsigned xb_add(unsigned* p, unsigned v) { return __hip_atomic_fetch_add(p, v, __ATOMIC_RELAXED, __HIP_MEMORY_SCOPE_AGENT); }
__device__ __forceinline__ unsigned xb_xcc_id() { return (unsigned)__builtin_amdgcn_s_getreg((3 << 11) | 20) & 0xFu; }
#define XB_SPIN(cond, bar) do { unsigned _sp = 0; while (cond) { __builtin_amdgcn_s_sleep(1); \
    if ((++_sp & 255u) == 0u) { if (xb_ld(&(bar)[XB_TMO])) break; if (_sp > XB_SPIN_CAP) { atomicAdd(&(bar)[XB_TMO], 1u); break; } } } } while (0)
struct XcdBarrier { unsigned* bar; unsigned x; volatile LAS unsigned* st; };
__device__ __forceinline__ XcdBarrier xcd_barrier_post(unsigned* bar, volatile LAS unsigned* st) {
    XcdBarrier b; b.bar = bar; b.x = xb_xcc_id(); b.st = st;
    if (threadIdx.x == 0) (void)xb_add(&bar[XB_XCNT(b.x)], 1u);
    return b;
}
__device__ __forceinline__ void xcd_barrier_complete(unsigned* bar, unsigned x, unsigned& nloc, unsigned& nx) {
    const unsigned G = gridDim.x * gridDim.y * gridDim.z;
    unsigned sum, cnt, mine, sp = 0u;
    for (;;) {
        sum = 0u; cnt = 0u; mine = 0u;
#pragma unroll
        for (unsigned j = 0; j < 16; ++j) { const unsigned c = xb_ld(&bar[XB_XCNT(j)]); sum += c; cnt += (c > 0u) ? 1u : 0u; mine = (j == x) ? c : mine; }
        if (sum == G) break;
        __builtin_amdgcn_s_sleep(1);
        if ((++sp & 255u) == 0u) { if (xb_ld(&bar[XB_TMO])) break; if (sp > XB_SPIN_CAP) { atomicAdd(&bar[XB_TMO], 1u); break; } }
    }
    nloc = mine > 0u ? mine : 1u; nx = cnt > 0u ? cnt : 1u;
}
__device__ __forceinline__ void xcd_barrier(const XcdBarrier& b) {
    asm volatile("s_waitcnt vmcnt(0)" ::: "memory");
    __syncthreads();
    if (threadIdx.x == 0) {
        unsigned* bar = b.bar;
        __builtin_amdgcn_s_waitcnt(0);
        unsigned nloc = b.st[0], nx = b.st[1];
        const unsigned old = xb_add(&bar[XB_XSUB(b.x)], 1u);
        const unsigned gen = old / nloc;
        if (old + 1u == (gen + 1u) * nloc) {
            __builtin_amdgcn_fence(__ATOMIC_RELEASE, "agent");
            asm volatile("s_waitcnt vmcnt(0)" ::: "memory");
            const unsigned og = xb_add(&bar[XB_TOP], 1u);
            const unsigned tg = og / nx;
            if (og + 1u == (tg + 1u) * nx) xb_add(&bar[XB_TOPGEN], 1u);
            else XB_SPIN(xb_ld(&bar[XB_TOPGEN]) == tg, bar);
            __builtin_amdgcn_fence(__ATOMIC_ACQUIRE, "agent");
            xb_add(&bar[XB_XGEN(b.x)], 1u);
            asm volatile("s_waitcnt vmcnt(0)" ::: "memory");
        } else {
            XB_SPIN(xb_ld(&bar[XB_XGEN(b.x)]) == gen, bar);
            __builtin_amdgcn_fence(__ATOMIC_ACQUIRE, "agent");
            asm volatile("s_waitcnt vmcnt(0)" ::: "memory");
        }
    }
    __syncthreads();
}

namespace gm {
constexpr int BM = 256, BK = 64, HALF = 128, HTB = HALF * BK * 2, STAGE_BYTES = 8 * HTB, NXCD = 8, WGM = 8;
__host__ __device__ __forceinline__ int lds_byte(int r, int c) { const int st = (r >> 4) * 2 + (c >> 5), rr = r & 15, cc = c & 31, ob = rr * 64 + cc * 2; return st * 1024 + (ob ^ (((ob >> 9) & 1) << 5)); }
__host__ __device__ __forceinline__ void stage_rc(int b, int& R, int& C) { const int st = b / 1024, sb = b % 1024, swz = sb ^ (((sb >> 9) & 1) << 5); R = (st >> 1) * 16 + swz / 64; C = (st & 1) * 32 + (swz % 64) / 2; }
__host__ __device__ __forceinline__ int perm32(int rho) { const int n = rho >> 4, i = rho & 15; return 8 * (i >> 2) + 4 * n + (i & 3); }

struct UnitD { const char* a; const char* b; unsigned va[2][2]; int e0, e1, e2, e3; };

__device__ __forceinline__ bool static_tile(int M, int N, int G, int c, int i, int& pm, int& pn) {
    const int nM = M / BM, nN = N / BM, nwg = nM * nN;
    const long L = (long)i * G + c; if (L >= nwg) return false;
    int wgid = (int)L; { const int q = nwg / NXCD, r = nwg % NXCD, xcd = wgid % NXCD, off = wgid / NXCD; wgid = (xcd < r ? xcd * (q + 1) : r * (q + 1) + (xcd - r) * q) + off; }
    const int nig = WGM * nN, gid = wgid / nig, fm = gid * WGM, gsz = (nM - fm) < WGM ? (nM - fm) : WGM;
    pm = fm + ((wgid % nig) % gsz); pn = (wgid % nig) / gsz; return true;
}

template <bool PERM, bool HOOK = false, bool FP8 = false, class Epi, class Sched>
__device__ __forceinline__ void gemm_phase(LAS unsigned char* lds, const int K, Sched& S, const Epi& E) {
    int tid_ = threadIdx.x; asm volatile("" : "+v"(tid_));
    const int tid = tid_, wid = __builtin_amdgcn_readfirstlane(tid >> 6), lane = tid & 63, wr = wid >> 2, wc = wid & 3, fr = lane & 15, fq = lane >> 4;
    const int nt = K / BK;
    unsigned voffB[2];
#pragma unroll
    for (int i = 0; i < 2; ++i) { int R, C; stage_rc(tid * 16 + i * 8192, R, C); const int Rb = PERM ? ((R & ~31) + perm32(R & 31)) : R; voffB[i] = (unsigned)(Rb * K + C) * 2u; }
    const size_t kstep = (size_t)(BK * 2);
    const size_t hstep = (size_t)HALF * K * 2;
    const unsigned ldsw = (unsigned)wid * 1024u;
    const int aoff = lds_byte(wr * 64 + fr, fq * 8), boff = lds_byte(wc * 32 + fr, fq * 8);
#define GM_SA(b, h) (((b) * 2 + (h)) * HTB)
#define GM_SB(b, h) ((4 + (b) * 2 + (h)) * HTB)
#define GM_STAGE_A(bufoff, U, h, kb) do { _Pragma("unroll") for (int _i = 0; _i < 2; ++_i) \
        __builtin_amdgcn_global_load_lds((const unsigned*)((U).a + (kb) + (U).va[h][_i]), (LAS unsigned*)(lds + (bufoff) + ldsw + _i * 8192), 16, 0, 0); } while (0)
#define GM_STAGE_B(bufoff, U, h, kb) do { _Pragma("unroll") for (int _i = 0; _i < 2; ++_i) \
        __builtin_amdgcn_global_load_lds((const unsigned*)((U).b + (kb) + (size_t)(h) * hstep + voffB[_i]), (LAS unsigned*)(lds + (bufoff) + ldsw + _i * 8192), 16, 0, 0); } while (0)
#define GM_LDA(dst, b, h) do { _Pragma("unroll") for (int m = 0; m < 4; ++m) _Pragma("unroll") for (int k = 0; k < 2; ++k) { \
        if constexpr (FP8) { const i32x4_ t_ = *(const LAS i32x4_*)(lds + GM_SA(b, h) + aoff + m * 2048 + k * 1024); dst##8[m][4 * k] = t_[0]; dst##8[m][4 * k + 1] = t_[1]; dst##8[m][4 * k + 2] = t_[2]; dst##8[m][4 * k + 3] = t_[3]; } \
        else dst[m][k] = *(const LAS bf16x8*)(lds + GM_SA(b, h) + aoff + m * 2048 + k * 1024); } } while (0)
#define GM_LDB(dst, b, h) do { _Pragma("unroll") for (int n = 0; n < 2; ++n) _Pragma("unroll") for (int k = 0; k < 2; ++k) { \
        if constexpr (FP8) { const i32x4_ t_ = *(const LAS i32x4_*)(lds + GM_SB(b, h) + boff + n * 2048 + k * 1024); dst##8[n][4 * k] = t_[0]; dst##8[n][4 * k + 1] = t_[1]; dst##8[n][4 * k + 2] = t_[2]; dst##8[n][4 * k + 3] = t_[3]; } \
        else dst[n][k] = *(const LAS bf16x8*)(lds + GM_SB(b, h) + boff + n * 2048 + k * 1024); } } while (0)
#define GM_MMA(ai, bj, At, Bt) do { __builtin_amdgcn_s_setprio(1); \
        if constexpr (FP8) { _Pragma("unroll") for (int m = 0; m < 4; ++m) _Pragma("unroll") for (int n = 0; n < 2; ++n) \
            asm volatile("v_mfma_scale_f32_16x16x128_f8f6f4 %0, %1, %2, %0, %3, %3 op_sel_hi:[0,0,0]" : "+v"(acc[ai][bj][m][n]) : "v"(Bt##8[n]), "v"(At##8[m]), "v"(scl1)); } \
        else { _Pragma("unroll") for (int m = 0; m < 4; ++m) _Pragma("unroll") for (int n = 0; n < 2; ++n) _Pragma("unroll") for (int k = 0; k < 2; ++k) \
            acc[ai][bj][m][n] = __builtin_amdgcn_mfma_f32_16x16x32_bf16(Bt[n][k], At[m][k], acc[ai][bj][m][n], 0, 0, 0); } \
        __builtin_amdgcn_s_setprio(0); } while (0)
#define GM_WAIT_V(n) asm volatile("s_waitcnt vmcnt(" #n ")" ::: "memory")
#define GM_WAIT_L(n) asm volatile("s_waitcnt lgkmcnt(" #n ")" ::: "memory")
#define GM_BAR __builtin_amdgcn_s_barrier()
#define GM_SCHED __builtin_amdgcn_sched_barrier(0)
    UnitD cur, nxt; int ui = 0;
    if (!S.next(0, cur)) return;
    f32x4 acc[2][2][4][2];
#pragma unroll
    for (int a = 0; a < 2; ++a)
#pragma unroll
        for (int b = 0; b < 2; ++b)
#pragma unroll
            for (int m = 0; m < 4; ++m)
#pragma unroll
                for (int n = 0; n < 2; ++n) acc[a][b][m][n] = (f32x4){0.f, 0.f, 0.f, 0.f};
    typedef int i32x8_ __attribute__((ext_vector_type(8))); typedef int i32x4_ __attribute__((ext_vector_type(4)));
    bf16x8 At[4][2], B0[2][2], B1[2][2]; i32x8_ At8[4], B08[2], B18[2];
    int scl1 = 0x7f7f7f7f; asm volatile("" : "+v"(scl1));
    GM_STAGE_B(GM_SB(0, 0), cur, 0, 0); GM_STAGE_B(GM_SB(0, 1), cur, 1, 0); GM_STAGE_A(GM_SA(0, 0), cur, 0, 0); GM_STAGE_A(GM_SA(0, 1), cur, 1, 0);
    if (wr == 1) GM_BAR;
    GM_WAIT_V(2); GM_BAR;
    GM_STAGE_B(GM_SB(1, 0), cur, 0, kstep); GM_STAGE_A(GM_SA(1, 0), cur, 0, kstep); GM_STAGE_B(GM_SB(1, 1), cur, 1, kstep);
    GM_WAIT_V(6); GM_BAR;
    for (;;) {
        const bool has_next = S.next(ui + 1, nxt);
        if (!has_next) nxt = cur;
#pragma unroll 1
        for (int t = 0; t < nt; t += 2) {
            const bool last = (t == nt - 2);
            if constexpr (HOOK) { if (t == nt / 2) E.mid(acc, cur, wr, wc, fr, fq); }
            const size_t k1 = (size_t)(t + 1) * kstep;
            UnitD U2 = cur; size_t k2 = (size_t)(t + 2) * kstep;
            if (last) { U2 = nxt; k2 = 0; }
            const size_t k3 = k2 + kstep;
            GM_LDB(B0, 0, 0); GM_LDB(B1, 0, 1); GM_SCHED; GM_LDA(At, 0, 0); GM_STAGE_A(GM_SA(1, 1), cur, 1, k1);
            GM_WAIT_V(8); GM_WAIT_L(0); GM_BAR; GM_MMA(0, 0, At, B0); GM_MMA(0, 1, At, B1); GM_BAR; GM_SCHED;
            GM_LDA(At, 0, 1); GM_STAGE_B(GM_SB(0, 0), U2, 0, k2); GM_STAGE_B(GM_SB(0, 1), U2, 1, k2); GM_STAGE_A(GM_SA(0, 0), U2, 0, k2);
            GM_WAIT_V(8); GM_WAIT_L(0); GM_BAR; GM_MMA(1, 0, At, B0); GM_MMA(1, 1, At, B1); GM_BAR; GM_SCHED;
            GM_LDB(B0, 1, 0); GM_LDB(B1, 1, 1); GM_SCHED; GM_LDA(At, 1, 0); GM_STAGE_A(GM_SA(0, 1), U2, 1, k2);
            GM_WAIT_V(8); GM_WAIT_L(0); GM_BAR; GM_MMA(0, 0, At, B0); GM_MMA(0, 1, At, B1); GM_BAR; GM_SCHED;
            GM_LDA(At, 1, 1); GM_STAGE_B(GM_SB(1, 0), U2, 0, k3); GM_STAGE_B(GM_SB(1, 1), U2, 1, k3); GM_STAGE_A(GM_SA(1, 0), U2, 0, k3);
            GM_WAIT_V(8); GM_WAIT_L(0); GM_BAR; GM_MMA(1, 0, At, B0); GM_MMA(1, 1, At, B1); GM_BAR; GM_SCHED;
        }
        if constexpr (FP8) asm volatile("s_nop 15\n\ts_nop 15" ::: "memory");
        if (wr == 0) GM_BAR;
        E(acc, cur, wr, wc, fr, fq);
        if (!has_next) break;
#pragma unroll
        for (int a = 0; a < 2; ++a)
#pragma unroll
            for (int b = 0; b < 2; ++b)
#pragma unroll
                for (int m = 0; m < 4; ++m)
#pragma unroll
                    for (int n = 0; n < 2; ++n) acc[a][b][m][n] = (f32x4){0.f, 0.f, 0.f, 0.f};
        cur = nxt; ++ui;
        if (wr == 1) GM_BAR;
    }
    GM_WAIT_V(0);
    GM_BAR;
#undef GM_SA
#undef GM_SB
#undef GM_STAGE_A
#undef GM_STAGE_B
#undef GM_LDA
#undef GM_LDB
#undef GM_MMA
#undef GM_WAIT_V
#undef GM_WAIT_L
#undef GM_BAR
#undef GM_SCHED
}
__device__ __forceinline__ void stage_geom(int tid, int (&R)[2], int (&C)[2]) {
#pragma unroll
    for (int i = 0; i < 2; ++i) stage_rc(tid * 16 + i * 8192, R[i], C[i]);
}
}

struct Args { const float* in[20]; float* out; unsigned char* ws; int ph_lo, ph_hi; };
struct Ctx {
    LAS unsigned char* lds;
    unsigned char* ws;
    const LAS unsigned long long* intab;
    float* out;
    int tid, lane, wave, G, bid;
};
#define LDS_WAIT() asm volatile("s_waitcnt lgkmcnt(0)" ::: "memory")
__device__ __forceinline__ const float* inp(const Ctx& F, int i) {
    const unsigned long long v = F.intab[i];
    const unsigned lo = __builtin_amdgcn_readfirstlane((unsigned)v), hi = __builtin_amdgcn_readfirstlane((unsigned)(v >> 32));
    return (const float*)(GAS const float*)(((unsigned long long)hi << 32) | lo);
}
template <class P> __device__ __forceinline__ P launder_ptr(P p) {
    unsigned long long v = (unsigned long long)p; unsigned lo = (unsigned)v, hi = (unsigned)(v >> 32);
    asm volatile("" : "+v"(lo), "+v"(hi));
    lo = __builtin_amdgcn_readfirstlane(lo); hi = __builtin_amdgcn_readfirstlane(hi);
    return (P)(GAS unsigned char*)(((unsigned long long)hi << 32) | lo);
}
__device__ __forceinline__ void launder(Ctx& F) {
    int t = F.tid, g = F.G, bid = F.bid;
    asm volatile("" : "+v"(t), "+v"(g), "+v"(bid));
    F.tid = t; F.G = __builtin_amdgcn_readfirstlane(g); F.bid = __builtin_amdgcn_readfirstlane(bid); F.lane = t & 63; F.wave = __builtin_amdgcn_readfirstlane(t >> 6);
    F.ws = launder_ptr(F.ws); F.out = launder_ptr(F.out);
}
__device__ __forceinline__ float wave_sum(float v) {
#pragma unroll
    for (int o = 1; o < 64; o <<= 1) v += __shfl_xor(v, o);
    return v;
}
__device__ __forceinline__ int lds_add(LAS int* p, int v) { return __hip_atomic_fetch_add(p, v, __ATOMIC_RELAXED, __HIP_MEMORY_SCOPE_WORKGROUP); }
__device__ __forceinline__ float f8c(float x) { return __builtin_amdgcn_fmed3f(x, -440.f, 440.f); }
__device__ __forceinline__ float sigmoidf_(float x) { return 1.f / (1.f + __expf(-x)); }
__device__ __forceinline__ float siluf_(float x) { return x / (1.f + __expf(-x)); }

enum { I_X = 0, I_C, I_N1G, I_N2G, I_WADA, I_BADA, I_WIN, I_WBSB, I_WBMB, I_WOUT, I_WR, I_RB, I_WGE, I_WUE, I_WDE, I_WGS, I_WUS, I_WDS, I_RELB, I_FG };

__device__ __forceinline__ void transpose_item(const float* W, int ldn, int k0, int n0, bf16_t* WT, int Kdst, int drow0, LAS float* scr, int lane) {
    const float* wp = W + (size_t)(k0 + (lane >> 3)) * ldn + n0 + 4 * (lane & 7);
    f32x4 v[8];
#pragma unroll
    for (int i = 0; i < 8; ++i) v[i] = *(const f32x4*)(wp + (size_t)(8 * i) * ldn);
#pragma unroll
    for (int i = 0; i < 8; ++i) { LAS float* d = scr + (8 * i + (lane >> 3)) * 33 + 4 * (lane & 7); d[0] = v[i].x; d[1] = v[i].y; d[2] = v[i].z; d[3] = v[i].w; }
    LDS_WAIT(); asm volatile("" ::: "memory");
    const int c = lane & 7;
#pragma unroll
    for (int j = 0; j < 4; ++j) { const int n = (lane >> 3) + 8 * j; const LAS float* s = scr + (8 * c) * 33 + n;
        u32x4 o; o.x = cvtpk(s[0 * 33], s[1 * 33]); o.y = cvtpk(s[2 * 33], s[3 * 33]); o.z = cvtpk(s[4 * 33], s[5 * 33]); o.w = cvtpk(s[6 * 33], s[7 * 33]);
        *(u32x4*)(WT + (size_t)(drow0 + n) * Kdst + k0 + 8 * c) = o; }
    LDS_WAIT(); asm volatile("" ::: "memory");
}
__device__ __forceinline__ void phase0(Ctx& F) {
    LAS float* silc = (LAS float*)(F.lds + MISC_OFF - 0);
    silc = (LAS float*)(F.lds + 0);
    for (int i = F.tid; i < 4 * DM; i += 512) silc[i] = siluf_(inp(F, I_C)[i]);
    __syncthreads();
    float* mod = (float*)(F.ws + WS_SMALL + SM_MOD);
    {
        const int gw = F.wave * F.G + F.bid;
        const int c = F.lane & 15, kp = F.lane >> 4;
        const float* wada = inp(F, I_WADA);
        for (int item = gw; item < NMOD / 16; item += 8 * F.G) {
            const int col = item * 16 + c;
            float a0 = 0.f, a1 = 0.f, a2 = 0.f, a3 = 0.f;
#pragma unroll 32
            for (int k = kp; k < DM; k += 4) { const float w = wada[(size_t)k * NMOD + col]; a0 += silc[k] * w; a1 += silc[DM + k] * w; a2 += silc[2 * DM + k] * w; a3 += silc[3 * DM + k] * w; }
            a0 += __shfl_xor(a0, 16); a0 += __shfl_xor(a0, 32); a1 += __shfl_xor(a1, 16); a1 += __shfl_xor(a1, 32);
            a2 += __shfl_xor(a2, 16); a2 += __shfl_xor(a2, 32); a3 += __shfl_xor(a3, 16); a3 += __shfl_xor(a3, 32);
            if (kp == 0) { const float bb = inp(F, I_BADA)[col]; mod[col] = a0 + bb; mod[NMOD + col] = a1 + bb; mod[2 * NMOD + col] = a2 + bb; mod[3 * NMOD + col] = a3 + bb; }
        }
    }
    __syncthreads();
    {
        LAS float* scr = (LAS float*)(F.lds + F.wave * 16384);
        const int gw = F.bid * 8 + F.wave, NGW = F.G * 8, lane = F.lane;
        constexpr int I_IN = 16 * 160, I_BR = 8 * 32, I_OUT = 16 * 32, I_EXP = 384, NIT = I_IN + 2 * I_BR + I_OUT + 65 * I_EXP;
        const float* p_win = inp(F, I_WIN); const float* p_bsb = inp(F, I_WBSB); const float* p_bmb = inp(F, I_WBMB); const float* p_out = inp(F, I_WOUT);
        const float* p_ge = inp(F, I_WGE); const float* p_ue = inp(F, I_WUE); const float* p_de = inp(F, I_WDE); const float* p_gs = inp(F, I_WGS); const float* p_us = inp(F, I_WUS); const float* p_ds = inp(F, I_WDS);
#define TD_GET(IT, SRC, LDN, DST, KD, F8) do { int r = (IT); F8 = 0; \
            if (r < I_IN) { const int kb = r / 160, nb = r % 160; SRC = p_win + (size_t)(kb * 64) * 5120 + nb * 32; LDN = 5120; \
                if (nb < 48) { DST = (bf16_t*)(F.ws + WS_WINT) + (size_t)(nb * 32) * 1024 + kb * 64; KD = 1024; } \
                else { DST = (bf16_t*)((unsigned char*)(F.ws + WS_WIN8) + (size_t)(nb * 32 - 1536) * 1024 + kb * 64); KD = 1024; F8 = 256; } } \
            else if ((r -= I_IN) < I_BR) { const int kb = r / 32, nb = r % 32; SRC = p_bsb + (size_t)(kb * 64) * 1024 + nb * 32; LDN = 1024; DST = (bf16_t*)(F.ws + WS_WBRT) + (size_t)(nb * 32) * 1024 + kb * 64; KD = 1024; } \
            else if ((r -= I_BR) < I_BR) { const int kb = r / 32, nb = r % 32; SRC = p_bmb + (size_t)(kb * 64) * 1024 + nb * 32; LDN = 1024; DST = (bf16_t*)(F.ws + WS_WBRT) + (size_t)(nb * 32) * 1024 + 512 + kb * 64; KD = 1024; } \
            else if ((r -= I_BR) < I_OUT) { const int kb = r / 32, nb = r % 32; SRC = p_out + (size_t)(kb * 64) * 1024 + nb * 32; LDN = 1024; DST = (bf16_t*)(F.ws + WS_WOUTT) + (size_t)(nb * 32) * 1024 + kb * 64; KD = 1024; } \
            else { r -= I_OUT; const int e = r / I_EXP; r -= e * I_EXP; \
                if (r < 128) { const int kb = r / 8, n0 = (r % 8) * 32; SRC = (e < NE ? p_ge + (size_t)e * DM * EFF : p_gs) + (size_t)(kb * 64) * EFF + n0; LDN = EFF; \
                    DST = (bf16_t*)((unsigned char*)(F.ws + WS_W1T) + ((size_t)e * 512 + (n0 >> 7) * 256 + (n0 & 127)) * 1024 + kb * 64); KD = 1024; F8 = 256; } \
                else if (r < 256) { r -= 128; const int kb = r / 8, n0 = (r % 8) * 32; SRC = (e < NE ? p_ue + (size_t)e * DM * EFF : p_us) + (size_t)(kb * 64) * EFF + n0; LDN = EFF; \
                    DST = (bf16_t*)((unsigned char*)(F.ws + WS_W1T) + ((size_t)e * 512 + (n0 >> 7) * 256 + 128 + (n0 & 127)) * 1024 + kb * 64); KD = 1024; F8 = 256; } \
                else { r -= 256; const int kb = r / 32, nb = r % 32; SRC = (e < NE ? p_de + (size_t)e * EFF * DM : p_ds) + (size_t)(kb * 64) * DM + nb * 32; LDN = DM; \
                    DST = (bf16_t*)((unsigned char*)(F.ws + WS_W2T) + ((size_t)e * 1024 + nb * 32) * 256 + kb * 64); KD = 256; F8 = 128; } } } while (0)
#define TD_LOAD(V, SRC, LDN) do { const float* wp_ = (SRC) + (size_t)(lane >> 3) * (LDN) + 4 * (lane & 7); _Pragma("unroll") for (int i = 0; i < 8; ++i) V[i] = *(const f32x4*)(wp_ + (size_t)(8 * i) * (LDN)); } while (0)
#define TD_PROC(V, DST, KD, F8) do { \
            _Pragma("unroll") for (int i = 0; i < 8; ++i) { LAS float* d = scr + (8 * i + (lane >> 3)) * 33 + 4 * (lane & 7); d[0] = V[i].x; d[1] = V[i].y; d[2] = V[i].z; d[3] = V[i].w; } \
            LDS_WAIT(); asm volatile("" ::: "memory"); \
            if (F8) { _Pragma("unroll") for (int j = 0; j < 4; ++j) { const int n = (lane >> 3) + 8 * j; const LAS float* sp = scr + (8 * (lane & 7)) * 33 + n; \
                int w0 = 0, w1 = 0; \
                const float fs_ = (float)(F8); w0 = __builtin_amdgcn_cvt_pk_fp8_f32(f8c(sp[0 * 33] * fs_), f8c(sp[1 * 33] * fs_), w0, false); w0 = __builtin_amdgcn_cvt_pk_fp8_f32(f8c(sp[2 * 33] * fs_), f8c(sp[3 * 33] * fs_), w0, true); \
                w1 = __builtin_amdgcn_cvt_pk_fp8_f32(f8c(sp[4 * 33] * fs_), f8c(sp[5 * 33] * fs_), w1, false); w1 = __builtin_amdgcn_cvt_pk_fp8_f32(f8c(sp[6 * 33] * fs_), f8c(sp[7 * 33] * fs_), w1, true); \
                *(u32x2*)((unsigned char*)(DST) + (size_t)n * (KD) + 8 * (lane & 7)) = (u32x2){(unsigned)w0, (unsigned)w1}; } } \
            else { _Pragma("unroll") for (int j = 0; j < 4; ++j) { const int n = (lane >> 3) + 8 * j; const LAS float* sp = scr + (8 * (lane & 7)) * 33 + n; \
                u32x4 o; o.x = cvtpk(sp[0 * 33], sp[1 * 33]); o.y = cvtpk(sp[2 * 33], sp[3 * 33]); o.z = cvtpk(sp[4 * 33], sp[5 * 33]); o.w = cvtpk(sp[6 * 33], sp[7 * 33]); \
                *(u32x4*)((DST) + (size_t)n * (KD) + 8 * (lane & 7)) = o; } } \
            LDS_WAIT(); asm volatile("" ::: "memory"); } while (0)
        for (int it = 4 * gw; it < NIT; it += 4 * NGW) {
            const float* src[4]; bf16_t* dst[4]; int ld[4], kd[4], f8[4];
            f32x4 v0[8], v1[8], v2[8], v3[8];
            TD_GET(it, src[0], ld[0], dst[0], kd[0], f8[0]); TD_GET(it + 1, src[1], ld[1], dst[1], kd[1], f8[1]); TD_GET(it + 2, src[2], ld[2], dst[2], kd[2], f8[2]); TD_GET(it + 3, src[3], ld[3], dst[3], kd[3], f8[3]);
            TD_LOAD(v0, src[0], ld[0]); TD_LOAD(v1, src[1], ld[1]); TD_LOAD(v2, src[2], ld[2]); TD_LOAD(v3, src[3], ld[3]);
            TD_PROC(v0, dst[0], kd[0], f8[0]); TD_PROC(v1, dst[1], kd[1], f8[1]); TD_PROC(v2, dst[2], kd[2], f8[2]); TD_PROC(v3, dst[3], kd[3], f8[3]);
        }
#undef TD_PROC
#undef TD_GET
#undef TD_LOAD
    }
    {
        bf16_t* wrh = (bf16_t*)(F.ws + WS_SMALL + SM_WRH); bf16_t* wrl = (bf16_t*)(F.ws + WS_SMALL + SM_WRL);
        const float* wr = inp(F, I_WR);
        for (int i = F.bid * 512 + F.tid; i < NE * DM; i += F.G * 512) { const int e = i >> 10, k = i & 1023; const float v = wr[k * NE + e];
            const unsigned h = cvtpk(v, 0.f) & 0xffffu; wrh[i] = (bf16_t)h; wrl[i] = (bf16_t)(cvtpk(v - bflo(h), 0.f) & 0xffffu); }
    }
}

__device__ __forceinline__ void phase1(Ctx& F) {
    const float* mod = (const float*)(F.ws + WS_SMALL + SM_MOD);
    const float* x = inp(F, I_X); const float* g1 = inp(F, I_N1G);
    bf16_t* H = (bf16_t*)(F.ws + WS_H); unsigned char* H8 = (unsigned char*)(F.ws + WS_H8);
    const int gw = F.bid * 8 + F.wave, NGW = F.G * 8;
    if (gw < 256) {
        const int b = gw >> 6, e = gw & 63; const float* wr = inp(F, I_WR); float a = 0.f;
#pragma unroll 4
        for (int k = F.lane; k < DM; k += 64) a += mod[b * NMOD + 3 * DM + k] * wr[k * NE + e];
        a = wave_sum(a);
        if (F.lane == 0) ((float*)(F.ws + WS_SMALL + SM_CB))[gw] = a;
    }
    if (F.bid == 32) {
        float* gvec = (float*)(F.ws + WS_SMALL + SM_GVEC); const float* g2 = inp(F, I_N2G);
        for (int i = F.tid; i < 4 * DM; i += 512) { const int b = i >> 10, k = i & 1023; gvec[i] = g2[k] * (1.f + mod[b * NMOD + 4 * DM + k]); }
    }
    for (int m0 = gw; m0 < MT; m0 += 2 * NGW) {
        const int m1 = m0 + NGW;
        const bool two = m1 < MT;
        const f32x4* xr0 = (const f32x4*)(x + (size_t)m0 * DM) + F.lane; const f32x4* xr1 = (const f32x4*)(x + (size_t)(two ? m1 : m0) * DM) + F.lane;
        f32x4 v0[4], v1[4]; float s0 = 0.f, s1 = 0.f;
#pragma unroll
        for (int j = 0; j < 4; ++j) { v0[j] = xr0[64 * j]; v1[j] = xr1[64 * j]; }
#pragma unroll
        for (int j = 0; j < 4; ++j) { s0 += (v0[j].x * v0[j].x + v0[j].y * v0[j].y) + (v0[j].z * v0[j].z + v0[j].w * v0[j].w); s1 += (v1[j].x * v1[j].x + v1[j].y * v1[j].y) + (v1[j].z * v1[j].z + v1[j].w * v1[j].w); }
        const float r0 = rsqrtf(wave_sum(s0) * (1.f / DM) + EPS), r1 = rsqrtf(wave_sum(s1) * (1.f / DM) + EPS);
        const int b0 = m0 / SEQ, b1 = (two ? m1 : m0) / SEQ;
        u32x2* o0 = (u32x2*)(H + (size_t)m0 * DM) + F.lane; u32x2* o1 = (u32x2*)(H + (size_t)(two ? m1 : m0) * DM) + F.lane;
#pragma unroll
        for (int j = 0; j < 4; ++j) {
            const int col = 4 * F.lane + 256 * j;
            const f32x4 g = *(const f32x4*)(g1 + col);
            const f32x4 h0 = (v0[j] * r0) * g * (*(const f32x4*)(mod + b0 * NMOD + DM + col) + 1.0f) + *(const f32x4*)(mod + b0 * NMOD + col);
            const f32x4 h1 = (v1[j] * r1) * g * (*(const f32x4*)(mod + b1 * NMOD + DM + col) + 1.0f) + *(const f32x4*)(mod + b1 * NMOD + col);
            u32x2 w; w.x = cvtpk(h0.x, h0.y); w.y = cvtpk(h0.z, h0.w); o0[64 * j] = w;
            { int q8 = 0; q8 = __builtin_amdgcn_cvt_pk_fp8_f32(f8c(h0.x * 16.f), f8c(h0.y * 16.f), q8, false); q8 = __builtin_amdgcn_cvt_pk_fp8_f32(f8c(h0.z * 16.f), f8c(h0.w * 16.f), q8, true);
              ((unsigned*)(H8 + (size_t)m0 * DM) + F.lane)[64 * j] = (unsigned)q8; }
            if (two) { w.x = cvtpk(h1.x, h1.y); w.y = cvtpk(h1.z, h1.w); o1[64 * j] = w;
                int q8 = 0; q8 = __builtin_amdgcn_cvt_pk_fp8_f32(f8c(h1.x * 16.f), f8c(h1.y * 16.f), q8, false); q8 = __builtin_amdgcn_cvt_pk_fp8_f32(f8c(h1.z * 16.f), f8c(h1.w * 16.f), q8, true);
                ((unsigned*)(H8 + (size_t)m1 * DM) + F.lane)[64 * j] = (unsigned)q8; }
        }
    }
}

struct ProjSched {
    const char* A; const char* Bt; int G, c, pn0, npn, f8; int R[2], C[2];
    __device__ __forceinline__ bool next(int i, gm::UnitD& u) {
        int pm, pn; if (!gm::static_tile(MT, npn * 256, G, c, i, pm, pn)) return false;
        const int kp = f8 ? 512 : 1024;
        u.a = A; u.b = Bt + (size_t)pn * 256 * kp * 2;
#pragma unroll
        for (int h = 0; h < 2; ++h)
#pragma unroll
            for (int j = 0; j < 2; ++j) u.va[h][j] = (unsigned)((pm * 256 + h * 128 + R[j]) * kp + C[j]) * 2u;
        u.e0 = pm; u.e1 = pn0 + pn; u.e2 = f8; u.e3 = 0; return true;
    }
};
struct EpiProj {
    bf16_t* qsb; bf16_t* qmb; bf16_t* g; float* kbs;
    __device__ __forceinline__ void operator()(const f32x4 (&acc)[2][2][4][2], const gm::UnitD& u, int wr, int wc, int fr, int fq) const {
        const int pm = u.e0, pn = u.e1;
        bf16_t* base; int ldc, colt; float sc = 1.f;
        if (pn < 6) { base = qsb; ldc = QW; colt = pn * 256; if (pn < 2) sc = 0.125f * LOG2E; }
        else if (pn < 12) { base = qmb; ldc = QW; colt = (pn - 6) * 256; if (pn < 8) sc = 0.125f; }
        else { base = g; ldc = 2048; colt = (pn - 12) * 256; }
        if (u.e2) sc *= (1.f / 4096.f);
        const int row0 = pm * 256 + wr * 64 + fr, col0 = colt + wc * 32 + 8 * fq;
        if (pn == 8 || pn == 9) {
#pragma unroll
            for (int bj = 0; bj < 2; ++bj)
#pragma unroll
                for (int n = 0; n < 2; ++n) { f32x4 cs = (f32x4){0.f, 0.f, 0.f, 0.f};
#pragma unroll
                    for (int ai = 0; ai < 2; ++ai)
#pragma unroll
                        for (int m = 0; m < 4; ++m) cs += acc[ai][bj][m][n];
#pragma unroll
                    for (int o = 1; o < 16; o <<= 1) { cs[0] += __shfl_xor(cs[0], o); cs[1] += __shfl_xor(cs[1], o); cs[2] += __shfl_xor(cs[2], o); cs[3] += __shfl_xor(cs[3], o); }
                    if (fr == 0) { float* kd = kbs + (size_t)pm * 512 + (pn - 8) * 256 + bj * 128 + wc * 32 + 8 * fq + 4 * n;
#pragma unroll
                        for (int j = 0; j < 4; ++j) atomicAdd(kd + j, cs[j]); } }
        }
#pragma unroll
        for (int ai = 0; ai < 2; ++ai)
#pragma unroll
            for (int m = 0; m < 4; ++m) { bf16_t* rowp = base + (size_t)(row0 + ai * 128 + m * 16) * ldc + col0;
#pragma unroll
                for (int bj = 0; bj < 2; ++bj) { const f32x4 v0 = acc[ai][bj][m][0] * sc, v1 = acc[ai][bj][m][1] * sc;
                    u32x4 w; w.x = cvtpk(v0[0], v0[1]); w.y = cvtpk(v0[2], v0[3]); w.z = cvtpk(v1[0], v1[1]); w.w = cvtpk(v1[2], v1[3]);
                    *(u32x4*)(rowp + bj * 128) = w; } }
    }
};
__device__ __forceinline__ void phase2(Ctx& F) {
    EpiProj E{(bf16_t*)(F.ws + WS_QSB), (bf16_t*)(F.ws + WS_QMB), (bf16_t*)(F.ws + WS_G), (float*)(F.ws + WS_CTL + CTL_KBS)};
    {
        ProjSched S; S.A = (const char*)(F.ws + WS_H); S.Bt = (const char*)(F.ws + WS_WINT); S.G = F.G; S.c = F.bid; S.pn0 = 0; S.npn = 6; S.f8 = 0; gm::stage_geom(F.tid, S.R, S.C);
        gm::gemm_phase<true>(F.lds, 1024, S, E);
    }
    {
        ProjSched S; S.A = (const char*)(F.ws + WS_H8); S.Bt = (const char*)(F.ws + WS_WIN8); S.G = F.G; S.c = F.bid; S.pn0 = 6; S.npn = 14; S.f8 = 1; gm::stage_geom(F.tid, S.R, S.C);
        gm::gemm_phase<true, false, true>(F.lds, 512, S, E);
    }
}

__device__ __forceinline__ int crow(int r, int hi) { return (r & 3) + 8 * (r >> 2) + 4 * hi; }
typedef short v4i16_t __attribute__((ext_vector_type(4)));
__device__ __forceinline__ s16x4 vtr(const LAS unsigned char* p) { return __builtin_bit_cast(s16x4, __builtin_amdgcn_ds_read_tr16_b64_v4i16((LAS v4i16_t*)p)); }
#define PV_TR(dst, off) asm volatile("ds_read_b64_tr_b16 %0, %1 offset:%2" : "=v"(dst) : "v"(vb), "n"(off) : "memory")
__device__ __forceinline__ void pv64(f32x16 (&o)[2], const LAS unsigned char* vt, int lane, const u32x4 (&pw)[4]) {
    const int hi = lane >> 5;
    const LAS unsigned char* vb = vt + ((lane >> 4) & 1) * 32 + (lane & 3) * 8 + (4 * hi + ((lane & 15) >> 2)) * 64;
    s16x4 lo[2][4], hh[2][4];
#pragma unroll
    for (int ks = 0; ks < 4; ++ks) { PV_TR(lo[0][ks], ks * 1024); PV_TR(hh[0][ks], ks * 1024 + 512); }
#pragma unroll
    for (int ks = 0; ks < 4; ++ks) { PV_TR(lo[1][ks], 4096 + ks * 1024); PV_TR(hh[1][ks], 4096 + ks * 1024 + 512); }
    asm volatile("s_waitcnt lgkmcnt(8)" : "+v"(lo[0][0]), "+v"(lo[0][1]), "+v"(lo[0][2]), "+v"(lo[0][3]), "+v"(hh[0][0]), "+v"(hh[0][1]), "+v"(hh[0][2]), "+v"(hh[0][3]) :: "memory");
#pragma unroll
    for (int ks = 0; ks < 4; ++ks) {
        const bf16x8 bv = (bf16x8){lo[0][ks][0], lo[0][ks][1], lo[0][ks][2], lo[0][ks][3], hh[0][ks][0], hh[0][ks][1], hh[0][ks][2], hh[0][ks][3]};
        o[0] = __builtin_amdgcn_mfma_f32_32x32x16_bf16(__builtin_bit_cast(bf16x8, pw[ks]), bv, o[0], 0, 0, 0);
    }
    asm volatile("s_waitcnt lgkmcnt(0)" : "+v"(lo[1][0]), "+v"(lo[1][1]), "+v"(lo[1][2]), "+v"(lo[1][3]), "+v"(hh[1][0]), "+v"(hh[1][1]), "+v"(hh[1][2]), "+v"(hh[1][3]) :: "memory");
#pragma unroll
    for (int ks = 0; ks < 4; ++ks) {
        const bf16x8 bv = (bf16x8){lo[1][ks][0], lo[1][ks][1], lo[1][ks][2], lo[1][ks][3], hh[1][ks][0], hh[1][ks][1], hh[1][ks][2], hh[1][ks][3]};
        o[1] = __builtin_amdgcn_mfma_f32_32x32x16_bf16(__builtin_bit_cast(bf16x8, pw[ks]), bv, o[1], 0, 0, 0);
    }
}
__device__ __forceinline__ void store_o_tile(const f32x16 (&o)[2], LAS unsigned char* stgb, int lane, bf16_t* dst0, size_t row_pitch) {
    const int r32 = lane & 31, hi = lane >> 5;
    LAS bf16_t* stg = (LAS bf16_t*)stgb;
#pragma unroll
    for (int r = 0; r < 16; ++r) { const int orow = crow(r, hi);
#pragma unroll
        for (int d0 = 0; d0 < 2; ++d0) stg[orow * 64 + d0 * 32 + r32] = (bf16_t)(cvtpk(o[d0][r], 0.f) & 0xffffu); }
    LDS_WAIT();
#pragma unroll
    for (int i = 0; i < 4; ++i) { const int row = i * 8 + (lane >> 3), ch = lane & 7; const u32x4 v = *(const LAS u32x4*)(stg + row * 64 + ch * 8); *(u32x4*)(dst0 + (size_t)row * row_pitch + ch * 8) = v; }
    LDS_WAIT();
}

template <bool MASKED>
__device__ __forceinline__ void sb_tile(const f32x16 (&z)[2], float& P, u32x4 (&pw)[4], int k0, int qpos, int hi) {
    f32x16 be[2], nb[2];
#pragma unroll
    for (int p = 0; p < 2; ++p)
#pragma unroll
        for (int r = 0; r < 16; ++r) {
            const float zz = __builtin_amdgcn_fmed3f(z[p][r], -126.f, 126.f);
            const float t = __builtin_amdgcn_exp2f(-zz), b_ = __builtin_amdgcn_rcpf(1.f + t);
            float n_ = t * b_, bb = b_;
            if (MASKED) { const bool valid = (k0 + 32 * p + crow(r, hi)) < qpos; n_ = valid ? n_ : 1.f; bb = valid ? bb : 0.f; }
            be[p][r] = bb; nb[p][r] = n_;
        }
    float Gp[8], PG[8], off[8];
#pragma unroll
    for (int idx = 0; idx < 8; ++idx) { const int p = idx >> 2, g4 = (idx & 3) * 4; Gp[idx] = (nb[p][g4] * nb[p][g4 + 1]) * (nb[p][g4 + 2] * nb[p][g4 + 3]); }
#pragma unroll
    for (int idx = 0; idx < 8; ++idx) PG[idx] = __shfl_xor(Gp[idx], 32);
    float run = P;
#pragma unroll
    for (int idx = 7; idx >= 0; --idx) { off[idx] = hi ? run : run * PG[idx]; run *= (Gp[idx] * PG[idx]); }
    P = run;
#pragma unroll
    for (int idx = 0; idx < 8; ++idx) { const int p = idx >> 2, g4 = (idx & 3) * 4; float c = off[idx]; float a[4];
#pragma unroll
        for (int j = 3; j >= 0; --j) { a[j] = be[p][g4 + j] * c; c *= nb[p][g4 + j]; }
        pw[idx >> 1][(idx & 1) * 2] = cvtpk(a[0], a[1]); pw[idx >> 1][(idx & 1) * 2 + 1] = cvtpk(a[2], a[3]); }
}
__device__ __forceinline__ void sb_unit(Ctx& F, int bh, int qt, LAS unsigned char* vl) {
    const int lane = F.lane, r32 = lane & 31, hi = lane >> 5;
    const int b = bh >> 3, h = bh & 7, q0 = qt * 32, qpos = q0 + r32;
    const bf16_t* base = (const bf16_t*)(F.ws + WS_QSB) + (size_t)b * SEQ * QW + h * 64;
    const bf16_t* Kb = base + 512 + (size_t)r32 * QW + hi * 8; const bf16_t* Vb = base + 1024 + (size_t)(lane >> 2) * QW + (lane & 3) * 8;
    bf16x8 qr[4];
#pragma unroll
    for (int d0 = 0; d0 < 4; ++d0) qr[d0] = *(const bf16x8*)(base + (size_t)qpos * QW + d0 * 16 + hi * 8);
    float P = 1.f; f32x16 o[2]; o[0] = f32x16{}; o[1] = f32x16{};
    bf16x8 kfn[8];
    const int kt0 = q0 >> 6; int kt = kt0, cur = 0;
#define SB_PREFETCH(KT, BUF) do { const size_t ko_ = (size_t)(KT) * 64 * QW; \
        _Pragma("unroll") for (int d0 = 0; d0 < 4; ++d0) _Pragma("unroll") for (int hf = 0; hf < 2; ++hf) kfn[2 * d0 + hf] = *(const bf16x8*)(Kb + ko_ + (size_t)(32 * hf) * QW + d0 * 16); \
        _Pragma("unroll") for (int p = 0; p < 8; ++p) __builtin_amdgcn_global_load_lds((const unsigned*)(Vb + ko_ + (size_t)(16 * (p & 3)) * QW + (p >> 2) * 32), (LAS unsigned*)(vl + (BUF) * 8192 + p * 1024), 16, 0, 0); } while (0)
    SB_PREFETCH(kt, 0);
#pragma unroll 1
    for (; kt >= 0; --kt) {
        if (__all(P == 0.f)) break;
        f32x16 z[2]; z[0] = f32x16{}; z[1] = f32x16{};
#pragma unroll
        for (int d0 = 0; d0 < 4; ++d0) { z[0] = __builtin_amdgcn_mfma_f32_32x32x16_bf16(kfn[2 * d0], qr[d0], z[0], 0, 0, 0); z[1] = __builtin_amdgcn_mfma_f32_32x32x16_bf16(kfn[2 * d0 + 1], qr[d0], z[1], 0, 0, 0); }
        asm volatile("" : "+v"(z[0]), "+v"(z[1]));
        { const int ktn = kt > 0 ? kt - 1 : 0; SB_PREFETCH(ktn, cur ^ 1); }
        u32x4 pw[4];
        if (kt == kt0) sb_tile<true>(z, P, pw, kt * 64, qpos, hi); else sb_tile<false>(z, P, pw, kt * 64, qpos, hi);
        asm volatile("s_waitcnt vmcnt(16)" ::: "memory");
        pv64(o, vl + cur * 8192, lane, pw);
        cur ^= 1;
    }
#undef SB_PREFETCH
    asm volatile("s_waitcnt vmcnt(0)" ::: "memory");
    bf16_t* dst = (bf16_t*)(F.ws + WS_OB) + (size_t)(b * SEQ + q0) * 1024 + h * 64;
    store_o_tile(o, vl, lane, dst, 1024);
}
__device__ __forceinline__ void sb_units(Ctx& F) {
    const int gw = F.bid * 8 + F.wave, NGW = F.G * 8;
    LAS unsigned char* vl = F.lds + F.wave * 16384;
    for (int u = gw; u < 32 * 256; u += NGW) sb_unit(F, u >> 8, u & 255, vl);
}

constexpr int MO_LUT = 0, MO_PRE = 4224, MO_WSF = 8320, MO_ENT = 12416, MO_ST = 16368;
__device__ __forceinline__ int mb_list_off(int j) { return 256 * (31 * j - (j * (j - 1)) / 2); }
constexpr int MB_LIST_STRIDE = 126976;
__device__ __forceinline__ int t5_bucket_dev(int n) {
    if (n < 16) return n;
    int large = 16 + (int)(logf((float)n / 16.f) / 2.0794415416798357f * 16.f);
    return large < 31 ? large : 31;
}
__device__ __forceinline__ void build_lut(Ctx& F) {
    LAS float* lut = (LAS float*)(F.lds + MISC_OFF + MO_LUT);
    for (int i = F.tid; i < 8 * 132; i += 512) { const int h = i / 132, d = i % 132; lut[i] = inp(F, I_RELB)[h * 32 + t5_bucket_dev(d < 128 ? d : 128)] * LOG2E; }
}
__device__ __forceinline__ void phase4(Ctx& F) {
    LAS int* lcnt = (LAS int*)(F.lds + MISC_OFF + MO_PRE); LAS int* lbase = lcnt + 32;
    const float* kbar = (const float*)(F.ws + WS_CTL + CTL_KBS);
    unsigned* cur = (unsigned*)(F.ws + WS_CTL) + CW_MBCUR;
    unsigned short* lists = (unsigned short*)(F.ws + WS_LMB);
    const int lane = F.lane, r32 = lane & 31, hi = lane >> 5;
    for (int u = F.bid; u < 32 * 31; u += F.G) {
        const int bh = u / 31, i = 1 + (u % 31), b = bh >> 3, h = bh & 7;
        if (F.tid < 32) lcnt[F.tid] = 0;
        __syncthreads();
        const int qpos = i * 256 + F.wave * 32 + r32;
        const float* kp = kbar + (size_t)(b * 32 + r32) * 512 + h * 64 + hi * 8;
        const bf16_t* qp = (const bf16_t*)(F.ws + WS_QMB) + (size_t)(b * SEQ + qpos) * QW + h * 64 + hi * 8;
        f32x16 gt = f32x16{};
#pragma unroll
        for (int s4 = 0; s4 < 4; ++s4) {
            const f32x4 k0 = *(const f32x4*)(kp + 16 * s4), k1 = *(const f32x4*)(kp + 16 * s4 + 4);
            const bf16x8 qf = *(const bf16x8*)(qp + 16 * s4);
            const unsigned a0 = cvtpk(k0.x, k0.y), a1 = cvtpk(k0.z, k0.w), a2 = cvtpk(k1.x, k1.y), a3 = cvtpk(k1.z, k1.w);
            const u32x4 kh = (u32x4){a0, a1, a2, a3};
            const u32x4 kl = (u32x4){cvtpk(k0.x - bflo(a0), k0.y - bfhi(a0)), cvtpk(k0.z - bflo(a1), k0.w - bfhi(a1)), cvtpk(k1.x - bflo(a2), k1.y - bfhi(a2)), cvtpk(k1.z - bflo(a3), k1.w - bfhi(a3))};
            gt = __builtin_amdgcn_mfma_f32_32x32x16_bf16(__builtin_bit_cast(bf16x8, kl), qf, gt, 0, 0, 0);
            gt = __builtin_amdgcn_mfma_f32_32x32x16_bf16(__builtin_bit_cast(bf16x8, kh), qf, gt, 0, 0, 0);
        }
        float v0 = -INFINITY, v1 = -INFINITY, v2 = -INFINITY; int j0 = 64, j1 = 64, j2 = 64;
#pragma unroll
        for (int r = 0; r < 16; ++r) { const int j = crow(r, hi); const float g = j < i ? gt[r] : -INFINITY;
            if (g > v0) { v2 = v1; j2 = j1; v1 = v0; j1 = j0; v0 = g; j0 = j; }
            else if (g > v1) { v2 = v1; j2 = j1; v1 = g; j1 = j; }
            else if (g > v2) { v2 = g; j2 = j; } }
        {
            const float pv[3] = {__shfl_xor(v0, 32), __shfl_xor(v1, 32), __shfl_xor(v2, 32)}; const int pj[3] = {__shfl_xor(j0, 32), __shfl_xor(j1, 32), __shfl_xor(j2, 32)};
#pragma unroll
            for (int t = 0; t < 3; ++t) { const float g = pv[t]; const int j = pj[t];
                if (g > v0 || (g == v0 && j < j0)) { v2 = v1; j2 = j1; v1 = v0; j1 = j0; v0 = g; j0 = j; }
                else if (g > v1 || (g == v1 && j < j1)) { v2 = v1; j2 = j1; v1 = g; j1 = j; }
                else if (g > v2 || (g == v2 && j < j2)) { v2 = g; j2 = j; } }
        }
        const int nsel = i < 3 ? i : 3;
        int r0 = 0, r1 = 0, r2 = 0;
        if (hi == 0) { r0 = lds_add(&lcnt[j0], 1); if (nsel > 1) r1 = lds_add(&lcnt[j1], 1); if (nsel > 2) r2 = lds_add(&lcnt[j2], 1); }
        __syncthreads();
        if (F.tid < i) { const int n = lcnt[F.tid]; lbase[F.tid] = n > 0 ? (int)atomicAdd(&cur[bh * 32 + F.tid], (unsigned)n) : 0; }
        __syncthreads();
        if (hi == 0) {
            unsigned short* lb = lists + (size_t)bh * MB_LIST_STRIDE;
            lb[mb_list_off(j0) + lbase[j0] + r0] = (unsigned short)(qpos | (0 << 13));
            if (nsel > 1) lb[mb_list_off(j1) + lbase[j1] + r1] = (unsigned short)(qpos | (1 << 13));
            if (nsel > 2) lb[mb_list_off(j2) + lbase[j2] + r2] = (unsigned short)(qpos | (2 << 13));
        }
    }
}
__device__ __forceinline__ void kv_dma(Ctx& F, const bf16_t* kg, const bf16_t* vg, int bufoff) {
    const int l = F.lane;
#pragma unroll
    for (int i = 0; i < 4; ++i) { const int p = 4 * F.wave + i;
        __builtin_amdgcn_global_load_lds((const unsigned*)(kg + (size_t)(8 * p + (l >> 3)) * QW + ((l & 7) ^ ((l >> 3) & 7)) * 8), (LAS unsigned*)(F.lds + bufoff + p * 1024), 16, 0, 0);
        __builtin_amdgcn_global_load_lds((const unsigned*)(vg + (size_t)((p >> 3) * 64 + (p & 3) * 16 + (l >> 2)) * QW + ((p >> 2) & 1) * 32 + (l & 3) * 8), (LAS unsigned*)(F.lds + bufoff + 32768 + p * 1024), 16, 0, 0); }
}
__device__ __forceinline__ void softmax_step(f32x16 (&t)[2], float& m, float& l, f32x16 (&o)[2], LAS float* wsf, const LAS unsigned char* vt, int lane) {
    const int r32 = lane & 31, hi = lane >> 5;
    float rm = -INFINITY;
#pragma unroll
    for (int p = 0; p < 2; ++p)
#pragma unroll
        for (int r = 0; r < 16; ++r) rm = fmaxf(rm, t[p][r]);
    rm = fmaxf(rm, __shfl_xor(rm, 32));
    const float mn = fmaxf(m, rm);
    const float f = __builtin_amdgcn_exp2f(m - mn);
    m = mn;
    float s = 0.f; u32x4 pw[4];
#pragma unroll
    for (int p = 0; p < 2; ++p)
#pragma unroll
        for (int r = 0; r < 16; ++r) { const float e = __builtin_amdgcn_exp2f(t[p][r] - mn); t[p][r] = e; s += e; }
    l = l * f + s;
#pragma unroll
    for (int idx = 0; idx < 8; ++idx) { const int p = idx >> 2, g4 = (idx & 3) * 4; pw[idx >> 1][(idx & 1) * 2] = cvtpk(t[p][g4], t[p][g4 + 1]); pw[idx >> 1][(idx & 1) * 2 + 1] = cvtpk(t[p][g4 + 2], t[p][g4 + 3]); }
    if (__any(f != 1.f)) {
        if (hi == 0) wsf[r32] = f;
        LDS_WAIT();
#pragma unroll
        for (int g = 0; g < 4; ++g) { const f32x4 fv = *(const LAS f32x4*)(wsf + 8 * g + 4 * hi);
#pragma unroll
            for (int j = 0; j < 4; ++j) { o[0][4 * g + j] *= fv[j]; o[1][4 * g + j] *= fv[j]; } }
        LDS_WAIT();
    }
    pv64(o, vt, lane, pw);
}
__device__ __forceinline__ void qkt64(f32x16 (&t)[2], const LAS unsigned char* kt, const bf16x8 (&qr)[4], int lane) {
    const int r32 = lane & 31, hi = lane >> 5;
    t[0] = f32x16{}; t[1] = f32x16{};
    const LAS unsigned char* rp = kt + r32 * 128;
#pragma unroll
    for (int d0 = 0; d0 < 4; ++d0) {
        const int pos = ((2 * d0 + hi) ^ (r32 & 7)) * 16;
        const bf16x8 k0 = *(const LAS bf16x8*)(rp + pos), k1 = *(const LAS bf16x8*)(rp + 4096 + pos);
        t[0] = __builtin_amdgcn_mfma_f32_32x32x16_bf16(k0, qr[d0], t[0], 0, 0, 0); t[1] = __builtin_amdgcn_mfma_f32_32x32x16_bf16(k1, qr[d0], t[1], 0, 0, 0);
    }
}
__device__ __forceinline__ void phase5(Ctx& F) {
    LAS int* pre = (LAS int*)(F.lds + MISC_OFF + MO_PRE);
    LAS int* wtot = (LAS int*)(F.lds + MISC_OFF + MO_ENT);
    const unsigned* cur = (const unsigned*)(F.ws + WS_CTL) + CW_MBCUR;
    build_lut(F);
    int total;
    {
        const int p0 = 2 * F.tid, p1 = p0 + 1;
        const int n0 = p0 < 992 ? (int)cur[(p0 / 31) * 32 + (p0 % 31)] : 0, n1 = p1 < 992 ? (int)cur[(p1 / 31) * 32 + (p1 % 31)] : 0;
        const int c0 = (n0 + 255) >> 8, c1 = (n1 + 255) >> 8;
        const int s = c0 + c1; int v = s;
#pragma unroll
        for (int o = 1; o < 64; o <<= 1) { const int n = __shfl_up(v, o); if (F.lane >= o) v += n; }
        if (F.lane == 63) wtot[248 + F.wave] = v;
        __syncthreads();
        int woff = 0; total = 0;
#pragma unroll
        for (int w = 0; w < 8; ++w) { const int x = wtot[248 + w]; if (w < F.wave) woff += x; total += x; }
        const int excl = woff + v - s;
        pre[p0] = excl | (n0 << 16); pre[p1] = (excl + c0) | (n1 << 16);
        __syncthreads();
    }
    const unsigned short* lists = (const unsigned short*)(F.ws + WS_LMB);
    LAS float* wsf = (LAS float*)(F.lds + MISC_OFF + MO_WSF) + F.wave * 128;
    LAS int* ent = (LAS int*)(F.lds + MISC_OFF + MO_ENT) + F.wave * 32;
    const int lane = F.lane, r32 = lane & 31, hi = lane >> 5;
#define P5_UNIT(U, BH, J, C, N) do { int lo_ = 0, hi_ = 992; while (hi_ - lo_ > 1) { const int mid = (lo_ + hi_) >> 1; if ((pre[mid] & 0xffff) <= (U)) lo_ = mid; else hi_ = mid; } \
        const int w_ = pre[lo_]; BH = lo_ / 31; J = lo_ % 31; C = (U) - (w_ & 0xffff); N = w_ >> 16; } while (0)
#define P5_DMA(BH, J, BUF) do { const bf16_t* b_ = (const bf16_t*)(F.ws + WS_QMB) + (size_t)((BH) >> 3) * SEQ * QW + ((BH) & 7) * 64; kv_dma(F, b_ + 512 + (size_t)((J) * 256) * QW, b_ + 1024 + (size_t)((J) * 256) * QW, (BUF) * 65536); } while (0)
#define P5_ENTRY(BH, J, C, N, ACT, VALID, ENTRY) do { const int e0_ = (C) * 256 + F.wave * 32; ACT = e0_ < (N); VALID = ACT && (e0_ + r32) < (N); \
        const unsigned short* lb_ = lists + (size_t)(BH) * MB_LIST_STRIDE + mb_list_off(J); ENTRY = ACT ? (int)lb_[VALID ? e0_ + r32 : e0_] : 0; } while (0)
#define P5_QLOAD(BH, ENTRY, Q) do { const bf16_t* b_ = (const bf16_t*)(F.ws + WS_QMB) + (size_t)((BH) >> 3) * SEQ * QW + ((BH) & 7) * 64 + (size_t)((ENTRY) & 8191) * QW + hi * 8; \
        _Pragma("unroll") for (int d0 = 0; d0 < 4; ++d0) Q[d0] = *(const bf16x8*)(b_ + d0 * 16); } while (0)
    int u = F.bid, bh = 0, j = 0, c = 0, n = 0, buf = 0, bhn = 0, jn = 0, cn = 0, nn = 0;
    bool act = false, valid = false, actn = false, validn = false; int entry = 0, entryn = 0; bf16x8 qr[4] = {};
    if (u < total) {
        P5_UNIT(u, bh, j, c, n); P5_ENTRY(bh, j, c, n, act, valid, entry);
        if (u + F.G < total) { P5_UNIT(u + F.G, bhn, jn, cn, nn); P5_ENTRY(bhn, jn, cn, nn, actn, validn, entryn); }
        P5_QLOAD(bh, entry, qr); P5_DMA(bh, j, 0);
    }
    asm volatile("s_waitcnt vmcnt(0)" : "+v"(qr[0]), "+v"(qr[1]), "+v"(qr[2]), "+v"(qr[3]), "+v"(entry), "+v"(entryn) :: "memory");
    for (; u < total; u += F.G) {
        const bool has_next = u + F.G < total, has_n2 = u + 2 * F.G < total;
        int bh2 = 0, j2 = 0, c2 = 0, n2 = 0;
        if (has_n2) P5_UNIT(u + 2 * F.G, bh2, j2, c2, n2);
        const int h = bh & 7;
        const int qpos = entry & 8191, slot = entry >> 13;
        LDS_WAIT();
        __builtin_amdgcn_s_barrier();
        bool act2 = false, valid2 = false; int entry2 = 0; bf16x8 qn[4] = {};
        if (has_next) { P5_QLOAD(bhn, entryn, qn); P5_DMA(bhn, jn, buf ^ 1); }
        if (has_n2) P5_ENTRY(bh2, j2, c2, n2, act2, valid2, entry2);
        const LAS unsigned char* kimg = F.lds + buf * 65536; const LAS unsigned char* vimg = kimg + 32768;
        float m = -INFINITY, l = 0.f; f32x16 o[2];
        if (act) {
            if (hi == 0) ent[r32] = valid ? entry : -1;
            o[0] = f32x16{}; o[1] = f32x16{};
            const LAS float* lut = (const LAS float*)(F.lds + MISC_OFF + MO_LUT) + h * 132;
            const float bfar = lut[128];
#pragma unroll 1
            for (int st = 0; st < 4; ++st) {
                f32x16 t[2]; qkt64(t, kimg + st * 8192, qr, lane);
                const int kbase = j * 256 + st * 64;
                const bool far = __all(qpos - (kbase + 63) >= 128);
                if (far) {
#pragma unroll
                    for (int pp = 0; pp < 2; ++pp)
#pragma unroll
                        for (int r = 0; r < 16; ++r) t[pp][r] = t[pp][r] * LOG2E + bfar;
                } else {
#pragma unroll
                    for (int pp = 0; pp < 2; ++pp)
#pragma unroll
                        for (int r = 0; r < 16; ++r) { int d = qpos - (kbase + 32 * pp + crow(r, hi)); d = d < 128 ? d : 128; d = d > 0 ? d : 0; t[pp][r] = t[pp][r] * LOG2E + lut[d]; }
                }
                softmax_step(t, m, l, o, wsf, vimg + st * 8192, lane);
            }
        }
        asm volatile("s_waitcnt vmcnt(0)" : "+v"(qn[0]), "+v"(qn[1]), "+v"(qn[2]), "+v"(qn[3]), "+v"(entry2) :: "memory");
#pragma unroll
        for (int d0 = 0; d0 < 4; ++d0) qr[d0] = qn[d0];
        if (act) {
            l += __shfl_xor(l, 32);
            const float rl = 1.f / l;
            if (hi == 0) { wsf[r32] = rl; if (valid) ((float*)(F.ws + WS_PLSE))[((size_t)bh * SEQ + qpos) * 3 + slot] = m + __log2f(l); }
            LDS_WAIT();
            {
                LAS bf16_t* stg = (LAS bf16_t*)(F.lds + MISC_OFF + MO_STG + F.wave * 2048);
                bf16_t* po = (bf16_t*)(F.ws + WS_PO);
#pragma unroll
                for (int d0 = 0; d0 < 2; ++d0) {
#pragma unroll
                    for (int r = 0; r < 16; ++r) { const int q = crow(r, hi); stg[q * 32 + r32] = (bf16_t)(cvtpk(o[d0][r] * wsf[q], 0.f) & 0xffffu); }
                    LDS_WAIT();
#pragma unroll
                    for (int it2 = 0; it2 < 2; ++it2) { const int row = it2 * 16 + (lane >> 2), ch = lane & 3; const int en = ent[row];
                        const u32x4 v = *(const LAS u32x4*)(stg + row * 32 + ch * 8);
                        if (en >= 0) *(u32x4*)(po + (((size_t)bh * SEQ + (en & 8191)) * 3 + (en >> 13)) * 64 + d0 * 32 + ch * 8) = v; }
                    LDS_WAIT();
                }
            }
        }
        bh = bhn; j = jn; c = cn; n = nn; act = actn; valid = validn; entry = entryn;
        bhn = bh2; jn = j2; cn = c2; nn = n2; actn = act2; validn = valid2; entryn = entry2;
        buf ^= 1;
    }
#undef P5_ENTRY
#undef P5_QLOAD
#undef P5_UNIT
#undef P5_DMA
    asm volatile("s_waitcnt vmcnt(0)" ::: "memory");
    __syncthreads();
}
__device__ __forceinline__ void phase6(Ctx& F) {
    build_lut(F);
    LAS float* wsf = (LAS float*)(F.lds + MISC_OFF + MO_WSF) + F.wave * 128;
    const int lane = F.lane, r32 = lane & 31, hi = lane >> 5, w = F.wave;
#define P6_DMA(U, BUF) do { const int bh_ = (U) >> 5, i_ = 31 - ((U) & 31); const bf16_t* b_ = (const bf16_t*)(F.ws + WS_QMB) + (size_t)(bh_ >> 3) * SEQ * QW + (bh_ & 7) * 64; \
        kv_dma(F, b_ + 512 + (size_t)(i_ * 256) * QW, b_ + 1024 + (size_t)(i_ * 256) * QW, (BUF) * 65536); } while (0)
#define P6_QLOAD(U, Q, L0, L1, L2) do { const int bh_ = (U) >> 5, i_ = 31 - ((U) & 31), qp_ = i_ * 256 + w * 32 + r32, ns_ = i_ < 3 ? i_ : 3; \
        const bf16_t* b_ = (const bf16_t*)(F.ws + WS_QMB) + (size_t)(bh_ >> 3) * SEQ * QW + (bh_ & 7) * 64 + (size_t)qp_ * QW + hi * 8; \
        _Pragma("unroll") for (int d0 = 0; d0 < 4; ++d0) Q[d0] = *(const bf16x8*)(b_ + d0 * 16); \
        const float* pl_ = (const float*)(F.ws + WS_PLSE) + ((size_t)bh_ * SEQ + qp_) * 3; \
        L0 = -INFINITY; L1 = -INFINITY; L2 = -INFINITY; if (ns_ > 0) L0 = pl_[0]; if (ns_ > 1) L1 = pl_[1]; if (ns_ > 2) L2 = pl_[2]; } while (0)
    int buf = 0;
    bf16x8 qr[4] = {}; float ls0 = -INFINITY, ls1 = -INFINITY, ls2 = -INFINITY;
    if (F.bid < 32 * 32) { P6_QLOAD(F.bid, qr, ls0, ls1, ls2); P6_DMA(F.bid, 0); }
    asm volatile("s_waitcnt vmcnt(0)" : "+v"(qr[0]), "+v"(qr[1]), "+v"(qr[2]), "+v"(qr[3]), "+v"(ls0), "+v"(ls1), "+v"(ls2) :: "memory");
    for (int u = F.bid; u < 32 * 32; u += F.G) {
        const int bh = u >> 5, i = 31 - (u & 31), b = bh >> 3, h = bh & 7;
        const int ql = w * 32 + r32;
        const int nsel = i < 3 ? i : 3;
        const bool has_next = u + F.G < 32 * 32;
        LDS_WAIT();
        __builtin_amdgcn_s_barrier();
        if (has_next) P6_DMA(u + F.G, buf ^ 1);
        const LAS unsigned char* kimg = F.lds + buf * 65536; const LAS unsigned char* vimg = kimg + 32768;
        float m = -INFINITY, l = 0.f; f32x16 o[2]; o[0] = f32x16{}; o[1] = f32x16{};
        const LAS float* lut = (const LAS float*)(F.lds + MISC_OFF + MO_LUT) + h * 132;
        const int nst = (w >> 1) + 1;
#pragma unroll 1
        for (int st = 0; st < nst; ++st) {
            f32x16 t[2]; qkt64(t, kimg + st * 8192, qr, lane);
#pragma unroll
            for (int pp = 0; pp < 2; ++pp)
#pragma unroll
                for (int r = 0; r < 16; ++r) { const int d = ql - (st * 64 + 32 * pp + crow(r, hi)); const int dc = d < 128 ? (d > 0 ? d : 0) : 128; const float v = t[pp][r] * LOG2E + lut[dc]; t[pp][r] = d >= 0 ? v : -INFINITY; }
            softmax_step(t, m, l, o, wsf, vimg + st * 8192, lane);
        }
        l += __shfl_xor(l, 32);
        const float M = fmaxf(fmaxf(m, ls0), fmaxf(ls1, ls2));
        const float eo = __builtin_amdgcn_exp2f(m - M), e0 = __builtin_amdgcn_exp2f(ls0 - M), e1 = __builtin_amdgcn_exp2f(ls1 - M), e2 = __builtin_amdgcn_exp2f(ls2 - M);
        const float rden = 1.f / (l * eo + e0 + e1 + e2);
        if (hi == 0) *(LAS f32x4*)(wsf + 4 * r32) = (f32x4){eo * rden, e0 * rden, e1 * rden, e2 * rden};
        LDS_WAIT();
#pragma unroll
        for (int r = 0; r < 16; ++r) { const float fo = wsf[4 * crow(r, hi)]; o[0][r] *= fo; o[1][r] *= fo; }
        LDS_WAIT();
        __builtin_amdgcn_s_barrier();
        {
            const bf16_t* po = (const bf16_t*)(F.ws + WS_PO) + ((size_t)bh * SEQ + i * 256 + w * 32) * 3 * 64;
            u32x4 pv[4][3];
#pragma unroll
            for (int it4 = 0; it4 < 4; ++it4) { const int row = it4 * 8 + (lane >> 3), ch = lane & 7;
#pragma unroll
                for (int sl = 0; sl < 3; ++sl) { pv[it4][sl] = (u32x4){0u, 0u, 0u, 0u}; if (sl < nsel) pv[it4][sl] = *(const u32x4*)(po + (size_t)(row * 3 + sl) * 64 + ch * 8); } }
            bf16x8 qn[4] = {}; float ln0 = -INFINITY, ln1 = -INFINITY, ln2 = -INFINITY;
            if (has_next) P6_QLOAD(u + F.G, qn, ln0, ln1, ln2);
            LAS bf16_t* stg = (LAS bf16_t*)(F.lds + buf * 65536 + w * 4096);
#pragma unroll
            for (int r = 0; r < 16; ++r) { const int orow = crow(r, hi);
#pragma unroll
                for (int d0 = 0; d0 < 2; ++d0) stg[orow * 64 + d0 * 32 + r32] = (bf16_t)(cvtpk(o[d0][r], 0.f) & 0xffffu); }
            LDS_WAIT();
            asm volatile("s_waitcnt vmcnt(0)" : "+v"(qn[0]), "+v"(qn[1]), "+v"(qn[2]), "+v"(qn[3]), "+v"(ln0), "+v"(ln1), "+v"(ln2) :: "memory");
#pragma unroll
            for (int it4 = 0; it4 < 4; ++it4)
#pragma unroll
                for (int sl = 0; sl < 3; ++sl) asm volatile("" : "+v"(pv[it4][sl]));
            bf16_t* dst = (bf16_t*)(F.ws + WS_OB) + (size_t)(b * SEQ + i * 256 + w * 32) * 1024 + 512 + h * 64;
#pragma unroll
            for (int it4 = 0; it4 < 4; ++it4) { const int row = it4 * 8 + (lane >> 3), ch = lane & 7;
                const u32x4 ov = *(const LAS u32x4*)(stg + row * 64 + ch * 8);
                float a[8] = {bflo(ov.x), bfhi(ov.x), bflo(ov.y), bfhi(ov.y), bflo(ov.z), bfhi(ov.z), bflo(ov.w), bfhi(ov.w)};
                const f32x4 fc = *(const LAS f32x4*)(wsf + 4 * row);
#pragma unroll
                for (int sl = 0; sl < 3; ++sl) if (sl < nsel) { const u32x4 pvv = pv[it4][sl]; const float f = fc[1 + sl];
                    a[0] += f * bflo(pvv.x); a[1] += f * bfhi(pvv.x); a[2] += f * bflo(pvv.y); a[3] += f * bfhi(pvv.y); a[4] += f * bflo(pvv.z); a[5] += f * bfhi(pvv.z); a[6] += f * bflo(pvv.w); a[7] += f * bfhi(pvv.w); }
                u32x4 w4; w4.x = cvtpk(a[0], a[1]); w4.y = cvtpk(a[2], a[3]); w4.z = cvtpk(a[4], a[5]); w4.w = cvtpk(a[6], a[7]);
                *(u32x4*)(dst + (size_t)row * 1024 + ch * 8) = w4; }
            LDS_WAIT();
#pragma unroll
            for (int d0 = 0; d0 < 4; ++d0) qr[d0] = qn[d0];
            ls0 = ln0; ls1 = ln1; ls2 = ln2;
        }
        buf ^= 1;
    }
#undef P6_DMA
#undef P6_QLOAD
    asm volatile("s_waitcnt vmcnt(0)" ::: "memory");
    __syncthreads();
}

struct BranchSched {
    const char* A; const char* Bt; int G, c; int R[2], C[2];
    __device__ __forceinline__ bool next(int i, gm::UnitD& u) {
        int pm, pn; if (!gm::static_tile(MT, 1024, G, c, i, pm, pn)) return false;
        u.a = A; u.b = Bt + (size_t)(pn * 256) * 1024 * 2;
#pragma unroll
        for (int h = 0; h < 2; ++h)
#pragma unroll
            for (int j = 0; j < 2; ++j) u.va[h][j] = (unsigned)((pm * 256 + h * 128 + R[j]) * 1024 + C[j]) * 2u;
        u.e0 = pm; u.e1 = pn; u.e2 = 0; u.e3 = 0; return true;
    }
};
struct EpiBranch {
    const bf16_t* g; bf16_t* merged;
    static __device__ __forceinline__ float ratio(float gs, float gm_) { return (1.f + fminf(__expf(-gm_), 1e30f)) * __builtin_amdgcn_rcpf(1.f + __expf(-gs)); }
    __device__ __forceinline__ void mid(f32x4 (&acc)[2][2][4][2], const gm::UnitD& u, int wr, int wc, int fr, int fq) const {
        const bf16_t* gp = g + (size_t)(u.e0 * 256 + wr * 64 + fr) * 2048 + u.e1 * 256 + wc * 32 + 8 * fq;
#pragma unroll
        for (int ai = 0; ai < 2; ++ai)
#pragma unroll
            for (int m = 0; m < 4; m += 2) {
                asm volatile("" : "+v"(gp) :: "memory");
                u32x4 gs[2][2], gq[2][2];
#pragma unroll
                for (int mm = 0; mm < 2; ++mm)
#pragma unroll
                    for (int bj = 0; bj < 2; ++bj) { gs[mm][bj] = *(const u32x4*)(gp + (size_t)mm * 16 * 2048 + bj * 128); gq[mm][bj] = *(const u32x4*)(gp + (size_t)mm * 16 * 2048 + 1024 + bj * 128); }
#pragma unroll
                for (int mm = 0; mm < 2; ++mm)
#pragma unroll
                    for (int bj = 0; bj < 2; ++bj) { const u32x4 a = gs[mm][bj], b = gq[mm][bj];
                        f32x4& c0 = acc[ai][bj][m + mm][0]; f32x4& c1 = acc[ai][bj][m + mm][1];
                        c0[0] *= ratio(bflo(a.x), bflo(b.x)); c0[1] *= ratio(bfhi(a.x), bfhi(b.x)); c0[2] *= ratio(bflo(a.y), bflo(b.y)); c0[3] *= ratio(bfhi(a.y), bfhi(b.y));
                        c1[0] *= ratio(bflo(a.z), bflo(b.z)); c1[1] *= ratio(bfhi(a.z), bfhi(b.z)); c1[2] *= ratio(bflo(a.w), bflo(b.w)); c1[3] *= ratio(bfhi(a.w), bfhi(b.w));
                        asm volatile("" : "+v"(c0), "+v"(c1) :: "memory"); }
                gp += (m == 2 ? 96 : 32) * 2048; }
    }
    __device__ __forceinline__ void operator()(const f32x4 (&acc)[2][2][4][2], const gm::UnitD& u, int wr, int wc, int fr, int fq) const {
        const int row0 = u.e0 * 256 + wr * 64 + fr, col0 = u.e1 * 256 + wc * 32 + 8 * fq;
#pragma unroll
        for (int ai = 0; ai < 2; ++ai)
#pragma unroll
            for (int m = 0; m < 4; ++m) { const size_t row = (size_t)(row0 + ai * 128 + m * 16);
#pragma unroll
                for (int bj = 0; bj < 2; ++bj) { const u32x4 gm_ = *(const u32x4*)(g + row * 2048 + 1024 + col0 + bj * 128);
                    const float b[8] = {bflo(gm_.x), bfhi(gm_.x), bflo(gm_.y), bfhi(gm_.y), bflo(gm_.z), bfhi(gm_.z), bflo(gm_.w), bfhi(gm_.w)};
                    float r[8];
#pragma unroll
                    for (int j = 0; j < 8; ++j) r[j] = acc[ai][bj][m][j >> 2][j & 3] * __builtin_amdgcn_rcpf(1.f + fminf(__expf(-b[j]), 1e30f));
                    u32x4 w; w.x = cvtpk(r[0], r[1]); w.y = cvtpk(r[2], r[3]); w.z = cvtpk(r[4], r[5]); w.w = cvtpk(r[6], r[7]);
                    *(u32x4*)(merged + row * 1024 + col0 + bj * 128) = w; } }
    }
};
__device__ __forceinline__ void phase7(Ctx& F) {
    BranchSched S; S.A = (const char*)(F.ws + WS_OB); S.Bt = (const char*)(F.ws + WS_WBRT); S.G = F.G; S.c = F.bid; gm::stage_geom(F.tid, S.R, S.C);
    EpiBranch E{(const bf16_t*)(F.ws + WS_G), (bf16_t*)(F.ws + WS_MERGED)};
    gm::gemm_phase<true, true>(F.lds, 1024, S, E);
}
struct OutSched {
    const char* A; const char* Bt; int G, c; int R[2], C[2];
    __device__ __forceinline__ bool next(int i, gm::UnitD& u) {
        int pm, pn; if (!gm::static_tile(MT, 1024, G, c, i, pm, pn)) return false;
        u.a = A; u.b = Bt + (size_t)pn * 256 * 1024 * 2;
#pragma unroll
        for (int h = 0; h < 2; ++h)
#pragma unroll
            for (int j = 0; j < 2; ++j) u.va[h][j] = (unsigned)((pm * 256 + h * 128 + R[j]) * 1024 + C[j]) * 2u;
        u.e0 = pm; u.e1 = pn; u.e2 = 0; u.e3 = 0; return true;
    }
};
struct EpiOut {
    const float* x; const float* mod; bf16_t* out;
    __device__ __forceinline__ void operator()(const f32x4 (&acc)[2][2][4][2], const gm::UnitD& u, int wr, int wc, int fr, int fq) const {
        const int pm = u.e0, pn = u.e1, b = (pm * 256) / SEQ;
        const int row0 = pm * 256 + wr * 64 + fr, col0 = pn * 256 + wc * 32 + 4 * fq;
        f32x4 gt[2][2];
#pragma unroll
        for (int bj = 0; bj < 2; ++bj)
#pragma unroll
            for (int n = 0; n < 2; ++n) gt[bj][n] = *(const f32x4*)(mod + b * NMOD + 2 * DM + col0 + bj * 128 + n * 16);
#pragma unroll
        for (int ai = 0; ai < 2; ++ai)
#pragma unroll
            for (int m = 0; m < 4; ++m) { const size_t off = (size_t)(row0 + ai * 128 + m * 16) * DM + col0;
#pragma unroll
                for (int bj = 0; bj < 2; ++bj)
#pragma unroll
                    for (int n = 0; n < 2; ++n) { const f32x4 xv = *(const f32x4*)(x + off + bj * 128 + n * 16); const f32x4 r = xv + gt[bj][n] * acc[ai][bj][m][n];
                        u32x2 pk; pk.x = cvtpk(r.x, r.y); pk.y = cvtpk(r.z, r.w); *(u32x2*)(out + off + bj * 128 + n * 16) = pk; } }
    }
};
__device__ __forceinline__ void phase8(Ctx& F) {
    OutSched S; S.A = (const char*)(F.ws + WS_MERGED); S.Bt = (const char*)(F.ws + WS_WOUTT); S.G = F.G; S.c = F.bid; gm::stage_geom(F.tid, S.R, S.C);
    EpiOut E{inp(F, I_X), (const float*)(F.ws + WS_SMALL + SM_MOD), (bf16_t*)(F.ws + WS_X1B)};
    gm::gemm_phase<false>(F.lds, 1024, S, E);
}

constexpr int NR_SSQ = MO_PRE + 1024;
constexpr int NR_RS = MO_PRE + 3072;
__device__ __forceinline__ void phase_n2r(Ctx& F, int rr) {
    const bf16_t* x1 = (const bf16_t*)(F.ws + WS_X1B); const float* gvec = (const float*)(F.ws + WS_SMALL + SM_GVEC); const float* cb = (const float*)(F.ws + WS_SMALL + SM_CB);
    const float* mod = (const float*)(F.ws + WS_SMALL + SM_MOD); const float* rbias = inp(F, I_RB);
    unsigned char* H2 = (unsigned char*)(F.ws + WS_H2) + (size_t)rr * RT * DM; int* tokl = (int*)(F.ws + WS_TOKL) + (size_t)rr * 64 * RT; float* wl = (float*)(F.ws + WS_WL) + (size_t)rr * 64 * RT; int* tpos = (int*)(F.ws + WS_TPOS) + (size_t)rr * RT * 8;
    unsigned* cur = (unsigned*)(F.ws + WS_CTL) + CW_MOECUR + rr * 64;
    LAS int* lcnt = (LAS int*)(F.lds + MISC_OFF + MO_PRE); LAS int* lbase = lcnt + 64;
    LAS float* part = (LAS float*)(F.lds);
    LAS float* ssqp = (LAS float*)(F.lds + MISC_OFF + NR_SSQ); LAS float* rsl = (LAS float*)(F.lds + MISC_OFF + NR_RS);
    const int lane = F.lane, w = F.wave, i16 = lane & 15, kk = lane >> 4;
    for (int u = F.bid; u < RT / 64; u += F.G) {
        if (F.tid < 64) lcnt[F.tid] = 0;
        const int tokb = rr * RT + u * 64, b = tokb / SEQ;
        {
            bf16x8 fah[4][4], fal[4][4];
            {
                const float* gp = gvec + b * DM + 128 * w + 8 * kk;
                f32x4 gv[4][2];
#pragma unroll
                for (int s4 = 0; s4 < 4; ++s4) { gv[s4][0] = *(const f32x4*)(gp + 32 * s4); gv[s4][1] = *(const f32x4*)(gp + 32 * s4 + 4); }
#pragma unroll
                for (int tt = 0; tt < 4; ++tt) {
                    const bf16_t* xp = x1 + (size_t)(tokb + tt * 16 + i16) * DM + 128 * w + 8 * kk;
                    u32x4 xb[4];
#pragma unroll
                    for (int s4 = 0; s4 < 4; ++s4) xb[s4] = *(const u32x4*)(xp + 32 * s4);
                    float ssq = 0.f;
#pragma unroll
                    for (int s4 = 0; s4 < 4; ++s4) {
                        u32x4 ah, al;
#pragma unroll
                        for (int q = 0; q < 2; ++q) { const unsigned b0 = q ? xb[s4].z : xb[s4].x, b1 = q ? xb[s4].w : xb[s4].y; const f32x4 xv = (f32x4){bflo(b0), bfhi(b0), bflo(b1), bfhi(b1)}; ssq += (xv.x * xv.x + xv.y * xv.y) + (xv.z * xv.z + xv.w * xv.w);
                            const f32x4 a = xv * gv[s4][q];
                            const unsigned h0 = cvtpk(a.x, a.y), h1 = cvtpk(a.z, a.w);
                            ah[2 * q] = h0; ah[2 * q + 1] = h1; al[2 * q] = cvtpk(a.x - bflo(h0), a.y - bfhi(h0)); al[2 * q + 1] = cvtpk(a.z - bflo(h1), a.w - bfhi(h1)); }
                        fah[tt][s4] = __builtin_bit_cast(bf16x8, ah); fal[tt][s4] = __builtin_bit_cast(bf16x8, al);
                    }
                    ssq += __shfl_xor(ssq, 16); ssq += __shfl_xor(ssq, 32); if (kk == 0) ssqp[w * 64 + tt * 16 + i16] = ssq;
                }
            }
#pragma unroll 1
            for (int eh = 0; eh < 2; ++eh) {
                bf16x8 wh[2][4], wl_[2][4];
                {
                    const bf16_t* ph = (const bf16_t*)(F.ws + WS_SMALL + SM_WRH) + (size_t)(eh * 32 + i16) * DM + 128 * w + 8 * kk;
                    const bf16_t* pl = (const bf16_t*)(F.ws + WS_SMALL + SM_WRL) + (size_t)(eh * 32 + i16) * DM + 128 * w + 8 * kk;
#pragma unroll
                    for (int c = 0; c < 2; ++c)
#pragma unroll
                        for (int s4 = 0; s4 < 4; ++s4) { wh[c][s4] = *(const bf16x8*)(ph + (size_t)c * 16 * DM + 32 * s4); wl_[c][s4] = *(const bf16x8*)(pl + (size_t)c * 16 * DM + 32 * s4); }
                }
#pragma unroll
                for (int tt = 0; tt < 4; ++tt) {
                    f32x4 acc[2]; acc[0] = acc[1] = (f32x4){0.f, 0.f, 0.f, 0.f};
#pragma unroll
                    for (int s4 = 0; s4 < 4; ++s4)
#pragma unroll
                        for (int c = 0; c < 2; ++c) {
                            acc[c] = __builtin_amdgcn_mfma_f32_16x16x32_bf16(fal[tt][s4], wh[c][s4], acc[c], 0, 0, 0);
                            acc[c] = __builtin_amdgcn_mfma_f32_16x16x32_bf16(fah[tt][s4], wl_[c][s4], acc[c], 0, 0, 0);
                            acc[c] = __builtin_amdgcn_mfma_f32_16x16x32_bf16(fah[tt][s4], wh[c][s4], acc[c], 0, 0, 0); }
#pragma unroll
                    for (int c = 0; c < 2; ++c)
#pragma unroll
                        for (int reg = 0; reg < 4; ++reg) part[(w * 64 + tt * 16 + 4 * kk + reg) * 64 + eh * 32 + 16 * c + i16] = acc[c][reg];
                }
            }
        }
        __syncthreads();
        const int tl = F.tid >> 3, g = F.tid & 7;
        int my_e; float my_w; int my_rank;
        {
            float ssq = 0.f;
#pragma unroll
            for (int q = 0; q < 8; ++q) ssq += ssqp[q * 64 + tl];
            const float rstd = rsqrtf(ssq * (1.f / DM) + EPS);
            if (g == 0) rsl[tl] = rstd;
            float s8[8], c8[8];
            {
                f32x4 lo4 = (f32x4){0.f, 0.f, 0.f, 0.f}, hi4 = lo4;
#pragma unroll
                for (int q = 0; q < 8; ++q) { const LAS f32x4* pp = (const LAS f32x4*)(part + (q * 64 + tl) * 64 + 8 * g); lo4 += pp[0]; hi4 += pp[1]; }
                const f32x4 cb0 = *(const f32x4*)(cb + b * 64 + 8 * g), cb1 = *(const f32x4*)(cb + b * 64 + 8 * g + 4), rb0 = *(const f32x4*)(rbias + 8 * g), rb1 = *(const f32x4*)(rbias + 8 * g + 4);
#pragma unroll
                for (int j = 0; j < 4; ++j) { s8[j] = sigmoidf_(lo4[j] * rstd + cb0[j]); s8[4 + j] = sigmoidf_(hi4[j] * rstd + cb1[j]); c8[j] = s8[j] + rb0[j]; c8[4 + j] = s8[4 + j] + rb1[j]; }
            }
            float m1 = -INFINITY, m2 = -INFINITY;
#pragma unroll
            for (int j = 0; j < 8; ++j) { const float v = c8[j]; if (v > m1) { m2 = m1; m1 = v; } else if (v > m2) m2 = v; }
            const float gs = m1 + m2;
            int rank = 0;
#pragma unroll
            for (int g2 = 0; g2 < 8; ++g2) { const float o = __shfl(gs, g2, 8); rank += (o > gs || (o == gs && g2 < g)) ? 1 : 0; }
            if (rank >= 4) {
#pragma unroll
                for (int j = 0; j < 8; ++j) c8[j] = -INFINITY;
            }
            int sel_e[8]; float sk[8]; float wsum = 0.f;
#pragma unroll
            for (int k = 0; k < 8; ++k) {
                float bv = -INFINITY, bs = 0.f; int be = 8 * g;
#pragma unroll
                for (int j = 0; j < 8; ++j) if (c8[j] > bv) { bv = c8[j]; be = 8 * g + j; bs = s8[j]; }
#pragma unroll
                for (int o = 1; o < 8; o <<= 1) { const float ov = __shfl_xor(bv, o, 8), os = __shfl_xor(bs, o, 8); const int oe = __shfl_xor(be, o, 8); if (ov > bv || (ov == bv && oe < be)) { bv = ov; be = oe; bs = os; } }
                sel_e[k] = be; sk[k] = bs; wsum += bs;
#pragma unroll
                for (int j = 0; j < 8; ++j) if (be == 8 * g + j) c8[j] = -INFINITY;
            }
            my_e = sel_e[0]; my_w = sk[0];
#pragma unroll
            for (int k = 1; k < 8; ++k) if (g == k) { my_e = sel_e[k]; my_w = sk[k]; }
            my_w *= 2.5f / wsum;
            my_rank = lds_add(&lcnt[my_e], 1);
        }
        __syncthreads();
        if (F.tid < 64) { const int n = lcnt[F.tid]; lbase[F.tid] = n > 0 ? (int)atomicAdd(&cur[F.tid], (unsigned)n) : 0; }
        __syncthreads();
        { const int tok = tokb + tl, pos = lbase[my_e] + my_rank; tokl[my_e * RT + pos] = tok * 8 + g; wl[my_e * RT + pos] = my_w; tpos[(tok - rr * RT) * 8 + g] = (my_e << 16) | pos; }
#pragma unroll 1
        for (int r0 = 0; r0 < 8; r0 += 4) {
            f32x4 xv[4][4];
#pragma unroll
            for (int r = 0; r < 4; ++r) { const u32x2* xr = (const u32x2*)(x1 + (size_t)(tokb + w * 8 + r0 + r) * DM) + lane;
#pragma unroll
                for (int j = 0; j < 4; ++j) { const u32x2 q = xr[64 * j]; xv[r][j] = (f32x4){bflo(q.x), bfhi(q.x), bflo(q.y), bfhi(q.y)}; } }
#pragma unroll
            for (int j = 0; j < 4; ++j) { const int col = 4 * lane + 256 * j; const f32x4 gq = *(const f32x4*)(gvec + b * DM + col), sh = *(const f32x4*)(mod + b * NMOD + 3 * DM + col);
#pragma unroll
                for (int r = 0; r < 4; ++r) { const int tl2 = w * 8 + r0 + r; const f32x4 hv = (xv[r][j] * rsl[tl2]) * gq + sh;
                    int o = 0; o = __builtin_amdgcn_cvt_pk_fp8_f32(f8c(hv.x * 16.f), f8c(hv.y * 16.f), o, false); o = __builtin_amdgcn_cvt_pk_fp8_f32(f8c(hv.z * 16.f), f8c(hv.w * 16.f), o, true);
                    ((unsigned*)(H2 + (size_t)(tokb - rr * RT + tl2) * DM) + lane)[64 * j] = (unsigned)o; } }
        }
        __syncthreads();
    }
}
constexpr int MO_TE = 4224;
struct MoeTabs { const LAS unsigned short* te; const LAS int* tb; const LAS int* cnt; int TR; };
__device__ __forceinline__ MoeTabs build_moe_tabs(Ctx& F, int rr) {
    LAS unsigned short* te = (LAS unsigned short*)(F.lds + MISC_OFF + MO_TE); LAS int* tb = (LAS int*)(F.lds + MISC_OFF + MO_TE + 1536); LAS int* cnt = tb + 72;
    const unsigned* cur = (const unsigned*)(F.ws + WS_CTL) + CW_MOECUR + rr * 64;
    __syncthreads();
    if (F.tid == 0) { int acc = 0; for (int e = 0; e < 64; ++e) { const int c = (int)cur[e]; cnt[e] = c; tb[e] = acc; acc += (c + 255) >> 8; } tb[64] = acc; tb[65] = acc + RT / 256; cnt[64] = RT; }
    __syncthreads();
    const int TR = tb[64];
    for (int e = F.tid >> 3; e < 65; e += 64) for (int t = tb[e] + (F.tid & 7); t < tb[e + 1]; t += 8) te[t] = (unsigned short)e;
    __syncthreads();
    MoeTabs T; T.te = te; T.tb = tb; T.cnt = cnt; T.TR = TR; return T;
}
struct Moe1Sched {
    const char* H2; const char* W1T; const int* tokl; MoeTabs T; int G, c, rr; int R[2], C[2];
    __device__ __forceinline__ bool next(int i, gm::UnitD& u) {
        const int uu = i * G + c; const int nt = T.TR + RT / 256;
        if (uu >= nt * 2) return false;
        const int tile = uu >> 1, pn = uu & 1, e = T.te[tile], rt = tile - T.tb[e], cnt = T.cnt[e];
        u.a = H2; u.b = W1T + (size_t)(e * 512 + pn * 256) * 1024;
#pragma unroll
        for (int h = 0; h < 2; ++h)
#pragma unroll
            for (int j = 0; j < 2; ++j) { const int idx = rt * 256 + h * 128 + R[j]; int trow;
                if (e < 64) { const int ent = tokl[e * RT + (idx < cnt ? idx : rt * 256)]; trow = (ent >> 3) - rr * RT; } else trow = idx;
                u.va[h][j] = (unsigned)(trow * 512 + C[j]) * 2u; }
        u.e0 = tile; u.e1 = pn; u.e2 = e; u.e3 = rt; return true;
    }
};
struct EpiMoe1 {
    bf16_t* act; const float* wl; const LAS int* cnt;
    __device__ __forceinline__ void operator()(const f32x4 (&acc)[2][2][4][2], const gm::UnitD& u, int wr, int wc, int fr, int fq) const {
        const int row0 = u.e0 * 256 + wr * 64 + fr, col0 = u.e1 * 128 + wc * 32 + 8 * fq, e = u.e2, n = cnt[e];
        float rw[2][4];
#pragma unroll
        for (int ai = 0; ai < 2; ++ai)
#pragma unroll
            for (int m = 0; m < 4; ++m) { const int idx = u.e3 * 256 + ai * 128 + wr * 64 + m * 16 + fr; rw[ai][m] = e < 64 ? (idx < n ? wl[e * RT + idx] : 0.f) : 1.f; }
#pragma unroll
        for (int ai = 0; ai < 2; ++ai)
#pragma unroll
            for (int m = 0; m < 4; ++m) { const float ww = rw[ai][m] * (32.f / 4096.f); const f32x4 g0 = acc[ai][0][m][0] * (1.f / 4096.f), g1 = acc[ai][0][m][1] * (1.f / 4096.f), u0 = acc[ai][1][m][0] * ww, u1 = acc[ai][1][m][1] * ww;
                int w0 = 0, w1 = 0;
                w0 = __builtin_amdgcn_cvt_pk_fp8_f32(f8c(siluf_(g0[0]) * u0[0]), f8c(siluf_(g0[1]) * u0[1]), w0, false); w0 = __builtin_amdgcn_cvt_pk_fp8_f32(f8c(siluf_(g0[2]) * u0[2]), f8c(siluf_(g0[3]) * u0[3]), w0, true);
                w1 = __builtin_amdgcn_cvt_pk_fp8_f32(f8c(siluf_(g1[0]) * u1[0]), f8c(siluf_(g1[1]) * u1[1]), w1, false); w1 = __builtin_amdgcn_cvt_pk_fp8_f32(f8c(siluf_(g1[2]) * u1[2]), f8c(siluf_(g1[3]) * u1[3]), w1, true);
                *(u32x2*)((unsigned char*)act + (size_t)(row0 + ai * 128 + m * 16) * 256 + col0) = (u32x2){(unsigned)w0, (unsigned)w1}; }
    }
};
__device__ __forceinline__ void phase_moe1(Ctx& F, int rr) {
    Moe1Sched S; S.T = build_moe_tabs(F, rr); S.H2 = (const char*)(F.ws + WS_H2) + (size_t)rr * RT * DM; S.W1T = (const char*)(F.ws + WS_W1T); S.tokl = (const int*)(F.ws + WS_TOKL) + (size_t)rr * 64 * RT; S.G = F.G; S.c = (F.G % 8 == 0) ? (F.bid % 8) * (F.G / 8) + F.bid / 8 : F.bid; S.rr = rr; gm::stage_geom(F.tid, S.R, S.C);
    EpiMoe1 E{(bf16_t*)(F.ws + WS_ACT), (const float*)(F.ws + WS_WL) + (size_t)rr * 64 * RT, S.T.cnt};
    gm::gemm_phase<true, false, true>(F.lds, 512, S, E);
}
struct Moe2Sched {
    const char* ACT; const char* W2T; MoeTabs T; int G, c; int R[2], C[2];
    __device__ __forceinline__ bool next(int i, gm::UnitD& u) {
        const int uu = i * G + c; const int nt = T.TR + RT / 256;
        if (uu >= nt * 4) return false;
        const int tile = uu >> 2, pn = uu & 3, e = T.te[tile], rt = tile - T.tb[e];
        u.a = ACT + (size_t)tile * 256 * 256; u.b = W2T + (size_t)(e * 1024 + pn * 256) * 256;
#pragma unroll
        for (int h = 0; h < 2; ++h)
#pragma unroll
            for (int j = 0; j < 2; ++j) u.va[h][j] = (unsigned)((h * 128 + R[j]) * 128 + C[j]) * 2u;
        u.e0 = pn; u.e1 = e; u.e2 = rt; u.e3 = tile; return true;
    }
};
struct EpiMoe2 {
    bf16_t* slots; bf16_t* shout; const LAS int* cnt;
    __device__ __forceinline__ void operator()(const f32x4 (&acc)[2][2][4][2], const gm::UnitD& u, int wr, int wc, int fr, int fq) const {
        const int pn = u.e0, e = u.e1, rt = u.e2, tile = u.e3;
        const int col0 = pn * 256 + wc * 32 + 8 * fq, n = cnt[e];
        if (e < 64) {
            unsigned char* base = (unsigned char*)slots + (size_t)(tile * 256 + wr * 64 + fr) * 1024 + col0;
#pragma unroll
            for (int ai = 0; ai < 2; ++ai)
#pragma unroll
                for (int m = 0; m < 4; ++m) {
                    if (rt * 256 + ai * 128 + wr * 64 + m * 16 + fr < n) {
#pragma unroll
                        for (int bj = 0; bj < 2; ++bj) { f32x4 v0 = acc[ai][bj][m][0] * (16.f / 4096.f), v1 = acc[ai][bj][m][1] * (16.f / 4096.f);
#pragma unroll
                            for (int j = 0; j < 4; ++j) { v0[j] = __builtin_amdgcn_fmed3f(v0[j], -440.f, 440.f); v1[j] = __builtin_amdgcn_fmed3f(v1[j], -440.f, 440.f); }
                            int w0 = 0, w1 = 0;
                            w0 = __builtin_amdgcn_cvt_pk_fp8_f32(v0[0], v0[1], w0, false); w0 = __builtin_amdgcn_cvt_pk_fp8_f32(v0[2], v0[3], w0, true);
                            w1 = __builtin_amdgcn_cvt_pk_fp8_f32(v1[0], v1[1], w1, false); w1 = __builtin_amdgcn_cvt_pk_fp8_f32(v1[2], v1[3], w1, true);
                            *(u32x2*)(base + (size_t)(ai * 128 + m * 16) * 1024 + bj * 128) = (u32x2){(unsigned)w0, (unsigned)w1}; } } }
        } else {
            bf16_t* base = shout + (size_t)(rt * 256 + wr * 64 + fr) * 1024 + col0;
#pragma unroll
            for (int ai = 0; ai < 2; ++ai)
#pragma unroll
                for (int m = 0; m < 4; ++m)
#pragma unroll
                    for (int bj = 0; bj < 2; ++bj) { const f32x4 v0 = acc[ai][bj][m][0] * (1.f / 4096.f), v1 = acc[ai][bj][m][1] * (1.f / 4096.f);
                        u32x4 o; o.x = cvtpk(v0[0], v0[1]); o.y = cvtpk(v0[2], v0[3]); o.z = cvtpk(v1[0], v1[1]); o.w = cvtpk(v1[2], v1[3]); *(u32x4*)(base + (size_t)(ai * 128 + m * 16) * 1024 + bj * 128) = o; }
        }
    }
};
__device__ __forceinline__ void phase_moe2(Ctx& F, int rr) {
    Moe2Sched S; S.T = build_moe_tabs(F, rr); S.ACT = (const char*)(F.ws + WS_ACT); S.W2T = (const char*)(F.ws + WS_W2T); S.G = F.G; S.c = (F.G % 8 == 0) ? (F.bid % 8) * (F.G / 8) + F.bid / 8 : F.bid; gm::stage_geom(F.tid, S.R, S.C);
    EpiMoe2 E{(bf16_t*)(F.ws + WS_SLOTS), (bf16_t*)(F.ws + WS_SHOUT), S.T.cnt};
    gm::gemm_phase<true, false, true>(F.lds, 128, S, E);
}
__device__ __forceinline__ void phase_final(Ctx& F, int rr) {
    const MoeTabs T = build_moe_tabs(F, rr);
    const float* mod = (const float*)(F.ws + WS_SMALL + SM_MOD); const float* fg = inp(F, I_FG);
    const unsigned char* slots = (const unsigned char*)(F.ws + WS_SLOTS); const int* tpos = (const int*)(F.ws + WS_TPOS) + (size_t)rr * RT * 8;
    const int gw = F.bid * 8 + F.wave, NGW = F.G * 8, c0 = F.lane * 8;
    struct Tok { u32x2 sv[8][2]; u32x4 sh[2]; u32x4 xq[2]; f32x4 g2[2][2]; };
#define FIN_TPOS(TT, TPV) do { TPV = tpos[(size_t)(TT) * 8 + (F.lane & 7)]; } while (0)
#define FIN_ISSUE(TT, X, TPV) do { \
        _Pragma("unroll") for (int k = 0; k < 8; ++k) { const int v_ = __builtin_amdgcn_readlane(TPV, k); const unsigned char* rp_ = slots + (size_t)(T.tb[v_ >> 16] * 256 + (v_ & 0xffff)) * 1024 + c0; \
            X.sv[k][0] = *(const u32x2*)(rp_); X.sv[k][1] = *(const u32x2*)(rp_ + 512); } \
        { const bf16_t* sp_ = (const bf16_t*)(F.ws + WS_SHOUT) + (size_t)(TT) * 1024 + c0; X.sh[0] = *(const u32x4*)sp_; X.sh[1] = *(const u32x4*)(sp_ + 512); } \
        { const bf16_t* xp_ = (const bf16_t*)(F.ws + WS_X1B) + (size_t)(rr * RT + (TT)) * DM + c0; X.xq[0] = *(const u32x4*)xp_; X.xq[1] = *(const u32x4*)(xp_ + 512); } \
        { const float* g2_ = mod + ((rr * RT + (TT)) / SEQ) * NMOD + 5 * DM + c0; _Pragma("unroll") for (int h = 0; h < 2; ++h) { X.g2[h][0] = *(const f32x4*)(g2_ + h * 512); X.g2[h][1] = *(const f32x4*)(g2_ + h * 512 + 4); } } } while (0)
#define FIN_DONE(TT, X) do { const int tok_ = rr * RT + (TT); float* orow_ = F.out + (size_t)tok_ * DM + c0; \
          \
        asm volatile("" : "+v"(X.sv[0][0]), "+v"(X.sv[0][1]), "+v"(X.sv[1][0]), "+v"(X.sv[1][1]), "+v"(X.sv[2][0]), "+v"(X.sv[2][1]), "+v"(X.sv[3][0]), "+v"(X.sv[3][1]), \
                          "+v"(X.sv[4][0]), "+v"(X.sv[4][1]), "+v"(X.sv[5][0]), "+v"(X.sv[5][1]), "+v"(X.sv[6][0]), "+v"(X.sv[6][1]), "+v"(X.sv[7][0]), "+v"(X.sv[7][1])); \
        asm volatile("" : "+v"(X.sh[0]), "+v"(X.sh[1]), "+v"(X.xq[0]), "+v"(X.xq[1]), "+v"(X.g2[0][0]), "+v"(X.g2[0][1]), "+v"(X.g2[1][0]), "+v"(X.g2[1][1])); \
        float s_ = 0.f; f32x4 v_[2][2]; \
        _Pragma("unroll") for (int h = 0; h < 2; ++h) { \
            f32x4 a0 = (f32x4){0.f, 0.f, 0.f, 0.f}, a1 = a0; \
            _Pragma("unroll") for (int k = 0; k < 8; ++k) { const u32x2 w = X.sv[k][h]; \
                const f32x2 p0 = __builtin_amdgcn_cvt_pk_f32_fp8((int)w.x, false), p1 = __builtin_amdgcn_cvt_pk_f32_fp8((int)w.x, true), p2 = __builtin_amdgcn_cvt_pk_f32_fp8((int)w.y, false), p3 = __builtin_amdgcn_cvt_pk_f32_fp8((int)w.y, true); \
                a0 += (f32x4){p0.x, p0.y, p1.x, p1.y}; a1 += (f32x4){p2.x, p2.y, p3.x, p3.y}; } \
            { const u32x4 w = X.sh[h]; a0 = a0 * 0.0625f + (f32x4){bflo(w.x), bfhi(w.x), bflo(w.y), bfhi(w.y)}; a1 = a1 * 0.0625f + (f32x4){bflo(w.z), bfhi(w.z), bflo(w.w), bfhi(w.w)}; } \
            const u32x4 q = X.xq[h]; \
            v_[h][0] = (f32x4){bflo(q.x), bfhi(q.x), bflo(q.y), bfhi(q.y)} + X.g2[h][0] * a0; v_[h][1] = (f32x4){bflo(q.z), bfhi(q.z), bflo(q.w), bfhi(q.w)} + X.g2[h][1] * a1; \
            _Pragma("unroll") for (int q2 = 0; q2 < 2; ++q2) s_ += (v_[h][q2].x * v_[h][q2].x + v_[h][q2].y * v_[h][q2].y) + (v_[h][q2].z * v_[h][q2].z + v_[h][q2].w * v_[h][q2].w); } \
        const float rstd_ = rsqrtf(wave_sum(s_) * (1.f / DM) + EPS); \
        _Pragma("unroll") for (int h = 0; h < 2; ++h) _Pragma("unroll") for (int q2 = 0; q2 < 2; ++q2) *(f32x4*)(orow_ + h * 512 + 4 * q2) = (v_[h][q2] * rstd_) * fgv[h][q2]; } while (0)
    f32x4 fgv[2][2];
#pragma unroll
    for (int h = 0; h < 2; ++h)
#pragma unroll
        for (int q2 = 0; q2 < 2; ++q2) fgv[h][q2] = *(const f32x4*)(fg + c0 + h * 512 + 4 * q2);
    Tok A, B; int tpA = 0, tpB = 0;
    if (gw < RT) { FIN_TPOS(gw, tpA); if (gw + NGW < RT) FIN_TPOS(gw + NGW, tpB); FIN_ISSUE(gw, A, tpA); }
    int t = gw;
#pragma unroll 1
    for (; t + 3 * NGW < RT; t += 2 * NGW) {
        const int t1 = t + NGW, t2 = t + 2 * NGW, t3 = t + 3 * NGW;
        FIN_TPOS(t2, tpA); FIN_ISSUE(t1, B, tpB); __builtin_amdgcn_sched_barrier(0);
        FIN_DONE(t, A); __builtin_amdgcn_sched_barrier(0);
        FIN_TPOS(t3, tpB); FIN_ISSUE(t2, A, tpA); __builtin_amdgcn_sched_barrier(0);
        FIN_DONE(t1, B); __builtin_amdgcn_sched_barrier(0);
    }
#pragma unroll 1
    for (; t < RT; t += 2 * NGW) {
        const int t1 = t + NGW, t2 = t + 2 * NGW, t3 = t + 3 * NGW;
        if (t1 < RT) { if (t2 < RT) FIN_TPOS(t2, tpA); FIN_ISSUE(t1, B, tpB); }
        FIN_DONE(t, A);
        if (t2 < RT) { if (t3 < RT) FIN_TPOS(t3, tpB); FIN_ISSUE(t2, A, tpA); }
        if (t1 < RT) FIN_DONE(t1, B);
    }
#undef FIN_TPOS
#undef FIN_ISSUE
#undef FIN_DONE
}

constexpr int N_PHASES = 10;
__global__ void __launch_bounds__(512, 2) mega_fwd(Args args) {
    extern __shared__ __attribute__((aligned(16))) unsigned char lds_raw[];
    Ctx F; F.lds = (LAS unsigned char*)lds_raw; F.ws = args.ws; F.out = args.out;
    {
        typedef __attribute__((address_space(4))) const unsigned long long* karg_t;
        const karg_t ka = (karg_t)__builtin_amdgcn_kernarg_segment_ptr();
        LAS unsigned long long* tab = (LAS unsigned long long*)(lds_raw + MISC_OFF + 14336);
        if (threadIdx.x < 20) tab[threadIdx.x] = ka[threadIdx.x];
        F.intab = tab;
    }
    F.tid = threadIdx.x; F.lane = F.tid & 63; F.wave = __builtin_amdgcn_readfirstlane(F.tid >> 6); F.G = gridDim.x; F.bid = blockIdx.x;
    volatile LAS unsigned* st = (volatile LAS unsigned*)(F.lds + MISC_OFF + MO_ST);
    if (F.tid < 4) st[F.tid] = 0u;
    __syncthreads();
    XcdBarrier bar = xcd_barrier_post((unsigned*)(F.ws + WS_CTL) + CW_BAR, st);
    if (threadIdx.x == 0) { unsigned nloc, nx; xcd_barrier_complete(bar.bar, bar.x, nloc, nx); st[0] = nloc; st[1] = nx; }
    int lo = args.ph_lo, hi = args.ph_hi;
    { int a = lo, b = hi; asm volatile("" : "+v"(a), "+v"(b)); lo = __builtin_amdgcn_readfirstlane(a); hi = __builtin_amdgcn_readfirstlane(b); }
    launder(F);
#ifndef PH_MASK
#define PH_MASK 0x1ffff
#endif
#define PH_ON(k) ((PH_MASK >> (k)) & 1)
#define IN(k) (lo <= (k) && (k) < hi)
#define SEAM(k) do { if (IN(k) && IN((k) + 1)) { bar.bar = launder_ptr(bar.bar); xcd_barrier(bar); } } while (0)
#define RUN(k, call) do { if (PH_ON(k) && IN(k)) { launder(F); call; } } while (0)
    RUN(0, phase0(F)); SEAM(0);
    RUN(1, phase1(F)); SEAM(1);
    RUN(2, phase2(F)); SEAM(2);
    RUN(4, (phase4(F), sb_units(F))); SEAM(4);
    RUN(5, phase5(F)); SEAM(5);
    RUN(6, phase6(F)); SEAM(6);
    RUN(7, phase7(F)); SEAM(7);
    RUN(8, phase8(F)); SEAM(8);
    if (PH_ON(9) && IN(9)) {
        const int par = (F.bid >> 3) & 1;
#pragma unroll 1
        for (int i = 0; i < 8; ++i) {
            launder(F);
            int op, rr; bool bar_after = true;
            switch (i) {
                case 0: op = 0; rr = 0; break;
                case 1: op = 1; rr = 0; break;
                case 2: op = par ? 0 : 2; rr = par ? 1 : 0; bar_after = false; break;
                case 3: op = par ? 2 : 0; rr = par ? 0 : 1; break;
                case 4: op = par ? 1 : 3; rr = par ? 1 : 0; bar_after = false; break;
                case 5: op = par ? 3 : 1; rr = par ? 0 : 1; break;
                case 6: op = 2; rr = 1; break;
                default: op = 3; rr = 1; bar_after = false; break;
            }
            switch (op) {
                case 0: launder(F); phase_n2r(F, rr); break;
                case 1: launder(F); phase_moe1(F, rr); break;
                case 2: launder(F); phase_moe2(F, rr); break;
                default: launder(F); phase_final(F, rr); break;
            }
            if (bar_after) { bar.bar = launder_ptr(bar.bar); xcd_barrier(bar); } else __syncthreads();
        }
    }
#undef IN
#undef SEAM
#undef RUN
}

#ifndef MK_SPLIT
#define MK_SPLIT 0
#endif
extern "C" void kernel_launch(void* const* d_in, const int* in_sizes, int n_in, void* d_out, int out_size, void* d_ws, size_t ws_size, hipStream_t stream) {
    static int grid = 0;
    if (grid == 0) {
        if (n_in != 20 || in_sizes[0] != MT * DM || out_size != MT * DM || ws_size < WS_END) { fprintf(stderr, "kernel_launch: unexpected shapes (n_in %d, in0 %d, out %d, ws %zu)\n", n_in, n_in > 0 ? in_sizes[0] : -1, out_size, ws_size); grid = -1; return; }
        int dev = 0, cus = 0;
        if (hipGetDevice(&dev) != hipSuccess || hipDeviceGetAttribute(&cus, hipDeviceAttributeMultiprocessorCount, dev) != hipSuccess) { grid = -1; return; }
        if (hipFuncSetAttribute((const void*)mega_fwd, hipFuncAttributeMaxDynamicSharedMemorySize, LDS_BYTES) != hipSuccess) { fprintf(stderr, "kernel_launch: hipFuncSetAttribute failed\n"); grid = -1; return; }
        int per_cu = 0;
        if (hipOccupancyMaxActiveBlocksPerMultiprocessor(&per_cu, (const void*)mega_fwd, 512, LDS_BYTES) != hipSuccess || per_cu < 1) fprintf(stderr, "kernel_launch: occupancy query reports %d\n", per_cu);
        (void)hipGetLastError();
        grid = cus;
    }
    if (grid < 0) return;
    (void)hipMemsetAsync((char*)d_ws + WS_CTL, 0, CTL_BYTES, stream);
    Args a{};
    for (int i = 0; i < 20; ++i) a.in[i] = (const float*)d_in[i];
    a.out = (float*)d_out; a.ws = (unsigned char*)d_ws;
#if MK_SPLIT
    for (int p = 0; p < N_PHASES; ++p) { a.ph_lo = p; a.ph_hi = p + 1; hipLaunchKernelGGL(mega_fwd, dim3(grid), dim3(512), LDS_BYTES, stream, a); }
#else
    a.ph_lo = 0; a.ph_hi = N_PHASES;
    hipLaunchKernelGGL(mega_fwd, dim3(grid), dim3(512), LDS_BYTES, stream, a);
#endif
}
```

```cpp
#include <hip/hip_runtime.h>
#include <cstdio>
#include <cstdint>

#define LAS __attribute__((address_space(3)))
#define GAS __attribute__((address_space(1)))
typedef unsigned short bf16_t;
typedef short bf16x8 __attribute__((ext_vector_type(8)));
typedef short s16x4 __attribute__((ext_vector_type(4)));
typedef float f32x4 __attribute__((ext_vector_type(4)));
typedef float f32x16 __attribute__((ext_vector_type(16)));
typedef float f32x2 __attribute__((ext_vector_type(2)));
typedef unsigned u32x4 __attribute__((ext_vector_type(4)));
typedef unsigned u32x2 __attribute__((ext_vector_type(2)));
typedef __bf16 bf16x2_t __attribute__((ext_vector_type(2)));

__device__ __forceinline__ unsigned cvtpk(float lo, float hi) { f32x2 v = {lo, hi}; bf16x2_t b = __builtin_convertvector(v, bf16x2_t); return __builtin_bit_cast(unsigned, b); }
__device__ __forceinline__ float bf2f(unsigned short u) { return __uint_as_float(((unsigned)u) << 16); }
__device__ __forceinline__ float bflo(unsigned u) { return __uint_as_float(u << 16); }
__device__ __forceinline__ float bfhi(unsigned u) { return __uint_as_float(u & 0xffff0000u); }

constexpr int NB = 4, SEQ = 8192, DM = 1024, MT = NB * SEQ;
constexpr int NHEAD = 8, HD = 64, QW = 1536;
constexpr int NE = 64, EFF = 256, NMOD = 6 * DM;
constexpr int RT = MT / 2;
constexpr float EPS = 1e-6f;
constexpr float LOG2E = 1.4426950408889634f;

constexpr size_t MiB = 1u << 20;
constexpr size_t WS_CTL = 0, CTL_BYTES = 1 * MiB;
constexpr size_t WS_SMALL = 1 * MiB;
constexpr size_t SM_MOD = 0, SM_GVEC = 98304, SM_CB = 114688, SM_KBAR = 131072, SM_WRH = 393216, SM_WRL = 524288;
constexpr size_t WS_W2T = 2 * MiB;
constexpr size_t WS_W1T = 35 * MiB;
constexpr size_t WS_WIN8 = 19 * MiB;
constexpr size_t WS_H8 = 68 * MiB;
constexpr size_t WS_WINT = 100 * MiB;
constexpr size_t WS_WBRT = 110 * MiB;
constexpr size_t WS_WOUTT = 112 * MiB;
constexpr size_t WS_H = 114 * MiB;
constexpr size_t WS_OB = 114 * MiB;
constexpr size_t WS_QSB = 178 * MiB;
constexpr size_t WS_PO = 178 * MiB;
constexpr size_t WS_QMB = 274 * MiB;
constexpr size_t WS_MERGED = 274 * MiB;
constexpr size_t WS_G = 370 * MiB;
constexpr size_t WS_LMB = 498 * MiB;
constexpr size_t WS_PLSE = 506 * MiB;
constexpr size_t WS_H2 = 100 * MiB;
constexpr size_t WS_TOKL = 164 * MiB;
constexpr size_t WS_WL = 172 * MiB;
constexpr size_t WS_TPOS = 180 * MiB;
constexpr size_t WS_ACT = 184 * MiB;
constexpr size_t WS_SLOTS = 264 * MiB;
constexpr size_t WS_SHOUT = 408 * MiB;
constexpr size_t WS_X1B = 440 * MiB;
constexpr size_t WS_END = 509 * MiB;
constexpr int CW_MBCUR = 0;
constexpr int CW_MOECUR = 1024;
constexpr int CW_BAR = 4096;
constexpr size_t CTL_KBS = 512 * 1024;

constexpr int RING_BYTES = 131072;
constexpr int MISC_OFF = RING_BYTES;
constexpr int LDS_BYTES = 163840;
constexpr int MO_STG = 16384;

#define XB_TMO      128
#define XB_XCNT(j)  (256  + 64 * (j))
#define XB_XSUB(j)  (1280 + 64 * (j))
#define XB_XGEN(j)  (2304 + 64 * (j))
#define XB_TOP      3328
#define XB_TOPGEN   3392
#define XCD_BAR_WORDS 3456
#define XB_SPIN_CAP (1u << 18)
__device__ __forceinline__ unsigned xb_ld(unsigned* p)              { return __hip_atomic_load(p, __ATOMIC_RELAXED, __HIP_MEMORY_SCOPE_AGENT); }
__device__ __forceinline__ unsigned xb_add(unsigned* p, unsigned v) { return __hip_atomic_fetch_add(p, v, __ATOMIC_RELAXED, __HIP_MEMORY_SCOPE_AGENT); }
__device__ __forceinline__ unsigned xb_xcc_id() { return (unsigned)__builtin_amdgcn_s_getreg((3 << 11) | 20) & 0xFu; }
#define XB_SPIN(cond, bar) do { unsigned _sp = 0; while (cond) { __builtin_amdgcn_s_sleep(1); \
    if ((++_sp & 255u) == 0u) { if (xb_ld(&(bar)[XB_TMO])) break; if (_sp > XB_SPIN_CAP) { atomicAdd(&(bar)[XB_TMO], 1u); break; } } } } while (0)
struct XcdBarrier { unsigned* bar; unsigned x; volatile LAS unsigned* st; };
__device__ __forceinline__ XcdBarrier xcd_barrier_post(unsigned* bar, volatile LAS unsigned* st) {
    XcdBarrier b; b.bar = bar; b.x = xb_xcc_id(); b.st = st;
    if (threadIdx.x == 0) (void)xb_add(&bar[XB_XCNT(b.x)], 1u);
    return b;
}
__device__ __forceinline__ void xcd_barrier_complete(unsigned* bar, unsigned x, unsigned& nloc, unsigned& nx) {
    const unsigned G = gridDim.x * gridDim.y * gridDim.z;
    unsigned sum, cnt, mine, sp = 0u;
    for (;;) {
        sum = 0u; cnt = 0u; mine = 0u;
#pragma unroll
        for (unsigned j = 0; j < 16; ++j) { const unsigned c = xb_ld(&bar[XB_XCNT(j)]); sum += c; cnt += (c > 0u) ? 1u : 0u; mine = (j == x) ? c : mine; }
        if (sum == G) break;
        __builtin_amdgcn_s_sleep(1);
        if ((++sp & 255u) == 0u) { if (xb_ld(&bar[XB_TMO])) break; if (sp > XB_SPIN_CAP) { atomicAdd(&bar[XB_TMO], 1u); break; } }
    }
    nloc = mine > 0u ? mine : 1u; nx = cnt > 0u ? cnt : 1u;
}
__device__ __forceinline__ void xcd_barrier(const XcdBarrier& b) {
    asm volatile("s_waitcnt vmcnt(0)" ::: "memory");
    __syncthreads();
    if (threadIdx.x == 0) {
        unsigned* bar = b.bar;
        __builtin_amdgcn_s_waitcnt(0);
        unsigned nloc = b.st[0], nx = b.st[1];
        const unsigned old = xb_add(&bar[XB_XSUB(b.x)], 1u);
        const unsigned gen = old / nloc;
        if (old + 1u == (gen + 1u) * nloc) {
            __builtin_amdgcn_fence(__ATOMIC_RELEASE, "agent");
            asm volatile("s_waitcnt vmcnt(0)" ::: "memory");
            const unsigned og = xb_add(&bar[XB_TOP], 1u);
            const unsigned tg = og / nx;
            if (og + 1u == (tg + 1u) * nx) xb_add(&bar[XB_TOPGEN], 1u);
            else XB_SPIN(xb_ld(&bar[XB_TOPGEN]) == tg, bar);
            __builtin_amdgcn_fence(__ATOMIC_ACQUIRE, "agent");
            xb_add(&bar[XB_XGEN(b.x)], 1u);
            asm volatile("s_waitcnt vmcnt(0)" ::: "memory");
        } else {
            XB_SPIN(xb_ld(&bar[XB_XGEN(b.x)]) == gen, bar);
            __builtin_amdgcn_fence(__ATOMIC_ACQUIRE, "agent");
            asm volatile("s_waitcnt vmcnt(0)" ::: "memory");
        }
    }
    __syncthreads();
}

namespace gm {
constexpr int BM = 256, BK = 64, HALF = 128, HTB = HALF * BK * 2, STAGE_BYTES = 8 * HTB, NXCD = 8, WGM = 8;
__host__ __device__ __forceinline__ int lds_byte(int r, int c) { const int st = (r >> 4) * 2 + (c >> 5), rr = r & 15, cc = c & 31, ob = rr * 64 + cc * 2; return st * 1024 + (ob ^ (((ob >> 9) & 1) << 5)); }
__host__ __device__ __forceinline__ void stage_rc(int b, int& R, int& C) { const int st = b / 1024, sb = b % 1024, swz = sb ^ (((sb >> 9) & 1) << 5); R = (st >> 1) * 16 + swz / 64; C = (st & 1) * 32 + (swz % 64) / 2; }
__host__ __device__ __forceinline__ int perm32(int rho) { const int n = rho >> 4, i = rho & 15; return 8 * (i >> 2) + 4 * n + (i & 3); }

struct UnitD { const char* a; const char* b; unsigned va[2][2]; int e0, e1, e2, e3; };

__device__ __forceinline__ bool static_tile(int M, int N, int G, int c, int i, int& pm, int& pn) {
    const int nM = M / BM, nN = N / BM, nwg = nM * nN;
    const long L = (long)i * G + c; if (L >= nwg) return false;
    int wgid = (int)L; { const int q = nwg / NXCD, r = nwg % NXCD, xcd = wgid % NXCD, off = wgid / NXCD; wgid = (xcd < r ? xcd * (q + 1) : r * (q + 1) + (xcd - r) * q) + off; }
    const int nig = WGM * nN, gid = wgid / nig, fm = gid * WGM, gsz = (nM - fm) < WGM ? (nM - fm) : WGM;
    pm = fm + ((wgid % nig) % gsz); pn = (wgid % nig) / gsz; return true;
}

template <bool PERM, bool HOOK = false, bool FP8 = false, class Epi, class Sched>
__device__ __forceinline__ void gemm_phase(LAS unsigned char* lds, const int K, Sched& S, const Epi& E) {
    int tid_ = threadIdx.x; asm volatile("" : "+v"(tid_));
    const int tid = tid_, wid = __builtin_amdgcn_readfirstlane(tid >> 6), lane = tid & 63, wr = wid >> 2, wc = wid & 3, fr = lane & 15, fq = lane >> 4;
    const int nt = K / BK;
    unsigned voffB[2];
#pragma unroll
    for (int i = 0; i < 2; ++i) { int R, C; stage_rc(tid * 16 + i * 8192, R, C); const int Rb = PERM ? ((R & ~31) + perm32(R & 31)) : R; voffB[i] = (unsigned)(Rb * K + C) * 2u; }
    const size_t kstep = (size_t)(BK * 2);
    const size_t hstep = (size_t)HALF * K * 2;
    const unsigned ldsw = (unsigned)wid * 1024u;
    const int aoff = lds_byte(wr * 64 + fr, fq * 8), boff = lds_byte(wc * 32 + fr, fq * 8);
#define GM_SA(b, h) (((b) * 2 + (h)) * HTB)
#define GM_SB(b, h) ((4 + (b) * 2 + (h)) * HTB)
#define GM_STAGE_A(bufoff, U, h, kb) do { _Pragma("unroll") for (int _i = 0; _i < 2; ++_i) \
        __builtin_amdgcn_global_load_lds((const unsigned*)((U).a + (kb) + (U).va[h][_i]), (LAS unsigned*)(lds + (bufoff) + ldsw + _i * 8192), 16, 0, 0); } while (0)
#define GM_STAGE_B(bufoff, U, h, kb) do { _Pragma("unroll") for (int _i = 0; _i < 2; ++_i) \
        __builtin_amdgcn_global_load_lds((const unsigned*)((U).b + (kb) + (size_t)(h) * hstep + voffB[_i]), (LAS unsigned*)(lds + (bufoff) + ldsw + _i * 8192), 16, 0, 0); } while (0)
#define GM_LDA(dst, b, h) do { _Pragma("unroll") for (int m = 0; m < 4; ++m) _Pragma("unroll") for (int k = 0; k < 2; ++k) { \
        if constexpr (FP8) { const i32x4_ t_ = *(const LAS i32x4_*)(lds + GM_SA(b, h) + aoff + m * 2048 + k * 1024); dst##8[m][4 * k] = t_[0]; dst##8[m][4 * k + 1] = t_[1]; dst##8[m][4 * k + 2] = t_[2]; dst##8[m][4 * k + 3] = t_[3]; } \
        else dst[m][k] = *(const LAS bf16x8*)(lds + GM_SA(b, h) + aoff + m * 2048 + k * 1024); } } while (0)
#define GM_LDB(dst, b, h) do { _Pragma("unroll") for (int n = 0; n < 2; ++n) _Pragma("unroll") for (int k = 0; k < 2; ++k) { \
        if constexpr (FP8) { const i32x4_ t_ = *(const LAS i32x4_*)(lds + GM_SB(b, h) + boff + n * 2048 + k * 1024); dst##8[n][4 * k] = t_[0]; dst##8[n][4 * k + 1] = t_[1]; dst##8[n][4 * k + 2] = t_[2]; dst##8[n][4 * k + 3] = t_[3]; } \
        else dst[n][k] = *(const LAS bf16x8*)(lds + GM_SB(b, h) + boff + n * 2048 + k * 1024); } } while (0)
#define GM_MMA(ai, bj, At, Bt) do { __builtin_amdgcn_s_setprio(1); \
        if constexpr (FP8) { _Pragma("unroll") for (int m = 0; m < 4; ++m) _Pragma("unroll") for (int n = 0; n < 2; ++n) \
            asm volatile("v_mfma_scale_f32_16x16x128_f8f6f4 %0, %1, %2, %0, %3, %3 op_sel_hi:[0,0,0]" : "+v"(acc[ai][bj][m][n]) : "v"(Bt##8[n]), "v"(At##8[m]), "v"(scl1)); } \
        else { _Pragma("unroll") for (int m = 0; m < 4; ++m) _Pragma("unroll") for (int n = 0; n < 2; ++n) _Pragma("unroll") for (int k = 0; k < 2; ++k) \
            acc[ai][bj][m][n] = __builtin_amdgcn_mfma_f32_16x16x32_bf16(Bt[n][k], At[m][k], acc[ai][bj][m][n], 0, 0, 0); } \
        __builtin_amdgcn_s_setprio(0); } while (0)
#define GM_WAIT_V(n) asm volatile("s_waitcnt vmcnt(" #n ")" ::: "memory")
#define GM_WAIT_L(n) asm volatile("s_waitcnt lgkmcnt(" #n ")" ::: "memory")
#define GM_BAR __builtin_amdgcn_s_barrier()
#define GM_SCHED __builtin_amdgcn_sched_barrier(0)
    UnitD cur, nxt; int ui = 0;
    if (!S.next(0, cur)) return;
    f32x4 acc[2][2][4][2];
#pragma unroll
    for (int a = 0; a < 2; ++a)
#pragma unroll
        for (int b = 0; b < 2; ++b)
#pragma unroll
            for (int m = 0; m < 4; ++m)
#pragma unroll
                for (int n = 0; n < 2; ++n) acc[a][b][m][n] = (f32x4){0.f, 0.f, 0.f, 0.f};
    typedef int i32x8_ __attribute__((ext_vector_type(8))); typedef int i32x4_ __attribute__((ext_vector_type(4)));
    bf16x8 At[4][2], B0[2][2], B1[2][2]; i32x8_ At8[4], B08[2], B18[2];
    int scl1 = 0x7f7f7f7f; asm volatile("" : "+v"(scl1));
    GM_STAGE_B(GM_SB(0, 0), cur, 0, 0); GM_STAGE_B(GM_SB(0, 1), cur, 1, 0); GM_STAGE_A(GM_SA(0, 0), cur, 0, 0); GM_STAGE_A(GM_SA(0, 1), cur, 1, 0);
    if (wr == 1) GM_BAR;
    GM_WAIT_V(2); GM_BAR;
    GM_STAGE_B(GM_SB(1, 0), cur, 0, kstep); GM_STAGE_A(GM_SA(1, 0), cur, 0, kstep); GM_STAGE_B(GM_SB(1, 1), cur, 1, kstep);
    GM_WAIT_V(6); GM_BAR;
    for (;;) {
        const bool has_next = S.next(ui + 1, nxt);
        if (!has_next) nxt = cur;
#pragma unroll 1
        for (int t = 0; t < nt; t += 2) {
            const bool last = (t == nt - 2);
            if constexpr (HOOK) { if (t == nt / 2) E.mid(acc, cur, wr, wc, fr, fq); }
            const size_t k1 = (size_t)(t + 1) * kstep;
            UnitD U2 = cur; size_t k2 = (size_t)(t + 2) * kstep;
            if (last) { U2 = nxt; k2 = 0; }
            const size_t k3 = k2 + kstep;
            GM_LDB(B0, 0, 0); GM_LDB(B1, 0, 1); GM_SCHED; GM_LDA(At, 0, 0); GM_STAGE_A(GM_SA(1, 1), cur, 1, k1);
            GM_WAIT_V(8); GM_WAIT_L(0); GM_BAR; GM_MMA(0, 0, At, B0); GM_MMA(0, 1, At, B1); GM_BAR; GM_SCHED;
            GM_LDA(At, 0, 1); GM_STAGE_B(GM_SB(0, 0), U2, 0, k2); GM_STAGE_B(GM_SB(0, 1), U2, 1, k2); GM_STAGE_A(GM_SA(0, 0), U2, 0, k2);
            GM_WAIT_V(8); GM_WAIT_L(0); GM_BAR; GM_MMA(1, 0, At, B0); GM_MMA(1, 1, At, B1); GM_BAR; GM_SCHED;
            GM_LDB(B0, 1, 0); GM_LDB(B1, 1, 1); GM_SCHED; GM_LDA(At, 1, 0); GM_STAGE_A(GM_SA(0, 1), U2, 1, k2);
            GM_WAIT_V(8); GM_WAIT_L(0); GM_BAR; GM_MMA(0, 0, At, B0); GM_MMA(0, 1, At, B1); GM_BAR; GM_SCHED;
            GM_LDA(At, 1, 1); GM_STAGE_B(GM_SB(1, 0), U2, 0, k3); GM_STAGE_B(GM_SB(1, 1), U2, 1, k3); GM_STAGE_A(GM_SA(1, 0), U2, 0, k3);
            GM_WAIT_V(8); GM_WAIT_L(0); GM_BAR; GM_MMA(1, 0, At, B0); GM_MMA(1, 1, At, B1); GM_BAR; GM_SCHED;
        }
        if constexpr (FP8) asm volatile("s_nop 15\n\ts_nop 15" ::: "memory");
        if (wr == 0) GM_BAR;
        E(acc, cur, wr, wc, fr, fq);
        if (!has_next) break;
#pragma unroll
        for (int a = 0; a < 2; ++a)
#pragma unroll
            for (int b = 0; b < 2; ++b)
#pragma unroll
                for (int m = 0; m < 4; ++m)
#pragma unroll
                    for (int n = 0; n < 2; ++n) acc[a][b][m][n] = (f32x4){0.f, 0.f, 0.f, 0.f};
        cur = nxt; ++ui;
        if (wr == 1) GM_BAR;
    }
    GM_WAIT_V(0);
    GM_BAR;
#undef GM_SA
#undef GM_SB
#undef GM_STAGE_A
#undef GM_STAGE_B
#undef GM_LDA
#undef GM_LDB
#undef GM_MMA
#undef GM_WAIT_V
#undef GM_WAIT_L
#undef GM_BAR
#undef GM_SCHED
}
__device__ __forceinline__ void stage_geom(int tid, int (&R)[2], int (&C)[2]) {
#pragma unroll
    for (int i = 0; i < 2; ++i) stage_rc(tid * 16 + i * 8192, R[i], C[i]);
}
}

struct Args { const float* in[20]; float* out; unsigned char* ws; int ph_lo, ph_hi; };
struct Ctx {
    LAS unsigned char* lds;
    unsigned char* ws;
    const LAS unsigned long long* intab;
    float* out;
    int tid, lane, wave, G, bid;
};
#define LDS_WAIT() asm volatile("s_waitcnt lgkmcnt(0)" ::: "memory")
__device__ __forceinline__ const float* inp(const Ctx& F, int i) {
    const unsigned long long v = F.intab[i];
    const unsigned lo = __builtin_amdgcn_readfirstlane((unsigned)v), hi = __builtin_amdgcn_readfirstlane((unsigned)(v >> 32));
    return (const float*)(GAS const float*)(((unsigned long long)hi << 32) | lo);
}
template <class P> __device__ __forceinline__ P launder_ptr(P p) {
    unsigned long long v = (unsigned long long)p; unsigned lo = (unsigned)v, hi = (unsigned)(v >> 32);
    asm volatile("" : "+v"(lo), "+v"(hi));
    lo = __builtin_amdgcn_readfirstlane(lo); hi = __builtin_amdgcn_readfirstlane(hi);
    return (P)(GAS unsigned char*)(((unsigned long long)hi << 32) | lo);
}
__device__ __forceinline__ void launder(Ctx& F) {
    int t = F.tid, g = F.G, bid = F.bid;
    asm volatile("" : "+v"(t), "+v"(g), "+v"(bid));
    F.tid = t; F.G = __builtin_amdgcn_readfirstlane(g); F.bid = __builtin_amdgcn_readfirstlane(bid); F.lane = t & 63; F.wave = __builtin_amdgcn_readfirstlane(t >> 6);
    F.ws = launder_ptr(F.ws); F.out = launder_ptr(F.out);
}
__device__ __forceinline__ float wave_sum(float v) {
#pragma unroll
    for (int o = 1; o < 64; o <<= 1) v += __shfl_xor(v, o);
    return v;
}
__device__ __forceinline__ int lds_add(LAS int* p, int v) { return __hip_atomic_fetch_add(p, v, __ATOMIC_RELAXED, __HIP_MEMORY_SCOPE_WORKGROUP); }
__device__ __forceinline__ float f8c(float x) { return __builtin_amdgcn_fmed3f(x, -440.f, 440.f); }
__device__ __forceinline__ float sigmoidf_(float x) { return 1.f / (1.f + __expf(-x)); }
__device__ __forceinline__ float siluf_(float x) { return x / (1.f + __expf(-x)); }

enum { I_X = 0, I_C, I_N1G, I_N2G, I_WADA, I_BADA, I_WIN, I_WBSB, I_WBMB, I_WOUT, I_WR, I_RB, I_WGE, I_WUE, I_WDE, I_WGS, I_WUS, I_WDS, I_RELB, I_FG };

__device__ __forceinline__ void transpose_item(const float* W, int ldn, int k0, int n0, bf16_t* WT, int Kdst, int drow0, LAS float* scr, int lane) {
    const float* wp = W + (size_t)(k0 + (lane >> 3)) * ldn + n0 + 4 * (lane & 7);
    f32x4 v[8];
#pragma unroll
    for (int i = 0; i < 8; ++i) v[i] = *(const f32x4*)(wp + (size_t)(8 * i) * ldn);
#pragma unroll
    for (int i = 0; i < 8; ++i) { LAS float* d = scr + (8 * i + (lane >> 3)) * 33 + 4 * (lane & 7); d[0] = v[i].x; d[1] = v[i].y; d[2] = v[i].z; d[3] = v[i].w; }
    LDS_WAIT(); asm volatile("" ::: "memory");
    const int c = lane & 7;
#pragma unroll
    for (int j = 0; j < 4; ++j) { const int n = (lane >> 3) + 8 * j; const LAS float* s = scr + (8 * c) * 33 + n;
        u32x4 o; o.x = cvtpk(s[0 * 33], s[1 * 33]); o.y = cvtpk(s[2 * 33], s[3 * 33]); o.z = cvtpk(s[4 * 33], s[5 * 33]); o.w = cvtpk(s[6 * 33], s[7 * 33]);
        *(u32x4*)(WT + (size_t)(drow0 + n) * Kdst + k0 + 8 * c) = o; }
    LDS_WAIT(); asm volatile("" ::: "memory");
}
__device__ __forceinline__ void phase0(Ctx& F) {
    LAS float* silc = (LAS float*)(F.lds + MISC_OFF - 0);
    silc = (LAS float*)(F.lds + 0);
    for (int i = F.tid; i < 4 * DM; i += 512) silc[i] = siluf_(inp(F, I_C)[i]);
    __syncthreads();
    float* mod = (float*)(F.ws + WS_SMALL + SM_MOD);
    {
        const int gw = F.wave * F.G + F.bid;
        const int c = F.lane & 15, kp = F.lane >> 4;
        const float* wada = inp(F, I_WADA);
        for (int item = gw; item < NMOD / 16; item += 8 * F.G) {
            const int col = item * 16 + c;
            float a0 = 0.f, a1 = 0.f, a2 = 0.f, a3 = 0.f;
#pragma unroll 32
            for (int k = kp; k < DM; k += 4) { const float w = wada[(size_t)k * NMOD + col]; a0 += silc[k] * w; a1 += silc[DM + k] * w; a2 += silc[2 * DM + k] * w; a3 += silc[3 * DM + k] * w; }
            a0 += __shfl_xor(a0, 16); a0 += __shfl_xor(a0, 32); a1 += __shfl_xor(a1, 16); a1 += __shfl_xor(a1, 32);
            a2 += __shfl_xor(a2, 16); a2 += __shfl_xor(a2, 32); a3 += __shfl_xor(a3, 16); a3 += __shfl_xor(a3, 32);
            if (kp == 0) { const float bb = inp(F, I_BADA)[col]; mod[col] = a0 + bb; mod[NMOD + col] = a1 + bb; mod[2 * NMOD + col] = a2 + bb; mod[3 * NMOD + col] = a3 + bb; }
        }
    }
    __syncthreads();
    {
        LAS float* scr = (LAS float*)(F.lds + F.wave * 16384);
        const int gw = F.bid * 8 + F.wave, NGW = F.G * 8, lane = F.lane;
        constexpr int I_IN = 16 * 160, I_BR = 8 * 32, I_OUT = 16 * 32, I_EXP = 384, NIT = I_IN + 2 * I_BR + I_OUT + 65 * I_EXP;
        const float* p_win = inp(F, I_WIN); const float* p_bsb = inp(F, I_WBSB); const float* p_bmb = inp(F, I_WBMB); const float* p_out = inp(F, I_WOUT);
        const float* p_ge = inp(F, I_WGE); const float* p_ue = inp(F, I_WUE); const float* p_de = inp(F, I_WDE); const float* p_gs = inp(F, I_WGS); const float* p_us = inp(F, I_WUS); const float* p_ds = inp(F, I_WDS);
#define TD_GET(IT, SRC, LDN, DST, KD, F8) do { int r = (IT); F8 = 0; \
            if (r < I_IN) { const int kb = r / 160, nb = r % 160; SRC = p_win + (size_t)(kb * 64) * 5120 + nb * 32; LDN = 5120; \
                if (nb < 48) { DST = (bf16_t*)(F.ws + WS_WINT) + (size_t)(nb * 32) * 1024 + kb * 64; KD = 1024; } \
                else { DST = (bf16_t*)((unsigned char*)(F.ws + WS_WIN8) + (size_t)(nb * 32 - 1536) * 1024 + kb * 64); KD = 1024; F8 = 256; } } \
            else if ((r -= I_IN) < I_BR) { const int kb = r / 32, nb = r % 32; SRC = p_bsb + (size_t)(kb * 64) * 1024 + nb * 32; LDN = 1024; DST = (bf16_t*)(F.ws + WS_WBRT) + (size_t)(nb * 32) * 1024 + kb * 64; KD = 1024; } \
            else if ((r -= I_BR) < I_BR) { const int kb = r / 32, nb = r % 32; SRC = p_bmb + (size_t)(kb * 64) * 1024 + nb * 32; LDN = 1024; DST = (bf16_t*)(F.ws + WS_WBRT) + (size_t)(nb * 32) * 1024 + 512 + kb * 64; KD = 1024; } \
            else if ((r -= I_BR) < I_OUT) { const int kb = r / 32, nb = r % 32; SRC = p_out + (size_t)(kb * 64) * 1024 + nb * 32; LDN = 1024; DST = (bf16_t*)(F.ws + WS_WOUTT) + (size_t)(nb * 32) * 1024 + kb * 64; KD = 1024; } \
            else { r -= I_OUT; const int e = r / I_EXP; r -= e * I_EXP; \
                if (r < 128) { const int kb = r / 8, n0 = (r % 8) * 32; SRC = (e < NE ? p_ge + (size_t)e * DM * EFF : p_gs) + (size_t)(kb * 64) * EFF + n0; LDN = EFF; \
                    DST = (bf16_t*)((unsigned char*)(F.ws + WS_W1T) + ((size_t)e * 512 + (n0 >> 7) * 256 + (n0 & 127)) * 1024 + kb * 64); KD = 1024; F8 = 256; } \
                else if (r < 256) { r -= 128; const int kb = r / 8, n0 = (r % 8) * 32; SRC = (e < NE ? p_ue + (size_t)e * DM * EFF : p_us) + (size_t)(kb * 64) * EFF + n0; LDN = EFF; \
                    DST = (bf16_t*)((unsigned char*)(F.ws + WS_W1T) + ((size_t)e * 512 + (n0 >> 7) * 256 + 128 + (n0 & 127)) * 1024 + kb * 64); KD = 1024; F8 = 256; } \
                else { r -= 256; const int kb = r / 32, nb = r % 32; SRC = (e < NE ? p_de + (size_t)e * EFF * DM : p_ds) + (size_t)(kb * 64) * DM + nb * 32; LDN = DM; \
                    DST = (bf16_t*)((unsigned char*)(F.ws + WS_W2T) + ((size_t)e * 1024 + nb * 32) * 256 + kb * 64); KD = 256; F8 = 128; } } } while (0)
#define TD_LOAD(V, SRC, LDN) do { const float* wp_ = (SRC) + (size_t)(lane >> 3) * (LDN) + 4 * (lane & 7); _Pragma("unroll") for (int i = 0; i < 8; ++i) V[i] = *(const f32x4*)(wp_ + (size_t)(8 * i) * (LDN)); } while (0)
#define TD_PROC(V, DST, KD, F8) do { \
            _Pragma("unroll") for (int i = 0; i < 8; ++i) { LAS float* d = scr + (8 * i + (lane >> 3)) * 33 + 4 * (lane & 7); d[0] = V[i].x; d[1] = V[i].y; d[2] = V[i].z; d[3] = V[i].w; } \
            LDS_WAIT(); asm volatile("" ::: "memory"); \
            if (F8) { _Pragma("unroll") for (int j = 0; j < 4; ++j) { const int n = (lane >> 3) + 8 * j; const LAS float* sp = scr + (8 * (lane & 7)) * 33 + n; \
                int w0 = 0, w1 = 0; \
                const float fs_ = (float)(F8); w0 = __builtin_amdgcn_cvt_pk_fp8_f32(f8c(sp[0 * 33] * fs_), f8c(sp[1 * 33] * fs_), w0, false); w0 = __builtin_amdgcn_cvt_pk_fp8_f32(f8c(sp[2 * 33] * fs_), f8c(sp[3 * 33] * fs_), w0, true); \
                w1 = __builtin_amdgcn_cvt_pk_fp8_f32(f8c(sp[4 * 33] * fs_), f8c(sp[5 * 33] * fs_), w1, false); w1 = __builtin_amdgcn_cvt_pk_fp8_f32(f8c(sp[6 * 33] * fs_), f8c(sp[7 * 33] * fs_), w1, true); \
                *(u32x2*)((unsigned char*)(DST) + (size_t)n * (KD) + 8 * (lane & 7)) = (u32x2){(unsigned)w0, (unsigned)w1}; } } \
            else { _Pragma("unroll") for (int j = 0; j < 4; ++j) { const int n = (lane >> 3) + 8 * j; const LAS float* sp = scr + (8 * (lane & 7)) * 33 + n; \
                u32x4 o; o.x = cvtpk(sp[0 * 33], sp[1 * 33]); o.y = cvtpk(sp[2 * 33], sp[3 * 33]); o.z = cvtpk(sp[4 * 33], sp[5 * 33]); o.w = cvtpk(sp[6 * 33], sp[7 * 33]); \
                *(u32x4*)((DST) + (size_t)n * (KD) + 8 * (lane & 7)) = o; } } \
            LDS_WAIT(); asm volatile("" ::: "memory"); } while (0)
        for (int it = 4 * gw; it < NIT; it += 4 * NGW) {
            const float* src[4]; bf16_t* dst[4]; int ld[4], kd[4], f8[4];
            f32x4 v0[8], v1[8], v2[8], v3[8];
            TD_GET(it, src[0], ld[0], dst[0], kd[0], f8[0]); TD_GET(it + 1, src[1], ld[1], dst[1], kd[1], f8[1]); TD_GET(it + 2, src[2], ld[2], dst[2], kd[2], f8[2]); TD_GET(it + 3, src[3], ld[3], dst[3], kd[3], f8[3]);
            TD_LOAD(v0, src[0], ld[0]); TD_LOAD(v1, src[1], ld[1]); TD_LOAD(v2, src[2], ld[2]); TD_LOAD(v3, src[3], ld[3]);
            TD_PROC(v0, dst[0], kd[0], f8[0]); TD_PROC(v1, dst[1], kd[1], f8[1]); TD_PROC(v2, dst[2], kd[2], f8[2]); TD_PROC(v3, dst[3], kd[3], f8[3]);
        }
#undef TD_PROC
#undef TD_GET
#undef TD_LOAD
    }
    {
        bf16_t* wrh = (bf16_t*)(F.ws + WS_SMALL + SM_WRH); bf16_t* wrl = (bf16_t*)(F.ws + WS_SMALL + SM_WRL);
        const float* wr = inp(F, I_WR);
        for (int i = F.bid * 512 + F.tid; i < NE * DM; i += F.G * 512) { const int e = i >> 10, k = i & 1023; const float v = wr[k * NE + e];
            const unsigned h = cvtpk(v, 0.f) & 0xffffu; wrh[i] = (bf16_t)h; wrl[i] = (bf16_t)(cvtpk(v - bflo(h), 0.f) & 0xffffu); }
    }
}

__device__ __forceinline__ void phase1(Ctx& F) {
    const float* mod = (const float*)(F.ws + WS_SMALL + SM_MOD);
    const float* x = inp(F, I_X); const float* g1 = inp(F, I_N1G);
    bf16_t* H = (bf16_t*)(F.ws + WS_H); unsigned char* H8 = (unsigned char*)(F.ws + WS_H8);
    const int gw = F.bid * 8 + F.wave, NGW = F.G * 8;
    if (gw < 256) {
        const int b = gw >> 6, e = gw & 63; const float* wr = inp(F, I_WR); float a = 0.f;
#pragma unroll 4
        for (int k = F.lane; k < DM; k += 64) a += mod[b * NMOD + 3 * DM + k] * wr[k * NE + e];
        a = wave_sum(a);
        if (F.lane == 0) ((float*)(F.ws + WS_SMALL + SM_CB))[gw] = a;
    }
    if (F.bid == 32) {
        float* gvec = (float*)(F.ws + WS_SMALL + SM_GVEC); const float* g2 = inp(F, I_N2G);
        for (int i = F.tid; i < 4 * DM; i += 512) { const int b = i >> 10, k = i & 1023; gvec[i] = g2[k] * (1.f + mod[b * NMOD + 4 * DM + k]); }
    }
    for (int m0 = gw; m0 < MT; m0 += 2 * NGW) {
        const int m1 = m0 + NGW;
        const bool two = m1 < MT;
        const f32x4* xr0 = (const f32x4*)(x + (size_t)m0 * DM) + F.lane; const f32x4* xr1 = (const f32x4*)(x + (size_t)(two ? m1 : m0) * DM) + F.lane;
        f32x4 v0[4], v1[4]; float s0 = 0.f, s1 = 0.f;
#pragma unroll
        for (int j = 0; j < 4; ++j) { v0[j] = xr0[64 * j]; v1[j] = xr1[64 * j]; }
#pragma unroll
        for (int j = 0; j < 4; ++j) { s0 += (v0[j].x * v0[j].x + v0[j].y * v0[j].y) + (v0[j].z * v0[j].z + v0[j].w * v0[j].w); s1 += (v1[j].x * v1[j].x + v1[j].y * v1[j].y) + (v1[j].z * v1[j].z + v1[j].w * v1[j].w); }
        const float r0 = rsqrtf(wave_sum(s0) * (1.f / DM) + EPS), r1 = rsqrtf(wave_sum(s1) * (1.f / DM) + EPS);
        const int b0 = m0 / SEQ, b1 = (two ? m1 : m0) / SEQ;
        u32x2* o0 = (u32x2*)(H + (size_t)m0 * DM) + F.lane; u32x2* o1 = (u32x2*)(H + (size_t)(two ? m1 : m0) * DM) + F.lane;
#pragma unroll
        for (int j = 0; j < 4; ++j) {
            const int col = 4 * F.lane + 256 * j;
            const f32x4 g = *(const f32x4*)(g1 + col);
            const f32x4 h0 = (v0[j] * r0) * g * (*(const f32x4*)(mod + b0 * NMOD + DM + col) + 1.0f) + *(const f32x4*)(mod + b0 * NMOD + col);
            const f32x4 h1 = (v1[j] * r1) * g * (*(const f32x4*)(mod + b1 * NMOD + DM + col) + 1.0f) + *(const f32x4*)(mod + b1 * NMOD + col);
            u32x2 w; w.x = cvtpk(h0.x, h0.y); w.y = cvtpk(h0.z, h0.w); o0[64 * j] = w;
            { int q8 = 0; q8 = __builtin_amdgcn_cvt_pk_fp8_f32(f8c(h0.x * 16.f), f8c(h0.y * 16.f), q8, false); q8 = __builtin_amdgcn_cvt_pk_fp8_f32(f8c(h0.z * 16.f), f8c(h0.w * 16.f), q8, true);
              ((unsigned*)(H8 + (size_t)m0 * DM) + F.lane)[64 * j] = (unsigned)q8; }
            if (two) { w.x = cvtpk(h1.x, h1.y); w.y = cvtpk(h1.z, h1.w); o1[64 * j] = w;
                int q8 = 0; q8 = __builtin_amdgcn_cvt_pk_fp8_f32(f8c(h1.x * 16.f), f8c(h1.y * 16.f), q8, false); q8 = __builtin_amdgcn_cvt_pk_fp8_f32(f8c(h1.z * 16.f), f8c(h1.w * 16.f), q8, true);
                ((unsigned*)(H8 + (size_t)m1 * DM) + F.lane)[64 * j] = (unsigned)q8; }
        }
    }
}

struct ProjSched {
    const char* A; const char* Bt; int G, c, pn0, npn, f8; int R[2], C[2];
    __device__ __forceinline__ bool next(int i, gm::UnitD& u) {
        int pm, pn; if (!gm::static_tile(MT, npn * 256, G, c, i, pm, pn)) return false;
        const int kp = f8 ? 512 : 1024;
        u.a = A; u.b = Bt + (size_t)pn * 256 * kp * 2;
#pragma unroll
        for (int h = 0; h < 2; ++h)
#pragma unroll
            for (int j = 0; j < 2; ++j) u.va[h][j] = (unsigned)((pm * 256 + h * 128 + R[j]) * kp + C[j]) * 2u;
        u.e0 = pm; u.e1 = pn0 + pn; u.e2 = f8; u.e3 = 0; return true;
    }
};
struct EpiProj {
    bf16_t* qsb; bf16_t* qmb; bf16_t* g; float* kbs;
    __device__ __forceinline__ void operator()(const f32x4 (&acc)[2][2][4][2], const gm::UnitD& u, int wr, int wc, int fr, int fq) const {
        const int pm = u.e0, pn = u.e1;
        bf16_t* base; int ldc, colt; float sc = 1.f;
        if (pn < 6) { base = qsb; ldc = QW; colt = pn * 256; if (pn < 2) sc = 0.125f * LOG2E; }
        else if (pn < 12) { base = qmb; ldc = QW; colt = (pn - 6) * 256; if (pn < 8) sc = 0.125f; }
        else { base = g; ldc = 2048; colt = (pn - 12) * 256; }
        if (u.e2) sc *= (1.f / 4096.f);
        const int row0 = pm * 256 + wr * 64 + fr, col0 = colt + wc * 32 + 8 * fq;
        if (pn == 8 || pn == 9) {
#pragma unroll
            for (int bj = 0; bj < 2; ++bj)
#pragma unroll
                for (int n = 0; n < 2; ++n) { f32x4 cs = (f32x4){0.f, 0.f, 0.f, 0.f};
#pragma unroll
                    for (int ai = 0; ai < 2; ++ai)
#pragma unroll
                        for (int m = 0; m < 4; ++m) cs += acc[ai][bj][m][n];
#pragma unroll
                    for (int o = 1; o < 16; o <<= 1) { cs[0] += __shfl_xor(cs[0], o); cs[1] += __shfl_xor(cs[1], o); cs[2] += __shfl_xor(cs[2], o); cs[3] += __shfl_xor(cs[3], o); }
                    if (fr == 0) { float* kd = kbs + (size_t)pm * 512 + (pn - 8) * 256 + bj * 128 + wc * 32 + 8 * fq + 4 * n;
#pragma unroll
                        for (int j = 0; j < 4; ++j) atomicAdd(kd + j, cs[j]); } }
        }
#pragma unroll
        for (int ai = 0; ai < 2; ++ai)
#pragma unroll
            for (int m = 0; m < 4; ++m) { bf16_t* rowp = base + (size_t)(row0 + ai * 128 + m * 16) * ldc + col0;
#pragma unroll
                for (int bj = 0; bj < 2; ++bj) { const f32x4 v0 = acc[ai][bj][m][0] * sc, v1 = acc[ai][bj][m][1] * sc;
                    u32x4 w; w.x = cvtpk(v0[0], v0[1]); w.y = cvtpk(v0[2], v0[3]); w.z = cvtpk(v1[0], v1[1]); w.w = cvtpk(v1[2], v1[3]);
                    *(u32x4*)(rowp + bj * 128) = w; } }
    }
};
__device__ __forceinline__ void phase2(Ctx& F) {
    EpiProj E{(bf16_t*)(F.ws + WS_QSB), (bf16_t*)(F.ws + WS_QMB), (bf16_t*)(F.ws + WS_G), (float*)(F.ws + WS_CTL + CTL_KBS)};
    {
        ProjSched S; S.A = (const char*)(F.ws + WS_H); S.Bt = (const char*)(F.ws + WS_WINT); S.G = F.G; S.c = F.bid; S.pn0 = 0; S.npn = 6; S.f8 = 0; gm::stage_geom(F.tid, S.R, S.C);
        gm::gemm_phase<true>(F.lds, 1024, S, E);
    }
    {
        ProjSched S; S.A = (const char*)(F.ws + WS_H8); S.Bt = (const char*)(F.ws + WS_WIN8); S.G = F.G; S.c = F.bid; S.pn0 = 6; S.npn = 14; S.f8 = 1; gm::stage_geom(F.tid, S.R, S.C);
        gm::gemm_phase<true, false, true>(F.lds, 512, S, E);
    }
}

__device__ __forceinline__ int crow(int r, int hi) { return (r & 3) + 8 * (r >> 2) + 4 * hi; }
typedef short v4i16_t __attribute__((ext_vector_type(4)));
__device__ __forceinline__ s16x4 vtr(const LAS unsigned char* p) { return __builtin_bit_cast(s16x4, __builtin_amdgcn_ds_read_tr16_b64_v4i16((LAS v4i16_t*)p)); }
#define PV_TR(dst, off) asm volatile("ds_read_b64_tr_b16 %0, %1 offset:%2" : "=v"(dst) : "v"(vb), "n"(off) : "memory")
__device__ __forceinline__ void pv64(f32x16 (&o)[2], const LAS unsigned char* vt, int lane, const u32x4 (&pw)[4]) {
    const int hi = lane >> 5;
    const LAS unsigned char* vb = vt + ((lane >> 4) & 1) * 32 + (lane & 3) * 8 + (4 * hi + ((lane & 15) >> 2)) * 64;
    s16x4 lo[2][4], hh[2][4];
#pragma unroll
    for (int ks = 0; ks < 4; ++ks) { PV_TR(lo[0][ks], ks * 1024); PV_TR(hh[0][ks], ks * 1024 + 512); }
#pragma unroll
    for (int ks = 0; ks < 4; ++ks) { PV_TR(lo[1][ks], 4096 + ks * 1024); PV_TR(hh[1][ks], 4096 + ks * 1024 + 512); }
    asm volatile("s_waitcnt lgkmcnt(8)" : "+v"(lo[0][0]), "+v"(lo[0][1]), "+v"(lo[0][2]), "+v"(lo[0][3]), "+v"(hh[0][0]), "+v"(hh[0][1]), "+v"(hh[0][2]), "+v"(hh[0][3]) :: "memory");
#pragma unroll
    for (int ks = 0; ks < 4; ++ks) {
        const bf16x8 bv = (bf16x8){lo[0][ks][0], lo[0][ks][1], lo[0][ks][2], lo[0][ks][3], hh[0][ks][0], hh[0][ks][1], hh[0][ks][2], hh[0][ks][3]};
        o[0] = __builtin_amdgcn_mfma_f32_32x32x16_bf16(__builtin_bit_cast(bf16x8, pw[ks]), bv, o[0], 0, 0, 0);
    }
    asm volatile("s_waitcnt lgkmcnt(0)" : "+v"(lo[1][0]), "+v"(lo[1][1]), "+v"(lo[1][2]), "+v"(lo[1][3]), "+v"(hh[1][0]), "+v"(hh[1][1]), "+v"(hh[1][2]), "+v"(hh[1][3]) :: "memory");
#pragma unroll
    for (int ks = 0; ks < 4; ++ks) {
        const bf16x8 bv = (bf16x8){lo[1][ks][0], lo[1][ks][1], lo[1][ks][2], lo[1][ks][3], hh[1][ks][0], hh[1][ks][1], hh[1][ks][2], hh[1][ks][3]};
        o[1] = __builtin_amdgcn_mfma_f32_32x32x16_bf16(__builtin_bit_cast(bf16x8, pw[ks]), bv, o[1], 0, 0, 0);
    }
}
__device__ __forceinline__ void store_o_tile(const f32x16 (&o)[2], LAS unsigned char* stgb, int lane, bf16_t* dst0, size_t row_pitch) {
    const int r32 = lane & 31, hi = lane >> 5;
    LAS bf16_t* stg = (LAS bf16_t*)stgb;
#pragma unroll
    for (int r = 0; r < 16; ++r) { const int orow = crow(r, hi);
#pragma unroll
        for (int d0 = 0; d0 < 2; ++d0) stg[orow * 64 + d0 * 32 + r32] = (bf16_t)(cvtpk(o[d0][r], 0.f) & 0xffffu); }
    LDS_WAIT();
#pragma unroll
    for (int i = 0; i < 4; ++i) { const int row = i * 8 + (lane >> 3), ch = lane & 7; const u32x4 v = *(const LAS u32x4*)(stg + row * 64 + ch * 8); *(u32x4*)(dst0 + (size_t)row * row_pitch + ch * 8) = v; }
    LDS_WAIT();
}

template <bool MASKED>
__device__ __forceinline__ void sb_tile(const f32x16 (&z)[2], float& P, u32x4 (&pw)[4], int k0, int qpos, int hi) {
    f32x16 be[2], nb[2];
#pragma unroll
    for (int p = 0; p < 2; ++p)
#pragma unroll
        for (int r = 0; r < 16; ++r) {
            const float zz = __builtin_amdgcn_fmed3f(z[p][r], -126.f, 126.f);
            const float t = __builtin_amdgcn_exp2f(-zz), b_ = __builtin_amdgcn_rcpf(1.f + t);
            float n_ = t * b_, bb = b_;
            if (MASKED) { const bool valid = (k0 + 32 * p + crow(r, hi)) < qpos; n_ = valid ? n_ : 1.f; bb = valid ? bb : 0.f; }
            be[p][r] = bb; nb[p][r] = n_;
        }
    float Gp[8], PG[8], off[8];
#pragma unroll
    for (int idx = 0; idx < 8; ++idx) { const int p = idx >> 2, g4 = (idx & 3) * 4; Gp[idx] = (nb[p][g4] * nb[p][g4 + 1]) * (nb[p][g4 + 2] * nb[p][g4 + 3]); }
#pragma unroll
    for (int idx = 0; idx < 8; ++idx) PG[idx] = __shfl_xor(Gp[idx], 32);
    float run = P;
#pragma unroll
    for (int idx = 7; idx >= 0; --idx) { off[idx] = hi ? run : run * PG[idx]; run *= (Gp[idx] * PG[idx]); }
    P = run;
#pragma unroll
    for (int idx = 0; idx < 8; ++idx) { const int p = idx >> 2, g4 = (idx & 3) * 4; float c = off[idx]; float a[4];
#pragma unroll
        for (int j = 3; j >= 0; --j) { a[j] = be[p][g4 + j] * c; c *= nb[p][g4 + j]; }
        pw[idx >> 1][(idx & 1) * 2] = cvtpk(a[0], a[1]); pw[idx >> 1][(idx & 1) * 2 + 1] = cvtpk(a[2], a[3]); }
}
__device__ __forceinline__ void sb_unit(Ctx& F, int bh, int qt, LAS unsigned char* vl) {
    const int lane = F.lane, r32 = lane & 31, hi = lane >> 5;
    const int b = bh >> 3, h = bh & 7, q0 = qt * 32, qpos = q0 + r32;
    const bf16_t* base = (const bf16_t*)(F.ws + WS_QSB) + (size_t)b * SEQ * QW + h * 64;
    const bf16_t* Kb = base + 512 + (size_t)r32 * QW + hi * 8; const bf16_t* Vb = base + 1024 + (size_t)(lane >> 2) * QW + (lane & 3) * 8;
    bf16x8 qr[4];
#pragma unroll
    for (int d0 = 0; d0 < 4; ++d0) qr[d0] = *(const bf16x8*)(base + (size_t)qpos * QW + d0 * 16 + hi * 8);
    float P = 1.f; f32x16 o[2]; o[0] = f32x16{}; o[1] = f32x16{};
    bf16x8 kfn[8];
    const int kt0 = q0 >> 6; int kt = kt0, cur = 0;
#define SB_PREFETCH(KT, BUF) do { const size_t ko_ = (size_t)(KT) * 64 * QW; \
        _Pragma("unroll") for (int d0 = 0; d0 < 4; ++d0) _Pragma("unroll") for (int hf = 0; hf < 2; ++hf) kfn[2 * d0 + hf] = *(const bf16x8*)(Kb + ko_ + (size_t)(32 * hf) * QW + d0 * 16); \
        _Pragma("unroll") for (int p = 0; p < 8; ++p) __builtin_amdgcn_global_load_lds((const unsigned*)(Vb + ko_ + (size_t)(16 * (p & 3)) * QW + (p >> 2) * 32), (LAS unsigned*)(vl + (BUF) * 8192 + p * 1024), 16, 0, 0); } while (0)
    SB_PREFETCH(kt, 0);
#pragma unroll 1
    for (; kt >= 0; --kt) {
        if (__all(P == 0.f)) break;
        f32x16 z[2]; z[0] = f32x16{}; z[1] = f32x16{};
#pragma unroll
        for (int d0 = 0; d0 < 4; ++d0) { z[0] = __builtin_amdgcn_mfma_f32_32x32x16_bf16(kfn[2 * d0], qr[d0], z[0], 0, 0, 0); z[1] = __builtin_amdgcn_mfma_f32_32x32x16_bf16(kfn[2 * d0 + 1], qr[d0], z[1], 0, 0, 0); }
        asm volatile("" : "+v"(z[0]), "+v"(z[1]));
        { const int ktn = kt > 0 ? kt - 1 : 0; SB_PREFETCH(ktn, cur ^ 1); }
        u32x4 pw[4];
        if (kt == kt0) sb_tile<true>(z, P, pw, kt * 64, qpos, hi); else sb_tile<false>(z, P, pw, kt * 64, qpos, hi);
        asm volatile("s_waitcnt vmcnt(16)" ::: "memory");
        pv64(o, vl + cur * 8192, lane, pw);
        cur ^= 1;
    }
#undef SB_PREFETCH
    asm volatile("s_waitcnt vmcnt(0)" ::: "memory");
    bf16_t* dst = (bf16_t*)(F.ws + WS_OB) + (size_t)(b * SEQ + q0) * 1024 + h * 64;
    store_o_tile(o, vl, lane, dst, 1024);
}
__device__ __forceinline__ void sb_units(Ctx& F) {
    const int gw = F.bid * 8 + F.wave, NGW = F.G * 8;
    LAS unsigned char* vl = F.lds + F.wave * 16384;
    for (int u = gw; u < 32 * 256; u += NGW) sb_unit(F, u >> 8, u & 255, vl);
}

constexpr int MO_LUT = 0, MO_PRE = 4224, MO_WSF = 8320, MO_ENT = 12416, MO_ST = 16368;
__device__ __forceinline__ int mb_list_off(int j) { return 256 * (31 * j - (j * (j - 1)) / 2); }
constexpr int MB_LIST_STRIDE = 126976;
__device__ __forceinline__ int t5_bucket_dev(int n) {
    if (n < 16) return n;
    int large = 16 + (int)(logf((float)n / 16.f) / 2.0794415416798357f * 16.f);
    return large < 31 ? large : 31;
}
__device__ __forceinline__ void build_lut(Ctx& F) {
    LAS float* lut = (LAS float*)(F.lds + MISC_OFF + MO_LUT);
    for (int i = F.tid; i < 8 * 132; i += 512) { const int h = i / 132, d = i % 132; lut[i] = inp(F, I_RELB)[h * 32 + t5_bucket_dev(d < 128 ? d : 128)] * LOG2E; }
}
__device__ __forceinline__ void phase4(Ctx& F) {
    LAS int* lcnt = (LAS int*)(F.lds + MISC_OFF + MO_PRE); LAS int* lbase = lcnt + 32;
    const float* kbar = (const float*)(F.ws + WS_CTL + CTL_KBS);
    unsigned* cur = (unsigned*)(F.ws + WS_CTL) + CW_MBCUR;
    unsigned short* lists = (unsigned short*)(F.ws + WS_LMB);
    const int lane = F.lane, r32 = lane & 31, hi = lane >> 5;
    for (int u = F.bid; u < 32 * 31; u += F.G) {
        const int bh = u / 31, i = 1 + (u % 31), b = bh >> 3, h = bh & 7;
        if (F.tid < 32) lcnt[F.tid] = 0;
        __syncthreads();
        const int qpos = i * 256 + F.wave * 32 + r32;
        const float* kp = kbar + (size_t)(b * 32 + r32) * 512 + h * 64 + hi * 8;
        const bf16_t* qp = (const bf16_t*)(F.ws + WS_QMB) + (size_t)(b * SEQ + qpos) * QW + h * 64 + hi * 8;
        f32x16 gt = f32x16{};
#pragma unroll
        for (int s4 = 0; s4 < 4; ++s4) {
            const f32x4 k0 = *(const f32x4*)(kp + 16 * s4), k1 = *(const f32x4*)(kp + 16 * s4 + 4);
            const bf16x8 qf = *(const bf16x8*)(qp + 16 * s4);
            const unsigned a0 = cvtpk(k0.x, k0.y), a1 = cvtpk(k0.z, k0.w), a2 = cvtpk(k1.x, k1.y), a3 = cvtpk(k1.z, k1.w);
            const u32x4 kh = (u32x4){a0, a1, a2, a3};
            const u32x4 kl = (u32x4){cvtpk(k0.x - bflo(a0), k0.y - bfhi(a0)), cvtpk(k0.z - bflo(a1), k0.w - bfhi(a1)), cvtpk(k1.x - bflo(a2), k1.y - bfhi(a2)), cvtpk(k1.z - bflo(a3), k1.w - bfhi(a3))};
            gt = __builtin_amdgcn_mfma_f32_32x32x16_bf16(__builtin_bit_cast(bf16x8, kl), qf, gt, 0, 0, 0);
            gt = __builtin_amdgcn_mfma_f32_32x32x16_bf16(__builtin_bit_cast(bf16x8, kh), qf, gt, 0, 0, 0);
        }
        float v0 = -INFINITY, v1 = -INFINITY, v2 = -INFINITY; int j0 = 64, j1 = 64, j2 = 64;
#pragma unroll
        for (int r = 0; r < 16; ++r) { const int j = crow(r, hi); const float g = j < i ? gt[r] : -INFINITY;
            if (g > v0) { v2 = v1; j2 = j1; v1 = v0; j1 = j0; v0 = g; j0 = j; }
            else if (g > v1) { v2 = v1; j2 = j1; v1 = g; j1 = j; }
            else if (g > v2) { v2 = g; j2 = j; } }
        {
            const float pv[3] = {__shfl_xor(v0, 32), __shfl_xor(v1, 32), __shfl_xor(v2, 32)}; const int pj[3] = {__shfl_xor(j0, 32), __shfl_xor(j1, 32), __shfl_xor(j2, 32)};
#pragma unroll
            for (int t = 0; t < 3; ++t) { const float g = pv[t]; const int j = pj[t];
                if (g > v0 || (g == v0 && j < j0)) { v2 = v1; j2 = j1; v1 = v0; j1 = j0; v0 = g; j0 = j; }
                else if (g > v1 || (g == v1 && j < j1)) { v2 = v1; j2 = j1; v1 = g; j1 = j; }
                else if (g > v2 || (g == v2 && j < j2)) { v2 = g; j2 = j; } }
        }
        const int nsel = i < 3 ? i : 3;
        int r0 = 0, r1 = 0, r2 = 0;
        if (hi == 0) { r0 = lds_add(&lcnt[j0], 1); if (nsel > 1) r1 = lds_add(&lcnt[j1], 1); if (nsel > 2) r2 = lds_add(&lcnt[j2], 1); }
        __syncthreads();
        if (F.tid < i) { const int n = lcnt[F.tid]; lbase[F.tid] = n > 0 ? (int)atomicAdd(&cur[bh * 32 + F.tid], (unsigned)n) : 0; }
        __syncthreads();
        if (hi == 0) {
            unsigned short* lb = lists + (size_t)bh * MB_LIST_STRIDE;
            lb[mb_list_off(j0) + lbase[j0] + r0] = (unsigned short)(qpos | (0 << 13));
            if (nsel > 1) lb[mb_list_off(j1) + lbase[j1] + r1] = (unsigned short)(qpos | (1 << 13));
            if (nsel > 2) lb[mb_list_off(j2) + lbase[j2] + r2] = (unsigned short)(qpos | (2 << 13));
        }
    }
}
__device__ __forceinline__ void kv_dma(Ctx& F, const bf16_t* kg, const bf16_t* vg, int bufoff) {
    const int l = F.lane;
#pragma unroll
    for (int i = 0; i < 4; ++i) { const int p = 4 * F.wave + i;
        __builtin_amdgcn_global_load_lds((const unsigned*)(kg + (size_t)(8 * p + (l >> 3)) * QW + ((l & 7) ^ ((l >> 3) & 7)) * 8), (LAS unsigned*)(F.lds + bufoff + p * 1024), 16, 0, 0);
        __builtin_amdgcn_global_load_lds((const unsigned*)(vg + (size_t)((p >> 3) * 64 + (p & 3) * 16 + (l >> 2)) * QW + ((p >> 2) & 1) * 32 + (l & 3) * 8), (LAS unsigned*)(F.lds + bufoff + 32768 + p * 1024), 16, 0, 0); }
}
__device__ __forceinline__ void softmax_step(f32x16 (&t)[2], float& m, float& l, f32x16 (&o)[2], LAS float* wsf, const LAS unsigned char* vt, int lane) {
    const int r32 = lane & 31, hi = lane >> 5;
    float rm = -INFINITY;
#pragma unroll
    for (int p = 0; p < 2; ++p)
#pragma unroll
        for (int r = 0; r < 16; ++r) rm = fmaxf(rm, t[p][r]);
    rm = fmaxf(rm, __shfl_xor(rm, 32));
    const float mn = fmaxf(m, rm);
    const float f = __builtin_amdgcn_exp2f(m - mn);
    m = mn;
    float s = 0.f; u32x4 pw[4];
#pragma unroll
    for (int p = 0; p < 2; ++p)
#pragma unroll
        for (int r = 0; r < 16; ++r) { const float e = __builtin_amdgcn_exp2f(t[p][r] - mn); t[p][r] = e; s += e; }
    l = l * f + s;
#pragma unroll
    for (int idx = 0; idx < 8; ++idx) { const int p = idx >> 2, g4 = (idx & 3) * 4; pw[idx >> 1][(idx & 1) * 2] = cvtpk(t[p][g4], t[p][g4 + 1]); pw[idx >> 1][(idx & 1) * 2 + 1] = cvtpk(t[p][g4 + 2], t[p][g4 + 3]); }
    if (__any(f != 1.f)) {
        if (hi == 0) wsf[r32] = f;
        LDS_WAIT();
#pragma unroll
        for (int g = 0; g < 4; ++g) { const f32x4 fv = *(const LAS f32x4*)(wsf + 8 * g + 4 * hi);
#pragma unroll
            for (int j = 0; j < 4; ++j) { o[0][4 * g + j] *= fv[j]; o[1][4 * g + j] *= fv[j]; } }
        LDS_WAIT();
    }
    pv64(o, vt, lane, pw);
}
__device__ __forceinline__ void qkt64(f32x16 (&t)[2], const LAS unsigned char* kt, const bf16x8 (&qr)[4], int lane) {
    const int r32 = lane & 31, hi = lane >> 5;
    t[0] = f32x16{}; t[1] = f32x16{};
    const LAS unsigned char* rp = kt + r32 * 128;
#pragma unroll
    for (int d0 = 0; d0 < 4; ++d0) {
        const int pos = ((2 * d0 + hi) ^ (r32 & 7)) * 16;
        const bf16x8 k0 = *(const LAS bf16x8*)(rp + pos), k1 = *(const LAS bf16x8*)(rp + 4096 + pos);
        t[0] = __builtin_amdgcn_mfma_f32_32x32x16_bf16(k0, qr[d0], t[0], 0, 0, 0); t[1] = __builtin_amdgcn_mfma_f32_32x32x16_bf16(k1, qr[d0], t[1], 0, 0, 0);
    }
}
__device__ __forceinline__ void phase5(Ctx& F) {
    LAS int* pre = (LAS int*)(F.lds + MISC_OFF + MO_PRE);
    LAS int* wtot = (LAS int*)(F.lds + MISC_OFF + MO_ENT);
    const unsigned* cur = (const unsigned*)(F.ws + WS_CTL) + CW_MBCUR;
    build_lut(F);
    int total;
    {
        const int p0 = 2 * F.tid, p1 = p0 + 1;
        const int n0 = p0 < 992 ? (int)cur[(p0 / 31) * 32 + (p0 % 31)] : 0, n1 = p1 < 992 ? (int)cur[(p1 / 31) * 32 + (p1 % 31)] : 0;
        const int c0 = (n0 + 255) >> 8, c1 = (n1 + 255) >> 8;
        const int s = c0 + c1; int v = s;
#pragma unroll
        for (int o = 1; o < 64; o <<= 1) { const int n = __shfl_up(v, o); if (F.lane >= o) v += n; }
        if (F.lane == 63) wtot[248 + F.wave] = v;
        __syncthreads();
        int woff = 0; total = 0;
#pragma unroll
        for (int w = 0; w < 8; ++w) { const int x = wtot[248 + w]; if (w < F.wave) woff += x; total += x; }
        const int excl = woff + v - s;
        pre[p0] = excl | (n0 << 16); pre[p1] = (excl + c0) | (n1 << 16);
        __syncthreads();
    }
    const unsigned short* lists = (const unsigned short*)(F.ws + WS_LMB);
    LAS float* wsf = (LAS float*)(F.lds + MISC_OFF + MO_WSF) + F.wave * 128;
    LAS int* ent = (LAS int*)(F.lds + MISC_OFF + MO_ENT) + F.wave * 32;
    const int lane = F.lane, r32 = lane & 31, hi = lane >> 5;
#define P5_UNIT(U, BH, J, C, N) do { int lo_ = 0, hi_ = 992; while (hi_ - lo_ > 1) { const int mid = (lo_ + hi_) >> 1; if ((pre[mid] & 0xffff) <= (U)) lo_ = mid; else hi_ = mid; } \
        const int w_ = pre[lo_]; BH = lo_ / 31; J = lo_ % 31; C = (U) - (w_ & 0xffff); N = w_ >> 16; } while (0)
#define P5_DMA(BH, J, BUF) do { const bf16_t* b_ = (const bf16_t*)(F.ws + WS_QMB) + (size_t)((BH) >> 3) * SEQ * QW + ((BH) & 7) * 64; kv_dma(F, b_ + 512 + (size_t)((J) * 256) * QW, b_ + 1024 + (size_t)((J) * 256) * QW, (BUF) * 65536); } while (0)
#define P5_ENTRY(BH, J, C, N, ACT, VALID, ENTRY) do { const int e0_ = (C) * 256 + F.wave * 32; ACT = e0_ < (N); VALID = ACT && (e0_ + r32) < (N); \
        const unsigned short* lb_ = lists + (size_t)(BH) * MB_LIST_STRIDE + mb_list_off(J); ENTRY = ACT ? (int)lb_[VALID ? e0_ + r32 : e0_] : 0; } while (0)
#define P5_QLOAD(BH, ENTRY, Q) do { const bf16_t* b_ = (const bf16_t*)(F.ws + WS_QMB) + (size_t)((BH) >> 3) * SEQ * QW + ((BH) & 7) * 64 + (size_t)((ENTRY) & 8191) * QW + hi * 8; \
        _Pragma("unroll") for (int d0 = 0; d0 < 4; ++d0) Q[d0] = *(const bf16x8*)(b_ + d0 * 16); } while (0)
    int u = F.bid, bh = 0, j = 0, c = 0, n = 0, buf = 0, bhn = 0, jn = 0, cn = 0, nn = 0;
    bool act = false, valid = false, actn = false, validn = false; int entry = 0, entryn = 0; bf16x8 qr[4] = {};
    if (u < total) {
        P5_UNIT(u, bh, j, c, n); P5_ENTRY(bh, j, c, n, act, valid, entry);
        if (u + F.G < total) { P5_UNIT(u + F.G, bhn, jn, cn, nn); P5_ENTRY(bhn, jn, cn, nn, actn, validn, entryn); }
        P5_QLOAD(bh, entry, qr); P5_DMA(bh, j, 0);
    }
    asm volatile("s_waitcnt vmcnt(0)" : "+v"(qr[0]), "+v"(qr[1]), "+v"(qr[2]), "+v"(qr[3]), "+v"(entry), "+v"(entryn) :: "memory");
    for (; u < total; u += F.G) {
        const bool has_next = u + F.G < total, has_n2 = u + 2 * F.G < total;
        int bh2 = 0, j2 = 0, c2 = 0, n2 = 0;
        if (has_n2) P5_UNIT(u + 2 * F.G, bh2, j2, c2, n2);
        const int h = bh & 7;
        const int qpos = entry & 8191, slot = entry >> 13;
        LDS_WAIT();
        __builtin_amdgcn_s_barrier();
        bool act2 = false, valid2 = false; int entry2 = 0; bf16x8 qn[4] = {};
        if (has_next) { P5_QLOAD(bhn, entryn, qn); P5_DMA(bhn, jn, buf ^ 1); }
        if (has_n2) P5_ENTRY(bh2, j2, c2, n2, act2, valid2, entry2);
        const LAS unsigned char* kimg = F.lds + buf * 65536; const LAS unsigned char* vimg = kimg + 32768;
        float m = -INFINITY, l = 0.f; f32x16 o[2];
        if (act) {
            if (hi == 0) ent[r32] = valid ? entry : -1;
            o[0] = f32x16{}; o[1] = f32x16{};
            const LAS float* lut = (const LAS float*)(F.lds + MISC_OFF + MO_LUT) + h * 132;
            const float bfar = lut[128];
#pragma unroll 1
            for (int st = 0; st < 4; ++st) {
                f32x16 t[2]; qkt64(t, kimg + st * 8192, qr, lane);
                const int kbase = j * 256 + st * 64;
                const bool far = __all(qpos - (kbase + 63) >= 128);
                if (far) {
#pragma unroll
                    for (int pp = 0; pp < 2; ++pp)
#pragma unroll
                        for (int r = 0; r < 16; ++r) t[pp][r] = t[pp][r] * LOG2E + bfar;
                } else {
#pragma unroll
                    for (int pp = 0; pp < 2; ++pp)
#pragma unroll
                        for (int r = 0; r < 16; ++r) { int d = qpos - (kbase + 32 * pp + crow(r, hi)); d = d < 128 ? d : 128; d = d > 0 ? d : 0; t[pp][r] = t[pp][r] * LOG2E + lut[d]; }
                }
                softmax_step(t, m, l, o, wsf, vimg + st * 8192, lane);
            }
        }
        asm volatile("s_waitcnt vmcnt(0)" : "+v"(qn[0]), "+v"(qn[1]), "+v"(qn[2]), "+v"(qn[3]), "+v"(entry2) :: "memory");
#pragma unroll
        for (int d0 = 0; d0 < 4; ++d0) qr[d0] = qn[d0];
        if (act) {
            l += __shfl_xor(l, 32);
            const float rl = 1.f / l;
            if (hi == 0) { wsf[r32] = rl; if (valid) ((float*)(F.ws + WS_PLSE))[((size_t)bh * SEQ + qpos) * 3 + slot] = m + __log2f(l); }
            LDS_WAIT();
            {
                LAS bf16_t* stg = (LAS bf16_t*)(F.lds + MISC_OFF + MO_STG + F.wave * 2048);
                bf16_t* po = (bf16_t*)(F.ws + WS_PO);
#pragma unroll
                for (int d0 = 0; d0 < 2; ++d0) {
#pragma unroll
                    for (int r = 0; r < 16; ++r) { const int q = crow(r, hi); stg[q * 32 + r32] = (bf16_t)(cvtpk(o[d0][r] * wsf[q], 0.f) & 0xffffu); }
                    LDS_WAIT();
#pragma unroll
                    for (int it2 = 0; it2 < 2; ++it2) { const int row = it2 * 16 + (lane >> 2), ch = lane & 3; const int en = ent[row];
                        const u32x4 v = *(const LAS u32x4*)(stg + row * 32 + ch * 8);
                        if (en >= 0) *(u32x4*)(po + (((size_t)bh * SEQ + (en & 8191)) * 3 + (en >> 13)) * 64 + d0 * 32 + ch * 8) = v; }
                    LDS_WAIT();
                }
            }
        }
        bh = bhn; j = jn; c = cn; n = nn; act = actn; valid = validn; entry = entryn;
        bhn = bh2; jn = j2; cn = c2; nn = n2; actn = act2; validn = valid2; entryn = entry2;
        buf ^= 1;
    }
#undef P5_ENTRY
#undef P5_QLOAD
#undef P5_UNIT
#undef P5_DMA
    asm volatile("s_waitcnt vmcnt(0)" ::: "memory");
    __syncthreads();
}
__device__ __forceinline__ void phase6(Ctx& F) {
    build_lut(F);
    LAS float* wsf = (LAS float*)(F.lds + MISC_OFF + MO_WSF) + F.wave * 128;
    const int lane = F.lane, r32 = lane & 31, hi = lane >> 5, w = F.wave;
#define P6_DMA(U, BUF) do { const int bh_ = (U) >> 5, i_ = 31 - ((U) & 31); const bf16_t* b_ = (const bf16_t*)(F.ws + WS_QMB) + (size_t)(bh_ >> 3) * SEQ * QW + (bh_ & 7) * 64; \
        kv_dma(F, b_ + 512 + (size_t)(i_ * 256) * QW, b_ + 1024 + (size_t)(i_ * 256) * QW, (BUF) * 65536); } while (0)
#define P6_QLOAD(U, Q, L0, L1, L2) do { const int bh_ = (U) >> 5, i_ = 31 - ((U) & 31), qp_ = i_ * 256 + w * 32 + r32, ns_ = i_ < 3 ? i_ : 3; \
        const bf16_t* b_ = (const bf16_t*)(F.ws + WS_QMB) + (size_t)(bh_ >> 3) * SEQ * QW + (bh_ & 7) * 64 + (size_t)qp_ * QW + hi * 8; \
        _Pragma("unroll") for (int d0 = 0; d0 < 4; ++d0) Q[d0] = *(const bf16x8*)(b_ + d0 * 16); \
        const float* pl_ = (const float*)(F.ws + WS_PLSE) + ((size_t)bh_ * SEQ + qp_) * 3; \
        L0 = -INFINITY; L1 = -INFINITY; L2 = -INFINITY; if (ns_ > 0) L0 = pl_[0]; if (ns_ > 1) L1 = pl_[1]; if (ns_ > 2) L2 = pl_[2]; } while (0)
    int buf = 0;
    bf16x8 qr[4] = {}; float ls0 = -INFINITY, ls1 = -INFINITY, ls2 = -INFINITY;
    if (F.bid < 32 * 32) { P6_QLOAD(F.bid, qr, ls0, ls1, ls2); P6_DMA(F.bid, 0); }
    asm volatile("s_waitcnt vmcnt(0)" : "+v"(qr[0]), "+v"(qr[1]), "+v"(qr[2]), "+v"(qr[3]), "+v"(ls0), "+v"(ls1), "+v"(ls2) :: "memory");
    for (int u = F.bid; u < 32 * 32; u += F.G) {
        const int bh = u >> 5, i = 31 - (u & 31), b = bh >> 3, h = bh & 7;
        const int ql = w * 32 + r32;
        const int nsel = i < 3 ? i : 3;
        const bool has_next = u + F.G < 32 * 32;
        LDS_WAIT();
        __builtin_amdgcn_s_barrier();
        if (has_next) P6_DMA(u + F.G, buf ^ 1);
        const LAS unsigned char* kimg = F.lds + buf * 65536; const LAS unsigned char* vimg = kimg + 32768;
        float m = -INFINITY, l = 0.f; f32x16 o[2]; o[0] = f32x16{}; o[1] = f32x16{};
        const LAS float* lut = (const LAS float*)(F.lds + MISC_OFF + MO_LUT) + h * 132;
        const int nst = (w >> 1) + 1;
#pragma unroll 1
        for (int st = 0; st < nst; ++st) {
            f32x16 t[2]; qkt64(t, kimg + st * 8192, qr, lane);
#pragma unroll
            for (int pp = 0; pp < 2; ++pp)
#pragma unroll
                for (int r = 0; r < 16; ++r) { const int d = ql - (st * 64 + 32 * pp + crow(r, hi)); const int dc = d < 128 ? (d > 0 ? d : 0) : 128; const float v = t[pp][r] * LOG2E + lut[dc]; t[pp][r] = d >= 0 ? v : -INFINITY; }
            softmax_step(t, m, l, o, wsf, vimg + st * 8192, lane);
        }
        l += __shfl_xor(l, 32);
        const float M = fmaxf(fmaxf(m, ls0), fmaxf(ls1, ls2));
        const float eo = __builtin_amdgcn_exp2f(m - M), e0 = __builtin_amdgcn_exp2f(ls0 - M), e1 = __builtin_amdgcn_exp2f(ls1 - M), e2 = __builtin_amdgcn_exp2f(ls2 - M);
        const float rden = 1.f / (l * eo + e0 + e1 + e2);
        if (hi == 0) *(LAS f32x4*)(wsf + 4 * r32) = (f32x4){eo * rden, e0 * rden, e1 * rden, e2 * rden};
        LDS_WAIT();
#pragma unroll
        for (int r = 0; r < 16; ++r) { const float fo = wsf[4 * crow(r, hi)]; o[0][r] *= fo; o[1][r] *= fo; }
        LDS_WAIT();
        __builtin_amdgcn_s_barrier();
        {
            const bf16_t* po = (const bf16_t*)(F.ws + WS_PO) + ((size_t)bh * SEQ + i * 256 + w * 32) * 3 * 64;
            u32x4 pv[4][3];
#pragma unroll
            for (int it4 = 0; it4 < 4; ++it4) { const int row = it4 * 8 + (lane >> 3), ch = lane & 7;
#pragma unroll
                for (int sl = 0; sl < 3; ++sl) { pv[it4][sl] = (u32x4){0u, 0u, 0u, 0u}; if (sl < nsel) pv[it4][sl] = *(const u32x4*)(po + (size_t)(row * 3 + sl) * 64 + ch * 8); } }
            bf16x8 qn[4] = {}; float ln0 = -INFINITY, ln1 = -INFINITY, ln2 = -INFINITY;
            if (has_next) P6_QLOAD(u + F.G, qn, ln0, ln1, ln2);
            LAS bf16_t* stg = (LAS bf16_t*)(F.lds + buf * 65536 + w * 4096);
#pragma unroll
            for (int r = 0; r < 16; ++r) { const int orow = crow(r, hi);
#pragma unroll
                for (int d0 = 0; d0 < 2; ++d0) stg[orow * 64 + d0 * 32 + r32] = (bf16_t)(cvtpk(o[d0][r], 0.f) & 0xffffu); }
            LDS_WAIT();
            asm volatile("s_waitcnt vmcnt(0)" : "+v"(qn[0]), "+v"(qn[1]), "+v"(qn[2]), "+v"(qn[3]), "+v"(ln0), "+v"(ln1), "+v"(ln2) :: "memory");
#pragma unroll
            for (int it4 = 0; it4 < 4; ++it4)
#pragma unroll
                for (int sl = 0; sl < 3; ++sl) asm volatile("" : "+v"(pv[it4][sl]));
            bf16_t* dst = (bf16_t*)(F.ws + WS_OB) + (size_t)(b * SEQ + i * 256 + w * 32) * 1024 + 512 + h * 64;
#pragma unroll
            for (int it4 = 0; it4 < 4; ++it4) { const int row = it4 * 8 + (lane >> 3), ch = lane & 7;
                const u32x4 ov = *(const LAS u32x4*)(stg + row * 64 + ch * 8);
                float a[8] = {bflo(ov.x), bfhi(ov.x), bflo(ov.y), bfhi(ov.y), bflo(ov.z), bfhi(ov.z), bflo(ov.w), bfhi(ov.w)};
                const f32x4 fc = *(const LAS f32x4*)(wsf + 4 * row);
#pragma unroll
                for (int sl = 0; sl < 3; ++sl) if (sl < nsel) { const u32x4 pvv = pv[it4][sl]; const float f = fc[1 + sl];
                    a[0] += f * bflo(pvv.x); a[1] += f * bfhi(pvv.x); a[2] += f * bflo(pvv.y); a[3] += f * bfhi(pvv.y); a[4] += f * bflo(pvv.z); a[5] += f * bfhi(pvv.z); a[6] += f * bflo(pvv.w); a[7] += f * bfhi(pvv.w); }
                u32x4 w4; w4.x = cvtpk(a[0], a[1]); w4.y = cvtpk(a[2], a[3]); w4.z = cvtpk(a[4], a[5]); w4.w = cvtpk(a[6], a[7]);
                *(u32x4*)(dst + (size_t)row * 1024 + ch * 8) = w4; }
            LDS_WAIT();
#pragma unroll
            for (int d0 = 0; d0 < 4; ++d0) qr[d0] = qn[d0];
            ls0 = ln0; ls1 = ln1; ls2 = ln2;
        }
        buf ^= 1;
    }
#undef P6_DMA
#undef P6_QLOAD
    asm volatile("s_waitcnt vmcnt(0)" ::: "memory");
    __syncthreads();
}

struct BranchSched {
    const char* A; const char* Bt; int G, c; int R[2], C[2];
    __device__ __forceinline__ bool next(int i, gm::UnitD& u) {
        int pm, pn; if (!gm::static_tile(MT, 1024, G, c, i, pm, pn)) return false;
        u.a = A; u.b = Bt + (size_t)(pn * 256) * 1024 * 2;
#pragma unroll
        for (int h = 0; h < 2; ++h)
#pragma unroll
            for (int j = 0; j < 2; ++j) u.va[h][j] = (unsigned)((pm * 256 + h * 128 + R[j]) * 1024 + C[j]) * 2u;
        u.e0 = pm; u.e1 = pn; u.e2 = 0; u.e3 = 0; return true;
    }
};
struct EpiBranch {
    const bf16_t* g; bf16_t* merged;
    static __device__ __forceinline__ float ratio(float gs, float gm_) { return (1.f + fminf(__expf(-gm_), 1e30f)) * __builtin_amdgcn_rcpf(1.f + __expf(-gs)); }
    __device__ __forceinline__ void mid(f32x4 (&acc)[2][2][4][2], const gm::UnitD& u, int wr, int wc, int fr, int fq) const {
        const bf16_t* gp = g + (size_t)(u.e0 * 256 + wr * 64 + fr) * 2048 + u.e1 * 256 + wc * 32 + 8 * fq;
#pragma unroll
        for (int ai = 0; ai < 2; ++ai)
#pragma unroll
            for (int m = 0; m < 4; m += 2) {
                asm volatile("" : "+v"(gp) :: "memory");
                u32x4 gs[2][2], gq[2][2];
#pragma unroll
                for (int mm = 0; mm < 2; ++mm)
#pragma unroll
                    for (int bj = 0; bj < 2; ++bj) { gs[mm][bj] = *(const u32x4*)(gp + (size_t)mm * 16 * 2048 + bj * 128); gq[mm][bj] = *(const u32x4*)(gp + (size_t)mm * 16 * 2048 + 1024 + bj * 128); }
#pragma unroll
                for (int mm = 0; mm < 2; ++mm)
#pragma unroll
                    for (int bj = 0; bj < 2; ++bj) { const u32x4 a = gs[mm][bj], b = gq[mm][bj];
                        f32x4& c0 = acc[ai][bj][m + mm][0]; f32x4& c1 = acc[ai][bj][m + mm][1];
                        c0[0] *= ratio(bflo(a.x), bflo(b.x)); c0[1] *= ratio(bfhi(a.x), bfhi(b.x)); c0[2] *= ratio(bflo(a.y), bflo(b.y)); c0[3] *= ratio(bfhi(a.y), bfhi(b.y));
                        c1[0] *= ratio(bflo(a.z), bflo(b.z)); c1[1] *= ratio(bfhi(a.z), bfhi(b.z)); c1[2] *= ratio(bflo(a.w), bflo(b.w)); c1[3] *= ratio(bfhi(a.w), bfhi(b.w));
                        asm volatile("" : "+v"(c0), "+v"(c1) :: "memory"); }
                gp += (m == 2 ? 96 : 32) * 2048; }
    }
    __device__ __forceinline__ void operator()(const f32x4 (&acc)[2][2][4][2], const gm::UnitD& u, int wr, int wc, int fr, int fq) const {
        const int row0 = u.e0 * 256 + wr * 64 + fr, col0 = u.e1 * 256 + wc * 32 + 8 * fq;
#pragma unroll
        for (int ai = 0; ai < 2; ++ai)
#pragma unroll
            for (int m = 0; m < 4; ++m) { const size_t row = (size_t)(row0 + ai * 128 + m * 16);
#pragma unroll
                for (int bj = 0; bj < 2; ++bj) { const u32x4 gm_ = *(const u32x4*)(g + row * 2048 + 1024 + col0 + bj * 128);
                    const float b[8] = {bflo(gm_.x), bfhi(gm_.x), bflo(gm_.y), bfhi(gm_.y), bflo(gm_.z), bfhi(gm_.z), bflo(gm_.w), bfhi(gm_.w)};
                    float r[8];
#pragma unroll
                    for (int j = 0; j < 8; ++j) r[j] = acc[ai][bj][m][j >> 2][j & 3] * __builtin_amdgcn_rcpf(1.f + fminf(__expf(-b[j]), 1e30f));
                    u32x4 w; w.x = cvtpk(r[0], r[1]); w.y = cvtpk(r[2], r[3]); w.z = cvtpk(r[4], r[5]); w.w = cvtpk(r[6], r[7]);
                    *(u32x4*)(merged + row * 1024 + col0 + bj * 128) = w; } }
    }
};
__device__ __forceinline__ void phase7(Ctx& F) {
    BranchSched S; S.A = (const char*)(F.ws + WS_OB); S.Bt = (const char*)(F.ws + WS_WBRT); S.G = F.G; S.c = F.bid; gm::stage_geom(F.tid, S.R, S.C);
    EpiBranch E{(const bf16_t*)(F.ws + WS_G), (bf16_t*)(F.ws + WS_MERGED)};
    gm::gemm_phase<true, true>(F.lds, 1024, S, E);
}
struct OutSched {
    const char* A; const char* Bt; int G, c; int R[2], C[2];
    __device__ __forceinline__ bool next(int i, gm::UnitD& u) {
        int pm, pn; if (!gm::static_tile(MT, 1024, G, c, i, pm, pn)) return false;
        u.a = A; u.b = Bt + (size_t)pn * 256 * 1024 * 2;
#pragma unroll
        for (int h = 0; h < 2; ++h)
#pragma unroll
            for (int j = 0; j < 2; ++j) u.va[h][j] = (unsigned)((pm * 256 + h * 128 + R[j]) * 1024 + C[j]) * 2u;
        u.e0 = pm; u.e1 = pn; u.e2 = 0; u.e3 = 0; return true;
    }
};
struct EpiOut {
    const float* x; const float* mod; bf16_t* out;
    __device__ __forceinline__ void operator()(const f32x4 (&acc)[2][2][4][2], const gm::UnitD& u, int wr, int wc, int fr, int fq) const {
        const int pm = u.e0, pn = u.e1, b = (pm * 256) / SEQ;
        const int row0 = pm * 256 + wr * 64 + fr, col0 = pn * 256 + wc * 32 + 4 * fq;
        f32x4 gt[2][2];
#pragma unroll
        for (int bj = 0; bj < 2; ++bj)
#pragma unroll
            for (int n = 0; n < 2; ++n) gt[bj][n] = *(const f32x4*)(mod + b * NMOD + 2 * DM + col0 + bj * 128 + n * 16);
#pragma unroll
        for (int ai = 0; ai < 2; ++ai)
#pragma unroll
            for (int m = 0; m < 4; ++m) { const size_t off = (size_t)(row0 + ai * 128 + m * 16) * DM + col0;
#pragma unroll
                for (int bj = 0; bj < 2; ++bj)
#pragma unroll
                    for (int n = 0; n < 2; ++n) { const f32x4 xv = *(const f32x4*)(x + off + bj * 128 + n * 16); const f32x4 r = xv + gt[bj][n] * acc[ai][bj][m][n];
                        u32x2 pk; pk.x = cvtpk(r.x, r.y); pk.y = cvtpk(r.z, r.w); *(u32x2*)(out + off + bj * 128 + n * 16) = pk; } }
    }
};
__device__ __forceinline__ void phase8(Ctx& F) {
    OutSched S; S.A = (const char*)(F.ws + WS_MERGED); S.Bt = (const char*)(F.ws + WS_WOUTT); S.G = F.G; S.c = F.bid; gm::stage_geom(F.tid, S.R, S.C);
    EpiOut E{inp(F, I_X), (const float*)(F.ws + WS_SMALL + SM_MOD), (bf16_t*)(F.ws + WS_X1B)};
    gm::gemm_phase<false>(F.lds, 1024, S, E);
}

constexpr int NR_SSQ = MO_PRE + 1024;
constexpr int NR_RS = MO_PRE + 3072;
__device__ __forceinline__ void phase_n2r(Ctx& F, int rr) {
    const bf16_t* x1 = (const bf16_t*)(F.ws + WS_X1B); const float* gvec = (const float*)(F.ws + WS_SMALL + SM_GVEC); const float* cb = (const float*)(F.ws + WS_SMALL + SM_CB);
    const float* mod = (const float*)(F.ws + WS_SMALL + SM_MOD); const float* rbias = inp(F, I_RB);
    unsigned char* H2 = (unsigned char*)(F.ws + WS_H2) + (size_t)rr * RT * DM; int* tokl = (int*)(F.ws + WS_TOKL) + (size_t)rr * 64 * RT; float* wl = (float*)(F.ws + WS_WL) + (size_t)rr * 64 * RT; int* tpos = (int*)(F.ws + WS_TPOS) + (size_t)rr * RT * 8;
    unsigned* cur = (unsigned*)(F.ws + WS_CTL) + CW_MOECUR + rr * 64;
    LAS int* lcnt = (LAS int*)(F.lds + MISC_OFF + MO_PRE); LAS int* lbase = lcnt + 64;
    LAS float* part = (LAS float*)(F.lds);
    LAS float* ssqp = (LAS float*)(F.lds + MISC_OFF + NR_SSQ); LAS float* rsl = (LAS float*)(F.lds + MISC_OFF + NR_RS);
    const int lane = F.lane, w = F.wave, i16 = lane & 15, kk = lane >> 4;
    for (int u = F.bid; u < RT / 64; u += F.G) {
        if (F.tid < 64) lcnt[F.tid] = 0;
        const int tokb = rr * RT + u * 64, b = tokb / SEQ;
        {
            bf16x8 fah[4][4], fal[4][4];
            {
                const float* gp = gvec + b * DM + 128 * w + 8 * kk;
                f32x4 gv[4][2];
#pragma unroll
                for (int s4 = 0; s4 < 4; ++s4) { gv[s4][0] = *(const f32x4*)(gp + 32 * s4); gv[s4][1] = *(const f32x4*)(gp + 32 * s4 + 4); }
                u32x4 xba[4][4];
#pragma unroll
                for (int tt = 0; tt < 4; ++tt) {
                    const bf16_t* xp = x1 + (size_t)(tokb + tt * 16 + i16) * DM + 128 * w + 8 * kk;
#pragma unroll
                    for (int s4 = 0; s4 < 4; ++s4) xba[tt][s4] = *(const u32x4*)(xp + 32 * s4);
                }
                asm volatile("" : "+v"(xba[0][0]), "+v"(xba[0][1]), "+v"(xba[0][2]), "+v"(xba[0][3]), "+v"(xba[1][0]), "+v"(xba[1][1]), "+v"(xba[1][2]), "+v"(xba[1][3]),
                                  "+v"(xba[2][0]), "+v"(xba[2][1]), "+v"(xba[2][2]), "+v"(xba[2][3]), "+v"(xba[3][0]), "+v"(xba[3][1]), "+v"(xba[3][2]), "+v"(xba[3][3]));
#pragma unroll
                for (int tt = 0; tt < 4; ++tt) {
                    const u32x4 (&xb)[4] = xba[tt];
                    float ssq = 0.f;
#pragma unroll
                    for (int s4 = 0; s4 < 4; ++s4) {
                        u32x4 ah, al;
#pragma unroll
                        for (int q = 0; q < 2; ++q) { const unsigned b0 = q ? xb[s4].z : xb[s4].x, b1 = q ? xb[s4].w : xb[s4].y; const f32x4 xv = (f32x4){bflo(b0), bfhi(b0), bflo(b1), bfhi(b1)}; ssq += (xv.x * xv.x + xv.y * xv.y) + (xv.z * xv.z + xv.w * xv.w);
                            const f32x4 a = xv * gv[s4][q];
                            const unsigned h0 = cvtpk(a.x, a.y), h1 = cvtpk(a.z, a.w);
                            ah[2 * q] = h0; ah[2 * q + 1] = h1; al[2 * q] = cvtpk(a.x - bflo(h0), a.y - bfhi(h0)); al[2 * q + 1] = cvtpk(a.z - bflo(h1), a.w - bfhi(h1)); }
                        fah[tt][s4] = __builtin_bit_cast(bf16x8, ah); fal[tt][s4] = __builtin_bit_cast(bf16x8, al);
                    }
                    ssq += __shfl_xor(ssq, 16); ssq += __shfl_xor(ssq, 32); if (kk == 0) ssqp[w * 64 + tt * 16 + i16] = ssq;
                }
            }
#pragma unroll 1
            for (int eh = 0; eh < 2; ++eh) {
                bf16x8 wh[2][4], wl_[2][4];
                {
                    const bf16_t* ph = (const bf16_t*)(F.ws + WS_SMALL + SM_WRH) + (size_t)(eh * 32 + i16) * DM + 128 * w + 8 * kk;
                    const bf16_t* pl = (const bf16_t*)(F.ws + WS_SMALL + SM_WRL) + (size_t)(eh * 32 + i16) * DM + 128 * w + 8 * kk;
#pragma unroll
                    for (int c = 0; c < 2; ++c)
#pragma unroll
                        for (int s4 = 0; s4 < 4; ++s4) { wh[c][s4] = *(const bf16x8*)(ph + (size_t)c * 16 * DM + 32 * s4); wl_[c][s4] = *(const bf16x8*)(pl + (size_t)c * 16 * DM + 32 * s4); }
                    asm volatile("" : "+v"(wh[0][0]), "+v"(wh[0][1]), "+v"(wh[0][2]), "+v"(wh[0][3]), "+v"(wh[1][0]), "+v"(wh[1][1]), "+v"(wh[1][2]), "+v"(wh[1][3]),
                                      "+v"(wl_[0][0]), "+v"(wl_[0][1]), "+v"(wl_[0][2]), "+v"(wl_[0][3]), "+v"(wl_[1][0]), "+v"(wl_[1][1]), "+v"(wl_[1][2]), "+v"(wl_[1][3]));
                }
#pragma unroll
                for (int tt = 0; tt < 4; ++tt) {
                    f32x4 acc[2]; acc[0] = acc[1] = (f32x4){0.f, 0.f, 0.f, 0.f};
#pragma unroll
                    for (int s4 = 0; s4 < 4; ++s4)
#pragma unroll
                        for (int c = 0; c < 2; ++c) {
                            acc[c] = __builtin_amdgcn_mfma_f32_16x16x32_bf16(fal[tt][s4], wh[c][s4], acc[c], 0, 0, 0);
                            acc[c] = __builtin_amdgcn_mfma_f32_16x16x32_bf16(fah[tt][s4], wl_[c][s4], acc[c], 0, 0, 0);
                            acc[c] = __builtin_amdgcn_mfma_f32_16x16x32_bf16(fah[tt][s4], wh[c][s4], acc[c], 0, 0, 0); }
#pragma unroll
                    for (int c = 0; c < 2; ++c)
#pragma unroll
                        for (int reg = 0; reg < 4; ++reg) part[(w * 64 + tt * 16 + 4 * kk + reg) * 64 + eh * 32 + 16 * c + i16] = acc[c][reg];
                }
            }
        }
        __syncthreads();
        const int tl = F.tid >> 3, g = F.tid & 7;
        int my_e; float my_w; int my_rank;
        {
            float ssq = 0.f;
#pragma unroll
            for (int q = 0; q < 8; ++q) ssq += ssqp[q * 64 + tl];
            const float rstd = rsqrtf(ssq * (1.f / DM) + EPS);
            if (g == 0) rsl[tl] = rstd;
            float s8[8], c8[8];
            {
                f32x4 lo4 = (f32x4){0.f, 0.f, 0.f, 0.f}, hi4 = lo4;
#pragma unroll
                for (int q = 0; q < 8; ++q) { const LAS f32x4* pp = (const LAS f32x4*)(part + (q * 64 + tl) * 64 + 8 * g); lo4 += pp[0]; hi4 += pp[1]; }
                const f32x4 cb0 = *(const f32x4*)(cb + b * 64 + 8 * g), cb1 = *(const f32x4*)(cb + b * 64 + 8 * g + 4), rb0 = *(const f32x4*)(rbias + 8 * g), rb1 = *(const f32x4*)(rbias + 8 * g + 4);
#pragma unroll
                for (int j = 0; j < 4; ++j) { s8[j] = sigmoidf_(lo4[j] * rstd + cb0[j]); s8[4 + j] = sigmoidf_(hi4[j] * rstd + cb1[j]); c8[j] = s8[j] + rb0[j]; c8[4 + j] = s8[4 + j] + rb1[j]; }
            }
            float m1 = -INFINITY, m2 = -INFINITY;
#pragma unroll
            for (int j = 0; j < 8; ++j) { const float v = c8[j]; if (v > m1) { m2 = m1; m1 = v; } else if (v > m2) m2 = v; }
            const float gs = m1 + m2;
            int rank = 0;
#pragma unroll
            for (int g2 = 0; g2 < 8; ++g2) { const float o = __shfl(gs, g2, 8); rank += (o > gs || (o == gs && g2 < g)) ? 1 : 0; }
            if (rank >= 4) {
#pragma unroll
                for (int j = 0; j < 8; ++j) c8[j] = -INFINITY;
            }
            int sel_e[8]; float sk[8]; float wsum = 0.f;
#pragma unroll
            for (int k = 0; k < 8; ++k) {
                float bv = -INFINITY, bs = 0.f; int be = 8 * g;
#pragma unroll
                for (int j = 0; j < 8; ++j) if (c8[j] > bv) { bv = c8[j]; be = 8 * g + j; bs = s8[j]; }
#pragma unroll
                for (int o = 1; o < 8; o <<= 1) { const float ov = __shfl_xor(bv, o, 8), os = __shfl_xor(bs, o, 8); const int oe = __shfl_xor(be, o, 8); if (ov > bv || (ov == bv && oe < be)) { bv = ov; be = oe; bs = os; } }
                sel_e[k] = be; sk[k] = bs; wsum += bs;
#pragma unroll
                for (int j = 0; j < 8; ++j) if (be == 8 * g + j) c8[j] = -INFINITY;
            }
            my_e = sel_e[0]; my_w = sk[0];
#pragma unroll
            for (int k = 1; k < 8; ++k) if (g == k) { my_e = sel_e[k]; my_w = sk[k]; }
            my_w *= 2.5f / wsum;
            my_rank = lds_add(&lcnt[my_e], 1);
        }
        __syncthreads();
        if (F.tid < 64) { const int n = lcnt[F.tid]; lbase[F.tid] = n > 0 ? (int)atomicAdd(&cur[F.tid], (unsigned)n) : 0; }
        __syncthreads();
        { const int tok = tokb + tl, pos = lbase[my_e] + my_rank; tokl[my_e * RT + pos] = tok * 8 + g; wl[my_e * RT + pos] = my_w; tpos[(tok - rr * RT) * 8 + g] = (my_e << 16) | pos; }
#pragma unroll 1
        for (int r0 = 0; r0 < 8; r0 += 4) {
            f32x4 xv[4][4]; u32x2 xq[4][4];
#pragma unroll
            for (int r = 0; r < 4; ++r) { const u32x2* xr = (const u32x2*)(x1 + (size_t)(tokb + w * 8 + r0 + r) * DM) + lane;
#pragma unroll
                for (int j = 0; j < 4; ++j) xq[r][j] = xr[64 * j]; }
            asm volatile("" : "+v"(xq[0][0]), "+v"(xq[0][1]), "+v"(xq[0][2]), "+v"(xq[0][3]), "+v"(xq[1][0]), "+v"(xq[1][1]), "+v"(xq[1][2]), "+v"(xq[1][3]),
                              "+v"(xq[2][0]), "+v"(xq[2][1]), "+v"(xq[2][2]), "+v"(xq[2][3]), "+v"(xq[3][0]), "+v"(xq[3][1]), "+v"(xq[3][2]), "+v"(xq[3][3]));
#pragma unroll
            for (int r = 0; r < 4; ++r)
#pragma unroll
                for (int j = 0; j < 4; ++j) { const u32x2 q = xq[r][j]; xv[r][j] = (f32x4){bflo(q.x), bfhi(q.x), bflo(q.y), bfhi(q.y)}; }
#pragma unroll
            for (int j = 0; j < 4; ++j) { const int col = 4 * lane + 256 * j; const f32x4 gq = *(const f32x4*)(gvec + b * DM + col), sh = *(const f32x4*)(mod + b * NMOD + 3 * DM + col);
#pragma unroll
                for (int r = 0; r < 4; ++r) { const int tl2 = w * 8 + r0 + r; const f32x4 hv = (xv[r][j] * rsl[tl2]) * gq + sh;
                    int o = 0; o = __builtin_amdgcn_cvt_pk_fp8_f32(f8c(hv.x * 16.f), f8c(hv.y * 16.f), o, false); o = __builtin_amdgcn_cvt_pk_fp8_f32(f8c(hv.z * 16.f), f8c(hv.w * 16.f), o, true);
                    ((unsigned*)(H2 + (size_t)(tokb - rr * RT + tl2) * DM) + lane)[64 * j] = (unsigned)o; } }
        }
        __syncthreads();
    }
}
constexpr int MO_TE = 4224;
struct MoeTabs { const LAS unsigned short* te; const LAS int* tb; const LAS int* cnt; int TR; };
__device__ __forceinline__ MoeTabs build_moe_tabs(Ctx& F, int rr) {
    LAS unsigned short* te = (LAS unsigned short*)(F.lds + MISC_OFF + MO_TE); LAS int* tb = (LAS int*)(F.lds + MISC_OFF + MO_TE + 1536); LAS int* cnt = tb + 72;
    const unsigned* cur = (const unsigned*)(F.ws + WS_CTL) + CW_MOECUR + rr * 64;
    __syncthreads();
    if (F.tid == 0) { int acc = 0; for (int e = 0; e < 64; ++e) { const int c = (int)cur[e]; cnt[e] = c; tb[e] = acc; acc += (c + 255) >> 8; } tb[64] = acc; tb[65] = acc + RT / 256; cnt[64] = RT; }
    __syncthreads();
    const int TR = tb[64];
    for (int e = F.tid >> 3; e < 65; e += 64) for (int t = tb[e] + (F.tid & 7); t < tb[e + 1]; t += 8) te[t] = (unsigned short)e;
    __syncthreads();
    MoeTabs T; T.te = te; T.tb = tb; T.cnt = cnt; T.TR = TR; return T;
}
struct Moe1Sched {
    const char* H2; const char* W1T; const int* tokl; MoeTabs T; int G, c, rr; int R[2], C[2];
    __device__ __forceinline__ bool next(int i, gm::UnitD& u) {
        const int uu = i * G + c; const int nt = T.TR + RT / 256;
        if (uu >= nt * 2) return false;
        const int tile = uu >> 1, pn = uu & 1, e = T.te[tile], rt = tile - T.tb[e], cnt = T.cnt[e];
        u.a = H2; u.b = W1T + (size_t)(e * 512 + pn * 256) * 1024;
#pragma unroll
        for (int h = 0; h < 2; ++h)
#pragma unroll
            for (int j = 0; j < 2; ++j) { const int idx = rt * 256 + h * 128 + R[j]; int trow;
                if (e < 64) { const int ent = tokl[e * RT + (idx < cnt ? idx : rt * 256)]; trow = (ent >> 3) - rr * RT; } else trow = idx;
                u.va[h][j] = (unsigned)(trow * 512 + C[j]) * 2u; }
        u.e0 = tile; u.e1 = pn; u.e2 = e; u.e3 = rt; return true;
    }
};
struct EpiMoe1 {
    bf16_t* act; const float* wl; const LAS int* cnt;
    __device__ __forceinline__ void operator()(const f32x4 (&acc)[2][2][4][2], const gm::UnitD& u, int wr, int wc, int fr, int fq) const {
        const int row0 = u.e0 * 256 + wr * 64 + fr, col0 = u.e1 * 128 + wc * 32 + 8 * fq, e = u.e2, n = cnt[e];
        float rw[2][4];
#pragma unroll
        for (int ai = 0; ai < 2; ++ai)
#pragma unroll
            for (int m = 0; m < 4; ++m) { const int idx = u.e3 * 256 + ai * 128 + wr * 64 + m * 16 + fr; rw[ai][m] = e < 64 ? (idx < n ? wl[e * RT + idx] : 0.f) : 1.f; }
#pragma unroll
        for (int ai = 0; ai < 2; ++ai)
#pragma unroll
            for (int m = 0; m < 4; ++m) { const float ww = rw[ai][m] * (32.f / 4096.f); const f32x4 g0 = acc[ai][0][m][0] * (1.f / 4096.f), g1 = acc[ai][0][m][1] * (1.f / 4096.f), u0 = acc[ai][1][m][0] * ww, u1 = acc[ai][1][m][1] * ww;
                int w0 = 0, w1 = 0;
                w0 = __builtin_amdgcn_cvt_pk_fp8_f32(f8c(siluf_(g0[0]) * u0[0]), f8c(siluf_(g0[1]) * u0[1]), w0, false); w0 = __builtin_amdgcn_cvt_pk_fp8_f32(f8c(siluf_(g0[2]) * u0[2]), f8c(siluf_(g0[3]) * u0[3]), w0, true);
                w1 = __builtin_amdgcn_cvt_pk_fp8_f32(f8c(siluf_(g1[0]) * u1[0]), f8c(siluf_(g1[1]) * u1[1]), w1, false); w1 = __builtin_amdgcn_cvt_pk_fp8_f32(f8c(siluf_(g1[2]) * u1[2]), f8c(siluf_(g1[3]) * u1[3]), w1, true);
                *(u32x2*)((unsigned char*)act + (size_t)(row0 + ai * 128 + m * 16) * 256 + col0) = (u32x2){(unsigned)w0, (unsigned)w1}; }
    }
};
__device__ __forceinline__ void phase_moe1(Ctx& F, int rr) {
    Moe1Sched S; S.T = build_moe_tabs(F, rr); S.H2 = (const char*)(F.ws + WS_H2) + (size_t)rr * RT * DM; S.W1T = (const char*)(F.ws + WS_W1T); S.tokl = (const int*)(F.ws + WS_TOKL) + (size_t)rr * 64 * RT; S.G = F.G; S.c = (F.G % 8 == 0) ? (F.bid % 8) * (F.G / 8) + F.bid / 8 : F.bid; S.rr = rr; gm::stage_geom(F.tid, S.R, S.C);
    EpiMoe1 E{(bf16_t*)(F.ws + WS_ACT), (const float*)(F.ws + WS_WL) + (size_t)rr * 64 * RT, S.T.cnt};
    gm::gemm_phase<true, false, true>(F.lds, 512, S, E);
}
struct Moe2Sched {
    const char* ACT; const char* W2T; MoeTabs T; int G, c; int R[2], C[2];
    __device__ __forceinline__ bool next(int i, gm::UnitD& u) {
        const int uu = i * G + c; const int nt = T.TR + RT / 256;
        if (uu >= nt * 4) return false;
        const int tile = uu >> 2, pn = uu & 3, e = T.te[tile], rt = tile - T.tb[e];
        u.a = ACT + (size_t)tile * 256 * 256; u.b = W2T + (size_t)(e * 1024 + pn * 256) * 256;
#pragma unroll
        for (int h = 0; h < 2; ++h)
#pragma unroll
            for (int j = 0; j < 2; ++j) u.va[h][j] = (unsigned)((h * 128 + R[j]) * 128 + C[j]) * 2u;
        u.e0 = pn; u.e1 = e; u.e2 = rt; u.e3 = tile; return true;
    }
};
struct EpiMoe2 {
    bf16_t* slots; bf16_t* shout; const LAS int* cnt;
    __device__ __forceinline__ void operator()(const f32x4 (&acc)[2][2][4][2], const gm::UnitD& u, int wr, int wc, int fr, int fq) const {
        const int pn = u.e0, e = u.e1, rt = u.e2, tile = u.e3;
        const int col0 = pn * 256 + wc * 32 + 8 * fq, n = cnt[e];
        if (e < 64) {
            unsigned char* base = (unsigned char*)slots + (size_t)(tile * 256 + wr * 64 + fr) * 1024 + col0;
#pragma unroll
            for (int ai = 0; ai < 2; ++ai)
#pragma unroll
                for (int m = 0; m < 4; ++m) {
                    if (rt * 256 + ai * 128 + wr * 64 + m * 16 + fr < n) {
#pragma unroll
                        for (int bj = 0; bj < 2; ++bj) { f32x4 v0 = acc[ai][bj][m][0] * (16.f / 4096.f), v1 = acc[ai][bj][m][1] * (16.f / 4096.f);
#pragma unroll
                            for (int j = 0; j < 4; ++j) { v0[j] = __builtin_amdgcn_fmed3f(v0[j], -440.f, 440.f); v1[j] = __builtin_amdgcn_fmed3f(v1[j], -440.f, 440.f); }
                            int w0 = 0, w1 = 0;
                            w0 = __builtin_amdgcn_cvt_pk_fp8_f32(v0[0], v0[1], w0, false); w0 = __builtin_amdgcn_cvt_pk_fp8_f32(v0[2], v0[3], w0, true);
                            w1 = __builtin_amdgcn_cvt_pk_fp8_f32(v1[0], v1[1], w1, false); w1 = __builtin_amdgcn_cvt_pk_fp8_f32(v1[2], v1[3], w1, true);
                            *(u32x2*)(base + (size_t)(ai * 128 + m * 16) * 1024 + bj * 128) = (u32x2){(unsigned)w0, (unsigned)w1}; } } }
        } else {
            bf16_t* base = shout + (size_t)(rt * 256 + wr * 64 + fr) * 1024 + col0;
#pragma unroll
            for (int ai = 0; ai < 2; ++ai)
#pragma unroll
                for (int m = 0; m < 4; ++m)
#pragma unroll
                    for (int bj = 0; bj < 2; ++bj) { const f32x4 v0 = acc[ai][bj][m][0] * (1.f / 4096.f), v1 = acc[ai][bj][m][1] * (1.f / 4096.f);
                        u32x4 o; o.x = cvtpk(v0[0], v0[1]); o.y = cvtpk(v0[2], v0[3]); o.z = cvtpk(v1[0], v1[1]); o.w = cvtpk(v1[2], v1[3]); *(u32x4*)(base + (size_t)(ai * 128 + m * 16) * 1024 + bj * 128) = o; }
        }
    }
};
__device__ __forceinline__ void phase_moe2(Ctx& F, int rr) {
    Moe2Sched S; S.T = build_moe_tabs(F, rr); S.ACT = (const char*)(F.ws + WS_ACT); S.W2T = (const char*)(F.ws + WS_W2T); S.G = F.G; S.c = (F.G % 8 == 0) ? (F.bid % 8) * (F.G / 8) + F.bid / 8 : F.bid; gm::stage_geom(F.tid, S.R, S.C);
    EpiMoe2 E{(bf16_t*)(F.ws + WS_SLOTS), (bf16_t*)(F.ws + WS_SHOUT), S.T.cnt};
    gm::gemm_phase<true, false, true>(F.lds, 128, S, E);
}
__device__ __forceinline__ void phase_final(Ctx& F, int rr) {
    const MoeTabs T = build_moe_tabs(F, rr);
    const float* mod = (const float*)(F.ws + WS_SMALL + SM_MOD); const float* fg = inp(F, I_FG);
    const unsigned char* slots = (const unsigned char*)(F.ws + WS_SLOTS); const int* tpos = (const int*)(F.ws + WS_TPOS) + (size_t)rr * RT * 8;
    const int gw = F.bid * 8 + F.wave, NGW = F.G * 8, c0 = F.lane * 8;
    struct Tok { u32x2 sv[8][2]; u32x4 sh[2]; u32x4 xq[2]; f32x4 g2[2][2]; };
#define FIN_TPOS(TT, TPV) do { TPV = tpos[(size_t)(TT) * 8 + (F.lane & 7)]; } while (0)
#define FIN_ISSUE(TT, X, TPV) do { \
        _Pragma("unroll") for (int k = 0; k < 8; ++k) { const int v_ = __builtin_amdgcn_readlane(TPV, k); const unsigned char* rp_ = slots + (size_t)(T.tb[v_ >> 16] * 256 + (v_ & 0xffff)) * 1024 + c0; \
            X.sv[k][0] = *(const u32x2*)(rp_); X.sv[k][1] = *(const u32x2*)(rp_ + 512); } \
        { const bf16_t* sp_ = (const bf16_t*)(F.ws + WS_SHOUT) + (size_t)(TT) * 1024 + c0; X.sh[0] = *(const u32x4*)sp_; X.sh[1] = *(const u32x4*)(sp_ + 512); } \
        { const bf16_t* xp_ = (const bf16_t*)(F.ws + WS_X1B) + (size_t)(rr * RT + (TT)) * DM + c0; X.xq[0] = *(const u32x4*)xp_; X.xq[1] = *(const u32x4*)(xp_ + 512); } \
        { const float* g2_ = mod + ((rr * RT + (TT)) / SEQ) * NMOD + 5 * DM + c0; _Pragma("unroll") for (int h = 0; h < 2; ++h) { X.g2[h][0] = *(const f32x4*)(g2_ + h * 512); X.g2[h][1] = *(const f32x4*)(g2_ + h * 512 + 4); } } } while (0)
#define FIN_DONE(TT, X) do { const int tok_ = rr * RT + (TT); float* orow_ = F.out + (size_t)tok_ * DM + c0; \
          \
        asm volatile("" : "+v"(X.sv[0][0]), "+v"(X.sv[0][1]), "+v"(X.sv[1][0]), "+v"(X.sv[1][1]), "+v"(X.sv[2][0]), "+v"(X.sv[2][1]), "+v"(X.sv[3][0]), "+v"(X.sv[3][1]), \
                          "+v"(X.sv[4][0]), "+v"(X.sv[4][1]), "+v"(X.sv[5][0]), "+v"(X.sv[5][1]), "+v"(X.sv[6][0]), "+v"(X.sv[6][1]), "+v"(X.sv[7][0]), "+v"(X.sv[7][1])); \
        asm volatile("" : "+v"(X.sh[0]), "+v"(X.sh[1]), "+v"(X.xq[0]), "+v"(X.xq[1]), "+v"(X.g2[0][0]), "+v"(X.g2[0][1]), "+v"(X.g2[1][0]), "+v"(X.g2[1][1])); \
        float s_ = 0.f; f32x4 v_[2][2]; \
        _Pragma("unroll") for (int h = 0; h < 2; ++h) { \
            f32x4 a0 = (f32x4){0.f, 0.f, 0.f, 0.f}, a1 = a0; \
            _Pragma("unroll") for (int k = 0; k < 8; ++k) { const u32x2 w = X.sv[k][h]; \
                const f32x2 p0 = __builtin_amdgcn_cvt_pk_f32_fp8((int)w.x, false), p1 = __builtin_amdgcn_cvt_pk_f32_fp8((int)w.x, true), p2 = __builtin_amdgcn_cvt_pk_f32_fp8((int)w.y, false), p3 = __builtin_amdgcn_cvt_pk_f32_fp8((int)w.y, true); \
                a0 += (f32x4){p0.x, p0.y, p1.x, p1.y}; a1 += (f32x4){p2.x, p2.y, p3.x, p3.y}; } \
            { const u32x4 w = X.sh[h]; a0 = a0 * 0.0625f + (f32x4){bflo(w.x), bfhi(w.x), bflo(w.y), bfhi(w.y)}; a1 = a1 * 0.0625f + (f32x4){bflo(w.z), bfhi(w.z), bflo(w.w), bfhi(w.w)}; } \
            const u32x4 q = X.xq[h]; \
            v_[h][0] = (f32x4){bflo(q.x), bfhi(q.x), bflo(q.y), bfhi(q.y)} + X.g2[h][0] * a0; v_[h][1] = (f32x4){bflo(q.z), bfhi(q.z), bflo(q.w), bfhi(q.w)} + X.g2[h][1] * a1; \
            _Pragma("unroll") for (int q2 = 0; q2 < 2; ++q2) s_ += (v_[h][q2].x * v_[h][q2].x + v_[h][q2].y * v_[h][q2].y) + (v_[h][q2].z * v_[h][q2].z + v_[h][q2].w * v_[h][q2].w); } \
        const float rstd_ = rsqrtf(wave_sum(s_) * (1.f / DM) + EPS); \
        _Pragma("unroll") for (int h = 0; h < 2; ++h) _Pragma("unroll") for (int q2 = 0; q2 < 2; ++q2) *(f32x4*)(orow_ + h * 512 + 4 * q2) = (v_[h][q2] * rstd_) * fgv[h][q2]; } while (0)
    f32x4 fgv[2][2];
#pragma unroll
    for (int h = 0; h < 2; ++h)
#pragma unroll
        for (int q2 = 0; q2 < 2; ++q2) fgv[h][q2] = *(const f32x4*)(fg + c0 + h * 512 + 4 * q2);
    Tok A, B; int tpA = 0, tpB = 0;
    if (gw < RT) { FIN_TPOS(gw, tpA); if (gw + NGW < RT) FIN_TPOS(gw + NGW, tpB); FIN_ISSUE(gw, A, tpA); }
    int t = gw;
#pragma unroll 1
    for (; t + 3 * NGW < RT; t += 2 * NGW) {
        const int t1 = t + NGW, t2 = t + 2 * NGW, t3 = t + 3 * NGW;
        FIN_TPOS(t2, tpA); FIN_ISSUE(t1, B, tpB); __builtin_amdgcn_sched_barrier(0);
        FIN_DONE(t, A); __builtin_amdgcn_sched_barrier(0);
        FIN_TPOS(t3, tpB); FIN_ISSUE(t2, A, tpA); __builtin_amdgcn_sched_barrier(0);
        FIN_DONE(t1, B); __builtin_amdgcn_sched_barrier(0);
    }
#pragma unroll 1
    for (; t < RT; t += 2 * NGW) {
        const int t1 = t + NGW, t2 = t + 2 * NGW, t3 = t + 3 * NGW;
        if (t1 < RT) { if (t2 < RT) FIN_TPOS(t2, tpA); FIN_ISSUE(t1, B, tpB); }
        FIN_DONE(t, A);
        if (t2 < RT) { if (t3 < RT) FIN_TPOS(t3, tpB); FIN_ISSUE(t2, A, tpA); }
        if (t1 < RT) FIN_DONE(t1, B);
    }
#undef FIN_TPOS
#undef FIN_ISSUE
#undef FIN_DONE
}

constexpr int N_PHASES = 10;
__global__ void __launch_bounds__(512, 2) mega_fwd(Args args) {
    extern __shared__ __attribute__((aligned(16))) unsigned char lds_raw[];
    Ctx F; F.lds = (LAS unsigned char*)lds_raw; F.ws = args.ws; F.out = args.out;
    {
        typedef __attribute__((address_space(4))) const unsigned long long* karg_t;
        const karg_t ka = (karg_t)__builtin_amdgcn_kernarg_segment_ptr();
        LAS unsigned long long* tab = (LAS unsigned long long*)(lds_raw + MISC_OFF + 14336);
        if (threadIdx.x < 20) tab[threadIdx.x] = ka[threadIdx.x];
        F.intab = tab;
    }
    F.tid = threadIdx.x; F.lane = F.tid & 63; F.wave = __builtin_amdgcn_readfirstlane(F.tid >> 6); F.G = gridDim.x; F.bid = blockIdx.x;
    volatile LAS unsigned* st = (volatile LAS unsigned*)(F.lds + MISC_OFF + MO_ST);
    if (F.tid < 4) st[F.tid] = 0u;
    __syncthreads();
    XcdBarrier bar = xcd_barrier_post((unsigned*)(F.ws + WS_CTL) + CW_BAR, st);
    if (threadIdx.x == 0) { unsigned nloc, nx; xcd_barrier_complete(bar.bar, bar.x, nloc, nx); st[0] = nloc; st[1] = nx; }
    int lo = args.ph_lo, hi = args.ph_hi;
    { int a = lo, b = hi; asm volatile("" : "+v"(a), "+v"(b)); lo = __builtin_amdgcn_readfirstlane(a); hi = __builtin_amdgcn_readfirstlane(b); }
    launder(F);
#ifndef PH_MASK
#define PH_MASK 0x1ffff
#endif
#define PH_ON(k) ((PH_MASK >> (k)) & 1)
#define IN(k) (lo <= (k) && (k) < hi)
#define SEAM(k) do { if (IN(k) && IN((k) + 1)) { bar.bar = launder_ptr(bar.bar); xcd_barrier(bar); } } while (0)
#define RUN(k, call) do { if (PH_ON(k) && IN(k)) { launder(F); call; } } while (0)
    RUN(0, phase0(F)); SEAM(0);
    RUN(1, phase1(F)); SEAM(1);
    RUN(2, phase2(F)); SEAM(2);
    RUN(4, (phase4(F), sb_units(F))); SEAM(4);
    RUN(5, phase5(F)); SEAM(5);
    RUN(6, phase6(F)); SEAM(6);
    RUN(7, phase7(F)); SEAM(7);
    RUN(8, phase8(F)); SEAM(8);
    if (PH_ON(9) && IN(9)) {
        const int par = (F.bid >> 3) & 1;
#pragma unroll 1
        for (int i = 0; i < 8; ++i) {
            launder(F);
            int op, rr; bool bar_after = true;
            switch (i) {
                case 0: op = 0; rr = 0; break;
                case 1: op = 1; rr = 0; break;
                case 2: op = par ? 0 : 2; rr = par ? 1 : 0; bar_after = false; break;
                case 3: op = par ? 2 : 0; rr = par ? 0 : 1; break;
                case 4: op = par ? 1 : 3; rr = par ? 1 : 0; bar_after = false; break;
                case 5: op = par ? 3 : 1; rr = par ? 0 : 1; break;
                case 6: op = 2; rr = 1; break;
                default: op = 3; rr = 1; bar_after = false; break;
            }
            switch (op) {
                case 0: launder(F); phase_n2r(F, rr); break;
                case 1: launder(F); phase_moe1(F, rr); break;
                case 2: launder(F); phase_moe2(F, rr); break;
                default: launder(F); phase_final(F, rr); break;
            }
            if (bar_after) { bar.bar = launder_ptr(bar.bar); xcd_barrier(bar); } else __syncthreads();
        }
    }
#undef IN
#undef SEAM
#undef RUN
}

#ifndef MK_SPLIT
#define MK_SPLIT 0
#endif
extern "C" void kernel_launch(void* const* d_in, const int* in_sizes, int n_in, void* d_out, int out_size, void* d_ws, size_t ws_size, hipStream_t stream) {
    static int grid = 0;
    if (grid == 0) {
        if (n_in != 20 || in_sizes[0] != MT * DM || out_size != MT * DM || ws_size < WS_END) { fprintf(stderr, "kernel_launch: unexpected shapes (n_in %d, in0 %d, out %d, ws %zu)\n", n_in, n_in > 0 ? in_sizes[0] : -1, out_size, ws_size); grid = -1; return; }
        int dev = 0, cus = 0;
        if (hipGetDevice(&dev) != hipSuccess || hipDeviceGetAttribute(&cus, hipDeviceAttributeMultiprocessorCount, dev) != hipSuccess) { grid = -1; return; }
        if (hipFuncSetAttribute((const void*)mega_fwd, hipFuncAttributeMaxDynamicSharedMemorySize, LDS_BYTES) != hipSuccess) { fprintf(stderr, "kernel_launch: hipFuncSetAttribute failed\n"); grid = -1; return; }
        int per_cu = 0;
        if (hipOccupancyMaxActiveBlocksPerMultiprocessor(&per_cu, (const void*)mega_fwd, 512, LDS_BYTES) != hipSuccess || per_cu < 1) fprintf(stderr, "kernel_launch: occupancy query reports %d\n", per_cu);
        (void)hipGetLastError();
        grid = cus;
    }
    if (grid < 0) return;
    (void)hipMemsetAsync((char*)d_ws + WS_CTL, 0, CTL_BYTES, stream);
    Args a{};
    for (int i = 0; i < 20; ++i) a.in[i] = (const float*)d_in[i];
    a.out = (float*)d_out; a.ws = (unsigned char*)d_ws;
#if MK_SPLIT
    for (int p = 0; p < N_PHASES; ++p) { a.ph_lo = p; a.ph_hi = p + 1; hipLaunchKernelGGL(mega_fwd, dim3(grid), dim3(512), LDS_BYTES, stream, a); }
#else
    a.ph_lo = 0; a.ph_hi = N_PHASES;
    hipLaunchKernelGGL(mega_fwd, dim3(grid), dim3(512), LDS_BYTES, stream, a);
#endif
}
```

```cpp
#include <hip/hip_runtime.h>
#include <cstdio>
#include <cstdint>

#define LAS __attribute__((address_space(3)))
#define GAS __attribute__((address_space(1)))
typedef unsigned short bf16_t;
typedef short bf16x8 __attribute__((ext_vector_type(8)));
typedef short s16x4 __attribute__((ext_vector_type(4)));
typedef float f32x4 __attribute__((ext_vector_type(4)));
typedef float f32x16 __attribute__((ext_vector_type(16)));
typedef float f32x2 __attribute__((ext_vector_type(2)));
typedef unsigned u32x4 __attribute__((ext_vector_type(4)));
typedef unsigned u32x2 __attribute__((ext_vector_type(2)));
typedef __bf16 bf16x2_t __attribute__((ext_vector_type(2)));

__device__ __forceinline__ unsigned cvtpk(float lo, float hi) { f32x2 v = {lo, hi}; bf16x2_t b = __builtin_convertvector(v, bf16x2_t); return __builtin_bit_cast(unsigned, b); }
__device__ __forceinline__ float bf2f(unsigned short u) { return __uint_as_float(((unsigned)u) << 16); }
__device__ __forceinline__ float bflo(unsigned u) { return __uint_as_float(u << 16); }
__device__ __forceinline__ float bfhi(unsigned u) { return __uint_as_float(u & 0xffff0000u); }

constexpr int NB = 4, SEQ = 8192, DM = 1024, MT = NB * SEQ;
constexpr int NHEAD = 8, HD = 64, QW = 1536;
constexpr int NE = 64, EFF = 256, NMOD = 6 * DM;
constexpr int RT = MT / 2;
constexpr float EPS = 1e-6f;
constexpr float LOG2E = 1.4426950408889634f;

constexpr size_t MiB = 1u << 20;
constexpr size_t WS_CTL = 0, CTL_BYTES = 1 * MiB;
constexpr size_t WS_SMALL = 1 * MiB;
constexpr size_t SM_MOD = 0, SM_GVEC = 98304, SM_CB = 114688, SM_KBAR = 131072, SM_WRH = 393216, SM_WRL = 524288;
constexpr size_t WS_W2T = 2 * MiB;
constexpr size_t WS_W1T = 35 * MiB;
constexpr size_t WS_WIN8 = 19 * MiB;
constexpr size_t WS_H8 = 68 * MiB;
constexpr size_t WS_WINT = 100 * MiB;
constexpr size_t WS_WBRT = 110 * MiB;
constexpr size_t WS_WOUTT = 112 * MiB;
constexpr size_t WS_H = 114 * MiB;
constexpr size_t WS_OB = 114 * MiB;
constexpr size_t WS_QSB = 178 * MiB;
constexpr size_t WS_PO = 178 * MiB;
constexpr size_t WS_QMB = 274 * MiB;
constexpr size_t WS_MERGED = 274 * MiB;
constexpr size_t WS_G = 370 * MiB;
constexpr size_t WS_LMB = 498 * MiB;
constexpr size_t WS_PLSE = 506 * MiB;
constexpr size_t WS_H2 = 100 * MiB;
constexpr size_t WS_TOKL = 164 * MiB;
constexpr size_t WS_WL = 172 * MiB;
constexpr size_t WS_TPOS = 180 * MiB;
constexpr size_t WS_ACT = 184 * MiB;
constexpr size_t WS_SLOTS = 264 * MiB;
constexpr size_t WS_SHOUT = 408 * MiB;
constexpr size_t WS_X1B = 440 * MiB;
constexpr size_t WS_END = 509 * MiB;
constexpr int CW_MBCUR = 0;
constexpr int CW_MOECUR = 1024;
constexpr int CW_BAR = 4096;
constexpr size_t CTL_KBS = 512 * 1024;

constexpr int RING_BYTES = 131072;
constexpr int MISC_OFF = RING_BYTES;
constexpr int LDS_BYTES = 163840;
constexpr int MO_STG = 16384;

#define XB_TMO      128
#define XB_XCNT(j)  (256  + 64 * (j))
#define XB_XSUB(j)  (1280 + 64 * (j))
#define XB_XGEN(j)  (2304 + 64 * (j))
#define XB_TOP      3328
#define XB_TOPGEN   3392
#define XCD_BAR_WORDS 3456
#define XB_SPIN_CAP (1u << 18)
__device__ __forceinline__ unsigned xb_ld(unsigned* p)              { return __hip_atomic_load(p, __ATOMIC_RELAXED, __HIP_MEMORY_SCOPE_AGENT); }
__device__ __forceinline__ unsigned xb_add(unsigned* p, unsigned v) { return __hip_atomic_fetch_add(p, v, __ATOMIC_RELAXED, __HIP_MEMORY_SCOPE_AGENT); }
__device__ __forceinline__ unsigned xb_xcc_id() { return (unsigned)__builtin_amdgcn_s_getreg((3 << 11) | 20) & 0xFu; }
#define XB_SPIN(cond, bar) do { unsigned _sp = 0; while (cond) { __builtin_amdgcn_s_sleep(1); \
    if ((++_sp & 255u) == 0u) { if (xb_ld(&(bar)[XB_TMO])) break; if (_sp > XB_SPIN_CAP) { atomicAdd(&(bar)[XB_TMO], 1u); break; } } } } while (0)
struct XcdBarrier { unsigned* bar; unsigned x; volatile LAS unsigned* st; };
__device__ __forceinline__ XcdBarrier xcd_barrier_post(unsigned* bar, volatile LAS unsigned* st) {
    XcdBarrier b; b.bar = bar; b.x = xb_xcc_id(); b.st = st;
    if (threadIdx.x == 0) (void)xb_add(&bar[XB_XCNT(b.x)], 1u);
    return b;
}
__device__ __forceinline__ void xcd_barrier_complete(unsigned* bar, unsigned x, unsigned& nloc, unsigned& nx) {
    const unsigned G = gridDim.x * gridDim.y * gridDim.z;
    unsigned sum, cnt, mine, sp = 0u;
    for (;;) {
        sum = 0u; cnt = 0u; mine = 0u;
#pragma unroll
        for (unsigned j = 0; j < 16; ++j) { const unsigned c = xb_ld(&bar[XB_XCNT(j)]); sum += c; cnt += (c > 0u) ? 1u : 0u; mine = (j == x) ? c : mine; }
        if (sum == G) break;
        __builtin_amdgcn_s_sleep(1);
        if ((++sp & 255u) == 0u) { if (xb_ld(&bar[XB_TMO])) break; if (sp > XB_SPIN_CAP) { atomicAdd(&bar[XB_TMO], 1u); break; } }
    }
    nloc = mine > 0u ? mine : 1u; nx = cnt > 0u ? cnt : 1u;
}
__device__ __forceinline__ void xcd_barrier(const XcdBarrier& b) {
    asm volatile("s_waitcnt vmcnt(0)" ::: "memory");
    __syncthreads();
    if (threadIdx.x == 0) {
        unsigned* bar = b.bar;
        __builtin_amdgcn_s_waitcnt(0);
        unsigned nloc = b.st[0], nx = b.st[1];
        const unsigned old = xb_add(&bar[XB_XSUB(b.x)], 1u);
        const unsigned gen = old / nloc;
        if (old + 1u == (gen + 1u) * nloc) {
            __builtin_amdgcn_fence(__ATOMIC_RELEASE, "agent");
            asm volatile("s_waitcnt vmcnt(0)" ::: "memory");
            const unsigned og = xb_add(&bar[XB_TOP], 1u);
            const unsigned tg = og / nx;
            if (og + 1u == (tg + 1u) * nx) xb_add(&bar[XB_TOPGEN], 1u);
            else XB_SPIN(xb_ld(&bar[XB_TOPGEN]) == tg, bar);
            __builtin_amdgcn_fence(__ATOMIC_ACQUIRE, "agent");
            xb_add(&bar[XB_XGEN(b.x)], 1u);
            asm volatile("s_waitcnt vmcnt(0)" ::: "memory");
        } else {
            XB_SPIN(xb_ld(&bar[XB_XGEN(b.x)]) == gen, bar);
            __builtin_amdgcn_fence(__ATOMIC_ACQUIRE, "agent");
            asm volatile("s_waitcnt vmcnt(0)" ::: "memory");
        }
    }
    __syncthreads();
}

namespace gm {
constexpr int BM = 256, BK = 64, HALF = 128, HTB = HALF * BK * 2, STAGE_BYTES = 8 * HTB, NXCD = 8, WGM = 8;
__host__ __device__ __forceinline__ int lds_byte(int r, int c) { const int st = (r >> 4) * 2 + (c >> 5), rr = r & 15, cc = c & 31, ob = rr * 64 + cc * 2; return st * 1024 + (ob ^ (((ob >> 9) & 1) << 5)); }
__host__ __device__ __forceinline__ void stage_rc(int b, int& R, int& C) { const int st = b / 1024, sb = b % 1024, swz = sb ^ (((sb >> 9) & 1) << 5); R = (st >> 1) * 16 + swz / 64; C = (st & 1) * 32 + (swz % 64) / 2; }
__host__ __device__ __forceinline__ int pgrp(int q) { return ((q & 1) << 1) | (q >> 1); }
__host__ __device__ __forceinline__ int perm32(int rho) { const int n = rho >> 4, i = rho & 15; return 8 * pgrp(i >> 2) + 4 * n + (i & 3); }
__device__ __forceinline__ void pl32swap(unsigned& a, unsigned& b) { const auto r = __builtin_amdgcn_permlane32_swap(a, b, false, false); a = r[0]; b = r[1]; }

struct UnitD { const char* a; const char* b; unsigned va[2][2]; int e0, e1, e2, e3; };

__device__ __forceinline__ bool static_tile(int M, int N, int G, int c, int i, int& pm, int& pn) {
    const int nM = M / BM, nN = N / BM, nwg = nM * nN;
    const long L = (long)i * G + c; if (L >= nwg) return false;
    int wgid = (int)L; { const int q = nwg / NXCD, r = nwg % NXCD, xcd = wgid % NXCD, off = wgid / NXCD; wgid = (xcd < r ? xcd * (q + 1) : r * (q + 1) + (xcd - r) * q) + off; }
    const int nig = WGM * nN, gid = wgid / nig, fm = gid * WGM, gsz = (nM - fm) < WGM ? (nM - fm) : WGM;
    pm = fm + ((wgid % nig) % gsz); pn = (wgid % nig) / gsz; return true;
}

template <bool PERM, bool HOOK = false, bool FP8 = false, class Epi, class Sched>
__device__ __forceinline__ void gemm_phase(LAS unsigned char* lds, const int K, Sched& S, const Epi& E) {
    int tid_ = threadIdx.x; asm volatile("" : "+v"(tid_));
    const int tid = tid_, wid = __builtin_amdgcn_readfirstlane(tid >> 6), lane = tid & 63, wr = wid >> 2, wc = wid & 3, fr = lane & 15, fq = lane >> 4;
    const int fqc = PERM ? pgrp(fq) : fq;
    const int nt = K / BK;
    unsigned voffB[2];
#pragma unroll
    for (int i = 0; i < 2; ++i) { int R, C; stage_rc(tid * 16 + i * 8192, R, C); const int Rb = PERM ? ((R & ~31) + perm32(R & 31)) : R; voffB[i] = (unsigned)(Rb * K + C) * 2u; }
    const size_t kstep = (size_t)(BK * 2);
    const size_t hstep = (size_t)HALF * K * 2;
    const unsigned ldsw = (unsigned)wid * 1024u;
    const int aoff = lds_byte(wr * 64 + fr, fq * 8), boff = lds_byte(wc * 32 + fr, fq * 8);
#define GM_SA(b, h) (((b) * 2 + (h)) * HTB)
#define GM_SB(b, h) ((4 + (b) * 2 + (h)) * HTB)
#define GM_STAGE_A(bufoff, U, h, kb) do { _Pragma("unroll") for (int _i = 0; _i < 2; ++_i) \
        __builtin_amdgcn_global_load_lds((const unsigned*)((U).a + (kb) + (U).va[h][_i]), (LAS unsigned*)(lds + (bufoff) + ldsw + _i * 8192), 16, 0, 0); } while (0)
#define GM_STAGE_B(bufoff, U, h, kb) do { _Pragma("unroll") for (int _i = 0; _i < 2; ++_i) \
        __builtin_amdgcn_global_load_lds((const unsigned*)((U).b + (kb) + (size_t)(h) * hstep + voffB[_i]), (LAS unsigned*)(lds + (bufoff) + ldsw + _i * 8192), 16, 0, 0); } while (0)
#define GM_LDA(dst, b, h) do { _Pragma("unroll") for (int m = 0; m < 4; ++m) _Pragma("unroll") for (int k = 0; k < 2; ++k) { \
        if constexpr (FP8) { const i32x4_ t_ = *(const LAS i32x4_*)(lds + GM_SA(b, h) + aoff + m * 2048 + k * 1024); dst##8[m][4 * k] = t_[0]; dst##8[m][4 * k + 1] = t_[1]; dst##8[m][4 * k + 2] = t_[2]; dst##8[m][4 * k + 3] = t_[3]; } \
        else dst[m][k] = *(const LAS bf16x8*)(lds + GM_SA(b, h) + aoff + m * 2048 + k * 1024); } } while (0)
#define GM_LDB(dst, b, h) do { _Pragma("unroll") for (int n = 0; n < 2; ++n) _Pragma("unroll") for (int k = 0; k < 2; ++k) { \
        if constexpr (FP8) { const i32x4_ t_ = *(const LAS i32x4_*)(lds + GM_SB(b, h) + boff + n * 2048 + k * 1024); dst##8[n][4 * k] = t_[0]; dst##8[n][4 * k + 1] = t_[1]; dst##8[n][4 * k + 2] = t_[2]; dst##8[n][4 * k + 3] = t_[3]; } \
        else dst[n][k] = *(const LAS bf16x8*)(lds + GM_SB(b, h) + boff + n * 2048 + k * 1024); } } while (0)
#define GM_MMA(ai, bj, At, Bt) do { __builtin_amdgcn_s_setprio(1); \
        if constexpr (FP8) { _Pragma("unroll") for (int m = 0; m < 4; ++m) _Pragma("unroll") for (int n = 0; n < 2; ++n) \
            asm volatile("v_mfma_scale_f32_16x16x128_f8f6f4 %0, %1, %2, %0, %3, %3 op_sel_hi:[0,0,0]" : "+v"(acc[ai][bj][m][n]) : "v"(Bt##8[n]), "v"(At##8[m]), "v"(scl1)); } \
        else { _Pragma("unroll") for (int m = 0; m < 4; ++m) _Pragma("unroll") for (int n = 0; n < 2; ++n) _Pragma("unroll") for (int k = 0; k < 2; ++k) \
            acc[ai][bj][m][n] = __builtin_amdgcn_mfma_f32_16x16x32_bf16(Bt[n][k], At[m][k], acc[ai][bj][m][n], 0, 0, 0); } \
        __builtin_amdgcn_s_setprio(0); } while (0)
#define GM_WAIT_V(n) asm volatile("s_waitcnt vmcnt(" #n ")" ::: "memory")
#define GM_WAIT_L(n) asm volatile("s_waitcnt lgkmcnt(" #n ")" ::: "memory")
#define GM_BAR __builtin_amdgcn_s_barrier()
#define GM_SCHED __builtin_amdgcn_sched_barrier(0)
    UnitD cur, nxt; int ui = 0;
    if (!S.next(0, cur)) return;
    f32x4 acc[2][2][4][2];
#pragma unroll
    for (int a = 0; a < 2; ++a)
#pragma unroll
        for (int b = 0; b < 2; ++b)
#pragma unroll
            for (int m = 0; m < 4; ++m)
#pragma unroll
                for (int n = 0; n < 2; ++n) acc[a][b][m][n] = (f32x4){0.f, 0.f, 0.f, 0.f};
    typedef int i32x8_ __attribute__((ext_vector_type(8))); typedef int i32x4_ __attribute__((ext_vector_type(4)));
    bf16x8 At[4][2], B0[2][2], B1[2][2]; i32x8_ At8[4], B08[2], B18[2];
    int scl1 = 0x7f7f7f7f; asm volatile("" : "+v"(scl1));
    GM_STAGE_B(GM_SB(0, 0), cur, 0, 0); GM_STAGE_B(GM_SB(0, 1), cur, 1, 0); GM_STAGE_A(GM_SA(0, 0), cur, 0, 0); GM_STAGE_A(GM_SA(0, 1), cur, 1, 0);
    if (wr == 1) GM_BAR;
    GM_WAIT_V(2); GM_BAR;
    GM_STAGE_B(GM_SB(1, 0), cur, 0, kstep); GM_STAGE_A(GM_SA(1, 0), cur, 0, kstep); GM_STAGE_B(GM_SB(1, 1), cur, 1, kstep);
    GM_WAIT_V(6); GM_BAR;
    for (;;) {
        const bool has_next = S.next(ui + 1, nxt);
        if (!has_next) nxt = cur;
#pragma unroll 1
        for (int t = 0; t < nt; t += 2) {
            const bool last = (t == nt - 2);
            if constexpr (HOOK) { if (t == nt / 2) E.mid(acc, cur, wr, wc, fr, fqc); }
            const size_t k1 = (size_t)(t + 1) * kstep;
            UnitD U2 = cur; size_t k2 = (size_t)(t + 2) * kstep;
            if (last) { U2 = nxt; k2 = 0; }
            const size_t k3 = k2 + kstep;
            GM_LDB(B0, 0, 0); GM_LDB(B1, 0, 1); GM_SCHED; GM_LDA(At, 0, 0); GM_STAGE_A(GM_SA(1, 1), cur, 1, k1);
            GM_WAIT_V(8); GM_WAIT_L(0); GM_BAR; GM_MMA(0, 0, At, B0); GM_MMA(0, 1, At, B1); GM_BAR; GM_SCHED;
            GM_LDA(At, 0, 1); GM_STAGE_B(GM_SB(0, 0), U2, 0, k2); GM_STAGE_B(GM_SB(0, 1), U2, 1, k2); GM_STAGE_A(GM_SA(0, 0), U2, 0, k2);
            GM_WAIT_V(8); GM_WAIT_L(0); GM_BAR; GM_MMA(1, 0, At, B0); GM_MMA(1, 1, At, B1); GM_BAR; GM_SCHED;
            GM_LDB(B0, 1, 0); GM_LDB(B1, 1, 1); GM_SCHED; GM_LDA(At, 1, 0); GM_STAGE_A(GM_SA(0, 1), U2, 1, k2);
            GM_WAIT_V(8); GM_WAIT_L(0); GM_BAR; GM_MMA(0, 0, At, B0); GM_MMA(0, 1, At, B1); GM_BAR; GM_SCHED;
            GM_LDA(At, 1, 1); GM_STAGE_B(GM_SB(1, 0), U2, 0, k3); GM_STAGE_B(GM_SB(1, 1), U2, 1, k3); GM_STAGE_A(GM_SA(1, 0), U2, 0, k3);
            GM_WAIT_V(8); GM_WAIT_L(0); GM_BAR; GM_MMA(1, 0, At, B0); GM_MMA(1, 1, At, B1); GM_BAR; GM_SCHED;
        }
        if constexpr (FP8) asm volatile("s_nop 15\n\ts_nop 15" ::: "memory");
        if (wr == 0) GM_BAR;
        E(acc, cur, wr, wc, fr, fqc);
        if (!has_next) break;
#pragma unroll
        for (int a = 0; a < 2; ++a)
#pragma unroll
            for (int b = 0; b < 2; ++b)
#pragma unroll
                for (int m = 0; m < 4; ++m)
#pragma unroll
                    for (int n = 0; n < 2; ++n) acc[a][b][m][n] = (f32x4){0.f, 0.f, 0.f, 0.f};
        cur = nxt; ++ui;
        if (wr == 1) GM_BAR;
    }
    GM_WAIT_V(0);
    GM_BAR;
#undef GM_SA
#undef GM_SB
#undef GM_STAGE_A
#undef GM_STAGE_B
#undef GM_LDA
#undef GM_LDB
#undef GM_MMA
#undef GM_WAIT_V
#undef GM_WAIT_L
#undef GM_BAR
#undef GM_SCHED
}
__device__ __forceinline__ void stage_geom(int tid, int (&R)[2], int (&C)[2]) {
#pragma unroll
    for (int i = 0; i < 2; ++i) stage_rc(tid * 16 + i * 8192, R[i], C[i]);
}
}

struct Args { const float* in[20]; float* out; unsigned char* ws; int ph_lo, ph_hi; };
struct Ctx {
    LAS unsigned char* lds;
    unsigned char* ws;
    const LAS unsigned long long* intab;
    float* out;
    int tid, lane, wave, G, bid;
};
#define LDS_WAIT() asm volatile("s_waitcnt lgkmcnt(0)" ::: "memory")
__device__ __forceinline__ const float* inp(const Ctx& F, int i) {
    const unsigned long long v = F.intab[i];
    const unsigned lo = __builtin_amdgcn_readfirstlane((unsigned)v), hi = __builtin_amdgcn_readfirstlane((unsigned)(v >> 32));
    return (const float*)(GAS const float*)(((unsigned long long)hi << 32) | lo);
}
template <class P> __device__ __forceinline__ P launder_ptr(P p) {
    unsigned long long v = (unsigned long long)p; unsigned lo = (unsigned)v, hi = (unsigned)(v >> 32);
    asm volatile("" : "+v"(lo), "+v"(hi));
    lo = __builtin_amdgcn_readfirstlane(lo); hi = __builtin_amdgcn_readfirstlane(hi);
    return (P)(GAS unsigned char*)(((unsigned long long)hi << 32) | lo);
}
__device__ __forceinline__ void launder(Ctx& F) {
    int t = F.tid, g = F.G, bid = F.bid;
    asm volatile("" : "+v"(t), "+v"(g), "+v"(bid));
    F.tid = t; F.G = __builtin_amdgcn_readfirstlane(g); F.bid = __builtin_amdgcn_readfirstlane(bid); F.lane = t & 63; F.wave = __builtin_amdgcn_readfirstlane(t >> 6);
    F.ws = launder_ptr(F.ws); F.out = launder_ptr(F.out);
}
__device__ __forceinline__ float xhalf(float x, int hi) {
    const unsigned u = __builtin_bit_cast(unsigned, x);
    const auto r = __builtin_amdgcn_permlane32_swap(u, u, false, false);
    return __builtin_bit_cast(float, hi ? r[0] : r[1]);
}
__device__ __forceinline__ float wave_sum(float v) {
#pragma unroll
    for (int o = 1; o < 64; o <<= 1) v += __shfl_xor(v, o);
    return v;
}
__device__ __forceinline__ int lds_add(LAS int* p, int v) { return __hip_atomic_fetch_add(p, v, __ATOMIC_RELAXED, __HIP_MEMORY_SCOPE_WORKGROUP); }
__device__ __forceinline__ float f8c(float x) { return __builtin_amdgcn_fmed3f(x, -440.f, 440.f); }
__device__ __forceinline__ float sigmoidf_(float x) { return 1.f / (1.f + __expf(-x)); }
__device__ __forceinline__ float siluf_(float x) { return x / (1.f + __expf(-x)); }

enum { I_X = 0, I_C, I_N1G, I_N2G, I_WADA, I_BADA, I_WIN, I_WBSB, I_WBMB, I_WOUT, I_WR, I_RB, I_WGE, I_WUE, I_WDE, I_WGS, I_WUS, I_WDS, I_RELB, I_FG };

__device__ __forceinline__ void transpose_item(const float* W, int ldn, int k0, int n0, bf16_t* WT, int Kdst, int drow0, LAS float* scr, int lane) {
    const float* wp = W + (size_t)(k0 + (lane >> 3)) * ldn + n0 + 4 * (lane & 7);
    f32x4 v[8];
#pragma unroll
    for (int i = 0; i < 8; ++i) v[i] = *(const f32x4*)(wp + (size_t)(8 * i) * ldn);
#pragma unroll
    for (int i = 0; i < 8; ++i) { LAS float* d = scr + (8 * i + (lane >> 3)) * 33 + 4 * (lane & 7); d[0] = v[i].x; d[1] = v[i].y; d[2] = v[i].z; d[3] = v[i].w; }
    LDS_WAIT(); asm volatile("" ::: "memory");
    const int c = lane & 7;
#pragma unroll
    for (int j = 0; j < 4; ++j) { const int n = (lane >> 3) + 8 * j; const LAS float* s = scr + (8 * c) * 33 + n;
        u32x4 o; o.x = cvtpk(s[0 * 33], s[1 * 33]); o.y = cvtpk(s[2 * 33], s[3 * 33]); o.z = cvtpk(s[4 * 33], s[5 * 33]); o.w = cvtpk(s[6 * 33], s[7 * 33]);
        *(u32x4*)(WT + (size_t)(drow0 + n) * Kdst + k0 + 8 * c) = o; }
    LDS_WAIT(); asm volatile("" ::: "memory");
}
__device__ __forceinline__ void phase0(Ctx& F) {
    LAS float* silc = (LAS float*)(F.lds + MISC_OFF + MO_STG);
    float* mod = (float*)(F.ws + WS_SMALL + SM_MOD);
    const bool split = (F.G == 256);
    if (!split || F.bid >= 128) {
        for (int i = F.tid; i < 4 * DM; i += 512) silc[i] = siluf_(inp(F, I_C)[i]);
        __syncthreads();
        const int c = F.lane & 15, kp = F.lane >> 4;
        const float* wada = inp(F, I_WADA);
        const int first = split ? (F.wave < 3 ? (F.bid - 128) * 3 + F.wave : NMOD) : F.wave * F.G + F.bid, step = split ? NMOD : 8 * F.G;
        for (int item = first; item < NMOD / 16; item += step) {
            const int col = item * 16 + c;
            float a0 = 0.f, a1 = 0.f, a2 = 0.f, a3 = 0.f;
#pragma unroll 32
            for (int k = kp; k < DM; k += 4) { const float w = __builtin_nontemporal_load(wada + (size_t)k * NMOD + col); a0 += silc[k] * w; a1 += silc[DM + k] * w; a2 += silc[2 * DM + k] * w; a3 += silc[3 * DM + k] * w; }
            a0 += __shfl_xor(a0, 16); a0 += __shfl_xor(a0, 32); a1 += __shfl_xor(a1, 16); a1 += __shfl_xor(a1, 32);
            a2 += __shfl_xor(a2, 16); a2 += __shfl_xor(a2, 32); a3 += __shfl_xor(a3, 16); a3 += __shfl_xor(a3, 32);
            if (kp == 0) { const float bb = inp(F, I_BADA)[col]; mod[col] = a0 + bb; mod[NMOD + col] = a1 + bb; mod[2 * NMOD + col] = a2 + bb; mod[3 * NMOD + col] = a3 + bb; }
        }
    }
    {
        LAS float* scr = (LAS float*)(F.lds + F.wave * 16384);
        const int gw = F.bid * 8 + F.wave, NGW = F.G * 8, lane = F.lane;
        constexpr int I_IN = 16 * 160, I_BR = 8 * 32, I_OUT = 16 * 32, I_EXP = 384, NIT = I_IN + 2 * I_BR + I_OUT + 65 * I_EXP;
        const float* p_win = inp(F, I_WIN); const float* p_bsb = inp(F, I_WBSB); const float* p_bmb = inp(F, I_WBMB); const float* p_out = inp(F, I_WOUT);
        const float* p_ge = inp(F, I_WGE); const float* p_ue = inp(F, I_WUE); const float* p_de = inp(F, I_WDE); const float* p_gs = inp(F, I_WGS); const float* p_us = inp(F, I_WUS); const float* p_ds = inp(F, I_WDS);
#define TD_GET(IT, SRC, LDN, DST, KD, F8) do { int r = (IT); F8 = 0; \
            if (r < I_IN) { const int kb = r / 160, nb = r % 160; SRC = p_win + (size_t)(kb * 64) * 5120 + nb * 32; LDN = 5120; \
                if (nb < 32) { DST = (bf16_t*)(F.ws + WS_WINT) + (size_t)(nb * 32) * 1024 + kb * 64; KD = 1024; } \
                else { DST = (bf16_t*)((unsigned char*)(F.ws + WS_WIN8) + (size_t)(nb * 32 - 1024) * 1024 + kb * 64); KD = 1024; F8 = 256; } } \
            else if ((r -= I_IN) < I_BR) { const int kb = r / 32, nb = r % 32; SRC = p_bsb + (size_t)(kb * 64) * 1024 + nb * 32; LDN = 1024; DST = (bf16_t*)(F.ws + WS_WBRT) + (size_t)(nb * 32) * 1024 + kb * 64; KD = 1024; } \
            else if ((r -= I_BR) < I_BR) { const int kb = r / 32, nb = r % 32; SRC = p_bmb + (size_t)(kb * 64) * 1024 + nb * 32; LDN = 1024; DST = (bf16_t*)(F.ws + WS_WBRT) + (size_t)(nb * 32) * 1024 + 512 + kb * 64; KD = 1024; } \
            else if ((r -= I_BR) < I_OUT) { const int kb = r / 32, nb = r % 32; SRC = p_out + (size_t)(kb * 64) * 1024 + nb * 32; LDN = 1024; DST = (bf16_t*)(F.ws + WS_WOUTT) + (size_t)(nb * 32) * 1024 + kb * 64; KD = 1024; } \
            else { r -= I_OUT; const int e = r / I_EXP; r -= e * I_EXP; \
                if (r < 128) { const int kb = r / 8, n0 = (r % 8) * 32; SRC = (e < NE ? p_ge + (size_t)e * DM * EFF : p_gs) + (size_t)(kb * 64) * EFF + n0; LDN = EFF; \
                    DST = (bf16_t*)((unsigned char*)(F.ws + WS_W1T) + ((size_t)e * 512 + (n0 >> 7) * 256 + (n0 & 127)) * 1024 + kb * 64); KD = 1024; F8 = 256; } \
                else if (r < 256) { r -= 128; const int kb = r / 8, n0 = (r % 8) * 32; SRC = (e < NE ? p_ue + (size_t)e * DM * EFF : p_us) + (size_t)(kb * 64) * EFF + n0; LDN = EFF; \
                    DST = (bf16_t*)((unsigned char*)(F.ws + WS_W1T) + ((size_t)e * 512 + (n0 >> 7) * 256 + 128 + (n0 & 127)) * 1024 + kb * 64); KD = 1024; F8 = 256; } \
                else { r -= 256; const int kb = r / 32, nb = r % 32; SRC = (e < NE ? p_de + (size_t)e * EFF * DM : p_ds) + (size_t)(kb * 64) * DM + nb * 32; LDN = DM; \
                    DST = (bf16_t*)((unsigned char*)(F.ws + WS_W2T) + ((size_t)e * 1024 + nb * 32) * 256 + kb * 64); KD = 256; F8 = 128; } } } while (0)
#define TD_LOAD(V, SRC, LDN) do { const float* wp_ = (SRC) + (size_t)(lane >> 3) * (LDN) + 4 * (lane & 7); _Pragma("unroll") for (int i = 0; i < 8; ++i) V[i] = __builtin_nontemporal_load((const f32x4*)(wp_ + (size_t)(8 * i) * (LDN))); } while (0)
#define TD_PROC(V, DST, KD, F8) do { \
            _Pragma("unroll") for (int i = 0; i < 8; ++i) { LAS float* d = scr + (8 * i + (lane >> 3)) * 33 + 4 * (lane & 7); d[0] = V[i].x; d[1] = V[i].y; d[2] = V[i].z; d[3] = V[i].w; } \
            LDS_WAIT(); asm volatile("" ::: "memory"); \
            if (F8) { _Pragma("unroll") for (int j = 0; j < 4; ++j) { const int n = (lane >> 3) + 8 * j; const LAS float* sp = scr + (8 * (lane & 7)) * 33 + n; \
                int w0 = 0, w1 = 0; \
                const float fs_ = (float)(F8); w0 = __builtin_amdgcn_cvt_pk_fp8_f32(f8c(sp[0 * 33] * fs_), f8c(sp[1 * 33] * fs_), w0, false); w0 = __builtin_amdgcn_cvt_pk_fp8_f32(f8c(sp[2 * 33] * fs_), f8c(sp[3 * 33] * fs_), w0, true); \
                w1 = __builtin_amdgcn_cvt_pk_fp8_f32(f8c(sp[4 * 33] * fs_), f8c(sp[5 * 33] * fs_), w1, false); w1 = __builtin_amdgcn_cvt_pk_fp8_f32(f8c(sp[6 * 33] * fs_), f8c(sp[7 * 33] * fs_), w1, true); \
                *(u32x2*)((unsigned char*)(DST) + (size_t)n * (KD) + 8 * (lane & 7)) = (u32x2){(unsigned)w0, (unsigned)w1}; } } \
            else { _Pragma("unroll") for (int j = 0; j < 4; ++j) { const int n = (lane >> 3) + 8 * j; const LAS float* sp = scr + (8 * (lane & 7)) * 33 + n; \
                u32x4 o; o.x = cvtpk(sp[0 * 33], sp[1 * 33]); o.y = cvtpk(sp[2 * 33], sp[3 * 33]); o.z = cvtpk(sp[4 * 33], sp[5 * 33]); o.w = cvtpk(sp[6 * 33], sp[7 * 33]); \
                *(u32x4*)((DST) + (size_t)n * (KD) + 8 * (lane & 7)) = o; } } \
            LDS_WAIT(); asm volatile("" ::: "memory"); } while (0)
        for (int it = 4 * gw; it < NIT; it += 4 * NGW) {
            const float* src[4]; bf16_t* dst[4]; int ld[4], kd[4], f8[4];
            f32x4 v0[8], v1[8], v2[8], v3[8];
            TD_GET(it, src[0], ld[0], dst[0], kd[0], f8[0]); TD_GET(it + 1, src[1], ld[1], dst[1], kd[1], f8[1]); TD_GET(it + 2, src[2], ld[2], dst[2], kd[2], f8[2]); TD_GET(it + 3, src[3], ld[3], dst[3], kd[3], f8[3]);
            TD_LOAD(v0, src[0], ld[0]); TD_LOAD(v1, src[1], ld[1]); TD_LOAD(v2, src[2], ld[2]); TD_LOAD(v3, src[3], ld[3]);
            TD_PROC(v0, dst[0], kd[0], f8[0]); TD_PROC(v1, dst[1], kd[1], f8[1]); TD_PROC(v2, dst[2], kd[2], f8[2]); TD_PROC(v3, dst[3], kd[3], f8[3]);
        }
#undef TD_PROC
#undef TD_GET
#undef TD_LOAD
    }
    {
        bf16_t* wrh = (bf16_t*)(F.ws + WS_SMALL + SM_WRH); bf16_t* wrl = (bf16_t*)(F.ws + WS_SMALL + SM_WRL);
        const float* wr = inp(F, I_WR);
        for (int i = F.bid * 512 + F.tid; i < NE * DM; i += F.G * 512) { const int e = i >> 10, k = i & 1023; const float v = wr[k * NE + e];
            const unsigned h = cvtpk(v, 0.f) & 0xffffu; wrh[i] = (bf16_t)h; wrl[i] = (bf16_t)(cvtpk(v - bflo(h), 0.f) & 0xffffu); }
    }
}

__device__ __forceinline__ void phase1(Ctx& F) {
    const float* mod = (const float*)(F.ws + WS_SMALL + SM_MOD);
    const float* x = inp(F, I_X); const float* g1 = inp(F, I_N1G);
    bf16_t* H = (bf16_t*)(F.ws + WS_H); unsigned char* H8 = (unsigned char*)(F.ws + WS_H8);
    const int gw = F.bid * 8 + F.wave, NGW = F.G * 8;
    if (gw < 256) {
        const int b = gw >> 6, e = gw & 63; const float* wr = inp(F, I_WR); float a = 0.f;
#pragma unroll 4
        for (int k = F.lane; k < DM; k += 64) a += mod[b * NMOD + 3 * DM + k] * wr[k * NE + e];
        a = wave_sum(a);
        if (F.lane == 0) ((float*)(F.ws + WS_SMALL + SM_CB))[gw] = a;
    }
    if (F.bid == 32) {
        float* gvec = (float*)(F.ws + WS_SMALL + SM_GVEC); const float* g2 = inp(F, I_N2G);
        for (int i = F.tid; i < 4 * DM; i += 512) { const int b = i >> 10, k = i & 1023; gvec[i] = g2[k] * (1.f + mod[b * NMOD + 4 * DM + k]); }
    }
    f32x4 Ag[4], Sh[4]; int cur_b = -1;
#define P1_LOAD(X0, X1, M) do { const int q0_ = (M) < MT ? (M) : gw, q1_ = (M) + NGW < MT ? (M) + NGW : q0_;     \
        const f32x4* a_ = (const f32x4*)(x + (size_t)q0_ * DM) + F.lane; const f32x4* b_ = (const f32x4*)(x + (size_t)q1_ * DM) + F.lane; \
        _Pragma("unroll") for (int j = 0; j < 4; ++j) { X0[j] = __builtin_nontemporal_load(a_ + 64 * j); X1[j] = __builtin_nontemporal_load(b_ + 64 * j); } } while (0)
#define P1_ROW(X, R, AA, SS, M) do { u32x2* o_ = (u32x2*)(H + (size_t)(M) * DM) + F.lane; unsigned* o8_ = (unsigned*)(H8 + (size_t)(M) * DM) + F.lane; \
        _Pragma("unroll") for (int j = 0; j < 4; ++j) { const f32x4 h = (X[j] * R) * AA[j] + SS[j]; \
            u32x2 w; w.x = cvtpk(h.x, h.y); w.y = cvtpk(h.z, h.w); o_[64 * j] = w; \
            int q8 = 0; q8 = __builtin_amdgcn_cvt_pk_fp8_f32(f8c(h.x * 16.f), f8c(h.y * 16.f), q8, false); q8 = __builtin_amdgcn_cvt_pk_fp8_f32(f8c(h.z * 16.f), f8c(h.w * 16.f), q8, true); \
            o8_[64 * j] = (unsigned)q8; } } while (0)
#define P1_CONST(B, AA, SS) do { _Pragma("unroll") for (int j = 0; j < 4; ++j) { const int col = 4 * F.lane + 256 * j; AA[j] = *(const f32x4*)(g1 + col) * (*(const f32x4*)(mod + (B) * NMOD + DM + col) + 1.0f); SS[j] = *(const f32x4*)(mod + (B) * NMOD + col); } } while (0)
#define P1_DONE(X0, X1, M, GUARD) do { if (!(GUARD) || (M) < MT) { const int m1_ = (M) + NGW; const bool two_ = !(GUARD) || m1_ < MT; const int b0_ = (M) / SEQ, b1_ = (two_ ? m1_ : (M)) / SEQ; \
        asm volatile("" : "+v"(X0[0]), "+v"(X0[1]), "+v"(X0[2]), "+v"(X0[3]), "+v"(X1[0]), "+v"(X1[1]), "+v"(X1[2]), "+v"(X1[3]));     \
        if (b0_ != cur_b) { cur_b = b0_; P1_CONST(b0_, Ag, Sh); asm volatile("" : "+v"(Ag[0]), "+v"(Ag[1]), "+v"(Ag[2]), "+v"(Ag[3]), "+v"(Sh[0]), "+v"(Sh[1]), "+v"(Sh[2]), "+v"(Sh[3])); } \
        float s0 = 0.f, s1 = 0.f; \
        _Pragma("unroll") for (int j = 0; j < 4; ++j) { s0 += (X0[j].x * X0[j].x + X0[j].y * X0[j].y) + (X0[j].z * X0[j].z + X0[j].w * X0[j].w); s1 += (X1[j].x * X1[j].x + X1[j].y * X1[j].y) + (X1[j].z * X1[j].z + X1[j].w * X1[j].w); } \
        const float r0 = rsqrtf(wave_sum(s0) * (1.f / DM) + EPS), r1 = rsqrtf(wave_sum(s1) * (1.f / DM) + EPS); \
        P1_ROW(X0, r0, Ag, Sh, (M)); \
        if (two_) { if (b1_ == b0_) P1_ROW(X1, r1, Ag, Sh, m1_); else { f32x4 A1[4], S1[4]; P1_CONST(b1_, A1, S1); P1_ROW(X1, r1, A1, S1, m1_); } } } } while (0)
    f32x4 a0[4], a1[4], c0[4], c1[4];
    P1_LOAD(a0, a1, gw); P1_LOAD(c0, c1, gw + 2 * NGW);
    int m = gw;
#pragma unroll 1
    for (; m + 3 * NGW < MT; m += 4 * NGW) {
        P1_DONE(a0, a1, m, false); __builtin_amdgcn_sched_barrier(0);
        P1_LOAD(a0, a1, m + 4 * NGW); __builtin_amdgcn_sched_barrier(0);
        P1_DONE(c0, c1, m + 2 * NGW, false); __builtin_amdgcn_sched_barrier(0);
        P1_LOAD(c0, c1, m + 6 * NGW); __builtin_amdgcn_sched_barrier(0);
    }
#pragma unroll 1
    for (; m < MT; m += 4 * NGW) {
        P1_DONE(a0, a1, m, true);
        P1_LOAD(a0, a1, m + 4 * NGW);
        P1_DONE(c0, c1, m + 2 * NGW, true);
        P1_LOAD(c0, c1, m + 6 * NGW);
    }
#undef P1_LOAD
#undef P1_ROW
#undef P1_CONST
#undef P1_DONE
}

struct ProjSched {
    const char* A; const char* Bt; int G, c, pn0, npn, f8; int R[2], C[2];
    __device__ __forceinline__ bool next(int i, gm::UnitD& u) {
        int pm, pn; if (!gm::static_tile(MT, npn * 256, G, c, i, pm, pn)) return false;
        const int kp = f8 ? 512 : 1024;
        u.a = A; u.b = Bt + (size_t)pn * 256 * kp * 2;
#pragma unroll
        for (int h = 0; h < 2; ++h)
#pragma unroll
            for (int j = 0; j < 2; ++j) u.va[h][j] = (unsigned)((pm * 256 + h * 128 + R[j]) * kp + C[j]) * 2u;
        u.e0 = pm; u.e1 = pn0 + pn; u.e2 = f8; u.e3 = 0; return true;
    }
};
struct EpiProj {
    bf16_t* qsb; bf16_t* qmb; bf16_t* g; float* kbs;
    __device__ __forceinline__ void operator()(const f32x4 (&acc)[2][2][4][2], const gm::UnitD& u, int wr, int wc, int fr, int fq) const {
        const int pm = u.e0, pn = u.e1;
        bf16_t* base; int ldc, colt; float sc = 1.f;
        if (pn < 6) { base = qsb; ldc = QW; colt = pn * 256; if (pn < 2) sc = 0.125f * LOG2E; }
        else if (pn < 12) { base = qmb; ldc = QW; colt = (pn - 6) * 256; if (pn < 8) sc = 0.125f; }
        else { base = g; ldc = 2048; colt = (pn - 12) * 256; }
        if (u.e2) sc *= (1.f / 4096.f);
        const int row0 = pm * 256 + wr * 64 + fr, col0 = colt + wc * 32 + 8 * fq;
        if (pn == 8 || pn == 9) {
#pragma unroll
            for (int bj = 0; bj < 2; ++bj)
#pragma unroll
                for (int n = 0; n < 2; ++n) { f32x4 cs = (f32x4){0.f, 0.f, 0.f, 0.f};
#pragma unroll
                    for (int ai = 0; ai < 2; ++ai)
#pragma unroll
                        for (int m = 0; m < 4; ++m) cs += acc[ai][bj][m][n];
#pragma unroll
                    for (int o = 1; o < 16; o <<= 1) { cs[0] += __shfl_xor(cs[0], o); cs[1] += __shfl_xor(cs[1], o); cs[2] += __shfl_xor(cs[2], o); cs[3] += __shfl_xor(cs[3], o); }
                    if (fr == 0) { float* kd = kbs + (size_t)pm * 512 + (pn - 8) * 256 + bj * 128 + wc * 32 + 8 * fq + 4 * n;
#pragma unroll
                        for (int j = 0; j < 4; ++j) atomicAdd(kd + j, cs[j]); } }
        }
#pragma unroll
        for (int ai = 0; ai < 2; ++ai)
#pragma unroll
            for (int m = 0; m < 4; ++m) { bf16_t* rowp = base + (size_t)(row0 + ai * 128 + m * 16) * ldc + col0;
#pragma unroll
                for (int bj = 0; bj < 2; ++bj) { const f32x4 v0 = acc[ai][bj][m][0] * sc, v1 = acc[ai][bj][m][1] * sc;
                    u32x4 w; w.x = cvtpk(v0[0], v0[1]); w.y = cvtpk(v0[2], v0[3]); w.z = cvtpk(v1[0], v1[1]); w.w = cvtpk(v1[2], v1[3]);
                    __builtin_nontemporal_store(w, (u32x4*)(rowp + bj * 128)); } }
    }
};
__device__ __forceinline__ void phase2(Ctx& F) {
    EpiProj E{(bf16_t*)(F.ws + WS_QSB), (bf16_t*)(F.ws + WS_QMB), (bf16_t*)(F.ws + WS_G), (float*)(F.ws + WS_CTL + CTL_KBS)};
    {
        ProjSched S; S.A = (const char*)(F.ws + WS_H); S.Bt = (const char*)(F.ws + WS_WINT); S.G = F.G; S.c = F.bid; S.pn0 = 0; S.npn = 4; S.f8 = 0; gm::stage_geom(F.tid, S.R, S.C);
        gm::gemm_phase<true>(F.lds, 1024, S, E);
    }
    {
        ProjSched S; S.A = (const char*)(F.ws + WS_H8); S.Bt = (const char*)(F.ws + WS_WIN8); S.G = F.G; S.c = F.bid; S.pn0 = 4; S.npn = 16; S.f8 = 1; gm::stage_geom(F.tid, S.R, S.C);
        gm::gemm_phase<true, false, true>(F.lds, 512, S, E);
    }
}

__device__ __forceinline__ int crow(int r, int hi) { return (r & 3) + 8 * (r >> 2) + 4 * hi; }
typedef short v4i16_t __attribute__((ext_vector_type(4)));
__device__ __forceinline__ s16x4 vtr(const LAS unsigned char* p) { return __builtin_bit_cast(s16x4, __builtin_amdgcn_ds_read_tr16_b64_v4i16((LAS v4i16_t*)p)); }
#define PV_TR(dst, off) asm volatile("ds_read_b64_tr_b16 %0, %1 offset:%2" : "=v"(dst) : "v"(vb), "n"(off) : "memory")
__device__ __forceinline__ void pv64(f32x16 (&o)[2], const LAS unsigned char* vt, int lane, const u32x4 (&pw)[4]) {
    const int hi = lane >> 5;
    const LAS unsigned char* vb = vt + ((lane >> 4) & 1) * 32 + (lane & 3) * 8 + (4 * hi + ((lane & 15) >> 2)) * 64;
    s16x4 lo[2][4], hh[2][4];
#pragma unroll
    for (int ks = 0; ks < 4; ++ks) { PV_TR(lo[0][ks], ks * 1024); PV_TR(hh[0][ks], ks * 1024 + 512); }
#pragma unroll
    for (int ks = 0; ks < 4; ++ks) { PV_TR(lo[1][ks], 4096 + ks * 1024); PV_TR(hh[1][ks], 4096 + ks * 1024 + 512); }
    asm volatile("s_waitcnt lgkmcnt(8)" : "+v"(lo[0][0]), "+v"(lo[0][1]), "+v"(lo[0][2]), "+v"(lo[0][3]), "+v"(hh[0][0]), "+v"(hh[0][1]), "+v"(hh[0][2]), "+v"(hh[0][3]) :: "memory");
#pragma unroll
    for (int ks = 0; ks < 4; ++ks) {
        const bf16x8 bv = (bf16x8){lo[0][ks][0], lo[0][ks][1], lo[0][ks][2], lo[0][ks][3], hh[0][ks][0], hh[0][ks][1], hh[0][ks][2], hh[0][ks][3]};
        o[0] = __builtin_amdgcn_mfma_f32_32x32x16_bf16(__builtin_bit_cast(bf16x8, pw[ks]), bv, o[0], 0, 0, 0);
    }
    asm volatile("s_waitcnt lgkmcnt(0)" : "+v"(lo[1][0]), "+v"(lo[1][1]), "+v"(lo[1][2]), "+v"(lo[1][3]), "+v"(hh[1][0]), "+v"(hh[1][1]), "+v"(hh[1][2]), "+v"(hh[1][3]) :: "memory");
#pragma unroll
    for (int ks = 0; ks < 4; ++ks) {
        const bf16x8 bv = (bf16x8){lo[1][ks][0], lo[1][ks][1], lo[1][ks][2], lo[1][ks][3], hh[1][ks][0], hh[1][ks][1], hh[1][ks][2], hh[1][ks][3]};
        o[1] = __builtin_amdgcn_mfma_f32_32x32x16_bf16(__builtin_bit_cast(bf16x8, pw[ks]), bv, o[1], 0, 0, 0);
    }
}
__device__ __forceinline__ void store_o_tile(const f32x16 (&o)[2], LAS unsigned char* stgb, int lane, bf16_t* dst0, size_t row_pitch) {
    const int r32 = lane & 31, hi = lane >> 5;
    LAS bf16_t* stg = (LAS bf16_t*)stgb;
#pragma unroll
    for (int r = 0; r < 16; ++r) { const int orow = crow(r, hi);
#pragma unroll
        for (int d0 = 0; d0 < 2; ++d0) stg[orow * 64 + d0 * 32 + r32] = (bf16_t)(cvtpk(o[d0][r], 0.f) & 0xffffu); }
    LDS_WAIT();
#pragma unroll
    for (int i = 0; i < 4; ++i) { const int row = i * 8 + (lane >> 3), ch = lane & 7; const u32x4 v = *(const LAS u32x4*)(stg + row * 64 + ch * 8); *(u32x4*)(dst0 + (size_t)row * row_pitch + ch * 8) = v; }
    LDS_WAIT();
}

template <bool MASKED>
__device__ __forceinline__ void sb_tile(const f32x16 (&z)[2], float& P, u32x4 (&pw)[4], int k0, int qpos, int hi) {
    f32x16 be[2], nb[2];
#pragma unroll
    for (int p = 0; p < 2; ++p)
#pragma unroll
        for (int r = 0; r < 16; ++r) {
            const float zz = __builtin_amdgcn_fmed3f(z[p][r], -126.f, 126.f);
            const float t = __builtin_amdgcn_exp2f(-zz), b_ = __builtin_amdgcn_rcpf(1.f + t);
            float n_ = t * b_, bb = b_;
            if (MASKED) { const bool valid = (k0 + 32 * p + crow(r, hi)) < qpos; n_ = valid ? n_ : 1.f; bb = valid ? bb : 0.f; }
            be[p][r] = bb; nb[p][r] = n_;
        }
    float Gp[8], PG[8], off[8];
#pragma unroll
    for (int idx = 0; idx < 8; ++idx) { const int p = idx >> 2, g4 = (idx & 3) * 4; Gp[idx] = (nb[p][g4] * nb[p][g4 + 1]) * (nb[p][g4 + 2] * nb[p][g4 + 3]); }
#pragma unroll
    for (int idx = 0; idx < 8; ++idx) PG[idx] = xhalf(Gp[idx], hi);
    float run = P;
#pragma unroll
    for (int idx = 7; idx >= 0; --idx) { off[idx] = hi ? run : run * PG[idx]; run *= (Gp[idx] * PG[idx]); }
    P = run;
#pragma unroll
    for (int idx = 0; idx < 8; ++idx) { const int p = idx >> 2, g4 = (idx & 3) * 4; float c = off[idx]; float a[4];
#pragma unroll
        for (int j = 3; j >= 0; --j) { a[j] = be[p][g4 + j] * c; c *= nb[p][g4 + j]; }
        pw[idx >> 1][(idx & 1) * 2] = cvtpk(a[0], a[1]); pw[idx >> 1][(idx & 1) * 2 + 1] = cvtpk(a[2], a[3]); }
}
__device__ __forceinline__ void sb_unit(Ctx& F, int bh, int qt, LAS unsigned char* vl) {
    const int lane = F.lane, r32 = lane & 31, hi = lane >> 5;
    const int b = bh >> 3, h = bh & 7, q0 = qt * 32, qpos = q0 + r32;
    const bf16_t* base = (const bf16_t*)(F.ws + WS_QSB) + (size_t)b * SEQ * QW + h * 64;
    const bf16_t* Kb = base + 512 + (size_t)r32 * QW + hi * 8; const bf16_t* Vb = base + 1024 + (size_t)(lane >> 2) * QW + (lane & 3) * 8;
    bf16x8 qr[4];
#pragma unroll
    for (int d0 = 0; d0 < 4; ++d0) qr[d0] = *(const bf16x8*)(base + (size_t)qpos * QW + d0 * 16 + hi * 8);
    float P = 1.f; f32x16 o[2]; o[0] = f32x16{}; o[1] = f32x16{};
    bf16x8 kfn[8];
    const int kt0 = q0 >> 6; int kt = kt0, cur = 0;
#define SB_PREFETCH(KT, BUF) do { const size_t ko_ = (size_t)(KT) * 64 * QW; \
        _Pragma("unroll") for (int d0 = 0; d0 < 4; ++d0) _Pragma("unroll") for (int hf = 0; hf < 2; ++hf) kfn[2 * d0 + hf] = *(const bf16x8*)(Kb + ko_ + (size_t)(32 * hf) * QW + d0 * 16); \
        _Pragma("unroll") for (int p = 0; p < 8; ++p) __builtin_amdgcn_global_load_lds((const unsigned*)(Vb + ko_ + (size_t)(16 * (p & 3)) * QW + (p >> 2) * 32), (LAS unsigned*)(vl + (BUF) * 8192 + p * 1024), 16, 0, 0); } while (0)
    SB_PREFETCH(kt, 0);
#pragma unroll 1
    for (; kt >= 0; --kt) {
        if (__all(P == 0.f)) break;
        f32x16 z[2]; z[0] = f32x16{}; z[1] = f32x16{};
#pragma unroll
        for (int d0 = 0; d0 < 4; ++d0) { z[0] = __builtin_amdgcn_mfma_f32_32x32x16_bf16(kfn[2 * d0], qr[d0], z[0], 0, 0, 0); z[1] = __builtin_amdgcn_mfma_f32_32x32x16_bf16(kfn[2 * d0 + 1], qr[d0], z[1], 0, 0, 0); }
        asm volatile("" : "+v"(z[0]), "+v"(z[1]));
        { const int ktn = kt > 0 ? kt - 1 : 0; SB_PREFETCH(ktn, cur ^ 1); }
        u32x4 pw[4];
        if (kt == kt0) sb_tile<true>(z, P, pw, kt * 64, qpos, hi); else sb_tile<false>(z, P, pw, kt * 64, qpos, hi);
        asm volatile("s_waitcnt vmcnt(16)" ::: "memory");
        pv64(o, vl + cur * 8192, lane, pw);
        cur ^= 1;
    }
#undef SB_PREFETCH
    asm volatile("s_waitcnt vmcnt(0)" ::: "memory");
    bf16_t* dst = (bf16_t*)(F.ws + WS_OB) + (size_t)(b * SEQ + q0) * 1024 + h * 64;
    store_o_tile(o, vl, lane, dst, 1024);
}
__device__ __forceinline__ void sb_units(Ctx& F) {
    const int vb = (F.G % 8 == 0) ? (F.bid & 7) * (F.G >> 3) + (F.bid >> 3) : F.bid;
    const int gw = vb * 8 + F.wave, NGW = F.G * 8;
    LAS unsigned char* vl = F.lds + F.wave * 16384;
    for (int u = gw; u < 32 * 256; u += NGW) sb_unit(F, u >> 8, u & 255, vl);
}

constexpr int MO_LUT = 0, MO_PRE = 4224, MO_WSF = 8320, MO_ENT = 12416, MO_UT = 13440, MO_ST = 16368;
__device__ __forceinline__ int mb_list_off(int j) { return 256 * (31 * j - (j * (j - 1)) / 2); }
constexpr int MB_LIST_STRIDE = 126976;
__device__ __forceinline__ int t5_bucket_dev(int n) {
    if (n < 16) return n;
    int large = 16 + (int)(logf((float)n / 16.f) / 2.0794415416798357f * 16.f);
    return large < 31 ? large : 31;
}
__device__ __forceinline__ void build_lut(Ctx& F) {
    LAS float* lut = (LAS float*)(F.lds + MISC_OFF + MO_LUT);
    for (int i = F.tid; i < 8 * 132; i += 512) { const int h = i / 132, d = i % 132; lut[i] = inp(F, I_RELB)[h * 32 + t5_bucket_dev(d < 128 ? d : 128)] * LOG2E; }
}
__device__ __forceinline__ void phase4(Ctx& F) {
    LAS int* lcnt = (LAS int*)(F.lds + MISC_OFF + MO_PRE); LAS int* lbase = lcnt + 32;
    const float* kbar = (const float*)(F.ws + WS_CTL + CTL_KBS);
    unsigned* cur = (unsigned*)(F.ws + WS_CTL) + CW_MBCUR;
    unsigned short* lists = (unsigned short*)(F.ws + WS_LMB);
    const int lane = F.lane, r32 = lane & 31, hi = lane >> 5;
    for (int u = F.bid; u < 32 * 31; u += F.G) {
        const int bh = u / 31, i = 1 + (u % 31), b = bh >> 3, h = bh & 7;
        if (F.tid < 32) lcnt[F.tid] = 0;
        __syncthreads();
        const int qpos = i * 256 + F.wave * 32 + r32;
        const float* kp = kbar + (size_t)(b * 32 + r32) * 512 + h * 64 + hi * 8;
        const bf16_t* qp = (const bf16_t*)(F.ws + WS_QMB) + (size_t)(b * SEQ + qpos) * QW + h * 64 + hi * 8;
        f32x16 gt = f32x16{};
#pragma unroll
        for (int s4 = 0; s4 < 4; ++s4) {
            const f32x4 k0 = *(const f32x4*)(kp + 16 * s4), k1 = *(const f32x4*)(kp + 16 * s4 + 4);
            const bf16x8 qf = *(const bf16x8*)(qp + 16 * s4);
            const unsigned a0 = cvtpk(k0.x, k0.y), a1 = cvtpk(k0.z, k0.w), a2 = cvtpk(k1.x, k1.y), a3 = cvtpk(k1.z, k1.w);
            const u32x4 kh = (u32x4){a0, a1, a2, a3};
            const u32x4 kl = (u32x4){cvtpk(k0.x - bflo(a0), k0.y - bfhi(a0)), cvtpk(k0.z - bflo(a1), k0.w - bfhi(a1)), cvtpk(k1.x - bflo(a2), k1.y - bfhi(a2)), cvtpk(k1.z - bflo(a3), k1.w - bfhi(a3))};
            gt = __builtin_amdgcn_mfma_f32_32x32x16_bf16(__builtin_bit_cast(bf16x8, kl), qf, gt, 0, 0, 0);
            gt = __builtin_amdgcn_mfma_f32_32x32x16_bf16(__builtin_bit_cast(bf16x8, kh), qf, gt, 0, 0, 0);
        }
        float v0 = -INFINITY, v1 = -INFINITY, v2 = -INFINITY; int j0 = 64, j1 = 64, j2 = 64;
#pragma unroll
        for (int r = 0; r < 16; ++r) { const int j = crow(r, hi); const float g = j < i ? gt[r] : -INFINITY;
            if (g > v0) { v2 = v1; j2 = j1; v1 = v0; j1 = j0; v0 = g; j0 = j; }
            else if (g > v1) { v2 = v1; j2 = j1; v1 = g; j1 = j; }
            else if (g > v2) { v2 = g; j2 = j; } }
        {
            const float pv[3] = {__shfl_xor(v0, 32), __shfl_xor(v1, 32), __shfl_xor(v2, 32)}; const int pj[3] = {__shfl_xor(j0, 32), __shfl_xor(j1, 32), __shfl_xor(j2, 32)};
#pragma unroll
            for (int t = 0; t < 3; ++t) { const float g = pv[t]; const int j = pj[t];
                if (g > v0 || (g == v0 && j < j0)) { v2 = v1; j2 = j1; v1 = v0; j1 = j0; v0 = g; j0 = j; }
                else if (g > v1 || (g == v1 && j < j1)) { v2 = v1; j2 = j1; v1 = g; j1 = j; }
                else if (g > v2 || (g == v2 && j < j2)) { v2 = g; j2 = j; } }
        }
        const int nsel = i < 3 ? i : 3;
        int r0 = 0, r1 = 0, r2 = 0;
        if (hi == 0) { r0 = lds_add(&lcnt[j0], 1); if (nsel > 1) r1 = lds_add(&lcnt[j1], 1); if (nsel > 2) r2 = lds_add(&lcnt[j2], 1); }
        __syncthreads();
        if (F.tid < i) { const int n = lcnt[F.tid]; lbase[F.tid] = n > 0 ? (int)atomicAdd(&cur[bh * 32 + F.tid], (unsigned)n) : 0; }
        __syncthreads();
        if (hi == 0) {
            unsigned short* lb = lists + (size_t)bh * MB_LIST_STRIDE;
            lb[mb_list_off(j0) + lbase[j0] + r0] = (unsigned short)(qpos | (0 << 13));
            if (nsel > 1) lb[mb_list_off(j1) + lbase[j1] + r1] = (unsigned short)(qpos | (1 << 13));
            if (nsel > 2) lb[mb_list_off(j2) + lbase[j2] + r2] = (unsigned short)(qpos | (2 << 13));
        }
    }
}
__device__ __forceinline__ void kv_dma(Ctx& F, const bf16_t* kg, const bf16_t* vg, int bufoff) {
    const int l = F.lane;
#pragma unroll
    for (int i = 0; i < 4; ++i) { const int p = 4 * F.wave + i;
        __builtin_amdgcn_global_load_lds((const unsigned*)(kg + (size_t)(8 * p + (l >> 3)) * QW + ((l & 7) ^ ((l >> 3) & 7)) * 8), (LAS unsigned*)(F.lds + bufoff + p * 1024), 16, 0, 0);
        __builtin_amdgcn_global_load_lds((const unsigned*)(vg + (size_t)((p >> 3) * 64 + (p & 3) * 16 + (l >> 2)) * QW + ((p >> 2) & 1) * 32 + (l & 3) * 8), (LAS unsigned*)(F.lds + bufoff + 32768 + p * 1024), 16, 0, 0); }
}
__device__ __forceinline__ void softmax_step(f32x16 (&t)[2], float& m, float& l, f32x16 (&o)[2], LAS float* wsf, const LAS unsigned char* vt, int lane) {
    const int r32 = lane & 31, hi = lane >> 5;
    float rm = -INFINITY;
#pragma unroll
    for (int p = 0; p < 2; ++p)
#pragma unroll
        for (int r = 0; r < 16; ++r) rm = fmaxf(rm, t[p][r]);
    rm = fmaxf(rm, xhalf(rm, hi));
    if (!__all(rm - m <= 8.f)) {
        const bool fresh = __all(l == 0.f);
        const float mn = fmaxf(m, rm);
        const float f = __builtin_amdgcn_exp2f(m - mn);
        m = mn; l *= f;
        if (!fresh) {
            if (hi == 0) wsf[r32] = f;
            LDS_WAIT();
#pragma unroll
            for (int g = 0; g < 4; ++g) { const f32x4 fv = *(const LAS f32x4*)(wsf + 8 * g + 4 * hi);
#pragma unroll
                for (int j = 0; j < 4; ++j) { o[0][4 * g + j] *= fv[j]; o[1][4 * g + j] *= fv[j]; } }
            LDS_WAIT();
        }
    }
    float s = 0.f; u32x4 pw[4];
#pragma unroll
    for (int p = 0; p < 2; ++p)
#pragma unroll
        for (int r = 0; r < 16; ++r) { const float e = __builtin_amdgcn_exp2f(t[p][r] - m); t[p][r] = e; s += e; }
    l += s;
#pragma unroll
    for (int idx = 0; idx < 8; ++idx) { const int p = idx >> 2, g4 = (idx & 3) * 4; pw[idx >> 1][(idx & 1) * 2] = cvtpk(t[p][g4], t[p][g4 + 1]); pw[idx >> 1][(idx & 1) * 2 + 1] = cvtpk(t[p][g4 + 2], t[p][g4 + 3]); }
    pv64(o, vt, lane, pw);
}
__device__ __forceinline__ void qkt64(f32x16 (&t)[2], const LAS unsigned char* kt, const bf16x8 (&qr)[4], int lane) {
    const int r32 = lane & 31, hi = lane >> 5;
    t[0] = f32x16{}; t[1] = f32x16{};
    const LAS unsigned char* rp = kt + r32 * 128;
#pragma unroll
    for (int d0 = 0; d0 < 4; ++d0) {
        const int pos = ((2 * d0 + hi) ^ (r32 & 7)) * 16;
        const bf16x8 k0 = *(const LAS bf16x8*)(rp + pos), k1 = *(const LAS bf16x8*)(rp + 4096 + pos);
        t[0] = __builtin_amdgcn_mfma_f32_32x32x16_bf16(k0, qr[d0], t[0], 0, 0, 0); t[1] = __builtin_amdgcn_mfma_f32_32x32x16_bf16(k1, qr[d0], t[1], 0, 0, 0);
    }
}
__device__ __forceinline__ void phase5(Ctx& F) {
    LAS int* pre = (LAS int*)(F.lds + MISC_OFF + MO_PRE);
    LAS int* wtot = (LAS int*)(F.lds + MISC_OFF + MO_ENT);
    const unsigned* cur = (const unsigned*)(F.ws + WS_CTL) + CW_MBCUR;
    build_lut(F);
    int total;
    {
        const int p0 = 2 * F.tid, p1 = p0 + 1;
        const int n0 = p0 < 992 ? (int)cur[(p0 / 31) * 32 + (p0 % 31)] : 0, n1 = p1 < 992 ? (int)cur[(p1 / 31) * 32 + (p1 % 31)] : 0;
        const int c0 = (n0 + 255) >> 8, c1 = (n1 + 255) >> 8;
        const int s = c0 + c1; int v = s;
#pragma unroll
        for (int o = 1; o < 64; o <<= 1) { const int n = __shfl_up(v, o); if (F.lane >= o) v += n; }
        if (F.lane == 63) wtot[248 + F.wave] = v;
        __syncthreads();
        int woff = 0; total = 0;
#pragma unroll
        for (int w = 0; w < 8; ++w) { const int x = wtot[248 + w]; if (w < F.wave) woff += x; total += x; }
        const int excl = woff + v - s;
        pre[p0] = excl | (n0 << 16); pre[p1] = (excl + c0) | (n1 << 16);
        __syncthreads();
    }
    const unsigned short* lists = (const unsigned short*)(F.ws + WS_LMB);
    LAS float* wsf = (LAS float*)(F.lds + MISC_OFF + MO_WSF) + F.wave * 128;
    LAS int* ent = (LAS int*)(F.lds + MISC_OFF + MO_ENT) + F.wave * 32;
    const int lane = F.lane, r32 = lane & 31, hi = lane >> 5;
#define P5_SEARCH(U, LO) do { int lo_ = 0, hi_ = 992; while (hi_ - lo_ > 1) { const int mid = (lo_ + hi_) >> 1; if ((pre[mid] & 0xffff) <= (U)) lo_ = mid; else hi_ = mid; } LO = lo_; } while (0)
    LAS int* utab = (LAS int*)(F.lds + MISC_OFF + MO_UT);
    if (F.tid < 64) { const int uu = F.bid + F.tid * F.G; int lo = 0; if (uu < total) P5_SEARCH(uu, lo); utab[F.tid] = lo; }
    __syncthreads();
#define P5_UNIT(K, U, BH, J, C, N) do { int lo_; if ((K) < 64) lo_ = utab[K]; else P5_SEARCH(U, lo_); \
        const int w_ = pre[lo_]; BH = lo_ / 31; J = lo_ % 31; C = (U) - (w_ & 0xffff); N = w_ >> 16; } while (0)
#define P5_DMA(BH, J, BUF) do { const bf16_t* b_ = (const bf16_t*)(F.ws + WS_QMB) + (size_t)((BH) >> 3) * SEQ * QW + ((BH) & 7) * 64; kv_dma(F, b_ + 512 + (size_t)((J) * 256) * QW, b_ + 1024 + (size_t)((J) * 256) * QW, (BUF) * 65536); } while (0)
#define P5_ENTRY(BH, J, C, N, ACT, VALID, ENTRY) do { const int e0_ = (C) * 256 + F.wave * 32; ACT = e0_ < (N); VALID = ACT && (e0_ + r32) < (N); \
        const unsigned short* lb_ = lists + (size_t)(BH) * MB_LIST_STRIDE + mb_list_off(J); ENTRY = ACT ? (int)lb_[VALID ? e0_ + r32 : e0_] : 0; } while (0)
#define P5_QLOAD(BH, ENTRY, Q) do { const bf16_t* b_ = (const bf16_t*)(F.ws + WS_QMB) + (size_t)((BH) >> 3) * SEQ * QW + ((BH) & 7) * 64 + (size_t)((ENTRY) & 8191) * QW + hi * 8; \
        _Pragma("unroll") for (int d0 = 0; d0 < 4; ++d0) Q[d0] = *(const bf16x8*)(b_ + d0 * 16); } while (0)
    int u = F.bid, bh = 0, j = 0, c = 0, n = 0, buf = 0, bhn = 0, jn = 0, cn = 0, nn = 0;
    bool act = false, valid = false, actn = false, validn = false; int entry = 0, entryn = 0; bf16x8 qr[4] = {};
    if (u < total) {
        P5_UNIT(0, u, bh, j, c, n); P5_ENTRY(bh, j, c, n, act, valid, entry);
        if (u + F.G < total) { P5_UNIT(1, u + F.G, bhn, jn, cn, nn); P5_ENTRY(bhn, jn, cn, nn, actn, validn, entryn); }
        P5_QLOAD(bh, entry, qr); P5_DMA(bh, j, 0);
    }
    asm volatile("s_waitcnt vmcnt(0)" : "+v"(qr[0]), "+v"(qr[1]), "+v"(qr[2]), "+v"(qr[3]), "+v"(entry), "+v"(entryn) :: "memory");
    for (int ku = 2; u < total; u += F.G, ++ku) {
        const bool has_next = u + F.G < total, has_n2 = u + 2 * F.G < total;
        int bh2 = 0, j2 = 0, c2 = 0, n2 = 0;
        if (has_n2) P5_UNIT(ku, u + 2 * F.G, bh2, j2, c2, n2);
        const int h = bh & 7;
        const int qpos = entry & 8191, slot = entry >> 13;
        bool act2 = false, valid2 = false; int entry2 = 0; bf16x8 qn[4] = {};
        if (has_next) P5_QLOAD(bhn, entryn, qn);
        if (has_n2) P5_ENTRY(bh2, j2, c2, n2, act2, valid2, entry2);
        LDS_WAIT();
        __builtin_amdgcn_s_barrier();
        if (has_next) P5_DMA(bhn, jn, buf ^ 1);
        const LAS unsigned char* kimg = F.lds + buf * 65536; const LAS unsigned char* vimg = kimg + 32768;
        float m = -INFINITY, l = 0.f; f32x16 o[2];
        if (act) {
            if (hi == 0) ent[r32] = valid ? entry : -1;
            o[0] = f32x16{}; o[1] = f32x16{};
            const LAS float* lut = (const LAS float*)(F.lds + MISC_OFF + MO_LUT) + h * 132;
            const float bfar = lut[128];
#pragma unroll 1
            for (int st = 0; st < 4; ++st) {
                f32x16 t[2]; qkt64(t, kimg + st * 8192, qr, lane);
                const int kbase = j * 256 + st * 64;
                const bool far = __all(qpos - (kbase + 63) >= 128);
                if (far) {
#pragma unroll
                    for (int pp = 0; pp < 2; ++pp)
#pragma unroll
                        for (int r = 0; r < 16; ++r) t[pp][r] = t[pp][r] * LOG2E + bfar;
                } else {
#pragma unroll
                    for (int pp = 0; pp < 2; ++pp)
#pragma unroll
                        for (int r = 0; r < 16; ++r) { int d = qpos - (kbase + 32 * pp + crow(r, hi)); d = d < 128 ? d : 128; d = d > 0 ? d : 0; t[pp][r] = t[pp][r] * LOG2E + lut[d]; }
                }
                softmax_step(t, m, l, o, wsf, vimg + st * 8192, lane);
            }
        }
        asm volatile("s_waitcnt vmcnt(0)" : "+v"(qn[0]), "+v"(qn[1]), "+v"(qn[2]), "+v"(qn[3]), "+v"(entry2) :: "memory");
#pragma unroll
        for (int d0 = 0; d0 < 4; ++d0) qr[d0] = qn[d0];
        if (act) {
            l += __shfl_xor(l, 32);
            const float rl = 1.f / l;
            if (hi == 0) { wsf[r32] = rl; if (valid) ((float*)(F.ws + WS_PLSE))[((size_t)bh * SEQ + qpos) * 3 + slot] = m + __log2f(l); }
            LDS_WAIT();
            {
                LAS bf16_t* stg = (LAS bf16_t*)(F.lds + MISC_OFF + MO_STG + F.wave * 2048);
                bf16_t* po = (bf16_t*)(F.ws + WS_PO);
#pragma unroll
                for (int qh = 0; qh < 2; ++qh) {
#pragma unroll
                    for (int r8 = 0; r8 < 8; ++r8) { const int r = 8 * qh + r8, q = crow(r, hi); const float sc = wsf[q];
                        stg[(q & 15) * 64 + r32] = (bf16_t)(cvtpk(o[0][r] * sc, 0.f) & 0xffffu); stg[(q & 15) * 64 + 32 + r32] = (bf16_t)(cvtpk(o[1][r] * sc, 0.f) & 0xffffu); }
                    LDS_WAIT();
#pragma unroll
                    for (int it2 = 0; it2 < 2; ++it2) { const int row = it2 * 8 + (lane >> 3), ch = lane & 7; const int en = ent[16 * qh + row];
                        const u32x4 v = *(const LAS u32x4*)(stg + row * 64 + ch * 8);
                        if (en >= 0) *(u32x4*)(po + (((size_t)bh * SEQ + (en & 8191)) * 3 + (en >> 13)) * 64 + ch * 8) = v; }
                    LDS_WAIT();
                }
            }
        }
        bh = bhn; j = jn; c = cn; n = nn; act = actn; valid = validn; entry = entryn;
        bhn = bh2; jn = j2; cn = c2; nn = n2; actn = act2; validn = valid2; entryn = entry2;
        buf ^= 1;
    }
#undef P5_ENTRY
#undef P5_QLOAD
#undef P5_UNIT
#undef P5_SEARCH
#undef P5_DMA
    asm volatile("s_waitcnt vmcnt(0)" ::: "memory");
    __syncthreads();
}
__device__ __forceinline__ void phase6(Ctx& F) {
    build_lut(F);
    LAS float* wsf = (LAS float*)(F.lds + MISC_OFF + MO_WSF) + F.wave * 128;
    const int lane = F.lane, r32 = lane & 31, hi = lane >> 5, w = F.wave;
#define P6_DMA(U, BUF) do { const int bh_ = (U) >> 5, i_ = 31 - ((U) & 31); const bf16_t* b_ = (const bf16_t*)(F.ws + WS_QMB) + (size_t)(bh_ >> 3) * SEQ * QW + (bh_ & 7) * 64; \
        kv_dma(F, b_ + 512 + (size_t)(i_ * 256) * QW, b_ + 1024 + (size_t)(i_ * 256) * QW, (BUF) * 65536); } while (0)
#define P6_QLOAD(U, Q, L0, L1, L2) do { const int bh_ = (U) >> 5, i_ = 31 - ((U) & 31), qp_ = i_ * 256 + w * 32 + r32, ns_ = i_ < 3 ? i_ : 3; \
        const bf16_t* b_ = (const bf16_t*)(F.ws + WS_QMB) + (size_t)(bh_ >> 3) * SEQ * QW + (bh_ & 7) * 64 + (size_t)qp_ * QW + hi * 8; \
        _Pragma("unroll") for (int d0 = 0; d0 < 4; ++d0) Q[d0] = *(const bf16x8*)(b_ + d0 * 16); \
        const float* pl_ = (const float*)(F.ws + WS_PLSE) + ((size_t)bh_ * SEQ + qp_) * 3; \
        L0 = -INFINITY; L1 = -INFINITY; L2 = -INFINITY; if (ns_ > 0) L0 = pl_[0]; if (ns_ > 1) L1 = pl_[1]; if (ns_ > 2) L2 = pl_[2]; } while (0)
    int buf = 0;
    bf16x8 qr[4] = {}; float ls0 = -INFINITY, ls1 = -INFINITY, ls2 = -INFINITY;
    if (F.bid < 32 * 32) { P6_QLOAD(F.bid, qr, ls0, ls1, ls2); P6_DMA(F.bid, 0); }
    asm volatile("s_waitcnt vmcnt(0)" : "+v"(qr[0]), "+v"(qr[1]), "+v"(qr[2]), "+v"(qr[3]), "+v"(ls0), "+v"(ls1), "+v"(ls2) :: "memory");
    for (int u = F.bid; u < 32 * 32; u += F.G) {
        const int bh = u >> 5, i = 31 - (u & 31), b = bh >> 3, h = bh & 7;
        const int ql = w * 32 + r32;
        const int nsel = i < 3 ? i : 3;
        const bool has_next = u + F.G < 32 * 32;
        LDS_WAIT();
        __builtin_amdgcn_s_barrier();
        if (has_next) P6_DMA(u + F.G, buf ^ 1);
        const LAS unsigned char* kimg = F.lds + buf * 65536; const LAS unsigned char* vimg = kimg + 32768;
        float m = -INFINITY, l = 0.f; f32x16 o[2]; o[0] = f32x16{}; o[1] = f32x16{};
        const LAS float* lut = (const LAS float*)(F.lds + MISC_OFF + MO_LUT) + h * 132;
        const int nst = (w >> 1) + 1;
#pragma unroll 1
        for (int st = 0; st < nst; ++st) {
            f32x16 t[2]; qkt64(t, kimg + st * 8192, qr, lane);
#pragma unroll
            for (int pp = 0; pp < 2; ++pp)
#pragma unroll
                for (int r = 0; r < 16; ++r) { const int d = ql - (st * 64 + 32 * pp + crow(r, hi)); const int dc = d < 128 ? (d > 0 ? d : 0) : 128; const float v = t[pp][r] * LOG2E + lut[dc]; t[pp][r] = d >= 0 ? v : -INFINITY; }
            softmax_step(t, m, l, o, wsf, vimg + st * 8192, lane);
        }
        l += __shfl_xor(l, 32);
        const float M = fmaxf(fmaxf(m, ls0), fmaxf(ls1, ls2));
        const float eo = __builtin_amdgcn_exp2f(m - M), e0 = __builtin_amdgcn_exp2f(ls0 - M), e1 = __builtin_amdgcn_exp2f(ls1 - M), e2 = __builtin_amdgcn_exp2f(ls2 - M);
        const float rden = 1.f / (l * eo + e0 + e1 + e2);
        if (hi == 0) *(LAS f32x4*)(wsf + 4 * r32) = (f32x4){eo * rden, e0 * rden, e1 * rden, e2 * rden};
        LDS_WAIT();
#pragma unroll
        for (int r = 0; r < 16; ++r) { const float fo = wsf[4 * crow(r, hi)]; o[0][r] *= fo; o[1][r] *= fo; }
        LDS_WAIT();
        __builtin_amdgcn_s_barrier();
        {
            const bf16_t* po = (const bf16_t*)(F.ws + WS_PO) + ((size_t)bh * SEQ + i * 256 + w * 32) * 3 * 64;
            u32x4 pv[4][3];
#pragma unroll
            for (int it4 = 0; it4 < 4; ++it4) { const int row = it4 * 8 + (lane >> 3), ch = lane & 7;
#pragma unroll
                for (int sl = 0; sl < 3; ++sl) { pv[it4][sl] = (u32x4){0u, 0u, 0u, 0u}; if (sl < nsel) pv[it4][sl] = __builtin_nontemporal_load((const u32x4*)(po + (size_t)(row * 3 + sl) * 64 + ch * 8)); } }
            bf16x8 qn[4] = {}; float ln0 = -INFINITY, ln1 = -INFINITY, ln2 = -INFINITY;
            if (has_next) P6_QLOAD(u + F.G, qn, ln0, ln1, ln2);
            LAS bf16_t* stg = (LAS bf16_t*)(F.lds + buf * 65536 + w * 4096);
#pragma unroll
            for (int r = 0; r < 16; ++r) { const int orow = crow(r, hi);
#pragma unroll
                for (int d0 = 0; d0 < 2; ++d0) stg[orow * 64 + d0 * 32 + r32] = (bf16_t)(cvtpk(o[d0][r], 0.f) & 0xffffu); }
            LDS_WAIT();
            asm volatile("s_waitcnt vmcnt(0)" : "+v"(qn[0]), "+v"(qn[1]), "+v"(qn[2]), "+v"(qn[3]), "+v"(ln0), "+v"(ln1), "+v"(ln2) :: "memory");
#pragma unroll
            for (int it4 = 0; it4 < 4; ++it4)
#pragma unroll
                for (int sl = 0; sl < 3; ++sl) asm volatile("" : "+v"(pv[it4][sl]));
            bf16_t* dst = (bf16_t*)(F.ws + WS_OB) + (size_t)(b * SEQ + i * 256 + w * 32) * 1024 + 512 + h * 64;
#pragma unroll
            for (int it4 = 0; it4 < 4; ++it4) { const int row = it4 * 8 + (lane >> 3), ch = lane & 7;
                const u32x4 ov = *(const LAS u32x4*)(stg + row * 64 + ch * 8);
                float a[8] = {bflo(ov.x), bfhi(ov.x), bflo(ov.y), bfhi(ov.y), bflo(ov.z), bfhi(ov.z), bflo(ov.w), bfhi(ov.w)};
                const f32x4 fc = *(const LAS f32x4*)(wsf + 4 * row);
#pragma unroll
                for (int sl = 0; sl < 3; ++sl) if (sl < nsel) { const u32x4 pvv = pv[it4][sl]; const float f = fc[1 + sl];
                    a[0] += f * bflo(pvv.x); a[1] += f * bfhi(pvv.x); a[2] += f * bflo(pvv.y); a[3] += f * bfhi(pvv.y); a[4] += f * bflo(pvv.z); a[5] += f * bfhi(pvv.z); a[6] += f * bflo(pvv.w); a[7] += f * bfhi(pvv.w); }
                u32x4 w4; w4.x = cvtpk(a[0], a[1]); w4.y = cvtpk(a[2], a[3]); w4.z = cvtpk(a[4], a[5]); w4.w = cvtpk(a[6], a[7]);
                *(u32x4*)(dst + (size_t)row * 1024 + ch * 8) = w4; }
            LDS_WAIT();
#pragma unroll
            for (int d0 = 0; d0 < 4; ++d0) qr[d0] = qn[d0];
            ls0 = ln0; ls1 = ln1; ls2 = ln2;
        }
        buf ^= 1;
    }
#undef P6_DMA
#undef P6_QLOAD
    asm volatile("s_waitcnt vmcnt(0)" ::: "memory");
    __syncthreads();
}

struct BranchSched {
    const char* A; const char* Bt; int G, c; int R[2], C[2];
    __device__ __forceinline__ bool next(int i, gm::UnitD& u) {
        int pm, pn; if (!gm::static_tile(MT, 1024, G, c, i, pm, pn)) return false;
        u.a = A; u.b = Bt + (size_t)(pn * 256) * 1024 * 2;
#pragma unroll
        for (int h = 0; h < 2; ++h)
#pragma unroll
            for (int j = 0; j < 2; ++j) u.va[h][j] = (unsigned)((pm * 256 + h * 128 + R[j]) * 1024 + C[j]) * 2u;
        u.e0 = pm; u.e1 = pn; u.e2 = 0; u.e3 = 0; return true;
    }
};
struct EpiBranch {
    const bf16_t* g; bf16_t* merged;
    static __device__ __forceinline__ float ratio(float gs, float gm_) { return (1.f + fminf(__expf(-gm_), 1e30f)) * __builtin_amdgcn_rcpf(1.f + __expf(-gs)); }
    __device__ __forceinline__ void mid(f32x4 (&acc)[2][2][4][2], const gm::UnitD& u, int wr, int wc, int fr, int fq) const {
        const bf16_t* gp = g + (size_t)(u.e0 * 256 + wr * 64 + fr) * 2048 + u.e1 * 256 + wc * 32 + 8 * fq;
#pragma unroll
        for (int ai = 0; ai < 2; ++ai)
#pragma unroll
            for (int m = 0; m < 4; m += 2) {
                asm volatile("" : "+v"(gp) :: "memory");
                u32x4 gs[2][2], gq[2][2];
#pragma unroll
                for (int mm = 0; mm < 2; ++mm)
#pragma unroll
                    for (int bj = 0; bj < 2; ++bj) { gs[mm][bj] = __builtin_nontemporal_load((const u32x4*)(gp + (size_t)mm * 16 * 2048 + bj * 128)); gq[mm][bj] = *(const u32x4*)(gp + (size_t)mm * 16 * 2048 + 1024 + bj * 128); }
#pragma unroll
                for (int mm = 0; mm < 2; ++mm)
#pragma unroll
                    for (int bj = 0; bj < 2; ++bj) { const u32x4 a = gs[mm][bj], b = gq[mm][bj];
                        f32x4& c0 = acc[ai][bj][m + mm][0]; f32x4& c1 = acc[ai][bj][m + mm][1];
                        c0[0] *= ratio(bflo(a.x), bflo(b.x)); c0[1] *= ratio(bfhi(a.x), bfhi(b.x)); c0[2] *= ratio(bflo(a.y), bflo(b.y)); c0[3] *= ratio(bfhi(a.y), bfhi(b.y));
                        c1[0] *= ratio(bflo(a.z), bflo(b.z)); c1[1] *= ratio(bfhi(a.z), bfhi(b.z)); c1[2] *= ratio(bflo(a.w), bflo(b.w)); c1[3] *= ratio(bfhi(a.w), bfhi(b.w));
                        asm volatile("" : "+v"(c0), "+v"(c1) :: "memory"); }
                gp += (m == 2 ? 96 : 32) * 2048; }
    }
    __device__ __forceinline__ void operator()(const f32x4 (&acc)[2][2][4][2], const gm::UnitD& u, int wr, int wc, int fr, int fq) const {
        const int row0 = u.e0 * 256 + wr * 64 + fr, col0 = u.e1 * 256 + wc * 32 + 8 * fq;
#pragma unroll
        for (int ai = 0; ai < 2; ++ai)
#pragma unroll
            for (int m = 0; m < 4; ++m) { const size_t row = (size_t)(row0 + ai * 128 + m * 16);
#pragma unroll
                for (int bj = 0; bj < 2; ++bj) { const u32x4 gm_ = __builtin_nontemporal_load((const u32x4*)(g + row * 2048 + 1024 + col0 + bj * 128));
                    const float b[8] = {bflo(gm_.x), bfhi(gm_.x), bflo(gm_.y), bfhi(gm_.y), bflo(gm_.z), bfhi(gm_.z), bflo(gm_.w), bfhi(gm_.w)};
                    float r[8];
#pragma unroll
                    for (int j = 0; j < 8; ++j) r[j] = acc[ai][bj][m][j >> 2][j & 3] * __builtin_amdgcn_rcpf(1.f + fminf(__expf(-b[j]), 1e30f));
                    u32x4 w; w.x = cvtpk(r[0], r[1]); w.y = cvtpk(r[2], r[3]); w.z = cvtpk(r[4], r[5]); w.w = cvtpk(r[6], r[7]);
                    *(u32x4*)(merged + row * 1024 + col0 + bj * 128) = w; } }
    }
};
__device__ __forceinline__ void phase7(Ctx& F) {
    BranchSched S; S.A = (const char*)(F.ws + WS_OB); S.Bt = (const char*)(F.ws + WS_WBRT); S.G = F.G; S.c = F.bid; gm::stage_geom(F.tid, S.R, S.C);
    EpiBranch E{(const bf16_t*)(F.ws + WS_G), (bf16_t*)(F.ws + WS_MERGED)};
    gm::gemm_phase<true, true>(F.lds, 1024, S, E);
}
struct OutSched {
    const char* A; const char* Bt; int G, c; int R[2], C[2];
    __device__ __forceinline__ bool next(int i, gm::UnitD& u) {
        int pm, pn; if (!gm::static_tile(MT, 1024, G, c, i, pm, pn)) return false;
        u.a = A; u.b = Bt + (size_t)pn * 256 * 1024 * 2;
#pragma unroll
        for (int h = 0; h < 2; ++h)
#pragma unroll
            for (int j = 0; j < 2; ++j) u.va[h][j] = (unsigned)((pm * 256 + h * 128 + R[j]) * 1024 + C[j]) * 2u;
        u.e0 = pm; u.e1 = pn; u.e2 = 0; u.e3 = 0; return true;
    }
};
struct EpiOut {
    const float* x; const float* mod; bf16_t* out;
    __device__ __forceinline__ void operator()(const f32x4 (&acc)[2][2][4][2], const gm::UnitD& u, int wr, int wc, int fr, int fq) const {
        const int pm = u.e0, pn = u.e1, b = (pm * 256) / SEQ;
        const int row0 = pm * 256 + wr * 64 + fr, col0 = pn * 256 + wc * 32 + 8 * fq;
        f32x4 gt[2][2];
#pragma unroll
        for (int bj = 0; bj < 2; ++bj)
#pragma unroll
            for (int n = 0; n < 2; ++n) gt[bj][n] = *(const f32x4*)(mod + b * NMOD + 2 * DM + col0 + bj * 128 + n * 4);
#pragma unroll
        for (int ai = 0; ai < 2; ++ai) {
            f32x4 xv[4][2][2];
#pragma unroll
            for (int m = 0; m < 4; ++m) { const size_t off = (size_t)(row0 + ai * 128 + m * 16) * DM + col0;
#pragma unroll
                for (int bj = 0; bj < 2; ++bj)
#pragma unroll
                    for (int n = 0; n < 2; ++n) xv[m][bj][n] = __builtin_nontemporal_load((const f32x4*)(x + off + bj * 128 + n * 4)); }
            asm volatile("" : "+v"(xv[0][0][0]), "+v"(xv[0][0][1]), "+v"(xv[0][1][0]), "+v"(xv[0][1][1]), "+v"(xv[1][0][0]), "+v"(xv[1][0][1]), "+v"(xv[1][1][0]), "+v"(xv[1][1][1]),
                              "+v"(xv[2][0][0]), "+v"(xv[2][0][1]), "+v"(xv[2][1][0]), "+v"(xv[2][1][1]), "+v"(xv[3][0][0]), "+v"(xv[3][0][1]), "+v"(xv[3][1][0]), "+v"(xv[3][1][1]));
#pragma unroll
            for (int m = 0; m < 4; ++m) { const size_t off = (size_t)(row0 + ai * 128 + m * 16) * DM + col0;
#pragma unroll
                for (int bj = 0; bj < 2; ++bj) { const f32x4 r0 = xv[m][bj][0] + gt[bj][0] * acc[ai][bj][m][0], r1 = xv[m][bj][1] + gt[bj][1] * acc[ai][bj][m][1];
                    u32x4 pk; pk.x = cvtpk(r0.x, r0.y); pk.y = cvtpk(r0.z, r0.w); pk.z = cvtpk(r1.x, r1.y); pk.w = cvtpk(r1.z, r1.w); *(u32x4*)(out + off + bj * 128) = pk; } }
        }
    }
};
__device__ __forceinline__ void phase8(Ctx& F) {
    OutSched S; S.A = (const char*)(F.ws + WS_MERGED); S.Bt = (const char*)(F.ws + WS_WOUTT); S.G = F.G; S.c = F.bid; gm::stage_geom(F.tid, S.R, S.C);
    EpiOut E{inp(F, I_X), (const float*)(F.ws + WS_SMALL + SM_MOD), (bf16_t*)(F.ws + WS_X1B)};
    gm::gemm_phase<true>(F.lds, 1024, S, E);
}

constexpr int NR_SSQ = MO_PRE + 1024;
constexpr int NR_RS = MO_PRE + 3072;
__device__ __forceinline__ void phase_n2r(Ctx& F, int rr) {
    const bf16_t* x1 = (const bf16_t*)(F.ws + WS_X1B); const float* gvec = (const float*)(F.ws + WS_SMALL + SM_GVEC); const float* cb = (const float*)(F.ws + WS_SMALL + SM_CB);
    const float* mod = (const float*)(F.ws + WS_SMALL + SM_MOD); const float* rbias = inp(F, I_RB);
    unsigned char* H2 = (unsigned char*)(F.ws + WS_H2) + (size_t)rr * RT * DM; int* tokl = (int*)(F.ws + WS_TOKL) + (size_t)rr * 64 * RT; float* wl = (float*)(F.ws + WS_WL) + (size_t)rr * 64 * RT; int* tpos = (int*)(F.ws + WS_TPOS) + (size_t)rr * RT * 8;
    unsigned* cur = (unsigned*)(F.ws + WS_CTL) + CW_MOECUR + rr * 64;
    LAS int* lcnt = (LAS int*)(F.lds + MISC_OFF + MO_PRE); LAS int* lbase = lcnt + 64;
    LAS float* part = (LAS float*)(F.lds);
    LAS float* ssqp = (LAS float*)(F.lds + MISC_OFF + NR_SSQ); LAS float* rsl = (LAS float*)(F.lds + MISC_OFF + NR_RS);
    const int lane = F.lane, w = F.wave, i16 = lane & 15, kk = lane >> 4;
    for (int u = F.bid; u < RT / 64; u += F.G) {
        if (F.tid < 64) lcnt[F.tid] = 0;
        const int tokb = rr * RT + u * 64, b = tokb / SEQ;
        {
            bf16x8 fah[4][4], fal[4][4];
            {
                const float* gp = gvec + b * DM + 128 * w + 8 * kk;
                f32x4 gv[4][2];
#pragma unroll
                for (int s4 = 0; s4 < 4; ++s4) { gv[s4][0] = *(const f32x4*)(gp + 32 * s4); gv[s4][1] = *(const f32x4*)(gp + 32 * s4 + 4); }
                u32x4 xba[4][4];
#pragma unroll
                for (int tt = 0; tt < 4; ++tt) {
                    const bf16_t* xp = x1 + (size_t)(tokb + tt * 16 + i16) * DM + 128 * w + 8 * kk;
#pragma unroll
                    for (int s4 = 0; s4 < 4; ++s4) xba[tt][s4] = *(const u32x4*)(xp + 32 * s4);
                }
                asm volatile("" : "+v"(xba[0][0]), "+v"(xba[0][1]), "+v"(xba[0][2]), "+v"(xba[0][3]), "+v"(xba[1][0]), "+v"(xba[1][1]), "+v"(xba[1][2]), "+v"(xba[1][3]),
                                  "+v"(xba[2][0]), "+v"(xba[2][1]), "+v"(xba[2][2]), "+v"(xba[2][3]), "+v"(xba[3][0]), "+v"(xba[3][1]), "+v"(xba[3][2]), "+v"(xba[3][3]));
#pragma unroll
                for (int tt = 0; tt < 4; ++tt) {
                    const u32x4 (&xb)[4] = xba[tt];
                    float ssq = 0.f;
#pragma unroll
                    for (int s4 = 0; s4 < 4; ++s4) {
                        u32x4 ah, al;
#pragma unroll
                        for (int q = 0; q < 2; ++q) { const unsigned b0 = q ? xb[s4].z : xb[s4].x, b1 = q ? xb[s4].w : xb[s4].y; const f32x4 xv = (f32x4){bflo(b0), bfhi(b0), bflo(b1), bfhi(b1)}; ssq += (xv.x * xv.x + xv.y * xv.y) + (xv.z * xv.z + xv.w * xv.w);
                            const f32x4 a = xv * gv[s4][q];
                            const unsigned h0 = cvtpk(a.x, a.y), h1 = cvtpk(a.z, a.w);
                            ah[2 * q] = h0; ah[2 * q + 1] = h1; al[2 * q] = cvtpk(a.x - bflo(h0), a.y - bfhi(h0)); al[2 * q + 1] = cvtpk(a.z - bflo(h1), a.w - bfhi(h1)); }
                        fah[tt][s4] = __builtin_bit_cast(bf16x8, ah); fal[tt][s4] = __builtin_bit_cast(bf16x8, al);
                    }
                    ssq += __shfl_xor(ssq, 16); ssq += __shfl_xor(ssq, 32); if (kk == 0) ssqp[w * 64 + tt * 16 + i16] = ssq;
                }
            }
#pragma unroll 1
            for (int eh = 0; eh < 2; ++eh) {
                bf16x8 wh[2][4], wl_[2][4];
                {
                    const bf16_t* ph = (const bf16_t*)(F.ws + WS_SMALL + SM_WRH) + (size_t)(eh * 32 + i16) * DM + 128 * w + 8 * kk;
                    const bf16_t* pl = (const bf16_t*)(F.ws + WS_SMALL + SM_WRL) + (size_t)(eh * 32 + i16) * DM + 128 * w + 8 * kk;
#pragma unroll
                    for (int c = 0; c < 2; ++c)
#pragma unroll
                        for (int s4 = 0; s4 < 4; ++s4) { wh[c][s4] = *(const bf16x8*)(ph + (size_t)c * 16 * DM + 32 * s4); wl_[c][s4] = *(const bf16x8*)(pl + (size_t)c * 16 * DM + 32 * s4); }
                    asm volatile("" : "+v"(wh[0][0]), "+v"(wh[0][1]), "+v"(wh[0][2]), "+v"(wh[0][3]), "+v"(wh[1][0]), "+v"(wh[1][1]), "+v"(wh[1][2]), "+v"(wh[1][3]),
                                      "+v"(wl_[0][0]), "+v"(wl_[0][1]), "+v"(wl_[0][2]), "+v"(wl_[0][3]), "+v"(wl_[1][0]), "+v"(wl_[1][1]), "+v"(wl_[1][2]), "+v"(wl_[1][3]));
                }
#pragma unroll
                for (int tt = 0; tt < 4; ++tt) {
                    f32x4 acc[2]; acc[0] = acc[1] = (f32x4){0.f, 0.f, 0.f, 0.f};
#pragma unroll
                    for (int s4 = 0; s4 < 4; ++s4)
#pragma unroll
                        for (int c = 0; c < 2; ++c) {
                            acc[c] = __builtin_amdgcn_mfma_f32_16x16x32_bf16(fal[tt][s4], wh[c][s4], acc[c], 0, 0, 0);
                            acc[c] = __builtin_amdgcn_mfma_f32_16x16x32_bf16(fah[tt][s4], wl_[c][s4], acc[c], 0, 0, 0);
                            acc[c] = __builtin_amdgcn_mfma_f32_16x16x32_bf16(fah[tt][s4], wh[c][s4], acc[c], 0, 0, 0); }
#pragma unroll
                    for (int c = 0; c < 2; ++c)
#pragma unroll
                        for (int reg = 0; reg < 4; ++reg) part[(w * 64 + tt * 16 + 4 * kk + reg) * 64 + eh * 32 + 16 * c + i16] = acc[c][reg];
                }
            }
        }
        __syncthreads();
#define N2R_H2LOAD(XQ, R0) do { _Pragma("unroll") for (int r = 0; r < 4; ++r) { const u32x2* xr_ = (const u32x2*)(x1 + (size_t)(tokb + w * 8 + (R0) + r) * DM) + lane; \
            _Pragma("unroll") for (int j = 0; j < 4; ++j) XQ[r][j] = xr_[64 * j]; } } while (0)
#define N2R_H2DONE(XQ, R0) do { \
            asm volatile("" : "+v"(XQ[0][0]), "+v"(XQ[0][1]), "+v"(XQ[0][2]), "+v"(XQ[0][3]), "+v"(XQ[1][0]), "+v"(XQ[1][1]), "+v"(XQ[1][2]), "+v"(XQ[1][3]), \
                              "+v"(XQ[2][0]), "+v"(XQ[2][1]), "+v"(XQ[2][2]), "+v"(XQ[2][3]), "+v"(XQ[3][0]), "+v"(XQ[3][1]), "+v"(XQ[3][2]), "+v"(XQ[3][3])); \
            _Pragma("unroll") for (int j = 0; j < 4; ++j) { \
                _Pragma("unroll") for (int r = 0; r < 4; ++r) { const int tl2 = w * 8 + (R0) + r; const u32x2 q = XQ[r][j]; const f32x4 hv = ((f32x4){bflo(q.x), bfhi(q.x), bflo(q.y), bfhi(q.y)} * rsl[tl2]) * hgq[j] + hsh[j]; \
                    int o = 0; o = __builtin_amdgcn_cvt_pk_fp8_f32(f8c(hv.x * 16.f), f8c(hv.y * 16.f), o, false); o = __builtin_amdgcn_cvt_pk_fp8_f32(f8c(hv.z * 16.f), f8c(hv.w * 16.f), o, true); \
                    ((unsigned*)(H2 + (size_t)(tokb - rr * RT + tl2) * DM) + lane)[64 * j] = (unsigned)o; } } } while (0)
        const int tl = F.tid >> 3, g = F.tid & 7;
        const f32x4 cb0 = *(const f32x4*)(cb + b * 64 + 8 * g), cb1 = *(const f32x4*)(cb + b * 64 + 8 * g + 4), rb0 = *(const f32x4*)(rbias + 8 * g), rb1 = *(const f32x4*)(rbias + 8 * g + 4);
        f32x4 hgq[4], hsh[4];
#pragma unroll
        for (int j = 0; j < 4; ++j) { const int col = 4 * lane + 256 * j; hgq[j] = *(const f32x4*)(gvec + b * DM + col); hsh[j] = *(const f32x4*)(mod + b * NMOD + 3 * DM + col); }
        u32x2 xqa[4][4], xqb[4][4];
        N2R_H2LOAD(xqa, 0);
        int my_e; float my_w; int my_rank;
        {
            float ssq = 0.f;
#pragma unroll
            for (int q = 0; q < 8; ++q) ssq += ssqp[q * 64 + tl];
            const float rstd = rsqrtf(ssq * (1.f / DM) + EPS);
            if (g == 0) rsl[tl] = rstd;
            float s8[8], c8[8];
            {
                f32x4 lo4 = (f32x4){0.f, 0.f, 0.f, 0.f}, hi4 = lo4;
#pragma unroll
                for (int q = 0; q < 8; ++q) { const LAS f32x4* pp = (const LAS f32x4*)(part + (q * 64 + tl) * 64 + 8 * g); lo4 += pp[0]; hi4 += pp[1]; }
#pragma unroll
                for (int j = 0; j < 4; ++j) { s8[j] = sigmoidf_(lo4[j] * rstd + cb0[j]); s8[4 + j] = sigmoidf_(hi4[j] * rstd + cb1[j]); c8[j] = s8[j] + rb0[j]; c8[4 + j] = s8[4 + j] + rb1[j]; }
            }
            float m1 = -INFINITY, m2 = -INFINITY;
#pragma unroll
            for (int j = 0; j < 8; ++j) { const float v = c8[j]; if (v > m1) { m2 = m1; m1 = v; } else if (v > m2) m2 = v; }
            const float gs = m1 + m2;
            int rank = 0;
#pragma unroll
            for (int g2 = 0; g2 < 8; ++g2) { const float o = __shfl(gs, g2, 8); rank += (o > gs || (o == gs && g2 < g)) ? 1 : 0; }
            if (rank >= 4) {
#pragma unroll
                for (int j = 0; j < 8; ++j) c8[j] = -INFINITY;
            }
            int sel_e[8]; float sk[8]; float wsum = 0.f;
#pragma unroll
            for (int k = 0; k < 8; ++k) {
                float bv = -INFINITY, bs = 0.f; int be = 8 * g;
#pragma unroll
                for (int j = 0; j < 8; ++j) if (c8[j] > bv) { bv = c8[j]; be = 8 * g + j; bs = s8[j]; }
#pragma unroll
                for (int o = 1; o < 8; o <<= 1) { const float ov = __shfl_xor(bv, o, 8), os = __shfl_xor(bs, o, 8); const int oe = __shfl_xor(be, o, 8); if (ov > bv || (ov == bv && oe < be)) { bv = ov; be = oe; bs = os; } }
                sel_e[k] = be; sk[k] = bs; wsum += bs;
#pragma unroll
                for (int j = 0; j < 8; ++j) if (be == 8 * g + j) c8[j] = -INFINITY;
            }
            my_e = sel_e[0]; my_w = sk[0];
#pragma unroll
            for (int k = 1; k < 8; ++k) if (g == k) { my_e = sel_e[k]; my_w = sk[k]; }
            my_w *= 2.5f / wsum;
            my_rank = lds_add(&lcnt[my_e], 1);
        }
        __syncthreads();
        int abase = 0;
        if (F.tid < 64) { const int n = lcnt[F.tid]; if (n > 0) abase = (int)atomicAdd(&cur[F.tid], (unsigned)n); }
        N2R_H2DONE(xqa, 0);
        N2R_H2LOAD(xqb, 4);
        if (F.tid < 64) lbase[F.tid] = abase;
        __syncthreads();
        { const int tok = tokb + tl, pos = lbase[my_e] + my_rank; tokl[my_e * RT + pos] = tok * 8 + g; wl[my_e * RT + pos] = my_w; tpos[(tok - rr * RT) * 8 + g] = (my_e << 16) | pos; }
        N2R_H2DONE(xqb, 4);
#undef N2R_H2LOAD
#undef N2R_H2DONE
        __syncthreads();
    }
}
constexpr int MO_TE = 4224;
struct MoeTabs { const LAS unsigned short* te; const LAS int* tb; const LAS int* cnt; int TR; };
__device__ __forceinline__ MoeTabs build_moe_tabs(Ctx& F, int rr) {
    LAS unsigned short* te = (LAS unsigned short*)(F.lds + MISC_OFF + MO_TE); LAS int* tb = (LAS int*)(F.lds + MISC_OFF + MO_TE + 1536); LAS int* cnt = tb + 72;
    const unsigned* cur = (const unsigned*)(F.ws + WS_CTL) + CW_MOECUR + rr * 64;
    __syncthreads();
    if (F.tid == 0) { int acc = 0; for (int e = 0; e < 64; ++e) { const int c = (int)cur[e]; cnt[e] = c; tb[e] = acc; acc += (c + 255) >> 8; } tb[64] = acc; tb[65] = acc + RT / 256; cnt[64] = RT; }
    __syncthreads();
    const int TR = tb[64];
    for (int e = F.tid >> 3; e < 65; e += 64) for (int t = tb[e] + (F.tid & 7); t < tb[e + 1]; t += 8) te[t] = (unsigned short)e;
    __syncthreads();
    MoeTabs T; T.te = te; T.tb = tb; T.cnt = cnt; T.TR = TR; return T;
}
struct Moe1Sched {
    const char* H2; const char* W1T; const int* tokl; MoeTabs T; int G, c, rr; int R[2], C[2];
    const float* wl; LAS float* rwbuf;
    __device__ __forceinline__ bool next(int i, gm::UnitD& u) {
        const int uu = i * G + c; const int nt = T.TR + RT / 256;
        if (uu >= nt * 2) return false;
        const int tile = uu >> 1, pn = uu & 1, e = T.te[tile], rt = tile - T.tb[e], cnt = T.cnt[e];
        { const int tid = threadIdx.x;
          if (e < 64 && tid < 256) __builtin_amdgcn_global_load_lds((const unsigned*)(wl + (size_t)e * RT + rt * 256 + tid), (LAS unsigned*)(rwbuf + (i & 1) * 256 + (tid & ~63)), 4, 0, 0); }
        u.a = H2; u.b = W1T + (size_t)(e * 512 + pn * 256) * 1024;
        int trow[2][2];
#pragma unroll
        for (int h = 0; h < 2; ++h)
#pragma unroll
            for (int j = 0; j < 2; ++j) trow[h][j] = rt * 256 + h * 128 + R[j];
        if (e < 64) {
            int ent[2][2];
#pragma unroll
            for (int h = 0; h < 2; ++h)
#pragma unroll
                for (int j = 0; j < 2; ++j) ent[h][j] = tokl[e * RT + (trow[h][j] < cnt ? trow[h][j] : rt * 256)];
            asm volatile("" : "+v"(ent[0][0]), "+v"(ent[0][1]), "+v"(ent[1][0]), "+v"(ent[1][1]));
#pragma unroll
            for (int h = 0; h < 2; ++h)
#pragma unroll
                for (int j = 0; j < 2; ++j) trow[h][j] = (ent[h][j] >> 3) - rr * RT;
        }
#pragma unroll
        for (int h = 0; h < 2; ++h)
#pragma unroll
            for (int j = 0; j < 2; ++j) u.va[h][j] = (unsigned)(trow[h][j] * 512 + C[j]) * 2u;
        u.e0 = tile; u.e1 = pn | ((i & 1) << 1); u.e2 = e; u.e3 = rt; return true;
    }
};
struct EpiMoe1 {
    bf16_t* act; const LAS float* rwbuf; const LAS int* cnt;
    __device__ __forceinline__ void operator()(const f32x4 (&acc)[2][2][4][2], const gm::UnitD& u, int wr, int wc, int fr, int fq) const {
        const int row0 = u.e0 * 256 + wr * 64 + fr, hi = fq & 1, colw = (u.e1 & 1) * 128 + wc * 32 + 8 * (fq & ~1), e = u.e2, n = cnt[e];
        float rw[2][4];
        if (e < 64) {
            const LAS float* rb = rwbuf + (u.e1 >> 1) * 256 + wr * 64 + fr;
#pragma unroll
            for (int ai = 0; ai < 2; ++ai)
#pragma unroll
                for (int m = 0; m < 4; ++m) { const int idx = u.e3 * 256 + ai * 128 + wr * 64 + m * 16 + fr; const float v = rb[ai * 128 + m * 16]; rw[ai][m] = idx < n ? v : 0.f; }
        } else {
#pragma unroll
            for (int ai = 0; ai < 2; ++ai)
#pragma unroll
                for (int m = 0; m < 4; ++m) rw[ai][m] = 1.f;
        }
#pragma unroll
        for (int ai = 0; ai < 2; ++ai)
            {   unsigned Px[4], Py[4];
#pragma unroll
                for (int m = 0; m < 4; ++m) { const float ww = rw[ai][m] * (32.f / 4096.f); const f32x4 g0 = acc[ai][0][m][0] * (1.f / 4096.f), g1 = acc[ai][0][m][1] * (1.f / 4096.f), u0 = acc[ai][1][m][0] * ww, u1 = acc[ai][1][m][1] * ww;
                    int w0 = 0, w1 = 0;
                    w0 = __builtin_amdgcn_cvt_pk_fp8_f32(f8c(siluf_(g0[0]) * u0[0]), f8c(siluf_(g0[1]) * u0[1]), w0, false); w0 = __builtin_amdgcn_cvt_pk_fp8_f32(f8c(siluf_(g0[2]) * u0[2]), f8c(siluf_(g0[3]) * u0[3]), w0, true);
                    w1 = __builtin_amdgcn_cvt_pk_fp8_f32(f8c(siluf_(g1[0]) * u1[0]), f8c(siluf_(g1[1]) * u1[1]), w1, false); w1 = __builtin_amdgcn_cvt_pk_fp8_f32(f8c(siluf_(g1[2]) * u1[2]), f8c(siluf_(g1[3]) * u1[3]), w1, true);
                    Px[m] = (unsigned)w0; Py[m] = (unsigned)w1; }
#pragma unroll
                for (int m = 0; m < 4; m += 2) { gm::pl32swap(Px[m], Px[m + 1]); gm::pl32swap(Py[m], Py[m + 1]);
                    *(u32x4*)((unsigned char*)act + (size_t)(row0 + ai * 128 + (m + hi) * 16) * 256 + colw) = (u32x4){Px[m], Py[m], Px[m + 1], Py[m + 1]}; } }
    }
};
__device__ __forceinline__ void phase_moe1(Ctx& F, int rr) {
    Moe1Sched S; S.T = build_moe_tabs(F, rr); S.H2 = (const char*)(F.ws + WS_H2) + (size_t)rr * RT * DM; S.W1T = (const char*)(F.ws + WS_W1T); S.tokl = (const int*)(F.ws + WS_TOKL) + (size_t)rr * 64 * RT; S.G = F.G; S.c = (F.G % 8 == 0) ? (F.bid % 8) * (F.G / 8) + F.bid / 8 : F.bid; S.rr = rr; gm::stage_geom(F.tid, S.R, S.C);
    S.wl = (const float*)(F.ws + WS_WL) + (size_t)rr * 64 * RT; S.rwbuf = (LAS float*)(F.lds + MISC_OFF + MO_STG);
    EpiMoe1 E{(bf16_t*)(F.ws + WS_ACT), S.rwbuf, S.T.cnt};
    gm::gemm_phase<true, false, true>(F.lds, 512, S, E);
}
struct Moe2Sched {
    const char* ACT; const char* W2T; MoeTabs T; int G, c; int R[2], C[2];
    __device__ __forceinline__ bool next(int i, gm::UnitD& u) {
        const int uu = i * G + c; const int nt = T.TR + RT / 256;
        if (uu >= nt * 4) return false;
        const int tile = uu >> 2, pn = uu & 3, e = T.te[tile], rt = tile - T.tb[e];
        u.a = ACT + (size_t)tile * 256 * 256; u.b = W2T + (size_t)(e * 1024 + pn * 256) * 256;
#pragma unroll
        for (int h = 0; h < 2; ++h)
#pragma unroll
            for (int j = 0; j < 2; ++j) u.va[h][j] = (unsigned)((h * 128 + R[j]) * 128 + C[j]) * 2u;
        u.e0 = pn; u.e1 = e; u.e2 = rt; u.e3 = tile; return true;
    }
};
struct EpiMoe2 {
    bf16_t* slots; bf16_t* shout; const LAS int* cnt;
    __device__ __forceinline__ void operator()(const f32x4 (&acc)[2][2][4][2], const gm::UnitD& u, int wr, int wc, int fr, int fq) const {
        const int pn = u.e0, e = u.e1, rt = u.e2, tile = u.e3;
        const int col0 = pn * 256 + wc * 32 + 8 * fq, n = cnt[e];
        if (e < 64) {
            const int hi = fq & 1;
            unsigned char* base = (unsigned char*)slots + (size_t)(tile * 256 + wr * 64 + fr) * 1024 + pn * 256 + wc * 32 + 8 * (fq & ~1);
#pragma unroll
            for (int ai = 0; ai < 2; ++ai)
#pragma unroll
                for (int bj = 0; bj < 2; ++bj) {
                    unsigned Px[4], Py[4];
#pragma unroll
                    for (int m = 0; m < 4; ++m) { f32x4 v0 = acc[ai][bj][m][0] * (16.f / 4096.f), v1 = acc[ai][bj][m][1] * (16.f / 4096.f);
#pragma unroll
                        for (int j = 0; j < 4; ++j) { v0[j] = __builtin_amdgcn_fmed3f(v0[j], -440.f, 440.f); v1[j] = __builtin_amdgcn_fmed3f(v1[j], -440.f, 440.f); }
                        int w0 = 0, w1 = 0;
                        w0 = __builtin_amdgcn_cvt_pk_fp8_f32(v0[0], v0[1], w0, false); w0 = __builtin_amdgcn_cvt_pk_fp8_f32(v0[2], v0[3], w0, true);
                        w1 = __builtin_amdgcn_cvt_pk_fp8_f32(v1[0], v1[1], w1, false); w1 = __builtin_amdgcn_cvt_pk_fp8_f32(v1[2], v1[3], w1, true);
                        Px[m] = (unsigned)w0; Py[m] = (unsigned)w1; }
#pragma unroll
                    for (int m = 0; m < 4; m += 2) { gm::pl32swap(Px[m], Px[m + 1]); gm::pl32swap(Py[m], Py[m + 1]);
                        if (rt * 256 + ai * 128 + wr * 64 + (m + hi) * 16 + fr < n)
                            *(u32x4*)(base + (size_t)(ai * 128 + (m + hi) * 16) * 1024 + bj * 128) = (u32x4){Px[m], Py[m], Px[m + 1], Py[m + 1]}; } }
        } else {
            bf16_t* base = shout + (size_t)(rt * 256 + wr * 64 + fr) * 1024 + col0;
#pragma unroll
            for (int ai = 0; ai < 2; ++ai)
#pragma unroll
                for (int m = 0; m < 4; ++m)
#pragma unroll
                    for (int bj = 0; bj < 2; ++bj) { const f32x4 v0 = acc[ai][bj][m][0] * (1.f / 4096.f), v1 = acc[ai][bj][m][1] * (1.f / 4096.f);
                        u32x4 o; o.x = cvtpk(v0[0], v0[1]); o.y = cvtpk(v0[2], v0[3]); o.z = cvtpk(v1[0], v1[1]); o.w = cvtpk(v1[2], v1[3]); *(u32x4*)(base + (size_t)(ai * 128 + m * 16) * 1024 + bj * 128) = o; }
        }
    }
};
__device__ __forceinline__ void phase_moe2(Ctx& F, int rr) {
    Moe2Sched S; S.T = build_moe_tabs(F, rr); S.ACT = (const char*)(F.ws + WS_ACT); S.W2T = (const char*)(F.ws + WS_W2T); S.G = F.G; S.c = (F.G % 8 == 0) ? (F.bid % 8) * (F.G / 8) + F.bid / 8 : F.bid; gm::stage_geom(F.tid, S.R, S.C);
    EpiMoe2 E{(bf16_t*)(F.ws + WS_SLOTS), (bf16_t*)(F.ws + WS_SHOUT), S.T.cnt};
    gm::gemm_phase<true, false, true>(F.lds, 128, S, E);
}
__device__ __forceinline__ void phase_final(Ctx& F, int rr) {
    const MoeTabs T = build_moe_tabs(F, rr);
    const float* mod = (const float*)(F.ws + WS_SMALL + SM_MOD); const float* fg = inp(F, I_FG);
    const unsigned char* slots = (const unsigned char*)(F.ws + WS_SLOTS); const int* tpos = (const int*)(F.ws + WS_TPOS) + (size_t)rr * RT * 8;
    const int gw = F.bid * 8 + F.wave, NGW = F.G * 8, c0 = F.lane * 8;
    struct Tok { u32x2 sv[8][2]; u32x4 sh[2]; u32x4 xq[2]; f32x4 g2[2][2]; };
#define FIN_TPOS(TT, TPV) do { TPV = tpos[(size_t)(TT) * 8 + (F.lane & 7)]; } while (0)
#define FIN_ISSUE(TT, X, TPV) do { \
        _Pragma("unroll") for (int k = 0; k < 8; ++k) { const int v_ = __builtin_amdgcn_readlane(TPV, k); const unsigned char* rp_ = slots + (size_t)(T.tb[v_ >> 16] * 256 + (v_ & 0xffff)) * 1024 + c0; \
            X.sv[k][0] = __builtin_nontemporal_load((const u32x2*)(rp_)); X.sv[k][1] = __builtin_nontemporal_load((const u32x2*)(rp_ + 512)); } \
        { const bf16_t* sp_ = (const bf16_t*)(F.ws + WS_SHOUT) + (size_t)(TT) * 1024 + c0; X.sh[0] = __builtin_nontemporal_load((const u32x4*)sp_); X.sh[1] = __builtin_nontemporal_load((const u32x4*)(sp_ + 512)); } \
        { const bf16_t* xp_ = (const bf16_t*)(F.ws + WS_X1B) + (size_t)(rr * RT + (TT)) * DM + c0; X.xq[0] = __builtin_nontemporal_load((const u32x4*)xp_); X.xq[1] = __builtin_nontemporal_load((const u32x4*)(xp_ + 512)); } \
        { const float* g2_ = mod + ((rr * RT + (TT)) / SEQ) * NMOD + 5 * DM + c0; _Pragma("unroll") for (int h = 0; h < 2; ++h) { X.g2[h][0] = *(const f32x4*)(g2_ + h * 512); X.g2[h][1] = *(const f32x4*)(g2_ + h * 512 + 4); } } } while (0)
#define FIN_DONE(TT, X) do { const int tok_ = rr * RT + (TT); float* orow_ = F.out + (size_t)tok_ * DM + c0; \
          \
        asm volatile("" : "+v"(X.sv[0][0]), "+v"(X.sv[0][1]), "+v"(X.sv[1][0]), "+v"(X.sv[1][1]), "+v"(X.sv[2][0]), "+v"(X.sv[2][1]), "+v"(X.sv[3][0]), "+v"(X.sv[3][1]), \
                          "+v"(X.sv[4][0]), "+v"(X.sv[4][1]), "+v"(X.sv[5][0]), "+v"(X.sv[5][1]), "+v"(X.sv[6][0]), "+v"(X.sv[6][1]), "+v"(X.sv[7][0]), "+v"(X.sv[7][1])); \
        asm volatile("" : "+v"(X.sh[0]), "+v"(X.sh[1]), "+v"(X.xq[0]), "+v"(X.xq[1]), "+v"(X.g2[0][0]), "+v"(X.g2[0][1]), "+v"(X.g2[1][0]), "+v"(X.g2[1][1])); \
        float s_ = 0.f; f32x4 v_[2][2]; \
        _Pragma("unroll") for (int h = 0; h < 2; ++h) { \
            f32x4 a0 = (f32x4){0.f, 0.f, 0.f, 0.f}, a1 = a0; \
            _Pragma("unroll") for (int k = 0; k < 8; ++k) { const u32x2 w = X.sv[k][h]; \
                const f32x2 p0 = __builtin_amdgcn_cvt_pk_f32_fp8((int)w.x, false), p1 = __builtin_amdgcn_cvt_pk_f32_fp8((int)w.x, true), p2 = __builtin_amdgcn_cvt_pk_f32_fp8((int)w.y, false), p3 = __builtin_amdgcn_cvt_pk_f32_fp8((int)w.y, true); \
                a0 += (f32x4){p0.x, p0.y, p1.x, p1.y}; a1 += (f32x4){p2.x, p2.y, p3.x, p3.y}; } \
            { const u32x4 w = X.sh[h]; a0 = a0 * 0.0625f + (f32x4){bflo(w.x), bfhi(w.x), bflo(w.y), bfhi(w.y)}; a1 = a1 * 0.0625f + (f32x4){bflo(w.z), bfhi(w.z), bflo(w.w), bfhi(w.w)}; } \
            const u32x4 q = X.xq[h]; \
            v_[h][0] = (f32x4){bflo(q.x), bfhi(q.x), bflo(q.y), bfhi(q.y)} + X.g2[h][0] * a0; v_[h][1] = (f32x4){bflo(q.z), bfhi(q.z), bflo(q.w), bfhi(q.w)} + X.g2[h][1] * a1; \
            _Pragma("unroll") for (int q2 = 0; q2 < 2; ++q2) s_ += (v_[h][q2].x * v_[h][q2].x + v_[h][q2].y * v_[h][q2].y) + (v_[h][q2].z * v_[h][q2].z + v_[h][q2].w * v_[h][q2].w); } \
        const float rstd_ = rsqrtf(wave_sum(s_) * (1.f / DM) + EPS); \
        _Pragma("unroll") for (int h = 0; h < 2; ++h) _Pragma("unroll") for (int q2 = 0; q2 < 2; ++q2) __builtin_nontemporal_store((v_[h][q2] * rstd_) * fgv[h][q2], (f32x4*)(orow_ + h * 512 + 4 * q2)); } while (0)
    f32x4 fgv[2][2];
#pragma unroll
    for (int h = 0; h < 2; ++h)
#pragma unroll
        for (int q2 = 0; q2 < 2; ++q2) fgv[h][q2] = *(const f32x4*)(fg + c0 + h * 512 + 4 * q2);
    Tok A, B; int tpA = 0, tpB = 0;
    if (gw < RT) { FIN_TPOS(gw, tpA); if (gw + NGW < RT) FIN_TPOS(gw + NGW, tpB); FIN_ISSUE(gw, A, tpA); }
    int t = gw;
#pragma unroll 1
    for (; t + 3 * NGW < RT; t += 2 * NGW) {
        const int t1 = t + NGW, t2 = t + 2 * NGW, t3 = t + 3 * NGW;
        FIN_TPOS(t2, tpA); FIN_ISSUE(t1, B, tpB); __builtin_amdgcn_sched_barrier(0);
        FIN_DONE(t, A); __builtin_amdgcn_sched_barrier(0);
        FIN_TPOS(t3, tpB); FIN_ISSUE(t2, A, tpA); __builtin_amdgcn_sched_barrier(0);
        FIN_DONE(t1, B); __builtin_amdgcn_sched_barrier(0);
    }
#pragma unroll 1
    for (; t < RT; t += 2 * NGW) {
        const int t1 = t + NGW, t2 = t + 2 * NGW, t3 = t + 3 * NGW;
        if (t1 < RT) { if (t2 < RT) FIN_TPOS(t2, tpA); FIN_ISSUE(t1, B, tpB); }
        FIN_DONE(t, A);
        if (t2 < RT) { if (t3 < RT) FIN_TPOS(t3, tpB); FIN_ISSUE(t2, A, tpA); }
        if (t1 < RT) FIN_DONE(t1, B);
    }
#undef FIN_TPOS
#undef FIN_ISSUE
#undef FIN_DONE
}

constexpr int N_PHASES = 10;
__global__ void __launch_bounds__(512, 2) mega_fwd(Args args) {
    extern __shared__ __attribute__((aligned(16))) unsigned char lds_raw[];
    Ctx F; F.lds = (LAS unsigned char*)lds_raw; F.ws = args.ws; F.out = args.out;
    {
        typedef __attribute__((address_space(4))) const unsigned long long* karg_t;
        const karg_t ka = (karg_t)__builtin_amdgcn_kernarg_segment_ptr();
        LAS unsigned long long* tab = (LAS unsigned long long*)(lds_raw + MISC_OFF + 14336);
        if (threadIdx.x < 20) tab[threadIdx.x] = ka[threadIdx.x];
        F.intab = tab;
    }
    F.tid = threadIdx.x; F.lane = F.tid & 63; F.wave = __builtin_amdgcn_readfirstlane(F.tid >> 6); F.G = gridDim.x; F.bid = blockIdx.x;
    volatile LAS unsigned* st = (volatile LAS unsigned*)(F.lds + MISC_OFF + MO_ST);
    if (F.tid < 4) st[F.tid] = 0u;
    __syncthreads();
    XcdBarrier bar = xcd_barrier_post((unsigned*)(F.ws + WS_CTL) + CW_BAR, st);
    if (threadIdx.x == 0) { unsigned nloc, nx; xcd_barrier_complete(bar.bar, bar.x, nloc, nx); st[0] = nloc; st[1] = nx; }
    int lo = args.ph_lo, hi = args.ph_hi;
    { int a = lo, b = hi; asm volatile("" : "+v"(a), "+v"(b)); lo = __builtin_amdgcn_readfirstlane(a); hi = __builtin_amdgcn_readfirstlane(b); }
    launder(F);
#ifndef PH_MASK
#define PH_MASK 0x1ffff
#endif
#define PH_ON(k) ((PH_MASK >> (k)) & 1)
#define IN(k) (lo <= (k) && (k) < hi)
#define SEAM(k) do { if (IN(k) && IN((k) + 1)) { bar.bar = launder_ptr(bar.bar); xcd_barrier(bar); } } while (0)
#define RUN(k, call) do { if (PH_ON(k) && IN(k)) { launder(F); call; } } while (0)
    RUN(0, phase0(F)); SEAM(0);
    RUN(1, phase1(F)); SEAM(1);
    RUN(2, phase2(F)); SEAM(2);
    RUN(4, (phase4(F), sb_units(F))); SEAM(4);
    RUN(5, phase5(F)); SEAM(5);
    RUN(6, phase6(F)); SEAM(6);
    RUN(7, phase7(F)); SEAM(7);
    RUN(8, phase8(F)); SEAM(8);
    if (PH_ON(9) && IN(9)) {
        const int par = (F.bid >> 3) & 1;
#pragma unroll 1
        for (int i = 0; i < 8; ++i) {
            launder(F);
            int op, rr; bool bar_after = true;
            switch (i) {
                case 0: op = 0; rr = 0; break;
                case 1: op = 1; rr = 0; break;
                case 2: op = par ? 0 : 2; rr = par ? 1 : 0; bar_after = false; break;
                case 3: op = par ? 2 : 0; rr = par ? 0 : 1; break;
                case 4: op = par ? 1 : 3; rr = par ? 1 : 0; bar_after = false; break;
                case 5: op = par ? 3 : 1; rr = par ? 0 : 1; break;
                case 6: op = 2; rr = 1; break;
                default: op = 3; rr = 1; bar_after = false; break;
            }
            switch (op) {
                case 0: launder(F); phase_n2r(F, rr); break;
                case 1: launder(F); phase_moe1(F, rr); break;
                case 2: launder(F); phase_moe2(F, rr); break;
                default: launder(F); phase_final(F, rr); break;
            }
            if (bar_after) { bar.bar = launder_ptr(bar.bar); xcd_barrier(bar); } else __syncthreads();
        }
    }
#undef IN
#undef SEAM
#undef RUN
}

#ifndef MK_SPLIT
#define MK_SPLIT 0
#endif
extern "C" void kernel_launch(void* const* d_in, const int* in_sizes, int n_in, void* d_out, int out_size, void* d_ws, size_t ws_size, hipStream_t stream) {
    static int grid = 0;
    if (grid == 0) {
        if (n_in != 20 || in_sizes[0] != MT * DM || out_size != MT * DM || ws_size < WS_END) { fprintf(stderr, "kernel_launch: unexpected shapes (n_in %d, in0 %d, out %d, ws %zu)\n", n_in, n_in > 0 ? in_sizes[0] : -1, out_size, ws_size); grid = -1; return; }
        int dev = 0, cus = 0;
        if (hipGetDevice(&dev) != hipSuccess || hipDeviceGetAttribute(&cus, hipDeviceAttributeMultiprocessorCount, dev) != hipSuccess) { grid = -1; return; }
        if (hipFuncSetAttribute((const void*)mega_fwd, hipFuncAttributeMaxDynamicSharedMemorySize, LDS_BYTES) != hipSuccess) { fprintf(stderr, "kernel_launch: hipFuncSetAttribute failed\n"); grid = -1; return; }
        int per_cu = 0;
        if (hipOccupancyMaxActiveBlocksPerMultiprocessor(&per_cu, (const void*)mega_fwd, 512, LDS_BYTES) != hipSuccess || per_cu < 1) fprintf(stderr, "kernel_launch: occupancy query reports %d\n", per_cu);
        (void)hipGetLastError();
        grid = cus;
    }
    if (grid < 0) return;
    (void)hipMemsetAsync((char*)d_ws + WS_CTL, 0, 16 * CTL_BYTES, stream);
    Args a{};
    for (int i = 0; i < 20; ++i) a.in[i] = (const float*)d_in[i];
    a.out = (float*)d_out; a.ws = (unsigned char*)d_ws;
#if MK_SPLIT
    for (int p = 0; p < N_PHASES; ++p) { a.ph_lo = p; a.ph_hi = p + 1; hipLaunchKernelGGL(mega_fwd, dim3(grid), dim3(512), LDS_BYTES, stream, a); }
#else
    a.ph_lo = 0; a.ph_hi = N_PHASES;
    hipLaunchKernelGGL(mega_fwd, dim3(grid), dim3(512), LDS_BYTES, stream, a);
#endif
}
```
